# Optimizing an MI355X kernel written in HIP

```python
import math
import jax, jax.numpy as jnp
from jax import lax
import numpy as np

D_MODEL = 1024
BATCH = 16
SEQ = 256
DEPTH = 2
DEC_BATCH = 4
DEC_SEQ = 4096
PAST_LEN = 256

GRID_W = 64
N_AB_LAYERS = (DEPTH + 1) // 2
N_C_LAYERS = DEPTH // 2
CONV_CH = D_MODEL // 2
CONV_WIDTH = 31
M_HEADS = 4
M_DK = (D_MODEL // 2) // M_HEADS
M_DV = (D_MODEL // 2) // M_HEADS
M_WIDTH = M_HEADS * M_DV
CHUNK = 64
FORGET_BIAS = 3.0
AB_IN = 2 * CONV_CH + 4 * M_WIDTH + 4 * M_HEADS
HEAD_DIM = 128
N_Q = D_MODEL // HEAD_DIM
N_KV = 2
GROUP = N_Q // N_KV
C_IN = (N_Q + 2 * N_KV) * HEAD_DIM
Q_BLOCK = 128
ROPE_THETA = 10000.0
D_FF = -(-8 * D_MODEL // (3 * 256)) * 256
EPS = 1e-6

kernel_name = 'hybrid_diffusion_conv_mlstm_gqa_step'


def rms_norm(x, g):
    x32 = x.astype(jnp.float32)
    y = x32 * lax.rsqrt(jnp.mean(x32 * x32, axis=-1, keepdims=True) + EPS)
    return (y * g.astype(jnp.float32)).astype(x.dtype)


def layer_norm(x, g, b):
    x32 = x.astype(jnp.float32)
    mu = jnp.mean(x32, axis=-1, keepdims=True)
    var = jnp.mean(jnp.square(x32 - mu), axis=-1, keepdims=True)
    y = (x32 - mu) * lax.rsqrt(var + EPS)
    return (y * g.astype(jnp.float32) + b.astype(jnp.float32)).astype(x.dtype)


def adaln(cond, w, b):
    mod = jax.nn.silu(cond) @ w + b
    return jnp.split(mod[:, None, :], 6, axis=-1)


def modulate(x, g, shift, scale):
    return rms_norm(x, g) * (1 + scale) + shift


def swiglu(h, w_in, w_out):
    gt, up = jnp.split(h @ w_in, 2, axis=-1)
    return (jax.nn.silu(gt) * up) @ w_out


def depthwise_conv(x, w, b):
    y = lax.conv_general_dilated(
        x, w[:, None, :], window_strides=(1,),
        padding=[(CONV_WIDTH // 2, CONV_WIDTH // 2)],
        dimension_numbers=('NWC', 'WIO', 'NWC'),
        feature_group_count=x.shape[-1])
    return y + b


def mlstm_scan(q, k, v, log_i, log_f, state):
    B, S, H, _ = q.shape
    DV = v.shape[-1]
    nc = S // CHUNK

    def chunks(a):
        a = a.reshape((B, nc, CHUNK, H) + a.shape[3:])
        return jnp.moveaxis(a, 3, 2).swapaxes(0, 1)

    mask = jnp.tril(jnp.ones((CHUNK, CHUNK), dtype=bool))

    def step(carry, xs):
        C, n, m = carry
        qc, kc, vc, ic, fc = xs
        b = jnp.cumsum(fc, axis=-1)
        logd = jnp.where(mask, b[..., :, None] - b[..., None, :] + ic[..., None, :], -jnp.inf)
        inter = b + m[..., None]
        m_t = jnp.maximum(inter, jnp.max(logd, axis=-1))
        dmat = jnp.exp(logd - m_t[..., None])
        w_inter = jnp.exp(inter - m_t)
        s = jnp.einsum('bhtd,bhsd->bhts', qc, kc) * dmat
        num = jnp.einsum('bhts,bhsv->bhtv', s, vc) + w_inter[..., None] * jnp.einsum('bhtd,bhdv->bhtv', qc, C)
        den = jnp.sum(s, axis=-1) + w_inter * jnp.einsum('bhtd,bhd->bht', qc, n)
        h = num / jnp.maximum(jnp.abs(den), jnp.exp(-m_t))[..., None]
        b_end = b[..., -1]
        log_w = b_end[..., None] - b + ic
        m_new = jnp.maximum(b_end + m, jnp.max(log_w, axis=-1))
        w = jnp.exp(log_w - m_new[..., None])
        a = jnp.exp(b_end + m - m_new)
        C_new = a[..., None, None] * C + jnp.einsum('bhsd,bhsv->bhdv', kc * w[..., None], vc)
        n_new = a[..., None] * n + jnp.einsum('bhs,bhsd->bhd', w, kc)
        return (C_new, n_new, m_new), h

    state, h = lax.scan(step, state, (chunks(q), chunks(k), chunks(v), chunks(log_i), chunks(log_f)))
    h = jnp.moveaxis(h.swapaxes(0, 1), 2, 3).reshape(B, S, H, DV)
    return h, state


def mlstm_bidir(q, k, v, gates, state_f, state_b):
    i_f, f_f, i_b, f_b = jnp.split(gates, 4, axis=-1)
    h_f, st_f = mlstm_scan(q, k, v, i_f, jax.nn.log_sigmoid(f_f), state_f)
    flip = lambda a: jnp.flip(a, axis=1)
    h_b, st_b = mlstm_scan(flip(q), flip(k), flip(v), flip(i_b), flip(jax.nn.log_sigmoid(f_b)), state_b)
    return h_f + flip(h_b), st_f, st_b


def ab_mixer(h, w_in, b_gate, conv_w, conv_b, ln_g, ln_b, mnorm_g, w_out, state_f, state_b):
    B, S, _ = h.shape
    p = h @ w_in
    cuts = [CONV_CH, 2 * CONV_CH, 2 * CONV_CH + M_WIDTH, 2 * CONV_CH + 2 * M_WIDTH,
            2 * CONV_CH + 3 * M_WIDTH, 2 * CONV_CH + 4 * M_WIDTH]
    ga, gg, q, k, v, o, gates = jnp.split(p, cuts, axis=-1)
    u = ga * jax.nn.sigmoid(gg)
    u = jax.nn.silu(layer_norm(depthwise_conv(u, conv_w, conv_b), ln_g, ln_b))
    f32 = jnp.float32
    q32 = q.reshape(B, S, M_HEADS, M_DK).astype(f32)
    k32 = k.reshape(B, S, M_HEADS, M_DK).astype(f32) * (M_DK ** -0.5)
    v32 = v.reshape(B, S, M_HEADS, M_DV).astype(f32)
    g32 = (gates + b_gate).astype(f32)
    hm, st_f, st_b = mlstm_bidir(q32, k32, v32, g32, state_f, state_b)
    hm = hm * lax.rsqrt(jnp.mean(hm * hm, axis=-1, keepdims=True) + EPS)
    hm = (hm * mnorm_g.astype(f32).reshape(M_HEADS, M_DV)).reshape(B, S, M_WIDTH).astype(h.dtype)
    hm = jax.nn.sigmoid(o) * hm
    out = jnp.concatenate([u, hm], axis=-1) @ w_out
    return out, st_f, st_b


def rope_2d(x):
    S = x.shape[1]
    rows = S // GRID_W
    t_row = jnp.repeat(jnp.arange(rows), GRID_W)
    t_col = jnp.tile(jnp.arange(GRID_W), rows)
    n_freq = HEAD_DIM // 4
    inv = 1.0 / (ROPE_THETA ** (jnp.arange(n_freq, dtype=jnp.float32) / n_freq))

    def rot(xa, pos):
        ang = pos.astype(jnp.float32)[:, None] * inv
        cos = jnp.cos(ang)[None, :, None, :]
        sin = jnp.sin(ang)[None, :, None, :]
        x1, x2 = jnp.split(xa, 2, axis=-1)
        return jnp.concatenate([x1 * cos - x2 * sin, x1 * sin + x2 * cos], axis=-1)

    xr, xc = jnp.split(x.astype(jnp.float32), 2, axis=-1)
    return jnp.concatenate([rot(xr, t_row), rot(xc, t_col)], axis=-1).astype(x.dtype)


def blocked_attention(q, k, v):
    B, Sq = q.shape[:2]
    nb = Sq // Q_BLOCK
    qb = q.reshape(B, nb, Q_BLOCK, N_KV, GROUP, HEAD_DIM).swapaxes(0, 1)
    scale = HEAD_DIM ** -0.5

    def one(qblk):
        s = jnp.einsum('bqhgd,bshd->bhgqs', qblk, k).astype(jnp.float32) * scale
        p = jax.nn.softmax(s, axis=-1).astype(v.dtype)
        return jnp.einsum('bhgqs,bshd->bqhgd', p, v)

    o = lax.map(one, qb)
    return o.swapaxes(0, 1).reshape(B, Sq, N_Q * HEAD_DIM)


def qkv_proj(h, w_in, qg, kg):
    B, S, _ = h.shape
    q, k, v = jnp.split(h @ w_in, [N_Q * HEAD_DIM, (N_Q + N_KV) * HEAD_DIM], axis=-1)
    q = rms_norm(q.reshape(B, S, N_Q, HEAD_DIM), qg)
    k = rms_norm(k.reshape(B, S, N_KV, HEAD_DIM), kg)
    return q, k, v.reshape(B, S, N_KV, HEAD_DIM)


def attn_context(h, w_in, qg, kg, w_out):
    B, S, _ = h.shape
    q, k, v = qkv_proj(h, w_in, qg, kg)
    o = blocked_attention(q.reshape(B, S, N_KV, GROUP, HEAD_DIM), k, v)
    return o @ w_out, k, v


def attn_latent(h, w_in, qg, kg, w_out, k_ctx, v_ctx):
    B, S, _ = h.shape
    q, k, v = qkv_proj(h, w_in, qg, kg)
    q, k = rope_2d(q), rope_2d(k)
    k_all = jnp.concatenate([k, k_ctx.astype(k.dtype)], axis=1)
    v_all = jnp.concatenate([v, v_ctx.astype(v.dtype)], axis=1)
    o = blocked_attention(q.reshape(B, S, N_KV, GROUP, HEAD_DIM), k_all, v_all)
    return o @ w_out


def setup_inputs(seed: int = 0) -> dict:
    key = jax.random.key(seed)
    ks = iter(jax.random.split(key, 40))

    def nrm(shape, scale=1.0):
        return scale * jax.random.normal(next(ks), shape, jnp.float32)

    D = D_MODEL
    gate_offset = jnp.tile(jnp.concatenate([jnp.zeros((M_HEADS,), jnp.float32),
                                            jnp.full((M_HEADS,), FORGET_BIAS, jnp.float32)]), 2)
    return {
        'x_prompt': nrm((BATCH, SEQ, D)),
        'x_sample': nrm((DEC_BATCH, DEC_SEQ, D)),
        'c': nrm((DEC_BATCH, D)),
        'state_mlstm_C': nrm((DEC_BATCH, N_AB_LAYERS, 2, M_HEADS, M_DK, M_DV), 0.5),
        'state_mlstm_n': nrm((DEC_BATCH, N_AB_LAYERS, 2, M_HEADS, M_DK), 0.5),
        'state_mlstm_m': nrm((DEC_BATCH, N_AB_LAYERS, 2, M_HEADS)),
        'cache_k': nrm((DEC_BATCH, N_C_LAYERS, PAST_LEN, N_KV, HEAD_DIM)),
        'cache_v': nrm((DEC_BATCH, N_C_LAYERS, PAST_LEN, N_KV, HEAD_DIM)),
        'c_ctx': nrm((D,)),
        'w_mod': nrm((DEPTH, D, 6 * D), D ** -0.5),
        'b_mod': nrm((DEPTH, 6 * D), 0.02),
        'norm1_g': 1.0 + nrm((DEPTH, D), 0.02),
        'norm2_g': 1.0 + nrm((DEPTH, D), 0.02),
        'w_in_ab': nrm((N_AB_LAYERS, D, AB_IN), D ** -0.5),
        'b_gate_ab': gate_offset + nrm((N_AB_LAYERS, 4 * M_HEADS), 0.1),
        'conv_w': nrm((N_AB_LAYERS, CONV_WIDTH, CONV_CH), CONV_WIDTH ** -0.5),
        'conv_b': nrm((N_AB_LAYERS, CONV_CH), 0.02),
        'conv_ln_g': 1.0 + nrm((N_AB_LAYERS, CONV_CH), 0.02),
        'conv_ln_b': nrm((N_AB_LAYERS, CONV_CH), 0.02),
        'mlstm_norm_g': 1.0 + nrm((N_AB_LAYERS, M_WIDTH), 0.02),
        'w_out_ab': nrm((N_AB_LAYERS, CONV_CH + M_WIDTH, D), (CONV_CH + M_WIDTH) ** -0.5),
        'w_in_c': nrm((N_C_LAYERS, D, C_IN), D ** -0.5),
        'q_norm_g': 1.0 + nrm((N_C_LAYERS, HEAD_DIM), 0.02),
        'k_norm_g': 1.0 + nrm((N_C_LAYERS, HEAD_DIM), 0.02),
        'w_out_c': nrm((N_C_LAYERS, N_Q * HEAD_DIM, D), (N_Q * HEAD_DIM) ** -0.5),
        'w_ffn_in': nrm((DEPTH, D, 2 * D_FF), D ** -0.5),
        'w_ffn_out': nrm((DEPTH, D_FF, D), D_FF ** -0.5),
        'final_norm_g': 1.0 + nrm((D,), 0.02),
    }


def reference(x_prompt, x_sample, c, state_mlstm_C, state_mlstm_n, state_mlstm_m, cache_k, cache_v,
              c_ctx, w_mod, b_mod, norm1_g, norm2_g, w_in_ab, b_gate_ab, conv_w, conv_b, conv_ln_g,
              conv_ln_b, mlstm_norm_g, w_out_ab, w_in_c, q_norm_g, k_norm_g, w_out_c, w_ffn_in,
              w_ffn_out, final_norm_g):
    f32 = jnp.float32
    ctx, lat = x_prompt, x_sample
    Bc = ctx.shape[0]
    zero_state = (jnp.zeros((Bc, M_HEADS, M_DK, M_DV), f32),
                  jnp.zeros((Bc, M_HEADS, M_DK), f32),
                  jnp.zeros((Bc, M_HEADS), f32))
    new_C, new_n, new_m, new_k, new_v = [], [], [], [], []
    for l in range(DEPTH):
        sh1c, sc1c, g1c, sh2c, sc2c, g2c = adaln(c_ctx[None, :], w_mod[l], b_mod[l])
        sh1, sc1, g1, sh2, sc2, g2 = adaln(c, w_mod[l], b_mod[l])
        hc = modulate(ctx, norm1_g[l], sh1c, sc1c)
        hl = modulate(lat, norm1_g[l], sh1, sc1)
        j = l // 2
        if l % 2 == 0:
            ab_w = (w_in_ab[j], b_gate_ab[j], conv_w[j], conv_b[j], conv_ln_g[j], conv_ln_b[j],
                    mlstm_norm_g[j], w_out_ab[j])
            oc, sf, sb = ab_mixer(hc, *ab_w, zero_state, zero_state)
            new_C.append(jnp.stack([sf[0], sb[0]], axis=1))
            new_n.append(jnp.stack([sf[1], sb[1]], axis=1))
            new_m.append(jnp.stack([sf[2], sb[2]], axis=1))
            lat_f = (state_mlstm_C[:, j, 0].astype(f32), state_mlstm_n[:, j, 0].astype(f32),
                     state_mlstm_m[:, j, 0].astype(f32))
            lat_b = (state_mlstm_C[:, j, 1].astype(f32), state_mlstm_n[:, j, 1].astype(f32),
                     state_mlstm_m[:, j, 1].astype(f32))
            ol, _, _ = ab_mixer(hl, *ab_w, lat_f, lat_b)
        else:
            oc, kc, vc = attn_context(hc, w_in_c[j], q_norm_g[j], k_norm_g[j], w_out_c[j])
            new_k.append(kc)
            new_v.append(vc)
            ol = attn_latent(hl, w_in_c[j], q_norm_g[j], k_norm_g[j], w_out_c[j],
                             cache_k[:, j], cache_v[:, j])
        ctx = ctx + g1c * oc
        lat = lat + g1 * ol
        ctx = ctx + g2c * swiglu(modulate(ctx, norm2_g[l], sh2c, sc2c), w_ffn_in[l], w_ffn_out[l])
        lat = lat + g2 * swiglu(modulate(lat, norm2_g[l], sh2, sc2), w_ffn_in[l], w_ffn_out[l])
    y_prompt = rms_norm(ctx, final_norm_g)
    y_sample = rms_norm(lat, final_norm_g)
    dt = x_prompt.dtype
    return (y_prompt, y_sample,
            jnp.stack(new_C, axis=1).astype(dt), jnp.stack(new_n, axis=1).astype(dt),
            jnp.stack(new_m, axis=1).astype(dt), jnp.stack(new_k, axis=1), jnp.stack(new_v, axis=1))
```

```cpp
#ifdef HOST_TEST
#include <cmath>
#include <cstdio>
#include <cstdlib>
#include <cstring>
#include <cstdint>
#include <vector>
#define HD_FN inline
#define DEV_FN inline
#else
#include <hip/hip_runtime.h>
#include <cstdio>
#include <cstdint>
#define HD_FN __host__ __device__ __forceinline__
#define DEV_FN __device__ __forceinline__
#endif

#ifdef TINY
constexpr int DM = 512, NCB = 2, CSEQ = 128, NLB = 2, LSEQ = 128, PAST = 128;
#else
constexpr int DM = 1024, NCB = 16, CSEQ = 256, NLB = 4, LSEQ = 4096, PAST = 256;
#endif
constexpr int GRIDW = 64, CCH = DM / 2, CWID = 31, MH = 4, MDK = CCH / MH, MW = CCH, NGATE = 16;
constexpr int ABIN = 2 * CCH + 4 * MW + NGATE, ABMAIN = 2 * CCH + 4 * MW;
constexpr int HDIM = 128, NQ = DM / HDIM, NKV = 2, GRP = NQ / NKV, CIN = (NQ + 2 * NKV) * HDIM;
constexpr int DFF = ((8 * DM + 3 * 256 - 1) / (3 * 256)) * 256;
constexpr int MC = NCB * CSEQ, ML = NLB * LSEQ, MTOK = MC + ML, NCLS = 1 + NLB, SKVL = LSEQ + PAST;
constexpr float EPSF = 1e-6f;
constexpr int NSEQ = NCB + NLB;

constexpr size_t O_Y = 0, O_C = (size_t)MTOK * DM, O_N = O_C + (size_t)NCB * 2 * MH * MDK * MDK, O_M = O_N + (size_t)NCB * 2 * MH * MDK,
                 O_K = O_M + (size_t)NCB * 2 * MH, O_V = O_K + (size_t)NCB * CSEQ * NKV * HDIM, O_END = O_V + (size_t)NCB * CSEQ * NKV * HDIM;

constexpr size_t MiB = 1u << 20;
#ifdef TINY
constexpr size_t WSCALE = 1;
#endif
constexpr size_t WS_CTL = 0, CTL_ZERO_BYTES = 1 * MiB;
constexpr size_t WS_MOD = 1 * MiB;
constexpr size_t WS_SW = WS_MOD + 256 * 1024;
constexpr size_t WS_SSQ = 512 * 1024;
constexpr int SSQ_STRIDE = 32768;
constexpr size_t WS_DEN = 232 * MiB;
constexpr size_t WS_WB = 2 * MiB;
constexpr size_t WS_XN = 50 * MiB;
constexpr size_t WS_UPRE = 90 * MiB;
constexpr size_t WS_QKVO = 110 * MiB;
constexpr size_t WS_UH = 190 * MiB;
constexpr size_t WS_GATES = 230 * MiB;
constexpr size_t WS_HS = 50 * MiB;
constexpr size_t WS_H = 110 * MiB;
constexpr size_t WS_QRAW = 110 * MiB;
constexpr size_t WS_LATK = 150 * MiB, WS_LATV = 159 * MiB, WS_CTXK = 168 * MiB, WS_CTXV = 170 * MiB;
constexpr size_t WS_KRAW = 172 * MiB;
constexpr size_t WS_O = 190 * MiB;
constexpr size_t WS_END = 256 * MiB;

typedef unsigned short bf16_t;
HD_FN float bf2f(bf16_t h) { unsigned u = (unsigned)h << 16; return __builtin_bit_cast(float, u); }
HD_FN bf16_t f2bf(float f) { unsigned u = __builtin_bit_cast(unsigned, f); return (bf16_t)((u + 0x7fffu + ((u >> 16) & 1u)) >> 16); }
HD_FN float rbf(float f) { return bf2f(f2bf(f)); }
HD_FN float sigmoidf_(float x) { return 1.0f / (1.0f + expf(-x)); }
HD_FN float siluf_(float x) { return x * sigmoidf_(x); }
HD_FN float logsigmoidf_(float x) { return x >= 0.f ? -log1pf(expf(-x)) : x - log1pf(expf(x)); }
HD_FN int cls_of(int row) { return row < MC ? 0 : 1 + (row - MC) / LSEQ; }
HD_FN int seqlen_of(int row) { return row < MC ? CSEQ : LSEQ; }
HD_FN int pos_of(int row) { return row < MC ? row % CSEQ : (row - MC) % LSEQ; }

struct Params {
    const float *xp, *xs, *c, *stC, *stn, *stm, *ck, *cv, *cctx, *wmod, *bmod, *n1g, *n2g, *winab, *bgate, *convw, *convb, *lng, *lnb, *mng,
        *woutab, *winc, *qng, *kng, *woutc, *wffi, *wffo, *fng;
    float* out; unsigned char* ws;
};
HD_FN const float* xrow(const Params& p, int row) { return row < MC ? p.xp + (size_t)row * DM : p.xs + (size_t)(row - MC) * DM; }
HD_FN const float* modv(const Params& p, int l, int cls, int which) { return (const float*)(p.ws + WS_MOD) + ((size_t)(l * NCLS + cls) * 6 + which) * DM; }
constexpr size_t WS_RS0 = 233 * MiB;

struct NMod {
    Params p; static long count() { return 2L * NCLS * 6 * DM; }
    HD_FN void operator()(long idx) const {
        const int col = (int)(idx % (6 * DM)); const int cls = (int)((idx / (6 * DM)) % NCLS); const int l = (int)(idx / (6 * DM * NCLS));
        const float* cond = cls == 0 ? p.cctx : p.c + (size_t)(cls - 1) * DM;
        const float* w = p.wmod + (size_t)l * DM * 6 * DM;
        float acc = 0.f;
        for (int k = 0; k < DM; ++k) acc += siluf_(cond[k]) * w[(size_t)k * 6 * DM + col];
        ((float*)(p.ws + WS_MOD))[idx] = acc + p.bmod[(size_t)l * 6 * DM + col];
    }
};
struct NNorm0a {
    Params p; static long count() { return MTOK; }
    HD_FN void operator()(long row) const {
        const float* x = xrow(p, (int)row); float s = 0.f;
        for (int k = 0; k < DM; ++k) s += x[k] * x[k];
        ((float*)(p.ws + WS_RS0))[row] = 1.0f / sqrtf(s / DM + EPSF);
    }
};
struct NNorm0b {
    Params p; static long count() { return (long)MTOK * DM; }
    HD_FN void operator()(long idx) const {
        const int row = (int)(idx / DM), col = (int)(idx % DM), cls = cls_of(row);
        const float rs = ((const float*)(p.ws + WS_RS0))[row];
        const float v = xrow(p, row)[col] * rs * p.n1g[col] * (1.f + modv(p, 0, cls, 1)[col]) + modv(p, 0, cls, 0)[col];
        ((bf16_t*)(p.ws + WS_XN))[idx] = f2bf(v);
    }
};
struct NGates {
    Params p; static long count() { return (long)MTOK * NGATE; }
    HD_FN void operator()(long idx) const {
        const int row = (int)(idx / NGATE), j = (int)(idx % NGATE), cls = cls_of(row);
        const float rs = ((const float*)(p.ws + WS_RS0))[row]; const float* x = xrow(p, row);
        const float* sc = modv(p, 0, cls, 1); const float* sh = modv(p, 0, cls, 0);
        float acc = 0.f;
        for (int k = 0; k < DM; ++k) { const float h = x[k] * rs * p.n1g[k] * (1.f + sc[k]) + sh[k]; acc += h * p.winab[(size_t)k * ABIN + ABMAIN + j]; }
        acc += p.bgate[j];
        if ((j & 7) >= 4) acc = logsigmoidf_(acc);
        ((float*)(p.ws + WS_GATES))[idx] = acc;
    }
};

template <bool DUAL, class Epi> struct NGemm {
    const bf16_t* A; const float* B; int lda, ldb, K, N, off2, pad_; Epi epi;
    long count() const { return (long)(MTOK / 4) * (N / 4); }
    HD_FN void operator()(long idx) const {
        const int nt = (int)(idx % (N / 4)), mt = (int)(idx / (N / 4)); const int m0 = mt * 4, n0 = nt * 4;
        float acc[4][4], acc2[4][4];
#pragma unroll
        for (int i = 0; i < 4; ++i)
#pragma unroll
            for (int j = 0; j < 4; ++j) { acc[i][j] = 0.f; acc2[i][j] = 0.f; }
        for (int k0 = 0; k0 < K; k0 += 8) {
            float a[4][8];
#pragma unroll
            for (int i = 0; i < 4; ++i) {
                const bf16_t* ap = A + (size_t)(m0 + i) * lda + k0;
#pragma unroll
                for (int kk = 0; kk < 8; ++kk) a[i][kk] = bf2f(ap[kk]);
            }
#pragma unroll
            for (int kk = 0; kk < 8; ++kk) {
                const float* bp = B + (size_t)(k0 + kk) * ldb + n0;
                float b[4], b2[4];
#pragma unroll
                for (int j = 0; j < 4; ++j) { b[j] = rbf(bp[j]); b2[j] = DUAL ? rbf(bp[off2 + j]) : 0.f; }
#pragma unroll
                for (int i = 0; i < 4; ++i)
#pragma unroll
                    for (int j = 0; j < 4; ++j) { acc[i][j] += a[i][kk] * b[j]; if (DUAL) acc2[i][j] += a[i][kk] * b2[j]; }
            }
        }
#pragma unroll
        for (int i = 0; i < 4; ++i)
#pragma unroll
            for (int j = 0; j < 4; ++j) epi(m0 + i, n0 + j, acc[i][j], acc2[i][j]);
    }
};
struct EGlu { Params p; HD_FN void operator()(int row, int col, float v, float v2) const { ((bf16_t*)(p.ws + WS_UPRE))[(size_t)row * CCH + col] = f2bf(v * sigmoidf_(v2)); } };
struct EQkvo { Params p; HD_FN void operator()(int row, int col, float v, float) const {
        const int part = col / MW; if (part == 1) v *= 1.0f / sqrtf((float)MDK); if (part == 3) v = sigmoidf_(v);
        ((bf16_t*)(p.ws + WS_QKVO))[(size_t)row * 4 * MW + col] = f2bf(v); } };
struct EOut { Params p; int l; int pad_ = 0; HD_FN void operator()(int row, int col, float v, float) const {
        const int cls = cls_of(row); float* Y = p.out + O_Y + (size_t)row * DM + col;
        const float xin = l == 0 ? xrow(p, row)[col] : *Y;
        const float x1 = xin + modv(p, l, cls, 2)[col] * v; *Y = x1;
        ((bf16_t*)(p.ws + WS_XN))[(size_t)row * DM + col] = f2bf(x1 * p.n2g[(size_t)l * DM + col] * (1.f + modv(p, l, cls, 4)[col])); } };
struct EFfnIn { Params p; const float* sw; int slot; int pad_ = 0; HD_FN void operator()(int row, int col, float v, float v2) const {
        const int cls = cls_of(row); const float rs = 1.0f / sqrtf(((const float*)(p.ws + WS_SSQ))[(size_t)slot * SSQ_STRIDE + row] / DM + EPSF);
        const float a = v * rs + sw[(size_t)cls * 2 * DFF + col], b = v2 * rs + sw[(size_t)cls * 2 * DFF + DFF + col];
        ((bf16_t*)(p.ws + WS_H))[(size_t)row * DFF + col] = f2bf(siluf_(a) * b); } };
struct EFfnOut { Params p; int l; int pad_ = 0; HD_FN void operator()(int row, int col, float v, float) const {
        const int cls = cls_of(row); float* Y = p.out + O_Y + (size_t)row * DM + col;
        const float x2 = *Y + modv(p, l, cls, 5)[col] * v; *Y = x2;
        if (l == 0) ((bf16_t*)(p.ws + WS_XN))[(size_t)row * DM + col] = f2bf(x2 * p.n1g[(size_t)DM + col] * (1.f + modv(p, 1, cls, 1)[col])); } };
struct EQkv { Params p; const float* sw; int slot; int pad_ = 0; HD_FN void operator()(int row, int col, float v, float) const {
        const int cls = cls_of(row); const float rs = 1.0f / sqrtf(((const float*)(p.ws + WS_SSQ))[(size_t)slot * SSQ_STRIDE + row] / DM + EPSF);
        const float a = v * rs + sw[(size_t)cls * CIN + col];
        if (col < NQ * HDIM) ((bf16_t*)(p.ws + WS_QRAW))[(size_t)row * NQ * HDIM + col] = f2bf(a);
        else if (col < (NQ + NKV) * HDIM) ((bf16_t*)(p.ws + WS_KRAW))[(size_t)row * NKV * HDIM + (col - NQ * HDIM)] = f2bf(a);
        else { const int c2 = col - (NQ + NKV) * HDIM;
            if (row < MC) { ((bf16_t*)(p.ws + WS_CTXV))[(size_t)row * NKV * HDIM + c2] = f2bf(a); p.out[O_V + (size_t)row * NKV * HDIM + c2] = a; }
            else { const int b = (row - MC) / LSEQ, s = (row - MC) % LSEQ; ((bf16_t*)(p.ws + WS_LATV))[((size_t)b * SKVL + s) * NKV * HDIM + c2] = f2bf(a); } } } };

struct NSsq {
    Params p; int slot; int pad_ = 0; static long count() { return MTOK; }
    HD_FN void operator()(long row) const { const float* y = p.out + O_Y + (size_t)row * DM; float s = 0.f; for (int k = 0; k < DM; ++k) s += y[k] * y[k];
        ((float*)(p.ws + WS_SSQ))[(size_t)slot * SSQ_STRIDE + row] = s; }
};
struct NSW {
    Params p; const float* W; float* sw; int l, which, N, pad_; long count() const { return (long)NCLS * N; }
    HD_FN void operator()(long idx) const { const int n = (int)(idx % N), cls = (int)(idx / N); const float* sh = modv(p, l, cls, which); float acc = 0.f;
        for (int k = 0; k < DM; ++k) acc += sh[k] * rbf(W[(size_t)k * N + n]); sw[idx] = acc; }
};
struct NConv {
    Params p; static long count() { return (long)MTOK * CCH; }
    HD_FN void operator()(long idx) const {
        const int row = (int)(idx / CCH), c = (int)(idx % CCH), pos = pos_of(row), len = seqlen_of(row);
        const bf16_t* U = (const bf16_t*)(p.ws + WS_UPRE); float acc = p.convb[c];
        for (int j = 0; j < CWID; ++j) { const int t = pos + j - CWID / 2; if (t >= 0 && t < len) acc += p.convw[(size_t)j * CCH + c] * bf2f(U[(size_t)(row + j - CWID / 2) * CCH + c]); }
        ((float*)(p.ws + WS_HS))[idx] = acc;
    }
};
struct NConvLN {
    Params p; static long count() { return MTOK; }
    HD_FN void operator()(long row) const {
        const float* t = (const float*)(p.ws + WS_HS) + (size_t)row * CCH; float mu = 0.f;
        for (int c = 0; c < CCH; ++c) mu += t[c]; mu /= CCH; float var = 0.f;
        for (int c = 0; c < CCH; ++c) { const float d = t[c] - mu; var += d * d; } var /= CCH;
        const float rs = 1.0f / sqrtf(var + EPSF); bf16_t* UH = (bf16_t*)(p.ws + WS_UH) + (size_t)row * DM;
        for (int c = 0; c < CCH; ++c) UH[c] = f2bf(siluf_((t[c] - mu) * rs * p.lng[c] + p.lnb[c]));
    }
};
HD_FN int seq_base(int sid) { return sid < NCB ? sid * CSEQ : MC + (sid - NCB) * LSEQ; }
struct NMlstmDen {
    Params p; static long count() { return (long)NSEQ * MH * 2; }
    HD_FN void operator()(long idx) const {
        const int dir = (int)(idx % 2), h = (int)((idx / 2) % MH), sid = (int)(idx / (2 * MH)); const bool isctx = sid < NCB;
        const int base = seq_base(sid), len = isctx ? CSEQ : LSEQ;
        float n[MDK]; float mrun = 0.f;
        if (isctx) {
#pragma unroll
            for (int d = 0; d < MDK; ++d) n[d] = 0.f;
        } else { const int b = sid - NCB; const float em = expf(p.stm[(size_t)(b * 2 + dir) * MH + h]);
#pragma unroll
            for (int d = 0; d < MDK; ++d) n[d] = p.stn[((size_t)(b * 2 + dir) * MH + h) * MDK + d] * em; }
        const bf16_t* QK = (const bf16_t*)(p.ws + WS_QKVO); const float* G = (const float*)(p.ws + WS_GATES); float* DEN = (float*)(p.ws + WS_DEN);
        for (int t = 0; t < len; ++t) {
            const int row = base + (dir == 0 ? t : len - 1 - t);
            const float ig = G[(size_t)row * NGATE + dir * 8 + h], lf = G[(size_t)row * NGATE + dir * 8 + 4 + h];
            const float f = expf(lf), ei = expf(ig); mrun = fmaxf(mrun + lf, ig);
            const bf16_t* q = QK + (size_t)row * 4 * MW + h * MDK; const bf16_t* k = q + MW; float den = 0.f;
#pragma unroll
            for (int d = 0; d < MDK; ++d) { n[d] = f * n[d] + ei * bf2f(k[d]); den += bf2f(q[d]) * n[d]; }
            DEN[((size_t)dir * MTOK + row) * MH + h] = den;
        }
        if (isctx) { const float em = expf(-mrun); p.out[O_M + (size_t)(sid * 2 + dir) * MH + h] = mrun;
#pragma unroll
            for (int d = 0; d < MDK; ++d) p.out[O_N + ((size_t)(sid * 2 + dir) * MH + h) * MDK + d] = n[d] * em; }
    }
};
struct NMlstmNum {
    Params p; int dir; int pad_ = 0; static long count() { return (long)NSEQ * MH * MDK; }
    HD_FN void operator()(long idx) const {
        const int v = (int)(idx % MDK), h = (int)((idx / MDK) % MH), sid = (int)(idx / (MDK * MH)); const bool isctx = sid < NCB;
        const int base = seq_base(sid), len = isctx ? CSEQ : LSEQ;
        float C[MDK];
        if (isctx) {
#pragma unroll
            for (int d = 0; d < MDK; ++d) C[d] = 0.f;
        } else { const int b = sid - NCB; const float em = expf(p.stm[(size_t)(b * 2 + dir) * MH + h]);
#pragma unroll
            for (int d = 0; d < MDK; ++d) C[d] = p.stC[(((size_t)(b * 2 + dir) * MH + h) * MDK + d) * MDK + v] * em; }
        const bf16_t* QK = (const bf16_t*)(p.ws + WS_QKVO); const float* G = (const float*)(p.ws + WS_GATES); const float* DEN = (const float*)(p.ws + WS_DEN);
        float* HS = (float*)(p.ws + WS_HS);
        for (int t = 0; t < len; ++t) {
            const int row = base + (dir == 0 ? t : len - 1 - t);
            const float ig = G[(size_t)row * NGATE + dir * 8 + h], lf = G[(size_t)row * NGATE + dir * 8 + 4 + h];
            const float f = expf(lf), ei = expf(ig);
            const bf16_t* q = QK + (size_t)row * 4 * MW + h * MDK; const bf16_t* k = q + MW; const float vv = bf2f(q[2 * MW + v]) * ei; float num = 0.f;
#pragma unroll
            for (int d = 0; d < MDK; ++d) { C[d] = f * C[d] + bf2f(k[d]) * vv; num += bf2f(q[d]) * C[d]; }
            const float den = DEN[((size_t)dir * MTOK + row) * MH + h]; const float hv = num / fmaxf(fabsf(den), 1.0f);
            float* o = HS + (size_t)row * MW + h * MDK + v; if (dir == 0) *o = hv; else *o += hv;
        }
        if (isctx) { const float em = expf(-p.out[O_M + (size_t)(sid * 2 + dir) * MH + h]);
#pragma unroll
            for (int d = 0; d < MDK; ++d) p.out[O_C + (((size_t)(sid * 2 + dir) * MH + h) * MDK + d) * MDK + v] = C[d] * em; }
    }
};
struct NHm {
    Params p; static long count() { return (long)MTOK * MH; }
    HD_FN void operator()(long idx) const {
        const int row = (int)(idx / MH), h = (int)(idx % MH); const float* x = (const float*)(p.ws + WS_HS) + (size_t)row * MW + h * MDK; float s = 0.f;
        for (int v = 0; v < MDK; ++v) s += x[v] * x[v];
        const float rs = 1.0f / sqrtf(s / MDK + EPSF); const bf16_t* og = (const bf16_t*)(p.ws + WS_QKVO) + (size_t)row * 4 * MW + 3 * MW + h * MDK;
        bf16_t* UH = (bf16_t*)(p.ws + WS_UH) + (size_t)row * DM + CCH + h * MDK;
        for (int v = 0; v < MDK; ++v) UH[v] = f2bf(bf2f(og[v]) * x[v] * rs * p.mng[h * MDK + v]);
    }
};
struct NCacheCvt {
    Params p; static long count() { return (long)NLB * PAST * NKV * HDIM; }
    HD_FN void operator()(long idx) const { const int e = (int)(idx % (NKV * HDIM)), pp = (int)((idx / (NKV * HDIM)) % PAST), b = (int)(idx / ((long)NKV * HDIM * PAST));
        const size_t dst = ((size_t)b * SKVL + LSEQ + pp) * NKV * HDIM + e;
        ((bf16_t*)(p.ws + WS_LATK))[dst] = f2bf(p.ck[idx]); ((bf16_t*)(p.ws + WS_LATV))[dst] = f2bf(p.cv[idx]); }
};
struct NQkPost {
    Params p; static long count() { return (long)MTOK * (NQ + NKV); }
    HD_FN void operator()(long idx) const {
        const int row = (int)(idx / (NQ + NKV)), j = (int)(idx % (NQ + NKV)); const bool isq = j < NQ; const bool lat = row >= MC;
        bf16_t* src = isq ? (bf16_t*)(p.ws + WS_QRAW) + (size_t)row * NQ * HDIM + j * HDIM : (bf16_t*)(p.ws + WS_KRAW) + (size_t)row * NKV * HDIM + (j - NQ) * HDIM;
        const float* g = isq ? p.qng : p.kng; float s = 0.f;
        for (int d = 0; d < HDIM; ++d) { const float x = bf2f(src[d]); s += x * x; }
        const float rs = 1.0f / sqrtf(s / HDIM + EPSF);
        bf16_t* dst; float* fo = nullptr;
        if (isq) dst = src;
        else if (!lat) { dst = (bf16_t*)(p.ws + WS_CTXK) + (size_t)row * NKV * HDIM + (j - NQ) * HDIM; fo = p.out + O_K + (size_t)row * NKV * HDIM + (j - NQ) * HDIM; }
        else { const int b = (row - MC) / LSEQ, sp = (row - MC) % LSEQ; dst = (bf16_t*)(p.ws + WS_LATK) + ((size_t)b * SKVL + sp) * NKV * HDIM + (j - NQ) * HDIM; }
        const int sp = pos_of(row); const float prow = (float)(sp / GRIDW), pcol = (float)(sp % GRIDW);
        for (int half = 0; half < 2; ++half)
            for (int d = 0; d < HDIM / 4; ++d) {
                const int i1 = half * (HDIM / 2) + d, i2 = i1 + HDIM / 4;
                const float x1 = bf2f(src[i1]) * rs * g[i1], x2 = bf2f(src[i2]) * rs * g[i2]; float y1 = x1, y2 = x2;
                if (lat) { const float inv = powf(10000.0f, -(float)d / (float)(HDIM / 4)); const float ang = (half == 0 ? prow : pcol) * inv; const float cs = cosf(ang), sn = sinf(ang);
                    y1 = x1 * cs - x2 * sn; y2 = x1 * sn + x2 * cs; }
                dst[i1] = f2bf(y1); dst[i2] = f2bf(y2); if (fo) { fo[i1] = y1; fo[i2] = y2; }
            }
    }
};
struct NAttn {
    Params p; static long count() { return (long)MTOK * NQ * 4; }
    HD_FN void operator()(long idx) const {
        const int sl = (int)(idx % 4), hq = (int)((idx / 4) % NQ), row = (int)(idx / (4 * NQ)); const int kv = hq / GRP;
        const bf16_t *Kb, *Vb; int nk;
        if (row < MC) { const int b = row / CSEQ; Kb = (const bf16_t*)(p.ws + WS_CTXK) + (size_t)b * CSEQ * NKV * HDIM; Vb = (const bf16_t*)(p.ws + WS_CTXV) + (size_t)b * CSEQ * NKV * HDIM; nk = CSEQ; }
        else { const int b = (row - MC) / LSEQ; Kb = (const bf16_t*)(p.ws + WS_LATK) + (size_t)b * SKVL * NKV * HDIM; Vb = (const bf16_t*)(p.ws + WS_LATV) + (size_t)b * SKVL * NKV * HDIM; nk = SKVL; }
        const bf16_t* qp = (const bf16_t*)(p.ws + WS_QRAW) + (size_t)row * NQ * HDIM + hq * HDIM;
        float q[HDIM];
#pragma unroll
        for (int d = 0; d < HDIM; ++d) q[d] = bf2f(qp[d]);
        float o[32];
#pragma unroll
        for (int e = 0; e < 32; ++e) o[e] = 0.f;
        float m = -1e30f, l = 0.f; const float scale = 1.0f / sqrtf((float)HDIM);
        for (int s = 0; s < nk; ++s) {
            const bf16_t* kp = Kb + (size_t)s * NKV * HDIM + kv * HDIM; float dot = 0.f;
#pragma unroll
            for (int d = 0; d < HDIM; ++d) dot += q[d] * bf2f(kp[d]);
            dot *= scale; const float mn = fmaxf(m, dot); const float al = expf(m - mn), pe = expf(dot - mn); m = mn; l = l * al + pe;
            const bf16_t* vp = Vb + (size_t)s * NKV * HDIM + kv * HDIM + sl * 32;
#pragma unroll
            for (int e = 0; e < 32; ++e) o[e] = o[e] * al + pe * bf2f(vp[e]);
        }
        bf16_t* op = (bf16_t*)(p.ws + WS_O) + (size_t)row * DM + hq * HDIM + sl * 32;
#pragma unroll
        for (int e = 0; e < 32; ++e) op[e] = f2bf(o[e] / l);
    }
};
struct NFinal {
    Params p; static long count() { return (long)MTOK * DM; }
    HD_FN void operator()(long idx) const { const int row = (int)(idx / DM), col = (int)(idx % DM);
        const float rs = 1.0f / sqrtf(((const float*)(p.ws + WS_SSQ))[(size_t)3 * SSQ_STRIDE + row] / DM + EPSF); p.out[O_Y + idx] *= rs * p.fng[col]; }
};
template <class L> void run_naive(const Params& p, L& go) {
    const bf16_t* XN = (const bf16_t*)(p.ws + WS_XN); const bf16_t* UH = (const bf16_t*)(p.ws + WS_UH); const bf16_t* Hh = (const bf16_t*)(p.ws + WS_H); const bf16_t* Ob = (const bf16_t*)(p.ws + WS_O);
    float* SW0 = (float*)(p.ws + WS_SW); float* SWC = SW0 + (size_t)NCLS * 2 * DFF; float* SW1 = SWC + (size_t)NCLS * CIN;
    go(NMod{p}, NMod::count());
    go(NNorm0a{p}, NNorm0a::count()); go(NNorm0b{p}, NNorm0b::count()); go(NGates{p}, NGates::count());
    { NGemm<true, EGlu> g{XN, p.winab, DM, ABIN, DM, CCH, CCH, 0, EGlu{p}}; go(g, g.count()); }
    { NGemm<false, EQkvo> g{XN, p.winab + 2 * CCH, DM, ABIN, DM, 4 * MW, 0, 0, EQkvo{p}}; go(g, g.count()); }
    go(NConv{p}, NConv::count()); go(NConvLN{p}, NConvLN::count());
    go(NMlstmDen{p}, NMlstmDen::count()); go(NMlstmNum{p, 0}, NMlstmNum::count()); go(NMlstmNum{p, 1}, NMlstmNum::count()); go(NHm{p}, NHm::count());
    { NGemm<false, EOut> g{UH, p.woutab, DM, DM, DM, DM, 0, 0, EOut{p, 0}}; go(g, g.count()); }
    go(NSsq{p, 0}, NSsq::count());
    { NSW s{p, p.wffi, SW0, 0, 3, 2 * DFF, 0}; go(s, s.count()); }
    { NGemm<true, EFfnIn> g{XN, p.wffi, DM, 2 * DFF, DM, DFF, DFF, 0, EFfnIn{p, SW0, 0}}; go(g, g.count()); }
    { NGemm<false, EFfnOut> g{Hh, p.wffo, DFF, DM, DFF, DM, 0, 0, EFfnOut{p, 0}}; go(g, g.count()); }
    go(NSsq{p, 1}, NSsq::count());
    { NSW s{p, p.winc, SWC, 1, 0, CIN, 0}; go(s, s.count()); }
    { NGemm<false, EQkv> g{XN, p.winc, DM, CIN, DM, CIN, 0, 0, EQkv{p, SWC, 1}}; go(g, g.count()); }
    go(NCacheCvt{p}, NCacheCvt::count()); go(NQkPost{p}, NQkPost::count());
    go(NAttn{p}, NAttn::count());
    { NGemm<false, EOut> g{Ob, p.woutc, DM, DM, DM, DM, 0, 0, EOut{p, 1}}; go(g, g.count()); }
    go(NSsq{p, 2}, NSsq::count());
    { NSW s{p, p.wffi + (size_t)DM * 2 * DFF, SW1, 1, 3, 2 * DFF, 0}; go(s, s.count()); }
    { NGemm<true, EFfnIn> g{XN, p.wffi + (size_t)DM * 2 * DFF, DM, 2 * DFF, DM, DFF, DFF, 0, EFfnIn{p, SW1, 2}}; go(g, g.count()); }
    { NGemm<false, EFfnOut> g{Hh, p.wffo + (size_t)DFF * DM, DFF, DM, DFF, DM, 0, 0, EFfnOut{p, 1}}; go(g, g.count()); }
    go(NSsq{p, 3}, NSsq::count());
    go(NFinal{p}, NFinal::count());
}
template <class F> __global__ void __launch_bounds__(256) run_k(F f, long n) {
    for (long i = blockIdx.x * 256L + threadIdx.x; i < n; i += (long)gridDim.x * 256L) f(i);
}
struct GpuGo { hipStream_t s; template <class F> void operator()(const F& f, long n) { long g = (n + 255) / 256; if (g > 262144) g = 262144; if (g < 1) g = 1;
    hipLaunchKernelGGL(run_k<F>, dim3((unsigned)g), dim3(256), 0, s, f, n); } };
static Params make_params(void* const* d_in, void* d_out, void* d_ws) {
    Params p{}; const float** pp = (const float**)&p; for (int i = 0; i < 28; ++i) pp[i] = (const float*)d_in[i];
    p.out = (float*)d_out; p.ws = (unsigned char*)d_ws; return p;
}
extern "C" void kernel_launch(void* const* d_in, const int* in_sizes, int n_in, void* d_out, int out_size, void* d_ws, size_t ws_size, hipStream_t stream) {
    if (n_in != 28 || (size_t)out_size != O_END || ws_size < WS_END || in_sizes[0] != MC * DM || in_sizes[1] != ML * DM) {
        fprintf(stderr, "kernel_launch: shape mismatch n_in %d out %d (want %zu) ws %zu (want %zu)\n", n_in, out_size, (size_t)O_END, ws_size, (size_t)WS_END); return; }
    hipMemsetAsync((char*)d_ws + WS_CTL, 0, CTL_ZERO_BYTES, stream);
    Params p = make_params(d_in, d_out, d_ws);
    GpuGo go{stream}; run_naive(p, go);
}
```

```cpp
#ifdef HOST_TEST
#include <cmath>
#include <cstdio>
#include <cstdlib>
#include <cstring>
#include <cstdint>
#include <vector>
#define HD_FN inline
#define DEV_FN inline
#else
#include <hip/hip_runtime.h>
#include <cstdio>
#include <cstdint>
#define HD_FN __host__ __device__ __forceinline__
#define DEV_FN __device__ __forceinline__
#endif

#ifdef TINY
constexpr int DM = 512, NCB = 2, CSEQ = 128, NLB = 2, LSEQ = 128, PAST = 128;
#else
constexpr int DM = 1024, NCB = 16, CSEQ = 256, NLB = 4, LSEQ = 4096, PAST = 256;
#endif
constexpr int GRIDW = 64, CCH = DM / 2, CWID = 31, MH = 4, MDK = CCH / MH, MW = CCH, NGATE = 16;
constexpr int ABIN = 2 * CCH + 4 * MW + NGATE, ABMAIN = 2 * CCH + 4 * MW;
constexpr int HDIM = 128, NQ = DM / HDIM, NKV = 2, GRP = NQ / NKV, CIN = (NQ + 2 * NKV) * HDIM;
constexpr int DFF = ((8 * DM + 3 * 256 - 1) / (3 * 256)) * 256;
constexpr int MC = NCB * CSEQ, ML = NLB * LSEQ, MTOK = MC + ML, NCLS = 1 + NLB, SKVL = LSEQ + PAST;
constexpr float EPSF = 1e-6f;
constexpr int NSEQ = NCB + NLB;

constexpr size_t O_Y = 0, O_C = (size_t)MTOK * DM, O_N = O_C + (size_t)NCB * 2 * MH * MDK * MDK, O_M = O_N + (size_t)NCB * 2 * MH * MDK,
                 O_K = O_M + (size_t)NCB * 2 * MH, O_V = O_K + (size_t)NCB * CSEQ * NKV * HDIM, O_END = O_V + (size_t)NCB * CSEQ * NKV * HDIM;

constexpr size_t MiB = 1u << 20;
#ifdef TINY
constexpr size_t WSCALE = 1;
#endif
constexpr size_t WS_CTL = 0, CTL_ZERO_BYTES = 1 * MiB;
constexpr size_t WS_MOD = 1 * MiB;
constexpr size_t WS_SW = WS_MOD + 256 * 1024;
constexpr size_t WS_SSQ = 512 * 1024;
constexpr int SSQ_STRIDE = 32768;
constexpr size_t WS_DEN = 232 * MiB;
constexpr size_t WS_WB = 2 * MiB;
constexpr size_t WS_XN = 50 * MiB;
constexpr size_t WS_UPRE = 90 * MiB;
constexpr size_t WS_QKVO = 110 * MiB;
constexpr size_t WS_UH = 190 * MiB;
constexpr size_t WS_GATES = 230 * MiB;
constexpr size_t WS_HS = 50 * MiB;
constexpr size_t WS_H = 110 * MiB;
constexpr size_t WS_QRAW = 110 * MiB;
constexpr size_t WS_LATK = 150 * MiB, WS_LATV = 159 * MiB, WS_CTXK = 168 * MiB, WS_CTXV = 170 * MiB;
constexpr size_t WS_KRAW = 172 * MiB;
constexpr size_t WS_O = 190 * MiB;
constexpr size_t WS_END = 256 * MiB;

typedef unsigned short bf16_t;
HD_FN float bf2f(bf16_t h) { unsigned u = (unsigned)h << 16; return __builtin_bit_cast(float, u); }
HD_FN bf16_t f2bf(float f) { unsigned u = __builtin_bit_cast(unsigned, f); return (bf16_t)((u + 0x7fffu + ((u >> 16) & 1u)) >> 16); }
HD_FN float rbf(float f) { return bf2f(f2bf(f)); }
HD_FN float sigmoidf_(float x) { return 1.0f / (1.0f + expf(-x)); }
HD_FN float siluf_(float x) { return x * sigmoidf_(x); }
HD_FN float logsigmoidf_(float x) { return x >= 0.f ? -log1pf(expf(-x)) : x - log1pf(expf(x)); }
HD_FN int cls_of(int row) { return row < MC ? 0 : 1 + (row - MC) / LSEQ; }
HD_FN int seqlen_of(int row) { return row < MC ? CSEQ : LSEQ; }
HD_FN int pos_of(int row) { return row < MC ? row % CSEQ : (row - MC) % LSEQ; }

struct Params {
    const float *xp, *xs, *c, *stC, *stn, *stm, *ck, *cv, *cctx, *wmod, *bmod, *n1g, *n2g, *winab, *bgate, *convw, *convb, *lng, *lnb, *mng,
        *woutab, *winc, *qng, *kng, *woutc, *wffi, *wffo, *fng;
    float* out; unsigned char* ws;
};
HD_FN const float* xrow(const Params& p, int row) { return row < MC ? p.xp + (size_t)row * DM : p.xs + (size_t)(row - MC) * DM; }
HD_FN const float* modv(const Params& p, int l, int cls, int which) { return (const float*)(p.ws + WS_MOD) + ((size_t)(l * NCLS + cls) * 6 + which) * DM; }
constexpr size_t WS_RS0 = 233 * MiB;

struct NMod {
    Params p; static HD_FN long count() { return 2L * NCLS * 6 * DM; }
    HD_FN void operator()(long idx) const {
        const int col = (int)(idx % (6 * DM)); const int cls = (int)((idx / (6 * DM)) % NCLS); const int l = (int)(idx / (6 * DM * NCLS));
        const float* cond = cls == 0 ? p.cctx : p.c + (size_t)(cls - 1) * DM;
        const float* w = p.wmod + (size_t)l * DM * 6 * DM;
        float acc = 0.f;
        for (int k = 0; k < DM; ++k) acc += siluf_(cond[k]) * w[(size_t)k * 6 * DM + col];
        ((float*)(p.ws + WS_MOD))[idx] = acc + p.bmod[(size_t)l * 6 * DM + col];
    }
};
struct NNorm0a {
    Params p; static HD_FN long count() { return MTOK; }
    HD_FN void operator()(long row) const {
        const float* x = xrow(p, (int)row); float s = 0.f;
        for (int k = 0; k < DM; ++k) s += x[k] * x[k];
        ((float*)(p.ws + WS_RS0))[row] = 1.0f / sqrtf(s / DM + EPSF);
    }
};
struct NNorm0b {
    Params p; static HD_FN long count() { return (long)MTOK * DM; }
    HD_FN void operator()(long idx) const {
        const int row = (int)(idx / DM), col = (int)(idx % DM), cls = cls_of(row);
        const float rs = ((const float*)(p.ws + WS_RS0))[row];
        const float v = xrow(p, row)[col] * rs * p.n1g[col] * (1.f + modv(p, 0, cls, 1)[col]) + modv(p, 0, cls, 0)[col];
        ((bf16_t*)(p.ws + WS_XN))[idx] = f2bf(v);
    }
};
struct NGates {
    Params p; static HD_FN long count() { return (long)MTOK * NGATE; }
    HD_FN void operator()(long idx) const {
        const int row = (int)(idx / NGATE), j = (int)(idx % NGATE), cls = cls_of(row);
        const float rs = ((const float*)(p.ws + WS_RS0))[row]; const float* x = xrow(p, row);
        const float* sc = modv(p, 0, cls, 1); const float* sh = modv(p, 0, cls, 0);
        float acc = 0.f;
        for (int k = 0; k < DM; ++k) { const float h = x[k] * rs * p.n1g[k] * (1.f + sc[k]) + sh[k]; acc += h * p.winab[(size_t)k * ABIN + ABMAIN + j]; }
        acc += p.bgate[j];
        if ((j & 7) >= 4) acc = logsigmoidf_(acc);
        ((float*)(p.ws + WS_GATES))[idx] = acc;
    }
};

template <bool DUAL, class Epi> struct NGemm {
    const bf16_t* A; const float* B; int lda, ldb, K, N, off2, pad_; Epi epi;
    HD_FN long count() const { return (long)(MTOK / 4) * (N / 4); }
    HD_FN void operator()(long idx) const {
        const int nt = (int)(idx % (N / 4)), mt = (int)(idx / (N / 4)); const int m0 = mt * 4, n0 = nt * 4;
        float acc[4][4], acc2[4][4];
#pragma unroll
        for (int i = 0; i < 4; ++i)
#pragma unroll
            for (int j = 0; j < 4; ++j) { acc[i][j] = 0.f; acc2[i][j] = 0.f; }
        for (int k0 = 0; k0 < K; k0 += 8) {
            float a[4][8];
#pragma unroll
            for (int i = 0; i < 4; ++i) {
                const bf16_t* ap = A + (size_t)(m0 + i) * lda + k0;
#pragma unroll
                for (int kk = 0; kk < 8; ++kk) a[i][kk] = bf2f(ap[kk]);
            }
#pragma unroll
            for (int kk = 0; kk < 8; ++kk) {
                const float* bp = B + (size_t)(k0 + kk) * ldb + n0;
                float b[4], b2[4];
#pragma unroll
                for (int j = 0; j < 4; ++j) { b[j] = rbf(bp[j]); b2[j] = DUAL ? rbf(bp[off2 + j]) : 0.f; }
#pragma unroll
                for (int i = 0; i < 4; ++i)
#pragma unroll
                    for (int j = 0; j < 4; ++j) { acc[i][j] += a[i][kk] * b[j]; if (DUAL) acc2[i][j] += a[i][kk] * b2[j]; }
            }
        }
#pragma unroll
        for (int i = 0; i < 4; ++i)
#pragma unroll
            for (int j = 0; j < 4; ++j) epi(m0 + i, n0 + j, acc[i][j], acc2[i][j]);
    }
};
struct EGlu { Params p; HD_FN void operator()(int row, int col, float v, float v2) const { ((bf16_t*)(p.ws + WS_UPRE))[(size_t)row * CCH + col] = f2bf(v * sigmoidf_(v2)); } };
struct EQkvo { Params p; HD_FN void operator()(int row, int col, float v, float) const {
        const int part = col / MW; if (part == 1) v *= 1.0f / sqrtf((float)MDK); if (part == 3) v = sigmoidf_(v);
        ((bf16_t*)(p.ws + WS_QKVO))[(size_t)row * 4 * MW + col] = f2bf(v); } };
struct EOut { Params p; int l; int pad_ = 0; HD_FN void operator()(int row, int col, float v, float) const {
        const int cls = cls_of(row); float* Y = p.out + O_Y + (size_t)row * DM + col;
        const float xin = l == 0 ? xrow(p, row)[col] : *Y;
        const float x1 = xin + modv(p, l, cls, 2)[col] * v; *Y = x1;
        ((bf16_t*)(p.ws + WS_XN))[(size_t)row * DM + col] = f2bf(x1 * p.n2g[(size_t)l * DM + col] * (1.f + modv(p, l, cls, 4)[col])); } };
struct EFfnIn { Params p; const float* sw; int slot; int pad_ = 0; HD_FN void operator()(int row, int col, float v, float v2) const {
        const int cls = cls_of(row); const float rs = 1.0f / sqrtf(((const float*)(p.ws + WS_SSQ))[(size_t)slot * SSQ_STRIDE + row] / DM + EPSF);
        const float a = v * rs + sw[(size_t)cls * 2 * DFF + col], b = v2 * rs + sw[(size_t)cls * 2 * DFF + DFF + col];
        ((bf16_t*)(p.ws + WS_H))[(size_t)row * DFF + col] = f2bf(siluf_(a) * b); } };
struct EFfnOut { Params p; int l; int pad_ = 0; HD_FN void operator()(int row, int col, float v, float) const {
        const int cls = cls_of(row); float* Y = p.out + O_Y + (size_t)row * DM + col;
        const float x2 = *Y + modv(p, l, cls, 5)[col] * v; *Y = x2;
        if (l == 0) ((bf16_t*)(p.ws + WS_XN))[(size_t)row * DM + col] = f2bf(x2 * p.n1g[(size_t)DM + col] * (1.f + modv(p, 1, cls, 1)[col])); } };
struct EQkv { Params p; const float* sw; int slot; int pad_ = 0; HD_FN void operator()(int row, int col, float v, float) const {
        const int cls = cls_of(row); const float rs = 1.0f / sqrtf(((const float*)(p.ws + WS_SSQ))[(size_t)slot * SSQ_STRIDE + row] / DM + EPSF);
        const float a = v * rs + sw[(size_t)cls * CIN + col];
        if (col < NQ * HDIM) ((bf16_t*)(p.ws + WS_QRAW))[(size_t)row * NQ * HDIM + col] = f2bf(a);
        else if (col < (NQ + NKV) * HDIM) ((bf16_t*)(p.ws + WS_KRAW))[(size_t)row * NKV * HDIM + (col - NQ * HDIM)] = f2bf(a);
        else { const int c2 = col - (NQ + NKV) * HDIM;
            if (row < MC) { ((bf16_t*)(p.ws + WS_CTXV))[(size_t)row * NKV * HDIM + c2] = f2bf(a); p.out[O_V + (size_t)row * NKV * HDIM + c2] = a; }
            else { const int b = (row - MC) / LSEQ, s = (row - MC) % LSEQ; ((bf16_t*)(p.ws + WS_LATV))[((size_t)b * SKVL + s) * NKV * HDIM + c2] = f2bf(a); } } } };

struct NSsq {
    Params p; int slot; int pad_ = 0; static HD_FN long count() { return MTOK; }
    HD_FN void operator()(long row) const { const float* y = p.out + O_Y + (size_t)row * DM; float s = 0.f; for (int k = 0; k < DM; ++k) s += y[k] * y[k];
        ((float*)(p.ws + WS_SSQ))[(size_t)slot * SSQ_STRIDE + row] = s; }
};
struct NSW {
    Params p; const float* W; float* sw; int l, which, N, pad_; HD_FN long count() const { return (long)NCLS * N; }
    HD_FN void operator()(long idx) const { const int n = (int)(idx % N), cls = (int)(idx / N); const float* sh = modv(p, l, cls, which); float acc = 0.f;
        for (int k = 0; k < DM; ++k) acc += sh[k] * rbf(W[(size_t)k * N + n]); sw[idx] = acc; }
};
struct NConv {
    Params p; static HD_FN long count() { return (long)MTOK * CCH; }
    HD_FN void operator()(long idx) const {
        const int row = (int)(idx / CCH), c = (int)(idx % CCH), pos = pos_of(row), len = seqlen_of(row);
        const bf16_t* U = (const bf16_t*)(p.ws + WS_UPRE); float acc = p.convb[c];
        for (int j = 0; j < CWID; ++j) { const int t = pos + j - CWID / 2; if (t >= 0 && t < len) acc += p.convw[(size_t)j * CCH + c] * bf2f(U[(size_t)(row + j - CWID / 2) * CCH + c]); }
        ((float*)(p.ws + WS_HS))[idx] = acc;
    }
};
struct NConvLN {
    Params p; static HD_FN long count() { return MTOK; }
    HD_FN void operator()(long row) const {
        const float* t = (const float*)(p.ws + WS_HS) + (size_t)row * CCH; float mu = 0.f;
        for (int c = 0; c < CCH; ++c) mu += t[c]; mu /= CCH; float var = 0.f;
        for (int c = 0; c < CCH; ++c) { const float d = t[c] - mu; var += d * d; } var /= CCH;
        const float rs = 1.0f / sqrtf(var + EPSF); bf16_t* UH = (bf16_t*)(p.ws + WS_UH) + (size_t)row * DM;
        for (int c = 0; c < CCH; ++c) UH[c] = f2bf(siluf_((t[c] - mu) * rs * p.lng[c] + p.lnb[c]));
    }
};
HD_FN int seq_base(int sid) { return sid < NCB ? sid * CSEQ : MC + (sid - NCB) * LSEQ; }
struct NMlstmDen {
    Params p; static HD_FN long count() { return (long)NSEQ * MH * 2; }
    HD_FN void operator()(long idx) const {
        const int dir = (int)(idx % 2), h = (int)((idx / 2) % MH), sid = (int)(idx / (2 * MH)); const bool isctx = sid < NCB;
        const int base = seq_base(sid), len = isctx ? CSEQ : LSEQ;
        float n[MDK]; float mrun = 0.f;
        if (isctx) {
#pragma unroll
            for (int d = 0; d < MDK; ++d) n[d] = 0.f;
        } else { const int b = sid - NCB; const float em = expf(p.stm[(size_t)(b * 2 + dir) * MH + h]);
#pragma unroll
            for (int d = 0; d < MDK; ++d) n[d] = p.stn[((size_t)(b * 2 + dir) * MH + h) * MDK + d] * em; }
        const bf16_t* QK = (const bf16_t*)(p.ws + WS_QKVO); const float* G = (const float*)(p.ws + WS_GATES); float* DEN = (float*)(p.ws + WS_DEN);
        for (int t = 0; t < len; ++t) {
            const int row = base + (dir == 0 ? t : len - 1 - t);
            const float ig = G[(size_t)row * NGATE + dir * 8 + h], lf = G[(size_t)row * NGATE + dir * 8 + 4 + h];
            const float f = expf(lf), ei = expf(ig); mrun = fmaxf(mrun + lf, ig);
            const bf16_t* q = QK + (size_t)row * 4 * MW + h * MDK; const bf16_t* k = q + MW; float den = 0.f;
#pragma unroll
            for (int d = 0; d < MDK; ++d) { n[d] = f * n[d] + ei * bf2f(k[d]); den += bf2f(q[d]) * n[d]; }
            DEN[((size_t)dir * MTOK + row) * MH + h] = den;
        }
        if (isctx) { const float em = expf(-mrun); p.out[O_M + (size_t)(sid * 2 + dir) * MH + h] = mrun;
#pragma unroll
            for (int d = 0; d < MDK; ++d) p.out[O_N + ((size_t)(sid * 2 + dir) * MH + h) * MDK + d] = n[d] * em; }
    }
};
struct NMlstmNum {
    Params p; int dir; int pad_ = 0; static HD_FN long count() { return (long)NSEQ * MH * MDK; }
    HD_FN void operator()(long idx) const {
        const int v = (int)(idx % MDK), h = (int)((idx / MDK) % MH), sid = (int)(idx / (MDK * MH)); const bool isctx = sid < NCB;
        const int base = seq_base(sid), len = isctx ? CSEQ : LSEQ;
        float C[MDK];
        if (isctx) {
#pragma unroll
            for (int d = 0; d < MDK; ++d) C[d] = 0.f;
        } else { const int b = sid - NCB; const float em = expf(p.stm[(size_t)(b * 2 + dir) * MH + h]);
#pragma unroll
            for (int d = 0; d < MDK; ++d) C[d] = p.stC[(((size_t)(b * 2 + dir) * MH + h) * MDK + d) * MDK + v] * em; }
        const bf16_t* QK = (const bf16_t*)(p.ws + WS_QKVO); const float* G = (const float*)(p.ws + WS_GATES); const float* DEN = (const float*)(p.ws + WS_DEN);
        float* HS = (float*)(p.ws + WS_HS);
        for (int t = 0; t < len; ++t) {
            const int row = base + (dir == 0 ? t : len - 1 - t);
            const float ig = G[(size_t)row * NGATE + dir * 8 + h], lf = G[(size_t)row * NGATE + dir * 8 + 4 + h];
            const float f = expf(lf), ei = expf(ig);
            const bf16_t* q = QK + (size_t)row * 4 * MW + h * MDK; const bf16_t* k = q + MW; const float vv = bf2f(q[2 * MW + v]) * ei; float num = 0.f;
#pragma unroll
            for (int d = 0; d < MDK; ++d) { C[d] = f * C[d] + bf2f(k[d]) * vv; num += bf2f(q[d]) * C[d]; }
            const float den = DEN[((size_t)dir * MTOK + row) * MH + h]; const float hv = num / fmaxf(fabsf(den), 1.0f);
            float* o = HS + (size_t)row * MW + h * MDK + v; if (dir == 0) *o = hv; else *o += hv;
        }
        if (isctx) { const float em = expf(-p.out[O_M + (size_t)(sid * 2 + dir) * MH + h]);
#pragma unroll
            for (int d = 0; d < MDK; ++d) p.out[O_C + (((size_t)(sid * 2 + dir) * MH + h) * MDK + d) * MDK + v] = C[d] * em; }
    }
};
struct NHm {
    Params p; static HD_FN long count() { return (long)MTOK * MH; }
    HD_FN void operator()(long idx) const {
        const int row = (int)(idx / MH), h = (int)(idx % MH); const float* x = (const float*)(p.ws + WS_HS) + (size_t)row * MW + h * MDK; float s = 0.f;
        for (int v = 0; v < MDK; ++v) s += x[v] * x[v];
        const float rs = 1.0f / sqrtf(s / MDK + EPSF); const bf16_t* og = (const bf16_t*)(p.ws + WS_QKVO) + (size_t)row * 4 * MW + 3 * MW + h * MDK;
        bf16_t* UH = (bf16_t*)(p.ws + WS_UH) + (size_t)row * DM + CCH + h * MDK;
        for (int v = 0; v < MDK; ++v) UH[v] = f2bf(bf2f(og[v]) * x[v] * rs * p.mng[h * MDK + v]);
    }
};
struct NCacheCvt {
    Params p; static HD_FN long count() { return (long)NLB * PAST * NKV * HDIM; }
    HD_FN void operator()(long idx) const { const int e = (int)(idx % (NKV * HDIM)), pp = (int)((idx / (NKV * HDIM)) % PAST), b = (int)(idx / ((long)NKV * HDIM * PAST));
        const size_t dst = ((size_t)b * SKVL + LSEQ + pp) * NKV * HDIM + e;
        ((bf16_t*)(p.ws + WS_LATK))[dst] = f2bf(p.ck[idx]); ((bf16_t*)(p.ws + WS_LATV))[dst] = f2bf(p.cv[idx]); }
};
struct NQkPost {
    Params p; static HD_FN long count() { return (long)MTOK * (NQ + NKV); }
    HD_FN void operator()(long idx) const {
        const int row = (int)(idx / (NQ + NKV)), j = (int)(idx % (NQ + NKV)); const bool isq = j < NQ; const bool lat = row >= MC;
        bf16_t* src = isq ? (bf16_t*)(p.ws + WS_QRAW) + (size_t)row * NQ * HDIM + j * HDIM : (bf16_t*)(p.ws + WS_KRAW) + (size_t)row * NKV * HDIM + (j - NQ) * HDIM;
        const float* g = isq ? p.qng : p.kng; float s = 0.f;
        for (int d = 0; d < HDIM; ++d) { const float x = bf2f(src[d]); s += x * x; }
        const float rs = 1.0f / sqrtf(s / HDIM + EPSF);
        bf16_t* dst; float* fo = nullptr;
        if (isq) dst = src;
        else if (!lat) { dst = (bf16_t*)(p.ws + WS_CTXK) + (size_t)row * NKV * HDIM + (j - NQ) * HDIM; fo = p.out + O_K + (size_t)row * NKV * HDIM + (j - NQ) * HDIM; }
        else { const int b = (row - MC) / LSEQ, sp = (row - MC) % LSEQ; dst = (bf16_t*)(p.ws + WS_LATK) + ((size_t)b * SKVL + sp) * NKV * HDIM + (j - NQ) * HDIM; }
        const int sp = pos_of(row); const float prow = (float)(sp / GRIDW), pcol = (float)(sp % GRIDW);
        for (int half = 0; half < 2; ++half)
            for (int d = 0; d < HDIM / 4; ++d) {
                const int i1 = half * (HDIM / 2) + d, i2 = i1 + HDIM / 4;
                const float x1 = bf2f(src[i1]) * rs * g[i1], x2 = bf2f(src[i2]) * rs * g[i2]; float y1 = x1, y2 = x2;
                if (lat) { const float inv = powf(10000.0f, -(float)d / (float)(HDIM / 4)); const float ang = (half == 0 ? prow : pcol) * inv; const float cs = cosf(ang), sn = sinf(ang);
                    y1 = x1 * cs - x2 * sn; y2 = x1 * sn + x2 * cs; }
                dst[i1] = f2bf(y1); dst[i2] = f2bf(y2); if (fo) { fo[i1] = y1; fo[i2] = y2; }
            }
    }
};
struct NAttn {
    Params p; static HD_FN long count() { return (long)MTOK * NQ * 4; }
    HD_FN void operator()(long idx) const {
        const int sl = (int)(idx % 4), hq = (int)((idx / 4) % NQ), row = (int)(idx / (4 * NQ)); const int kv = hq / GRP;
        const bf16_t *Kb, *Vb; int nk;
        if (row < MC) { const int b = row / CSEQ; Kb = (const bf16_t*)(p.ws + WS_CTXK) + (size_t)b * CSEQ * NKV * HDIM; Vb = (const bf16_t*)(p.ws + WS_CTXV) + (size_t)b * CSEQ * NKV * HDIM; nk = CSEQ; }
        else { const int b = (row - MC) / LSEQ; Kb = (const bf16_t*)(p.ws + WS_LATK) + (size_t)b * SKVL * NKV * HDIM; Vb = (const bf16_t*)(p.ws + WS_LATV) + (size_t)b * SKVL * NKV * HDIM; nk = SKVL; }
        const bf16_t* qp = (const bf16_t*)(p.ws + WS_QRAW) + (size_t)row * NQ * HDIM + hq * HDIM;
        float q[HDIM];
#pragma unroll
        for (int d = 0; d < HDIM; ++d) q[d] = bf2f(qp[d]);
        float o[32];
#pragma unroll
        for (int e = 0; e < 32; ++e) o[e] = 0.f;
        float m = -1e30f, l = 0.f; const float scale = 1.0f / sqrtf((float)HDIM);
        for (int s = 0; s < nk; ++s) {
            const bf16_t* kp = Kb + (size_t)s * NKV * HDIM + kv * HDIM; float dot = 0.f;
#pragma unroll
            for (int d = 0; d < HDIM; ++d) dot += q[d] * bf2f(kp[d]);
            dot *= scale; const float mn = fmaxf(m, dot); const float al = expf(m - mn), pe = expf(dot - mn); m = mn; l = l * al + pe;
            const bf16_t* vp = Vb + (size_t)s * NKV * HDIM + kv * HDIM + sl * 32;
#pragma unroll
            for (int e = 0; e < 32; ++e) o[e] = o[e] * al + pe * bf2f(vp[e]);
        }
        bf16_t* op = (bf16_t*)(p.ws + WS_O) + (size_t)row * DM + hq * HDIM + sl * 32;
#pragma unroll
        for (int e = 0; e < 32; ++e) op[e] = f2bf(o[e] / l);
    }
};
struct NFinal {
    Params p; static HD_FN long count() { return (long)MTOK * DM; }
    HD_FN void operator()(long idx) const { const int row = (int)(idx / DM), col = (int)(idx % DM);
        const float rs = 1.0f / sqrtf(((const float*)(p.ws + WS_SSQ))[(size_t)3 * SSQ_STRIDE + row] / DM + EPSF); p.out[O_Y + idx] *= rs * p.fng[col]; }
};
template <class L> HD_FN void run_naive(const Params& p, L& go) {
    const bf16_t* XN = (const bf16_t*)(p.ws + WS_XN); const bf16_t* UH = (const bf16_t*)(p.ws + WS_UH); const bf16_t* Hh = (const bf16_t*)(p.ws + WS_H); const bf16_t* Ob = (const bf16_t*)(p.ws + WS_O);
    float* SW0 = (float*)(p.ws + WS_SW); float* SWC = SW0 + (size_t)NCLS * 2 * DFF; float* SW1 = SWC + (size_t)NCLS * CIN;
    go(NMod{p}, NMod::count());
    go(NNorm0a{p}, NNorm0a::count()); go(NNorm0b{p}, NNorm0b::count()); go(NGates{p}, NGates::count());
    { NGemm<true, EGlu> g{XN, p.winab, DM, ABIN, DM, CCH, CCH, 0, EGlu{p}}; go(g, g.count()); }
    { NGemm<false, EQkvo> g{XN, p.winab + 2 * CCH, DM, ABIN, DM, 4 * MW, 0, 0, EQkvo{p}}; go(g, g.count()); }
    go(NConv{p}, NConv::count()); go(NConvLN{p}, NConvLN::count());
    go(NMlstmDen{p}, NMlstmDen::count()); go(NMlstmNum{p, 0}, NMlstmNum::count()); go(NMlstmNum{p, 1}, NMlstmNum::count()); go(NHm{p}, NHm::count());
    { NGemm<false, EOut> g{UH, p.woutab, DM, DM, DM, DM, 0, 0, EOut{p, 0}}; go(g, g.count()); }
    go(NSsq{p, 0}, NSsq::count());
    { NSW s{p, p.wffi, SW0, 0, 3, 2 * DFF, 0}; go(s, s.count()); }
    { NGemm<true, EFfnIn> g{XN, p.wffi, DM, 2 * DFF, DM, DFF, DFF, 0, EFfnIn{p, SW0, 0}}; go(g, g.count()); }
    { NGemm<false, EFfnOut> g{Hh, p.wffo, DFF, DM, DFF, DM, 0, 0, EFfnOut{p, 0}}; go(g, g.count()); }
    go(NSsq{p, 1}, NSsq::count());
    { NSW s{p, p.winc, SWC, 1, 0, CIN, 0}; go(s, s.count()); }
    { NGemm<false, EQkv> g{XN, p.winc, DM, CIN, DM, CIN, 0, 0, EQkv{p, SWC, 1}}; go(g, g.count()); }
    go(NCacheCvt{p}, NCacheCvt::count()); go(NQkPost{p}, NQkPost::count());
    go(NAttn{p}, NAttn::count());
    { NGemm<false, EOut> g{Ob, p.woutc, DM, DM, DM, DM, 0, 0, EOut{p, 1}}; go(g, g.count()); }
    go(NSsq{p, 2}, NSsq::count());
    { NSW s{p, p.wffi + (size_t)DM * 2 * DFF, SW1, 1, 3, 2 * DFF, 0}; go(s, s.count()); }
    { NGemm<true, EFfnIn> g{XN, p.wffi + (size_t)DM * 2 * DFF, DM, 2 * DFF, DM, DFF, DFF, 0, EFfnIn{p, SW1, 2}}; go(g, g.count()); }
    { NGemm<false, EFfnOut> g{Hh, p.wffo + (size_t)DFF * DM, DFF, DM, DFF, DM, 0, 0, EFfnOut{p, 1}}; go(g, g.count()); }
    go(NSsq{p, 3}, NSsq::count());
    go(NFinal{p}, NFinal::count());
}
constexpr int NWAVES = 8, NTHREADS = NWAVES * 64;
constexpr int RING_OFF = 0, RING_BYTES = 131072;
constexpr int LDSCTL_OFF = RING_BYTES, MISC_OFF = LDSCTL_OFF + 320;
constexpr int LDS_BYTES = 147456;
constexpr int CW_TMO = 0, CW_CODE = 1, CW_BAR = 4096;
#define GAS __attribute__((address_space(1)))
#define LAS __attribute__((address_space(3)))
typedef GAS unsigned gu32;
#define RLX_AGENT __ATOMIC_RELAXED, __HIP_MEMORY_SCOPE_AGENT
#define XB_TMO      128
#define XB_XCNT(j)  (256  + 64 * (j))
#define XB_XSUB(j)  (1280 + 64 * (j))
#define XB_XGEN(j)  (2304 + 64 * (j))
#define XB_TOP      3328
#define XB_TOPGEN   3392
#define XCD_BAR_WORDS 3456
#define XB_SPIN_CAP (1u << 22)
__device__ __forceinline__ unsigned xb_ld(unsigned* p)              { return __hip_atomic_load(p, __ATOMIC_RELAXED, __HIP_MEMORY_SCOPE_AGENT); }
__device__ __forceinline__ unsigned xb_add(unsigned* p, unsigned v) { return __hip_atomic_fetch_add(p, v, __ATOMIC_RELAXED, __HIP_MEMORY_SCOPE_AGENT); }
__device__ __forceinline__ unsigned xb_xcc_id() { return (unsigned)__builtin_amdgcn_s_getreg((3 << 11) | 20) & 0xFu; }
#define XB_SPIN(cond, bar) do { unsigned _sp = 0; while (cond) { __builtin_amdgcn_s_sleep(1); \
    if ((++_sp & 255u) == 0u) { if (xb_ld(&(bar)[XB_TMO])) break; if (_sp > XB_SPIN_CAP) { atomicAdd(&(bar)[XB_TMO], 1u); break; } } } } while (0)
struct XcdBarrier { unsigned* bar; unsigned x; volatile LAS unsigned* st; };
__device__ __forceinline__ XcdBarrier xcd_barrier_post(unsigned* bar, volatile LAS unsigned* st) {
    XcdBarrier b; b.bar = bar; b.x = xb_xcc_id(); b.st = st;
    if (threadIdx.x == 0) (void)xb_add(&bar[XB_XCNT(b.x)], 1u);
    return b;
}
__device__ __forceinline__ void xcd_barrier_complete(unsigned* bar, unsigned x, unsigned& nloc, unsigned& nx) {
    const unsigned G = gridDim.x * gridDim.y * gridDim.z;
    unsigned sum, cnt, mine, sp = 0u;
    for (;;) {
        sum = 0u; cnt = 0u; mine = 0u;
#pragma unroll
        for (unsigned j = 0; j < 16; ++j) { const unsigned c = xb_ld(&bar[XB_XCNT(j)]); sum += c; cnt += (c > 0u) ? 1u : 0u; mine = (j == x) ? c : mine; }
        if (sum == G) break;
        __builtin_amdgcn_s_sleep(1);
        if ((++sp & 255u) == 0u) { if (xb_ld(&bar[XB_TMO])) break; if (sp > XB_SPIN_CAP) { atomicAdd(&bar[XB_TMO], 1u); break; } }
    }
    nloc = mine > 0u ? mine : 1u; nx = cnt > 0u ? cnt : 1u;
}
__device__ __forceinline__ void xcd_barrier(const XcdBarrier& b) {
    asm volatile("s_waitcnt vmcnt(0)" ::: "memory");
    __syncthreads();
    if (threadIdx.x == 0) {
        unsigned* bar = b.bar;
        __builtin_amdgcn_s_waitcnt(0);
        unsigned nloc = b.st[0], nx = b.st[1];
        if (nloc == 0u) { xcd_barrier_complete(bar, b.x, nloc, nx); b.st[0] = nloc; b.st[1] = nx; }
        const unsigned old = xb_add(&bar[XB_XSUB(b.x)], 1u);
        const unsigned gen = old / nloc;
        if (old + 1u == (gen + 1u) * nloc) {
            __builtin_amdgcn_fence(__ATOMIC_RELEASE, "agent");
            asm volatile("s_waitcnt vmcnt(0)" ::: "memory");
            const unsigned og = xb_add(&bar[XB_TOP], 1u);
            const unsigned tg = og / nx;
            if (og + 1u == (tg + 1u) * nx) xb_add(&bar[XB_TOPGEN], 1u);
            else XB_SPIN(xb_ld(&bar[XB_TOPGEN]) == tg, bar);
            __builtin_amdgcn_fence(__ATOMIC_ACQUIRE, "agent");
            xb_add(&bar[XB_XGEN(b.x)], 1u);
            asm volatile("s_waitcnt vmcnt(0)" ::: "memory");
        } else {
            XB_SPIN(xb_ld(&bar[XB_XGEN(b.x)]) == gen, bar);
            __builtin_amdgcn_fence(__ATOMIC_ACQUIRE, "agent");
            asm volatile("s_waitcnt vmcnt(0)" ::: "memory");
        }
    }
    __syncthreads();
}
struct DevGo { XcdBarrier bar; template <class F> __device__ __forceinline__ void operator()(const F& f, long n) {
    for (long i = blockIdx.x * (long)NTHREADS + threadIdx.x; i < n; i += (long)gridDim.x * NTHREADS) f(i);
    xcd_barrier(bar); } };
__global__ void __launch_bounds__(NTHREADS, 2) mega_fwd(Params p) {
    extern __shared__ __attribute__((aligned(16))) unsigned char lds[];
    LAS unsigned char* L = (LAS unsigned char*)lds;
    for (int u = threadIdx.x; u < (LDS_BYTES - LDSCTL_OFF) / 4; u += NTHREADS) ((LAS unsigned*)(L + LDSCTL_OFF))[u] = 0u;
    __syncthreads();
    volatile LAS unsigned* MISC = (volatile LAS unsigned*)(L + MISC_OFF);
    DevGo go; go.bar = xcd_barrier_post((unsigned*)(p.ws + WS_CTL) + CW_BAR, MISC + 8);
    run_naive(p, go);
}
static Params make_params(void* const* d_in, void* d_out, void* d_ws) {
    Params p{}; const float** pp = (const float**)&p; for (int i = 0; i < 28; ++i) pp[i] = (const float*)d_in[i];
    p.out = (float*)d_out; p.ws = (unsigned char*)d_ws; return p;
}
extern "C" void kernel_launch(void* const* d_in, const int* in_sizes, int n_in, void* d_out, int out_size, void* d_ws, size_t ws_size, hipStream_t stream) {
    static int grid = 0;
    if (grid == 0) {
        if (n_in != 28 || (size_t)out_size != O_END || ws_size < WS_END || in_sizes[0] != MC * DM || in_sizes[1] != ML * DM) {
            fprintf(stderr, "kernel_launch: shape mismatch n_in %d out %d (want %zu) ws %zu (want %zu)\n", n_in, out_size, (size_t)O_END, ws_size, (size_t)WS_END); grid = -1; return; }
        int dev = 0, cus = 0;
        if (hipGetDevice(&dev) != hipSuccess || hipDeviceGetAttribute(&cus, hipDeviceAttributeMultiprocessorCount, dev) != hipSuccess) { grid = -1; return; }
        if (hipFuncSetAttribute((const void*)mega_fwd, hipFuncAttributeMaxDynamicSharedMemorySize, LDS_BYTES) != hipSuccess) { fprintf(stderr, "hipFuncSetAttribute failed\n"); grid = -1; return; }
        int per_cu = 0; (void)hipOccupancyMaxActiveBlocksPerMultiprocessor(&per_cu, (const void*)mega_fwd, NTHREADS, LDS_BYTES); (void)hipGetLastError();
        if (per_cu < 1) fprintf(stderr, "kernel_launch: occupancy query says %d blocks/CU\n", per_cu);
        grid = cus;
    }
    if (grid < 0) return;
    hipMemsetAsync((char*)d_ws + WS_CTL, 0, CTL_ZERO_BYTES, stream);
    Params p = make_params(d_in, d_out, d_ws);
    hipLaunchKernelGGL(mega_fwd, dim3(grid), dim3(NTHREADS), LDS_BYTES, stream, p);
}
```

```cpp
#ifdef HOST_TEST
#include <cmath>
#include <cstdio>
#include <cstdlib>
#include <cstring>
#include <cstdint>
#include <vector>
#define HD_FN inline
#define DEV_FN inline
#else
#include <hip/hip_runtime.h>
#include <cstdio>
#include <cstdint>
#define HD_FN __host__ __device__ __forceinline__
#define DEV_FN __device__ __forceinline__
#endif

#ifdef TINY
constexpr int DM = 512, NCB = 2, CSEQ = 128, NLB = 2, LSEQ = 128, PAST = 128;
#else
constexpr int DM = 1024, NCB = 16, CSEQ = 256, NLB = 4, LSEQ = 4096, PAST = 256;
#endif
constexpr int GRIDW = 64, CCH = DM / 2, CWID = 31, MH = 4, MDK = CCH / MH, MW = CCH, NGATE = 16;
constexpr int ABIN = 2 * CCH + 4 * MW + NGATE, ABMAIN = 2 * CCH + 4 * MW;
constexpr int HDIM = 128, NQ = DM / HDIM, NKV = 2, GRP = NQ / NKV, CIN = (NQ + 2 * NKV) * HDIM;
constexpr int DFF = ((8 * DM + 3 * 256 - 1) / (3 * 256)) * 256;
constexpr int MC = NCB * CSEQ, ML = NLB * LSEQ, MTOK = MC + ML, NCLS = 1 + NLB, SKVL = LSEQ + PAST;
constexpr float EPSF = 1e-6f;
constexpr int NSEQ = NCB + NLB;

constexpr size_t O_Y = 0, O_C = (size_t)MTOK * DM, O_N = O_C + (size_t)NCB * 2 * MH * MDK * MDK, O_M = O_N + (size_t)NCB * 2 * MH * MDK,
                 O_K = O_M + (size_t)NCB * 2 * MH, O_V = O_K + (size_t)NCB * CSEQ * NKV * HDIM, O_END = O_V + (size_t)NCB * CSEQ * NKV * HDIM;

constexpr size_t MiB = 1u << 20;
#ifdef TINY
constexpr size_t WSCALE = 1;
#endif
constexpr size_t WS_CTL = 0, CTL_ZERO_BYTES = 1 * MiB;
constexpr size_t WS_MOD = 1 * MiB;
constexpr size_t WS_SW = WS_MOD + 256 * 1024;
constexpr size_t WS_SSQ = 512 * 1024;
constexpr int SSQ_STRIDE = 32768;
constexpr size_t WS_DEN = 232 * MiB;
constexpr size_t WS_WB = 2 * MiB;
constexpr size_t WS_XN = 50 * MiB;
constexpr size_t WS_UPRE = 90 * MiB;
constexpr size_t WS_QKVO = 110 * MiB;
constexpr size_t WS_UH = 190 * MiB;
constexpr size_t WS_GATES = 230 * MiB;
constexpr size_t WS_HS = 50 * MiB;
constexpr size_t WS_H = 110 * MiB;
constexpr size_t WS_QRAW = 110 * MiB;
constexpr size_t WS_LATK = 150 * MiB, WS_LATV = 159 * MiB, WS_CTXK = 168 * MiB, WS_CTXV = 170 * MiB;
constexpr size_t WS_KRAW = 172 * MiB;
constexpr size_t WS_O = 190 * MiB;
constexpr size_t WS_END = 256 * MiB;

typedef unsigned short bf16_t;
HD_FN float bf2f(bf16_t h) { unsigned u = (unsigned)h << 16; return __builtin_bit_cast(float, u); }
HD_FN bf16_t f2bf(float f) { unsigned u = __builtin_bit_cast(unsigned, f); return (bf16_t)((u + 0x7fffu + ((u >> 16) & 1u)) >> 16); }
HD_FN float rbf(float f) { return bf2f(f2bf(f)); }
HD_FN float sigmoidf_(float x) { return 1.0f / (1.0f + expf(-x)); }
HD_FN float siluf_(float x) { return x * sigmoidf_(x); }
HD_FN float logsigmoidf_(float x) { return x >= 0.f ? -log1pf(expf(-x)) : x - log1pf(expf(x)); }
HD_FN int cls_of(int row) { return row < MC ? 0 : 1 + (row - MC) / LSEQ; }
HD_FN int seqlen_of(int row) { return row < MC ? CSEQ : LSEQ; }
HD_FN int pos_of(int row) { return row < MC ? row % CSEQ : (row - MC) % LSEQ; }

struct Params {
    const float *xp, *xs, *c, *stC, *stn, *stm, *ck, *cv, *cctx, *wmod, *bmod, *n1g, *n2g, *winab, *bgate, *convw, *convb, *lng, *lnb, *mng,
        *woutab, *winc, *qng, *kng, *woutc, *wffi, *wffo, *fng;
    float* out; unsigned char* ws;
};
HD_FN const float* xrow(const Params& p, int row) { return row < MC ? p.xp + (size_t)row * DM : p.xs + (size_t)(row - MC) * DM; }
HD_FN const float* modv(const Params& p, int l, int cls, int which) { return (const float*)(p.ws + WS_MOD) + ((size_t)(l * NCLS + cls) * 6 + which) * DM; }
constexpr size_t WS_RS0 = 233 * MiB;

struct NMod {
    Params p; static HD_FN long count() { return 2L * NCLS * 6 * DM; }
    HD_FN void operator()(long idx) const {
        const int col = (int)(idx % (6 * DM)); const int cls = (int)((idx / (6 * DM)) % NCLS); const int l = (int)(idx / (6 * DM * NCLS));
        const float* cond = cls == 0 ? p.cctx : p.c + (size_t)(cls - 1) * DM;
        const float* w = p.wmod + (size_t)l * DM * 6 * DM;
        float acc = 0.f;
        for (int k = 0; k < DM; ++k) acc += siluf_(cond[k]) * w[(size_t)k * 6 * DM + col];
        ((float*)(p.ws + WS_MOD))[idx] = acc + p.bmod[(size_t)l * 6 * DM + col];
    }
};
struct NNorm0a {
    Params p; static HD_FN long count() { return MTOK; }
    HD_FN void operator()(long row) const {
        const float* x = xrow(p, (int)row); float s = 0.f;
        for (int k = 0; k < DM; ++k) s += x[k] * x[k];
        ((float*)(p.ws + WS_RS0))[row] = 1.0f / sqrtf(s / DM + EPSF);
    }
};
struct NNorm0b {
    Params p; static HD_FN long count() { return (long)MTOK * DM; }
    HD_FN void operator()(long idx) const {
        const int row = (int)(idx / DM), col = (int)(idx % DM), cls = cls_of(row);
        const float rs = ((const float*)(p.ws + WS_RS0))[row];
        const float v = xrow(p, row)[col] * rs * p.n1g[col] * (1.f + modv(p, 0, cls, 1)[col]) + modv(p, 0, cls, 0)[col];
        ((bf16_t*)(p.ws + WS_XN))[idx] = f2bf(v);
    }
};
struct NGates {
    Params p; static HD_FN long count() { return (long)MTOK * NGATE; }
    HD_FN void operator()(long idx) const {
        const int row = (int)(idx / NGATE), j = (int)(idx % NGATE), cls = cls_of(row);
        const float rs = ((const float*)(p.ws + WS_RS0))[row]; const float* x = xrow(p, row);
        const float* sc = modv(p, 0, cls, 1); const float* sh = modv(p, 0, cls, 0);
        float acc = 0.f;
        for (int k = 0; k < DM; ++k) { const float h = x[k] * rs * p.n1g[k] * (1.f + sc[k]) + sh[k]; acc += h * p.winab[(size_t)k * ABIN + ABMAIN + j]; }
        acc += p.bgate[j];
        if ((j & 7) >= 4) acc = logsigmoidf_(acc);
        ((float*)(p.ws + WS_GATES))[idx] = acc;
    }
};

template <bool DUAL, class Epi> struct NGemm {
    const bf16_t* A; const float* B; int lda, ldb, K, N, off2, pad_; Epi epi;
    HD_FN long count() const { return (long)(MTOK / 4) * (N / 4); }
    HD_FN void operator()(long idx) const {
        const int nt = (int)(idx % (N / 4)), mt = (int)(idx / (N / 4)); const int m0 = mt * 4, n0 = nt * 4;
        float acc[4][4], acc2[4][4];
#pragma unroll
        for (int i = 0; i < 4; ++i)
#pragma unroll
            for (int j = 0; j < 4; ++j) { acc[i][j] = 0.f; acc2[i][j] = 0.f; }
        for (int k0 = 0; k0 < K; k0 += 8) {
            float a[4][8];
#pragma unroll
            for (int i = 0; i < 4; ++i) {
                const bf16_t* ap = A + (size_t)(m0 + i) * lda + k0;
#pragma unroll
                for (int kk = 0; kk < 8; ++kk) a[i][kk] = bf2f(ap[kk]);
            }
#pragma unroll
            for (int kk = 0; kk < 8; ++kk) {
                const float* bp = B + (size_t)(k0 + kk) * ldb + n0;
                float b[4], b2[4];
#pragma unroll
                for (int j = 0; j < 4; ++j) { b[j] = rbf(bp[j]); b2[j] = DUAL ? rbf(bp[off2 + j]) : 0.f; }
#pragma unroll
                for (int i = 0; i < 4; ++i)
#pragma unroll
                    for (int j = 0; j < 4; ++j) { acc[i][j] += a[i][kk] * b[j]; if (DUAL) acc2[i][j] += a[i][kk] * b2[j]; }
            }
        }
#pragma unroll
        for (int i = 0; i < 4; ++i)
#pragma unroll
            for (int j = 0; j < 4; ++j) epi(m0 + i, n0 + j, acc[i][j], acc2[i][j]);
    }
};
struct EGlu { Params p; HD_FN void operator()(int row, int col, float v, float v2) const { ((bf16_t*)(p.ws + WS_UPRE))[(size_t)row * CCH + col] = f2bf(v * sigmoidf_(v2)); } };
struct EQkvo { Params p; HD_FN void operator()(int row, int col, float v, float) const {
        const int part = col / MW; if (part == 1) v *= 1.0f / sqrtf((float)MDK); if (part == 3) v = sigmoidf_(v);
        ((bf16_t*)(p.ws + WS_QKVO))[(size_t)row * 4 * MW + col] = f2bf(v); } };
struct EOut { Params p; int l; int pad_ = 0; HD_FN void operator()(int row, int col, float v, float) const {
        const int cls = cls_of(row); float* Y = p.out + O_Y + (size_t)row * DM + col;
        const float xin = l == 0 ? xrow(p, row)[col] : *Y;
        const float x1 = xin + modv(p, l, cls, 2)[col] * v; *Y = x1;
        ((bf16_t*)(p.ws + WS_XN))[(size_t)row * DM + col] = f2bf(x1 * p.n2g[(size_t)l * DM + col] * (1.f + modv(p, l, cls, 4)[col])); } };
struct EFfnIn { Params p; const float* sw; int slot; int pad_ = 0; HD_FN void operator()(int row, int col, float v, float v2) const {
        const int cls = cls_of(row); const float rs = 1.0f / sqrtf(((const float*)(p.ws + WS_SSQ))[(size_t)slot * SSQ_STRIDE + row] / DM + EPSF);
        const float a = v * rs + sw[(size_t)cls * 2 * DFF + col], b = v2 * rs + sw[(size_t)cls * 2 * DFF + DFF + col];
        ((bf16_t*)(p.ws + WS_H))[(size_t)row * DFF + col] = f2bf(siluf_(a) * b); } };
struct EFfnOut { Params p; int l; int pad_ = 0; HD_FN void operator()(int row, int col, float v, float) const {
        const int cls = cls_of(row); float* Y = p.out + O_Y + (size_t)row * DM + col;
        const float x2 = *Y + modv(p, l, cls, 5)[col] * v; *Y = x2;
        if (l == 0) ((bf16_t*)(p.ws + WS_XN))[(size_t)row * DM + col] = f2bf(x2 * p.n1g[(size_t)DM + col] * (1.f + modv(p, 1, cls, 1)[col])); } };
struct EQkv { Params p; const float* sw; int slot; int pad_ = 0; HD_FN void operator()(int row, int col, float v, float) const {
        const int cls = cls_of(row); const float rs = 1.0f / sqrtf(((const float*)(p.ws + WS_SSQ))[(size_t)slot * SSQ_STRIDE + row] / DM + EPSF);
        const float a = v * rs + sw[(size_t)cls * CIN + col];
        if (col < NQ * HDIM) ((bf16_t*)(p.ws + WS_QRAW))[(size_t)row * NQ * HDIM + col] = f2bf(a);
        else if (col < (NQ + NKV) * HDIM) ((bf16_t*)(p.ws + WS_KRAW))[(size_t)row * NKV * HDIM + (col - NQ * HDIM)] = f2bf(a);
        else { const int c2 = col - (NQ + NKV) * HDIM;
            if (row < MC) { ((bf16_t*)(p.ws + WS_CTXV))[(size_t)row * NKV * HDIM + c2] = f2bf(a); p.out[O_V + (size_t)row * NKV * HDIM + c2] = a; }
            else { const int b = (row - MC) / LSEQ, s = (row - MC) % LSEQ; ((bf16_t*)(p.ws + WS_LATV))[((size_t)b * SKVL + s) * NKV * HDIM + c2] = f2bf(a); } } } };

struct NSsq {
    Params p; int slot; int pad_ = 0; static HD_FN long count() { return MTOK; }
    HD_FN void operator()(long row) const { const float* y = p.out + O_Y + (size_t)row * DM; float s = 0.f; for (int k = 0; k < DM; ++k) s += y[k] * y[k];
        ((float*)(p.ws + WS_SSQ))[(size_t)slot * SSQ_STRIDE + row] = s; }
};
struct NSW {
    Params p; const float* W; float* sw; int l, which, N, pad_; HD_FN long count() const { return (long)NCLS * N; }
    HD_FN void operator()(long idx) const { const int n = (int)(idx % N), cls = (int)(idx / N); const float* sh = modv(p, l, cls, which); float acc = 0.f;
        for (int k = 0; k < DM; ++k) acc += sh[k] * rbf(W[(size_t)k * N + n]); sw[idx] = acc; }
};
struct NConv {
    Params p; static HD_FN long count() { return (long)MTOK * CCH; }
    HD_FN void operator()(long idx) const {
        const int row = (int)(idx / CCH), c = (int)(idx % CCH), pos = pos_of(row), len = seqlen_of(row);
        const bf16_t* U = (const bf16_t*)(p.ws + WS_UPRE); float acc = p.convb[c];
        for (int j = 0; j < CWID; ++j) { const int t = pos + j - CWID / 2; if (t >= 0 && t < len) acc += p.convw[(size_t)j * CCH + c] * bf2f(U[(size_t)(row + j - CWID / 2) * CCH + c]); }
        ((float*)(p.ws + WS_HS))[idx] = acc;
    }
};
struct NConvLN {
    Params p; static HD_FN long count() { return MTOK; }
    HD_FN void operator()(long row) const {
        const float* t = (const float*)(p.ws + WS_HS) + (size_t)row * CCH; float mu = 0.f;
        for (int c = 0; c < CCH; ++c) mu += t[c]; mu /= CCH; float var = 0.f;
        for (int c = 0; c < CCH; ++c) { const float d = t[c] - mu; var += d * d; } var /= CCH;
        const float rs = 1.0f / sqrtf(var + EPSF); bf16_t* UH = (bf16_t*)(p.ws + WS_UH) + (size_t)row * DM;
        for (int c = 0; c < CCH; ++c) UH[c] = f2bf(siluf_((t[c] - mu) * rs * p.lng[c] + p.lnb[c]));
    }
};
HD_FN int seq_base(int sid) { return sid < NCB ? sid * CSEQ : MC + (sid - NCB) * LSEQ; }
struct NMlstmDen {
    Params p; static HD_FN long count() { return (long)NSEQ * MH * 2; }
    HD_FN void operator()(long idx) const {
        const int dir = (int)(idx % 2), h = (int)((idx / 2) % MH), sid = (int)(idx / (2 * MH)); const bool isctx = sid < NCB;
        const int base = seq_base(sid), len = isctx ? CSEQ : LSEQ;
        float n[MDK]; float mrun = 0.f;
        if (isctx) {
#pragma unroll
            for (int d = 0; d < MDK; ++d) n[d] = 0.f;
        } else { const int b = sid - NCB; const float em = expf(p.stm[(size_t)(b * 2 + dir) * MH + h]);
#pragma unroll
            for (int d = 0; d < MDK; ++d) n[d] = p.stn[((size_t)(b * 2 + dir) * MH + h) * MDK + d] * em; }
        const bf16_t* QK = (const bf16_t*)(p.ws + WS_QKVO); const float* G = (const float*)(p.ws + WS_GATES); float* DEN = (float*)(p.ws + WS_DEN);
        for (int t = 0; t < len; ++t) {
            const int row = base + (dir == 0 ? t : len - 1 - t);
            const float ig = G[(size_t)row * NGATE + dir * 8 + h], lf = G[(size_t)row * NGATE + dir * 8 + 4 + h];
            const float f = expf(lf), ei = expf(ig); mrun = fmaxf(mrun + lf, ig);
            const bf16_t* q = QK + (size_t)row * 4 * MW + h * MDK; const bf16_t* k = q + MW; float den = 0.f;
#pragma unroll
            for (int d = 0; d < MDK; ++d) { n[d] = f * n[d] + ei * bf2f(k[d]); den += bf2f(q[d]) * n[d]; }
            DEN[((size_t)dir * MTOK + row) * MH + h] = den;
        }
        if (isctx) { const float em = expf(-mrun); p.out[O_M + (size_t)(sid * 2 + dir) * MH + h] = mrun;
#pragma unroll
            for (int d = 0; d < MDK; ++d) p.out[O_N + ((size_t)(sid * 2 + dir) * MH + h) * MDK + d] = n[d] * em; }
    }
};
struct NMlstmNum {
    Params p; int dir; int pad_ = 0; static HD_FN long count() { return (long)NSEQ * MH * MDK; }
    HD_FN void operator()(long idx) const {
        const int v = (int)(idx % MDK), h = (int)((idx / MDK) % MH), sid = (int)(idx / (MDK * MH)); const bool isctx = sid < NCB;
        const int base = seq_base(sid), len = isctx ? CSEQ : LSEQ;
        float C[MDK];
        if (isctx) {
#pragma unroll
            for (int d = 0; d < MDK; ++d) C[d] = 0.f;
        } else { const int b = sid - NCB; const float em = expf(p.stm[(size_t)(b * 2 + dir) * MH + h]);
#pragma unroll
            for (int d = 0; d < MDK; ++d) C[d] = p.stC[(((size_t)(b * 2 + dir) * MH + h) * MDK + d) * MDK + v] * em; }
        const bf16_t* QK = (const bf16_t*)(p.ws + WS_QKVO); const float* G = (const float*)(p.ws + WS_GATES); const float* DEN = (const float*)(p.ws + WS_DEN);
        float* HS = (float*)(p.ws + WS_HS);
        for (int t = 0; t < len; ++t) {
            const int row = base + (dir == 0 ? t : len - 1 - t);
            const float ig = G[(size_t)row * NGATE + dir * 8 + h], lf = G[(size_t)row * NGATE + dir * 8 + 4 + h];
            const float f = expf(lf), ei = expf(ig);
            const bf16_t* q = QK + (size_t)row * 4 * MW + h * MDK; const bf16_t* k = q + MW; const float vv = bf2f(q[2 * MW + v]) * ei; float num = 0.f;
#pragma unroll
            for (int d = 0; d < MDK; ++d) { C[d] = f * C[d] + bf2f(k[d]) * vv; num += bf2f(q[d]) * C[d]; }
            const float den = DEN[((size_t)dir * MTOK + row) * MH + h]; const float hv = num / fmaxf(fabsf(den), 1.0f);
            float* o = HS + (size_t)row * MW + h * MDK + v; if (dir == 0) *o = hv; else *o += hv;
        }
        if (isctx) { const float em = expf(-p.out[O_M + (size_t)(sid * 2 + dir) * MH + h]);
#pragma unroll
            for (int d = 0; d < MDK; ++d) p.out[O_C + (((size_t)(sid * 2 + dir) * MH + h) * MDK + d) * MDK + v] = C[d] * em; }
    }
};
struct NHm {
    Params p; static HD_FN long count() { return (long)MTOK * MH; }
    HD_FN void operator()(long idx) const {
        const int row = (int)(idx / MH), h = (int)(idx % MH); const float* x = (const float*)(p.ws + WS_HS) + (size_t)row * MW + h * MDK; float s = 0.f;
        for (int v = 0; v < MDK; ++v) s += x[v] * x[v];
        const float rs = 1.0f / sqrtf(s / MDK + EPSF); const bf16_t* og = (const bf16_t*)(p.ws + WS_QKVO) + (size_t)row * 4 * MW + 3 * MW + h * MDK;
        bf16_t* UH = (bf16_t*)(p.ws + WS_UH) + (size_t)row * DM + CCH + h * MDK;
        for (int v = 0; v < MDK; ++v) UH[v] = f2bf(bf2f(og[v]) * x[v] * rs * p.mng[h * MDK + v]);
    }
};
struct NCacheCvt {
    Params p; static HD_FN long count() { return (long)NLB * PAST * NKV * HDIM; }
    HD_FN void operator()(long idx) const { const int e = (int)(idx % (NKV * HDIM)), pp = (int)((idx / (NKV * HDIM)) % PAST), b = (int)(idx / ((long)NKV * HDIM * PAST));
        const size_t dst = ((size_t)b * SKVL + LSEQ + pp) * NKV * HDIM + e;
        ((bf16_t*)(p.ws + WS_LATK))[dst] = f2bf(p.ck[idx]); ((bf16_t*)(p.ws + WS_LATV))[dst] = f2bf(p.cv[idx]); }
};
struct NQkPost {
    Params p; static HD_FN long count() { return (long)MTOK * (NQ + NKV); }
    HD_FN void operator()(long idx) const {
        const int row = (int)(idx / (NQ + NKV)), j = (int)(idx % (NQ + NKV)); const bool isq = j < NQ; const bool lat = row >= MC;
        bf16_t* src = isq ? (bf16_t*)(p.ws + WS_QRAW) + (size_t)row * NQ * HDIM + j * HDIM : (bf16_t*)(p.ws + WS_KRAW) + (size_t)row * NKV * HDIM + (j - NQ) * HDIM;
        const float* g = isq ? p.qng : p.kng; float s = 0.f;
        for (int d = 0; d < HDIM; ++d) { const float x = bf2f(src[d]); s += x * x; }
        const float rs = 1.0f / sqrtf(s / HDIM + EPSF);
        bf16_t* dst; float* fo = nullptr;
        if (isq) dst = src;
        else if (!lat) { dst = (bf16_t*)(p.ws + WS_CTXK) + (size_t)row * NKV * HDIM + (j - NQ) * HDIM; fo = p.out + O_K + (size_t)row * NKV * HDIM + (j - NQ) * HDIM; }
        else { const int b = (row - MC) / LSEQ, sp = (row - MC) % LSEQ; dst = (bf16_t*)(p.ws + WS_LATK) + ((size_t)b * SKVL + sp) * NKV * HDIM + (j - NQ) * HDIM; }
        const int sp = pos_of(row); const float prow = (float)(sp / GRIDW), pcol = (float)(sp % GRIDW);
        for (int half = 0; half < 2; ++half)
            for (int d = 0; d < HDIM / 4; ++d) {
                const int i1 = half * (HDIM / 2) + d, i2 = i1 + HDIM / 4;
                const float x1 = bf2f(src[i1]) * rs * g[i1], x2 = bf2f(src[i2]) * rs * g[i2]; float y1 = x1, y2 = x2;
                if (lat) { const float inv = powf(10000.0f, -(float)d / (float)(HDIM / 4)); const float ang = (half == 0 ? prow : pcol) * inv; const float cs = cosf(ang), sn = sinf(ang);
                    y1 = x1 * cs - x2 * sn; y2 = x1 * sn + x2 * cs; }
                dst[i1] = f2bf(y1); dst[i2] = f2bf(y2); if (fo) { fo[i1] = y1; fo[i2] = y2; }
            }
    }
};
struct NAttn {
    Params p; static HD_FN long count() { return (long)MTOK * NQ * 4; }
    HD_FN void operator()(long idx) const {
        const int sl = (int)(idx % 4), hq = (int)((idx / 4) % NQ), row = (int)(idx / (4 * NQ)); const int kv = hq / GRP;
        const bf16_t *Kb, *Vb; int nk;
        if (row < MC) { const int b = row / CSEQ; Kb = (const bf16_t*)(p.ws + WS_CTXK) + (size_t)b * CSEQ * NKV * HDIM; Vb = (const bf16_t*)(p.ws + WS_CTXV) + (size_t)b * CSEQ * NKV * HDIM; nk = CSEQ; }
        else { const int b = (row - MC) / LSEQ; Kb = (const bf16_t*)(p.ws + WS_LATK) + (size_t)b * SKVL * NKV * HDIM; Vb = (const bf16_t*)(p.ws + WS_LATV) + (size_t)b * SKVL * NKV * HDIM; nk = SKVL; }
        const bf16_t* qp = (const bf16_t*)(p.ws + WS_QRAW) + (size_t)row * NQ * HDIM + hq * HDIM;
        float q[HDIM];
#pragma unroll
        for (int d = 0; d < HDIM; ++d) q[d] = bf2f(qp[d]);
        float o[32];
#pragma unroll
        for (int e = 0; e < 32; ++e) o[e] = 0.f;
        float m = -1e30f, l = 0.f; const float scale = 1.0f / sqrtf((float)HDIM);
        for (int s = 0; s < nk; ++s) {
            const bf16_t* kp = Kb + (size_t)s * NKV * HDIM + kv * HDIM; float dot = 0.f;
#pragma unroll
            for (int d = 0; d < HDIM; ++d) dot += q[d] * bf2f(kp[d]);
            dot *= scale; const float mn = fmaxf(m, dot); const float al = expf(m - mn), pe = expf(dot - mn); m = mn; l = l * al + pe;
            const bf16_t* vp = Vb + (size_t)s * NKV * HDIM + kv * HDIM + sl * 32;
#pragma unroll
            for (int e = 0; e < 32; ++e) o[e] = o[e] * al + pe * bf2f(vp[e]);
        }
        bf16_t* op = (bf16_t*)(p.ws + WS_O) + (size_t)row * DM + hq * HDIM + sl * 32;
#pragma unroll
        for (int e = 0; e < 32; ++e) op[e] = f2bf(o[e] / l);
    }
};
struct NFinal {
    Params p; static HD_FN long count() { return (long)MTOK * DM; }
    HD_FN void operator()(long idx) const { const int row = (int)(idx / DM), col = (int)(idx % DM);
        const float rs = 1.0f / sqrtf(((const float*)(p.ws + WS_SSQ))[(size_t)3 * SSQ_STRIDE + row] / DM + EPSF); p.out[O_Y + idx] *= rs * p.fng[col]; }
};
constexpr int NWAVES = 8, NTHREADS = NWAVES * 64;
constexpr int RING_OFF = 0, RING_BYTES = 131072;
constexpr int LDSCTL_OFF = RING_BYTES, MISC_OFF = LDSCTL_OFF + 320;
constexpr int LDS_BYTES = 147456;
constexpr int CW_TMO = 0, CW_CODE = 1, CW_BAR = 4096;
#define GAS __attribute__((address_space(1)))
#define LAS __attribute__((address_space(3)))
typedef GAS unsigned gu32;
#define RLX_AGENT __ATOMIC_RELAXED, __HIP_MEMORY_SCOPE_AGENT
#define XB_TMO      128
#define XB_XCNT(j)  (256  + 64 * (j))
#define XB_XSUB(j)  (1280 + 64 * (j))
#define XB_XGEN(j)  (2304 + 64 * (j))
#define XB_TOP      3328
#define XB_TOPGEN   3392
#define XCD_BAR_WORDS 3456
#define XB_SPIN_CAP (1u << 22)
__device__ __forceinline__ unsigned xb_ld(unsigned* p)              { return __hip_atomic_load(p, __ATOMIC_RELAXED, __HIP_MEMORY_SCOPE_AGENT); }
__device__ __forceinline__ unsigned xb_add(unsigned* p, unsigned v) { return __hip_atomic_fetch_add(p, v, __ATOMIC_RELAXED, __HIP_MEMORY_SCOPE_AGENT); }
__device__ __forceinline__ unsigned xb_xcc_id() { return (unsigned)__builtin_amdgcn_s_getreg((3 << 11) | 20) & 0xFu; }
#define XB_SPIN(cond, bar) do { unsigned _sp = 0; while (cond) { __builtin_amdgcn_s_sleep(1); \
    if ((++_sp & 255u) == 0u) { if (xb_ld(&(bar)[XB_TMO])) break; if (_sp > XB_SPIN_CAP) { atomicAdd(&(bar)[XB_TMO], 1u); break; } } } } while (0)
struct XcdBarrier { unsigned* bar; unsigned x; volatile LAS unsigned* st; };
__device__ __forceinline__ XcdBarrier xcd_barrier_post(unsigned* bar, volatile LAS unsigned* st) {
    XcdBarrier b; b.bar = bar; b.x = xb_xcc_id(); b.st = st;
    if (threadIdx.x == 0) (void)xb_add(&bar[XB_XCNT(b.x)], 1u);
    return b;
}
__device__ __forceinline__ void xcd_barrier_complete(unsigned* bar, unsigned x, unsigned& nloc, unsigned& nx) {
    const unsigned G = gridDim.x * gridDim.y * gridDim.z;
    unsigned sum, cnt, mine, sp = 0u;
    for (;;) {
        sum = 0u; cnt = 0u; mine = 0u;
#pragma unroll
        for (unsigned j = 0; j < 16; ++j) { const unsigned c = xb_ld(&bar[XB_XCNT(j)]); sum += c; cnt += (c > 0u) ? 1u : 0u; mine = (j == x) ? c : mine; }
        if (sum == G) break;
        __builtin_amdgcn_s_sleep(1);
        if ((++sp & 255u) == 0u) { if (xb_ld(&bar[XB_TMO])) break; if (sp > XB_SPIN_CAP) { atomicAdd(&bar[XB_TMO], 1u); break; } }
    }
    nloc = mine > 0u ? mine : 1u; nx = cnt > 0u ? cnt : 1u;
}
__device__ __forceinline__ void xcd_barrier(const XcdBarrier& b) {
    asm volatile("s_waitcnt vmcnt(0)" ::: "memory");
    __syncthreads();
    if (threadIdx.x == 0) {
        unsigned* bar = b.bar;
        __builtin_amdgcn_s_waitcnt(0);
        unsigned nloc = b.st[0], nx = b.st[1];
        if (nloc == 0u) { xcd_barrier_complete(bar, b.x, nloc, nx); b.st[0] = nloc; b.st[1] = nx; }
        const unsigned old = xb_add(&bar[XB_XSUB(b.x)], 1u);
        const unsigned gen = old / nloc;
        if (old + 1u == (gen + 1u) * nloc) {
            __builtin_amdgcn_fence(__ATOMIC_RELEASE, "agent");
            asm volatile("s_waitcnt vmcnt(0)" ::: "memory");
            const unsigned og = xb_add(&bar[XB_TOP], 1u);
            const unsigned tg = og / nx;
            if (og + 1u == (tg + 1u) * nx) xb_add(&bar[XB_TOPGEN], 1u);
            else XB_SPIN(xb_ld(&bar[XB_TOPGEN]) == tg, bar);
            __builtin_amdgcn_fence(__ATOMIC_ACQUIRE, "agent");
            xb_add(&bar[XB_XGEN(b.x)], 1u);
            asm volatile("s_waitcnt vmcnt(0)" ::: "memory");
        } else {
            XB_SPIN(xb_ld(&bar[XB_XGEN(b.x)]) == gen, bar);
            __builtin_amdgcn_fence(__ATOMIC_ACQUIRE, "agent");
            asm volatile("s_waitcnt vmcnt(0)" ::: "memory");
        }
    }
    __syncthreads();
}
namespace pg8 {
#define PG8_LAS __attribute__((address_space(3)))
typedef unsigned short bf16_t;
typedef short bf16x8 __attribute__((ext_vector_type(8)));
typedef float f32x4 __attribute__((ext_vector_type(4)));
typedef unsigned u32x4 __attribute__((ext_vector_type(4)));
constexpr int BM = 256, BK = 64, HALF = 128, HTB = HALF * BK * 2  , STAGE_BYTES = 8 * HTB, NXCD = 8, WGM = 8;

__host__ __device__ __forceinline__ int lds_byte(int r, int c) { const int st = (r >> 4) * 2 + (c >> 5), rr = r & 15, cc = c & 31, ob = rr * 64 + cc * 2; return st * 1024 + (ob ^ (((ob >> 9) & 1) << 5)); }
__host__ __device__ __forceinline__ void stage_rc(int b, int& R, int& C) { const int st = b / 1024, sb = b % 1024, swz = sb ^ (((sb >> 9) & 1) << 5); R = (st >> 1) * 16 + swz / 64; C = (st & 1) * 32 + (swz % 64) / 2; }
__host__ __device__ __forceinline__ int perm32(int rho) { const int n = rho >> 4, i = rho & 15; return 8 * (i >> 2) + 4 * n + (i & 3); }

struct Unit { int pm, pn; };
struct Gemm { const bf16_t* A; const bf16_t* Bt; int M, N, K; };

struct StaticOrder {
    int nM, nN, nwg, G, c;
    __host__ __device__ void init(int M, int N, int G_, int c_) { nM = M / BM; nN = N / BM; nwg = nM * nN; G = G_; c = c_; }
    __host__ __device__ bool next(int i, Unit& u) const {
        const long L = (long)i * G + c; if (L >= nwg) return false;
        int wgid = (int)L; { const int q = nwg / NXCD, r = nwg % NXCD, xcd = wgid % NXCD, off = wgid / NXCD; wgid = (xcd < r ? xcd * (q + 1) : r * (q + 1) + (xcd - r) * q) + off; }
        const int nig = WGM * nN, gid = wgid / nig, fm = gid * WGM, gsz = (nM - fm) < WGM ? (nM - fm) : WGM;
        u.pm = fm + ((wgid % nig) % gsz); u.pn = (wgid % nig) / gsz; return true;
    }
    __device__ __forceinline__ void a_ready(const Unit&) const {}
    __device__ __forceinline__ void done(const Unit&) const {}
};

__device__ __forceinline__ unsigned cvt_pk_bf16(float lo, float hi) { unsigned r; asm volatile("v_cvt_pk_bf16_f32 %0, %1, %2" : "=v"(r) : "v"(lo), "v"(hi)); return r; }
typedef float f32x2 __attribute__((ext_vector_type(2)));
template <class Epi, class Sched, bool ALIGN_EPI = false, bool SP2 = false>
__device__ __forceinline__ void gemm_phase(PG8_LAS unsigned char* lds, const Gemm g, const Sched& S, const Epi& E) {
    const int tid = threadIdx.x, wid = __builtin_amdgcn_readfirstlane(tid >> 6), lane = tid & 63, wr = wid >> 2, wc = wid & 3, fr = lane & 15, fq = lane >> 4;
    const int K = g.K, nt = K / BK;
    unsigned voffA[2], voffB[2];
#pragma unroll
    for (int i = 0; i < 2; ++i) { int R, C; stage_rc(tid * 16 + i * 8192, R, C); const int Rb = Epi::PERM ? ((R & ~31) + perm32(R & 31)) : R;
        voffA[i] = (unsigned)(R * K + C) * 2u; voffB[i] = (unsigned)(Rb * K + C) * 2u; }
    const size_t kstep = (size_t)(BK * 2);
    const size_t hstep = (size_t)HALF * K * 2;
    const size_t tstep = 2 * hstep;
    const unsigned ldsw = (unsigned)wid * 1024u;
    const int aoff = lds_byte(wr * 64 + fr, fq * 8), boff = lds_byte(wc * 32 + fr, fq * 8);
#define PG8_SA(b, h) (((b) * 2 + (h)) * HTB)
#define PG8_SB(b, h) ((4 + (b) * 2 + (h)) * HTB)
#define PG8_STAGE(bufoff, gbase, voff) do { _Pragma("unroll") for (int _i = 0; _i < 2; ++_i) \
        __builtin_amdgcn_global_load_lds((const unsigned*)((const char*)(gbase) + (voff)[_i]), (PG8_LAS unsigned*)(lds + (bufoff) + ldsw + _i * 8192), 16, 0, 0); } while (0)
#define PG8_LDA(dst, b, h) do { _Pragma("unroll") for (int m = 0; m < 4; ++m) _Pragma("unroll") for (int k = 0; k < 2; ++k) dst[m][k] = *(const PG8_LAS bf16x8*)(lds + PG8_SA(b, h) + aoff + m * 2048 + k * 1024); } while (0)
#define PG8_LDB(dst, b, h) do { _Pragma("unroll") for (int n = 0; n < 2; ++n) _Pragma("unroll") for (int k = 0; k < 2; ++k) dst[n][k] = *(const PG8_LAS bf16x8*)(lds + PG8_SB(b, h) + boff + n * 2048 + k * 1024); } while (0)
#define PG8_MMA(ai, bj, At, Bt) do { __builtin_amdgcn_s_setprio(1); _Pragma("unroll") for (int m = 0; m < 4; ++m) _Pragma("unroll") for (int n = 0; n < 2; ++n) _Pragma("unroll") for (int k = 0; k < 2; ++k) \
        acc[ai][bj][m][n] = __builtin_amdgcn_mfma_f32_16x16x32_bf16(Bt[n][k], At[m][k], acc[ai][bj][m][n], 0, 0, 0); __builtin_amdgcn_s_setprio(0); } while (0)
#define PG8_WAIT_V(n) asm volatile("s_waitcnt vmcnt(" #n ")" ::: "memory")
#define PG8_WAIT_L(n) asm volatile("s_waitcnt lgkmcnt(" #n ")" ::: "memory")
#define PG8_BAR __builtin_amdgcn_s_barrier()
#define PG8_SCHED __builtin_amdgcn_sched_barrier(0)
    Unit cur, nxt; int ui = 0;
    if (!S.next(0, cur)) return;
    f32x4 acc[2][2][4][2];
#pragma unroll
    for (int a = 0; a < 2; ++a)
#pragma unroll
        for (int b = 0; b < 2; ++b)
#pragma unroll
            for (int m = 0; m < 4; ++m)
#pragma unroll
                for (int n = 0; n < 2; ++n) acc[a][b][m][n] = (f32x4){0.f, 0.f, 0.f, 0.f};
    bf16x8 At[4][2], B0[2][2], B1[2][2];
    const char* cA = (const char*)g.A + (size_t)cur.pm * tstep; const char* cB = (const char*)g.Bt + (size_t)cur.pn * tstep;
    S.a_ready(cur);
    if constexpr (SP2) {
        PG8_STAGE(PG8_SB(0, 0), cB, voffB); PG8_STAGE(PG8_SB(0, 1), cB + hstep, voffB); PG8_STAGE(PG8_SA(0, 0), cA, voffA); PG8_STAGE(PG8_SA(0, 1), cA + hstep, voffA);
        if (wr == 1) PG8_BAR;
        PG8_WAIT_V(2); PG8_BAR;
        PG8_STAGE(PG8_SB(1, 0), cB + kstep, voffB); PG8_STAGE(PG8_SA(1, 0), cA + kstep, voffA); PG8_STAGE(PG8_SB(1, 1), cB + hstep + kstep, voffB);
        PG8_WAIT_V(6); PG8_BAR;
    } else {
        PG8_STAGE(PG8_SB(0, 0), cB, voffB); PG8_STAGE(PG8_SA(0, 0), cA, voffA); PG8_STAGE(PG8_SB(0, 1), cB + hstep, voffB); PG8_STAGE(PG8_SA(0, 1), cA + hstep, voffA);
        if (wr == 1) PG8_BAR;
        PG8_WAIT_V(4); PG8_BAR;
        PG8_STAGE(PG8_SB(1, 0), cB + kstep, voffB); PG8_STAGE(PG8_SA(1, 0), cA + kstep, voffA); PG8_STAGE(PG8_SB(1, 1), cB + hstep + kstep, voffB);
        PG8_WAIT_V(6); PG8_BAR;
    }
    for (;;) {
        const bool has_next = S.next(ui + 1, nxt);
        const char* nA = has_next ? (const char*)g.A + (size_t)nxt.pm * tstep : cA; const char* nB = has_next ? (const char*)g.Bt + (size_t)nxt.pn * tstep : cB;
        for (int t = 0; t < nt; t += 2) {
            const bool last = (t == nt - 2);
            const char* a1 = cA + (size_t)(t + 1) * kstep;
            const char* a2 = last ? nA : cA + (size_t)(t + 2) * kstep; const char* b2 = last ? nB : cB + (size_t)(t + 2) * kstep;
            const char* a3 = a2 + kstep; const char* b3 = b2 + kstep;
            if (last && has_next) S.a_ready(nxt);
            if constexpr (SP2) {
            PG8_LDB(B0, 0, 0); PG8_LDB(B1, 0, 1); PG8_SCHED; PG8_LDA(At, 0, 0); PG8_STAGE(PG8_SA(1, 1), a1 + hstep, voffA);
            PG8_WAIT_V(8); PG8_WAIT_L(0); PG8_BAR; PG8_MMA(0, 0, At, B0); PG8_MMA(0, 1, At, B1); PG8_BAR; PG8_SCHED;
            PG8_LDA(At, 0, 1); PG8_STAGE(PG8_SB(0, 0), b2, voffB); PG8_STAGE(PG8_SB(0, 1), b2 + hstep, voffB); PG8_STAGE(PG8_SA(0, 0), a2, voffA);
            PG8_WAIT_V(8); PG8_WAIT_L(0); PG8_BAR; PG8_MMA(1, 0, At, B0); PG8_MMA(1, 1, At, B1); PG8_BAR; PG8_SCHED;
            PG8_LDB(B0, 1, 0); PG8_LDB(B1, 1, 1); PG8_SCHED; PG8_LDA(At, 1, 0); PG8_STAGE(PG8_SA(0, 1), a2 + hstep, voffA);
            PG8_WAIT_V(8); PG8_WAIT_L(0); PG8_BAR; PG8_MMA(0, 0, At, B0); PG8_MMA(0, 1, At, B1); PG8_BAR; PG8_SCHED;
            PG8_LDA(At, 1, 1); PG8_STAGE(PG8_SB(1, 0), b3, voffB); PG8_STAGE(PG8_SB(1, 1), b3 + hstep, voffB); PG8_STAGE(PG8_SA(1, 0), a3, voffA);
            PG8_WAIT_V(8); PG8_WAIT_L(0); PG8_BAR; PG8_MMA(1, 0, At, B0); PG8_MMA(1, 1, At, B1); PG8_BAR; PG8_SCHED;
            } else {
            PG8_LDB(B0, 0, 0); PG8_SCHED; PG8_LDA(At, 0, 0); PG8_STAGE(PG8_SA(1, 1), a1 + hstep, voffA);
            PG8_WAIT_L(8); PG8_BAR; PG8_WAIT_L(0); PG8_MMA(0, 0, At, B0); PG8_BAR; PG8_SCHED;
            PG8_LDB(B1, 0, 1); PG8_STAGE(PG8_SB(0, 0), b2, voffB);
            PG8_BAR; PG8_WAIT_L(0); PG8_MMA(0, 1, At, B1); PG8_BAR;
            PG8_LDA(At, 0, 1); PG8_STAGE(PG8_SA(0, 0), a2, voffA);
            PG8_BAR; PG8_WAIT_L(0); PG8_MMA(1, 0, At, B0); PG8_BAR; PG8_SCHED;
            PG8_STAGE(PG8_SB(0, 1), b2 + hstep, voffB);
            PG8_WAIT_V(6); PG8_BAR; PG8_MMA(1, 1, At, B1); PG8_BAR;
            PG8_LDB(B0, 1, 0); PG8_SCHED; PG8_LDA(At, 1, 0); PG8_STAGE(PG8_SA(0, 1), a2 + hstep, voffA);
            PG8_WAIT_L(8); PG8_BAR; PG8_WAIT_L(0); PG8_MMA(0, 0, At, B0); PG8_BAR; PG8_SCHED;
            PG8_LDB(B1, 1, 1); PG8_STAGE(PG8_SB(1, 0), b3, voffB);
            PG8_BAR; PG8_WAIT_L(0); PG8_MMA(0, 1, At, B1); PG8_BAR;
            PG8_LDA(At, 1, 1); PG8_STAGE(PG8_SA(1, 0), a3, voffA);
            PG8_BAR; PG8_WAIT_L(0); PG8_MMA(1, 0, At, B0); PG8_BAR; PG8_SCHED;
            PG8_STAGE(PG8_SB(1, 1), b3 + hstep, voffB);
            PG8_WAIT_V(6); PG8_BAR; PG8_MMA(1, 1, At, B1); PG8_BAR;
            }
        }
        if constexpr (ALIGN_EPI) { if (wr == 0) PG8_BAR; }
        if constexpr (!Epi::AFTER_DRAIN) { E(acc, cur, wr, wc, fr, fq); S.done(cur); }
        if (!has_next) break;
#pragma unroll
        for (int a = 0; a < 2; ++a)
#pragma unroll
            for (int b = 0; b < 2; ++b)
#pragma unroll
                for (int m = 0; m < 4; ++m)
#pragma unroll
                    for (int n = 0; n < 2; ++n) acc[a][b][m][n] = (f32x4){0.f, 0.f, 0.f, 0.f};
        cur = nxt; cA = nA; cB = nB; ++ui;
        if constexpr (ALIGN_EPI) { if (wr == 1) PG8_BAR; }
    }
    PG8_WAIT_V(0);
    if constexpr (!ALIGN_EPI) { if (wr == 0) PG8_BAR; }
    PG8_BAR;
    if constexpr (Epi::AFTER_DRAIN) { E.fused(acc, cur, wr, wc, fr, fq, lds, wid, lane); S.done(cur); }
#undef PG8_SA
#undef PG8_SB
#undef PG8_STAGE
#undef PG8_LDA
#undef PG8_LDB
#undef PG8_MMA
#undef PG8_WAIT_V
#undef PG8_WAIT_L
#undef PG8_BAR
#undef PG8_SCHED
}
}
constexpr size_t WB_AB = 2 * MiB, WB_OUTAB = 8 * MiB, WB_FFI0 = 10 * MiB, WB_FFO0 = 21 * MiB, WB_INC = 27 * MiB, WB_OUTC = 30 * MiB, WB_FFI1 = 32 * MiB, WB_FFO1 = 43 * MiB;
static_assert(WB_FFO1 + (size_t)DM * DFF * 2 <= WS_XN && WB_AB + (size_t)ABMAIN * DM * 2 <= WB_OUTAB && WB_FFI0 + (size_t)2 * DFF * DM * 2 <= WB_FFO0 && WB_FFO0 + (size_t)DM * DFF * 2 <= WB_INC &&
              WB_INC + (size_t)CIN * DM * 2 <= WB_OUTC && WB_FFI1 + (size_t)2 * DFF * DM * 2 <= WB_FFO1, "weight copy map");

typedef unsigned v4u __attribute__((ext_vector_type(4)));
typedef unsigned v2u __attribute__((ext_vector_type(2)));
typedef float f32x4 __attribute__((ext_vector_type(4)));
__device__ __forceinline__ unsigned pk2(float lo, float hi) { return (unsigned)f2bf(lo) | ((unsigned)f2bf(hi) << 16); }
__device__ __forceinline__ float fsigmoid(float x) { return __builtin_amdgcn_rcpf(1.0f + __builtin_amdgcn_exp2f(-1.4426950408889634f * x)); }

__device__ __forceinline__ void p0_transpose_item(const float* W, int K, int ldw, int c0, int k0, bf16_t* WT, int drow, LAS float* scr, int lane) {
#pragma unroll 8
    for (int i = 0; i < 32; ++i) { const int kk = 2 * i + (lane >> 5); scr[kk * 33 + (lane & 31)] = W[(size_t)(k0 + kk) * ldw + c0 + (lane & 31)]; }
    asm volatile("s_waitcnt lgkmcnt(0)" ::: "memory");
    const int c = lane & 7;
#pragma unroll
    for (int j = 0; j < 4; ++j) { const int n = (lane >> 3) + 8 * j; const LAS float* s = scr + (8 * c) * 33 + n;
        v4u o; o.x = pk2(s[0 * 33], s[1 * 33]); o.y = pk2(s[2 * 33], s[3 * 33]); o.z = pk2(s[4 * 33], s[5 * 33]); o.w = pk2(s[6 * 33], s[7 * 33]);
        *(GAS v4u*)(WT + (size_t)(drow + n) * K + k0 + 8 * c) = o; }
    asm volatile("s_waitcnt lgkmcnt(0)" ::: "memory");
}
struct CvtJob { const float* W; bf16_t* WT; int K, ldw, c0, ncols, mode, Hn, dbase; };
__device__ __forceinline__ int cvt_items(const CvtJob& j) { return (j.K / 64) * (j.ncols / 32); }
__device__ __forceinline__ void cvt_run(const CvtJob& j, int item, LAS float* scr, int lane) {
    const int nblk = j.ncols / 32, kb = item / nblk, nb = item % nblk; const int c = j.c0 + 32 * nb;
    int drow; if (j.mode == 0) drow = j.dbase + 32 * nb; else { const int cc = c < j.Hn ? c : c - j.Hn; drow = 256 * (cc / 128) + (cc % 128) + (c < j.Hn ? 0 : 128); }
    p0_transpose_item(j.W, j.K, j.ldw, c, 64 * kb, j.WT, drow, scr, lane);
}
__device__ __forceinline__ void p0_weights(const Params& p, LAS unsigned char* lds, int vcu, int G) {
    const int lane = threadIdx.x & 63, wave = __builtin_amdgcn_readfirstlane(threadIdx.x >> 6);
    LAS float* scr = (LAS float*)(lds + wave * 16384);
    const int gw = vcu * NWAVES + wave, NGW = G * NWAVES;
    CvtJob jobs[9] = {
        {p.winab, (bf16_t*)(p.ws + WB_AB), DM, ABIN, 0, 2 * CCH, 1, CCH, 0},
        {p.winab, (bf16_t*)(p.ws + WB_AB), DM, ABIN, 2 * CCH, 4 * MW, 0, 0, 2 * CCH},
        {p.woutab, (bf16_t*)(p.ws + WB_OUTAB), DM, DM, 0, DM, 0, 0, 0},
        {p.wffi, (bf16_t*)(p.ws + WB_FFI0), DM, 2 * DFF, 0, 2 * DFF, 1, DFF, 0},
        {p.wffo, (bf16_t*)(p.ws + WB_FFO0), DFF, DM, 0, DM, 0, 0, 0},
        {p.winc, (bf16_t*)(p.ws + WB_INC), DM, CIN, 0, CIN, 0, 0, 0},
        {p.woutc, (bf16_t*)(p.ws + WB_OUTC), DM, DM, 0, DM, 0, 0, 0},
        {p.wffi + (size_t)DM * 2 * DFF, (bf16_t*)(p.ws + WB_FFI1), DM, 2 * DFF, 0, 2 * DFF, 1, DFF, 0},
        {p.wffo + (size_t)DFF * DM, (bf16_t*)(p.ws + WB_FFO1), DFF, DM, 0, DM, 0, 0, 0}};
    int base = 0;
#pragma unroll
    for (int jj = 0; jj < 9; ++jj) {
        const int n = cvt_items(jobs[jj]);
        int first = ((gw - base) % NGW + NGW) % NGW;
        for (int it = first; it < n; it += NGW) cvt_run(jobs[jj], it, scr, lane);
        base += n;
    }
}

struct EpiAB {
    static constexpr bool PERM = true, AFTER_DRAIN = false;
    bf16_t* upre; bf16_t* qkvo;
    __device__ __forceinline__ void operator()(const f32x4 (&acc)[2][2][4][2], const pg8::Unit& u, int wr, int wc, int fr, int fq) const {
        const int row0 = u.pm * 256 + wr * 64 + fr, lc = wc * 32 + 8 * fq;
        if (u.pn < 4) {
#pragma unroll
            for (int ai = 0; ai < 2; ++ai)
#pragma unroll
                for (int m = 0; m < 4; ++m) { const f32x4 a0 = acc[ai][0][m][0], a1 = acc[ai][0][m][1], g0 = acc[ai][1][m][0], g1 = acc[ai][1][m][1]; v4u w;
                    w.x = pg8::cvt_pk_bf16(a0[0] * fsigmoid(g0[0]), a0[1] * fsigmoid(g0[1])); w.y = pg8::cvt_pk_bf16(a0[2] * fsigmoid(g0[2]), a0[3] * fsigmoid(g0[3]));
                    w.z = pg8::cvt_pk_bf16(a1[0] * fsigmoid(g1[0]), a1[1] * fsigmoid(g1[1])); w.w = pg8::cvt_pk_bf16(a1[2] * fsigmoid(g1[2]), a1[3] * fsigmoid(g1[3]));
                    *(v4u*)(upre + (size_t)(row0 + ai * 128 + m * 16) * CCH + 128 * u.pn + lc) = w; }
        } else {
#pragma unroll
            for (int bj = 0; bj < 2; ++bj) { const int col = 256 * (u.pn - 4) + 128 * bj + lc; const int part = col / MW; const float sc = part == 1 ? 0.08838834764831845f : 1.0f;
#pragma unroll
                for (int ai = 0; ai < 2; ++ai)
#pragma unroll
                    for (int m = 0; m < 4; ++m) { f32x4 v0 = acc[ai][bj][m][0] * sc, v1 = acc[ai][bj][m][1] * sc;
                        if (part == 3) { v0 = (f32x4){fsigmoid(v0[0]), fsigmoid(v0[1]), fsigmoid(v0[2]), fsigmoid(v0[3])}; v1 = (f32x4){fsigmoid(v1[0]), fsigmoid(v1[1]), fsigmoid(v1[2]), fsigmoid(v1[3])}; }
                        v4u w; w.x = pg8::cvt_pk_bf16(v0[0], v0[1]); w.y = pg8::cvt_pk_bf16(v0[2], v0[3]); w.z = pg8::cvt_pk_bf16(v1[0], v1[1]); w.w = pg8::cvt_pk_bf16(v1[2], v1[3]);
                        *(v4u*)(qkvo + (size_t)(row0 + ai * 128 + m * 16) * (4 * MW) + col) = w; } }
        }
    }
};
static_assert(MDK == 128, "EpiAB hard-codes MDK^-0.5");
struct EpiRes {
    static constexpr bool PERM = false, AFTER_DRAIN = false;
    const float* xp; const float* xs;
    float* Y; bf16_t* XN; float* ssq; const float* mod_g; const float* mod_sc; const float* ng;
    int from_input; int pad_;
    __device__ __forceinline__ void operator()(const f32x4 (&acc)[2][2][4][2], const pg8::Unit& u, int wr, int wc, int fr, int fq) const {
        const int row0 = u.pm * 256 + wr * 64 + fr; const int cls = cls_of(u.pm * 256);
        const float* xin = from_input ? (u.pm * 256 < MC ? xp : xs - (size_t)MC * DM) : Y;
        const float* gv = mod_g + (size_t)cls * 6 * DM; const float* scv = mod_sc + (size_t)cls * 6 * DM;
        float sq[2][4];
#pragma unroll
        for (int ai = 0; ai < 2; ++ai)
#pragma unroll
            for (int m = 0; m < 4; ++m) sq[ai][m] = 0.f;
#pragma unroll
        for (int bj = 0; bj < 2; ++bj)
#pragma unroll
            for (int n = 0; n < 2; ++n) { const int col = u.pn * 256 + bj * 128 + wc * 32 + n * 16 + 4 * fq;
                const f32x4 g4 = *(const f32x4*)(gv + col); f32x4 gs4 = (f32x4){0.f, 0.f, 0.f, 0.f};
                if (ng) { const f32x4 n4 = *(const f32x4*)(ng + col), s4 = *(const f32x4*)(scv + col); gs4 = n4 * (s4 + 1.0f); }
#pragma unroll
                for (int ai = 0; ai < 2; ++ai)
#pragma unroll
                    for (int m = 0; m < 4; ++m) { const size_t off = (size_t)(row0 + ai * 128 + m * 16) * DM + col;
                        const f32x4 xi = *(const f32x4*)(xin + off); const f32x4 xn = xi + g4 * acc[ai][bj][m][n];
                        *(f32x4*)(Y + off) = xn; sq[ai][m] += (xn[0] * xn[0] + xn[1] * xn[1]) + (xn[2] * xn[2] + xn[3] * xn[3]);
                        if (ng) { const f32x4 t = xn * gs4; v2u w; w.x = pg8::cvt_pk_bf16(t[0], t[1]); w.y = pg8::cvt_pk_bf16(t[2], t[3]); *(v2u*)(XN + off) = w; } } }
#pragma unroll
        for (int ai = 0; ai < 2; ++ai)
#pragma unroll
            for (int m = 0; m < 4; ++m) { float s = sq[ai][m]; s += __shfl_xor(s, 16); s += __shfl_xor(s, 32);
                if (fq == 0) atomicAdd(ssq + row0 + ai * 128 + m * 16, s); }
    }
};
struct EpiFfnIn {
    static constexpr bool PERM = true, AFTER_DRAIN = false;
    bf16_t* H; const float* ssq; const float* sw;
    __device__ __forceinline__ void operator()(const f32x4 (&acc)[2][2][4][2], const pg8::Unit& u, int wr, int wc, int fr, int fq) const {
        const int row0 = u.pm * 256 + wr * 64 + fr, lc = wc * 32 + 8 * fq; const int cls = cls_of(u.pm * 256); const int col = 128 * u.pn + lc;
        const float* swr = sw + (size_t)cls * 2 * DFF;
        const f32x4 sg0 = *(const f32x4*)(swr + col), sg1 = *(const f32x4*)(swr + col + 4), su0 = *(const f32x4*)(swr + DFF + col), su1 = *(const f32x4*)(swr + DFF + col + 4);
#pragma unroll
        for (int ai = 0; ai < 2; ++ai)
#pragma unroll
            for (int m = 0; m < 4; ++m) { const int row = row0 + ai * 128 + m * 16; const float rs = 1.0f / sqrtf(ssq[row] * (1.0f / DM) + EPSF);
                const f32x4 a0 = acc[ai][0][m][0] * rs + sg0, a1 = acc[ai][0][m][1] * rs + sg1, b0 = acc[ai][1][m][0] * rs + su0, b1 = acc[ai][1][m][1] * rs + su1; v4u w;
                w.x = pg8::cvt_pk_bf16(a0[0] * fsigmoid(a0[0]) * b0[0], a0[1] * fsigmoid(a0[1]) * b0[1]); w.y = pg8::cvt_pk_bf16(a0[2] * fsigmoid(a0[2]) * b0[2], a0[3] * fsigmoid(a0[3]) * b0[3]);
                w.z = pg8::cvt_pk_bf16(a1[0] * fsigmoid(a1[0]) * b1[0], a1[1] * fsigmoid(a1[1]) * b1[1]); w.w = pg8::cvt_pk_bf16(a1[2] * fsigmoid(a1[2]) * b1[2], a1[3] * fsigmoid(a1[3]) * b1[3]);
                *(v4u*)(H + (size_t)row * DFF + col) = w; }
    }
};
struct EpiQkv {
    static constexpr bool PERM = true, AFTER_DRAIN = false;
    bf16_t* qraw; bf16_t* kraw; bf16_t* ctxv; bf16_t* latv; float* outv; const float* ssq; const float* sw;
    __device__ __forceinline__ void operator()(const f32x4 (&acc)[2][2][4][2], const pg8::Unit& u, int wr, int wc, int fr, int fq) const {
        const int row0 = u.pm * 256 + wr * 64 + fr, lc = wc * 32 + 8 * fq; const int cls = cls_of(u.pm * 256); const float* swr = sw + (size_t)cls * CIN;
        float rs[2][4];
#pragma unroll
        for (int ai = 0; ai < 2; ++ai)
#pragma unroll
            for (int m = 0; m < 4; ++m) rs[ai][m] = 1.0f / sqrtf(ssq[row0 + ai * 128 + m * 16] * (1.0f / DM) + EPSF);
#pragma unroll
        for (int bj = 0; bj < 2; ++bj) { const int col = 256 * u.pn + 128 * bj + lc; const f32x4 s0 = *(const f32x4*)(swr + col), s1 = *(const f32x4*)(swr + col + 4);
#pragma unroll
            for (int ai = 0; ai < 2; ++ai)
#pragma unroll
                for (int m = 0; m < 4; ++m) { const int row = row0 + ai * 128 + m * 16; const f32x4 v0 = acc[ai][bj][m][0] * rs[ai][m] + s0, v1 = acc[ai][bj][m][1] * rs[ai][m] + s1;
                    v4u w; w.x = pg8::cvt_pk_bf16(v0[0], v0[1]); w.y = pg8::cvt_pk_bf16(v0[2], v0[3]); w.z = pg8::cvt_pk_bf16(v1[0], v1[1]); w.w = pg8::cvt_pk_bf16(v1[2], v1[3]);
                    if (u.pn < NQ * HDIM / 256) *(v4u*)(qraw + (size_t)row * (NQ * HDIM) + col) = w;
                    else if (u.pn == NQ * HDIM / 256) *(v4u*)(kraw + (size_t)row * (NKV * HDIM) + (col - NQ * HDIM)) = w;
                    else { const int c2 = col - (NQ + NKV) * HDIM;
                        if (row < MC) { *(v4u*)(ctxv + (size_t)row * (NKV * HDIM) + c2) = w; float* o = outv + (size_t)row * (NKV * HDIM) + c2; *(f32x4*)o = v0; *(f32x4*)(o + 4) = v1; }
                        else { const int b = (row - MC) / LSEQ, s = (row - MC) % LSEQ; *(v4u*)(latv + ((size_t)b * SKVL + s) * (NKV * HDIM) + c2) = w; } } } }
    }
};
static_assert(NKV * HDIM == 256 && (NQ * HDIM) % 256 == 0, "EpiQkv tile mapping");
struct DevGo { XcdBarrier bar;
    template <class F> __device__ __forceinline__ void run(const F& f, long n) const { for (long i = blockIdx.x * (long)NTHREADS + threadIdx.x; i < n; i += (long)gridDim.x * NTHREADS) f(i); }
    template <class F> __device__ __forceinline__ void operator()(const F& f, long n) const { run(f, n); xcd_barrier(bar); } };
template <class Epi> __device__ __forceinline__ void gemm_call(LAS unsigned char* lds, const bf16_t* A, const bf16_t* Bt, int N, int K, const Epi& E) {
    pg8::Gemm g{A, Bt, MTOK, N, K}; pg8::StaticOrder S; S.init(MTOK, N, (int)gridDim.x, (int)blockIdx.x);
    pg8::gemm_phase<Epi, pg8::StaticOrder, true, true>((PG8_LAS unsigned char*)lds, g, S, E);
}
__global__ void __launch_bounds__(NTHREADS, 2) mega_fwd(Params p) {
    extern __shared__ __attribute__((aligned(16))) unsigned char lds[];
    LAS unsigned char* L = (LAS unsigned char*)lds;
    for (int u = threadIdx.x; u < (LDS_BYTES - LDSCTL_OFF) / 4; u += NTHREADS) ((LAS unsigned*)(L + LDSCTL_OFF))[u] = 0u;
    __syncthreads();
    volatile LAS unsigned* MISC = (volatile LAS unsigned*)(L + MISC_OFF);
    DevGo go; go.bar = xcd_barrier_post((unsigned*)(p.ws + WS_CTL) + CW_BAR, MISC + 8);
    const int G = gridDim.x, bx = blockIdx.x; const int vcu = (G % 8 == 0) ? (bx % 8) * (G / 8) + bx / 8 : bx;
    unsigned char* ws = p.ws;
    const bf16_t* XN = (const bf16_t*)(ws + WS_XN); const bf16_t* UH = (const bf16_t*)(ws + WS_UH); const bf16_t* Hh = (const bf16_t*)(ws + WS_H); const bf16_t* Ob = (const bf16_t*)(ws + WS_O);
    float* SW0 = (float*)(ws + WS_SW); float* SWC = SW0 + (size_t)NCLS * 2 * DFF; float* SW1 = SWC + (size_t)NCLS * CIN;
    float* SSQ = (float*)(ws + WS_SSQ); float* Y = p.out + O_Y;
    p0_weights(p, L, vcu, G); go(NMod{p}, NMod::count());
    go(NNorm0a{p}, NNorm0a::count()); go.run(NNorm0b{p}, NNorm0b::count()); go(NGates{p}, NGates::count());
    gemm_call(L, XN, (const bf16_t*)(ws + WB_AB), ABMAIN, DM, EpiAB{(bf16_t*)(ws + WS_UPRE), (bf16_t*)(ws + WS_QKVO)}); xcd_barrier(go.bar);
    go(NConv{p}, NConv::count()); go.run(NConvLN{p}, NConvLN::count());
    go(NMlstmDen{p}, NMlstmDen::count()); go(NMlstmNum{p, 0}, NMlstmNum::count()); go(NMlstmNum{p, 1}, NMlstmNum::count()); go(NHm{p}, NHm::count());
    gemm_call(L, UH, (const bf16_t*)(ws + WB_OUTAB), DM, DM, EpiRes{p.xp, p.xs, Y, (bf16_t*)(ws + WS_XN), SSQ + 0 * SSQ_STRIDE, modv(p, 0, 0, 2), modv(p, 0, 0, 4), p.n2g, 1, 0});
    { NSW s{p, p.wffi, SW0, 0, 3, 2 * DFF, 0}; go(s, s.count()); }
    gemm_call(L, XN, (const bf16_t*)(ws + WB_FFI0), 2 * DFF, DM, EpiFfnIn{(bf16_t*)(ws + WS_H), SSQ + 0 * SSQ_STRIDE, SW0}); xcd_barrier(go.bar);
    gemm_call(L, Hh, (const bf16_t*)(ws + WB_FFO0), DM, DFF, EpiRes{p.xp, p.xs, Y, (bf16_t*)(ws + WS_XN), SSQ + 1 * SSQ_STRIDE, modv(p, 0, 0, 5), modv(p, 1, 0, 1), p.n1g + DM, 0, 0});
    { NSW s{p, p.winc, SWC, 1, 0, CIN, 0}; go(s, s.count()); }
    gemm_call(L, XN, (const bf16_t*)(ws + WB_INC), CIN, DM, EpiQkv{(bf16_t*)(ws + WS_QRAW), (bf16_t*)(ws + WS_KRAW), (bf16_t*)(ws + WS_CTXV), (bf16_t*)(ws + WS_LATV), p.out + O_V, SSQ + 1 * SSQ_STRIDE, SWC});
    go(NCacheCvt{p}, NCacheCvt::count()); go(NQkPost{p}, NQkPost::count());
    go(NAttn{p}, NAttn::count());
    gemm_call(L, Ob, (const bf16_t*)(ws + WB_OUTC), DM, DM, EpiRes{p.xp, p.xs, Y, (bf16_t*)(ws + WS_XN), SSQ + 2 * SSQ_STRIDE, modv(p, 1, 0, 2), modv(p, 1, 0, 4), p.n2g + DM, 0, 0});
    { NSW s{p, p.wffi + (size_t)DM * 2 * DFF, SW1, 1, 3, 2 * DFF, 0}; go(s, s.count()); }
    gemm_call(L, XN, (const bf16_t*)(ws + WB_FFI1), 2 * DFF, DM, EpiFfnIn{(bf16_t*)(ws + WS_H), SSQ + 2 * SSQ_STRIDE, SW1}); xcd_barrier(go.bar);
    gemm_call(L, Hh, (const bf16_t*)(ws + WB_FFO1), DM, DFF, EpiRes{p.xp, p.xs, Y, (bf16_t*)(ws + WS_XN), SSQ + 3 * SSQ_STRIDE, modv(p, 1, 0, 5), modv(p, 1, 0, 1), nullptr, 0, 0}); xcd_barrier(go.bar);
    go.run(NFinal{p}, NFinal::count());
}
static Params make_params(void* const* d_in, void* d_out, void* d_ws) {
    Params p{}; const float** pp = (const float**)&p; for (int i = 0; i < 28; ++i) pp[i] = (const float*)d_in[i];
    p.out = (float*)d_out; p.ws = (unsigned char*)d_ws; return p;
}
extern "C" void kernel_launch(void* const* d_in, const int* in_sizes, int n_in, void* d_out, int out_size, void* d_ws, size_t ws_size, hipStream_t stream) {
    static int grid = 0;
    if (grid == 0) {
        if (n_in != 28 || (size_t)out_size != O_END || ws_size < WS_END || in_sizes[0] != MC * DM || in_sizes[1] != ML * DM) {
            fprintf(stderr, "kernel_launch: shape mismatch n_in %d out %d (want %zu) ws %zu (want %zu)\n", n_in, out_size, (size_t)O_END, ws_size, (size_t)WS_END); grid = -1; return; }
        int dev = 0, cus = 0;
        if (hipGetDevice(&dev) != hipSuccess || hipDeviceGetAttribute(&cus, hipDeviceAttributeMultiprocessorCount, dev) != hipSuccess) { grid = -1; return; }
        if (hipFuncSetAttribute((const void*)mega_fwd, hipFuncAttributeMaxDynamicSharedMemorySize, LDS_BYTES) != hipSuccess) { fprintf(stderr, "hipFuncSetAttribute failed\n"); grid = -1; return; }
        int per_cu = 0; (void)hipOccupancyMaxActiveBlocksPerMultiprocessor(&per_cu, (const void*)mega_fwd, NTHREADS, LDS_BYTES); (void)hipGetLastError();
        if (per_cu < 1) fprintf(stderr, "kernel_launch: occupancy query says %d blocks/CU\n", per_cu);
        grid = cus;
    }
    if (grid < 0) return;
    hipMemsetAsync((char*)d_ws + WS_CTL, 0, CTL_ZERO_BYTES, stream);
    Params p = make_params(d_in, d_out, d_ws);
    hipLaunchKernelGGL(mega_fwd, dim3(grid), dim3(NTHREADS), LDS_BYTES, stream, p);
}
```

```cpp
#ifdef HOST_TEST
#include <cmath>
#include <cstdio>
#include <cstdlib>
#include <cstring>
#include <cstdint>
#include <vector>
#define HD_FN inline
#define DEV_FN inline
#else
#include <hip/hip_runtime.h>
#include <cstdio>
#include <cstdint>
#define HD_FN __host__ __device__ __forceinline__
#define DEV_FN __device__ __forceinline__
#endif

#ifdef TINY
constexpr int DM = 512, NCB = 2, CSEQ = 128, NLB = 2, LSEQ = 128, PAST = 128;
#else
constexpr int DM = 1024, NCB = 16, CSEQ = 256, NLB = 4, LSEQ = 4096, PAST = 256;
#endif
constexpr int GRIDW = 64, CCH = DM / 2, CWID = 31, MH = 4, MDK = CCH / MH, MW = CCH, NGATE = 16;
constexpr int ABIN = 2 * CCH + 4 * MW + NGATE, ABMAIN = 2 * CCH + 4 * MW;
constexpr int HDIM = 128, NQ = DM / HDIM, NKV = 2, GRP = NQ / NKV, CIN = (NQ + 2 * NKV) * HDIM;
constexpr int DFF = ((8 * DM + 3 * 256 - 1) / (3 * 256)) * 256;
constexpr int MC = NCB * CSEQ, ML = NLB * LSEQ, MTOK = MC + ML, NCLS = 1 + NLB, SKVL = LSEQ + PAST;
constexpr float EPSF = 1e-6f;
constexpr int NSEQ = NCB + NLB;

constexpr size_t O_Y = 0, O_C = (size_t)MTOK * DM, O_N = O_C + (size_t)NCB * 2 * MH * MDK * MDK, O_M = O_N + (size_t)NCB * 2 * MH * MDK,
                 O_K = O_M + (size_t)NCB * 2 * MH, O_V = O_K + (size_t)NCB * CSEQ * NKV * HDIM, O_END = O_V + (size_t)NCB * CSEQ * NKV * HDIM;

constexpr size_t MiB = 1u << 20;
#ifdef TINY
constexpr size_t WSCALE = 1;
#endif
constexpr size_t WS_CTL = 0, CTL_ZERO_BYTES = 1 * MiB;
constexpr size_t WS_MOD = 1 * MiB;
constexpr size_t WS_SW = WS_MOD + 256 * 1024;
constexpr size_t WS_SSQ = 512 * 1024;
constexpr int SSQ_STRIDE = 32768;
constexpr size_t WS_DEN = 232 * MiB;
constexpr size_t WS_WB = 2 * MiB;
constexpr size_t WS_XN = 50 * MiB;
constexpr size_t WS_UPRE = 90 * MiB;
constexpr size_t WS_QKVO = 110 * MiB;
constexpr size_t WS_UH = 190 * MiB;
constexpr size_t WS_GATES = 230 * MiB;
constexpr size_t WS_HS = 50 * MiB;
constexpr size_t WS_H = 110 * MiB;
constexpr size_t WS_QRAW = 110 * MiB;
constexpr size_t WS_LATK = 150 * MiB, WS_LATV = 159 * MiB, WS_CTXK = 168 * MiB, WS_CTXV = 170 * MiB;
constexpr size_t WS_KRAW = 172 * MiB;
constexpr size_t WS_O = 190 * MiB;
constexpr size_t WS_END = 256 * MiB;

typedef unsigned short bf16_t;
HD_FN float bf2f(bf16_t h) { unsigned u = (unsigned)h << 16; return __builtin_bit_cast(float, u); }
HD_FN bf16_t f2bf(float f) { unsigned u = __builtin_bit_cast(unsigned, f); return (bf16_t)((u + 0x7fffu + ((u >> 16) & 1u)) >> 16); }
HD_FN float rbf(float f) { return bf2f(f2bf(f)); }
HD_FN float sigmoidf_(float x) { return 1.0f / (1.0f + expf(-x)); }
HD_FN float siluf_(float x) { return x * sigmoidf_(x); }
HD_FN float logsigmoidf_(float x) { return x >= 0.f ? -log1pf(expf(-x)) : x - log1pf(expf(x)); }
HD_FN int cls_of(int row) { return row < MC ? 0 : 1 + (row - MC) / LSEQ; }
HD_FN int seqlen_of(int row) { return row < MC ? CSEQ : LSEQ; }
HD_FN int pos_of(int row) { return row < MC ? row % CSEQ : (row - MC) % LSEQ; }

struct Params {
    const float *xp, *xs, *c, *stC, *stn, *stm, *ck, *cv, *cctx, *wmod, *bmod, *n1g, *n2g, *winab, *bgate, *convw, *convb, *lng, *lnb, *mng,
        *woutab, *winc, *qng, *kng, *woutc, *wffi, *wffo, *fng;
    float* out; unsigned char* ws;
};
HD_FN const float* xrow(const Params& p, int row) { return row < MC ? p.xp + (size_t)row * DM : p.xs + (size_t)(row - MC) * DM; }
HD_FN const float* modv(const Params& p, int l, int cls, int which) { return (const float*)(p.ws + WS_MOD) + ((size_t)(l * NCLS + cls) * 6 + which) * DM; }
constexpr size_t WS_RS0 = 233 * MiB;

struct NMod {
    Params p; static HD_FN long count() { return 2L * NCLS * 6 * DM; }
    HD_FN void operator()(long idx) const {
        const int col = (int)(idx % (6 * DM)); const int cls = (int)((idx / (6 * DM)) % NCLS); const int l = (int)(idx / (6 * DM * NCLS));
        const float* cond = cls == 0 ? p.cctx : p.c + (size_t)(cls - 1) * DM;
        const float* w = p.wmod + (size_t)l * DM * 6 * DM;
        float acc = 0.f;
        for (int k = 0; k < DM; ++k) acc += siluf_(cond[k]) * w[(size_t)k * 6 * DM + col];
        ((float*)(p.ws + WS_MOD))[idx] = acc + p.bmod[(size_t)l * 6 * DM + col];
    }
};
struct NNorm0a {
    Params p; static HD_FN long count() { return MTOK; }
    HD_FN void operator()(long row) const {
        const float* x = xrow(p, (int)row); float s = 0.f;
        for (int k = 0; k < DM; ++k) s += x[k] * x[k];
        ((float*)(p.ws + WS_RS0))[row] = 1.0f / sqrtf(s / DM + EPSF);
    }
};
struct NNorm0b {
    Params p; static HD_FN long count() { return (long)MTOK * DM; }
    HD_FN void operator()(long idx) const {
        const int row = (int)(idx / DM), col = (int)(idx % DM), cls = cls_of(row);
        const float rs = ((const float*)(p.ws + WS_RS0))[row];
        const float v = xrow(p, row)[col] * rs * p.n1g[col] * (1.f + modv(p, 0, cls, 1)[col]) + modv(p, 0, cls, 0)[col];
        ((bf16_t*)(p.ws + WS_XN))[idx] = f2bf(v);
    }
};
struct NGates {
    Params p; static HD_FN long count() { return (long)MTOK * NGATE; }
    HD_FN void operator()(long idx) const {
        const int row = (int)(idx / NGATE), j = (int)(idx % NGATE), cls = cls_of(row);
        const float rs = ((const float*)(p.ws + WS_RS0))[row]; const float* x = xrow(p, row);
        const float* sc = modv(p, 0, cls, 1); const float* sh = modv(p, 0, cls, 0);
        float acc = 0.f;
        for (int k = 0; k < DM; ++k) { const float h = x[k] * rs * p.n1g[k] * (1.f + sc[k]) + sh[k]; acc += h * p.winab[(size_t)k * ABIN + ABMAIN + j]; }
        acc += p.bgate[j];
        if ((j & 7) >= 4) acc = logsigmoidf_(acc);
        ((float*)(p.ws + WS_GATES))[idx] = acc;
    }
};

template <bool DUAL, class Epi> struct NGemm {
    const bf16_t* A; const float* B; int lda, ldb, K, N, off2, pad_; Epi epi;
    HD_FN long count() const { return (long)(MTOK / 4) * (N / 4); }
    HD_FN void operator()(long idx) const {
        const int nt = (int)(idx % (N / 4)), mt = (int)(idx / (N / 4)); const int m0 = mt * 4, n0 = nt * 4;
        float acc[4][4], acc2[4][4];
#pragma unroll
        for (int i = 0; i < 4; ++i)
#pragma unroll
            for (int j = 0; j < 4; ++j) { acc[i][j] = 0.f; acc2[i][j] = 0.f; }
        for (int k0 = 0; k0 < K; k0 += 8) {
            float a[4][8];
#pragma unroll
            for (int i = 0; i < 4; ++i) {
                const bf16_t* ap = A + (size_t)(m0 + i) * lda + k0;
#pragma unroll
                for (int kk = 0; kk < 8; ++kk) a[i][kk] = bf2f(ap[kk]);
            }
#pragma unroll
            for (int kk = 0; kk < 8; ++kk) {
                const float* bp = B + (size_t)(k0 + kk) * ldb + n0;
                float b[4], b2[4];
#pragma unroll
                for (int j = 0; j < 4; ++j) { b[j] = rbf(bp[j]); b2[j] = DUAL ? rbf(bp[off2 + j]) : 0.f; }
#pragma unroll
                for (int i = 0; i < 4; ++i)
#pragma unroll
                    for (int j = 0; j < 4; ++j) { acc[i][j] += a[i][kk] * b[j]; if (DUAL) acc2[i][j] += a[i][kk] * b2[j]; }
            }
        }
#pragma unroll
        for (int i = 0; i < 4; ++i)
#pragma unroll
            for (int j = 0; j < 4; ++j) epi(m0 + i, n0 + j, acc[i][j], acc2[i][j]);
    }
};
struct EGlu { Params p; HD_FN void operator()(int row, int col, float v, float v2) const { ((bf16_t*)(p.ws + WS_UPRE))[(size_t)row * CCH + col] = f2bf(v * sigmoidf_(v2)); } };
struct EQkvo { Params p; HD_FN void operator()(int row, int col, float v, float) const {
        const int part = col / MW; if (part == 1) v *= 1.0f / sqrtf((float)MDK); if (part == 3) v = sigmoidf_(v);
        ((bf16_t*)(p.ws + WS_QKVO))[(size_t)row * 4 * MW + col] = f2bf(v); } };
struct EOut { Params p; int l; int pad_ = 0; HD_FN void operator()(int row, int col, float v, float) const {
        const int cls = cls_of(row); float* Y = p.out + O_Y + (size_t)row * DM + col;
        const float xin = l == 0 ? xrow(p, row)[col] : *Y;
        const float x1 = xin + modv(p, l, cls, 2)[col] * v; *Y = x1;
        ((bf16_t*)(p.ws + WS_XN))[(size_t)row * DM + col] = f2bf(x1 * p.n2g[(size_t)l * DM + col] * (1.f + modv(p, l, cls, 4)[col])); } };
struct EFfnIn { Params p; const float* sw; int slot; int pad_ = 0; HD_FN void operator()(int row, int col, float v, float v2) const {
        const int cls = cls_of(row); const float rs = 1.0f / sqrtf(((const float*)(p.ws + WS_SSQ))[(size_t)slot * SSQ_STRIDE + row] / DM + EPSF);
        const float a = v * rs + sw[(size_t)cls * 2 * DFF + col], b = v2 * rs + sw[(size_t)cls * 2 * DFF + DFF + col];
        ((bf16_t*)(p.ws + WS_H))[(size_t)row * DFF + col] = f2bf(siluf_(a) * b); } };
struct EFfnOut { Params p; int l; int pad_ = 0; HD_FN void operator()(int row, int col, float v, float) const {
        const int cls = cls_of(row); float* Y = p.out + O_Y + (size_t)row * DM + col;
        const float x2 = *Y + modv(p, l, cls, 5)[col] * v; *Y = x2;
        if (l == 0) ((bf16_t*)(p.ws + WS_XN))[(size_t)row * DM + col] = f2bf(x2 * p.n1g[(size_t)DM + col] * (1.f + modv(p, 1, cls, 1)[col])); } };
struct EQkv { Params p; const float* sw; int slot; int pad_ = 0; HD_FN void operator()(int row, int col, float v, float) const {
        const int cls = cls_of(row); const float rs = 1.0f / sqrtf(((const float*)(p.ws + WS_SSQ))[(size_t)slot * SSQ_STRIDE + row] / DM + EPSF);
        const float a = v * rs + sw[(size_t)cls * CIN + col];
        if (col < NQ * HDIM) ((bf16_t*)(p.ws + WS_QRAW))[(size_t)row * NQ * HDIM + col] = f2bf(a);
        else if (col < (NQ + NKV) * HDIM) ((bf16_t*)(p.ws + WS_KRAW))[(size_t)row * NKV * HDIM + (col - NQ * HDIM)] = f2bf(a);
        else { const int c2 = col - (NQ + NKV) * HDIM;
            if (row < MC) { ((bf16_t*)(p.ws + WS_CTXV))[(size_t)row * NKV * HDIM + c2] = f2bf(a); p.out[O_V + (size_t)row * NKV * HDIM + c2] = a; }
            else { const int b = (row - MC) / LSEQ, s = (row - MC) % LSEQ; ((bf16_t*)(p.ws + WS_LATV))[((size_t)b * SKVL + s) * NKV * HDIM + c2] = f2bf(a); } } } };

struct NSsq {
    Params p; int slot; int pad_ = 0; static HD_FN long count() { return MTOK; }
    HD_FN void operator()(long row) const { const float* y = p.out + O_Y + (size_t)row * DM; float s = 0.f; for (int k = 0; k < DM; ++k) s += y[k] * y[k];
        ((float*)(p.ws + WS_SSQ))[(size_t)slot * SSQ_STRIDE + row] = s; }
};
struct NSW {
    Params p; const float* W; float* sw; int l, which, N, pad_; HD_FN long count() const { return (long)NCLS * N; }
    HD_FN void operator()(long idx) const { const int n = (int)(idx % N), cls = (int)(idx / N); const float* sh = modv(p, l, cls, which); float acc = 0.f;
        for (int k = 0; k < DM; ++k) acc += sh[k] * rbf(W[(size_t)k * N + n]); sw[idx] = acc; }
};
struct NConv {
    Params p; static HD_FN long count() { return (long)MTOK * CCH; }
    HD_FN void operator()(long idx) const {
        const int row = (int)(idx / CCH), c = (int)(idx % CCH), pos = pos_of(row), len = seqlen_of(row);
        const bf16_t* U = (const bf16_t*)(p.ws + WS_UPRE); float acc = p.convb[c];
        for (int j = 0; j < CWID; ++j) { const int t = pos + j - CWID / 2; if (t >= 0 && t < len) acc += p.convw[(size_t)j * CCH + c] * bf2f(U[(size_t)(row + j - CWID / 2) * CCH + c]); }
        ((float*)(p.ws + WS_HS))[idx] = acc;
    }
};
struct NConvLN {
    Params p; static HD_FN long count() { return MTOK; }
    HD_FN void operator()(long row) const {
        const float* t = (const float*)(p.ws + WS_HS) + (size_t)row * CCH; float mu = 0.f;
        for (int c = 0; c < CCH; ++c) mu += t[c]; mu /= CCH; float var = 0.f;
        for (int c = 0; c < CCH; ++c) { const float d = t[c] - mu; var += d * d; } var /= CCH;
        const float rs = 1.0f / sqrtf(var + EPSF); bf16_t* UH = (bf16_t*)(p.ws + WS_UH) + (size_t)row * DM;
        for (int c = 0; c < CCH; ++c) UH[c] = f2bf(siluf_((t[c] - mu) * rs * p.lng[c] + p.lnb[c]));
    }
};
HD_FN int seq_base(int sid) { return sid < NCB ? sid * CSEQ : MC + (sid - NCB) * LSEQ; }
struct NMlstmDen {
    Params p; static HD_FN long count() { return (long)NSEQ * MH * 2; }
    HD_FN void operator()(long idx) const {
        const int dir = (int)(idx % 2), h = (int)((idx / 2) % MH), sid = (int)(idx / (2 * MH)); const bool isctx = sid < NCB;
        const int base = seq_base(sid), len = isctx ? CSEQ : LSEQ;
        float n[MDK]; float mrun = 0.f;
        if (isctx) {
#pragma unroll
            for (int d = 0; d < MDK; ++d) n[d] = 0.f;
        } else { const int b = sid - NCB; const float em = expf(p.stm[(size_t)(b * 2 + dir) * MH + h]);
#pragma unroll
            for (int d = 0; d < MDK; ++d) n[d] = p.stn[((size_t)(b * 2 + dir) * MH + h) * MDK + d] * em; }
        const bf16_t* QK = (const bf16_t*)(p.ws + WS_QKVO); const float* G = (const float*)(p.ws + WS_GATES); float* DEN = (float*)(p.ws + WS_DEN);
        for (int t = 0; t < len; ++t) {
            const int row = base + (dir == 0 ? t : len - 1 - t);
            const float ig = G[(size_t)row * NGATE + dir * 8 + h], lf = G[(size_t)row * NGATE + dir * 8 + 4 + h];
            const float f = expf(lf), ei = expf(ig); mrun = fmaxf(mrun + lf, ig);
            const bf16_t* q = QK + (size_t)row * 4 * MW + h * MDK; const bf16_t* k = q + MW; float den = 0.f;
#pragma unroll
            for (int d = 0; d < MDK; ++d) { n[d] = f * n[d] + ei * bf2f(k[d]); den += bf2f(q[d]) * n[d]; }
            DEN[((size_t)dir * MTOK + row) * MH + h] = den;
        }
        if (isctx) { const float em = expf(-mrun); p.out[O_M + (size_t)(sid * 2 + dir) * MH + h] = mrun;
#pragma unroll
            for (int d = 0; d < MDK; ++d) p.out[O_N + ((size_t)(sid * 2 + dir) * MH + h) * MDK + d] = n[d] * em; }
    }
};
struct NMlstmNum {
    Params p; int dir; int pad_ = 0; static HD_FN long count() { return (long)NSEQ * MH * MDK; }
    HD_FN void operator()(long idx) const {
        const int v = (int)(idx % MDK), h = (int)((idx / MDK) % MH), sid = (int)(idx / (MDK * MH)); const bool isctx = sid < NCB;
        const int base = seq_base(sid), len = isctx ? CSEQ : LSEQ;
        float C[MDK];
        if (isctx) {
#pragma unroll
            for (int d = 0; d < MDK; ++d) C[d] = 0.f;
        } else { const int b = sid - NCB; const float em = expf(p.stm[(size_t)(b * 2 + dir) * MH + h]);
#pragma unroll
            for (int d = 0; d < MDK; ++d) C[d] = p.stC[(((size_t)(b * 2 + dir) * MH + h) * MDK + d) * MDK + v] * em; }
        const bf16_t* QK = (const bf16_t*)(p.ws + WS_QKVO); const float* G = (const float*)(p.ws + WS_GATES); const float* DEN = (const float*)(p.ws + WS_DEN);
        float* HS = (float*)(p.ws + WS_HS);
        for (int t = 0; t < len; ++t) {
            const int row = base + (dir == 0 ? t : len - 1 - t);
            const float ig = G[(size_t)row * NGATE + dir * 8 + h], lf = G[(size_t)row * NGATE + dir * 8 + 4 + h];
            const float f = expf(lf), ei = expf(ig);
            const bf16_t* q = QK + (size_t)row * 4 * MW + h * MDK; const bf16_t* k = q + MW; const float vv = bf2f(q[2 * MW + v]) * ei; float num = 0.f;
#pragma unroll
            for (int d = 0; d < MDK; ++d) { C[d] = f * C[d] + bf2f(k[d]) * vv; num += bf2f(q[d]) * C[d]; }
            const float den = DEN[((size_t)dir * MTOK + row) * MH + h]; const float hv = num / fmaxf(fabsf(den), 1.0f);
            float* o = HS + (size_t)row * MW + h * MDK + v; if (dir == 0) *o = hv; else *o += hv;
        }
        if (isctx) { const float em = expf(-p.out[O_M + (size_t)(sid * 2 + dir) * MH + h]);
#pragma unroll
            for (int d = 0; d < MDK; ++d) p.out[O_C + (((size_t)(sid * 2 + dir) * MH + h) * MDK + d) * MDK + v] = C[d] * em; }
    }
};
struct NHm {
    Params p; static HD_FN long count() { return (long)MTOK * MH; }
    HD_FN void operator()(long idx) const {
        const int row = (int)(idx / MH), h = (int)(idx % MH); const float* x = (const float*)(p.ws + WS_HS) + (size_t)row * MW + h * MDK; float s = 0.f;
        for (int v = 0; v < MDK; ++v) s += x[v] * x[v];
        const float rs = 1.0f / sqrtf(s / MDK + EPSF); const bf16_t* og = (const bf16_t*)(p.ws + WS_QKVO) + (size_t)row * 4 * MW + 3 * MW + h * MDK;
        bf16_t* UH = (bf16_t*)(p.ws + WS_UH) + (size_t)row * DM + CCH + h * MDK;
        for (int v = 0; v < MDK; ++v) UH[v] = f2bf(bf2f(og[v]) * x[v] * rs * p.mng[h * MDK + v]);
    }
};
struct NCacheCvt {
    Params p; static HD_FN long count() { return (long)NLB * PAST * NKV * HDIM; }
    HD_FN void operator()(long idx) const { const int e = (int)(idx % (NKV * HDIM)), pp = (int)((idx / (NKV * HDIM)) % PAST), b = (int)(idx / ((long)NKV * HDIM * PAST));
        const size_t dst = ((size_t)b * SKVL + LSEQ + pp) * NKV * HDIM + e;
        ((bf16_t*)(p.ws + WS_LATK))[dst] = f2bf(p.ck[idx]); ((bf16_t*)(p.ws + WS_LATV))[dst] = f2bf(p.cv[idx]); }
};
struct NQkPost {
    Params p; static HD_FN long count() { return (long)MTOK * (NQ + NKV); }
    HD_FN void operator()(long idx) const {
        const int row = (int)(idx / (NQ + NKV)), j = (int)(idx % (NQ + NKV)); const bool isq = j < NQ; const bool lat = row >= MC;
        bf16_t* src = isq ? (bf16_t*)(p.ws + WS_QRAW) + (size_t)row * NQ * HDIM + j * HDIM : (bf16_t*)(p.ws + WS_KRAW) + (size_t)row * NKV * HDIM + (j - NQ) * HDIM;
        const float* g = isq ? p.qng : p.kng; float s = 0.f;
        for (int d = 0; d < HDIM; ++d) { const float x = bf2f(src[d]); s += x * x; }
        const float rs = 1.0f / sqrtf(s / HDIM + EPSF);
        bf16_t* dst; float* fo = nullptr;
        if (isq) dst = src;
        else if (!lat) { dst = (bf16_t*)(p.ws + WS_CTXK) + (size_t)row * NKV * HDIM + (j - NQ) * HDIM; fo = p.out + O_K + (size_t)row * NKV * HDIM + (j - NQ) * HDIM; }
        else { const int b = (row - MC) / LSEQ, sp = (row - MC) % LSEQ; dst = (bf16_t*)(p.ws + WS_LATK) + ((size_t)b * SKVL + sp) * NKV * HDIM + (j - NQ) * HDIM; }
        const int sp = pos_of(row); const float prow = (float)(sp / GRIDW), pcol = (float)(sp % GRIDW);
        for (int half = 0; half < 2; ++half)
            for (int d = 0; d < HDIM / 4; ++d) {
                const int i1 = half * (HDIM / 2) + d, i2 = i1 + HDIM / 4;
                const float x1 = bf2f(src[i1]) * rs * g[i1], x2 = bf2f(src[i2]) * rs * g[i2]; float y1 = x1, y2 = x2;
                if (lat) { const float inv = powf(10000.0f, -(float)d / (float)(HDIM / 4)); const float ang = (half == 0 ? prow : pcol) * inv; const float cs = cosf(ang), sn = sinf(ang);
                    y1 = x1 * cs - x2 * sn; y2 = x1 * sn + x2 * cs; }
                dst[i1] = f2bf(y1); dst[i2] = f2bf(y2); if (fo) { fo[i1] = y1; fo[i2] = y2; }
            }
    }
};
struct NAttn {
    Params p; static HD_FN long count() { return (long)MTOK * NQ * 4; }
    HD_FN void operator()(long idx) const {
        const int sl = (int)(idx % 4), hq = (int)((idx / 4) % NQ), row = (int)(idx / (4 * NQ)); const int kv = hq / GRP;
        const bf16_t *Kb, *Vb; int nk;
        if (row < MC) { const int b = row / CSEQ; Kb = (const bf16_t*)(p.ws + WS_CTXK) + (size_t)b * CSEQ * NKV * HDIM; Vb = (const bf16_t*)(p.ws + WS_CTXV) + (size_t)b * CSEQ * NKV * HDIM; nk = CSEQ; }
        else { const int b = (row - MC) / LSEQ; Kb = (const bf16_t*)(p.ws + WS_LATK) + (size_t)b * SKVL * NKV * HDIM; Vb = (const bf16_t*)(p.ws + WS_LATV) + (size_t)b * SKVL * NKV * HDIM; nk = SKVL; }
        const bf16_t* qp = (const bf16_t*)(p.ws + WS_QRAW) + (size_t)row * NQ * HDIM + hq * HDIM;
        float q[HDIM];
#pragma unroll
        for (int d = 0; d < HDIM; ++d) q[d] = bf2f(qp[d]);
        float o[32];
#pragma unroll
        for (int e = 0; e < 32; ++e) o[e] = 0.f;
        float m = -1e30f, l = 0.f; const float scale = 1.0f / sqrtf((float)HDIM);
        for (int s = 0; s < nk; ++s) {
            const bf16_t* kp = Kb + (size_t)s * NKV * HDIM + kv * HDIM; float dot = 0.f;
#pragma unroll
            for (int d = 0; d < HDIM; ++d) dot += q[d] * bf2f(kp[d]);
            dot *= scale; const float mn = fmaxf(m, dot); const float al = expf(m - mn), pe = expf(dot - mn); m = mn; l = l * al + pe;
            const bf16_t* vp = Vb + (size_t)s * NKV * HDIM + kv * HDIM + sl * 32;
#pragma unroll
            for (int e = 0; e < 32; ++e) o[e] = o[e] * al + pe * bf2f(vp[e]);
        }
        bf16_t* op = (bf16_t*)(p.ws + WS_O) + (size_t)row * DM + hq * HDIM + sl * 32;
#pragma unroll
        for (int e = 0; e < 32; ++e) op[e] = f2bf(o[e] / l);
    }
};
struct NFinal {
    Params p; static HD_FN long count() { return (long)MTOK * DM; }
    HD_FN void operator()(long idx) const { const int row = (int)(idx / DM), col = (int)(idx % DM);
        const float rs = 1.0f / sqrtf(((const float*)(p.ws + WS_SSQ))[(size_t)3 * SSQ_STRIDE + row] / DM + EPSF); p.out[O_Y + idx] *= rs * p.fng[col]; }
};
constexpr int NWAVES = 8, NTHREADS = NWAVES * 64;
constexpr int RING_OFF = 0, RING_BYTES = 131072;
constexpr int LDSCTL_OFF = RING_BYTES, MISC_OFF = LDSCTL_OFF + 320;
constexpr int LDS_BYTES = 147456;
constexpr int CW_TMO = 0, CW_CODE = 1, CW_BAR = 4096;
__device__ __forceinline__ int tid_opaque() { int t = threadIdx.x; asm volatile("" : "+v"(t)); return t; }
#define GAS __attribute__((address_space(1)))
#define LAS __attribute__((address_space(3)))
typedef GAS unsigned gu32;
#define RLX_AGENT __ATOMIC_RELAXED, __HIP_MEMORY_SCOPE_AGENT
#define XB_TMO      128
#define XB_XCNT(j)  (256  + 64 * (j))
#define XB_XSUB(j)  (1280 + 64 * (j))
#define XB_XGEN(j)  (2304 + 64 * (j))
#define XB_TOP      3328
#define XB_TOPGEN   3392
#define XCD_BAR_WORDS 3456
#define XB_SPIN_CAP (1u << 22)
__device__ __forceinline__ unsigned xb_ld(unsigned* p)              { return __hip_atomic_load(p, __ATOMIC_RELAXED, __HIP_MEMORY_SCOPE_AGENT); }
__device__ __forceinline__ unsigned xb_add(unsigned* p, unsigned v) { return __hip_atomic_fetch_add(p, v, __ATOMIC_RELAXED, __HIP_MEMORY_SCOPE_AGENT); }
__device__ __forceinline__ unsigned xb_xcc_id() { return (unsigned)__builtin_amdgcn_s_getreg((3 << 11) | 20) & 0xFu; }
#define XB_SPIN(cond, bar) do { unsigned _sp = 0; while (cond) { __builtin_amdgcn_s_sleep(1); \
    if ((++_sp & 255u) == 0u) { if (xb_ld(&(bar)[XB_TMO])) break; if (_sp > XB_SPIN_CAP) { atomicAdd(&(bar)[XB_TMO], 1u); break; } } } } while (0)
struct XcdBarrier { unsigned* bar; unsigned x; volatile LAS unsigned* st; };
__device__ __forceinline__ XcdBarrier xcd_barrier_post(unsigned* bar, volatile LAS unsigned* st) {
    XcdBarrier b; b.bar = bar; b.x = xb_xcc_id(); b.st = st;
    if (threadIdx.x == 0) (void)xb_add(&bar[XB_XCNT(b.x)], 1u);
    return b;
}
__device__ __forceinline__ void xcd_barrier_complete(unsigned* bar, unsigned x, unsigned& nloc, unsigned& nx) {
    const unsigned G = gridDim.x * gridDim.y * gridDim.z;
    unsigned sum, cnt, mine, sp = 0u;
    for (;;) {
        sum = 0u; cnt = 0u; mine = 0u;
#pragma unroll
        for (unsigned j = 0; j < 16; ++j) { const unsigned c = xb_ld(&bar[XB_XCNT(j)]); sum += c; cnt += (c > 0u) ? 1u : 0u; mine = (j == x) ? c : mine; }
        if (sum == G) break;
        __builtin_amdgcn_s_sleep(1);
        if ((++sp & 255u) == 0u) { if (xb_ld(&bar[XB_TMO])) break; if (sp > XB_SPIN_CAP) { atomicAdd(&bar[XB_TMO], 1u); break; } }
    }
    nloc = mine > 0u ? mine : 1u; nx = cnt > 0u ? cnt : 1u;
}
__device__ __forceinline__ void xcd_barrier(const XcdBarrier& b) {
    asm volatile("s_waitcnt vmcnt(0)" ::: "memory");
    __syncthreads();
    if (threadIdx.x == 0) {
        unsigned* bar = b.bar;
        __builtin_amdgcn_s_waitcnt(0);
        unsigned nloc = b.st[0], nx = b.st[1];
        if (nloc == 0u) { xcd_barrier_complete(bar, b.x, nloc, nx); b.st[0] = nloc; b.st[1] = nx; }
        const unsigned old = xb_add(&bar[XB_XSUB(b.x)], 1u);
        const unsigned gen = old / nloc;
        if (old + 1u == (gen + 1u) * nloc) {
            __builtin_amdgcn_fence(__ATOMIC_RELEASE, "agent");
            asm volatile("s_waitcnt vmcnt(0)" ::: "memory");
            const unsigned og = xb_add(&bar[XB_TOP], 1u);
            const unsigned tg = og / nx;
            if (og + 1u == (tg + 1u) * nx) xb_add(&bar[XB_TOPGEN], 1u);
            else XB_SPIN(xb_ld(&bar[XB_TOPGEN]) == tg, bar);
            __builtin_amdgcn_fence(__ATOMIC_ACQUIRE, "agent");
            xb_add(&bar[XB_XGEN(b.x)], 1u);
            asm volatile("s_waitcnt vmcnt(0)" ::: "memory");
        } else {
            XB_SPIN(xb_ld(&bar[XB_XGEN(b.x)]) == gen, bar);
            __builtin_amdgcn_fence(__ATOMIC_ACQUIRE, "agent");
            asm volatile("s_waitcnt vmcnt(0)" ::: "memory");
        }
    }
    __syncthreads();
}
namespace pg8 {
#define PG8_LAS __attribute__((address_space(3)))
typedef unsigned short bf16_t;
typedef short bf16x8 __attribute__((ext_vector_type(8)));
typedef float f32x4 __attribute__((ext_vector_type(4)));
typedef unsigned u32x4 __attribute__((ext_vector_type(4)));
constexpr int BM = 256, BK = 64, HALF = 128, HTB = HALF * BK * 2  , STAGE_BYTES = 8 * HTB, NXCD = 8, WGM = 8;

__host__ __device__ __forceinline__ int lds_byte(int r, int c) { const int st = (r >> 4) * 2 + (c >> 5), rr = r & 15, cc = c & 31, ob = rr * 64 + cc * 2; return st * 1024 + (ob ^ (((ob >> 9) & 1) << 5)); }
__host__ __device__ __forceinline__ void stage_rc(int b, int& R, int& C) { const int st = b / 1024, sb = b % 1024, swz = sb ^ (((sb >> 9) & 1) << 5); R = (st >> 1) * 16 + swz / 64; C = (st & 1) * 32 + (swz % 64) / 2; }
__host__ __device__ __forceinline__ int perm32(int rho) { const int n = rho >> 4, i = rho & 15; return 8 * (i >> 2) + 4 * n + (i & 3); }

struct Unit { int pm, pn; };
struct Gemm { const bf16_t* A; const bf16_t* Bt; int M, N, K; };

struct StaticOrder {
    int nM, nN, nwg, G, c;
    __host__ __device__ void init(int M, int N, int G_, int c_) { nM = M / BM; nN = N / BM; nwg = nM * nN; G = G_; c = c_; }
    __host__ __device__ bool next(int i, Unit& u) const {
        const long L = (long)i * G + c; if (L >= nwg) return false;
        int wgid = (int)L; { const int q = nwg / NXCD, r = nwg % NXCD, xcd = wgid % NXCD, off = wgid / NXCD; wgid = (xcd < r ? xcd * (q + 1) : r * (q + 1) + (xcd - r) * q) + off; }
        const int nig = WGM * nN, gid = wgid / nig, fm = gid * WGM, gsz = (nM - fm) < WGM ? (nM - fm) : WGM;
        u.pm = fm + ((wgid % nig) % gsz); u.pn = (wgid % nig) / gsz; return true;
    }
    __device__ __forceinline__ void a_ready(const Unit&) const {}
    __device__ __forceinline__ void done(const Unit&) const {}
};

__device__ __forceinline__ unsigned cvt_pk_bf16(float lo, float hi) { unsigned r; asm volatile("v_cvt_pk_bf16_f32 %0, %1, %2" : "=v"(r) : "v"(lo), "v"(hi)); return r; }
typedef float f32x2 __attribute__((ext_vector_type(2)));
template <class Epi, class Sched, bool ALIGN_EPI = false, bool SP2 = false>
__device__ __forceinline__ void gemm_phase(PG8_LAS unsigned char* lds, const Gemm g, const Sched& S, const Epi& E) {
    const int tid = tid_opaque(), wid = __builtin_amdgcn_readfirstlane(tid >> 6), lane = tid & 63, wr = wid >> 2, wc = wid & 3, fr = lane & 15, fq = lane >> 4;
    const int K = g.K, nt = K / BK;
    unsigned voffA[2], voffB[2];
#pragma unroll
    for (int i = 0; i < 2; ++i) { int R, C; stage_rc(tid * 16 + i * 8192, R, C); const int Rb = Epi::PERM ? ((R & ~31) + perm32(R & 31)) : R;
        voffA[i] = (unsigned)(R * K + C) * 2u; voffB[i] = (unsigned)(Rb * K + C) * 2u; }
    const size_t kstep = (size_t)(BK * 2);
    const size_t hstep = (size_t)HALF * K * 2;
    const size_t tstep = 2 * hstep;
    const unsigned ldsw = (unsigned)wid * 1024u;
    const int aoff = lds_byte(wr * 64 + fr, fq * 8), boff = lds_byte(wc * 32 + fr, fq * 8);
#define PG8_SA(b, h) (((b) * 2 + (h)) * HTB)
#define PG8_SB(b, h) ((4 + (b) * 2 + (h)) * HTB)
#define PG8_STAGE(bufoff, gbase, voff) do { _Pragma("unroll") for (int _i = 0; _i < 2; ++_i) \
        __builtin_amdgcn_global_load_lds((const unsigned*)((const char*)(gbase) + (voff)[_i]), (PG8_LAS unsigned*)(lds + (bufoff) + ldsw + _i * 8192), 16, 0, 0); } while (0)
#define PG8_LDA(dst, b, h) do { _Pragma("unroll") for (int m = 0; m < 4; ++m) _Pragma("unroll") for (int k = 0; k < 2; ++k) dst[m][k] = *(const PG8_LAS bf16x8*)(lds + PG8_SA(b, h) + aoff + m * 2048 + k * 1024); } while (0)
#define PG8_LDB(dst, b, h) do { _Pragma("unroll") for (int n = 0; n < 2; ++n) _Pragma("unroll") for (int k = 0; k < 2; ++k) dst[n][k] = *(const PG8_LAS bf16x8*)(lds + PG8_SB(b, h) + boff + n * 2048 + k * 1024); } while (0)
#define PG8_MMA(ai, bj, At, Bt) do { __builtin_amdgcn_s_setprio(1); _Pragma("unroll") for (int m = 0; m < 4; ++m) _Pragma("unroll") for (int n = 0; n < 2; ++n) _Pragma("unroll") for (int k = 0; k < 2; ++k) \
        acc[ai][bj][m][n] = __builtin_amdgcn_mfma_f32_16x16x32_bf16(Bt[n][k], At[m][k], acc[ai][bj][m][n], 0, 0, 0); __builtin_amdgcn_s_setprio(0); } while (0)
#define PG8_WAIT_V(n) asm volatile("s_waitcnt vmcnt(" #n ")" ::: "memory")
#define PG8_WAIT_L(n) asm volatile("s_waitcnt lgkmcnt(" #n ")" ::: "memory")
#define PG8_BAR __builtin_amdgcn_s_barrier()
#define PG8_SCHED __builtin_amdgcn_sched_barrier(0)
    Unit cur, nxt; int ui = 0;
    if (!S.next(0, cur)) return;
    f32x4 acc[2][2][4][2];
#pragma unroll
    for (int a = 0; a < 2; ++a)
#pragma unroll
        for (int b = 0; b < 2; ++b)
#pragma unroll
            for (int m = 0; m < 4; ++m)
#pragma unroll
                for (int n = 0; n < 2; ++n) acc[a][b][m][n] = (f32x4){0.f, 0.f, 0.f, 0.f};
    bf16x8 At[4][2], B0[2][2], B1[2][2];
    const char* cA = (const char*)g.A + (size_t)cur.pm * tstep; const char* cB = (const char*)g.Bt + (size_t)cur.pn * tstep;
    S.a_ready(cur);
    if constexpr (SP2) {
        PG8_STAGE(PG8_SB(0, 0), cB, voffB); PG8_STAGE(PG8_SB(0, 1), cB + hstep, voffB); PG8_STAGE(PG8_SA(0, 0), cA, voffA); PG8_STAGE(PG8_SA(0, 1), cA + hstep, voffA);
        if (wr == 1) PG8_BAR;
        PG8_WAIT_V(2); PG8_BAR;
        PG8_STAGE(PG8_SB(1, 0), cB + kstep, voffB); PG8_STAGE(PG8_SA(1, 0), cA + kstep, voffA); PG8_STAGE(PG8_SB(1, 1), cB + hstep + kstep, voffB);
        PG8_WAIT_V(6); PG8_BAR;
    } else {
        PG8_STAGE(PG8_SB(0, 0), cB, voffB); PG8_STAGE(PG8_SA(0, 0), cA, voffA); PG8_STAGE(PG8_SB(0, 1), cB + hstep, voffB); PG8_STAGE(PG8_SA(0, 1), cA + hstep, voffA);
        if (wr == 1) PG8_BAR;
        PG8_WAIT_V(4); PG8_BAR;
        PG8_STAGE(PG8_SB(1, 0), cB + kstep, voffB); PG8_STAGE(PG8_SA(1, 0), cA + kstep, voffA); PG8_STAGE(PG8_SB(1, 1), cB + hstep + kstep, voffB);
        PG8_WAIT_V(6); PG8_BAR;
    }
    for (;;) {
        const bool has_next = S.next(ui + 1, nxt);
        const char* nA = has_next ? (const char*)g.A + (size_t)nxt.pm * tstep : cA; const char* nB = has_next ? (const char*)g.Bt + (size_t)nxt.pn * tstep : cB;
        for (int t = 0; t < nt; t += 2) {
            const bool last = (t == nt - 2);
            const char* a1 = cA + (size_t)(t + 1) * kstep;
            const char* a2 = last ? nA : cA + (size_t)(t + 2) * kstep; const char* b2 = last ? nB : cB + (size_t)(t + 2) * kstep;
            const char* a3 = a2 + kstep; const char* b3 = b2 + kstep;
            if (last && has_next) S.a_ready(nxt);
            if constexpr (SP2) {
            PG8_LDB(B0, 0, 0); PG8_LDB(B1, 0, 1); PG8_SCHED; PG8_LDA(At, 0, 0); PG8_STAGE(PG8_SA(1, 1), a1 + hstep, voffA);
            PG8_WAIT_V(8); PG8_WAIT_L(0); PG8_BAR; PG8_MMA(0, 0, At, B0); PG8_MMA(0, 1, At, B1); PG8_BAR; PG8_SCHED;
            PG8_LDA(At, 0, 1); PG8_STAGE(PG8_SB(0, 0), b2, voffB); PG8_STAGE(PG8_SB(0, 1), b2 + hstep, voffB); PG8_STAGE(PG8_SA(0, 0), a2, voffA);
            PG8_WAIT_V(8); PG8_WAIT_L(0); PG8_BAR; PG8_MMA(1, 0, At, B0); PG8_MMA(1, 1, At, B1); PG8_BAR; PG8_SCHED;
            PG8_LDB(B0, 1, 0); PG8_LDB(B1, 1, 1); PG8_SCHED; PG8_LDA(At, 1, 0); PG8_STAGE(PG8_SA(0, 1), a2 + hstep, voffA);
            PG8_WAIT_V(8); PG8_WAIT_L(0); PG8_BAR; PG8_MMA(0, 0, At, B0); PG8_MMA(0, 1, At, B1); PG8_BAR; PG8_SCHED;
            PG8_LDA(At, 1, 1); PG8_STAGE(PG8_SB(1, 0), b3, voffB); PG8_STAGE(PG8_SB(1, 1), b3 + hstep, voffB); PG8_STAGE(PG8_SA(1, 0), a3, voffA);
            PG8_WAIT_V(8); PG8_WAIT_L(0); PG8_BAR; PG8_MMA(1, 0, At, B0); PG8_MMA(1, 1, At, B1); PG8_BAR; PG8_SCHED;
            } else {
            PG8_LDB(B0, 0, 0); PG8_SCHED; PG8_LDA(At, 0, 0); PG8_STAGE(PG8_SA(1, 1), a1 + hstep, voffA);
            PG8_WAIT_L(8); PG8_BAR; PG8_WAIT_L(0); PG8_MMA(0, 0, At, B0); PG8_BAR; PG8_SCHED;
            PG8_LDB(B1, 0, 1); PG8_STAGE(PG8_SB(0, 0), b2, voffB);
            PG8_BAR; PG8_WAIT_L(0); PG8_MMA(0, 1, At, B1); PG8_BAR;
            PG8_LDA(At, 0, 1); PG8_STAGE(PG8_SA(0, 0), a2, voffA);
            PG8_BAR; PG8_WAIT_L(0); PG8_MMA(1, 0, At, B0); PG8_BAR; PG8_SCHED;
            PG8_STAGE(PG8_SB(0, 1), b2 + hstep, voffB);
            PG8_WAIT_V(6); PG8_BAR; PG8_MMA(1, 1, At, B1); PG8_BAR;
            PG8_LDB(B0, 1, 0); PG8_SCHED; PG8_LDA(At, 1, 0); PG8_STAGE(PG8_SA(0, 1), a2 + hstep, voffA);
            PG8_WAIT_L(8); PG8_BAR; PG8_WAIT_L(0); PG8_MMA(0, 0, At, B0); PG8_BAR; PG8_SCHED;
            PG8_LDB(B1, 1, 1); PG8_STAGE(PG8_SB(1, 0), b3, voffB);
            PG8_BAR; PG8_WAIT_L(0); PG8_MMA(0, 1, At, B1); PG8_BAR;
            PG8_LDA(At, 1, 1); PG8_STAGE(PG8_SA(1, 0), a3, voffA);
            PG8_BAR; PG8_WAIT_L(0); PG8_MMA(1, 0, At, B0); PG8_BAR; PG8_SCHED;
            PG8_STAGE(PG8_SB(1, 1), b3 + hstep, voffB);
            PG8_WAIT_V(6); PG8_BAR; PG8_MMA(1, 1, At, B1); PG8_BAR;
            }
        }
        if constexpr (ALIGN_EPI) { if (wr == 0) PG8_BAR; }
        if constexpr (!Epi::AFTER_DRAIN) { E(acc, cur, wr, wc, fr, fq); S.done(cur); }
        if (!has_next) break;
#pragma unroll
        for (int a = 0; a < 2; ++a)
#pragma unroll
            for (int b = 0; b < 2; ++b)
#pragma unroll
                for (int m = 0; m < 4; ++m)
#pragma unroll
                    for (int n = 0; n < 2; ++n) acc[a][b][m][n] = (f32x4){0.f, 0.f, 0.f, 0.f};
        cur = nxt; cA = nA; cB = nB; ++ui;
        if constexpr (ALIGN_EPI) { if (wr == 1) PG8_BAR; }
    }
    PG8_WAIT_V(0);
    if constexpr (!ALIGN_EPI) { if (wr == 0) PG8_BAR; }
    PG8_BAR;
    if constexpr (Epi::AFTER_DRAIN) { E.fused(acc, cur, wr, wc, fr, fq, lds, wid, lane); S.done(cur); }
#undef PG8_SA
#undef PG8_SB
#undef PG8_STAGE
#undef PG8_LDA
#undef PG8_LDB
#undef PG8_MMA
#undef PG8_WAIT_V
#undef PG8_WAIT_L
#undef PG8_BAR
#undef PG8_SCHED
}
}
constexpr size_t WB_AB = 2 * MiB, WB_OUTAB = 8 * MiB, WB_FFI0 = 10 * MiB, WB_FFO0 = 21 * MiB, WB_INC = 27 * MiB, WB_OUTC = 30 * MiB, WB_FFI1 = 32 * MiB, WB_FFO1 = 43 * MiB;
static_assert(WB_FFO1 + (size_t)DM * DFF * 2 <= WS_XN && WB_AB + (size_t)ABMAIN * DM * 2 <= WB_OUTAB && WB_FFI0 + (size_t)2 * DFF * DM * 2 <= WB_FFO0 && WB_FFO0 + (size_t)DM * DFF * 2 <= WB_INC &&
              WB_INC + (size_t)CIN * DM * 2 <= WB_OUTC && WB_FFI1 + (size_t)2 * DFF * DM * 2 <= WB_FFO1, "weight copy map");

typedef unsigned v4u __attribute__((ext_vector_type(4)));
typedef unsigned v2u __attribute__((ext_vector_type(2)));
typedef float f32x4 __attribute__((ext_vector_type(4)));
__device__ __forceinline__ unsigned pk2(float lo, float hi) { return (unsigned)f2bf(lo) | ((unsigned)f2bf(hi) << 16); }
__device__ __forceinline__ float fsigmoid(float x) { return __builtin_amdgcn_rcpf(1.0f + __builtin_amdgcn_exp2f(-1.4426950408889634f * x)); }

__device__ __forceinline__ void p0_transpose_item(const float* W, int K, int ldw, int c0, int k0, bf16_t* WT, int drow, LAS float* scr, int lane) {
#pragma unroll 8
    for (int i = 0; i < 32; ++i) { const int kk = 2 * i + (lane >> 5); scr[kk * 33 + (lane & 31)] = W[(size_t)(k0 + kk) * ldw + c0 + (lane & 31)]; }
    asm volatile("s_waitcnt lgkmcnt(0)" ::: "memory");
    const int c = lane & 7;
#pragma unroll
    for (int j = 0; j < 4; ++j) { const int n = (lane >> 3) + 8 * j; const LAS float* s = scr + (8 * c) * 33 + n;
        v4u o; o.x = pk2(s[0 * 33], s[1 * 33]); o.y = pk2(s[2 * 33], s[3 * 33]); o.z = pk2(s[4 * 33], s[5 * 33]); o.w = pk2(s[6 * 33], s[7 * 33]);
        *(GAS v4u*)(WT + (size_t)(drow + n) * K + k0 + 8 * c) = o; }
    asm volatile("s_waitcnt lgkmcnt(0)" ::: "memory");
}
struct CvtJob { const float* W; bf16_t* WT; int K, ldw, c0, ncols, mode, Hn, dbase; };
__device__ __forceinline__ int cvt_items(const CvtJob& j) { return (j.K / 64) * (j.ncols / 32); }
__device__ __forceinline__ void cvt_run(const CvtJob& j, int item, LAS float* scr, int lane) {
    const int nblk = j.ncols / 32, kb = item / nblk, nb = item % nblk; const int c = j.c0 + 32 * nb;
    int drow; if (j.mode == 0) drow = j.dbase + 32 * nb; else { const int cc = c < j.Hn ? c : c - j.Hn; drow = 256 * (cc / 128) + (cc % 128) + (c < j.Hn ? 0 : 128); }
    p0_transpose_item(j.W, j.K, j.ldw, c, 64 * kb, j.WT, drow, scr, lane);
}
__device__ __forceinline__ void p0_weights(const Params& p, LAS unsigned char* lds, int vcu, int G) {
    const int tid_ = tid_opaque(); const int lane = tid_ & 63, wave = __builtin_amdgcn_readfirstlane(tid_ >> 6);
    LAS float* scr = (LAS float*)(lds + wave * 16384);
    const int gw = vcu * NWAVES + wave, NGW = G * NWAVES;
    CvtJob jobs[9] = {
        {p.winab, (bf16_t*)(p.ws + WB_AB), DM, ABIN, 0, 2 * CCH, 1, CCH, 0},
        {p.winab, (bf16_t*)(p.ws + WB_AB), DM, ABIN, 2 * CCH, 4 * MW, 0, 0, 2 * CCH},
        {p.woutab, (bf16_t*)(p.ws + WB_OUTAB), DM, DM, 0, DM, 0, 0, 0},
        {p.wffi, (bf16_t*)(p.ws + WB_FFI0), DM, 2 * DFF, 0, 2 * DFF, 1, DFF, 0},
        {p.wffo, (bf16_t*)(p.ws + WB_FFO0), DFF, DM, 0, DM, 0, 0, 0},
        {p.winc, (bf16_t*)(p.ws + WB_INC), DM, CIN, 0, CIN, 0, 0, 0},
        {p.woutc, (bf16_t*)(p.ws + WB_OUTC), DM, DM, 0, DM, 0, 0, 0},
        {p.wffi + (size_t)DM * 2 * DFF, (bf16_t*)(p.ws + WB_FFI1), DM, 2 * DFF, 0, 2 * DFF, 1, DFF, 0},
        {p.wffo + (size_t)DFF * DM, (bf16_t*)(p.ws + WB_FFO1), DFF, DM, 0, DM, 0, 0, 0}};
    int base = 0;
#pragma unroll
    for (int jj = 0; jj < 9; ++jj) {
        const int n = cvt_items(jobs[jj]);
        int first = ((gw - base) % NGW + NGW) % NGW;
        for (int it = first; it < n; it += NGW) cvt_run(jobs[jj], it, scr, lane);
        base += n;
    }
}

struct EpiAB {
    static constexpr bool PERM = true, AFTER_DRAIN = false;
    bf16_t* upre; bf16_t* qkvo;
    __device__ __forceinline__ void operator()(const f32x4 (&acc)[2][2][4][2], const pg8::Unit& u, int wr, int wc, int fr, int fq) const {
        const int row0 = u.pm * 256 + wr * 64 + fr, lc = wc * 32 + 8 * fq;
        if (u.pn < 4) {
#pragma unroll
            for (int ai = 0; ai < 2; ++ai)
#pragma unroll
                for (int m = 0; m < 4; ++m) { const f32x4 a0 = acc[ai][0][m][0], a1 = acc[ai][0][m][1], g0 = acc[ai][1][m][0], g1 = acc[ai][1][m][1]; v4u w;
                    w.x = pg8::cvt_pk_bf16(a0[0] * fsigmoid(g0[0]), a0[1] * fsigmoid(g0[1])); w.y = pg8::cvt_pk_bf16(a0[2] * fsigmoid(g0[2]), a0[3] * fsigmoid(g0[3]));
                    w.z = pg8::cvt_pk_bf16(a1[0] * fsigmoid(g1[0]), a1[1] * fsigmoid(g1[1])); w.w = pg8::cvt_pk_bf16(a1[2] * fsigmoid(g1[2]), a1[3] * fsigmoid(g1[3]));
                    *(v4u*)(upre + (size_t)(row0 + ai * 128 + m * 16) * CCH + 128 * u.pn + lc) = w; }
        } else {
#pragma unroll
            for (int bj = 0; bj < 2; ++bj) { const int col = 256 * (u.pn - 4) + 128 * bj + lc; const int part = col / MW; const float sc = part == 1 ? 0.08838834764831845f : 1.0f;
#pragma unroll
                for (int ai = 0; ai < 2; ++ai)
#pragma unroll
                    for (int m = 0; m < 4; ++m) { f32x4 v0 = acc[ai][bj][m][0] * sc, v1 = acc[ai][bj][m][1] * sc;
                        if (part == 3) { v0 = (f32x4){fsigmoid(v0[0]), fsigmoid(v0[1]), fsigmoid(v0[2]), fsigmoid(v0[3])}; v1 = (f32x4){fsigmoid(v1[0]), fsigmoid(v1[1]), fsigmoid(v1[2]), fsigmoid(v1[3])}; }
                        v4u w; w.x = pg8::cvt_pk_bf16(v0[0], v0[1]); w.y = pg8::cvt_pk_bf16(v0[2], v0[3]); w.z = pg8::cvt_pk_bf16(v1[0], v1[1]); w.w = pg8::cvt_pk_bf16(v1[2], v1[3]);
                        *(v4u*)(qkvo + (size_t)(row0 + ai * 128 + m * 16) * (4 * MW) + col) = w; } }
        }
    }
};
static_assert(MDK == 128, "EpiAB hard-codes MDK^-0.5");
struct EpiRes {
    static constexpr bool PERM = false, AFTER_DRAIN = false;
    const float* xp; const float* xs;
    float* Y; bf16_t* XN; float* ssq; const float* mod_g; const float* mod_sc; const float* ng;
    int from_input; int pad_;
    __device__ __forceinline__ void operator()(const f32x4 (&acc)[2][2][4][2], const pg8::Unit& u, int wr, int wc, int fr, int fq) const {
        const int row0 = u.pm * 256 + wr * 64 + fr; const int cls = cls_of(u.pm * 256);
        const float* xin = from_input ? (u.pm * 256 < MC ? xp : xs - (size_t)MC * DM) : Y;
        const float* gv = mod_g + (size_t)cls * 6 * DM; const float* scv = mod_sc + (size_t)cls * 6 * DM;
        float sq[2][4];
#pragma unroll
        for (int ai = 0; ai < 2; ++ai)
#pragma unroll
            for (int m = 0; m < 4; ++m) sq[ai][m] = 0.f;
#pragma unroll
        for (int bj = 0; bj < 2; ++bj)
#pragma unroll
            for (int n = 0; n < 2; ++n) { const int col = u.pn * 256 + bj * 128 + wc * 32 + n * 16 + 4 * fq;
                const f32x4 g4 = *(const f32x4*)(gv + col); f32x4 gs4 = (f32x4){0.f, 0.f, 0.f, 0.f};
                if (ng) { const f32x4 n4 = *(const f32x4*)(ng + col), s4 = *(const f32x4*)(scv + col); gs4 = n4 * (s4 + 1.0f); }
#pragma unroll
                for (int ai = 0; ai < 2; ++ai)
#pragma unroll
                    for (int m = 0; m < 4; ++m) { const size_t off = (size_t)(row0 + ai * 128 + m * 16) * DM + col;
                        const f32x4 xi = *(const f32x4*)(xin + off); const f32x4 xn = xi + g4 * acc[ai][bj][m][n];
                        *(f32x4*)(Y + off) = xn; sq[ai][m] += (xn[0] * xn[0] + xn[1] * xn[1]) + (xn[2] * xn[2] + xn[3] * xn[3]);
                        if (ng) { const f32x4 t = xn * gs4; v2u w; w.x = pg8::cvt_pk_bf16(t[0], t[1]); w.y = pg8::cvt_pk_bf16(t[2], t[3]); *(v2u*)(XN + off) = w; } } }
#pragma unroll
        for (int ai = 0; ai < 2; ++ai)
#pragma unroll
            for (int m = 0; m < 4; ++m) { float s = sq[ai][m]; s += __shfl_xor(s, 16); s += __shfl_xor(s, 32);
                if (fq == 0) atomicAdd(ssq + row0 + ai * 128 + m * 16, s); }
    }
};
struct EpiFfnIn {
    static constexpr bool PERM = true, AFTER_DRAIN = false;
    bf16_t* H; const float* ssq; const float* sw;
    __device__ __forceinline__ void operator()(const f32x4 (&acc)[2][2][4][2], const pg8::Unit& u, int wr, int wc, int fr, int fq) const {
        const int row0 = u.pm * 256 + wr * 64 + fr, lc = wc * 32 + 8 * fq; const int cls = cls_of(u.pm * 256); const int col = 128 * u.pn + lc;
        const float* swr = sw + (size_t)cls * 2 * DFF;
        const f32x4 sg0 = *(const f32x4*)(swr + col), sg1 = *(const f32x4*)(swr + col + 4), su0 = *(const f32x4*)(swr + DFF + col), su1 = *(const f32x4*)(swr + DFF + col + 4);
#pragma unroll
        for (int ai = 0; ai < 2; ++ai)
#pragma unroll
            for (int m = 0; m < 4; ++m) { const int row = row0 + ai * 128 + m * 16; const float rs = 1.0f / sqrtf(ssq[row] * (1.0f / DM) + EPSF);
                const f32x4 a0 = acc[ai][0][m][0] * rs + sg0, a1 = acc[ai][0][m][1] * rs + sg1, b0 = acc[ai][1][m][0] * rs + su0, b1 = acc[ai][1][m][1] * rs + su1; v4u w;
                w.x = pg8::cvt_pk_bf16(a0[0] * fsigmoid(a0[0]) * b0[0], a0[1] * fsigmoid(a0[1]) * b0[1]); w.y = pg8::cvt_pk_bf16(a0[2] * fsigmoid(a0[2]) * b0[2], a0[3] * fsigmoid(a0[3]) * b0[3]);
                w.z = pg8::cvt_pk_bf16(a1[0] * fsigmoid(a1[0]) * b1[0], a1[1] * fsigmoid(a1[1]) * b1[1]); w.w = pg8::cvt_pk_bf16(a1[2] * fsigmoid(a1[2]) * b1[2], a1[3] * fsigmoid(a1[3]) * b1[3]);
                *(v4u*)(H + (size_t)row * DFF + col) = w; }
    }
};
struct EpiQkv {
    static constexpr bool PERM = true, AFTER_DRAIN = false;
    bf16_t* qraw; bf16_t* kraw; bf16_t* ctxv; bf16_t* latv; float* outv; const float* ssq; const float* sw;
    __device__ __forceinline__ void operator()(const f32x4 (&acc)[2][2][4][2], const pg8::Unit& u, int wr, int wc, int fr, int fq) const {
        const int row0 = u.pm * 256 + wr * 64 + fr, lc = wc * 32 + 8 * fq; const int cls = cls_of(u.pm * 256); const float* swr = sw + (size_t)cls * CIN;
        float rs[2][4];
#pragma unroll
        for (int ai = 0; ai < 2; ++ai)
#pragma unroll
            for (int m = 0; m < 4; ++m) rs[ai][m] = 1.0f / sqrtf(ssq[row0 + ai * 128 + m * 16] * (1.0f / DM) + EPSF);
#pragma unroll
        for (int bj = 0; bj < 2; ++bj) { const int col = 256 * u.pn + 128 * bj + lc; const f32x4 s0 = *(const f32x4*)(swr + col), s1 = *(const f32x4*)(swr + col + 4);
#pragma unroll
            for (int ai = 0; ai < 2; ++ai)
#pragma unroll
                for (int m = 0; m < 4; ++m) { const int row = row0 + ai * 128 + m * 16; const f32x4 v0 = acc[ai][bj][m][0] * rs[ai][m] + s0, v1 = acc[ai][bj][m][1] * rs[ai][m] + s1;
                    v4u w; w.x = pg8::cvt_pk_bf16(v0[0], v0[1]); w.y = pg8::cvt_pk_bf16(v0[2], v0[3]); w.z = pg8::cvt_pk_bf16(v1[0], v1[1]); w.w = pg8::cvt_pk_bf16(v1[2], v1[3]);
                    if (u.pn < NQ * HDIM / 256) *(v4u*)(qraw + (size_t)row * (NQ * HDIM) + col) = w;
                    else if (u.pn == NQ * HDIM / 256) *(v4u*)(kraw + (size_t)row * (NKV * HDIM) + (col - NQ * HDIM)) = w;
                    else { const int c2 = col - (NQ + NKV) * HDIM;
                        if (row < MC) { *(v4u*)(ctxv + (size_t)row * (NKV * HDIM) + c2) = w; float* o = outv + (size_t)row * (NKV * HDIM) + c2; *(f32x4*)o = v0; *(f32x4*)(o + 4) = v1; }
                        else { const int b = (row - MC) / LSEQ, s = (row - MC) % LSEQ; *(v4u*)(latv + ((size_t)b * SKVL + s) * (NKV * HDIM) + c2) = w; } } } }
    }
};
static_assert(NKV * HDIM == 256 && (NQ * HDIM) % 256 == 0, "EpiQkv tile mapping");
namespace att {
typedef unsigned short bf16;
constexpr int D = 128, NW = 8, QBLK = 32, KVBLK = 64; constexpr float SCALE = 0.088388347648318440f; constexpr float THR = 8.f; constexpr int SDEPTH = 1;
constexpr int LDQ = NQ * HDIM, LDK = NKV * HDIM, LDO = DM;
constexpr size_t SHM_V = KVBLK * D * 2, SHM_K = KVBLK * D * 2, SHM_ATTN = 2 * SHM_V + 2 * SHM_K + NW * 64 * 4;
using bf16x8 = __attribute__((ext_vector_type(8))) short;
using s16x4  = __attribute__((ext_vector_type(4))) short;
using f32x16 = __attribute__((ext_vector_type(16))) float;
using f32x8  = __attribute__((ext_vector_type(8))) float;
using u32x4  = __attribute__((ext_vector_type(4))) unsigned;
#define KSWZ(row, colB) ((row) * 256 + ((colB) ^ (((row) & 7) << 4)))
#define SBAR() __builtin_amdgcn_sched_barrier(0)
__device__ __forceinline__ int crow(int r, int hi) { return (r & 3) + 8 * (r >> 2) + 4 * hi; }
__device__ __forceinline__ unsigned cvtpk(float lo, float hi) {
  unsigned r; asm volatile("v_cvt_pk_bf16_f32 %0, %1, %2" : "=v"(r) : "v"(lo), "v"(hi)); return r;
}
template <typename TIn> struct Stage;
template <> struct Stage<bf16>  { using T = bf16x8;
  __device__ static __forceinline__ T ld8(const bf16* p) { return *reinterpret_cast<const bf16x8*>(p); }
  __device__ static __forceinline__ bf16x8 tobf(T x) { return x; } };
__device__ __forceinline__ void partialSM(f32x16& p0, f32x16& p1, float& m_reg, float& mn, float& alpha) {
  constexpr float C = SCALE * 1.4426950408889634f;
  float pmax = p0[0]; for (int r = 1; r < 16; ++r) pmax = fmaxf(pmax, p0[r]); for (int r = 0; r < 16; ++r) pmax = fmaxf(pmax, p1[r]);
  { auto rr = __builtin_amdgcn_permlane32_swap(__float_as_uint(pmax), __float_as_uint(pmax), false, false);
    pmax = fmaxf(__uint_as_float(rr[0]), __uint_as_float(rr[1])); }
  if (__builtin_expect(__all(pmax - m_reg <= THR / SCALE), 1)) { mn = m_reg; alpha = 1.f; }
  else { mn = fmaxf(m_reg, pmax); alpha = __builtin_amdgcn_exp2f((m_reg - mn) * C); m_reg = mn; }
  float mnC = -mn * C;
  for (int r = 0; r < 16; ++r) p0[r] = fmaf(p0[r], C, mnC); for (int r = 0; r < 16; ++r) p1[r] = fmaf(p1[r], C, mnC);
  for (int r = 0; r < 16; ++r) p0[r] = __builtin_amdgcn_exp2f(p0[r]);
}
__device__ __forceinline__ void finishSM(f32x16& p0, f32x16& p1, float alpha, float& l_reg, bf16x8& pa0, bf16x8& pa1, bf16x8& pa2, bf16x8& pa3) {
  for (int r = 0; r < 16; ++r) p1[r] = __builtin_amdgcn_exp2f(p1[r]);
  float ps = 0; for (int r = 0; r < 16; ++r) ps += p0[r]; for (int r = 0; r < 16; ++r) ps += p1[r];
  { auto rr = __builtin_amdgcn_permlane32_swap(__float_as_uint(ps), __float_as_uint(ps), false, false);
    ps = __uint_as_float(rr[0]) + __uint_as_float(rr[1]); }
  l_reg = l_reg * alpha + ps;
#define PK4(P, BASE, OUT) do { unsigned a0 = cvtpk(P[BASE + 0], P[BASE + 1]), a1 = cvtpk(P[BASE + 2], P[BASE + 3]);   \
    unsigned b0 = cvtpk(P[BASE + 4], P[BASE + 5]), b1 = cvtpk(P[BASE + 6], P[BASE + 7]);                              \
    auto r0 = __builtin_amdgcn_permlane32_swap(a0, b0, false, false); auto r1 = __builtin_amdgcn_permlane32_swap(a1, b1, false, false); \
    u32x4 w = {r0[0], r1[0], r0[1], r1[1]}; OUT = *reinterpret_cast<bf16x8*>(&w); } while (0)
  PK4(p0, 0, pa0); PK4(p0, 8, pa1); PK4(p1, 0, pa2); PK4(p1, 8, pa3);
#undef PK4
}
__device__ __forceinline__ void qkt(f32x16& p0, f32x16& p1, const bf16* Ks, const bf16x8* qr, int r32, int hi) {
  p0 = f32x16{}; p1 = f32x16{};
  for (int d0 = 0; d0 < 8; ++d0) { int cb = (d0 * 16 + hi * 8) * 2;
    bf16x8 b0 = *reinterpret_cast<const bf16x8*>((const char*)Ks + KSWZ(r32, cb));
    bf16x8 b1 = *reinterpret_cast<const bf16x8*>((const char*)Ks + KSWZ(32 + r32, cb));
    p0 = __builtin_amdgcn_mfma_f32_32x32x16_bf16(b0, qr[d0], p0, 0, 0, 0);
    p1 = __builtin_amdgcn_mfma_f32_32x32x16_bf16(b1, qr[d0], p1, 0, 0, 0); }
}
__device__ __forceinline__ int v_st(int k, int c) { const int kk = (k & ~0xC) | ((k & 4) << 1) | ((k & 8) >> 1); return ((kk >> 3) * 4 + (c >> 5)) * 512 + ((kk & 7) * 32 + (c & 31)) * 2; }
__device__ __forceinline__ int v_rd_base(int lane) { return ((lane & 3) << 3) | (((lane >> 2) & 3) << 6) | (((lane >> 4) & 1) << 5) | (((lane >> 5) & 1) << 8); }
constexpr int v_rd_off(int d0, int ks, int half) { return d0 * 512 + ks * 4096 + half * 2048; }
template <int OFF> __device__ __forceinline__ s16x4 tr_read(int vb) {
  s16x4 r; asm volatile("ds_read_b64_tr_b16 %0, %1 offset:%2" : "=&v"(r) : "v"(vb), "i"(OFF) : "memory"); return r;
}
template <int D0> __device__ __forceinline__ void pv_one(f32x16& od, int vb, bf16x8 pa0, bf16x8 pa1, bf16x8 pa2, bf16x8 pa3) {
  const s16x4 l0 = tr_read<v_rd_off(D0, 0, 0)>(vb), h0 = tr_read<v_rd_off(D0, 0, 1)>(vb), l1 = tr_read<v_rd_off(D0, 1, 0)>(vb), h1 = tr_read<v_rd_off(D0, 1, 1)>(vb);
  const s16x4 l2 = tr_read<v_rd_off(D0, 2, 0)>(vb), h2 = tr_read<v_rd_off(D0, 2, 1)>(vb), l3 = tr_read<v_rd_off(D0, 3, 0)>(vb), h3 = tr_read<v_rd_off(D0, 3, 1)>(vb);
  asm volatile("s_waitcnt lgkmcnt(0)" ::: "memory"); SBAR();
#define PK(L, H) (bf16x8){L[0], L[1], L[2], L[3], H[0], H[1], H[2], H[3]}
  od = __builtin_amdgcn_mfma_f32_32x32x16_bf16(pa0, PK(l0, h0), od, 0, 0, 0);
  od = __builtin_amdgcn_mfma_f32_32x32x16_bf16(pa1, PK(l1, h1), od, 0, 0, 0);
  od = __builtin_amdgcn_mfma_f32_32x32x16_bf16(pa2, PK(l2, h2), od, 0, 0, 0);
  od = __builtin_amdgcn_mfma_f32_32x32x16_bf16(pa3, PK(l3, h3), od, 0, 0, 0);
#undef PK
}
__device__ __forceinline__ void pv_d0(f32x16* o, int vb, bf16x8 pa0, bf16x8 pa1, bf16x8 pa2, bf16x8 pa3) {
  pv_one<0>(o[0], vb, pa0, pa1, pa2, pa3); pv_one<1>(o[1], vb, pa0, pa1, pa2, pa3); pv_one<2>(o[2], vb, pa0, pa1, pa2, pa3); pv_one<3>(o[3], vb, pa0, pa1, pa2, pa3);
}

__device__ __forceinline__ void attn_dense_body(const bf16* __restrict__ Qb, const bf16* __restrict__ Kh, const bf16* __restrict__ Vh,
                                                bf16* __restrict__ Ob, int seq, char* lds) {
  typedef bf16 TQ;
  using St = Stage<bf16>; using SQ = Stage<TQ>;
  const int tid = tid_opaque(), wid = tid >> 6, lane = tid & 63, r32 = lane & 31, hi = lane >> 5;
  bf16* V_lds = (bf16*)lds; bf16* K_lds = (bf16*)(lds + 2 * SHM_V);
  float* ws = (float*)(lds + 2 * SHM_V + 2 * SHM_K) + wid * 64; float* li_l = ws; float* al_l = ws + 32;
  float m_reg = -1e30f, l_reg = 0; f32x16 o[4] = {}; bf16x8 qr[8];
  const TQ* Qw = Qb + (long)(wid * QBLK + r32) * LDQ + hi * 8;
#pragma unroll
  for (int d0 = 0; d0 < 8; ++d0) qr[d0] = SQ::tobf(SQ::ld8(Qw + d0 * 16));
  const int sr = tid >> 4, sc = (tid & 15) * 8, vst0 = v_st(sr, sc), vst1 = v_st(32 + sr, sc);
  const int vb0 = (int)(uintptr_t)V_lds + v_rd_base(lane);
  struct { typename St::T vs0, vs1, ks0, ks1; } sr_[SDEPTH];
#define SLOAD(i, k0) do { sr_[i].vs0 = St::ld8(&Vh[(long)((k0) + sr) * LDK + sc]); sr_[i].vs1 = St::ld8(&Vh[(long)((k0) + 32 + sr) * LDK + sc]); \
    sr_[i].ks0 = St::ld8(&Kh[(long)((k0) + sr) * LDK + sc]); sr_[i].ks1 = St::ld8(&Kh[(long)((k0) + 32 + sr) * LDK + sc]); } while (0)
#define SWRITE(b, i) do { *(bf16x8*)((char*)V_lds + (b) * SHM_V + vst0) = St::tobf(sr_[i].vs0);          \
    *(bf16x8*)((char*)V_lds + (b) * SHM_V + vst1) = St::tobf(sr_[i].vs1); int kc = sc * 2;               \
    *(bf16x8*)((char*)K_lds + (b) * SHM_K + KSWZ(sr, kc)) = St::tobf(sr_[i].ks0);                       \
    *(bf16x8*)((char*)K_lds + (b) * SHM_K + KSWZ(32 + sr, kc)) = St::tobf(sr_[i].ks1); } while (0)
#define SWAIT() do { if constexpr (SDEPTH == 2) asm volatile("s_waitcnt vmcnt(4)" ::: "memory"); else asm volatile("s_waitcnt vmcnt(0)" ::: "memory"); } while (0)
#define RESC(a) do { if (__any((a) < 1.f)) { if (hi == 0) al_l[r32] = (a); asm volatile("s_waitcnt lgkmcnt(0)" ::: "memory"); \
    for (int d = 0; d < 4; ++d) for (int r = 0; r < 16; ++r) o[d][r] *= al_l[crow(r, hi)]; } } while (0)
  f32x16 pA0, pA1, pB0, pB1; float mnA, mnB, alA, alB; bf16x8 pa0, pa1, pa2, pa3; const int NT = seq / KVBLK;
  constexpr int SE = 0, SO = SDEPTH - 1;
  SLOAD(SE, 0); asm volatile("s_waitcnt vmcnt(0)" ::: "memory"); SWRITE(0, SE); __syncthreads();
  qkt(pA0, pA1, K_lds, qr, r32, hi); partialSM(pA0, pA1, m_reg, mnA, alA);
  SLOAD(SO, KVBLK); if constexpr (SDEPTH == 2) { if (2 < NT) SLOAD(SE, 2 * KVBLK); }
  SWAIT(); SWRITE(1, SO); __syncthreads();
  for (int j = 1; j + 1 < NT; j += 2) {
    SBAR(); qkt(pB0, pB1, (bf16*)((char*)K_lds + SHM_K), qr, r32, hi);
    finishSM(pA0, pA1, alA, l_reg, pa0, pa1, pa2, pa3); SBAR();
    SLOAD(SO, (j + SDEPTH) * KVBLK); SBAR();
    pv_d0(o, vb0, pa0, pa1, pa2, pa3); partialSM(pB0, pB1, m_reg, mnB, alB);
    __syncthreads(); SWAIT(); SWRITE(0, SE);
    RESC(alB); __syncthreads();
    SBAR(); qkt(pA0, pA1, K_lds, qr, r32, hi);
    finishSM(pB0, pB1, alB, l_reg, pa0, pa1, pa2, pa3); SBAR();
    if (SDEPTH == 1 || j + 3 < NT) SLOAD(SE, (j + 1 + SDEPTH) * KVBLK); SBAR();
    pv_d0(o, vb0 + (int)SHM_V, pa0, pa1, pa2, pa3); partialSM(pA0, pA1, m_reg, mnA, alA);
    __syncthreads(); SWAIT(); SWRITE(1, SO);
    RESC(alA); __syncthreads();
  }
  SBAR(); qkt(pB0, pB1, (bf16*)((char*)K_lds + SHM_K), qr, r32, hi);
  finishSM(pA0, pA1, alA, l_reg, pa0, pa1, pa2, pa3); SBAR();
  pv_d0(o, vb0, pa0, pa1, pa2, pa3); partialSM(pB0, pB1, m_reg, mnB, alB);
  __syncthreads(); RESC(alB);
  finishSM(pB0, pB1, alB, l_reg, pa0, pa1, pa2, pa3); SBAR();
  pv_d0(o, vb0 + (int)SHM_V, pa0, pa1, pa2, pa3);
  if (hi == 0) li_l[r32] = l_reg; asm volatile("s_waitcnt lgkmcnt(0)" ::: "memory");
  float rli[16];
#pragma unroll
  for (int r = 0; r < 16; ++r) rli[r] = __builtin_amdgcn_rcpf(li_l[crow(r, hi)]);
  bf16* Ow = Ob + (long)(wid * QBLK) * LDO;
#pragma unroll
  for (int r = 0; r < 16; ++r) { int orow = crow(r, hi);
    for (int d0 = 0; d0 < 4; ++d0) Ow[(long)orow * LDO + d0 * 32 + r32] = f2bf(o[d0][r] * rli[r]); }
#undef SLOAD
#undef SWRITE
#undef SWAIT
#undef RESC
}
}
__device__ __forceinline__ void attn_phase(const Params& p, unsigned char* lds, int vcu, int G) {
    constexpr int QB = 256, LQB = LSEQ / QB, CQB = CSEQ / QB;
    constexpr int NUL = NLB * NQ * LQB, NUC = NCB * NQ * CQB, NU = NUL + NUC;
    const att::bf16* QR = (const att::bf16*)(p.ws + WS_QRAW); att::bf16* OB = (att::bf16*)(p.ws + WS_O);
    for (int i = 0;; ++i) {
        int u;
        if (G == 256 && NUL == 512) { if (i < 2) u = (vcu >> 5) * 64 + (vcu & 31) + 32 * i; else u = NUL + vcu + (i - 2) * G; }
        else u = vcu + i * G;
        if (u >= NU) break;
        const att::bf16 *Q, *K, *V; att::bf16* O; int seq;
        if (u < NUL) { const int grp = u / (GRP * LQB), j = u % (GRP * LQB); const int b = grp / NKV, kvh = grp % NKV, g = j / LQB, qb = j % LQB, hq = kvh * GRP + g;
            const size_t row0 = (size_t)MC + (size_t)b * LSEQ + (size_t)qb * QB;
            Q = QR + row0 * (NQ * HDIM) + hq * HDIM; O = OB + row0 * DM + hq * HDIM;
            K = (const att::bf16*)(p.ws + WS_LATK) + (size_t)b * SKVL * (NKV * HDIM) + kvh * HDIM; V = (const att::bf16*)(p.ws + WS_LATV) + (size_t)b * SKVL * (NKV * HDIM) + kvh * HDIM; seq = SKVL; }
        else { const int uc = u - NUL; const int b = uc / (NQ * CQB), r = uc % (NQ * CQB), hq = r / CQB, qb = r % CQB, kvh = hq / GRP;
            const size_t row0 = (size_t)b * CSEQ + (size_t)qb * QB;
            Q = QR + row0 * (NQ * HDIM) + hq * HDIM; O = OB + row0 * DM + hq * HDIM;
            K = (const att::bf16*)(p.ws + WS_CTXK) + (size_t)b * CSEQ * (NKV * HDIM) + kvh * HDIM; V = (const att::bf16*)(p.ws + WS_CTXV) + (size_t)b * CSEQ * (NKV * HDIM) + kvh * HDIM; seq = CSEQ; }
        __syncthreads();
        att::attn_dense_body(Q, K, V, O, seq, (char*)lds);
    }
}
static_assert(SKVL % 128 == 0 && CSEQ % 128 == 0 && LSEQ % 256 == 0 && CSEQ % 256 == 0, "attention tiling");
struct DevGo { XcdBarrier bar;
    template <class F> __device__ __forceinline__ void run(const F& f, long n) const { const int t_ = tid_opaque(); for (long i = blockIdx.x * (long)NTHREADS + t_; i < n; i += (long)gridDim.x * NTHREADS) f(i); }
    template <class F> __device__ __forceinline__ void operator()(const F& f, long n) const { run(f, n); xcd_barrier(bar); } };
template <class Epi> __device__ __forceinline__ void gemm_call(LAS unsigned char* lds, const bf16_t* A, const bf16_t* Bt, int N, int K, const Epi& E) {
    pg8::Gemm g{A, Bt, MTOK, N, K}; pg8::StaticOrder S; S.init(MTOK, N, (int)gridDim.x, (int)blockIdx.x);
    pg8::gemm_phase<Epi, pg8::StaticOrder, true, true>((PG8_LAS unsigned char*)lds, g, S, E);
}
__global__ void __launch_bounds__(NTHREADS, 2) mega_fwd(Params p) {
    extern __shared__ __attribute__((aligned(16))) unsigned char lds[];
    LAS unsigned char* L = (LAS unsigned char*)lds;
    for (int u = threadIdx.x; u < (LDS_BYTES - LDSCTL_OFF) / 4; u += NTHREADS) ((LAS unsigned*)(L + LDSCTL_OFF))[u] = 0u;
    __syncthreads();
    volatile LAS unsigned* MISC = (volatile LAS unsigned*)(L + MISC_OFF);
    DevGo go; go.bar = xcd_barrier_post((unsigned*)(p.ws + WS_CTL) + CW_BAR, MISC + 8);
    const int G = gridDim.x, bx = blockIdx.x; const int vcu = (G % 8 == 0) ? (bx % 8) * (G / 8) + bx / 8 : bx;
    unsigned char* ws = p.ws;
    const bf16_t* XN = (const bf16_t*)(ws + WS_XN); const bf16_t* UH = (const bf16_t*)(ws + WS_UH); const bf16_t* Hh = (const bf16_t*)(ws + WS_H); const bf16_t* Ob = (const bf16_t*)(ws + WS_O);
    float* SW0 = (float*)(ws + WS_SW); float* SWC = SW0 + (size_t)NCLS * 2 * DFF; float* SW1 = SWC + (size_t)NCLS * CIN;
    float* SSQ = (float*)(ws + WS_SSQ); float* Y = p.out + O_Y;
    p0_weights(p, L, vcu, G); go(NMod{p}, NMod::count());
    go(NNorm0a{p}, NNorm0a::count()); go.run(NNorm0b{p}, NNorm0b::count()); go(NGates{p}, NGates::count());
    gemm_call(L, XN, (const bf16_t*)(ws + WB_AB), ABMAIN, DM, EpiAB{(bf16_t*)(ws + WS_UPRE), (bf16_t*)(ws + WS_QKVO)}); xcd_barrier(go.bar);
    go(NConv{p}, NConv::count()); go.run(NConvLN{p}, NConvLN::count());
    go(NMlstmDen{p}, NMlstmDen::count()); go(NMlstmNum{p, 0}, NMlstmNum::count()); go(NMlstmNum{p, 1}, NMlstmNum::count()); go(NHm{p}, NHm::count());
    gemm_call(L, UH, (const bf16_t*)(ws + WB_OUTAB), DM, DM, EpiRes{p.xp, p.xs, Y, (bf16_t*)(ws + WS_XN), SSQ + 0 * SSQ_STRIDE, modv(p, 0, 0, 2), modv(p, 0, 0, 4), p.n2g, 1, 0});
    { NSW s{p, p.wffi, SW0, 0, 3, 2 * DFF, 0}; go(s, s.count()); }
    gemm_call(L, XN, (const bf16_t*)(ws + WB_FFI0), 2 * DFF, DM, EpiFfnIn{(bf16_t*)(ws + WS_H), SSQ + 0 * SSQ_STRIDE, SW0}); xcd_barrier(go.bar);
    gemm_call(L, Hh, (const bf16_t*)(ws + WB_FFO0), DM, DFF, EpiRes{p.xp, p.xs, Y, (bf16_t*)(ws + WS_XN), SSQ + 1 * SSQ_STRIDE, modv(p, 0, 0, 5), modv(p, 1, 0, 1), p.n1g + DM, 0, 0});
    { NSW s{p, p.winc, SWC, 1, 0, CIN, 0}; go(s, s.count()); }
    gemm_call(L, XN, (const bf16_t*)(ws + WB_INC), CIN, DM, EpiQkv{(bf16_t*)(ws + WS_QRAW), (bf16_t*)(ws + WS_KRAW), (bf16_t*)(ws + WS_CTXV), (bf16_t*)(ws + WS_LATV), p.out + O_V, SSQ + 1 * SSQ_STRIDE, SWC});
    go(NCacheCvt{p}, NCacheCvt::count()); go(NQkPost{p}, NQkPost::count());
    attn_phase(p, lds, vcu, G); xcd_barrier(go.bar);
    gemm_call(L, Ob, (const bf16_t*)(ws + WB_OUTC), DM, DM, EpiRes{p.xp, p.xs, Y, (bf16_t*)(ws + WS_XN), SSQ + 2 * SSQ_STRIDE, modv(p, 1, 0, 2), modv(p, 1, 0, 4), p.n2g + DM, 0, 0});
    { NSW s{p, p.wffi + (size_t)DM * 2 * DFF, SW1, 1, 3, 2 * DFF, 0}; go(s, s.count()); }
    gemm_call(L, XN, (const bf16_t*)(ws + WB_FFI1), 2 * DFF, DM, EpiFfnIn{(bf16_t*)(ws + WS_H), SSQ + 2 * SSQ_STRIDE, SW1}); xcd_barrier(go.bar);
    gemm_call(L, Hh, (const bf16_t*)(ws + WB_FFO1), DM, DFF, EpiRes{p.xp, p.xs, Y, (bf16_t*)(ws + WS_XN), SSQ + 3 * SSQ_STRIDE, modv(p, 1, 0, 5), modv(p, 1, 0, 1), nullptr, 0, 0}); xcd_barrier(go.bar);
    go.run(NFinal{p}, NFinal::count());
}
static Params make_params(void* const* d_in, void* d_out, void* d_ws) {
    Params p{}; const float** pp = (const float**)&p; for (int i = 0; i < 28; ++i) pp[i] = (const float*)d_in[i];
    p.out = (float*)d_out; p.ws = (unsigned char*)d_ws; return p;
}
extern "C" void kernel_launch(void* const* d_in, const int* in_sizes, int n_in, void* d_out, int out_size, void* d_ws, size_t ws_size, hipStream_t stream) {
    static int grid = 0;
    if (grid == 0) {
        if (n_in != 28 || (size_t)out_size != O_END || ws_size < WS_END || in_sizes[0] != MC * DM || in_sizes[1] != ML * DM) {
            fprintf(stderr, "kernel_launch: shape mismatch n_in %d out %d (want %zu) ws %zu (want %zu)\n", n_in, out_size, (size_t)O_END, ws_size, (size_t)WS_END); grid = -1; return; }
        int dev = 0, cus = 0;
        if (hipGetDevice(&dev) != hipSuccess || hipDeviceGetAttribute(&cus, hipDeviceAttributeMultiprocessorCount, dev) != hipSuccess) { grid = -1; return; }
        if (hipFuncSetAttribute((const void*)mega_fwd, hipFuncAttributeMaxDynamicSharedMemorySize, LDS_BYTES) != hipSuccess) { fprintf(stderr, "hipFuncSetAttribute failed\n"); grid = -1; return; }
        int per_cu = 0; (void)hipOccupancyMaxActiveBlocksPerMultiprocessor(&per_cu, (const void*)mega_fwd, NTHREADS, LDS_BYTES); (void)hipGetLastError();
        if (per_cu < 1) fprintf(stderr, "kernel_launch: occupancy query says %d blocks/CU\n", per_cu);
        grid = cus;
    }
    if (grid < 0) return;
    hipMemsetAsync((char*)d_ws + WS_CTL, 0, CTL_ZERO_BYTES, stream);
    Params p = make_params(d_in, d_out, d_ws);
    hipLaunchKernelGGL(mega_fwd, dim3(grid), dim3(NTHREADS), LDS_BYTES, stream, p);
}
```

```cpp
#ifdef HOST_TEST
#include <cmath>
#include <cstdio>
#include <cstdlib>
#include <cstring>
#include <cstdint>
#include <vector>
#define HD_FN inline
#define DEV_FN inline
#else
#include <hip/hip_runtime.h>
#include <cstdio>
#include <cstdint>
#define HD_FN __host__ __device__ __forceinline__
#define DEV_FN __device__ __forceinline__
#endif

#ifdef TINY
constexpr int DM = 512, NCB = 2, CSEQ = 128, NLB = 2, LSEQ = 128, PAST = 128;
#else
constexpr int DM = 1024, NCB = 16, CSEQ = 256, NLB = 4, LSEQ = 4096, PAST = 256;
#endif
constexpr int GRIDW = 64, CCH = DM / 2, CWID = 31, MH = 4, MDK = CCH / MH, MW = CCH, NGATE = 16;
constexpr int ABIN = 2 * CCH + 4 * MW + NGATE, ABMAIN = 2 * CCH + 4 * MW;
constexpr int HDIM = 128, NQ = DM / HDIM, NKV = 2, GRP = NQ / NKV, CIN = (NQ + 2 * NKV) * HDIM;
constexpr int DFF = ((8 * DM + 3 * 256 - 1) / (3 * 256)) * 256;
constexpr int MC = NCB * CSEQ, ML = NLB * LSEQ, MTOK = MC + ML, NCLS = 1 + NLB, SKVL = LSEQ + PAST;
constexpr float EPSF = 1e-6f;
constexpr int NSEQ = NCB + NLB;

constexpr size_t O_Y = 0, O_C = (size_t)MTOK * DM, O_N = O_C + (size_t)NCB * 2 * MH * MDK * MDK, O_M = O_N + (size_t)NCB * 2 * MH * MDK,
                 O_K = O_M + (size_t)NCB * 2 * MH, O_V = O_K + (size_t)NCB * CSEQ * NKV * HDIM, O_END = O_V + (size_t)NCB * CSEQ * NKV * HDIM;

constexpr size_t MiB = 1u << 20;
#ifdef TINY
constexpr size_t WSCALE = 1;
#endif
constexpr size_t WS_CTL = 0, CTL_ZERO_BYTES = 1 * MiB;
constexpr size_t WS_MOD = 1 * MiB;
constexpr size_t WS_SW = WS_MOD + 256 * 1024;
constexpr size_t WS_SSQ = 512 * 1024;
constexpr int SSQ_STRIDE = 32768;
constexpr size_t WS_DEN = 232 * MiB;
constexpr size_t WS_WB = 2 * MiB;
constexpr size_t WS_XN = 50 * MiB;
constexpr size_t WS_UPRE = 90 * MiB;
constexpr size_t WS_QKVO = 110 * MiB;
constexpr size_t WS_UH = 190 * MiB;
constexpr size_t WS_GATES = 230 * MiB;
constexpr size_t WS_HS = 50 * MiB;
constexpr size_t WS_H = 110 * MiB;
constexpr size_t WS_QRAW = 110 * MiB;
constexpr size_t WS_LATK = 150 * MiB, WS_LATV = 159 * MiB, WS_CTXK = 168 * MiB, WS_CTXV = 170 * MiB;
constexpr size_t WS_KRAW = 172 * MiB;
constexpr size_t WS_O = 190 * MiB;
constexpr size_t WS_END = 256 * MiB;

typedef unsigned short bf16_t;
HD_FN float bf2f(bf16_t h) { unsigned u = (unsigned)h << 16; return __builtin_bit_cast(float, u); }
HD_FN bf16_t f2bf(float f) { unsigned u = __builtin_bit_cast(unsigned, f); return (bf16_t)((u + 0x7fffu + ((u >> 16) & 1u)) >> 16); }
HD_FN float rbf(float f) { return bf2f(f2bf(f)); }
HD_FN float sigmoidf_(float x) { return 1.0f / (1.0f + expf(-x)); }
HD_FN float siluf_(float x) { return x * sigmoidf_(x); }
HD_FN float logsigmoidf_(float x) { return x >= 0.f ? -log1pf(expf(-x)) : x - log1pf(expf(x)); }
HD_FN int cls_of(int row) { return row < MC ? 0 : 1 + (row - MC) / LSEQ; }
HD_FN int seqlen_of(int row) { return row < MC ? CSEQ : LSEQ; }
HD_FN int pos_of(int row) { return row < MC ? row % CSEQ : (row - MC) % LSEQ; }

struct Params {
    const float *xp, *xs, *c, *stC, *stn, *stm, *ck, *cv, *cctx, *wmod, *bmod, *n1g, *n2g, *winab, *bgate, *convw, *convb, *lng, *lnb, *mng,
        *woutab, *winc, *qng, *kng, *woutc, *wffi, *wffo, *fng;
    float* out; unsigned char* ws;
};
HD_FN const float* xrow(const Params& p, int row) { return row < MC ? p.xp + (size_t)row * DM : p.xs + (size_t)(row - MC) * DM; }
HD_FN const float* modv(const Params& p, int l, int cls, int which) { return (const float*)(p.ws + WS_MOD) + ((size_t)(l * NCLS + cls) * 6 + which) * DM; }
constexpr size_t WS_RS0 = 233 * MiB;

struct NMod {
    Params p; static HD_FN long count() { return 2L * NCLS * 6 * DM; }
    HD_FN void operator()(long idx) const {
        const int col = (int)(idx % (6 * DM)); const int cls = (int)((idx / (6 * DM)) % NCLS); const int l = (int)(idx / (6 * DM * NCLS));
        const float* cond = cls == 0 ? p.cctx : p.c + (size_t)(cls - 1) * DM;
        const float* w = p.wmod + (size_t)l * DM * 6 * DM;
        float acc = 0.f;
        for (int k = 0; k < DM; ++k) acc += siluf_(cond[k]) * w[(size_t)k * 6 * DM + col];
        ((float*)(p.ws + WS_MOD))[idx] = acc + p.bmod[(size_t)l * 6 * DM + col];
    }
};
struct NNorm0a {
    Params p; static HD_FN long count() { return MTOK; }
    HD_FN void operator()(long row) const {
        const float* x = xrow(p, (int)row); float s = 0.f;
        for (int k = 0; k < DM; ++k) s += x[k] * x[k];
        ((float*)(p.ws + WS_RS0))[row] = 1.0f / sqrtf(s / DM + EPSF);
    }
};
struct NNorm0b {
    Params p; static HD_FN long count() { return (long)MTOK * DM; }
    HD_FN void operator()(long idx) const {
        const int row = (int)(idx / DM), col = (int)(idx % DM), cls = cls_of(row);
        const float rs = ((const float*)(p.ws + WS_RS0))[row];
        const float v = xrow(p, row)[col] * rs * p.n1g[col] * (1.f + modv(p, 0, cls, 1)[col]) + modv(p, 0, cls, 0)[col];
        ((bf16_t*)(p.ws + WS_XN))[idx] = f2bf(v);
    }
};
struct NGates {
    Params p; static HD_FN long count() { return (long)MTOK * NGATE; }
    HD_FN void operator()(long idx) const {
        const int row = (int)(idx / NGATE), j = (int)(idx % NGATE), cls = cls_of(row);
        const float rs = ((const float*)(p.ws + WS_RS0))[row]; const float* x = xrow(p, row);
        const float* sc = modv(p, 0, cls, 1); const float* sh = modv(p, 0, cls, 0);
        float acc = 0.f;
        for (int k = 0; k < DM; ++k) { const float h = x[k] * rs * p.n1g[k] * (1.f + sc[k]) + sh[k]; acc += h * p.winab[(size_t)k * ABIN + ABMAIN + j]; }
        acc += p.bgate[j];
        if ((j & 7) >= 4) acc = logsigmoidf_(acc);
        ((float*)(p.ws + WS_GATES))[idx] = acc;
    }
};

template <bool DUAL, class Epi> struct NGemm {
    const bf16_t* A; const float* B; int lda, ldb, K, N, off2, pad_; Epi epi;
    HD_FN long count() const { return (long)(MTOK / 4) * (N / 4); }
    HD_FN void operator()(long idx) const {
        const int nt = (int)(idx % (N / 4)), mt = (int)(idx / (N / 4)); const int m0 = mt * 4, n0 = nt * 4;
        float acc[4][4], acc2[4][4];
#pragma unroll
        for (int i = 0; i < 4; ++i)
#pragma unroll
            for (int j = 0; j < 4; ++j) { acc[i][j] = 0.f; acc2[i][j] = 0.f; }
        for (int k0 = 0; k0 < K; k0 += 8) {
            float a[4][8];
#pragma unroll
            for (int i = 0; i < 4; ++i) {
                const bf16_t* ap = A + (size_t)(m0 + i) * lda + k0;
#pragma unroll
                for (int kk = 0; kk < 8; ++kk) a[i][kk] = bf2f(ap[kk]);
            }
#pragma unroll
            for (int kk = 0; kk < 8; ++kk) {
                const float* bp = B + (size_t)(k0 + kk) * ldb + n0;
                float b[4], b2[4];
#pragma unroll
                for (int j = 0; j < 4; ++j) { b[j] = rbf(bp[j]); b2[j] = DUAL ? rbf(bp[off2 + j]) : 0.f; }
#pragma unroll
                for (int i = 0; i < 4; ++i)
#pragma unroll
                    for (int j = 0; j < 4; ++j) { acc[i][j] += a[i][kk] * b[j]; if (DUAL) acc2[i][j] += a[i][kk] * b2[j]; }
            }
        }
#pragma unroll
        for (int i = 0; i < 4; ++i)
#pragma unroll
            for (int j = 0; j < 4; ++j) epi(m0 + i, n0 + j, acc[i][j], acc2[i][j]);
    }
};
struct EGlu { Params p; HD_FN void operator()(int row, int col, float v, float v2) const { ((bf16_t*)(p.ws + WS_UPRE))[(size_t)row * CCH + col] = f2bf(v * sigmoidf_(v2)); } };
struct EQkvo { Params p; HD_FN void operator()(int row, int col, float v, float) const {
        const int part = col / MW; if (part == 1) v *= 1.0f / sqrtf((float)MDK); if (part == 3) v = sigmoidf_(v);
        ((bf16_t*)(p.ws + WS_QKVO))[(size_t)row * 4 * MW + col] = f2bf(v); } };
struct EOut { Params p; int l; int pad_ = 0; HD_FN void operator()(int row, int col, float v, float) const {
        const int cls = cls_of(row); float* Y = p.out + O_Y + (size_t)row * DM + col;
        const float xin = l == 0 ? xrow(p, row)[col] : *Y;
        const float x1 = xin + modv(p, l, cls, 2)[col] * v; *Y = x1;
        ((bf16_t*)(p.ws + WS_XN))[(size_t)row * DM + col] = f2bf(x1 * p.n2g[(size_t)l * DM + col] * (1.f + modv(p, l, cls, 4)[col])); } };
struct EFfnIn { Params p; const float* sw; int slot; int pad_ = 0; HD_FN void operator()(int row, int col, float v, float v2) const {
        const int cls = cls_of(row); const float rs = 1.0f / sqrtf(((const float*)(p.ws + WS_SSQ))[(size_t)slot * SSQ_STRIDE + row] / DM + EPSF);
        const float a = v * rs + sw[(size_t)cls * 2 * DFF + col], b = v2 * rs + sw[(size_t)cls * 2 * DFF + DFF + col];
        ((bf16_t*)(p.ws + WS_H))[(size_t)row * DFF + col] = f2bf(siluf_(a) * b); } };
struct EFfnOut { Params p; int l; int pad_ = 0; HD_FN void operator()(int row, int col, float v, float) const {
        const int cls = cls_of(row); float* Y = p.out + O_Y + (size_t)row * DM + col;
        const float x2 = *Y + modv(p, l, cls, 5)[col] * v; *Y = x2;
        if (l == 0) ((bf16_t*)(p.ws + WS_XN))[(size_t)row * DM + col] = f2bf(x2 * p.n1g[(size_t)DM + col] * (1.f + modv(p, 1, cls, 1)[col])); } };
struct EQkv { Params p; const float* sw; int slot; int pad_ = 0; HD_FN void operator()(int row, int col, float v, float) const {
        const int cls = cls_of(row); const float rs = 1.0f / sqrtf(((const float*)(p.ws + WS_SSQ))[(size_t)slot * SSQ_STRIDE + row] / DM + EPSF);
        const float a = v * rs + sw[(size_t)cls * CIN + col];
        if (col < NQ * HDIM) ((bf16_t*)(p.ws + WS_QRAW))[(size_t)row * NQ * HDIM + col] = f2bf(a);
        else if (col < (NQ + NKV) * HDIM) ((bf16_t*)(p.ws + WS_KRAW))[(size_t)row * NKV * HDIM + (col - NQ * HDIM)] = f2bf(a);
        else { const int c2 = col - (NQ + NKV) * HDIM;
            if (row < MC) { ((bf16_t*)(p.ws + WS_CTXV))[(size_t)row * NKV * HDIM + c2] = f2bf(a); p.out[O_V + (size_t)row * NKV * HDIM + c2] = a; }
            else { const int b = (row - MC) / LSEQ, s = (row - MC) % LSEQ; ((bf16_t*)(p.ws + WS_LATV))[((size_t)b * SKVL + s) * NKV * HDIM + c2] = f2bf(a); } } } };

struct NSsq {
    Params p; int slot; int pad_ = 0; static HD_FN long count() { return MTOK; }
    HD_FN void operator()(long row) const { const float* y = p.out + O_Y + (size_t)row * DM; float s = 0.f; for (int k = 0; k < DM; ++k) s += y[k] * y[k];
        ((float*)(p.ws + WS_SSQ))[(size_t)slot * SSQ_STRIDE + row] = s; }
};
struct NSW {
    Params p; const float* W; float* sw; int l, which, N, pad_; HD_FN long count() const { return (long)NCLS * N; }
    HD_FN void operator()(long idx) const { const int n = (int)(idx % N), cls = (int)(idx / N); const float* sh = modv(p, l, cls, which); float acc = 0.f;
        for (int k = 0; k < DM; ++k) acc += sh[k] * rbf(W[(size_t)k * N + n]); sw[idx] = acc; }
};
struct NConv {
    Params p; static HD_FN long count() { return (long)MTOK * CCH; }
    HD_FN void operator()(long idx) const {
        const int row = (int)(idx / CCH), c = (int)(idx % CCH), pos = pos_of(row), len = seqlen_of(row);
        const bf16_t* U = (const bf16_t*)(p.ws + WS_UPRE); float acc = p.convb[c];
        for (int j = 0; j < CWID; ++j) { const int t = pos + j - CWID / 2; if (t >= 0 && t < len) acc += p.convw[(size_t)j * CCH + c] * bf2f(U[(size_t)(row + j - CWID / 2) * CCH + c]); }
        ((float*)(p.ws + WS_HS))[idx] = acc;
    }
};
struct NConvLN {
    Params p; static HD_FN long count() { return MTOK; }
    HD_FN void operator()(long row) const {
        const float* t = (const float*)(p.ws + WS_HS) + (size_t)row * CCH; float mu = 0.f;
        for (int c = 0; c < CCH; ++c) mu += t[c]; mu /= CCH; float var = 0.f;
        for (int c = 0; c < CCH; ++c) { const float d = t[c] - mu; var += d * d; } var /= CCH;
        const float rs = 1.0f / sqrtf(var + EPSF); bf16_t* UH = (bf16_t*)(p.ws + WS_UH) + (size_t)row * DM;
        for (int c = 0; c < CCH; ++c) UH[c] = f2bf(siluf_((t[c] - mu) * rs * p.lng[c] + p.lnb[c]));
    }
};
HD_FN int seq_base(int sid) { return sid < NCB ? sid * CSEQ : MC + (sid - NCB) * LSEQ; }
struct NMlstmDen {
    Params p; static HD_FN long count() { return (long)NSEQ * MH * 2; }
    HD_FN void operator()(long idx) const {
        const int dir = (int)(idx % 2), h = (int)((idx / 2) % MH), sid = (int)(idx / (2 * MH)); const bool isctx = sid < NCB;
        const int base = seq_base(sid), len = isctx ? CSEQ : LSEQ;
        float n[MDK]; float mrun = 0.f;
        if (isctx) {
#pragma unroll
            for (int d = 0; d < MDK; ++d) n[d] = 0.f;
        } else { const int b = sid - NCB; const float em = expf(p.stm[(size_t)(b * 2 + dir) * MH + h]);
#pragma unroll
            for (int d = 0; d < MDK; ++d) n[d] = p.stn[((size_t)(b * 2 + dir) * MH + h) * MDK + d] * em; }
        const bf16_t* QK = (const bf16_t*)(p.ws + WS_QKVO); const float* G = (const float*)(p.ws + WS_GATES); float* DEN = (float*)(p.ws + WS_DEN);
        for (int t = 0; t < len; ++t) {
            const int row = base + (dir == 0 ? t : len - 1 - t);
            const float ig = G[(size_t)row * NGATE + dir * 8 + h], lf = G[(size_t)row * NGATE + dir * 8 + 4 + h];
            const float f = expf(lf), ei = expf(ig); mrun = fmaxf(mrun + lf, ig);
            const bf16_t* q = QK + (size_t)row * 4 * MW + h * MDK; const bf16_t* k = q + MW; float den = 0.f;
#pragma unroll
            for (int d = 0; d < MDK; ++d) { n[d] = f * n[d] + ei * bf2f(k[d]); den += bf2f(q[d]) * n[d]; }
            DEN[((size_t)dir * MTOK + row) * MH + h] = den;
        }
        if (isctx) { const float em = expf(-mrun); p.out[O_M + (size_t)(sid * 2 + dir) * MH + h] = mrun;
#pragma unroll
            for (int d = 0; d < MDK; ++d) p.out[O_N + ((size_t)(sid * 2 + dir) * MH + h) * MDK + d] = n[d] * em; }
    }
};
struct NMlstmNum {
    Params p; int dir; int pad_ = 0; static HD_FN long count() { return (long)NSEQ * MH * MDK; }
    HD_FN void operator()(long idx) const {
        const int v = (int)(idx % MDK), h = (int)((idx / MDK) % MH), sid = (int)(idx / (MDK * MH)); const bool isctx = sid < NCB;
        const int base = seq_base(sid), len = isctx ? CSEQ : LSEQ;
        float C[MDK];
        if (isctx) {
#pragma unroll
            for (int d = 0; d < MDK; ++d) C[d] = 0.f;
        } else { const int b = sid - NCB; const float em = expf(p.stm[(size_t)(b * 2 + dir) * MH + h]);
#pragma unroll
            for (int d = 0; d < MDK; ++d) C[d] = p.stC[(((size_t)(b * 2 + dir) * MH + h) * MDK + d) * MDK + v] * em; }
        const bf16_t* QK = (const bf16_t*)(p.ws + WS_QKVO); const float* G = (const float*)(p.ws + WS_GATES); const float* DEN = (const float*)(p.ws + WS_DEN);
        float* HS = (float*)(p.ws + WS_HS);
        for (int t = 0; t < len; ++t) {
            const int row = base + (dir == 0 ? t : len - 1 - t);
            const float ig = G[(size_t)row * NGATE + dir * 8 + h], lf = G[(size_t)row * NGATE + dir * 8 + 4 + h];
            const float f = expf(lf), ei = expf(ig);
            const bf16_t* q = QK + (size_t)row * 4 * MW + h * MDK; const bf16_t* k = q + MW; const float vv = bf2f(q[2 * MW + v]) * ei; float num = 0.f;
#pragma unroll
            for (int d = 0; d < MDK; ++d) { C[d] = f * C[d] + bf2f(k[d]) * vv; num += bf2f(q[d]) * C[d]; }
            const float den = DEN[((size_t)dir * MTOK + row) * MH + h]; const float hv = num / fmaxf(fabsf(den), 1.0f);
            float* o = HS + (size_t)row * MW + h * MDK + v; if (dir == 0) *o = hv; else *o += hv;
        }
        if (isctx) { const float em = expf(-p.out[O_M + (size_t)(sid * 2 + dir) * MH + h]);
#pragma unroll
            for (int d = 0; d < MDK; ++d) p.out[O_C + (((size_t)(sid * 2 + dir) * MH + h) * MDK + d) * MDK + v] = C[d] * em; }
    }
};
struct NHm {
    Params p; static HD_FN long count() { return (long)MTOK * MH; }
    HD_FN void operator()(long idx) const {
        const int row = (int)(idx / MH), h = (int)(idx % MH); const float* x = (const float*)(p.ws + WS_HS) + (size_t)row * MW + h * MDK; float s = 0.f;
        for (int v = 0; v < MDK; ++v) s += x[v] * x[v];
        const float rs = 1.0f / sqrtf(s / MDK + EPSF); const bf16_t* og = (const bf16_t*)(p.ws + WS_QKVO) + (size_t)row * 4 * MW + 3 * MW + h * MDK;
        bf16_t* UH = (bf16_t*)(p.ws + WS_UH) + (size_t)row * DM + CCH + h * MDK;
        for (int v = 0; v < MDK; ++v) UH[v] = f2bf(bf2f(og[v]) * x[v] * rs * p.mng[h * MDK + v]);
    }
};
struct NCacheCvt {
    Params p; static HD_FN long count() { return (long)NLB * PAST * NKV * HDIM; }
    HD_FN void operator()(long idx) const { const int e = (int)(idx % (NKV * HDIM)), pp = (int)((idx / (NKV * HDIM)) % PAST), b = (int)(idx / ((long)NKV * HDIM * PAST));
        const size_t dst = ((size_t)b * SKVL + LSEQ + pp) * NKV * HDIM + e;
        ((bf16_t*)(p.ws + WS_LATK))[dst] = f2bf(p.ck[idx]); ((bf16_t*)(p.ws + WS_LATV))[dst] = f2bf(p.cv[idx]); }
};
struct NQkPost {
    Params p; static HD_FN long count() { return (long)MTOK * (NQ + NKV); }
    HD_FN void operator()(long idx) const {
        const int row = (int)(idx / (NQ + NKV)), j = (int)(idx % (NQ + NKV)); const bool isq = j < NQ; const bool lat = row >= MC;
        bf16_t* src = isq ? (bf16_t*)(p.ws + WS_QRAW) + (size_t)row * NQ * HDIM + j * HDIM : (bf16_t*)(p.ws + WS_KRAW) + (size_t)row * NKV * HDIM + (j - NQ) * HDIM;
        const float* g = isq ? p.qng : p.kng; float s = 0.f;
        for (int d = 0; d < HDIM; ++d) { const float x = bf2f(src[d]); s += x * x; }
        const float rs = 1.0f / sqrtf(s / HDIM + EPSF);
        bf16_t* dst; float* fo = nullptr;
        if (isq) dst = src;
        else if (!lat) { dst = (bf16_t*)(p.ws + WS_CTXK) + (size_t)row * NKV * HDIM + (j - NQ) * HDIM; fo = p.out + O_K + (size_t)row * NKV * HDIM + (j - NQ) * HDIM; }
        else { const int b = (row - MC) / LSEQ, sp = (row - MC) % LSEQ; dst = (bf16_t*)(p.ws + WS_LATK) + ((size_t)b * SKVL + sp) * NKV * HDIM + (j - NQ) * HDIM; }
        const int sp = pos_of(row); const float prow = (float)(sp / GRIDW), pcol = (float)(sp % GRIDW);
        for (int half = 0; half < 2; ++half)
            for (int d = 0; d < HDIM / 4; ++d) {
                const int i1 = half * (HDIM / 2) + d, i2 = i1 + HDIM / 4;
                const float x1 = bf2f(src[i1]) * rs * g[i1], x2 = bf2f(src[i2]) * rs * g[i2]; float y1 = x1, y2 = x2;
                if (lat) { const float inv = powf(10000.0f, -(float)d / (float)(HDIM / 4)); const float ang = (half == 0 ? prow : pcol) * inv; const float cs = cosf(ang), sn = sinf(ang);
                    y1 = x1 * cs - x2 * sn; y2 = x1 * sn + x2 * cs; }
                dst[i1] = f2bf(y1); dst[i2] = f2bf(y2); if (fo) { fo[i1] = y1; fo[i2] = y2; }
            }
    }
};
struct NAttn {
    Params p; static HD_FN long count() { return (long)MTOK * NQ * 4; }
    HD_FN void operator()(long idx) const {
        const int sl = (int)(idx % 4), hq = (int)((idx / 4) % NQ), row = (int)(idx / (4 * NQ)); const int kv = hq / GRP;
        const bf16_t *Kb, *Vb; int nk;
        if (row < MC) { const int b = row / CSEQ; Kb = (const bf16_t*)(p.ws + WS_CTXK) + (size_t)b * CSEQ * NKV * HDIM; Vb = (const bf16_t*)(p.ws + WS_CTXV) + (size_t)b * CSEQ * NKV * HDIM; nk = CSEQ; }
        else { const int b = (row - MC) / LSEQ; Kb = (const bf16_t*)(p.ws + WS_LATK) + (size_t)b * SKVL * NKV * HDIM; Vb = (const bf16_t*)(p.ws + WS_LATV) + (size_t)b * SKVL * NKV * HDIM; nk = SKVL; }
        const bf16_t* qp = (const bf16_t*)(p.ws + WS_QRAW) + (size_t)row * NQ * HDIM + hq * HDIM;
        float q[HDIM];
#pragma unroll
        for (int d = 0; d < HDIM; ++d) q[d] = bf2f(qp[d]);
        float o[32];
#pragma unroll
        for (int e = 0; e < 32; ++e) o[e] = 0.f;
        float m = -1e30f, l = 0.f; const float scale = 1.0f / sqrtf((float)HDIM);
        for (int s = 0; s < nk; ++s) {
            const bf16_t* kp = Kb + (size_t)s * NKV * HDIM + kv * HDIM; float dot = 0.f;
#pragma unroll
            for (int d = 0; d < HDIM; ++d) dot += q[d] * bf2f(kp[d]);
            dot *= scale; const float mn = fmaxf(m, dot); const float al = expf(m - mn), pe = expf(dot - mn); m = mn; l = l * al + pe;
            const bf16_t* vp = Vb + (size_t)s * NKV * HDIM + kv * HDIM + sl * 32;
#pragma unroll
            for (int e = 0; e < 32; ++e) o[e] = o[e] * al + pe * bf2f(vp[e]);
        }
        bf16_t* op = (bf16_t*)(p.ws + WS_O) + (size_t)row * DM + hq * HDIM + sl * 32;
#pragma unroll
        for (int e = 0; e < 32; ++e) op[e] = f2bf(o[e] / l);
    }
};
struct NFinal {
    Params p; static HD_FN long count() { return (long)MTOK * DM; }
    HD_FN void operator()(long idx) const { const int row = (int)(idx / DM), col = (int)(idx % DM);
        const float rs = 1.0f / sqrtf(((const float*)(p.ws + WS_SSQ))[(size_t)3 * SSQ_STRIDE + row] / DM + EPSF); p.out[O_Y + idx] *= rs * p.fng[col]; }
};
constexpr int NWAVES = 8, NTHREADS = NWAVES * 64;
constexpr int RING_OFF = 0, RING_BYTES = 131072;
constexpr int LDSCTL_OFF = RING_BYTES, MISC_OFF = LDSCTL_OFF + 320;
constexpr int LDS_BYTES = 147456;
constexpr int CW_TMO = 0, CW_CODE = 1, CW_BAR = 4096;
__device__ __forceinline__ int tid_opaque() { int t = threadIdx.x; asm volatile("" : "+v"(t)); return t; }
#define GAS __attribute__((address_space(1)))
#define LAS __attribute__((address_space(3)))
typedef GAS unsigned gu32;
#define RLX_AGENT __ATOMIC_RELAXED, __HIP_MEMORY_SCOPE_AGENT
#define XB_TMO      128
#define XB_XCNT(j)  (256  + 64 * (j))
#define XB_XSUB(j)  (1280 + 64 * (j))
#define XB_XGEN(j)  (2304 + 64 * (j))
#define XB_TOP      3328
#define XB_TOPGEN   3392
#define XCD_BAR_WORDS 3456
#define XB_SPIN_CAP (1u << 22)
__device__ __forceinline__ unsigned xb_ld(unsigned* p)              { return __hip_atomic_load(p, __ATOMIC_RELAXED, __HIP_MEMORY_SCOPE_AGENT); }
__device__ __forceinline__ unsigned xb_add(unsigned* p, unsigned v) { return __hip_atomic_fetch_add(p, v, __ATOMIC_RELAXED, __HIP_MEMORY_SCOPE_AGENT); }
__device__ __forceinline__ unsigned xb_xcc_id() { return (unsigned)__builtin_amdgcn_s_getreg((3 << 11) | 20) & 0xFu; }
#define XB_SPIN(cond, bar) do { unsigned _sp = 0; while (cond) { __builtin_amdgcn_s_sleep(1); \
    if ((++_sp & 255u) == 0u) { if (xb_ld(&(bar)[XB_TMO])) break; if (_sp > XB_SPIN_CAP) { atomicAdd(&(bar)[XB_TMO], 1u); break; } } } } while (0)
struct XcdBarrier { unsigned* bar; unsigned x; volatile LAS unsigned* st; };
__device__ __forceinline__ XcdBarrier xcd_barrier_post(unsigned* bar, volatile LAS unsigned* st) {
    XcdBarrier b; b.bar = bar; b.x = xb_xcc_id(); b.st = st;
    if (threadIdx.x == 0) (void)xb_add(&bar[XB_XCNT(b.x)], 1u);
    return b;
}
__device__ __forceinline__ void xcd_barrier_complete(unsigned* bar, unsigned x, unsigned& nloc, unsigned& nx) {
    const unsigned G = gridDim.x * gridDim.y * gridDim.z;
    unsigned sum, cnt, mine, sp = 0u;
    for (;;) {
        sum = 0u; cnt = 0u; mine = 0u;
#pragma unroll
        for (unsigned j = 0; j < 16; ++j) { const unsigned c = xb_ld(&bar[XB_XCNT(j)]); sum += c; cnt += (c > 0u) ? 1u : 0u; mine = (j == x) ? c : mine; }
        if (sum == G) break;
        __builtin_amdgcn_s_sleep(1);
        if ((++sp & 255u) == 0u) { if (xb_ld(&bar[XB_TMO])) break; if (sp > XB_SPIN_CAP) { atomicAdd(&bar[XB_TMO], 1u); break; } }
    }
    nloc = mine > 0u ? mine : 1u; nx = cnt > 0u ? cnt : 1u;
}
__device__ __forceinline__ void xcd_barrier(const XcdBarrier& b) {
    asm volatile("s_waitcnt vmcnt(0)" ::: "memory");
    __syncthreads();
    if (threadIdx.x == 0) {
        unsigned* bar = b.bar;
        __builtin_amdgcn_s_waitcnt(0);
        unsigned nloc = b.st[0], nx = b.st[1];
        if (nloc == 0u) { xcd_barrier_complete(bar, b.x, nloc, nx); b.st[0] = nloc; b.st[1] = nx; }
        const unsigned old = xb_add(&bar[XB_XSUB(b.x)], 1u);
        const unsigned gen = old / nloc;
        if (old + 1u == (gen + 1u) * nloc) {
            __builtin_amdgcn_fence(__ATOMIC_RELEASE, "agent");
            asm volatile("s_waitcnt vmcnt(0)" ::: "memory");
            const unsigned og = xb_add(&bar[XB_TOP], 1u);
            const unsigned tg = og / nx;
            if (og + 1u == (tg + 1u) * nx) xb_add(&bar[XB_TOPGEN], 1u);
            else XB_SPIN(xb_ld(&bar[XB_TOPGEN]) == tg, bar);
            __builtin_amdgcn_fence(__ATOMIC_ACQUIRE, "agent");
            xb_add(&bar[XB_XGEN(b.x)], 1u);
            asm volatile("s_waitcnt vmcnt(0)" ::: "memory");
        } else {
            XB_SPIN(xb_ld(&bar[XB_XGEN(b.x)]) == gen, bar);
            __builtin_amdgcn_fence(__ATOMIC_ACQUIRE, "agent");
            asm volatile("s_waitcnt vmcnt(0)" ::: "memory");
        }
    }
    __syncthreads();
}
namespace pg8 {
#define PG8_LAS __attribute__((address_space(3)))
typedef unsigned short bf16_t;
typedef short bf16x8 __attribute__((ext_vector_type(8)));
typedef float f32x4 __attribute__((ext_vector_type(4)));
typedef unsigned u32x4 __attribute__((ext_vector_type(4)));
constexpr int BM = 256, BK = 64, HALF = 128, HTB = HALF * BK * 2  , STAGE_BYTES = 8 * HTB, NXCD = 8, WGM = 8;

__host__ __device__ __forceinline__ int lds_byte(int r, int c) { const int st = (r >> 4) * 2 + (c >> 5), rr = r & 15, cc = c & 31, ob = rr * 64 + cc * 2; return st * 1024 + (ob ^ (((ob >> 9) & 1) << 5)); }
__host__ __device__ __forceinline__ void stage_rc(int b, int& R, int& C) { const int st = b / 1024, sb = b % 1024, swz = sb ^ (((sb >> 9) & 1) << 5); R = (st >> 1) * 16 + swz / 64; C = (st & 1) * 32 + (swz % 64) / 2; }
__host__ __device__ __forceinline__ int perm32(int rho) { const int n = rho >> 4, i = rho & 15; return 8 * (i >> 2) + 4 * n + (i & 3); }

struct Unit { int pm, pn; };
struct Gemm { const bf16_t* A; const bf16_t* Bt; int M, N, K; };

struct StaticOrder {
    int nM, nN, nwg, G, c;
    __host__ __device__ void init(int M, int N, int G_, int c_) { nM = M / BM; nN = N / BM; nwg = nM * nN; G = G_; c = c_; }
    __host__ __device__ bool next(int i, Unit& u) const {
        const long L = (long)i * G + c; if (L >= nwg) return false;
        int wgid = (int)L; { const int q = nwg / NXCD, r = nwg % NXCD, xcd = wgid % NXCD, off = wgid / NXCD; wgid = (xcd < r ? xcd * (q + 1) : r * (q + 1) + (xcd - r) * q) + off; }
        const int nig = WGM * nN, gid = wgid / nig, fm = gid * WGM, gsz = (nM - fm) < WGM ? (nM - fm) : WGM;
        u.pm = fm + ((wgid % nig) % gsz); u.pn = (wgid % nig) / gsz; return true;
    }
    __device__ __forceinline__ void a_ready(const Unit&) const {}
    __device__ __forceinline__ void done(const Unit&) const {}
};

__device__ __forceinline__ unsigned cvt_pk_bf16(float lo, float hi) { unsigned r; asm volatile("v_cvt_pk_bf16_f32 %0, %1, %2" : "=v"(r) : "v"(lo), "v"(hi)); return r; }
typedef float f32x2 __attribute__((ext_vector_type(2)));
template <class Epi, class Sched, bool ALIGN_EPI = false, bool SP2 = false>
__device__ __forceinline__ void gemm_phase(PG8_LAS unsigned char* lds, const Gemm g, const Sched& S, const Epi& E) {
    const int tid = tid_opaque(), wid = __builtin_amdgcn_readfirstlane(tid >> 6), lane = tid & 63, wr = wid >> 2, wc = wid & 3, fr = lane & 15, fq = lane >> 4;
    const int K = g.K, nt = K / BK;
    unsigned voffA[2], voffB[2];
#pragma unroll
    for (int i = 0; i < 2; ++i) { int R, C; stage_rc(tid * 16 + i * 8192, R, C); const int Rb = Epi::PERM ? ((R & ~31) + perm32(R & 31)) : R;
        voffA[i] = (unsigned)(R * K + C) * 2u; voffB[i] = (unsigned)(Rb * K + C) * 2u; }
    const size_t kstep = (size_t)(BK * 2);
    const size_t hstep = (size_t)HALF * K * 2;
    const size_t tstep = 2 * hstep;
    const unsigned ldsw = (unsigned)wid * 1024u;
    const int aoff = lds_byte(wr * 64 + fr, fq * 8), boff = lds_byte(wc * 32 + fr, fq * 8);
#define PG8_SA(b, h) (((b) * 2 + (h)) * HTB)
#define PG8_SB(b, h) ((4 + (b) * 2 + (h)) * HTB)
#define PG8_STAGE(bufoff, gbase, voff) do { _Pragma("unroll") for (int _i = 0; _i < 2; ++_i) \
        __builtin_amdgcn_global_load_lds((const unsigned*)((const char*)(gbase) + (voff)[_i]), (PG8_LAS unsigned*)(lds + (bufoff) + ldsw + _i * 8192), 16, 0, 0); } while (0)
#define PG8_LDA(dst, b, h) do { _Pragma("unroll") for (int m = 0; m < 4; ++m) _Pragma("unroll") for (int k = 0; k < 2; ++k) dst[m][k] = *(const PG8_LAS bf16x8*)(lds + PG8_SA(b, h) + aoff + m * 2048 + k * 1024); } while (0)
#define PG8_LDB(dst, b, h) do { _Pragma("unroll") for (int n = 0; n < 2; ++n) _Pragma("unroll") for (int k = 0; k < 2; ++k) dst[n][k] = *(const PG8_LAS bf16x8*)(lds + PG8_SB(b, h) + boff + n * 2048 + k * 1024); } while (0)
#define PG8_MMA(ai, bj, At, Bt) do { __builtin_amdgcn_s_setprio(1); _Pragma("unroll") for (int m = 0; m < 4; ++m) _Pragma("unroll") for (int n = 0; n < 2; ++n) _Pragma("unroll") for (int k = 0; k < 2; ++k) \
        acc[ai][bj][m][n] = __builtin_amdgcn_mfma_f32_16x16x32_bf16(Bt[n][k], At[m][k], acc[ai][bj][m][n], 0, 0, 0); __builtin_amdgcn_s_setprio(0); } while (0)
#define PG8_WAIT_V(n) asm volatile("s_waitcnt vmcnt(" #n ")" ::: "memory")
#define PG8_WAIT_L(n) asm volatile("s_waitcnt lgkmcnt(" #n ")" ::: "memory")
#define PG8_BAR __builtin_amdgcn_s_barrier()
#define PG8_SCHED __builtin_amdgcn_sched_barrier(0)
    Unit cur, nxt; int ui = 0;
    if (!S.next(0, cur)) return;
    f32x4 acc[2][2][4][2];
#pragma unroll
    for (int a = 0; a < 2; ++a)
#pragma unroll
        for (int b = 0; b < 2; ++b)
#pragma unroll
            for (int m = 0; m < 4; ++m)
#pragma unroll
                for (int n = 0; n < 2; ++n) acc[a][b][m][n] = (f32x4){0.f, 0.f, 0.f, 0.f};
    bf16x8 At[4][2], B0[2][2], B1[2][2];
    const char* cA = (const char*)g.A + (size_t)cur.pm * tstep; const char* cB = (const char*)g.Bt + (size_t)cur.pn * tstep;
    S.a_ready(cur);
    if constexpr (SP2) {
        PG8_STAGE(PG8_SB(0, 0), cB, voffB); PG8_STAGE(PG8_SB(0, 1), cB + hstep, voffB); PG8_STAGE(PG8_SA(0, 0), cA, voffA); PG8_STAGE(PG8_SA(0, 1), cA + hstep, voffA);
        if (wr == 1) PG8_BAR;
        PG8_WAIT_V(2); PG8_BAR;
        PG8_STAGE(PG8_SB(1, 0), cB + kstep, voffB); PG8_STAGE(PG8_SA(1, 0), cA + kstep, voffA); PG8_STAGE(PG8_SB(1, 1), cB + hstep + kstep, voffB);
        PG8_WAIT_V(6); PG8_BAR;
    } else {
        PG8_STAGE(PG8_SB(0, 0), cB, voffB); PG8_STAGE(PG8_SA(0, 0), cA, voffA); PG8_STAGE(PG8_SB(0, 1), cB + hstep, voffB); PG8_STAGE(PG8_SA(0, 1), cA + hstep, voffA);
        if (wr == 1) PG8_BAR;
        PG8_WAIT_V(4); PG8_BAR;
        PG8_STAGE(PG8_SB(1, 0), cB + kstep, voffB); PG8_STAGE(PG8_SA(1, 0), cA + kstep, voffA); PG8_STAGE(PG8_SB(1, 1), cB + hstep + kstep, voffB);
        PG8_WAIT_V(6); PG8_BAR;
    }
    for (;;) {
        const bool has_next = S.next(ui + 1, nxt);
        const char* nA = has_next ? (const char*)g.A + (size_t)nxt.pm * tstep : cA; const char* nB = has_next ? (const char*)g.Bt + (size_t)nxt.pn * tstep : cB;
        for (int t = 0; t < nt; t += 2) {
            const bool last = (t == nt - 2);
            const char* a1 = cA + (size_t)(t + 1) * kstep;
            const char* a2 = last ? nA : cA + (size_t)(t + 2) * kstep; const char* b2 = last ? nB : cB + (size_t)(t + 2) * kstep;
            const char* a3 = a2 + kstep; const char* b3 = b2 + kstep;
            if (last && has_next) S.a_ready(nxt);
            if constexpr (SP2) {
            PG8_LDB(B0, 0, 0); PG8_LDB(B1, 0, 1); PG8_SCHED; PG8_LDA(At, 0, 0); PG8_STAGE(PG8_SA(1, 1), a1 + hstep, voffA);
            PG8_WAIT_V(8); PG8_WAIT_L(0); PG8_BAR; PG8_MMA(0, 0, At, B0); PG8_MMA(0, 1, At, B1); PG8_BAR; PG8_SCHED;
            PG8_LDA(At, 0, 1); PG8_STAGE(PG8_SB(0, 0), b2, voffB); PG8_STAGE(PG8_SB(0, 1), b2 + hstep, voffB); PG8_STAGE(PG8_SA(0, 0), a2, voffA);
            PG8_WAIT_V(8); PG8_WAIT_L(0); PG8_BAR; PG8_MMA(1, 0, At, B0); PG8_MMA(1, 1, At, B1); PG8_BAR; PG8_SCHED;
            PG8_LDB(B0, 1, 0); PG8_LDB(B1, 1, 1); PG8_SCHED; PG8_LDA(At, 1, 0); PG8_STAGE(PG8_SA(0, 1), a2 + hstep, voffA);
            PG8_WAIT_V(8); PG8_WAIT_L(0); PG8_BAR; PG8_MMA(0, 0, At, B0); PG8_MMA(0, 1, At, B1); PG8_BAR; PG8_SCHED;
            PG8_LDA(At, 1, 1); PG8_STAGE(PG8_SB(1, 0), b3, voffB); PG8_STAGE(PG8_SB(1, 1), b3 + hstep, voffB); PG8_STAGE(PG8_SA(1, 0), a3, voffA);
            PG8_WAIT_V(8); PG8_WAIT_L(0); PG8_BAR; PG8_MMA(1, 0, At, B0); PG8_MMA(1, 1, At, B1); PG8_BAR; PG8_SCHED;
            } else {
            PG8_LDB(B0, 0, 0); PG8_SCHED; PG8_LDA(At, 0, 0); PG8_STAGE(PG8_SA(1, 1), a1 + hstep, voffA);
            PG8_WAIT_L(8); PG8_BAR; PG8_WAIT_L(0); PG8_MMA(0, 0, At, B0); PG8_BAR; PG8_SCHED;
            PG8_LDB(B1, 0, 1); PG8_STAGE(PG8_SB(0, 0), b2, voffB);
            PG8_BAR; PG8_WAIT_L(0); PG8_MMA(0, 1, At, B1); PG8_BAR;
            PG8_LDA(At, 0, 1); PG8_STAGE(PG8_SA(0, 0), a2, voffA);
            PG8_BAR; PG8_WAIT_L(0); PG8_MMA(1, 0, At, B0); PG8_BAR; PG8_SCHED;
            PG8_STAGE(PG8_SB(0, 1), b2 + hstep, voffB);
            PG8_WAIT_V(6); PG8_BAR; PG8_MMA(1, 1, At, B1); PG8_BAR;
            PG8_LDB(B0, 1, 0); PG8_SCHED; PG8_LDA(At, 1, 0); PG8_STAGE(PG8_SA(0, 1), a2 + hstep, voffA);
            PG8_WAIT_L(8); PG8_BAR; PG8_WAIT_L(0); PG8_MMA(0, 0, At, B0); PG8_BAR; PG8_SCHED;
            PG8_LDB(B1, 1, 1); PG8_STAGE(PG8_SB(1, 0), b3, voffB);
            PG8_BAR; PG8_WAIT_L(0); PG8_MMA(0, 1, At, B1); PG8_BAR;
            PG8_LDA(At, 1, 1); PG8_STAGE(PG8_SA(1, 0), a3, voffA);
            PG8_BAR; PG8_WAIT_L(0); PG8_MMA(1, 0, At, B0); PG8_BAR; PG8_SCHED;
            PG8_STAGE(PG8_SB(1, 1), b3 + hstep, voffB);
            PG8_WAIT_V(6); PG8_BAR; PG8_MMA(1, 1, At, B1); PG8_BAR;
            }
        }
        if constexpr (ALIGN_EPI) { if (wr == 0) PG8_BAR; }
        if constexpr (!Epi::AFTER_DRAIN) { E(acc, cur, wr, wc, fr, fq); S.done(cur); }
        if (!has_next) break;
#pragma unroll
        for (int a = 0; a < 2; ++a)
#pragma unroll
            for (int b = 0; b < 2; ++b)
#pragma unroll
                for (int m = 0; m < 4; ++m)
#pragma unroll
                    for (int n = 0; n < 2; ++n) acc[a][b][m][n] = (f32x4){0.f, 0.f, 0.f, 0.f};
        cur = nxt; cA = nA; cB = nB; ++ui;
        if constexpr (ALIGN_EPI) { if (wr == 1) PG8_BAR; }
    }
    PG8_WAIT_V(0);
    if constexpr (!ALIGN_EPI) { if (wr == 0) PG8_BAR; }
    PG8_BAR;
    if constexpr (Epi::AFTER_DRAIN) { E.fused(acc, cur, wr, wc, fr, fq, lds, wid, lane); S.done(cur); }
#undef PG8_SA
#undef PG8_SB
#undef PG8_STAGE
#undef PG8_LDA
#undef PG8_LDB
#undef PG8_MMA
#undef PG8_WAIT_V
#undef PG8_WAIT_L
#undef PG8_BAR
#undef PG8_SCHED
}
}
constexpr size_t WB_AB = 2 * MiB, WB_OUTAB = 8 * MiB, WB_FFI0 = 10 * MiB, WB_FFO0 = 21 * MiB, WB_INC = 27 * MiB, WB_OUTC = 30 * MiB, WB_FFI1 = 32 * MiB, WB_FFO1 = 43 * MiB;
static_assert(WB_FFO1 + (size_t)DM * DFF * 2 <= WS_XN && WB_AB + (size_t)ABMAIN * DM * 2 <= WB_OUTAB && WB_FFI0 + (size_t)2 * DFF * DM * 2 <= WB_FFO0 && WB_FFO0 + (size_t)DM * DFF * 2 <= WB_INC &&
              WB_INC + (size_t)CIN * DM * 2 <= WB_OUTC && WB_FFI1 + (size_t)2 * DFF * DM * 2 <= WB_FFO1, "weight copy map");

typedef unsigned v4u __attribute__((ext_vector_type(4)));
typedef unsigned v2u __attribute__((ext_vector_type(2)));
typedef float f32x4 __attribute__((ext_vector_type(4)));
__device__ __forceinline__ unsigned pk2(float lo, float hi) { return (unsigned)f2bf(lo) | ((unsigned)f2bf(hi) << 16); }
__device__ __forceinline__ float fsigmoid(float x) { return __builtin_amdgcn_rcpf(1.0f + __builtin_amdgcn_exp2f(-1.4426950408889634f * x)); }

__device__ __forceinline__ void p0_transpose_item(const float* W, int K, int ldw, int c0, int k0, bf16_t* WT, int drow, LAS float* scr, int lane) {
#pragma unroll 8
    for (int i = 0; i < 32; ++i) { const int kk = 2 * i + (lane >> 5); scr[kk * 33 + (lane & 31)] = W[(size_t)(k0 + kk) * ldw + c0 + (lane & 31)]; }
    asm volatile("s_waitcnt lgkmcnt(0)" ::: "memory");
    const int c = lane & 7;
#pragma unroll
    for (int j = 0; j < 4; ++j) { const int n = (lane >> 3) + 8 * j; const LAS float* s = scr + (8 * c) * 33 + n;
        v4u o; o.x = pk2(s[0 * 33], s[1 * 33]); o.y = pk2(s[2 * 33], s[3 * 33]); o.z = pk2(s[4 * 33], s[5 * 33]); o.w = pk2(s[6 * 33], s[7 * 33]);
        *(GAS v4u*)(WT + (size_t)(drow + n) * K + k0 + 8 * c) = o; }
    asm volatile("s_waitcnt lgkmcnt(0)" ::: "memory");
}
struct CvtJob { const float* W; bf16_t* WT; int K, ldw, c0, ncols, mode, Hn, dbase; };
__device__ __forceinline__ int cvt_items(const CvtJob& j) { return (j.K / 64) * (j.ncols / 32); }
__device__ __forceinline__ void cvt_run(const CvtJob& j, int item, LAS float* scr, int lane) {
    const int nblk = j.ncols / 32, kb = item / nblk, nb = item % nblk; const int c = j.c0 + 32 * nb;
    int drow; if (j.mode == 0) drow = j.dbase + 32 * nb; else { const int cc = c < j.Hn ? c : c - j.Hn; drow = 256 * (cc / 128) + (cc % 128) + (c < j.Hn ? 0 : 128); }
    p0_transpose_item(j.W, j.K, j.ldw, c, 64 * kb, j.WT, drow, scr, lane);
}
__device__ __forceinline__ void p0_weights(const Params& p, LAS unsigned char* lds, int vcu, int G) {
    const int tid_ = tid_opaque(); const int lane = tid_ & 63, wave = __builtin_amdgcn_readfirstlane(tid_ >> 6);
    LAS float* scr = (LAS float*)(lds + wave * 16384);
    const int gw = vcu * NWAVES + wave, NGW = G * NWAVES;
    CvtJob jobs[9] = {
        {p.winab, (bf16_t*)(p.ws + WB_AB), DM, ABIN, 0, 2 * CCH, 1, CCH, 0},
        {p.winab, (bf16_t*)(p.ws + WB_AB), DM, ABIN, 2 * CCH, 4 * MW, 0, 0, 2 * CCH},
        {p.woutab, (bf16_t*)(p.ws + WB_OUTAB), DM, DM, 0, DM, 0, 0, 0},
        {p.wffi, (bf16_t*)(p.ws + WB_FFI0), DM, 2 * DFF, 0, 2 * DFF, 1, DFF, 0},
        {p.wffo, (bf16_t*)(p.ws + WB_FFO0), DFF, DM, 0, DM, 0, 0, 0},
        {p.winc, (bf16_t*)(p.ws + WB_INC), DM, CIN, 0, CIN, 0, 0, 0},
        {p.woutc, (bf16_t*)(p.ws + WB_OUTC), DM, DM, 0, DM, 0, 0, 0},
        {p.wffi + (size_t)DM * 2 * DFF, (bf16_t*)(p.ws + WB_FFI1), DM, 2 * DFF, 0, 2 * DFF, 1, DFF, 0},
        {p.wffo + (size_t)DFF * DM, (bf16_t*)(p.ws + WB_FFO1), DFF, DM, 0, DM, 0, 0, 0}};
    int base = 0;
#pragma unroll
    for (int jj = 0; jj < 9; ++jj) {
        const int n = cvt_items(jobs[jj]);
        int first = ((gw - base) % NGW + NGW) % NGW;
        for (int it = first; it < n; it += NGW) cvt_run(jobs[jj], it, scr, lane);
        base += n;
    }
}

struct EpiAB {
    static constexpr bool PERM = true, AFTER_DRAIN = false;
    bf16_t* upre; bf16_t* qkvo;
    __device__ __forceinline__ void operator()(const f32x4 (&acc)[2][2][4][2], const pg8::Unit& u, int wr, int wc, int fr, int fq) const {
        const int row0 = u.pm * 256 + wr * 64 + fr, lc = wc * 32 + 8 * fq;
        if (u.pn < 4) {
#pragma unroll
            for (int ai = 0; ai < 2; ++ai)
#pragma unroll
                for (int m = 0; m < 4; ++m) { const f32x4 a0 = acc[ai][0][m][0], a1 = acc[ai][0][m][1], g0 = acc[ai][1][m][0], g1 = acc[ai][1][m][1]; v4u w;
                    w.x = pg8::cvt_pk_bf16(a0[0] * fsigmoid(g0[0]), a0[1] * fsigmoid(g0[1])); w.y = pg8::cvt_pk_bf16(a0[2] * fsigmoid(g0[2]), a0[3] * fsigmoid(g0[3]));
                    w.z = pg8::cvt_pk_bf16(a1[0] * fsigmoid(g1[0]), a1[1] * fsigmoid(g1[1])); w.w = pg8::cvt_pk_bf16(a1[2] * fsigmoid(g1[2]), a1[3] * fsigmoid(g1[3]));
                    *(v4u*)(upre + (size_t)(row0 + ai * 128 + m * 16) * CCH + 128 * u.pn + lc) = w; }
        } else {
#pragma unroll
            for (int bj = 0; bj < 2; ++bj) { const int col = 256 * (u.pn - 4) + 128 * bj + lc; const int part = col / MW; const float sc = part == 1 ? 0.08838834764831845f : 1.0f;
#pragma unroll
                for (int ai = 0; ai < 2; ++ai)
#pragma unroll
                    for (int m = 0; m < 4; ++m) { f32x4 v0 = acc[ai][bj][m][0] * sc, v1 = acc[ai][bj][m][1] * sc;
                        if (part == 3) { v0 = (f32x4){fsigmoid(v0[0]), fsigmoid(v0[1]), fsigmoid(v0[2]), fsigmoid(v0[3])}; v1 = (f32x4){fsigmoid(v1[0]), fsigmoid(v1[1]), fsigmoid(v1[2]), fsigmoid(v1[3])}; }
                        v4u w; w.x = pg8::cvt_pk_bf16(v0[0], v0[1]); w.y = pg8::cvt_pk_bf16(v0[2], v0[3]); w.z = pg8::cvt_pk_bf16(v1[0], v1[1]); w.w = pg8::cvt_pk_bf16(v1[2], v1[3]);
                        *(v4u*)(qkvo + (size_t)(row0 + ai * 128 + m * 16) * (4 * MW) + col) = w; } }
        }
    }
};
static_assert(MDK == 128, "EpiAB hard-codes MDK^-0.5");
struct EpiRes {
    static constexpr bool PERM = false, AFTER_DRAIN = false;
    const float* xp; const float* xs;
    float* Y; bf16_t* XN; float* ssq; const float* mod_g; const float* mod_sc; const float* ng;
    int from_input; int pad_;
    __device__ __forceinline__ void operator()(const f32x4 (&acc)[2][2][4][2], const pg8::Unit& u, int wr, int wc, int fr, int fq) const {
        const int row0 = u.pm * 256 + wr * 64 + fr; const int cls = cls_of(u.pm * 256);
        const float* xin = from_input ? (u.pm * 256 < MC ? xp : xs - (size_t)MC * DM) : Y;
        const float* gv = mod_g + (size_t)cls * 6 * DM; const float* scv = mod_sc + (size_t)cls * 6 * DM;
        float sq[2][4];
#pragma unroll
        for (int ai = 0; ai < 2; ++ai)
#pragma unroll
            for (int m = 0; m < 4; ++m) sq[ai][m] = 0.f;
#pragma unroll
        for (int bj = 0; bj < 2; ++bj)
#pragma unroll
            for (int n = 0; n < 2; ++n) { const int col = u.pn * 256 + bj * 128 + wc * 32 + n * 16 + 4 * fq;
                const f32x4 g4 = *(const f32x4*)(gv + col); f32x4 gs4 = (f32x4){0.f, 0.f, 0.f, 0.f};
                if (ng) { const f32x4 n4 = *(const f32x4*)(ng + col), s4 = *(const f32x4*)(scv + col); gs4 = n4 * (s4 + 1.0f); }
#pragma unroll
                for (int ai = 0; ai < 2; ++ai)
#pragma unroll
                    for (int m = 0; m < 4; ++m) { const size_t off = (size_t)(row0 + ai * 128 + m * 16) * DM + col;
                        const f32x4 xi = *(const f32x4*)(xin + off); const f32x4 xn = xi + g4 * acc[ai][bj][m][n];
                        *(f32x4*)(Y + off) = xn; sq[ai][m] += (xn[0] * xn[0] + xn[1] * xn[1]) + (xn[2] * xn[2] + xn[3] * xn[3]);
                        if (ng) { const f32x4 t = xn * gs4; v2u w; w.x = pg8::cvt_pk_bf16(t[0], t[1]); w.y = pg8::cvt_pk_bf16(t[2], t[3]); *(v2u*)(XN + off) = w; } } }
#pragma unroll
        for (int ai = 0; ai < 2; ++ai)
#pragma unroll
            for (int m = 0; m < 4; ++m) { float s = sq[ai][m]; s += __shfl_xor(s, 16); s += __shfl_xor(s, 32);
                if (fq == 0) atomicAdd(ssq + row0 + ai * 128 + m * 16, s); }
    }
};
struct EpiFfnIn {
    static constexpr bool PERM = true, AFTER_DRAIN = false;
    bf16_t* H; const float* ssq; const float* sw;
    __device__ __forceinline__ void operator()(const f32x4 (&acc)[2][2][4][2], const pg8::Unit& u, int wr, int wc, int fr, int fq) const {
        const int row0 = u.pm * 256 + wr * 64 + fr, lc = wc * 32 + 8 * fq; const int cls = cls_of(u.pm * 256); const int col = 128 * u.pn + lc;
        const float* swr = sw + (size_t)cls * 2 * DFF;
        const f32x4 sg0 = *(const f32x4*)(swr + col), sg1 = *(const f32x4*)(swr + col + 4), su0 = *(const f32x4*)(swr + DFF + col), su1 = *(const f32x4*)(swr + DFF + col + 4);
#pragma unroll
        for (int ai = 0; ai < 2; ++ai)
#pragma unroll
            for (int m = 0; m < 4; ++m) { const int row = row0 + ai * 128 + m * 16; const float rs = 1.0f / sqrtf(ssq[row] * (1.0f / DM) + EPSF);
                const f32x4 a0 = acc[ai][0][m][0] * rs + sg0, a1 = acc[ai][0][m][1] * rs + sg1, b0 = acc[ai][1][m][0] * rs + su0, b1 = acc[ai][1][m][1] * rs + su1; v4u w;
                w.x = pg8::cvt_pk_bf16(a0[0] * fsigmoid(a0[0]) * b0[0], a0[1] * fsigmoid(a0[1]) * b0[1]); w.y = pg8::cvt_pk_bf16(a0[2] * fsigmoid(a0[2]) * b0[2], a0[3] * fsigmoid(a0[3]) * b0[3]);
                w.z = pg8::cvt_pk_bf16(a1[0] * fsigmoid(a1[0]) * b1[0], a1[1] * fsigmoid(a1[1]) * b1[1]); w.w = pg8::cvt_pk_bf16(a1[2] * fsigmoid(a1[2]) * b1[2], a1[3] * fsigmoid(a1[3]) * b1[3]);
                *(v4u*)(H + (size_t)row * DFF + col) = w; }
    }
};
struct EpiQkv {
    static constexpr bool PERM = true, AFTER_DRAIN = false;
    bf16_t* qraw; bf16_t* kraw; bf16_t* ctxv; bf16_t* latv; float* outv; const float* ssq; const float* sw;
    __device__ __forceinline__ void operator()(const f32x4 (&acc)[2][2][4][2], const pg8::Unit& u, int wr, int wc, int fr, int fq) const {
        const int row0 = u.pm * 256 + wr * 64 + fr, lc = wc * 32 + 8 * fq; const int cls = cls_of(u.pm * 256); const float* swr = sw + (size_t)cls * CIN;
        float rs[2][4];
#pragma unroll
        for (int ai = 0; ai < 2; ++ai)
#pragma unroll
            for (int m = 0; m < 4; ++m) rs[ai][m] = 1.0f / sqrtf(ssq[row0 + ai * 128 + m * 16] * (1.0f / DM) + EPSF);
#pragma unroll
        for (int bj = 0; bj < 2; ++bj) { const int col = 256 * u.pn + 128 * bj + lc; const f32x4 s0 = *(const f32x4*)(swr + col), s1 = *(const f32x4*)(swr + col + 4);
#pragma unroll
            for (int ai = 0; ai < 2; ++ai)
#pragma unroll
                for (int m = 0; m < 4; ++m) { const int row = row0 + ai * 128 + m * 16; const f32x4 v0 = acc[ai][bj][m][0] * rs[ai][m] + s0, v1 = acc[ai][bj][m][1] * rs[ai][m] + s1;
                    v4u w; w.x = pg8::cvt_pk_bf16(v0[0], v0[1]); w.y = pg8::cvt_pk_bf16(v0[2], v0[3]); w.z = pg8::cvt_pk_bf16(v1[0], v1[1]); w.w = pg8::cvt_pk_bf16(v1[2], v1[3]);
                    if (u.pn < NQ * HDIM / 256) *(v4u*)(qraw + (size_t)row * (NQ * HDIM) + col) = w;
                    else if (u.pn == NQ * HDIM / 256) *(v4u*)(kraw + (size_t)row * (NKV * HDIM) + (col - NQ * HDIM)) = w;
                    else { const int c2 = col - (NQ + NKV) * HDIM;
                        if (row < MC) { *(v4u*)(ctxv + (size_t)row * (NKV * HDIM) + c2) = w; float* o = outv + (size_t)row * (NKV * HDIM) + c2; *(f32x4*)o = v0; *(f32x4*)(o + 4) = v1; }
                        else { const int b = (row - MC) / LSEQ, s = (row - MC) % LSEQ; *(v4u*)(latv + ((size_t)b * SKVL + s) * (NKV * HDIM) + c2) = w; } } } }
    }
};
static_assert(NKV * HDIM == 256 && (NQ * HDIM) % 256 == 0, "EpiQkv tile mapping");
namespace att {
typedef unsigned short bf16;
constexpr int D = 128, NW = 8, QBLK = 32, KVBLK = 64; constexpr float SCALE = 0.088388347648318440f; constexpr float THR = 8.f; constexpr int SDEPTH = 1;
constexpr int LDQ = NQ * HDIM, LDK = NKV * HDIM, LDO = DM;
constexpr size_t SHM_V = KVBLK * D * 2, SHM_K = KVBLK * D * 2, SHM_ATTN = 2 * SHM_V + 2 * SHM_K + NW * 64 * 4;
using bf16x8 = __attribute__((ext_vector_type(8))) short;
using s16x4  = __attribute__((ext_vector_type(4))) short;
using f32x16 = __attribute__((ext_vector_type(16))) float;
using f32x8  = __attribute__((ext_vector_type(8))) float;
using u32x4  = __attribute__((ext_vector_type(4))) unsigned;
#define KSWZ(row, colB) ((row) * 256 + ((colB) ^ (((row) & 7) << 4)))
#define SBAR() __builtin_amdgcn_sched_barrier(0)
__device__ __forceinline__ int crow(int r, int hi) { return (r & 3) + 8 * (r >> 2) + 4 * hi; }
__device__ __forceinline__ unsigned cvtpk(float lo, float hi) {
  unsigned r; asm volatile("v_cvt_pk_bf16_f32 %0, %1, %2" : "=v"(r) : "v"(lo), "v"(hi)); return r;
}
template <typename TIn> struct Stage;
template <> struct Stage<bf16>  { using T = bf16x8;
  __device__ static __forceinline__ T ld8(const bf16* p) { return *reinterpret_cast<const bf16x8*>(p); }
  __device__ static __forceinline__ bf16x8 tobf(T x) { return x; } };
__device__ __forceinline__ void partialSM(f32x16& p0, f32x16& p1, float& m_reg, float& mn, float& alpha) {
  constexpr float C = SCALE * 1.4426950408889634f;
  float pmax = p0[0]; for (int r = 1; r < 16; ++r) pmax = fmaxf(pmax, p0[r]); for (int r = 0; r < 16; ++r) pmax = fmaxf(pmax, p1[r]);
  { auto rr = __builtin_amdgcn_permlane32_swap(__float_as_uint(pmax), __float_as_uint(pmax), false, false);
    pmax = fmaxf(__uint_as_float(rr[0]), __uint_as_float(rr[1])); }
  if (__builtin_expect(__all(pmax - m_reg <= THR / SCALE), 1)) { mn = m_reg; alpha = 1.f; }
  else { mn = fmaxf(m_reg, pmax); alpha = __builtin_amdgcn_exp2f((m_reg - mn) * C); m_reg = mn; }
  float mnC = -mn * C;
  for (int r = 0; r < 16; ++r) p0[r] = fmaf(p0[r], C, mnC); for (int r = 0; r < 16; ++r) p1[r] = fmaf(p1[r], C, mnC);
  for (int r = 0; r < 16; ++r) p0[r] = __builtin_amdgcn_exp2f(p0[r]);
}
__device__ __forceinline__ void finishSM(f32x16& p0, f32x16& p1, float alpha, float& l_reg, bf16x8& pa0, bf16x8& pa1, bf16x8& pa2, bf16x8& pa3) {
  for (int r = 0; r < 16; ++r) p1[r] = __builtin_amdgcn_exp2f(p1[r]);
  float ps = 0; for (int r = 0; r < 16; ++r) ps += p0[r]; for (int r = 0; r < 16; ++r) ps += p1[r];
  { auto rr = __builtin_amdgcn_permlane32_swap(__float_as_uint(ps), __float_as_uint(ps), false, false);
    ps = __uint_as_float(rr[0]) + __uint_as_float(rr[1]); }
  l_reg = l_reg * alpha + ps;
#define PK4(P, BASE, OUT) do { unsigned a0 = cvtpk(P[BASE + 0], P[BASE + 1]), a1 = cvtpk(P[BASE + 2], P[BASE + 3]);   \
    unsigned b0 = cvtpk(P[BASE + 4], P[BASE + 5]), b1 = cvtpk(P[BASE + 6], P[BASE + 7]);                              \
    auto r0 = __builtin_amdgcn_permlane32_swap(a0, b0, false, false); auto r1 = __builtin_amdgcn_permlane32_swap(a1, b1, false, false); \
    u32x4 w = {r0[0], r1[0], r0[1], r1[1]}; OUT = *reinterpret_cast<bf16x8*>(&w); } while (0)
  PK4(p0, 0, pa0); PK4(p0, 8, pa1); PK4(p1, 0, pa2); PK4(p1, 8, pa3);
#undef PK4
}
__device__ __forceinline__ void qkt(f32x16& p0, f32x16& p1, const bf16* Ks, const bf16x8* qr, int r32, int hi) {
  p0 = f32x16{}; p1 = f32x16{};
  for (int d0 = 0; d0 < 8; ++d0) { int cb = (d0 * 16 + hi * 8) * 2;
    bf16x8 b0 = *reinterpret_cast<const bf16x8*>((const char*)Ks + KSWZ(r32, cb));
    bf16x8 b1 = *reinterpret_cast<const bf16x8*>((const char*)Ks + KSWZ(32 + r32, cb));
    p0 = __builtin_amdgcn_mfma_f32_32x32x16_bf16(b0, qr[d0], p0, 0, 0, 0);
    p1 = __builtin_amdgcn_mfma_f32_32x32x16_bf16(b1, qr[d0], p1, 0, 0, 0); }
}
__device__ __forceinline__ int v_st(int k, int c) { const int kk = (k & ~0xC) | ((k & 4) << 1) | ((k & 8) >> 1); return ((kk >> 3) * 4 + (c >> 5)) * 512 + ((kk & 7) * 32 + (c & 31)) * 2; }
__device__ __forceinline__ int v_rd_base(int lane) { return ((lane & 3) << 3) | (((lane >> 2) & 3) << 6) | (((lane >> 4) & 1) << 5) | (((lane >> 5) & 1) << 8); }
constexpr int v_rd_off(int d0, int ks, int half) { return d0 * 512 + ks * 4096 + half * 2048; }
template <int OFF> __device__ __forceinline__ s16x4 tr_read(int vb) {
  s16x4 r; asm volatile("ds_read_b64_tr_b16 %0, %1 offset:%2" : "=&v"(r) : "v"(vb), "i"(OFF) : "memory"); return r;
}
template <int D0> __device__ __forceinline__ void pv_one(f32x16& od, int vb, bf16x8 pa0, bf16x8 pa1, bf16x8 pa2, bf16x8 pa3) {
  const s16x4 l0 = tr_read<v_rd_off(D0, 0, 0)>(vb), h0 = tr_read<v_rd_off(D0, 0, 1)>(vb), l1 = tr_read<v_rd_off(D0, 1, 0)>(vb), h1 = tr_read<v_rd_off(D0, 1, 1)>(vb);
  const s16x4 l2 = tr_read<v_rd_off(D0, 2, 0)>(vb), h2 = tr_read<v_rd_off(D0, 2, 1)>(vb), l3 = tr_read<v_rd_off(D0, 3, 0)>(vb), h3 = tr_read<v_rd_off(D0, 3, 1)>(vb);
  asm volatile("s_waitcnt lgkmcnt(0)" ::: "memory"); SBAR();
#define PK(L, H) (bf16x8){L[0], L[1], L[2], L[3], H[0], H[1], H[2], H[3]}
  od = __builtin_amdgcn_mfma_f32_32x32x16_bf16(pa0, PK(l0, h0), od, 0, 0, 0);
  od = __builtin_amdgcn_mfma_f32_32x32x16_bf16(pa1, PK(l1, h1), od, 0, 0, 0);
  od = __builtin_amdgcn_mfma_f32_32x32x16_bf16(pa2, PK(l2, h2), od, 0, 0, 0);
  od = __builtin_amdgcn_mfma_f32_32x32x16_bf16(pa3, PK(l3, h3), od, 0, 0, 0);
#undef PK
}
__device__ __forceinline__ void pv_d0(f32x16* o, int vb, bf16x8 pa0, bf16x8 pa1, bf16x8 pa2, bf16x8 pa3) {
  pv_one<0>(o[0], vb, pa0, pa1, pa2, pa3); pv_one<1>(o[1], vb, pa0, pa1, pa2, pa3); pv_one<2>(o[2], vb, pa0, pa1, pa2, pa3); pv_one<3>(o[3], vb, pa0, pa1, pa2, pa3);
}

__device__ __forceinline__ void attn_dense_body(const bf16* __restrict__ Qb, const bf16* __restrict__ Kh, const bf16* __restrict__ Vh,
                                                bf16* __restrict__ Ob, int seq, char* lds) {
  typedef bf16 TQ;
  using St = Stage<bf16>; using SQ = Stage<TQ>;
  const int tid = tid_opaque(), wid = tid >> 6, lane = tid & 63, r32 = lane & 31, hi = lane >> 5;
  bf16* V_lds = (bf16*)lds; bf16* K_lds = (bf16*)(lds + 2 * SHM_V);
  float* ws = (float*)(lds + 2 * SHM_V + 2 * SHM_K) + wid * 64; float* li_l = ws; float* al_l = ws + 32;
  float m_reg = -1e30f, l_reg = 0; f32x16 o[4] = {}; bf16x8 qr[8];
  const TQ* Qw = Qb + (long)(wid * QBLK + r32) * LDQ + hi * 8;
#pragma unroll
  for (int d0 = 0; d0 < 8; ++d0) qr[d0] = SQ::tobf(SQ::ld8(Qw + d0 * 16));
  const int sr = tid >> 4, sc = (tid & 15) * 8, vst0 = v_st(sr, sc), vst1 = v_st(32 + sr, sc);
  const int vb0 = (int)(uintptr_t)V_lds + v_rd_base(lane);
  struct { typename St::T vs0, vs1, ks0, ks1; } sr_[SDEPTH];
#define SLOAD(i, k0) do { sr_[i].vs0 = St::ld8(&Vh[(long)((k0) + sr) * LDK + sc]); sr_[i].vs1 = St::ld8(&Vh[(long)((k0) + 32 + sr) * LDK + sc]); \
    sr_[i].ks0 = St::ld8(&Kh[(long)((k0) + sr) * LDK + sc]); sr_[i].ks1 = St::ld8(&Kh[(long)((k0) + 32 + sr) * LDK + sc]); } while (0)
#define SWRITE(b, i) do { *(bf16x8*)((char*)V_lds + (b) * SHM_V + vst0) = St::tobf(sr_[i].vs0);          \
    *(bf16x8*)((char*)V_lds + (b) * SHM_V + vst1) = St::tobf(sr_[i].vs1); int kc = sc * 2;               \
    *(bf16x8*)((char*)K_lds + (b) * SHM_K + KSWZ(sr, kc)) = St::tobf(sr_[i].ks0);                       \
    *(bf16x8*)((char*)K_lds + (b) * SHM_K + KSWZ(32 + sr, kc)) = St::tobf(sr_[i].ks1); } while (0)
#define SWAIT() do { if constexpr (SDEPTH == 2) asm volatile("s_waitcnt vmcnt(4)" ::: "memory"); else asm volatile("s_waitcnt vmcnt(0)" ::: "memory"); } while (0)
#define RESC(a) do { if (__any((a) < 1.f)) { if (hi == 0) al_l[r32] = (a); asm volatile("s_waitcnt lgkmcnt(0)" ::: "memory"); \
    for (int d = 0; d < 4; ++d) for (int r = 0; r < 16; ++r) o[d][r] *= al_l[crow(r, hi)]; } } while (0)
  f32x16 pA0, pA1, pB0, pB1; float mnA, mnB, alA, alB; bf16x8 pa0, pa1, pa2, pa3; const int NT = seq / KVBLK;
  constexpr int SE = 0, SO = SDEPTH - 1;
  SLOAD(SE, 0); asm volatile("s_waitcnt vmcnt(0)" ::: "memory"); SWRITE(0, SE); __syncthreads();
  qkt(pA0, pA1, K_lds, qr, r32, hi); partialSM(pA0, pA1, m_reg, mnA, alA);
  SLOAD(SO, KVBLK); if constexpr (SDEPTH == 2) { if (2 < NT) SLOAD(SE, 2 * KVBLK); }
  SWAIT(); SWRITE(1, SO); __syncthreads();
  for (int j = 1; j + 1 < NT; j += 2) {
    SBAR(); qkt(pB0, pB1, (bf16*)((char*)K_lds + SHM_K), qr, r32, hi);
    finishSM(pA0, pA1, alA, l_reg, pa0, pa1, pa2, pa3); SBAR();
    SLOAD(SO, (j + SDEPTH) * KVBLK); SBAR();
    pv_d0(o, vb0, pa0, pa1, pa2, pa3); partialSM(pB0, pB1, m_reg, mnB, alB);
    __syncthreads(); SWAIT(); SWRITE(0, SE);
    RESC(alB); __syncthreads();
    SBAR(); qkt(pA0, pA1, K_lds, qr, r32, hi);
    finishSM(pB0, pB1, alB, l_reg, pa0, pa1, pa2, pa3); SBAR();
    if (SDEPTH == 1 || j + 3 < NT) SLOAD(SE, (j + 1 + SDEPTH) * KVBLK); SBAR();
    pv_d0(o, vb0 + (int)SHM_V, pa0, pa1, pa2, pa3); partialSM(pA0, pA1, m_reg, mnA, alA);
    __syncthreads(); SWAIT(); SWRITE(1, SO);
    RESC(alA); __syncthreads();
  }
  SBAR(); qkt(pB0, pB1, (bf16*)((char*)K_lds + SHM_K), qr, r32, hi);
  finishSM(pA0, pA1, alA, l_reg, pa0, pa1, pa2, pa3); SBAR();
  pv_d0(o, vb0, pa0, pa1, pa2, pa3); partialSM(pB0, pB1, m_reg, mnB, alB);
  __syncthreads(); RESC(alB);
  finishSM(pB0, pB1, alB, l_reg, pa0, pa1, pa2, pa3); SBAR();
  pv_d0(o, vb0 + (int)SHM_V, pa0, pa1, pa2, pa3);
  if (hi == 0) li_l[r32] = l_reg; asm volatile("s_waitcnt lgkmcnt(0)" ::: "memory");
  float rli[16];
#pragma unroll
  for (int r = 0; r < 16; ++r) rli[r] = __builtin_amdgcn_rcpf(li_l[crow(r, hi)]);
  bf16* Ow = Ob + (long)(wid * QBLK) * LDO;
#pragma unroll
  for (int r = 0; r < 16; ++r) { int orow = crow(r, hi);
    for (int d0 = 0; d0 < 4; ++d0) Ow[(long)orow * LDO + d0 * 32 + r32] = f2bf(o[d0][r] * rli[r]); }
#undef SLOAD
#undef SWRITE
#undef SWAIT
#undef RESC
}
}
__device__ __forceinline__ void attn_phase(const Params& p, unsigned char* lds, int vcu, int G) {
    constexpr int QB = 256, LQB = LSEQ / QB, CQB = CSEQ / QB;
    constexpr int NUL = NLB * NQ * LQB, NUC = NCB * NQ * CQB, NU = NUL + NUC;
    const att::bf16* QR = (const att::bf16*)(p.ws + WS_QRAW); att::bf16* OB = (att::bf16*)(p.ws + WS_O);
    for (int i = 0;; ++i) {
        int u;
        if (G == 256 && NUL == 512) { if (i < 2) u = (vcu >> 5) * 64 + (vcu & 31) + 32 * i; else u = NUL + vcu + (i - 2) * G; }
        else u = vcu + i * G;
        if (u >= NU) break;
        const att::bf16 *Q, *K, *V; att::bf16* O; int seq;
        if (u < NUL) { const int grp = u / (GRP * LQB), j = u % (GRP * LQB); const int b = grp / NKV, kvh = grp % NKV, g = j / LQB, qb = j % LQB, hq = kvh * GRP + g;
            const size_t row0 = (size_t)MC + (size_t)b * LSEQ + (size_t)qb * QB;
            Q = QR + row0 * (NQ * HDIM) + hq * HDIM; O = OB + row0 * DM + hq * HDIM;
            K = (const att::bf16*)(p.ws + WS_LATK) + (size_t)b * SKVL * (NKV * HDIM) + kvh * HDIM; V = (const att::bf16*)(p.ws + WS_LATV) + (size_t)b * SKVL * (NKV * HDIM) + kvh * HDIM; seq = SKVL; }
        else { const int uc = u - NUL; const int b = uc / (NQ * CQB), r = uc % (NQ * CQB), hq = r / CQB, qb = r % CQB, kvh = hq / GRP;
            const size_t row0 = (size_t)b * CSEQ + (size_t)qb * QB;
            Q = QR + row0 * (NQ * HDIM) + hq * HDIM; O = OB + row0 * DM + hq * HDIM;
            K = (const att::bf16*)(p.ws + WS_CTXK) + (size_t)b * CSEQ * (NKV * HDIM) + kvh * HDIM; V = (const att::bf16*)(p.ws + WS_CTXV) + (size_t)b * CSEQ * (NKV * HDIM) + kvh * HDIM; seq = CSEQ; }
        __syncthreads();
        att::attn_dense_body(Q, K, V, O, seq, (char*)lds);
    }
}
static_assert(SKVL % 128 == 0 && CSEQ % 128 == 0 && LSEQ % 256 == 0 && CSEQ % 256 == 0, "attention tiling");
constexpr size_t WS_CST = 232 * MiB;
constexpr int NBLK = LSEQ / 256;
constexpr size_t WS_NST = WS_CST + (size_t)NLB * MH * 2 * NBLK * MDK * MDK * 2;
constexpr size_t WS_FTOT = WS_NST + (size_t)NLB * MH * 2 * NBLK * MDK * 4;
static_assert(WS_FTOT + (size_t)NLB * MH * 2 * NBLK * 4 <= WS_END && MDK == 128 && CSEQ == 256 && LSEQ % 256 == 0, "mLSTM fast path geometry");
namespace att {
constexpr int ML_OFF = 132096;
constexpr int ML_SC = ML_OFF + 6144;
constexpr int ML_N = ML_SC + 128;
constexpr int ML_LI = ML_N + 1024;
static_assert(ML_LI + 1024 <= LDS_BYTES, "mLSTM LDS map");
constexpr float L2E = 1.4426950408889634f;
using f32x4v = __attribute__((ext_vector_type(4))) float;
template <int M> __device__ __forceinline__ float swz_xor(float v) { return __int_as_float(__builtin_amdgcn_ds_swizzle(__float_as_int(v), (M << 10) | 0x1f)); }
__device__ __forceinline__ float half_sum(float v) { auto rr = __builtin_amdgcn_permlane32_swap(__float_as_uint(v), __float_as_uint(v), false, false); return __uint_as_float(rr[0]) + __uint_as_float(rr[1]); }
__device__ __forceinline__ float half_max(float v) { auto rr = __builtin_amdgcn_permlane32_swap(__float_as_uint(v), __float_as_uint(v), false, false); return fmaxf(__uint_as_float(rr[0]), __uint_as_float(rr[1])); }
__device__ __forceinline__ float lane_get(float v, int src_lane) { return __int_as_float(__builtin_amdgcn_ds_bpermute(src_lane << 2, __float_as_int(v))); }

__device__ __forceinline__ void ml_gates(const Params& p, char* lds, int row0, int h, int tid) {
    float* A = (float*)(lds + ML_OFF); float* S = (float*)(lds + ML_SC);
    const int half = tid >> 8, t = tid & 255, tok = half ? 255 - t : t, lane = tid & 63, wv = (tid >> 6) & 3;
    const float* G = (const float*)(p.ws + WS_GATES) + (size_t)(row0 + tok) * NGATE + half * 8 + h;
    const float ig = G[0], lf = G[4];
    float v = lf;
#pragma unroll
    for (int off = 1; off < 64; off <<= 1) { const float u = lane_get(v, lane - off); if (lane >= off) v += u; }
    if (lane == 63) S[4 + half * 4 + wv] = v;
    __syncthreads();
    float pre = 0.f, tot = 0.f;
#pragma unroll
    for (int w = 0; w < 4; ++w) { const float x = S[4 + half * 4 + w]; if (w < wv) pre += x; tot += x; }
    const float P = v + pre, a = ig - P;
    A[(0 + half) * 256 + tok] = P * L2E; A[(2 + half) * 256 + tok] = a * L2E; A[(4 + half) * 256 + tok] = __builtin_amdgcn_exp2f(P * L2E);
    float mx = a;
    mx = fmaxf(mx, swz_xor<1>(mx)); mx = fmaxf(mx, swz_xor<2>(mx)); mx = fmaxf(mx, swz_xor<4>(mx)); mx = fmaxf(mx, swz_xor<8>(mx)); mx = fmaxf(mx, swz_xor<16>(mx)); mx = half_max(mx);
    if (lane == 0) S[12 + half * 4 + wv] = mx;
    if (t == 0) S[half] = tot;
    __syncthreads();
    if (t == 0) S[2 + half] = fmaxf(fmaxf(S[12 + half * 4], S[13 + half * 4]), fmaxf(S[14 + half * 4], S[15 + half * 4]));
    __syncthreads();
}
#define ML_PK(L, H) (bf16x8){L[0], L[1], L[2], L[3], H[0], H[1], H[2], H[3]}
__device__ __forceinline__ s16x4 tr_read_rt(int vb) { s16x4 r; asm volatile("ds_read_b64_tr_b16 %0, %1" : "=&v"(r) : "v"(vb) : "memory"); return r; }

__device__ __forceinline__ void ml_passA_unit(const Params& p, char* lds, int sid, int h, int blk) {
    const int tid = tid_opaque(), wid = tid >> 6, lane = tid & 63, r32 = lane & 31, hi = lane >> 5;
    const bool isctx = sid < NCB; const int row0 = seq_base(sid) + 256 * blk;
    __syncthreads();
    ml_gates(p, lds, row0, h, tid);
    float* A = (float*)(lds + ML_OFF); float* S = (float*)(lds + ML_SC); float* NA = (float*)(lds + ML_N);
    const bf16* QK = (const bf16*)(p.ws + WS_QKVO) + (size_t)row0 * (4 * MW) + h * MDK;
    const int sr = tid >> 4, sc8 = (tid & 15) * 8;
#pragma unroll
    for (int j = 0; j < 4; ++j)
#pragma unroll
        for (int hf = 0; hf < 2; ++hf) { const int row = 64 * j + 32 * hf + sr;
            *(bf16x8*)(lds + 65536 + j * 16384 + v_st(32 * hf + sr, sc8)) = *(const bf16x8*)(QK + (size_t)row * (4 * MW) + 2 * MW + sc8); }
    if (tid < 256) NA[tid] = 0.f;
    const int a = wid >> 1, dvb0 = 2 * (wid & 1);
    const int ldsb = (int)(uintptr_t)lds; const int vbK = ldsb + v_rd_base(lane) + a * 512, vbV = ldsb + 65536 + v_rd_base(lane) + dvb0 * 512;
    for (int dir = 0; dir < 2; ++dir) {
        __syncthreads();
        const float ft = S[dir], am = S[2 + dir]; const float mT = isctx ? ft + fmaxf(am, 0.f) : 0.f; const float wl2 = (ft - mT) * L2E;
        float xs[8];
#pragma unroll
        for (int i = 0; i < 8; ++i) xs[i] = 0.f;
#pragma unroll
        for (int j = 0; j < 4; ++j)
#pragma unroll
            for (int hf = 0; hf < 2; ++hf) { const int row = 64 * j + 32 * hf + sr; const float w = __builtin_amdgcn_exp2f(wl2 + A[(2 + dir) * 256 + row]);
                const bf16x8 k8 = *(const bf16x8*)(QK + (size_t)row * (4 * MW) + MW + sc8); float x[8];
#pragma unroll
                for (int i = 0; i < 8; ++i) { x[i] = bf2f((unsigned short)k8[i]) * w; xs[i] += x[i]; }
                u32x4 pk = {cvtpk(x[0], x[1]), cvtpk(x[2], x[3]), cvtpk(x[4], x[5]), cvtpk(x[6], x[7])};
                *(u32x4*)(lds + j * 16384 + v_st(32 * hf + sr, sc8)) = pk; }
#pragma unroll
        for (int i = 0; i < 8; ++i) { float v = xs[i]; v += swz_xor<16>(v); v = half_sum(v); if (lane < 16) atomicAdd(&NA[dir * 128 + sc8 + i], v); }
        __syncthreads();
        f32x16 acc0 = {}, acc1 = {}; const unsigned eoff = (unsigned)((32 * a + 4 * hi) * MDK + 32 * dvb0 + r32);
#pragma unroll
        for (int j = 0; j < 4; ++j)
#pragma unroll
            for (int ks = 0; ks < 4; ++ks) { const int off = j * 16384 + ks * 4096;
                const s16x4 al = tr_read_rt(vbK + off), ah = tr_read_rt(vbK + off + 2048);
                const s16x4 bl0 = tr_read_rt(vbV + off), bh0 = tr_read_rt(vbV + off + 2048), bl1 = tr_read_rt(vbV + off + 512), bh1 = tr_read_rt(vbV + off + 512 + 2048);
                asm volatile("s_waitcnt lgkmcnt(0)" ::: "memory"); SBAR();
                acc0 = __builtin_amdgcn_mfma_f32_32x32x16_bf16(ML_PK(al, ah), ML_PK(bl0, bh0), acc0, 0, 0, 0);
                acc1 = __builtin_amdgcn_mfma_f32_32x32x16_bf16(ML_PK(al, ah), ML_PK(bl1, bh1), acc1, 0, 0, 0); }
        if (isctx) {
            float* Co = p.out + O_C + ((size_t)(sid * 2 + dir) * MH + h) * MDK * MDK;
#pragma unroll
            for (int r = 0; r < 16; ++r) { const unsigned eo = eoff + (unsigned)(((r & 3) + 8 * (r >> 2)) * MDK); Co[eo] = acc0[r]; Co[eo + 32] = acc1[r]; }
            if (tid == 0) p.out[O_M + (size_t)(sid * 2 + dir) * MH + h] = mT;
        } else {
            const int b = sid - NCB; bf16* Cs = (bf16*)(p.ws + WS_CST) + ((size_t)((b * MH + h) * 2 + dir) * NBLK + blk) * MDK * MDK;
#pragma unroll
            for (int r = 0; r < 16; ++r) { const unsigned eo = eoff + (unsigned)(((r & 3) + 8 * (r >> 2)) * MDK); Cs[eo] = f2bf(acc0[r]); Cs[eo + 32] = f2bf(acc1[r]); }
            if (tid == 0) ((float*)(p.ws + WS_FTOT))[((size_t)(b * MH + h) * 2 + dir) * NBLK + blk] = ft;
        }
    }
    __syncthreads();
    if (tid < 256) { const int dir = tid >> 7, d = tid & 127;
        if (isctx) p.out[O_N + ((size_t)(sid * 2 + dir) * MH + h) * MDK + d] = NA[tid];
        else { const int b = sid - NCB; ((float*)(p.ws + WS_NST))[(((size_t)(b * MH + h) * 2 + dir) * NBLK + blk) * MDK + d] = NA[tid]; } }
}

template <int DIR> __device__ __forceinline__ void ml_tile(f32x16* o, float& den, const bf16x8* qr, const char* Ktile, int vbV, const float* AL2, int j, float cq, int trow, bool diag, int r32, int hi) {
    SBAR(); f32x16 p0, p1; qkt(p0, p1, (const bf16*)Ktile, qr, r32, hi); SBAR();
    float ds = 0.f; const int tl = trow - 64 * j - 4 * hi;
#pragma unroll
    for (int g = 0; g < 4; ++g) { const f32x4v a0 = *(const f32x4v*)(AL2 + 64 * j + 8 * g + 4 * hi), a1 = *(const f32x4v*)(AL2 + 64 * j + 32 + 8 * g + 4 * hi);
#pragma unroll
        for (int e = 0; e < 4; ++e) { float w0 = __builtin_amdgcn_exp2f(cq + a0[e]), w1 = __builtin_amdgcn_exp2f(cq + a1[e]);
            if (diag) { if (DIR == 0 ? (8 * g + e > tl) : (8 * g + e < tl)) w0 = 0.f; if (DIR == 0 ? (8 * g + e + 32 > tl) : (8 * g + e + 32 < tl)) w1 = 0.f; }
            p0[4 * g + e] *= w0; p1[4 * g + e] *= w1; ds += p0[4 * g + e] + p1[4 * g + e]; } }
    den += ds;
    bf16x8 pa0, pa1, pa2, pa3;
#define PK4(P, BASE, OUT) do { unsigned a0_ = cvtpk(P[BASE + 0], P[BASE + 1]), a1_ = cvtpk(P[BASE + 2], P[BASE + 3]);   \
    unsigned b0_ = cvtpk(P[BASE + 4], P[BASE + 5]), b1_ = cvtpk(P[BASE + 6], P[BASE + 7]);                              \
    auto r0_ = __builtin_amdgcn_permlane32_swap(a0_, b0_, false, false); auto r1_ = __builtin_amdgcn_permlane32_swap(a1_, b1_, false, false); \
    u32x4 w_ = {r0_[0], r1_[0], r0_[1], r1_[1]}; OUT = *reinterpret_cast<bf16x8*>(&w_); } while (0)
    PK4(p0, 0, pa0); PK4(p0, 8, pa1); PK4(p1, 0, pa2); PK4(p1, 8, pa3);
#undef PK4
    SBAR(); pv_d0(o, vbV, pa0, pa1, pa2, pa3); SBAR();
}
__device__ __forceinline__ void ml_stage_kv(char* lds, const bf16* QK, int tile0, int sr, int sc8) {
#pragma unroll
    for (int jj = 0; jj < 2; ++jj)
#pragma unroll
        for (int hf = 0; hf < 2; ++hf) { const int rl = 32 * hf + sr, row = 64 * (tile0 + jj) + rl;
            const bf16x8 k8 = *(const bf16x8*)(QK + (size_t)row * (4 * MW) + MW + sc8), v8 = *(const bf16x8*)(QK + (size_t)row * (4 * MW) + 2 * MW + sc8);
            *(bf16x8*)(lds + jj * 16384 + KSWZ(rl, sc8 * 2)) = k8; *(bf16x8*)(lds + 32768 + jj * 16384 + v_st(rl, sc8)) = v8; }
}
__device__ __forceinline__ void ml_passC_unit(const Params& p, char* lds, int sid, int h, int blk) {
    const int tid = tid_opaque(), wid = tid >> 6, lane = tid & 63, r32 = lane & 31, hi = lane >> 5;
    const bool isctx = sid < NCB; const int row0 = seq_base(sid) + 256 * blk; const int wq = wid >> 1;
    __syncthreads();
    ml_gates(p, lds, row0, h, tid);
    float* A = (float*)(lds + ML_OFF); float* NS = (float*)(lds + ML_N); float* li = (float*)(lds + ML_LI) + wid * 32;
    const bf16* QK = (const bf16*)(p.ws + WS_QKVO) + (size_t)row0 * (4 * MW) + h * MDK;
    const int sr = tid >> 4, sc8 = (tid & 15) * 8; const int b = sid - NCB;
    if (tid < 256) { const int dir = tid >> 7, d = tid & 127;
        NS[tid] = isctx ? 0.f : ((const float*)(p.ws + WS_NST))[(((size_t)(b * MH + h) * 2 + dir) * NBLK + blk) * MDK + d]; }
    if (!isctx) {
#pragma unroll
        for (int dir = 0; dir < 2; ++dir) { const bf16* Cs = (const bf16*)(p.ws + WS_CST) + ((size_t)((b * MH + h) * 2 + dir) * NBLK + blk) * MDK * MDK;
#pragma unroll
            for (int c4 = 0; c4 < 4; ++c4) { const int c = tid + 512 * c4, row = c >> 4, col8 = (c & 15) * 8;
                *(bf16x8*)(lds + 65536 + dir * 32768 + (row >> 6) * 16384 + v_st(row & 63, col8)) = *(const bf16x8*)(Cs + (size_t)row * MDK + col8); } }
    }
    bf16x8 qr[8];
    { const bf16* Qw = QK + (size_t)(wid * 32 + r32) * (4 * MW) + hi * 8;
#pragma unroll
        for (int d0 = 0; d0 < 8; ++d0) qr[d0] = *(const bf16x8*)(Qw + d0 * 16); }
    ml_stage_kv(lds, QK, 0, sr, sc8);
    __syncthreads();
    float qn_f = 0.f, qn_b = 0.f;
#pragma unroll
    for (int d0 = 0; d0 < 8; ++d0)
#pragma unroll
        for (int i = 0; i < 8; ++i) { const float qv = bf2f((unsigned short)qr[d0][i]); qn_f += qv * NS[d0 * 16 + hi * 8 + i]; qn_b += qv * NS[128 + d0 * 16 + hi * 8 + i]; }
    qn_f = half_sum(qn_f); qn_b = half_sum(qn_b);
    const int ldsb = (int)(uintptr_t)lds; const int vbV = ldsb + 32768 + v_rd_base(lane), vbC = ldsb + 65536 + v_rd_base(lane);
    const int trow = wid * 32 + r32;
    float* HS = (float*)(p.ws + WS_HS) + (size_t)(row0 + wid * 32) * MW + h * MDK;
    f32x16 o[4]; const unsigned hso = (unsigned)(4 * hi * MW + r32), uho = (unsigned)(4 * hi * DM + r32), ogo = (unsigned)(4 * hi * 4 * MW + r32);
    {
        float qn = qn_f;
        o[0] = f32x16{}; o[1] = f32x16{}; o[2] = f32x16{}; o[3] = f32x16{};
        if (!isctx) { pv_d0(o, vbC, qr[0], qr[1], qr[2], qr[3]); pv_d0(o, vbC + 16384, qr[4], qr[5], qr[6], qr[7]);
#pragma unroll
            for (int r = 0; r < 16; ++r) { const float e = A[4 * 256 + wid * 32 + crow(r, hi)];
#pragma unroll
                for (int d0 = 0; d0 < 4; ++d0) o[d0][r] *= e; } }
        const float cq = A[0 * 256 + trow]; float den = 0.f;
        ml_tile<0>(o, den, qr, lds, vbV, A + 2 * 256, 0, cq, trow, wq == 0, r32, hi);
        if (wq >= 1) ml_tile<0>(o, den, qr, lds + 16384, vbV + 16384, A + 2 * 256, 1, cq, trow, wq == 1, r32, hi);
        __syncthreads(); ml_stage_kv(lds, QK, 2, sr, sc8); __syncthreads();
        if (wq >= 2) ml_tile<0>(o, den, qr, lds, vbV, A + 2 * 256, 2, cq, trow, wq == 2, r32, hi);
        if (wq >= 3) ml_tile<0>(o, den, qr, lds + 16384, vbV + 16384, A + 2 * 256, 3, cq, trow, wq == 3, r32, hi);
        { auto rr = __builtin_amdgcn_permlane32_swap(__float_as_uint(den), __float_as_uint(den), false, false); den = __uint_as_float(rr[0]) + __uint_as_float(rr[1]); }
        const float dn = den + __builtin_amdgcn_exp2f(cq) * qn; const float inv = 1.0f / fmaxf(fabsf(dn), 1.0f);
        if (hi == 0) li[r32] = inv; asm volatile("s_waitcnt lgkmcnt(0)" ::: "memory");
#pragma unroll
        for (int r = 0; r < 16; ++r) { const float rl = li[crow(r, hi)]; const unsigned eo = hso + (unsigned)(((r & 3) + 8 * (r >> 2)) * MW);
#pragma unroll
            for (int d0 = 0; d0 < 4; ++d0) HS[eo + d0 * 32] = o[d0][r] * rl;
            asm volatile("" ::: "memory"); }
    }
    {
        float qn = qn_b;
        o[0] = f32x16{}; o[1] = f32x16{}; o[2] = f32x16{}; o[3] = f32x16{};
        if (!isctx) { pv_d0(o, vbC + 32768, qr[0], qr[1], qr[2], qr[3]); pv_d0(o, vbC + 32768 + 16384, qr[4], qr[5], qr[6], qr[7]);
#pragma unroll
            for (int r = 0; r < 16; ++r) { const float e = A[5 * 256 + wid * 32 + crow(r, hi)];
#pragma unroll
                for (int d0 = 0; d0 < 4; ++d0) o[d0][r] *= e; } }
        const float cq = A[1 * 256 + trow]; float den = 0.f;
        ml_tile<1>(o, den, qr, lds + 16384, vbV + 16384, A + 3 * 256, 3, cq, trow, wq == 3, r32, hi);
        if (wq <= 2) ml_tile<1>(o, den, qr, lds, vbV, A + 3 * 256, 2, cq, trow, wq == 2, r32, hi);
        __syncthreads(); ml_stage_kv(lds, QK, 0, sr, sc8); __syncthreads();
        if (wq <= 1) ml_tile<1>(o, den, qr, lds + 16384, vbV + 16384, A + 3 * 256, 1, cq, trow, wq == 1, r32, hi);
        if (wq <= 0) ml_tile<1>(o, den, qr, lds, vbV, A + 3 * 256, 0, cq, trow, wq == 0, r32, hi);
        { auto rr = __builtin_amdgcn_permlane32_swap(__float_as_uint(den), __float_as_uint(den), false, false); den = __uint_as_float(rr[0]) + __uint_as_float(rr[1]); }
        const float dn = den + __builtin_amdgcn_exp2f(cq) * qn; const float inv = 1.0f / fmaxf(fabsf(dn), 1.0f);
        asm volatile("s_waitcnt vmcnt(0)" ::: "memory");
        if (hi == 0) li[r32] = inv; asm volatile("s_waitcnt lgkmcnt(0)" ::: "memory");
        float mg[4];
#pragma unroll
        for (int d0 = 0; d0 < 4; ++d0) mg[d0] = p.mng[h * MDK + d0 * 32 + r32];
        const bf16* OG = QK + (size_t)(wid * 32) * (4 * MW) + 3 * MW; bf16* UHo = (bf16*)(p.ws + WS_UH) + (size_t)(row0 + wid * 32) * DM + CCH + h * MDK;
#pragma unroll
        for (int r = 0; r < 16; ++r) { const float rl = li[crow(r, hi)]; const int rc = (r & 3) + 8 * (r >> 2); float ss = 0.f;
#pragma unroll
            for (int d0 = 0; d0 < 4; ++d0) { const float hf = __hip_atomic_load(HS + hso + (unsigned)(rc * MW + d0 * 32), __ATOMIC_RELAXED, __HIP_MEMORY_SCOPE_AGENT); const float x = hf + o[d0][r] * rl; o[d0][r] = x; ss += x * x; }
            ss += swz_xor<1>(ss); ss += swz_xor<2>(ss); ss += swz_xor<4>(ss); ss += swz_xor<8>(ss); ss += swz_xor<16>(ss);
            const float rs = 1.0f / sqrtf(ss * (1.0f / MDK) + EPSF);
#pragma unroll
            for (int d0 = 0; d0 < 4; ++d0) UHo[uho + (unsigned)(rc * DM + d0 * 32)] = f2bf(bf2f(OG[ogo + (unsigned)(rc * 4 * MW + d0 * 32)]) * o[d0][r] * rs * mg[d0]);
            asm volatile("" ::: "memory"); }
    }
}
}

struct MlScan {
    Params p; static HD_FN long count() { return (long)NLB * MH * 2 * (MDK * MDK + MDK); }
    HD_FN void operator()(long idx) const {
        const int per = MDK * MDK + MDK; const int e = (int)(idx % per); const int ch = (int)(idx / per); const int dir = ch & 1, h = (ch >> 1) % MH, b = ch / (2 * MH);
        const float em = expf(p.stm[(size_t)(b * 2 + dir) * MH + h]); const float* FT = (const float*)(p.ws + WS_FTOT) + (size_t)ch * NBLK;
        if (e < MDK * MDK) { bf16_t* Cs = (bf16_t*)(p.ws + WS_CST) + (size_t)ch * NBLK * MDK * MDK + e; float c = p.stC[((size_t)(b * 2 + dir) * MH + h) * MDK * MDK + e] * em;
            for (int i = 0; i < NBLK; ++i) { const int blk = dir == 0 ? i : NBLK - 1 - i; const float d = bf2f(Cs[(size_t)blk * MDK * MDK]); Cs[(size_t)blk * MDK * MDK] = f2bf(c); c = expf(FT[blk]) * c + d; } }
        else { const int d_ = e - MDK * MDK; float* Ns = (float*)(p.ws + WS_NST) + (size_t)ch * NBLK * MDK + d_; float c = p.stn[((size_t)(b * 2 + dir) * MH + h) * MDK + d_] * em;
            for (int i = 0; i < NBLK; ++i) { const int blk = dir == 0 ? i : NBLK - 1 - i; const float d = Ns[(size_t)blk * MDK]; Ns[(size_t)blk * MDK] = c; c = expf(FT[blk]) * c + d; } }
    }
};
__device__ __forceinline__ void ml_phase_A(const Params& p, unsigned char* lds, int vcu, int G) {
    constexpr int NUL = NLB * MH * NBLK, NU = NUL + NCB * MH;
    for (int u = vcu; u < NU; u += G) {
        if (u < NUL) att::ml_passA_unit(p, (char*)lds, NCB + u / (MH * NBLK), (u / NBLK) % MH, u % NBLK);
        else att::ml_passA_unit(p, (char*)lds, (u - NUL) / MH, (u - NUL) % MH, 0); }
}
__device__ __forceinline__ void ml_phase_C(const Params& p, unsigned char* lds, int vcu, int G) {
    constexpr int NUL = NLB * MH * NBLK, NU = NUL + NCB * MH;
    for (int u = vcu; u < NU; u += G) {
        if (u < NUL) att::ml_passC_unit(p, (char*)lds, NCB + u / (MH * NBLK), (u / NBLK) % MH, u % NBLK);
        else att::ml_passC_unit(p, (char*)lds, (u - NUL) / MH, (u - NUL) % MH, 0); }
}
struct DevGo { XcdBarrier bar;
    template <class F> __device__ __forceinline__ void run(const F& f, long n) const { const int t_ = tid_opaque(); for (long i = blockIdx.x * (long)NTHREADS + t_; i < n; i += (long)gridDim.x * NTHREADS) f(i); }
    template <class F> __device__ __forceinline__ void operator()(const F& f, long n) const { run(f, n); xcd_barrier(bar); } };
template <class Epi> __device__ __forceinline__ void gemm_call(LAS unsigned char* lds, const bf16_t* A, const bf16_t* Bt, int N, int K, const Epi& E) {
    pg8::Gemm g{A, Bt, MTOK, N, K}; pg8::StaticOrder S; S.init(MTOK, N, (int)gridDim.x, (int)blockIdx.x);
    pg8::gemm_phase<Epi, pg8::StaticOrder, true, true>((PG8_LAS unsigned char*)lds, g, S, E);
}
__global__ void __launch_bounds__(NTHREADS, 2) mega_fwd(Params p) {
    extern __shared__ __attribute__((aligned(16))) unsigned char lds[];
    LAS unsigned char* L = (LAS unsigned char*)lds;
    for (int u = threadIdx.x; u < (LDS_BYTES - LDSCTL_OFF) / 4; u += NTHREADS) ((LAS unsigned*)(L + LDSCTL_OFF))[u] = 0u;
    __syncthreads();
    volatile LAS unsigned* MISC = (volatile LAS unsigned*)(L + MISC_OFF);
    DevGo go; go.bar = xcd_barrier_post((unsigned*)(p.ws + WS_CTL) + CW_BAR, MISC + 8);
    const int G = gridDim.x, bx = blockIdx.x; const int vcu = (G % 8 == 0) ? (bx % 8) * (G / 8) + bx / 8 : bx;
    unsigned char* ws = p.ws;
    const bf16_t* XN = (const bf16_t*)(ws + WS_XN); const bf16_t* UH = (const bf16_t*)(ws + WS_UH); const bf16_t* Hh = (const bf16_t*)(ws + WS_H); const bf16_t* Ob = (const bf16_t*)(ws + WS_O);
    float* SW0 = (float*)(ws + WS_SW); float* SWC = SW0 + (size_t)NCLS * 2 * DFF; float* SW1 = SWC + (size_t)NCLS * CIN;
    float* SSQ = (float*)(ws + WS_SSQ); float* Y = p.out + O_Y;
    p0_weights(p, L, vcu, G); go(NMod{p}, NMod::count());
    go(NNorm0a{p}, NNorm0a::count()); go.run(NNorm0b{p}, NNorm0b::count()); go(NGates{p}, NGates::count());
    gemm_call(L, XN, (const bf16_t*)(ws + WB_AB), ABMAIN, DM, EpiAB{(bf16_t*)(ws + WS_UPRE), (bf16_t*)(ws + WS_QKVO)}); xcd_barrier(go.bar);
    go.run(NConv{p}, NConv::count()); ml_phase_A(p, lds, vcu, G); xcd_barrier(go.bar);
    go.run(NConvLN{p}, NConvLN::count()); go(MlScan{p}, MlScan::count());
    ml_phase_C(p, lds, vcu, G); xcd_barrier(go.bar);
    gemm_call(L, UH, (const bf16_t*)(ws + WB_OUTAB), DM, DM, EpiRes{p.xp, p.xs, Y, (bf16_t*)(ws + WS_XN), SSQ + 0 * SSQ_STRIDE, modv(p, 0, 0, 2), modv(p, 0, 0, 4), p.n2g, 1, 0});
    { NSW s{p, p.wffi, SW0, 0, 3, 2 * DFF, 0}; go(s, s.count()); }
    gemm_call(L, XN, (const bf16_t*)(ws + WB_FFI0), 2 * DFF, DM, EpiFfnIn{(bf16_t*)(ws + WS_H), SSQ + 0 * SSQ_STRIDE, SW0}); xcd_barrier(go.bar);
    gemm_call(L, Hh, (const bf16_t*)(ws + WB_FFO0), DM, DFF, EpiRes{p.xp, p.xs, Y, (bf16_t*)(ws + WS_XN), SSQ + 1 * SSQ_STRIDE, modv(p, 0, 0, 5), modv(p, 1, 0, 1), p.n1g + DM, 0, 0});
    { NSW s{p, p.winc, SWC, 1, 0, CIN, 0}; go(s, s.count()); }
    gemm_call(L, XN, (const bf16_t*)(ws + WB_INC), CIN, DM, EpiQkv{(bf16_t*)(ws + WS_QRAW), (bf16_t*)(ws + WS_KRAW), (bf16_t*)(ws + WS_CTXV), (bf16_t*)(ws + WS_LATV), p.out + O_V, SSQ + 1 * SSQ_STRIDE, SWC});
    go(NCacheCvt{p}, NCacheCvt::count()); go(NQkPost{p}, NQkPost::count());
    attn_phase(p, lds, vcu, G); xcd_barrier(go.bar);
    gemm_call(L, Ob, (const bf16_t*)(ws + WB_OUTC), DM, DM, EpiRes{p.xp, p.xs, Y, (bf16_t*)(ws + WS_XN), SSQ + 2 * SSQ_STRIDE, modv(p, 1, 0, 2), modv(p, 1, 0, 4), p.n2g + DM, 0, 0});
    { NSW s{p, p.wffi + (size_t)DM * 2 * DFF, SW1, 1, 3, 2 * DFF, 0}; go(s, s.count()); }
    gemm_call(L, XN, (const bf16_t*)(ws + WB_FFI1), 2 * DFF, DM, EpiFfnIn{(bf16_t*)(ws + WS_H), SSQ + 2 * SSQ_STRIDE, SW1}); xcd_barrier(go.bar);
    gemm_call(L, Hh, (const bf16_t*)(ws + WB_FFO1), DM, DFF, EpiRes{p.xp, p.xs, Y, (bf16_t*)(ws + WS_XN), SSQ + 3 * SSQ_STRIDE, modv(p, 1, 0, 5), modv(p, 1, 0, 1), nullptr, 0, 0}); xcd_barrier(go.bar);
    go.run(NFinal{p}, NFinal::count());
}
static Params make_params(void* const* d_in, void* d_out, void* d_ws) {
    Params p{}; const float** pp = (const float**)&p; for (int i = 0; i < 28; ++i) pp[i] = (const float*)d_in[i];
    p.out = (float*)d_out; p.ws = (unsigned char*)d_ws; return p;
}
extern "C" void kernel_launch(void* const* d_in, const int* in_sizes, int n_in, void* d_out, int out_size, void* d_ws, size_t ws_size, hipStream_t stream) {
    static int grid = 0;
    if (grid == 0) {
        if (n_in != 28 || (size_t)out_size != O_END || ws_size < WS_END || in_sizes[0] != MC * DM || in_sizes[1] != ML * DM) {
            fprintf(stderr, "kernel_launch: shape mismatch n_in %d out %d (want %zu) ws %zu (want %zu)\n", n_in, out_size, (size_t)O_END, ws_size, (size_t)WS_END); grid = -1; return; }
        int dev = 0, cus = 0;
        if (hipGetDevice(&dev) != hipSuccess || hipDeviceGetAttribute(&cus, hipDeviceAttributeMultiprocessorCount, dev) != hipSuccess) { grid = -1; return; }
        if (hipFuncSetAttribute((const void*)mega_fwd, hipFuncAttributeMaxDynamicSharedMemorySize, LDS_BYTES) != hipSuccess) { fprintf(stderr, "hipFuncSetAttribute failed\n"); grid = -1; return; }
        int per_cu = 0; (void)hipOccupancyMaxActiveBlocksPerMultiprocessor(&per_cu, (const void*)mega_fwd, NTHREADS, LDS_BYTES); (void)hipGetLastError();
        if (per_cu < 1) fprintf(stderr, "kernel_launch: occupancy query says %d blocks/CU\n", per_cu);
        grid = cus;
    }
    if (grid < 0) return;
    hipMemsetAsync((char*)d_ws + WS_CTL, 0, CTL_ZERO_BYTES, stream);
    Params p = make_params(d_in, d_out, d_ws);
    hipLaunchKernelGGL(mega_fwd, dim3(grid), dim3(NTHREADS), LDS_BYTES, stream, p);
}
```

```cpp
#ifdef HOST_TEST
#include <cmath>
#include <cstdio>
#include <cstdlib>
#include <cstring>
#include <cstdint>
#include <vector>
#define HD_FN inline
#define DEV_FN inline
#else
#include <hip/hip_runtime.h>
#include <cstdio>
#include <cstdint>
#define HD_FN __host__ __device__ __forceinline__
#define DEV_FN __device__ __forceinline__
#endif

#ifdef TINY
constexpr int DM = 512, NCB = 2, CSEQ = 128, NLB = 2, LSEQ = 128, PAST = 128;
#else
constexpr int DM = 1024, NCB = 16, CSEQ = 256, NLB = 4, LSEQ = 4096, PAST = 256;
#endif
constexpr int GRIDW = 64, CCH = DM / 2, CWID = 31, MH = 4, MDK = CCH / MH, MW = CCH, NGATE = 16;
constexpr int ABIN = 2 * CCH + 4 * MW + NGATE, ABMAIN = 2 * CCH + 4 * MW;
constexpr int HDIM = 128, NQ = DM / HDIM, NKV = 2, GRP = NQ / NKV, CIN = (NQ + 2 * NKV) * HDIM;
constexpr int DFF = ((8 * DM + 3 * 256 - 1) / (3 * 256)) * 256;
constexpr int MC = NCB * CSEQ, ML = NLB * LSEQ, MTOK = MC + ML, NCLS = 1 + NLB, SKVL = LSEQ + PAST;
constexpr float EPSF = 1e-6f;
constexpr int NSEQ = NCB + NLB;

constexpr size_t O_Y = 0, O_C = (size_t)MTOK * DM, O_N = O_C + (size_t)NCB * 2 * MH * MDK * MDK, O_M = O_N + (size_t)NCB * 2 * MH * MDK,
                 O_K = O_M + (size_t)NCB * 2 * MH, O_V = O_K + (size_t)NCB * CSEQ * NKV * HDIM, O_END = O_V + (size_t)NCB * CSEQ * NKV * HDIM;

constexpr size_t MiB = 1u << 20;
#ifdef TINY
constexpr size_t WSCALE = 1;
#endif
constexpr size_t WS_CTL = 0, CTL_ZERO_BYTES = 1 * MiB;
constexpr size_t WS_MOD = 1 * MiB;
constexpr size_t WS_SW = WS_MOD + 256 * 1024;
constexpr size_t WS_SSQ = 512 * 1024;
constexpr int SSQ_STRIDE = 32768;
constexpr size_t WS_DEN = 232 * MiB;
constexpr size_t WS_WB = 2 * MiB;
constexpr size_t WS_XN = 50 * MiB;
constexpr size_t WS_UPRE = 90 * MiB;
constexpr size_t WS_QKVO = 110 * MiB;
constexpr size_t WS_UH = 190 * MiB;
constexpr size_t WS_GATES = 230 * MiB;
constexpr size_t WS_HS = 50 * MiB;
constexpr size_t WS_H = 110 * MiB;
constexpr size_t WS_QRAW = 110 * MiB;
constexpr size_t WS_LATK = 150 * MiB, WS_LATV = 159 * MiB, WS_CTXK = 168 * MiB, WS_CTXV = 170 * MiB;
constexpr size_t WS_KRAW = 172 * MiB;
constexpr size_t WS_O = 190 * MiB;
constexpr size_t WS_END = 256 * MiB;

typedef unsigned short bf16_t;
HD_FN float bf2f(bf16_t h) { unsigned u = (unsigned)h << 16; return __builtin_bit_cast(float, u); }
HD_FN bf16_t f2bf(float f) { unsigned u = __builtin_bit_cast(unsigned, f); return (bf16_t)((u + 0x7fffu + ((u >> 16) & 1u)) >> 16); }
HD_FN float rbf(float f) { return bf2f(f2bf(f)); }
HD_FN float sigmoidf_(float x) { return 1.0f / (1.0f + expf(-x)); }
HD_FN float siluf_(float x) { return x * sigmoidf_(x); }
HD_FN float logsigmoidf_(float x) { return x >= 0.f ? -log1pf(expf(-x)) : x - log1pf(expf(x)); }
HD_FN int cls_of(int row) { return row < MC ? 0 : 1 + (row - MC) / LSEQ; }
HD_FN int seqlen_of(int row) { return row < MC ? CSEQ : LSEQ; }
HD_FN int pos_of(int row) { return row < MC ? row % CSEQ : (row - MC) % LSEQ; }

struct Params {
    const float *xp, *xs, *c, *stC, *stn, *stm, *ck, *cv, *cctx, *wmod, *bmod, *n1g, *n2g, *winab, *bgate, *convw, *convb, *lng, *lnb, *mng,
        *woutab, *winc, *qng, *kng, *woutc, *wffi, *wffo, *fng;
    float* out; unsigned char* ws;
};
HD_FN const float* xrow(const Params& p, int row) { return row < MC ? p.xp + (size_t)row * DM : p.xs + (size_t)(row - MC) * DM; }
HD_FN const float* modv(const Params& p, int l, int cls, int which) { return (const float*)(p.ws + WS_MOD) + ((size_t)(l * NCLS + cls) * 6 + which) * DM; }
constexpr size_t WS_RS0 = 233 * MiB;

struct NMod {
    Params p; static HD_FN long count() { return 2L * NCLS * 6 * DM; }
    HD_FN void operator()(long idx) const {
        const int col = (int)(idx % (6 * DM)); const int cls = (int)((idx / (6 * DM)) % NCLS); const int l = (int)(idx / (6 * DM * NCLS));
        const float* cond = cls == 0 ? p.cctx : p.c + (size_t)(cls - 1) * DM;
        const float* w = p.wmod + (size_t)l * DM * 6 * DM;
        float acc = 0.f;
        for (int k = 0; k < DM; ++k) acc += siluf_(cond[k]) * w[(size_t)k * 6 * DM + col];
        ((float*)(p.ws + WS_MOD))[idx] = acc + p.bmod[(size_t)l * 6 * DM + col];
    }
};
struct NNorm0a {
    Params p; static HD_FN long count() { return MTOK; }
    HD_FN void operator()(long row) const {
        const float* x = xrow(p, (int)row); float s = 0.f;
        for (int k = 0; k < DM; ++k) s += x[k] * x[k];
        ((float*)(p.ws + WS_RS0))[row] = 1.0f / sqrtf(s / DM + EPSF);
    }
};
struct NNorm0b {
    Params p; static HD_FN long count() { return (long)MTOK * DM; }
    HD_FN void operator()(long idx) const {
        const int row = (int)(idx / DM), col = (int)(idx % DM), cls = cls_of(row);
        const float rs = ((const float*)(p.ws + WS_RS0))[row];
        const float v = xrow(p, row)[col] * rs * p.n1g[col] * (1.f + modv(p, 0, cls, 1)[col]) + modv(p, 0, cls, 0)[col];
        ((bf16_t*)(p.ws + WS_XN))[idx] = f2bf(v);
    }
};
struct NGates {
    Params p; static HD_FN long count() { return (long)MTOK * NGATE; }
    HD_FN void operator()(long idx) const {
        const int row = (int)(idx / NGATE), j = (int)(idx % NGATE), cls = cls_of(row);
        const float rs = ((const float*)(p.ws + WS_RS0))[row]; const float* x = xrow(p, row);
        const float* sc = modv(p, 0, cls, 1); const float* sh = modv(p, 0, cls, 0);
        float acc = 0.f;
        for (int k = 0; k < DM; ++k) { const float h = x[k] * rs * p.n1g[k] * (1.f + sc[k]) + sh[k]; acc += h * p.winab[(size_t)k * ABIN + ABMAIN + j]; }
        acc += p.bgate[j];
        if ((j & 7) >= 4) acc = logsigmoidf_(acc);
        ((float*)(p.ws + WS_GATES))[idx] = acc;
    }
};

template <bool DUAL, class Epi> struct NGemm {
    const bf16_t* A; const float* B; int lda, ldb, K, N, off2, pad_; Epi epi;
    HD_FN long count() const { return (long)(MTOK / 4) * (N / 4); }
    HD_FN void operator()(long idx) const {
        const int nt = (int)(idx % (N / 4)), mt = (int)(idx / (N / 4)); const int m0 = mt * 4, n0 = nt * 4;
        float acc[4][4], acc2[4][4];
#pragma unroll
        for (int i = 0; i < 4; ++i)
#pragma unroll
            for (int j = 0; j < 4; ++j) { acc[i][j] = 0.f; acc2[i][j] = 0.f; }
        for (int k0 = 0; k0 < K; k0 += 8) {
            float a[4][8];
#pragma unroll
            for (int i = 0; i < 4; ++i) {
                const bf16_t* ap = A + (size_t)(m0 + i) * lda + k0;
#pragma unroll
                for (int kk = 0; kk < 8; ++kk) a[i][kk] = bf2f(ap[kk]);
            }
#pragma unroll
            for (int kk = 0; kk < 8; ++kk) {
                const float* bp = B + (size_t)(k0 + kk) * ldb + n0;
                float b[4], b2[4];
#pragma unroll
                for (int j = 0; j < 4; ++j) { b[j] = rbf(bp[j]); b2[j] = DUAL ? rbf(bp[off2 + j]) : 0.f; }
#pragma unroll
                for (int i = 0; i < 4; ++i)
#pragma unroll
                    for (int j = 0; j < 4; ++j) { acc[i][j] += a[i][kk] * b[j]; if (DUAL) acc2[i][j] += a[i][kk] * b2[j]; }
            }
        }
#pragma unroll
        for (int i = 0; i < 4; ++i)
#pragma unroll
            for (int j = 0; j < 4; ++j) epi(m0 + i, n0 + j, acc[i][j], acc2[i][j]);
    }
};
struct EGlu { Params p; HD_FN void operator()(int row, int col, float v, float v2) const { ((bf16_t*)(p.ws + WS_UPRE))[(size_t)row * CCH + col] = f2bf(v * sigmoidf_(v2)); } };
struct EQkvo { Params p; HD_FN void operator()(int row, int col, float v, float) const {
        const int part = col / MW; if (part == 1) v *= 1.0f / sqrtf((float)MDK); if (part == 3) v = sigmoidf_(v);
        ((bf16_t*)(p.ws + WS_QKVO))[(size_t)row * 4 * MW + col] = f2bf(v); } };
struct EOut { Params p; int l; int pad_ = 0; HD_FN void operator()(int row, int col, float v, float) const {
        const int cls = cls_of(row); float* Y = p.out + O_Y + (size_t)row * DM + col;
        const float xin = l == 0 ? xrow(p, row)[col] : *Y;
        const float x1 = xin + modv(p, l, cls, 2)[col] * v; *Y = x1;
        ((bf16_t*)(p.ws + WS_XN))[(size_t)row * DM + col] = f2bf(x1 * p.n2g[(size_t)l * DM + col] * (1.f + modv(p, l, cls, 4)[col])); } };
struct EFfnIn { Params p; const float* sw; int slot; int pad_ = 0; HD_FN void operator()(int row, int col, float v, float v2) const {
        const int cls = cls_of(row); const float rs = 1.0f / sqrtf(((const float*)(p.ws + WS_SSQ))[(size_t)slot * SSQ_STRIDE + row] / DM + EPSF);
        const float a = v * rs + sw[(size_t)cls * 2 * DFF + col], b = v2 * rs + sw[(size_t)cls * 2 * DFF + DFF + col];
        ((bf16_t*)(p.ws + WS_H))[(size_t)row * DFF + col] = f2bf(siluf_(a) * b); } };
struct EFfnOut { Params p; int l; int pad_ = 0; HD_FN void operator()(int row, int col, float v, float) const {
        const int cls = cls_of(row); float* Y = p.out + O_Y + (size_t)row * DM + col;
        const float x2 = *Y + modv(p, l, cls, 5)[col] * v; *Y = x2;
        if (l == 0) ((bf16_t*)(p.ws + WS_XN))[(size_t)row * DM + col] = f2bf(x2 * p.n1g[(size_t)DM + col] * (1.f + modv(p, 1, cls, 1)[col])); } };
struct EQkv { Params p; const float* sw; int slot; int pad_ = 0; HD_FN void operator()(int row, int col, float v, float) const {
        const int cls = cls_of(row); const float rs = 1.0f / sqrtf(((const float*)(p.ws + WS_SSQ))[(size_t)slot * SSQ_STRIDE + row] / DM + EPSF);
        const float a = v * rs + sw[(size_t)cls * CIN + col];
        if (col < NQ * HDIM) ((bf16_t*)(p.ws + WS_QRAW))[(size_t)row * NQ * HDIM + col] = f2bf(a);
        else if (col < (NQ + NKV) * HDIM) ((bf16_t*)(p.ws + WS_KRAW))[(size_t)row * NKV * HDIM + (col - NQ * HDIM)] = f2bf(a);
        else { const int c2 = col - (NQ + NKV) * HDIM;
            if (row < MC) { ((bf16_t*)(p.ws + WS_CTXV))[(size_t)row * NKV * HDIM + c2] = f2bf(a); p.out[O_V + (size_t)row * NKV * HDIM + c2] = a; }
            else { const int b = (row - MC) / LSEQ, s = (row - MC) % LSEQ; ((bf16_t*)(p.ws + WS_LATV))[((size_t)b * SKVL + s) * NKV * HDIM + c2] = f2bf(a); } } } };

struct NSsq {
    Params p; int slot; int pad_ = 0; static HD_FN long count() { return MTOK; }
    HD_FN void operator()(long row) const { const float* y = p.out + O_Y + (size_t)row * DM; float s = 0.f; for (int k = 0; k < DM; ++k) s += y[k] * y[k];
        ((float*)(p.ws + WS_SSQ))[(size_t)slot * SSQ_STRIDE + row] = s; }
};
struct NSW {
    Params p; const float* W; float* sw; int l, which, N, pad_; HD_FN long count() const { return (long)NCLS * N; }
    HD_FN void operator()(long idx) const { const int n = (int)(idx % N), cls = (int)(idx / N); const float* sh = modv(p, l, cls, which); float acc = 0.f;
        for (int k = 0; k < DM; ++k) acc += sh[k] * rbf(W[(size_t)k * N + n]); sw[idx] = acc; }
};
struct NConv {
    Params p; static HD_FN long count() { return (long)MTOK * CCH; }
    HD_FN void operator()(long idx) const {
        const int row = (int)(idx / CCH), c = (int)(idx % CCH), pos = pos_of(row), len = seqlen_of(row);
        const bf16_t* U = (const bf16_t*)(p.ws + WS_UPRE); float acc = p.convb[c];
        for (int j = 0; j < CWID; ++j) { const int t = pos + j - CWID / 2; if (t >= 0 && t < len) acc += p.convw[(size_t)j * CCH + c] * bf2f(U[(size_t)(row + j - CWID / 2) * CCH + c]); }
        ((float*)(p.ws + WS_HS))[idx] = acc;
    }
};
struct NConvLN {
    Params p; static HD_FN long count() { return MTOK; }
    HD_FN void operator()(long row) const {
        const float* t = (const float*)(p.ws + WS_HS) + (size_t)row * CCH; float mu = 0.f;
        for (int c = 0; c < CCH; ++c) mu += t[c]; mu /= CCH; float var = 0.f;
        for (int c = 0; c < CCH; ++c) { const float d = t[c] - mu; var += d * d; } var /= CCH;
        const float rs = 1.0f / sqrtf(var + EPSF); bf16_t* UH = (bf16_t*)(p.ws + WS_UH) + (size_t)row * DM;
        for (int c = 0; c < CCH; ++c) UH[c] = f2bf(siluf_((t[c] - mu) * rs * p.lng[c] + p.lnb[c]));
    }
};
HD_FN int seq_base(int sid) { return sid < NCB ? sid * CSEQ : MC + (sid - NCB) * LSEQ; }
struct NMlstmDen {
    Params p; static HD_FN long count() { return (long)NSEQ * MH * 2; }
    HD_FN void operator()(long idx) const {
        const int dir = (int)(idx % 2), h = (int)((idx / 2) % MH), sid = (int)(idx / (2 * MH)); const bool isctx = sid < NCB;
        const int base = seq_base(sid), len = isctx ? CSEQ : LSEQ;
        float n[MDK]; float mrun = 0.f;
        if (isctx) {
#pragma unroll
            for (int d = 0; d < MDK; ++d) n[d] = 0.f;
        } else { const int b = sid - NCB; const float em = expf(p.stm[(size_t)(b * 2 + dir) * MH + h]);
#pragma unroll
            for (int d = 0; d < MDK; ++d) n[d] = p.stn[((size_t)(b * 2 + dir) * MH + h) * MDK + d] * em; }
        const bf16_t* QK = (const bf16_t*)(p.ws + WS_QKVO); const float* G = (const float*)(p.ws + WS_GATES); float* DEN = (float*)(p.ws + WS_DEN);
        for (int t = 0; t < len; ++t) {
            const int row = base + (dir == 0 ? t : len - 1 - t);
            const float ig = G[(size_t)row * NGATE + dir * 8 + h], lf = G[(size_t)row * NGATE + dir * 8 + 4 + h];
            const float f = expf(lf), ei = expf(ig); mrun = fmaxf(mrun + lf, ig);
            const bf16_t* q = QK + (size_t)row * 4 * MW + h * MDK; const bf16_t* k = q + MW; float den = 0.f;
#pragma unroll
            for (int d = 0; d < MDK; ++d) { n[d] = f * n[d] + ei * bf2f(k[d]); den += bf2f(q[d]) * n[d]; }
            DEN[((size_t)dir * MTOK + row) * MH + h] = den;
        }
        if (isctx) { const float em = expf(-mrun); p.out[O_M + (size_t)(sid * 2 + dir) * MH + h] = mrun;
#pragma unroll
            for (int d = 0; d < MDK; ++d) p.out[O_N + ((size_t)(sid * 2 + dir) * MH + h) * MDK + d] = n[d] * em; }
    }
};
struct NMlstmNum {
    Params p; int dir; int pad_ = 0; static HD_FN long count() { return (long)NSEQ * MH * MDK; }
    HD_FN void operator()(long idx) const {
        const int v = (int)(idx % MDK), h = (int)((idx / MDK) % MH), sid = (int)(idx / (MDK * MH)); const bool isctx = sid < NCB;
        const int base = seq_base(sid), len = isctx ? CSEQ : LSEQ;
        float C[MDK];
        if (isctx) {
#pragma unroll
            for (int d = 0; d < MDK; ++d) C[d] = 0.f;
        } else { const int b = sid - NCB; const float em = expf(p.stm[(size_t)(b * 2 + dir) * MH + h]);
#pragma unroll
            for (int d = 0; d < MDK; ++d) C[d] = p.stC[(((size_t)(b * 2 + dir) * MH + h) * MDK + d) * MDK + v] * em; }
        const bf16_t* QK = (const bf16_t*)(p.ws + WS_QKVO); const float* G = (const float*)(p.ws + WS_GATES); const float* DEN = (const float*)(p.ws + WS_DEN);
        float* HS = (float*)(p.ws + WS_HS);
        for (int t = 0; t < len; ++t) {
            const int row = base + (dir == 0 ? t : len - 1 - t);
            const float ig = G[(size_t)row * NGATE + dir * 8 + h], lf = G[(size_t)row * NGATE + dir * 8 + 4 + h];
            const float f = expf(lf), ei = expf(ig);
            const bf16_t* q = QK + (size_t)row * 4 * MW + h * MDK; const bf16_t* k = q + MW; const float vv = bf2f(q[2 * MW + v]) * ei; float num = 0.f;
#pragma unroll
            for (int d = 0; d < MDK; ++d) { C[d] = f * C[d] + bf2f(k[d]) * vv; num += bf2f(q[d]) * C[d]; }
            const float den = DEN[((size_t)dir * MTOK + row) * MH + h]; const float hv = num / fmaxf(fabsf(den), 1.0f);
            float* o = HS + (size_t)row * MW + h * MDK + v; if (dir == 0) *o = hv; else *o += hv;
        }
        if (isctx) { const float em = expf(-p.out[O_M + (size_t)(sid * 2 + dir) * MH + h]);
#pragma unroll
            for (int d = 0; d < MDK; ++d) p.out[O_C + (((size_t)(sid * 2 + dir) * MH + h) * MDK + d) * MDK + v] = C[d] * em; }
    }
};
struct NHm {
    Params p; static HD_FN long count() { return (long)MTOK * MH; }
    HD_FN void operator()(long idx) const {
        const int row = (int)(idx / MH), h = (int)(idx % MH); const float* x = (const float*)(p.ws + WS_HS) + (size_t)row * MW + h * MDK; float s = 0.f;
        for (int v = 0; v < MDK; ++v) s += x[v] * x[v];
        const float rs = 1.0f / sqrtf(s / MDK + EPSF); const bf16_t* og = (const bf16_t*)(p.ws + WS_QKVO) + (size_t)row * 4 * MW + 3 * MW + h * MDK;
        bf16_t* UH = (bf16_t*)(p.ws + WS_UH) + (size_t)row * DM + CCH + h * MDK;
        for (int v = 0; v < MDK; ++v) UH[v] = f2bf(bf2f(og[v]) * x[v] * rs * p.mng[h * MDK + v]);
    }
};
struct NCacheCvt {
    Params p; static HD_FN long count() { return (long)NLB * PAST * NKV * HDIM; }
    HD_FN void operator()(long idx) const { const int e = (int)(idx % (NKV * HDIM)), pp = (int)((idx / (NKV * HDIM)) % PAST), b = (int)(idx / ((long)NKV * HDIM * PAST));
        const size_t dst = ((size_t)b * SKVL + LSEQ + pp) * NKV * HDIM + e;
        ((bf16_t*)(p.ws + WS_LATK))[dst] = f2bf(p.ck[idx]); ((bf16_t*)(p.ws + WS_LATV))[dst] = f2bf(p.cv[idx]); }
};
struct NQkPost {
    Params p; static HD_FN long count() { return (long)MTOK * (NQ + NKV); }
    HD_FN void operator()(long idx) const {
        const int row = (int)(idx / (NQ + NKV)), j = (int)(idx % (NQ + NKV)); const bool isq = j < NQ; const bool lat = row >= MC;
        bf16_t* src = isq ? (bf16_t*)(p.ws + WS_QRAW) + (size_t)row * NQ * HDIM + j * HDIM : (bf16_t*)(p.ws + WS_KRAW) + (size_t)row * NKV * HDIM + (j - NQ) * HDIM;
        const float* g = isq ? p.qng : p.kng; float s = 0.f;
        for (int d = 0; d < HDIM; ++d) { const float x = bf2f(src[d]); s += x * x; }
        const float rs = 1.0f / sqrtf(s / HDIM + EPSF);
        bf16_t* dst; float* fo = nullptr;
        if (isq) dst = src;
        else if (!lat) { dst = (bf16_t*)(p.ws + WS_CTXK) + (size_t)row * NKV * HDIM + (j - NQ) * HDIM; fo = p.out + O_K + (size_t)row * NKV * HDIM + (j - NQ) * HDIM; }
        else { const int b = (row - MC) / LSEQ, sp = (row - MC) % LSEQ; dst = (bf16_t*)(p.ws + WS_LATK) + ((size_t)b * SKVL + sp) * NKV * HDIM + (j - NQ) * HDIM; }
        const int sp = pos_of(row); const float prow = (float)(sp / GRIDW), pcol = (float)(sp % GRIDW);
        for (int half = 0; half < 2; ++half)
            for (int d = 0; d < HDIM / 4; ++d) {
                const int i1 = half * (HDIM / 2) + d, i2 = i1 + HDIM / 4;
                const float x1 = bf2f(src[i1]) * rs * g[i1], x2 = bf2f(src[i2]) * rs * g[i2]; float y1 = x1, y2 = x2;
                if (lat) { const float inv = powf(10000.0f, -(float)d / (float)(HDIM / 4)); const float ang = (half == 0 ? prow : pcol) * inv; const float cs = cosf(ang), sn = sinf(ang);
                    y1 = x1 * cs - x2 * sn; y2 = x1 * sn + x2 * cs; }
                dst[i1] = f2bf(y1); dst[i2] = f2bf(y2); if (fo) { fo[i1] = y1; fo[i2] = y2; }
            }
    }
};
struct NAttn {
    Params p; static HD_FN long count() { return (long)MTOK * NQ * 4; }
    HD_FN void operator()(long idx) const {
        const int sl = (int)(idx % 4), hq = (int)((idx / 4) % NQ), row = (int)(idx / (4 * NQ)); const int kv = hq / GRP;
        const bf16_t *Kb, *Vb; int nk;
        if (row < MC) { const int b = row / CSEQ; Kb = (const bf16_t*)(p.ws + WS_CTXK) + (size_t)b * CSEQ * NKV * HDIM; Vb = (const bf16_t*)(p.ws + WS_CTXV) + (size_t)b * CSEQ * NKV * HDIM; nk = CSEQ; }
        else { const int b = (row - MC) / LSEQ; Kb = (const bf16_t*)(p.ws + WS_LATK) + (size_t)b * SKVL * NKV * HDIM; Vb = (const bf16_t*)(p.ws + WS_LATV) + (size_t)b * SKVL * NKV * HDIM; nk = SKVL; }
        const bf16_t* qp = (const bf16_t*)(p.ws + WS_QRAW) + (size_t)row * NQ * HDIM + hq * HDIM;
        float q[HDIM];
#pragma unroll
        for (int d = 0; d < HDIM; ++d) q[d] = bf2f(qp[d]);
        float o[32];
#pragma unroll
        for (int e = 0; e < 32; ++e) o[e] = 0.f;
        float m = -1e30f, l = 0.f; const float scale = 1.0f / sqrtf((float)HDIM);
        for (int s = 0; s < nk; ++s) {
            const bf16_t* kp = Kb + (size_t)s * NKV * HDIM + kv * HDIM; float dot = 0.f;
#pragma unroll
            for (int d = 0; d < HDIM; ++d) dot += q[d] * bf2f(kp[d]);
            dot *= scale; const float mn = fmaxf(m, dot); const float al = expf(m - mn), pe = expf(dot - mn); m = mn; l = l * al + pe;
            const bf16_t* vp = Vb + (size_t)s * NKV * HDIM + kv * HDIM + sl * 32;
#pragma unroll
            for (int e = 0; e < 32; ++e) o[e] = o[e] * al + pe * bf2f(vp[e]);
        }
        bf16_t* op = (bf16_t*)(p.ws + WS_O) + (size_t)row * DM + hq * HDIM + sl * 32;
#pragma unroll
        for (int e = 0; e < 32; ++e) op[e] = f2bf(o[e] / l);
    }
};
struct NFinal {
    Params p; static HD_FN long count() { return (long)MTOK * DM; }
    HD_FN void operator()(long idx) const { const int row = (int)(idx / DM), col = (int)(idx % DM);
        const float rs = 1.0f / sqrtf(((const float*)(p.ws + WS_SSQ))[(size_t)3 * SSQ_STRIDE + row] / DM + EPSF); p.out[O_Y + idx] *= rs * p.fng[col]; }
};
constexpr int NWAVES = 8, NTHREADS = NWAVES * 64;
constexpr int RING_OFF = 0, RING_BYTES = 131072;
constexpr int LDSCTL_OFF = RING_BYTES, MISC_OFF = LDSCTL_OFF + 320;
constexpr int LDS_BYTES = 147456;
constexpr int CW_TMO = 0, CW_CODE = 1, CW_BAR = 4096;
__device__ __forceinline__ int tid_opaque() { int t = threadIdx.x; asm volatile("" : "+v"(t)); return t; }
template <int M> __device__ __forceinline__ float swz_xor(float v) { return __int_as_float(__builtin_amdgcn_ds_swizzle(__float_as_int(v), (M << 10) | 0x1f)); }
__device__ __forceinline__ float half_sum(float v) { auto rr = __builtin_amdgcn_permlane32_swap(__float_as_uint(v), __float_as_uint(v), false, false); return __uint_as_float(rr[0]) + __uint_as_float(rr[1]); }
__device__ __forceinline__ float half_max(float v) { auto rr = __builtin_amdgcn_permlane32_swap(__float_as_uint(v), __float_as_uint(v), false, false); return fmaxf(__uint_as_float(rr[0]), __uint_as_float(rr[1])); }
__device__ __forceinline__ float lane_get(float v, int src_lane) { return __int_as_float(__builtin_amdgcn_ds_bpermute(src_lane << 2, __float_as_int(v))); }
#define GAS __attribute__((address_space(1)))
#define LAS __attribute__((address_space(3)))
typedef GAS unsigned gu32;
#define RLX_AGENT __ATOMIC_RELAXED, __HIP_MEMORY_SCOPE_AGENT
#define XB_TMO      128
#define XB_XCNT(j)  (256  + 64 * (j))
#define XB_XSUB(j)  (1280 + 64 * (j))
#define XB_XGEN(j)  (2304 + 64 * (j))
#define XB_TOP      3328
#define XB_TOPGEN   3392
#define XCD_BAR_WORDS 3456
#define XB_SPIN_CAP (1u << 22)
__device__ __forceinline__ unsigned xb_ld(unsigned* p)              { return __hip_atomic_load(p, __ATOMIC_RELAXED, __HIP_MEMORY_SCOPE_AGENT); }
__device__ __forceinline__ unsigned xb_add(unsigned* p, unsigned v) { return __hip_atomic_fetch_add(p, v, __ATOMIC_RELAXED, __HIP_MEMORY_SCOPE_AGENT); }
__device__ __forceinline__ unsigned xb_xcc_id() { return (unsigned)__builtin_amdgcn_s_getreg((3 << 11) | 20) & 0xFu; }
#define XB_SPIN(cond, bar) do { unsigned _sp = 0; while (cond) { __builtin_amdgcn_s_sleep(1); \
    if ((++_sp & 255u) == 0u) { if (xb_ld(&(bar)[XB_TMO])) break; if (_sp > XB_SPIN_CAP) { atomicAdd(&(bar)[XB_TMO], 1u); break; } } } } while (0)
struct XcdBarrier { unsigned* bar; unsigned x; volatile LAS unsigned* st; };
__device__ __forceinline__ XcdBarrier xcd_barrier_post(unsigned* bar, volatile LAS unsigned* st) {
    XcdBarrier b; b.bar = bar; b.x = xb_xcc_id(); b.st = st;
    if (threadIdx.x == 0) (void)xb_add(&bar[XB_XCNT(b.x)], 1u);
    return b;
}
__device__ __forceinline__ void xcd_barrier_complete(unsigned* bar, unsigned x, unsigned& nloc, unsigned& nx) {
    const unsigned G = gridDim.x * gridDim.y * gridDim.z;
    unsigned sum, cnt, mine, sp = 0u;
    for (;;) {
        sum = 0u; cnt = 0u; mine = 0u;
#pragma unroll
        for (unsigned j = 0; j < 16; ++j) { const unsigned c = xb_ld(&bar[XB_XCNT(j)]); sum += c; cnt += (c > 0u) ? 1u : 0u; mine = (j == x) ? c : mine; }
        if (sum == G) break;
        __builtin_amdgcn_s_sleep(1);
        if ((++sp & 255u) == 0u) { if (xb_ld(&bar[XB_TMO])) break; if (sp > XB_SPIN_CAP) { atomicAdd(&bar[XB_TMO], 1u); break; } }
    }
    nloc = mine > 0u ? mine : 1u; nx = cnt > 0u ? cnt : 1u;
}
__device__ __forceinline__ void xcd_barrier(const XcdBarrier& b) {
    asm volatile("s_waitcnt vmcnt(0)" ::: "memory");
    __syncthreads();
    if (threadIdx.x == 0) {
        unsigned* bar = b.bar;
        __builtin_amdgcn_s_waitcnt(0);
        unsigned nloc = b.st[0], nx = b.st[1];
        if (nloc == 0u) { xcd_barrier_complete(bar, b.x, nloc, nx); b.st[0] = nloc; b.st[1] = nx; }
        const unsigned old = xb_add(&bar[XB_XSUB(b.x)], 1u);
        const unsigned gen = old / nloc;
        if (old + 1u == (gen + 1u) * nloc) {
            __builtin_amdgcn_fence(__ATOMIC_RELEASE, "agent");
            asm volatile("s_waitcnt vmcnt(0)" ::: "memory");
            const unsigned og = xb_add(&bar[XB_TOP], 1u);
            const unsigned tg = og / nx;
            if (og + 1u == (tg + 1u) * nx) xb_add(&bar[XB_TOPGEN], 1u);
            else XB_SPIN(xb_ld(&bar[XB_TOPGEN]) == tg, bar);
            __builtin_amdgcn_fence(__ATOMIC_ACQUIRE, "agent");
            xb_add(&bar[XB_XGEN(b.x)], 1u);
            asm volatile("s_waitcnt vmcnt(0)" ::: "memory");
        } else {
            XB_SPIN(xb_ld(&bar[XB_XGEN(b.x)]) == gen, bar);
            __builtin_amdgcn_fence(__ATOMIC_ACQUIRE, "agent");
            asm volatile("s_waitcnt vmcnt(0)" ::: "memory");
        }
    }
    __syncthreads();
}
namespace pg8 {
#define PG8_LAS __attribute__((address_space(3)))
typedef unsigned short bf16_t;
typedef short bf16x8 __attribute__((ext_vector_type(8)));
typedef float f32x4 __attribute__((ext_vector_type(4)));
typedef unsigned u32x4 __attribute__((ext_vector_type(4)));
constexpr int BM = 256, BK = 64, HALF = 128, HTB = HALF * BK * 2  , STAGE_BYTES = 8 * HTB, NXCD = 8, WGM = 8;

__host__ __device__ __forceinline__ int lds_byte(int r, int c) { const int st = (r >> 4) * 2 + (c >> 5), rr = r & 15, cc = c & 31, ob = rr * 64 + cc * 2; return st * 1024 + (ob ^ (((ob >> 9) & 1) << 5)); }
__host__ __device__ __forceinline__ void stage_rc(int b, int& R, int& C) { const int st = b / 1024, sb = b % 1024, swz = sb ^ (((sb >> 9) & 1) << 5); R = (st >> 1) * 16 + swz / 64; C = (st & 1) * 32 + (swz % 64) / 2; }
__host__ __device__ __forceinline__ int perm32(int rho) { const int n = rho >> 4, i = rho & 15; return 8 * (i >> 2) + 4 * n + (i & 3); }

struct Unit { int pm, pn; };
struct Gemm { const bf16_t* A; const bf16_t* Bt; int M, N, K; };

struct StaticOrder {
    int nM, nN, nwg, G, c;
    __host__ __device__ void init(int M, int N, int G_, int c_) { nM = M / BM; nN = N / BM; nwg = nM * nN; G = G_; c = c_; }
    __host__ __device__ bool next(int i, Unit& u) const {
        const long L = (long)i * G + c; if (L >= nwg) return false;
        int wgid = (int)L; { const int q = nwg / NXCD, r = nwg % NXCD, xcd = wgid % NXCD, off = wgid / NXCD; wgid = (xcd < r ? xcd * (q + 1) : r * (q + 1) + (xcd - r) * q) + off; }
        const int nig = WGM * nN, gid = wgid / nig, fm = gid * WGM, gsz = (nM - fm) < WGM ? (nM - fm) : WGM;
        u.pm = fm + ((wgid % nig) % gsz); u.pn = (wgid % nig) / gsz; return true;
    }
    __device__ __forceinline__ void a_ready(const Unit&) const {}
    __device__ __forceinline__ void done(const Unit&) const {}
};

__device__ __forceinline__ unsigned cvt_pk_bf16(float lo, float hi) { unsigned r; asm volatile("v_cvt_pk_bf16_f32 %0, %1, %2" : "=v"(r) : "v"(lo), "v"(hi)); return r; }
typedef float f32x2 __attribute__((ext_vector_type(2)));
template <class Epi, class Sched, bool ALIGN_EPI = false, bool SP2 = false>
__device__ __forceinline__ void gemm_phase(PG8_LAS unsigned char* lds, const Gemm g, const Sched& S, const Epi& E) {
    const int tid = tid_opaque(), wid = __builtin_amdgcn_readfirstlane(tid >> 6), lane = tid & 63, wr = wid >> 2, wc = wid & 3, fr = lane & 15, fq = lane >> 4;
    const int K = g.K, nt = K / BK;
    unsigned voffA[2], voffB[2];
#pragma unroll
    for (int i = 0; i < 2; ++i) { int R, C; stage_rc(tid * 16 + i * 8192, R, C); const int Rb = Epi::PERM ? ((R & ~31) + perm32(R & 31)) : R;
        voffA[i] = (unsigned)(R * K + C) * 2u; voffB[i] = (unsigned)(Rb * K + C) * 2u; }
    const size_t kstep = (size_t)(BK * 2);
    const size_t hstep = (size_t)HALF * K * 2;
    const size_t tstep = 2 * hstep;
    const unsigned ldsw = (unsigned)wid * 1024u;
    const int aoff = lds_byte(wr * 64 + fr, fq * 8), boff = lds_byte(wc * 32 + fr, fq * 8);
#define PG8_SA(b, h) (((b) * 2 + (h)) * HTB)
#define PG8_SB(b, h) ((4 + (b) * 2 + (h)) * HTB)
#define PG8_STAGE(bufoff, gbase, voff) do { _Pragma("unroll") for (int _i = 0; _i < 2; ++_i) \
        __builtin_amdgcn_global_load_lds((const unsigned*)((const char*)(gbase) + (voff)[_i]), (PG8_LAS unsigned*)(lds + (bufoff) + ldsw + _i * 8192), 16, 0, 0); } while (0)
#define PG8_LDA(dst, b, h) do { _Pragma("unroll") for (int m = 0; m < 4; ++m) _Pragma("unroll") for (int k = 0; k < 2; ++k) dst[m][k] = *(const PG8_LAS bf16x8*)(lds + PG8_SA(b, h) + aoff + m * 2048 + k * 1024); } while (0)
#define PG8_LDB(dst, b, h) do { _Pragma("unroll") for (int n = 0; n < 2; ++n) _Pragma("unroll") for (int k = 0; k < 2; ++k) dst[n][k] = *(const PG8_LAS bf16x8*)(lds + PG8_SB(b, h) + boff + n * 2048 + k * 1024); } while (0)
#define PG8_MMA(ai, bj, At, Bt) do { __builtin_amdgcn_s_setprio(1); _Pragma("unroll") for (int m = 0; m < 4; ++m) _Pragma("unroll") for (int n = 0; n < 2; ++n) _Pragma("unroll") for (int k = 0; k < 2; ++k) \
        acc[ai][bj][m][n] = __builtin_amdgcn_mfma_f32_16x16x32_bf16(Bt[n][k], At[m][k], acc[ai][bj][m][n], 0, 0, 0); __builtin_amdgcn_s_setprio(0); } while (0)
#define PG8_WAIT_V(n) asm volatile("s_waitcnt vmcnt(" #n ")" ::: "memory")
#define PG8_WAIT_L(n) asm volatile("s_waitcnt lgkmcnt(" #n ")" ::: "memory")
#define PG8_BAR __builtin_amdgcn_s_barrier()
#define PG8_SCHED __builtin_amdgcn_sched_barrier(0)
    Unit cur, nxt; int ui = 0;
    if (!S.next(0, cur)) return;
    f32x4 acc[2][2][4][2];
#pragma unroll
    for (int a = 0; a < 2; ++a)
#pragma unroll
        for (int b = 0; b < 2; ++b)
#pragma unroll
            for (int m = 0; m < 4; ++m)
#pragma unroll
                for (int n = 0; n < 2; ++n) acc[a][b][m][n] = (f32x4){0.f, 0.f, 0.f, 0.f};
    bf16x8 At[4][2], B0[2][2], B1[2][2];
    const char* cA = (const char*)g.A + (size_t)cur.pm * tstep; const char* cB = (const char*)g.Bt + (size_t)cur.pn * tstep;
    S.a_ready(cur);
    if constexpr (SP2) {
        PG8_STAGE(PG8_SB(0, 0), cB, voffB); PG8_STAGE(PG8_SB(0, 1), cB + hstep, voffB); PG8_STAGE(PG8_SA(0, 0), cA, voffA); PG8_STAGE(PG8_SA(0, 1), cA + hstep, voffA);
        if (wr == 1) PG8_BAR;
        PG8_WAIT_V(2); PG8_BAR;
        PG8_STAGE(PG8_SB(1, 0), cB + kstep, voffB); PG8_STAGE(PG8_SA(1, 0), cA + kstep, voffA); PG8_STAGE(PG8_SB(1, 1), cB + hstep + kstep, voffB);
        PG8_WAIT_V(6); PG8_BAR;
    } else {
        PG8_STAGE(PG8_SB(0, 0), cB, voffB); PG8_STAGE(PG8_SA(0, 0), cA, voffA); PG8_STAGE(PG8_SB(0, 1), cB + hstep, voffB); PG8_STAGE(PG8_SA(0, 1), cA + hstep, voffA);
        if (wr == 1) PG8_BAR;
        PG8_WAIT_V(4); PG8_BAR;
        PG8_STAGE(PG8_SB(1, 0), cB + kstep, voffB); PG8_STAGE(PG8_SA(1, 0), cA + kstep, voffA); PG8_STAGE(PG8_SB(1, 1), cB + hstep + kstep, voffB);
        PG8_WAIT_V(6); PG8_BAR;
    }
    for (;;) {
        const bool has_next = S.next(ui + 1, nxt);
        const char* nA = has_next ? (const char*)g.A + (size_t)nxt.pm * tstep : cA; const char* nB = has_next ? (const char*)g.Bt + (size_t)nxt.pn * tstep : cB;
        for (int t = 0; t < nt; t += 2) {
            const bool last = (t == nt - 2);
            const char* a1 = cA + (size_t)(t + 1) * kstep;
            const char* a2 = last ? nA : cA + (size_t)(t + 2) * kstep; const char* b2 = last ? nB : cB + (size_t)(t + 2) * kstep;
            const char* a3 = a2 + kstep; const char* b3 = b2 + kstep;
            if (last && has_next) S.a_ready(nxt);
            if constexpr (SP2) {
            PG8_LDB(B0, 0, 0); PG8_LDB(B1, 0, 1); PG8_SCHED; PG8_LDA(At, 0, 0); PG8_STAGE(PG8_SA(1, 1), a1 + hstep, voffA);
            PG8_WAIT_V(8); PG8_WAIT_L(0); PG8_BAR; PG8_MMA(0, 0, At, B0); PG8_MMA(0, 1, At, B1); PG8_BAR; PG8_SCHED;
            PG8_LDA(At, 0, 1); PG8_STAGE(PG8_SB(0, 0), b2, voffB); PG8_STAGE(PG8_SB(0, 1), b2 + hstep, voffB); PG8_STAGE(PG8_SA(0, 0), a2, voffA);
            PG8_WAIT_V(8); PG8_WAIT_L(0); PG8_BAR; PG8_MMA(1, 0, At, B0); PG8_MMA(1, 1, At, B1); PG8_BAR; PG8_SCHED;
            PG8_LDB(B0, 1, 0); PG8_LDB(B1, 1, 1); PG8_SCHED; PG8_LDA(At, 1, 0); PG8_STAGE(PG8_SA(0, 1), a2 + hstep, voffA);
            PG8_WAIT_V(8); PG8_WAIT_L(0); PG8_BAR; PG8_MMA(0, 0, At, B0); PG8_MMA(0, 1, At, B1); PG8_BAR; PG8_SCHED;
            PG8_LDA(At, 1, 1); PG8_STAGE(PG8_SB(1, 0), b3, voffB); PG8_STAGE(PG8_SB(1, 1), b3 + hstep, voffB); PG8_STAGE(PG8_SA(1, 0), a3, voffA);
            PG8_WAIT_V(8); PG8_WAIT_L(0); PG8_BAR; PG8_MMA(1, 0, At, B0); PG8_MMA(1, 1, At, B1); PG8_BAR; PG8_SCHED;
            } else {
            PG8_LDB(B0, 0, 0); PG8_SCHED; PG8_LDA(At, 0, 0); PG8_STAGE(PG8_SA(1, 1), a1 + hstep, voffA);
            PG8_WAIT_L(8); PG8_BAR; PG8_WAIT_L(0); PG8_MMA(0, 0, At, B0); PG8_BAR; PG8_SCHED;
            PG8_LDB(B1, 0, 1); PG8_STAGE(PG8_SB(0, 0), b2, voffB);
            PG8_BAR; PG8_WAIT_L(0); PG8_MMA(0, 1, At, B1); PG8_BAR;
            PG8_LDA(At, 0, 1); PG8_STAGE(PG8_SA(0, 0), a2, voffA);
            PG8_BAR; PG8_WAIT_L(0); PG8_MMA(1, 0, At, B0); PG8_BAR; PG8_SCHED;
            PG8_STAGE(PG8_SB(0, 1), b2 + hstep, voffB);
            PG8_WAIT_V(6); PG8_BAR; PG8_MMA(1, 1, At, B1); PG8_BAR;
            PG8_LDB(B0, 1, 0); PG8_SCHED; PG8_LDA(At, 1, 0); PG8_STAGE(PG8_SA(0, 1), a2 + hstep, voffA);
            PG8_WAIT_L(8); PG8_BAR; PG8_WAIT_L(0); PG8_MMA(0, 0, At, B0); PG8_BAR; PG8_SCHED;
            PG8_LDB(B1, 1, 1); PG8_STAGE(PG8_SB(1, 0), b3, voffB);
            PG8_BAR; PG8_WAIT_L(0); PG8_MMA(0, 1, At, B1); PG8_BAR;
            PG8_LDA(At, 1, 1); PG8_STAGE(PG8_SA(1, 0), a3, voffA);
            PG8_BAR; PG8_WAIT_L(0); PG8_MMA(1, 0, At, B0); PG8_BAR; PG8_SCHED;
            PG8_STAGE(PG8_SB(1, 1), b3 + hstep, voffB);
            PG8_WAIT_V(6); PG8_BAR; PG8_MMA(1, 1, At, B1); PG8_BAR;
            }
        }
        if constexpr (ALIGN_EPI) { if (wr == 0) PG8_BAR; }
        if constexpr (!Epi::AFTER_DRAIN) { E(acc, cur, wr, wc, fr, fq); S.done(cur); }
        if (!has_next) break;
#pragma unroll
        for (int a = 0; a < 2; ++a)
#pragma unroll
            for (int b = 0; b < 2; ++b)
#pragma unroll
                for (int m = 0; m < 4; ++m)
#pragma unroll
                    for (int n = 0; n < 2; ++n) acc[a][b][m][n] = (f32x4){0.f, 0.f, 0.f, 0.f};
        cur = nxt; cA = nA; cB = nB; ++ui;
        if constexpr (ALIGN_EPI) { if (wr == 1) PG8_BAR; }
    }
    PG8_WAIT_V(0);
    if constexpr (!ALIGN_EPI) { if (wr == 0) PG8_BAR; }
    PG8_BAR;
    if constexpr (Epi::AFTER_DRAIN) { E.fused(acc, cur, wr, wc, fr, fq, lds, wid, lane); S.done(cur); }
#undef PG8_SA
#undef PG8_SB
#undef PG8_STAGE
#undef PG8_LDA
#undef PG8_LDB
#undef PG8_MMA
#undef PG8_WAIT_V
#undef PG8_WAIT_L
#undef PG8_BAR
#undef PG8_SCHED
}
}
constexpr size_t WB_AB = 2 * MiB, WB_OUTAB = 8 * MiB, WB_FFI0 = 10 * MiB, WB_FFO0 = 21 * MiB, WB_INC = 27 * MiB, WB_OUTC = 30 * MiB, WB_FFI1 = 32 * MiB, WB_FFO1 = 43 * MiB;
static_assert(WB_FFO1 + (size_t)DM * DFF * 2 <= WS_XN && WB_AB + (size_t)ABMAIN * DM * 2 <= WB_OUTAB && WB_FFI0 + (size_t)2 * DFF * DM * 2 <= WB_FFO0 && WB_FFO0 + (size_t)DM * DFF * 2 <= WB_INC &&
              WB_INC + (size_t)CIN * DM * 2 <= WB_OUTC && WB_FFI1 + (size_t)2 * DFF * DM * 2 <= WB_FFO1, "weight copy map");

typedef unsigned v4u __attribute__((ext_vector_type(4)));
typedef unsigned v2u __attribute__((ext_vector_type(2)));
typedef float f32x4 __attribute__((ext_vector_type(4)));
__device__ __forceinline__ unsigned pk2(float lo, float hi) { return (unsigned)f2bf(lo) | ((unsigned)f2bf(hi) << 16); }
__device__ __forceinline__ float fsigmoid(float x) { return __builtin_amdgcn_rcpf(1.0f + __builtin_amdgcn_exp2f(-1.4426950408889634f * x)); }

__device__ __forceinline__ void p0_transpose_item(const float* W, int K, int ldw, int c0, int k0, bf16_t* WT, int drow, LAS float* scr, int lane) {
#pragma unroll 8
    for (int i = 0; i < 32; ++i) { const int kk = 2 * i + (lane >> 5); scr[kk * 33 + (lane & 31)] = W[(size_t)(k0 + kk) * ldw + c0 + (lane & 31)]; }
    asm volatile("s_waitcnt lgkmcnt(0)" ::: "memory");
    const int c = lane & 7;
#pragma unroll
    for (int j = 0; j < 4; ++j) { const int n = (lane >> 3) + 8 * j; const LAS float* s = scr + (8 * c) * 33 + n;
        v4u o; o.x = pk2(s[0 * 33], s[1 * 33]); o.y = pk2(s[2 * 33], s[3 * 33]); o.z = pk2(s[4 * 33], s[5 * 33]); o.w = pk2(s[6 * 33], s[7 * 33]);
        *(GAS v4u*)(WT + (size_t)(drow + n) * K + k0 + 8 * c) = o; }
    asm volatile("s_waitcnt lgkmcnt(0)" ::: "memory");
}
struct CvtJob { const float* W; bf16_t* WT; int K, ldw, c0, ncols, mode, Hn, dbase; };
__device__ __forceinline__ int cvt_items(const CvtJob& j) { return (j.K / 64) * (j.ncols / 32); }
__device__ __forceinline__ void cvt_run(const CvtJob& j, int item, LAS float* scr, int lane) {
    const int nblk = j.ncols / 32, kb = item / nblk, nb = item % nblk; const int c = j.c0 + 32 * nb;
    int drow; if (j.mode == 0) drow = j.dbase + 32 * nb; else { const int cc = c < j.Hn ? c : c - j.Hn; drow = 256 * (cc / 128) + (cc % 128) + (c < j.Hn ? 0 : 128); }
    p0_transpose_item(j.W, j.K, j.ldw, c, 64 * kb, j.WT, drow, scr, lane);
}
__device__ __forceinline__ void p0_weights(const Params& p, LAS unsigned char* lds, int vcu, int G) {
    const int tid_ = tid_opaque(); const int lane = tid_ & 63, wave = __builtin_amdgcn_readfirstlane(tid_ >> 6);
    LAS float* scr = (LAS float*)(lds + wave * 16384);
    const int gw = vcu * NWAVES + wave, NGW = G * NWAVES;
    CvtJob jobs[9] = {
        {p.winab, (bf16_t*)(p.ws + WB_AB), DM, ABIN, 0, 2 * CCH, 1, CCH, 0},
        {p.winab, (bf16_t*)(p.ws + WB_AB), DM, ABIN, 2 * CCH, 4 * MW, 0, 0, 2 * CCH},
        {p.woutab, (bf16_t*)(p.ws + WB_OUTAB), DM, DM, 0, DM, 0, 0, 0},
        {p.wffi, (bf16_t*)(p.ws + WB_FFI0), DM, 2 * DFF, 0, 2 * DFF, 1, DFF, 0},
        {p.wffo, (bf16_t*)(p.ws + WB_FFO0), DFF, DM, 0, DM, 0, 0, 0},
        {p.winc, (bf16_t*)(p.ws + WB_INC), DM, CIN, 0, CIN, 0, 0, 0},
        {p.woutc, (bf16_t*)(p.ws + WB_OUTC), DM, DM, 0, DM, 0, 0, 0},
        {p.wffi + (size_t)DM * 2 * DFF, (bf16_t*)(p.ws + WB_FFI1), DM, 2 * DFF, 0, 2 * DFF, 1, DFF, 0},
        {p.wffo + (size_t)DFF * DM, (bf16_t*)(p.ws + WB_FFO1), DFF, DM, 0, DM, 0, 0, 0}};
    int base = 0;
#pragma unroll
    for (int jj = 0; jj < 9; ++jj) {
        const int n = cvt_items(jobs[jj]);
        int first = ((gw - base) % NGW + NGW) % NGW;
        for (int it = first; it < n; it += NGW) cvt_run(jobs[jj], it, scr, lane);
        base += n;
    }
}

struct EpiAB {
    static constexpr bool PERM = true, AFTER_DRAIN = false;
    bf16_t* upre; bf16_t* qkvo;
    __device__ __forceinline__ void operator()(const f32x4 (&acc)[2][2][4][2], const pg8::Unit& u, int wr, int wc, int fr, int fq) const {
        const int row0 = u.pm * 256 + wr * 64 + fr, lc = wc * 32 + 8 * fq;
        if (u.pn < 4) {
#pragma unroll
            for (int ai = 0; ai < 2; ++ai)
#pragma unroll
                for (int m = 0; m < 4; ++m) { const f32x4 a0 = acc[ai][0][m][0], a1 = acc[ai][0][m][1], g0 = acc[ai][1][m][0], g1 = acc[ai][1][m][1]; v4u w;
                    w.x = pg8::cvt_pk_bf16(a0[0] * fsigmoid(g0[0]), a0[1] * fsigmoid(g0[1])); w.y = pg8::cvt_pk_bf16(a0[2] * fsigmoid(g0[2]), a0[3] * fsigmoid(g0[3]));
                    w.z = pg8::cvt_pk_bf16(a1[0] * fsigmoid(g1[0]), a1[1] * fsigmoid(g1[1])); w.w = pg8::cvt_pk_bf16(a1[2] * fsigmoid(g1[2]), a1[3] * fsigmoid(g1[3]));
                    *(v4u*)(upre + (size_t)(row0 + ai * 128 + m * 16) * CCH + 128 * u.pn + lc) = w; }
        } else {
#pragma unroll
            for (int bj = 0; bj < 2; ++bj) { const int col = 256 * (u.pn - 4) + 128 * bj + lc; const int part = col / MW; const float sc = part == 1 ? 0.08838834764831845f : 1.0f;
#pragma unroll
                for (int ai = 0; ai < 2; ++ai)
#pragma unroll
                    for (int m = 0; m < 4; ++m) { f32x4 v0 = acc[ai][bj][m][0] * sc, v1 = acc[ai][bj][m][1] * sc;
                        if (part == 3) { v0 = (f32x4){fsigmoid(v0[0]), fsigmoid(v0[1]), fsigmoid(v0[2]), fsigmoid(v0[3])}; v1 = (f32x4){fsigmoid(v1[0]), fsigmoid(v1[1]), fsigmoid(v1[2]), fsigmoid(v1[3])}; }
                        v4u w; w.x = pg8::cvt_pk_bf16(v0[0], v0[1]); w.y = pg8::cvt_pk_bf16(v0[2], v0[3]); w.z = pg8::cvt_pk_bf16(v1[0], v1[1]); w.w = pg8::cvt_pk_bf16(v1[2], v1[3]);
                        *(v4u*)(qkvo + (size_t)(row0 + ai * 128 + m * 16) * (4 * MW) + col) = w; } }
        }
    }
};
static_assert(MDK == 128, "EpiAB hard-codes MDK^-0.5");
struct EpiRes {
    static constexpr bool PERM = false, AFTER_DRAIN = false;
    const float* xp; const float* xs;
    float* Y; bf16_t* XN; float* ssq; const float* mod_g; const float* mod_sc; const float* ng;
    int from_input; int pad_;
    __device__ __forceinline__ void operator()(const f32x4 (&acc)[2][2][4][2], const pg8::Unit& u, int wr, int wc, int fr, int fq) const {
        const int row0 = u.pm * 256 + wr * 64 + fr; const int cls = cls_of(u.pm * 256);
        const float* xin = from_input ? (u.pm * 256 < MC ? xp : xs - (size_t)MC * DM) : Y;
        const float* gv = mod_g + (size_t)cls * 6 * DM; const float* scv = mod_sc + (size_t)cls * 6 * DM;
        float sq[2][4];
#pragma unroll
        for (int ai = 0; ai < 2; ++ai)
#pragma unroll
            for (int m = 0; m < 4; ++m) sq[ai][m] = 0.f;
#pragma unroll
        for (int bj = 0; bj < 2; ++bj)
#pragma unroll
            for (int n = 0; n < 2; ++n) { const int col = u.pn * 256 + bj * 128 + wc * 32 + n * 16 + 4 * fq;
                const f32x4 g4 = *(const f32x4*)(gv + col); f32x4 gs4 = (f32x4){0.f, 0.f, 0.f, 0.f};
                if (ng) { const f32x4 n4 = *(const f32x4*)(ng + col), s4 = *(const f32x4*)(scv + col); gs4 = n4 * (s4 + 1.0f); }
#pragma unroll
                for (int ai = 0; ai < 2; ++ai)
#pragma unroll
                    for (int m = 0; m < 4; ++m) { const size_t off = (size_t)(row0 + ai * 128 + m * 16) * DM + col;
                        const f32x4 xi = *(const f32x4*)(xin + off); const f32x4 xn = xi + g4 * acc[ai][bj][m][n];
                        *(f32x4*)(Y + off) = xn; sq[ai][m] += (xn[0] * xn[0] + xn[1] * xn[1]) + (xn[2] * xn[2] + xn[3] * xn[3]);
                        if (ng) { const f32x4 t = xn * gs4; v2u w; w.x = pg8::cvt_pk_bf16(t[0], t[1]); w.y = pg8::cvt_pk_bf16(t[2], t[3]); *(v2u*)(XN + off) = w; } } }
#pragma unroll
        for (int ai = 0; ai < 2; ++ai)
#pragma unroll
            for (int m = 0; m < 4; ++m) { float s = sq[ai][m]; s += __shfl_xor(s, 16); s += __shfl_xor(s, 32);
                if (fq == 0) atomicAdd(ssq + row0 + ai * 128 + m * 16, s); }
    }
};
struct EpiFfnIn {
    static constexpr bool PERM = true, AFTER_DRAIN = false;
    bf16_t* H; const float* ssq; const float* sw;
    __device__ __forceinline__ void operator()(const f32x4 (&acc)[2][2][4][2], const pg8::Unit& u, int wr, int wc, int fr, int fq) const {
        const int row0 = u.pm * 256 + wr * 64 + fr, lc = wc * 32 + 8 * fq; const int cls = cls_of(u.pm * 256); const int col = 128 * u.pn + lc;
        const float* swr = sw + (size_t)cls * 2 * DFF;
        const f32x4 sg0 = *(const f32x4*)(swr + col), sg1 = *(const f32x4*)(swr + col + 4), su0 = *(const f32x4*)(swr + DFF + col), su1 = *(const f32x4*)(swr + DFF + col + 4);
#pragma unroll
        for (int ai = 0; ai < 2; ++ai)
#pragma unroll
            for (int m = 0; m < 4; ++m) { const int row = row0 + ai * 128 + m * 16; const float rs = 1.0f / sqrtf(ssq[row] * (1.0f / DM) + EPSF);
                const f32x4 a0 = acc[ai][0][m][0] * rs + sg0, a1 = acc[ai][0][m][1] * rs + sg1, b0 = acc[ai][1][m][0] * rs + su0, b1 = acc[ai][1][m][1] * rs + su1; v4u w;
                w.x = pg8::cvt_pk_bf16(a0[0] * fsigmoid(a0[0]) * b0[0], a0[1] * fsigmoid(a0[1]) * b0[1]); w.y = pg8::cvt_pk_bf16(a0[2] * fsigmoid(a0[2]) * b0[2], a0[3] * fsigmoid(a0[3]) * b0[3]);
                w.z = pg8::cvt_pk_bf16(a1[0] * fsigmoid(a1[0]) * b1[0], a1[1] * fsigmoid(a1[1]) * b1[1]); w.w = pg8::cvt_pk_bf16(a1[2] * fsigmoid(a1[2]) * b1[2], a1[3] * fsigmoid(a1[3]) * b1[3]);
                *(v4u*)(H + (size_t)row * DFF + col) = w; }
    }
};
struct EpiQkv {
    static constexpr bool PERM = true, AFTER_DRAIN = false;
    bf16_t* qraw; bf16_t* kraw; bf16_t* ctxv; bf16_t* latv; float* outv; const float* ssq; const float* sw;
    __device__ __forceinline__ void operator()(const f32x4 (&acc)[2][2][4][2], const pg8::Unit& u, int wr, int wc, int fr, int fq) const {
        const int row0 = u.pm * 256 + wr * 64 + fr, lc = wc * 32 + 8 * fq; const int cls = cls_of(u.pm * 256); const float* swr = sw + (size_t)cls * CIN;
        float rs[2][4];
#pragma unroll
        for (int ai = 0; ai < 2; ++ai)
#pragma unroll
            for (int m = 0; m < 4; ++m) rs[ai][m] = 1.0f / sqrtf(ssq[row0 + ai * 128 + m * 16] * (1.0f / DM) + EPSF);
#pragma unroll
        for (int bj = 0; bj < 2; ++bj) { const int col = 256 * u.pn + 128 * bj + lc; const f32x4 s0 = *(const f32x4*)(swr + col), s1 = *(const f32x4*)(swr + col + 4);
#pragma unroll
            for (int ai = 0; ai < 2; ++ai)
#pragma unroll
                for (int m = 0; m < 4; ++m) { const int row = row0 + ai * 128 + m * 16; const f32x4 v0 = acc[ai][bj][m][0] * rs[ai][m] + s0, v1 = acc[ai][bj][m][1] * rs[ai][m] + s1;
                    v4u w; w.x = pg8::cvt_pk_bf16(v0[0], v0[1]); w.y = pg8::cvt_pk_bf16(v0[2], v0[3]); w.z = pg8::cvt_pk_bf16(v1[0], v1[1]); w.w = pg8::cvt_pk_bf16(v1[2], v1[3]);
                    if (u.pn < NQ * HDIM / 256) *(v4u*)(qraw + (size_t)row * (NQ * HDIM) + col) = w;
                    else if (u.pn == NQ * HDIM / 256) *(v4u*)(kraw + (size_t)row * (NKV * HDIM) + (col - NQ * HDIM)) = w;
                    else { const int c2 = col - (NQ + NKV) * HDIM;
                        if (row < MC) { *(v4u*)(ctxv + (size_t)row * (NKV * HDIM) + c2) = w; float* o = outv + (size_t)row * (NKV * HDIM) + c2; *(f32x4*)o = v0; *(f32x4*)(o + 4) = v1; }
                        else { const int b = (row - MC) / LSEQ, s = (row - MC) % LSEQ; *(v4u*)(latv + ((size_t)b * SKVL + s) * (NKV * HDIM) + c2) = w; } } } }
    }
};
static_assert(NKV * HDIM == 256 && (NQ * HDIM) % 256 == 0, "EpiQkv tile mapping");
namespace att {
typedef unsigned short bf16;
constexpr int D = 128, NW = 8, QBLK = 32, KVBLK = 64; constexpr float SCALE = 0.088388347648318440f; constexpr float THR = 8.f; constexpr int SDEPTH = 1;
constexpr int LDQ = NQ * HDIM, LDK = NKV * HDIM, LDO = DM;
constexpr size_t SHM_V = KVBLK * D * 2, SHM_K = KVBLK * D * 2, SHM_ATTN = 2 * SHM_V + 2 * SHM_K + NW * 64 * 4;
using bf16x8 = __attribute__((ext_vector_type(8))) short;
using s16x4  = __attribute__((ext_vector_type(4))) short;
using f32x16 = __attribute__((ext_vector_type(16))) float;
using f32x8  = __attribute__((ext_vector_type(8))) float;
using u32x4  = __attribute__((ext_vector_type(4))) unsigned;
#define KSWZ(row, colB) ((row) * 256 + ((colB) ^ (((row) & 7) << 4)))
#define SBAR() __builtin_amdgcn_sched_barrier(0)
__device__ __forceinline__ int crow(int r, int hi) { return (r & 3) + 8 * (r >> 2) + 4 * hi; }
__device__ __forceinline__ unsigned cvtpk(float lo, float hi) {
  unsigned r; asm volatile("v_cvt_pk_bf16_f32 %0, %1, %2" : "=v"(r) : "v"(lo), "v"(hi)); return r;
}
template <typename TIn> struct Stage;
template <> struct Stage<bf16>  { using T = bf16x8;
  __device__ static __forceinline__ T ld8(const bf16* p) { return *reinterpret_cast<const bf16x8*>(p); }
  __device__ static __forceinline__ bf16x8 tobf(T x) { return x; } };
__device__ __forceinline__ void partialSM(f32x16& p0, f32x16& p1, float& m_reg, float& mn, float& alpha) {
  constexpr float C = SCALE * 1.4426950408889634f;
  float pmax = p0[0]; for (int r = 1; r < 16; ++r) pmax = fmaxf(pmax, p0[r]); for (int r = 0; r < 16; ++r) pmax = fmaxf(pmax, p1[r]);
  { auto rr = __builtin_amdgcn_permlane32_swap(__float_as_uint(pmax), __float_as_uint(pmax), false, false);
    pmax = fmaxf(__uint_as_float(rr[0]), __uint_as_float(rr[1])); }
  if (__builtin_expect(__all(pmax - m_reg <= THR / SCALE), 1)) { mn = m_reg; alpha = 1.f; }
  else { mn = fmaxf(m_reg, pmax); alpha = __builtin_amdgcn_exp2f((m_reg - mn) * C); m_reg = mn; }
  float mnC = -mn * C;
  for (int r = 0; r < 16; ++r) p0[r] = fmaf(p0[r], C, mnC); for (int r = 0; r < 16; ++r) p1[r] = fmaf(p1[r], C, mnC);
  for (int r = 0; r < 16; ++r) p0[r] = __builtin_amdgcn_exp2f(p0[r]);
}
__device__ __forceinline__ void finishSM(f32x16& p0, f32x16& p1, float alpha, float& l_reg, bf16x8& pa0, bf16x8& pa1, bf16x8& pa2, bf16x8& pa3) {
  for (int r = 0; r < 16; ++r) p1[r] = __builtin_amdgcn_exp2f(p1[r]);
  float ps = 0; for (int r = 0; r < 16; ++r) ps += p0[r]; for (int r = 0; r < 16; ++r) ps += p1[r];
  { auto rr = __builtin_amdgcn_permlane32_swap(__float_as_uint(ps), __float_as_uint(ps), false, false);
    ps = __uint_as_float(rr[0]) + __uint_as_float(rr[1]); }
  l_reg = l_reg * alpha + ps;
#define PK4(P, BASE, OUT) do { unsigned a0 = cvtpk(P[BASE + 0], P[BASE + 1]), a1 = cvtpk(P[BASE + 2], P[BASE + 3]);   \
    unsigned b0 = cvtpk(P[BASE + 4], P[BASE + 5]), b1 = cvtpk(P[BASE + 6], P[BASE + 7]);                              \
    auto r0 = __builtin_amdgcn_permlane32_swap(a0, b0, false, false); auto r1 = __builtin_amdgcn_permlane32_swap(a1, b1, false, false); \
    u32x4 w = {r0[0], r1[0], r0[1], r1[1]}; OUT = *reinterpret_cast<bf16x8*>(&w); } while (0)
  PK4(p0, 0, pa0); PK4(p0, 8, pa1); PK4(p1, 0, pa2); PK4(p1, 8, pa3);
#undef PK4
}
__device__ __forceinline__ void qkt(f32x16& p0, f32x16& p1, const bf16* Ks, const bf16x8* qr, int r32, int hi) {
  p0 = f32x16{}; p1 = f32x16{};
  for (int d0 = 0; d0 < 8; ++d0) { int cb = (d0 * 16 + hi * 8) * 2;
    bf16x8 b0 = *reinterpret_cast<const bf16x8*>((const char*)Ks + KSWZ(r32, cb));
    bf16x8 b1 = *reinterpret_cast<const bf16x8*>((const char*)Ks + KSWZ(32 + r32, cb));
    p0 = __builtin_amdgcn_mfma_f32_32x32x16_bf16(b0, qr[d0], p0, 0, 0, 0);
    p1 = __builtin_amdgcn_mfma_f32_32x32x16_bf16(b1, qr[d0], p1, 0, 0, 0); }
}
__device__ __forceinline__ int v_st(int k, int c) { const int kk = (k & ~0xC) | ((k & 4) << 1) | ((k & 8) >> 1); return ((kk >> 3) * 4 + (c >> 5)) * 512 + ((kk & 7) * 32 + (c & 31)) * 2; }
__device__ __forceinline__ int v_rd_base(int lane) { return ((lane & 3) << 3) | (((lane >> 2) & 3) << 6) | (((lane >> 4) & 1) << 5) | (((lane >> 5) & 1) << 8); }
constexpr int v_rd_off(int d0, int ks, int half) { return d0 * 512 + ks * 4096 + half * 2048; }
template <int OFF> __device__ __forceinline__ s16x4 tr_read(int vb) {
  s16x4 r; asm volatile("ds_read_b64_tr_b16 %0, %1 offset:%2" : "=&v"(r) : "v"(vb), "i"(OFF) : "memory"); return r;
}
template <int D0> __device__ __forceinline__ void pv_one(f32x16& od, int vb, bf16x8 pa0, bf16x8 pa1, bf16x8 pa2, bf16x8 pa3) {
  const s16x4 l0 = tr_read<v_rd_off(D0, 0, 0)>(vb), h0 = tr_read<v_rd_off(D0, 0, 1)>(vb), l1 = tr_read<v_rd_off(D0, 1, 0)>(vb), h1 = tr_read<v_rd_off(D0, 1, 1)>(vb);
  const s16x4 l2 = tr_read<v_rd_off(D0, 2, 0)>(vb), h2 = tr_read<v_rd_off(D0, 2, 1)>(vb), l3 = tr_read<v_rd_off(D0, 3, 0)>(vb), h3 = tr_read<v_rd_off(D0, 3, 1)>(vb);
  asm volatile("s_waitcnt lgkmcnt(0)" ::: "memory"); SBAR();
#define PK(L, H) (bf16x8){L[0], L[1], L[2], L[3], H[0], H[1], H[2], H[3]}
  od = __builtin_amdgcn_mfma_f32_32x32x16_bf16(pa0, PK(l0, h0), od, 0, 0, 0);
  od = __builtin_amdgcn_mfma_f32_32x32x16_bf16(pa1, PK(l1, h1), od, 0, 0, 0);
  od = __builtin_amdgcn_mfma_f32_32x32x16_bf16(pa2, PK(l2, h2), od, 0, 0, 0);
  od = __builtin_amdgcn_mfma_f32_32x32x16_bf16(pa3, PK(l3, h3), od, 0, 0, 0);
#undef PK
}
__device__ __forceinline__ void pv_d0(f32x16* o, int vb, bf16x8 pa0, bf16x8 pa1, bf16x8 pa2, bf16x8 pa3) {
  pv_one<0>(o[0], vb, pa0, pa1, pa2, pa3); pv_one<1>(o[1], vb, pa0, pa1, pa2, pa3); pv_one<2>(o[2], vb, pa0, pa1, pa2, pa3); pv_one<3>(o[3], vb, pa0, pa1, pa2, pa3);
}

__device__ __forceinline__ void attn_dense_body(const bf16* __restrict__ Qb, const bf16* __restrict__ Kh, const bf16* __restrict__ Vh,
                                                bf16* __restrict__ Ob, int seq, char* lds) {
  typedef bf16 TQ;
  using St = Stage<bf16>; using SQ = Stage<TQ>;
  const int tid = tid_opaque(), wid = tid >> 6, lane = tid & 63, r32 = lane & 31, hi = lane >> 5;
  bf16* V_lds = (bf16*)lds; bf16* K_lds = (bf16*)(lds + 2 * SHM_V);
  float* ws = (float*)(lds + 2 * SHM_V + 2 * SHM_K) + wid * 64; float* li_l = ws; float* al_l = ws + 32;
  float m_reg = -1e30f, l_reg = 0; f32x16 o[4] = {}; bf16x8 qr[8];
  const TQ* Qw = Qb + (long)(wid * QBLK + r32) * LDQ + hi * 8;
#pragma unroll
  for (int d0 = 0; d0 < 8; ++d0) qr[d0] = SQ::tobf(SQ::ld8(Qw + d0 * 16));
  const int sr = tid >> 4, sc = (tid & 15) * 8, vst0 = v_st(sr, sc), vst1 = v_st(32 + sr, sc);
  const int vb0 = (int)(uintptr_t)V_lds + v_rd_base(lane);
  struct { typename St::T vs0, vs1, ks0, ks1; } sr_[SDEPTH];
#define SLOAD(i, k0) do { sr_[i].vs0 = St::ld8(&Vh[(long)((k0) + sr) * LDK + sc]); sr_[i].vs1 = St::ld8(&Vh[(long)((k0) + 32 + sr) * LDK + sc]); \
    sr_[i].ks0 = St::ld8(&Kh[(long)((k0) + sr) * LDK + sc]); sr_[i].ks1 = St::ld8(&Kh[(long)((k0) + 32 + sr) * LDK + sc]); } while (0)
#define SWRITE(b, i) do { *(bf16x8*)((char*)V_lds + (b) * SHM_V + vst0) = St::tobf(sr_[i].vs0);          \
    *(bf16x8*)((char*)V_lds + (b) * SHM_V + vst1) = St::tobf(sr_[i].vs1); int kc = sc * 2;               \
    *(bf16x8*)((char*)K_lds + (b) * SHM_K + KSWZ(sr, kc)) = St::tobf(sr_[i].ks0);                       \
    *(bf16x8*)((char*)K_lds + (b) * SHM_K + KSWZ(32 + sr, kc)) = St::tobf(sr_[i].ks1); } while (0)
#define SWAIT() do { if constexpr (SDEPTH == 2) asm volatile("s_waitcnt vmcnt(4)" ::: "memory"); else asm volatile("s_waitcnt vmcnt(0)" ::: "memory"); } while (0)
#define RESC(a) do { if (__any((a) < 1.f)) { if (hi == 0) al_l[r32] = (a); asm volatile("s_waitcnt lgkmcnt(0)" ::: "memory"); \
    for (int d = 0; d < 4; ++d) for (int r = 0; r < 16; ++r) o[d][r] *= al_l[crow(r, hi)]; } } while (0)
  f32x16 pA0, pA1, pB0, pB1; float mnA, mnB, alA, alB; bf16x8 pa0, pa1, pa2, pa3; const int NT = seq / KVBLK;
  constexpr int SE = 0, SO = SDEPTH - 1;
  SLOAD(SE, 0); asm volatile("s_waitcnt vmcnt(0)" ::: "memory"); SWRITE(0, SE); __syncthreads();
  qkt(pA0, pA1, K_lds, qr, r32, hi); partialSM(pA0, pA1, m_reg, mnA, alA);
  SLOAD(SO, KVBLK); if constexpr (SDEPTH == 2) { if (2 < NT) SLOAD(SE, 2 * KVBLK); }
  SWAIT(); SWRITE(1, SO); __syncthreads();
  for (int j = 1; j + 1 < NT; j += 2) {
    SBAR(); qkt(pB0, pB1, (bf16*)((char*)K_lds + SHM_K), qr, r32, hi);
    finishSM(pA0, pA1, alA, l_reg, pa0, pa1, pa2, pa3); SBAR();
    SLOAD(SO, (j + SDEPTH) * KVBLK); SBAR();
    pv_d0(o, vb0, pa0, pa1, pa2, pa3); partialSM(pB0, pB1, m_reg, mnB, alB);
    __syncthreads(); SWAIT(); SWRITE(0, SE);
    RESC(alB); __syncthreads();
    SBAR(); qkt(pA0, pA1, K_lds, qr, r32, hi);
    finishSM(pB0, pB1, alB, l_reg, pa0, pa1, pa2, pa3); SBAR();
    if (SDEPTH == 1 || j + 3 < NT) SLOAD(SE, (j + 1 + SDEPTH) * KVBLK); SBAR();
    pv_d0(o, vb0 + (int)SHM_V, pa0, pa1, pa2, pa3); partialSM(pA0, pA1, m_reg, mnA, alA);
    __syncthreads(); SWAIT(); SWRITE(1, SO);
    RESC(alA); __syncthreads();
  }
  SBAR(); qkt(pB0, pB1, (bf16*)((char*)K_lds + SHM_K), qr, r32, hi);
  finishSM(pA0, pA1, alA, l_reg, pa0, pa1, pa2, pa3); SBAR();
  pv_d0(o, vb0, pa0, pa1, pa2, pa3); partialSM(pB0, pB1, m_reg, mnB, alB);
  __syncthreads(); RESC(alB);
  finishSM(pB0, pB1, alB, l_reg, pa0, pa1, pa2, pa3); SBAR();
  pv_d0(o, vb0 + (int)SHM_V, pa0, pa1, pa2, pa3);
  if (hi == 0) li_l[r32] = l_reg; asm volatile("s_waitcnt lgkmcnt(0)" ::: "memory");
  float rli[16];
#pragma unroll
  for (int r = 0; r < 16; ++r) rli[r] = __builtin_amdgcn_rcpf(li_l[crow(r, hi)]);
  bf16* Ow = Ob + (long)(wid * QBLK) * LDO;
#pragma unroll
  for (int r = 0; r < 16; ++r) { int orow = crow(r, hi);
    for (int d0 = 0; d0 < 4; ++d0) Ow[(long)orow * LDO + d0 * 32 + r32] = f2bf(o[d0][r] * rli[r]); }
#undef SLOAD
#undef SWRITE
#undef SWAIT
#undef RESC
}
}
__device__ __forceinline__ void attn_phase(const Params& p, unsigned char* lds, int vcu, int G) {
    constexpr int QB = 256, LQB = LSEQ / QB, CQB = CSEQ / QB;
    constexpr int NUL = NLB * NQ * LQB, NUC = NCB * NQ * CQB, NU = NUL + NUC;
    const att::bf16* QR = (const att::bf16*)(p.ws + WS_QRAW); att::bf16* OB = (att::bf16*)(p.ws + WS_O);
    for (int i = 0;; ++i) {
        int u;
        if (G == 256 && NUL == 512) { if (i < 2) u = (vcu >> 5) * 64 + (vcu & 31) + 32 * i; else u = NUL + vcu + (i - 2) * G; }
        else u = vcu + i * G;
        if (u >= NU) break;
        const att::bf16 *Q, *K, *V; att::bf16* O; int seq;
        if (u < NUL) { const int grp = u / (GRP * LQB), j = u % (GRP * LQB); const int b = grp / NKV, kvh = grp % NKV, g = j / LQB, qb = j % LQB, hq = kvh * GRP + g;
            const size_t row0 = (size_t)MC + (size_t)b * LSEQ + (size_t)qb * QB;
            Q = QR + row0 * (NQ * HDIM) + hq * HDIM; O = OB + row0 * DM + hq * HDIM;
            K = (const att::bf16*)(p.ws + WS_LATK) + (size_t)b * SKVL * (NKV * HDIM) + kvh * HDIM; V = (const att::bf16*)(p.ws + WS_LATV) + (size_t)b * SKVL * (NKV * HDIM) + kvh * HDIM; seq = SKVL; }
        else { const int uc = u - NUL; const int b = uc / (NQ * CQB), r = uc % (NQ * CQB), hq = r / CQB, qb = r % CQB, kvh = hq / GRP;
            const size_t row0 = (size_t)b * CSEQ + (size_t)qb * QB;
            Q = QR + row0 * (NQ * HDIM) + hq * HDIM; O = OB + row0 * DM + hq * HDIM;
            K = (const att::bf16*)(p.ws + WS_CTXK) + (size_t)b * CSEQ * (NKV * HDIM) + kvh * HDIM; V = (const att::bf16*)(p.ws + WS_CTXV) + (size_t)b * CSEQ * (NKV * HDIM) + kvh * HDIM; seq = CSEQ; }
        __syncthreads();
        att::attn_dense_body(Q, K, V, O, seq, (char*)lds);
    }
}
static_assert(SKVL % 128 == 0 && CSEQ % 128 == 0 && LSEQ % 256 == 0 && CSEQ % 256 == 0, "attention tiling");
constexpr size_t WS_CST = 232 * MiB;
constexpr int NBLK = LSEQ / 256;
constexpr size_t WS_NST = WS_CST + (size_t)NLB * MH * 2 * NBLK * MDK * MDK * 2;
constexpr size_t WS_FTOT = WS_NST + (size_t)NLB * MH * 2 * NBLK * MDK * 4;
static_assert(WS_FTOT + (size_t)NLB * MH * 2 * NBLK * 4 <= WS_END && MDK == 128 && CSEQ == 256 && LSEQ % 256 == 0, "mLSTM fast path geometry");
namespace att {
constexpr int ML_OFF = 132096;
constexpr int ML_SC = ML_OFF + 6144;
constexpr int ML_N = ML_SC + 128;
constexpr int ML_LI = ML_N + 1024;
static_assert(ML_LI + 1024 <= LDS_BYTES, "mLSTM LDS map");
constexpr float L2E = 1.4426950408889634f;
using f32x4v = __attribute__((ext_vector_type(4))) float;


__device__ __forceinline__ void ml_gates(const Params& p, char* lds, int row0, int h, int tid) {
    float* A = (float*)(lds + ML_OFF); float* S = (float*)(lds + ML_SC);
    const int half = tid >> 8, t = tid & 255, tok = half ? 255 - t : t, lane = tid & 63, wv = (tid >> 6) & 3;
    const float* G = (const float*)(p.ws + WS_GATES) + (size_t)(row0 + tok) * NGATE + half * 8 + h;
    const float ig = G[0], lf = G[4];
    float v = lf;
#pragma unroll
    for (int off = 1; off < 64; off <<= 1) { const float u = lane_get(v, lane - off); if (lane >= off) v += u; }
    if (lane == 63) S[4 + half * 4 + wv] = v;
    __syncthreads();
    float pre = 0.f, tot = 0.f;
#pragma unroll
    for (int w = 0; w < 4; ++w) { const float x = S[4 + half * 4 + w]; if (w < wv) pre += x; tot += x; }
    const float P = v + pre, a = ig - P;
    A[(0 + half) * 256 + tok] = P * L2E; A[(2 + half) * 256 + tok] = a * L2E; A[(4 + half) * 256 + tok] = __builtin_amdgcn_exp2f(P * L2E);
    float mx = a;
    mx = fmaxf(mx, swz_xor<1>(mx)); mx = fmaxf(mx, swz_xor<2>(mx)); mx = fmaxf(mx, swz_xor<4>(mx)); mx = fmaxf(mx, swz_xor<8>(mx)); mx = fmaxf(mx, swz_xor<16>(mx)); mx = half_max(mx);
    if (lane == 0) S[12 + half * 4 + wv] = mx;
    if (t == 0) S[half] = tot;
    __syncthreads();
    if (t == 0) S[2 + half] = fmaxf(fmaxf(S[12 + half * 4], S[13 + half * 4]), fmaxf(S[14 + half * 4], S[15 + half * 4]));
    __syncthreads();
}
#define ML_PK(L, H) (bf16x8){L[0], L[1], L[2], L[3], H[0], H[1], H[2], H[3]}
__device__ __forceinline__ s16x4 tr_read_rt(int vb) { s16x4 r; asm volatile("ds_read_b64_tr_b16 %0, %1" : "=&v"(r) : "v"(vb) : "memory"); return r; }

__device__ __forceinline__ void ml_passA_unit(const Params& p, char* lds, int sid, int h, int blk) {
    const int tid = tid_opaque(), wid = tid >> 6, lane = tid & 63, r32 = lane & 31, hi = lane >> 5;
    const bool isctx = sid < NCB; const int row0 = seq_base(sid) + 256 * blk;
    __syncthreads();
    ml_gates(p, lds, row0, h, tid);
    float* A = (float*)(lds + ML_OFF); float* S = (float*)(lds + ML_SC); float* NA = (float*)(lds + ML_N);
    const bf16* QK = (const bf16*)(p.ws + WS_QKVO) + (size_t)row0 * (4 * MW) + h * MDK;
    const int sr = tid >> 4, sc8 = (tid & 15) * 8;
#pragma unroll
    for (int j = 0; j < 4; ++j)
#pragma unroll
        for (int hf = 0; hf < 2; ++hf) { const int row = 64 * j + 32 * hf + sr;
            *(bf16x8*)(lds + 65536 + j * 16384 + v_st(32 * hf + sr, sc8)) = *(const bf16x8*)(QK + (size_t)row * (4 * MW) + 2 * MW + sc8); }
    if (tid < 256) NA[tid] = 0.f;
    const int a = wid >> 1, dvb0 = 2 * (wid & 1);
    const int ldsb = (int)(uintptr_t)lds; const int vbK = ldsb + v_rd_base(lane) + a * 512, vbV = ldsb + 65536 + v_rd_base(lane) + dvb0 * 512;
    for (int dir = 0; dir < 2; ++dir) {
        __syncthreads();
        const float ft = S[dir], am = S[2 + dir]; const float mT = isctx ? ft + fmaxf(am, 0.f) : 0.f; const float wl2 = (ft - mT) * L2E;
        float xs[8];
#pragma unroll
        for (int i = 0; i < 8; ++i) xs[i] = 0.f;
#pragma unroll
        for (int j = 0; j < 4; ++j)
#pragma unroll
            for (int hf = 0; hf < 2; ++hf) { const int row = 64 * j + 32 * hf + sr; const float w = __builtin_amdgcn_exp2f(wl2 + A[(2 + dir) * 256 + row]);
                const bf16x8 k8 = *(const bf16x8*)(QK + (size_t)row * (4 * MW) + MW + sc8); float x[8];
#pragma unroll
                for (int i = 0; i < 8; ++i) { x[i] = bf2f((unsigned short)k8[i]) * w; xs[i] += x[i]; }
                u32x4 pk = {cvtpk(x[0], x[1]), cvtpk(x[2], x[3]), cvtpk(x[4], x[5]), cvtpk(x[6], x[7])};
                *(u32x4*)(lds + j * 16384 + v_st(32 * hf + sr, sc8)) = pk; }
#pragma unroll
        for (int i = 0; i < 8; ++i) { float v = xs[i]; v += swz_xor<16>(v); v = half_sum(v); if (lane < 16) atomicAdd(&NA[dir * 128 + sc8 + i], v); }
        __syncthreads();
        f32x16 acc0 = {}, acc1 = {}; const unsigned eoff = (unsigned)((32 * a + 4 * hi) * MDK + 32 * dvb0 + r32);
#pragma unroll
        for (int j = 0; j < 4; ++j)
#pragma unroll
            for (int ks = 0; ks < 4; ++ks) { const int off = j * 16384 + ks * 4096;
                const s16x4 al = tr_read_rt(vbK + off), ah = tr_read_rt(vbK + off + 2048);
                const s16x4 bl0 = tr_read_rt(vbV + off), bh0 = tr_read_rt(vbV + off + 2048), bl1 = tr_read_rt(vbV + off + 512), bh1 = tr_read_rt(vbV + off + 512 + 2048);
                asm volatile("s_waitcnt lgkmcnt(0)" ::: "memory"); SBAR();
                acc0 = __builtin_amdgcn_mfma_f32_32x32x16_bf16(ML_PK(al, ah), ML_PK(bl0, bh0), acc0, 0, 0, 0);
                acc1 = __builtin_amdgcn_mfma_f32_32x32x16_bf16(ML_PK(al, ah), ML_PK(bl1, bh1), acc1, 0, 0, 0); }
        if (isctx) {
            float* Co = p.out + O_C + ((size_t)(sid * 2 + dir) * MH + h) * MDK * MDK;
#pragma unroll
            for (int r = 0; r < 16; ++r) { const unsigned eo = eoff + (unsigned)(((r & 3) + 8 * (r >> 2)) * MDK); Co[eo] = acc0[r]; Co[eo + 32] = acc1[r]; }
            if (tid == 0) p.out[O_M + (size_t)(sid * 2 + dir) * MH + h] = mT;
        } else {
            const int b = sid - NCB; bf16* Cs = (bf16*)(p.ws + WS_CST) + ((size_t)((b * MH + h) * 2 + dir) * NBLK + blk) * MDK * MDK;
#pragma unroll
            for (int r = 0; r < 16; ++r) { const unsigned eo = eoff + (unsigned)(((r & 3) + 8 * (r >> 2)) * MDK); Cs[eo] = f2bf(acc0[r]); Cs[eo + 32] = f2bf(acc1[r]); }
            if (tid == 0) ((float*)(p.ws + WS_FTOT))[((size_t)(b * MH + h) * 2 + dir) * NBLK + blk] = ft;
        }
    }
    __syncthreads();
    if (tid < 256) { const int dir = tid >> 7, d = tid & 127;
        if (isctx) p.out[O_N + ((size_t)(sid * 2 + dir) * MH + h) * MDK + d] = NA[tid];
        else { const int b = sid - NCB; ((float*)(p.ws + WS_NST))[(((size_t)(b * MH + h) * 2 + dir) * NBLK + blk) * MDK + d] = NA[tid]; } }
}

template <int DIR> __device__ __forceinline__ void ml_tile(f32x16* o, float& den, const bf16x8* qr, const char* Ktile, int vbV, const float* AL2, int j, float cq, int trow, bool diag, int r32, int hi) {
    SBAR(); f32x16 p0, p1; qkt(p0, p1, (const bf16*)Ktile, qr, r32, hi); SBAR();
    float ds = 0.f; const int tl = trow - 64 * j - 4 * hi;
#pragma unroll
    for (int g = 0; g < 4; ++g) { const f32x4v a0 = *(const f32x4v*)(AL2 + 64 * j + 8 * g + 4 * hi), a1 = *(const f32x4v*)(AL2 + 64 * j + 32 + 8 * g + 4 * hi);
#pragma unroll
        for (int e = 0; e < 4; ++e) { float w0 = __builtin_amdgcn_exp2f(cq + a0[e]), w1 = __builtin_amdgcn_exp2f(cq + a1[e]);
            if (diag) { if (DIR == 0 ? (8 * g + e > tl) : (8 * g + e < tl)) w0 = 0.f; if (DIR == 0 ? (8 * g + e + 32 > tl) : (8 * g + e + 32 < tl)) w1 = 0.f; }
            p0[4 * g + e] *= w0; p1[4 * g + e] *= w1; ds += p0[4 * g + e] + p1[4 * g + e]; } }
    den += ds;
    bf16x8 pa0, pa1, pa2, pa3;
#define PK4(P, BASE, OUT) do { unsigned a0_ = cvtpk(P[BASE + 0], P[BASE + 1]), a1_ = cvtpk(P[BASE + 2], P[BASE + 3]);   \
    unsigned b0_ = cvtpk(P[BASE + 4], P[BASE + 5]), b1_ = cvtpk(P[BASE + 6], P[BASE + 7]);                              \
    auto r0_ = __builtin_amdgcn_permlane32_swap(a0_, b0_, false, false); auto r1_ = __builtin_amdgcn_permlane32_swap(a1_, b1_, false, false); \
    u32x4 w_ = {r0_[0], r1_[0], r0_[1], r1_[1]}; OUT = *reinterpret_cast<bf16x8*>(&w_); } while (0)
    PK4(p0, 0, pa0); PK4(p0, 8, pa1); PK4(p1, 0, pa2); PK4(p1, 8, pa3);
#undef PK4
    SBAR(); pv_d0(o, vbV, pa0, pa1, pa2, pa3); SBAR();
}
__device__ __forceinline__ void ml_stage_kv(char* lds, const bf16* QK, int tile0, int sr, int sc8) {
#pragma unroll
    for (int jj = 0; jj < 2; ++jj)
#pragma unroll
        for (int hf = 0; hf < 2; ++hf) { const int rl = 32 * hf + sr, row = 64 * (tile0 + jj) + rl;
            const bf16x8 k8 = *(const bf16x8*)(QK + (size_t)row * (4 * MW) + MW + sc8), v8 = *(const bf16x8*)(QK + (size_t)row * (4 * MW) + 2 * MW + sc8);
            *(bf16x8*)(lds + jj * 16384 + KSWZ(rl, sc8 * 2)) = k8; *(bf16x8*)(lds + 32768 + jj * 16384 + v_st(rl, sc8)) = v8; }
}
__device__ __forceinline__ void ml_passC_unit(const Params& p, char* lds, int sid, int h, int blk) {
    const int tid = tid_opaque(), wid = tid >> 6, lane = tid & 63, r32 = lane & 31, hi = lane >> 5;
    const bool isctx = sid < NCB; const int row0 = seq_base(sid) + 256 * blk; const int wq = wid >> 1;
    __syncthreads();
    ml_gates(p, lds, row0, h, tid);
    float* A = (float*)(lds + ML_OFF); float* NS = (float*)(lds + ML_N); float* li = (float*)(lds + ML_LI) + wid * 32;
    const bf16* QK = (const bf16*)(p.ws + WS_QKVO) + (size_t)row0 * (4 * MW) + h * MDK;
    const int sr = tid >> 4, sc8 = (tid & 15) * 8; const int b = sid - NCB;
    if (tid < 256) { const int dir = tid >> 7, d = tid & 127;
        NS[tid] = isctx ? 0.f : ((const float*)(p.ws + WS_NST))[(((size_t)(b * MH + h) * 2 + dir) * NBLK + blk) * MDK + d]; }
    if (!isctx) {
#pragma unroll
        for (int dir = 0; dir < 2; ++dir) { const bf16* Cs = (const bf16*)(p.ws + WS_CST) + ((size_t)((b * MH + h) * 2 + dir) * NBLK + blk) * MDK * MDK;
#pragma unroll
            for (int c4 = 0; c4 < 4; ++c4) { const int c = tid + 512 * c4, row = c >> 4, col8 = (c & 15) * 8;
                *(bf16x8*)(lds + 65536 + dir * 32768 + (row >> 6) * 16384 + v_st(row & 63, col8)) = *(const bf16x8*)(Cs + (size_t)row * MDK + col8); } }
    }
    bf16x8 qr[8];
    { const bf16* Qw = QK + (size_t)(wid * 32 + r32) * (4 * MW) + hi * 8;
#pragma unroll
        for (int d0 = 0; d0 < 8; ++d0) qr[d0] = *(const bf16x8*)(Qw + d0 * 16); }
    ml_stage_kv(lds, QK, 0, sr, sc8);
    __syncthreads();
    float qn_f = 0.f, qn_b = 0.f;
#pragma unroll
    for (int d0 = 0; d0 < 8; ++d0)
#pragma unroll
        for (int i = 0; i < 8; ++i) { const float qv = bf2f((unsigned short)qr[d0][i]); qn_f += qv * NS[d0 * 16 + hi * 8 + i]; qn_b += qv * NS[128 + d0 * 16 + hi * 8 + i]; }
    qn_f = half_sum(qn_f); qn_b = half_sum(qn_b);
    const int ldsb = (int)(uintptr_t)lds; const int vbV = ldsb + 32768 + v_rd_base(lane), vbC = ldsb + 65536 + v_rd_base(lane);
    const int trow = wid * 32 + r32;
    float* HS = (float*)(p.ws + WS_HS) + (size_t)(row0 + wid * 32) * MW + h * MDK;
    f32x16 o[4]; const unsigned hso = (unsigned)(4 * hi * MW + r32), uho = (unsigned)(4 * hi * DM + r32), ogo = (unsigned)(4 * hi * 4 * MW + r32);
    {
        float qn = qn_f;
        o[0] = f32x16{}; o[1] = f32x16{}; o[2] = f32x16{}; o[3] = f32x16{};
        if (!isctx) { pv_d0(o, vbC, qr[0], qr[1], qr[2], qr[3]); pv_d0(o, vbC + 16384, qr[4], qr[5], qr[6], qr[7]);
#pragma unroll
            for (int r = 0; r < 16; ++r) { const float e = A[4 * 256 + wid * 32 + crow(r, hi)];
#pragma unroll
                for (int d0 = 0; d0 < 4; ++d0) o[d0][r] *= e; } }
        const float cq = A[0 * 256 + trow]; float den = 0.f;
        ml_tile<0>(o, den, qr, lds, vbV, A + 2 * 256, 0, cq, trow, wq == 0, r32, hi);
        if (wq >= 1) ml_tile<0>(o, den, qr, lds + 16384, vbV + 16384, A + 2 * 256, 1, cq, trow, wq == 1, r32, hi);
        __syncthreads(); ml_stage_kv(lds, QK, 2, sr, sc8); __syncthreads();
        if (wq >= 2) ml_tile<0>(o, den, qr, lds, vbV, A + 2 * 256, 2, cq, trow, wq == 2, r32, hi);
        if (wq >= 3) ml_tile<0>(o, den, qr, lds + 16384, vbV + 16384, A + 2 * 256, 3, cq, trow, wq == 3, r32, hi);
        { auto rr = __builtin_amdgcn_permlane32_swap(__float_as_uint(den), __float_as_uint(den), false, false); den = __uint_as_float(rr[0]) + __uint_as_float(rr[1]); }
        const float dn = den + __builtin_amdgcn_exp2f(cq) * qn; const float inv = 1.0f / fmaxf(fabsf(dn), 1.0f);
        if (hi == 0) li[r32] = inv; asm volatile("s_waitcnt lgkmcnt(0)" ::: "memory");
#pragma unroll
        for (int r = 0; r < 16; ++r) { const float rl = li[crow(r, hi)]; const unsigned eo = hso + (unsigned)(((r & 3) + 8 * (r >> 2)) * MW);
#pragma unroll
            for (int d0 = 0; d0 < 4; ++d0) HS[eo + d0 * 32] = o[d0][r] * rl;
            asm volatile("" ::: "memory"); }
    }
    {
        float qn = qn_b;
        o[0] = f32x16{}; o[1] = f32x16{}; o[2] = f32x16{}; o[3] = f32x16{};
        if (!isctx) { pv_d0(o, vbC + 32768, qr[0], qr[1], qr[2], qr[3]); pv_d0(o, vbC + 32768 + 16384, qr[4], qr[5], qr[6], qr[7]);
#pragma unroll
            for (int r = 0; r < 16; ++r) { const float e = A[5 * 256 + wid * 32 + crow(r, hi)];
#pragma unroll
                for (int d0 = 0; d0 < 4; ++d0) o[d0][r] *= e; } }
        const float cq = A[1 * 256 + trow]; float den = 0.f;
        ml_tile<1>(o, den, qr, lds + 16384, vbV + 16384, A + 3 * 256, 3, cq, trow, wq == 3, r32, hi);
        if (wq <= 2) ml_tile<1>(o, den, qr, lds, vbV, A + 3 * 256, 2, cq, trow, wq == 2, r32, hi);
        __syncthreads(); ml_stage_kv(lds, QK, 0, sr, sc8); __syncthreads();
        if (wq <= 1) ml_tile<1>(o, den, qr, lds + 16384, vbV + 16384, A + 3 * 256, 1, cq, trow, wq == 1, r32, hi);
        if (wq <= 0) ml_tile<1>(o, den, qr, lds, vbV, A + 3 * 256, 0, cq, trow, wq == 0, r32, hi);
        { auto rr = __builtin_amdgcn_permlane32_swap(__float_as_uint(den), __float_as_uint(den), false, false); den = __uint_as_float(rr[0]) + __uint_as_float(rr[1]); }
        const float dn = den + __builtin_amdgcn_exp2f(cq) * qn; const float inv = 1.0f / fmaxf(fabsf(dn), 1.0f);
        asm volatile("s_waitcnt vmcnt(0)" ::: "memory");
        if (hi == 0) li[r32] = inv; asm volatile("s_waitcnt lgkmcnt(0)" ::: "memory");
        float mg[4];
#pragma unroll
        for (int d0 = 0; d0 < 4; ++d0) mg[d0] = p.mng[h * MDK + d0 * 32 + r32];
        const bf16* OG = QK + (size_t)(wid * 32) * (4 * MW) + 3 * MW; bf16* UHo = (bf16*)(p.ws + WS_UH) + (size_t)(row0 + wid * 32) * DM + CCH + h * MDK;
#pragma unroll
        for (int r = 0; r < 16; ++r) { const float rl = li[crow(r, hi)]; const int rc = (r & 3) + 8 * (r >> 2); float ss = 0.f;
#pragma unroll
            for (int d0 = 0; d0 < 4; ++d0) { const float hf = __hip_atomic_load(HS + hso + (unsigned)(rc * MW + d0 * 32), __ATOMIC_RELAXED, __HIP_MEMORY_SCOPE_AGENT); const float x = hf + o[d0][r] * rl; o[d0][r] = x; ss += x * x; }
            ss += swz_xor<1>(ss); ss += swz_xor<2>(ss); ss += swz_xor<4>(ss); ss += swz_xor<8>(ss); ss += swz_xor<16>(ss);
            const float rs = 1.0f / sqrtf(ss * (1.0f / MDK) + EPSF);
#pragma unroll
            for (int d0 = 0; d0 < 4; ++d0) UHo[uho + (unsigned)(rc * DM + d0 * 32)] = f2bf(bf2f(OG[ogo + (unsigned)(rc * 4 * MW + d0 * 32)]) * o[d0][r] * rs * mg[d0]);
            asm volatile("" ::: "memory"); }
    }
}
}

struct MlScan {
    Params p; static HD_FN long count() { return (long)NLB * MH * 2 * (MDK * MDK + MDK); }
    HD_FN void operator()(long idx) const {
        const int per = MDK * MDK + MDK; const int e = (int)(idx % per); const int ch = (int)(idx / per); const int dir = ch & 1, h = (ch >> 1) % MH, b = ch / (2 * MH);
        const float em = expf(p.stm[(size_t)(b * 2 + dir) * MH + h]); const float* FT = (const float*)(p.ws + WS_FTOT) + (size_t)ch * NBLK;
        if (e < MDK * MDK) { bf16_t* Cs = (bf16_t*)(p.ws + WS_CST) + (size_t)ch * NBLK * MDK * MDK + e; float c = p.stC[((size_t)(b * 2 + dir) * MH + h) * MDK * MDK + e] * em;
            for (int i = 0; i < NBLK; ++i) { const int blk = dir == 0 ? i : NBLK - 1 - i; const float d = bf2f(Cs[(size_t)blk * MDK * MDK]); Cs[(size_t)blk * MDK * MDK] = f2bf(c); c = expf(FT[blk]) * c + d; } }
        else { const int d_ = e - MDK * MDK; float* Ns = (float*)(p.ws + WS_NST) + (size_t)ch * NBLK * MDK + d_; float c = p.stn[((size_t)(b * 2 + dir) * MH + h) * MDK + d_] * em;
            for (int i = 0; i < NBLK; ++i) { const int blk = dir == 0 ? i : NBLK - 1 - i; const float d = Ns[(size_t)blk * MDK]; Ns[(size_t)blk * MDK] = c; c = expf(FT[blk]) * c + d; } }
    }
};
__device__ __forceinline__ void ml_phase_A(const Params& p, unsigned char* lds, int vcu, int G) {
    constexpr int NUL = NLB * MH * NBLK, NU = NUL + NCB * MH;
    for (int u = vcu; u < NU; u += G) {
        if (u < NUL) att::ml_passA_unit(p, (char*)lds, NCB + u / (MH * NBLK), (u / NBLK) % MH, u % NBLK);
        else att::ml_passA_unit(p, (char*)lds, (u - NUL) / MH, (u - NUL) % MH, 0); }
}
__device__ __forceinline__ void ml_phase_C(const Params& p, unsigned char* lds, int vcu, int G) {
    constexpr int NUL = NLB * MH * NBLK, NU = NUL + NCB * MH;
    for (int u = vcu; u < NU; u += G) {
        if (u < NUL) att::ml_passC_unit(p, (char*)lds, NCB + u / (MH * NBLK), (u / NBLK) % MH, u % NBLK);
        else att::ml_passC_unit(p, (char*)lds, (u - NUL) / MH, (u - NUL) % MH, 0); }
}
typedef float f4 __attribute__((ext_vector_type(4)));
typedef unsigned u4 __attribute__((ext_vector_type(4)));
typedef unsigned u2 __attribute__((ext_vector_type(2)));
__device__ __forceinline__ float wave_sum64(float v) { v += swz_xor<1>(v); v += swz_xor<2>(v); v += swz_xor<4>(v); v += swz_xor<8>(v); v += swz_xor<16>(v); return half_sum(v); }
__device__ __forceinline__ float fsilu(float x) { return x * fsigmoid(x); }

__device__ __forceinline__ void phase_mod(const Params& p, char* lds, int bx, int G) {
    const int tid = tid_opaque(), lane = tid & 63, wave = tid >> 6;
    float* SL = (float*)lds; float* PT = (float*)(lds + 32768);
    constexpr int NCG = 6 * DM / 64, NIT = 2 * NCG;
    if (bx >= NIT) return;
    __syncthreads();
    for (int i = tid; i < NCLS * DM; i += NTHREADS) { const int cls = i / DM, k = i % DM; const float cv = cls == 0 ? p.cctx[k] : p.c[(size_t)(cls - 1) * DM + k]; SL[i] = fsilu(cv); }
    for (int item = bx; item < NIT; item += G) {
        __syncthreads();
        const int l = item / NCG, cg = item % NCG; const float* w = p.wmod + (size_t)l * DM * 6 * DM + cg * 64 + lane;
        float acc[NCLS];
#pragma unroll
        for (int r = 0; r < NCLS; ++r) acc[r] = 0.f;
        const int k0 = wave * (DM / 8);
#pragma unroll 8
        for (int k = k0; k < k0 + DM / 8; ++k) { const float wv = w[(size_t)k * 6 * DM];
#pragma unroll
            for (int r = 0; r < NCLS; ++r) acc[r] += SL[r * DM + k] * wv; }
#pragma unroll
        for (int r = 0; r < NCLS; ++r) PT[(wave * NCLS + r) * 64 + lane] = acc[r];
        __syncthreads();
        if (tid < NCLS * 64) { const int r = tid >> 6; float s = p.bmod[(size_t)l * 6 * DM + cg * 64 + lane];
#pragma unroll
            for (int w8 = 0; w8 < 8; ++w8) s += PT[(w8 * NCLS + r) * 64 + lane];
            ((float*)(p.ws + WS_MOD))[((size_t)(l * NCLS + r) * 6 * DM) + cg * 64 + lane] = s; }
    }
}
__device__ __forceinline__ void sw_job(const Params& p, const bf16_t* Bt, int nrows, int l, int which, float* sw, int N, int mode, int gw, int NGW, int lane) {
    for (int n = gw; n < nrows; n += NGW) {
        const u4 w0 = *(const u4*)(Bt + (size_t)n * DM + lane * 8), w1 = *(const u4*)(Bt + (size_t)n * DM + DM / 2 + lane * 8);
        float wf[16];
#pragma unroll
        for (int i = 0; i < 4; ++i) { wf[2 * i] = __uint_as_float(w0[i] << 16); wf[2 * i + 1] = __uint_as_float(w0[i] & 0xffff0000u); wf[8 + 2 * i] = __uint_as_float(w1[i] << 16); wf[8 + 2 * i + 1] = __uint_as_float(w1[i] & 0xffff0000u); }
        int col = n; if (mode == 1) { const int t = n >> 8, r = n & 255; col = r < 128 ? 128 * t + r : (N / 2) + 128 * t + (r - 128); }
#pragma unroll
        for (int cls = 0; cls < NCLS; ++cls) { const float* sh = modv(p, l, cls, which);
            const f4 a0 = *(const f4*)(sh + lane * 8), a1 = *(const f4*)(sh + lane * 8 + 4), b0 = *(const f4*)(sh + DM / 2 + lane * 8), b1 = *(const f4*)(sh + DM / 2 + lane * 8 + 4);
            float s = (a0[0] * wf[0] + a0[1] * wf[1]) + (a0[2] * wf[2] + a0[3] * wf[3]) + (a1[0] * wf[4] + a1[1] * wf[5]) + (a1[2] * wf[6] + a1[3] * wf[7])
                    + (b0[0] * wf[8] + b0[1] * wf[9]) + (b0[2] * wf[10] + b0[3] * wf[11]) + (b1[0] * wf[12] + b1[1] * wf[13]) + (b1[2] * wf[14] + b1[3] * wf[15]);
            s = wave_sum64(s); if (lane == 0) sw[(size_t)cls * N + col] = s; }
    }
}
static_assert(DM == 1024, "sw_job / norm passes assume 1024 = 64 lanes x 16");
__device__ __forceinline__ void phase_norm0(const Params& p, char* lds, int bx, int G) {
    const int tid = tid_opaque(), lane = tid & 63, wave = tid >> 6;
    float* WG = (float*)lds;
    __syncthreads();
    for (int i = tid; i < NGATE * DM; i += NTHREADS) { const int k = i / NGATE, g = i % NGATE; WG[g * DM + k] = p.winab[(size_t)k * ABIN + ABMAIN + g]; }
    __syncthreads();
    const int gw = bx * NWAVES + wave, NGW = G * NWAVES;
    for (int row = gw; row < MTOK; row += NGW) {
        const int cls = cls_of(row); const f4* xr = (const f4*)xrow(p, row) + lane;
        const f4* g4 = (const f4*)p.n1g + lane; const f4* sc4 = (const f4*)modv(p, 0, cls, 1) + lane; const f4* sh4 = (const f4*)modv(p, 0, cls, 0) + lane;
        f4 v[4]; float s = 0.f;
#pragma unroll
        for (int j = 0; j < 4; ++j) { v[j] = xr[64 * j]; s += (v[j][0] * v[j][0] + v[j][1] * v[j][1]) + (v[j][2] * v[j][2] + v[j][3] * v[j][3]); }
        const float rs = 1.0f / sqrtf(wave_sum64(s) * (1.0f / DM) + EPSF);
        bf16_t* xo = (bf16_t*)(p.ws + WS_XN) + (size_t)row * DM + lane * 4;
#pragma unroll
        for (int j = 0; j < 4; ++j) { const f4 gg = g4[64 * j], sc = sc4[64 * j], sh = sh4[64 * j]; v[j] = v[j] * rs * gg * (sc + 1.0f) + sh;
            u2 w; w.x = pg8::cvt_pk_bf16(v[j][0], v[j][1]); w.y = pg8::cvt_pk_bf16(v[j][2], v[j][3]); *(u2*)(xo + 256 * j) = w; }
        float mine = 0.f;
#pragma unroll
        for (int g = 0; g < NGATE; ++g) { float a = 0.f;
#pragma unroll
            for (int j = 0; j < 4; ++j) { const f4 w = *(const f4*)(WG + g * DM + 256 * j + lane * 4); a += (v[j][0] * w[0] + v[j][1] * w[1]) + (v[j][2] * w[2] + v[j][3] * w[3]); }
            a = wave_sum64(a); if (lane == g) mine = a; }
        if (lane < NGATE) { float a = mine + p.bgate[lane]; if ((lane & 7) >= 4) a = logsigmoidf_(a); ((float*)(p.ws + WS_GATES))[(size_t)row * NGATE + lane] = a; }
    }
}
__device__ __forceinline__ void phase_conv(const Params& p, char* lds, int vcu, int G) {
    const int tid = tid_opaque(), lane = tid & 63, wave = tid >> 6; constexpr int TT = 32, NR = TT + CWID - 1;
    bf16_t* X = (bf16_t*)lds; float* OUT = (float*)(lds + 65536);
    const int cp = tid & 255, tg = tid >> 8, c0 = 2 * cp;
    float w0[CWID], w1[CWID];
#pragma unroll
    for (int j = 0; j < CWID; ++j) { w0[j] = p.convw[(size_t)j * CCH + c0]; w1[j] = p.convw[(size_t)j * CCH + c0 + 1]; }
    const float b0 = p.convb[c0], b1 = p.convb[c0 + 1];
    const bf16_t* U = (const bf16_t*)(p.ws + WS_UPRE);
    for (int u = vcu; u < MTOK / TT; u += G) {
        const int row0 = u * TT, pos0 = pos_of(row0), len = seqlen_of(row0);
        __syncthreads();
        for (int c = tid; c < NR * (CCH / 8); c += NTHREADS) { const int r = c / (CCH / 8), ch = (c % (CCH / 8)) * 8; const int t = pos0 + r - CWID / 2;
            u4 val = {0u, 0u, 0u, 0u}; if (t >= 0 && t < len) val = *(const u4*)(U + (size_t)(row0 + r - CWID / 2) * CCH + ch);
            *(u4*)(X + (size_t)r * CCH + ch) = val; }
        __syncthreads();
#pragma unroll 2
        for (int tt = 0; tt < TT / 2; ++tt) { const int t = tg * (TT / 2) + tt; float a0 = b0, a1 = b1;
#pragma unroll
            for (int j = 0; j < CWID; ++j) { const unsigned xx = *(const unsigned*)(X + (size_t)(t + j) * CCH + c0); a0 += w0[j] * __uint_as_float(xx << 16); a1 += w1[j] * __uint_as_float(xx & 0xffff0000u); }
            *(float2*)(OUT + (size_t)t * CCH + c0) = make_float2(a0, a1); }
        __syncthreads();
#pragma unroll
        for (int q = 0; q < TT / NWAVES; ++q) { const int t = wave * (TT / NWAVES) + q; const f4 x0 = *(const f4*)(OUT + (size_t)t * CCH + lane * 8), x1 = *(const f4*)(OUT + (size_t)t * CCH + lane * 8 + 4);
            const float mu = wave_sum64((x0[0] + x0[1]) + (x0[2] + x0[3]) + (x1[0] + x1[1]) + (x1[2] + x1[3])) * (1.0f / CCH);
            const f4 d0 = x0 - mu, d1 = x1 - mu;
            const float var = wave_sum64((d0[0] * d0[0] + d0[1] * d0[1]) + (d0[2] * d0[2] + d0[3] * d0[3]) + (d1[0] * d1[0] + d1[1] * d1[1]) + (d1[2] * d1[2] + d1[3] * d1[3])) * (1.0f / CCH);
            const float rs = 1.0f / sqrtf(var + EPSF);
            const f4 g0 = *(const f4*)(p.lng + lane * 8), g1 = *(const f4*)(p.lng + lane * 8 + 4), be0 = *(const f4*)(p.lnb + lane * 8), be1 = *(const f4*)(p.lnb + lane * 8 + 4);
            const f4 y0 = d0 * rs * g0 + be0, y1 = d1 * rs * g1 + be1; u4 w;
            w.x = pg8::cvt_pk_bf16(fsilu(y0[0]), fsilu(y0[1])); w.y = pg8::cvt_pk_bf16(fsilu(y0[2]), fsilu(y0[3])); w.z = pg8::cvt_pk_bf16(fsilu(y1[0]), fsilu(y1[1])); w.w = pg8::cvt_pk_bf16(fsilu(y1[2]), fsilu(y1[3]));
            *(u4*)((bf16_t*)(p.ws + WS_UH) + (size_t)(row0 + t) * DM + lane * 8) = w; }
    }
}
static_assert(CCH == 512 && CSEQ % 32 == 0 && LSEQ % 32 == 0, "conv phase geometry");
__device__ __forceinline__ void phase_cachecvt(const Params& p, int gtid, int gthreads) {
    constexpr int PER = PAST * NKV * HDIM / 8;
    for (int i = gtid; i < NLB * PER; i += gthreads) { const int b = i / PER, e = (i % PER) * 8; const size_t src = (size_t)b * PAST * NKV * HDIM + e, dst = ((size_t)b * SKVL + LSEQ) * NKV * HDIM + e;
        const f4 k0 = *(const f4*)(p.ck + src), k1 = *(const f4*)(p.ck + src + 4), v0 = *(const f4*)(p.cv + src), v1 = *(const f4*)(p.cv + src + 4); u4 wk, wv;
        wk.x = pg8::cvt_pk_bf16(k0[0], k0[1]); wk.y = pg8::cvt_pk_bf16(k0[2], k0[3]); wk.z = pg8::cvt_pk_bf16(k1[0], k1[1]); wk.w = pg8::cvt_pk_bf16(k1[2], k1[3]);
        wv.x = pg8::cvt_pk_bf16(v0[0], v0[1]); wv.y = pg8::cvt_pk_bf16(v0[2], v0[3]); wv.z = pg8::cvt_pk_bf16(v1[0], v1[1]); wv.w = pg8::cvt_pk_bf16(v1[2], v1[3]);
        *(u4*)((bf16_t*)(p.ws + WS_LATK) + dst) = wk; *(u4*)((bf16_t*)(p.ws + WS_LATV) + dst) = wv; }
}
__device__ __forceinline__ void phase_qkpost(const Params& p, int gw, int NGW, int lane) {
    const int f = lane & 31, hf = lane >> 5, d1 = hf * 64 + f, d2 = d1 + 32;
    const float inv = __builtin_amdgcn_exp2f(-(float)f * (13.287712379549449f / 32.0f));
    const float qg1 = p.qng[d1], qg2 = p.qng[d2], kg1 = p.kng[d1], kg2 = p.kng[d2];
    for (int row = gw; row < MTOK; row += NGW) {
        const bool lat = row >= MC; const int sp = pos_of(row); float cs = 1.f, sn = 0.f;
        if (lat) { const float ang = (float)(hf == 0 ? sp / GRIDW : sp % GRIDW) * inv; cs = cosf(ang); sn = sinf(ang); }
        bf16_t* Q = (bf16_t*)(p.ws + WS_QRAW) + (size_t)row * NQ * HDIM; const bf16_t* KR = (const bf16_t*)(p.ws + WS_KRAW) + (size_t)row * NKV * HDIM;
#pragma unroll
        for (int j = 0; j < NQ; ++j) { const float x1 = bf2f(Q[j * HDIM + d1]), x2 = bf2f(Q[j * HDIM + d2]);
            const float rs = 1.0f / sqrtf(wave_sum64(x1 * x1 + x2 * x2) * (1.0f / HDIM) + EPSF); const float a = x1 * rs * qg1, b = x2 * rs * qg2;
            Q[j * HDIM + d1] = f2bf(a * cs - b * sn); Q[j * HDIM + d2] = f2bf(a * sn + b * cs); }
#pragma unroll
        for (int j = 0; j < NKV; ++j) { const float x1 = bf2f(KR[j * HDIM + d1]), x2 = bf2f(KR[j * HDIM + d2]);
            const float rs = 1.0f / sqrtf(wave_sum64(x1 * x1 + x2 * x2) * (1.0f / HDIM) + EPSF); const float a = x1 * rs * kg1, b = x2 * rs * kg2;
            const float y1 = a * cs - b * sn, y2 = a * sn + b * cs;
            if (!lat) { bf16_t* K = (bf16_t*)(p.ws + WS_CTXK) + (size_t)row * NKV * HDIM + j * HDIM; K[d1] = f2bf(y1); K[d2] = f2bf(y2); float* fo = p.out + O_K + (size_t)row * NKV * HDIM + j * HDIM; fo[d1] = y1; fo[d2] = y2; }
            else { const int b_ = (row - MC) / LSEQ, s_ = (row - MC) % LSEQ; bf16_t* K = (bf16_t*)(p.ws + WS_LATK) + ((size_t)b_ * SKVL + s_) * NKV * HDIM + j * HDIM; K[d1] = f2bf(y1); K[d2] = f2bf(y2); } }
    }
}
__device__ __forceinline__ void phase_final(const Params& p, int gw, int NGW, int lane) {
    const f4* g4 = (const f4*)p.fng + lane;
    for (int row = gw; row < MTOK; row += NGW) { const float rs = 1.0f / sqrtf(((const float*)(p.ws + WS_SSQ))[(size_t)3 * SSQ_STRIDE + row] * (1.0f / DM) + EPSF);
        f4* y = (f4*)(p.out + O_Y + (size_t)row * DM) + lane;
#pragma unroll
        for (int j = 0; j < 4; ++j) y[64 * j] = y[64 * j] * rs * g4[64 * j]; }
}
template <class Epi> __device__ __forceinline__ void gemm_call(LAS unsigned char* lds, const bf16_t* A, const bf16_t* Bt, int N, int K, const Epi& E) {
    pg8::Gemm g{A, Bt, MTOK, N, K}; pg8::StaticOrder S; S.init(MTOK, N, (int)gridDim.x, (int)blockIdx.x);
    pg8::gemm_phase<Epi, pg8::StaticOrder, true, true>((PG8_LAS unsigned char*)lds, g, S, E);
}
__global__ void __launch_bounds__(NTHREADS, 2) mega_fwd(Params p) {
    extern __shared__ __attribute__((aligned(16))) unsigned char lds[];
    LAS unsigned char* L = (LAS unsigned char*)lds;
    for (int u = threadIdx.x; u < (LDS_BYTES - LDSCTL_OFF) / 4; u += NTHREADS) ((LAS unsigned*)(L + LDSCTL_OFF))[u] = 0u;
    __syncthreads();
    volatile LAS unsigned* MISC = (volatile LAS unsigned*)(L + MISC_OFF);
    const XcdBarrier bar = xcd_barrier_post((unsigned*)(p.ws + WS_CTL) + CW_BAR, MISC + 8);
    const int G = gridDim.x, bx = blockIdx.x; const int vcu = (G % 8 == 0) ? (bx % 8) * (G / 8) + bx / 8 : bx;
    unsigned char* ws = p.ws;
    const bf16_t* XN = (const bf16_t*)(ws + WS_XN); const bf16_t* UH = (const bf16_t*)(ws + WS_UH); const bf16_t* Hh = (const bf16_t*)(ws + WS_H); const bf16_t* Ob = (const bf16_t*)(ws + WS_O);
    float* SW0 = (float*)(ws + WS_SW); float* SWC = SW0 + (size_t)NCLS * 2 * DFF; float* SW1 = SWC + (size_t)NCLS * CIN;
    float* SSQ = (float*)(ws + WS_SSQ); float* Y = p.out + O_Y;
#define WAVE_IDS() const int tid_ = tid_opaque(); const int lane_ = tid_ & 63; const int gw_ = bx * NWAVES + (tid_ >> 6); const int NGW_ = G * NWAVES
    p0_weights(p, L, vcu, G); phase_mod(p, (char*)lds, bx, G);
    xcd_barrier(bar);
    phase_norm0(p, (char*)lds, bx, G);
    { WAVE_IDS(); sw_job(p, (const bf16_t*)(ws + WB_FFI0), 2 * DFF, 0, 3, SW0, 2 * DFF, 1, gw_, NGW_, lane_); sw_job(p, (const bf16_t*)(ws + WB_INC), CIN, 1, 0, SWC, CIN, 0, gw_, NGW_, lane_);
      sw_job(p, (const bf16_t*)(ws + WB_FFI1), 2 * DFF, 1, 3, SW1, 2 * DFF, 1, gw_, NGW_, lane_); }
    xcd_barrier(bar);
    gemm_call(L, XN, (const bf16_t*)(ws + WB_AB), ABMAIN, DM, EpiAB{(bf16_t*)(ws + WS_UPRE), (bf16_t*)(ws + WS_QKVO)}); xcd_barrier(bar);
    ml_phase_A(p, lds, vcu, G); phase_conv(p, (char*)lds, vcu, G); xcd_barrier(bar);
    { WAVE_IDS(); MlScan sc{p}; for (long i = bx * (long)NTHREADS + tid_; i < MlScan::count(); i += (long)G * NTHREADS) sc(i); } xcd_barrier(bar);
    ml_phase_C(p, lds, vcu, G); xcd_barrier(bar);
    gemm_call(L, UH, (const bf16_t*)(ws + WB_OUTAB), DM, DM, EpiRes{p.xp, p.xs, Y, (bf16_t*)(ws + WS_XN), SSQ + 0 * SSQ_STRIDE, modv(p, 0, 0, 2), modv(p, 0, 0, 4), p.n2g, 1, 0}); xcd_barrier(bar);
    gemm_call(L, XN, (const bf16_t*)(ws + WB_FFI0), 2 * DFF, DM, EpiFfnIn{(bf16_t*)(ws + WS_H), SSQ + 0 * SSQ_STRIDE, SW0}); xcd_barrier(bar);
    gemm_call(L, Hh, (const bf16_t*)(ws + WB_FFO0), DM, DFF, EpiRes{p.xp, p.xs, Y, (bf16_t*)(ws + WS_XN), SSQ + 1 * SSQ_STRIDE, modv(p, 0, 0, 5), modv(p, 1, 0, 1), p.n1g + DM, 0, 0}); xcd_barrier(bar);
    gemm_call(L, XN, (const bf16_t*)(ws + WB_INC), CIN, DM, EpiQkv{(bf16_t*)(ws + WS_QRAW), (bf16_t*)(ws + WS_KRAW), (bf16_t*)(ws + WS_CTXV), (bf16_t*)(ws + WS_LATV), p.out + O_V, SSQ + 1 * SSQ_STRIDE, SWC}); xcd_barrier(bar);
    { WAVE_IDS(); phase_qkpost(p, gw_, NGW_, lane_); phase_cachecvt(p, bx * NTHREADS + tid_, G * NTHREADS); } xcd_barrier(bar);
    attn_phase(p, lds, vcu, G); xcd_barrier(bar);
    gemm_call(L, Ob, (const bf16_t*)(ws + WB_OUTC), DM, DM, EpiRes{p.xp, p.xs, Y, (bf16_t*)(ws + WS_XN), SSQ + 2 * SSQ_STRIDE, modv(p, 1, 0, 2), modv(p, 1, 0, 4), p.n2g + DM, 0, 0}); xcd_barrier(bar);
    gemm_call(L, XN, (const bf16_t*)(ws + WB_FFI1), 2 * DFF, DM, EpiFfnIn{(bf16_t*)(ws + WS_H), SSQ + 2 * SSQ_STRIDE, SW1}); xcd_barrier(bar);
    gemm_call(L, Hh, (const bf16_t*)(ws + WB_FFO1), DM, DFF, EpiRes{p.xp, p.xs, Y, (bf16_t*)(ws + WS_XN), SSQ + 3 * SSQ_STRIDE, modv(p, 1, 0, 5), modv(p, 1, 0, 1), nullptr, 0, 0}); xcd_barrier(bar);
    { WAVE_IDS(); phase_final(p, gw_, NGW_, lane_); }
#undef WAVE_IDS
}
static Params make_params(void* const* d_in, void* d_out, void* d_ws) {
    Params p{}; const float** pp = (const float**)&p; for (int i = 0; i < 28; ++i) pp[i] = (const float*)d_in[i];
    p.out = (float*)d_out; p.ws = (unsigned char*)d_ws; return p;
}
extern "C" void kernel_launch(void* const* d_in, const int* in_sizes, int n_in, void* d_out, int out_size, void* d_ws, size_t ws_size, hipStream_t stream) {
    static int grid = 0;
    if (grid == 0) {
        if (n_in != 28 || (size_t)out_size != O_END || ws_size < WS_END || in_sizes[0] != MC * DM || in_sizes[1] != ML * DM) {
            fprintf(stderr, "kernel_launch: shape mismatch n_in %d out %d (want %zu) ws %zu (want %zu)\n", n_in, out_size, (size_t)O_END, ws_size, (size_t)WS_END); grid = -1; return; }
        int dev = 0, cus = 0;
        if (hipGetDevice(&dev) != hipSuccess || hipDeviceGetAttribute(&cus, hipDeviceAttributeMultiprocessorCount, dev) != hipSuccess) { grid = -1; return; }
        if (hipFuncSetAttribute((const void*)mega_fwd, hipFuncAttributeMaxDynamicSharedMemorySize, LDS_BYTES) != hipSuccess) { fprintf(stderr, "hipFuncSetAttribute failed\n"); grid = -1; return; }
        int per_cu = 0; (void)hipOccupancyMaxActiveBlocksPerMultiprocessor(&per_cu, (const void*)mega_fwd, NTHREADS, LDS_BYTES); (void)hipGetLastError();
        if (per_cu < 1) fprintf(stderr, "kernel_launch: occupancy query says %d blocks/CU\n", per_cu);
        grid = cus;
    }
    if (grid < 0) return;
    hipMemsetAsync((char*)d_ws + WS_CTL, 0, CTL_ZERO_BYTES, stream);
    Params p = make_params(d_in, d_out, d_ws);
    hipLaunchKernelGGL(mega_fwd, dim3(grid), dim3(NTHREADS), LDS_BYTES, stream, p);
}
```

```cpp
#ifdef HOST_TEST
#include <cmath>
#include <cstdio>
#include <cstdlib>
#include <cstring>
#include <cstdint>
#include <vector>
#define HD_FN inline
#define DEV_FN inline
#else
#include <hip/hip_runtime.h>
#include <cstdio>
#include <cstdint>
#define HD_FN __host__ __device__ __forceinline__
#define DEV_FN __device__ __forceinline__
#endif

#ifdef TINY
constexpr int DM = 512, NCB = 2, CSEQ = 128, NLB = 2, LSEQ = 128, PAST = 128;
#else
constexpr int DM = 1024, NCB = 16, CSEQ = 256, NLB = 4, LSEQ = 4096, PAST = 256;
#endif
constexpr int GRIDW = 64, CCH = DM / 2, CWID = 31, MH = 4, MDK = CCH / MH, MW = CCH, NGATE = 16;
constexpr int ABIN = 2 * CCH + 4 * MW + NGATE, ABMAIN = 2 * CCH + 4 * MW;
constexpr int HDIM = 128, NQ = DM / HDIM, NKV = 2, GRP = NQ / NKV, CIN = (NQ + 2 * NKV) * HDIM;
constexpr int DFF = ((8 * DM + 3 * 256 - 1) / (3 * 256)) * 256;
constexpr int MC = NCB * CSEQ, ML = NLB * LSEQ, MTOK = MC + ML, NCLS = 1 + NLB, SKVL = LSEQ + PAST;
constexpr float EPSF = 1e-6f;
constexpr int NSEQ = NCB + NLB;

constexpr size_t O_Y = 0, O_C = (size_t)MTOK * DM, O_N = O_C + (size_t)NCB * 2 * MH * MDK * MDK, O_M = O_N + (size_t)NCB * 2 * MH * MDK,
                 O_K = O_M + (size_t)NCB * 2 * MH, O_V = O_K + (size_t)NCB * CSEQ * NKV * HDIM, O_END = O_V + (size_t)NCB * CSEQ * NKV * HDIM;

constexpr size_t MiB = 1u << 20;
#ifdef TINY
constexpr size_t WSCALE = 1;
#endif
constexpr size_t WS_CTL = 0, CTL_ZERO_BYTES = 1 * MiB;
constexpr size_t WS_MOD = 1 * MiB;
constexpr size_t WS_SW = WS_MOD + 256 * 1024;
constexpr size_t WS_SSQ = 512 * 1024;
constexpr int SSQ_STRIDE = 32768;
constexpr size_t WS_DEN = 232 * MiB;
constexpr size_t WS_WB = 2 * MiB;
constexpr size_t WS_XN = 50 * MiB;
constexpr size_t WS_UPRE = 90 * MiB;
constexpr size_t WS_QKVO = 110 * MiB;
constexpr size_t WS_UH = 190 * MiB;
constexpr size_t WS_GATES = 230 * MiB;
constexpr size_t WS_HS = 50 * MiB;
constexpr size_t WS_H = 110 * MiB;
constexpr size_t WS_QRAW = 110 * MiB;
constexpr size_t WS_LATK = 150 * MiB, WS_LATV = 159 * MiB, WS_CTXK = 168 * MiB, WS_CTXV = 170 * MiB;
constexpr size_t WS_KRAW = 172 * MiB;
constexpr size_t WS_O = 190 * MiB;
constexpr size_t WS_END = 256 * MiB;

typedef unsigned short bf16_t;
HD_FN float bf2f(bf16_t h) { unsigned u = (unsigned)h << 16; return __builtin_bit_cast(float, u); }
HD_FN bf16_t f2bf(float f) { unsigned u = __builtin_bit_cast(unsigned, f); return (bf16_t)((u + 0x7fffu + ((u >> 16) & 1u)) >> 16); }
HD_FN float rbf(float f) { return bf2f(f2bf(f)); }
HD_FN float sigmoidf_(float x) { return 1.0f / (1.0f + expf(-x)); }
HD_FN float siluf_(float x) { return x * sigmoidf_(x); }
HD_FN float logsigmoidf_(float x) { return x >= 0.f ? -log1pf(expf(-x)) : x - log1pf(expf(x)); }
HD_FN int cls_of(int row) { return row < MC ? 0 : 1 + (row - MC) / LSEQ; }
HD_FN int seqlen_of(int row) { return row < MC ? CSEQ : LSEQ; }
HD_FN int pos_of(int row) { return row < MC ? row % CSEQ : (row - MC) % LSEQ; }

struct Params {
    const float *xp, *xs, *c, *stC, *stn, *stm, *ck, *cv, *cctx, *wmod, *bmod, *n1g, *n2g, *winab, *bgate, *convw, *convb, *lng, *lnb, *mng,
        *woutab, *winc, *qng, *kng, *woutc, *wffi, *wffo, *fng;
    float* out; unsigned char* ws;
};
HD_FN const float* xrow(const Params& p, int row) { return row < MC ? p.xp + (size_t)row * DM : p.xs + (size_t)(row - MC) * DM; }
HD_FN const float* modv(const Params& p, int l, int cls, int which) { return (const float*)(p.ws + WS_MOD) + ((size_t)(l * NCLS + cls) * 6 + which) * DM; }
constexpr size_t WS_RS0 = 233 * MiB;

struct NMod {
    Params p; static HD_FN long count() { return 2L * NCLS * 6 * DM; }
    HD_FN void operator()(long idx) const {
        const int col = (int)(idx % (6 * DM)); const int cls = (int)((idx / (6 * DM)) % NCLS); const int l = (int)(idx / (6 * DM * NCLS));
        const float* cond = cls == 0 ? p.cctx : p.c + (size_t)(cls - 1) * DM;
        const float* w = p.wmod + (size_t)l * DM * 6 * DM;
        float acc = 0.f;
        for (int k = 0; k < DM; ++k) acc += siluf_(cond[k]) * w[(size_t)k * 6 * DM + col];
        ((float*)(p.ws + WS_MOD))[idx] = acc + p.bmod[(size_t)l * 6 * DM + col];
    }
};
struct NNorm0a {
    Params p; static HD_FN long count() { return MTOK; }
    HD_FN void operator()(long row) const {
        const float* x = xrow(p, (int)row); float s = 0.f;
        for (int k = 0; k < DM; ++k) s += x[k] * x[k];
        ((float*)(p.ws + WS_RS0))[row] = 1.0f / sqrtf(s / DM + EPSF);
    }
};
struct NNorm0b {
    Params p; static HD_FN long count() { return (long)MTOK * DM; }
    HD_FN void operator()(long idx) const {
        const int row = (int)(idx / DM), col = (int)(idx % DM), cls = cls_of(row);
        const float rs = ((const float*)(p.ws + WS_RS0))[row];
        const float v = xrow(p, row)[col] * rs * p.n1g[col] * (1.f + modv(p, 0, cls, 1)[col]) + modv(p, 0, cls, 0)[col];
        ((bf16_t*)(p.ws + WS_XN))[idx] = f2bf(v);
    }
};
struct NGates {
    Params p; static HD_FN long count() { return (long)MTOK * NGATE; }
    HD_FN void operator()(long idx) const {
        const int row = (int)(idx / NGATE), j = (int)(idx % NGATE), cls = cls_of(row);
        const float rs = ((const float*)(p.ws + WS_RS0))[row]; const float* x = xrow(p, row);
        const float* sc = modv(p, 0, cls, 1); const float* sh = modv(p, 0, cls, 0);
        float acc = 0.f;
        for (int k = 0; k < DM; ++k) { const float h = x[k] * rs * p.n1g[k] * (1.f + sc[k]) + sh[k]; acc += h * p.winab[(size_t)k * ABIN + ABMAIN + j]; }
        acc += p.bgate[j];
        if ((j & 7) >= 4) acc = logsigmoidf_(acc);
        ((float*)(p.ws + WS_GATES))[idx] = acc;
    }
};

template <bool DUAL, class Epi> struct NGemm {
    const bf16_t* A; const float* B; int lda, ldb, K, N, off2, pad_; Epi epi;
    HD_FN long count() const { return (long)(MTOK / 4) * (N / 4); }
    HD_FN void operator()(long idx) const {
        const int nt = (int)(idx % (N / 4)), mt = (int)(idx / (N / 4)); const int m0 = mt * 4, n0 = nt * 4;
        float acc[4][4], acc2[4][4];
#pragma unroll
        for (int i = 0; i < 4; ++i)
#pragma unroll
            for (int j = 0; j < 4; ++j) { acc[i][j] = 0.f; acc2[i][j] = 0.f; }
        for (int k0 = 0; k0 < K; k0 += 8) {
            float a[4][8];
#pragma unroll
            for (int i = 0; i < 4; ++i) {
                const bf16_t* ap = A + (size_t)(m0 + i) * lda + k0;
#pragma unroll
                for (int kk = 0; kk < 8; ++kk) a[i][kk] = bf2f(ap[kk]);
            }
#pragma unroll
            for (int kk = 0; kk < 8; ++kk) {
                const float* bp = B + (size_t)(k0 + kk) * ldb + n0;
                float b[4], b2[4];
#pragma unroll
                for (int j = 0; j < 4; ++j) { b[j] = rbf(bp[j]); b2[j] = DUAL ? rbf(bp[off2 + j]) : 0.f; }
#pragma unroll
                for (int i = 0; i < 4; ++i)
#pragma unroll
                    for (int j = 0; j < 4; ++j) { acc[i][j] += a[i][kk] * b[j]; if (DUAL) acc2[i][j] += a[i][kk] * b2[j]; }
            }
        }
#pragma unroll
        for (int i = 0; i < 4; ++i)
#pragma unroll
            for (int j = 0; j < 4; ++j) epi(m0 + i, n0 + j, acc[i][j], acc2[i][j]);
    }
};
struct EGlu { Params p; HD_FN void operator()(int row, int col, float v, float v2) const { ((bf16_t*)(p.ws + WS_UPRE))[(size_t)row * CCH + col] = f2bf(v * sigmoidf_(v2)); } };
struct EQkvo { Params p; HD_FN void operator()(int row, int col, float v, float) const {
        const int part = col / MW; if (part == 1) v *= 1.0f / sqrtf((float)MDK); if (part == 3) v = sigmoidf_(v);
        ((bf16_t*)(p.ws + WS_QKVO))[(size_t)row * 4 * MW + col] = f2bf(v); } };
struct EOut { Params p; int l; int pad_ = 0; HD_FN void operator()(int row, int col, float v, float) const {
        const int cls = cls_of(row); float* Y = p.out + O_Y + (size_t)row * DM + col;
        const float xin = l == 0 ? xrow(p, row)[col] : *Y;
        const float x1 = xin + modv(p, l, cls, 2)[col] * v; *Y = x1;
        ((bf16_t*)(p.ws + WS_XN))[(size_t)row * DM + col] = f2bf(x1 * p.n2g[(size_t)l * DM + col] * (1.f + modv(p, l, cls, 4)[col])); } };
struct EFfnIn { Params p; const float* sw; int slot; int pad_ = 0; HD_FN void operator()(int row, int col, float v, float v2) const {
        const int cls = cls_of(row); const float rs = 1.0f / sqrtf(((const float*)(p.ws + WS_SSQ))[(size_t)slot * SSQ_STRIDE + row] / DM + EPSF);
        const float a = v * rs + sw[(size_t)cls * 2 * DFF + col], b = v2 * rs + sw[(size_t)cls * 2 * DFF + DFF + col];
        ((bf16_t*)(p.ws + WS_H))[(size_t)row * DFF + col] = f2bf(siluf_(a) * b); } };
struct EFfnOut { Params p; int l; int pad_ = 0; HD_FN void operator()(int row, int col, float v, float) const {
        const int cls = cls_of(row); float* Y = p.out + O_Y + (size_t)row * DM + col;
        const float x2 = *Y + modv(p, l, cls, 5)[col] * v; *Y = x2;
        if (l == 0) ((bf16_t*)(p.ws + WS_XN))[(size_t)row * DM + col] = f2bf(x2 * p.n1g[(size_t)DM + col] * (1.f + modv(p, 1, cls, 1)[col])); } };
struct EQkv { Params p; const float* sw; int slot; int pad_ = 0; HD_FN void operator()(int row, int col, float v, float) const {
        const int cls = cls_of(row); const float rs = 1.0f / sqrtf(((const float*)(p.ws + WS_SSQ))[(size_t)slot * SSQ_STRIDE + row] / DM + EPSF);
        const float a = v * rs + sw[(size_t)cls * CIN + col];
        if (col < NQ * HDIM) ((bf16_t*)(p.ws + WS_QRAW))[(size_t)row * NQ * HDIM + col] = f2bf(a);
        else if (col < (NQ + NKV) * HDIM) ((bf16_t*)(p.ws + WS_KRAW))[(size_t)row * NKV * HDIM + (col - NQ * HDIM)] = f2bf(a);
        else { const int c2 = col - (NQ + NKV) * HDIM;
            if (row < MC) { ((bf16_t*)(p.ws + WS_CTXV))[(size_t)row * NKV * HDIM + c2] = f2bf(a); p.out[O_V + (size_t)row * NKV * HDIM + c2] = a; }
            else { const int b = (row - MC) / LSEQ, s = (row - MC) % LSEQ; ((bf16_t*)(p.ws + WS_LATV))[((size_t)b * SKVL + s) * NKV * HDIM + c2] = f2bf(a); } } } };

struct NSsq {
    Params p; int slot; int pad_ = 0; static HD_FN long count() { return MTOK; }
    HD_FN void operator()(long row) const { const float* y = p.out + O_Y + (size_t)row * DM; float s = 0.f; for (int k = 0; k < DM; ++k) s += y[k] * y[k];
        ((float*)(p.ws + WS_SSQ))[(size_t)slot * SSQ_STRIDE + row] = s; }
};
struct NSW {
    Params p; const float* W; float* sw; int l, which, N, pad_; HD_FN long count() const { return (long)NCLS * N; }
    HD_FN void operator()(long idx) const { const int n = (int)(idx % N), cls = (int)(idx / N); const float* sh = modv(p, l, cls, which); float acc = 0.f;
        for (int k = 0; k < DM; ++k) acc += sh[k] * rbf(W[(size_t)k * N + n]); sw[idx] = acc; }
};
struct NConv {
    Params p; static HD_FN long count() { return (long)MTOK * CCH; }
    HD_FN void operator()(long idx) const {
        const int row = (int)(idx / CCH), c = (int)(idx % CCH), pos = pos_of(row), len = seqlen_of(row);
        const bf16_t* U = (const bf16_t*)(p.ws + WS_UPRE); float acc = p.convb[c];
        for (int j = 0; j < CWID; ++j) { const int t = pos + j - CWID / 2; if (t >= 0 && t < len) acc += p.convw[(size_t)j * CCH + c] * bf2f(U[(size_t)(row + j - CWID / 2) * CCH + c]); }
        ((float*)(p.ws + WS_HS))[idx] = acc;
    }
};
struct NConvLN {
    Params p; static HD_FN long count() { return MTOK; }
    HD_FN void operator()(long row) const {
        const float* t = (const float*)(p.ws + WS_HS) + (size_t)row * CCH; float mu = 0.f;
        for (int c = 0; c < CCH; ++c) mu += t[c]; mu /= CCH; float var = 0.f;
        for (int c = 0; c < CCH; ++c) { const float d = t[c] - mu; var += d * d; } var /= CCH;
        const float rs = 1.0f / sqrtf(var + EPSF); bf16_t* UH = (bf16_t*)(p.ws + WS_UH) + (size_t)row * DM;
        for (int c = 0; c < CCH; ++c) UH[c] = f2bf(siluf_((t[c] - mu) * rs * p.lng[c] + p.lnb[c]));
    }
};
HD_FN int seq_base(int sid) { return sid < NCB ? sid * CSEQ : MC + (sid - NCB) * LSEQ; }
struct NMlstmDen {
    Params p; static HD_FN long count() { return (long)NSEQ * MH * 2; }
    HD_FN void operator()(long idx) const {
        const int dir = (int)(idx % 2), h = (int)((idx / 2) % MH), sid = (int)(idx / (2 * MH)); const bool isctx = sid < NCB;
        const int base = seq_base(sid), len = isctx ? CSEQ : LSEQ;
        float n[MDK]; float mrun = 0.f;
        if (isctx) {
#pragma unroll
            for (int d = 0; d < MDK; ++d) n[d] = 0.f;
        } else { const int b = sid - NCB; const float em = expf(p.stm[(size_t)(b * 2 + dir) * MH + h]);
#pragma unroll
            for (int d = 0; d < MDK; ++d) n[d] = p.stn[((size_t)(b * 2 + dir) * MH + h) * MDK + d] * em; }
        const bf16_t* QK = (const bf16_t*)(p.ws + WS_QKVO); const float* G = (const float*)(p.ws + WS_GATES); float* DEN = (float*)(p.ws + WS_DEN);
        for (int t = 0; t < len; ++t) {
            const int row = base + (dir == 0 ? t : len - 1 - t);
            const float ig = G[(size_t)row * NGATE + dir * 8 + h], lf = G[(size_t)row * NGATE + dir * 8 + 4 + h];
            const float f = expf(lf), ei = expf(ig); mrun = fmaxf(mrun + lf, ig);
            const bf16_t* q = QK + (size_t)row * 4 * MW + h * MDK; const bf16_t* k = q + MW; float den = 0.f;
#pragma unroll
            for (int d = 0; d < MDK; ++d) { n[d] = f * n[d] + ei * bf2f(k[d]); den += bf2f(q[d]) * n[d]; }
            DEN[((size_t)dir * MTOK + row) * MH + h] = den;
        }
        if (isctx) { const float em = expf(-mrun); p.out[O_M + (size_t)(sid * 2 + dir) * MH + h] = mrun;
#pragma unroll
            for (int d = 0; d < MDK; ++d) p.out[O_N + ((size_t)(sid * 2 + dir) * MH + h) * MDK + d] = n[d] * em; }
    }
};
struct NMlstmNum {
    Params p; int dir; int pad_ = 0; static HD_FN long count() { return (long)NSEQ * MH * MDK; }
    HD_FN void operator()(long idx) const {
        const int v = (int)(idx % MDK), h = (int)((idx / MDK) % MH), sid = (int)(idx / (MDK * MH)); const bool isctx = sid < NCB;
        const int base = seq_base(sid), len = isctx ? CSEQ : LSEQ;
        float C[MDK];
        if (isctx) {
#pragma unroll
            for (int d = 0; d < MDK; ++d) C[d] = 0.f;
        } else { const int b = sid - NCB; const float em = expf(p.stm[(size_t)(b * 2 + dir) * MH + h]);
#pragma unroll
            for (int d = 0; d < MDK; ++d) C[d] = p.stC[(((size_t)(b * 2 + dir) * MH + h) * MDK + d) * MDK + v] * em; }
        const bf16_t* QK = (const bf16_t*)(p.ws + WS_QKVO); const float* G = (const float*)(p.ws + WS_GATES); const float* DEN = (const float*)(p.ws + WS_DEN);
        float* HS = (float*)(p.ws + WS_HS);
        for (int t = 0; t < len; ++t) {
            const int row = base + (dir == 0 ? t : len - 1 - t);
            const float ig = G[(size_t)row * NGATE + dir * 8 + h], lf = G[(size_t)row * NGATE + dir * 8 + 4 + h];
            const float f = expf(lf), ei = expf(ig);
            const bf16_t* q = QK + (size_t)row * 4 * MW + h * MDK; const bf16_t* k = q + MW; const float vv = bf2f(q[2 * MW + v]) * ei; float num = 0.f;
#pragma unroll
            for (int d = 0; d < MDK; ++d) { C[d] = f * C[d] + bf2f(k[d]) * vv; num += bf2f(q[d]) * C[d]; }
            const float den = DEN[((size_t)dir * MTOK + row) * MH + h]; const float hv = num / fmaxf(fabsf(den), 1.0f);
            float* o = HS + (size_t)row * MW + h * MDK + v; if (dir == 0) *o = hv; else *o += hv;
        }
        if (isctx) { const float em = expf(-p.out[O_M + (size_t)(sid * 2 + dir) * MH + h]);
#pragma unroll
            for (int d = 0; d < MDK; ++d) p.out[O_C + (((size_t)(sid * 2 + dir) * MH + h) * MDK + d) * MDK + v] = C[d] * em; }
    }
};
struct NHm {
    Params p; static HD_FN long count() { return (long)MTOK * MH; }
    HD_FN void operator()(long idx) const {
        const int row = (int)(idx / MH), h = (int)(idx % MH); const float* x = (const float*)(p.ws + WS_HS) + (size_t)row * MW + h * MDK; float s = 0.f;
        for (int v = 0; v < MDK; ++v) s += x[v] * x[v];
        const float rs = 1.0f / sqrtf(s / MDK + EPSF); const bf16_t* og = (const bf16_t*)(p.ws + WS_QKVO) + (size_t)row * 4 * MW + 3 * MW + h * MDK;
        bf16_t* UH = (bf16_t*)(p.ws + WS_UH) + (size_t)row * DM + CCH + h * MDK;
        for (int v = 0; v < MDK; ++v) UH[v] = f2bf(bf2f(og[v]) * x[v] * rs * p.mng[h * MDK + v]);
    }
};
struct NCacheCvt {
    Params p; static HD_FN long count() { return (long)NLB * PAST * NKV * HDIM; }
    HD_FN void operator()(long idx) const { const int e = (int)(idx % (NKV * HDIM)), pp = (int)((idx / (NKV * HDIM)) % PAST), b = (int)(idx / ((long)NKV * HDIM * PAST));
        const size_t dst = ((size_t)b * SKVL + LSEQ + pp) * NKV * HDIM + e;
        ((bf16_t*)(p.ws + WS_LATK))[dst] = f2bf(p.ck[idx]); ((bf16_t*)(p.ws + WS_LATV))[dst] = f2bf(p.cv[idx]); }
};
struct NQkPost {
    Params p; static HD_FN long count() { return (long)MTOK * (NQ + NKV); }
    HD_FN void operator()(long idx) const {
        const int row = (int)(idx / (NQ + NKV)), j = (int)(idx % (NQ + NKV)); const bool isq = j < NQ; const bool lat = row >= MC;
        bf16_t* src = isq ? (bf16_t*)(p.ws + WS_QRAW) + (size_t)row * NQ * HDIM + j * HDIM : (bf16_t*)(p.ws + WS_KRAW) + (size_t)row * NKV * HDIM + (j - NQ) * HDIM;
        const float* g = isq ? p.qng : p.kng; float s = 0.f;
        for (int d = 0; d < HDIM; ++d) { const float x = bf2f(src[d]); s += x * x; }
        const float rs = 1.0f / sqrtf(s / HDIM + EPSF);
        bf16_t* dst; float* fo = nullptr;
        if (isq) dst = src;
        else if (!lat) { dst = (bf16_t*)(p.ws + WS_CTXK) + (size_t)row * NKV * HDIM + (j - NQ) * HDIM; fo = p.out + O_K + (size_t)row * NKV * HDIM + (j - NQ) * HDIM; }
        else { const int b = (row - MC) / LSEQ, sp = (row - MC) % LSEQ; dst = (bf16_t*)(p.ws + WS_LATK) + ((size_t)b * SKVL + sp) * NKV * HDIM + (j - NQ) * HDIM; }
        const int sp = pos_of(row); const float prow = (float)(sp / GRIDW), pcol = (float)(sp % GRIDW);
        for (int half = 0; half < 2; ++half)
            for (int d = 0; d < HDIM / 4; ++d) {
                const int i1 = half * (HDIM / 2) + d, i2 = i1 + HDIM / 4;
                const float x1 = bf2f(src[i1]) * rs * g[i1], x2 = bf2f(src[i2]) * rs * g[i2]; float y1 = x1, y2 = x2;
                if (lat) { const float inv = powf(10000.0f, -(float)d / (float)(HDIM / 4)); const float ang = (half == 0 ? prow : pcol) * inv; const float cs = cosf(ang), sn = sinf(ang);
                    y1 = x1 * cs - x2 * sn; y2 = x1 * sn + x2 * cs; }
                dst[i1] = f2bf(y1); dst[i2] = f2bf(y2); if (fo) { fo[i1] = y1; fo[i2] = y2; }
            }
    }
};
struct NAttn {
    Params p; static HD_FN long count() { return (long)MTOK * NQ * 4; }
    HD_FN void operator()(long idx) const {
        const int sl = (int)(idx % 4), hq = (int)((idx / 4) % NQ), row = (int)(idx / (4 * NQ)); const int kv = hq / GRP;
        const bf16_t *Kb, *Vb; int nk;
        if (row < MC) { const int b = row / CSEQ; Kb = (const bf16_t*)(p.ws + WS_CTXK) + (size_t)b * CSEQ * NKV * HDIM; Vb = (const bf16_t*)(p.ws + WS_CTXV) + (size_t)b * CSEQ * NKV * HDIM; nk = CSEQ; }
        else { const int b = (row - MC) / LSEQ; Kb = (const bf16_t*)(p.ws + WS_LATK) + (size_t)b * SKVL * NKV * HDIM; Vb = (const bf16_t*)(p.ws + WS_LATV) + (size_t)b * SKVL * NKV * HDIM; nk = SKVL; }
        const bf16_t* qp = (const bf16_t*)(p.ws + WS_QRAW) + (size_t)row * NQ * HDIM + hq * HDIM;
        float q[HDIM];
#pragma unroll
        for (int d = 0; d < HDIM; ++d) q[d] = bf2f(qp[d]);
        float o[32];
#pragma unroll
        for (int e = 0; e < 32; ++e) o[e] = 0.f;
        float m = -1e30f, l = 0.f; const float scale = 1.0f / sqrtf((float)HDIM);
        for (int s = 0; s < nk; ++s) {
            const bf16_t* kp = Kb + (size_t)s * NKV * HDIM + kv * HDIM; float dot = 0.f;
#pragma unroll
            for (int d = 0; d < HDIM; ++d) dot += q[d] * bf2f(kp[d]);
            dot *= scale; const float mn = fmaxf(m, dot); const float al = expf(m - mn), pe = expf(dot - mn); m = mn; l = l * al + pe;
            const bf16_t* vp = Vb + (size_t)s * NKV * HDIM + kv * HDIM + sl * 32;
#pragma unroll
            for (int e = 0; e < 32; ++e) o[e] = o[e] * al + pe * bf2f(vp[e]);
        }
        bf16_t* op = (bf16_t*)(p.ws + WS_O) + (size_t)row * DM + hq * HDIM + sl * 32;
#pragma unroll
        for (int e = 0; e < 32; ++e) op[e] = f2bf(o[e] / l);
    }
};
struct NFinal {
    Params p; static HD_FN long count() { return (long)MTOK * DM; }
    HD_FN void operator()(long idx) const { const int row = (int)(idx / DM), col = (int)(idx % DM);
        const float rs = 1.0f / sqrtf(((const float*)(p.ws + WS_SSQ))[(size_t)3 * SSQ_STRIDE + row] / DM + EPSF); p.out[O_Y + idx] *= rs * p.fng[col]; }
};
constexpr int NWAVES = 8, NTHREADS = NWAVES * 64;
constexpr int RING_OFF = 0, RING_BYTES = 131072;
constexpr int LDSCTL_OFF = RING_BYTES, MISC_OFF = LDSCTL_OFF + 320;
constexpr int LDS_BYTES = 147456;
constexpr int CW_TMO = 0, CW_CODE = 1, CW_BAR = 4096;
__device__ __forceinline__ int tid_opaque() { int t = threadIdx.x; asm volatile("" : "+v"(t)); return t; }
template <int M> __device__ __forceinline__ float swz_xor(float v) { return __int_as_float(__builtin_amdgcn_ds_swizzle(__float_as_int(v), (M << 10) | 0x1f)); }
__device__ __forceinline__ float half_sum(float v) { auto rr = __builtin_amdgcn_permlane32_swap(__float_as_uint(v), __float_as_uint(v), false, false); return __uint_as_float(rr[0]) + __uint_as_float(rr[1]); }
__device__ __forceinline__ float half_max(float v) { auto rr = __builtin_amdgcn_permlane32_swap(__float_as_uint(v), __float_as_uint(v), false, false); return fmaxf(__uint_as_float(rr[0]), __uint_as_float(rr[1])); }
__device__ __forceinline__ float lane_get(float v, int src_lane) { return __int_as_float(__builtin_amdgcn_ds_bpermute(src_lane << 2, __float_as_int(v))); }
#define GAS __attribute__((address_space(1)))
#define LAS __attribute__((address_space(3)))
typedef GAS unsigned gu32;
#define RLX_AGENT __ATOMIC_RELAXED, __HIP_MEMORY_SCOPE_AGENT
#define XB_TMO      128
#define XB_XCNT(j)  (256  + 64 * (j))
#define XB_XSUB(j)  (1280 + 64 * (j))
#define XB_XGEN(j)  (2304 + 64 * (j))
#define XB_TOP      3328
#define XB_TOPGEN   3392
#define XCD_BAR_WORDS 3456
#define XB_SPIN_CAP (1u << 22)
__device__ __forceinline__ unsigned xb_ld(unsigned* p)              { return __hip_atomic_load(p, __ATOMIC_RELAXED, __HIP_MEMORY_SCOPE_AGENT); }
__device__ __forceinline__ unsigned xb_add(unsigned* p, unsigned v) { return __hip_atomic_fetch_add(p, v, __ATOMIC_RELAXED, __HIP_MEMORY_SCOPE_AGENT); }
__device__ __forceinline__ unsigned xb_xcc_id() { return (unsigned)__builtin_amdgcn_s_getreg((3 << 11) | 20) & 0xFu; }
#define XB_SPIN(cond, bar) do { unsigned _sp = 0; while (cond) { __builtin_amdgcn_s_sleep(1); \
    if ((++_sp & 255u) == 0u) { if (xb_ld(&(bar)[XB_TMO])) break; if (_sp > XB_SPIN_CAP) { atomicAdd(&(bar)[XB_TMO], 1u); break; } } } } while (0)
struct XcdBarrier { unsigned* bar; unsigned x; volatile LAS unsigned* st; };
__device__ __forceinline__ XcdBarrier xcd_barrier_post(unsigned* bar, volatile LAS unsigned* st) {
    XcdBarrier b; b.bar = bar; b.x = xb_xcc_id(); b.st = st;
    if (threadIdx.x == 0) (void)xb_add(&bar[XB_XCNT(b.x)], 1u);
    return b;
}
__device__ __forceinline__ void xcd_barrier_complete(unsigned* bar, unsigned x, unsigned& nloc, unsigned& nx) {
    const unsigned G = gridDim.x * gridDim.y * gridDim.z;
    unsigned sum, cnt, mine, sp = 0u;
    for (;;) {
        sum = 0u; cnt = 0u; mine = 0u;
#pragma unroll
        for (unsigned j = 0; j < 16; ++j) { const unsigned c = xb_ld(&bar[XB_XCNT(j)]); sum += c; cnt += (c > 0u) ? 1u : 0u; mine = (j == x) ? c : mine; }
        if (sum == G) break;
        __builtin_amdgcn_s_sleep(1);
        if ((++sp & 255u) == 0u) { if (xb_ld(&bar[XB_TMO])) break; if (sp > XB_SPIN_CAP) { atomicAdd(&bar[XB_TMO], 1u); break; } }
    }
    nloc = mine > 0u ? mine : 1u; nx = cnt > 0u ? cnt : 1u;
}
__device__ __forceinline__ void xcd_barrier(const XcdBarrier& b) {
    asm volatile("s_waitcnt vmcnt(0)" ::: "memory");
    __syncthreads();
    if (threadIdx.x == 0) {
        unsigned* bar = b.bar;
        __builtin_amdgcn_s_waitcnt(0);
        unsigned nloc = b.st[0], nx = b.st[1];
        if (nloc == 0u) { xcd_barrier_complete(bar, b.x, nloc, nx); b.st[0] = nloc; b.st[1] = nx; }
        const unsigned old = xb_add(&bar[XB_XSUB(b.x)], 1u);
        const unsigned gen = old / nloc;
        if (old + 1u == (gen + 1u) * nloc) {
            __builtin_amdgcn_fence(__ATOMIC_RELEASE, "agent");
            asm volatile("s_waitcnt vmcnt(0)" ::: "memory");
            const unsigned og = xb_add(&bar[XB_TOP], 1u);
            const unsigned tg = og / nx;
            if (og + 1u == (tg + 1u) * nx) xb_add(&bar[XB_TOPGEN], 1u);
            else XB_SPIN(xb_ld(&bar[XB_TOPGEN]) == tg, bar);
            __builtin_amdgcn_fence(__ATOMIC_ACQUIRE, "agent");
            xb_add(&bar[XB_XGEN(b.x)], 1u);
            asm volatile("s_waitcnt vmcnt(0)" ::: "memory");
        } else {
            XB_SPIN(xb_ld(&bar[XB_XGEN(b.x)]) == gen, bar);
            __builtin_amdgcn_fence(__ATOMIC_ACQUIRE, "agent");
            asm volatile("s_waitcnt vmcnt(0)" ::: "memory");
        }
    }
    __syncthreads();
}
namespace pg8 {
#define PG8_LAS __attribute__((address_space(3)))
typedef unsigned short bf16_t;
typedef short bf16x8 __attribute__((ext_vector_type(8)));
typedef float f32x4 __attribute__((ext_vector_type(4)));
typedef unsigned u32x4 __attribute__((ext_vector_type(4)));
constexpr int BM = 256, BK = 64, HALF = 128, HTB = HALF * BK * 2  , STAGE_BYTES = 8 * HTB, NXCD = 8, WGM = 8;

__host__ __device__ __forceinline__ int lds_byte(int r, int c) { const int st = (r >> 4) * 2 + (c >> 5), rr = r & 15, cc = c & 31, ob = rr * 64 + cc * 2; return st * 1024 + (ob ^ (((ob >> 9) & 1) << 5)); }
__host__ __device__ __forceinline__ void stage_rc(int b, int& R, int& C) { const int st = b / 1024, sb = b % 1024, swz = sb ^ (((sb >> 9) & 1) << 5); R = (st >> 1) * 16 + swz / 64; C = (st & 1) * 32 + (swz % 64) / 2; }
__host__ __device__ __forceinline__ int perm32(int rho) { const int n = rho >> 4, i = rho & 15; return 8 * (i >> 2) + 4 * n + (i & 3); }

struct Unit { int pm, pn; };
struct Gemm { const bf16_t* A; const bf16_t* Bt; int M, N, K; };

struct StaticOrder {
    int nM, nN, nwg, G, c;
    __host__ __device__ void init(int M, int N, int G_, int c_) { nM = M / BM; nN = N / BM; nwg = nM * nN; G = G_; c = c_; }
    __host__ __device__ bool next(int i, Unit& u) const {
        const long L = (long)i * G + c; if (L >= nwg) return false;
        int wgid = (int)L; { const int q = nwg / NXCD, r = nwg % NXCD, xcd = wgid % NXCD, off = wgid / NXCD; wgid = (xcd < r ? xcd * (q + 1) : r * (q + 1) + (xcd - r) * q) + off; }
        const int nig = WGM * nN, gid = wgid / nig, fm = gid * WGM, gsz = (nM - fm) < WGM ? (nM - fm) : WGM;
        u.pm = fm + ((wgid % nig) % gsz); u.pn = (wgid % nig) / gsz; return true;
    }
    __device__ __forceinline__ void a_ready(const Unit&) const {}
    __device__ __forceinline__ void done(const Unit&) const {}
};

__device__ __forceinline__ unsigned cvt_pk_bf16(float lo, float hi) { unsigned r; asm volatile("v_cvt_pk_bf16_f32 %0, %1, %2" : "=v"(r) : "v"(lo), "v"(hi)); return r; }
typedef float f32x2 __attribute__((ext_vector_type(2)));
template <class Epi, class Sched, bool ALIGN_EPI = false, bool SP2 = false>
__device__ __forceinline__ void gemm_phase(PG8_LAS unsigned char* lds, const Gemm g, const Sched& S, const Epi& E) {
    const int tid = tid_opaque(), wid = __builtin_amdgcn_readfirstlane(tid >> 6), lane = tid & 63, wr = wid >> 2, wc = wid & 3, fr = lane & 15, fq = lane >> 4;
    const int K = g.K, nt = K / BK;
    unsigned voffA[2], voffB[2];
#pragma unroll
    for (int i = 0; i < 2; ++i) { int R, C; stage_rc(tid * 16 + i * 8192, R, C); const int Rb = Epi::PERM ? ((R & ~31) + perm32(R & 31)) : R;
        voffA[i] = (unsigned)(R * K + C) * 2u; voffB[i] = (unsigned)(Rb * K + C) * 2u; }
    const size_t kstep = (size_t)(BK * 2);
    const size_t hstep = (size_t)HALF * K * 2;
    const size_t tstep = 2 * hstep;
    const unsigned ldsw = (unsigned)wid * 1024u;
    const int aoff = lds_byte(wr * 64 + fr, fq * 8), boff = lds_byte(wc * 32 + fr, fq * 8);
#define PG8_SA(b, h) (((b) * 2 + (h)) * HTB)
#define PG8_SB(b, h) ((4 + (b) * 2 + (h)) * HTB)
#define PG8_STAGE(bufoff, gbase, voff) do { _Pragma("unroll") for (int _i = 0; _i < 2; ++_i) \
        __builtin_amdgcn_global_load_lds((const unsigned*)((const char*)(gbase) + (voff)[_i]), (PG8_LAS unsigned*)(lds + (bufoff) + ldsw + _i * 8192), 16, 0, 0); } while (0)
#define PG8_LDA(dst, b, h) do { _Pragma("unroll") for (int m = 0; m < 4; ++m) _Pragma("unroll") for (int k = 0; k < 2; ++k) dst[m][k] = *(const PG8_LAS bf16x8*)(lds + PG8_SA(b, h) + aoff + m * 2048 + k * 1024); } while (0)
#define PG8_LDB(dst, b, h) do { _Pragma("unroll") for (int n = 0; n < 2; ++n) _Pragma("unroll") for (int k = 0; k < 2; ++k) dst[n][k] = *(const PG8_LAS bf16x8*)(lds + PG8_SB(b, h) + boff + n * 2048 + k * 1024); } while (0)
#define PG8_MMA(ai, bj, At, Bt) do { __builtin_amdgcn_s_setprio(1); _Pragma("unroll") for (int m = 0; m < 4; ++m) _Pragma("unroll") for (int n = 0; n < 2; ++n) _Pragma("unroll") for (int k = 0; k < 2; ++k) \
        acc[ai][bj][m][n] = __builtin_amdgcn_mfma_f32_16x16x32_bf16(Bt[n][k], At[m][k], acc[ai][bj][m][n], 0, 0, 0); __builtin_amdgcn_s_setprio(0); } while (0)
#define PG8_WAIT_V(n) asm volatile("s_waitcnt vmcnt(" #n ")" ::: "memory")
#define PG8_WAIT_L(n) asm volatile("s_waitcnt lgkmcnt(" #n ")" ::: "memory")
#define PG8_BAR __builtin_amdgcn_s_barrier()
#define PG8_SCHED __builtin_amdgcn_sched_barrier(0)
    Unit cur, nxt; int ui = 0;
    if (!S.next(0, cur)) return;
    f32x4 acc[2][2][4][2];
#pragma unroll
    for (int a = 0; a < 2; ++a)
#pragma unroll
        for (int b = 0; b < 2; ++b)
#pragma unroll
            for (int m = 0; m < 4; ++m)
#pragma unroll
                for (int n = 0; n < 2; ++n) acc[a][b][m][n] = (f32x4){0.f, 0.f, 0.f, 0.f};
    bf16x8 At[4][2], B0[2][2], B1[2][2];
    const char* cA = (const char*)g.A + (size_t)cur.pm * tstep; const char* cB = (const char*)g.Bt + (size_t)cur.pn * tstep;
    S.a_ready(cur);
    if constexpr (SP2) {
        PG8_STAGE(PG8_SB(0, 0), cB, voffB); PG8_STAGE(PG8_SB(0, 1), cB + hstep, voffB); PG8_STAGE(PG8_SA(0, 0), cA, voffA); PG8_STAGE(PG8_SA(0, 1), cA + hstep, voffA);
        if (wr == 1) PG8_BAR;
        PG8_WAIT_V(2); PG8_BAR;
        PG8_STAGE(PG8_SB(1, 0), cB + kstep, voffB); PG8_STAGE(PG8_SA(1, 0), cA + kstep, voffA); PG8_STAGE(PG8_SB(1, 1), cB + hstep + kstep, voffB);
        PG8_WAIT_V(6); PG8_BAR;
    } else {
        PG8_STAGE(PG8_SB(0, 0), cB, voffB); PG8_STAGE(PG8_SA(0, 0), cA, voffA); PG8_STAGE(PG8_SB(0, 1), cB + hstep, voffB); PG8_STAGE(PG8_SA(0, 1), cA + hstep, voffA);
        if (wr == 1) PG8_BAR;
        PG8_WAIT_V(4); PG8_BAR;
        PG8_STAGE(PG8_SB(1, 0), cB + kstep, voffB); PG8_STAGE(PG8_SA(1, 0), cA + kstep, voffA); PG8_STAGE(PG8_SB(1, 1), cB + hstep + kstep, voffB);
        PG8_WAIT_V(6); PG8_BAR;
    }
    for (;;) {
        const bool has_next = S.next(ui + 1, nxt);
        const char* nA = has_next ? (const char*)g.A + (size_t)nxt.pm * tstep : cA; const char* nB = has_next ? (const char*)g.Bt + (size_t)nxt.pn * tstep : cB;
        for (int t = 0; t < nt; t += 2) {
            const bool last = (t == nt - 2);
            const char* a1 = cA + (size_t)(t + 1) * kstep;
            const char* a2 = last ? nA : cA + (size_t)(t + 2) * kstep; const char* b2 = last ? nB : cB + (size_t)(t + 2) * kstep;
            const char* a3 = a2 + kstep; const char* b3 = b2 + kstep;
            if (last && has_next) S.a_ready(nxt);
            if constexpr (SP2) {
            PG8_LDB(B0, 0, 0); PG8_LDB(B1, 0, 1); PG8_SCHED; PG8_LDA(At, 0, 0); PG8_STAGE(PG8_SA(1, 1), a1 + hstep, voffA);
            PG8_WAIT_V(8); PG8_WAIT_L(0); PG8_BAR; PG8_MMA(0, 0, At, B0); PG8_MMA(0, 1, At, B1); PG8_BAR; PG8_SCHED;
            PG8_LDA(At, 0, 1); PG8_STAGE(PG8_SB(0, 0), b2, voffB); PG8_STAGE(PG8_SB(0, 1), b2 + hstep, voffB); PG8_STAGE(PG8_SA(0, 0), a2, voffA);
            PG8_WAIT_V(8); PG8_WAIT_L(0); PG8_BAR; PG8_MMA(1, 0, At, B0); PG8_MMA(1, 1, At, B1); PG8_BAR; PG8_SCHED;
            PG8_LDB(B0, 1, 0); PG8_LDB(B1, 1, 1); PG8_SCHED; PG8_LDA(At, 1, 0); PG8_STAGE(PG8_SA(0, 1), a2 + hstep, voffA);
            PG8_WAIT_V(8); PG8_WAIT_L(0); PG8_BAR; PG8_MMA(0, 0, At, B0); PG8_MMA(0, 1, At, B1); PG8_BAR; PG8_SCHED;
            PG8_LDA(At, 1, 1); PG8_STAGE(PG8_SB(1, 0), b3, voffB); PG8_STAGE(PG8_SB(1, 1), b3 + hstep, voffB); PG8_STAGE(PG8_SA(1, 0), a3, voffA);
            PG8_WAIT_V(8); PG8_WAIT_L(0); PG8_BAR; PG8_MMA(1, 0, At, B0); PG8_MMA(1, 1, At, B1); PG8_BAR; PG8_SCHED;
            } else {
            PG8_LDB(B0, 0, 0); PG8_SCHED; PG8_LDA(At, 0, 0); PG8_STAGE(PG8_SA(1, 1), a1 + hstep, voffA);
            PG8_WAIT_L(8); PG8_BAR; PG8_WAIT_L(0); PG8_MMA(0, 0, At, B0); PG8_BAR; PG8_SCHED;
            PG8_LDB(B1, 0, 1); PG8_STAGE(PG8_SB(0, 0), b2, voffB);
            PG8_BAR; PG8_WAIT_L(0); PG8_MMA(0, 1, At, B1); PG8_BAR;
            PG8_LDA(At, 0, 1); PG8_STAGE(PG8_SA(0, 0), a2, voffA);
            PG8_BAR; PG8_WAIT_L(0); PG8_MMA(1, 0, At, B0); PG8_BAR; PG8_SCHED;
            PG8_STAGE(PG8_SB(0, 1), b2 + hstep, voffB);
            PG8_WAIT_V(6); PG8_BAR; PG8_MMA(1, 1, At, B1); PG8_BAR;
            PG8_LDB(B0, 1, 0); PG8_SCHED; PG8_LDA(At, 1, 0); PG8_STAGE(PG8_SA(0, 1), a2 + hstep, voffA);
            PG8_WAIT_L(8); PG8_BAR; PG8_WAIT_L(0); PG8_MMA(0, 0, At, B0); PG8_BAR; PG8_SCHED;
            PG8_LDB(B1, 1, 1); PG8_STAGE(PG8_SB(1, 0), b3, voffB);
            PG8_BAR; PG8_WAIT_L(0); PG8_MMA(0, 1, At, B1); PG8_BAR;
            PG8_LDA(At, 1, 1); PG8_STAGE(PG8_SA(1, 0), a3, voffA);
            PG8_BAR; PG8_WAIT_L(0); PG8_MMA(1, 0, At, B0); PG8_BAR; PG8_SCHED;
            PG8_STAGE(PG8_SB(1, 1), b3 + hstep, voffB);
            PG8_WAIT_V(6); PG8_BAR; PG8_MMA(1, 1, At, B1); PG8_BAR;
            }
        }
        if constexpr (ALIGN_EPI) { if (wr == 0) PG8_BAR; }
        if constexpr (!Epi::AFTER_DRAIN) { E(acc, cur, wr, wc, fr, fq); S.done(cur); }
        if (!has_next) break;
#pragma unroll
        for (int a = 0; a < 2; ++a)
#pragma unroll
            for (int b = 0; b < 2; ++b)
#pragma unroll
                for (int m = 0; m < 4; ++m)
#pragma unroll
                    for (int n = 0; n < 2; ++n) acc[a][b][m][n] = (f32x4){0.f, 0.f, 0.f, 0.f};
        cur = nxt; cA = nA; cB = nB; ++ui;
        if constexpr (ALIGN_EPI) { if (wr == 1) PG8_BAR; }
    }
    PG8_WAIT_V(0);
    if constexpr (!ALIGN_EPI) { if (wr == 0) PG8_BAR; }
    PG8_BAR;
    if constexpr (Epi::AFTER_DRAIN) { E.fused(acc, cur, wr, wc, fr, fq, lds, wid, lane); S.done(cur); }
#undef PG8_SA
#undef PG8_SB
#undef PG8_STAGE
#undef PG8_LDA
#undef PG8_LDB
#undef PG8_MMA
#undef PG8_WAIT_V
#undef PG8_WAIT_L
#undef PG8_BAR
#undef PG8_SCHED
}
}
constexpr size_t WB_AB = 2 * MiB, WB_OUTAB = 8 * MiB, WB_FFI0 = 10 * MiB, WB_FFO0 = 21 * MiB, WB_INC = 27 * MiB, WB_OUTC = 30 * MiB, WB_FFI1 = 32 * MiB, WB_FFO1 = 43 * MiB;
static_assert(WB_FFO1 + (size_t)DM * DFF * 2 <= WS_XN && WB_AB + (size_t)ABMAIN * DM * 2 <= WB_OUTAB && WB_FFI0 + (size_t)2 * DFF * DM * 2 <= WB_FFO0 && WB_FFO0 + (size_t)DM * DFF * 2 <= WB_INC &&
              WB_INC + (size_t)CIN * DM * 2 <= WB_OUTC && WB_FFI1 + (size_t)2 * DFF * DM * 2 <= WB_FFO1, "weight copy map");

typedef unsigned v4u __attribute__((ext_vector_type(4)));
typedef unsigned v2u __attribute__((ext_vector_type(2)));
typedef float f32x4 __attribute__((ext_vector_type(4)));
__device__ __forceinline__ unsigned pk2(float lo, float hi) { return (unsigned)f2bf(lo) | ((unsigned)f2bf(hi) << 16); }
__device__ __forceinline__ float fsigmoid(float x) { return __builtin_amdgcn_rcpf(1.0f + __builtin_amdgcn_exp2f(-1.4426950408889634f * x)); }

__device__ __forceinline__ void p0_transpose_item(const float* W, int K, int ldw, int c0, int k0, bf16_t* WT, int drow, LAS float* scr, int lane) {
    { f32x4 tv[8]; const int rr = lane >> 3, cg = (lane & 7) * 4;
#pragma unroll
      for (int i = 0; i < 8; ++i) tv[i] = *(const f32x4*)(W + (size_t)(k0 + 8 * i + rr) * ldw + c0 + cg);
#pragma unroll
      for (int i = 0; i < 8; ++i) { LAS float* d = scr + (8 * i + rr) * 33 + cg; d[0] = tv[i][0]; d[1] = tv[i][1]; d[2] = tv[i][2]; d[3] = tv[i][3]; } }
    asm volatile("s_waitcnt lgkmcnt(0)" ::: "memory");
    const int c = lane & 7;
#pragma unroll
    for (int j = 0; j < 4; ++j) { const int n = (lane >> 3) + 8 * j; const LAS float* s = scr + (8 * c) * 33 + n;
        v4u o; o.x = pk2(s[0 * 33], s[1 * 33]); o.y = pk2(s[2 * 33], s[3 * 33]); o.z = pk2(s[4 * 33], s[5 * 33]); o.w = pk2(s[6 * 33], s[7 * 33]);
        *(GAS v4u*)(WT + (size_t)(drow + n) * K + k0 + 8 * c) = o; }
    asm volatile("s_waitcnt lgkmcnt(0)" ::: "memory");
}
struct CvtJob { const float* W; bf16_t* WT; int K, ldw, c0, ncols, mode, Hn, dbase; };
__device__ __forceinline__ int cvt_items(const CvtJob& j) { return (j.K / 64) * (j.ncols / 32); }
__device__ __forceinline__ void cvt_run(const CvtJob& j, int item, LAS float* scr, int lane) {
    const int nblk = j.ncols / 32, kb = item / nblk, nb = item % nblk; const int c = j.c0 + 32 * nb;
    int drow; if (j.mode == 0) drow = j.dbase + 32 * nb; else { const int cc = c < j.Hn ? c : c - j.Hn; drow = 256 * (cc / 128) + (cc % 128) + (c < j.Hn ? 0 : 128); }
    p0_transpose_item(j.W, j.K, j.ldw, c, 64 * kb, j.WT, drow, scr, lane);
}
__device__ __forceinline__ void p0_weights(const Params& p, LAS unsigned char* lds, int vcu, int G) {
    const int tid_ = tid_opaque(); const int lane = tid_ & 63, wave = __builtin_amdgcn_readfirstlane(tid_ >> 6);
    LAS float* scr = (LAS float*)(lds + wave * 16384);
    const int gw = vcu * NWAVES + wave, NGW = G * NWAVES;
    CvtJob jobs[9] = {
        {p.winab, (bf16_t*)(p.ws + WB_AB), DM, ABIN, 0, 2 * CCH, 1, CCH, 0},
        {p.winab, (bf16_t*)(p.ws + WB_AB), DM, ABIN, 2 * CCH, 4 * MW, 0, 0, 2 * CCH},
        {p.woutab, (bf16_t*)(p.ws + WB_OUTAB), DM, DM, 0, DM, 0, 0, 0},
        {p.wffi, (bf16_t*)(p.ws + WB_FFI0), DM, 2 * DFF, 0, 2 * DFF, 1, DFF, 0},
        {p.wffo, (bf16_t*)(p.ws + WB_FFO0), DFF, DM, 0, DM, 0, 0, 0},
        {p.winc, (bf16_t*)(p.ws + WB_INC), DM, CIN, 0, CIN, 0, 0, 0},
        {p.woutc, (bf16_t*)(p.ws + WB_OUTC), DM, DM, 0, DM, 0, 0, 0},
        {p.wffi + (size_t)DM * 2 * DFF, (bf16_t*)(p.ws + WB_FFI1), DM, 2 * DFF, 0, 2 * DFF, 1, DFF, 0},
        {p.wffo + (size_t)DFF * DM, (bf16_t*)(p.ws + WB_FFO1), DFF, DM, 0, DM, 0, 0, 0}};
    int base = 0;
#pragma unroll
    for (int jj = 0; jj < 9; ++jj) {
        const int n = cvt_items(jobs[jj]);
        int first = ((gw - base) % NGW + NGW) % NGW;
        for (int it = first; it < n; it += NGW) cvt_run(jobs[jj], it, scr, lane);
        base += n;
    }
}

struct EpiAB {
    static constexpr bool PERM = true, AFTER_DRAIN = false;
    bf16_t* upre; bf16_t* qkvo;
    __device__ __forceinline__ void operator()(const f32x4 (&acc)[2][2][4][2], const pg8::Unit& u, int wr, int wc, int fr, int fq) const {
        const int row0 = u.pm * 256 + wr * 64 + fr, lc = wc * 32 + 8 * fq;
        if (u.pn < 4) {
#pragma unroll
            for (int ai = 0; ai < 2; ++ai)
#pragma unroll
                for (int m = 0; m < 4; ++m) { const f32x4 a0 = acc[ai][0][m][0], a1 = acc[ai][0][m][1], g0 = acc[ai][1][m][0], g1 = acc[ai][1][m][1]; v4u w;
                    w.x = pg8::cvt_pk_bf16(a0[0] * fsigmoid(g0[0]), a0[1] * fsigmoid(g0[1])); w.y = pg8::cvt_pk_bf16(a0[2] * fsigmoid(g0[2]), a0[3] * fsigmoid(g0[3]));
                    w.z = pg8::cvt_pk_bf16(a1[0] * fsigmoid(g1[0]), a1[1] * fsigmoid(g1[1])); w.w = pg8::cvt_pk_bf16(a1[2] * fsigmoid(g1[2]), a1[3] * fsigmoid(g1[3]));
                    *(v4u*)(upre + (size_t)(row0 + ai * 128 + m * 16) * CCH + 128 * u.pn + lc) = w; }
        } else {
#pragma unroll
            for (int bj = 0; bj < 2; ++bj) { const int col = 256 * (u.pn - 4) + 128 * bj + lc; const int part = col / MW; const float sc = part == 1 ? 0.08838834764831845f : 1.0f;
#pragma unroll
                for (int ai = 0; ai < 2; ++ai)
#pragma unroll
                    for (int m = 0; m < 4; ++m) { f32x4 v0 = acc[ai][bj][m][0] * sc, v1 = acc[ai][bj][m][1] * sc;
                        if (part == 3) { v0 = (f32x4){fsigmoid(v0[0]), fsigmoid(v0[1]), fsigmoid(v0[2]), fsigmoid(v0[3])}; v1 = (f32x4){fsigmoid(v1[0]), fsigmoid(v1[1]), fsigmoid(v1[2]), fsigmoid(v1[3])}; }
                        v4u w; w.x = pg8::cvt_pk_bf16(v0[0], v0[1]); w.y = pg8::cvt_pk_bf16(v0[2], v0[3]); w.z = pg8::cvt_pk_bf16(v1[0], v1[1]); w.w = pg8::cvt_pk_bf16(v1[2], v1[3]);
                        *(v4u*)(qkvo + (size_t)(row0 + ai * 128 + m * 16) * (4 * MW) + col) = w; } }
        }
    }
};
static_assert(MDK == 128, "EpiAB hard-codes MDK^-0.5");
struct EpiRes {
    static constexpr bool PERM = false, AFTER_DRAIN = false;
    const float* xp; const float* xs;
    float* Y; bf16_t* XN; float* ssq; const float* mod_g; const float* mod_sc; const float* ng;
    int from_input; int pad_;
    __device__ __forceinline__ void operator()(const f32x4 (&acc)[2][2][4][2], const pg8::Unit& u, int wr, int wc, int fr, int fq) const {
        const int row0 = u.pm * 256 + wr * 64 + fr; const int cls = cls_of(u.pm * 256);
        const float* xin = from_input ? (u.pm * 256 < MC ? xp : xs - (size_t)MC * DM) : Y;
        const float* gv = mod_g + (size_t)cls * 6 * DM; const float* scv = mod_sc + (size_t)cls * 6 * DM;
        float sq[2][4];
#pragma unroll
        for (int ai = 0; ai < 2; ++ai)
#pragma unroll
            for (int m = 0; m < 4; ++m) sq[ai][m] = 0.f;
#pragma unroll
        for (int bj = 0; bj < 2; ++bj)
#pragma unroll
            for (int n = 0; n < 2; ++n) { const int col = u.pn * 256 + bj * 128 + wc * 32 + n * 16 + 4 * fq;
                const f32x4 g4 = *(const f32x4*)(gv + col); f32x4 gs4 = (f32x4){0.f, 0.f, 0.f, 0.f};
                if (ng) { const f32x4 n4 = *(const f32x4*)(ng + col), s4 = *(const f32x4*)(scv + col); gs4 = n4 * (s4 + 1.0f); }
#pragma unroll
                for (int ai = 0; ai < 2; ++ai)
#pragma unroll
                    for (int m = 0; m < 4; ++m) { const size_t off = (size_t)(row0 + ai * 128 + m * 16) * DM + col;
                        const f32x4 xi = *(const f32x4*)(xin + off); const f32x4 xn = xi + g4 * acc[ai][bj][m][n];
                        *(f32x4*)(Y + off) = xn; sq[ai][m] += (xn[0] * xn[0] + xn[1] * xn[1]) + (xn[2] * xn[2] + xn[3] * xn[3]);
                        if (ng) { const f32x4 t = xn * gs4; v2u w; w.x = pg8::cvt_pk_bf16(t[0], t[1]); w.y = pg8::cvt_pk_bf16(t[2], t[3]); *(v2u*)(XN + off) = w; } } }
#pragma unroll
        for (int ai = 0; ai < 2; ++ai)
#pragma unroll
            for (int m = 0; m < 4; ++m) { float s = sq[ai][m]; s += __shfl_xor(s, 16); s += __shfl_xor(s, 32);
                if (fq == 0) atomicAdd(ssq + row0 + ai * 128 + m * 16, s); }
    }
};
struct EpiFfnIn {
    static constexpr bool PERM = true, AFTER_DRAIN = false;
    bf16_t* H; const float* ssq; const float* sw;
    __device__ __forceinline__ void operator()(const f32x4 (&acc)[2][2][4][2], const pg8::Unit& u, int wr, int wc, int fr, int fq) const {
        const int row0 = u.pm * 256 + wr * 64 + fr, lc = wc * 32 + 8 * fq; const int cls = cls_of(u.pm * 256); const int col = 128 * u.pn + lc;
        const float* swr = sw + (size_t)cls * 2 * DFF;
        const f32x4 sg0 = *(const f32x4*)(swr + col), sg1 = *(const f32x4*)(swr + col + 4), su0 = *(const f32x4*)(swr + DFF + col), su1 = *(const f32x4*)(swr + DFF + col + 4);
#pragma unroll
        for (int ai = 0; ai < 2; ++ai)
#pragma unroll
            for (int m = 0; m < 4; ++m) { const int row = row0 + ai * 128 + m * 16; const float rs = 1.0f / sqrtf(ssq[row] * (1.0f / DM) + EPSF);
                const f32x4 a0 = acc[ai][0][m][0] * rs + sg0, a1 = acc[ai][0][m][1] * rs + sg1, b0 = acc[ai][1][m][0] * rs + su0, b1 = acc[ai][1][m][1] * rs + su1; v4u w;
                w.x = pg8::cvt_pk_bf16(a0[0] * fsigmoid(a0[0]) * b0[0], a0[1] * fsigmoid(a0[1]) * b0[1]); w.y = pg8::cvt_pk_bf16(a0[2] * fsigmoid(a0[2]) * b0[2], a0[3] * fsigmoid(a0[3]) * b0[3]);
                w.z = pg8::cvt_pk_bf16(a1[0] * fsigmoid(a1[0]) * b1[0], a1[1] * fsigmoid(a1[1]) * b1[1]); w.w = pg8::cvt_pk_bf16(a1[2] * fsigmoid(a1[2]) * b1[2], a1[3] * fsigmoid(a1[3]) * b1[3]);
                *(v4u*)(H + (size_t)row * DFF + col) = w; }
    }
};
struct EpiQkv {
    static constexpr bool PERM = true, AFTER_DRAIN = false;
    bf16_t* qraw; bf16_t* kraw; bf16_t* ctxv; bf16_t* latv; float* outv; const float* ssq; const float* sw;
    __device__ __forceinline__ void operator()(const f32x4 (&acc)[2][2][4][2], const pg8::Unit& u, int wr, int wc, int fr, int fq) const {
        const int row0 = u.pm * 256 + wr * 64 + fr, lc = wc * 32 + 8 * fq; const int cls = cls_of(u.pm * 256); const float* swr = sw + (size_t)cls * CIN;
        float rs[2][4];
#pragma unroll
        for (int ai = 0; ai < 2; ++ai)
#pragma unroll
            for (int m = 0; m < 4; ++m) rs[ai][m] = 1.0f / sqrtf(ssq[row0 + ai * 128 + m * 16] * (1.0f / DM) + EPSF);
#pragma unroll
        for (int bj = 0; bj < 2; ++bj) { const int col = 256 * u.pn + 128 * bj + lc; const f32x4 s0 = *(const f32x4*)(swr + col), s1 = *(const f32x4*)(swr + col + 4);
#pragma unroll
            for (int ai = 0; ai < 2; ++ai)
#pragma unroll
                for (int m = 0; m < 4; ++m) { const int row = row0 + ai * 128 + m * 16; const f32x4 v0 = acc[ai][bj][m][0] * rs[ai][m] + s0, v1 = acc[ai][bj][m][1] * rs[ai][m] + s1;
                    v4u w; w.x = pg8::cvt_pk_bf16(v0[0], v0[1]); w.y = pg8::cvt_pk_bf16(v0[2], v0[3]); w.z = pg8::cvt_pk_bf16(v1[0], v1[1]); w.w = pg8::cvt_pk_bf16(v1[2], v1[3]);
                    if (u.pn < NQ * HDIM / 256) *(v4u*)(qraw + (size_t)row * (NQ * HDIM) + col) = w;
                    else if (u.pn == NQ * HDIM / 256) *(v4u*)(kraw + (size_t)row * (NKV * HDIM) + (col - NQ * HDIM)) = w;
                    else { const int c2 = col - (NQ + NKV) * HDIM;
                        if (row < MC) { *(v4u*)(ctxv + (size_t)row * (NKV * HDIM) + c2) = w; float* o = outv + (size_t)row * (NKV * HDIM) + c2; *(f32x4*)o = v0; *(f32x4*)(o + 4) = v1; }
                        else { const int b = (row - MC) / LSEQ, s = (row - MC) % LSEQ; *(v4u*)(latv + ((size_t)b * SKVL + s) * (NKV * HDIM) + c2) = w; } } } }
    }
};
static_assert(NKV * HDIM == 256 && (NQ * HDIM) % 256 == 0, "EpiQkv tile mapping");
namespace att {
typedef unsigned short bf16;
constexpr int D = 128, NW = 8, QBLK = 32, KVBLK = 64; constexpr float SCALE = 0.088388347648318440f; constexpr float THR = 8.f; constexpr int SDEPTH = 1;
constexpr int LDQ = NQ * HDIM, LDK = NKV * HDIM, LDO = DM;
constexpr size_t SHM_V = KVBLK * D * 2, SHM_K = KVBLK * D * 2, SHM_ATTN = 2 * SHM_V + 2 * SHM_K + NW * 64 * 4;
using bf16x8 = __attribute__((ext_vector_type(8))) short;
using s16x4  = __attribute__((ext_vector_type(4))) short;
using f32x16 = __attribute__((ext_vector_type(16))) float;
using f32x8  = __attribute__((ext_vector_type(8))) float;
using u32x4  = __attribute__((ext_vector_type(4))) unsigned;
#define KSWZ(row, colB) ((row) * 256 + ((colB) ^ (((row) & 7) << 4)))
#define SBAR() __builtin_amdgcn_sched_barrier(0)
__device__ __forceinline__ int crow(int r, int hi) { return (r & 3) + 8 * (r >> 2) + 4 * hi; }
__device__ __forceinline__ unsigned cvtpk(float lo, float hi) {
  unsigned r; asm volatile("v_cvt_pk_bf16_f32 %0, %1, %2" : "=v"(r) : "v"(lo), "v"(hi)); return r;
}
template <typename TIn> struct Stage;
template <> struct Stage<bf16>  { using T = bf16x8;
  __device__ static __forceinline__ T ld8(const bf16* p) { return *reinterpret_cast<const bf16x8*>(p); }
  __device__ static __forceinline__ bf16x8 tobf(T x) { return x; } };
__device__ __forceinline__ void partialSM(f32x16& p0, f32x16& p1, float& m_reg, float& mn, float& alpha) {
  constexpr float C = SCALE * 1.4426950408889634f;
  float pmax = p0[0]; for (int r = 1; r < 16; ++r) pmax = fmaxf(pmax, p0[r]); for (int r = 0; r < 16; ++r) pmax = fmaxf(pmax, p1[r]);
  { auto rr = __builtin_amdgcn_permlane32_swap(__float_as_uint(pmax), __float_as_uint(pmax), false, false);
    pmax = fmaxf(__uint_as_float(rr[0]), __uint_as_float(rr[1])); }
  if (__builtin_expect(__all(pmax - m_reg <= THR / SCALE), 1)) { mn = m_reg; alpha = 1.f; }
  else { mn = fmaxf(m_reg, pmax); alpha = __builtin_amdgcn_exp2f((m_reg - mn) * C); m_reg = mn; }
  float mnC = -mn * C;
  for (int r = 0; r < 16; ++r) p0[r] = fmaf(p0[r], C, mnC); for (int r = 0; r < 16; ++r) p1[r] = fmaf(p1[r], C, mnC);
  for (int r = 0; r < 16; ++r) p0[r] = __builtin_amdgcn_exp2f(p0[r]);
}
__device__ __forceinline__ void finishSM(f32x16& p0, f32x16& p1, float alpha, float& l_reg, bf16x8& pa0, bf16x8& pa1, bf16x8& pa2, bf16x8& pa3) {
  for (int r = 0; r < 16; ++r) p1[r] = __builtin_amdgcn_exp2f(p1[r]);
  float ps = 0; for (int r = 0; r < 16; ++r) ps += p0[r]; for (int r = 0; r < 16; ++r) ps += p1[r];
  { auto rr = __builtin_amdgcn_permlane32_swap(__float_as_uint(ps), __float_as_uint(ps), false, false);
    ps = __uint_as_float(rr[0]) + __uint_as_float(rr[1]); }
  l_reg = l_reg * alpha + ps;
#define PK4(P, BASE, OUT) do { unsigned a0 = cvtpk(P[BASE + 0], P[BASE + 1]), a1 = cvtpk(P[BASE + 2], P[BASE + 3]);   \
    unsigned b0 = cvtpk(P[BASE + 4], P[BASE + 5]), b1 = cvtpk(P[BASE + 6], P[BASE + 7]);                              \
    auto r0 = __builtin_amdgcn_permlane32_swap(a0, b0, false, false); auto r1 = __builtin_amdgcn_permlane32_swap(a1, b1, false, false); \
    u32x4 w = {r0[0], r1[0], r0[1], r1[1]}; OUT = *reinterpret_cast<bf16x8*>(&w); } while (0)
  PK4(p0, 0, pa0); PK4(p0, 8, pa1); PK4(p1, 0, pa2); PK4(p1, 8, pa3);
#undef PK4
}
__device__ __forceinline__ void qkt(f32x16& p0, f32x16& p1, const bf16* Ks, const bf16x8* qr, int r32, int hi) {
  p0 = f32x16{}; p1 = f32x16{};
  for (int d0 = 0; d0 < 8; ++d0) { int cb = (d0 * 16 + hi * 8) * 2;
    bf16x8 b0 = *reinterpret_cast<const bf16x8*>((const char*)Ks + KSWZ(r32, cb));
    bf16x8 b1 = *reinterpret_cast<const bf16x8*>((const char*)Ks + KSWZ(32 + r32, cb));
    p0 = __builtin_amdgcn_mfma_f32_32x32x16_bf16(b0, qr[d0], p0, 0, 0, 0);
    p1 = __builtin_amdgcn_mfma_f32_32x32x16_bf16(b1, qr[d0], p1, 0, 0, 0); }
}
__device__ __forceinline__ int v_st(int k, int c) { const int kk = (k & ~0xC) | ((k & 4) << 1) | ((k & 8) >> 1); return ((kk >> 3) * 4 + (c >> 5)) * 512 + ((kk & 7) * 32 + (c & 31)) * 2; }
__device__ __forceinline__ int v_rd_base(int lane) { return ((lane & 3) << 3) | (((lane >> 2) & 3) << 6) | (((lane >> 4) & 1) << 5) | (((lane >> 5) & 1) << 8); }
constexpr int v_rd_off(int d0, int ks, int half) { return d0 * 512 + ks * 4096 + half * 2048; }
template <int OFF> __device__ __forceinline__ s16x4 tr_read(int vb) {
  s16x4 r; asm volatile("ds_read_b64_tr_b16 %0, %1 offset:%2" : "=&v"(r) : "v"(vb), "i"(OFF) : "memory"); return r;
}
template <int D0> __device__ __forceinline__ void pv_one(f32x16& od, int vb, bf16x8 pa0, bf16x8 pa1, bf16x8 pa2, bf16x8 pa3) {
  const s16x4 l0 = tr_read<v_rd_off(D0, 0, 0)>(vb), h0 = tr_read<v_rd_off(D0, 0, 1)>(vb), l1 = tr_read<v_rd_off(D0, 1, 0)>(vb), h1 = tr_read<v_rd_off(D0, 1, 1)>(vb);
  const s16x4 l2 = tr_read<v_rd_off(D0, 2, 0)>(vb), h2 = tr_read<v_rd_off(D0, 2, 1)>(vb), l3 = tr_read<v_rd_off(D0, 3, 0)>(vb), h3 = tr_read<v_rd_off(D0, 3, 1)>(vb);
  asm volatile("s_waitcnt lgkmcnt(0)" ::: "memory"); SBAR();
#define PK(L, H) (bf16x8){L[0], L[1], L[2], L[3], H[0], H[1], H[2], H[3]}
  od = __builtin_amdgcn_mfma_f32_32x32x16_bf16(pa0, PK(l0, h0), od, 0, 0, 0);
  od = __builtin_amdgcn_mfma_f32_32x32x16_bf16(pa1, PK(l1, h1), od, 0, 0, 0);
  od = __builtin_amdgcn_mfma_f32_32x32x16_bf16(pa2, PK(l2, h2), od, 0, 0, 0);
  od = __builtin_amdgcn_mfma_f32_32x32x16_bf16(pa3, PK(l3, h3), od, 0, 0, 0);
#undef PK
}
__device__ __forceinline__ void pv_d0(f32x16* o, int vb, bf16x8 pa0, bf16x8 pa1, bf16x8 pa2, bf16x8 pa3) {
  pv_one<0>(o[0], vb, pa0, pa1, pa2, pa3); pv_one<1>(o[1], vb, pa0, pa1, pa2, pa3); pv_one<2>(o[2], vb, pa0, pa1, pa2, pa3); pv_one<3>(o[3], vb, pa0, pa1, pa2, pa3);
}

__device__ __forceinline__ void attn_dense_body(const bf16* __restrict__ Qb, const bf16* __restrict__ Kh, const bf16* __restrict__ Vh,
                                                bf16* __restrict__ Ob, int seq, char* lds) {
  typedef bf16 TQ;
  using St = Stage<bf16>; using SQ = Stage<TQ>;
  const int tid = tid_opaque(), wid = tid >> 6, lane = tid & 63, r32 = lane & 31, hi = lane >> 5;
  bf16* V_lds = (bf16*)lds; bf16* K_lds = (bf16*)(lds + 2 * SHM_V);
  float* ws = (float*)(lds + 2 * SHM_V + 2 * SHM_K) + wid * 64; float* li_l = ws; float* al_l = ws + 32;
  float m_reg = -1e30f, l_reg = 0; f32x16 o[4] = {}; bf16x8 qr[8];
  const TQ* Qw = Qb + (long)(wid * QBLK + r32) * LDQ + hi * 8;
#pragma unroll
  for (int d0 = 0; d0 < 8; ++d0) qr[d0] = SQ::tobf(SQ::ld8(Qw + d0 * 16));
  const int sr = tid >> 4, sc = (tid & 15) * 8, vst0 = v_st(sr, sc), vst1 = v_st(32 + sr, sc);
  const int vb0 = (int)(uintptr_t)V_lds + v_rd_base(lane);
  struct { typename St::T vs0, vs1, ks0, ks1; } sr_[SDEPTH];
#define SLOAD(i, k0) do { sr_[i].vs0 = St::ld8(&Vh[(long)((k0) + sr) * LDK + sc]); sr_[i].vs1 = St::ld8(&Vh[(long)((k0) + 32 + sr) * LDK + sc]); \
    sr_[i].ks0 = St::ld8(&Kh[(long)((k0) + sr) * LDK + sc]); sr_[i].ks1 = St::ld8(&Kh[(long)((k0) + 32 + sr) * LDK + sc]); } while (0)
#define SWRITE(b, i) do { *(bf16x8*)((char*)V_lds + (b) * SHM_V + vst0) = St::tobf(sr_[i].vs0);          \
    *(bf16x8*)((char*)V_lds + (b) * SHM_V + vst1) = St::tobf(sr_[i].vs1); int kc = sc * 2;               \
    *(bf16x8*)((char*)K_lds + (b) * SHM_K + KSWZ(sr, kc)) = St::tobf(sr_[i].ks0);                       \
    *(bf16x8*)((char*)K_lds + (b) * SHM_K + KSWZ(32 + sr, kc)) = St::tobf(sr_[i].ks1); } while (0)
#define SWAIT() do { if constexpr (SDEPTH == 2) asm volatile("s_waitcnt vmcnt(4)" ::: "memory"); else asm volatile("s_waitcnt vmcnt(0)" ::: "memory"); } while (0)
#define RESC(a) do { if (__any((a) < 1.f)) { if (hi == 0) al_l[r32] = (a); asm volatile("s_waitcnt lgkmcnt(0)" ::: "memory"); \
    for (int d = 0; d < 4; ++d) for (int r = 0; r < 16; ++r) o[d][r] *= al_l[crow(r, hi)]; } } while (0)
  f32x16 pA0, pA1, pB0, pB1; float mnA, mnB, alA, alB; bf16x8 pa0, pa1, pa2, pa3; const int NT = seq / KVBLK;
  constexpr int SE = 0, SO = SDEPTH - 1;
  SLOAD(SE, 0); asm volatile("s_waitcnt vmcnt(0)" ::: "memory"); SWRITE(0, SE); __syncthreads();
  qkt(pA0, pA1, K_lds, qr, r32, hi); partialSM(pA0, pA1, m_reg, mnA, alA);
  SLOAD(SO, KVBLK); if constexpr (SDEPTH == 2) { if (2 < NT) SLOAD(SE, 2 * KVBLK); }
  SWAIT(); SWRITE(1, SO); __syncthreads();
  for (int j = 1; j + 1 < NT; j += 2) {
    SBAR(); qkt(pB0, pB1, (bf16*)((char*)K_lds + SHM_K), qr, r32, hi);
    finishSM(pA0, pA1, alA, l_reg, pa0, pa1, pa2, pa3); SBAR();
    SLOAD(SO, (j + SDEPTH) * KVBLK); SBAR();
    pv_d0(o, vb0, pa0, pa1, pa2, pa3); partialSM(pB0, pB1, m_reg, mnB, alB);
    __syncthreads(); SWAIT(); SWRITE(0, SE);
    RESC(alB); __syncthreads();
    SBAR(); qkt(pA0, pA1, K_lds, qr, r32, hi);
    finishSM(pB0, pB1, alB, l_reg, pa0, pa1, pa2, pa3); SBAR();
    if (SDEPTH == 1 || j + 3 < NT) SLOAD(SE, (j + 1 + SDEPTH) * KVBLK); SBAR();
    pv_d0(o, vb0 + (int)SHM_V, pa0, pa1, pa2, pa3); partialSM(pA0, pA1, m_reg, mnA, alA);
    __syncthreads(); SWAIT(); SWRITE(1, SO);
    RESC(alA); __syncthreads();
  }
  SBAR(); qkt(pB0, pB1, (bf16*)((char*)K_lds + SHM_K), qr, r32, hi);
  finishSM(pA0, pA1, alA, l_reg, pa0, pa1, pa2, pa3); SBAR();
  pv_d0(o, vb0, pa0, pa1, pa2, pa3); partialSM(pB0, pB1, m_reg, mnB, alB);
  __syncthreads(); RESC(alB);
  finishSM(pB0, pB1, alB, l_reg, pa0, pa1, pa2, pa3); SBAR();
  pv_d0(o, vb0 + (int)SHM_V, pa0, pa1, pa2, pa3);
  if (hi == 0) li_l[r32] = l_reg; asm volatile("s_waitcnt lgkmcnt(0)" ::: "memory");
  float rli[16];
#pragma unroll
  for (int r = 0; r < 16; ++r) rli[r] = __builtin_amdgcn_rcpf(li_l[crow(r, hi)]);
  bf16* Ow = Ob + (long)(wid * QBLK) * LDO;
#pragma unroll
  for (int r = 0; r < 16; ++r) { int orow = crow(r, hi);
    for (int d0 = 0; d0 < 4; ++d0) Ow[(long)orow * LDO + d0 * 32 + r32] = f2bf(o[d0][r] * rli[r]); }
#undef SLOAD
#undef SWRITE
#undef SWAIT
#undef RESC
}
}
__device__ __forceinline__ void attn_phase(const Params& p, unsigned char* lds, int vcu, int G) {
    constexpr int QB = 256, LQB = LSEQ / QB, CQB = CSEQ / QB;
    constexpr int NUL = NLB * NQ * LQB, NUC = NCB * NQ * CQB, NU = NUL + NUC;
    const att::bf16* QR = (const att::bf16*)(p.ws + WS_QRAW); att::bf16* OB = (att::bf16*)(p.ws + WS_O);
    for (int i = 0;; ++i) {
        int u;
        if (G == 256 && NUL == 512) { if (i < 2) u = (vcu >> 5) * 64 + (vcu & 31) + 32 * i; else u = NUL + vcu + (i - 2) * G; }
        else u = vcu + i * G;
        if (u >= NU) break;
        const att::bf16 *Q, *K, *V; att::bf16* O; int seq;
        if (u < NUL) { const int grp = u / (GRP * LQB), j = u % (GRP * LQB); const int b = grp / NKV, kvh = grp % NKV, g = j / LQB, qb = j % LQB, hq = kvh * GRP + g;
            const size_t row0 = (size_t)MC + (size_t)b * LSEQ + (size_t)qb * QB;
            Q = QR + row0 * (NQ * HDIM) + hq * HDIM; O = OB + row0 * DM + hq * HDIM;
            K = (const att::bf16*)(p.ws + WS_LATK) + (size_t)b * SKVL * (NKV * HDIM) + kvh * HDIM; V = (const att::bf16*)(p.ws + WS_LATV) + (size_t)b * SKVL * (NKV * HDIM) + kvh * HDIM; seq = SKVL; }
        else { const int uc = u - NUL; const int b = uc / (NQ * CQB), r = uc % (NQ * CQB), hq = r / CQB, qb = r % CQB, kvh = hq / GRP;
            const size_t row0 = (size_t)b * CSEQ + (size_t)qb * QB;
            Q = QR + row0 * (NQ * HDIM) + hq * HDIM; O = OB + row0 * DM + hq * HDIM;
            K = (const att::bf16*)(p.ws + WS_CTXK) + (size_t)b * CSEQ * (NKV * HDIM) + kvh * HDIM; V = (const att::bf16*)(p.ws + WS_CTXV) + (size_t)b * CSEQ * (NKV * HDIM) + kvh * HDIM; seq = CSEQ; }
        __syncthreads();
        att::attn_dense_body(Q, K, V, O, seq, (char*)lds);
    }
}
static_assert(SKVL % 128 == 0 && CSEQ % 128 == 0 && LSEQ % 256 == 0 && CSEQ % 256 == 0, "attention tiling");
constexpr size_t WS_CST = 232 * MiB;
constexpr int NBLK = LSEQ / 256;
constexpr size_t WS_NST = WS_CST + (size_t)NLB * MH * 2 * NBLK * MDK * MDK * 2;
constexpr size_t WS_FTOT = WS_NST + (size_t)NLB * MH * 2 * NBLK * MDK * 4;
static_assert(WS_FTOT + (size_t)NLB * MH * 2 * NBLK * 4 <= WS_END && MDK == 128 && CSEQ == 256 && LSEQ % 256 == 0, "mLSTM fast path geometry");
namespace att {
constexpr int ML_OFF = 132096;
constexpr int ML_SC = ML_OFF + 6144;
constexpr int ML_N = ML_SC + 128;
constexpr int ML_LI = ML_N + 1024;
static_assert(ML_LI + 1024 <= LDS_BYTES, "mLSTM LDS map");
constexpr float L2E = 1.4426950408889634f;
using f32x4v = __attribute__((ext_vector_type(4))) float;


__device__ __forceinline__ void ml_gates(const Params& p, char* lds, int row0, int h, int tid) {
    float* A = (float*)(lds + ML_OFF); float* S = (float*)(lds + ML_SC);
    const int half = tid >> 8, t = tid & 255, tok = half ? 255 - t : t, lane = tid & 63, wv = (tid >> 6) & 3;
    const float* G = (const float*)(p.ws + WS_GATES) + (size_t)(row0 + tok) * NGATE + half * 8 + h;
    const float ig = G[0], lf = G[4];
    float v = lf;
#pragma unroll
    for (int off = 1; off < 64; off <<= 1) { const float u = lane_get(v, lane - off); if (lane >= off) v += u; }
    if (lane == 63) S[4 + half * 4 + wv] = v;
    __syncthreads();
    float pre = 0.f, tot = 0.f;
#pragma unroll
    for (int w = 0; w < 4; ++w) { const float x = S[4 + half * 4 + w]; if (w < wv) pre += x; tot += x; }
    const float P = v + pre, a = ig - P;
    A[(0 + half) * 256 + tok] = P * L2E; A[(2 + half) * 256 + tok] = a * L2E; A[(4 + half) * 256 + tok] = __builtin_amdgcn_exp2f(P * L2E);
    float mx = a;
    mx = fmaxf(mx, swz_xor<1>(mx)); mx = fmaxf(mx, swz_xor<2>(mx)); mx = fmaxf(mx, swz_xor<4>(mx)); mx = fmaxf(mx, swz_xor<8>(mx)); mx = fmaxf(mx, swz_xor<16>(mx)); mx = half_max(mx);
    if (lane == 0) S[12 + half * 4 + wv] = mx;
    if (t == 0) S[half] = tot;
    __syncthreads();
    if (t == 0) S[2 + half] = fmaxf(fmaxf(S[12 + half * 4], S[13 + half * 4]), fmaxf(S[14 + half * 4], S[15 + half * 4]));
    __syncthreads();
}
#define ML_PK(L, H) (bf16x8){L[0], L[1], L[2], L[3], H[0], H[1], H[2], H[3]}
__device__ __forceinline__ s16x4 tr_read_rt(int vb) { s16x4 r; asm volatile("ds_read_b64_tr_b16 %0, %1" : "=&v"(r) : "v"(vb) : "memory"); return r; }

__device__ __forceinline__ void ml_passA_unit(const Params& p, char* lds, int sid, int h, int blk) {
    const int tid = tid_opaque(), wid = tid >> 6, lane = tid & 63, r32 = lane & 31, hi = lane >> 5;
    const bool isctx = sid < NCB; const int row0 = seq_base(sid) + 256 * blk;
    __syncthreads();
    ml_gates(p, lds, row0, h, tid);
    float* A = (float*)(lds + ML_OFF); float* S = (float*)(lds + ML_SC); float* NA = (float*)(lds + ML_N);
    const bf16* QK = (const bf16*)(p.ws + WS_QKVO) + (size_t)row0 * (4 * MW) + h * MDK;
    const int sr = tid >> 4, sc8 = (tid & 15) * 8;
    { bf16x8 tv[8];
#pragma unroll
      for (int i = 0; i < 8; ++i) tv[i] = *(const bf16x8*)(QK + (size_t)(32 * i + sr) * (4 * MW) + 2 * MW + sc8);
#pragma unroll
      for (int i = 0; i < 8; ++i) *(bf16x8*)(lds + 65536 + (i >> 1) * 16384 + v_st(32 * (i & 1) + sr, sc8)) = tv[i]; }
    if (tid < 256) NA[tid] = 0.f;
    const int a = wid >> 1, dvb0 = 2 * (wid & 1);
    const int ldsb = (int)(uintptr_t)lds; const int vbK = ldsb + v_rd_base(lane) + a * 512, vbV = ldsb + 65536 + v_rd_base(lane) + dvb0 * 512;
    for (int dir = 0; dir < 2; ++dir) {
        __syncthreads();
        const float ft = S[dir], am = S[2 + dir]; const float mT = isctx ? ft + fmaxf(am, 0.f) : 0.f; const float wl2 = (ft - mT) * L2E;
        float xs[8];
#pragma unroll
        for (int i = 0; i < 8; ++i) xs[i] = 0.f;
        bf16x8 tk[8];
#pragma unroll
        for (int i = 0; i < 8; ++i) tk[i] = *(const bf16x8*)(QK + (size_t)(32 * i + sr) * (4 * MW) + MW + sc8);
#pragma unroll
        for (int j = 0; j < 4; ++j)
#pragma unroll
            for (int hf = 0; hf < 2; ++hf) { const int row = 64 * j + 32 * hf + sr; const float w = __builtin_amdgcn_exp2f(wl2 + A[(2 + dir) * 256 + row]);
                const bf16x8 k8 = tk[2 * j + hf]; float x[8];
#pragma unroll
                for (int i = 0; i < 8; ++i) { x[i] = bf2f((unsigned short)k8[i]) * w; xs[i] += x[i]; }
                u32x4 pk = {cvtpk(x[0], x[1]), cvtpk(x[2], x[3]), cvtpk(x[4], x[5]), cvtpk(x[6], x[7])};
                *(u32x4*)(lds + j * 16384 + v_st(32 * hf + sr, sc8)) = pk; }
#pragma unroll
        for (int i = 0; i < 8; ++i) { float v = xs[i]; v += swz_xor<16>(v); v = half_sum(v); if (lane < 16) atomicAdd(&NA[dir * 128 + sc8 + i], v); }
        __syncthreads();
        f32x16 acc0 = {}, acc1 = {}; const unsigned eoff = (unsigned)((32 * a + 4 * hi) * MDK + 32 * dvb0 + r32);
#pragma unroll
        for (int j = 0; j < 4; ++j)
#pragma unroll
            for (int ks = 0; ks < 4; ++ks) { const int off = j * 16384 + ks * 4096;
                const s16x4 al = tr_read_rt(vbK + off), ah = tr_read_rt(vbK + off + 2048);
                const s16x4 bl0 = tr_read_rt(vbV + off), bh0 = tr_read_rt(vbV + off + 2048), bl1 = tr_read_rt(vbV + off + 512), bh1 = tr_read_rt(vbV + off + 512 + 2048);
                asm volatile("s_waitcnt lgkmcnt(0)" ::: "memory"); SBAR();
                acc0 = __builtin_amdgcn_mfma_f32_32x32x16_bf16(ML_PK(al, ah), ML_PK(bl0, bh0), acc0, 0, 0, 0);
                acc1 = __builtin_amdgcn_mfma_f32_32x32x16_bf16(ML_PK(al, ah), ML_PK(bl1, bh1), acc1, 0, 0, 0); }
        if (isctx) {
            float* Co = p.out + O_C + ((size_t)(sid * 2 + dir) * MH + h) * MDK * MDK;
#pragma unroll
            for (int r = 0; r < 16; ++r) { const unsigned eo = eoff + (unsigned)(((r & 3) + 8 * (r >> 2)) * MDK); Co[eo] = acc0[r]; Co[eo + 32] = acc1[r]; }
            if (tid == 0) p.out[O_M + (size_t)(sid * 2 + dir) * MH + h] = mT;
        } else {
            const int b = sid - NCB; bf16* Cs = (bf16*)(p.ws + WS_CST) + ((size_t)((b * MH + h) * 2 + dir) * NBLK + blk) * MDK * MDK;
#pragma unroll
            for (int r = 0; r < 16; ++r) { const unsigned eo = eoff + (unsigned)(((r & 3) + 8 * (r >> 2)) * MDK); Cs[eo] = f2bf(acc0[r]); Cs[eo + 32] = f2bf(acc1[r]); }
            if (tid == 0) ((float*)(p.ws + WS_FTOT))[((size_t)(b * MH + h) * 2 + dir) * NBLK + blk] = ft;
        }
    }
    __syncthreads();
    if (tid < 256) { const int dir = tid >> 7, d = tid & 127;
        if (isctx) p.out[O_N + ((size_t)(sid * 2 + dir) * MH + h) * MDK + d] = NA[tid];
        else { const int b = sid - NCB; ((float*)(p.ws + WS_NST))[(((size_t)(b * MH + h) * 2 + dir) * NBLK + blk) * MDK + d] = NA[tid]; } }
}

template <int DIR> __device__ __forceinline__ void ml_tile(f32x16* o, float& den, const bf16x8* qr, const char* Ktile, int vbV, const float* AL2, int j, float cq, int trow, bool diag, int r32, int hi) {
    SBAR(); f32x16 p0, p1; qkt(p0, p1, (const bf16*)Ktile, qr, r32, hi); SBAR();
    float ds = 0.f; const int tl = trow - 64 * j - 4 * hi;
#pragma unroll
    for (int g = 0; g < 4; ++g) { const f32x4v a0 = *(const f32x4v*)(AL2 + 64 * j + 8 * g + 4 * hi), a1 = *(const f32x4v*)(AL2 + 64 * j + 32 + 8 * g + 4 * hi);
#pragma unroll
        for (int e = 0; e < 4; ++e) { float w0 = __builtin_amdgcn_exp2f(cq + a0[e]), w1 = __builtin_amdgcn_exp2f(cq + a1[e]);
            if (diag) { if (DIR == 0 ? (8 * g + e > tl) : (8 * g + e < tl)) w0 = 0.f; if (DIR == 0 ? (8 * g + e + 32 > tl) : (8 * g + e + 32 < tl)) w1 = 0.f; }
            p0[4 * g + e] *= w0; p1[4 * g + e] *= w1; ds += p0[4 * g + e] + p1[4 * g + e]; } }
    den += ds;
    bf16x8 pa0, pa1, pa2, pa3;
#define PK4(P, BASE, OUT) do { unsigned a0_ = cvtpk(P[BASE + 0], P[BASE + 1]), a1_ = cvtpk(P[BASE + 2], P[BASE + 3]);   \
    unsigned b0_ = cvtpk(P[BASE + 4], P[BASE + 5]), b1_ = cvtpk(P[BASE + 6], P[BASE + 7]);                              \
    auto r0_ = __builtin_amdgcn_permlane32_swap(a0_, b0_, false, false); auto r1_ = __builtin_amdgcn_permlane32_swap(a1_, b1_, false, false); \
    u32x4 w_ = {r0_[0], r1_[0], r0_[1], r1_[1]}; OUT = *reinterpret_cast<bf16x8*>(&w_); } while (0)
    PK4(p0, 0, pa0); PK4(p0, 8, pa1); PK4(p1, 0, pa2); PK4(p1, 8, pa3);
#undef PK4
    SBAR(); pv_d0(o, vbV, pa0, pa1, pa2, pa3); SBAR();
}
__device__ __forceinline__ void ml_stage_kv(char* lds, const bf16* QK, int tile0, int sr, int sc8) {
    bf16x8 tk[4], tv[4];
#pragma unroll
    for (int i = 0; i < 4; ++i) { const int row = 64 * tile0 + 32 * i + sr; tk[i] = *(const bf16x8*)(QK + (size_t)row * (4 * MW) + MW + sc8); tv[i] = *(const bf16x8*)(QK + (size_t)row * (4 * MW) + 2 * MW + sc8); }
#pragma unroll
    for (int i = 0; i < 4; ++i) { const int jj = i >> 1, rl = 32 * (i & 1) + sr; *(bf16x8*)(lds + jj * 16384 + KSWZ(rl, sc8 * 2)) = tk[i]; *(bf16x8*)(lds + 32768 + jj * 16384 + v_st(rl, sc8)) = tv[i]; }
}
__device__ __forceinline__ void ml_passC_unit(const Params& p, char* lds, int sid, int h, int blk) {
    const int tid = tid_opaque(), wid = tid >> 6, lane = tid & 63, r32 = lane & 31, hi = lane >> 5;
    const bool isctx = sid < NCB; const int row0 = seq_base(sid) + 256 * blk; const int wq = wid >> 1;
    __syncthreads();
    ml_gates(p, lds, row0, h, tid);
    float* A = (float*)(lds + ML_OFF); float* NS = (float*)(lds + ML_N); float* li = (float*)(lds + ML_LI) + wid * 32;
    const bf16* QK = (const bf16*)(p.ws + WS_QKVO) + (size_t)row0 * (4 * MW) + h * MDK;
    const int sr = tid >> 4, sc8 = (tid & 15) * 8; const int b = sid - NCB;
    if (tid < 256) { const int dir = tid >> 7, d = tid & 127;
        NS[tid] = isctx ? 0.f : ((const float*)(p.ws + WS_NST))[(((size_t)(b * MH + h) * 2 + dir) * NBLK + blk) * MDK + d]; }
    if (!isctx) { bf16x8 tc[8];
#pragma unroll
        for (int i = 0; i < 8; ++i) { const int dir = i >> 2, c = tid + 512 * (i & 3); tc[i] = *(const bf16x8*)((const bf16*)(p.ws + WS_CST) + ((size_t)((b * MH + h) * 2 + dir) * NBLK + blk) * MDK * MDK + (size_t)c * 8); }
#pragma unroll
        for (int i = 0; i < 8; ++i) { const int dir = i >> 2, c = tid + 512 * (i & 3), row = c >> 4, col8 = (c & 15) * 8; *(bf16x8*)(lds + 65536 + dir * 32768 + (row >> 6) * 16384 + v_st(row & 63, col8)) = tc[i]; }
    }
    bf16x8 qr[8];
    { const bf16* Qw = QK + (size_t)(wid * 32 + r32) * (4 * MW) + hi * 8;
#pragma unroll
        for (int d0 = 0; d0 < 8; ++d0) qr[d0] = *(const bf16x8*)(Qw + d0 * 16); }
    ml_stage_kv(lds, QK, 0, sr, sc8);
    __syncthreads();
    float qn_f = 0.f, qn_b = 0.f;
#pragma unroll
    for (int d0 = 0; d0 < 8; ++d0)
#pragma unroll
        for (int i = 0; i < 8; ++i) { const float qv = bf2f((unsigned short)qr[d0][i]); qn_f += qv * NS[d0 * 16 + hi * 8 + i]; qn_b += qv * NS[128 + d0 * 16 + hi * 8 + i]; }
    qn_f = half_sum(qn_f); qn_b = half_sum(qn_b);
    const int ldsb = (int)(uintptr_t)lds; const int vbV = ldsb + 32768 + v_rd_base(lane), vbC = ldsb + 65536 + v_rd_base(lane);
    const int trow = wid * 32 + r32;
    float* HS = (float*)(p.ws + WS_HS) + (size_t)(row0 + wid * 32) * MW + h * MDK;
    f32x16 o[4]; const unsigned hso = (unsigned)(4 * hi * MW + r32), uho = (unsigned)(4 * hi * DM + r32), ogo = (unsigned)(4 * hi * 4 * MW + r32);
    {
        float qn = qn_f;
        o[0] = f32x16{}; o[1] = f32x16{}; o[2] = f32x16{}; o[3] = f32x16{};
        if (!isctx) { pv_d0(o, vbC, qr[0], qr[1], qr[2], qr[3]); pv_d0(o, vbC + 16384, qr[4], qr[5], qr[6], qr[7]);
#pragma unroll
            for (int r = 0; r < 16; ++r) { const float e = A[4 * 256 + wid * 32 + crow(r, hi)];
#pragma unroll
                for (int d0 = 0; d0 < 4; ++d0) o[d0][r] *= e; } }
        const float cq = A[0 * 256 + trow]; float den = 0.f;
        ml_tile<0>(o, den, qr, lds, vbV, A + 2 * 256, 0, cq, trow, wq == 0, r32, hi);
        if (wq >= 1) ml_tile<0>(o, den, qr, lds + 16384, vbV + 16384, A + 2 * 256, 1, cq, trow, wq == 1, r32, hi);
        __syncthreads(); ml_stage_kv(lds, QK, 2, sr, sc8); __syncthreads();
        if (wq >= 2) ml_tile<0>(o, den, qr, lds, vbV, A + 2 * 256, 2, cq, trow, wq == 2, r32, hi);
        if (wq >= 3) ml_tile<0>(o, den, qr, lds + 16384, vbV + 16384, A + 2 * 256, 3, cq, trow, wq == 3, r32, hi);
        { auto rr = __builtin_amdgcn_permlane32_swap(__float_as_uint(den), __float_as_uint(den), false, false); den = __uint_as_float(rr[0]) + __uint_as_float(rr[1]); }
        const float dn = den + __builtin_amdgcn_exp2f(cq) * qn; const float inv = 1.0f / fmaxf(fabsf(dn), 1.0f);
        if (hi == 0) li[r32] = inv; asm volatile("s_waitcnt lgkmcnt(0)" ::: "memory");
#pragma unroll
        for (int r = 0; r < 16; ++r) { const float rl = li[crow(r, hi)]; const unsigned eo = hso + (unsigned)(((r & 3) + 8 * (r >> 2)) * MW);
#pragma unroll
            for (int d0 = 0; d0 < 4; ++d0) HS[eo + d0 * 32] = o[d0][r] * rl;
            asm volatile("" ::: "memory"); }
    }
    {
        float qn = qn_b;
        o[0] = f32x16{}; o[1] = f32x16{}; o[2] = f32x16{}; o[3] = f32x16{};
        if (!isctx) { pv_d0(o, vbC + 32768, qr[0], qr[1], qr[2], qr[3]); pv_d0(o, vbC + 32768 + 16384, qr[4], qr[5], qr[6], qr[7]);
#pragma unroll
            for (int r = 0; r < 16; ++r) { const float e = A[5 * 256 + wid * 32 + crow(r, hi)];
#pragma unroll
                for (int d0 = 0; d0 < 4; ++d0) o[d0][r] *= e; } }
        const float cq = A[1 * 256 + trow]; float den = 0.f;
        ml_tile<1>(o, den, qr, lds + 16384, vbV + 16384, A + 3 * 256, 3, cq, trow, wq == 3, r32, hi);
        if (wq <= 2) ml_tile<1>(o, den, qr, lds, vbV, A + 3 * 256, 2, cq, trow, wq == 2, r32, hi);
        __syncthreads(); ml_stage_kv(lds, QK, 0, sr, sc8); __syncthreads();
        if (wq <= 1) ml_tile<1>(o, den, qr, lds + 16384, vbV + 16384, A + 3 * 256, 1, cq, trow, wq == 1, r32, hi);
        if (wq <= 0) ml_tile<1>(o, den, qr, lds, vbV, A + 3 * 256, 0, cq, trow, wq == 0, r32, hi);
        { auto rr = __builtin_amdgcn_permlane32_swap(__float_as_uint(den), __float_as_uint(den), false, false); den = __uint_as_float(rr[0]) + __uint_as_float(rr[1]); }
        const float dn = den + __builtin_amdgcn_exp2f(cq) * qn; const float inv = 1.0f / fmaxf(fabsf(dn), 1.0f);
        asm volatile("s_waitcnt vmcnt(0)" ::: "memory");
        if (hi == 0) li[r32] = inv; asm volatile("s_waitcnt lgkmcnt(0)" ::: "memory");
        float mg[4];
#pragma unroll
        for (int d0 = 0; d0 < 4; ++d0) mg[d0] = p.mng[h * MDK + d0 * 32 + r32];
        const bf16* OG = QK + (size_t)(wid * 32) * (4 * MW) + 3 * MW; bf16* UHo = (bf16*)(p.ws + WS_UH) + (size_t)(row0 + wid * 32) * DM + CCH + h * MDK;
#pragma unroll
        for (int r = 0; r < 16; ++r) { const float rl = li[crow(r, hi)]; const int rc = (r & 3) + 8 * (r >> 2); float ss = 0.f;
#pragma unroll
            for (int d0 = 0; d0 < 4; ++d0) { const float hf = __hip_atomic_load(HS + hso + (unsigned)(rc * MW + d0 * 32), __ATOMIC_RELAXED, __HIP_MEMORY_SCOPE_AGENT); const float x = hf + o[d0][r] * rl; o[d0][r] = x; ss += x * x; }
            ss += swz_xor<1>(ss); ss += swz_xor<2>(ss); ss += swz_xor<4>(ss); ss += swz_xor<8>(ss); ss += swz_xor<16>(ss);
            const float rs = 1.0f / sqrtf(ss * (1.0f / MDK) + EPSF);
#pragma unroll
            for (int d0 = 0; d0 < 4; ++d0) UHo[uho + (unsigned)(rc * DM + d0 * 32)] = f2bf(bf2f(OG[ogo + (unsigned)(rc * 4 * MW + d0 * 32)]) * o[d0][r] * rs * mg[d0]);
            asm volatile("" ::: "memory"); }
    }
}
}

template <int DIR> __device__ __forceinline__ void ml_scan_item(const Params& p, int ch, int b, int h, int e8) {
    const float em = expf(p.stm[(size_t)(b * 2 + DIR) * MH + h]); const float* FT = (const float*)(p.ws + WS_FTOT) + (size_t)ch * NBLK;
    float fd[NBLK];
#pragma unroll
    for (int i = 0; i < NBLK; ++i) fd[i] = expf(FT[i]);
    if (e8 < MDK * MDK) { bf16_t* Cs = (bf16_t*)(p.ws + WS_CST) + (size_t)ch * NBLK * MDK * MDK + e8; const float* c0 = p.stC + ((size_t)(b * 2 + DIR) * MH + h) * MDK * MDK + e8;
        v4u d[NBLK];
#pragma unroll
        for (int i = 0; i < NBLK; ++i) d[i] = *(const v4u*)(Cs + (size_t)i * MDK * MDK);
        const f32x4 ca = *(const f32x4*)c0, cb = *(const f32x4*)(c0 + 4); float c[8] = {ca[0] * em, ca[1] * em, ca[2] * em, ca[3] * em, cb[0] * em, cb[1] * em, cb[2] * em, cb[3] * em};
#pragma unroll
        for (int i = 0; i < NBLK; ++i) { const int blk = DIR == 0 ? i : NBLK - 1 - i; v4u o;
#pragma unroll
            for (int w = 0; w < 4; ++w) { const float lo = __uint_as_float(d[blk][w] << 16), hi = __uint_as_float(d[blk][w] & 0xffff0000u); o[w] = pg8::cvt_pk_bf16(c[2 * w], c[2 * w + 1]);
                c[2 * w] = fd[blk] * c[2 * w] + lo; c[2 * w + 1] = fd[blk] * c[2 * w + 1] + hi; }
            *(v4u*)(Cs + (size_t)blk * MDK * MDK) = o; } }
    else { const int d_ = e8 - MDK * MDK; float* Ns = (float*)(p.ws + WS_NST) + (size_t)ch * NBLK * MDK + d_; const float* n0 = p.stn + ((size_t)(b * 2 + DIR) * MH + h) * MDK + d_;
        f32x4 da[NBLK], db[NBLK];
#pragma unroll
        for (int i = 0; i < NBLK; ++i) { da[i] = *(const f32x4*)(Ns + (size_t)i * MDK); db[i] = *(const f32x4*)(Ns + (size_t)i * MDK + 4); }
        f32x4 ca = *(const f32x4*)n0 * em, cb = *(const f32x4*)(n0 + 4) * em;
#pragma unroll
        for (int i = 0; i < NBLK; ++i) { const int blk = DIR == 0 ? i : NBLK - 1 - i;
            *(f32x4*)(Ns + (size_t)blk * MDK) = ca; *(f32x4*)(Ns + (size_t)blk * MDK + 4) = cb; ca = ca * fd[blk] + da[blk]; cb = cb * fd[blk] + db[blk]; } }
}
struct MlScan {
    Params p; static HD_FN long count() { return (long)NLB * MH * 2 * ((MDK * MDK + MDK) / 8); }
    __device__ __forceinline__ void operator()(long idx) const {
        constexpr int per = (MDK * MDK + MDK) / 8; const int e8 = (int)(idx % per) * 8; const int ch = (int)(idx / per); const int dir = ch & 1, h = (ch >> 1) % MH, b = ch / (2 * MH);
        if (dir == 0) ml_scan_item<0>(p, ch, b, h, e8); else ml_scan_item<1>(p, ch, b, h, e8);
    }
};
__device__ __forceinline__ void ml_phase_A(const Params& p, unsigned char* lds, int vcu, int G) {
    constexpr int NUL = NLB * MH * NBLK, NU = NUL + NCB * MH;
    for (int u = vcu; u < NU; u += G) {
        if (u < NUL) att::ml_passA_unit(p, (char*)lds, NCB + u / (MH * NBLK), (u / NBLK) % MH, u % NBLK);
        else att::ml_passA_unit(p, (char*)lds, (u - NUL) / MH, (u - NUL) % MH, 0); }
}
__device__ __forceinline__ void ml_phase_C(const Params& p, unsigned char* lds, int vcu, int G) {
    constexpr int NUL = NLB * MH * NBLK, NU = NUL + NCB * MH;
    for (int u = vcu; u < NU; u += G) {
        if (u < NUL) att::ml_passC_unit(p, (char*)lds, NCB + u / (MH * NBLK), (u / NBLK) % MH, u % NBLK);
        else att::ml_passC_unit(p, (char*)lds, (u - NUL) / MH, (u - NUL) % MH, 0); }
}
typedef float f4 __attribute__((ext_vector_type(4)));
typedef unsigned u4 __attribute__((ext_vector_type(4)));
typedef unsigned u2 __attribute__((ext_vector_type(2)));
__device__ __forceinline__ float wave_sum64(float v) { v += swz_xor<1>(v); v += swz_xor<2>(v); v += swz_xor<4>(v); v += swz_xor<8>(v); v += swz_xor<16>(v); return half_sum(v); }
__device__ __forceinline__ float fsilu(float x) { return x * fsigmoid(x); }

__device__ __forceinline__ void phase_mod(const Params& p, char* lds, int bx, int G) {
    const int tid = tid_opaque(), lane = tid & 63, wave = tid >> 6;
    float* SL = (float*)lds; float* PT = (float*)(lds + 32768);
    constexpr int NCG = 6 * DM / 64, NIT = 2 * NCG;
    if (bx >= NIT) return;
    __syncthreads();
    for (int i = tid; i < NCLS * DM; i += NTHREADS) { const int cls = i / DM, k = i % DM; const float cv = cls == 0 ? p.cctx[k] : p.c[(size_t)(cls - 1) * DM + k]; SL[i] = fsilu(cv); }
    for (int item = bx; item < NIT; item += G) {
        __syncthreads();
        const int l = item / NCG, cg = item % NCG; const float* w = p.wmod + (size_t)l * DM * 6 * DM + cg * 64 + lane;
        float acc[NCLS];
#pragma unroll
        for (int r = 0; r < NCLS; ++r) acc[r] = 0.f;
        const int k0 = wave * (DM / 8);
#pragma unroll 8
        for (int k = k0; k < k0 + DM / 8; ++k) { const float wv = w[(size_t)k * 6 * DM];
#pragma unroll
            for (int r = 0; r < NCLS; ++r) acc[r] += SL[r * DM + k] * wv; }
#pragma unroll
        for (int r = 0; r < NCLS; ++r) PT[(wave * NCLS + r) * 64 + lane] = acc[r];
        __syncthreads();
        if (tid < NCLS * 64) { const int r = tid >> 6; float s = p.bmod[(size_t)l * 6 * DM + cg * 64 + lane];
#pragma unroll
            for (int w8 = 0; w8 < 8; ++w8) s += PT[(w8 * NCLS + r) * 64 + lane];
            ((float*)(p.ws + WS_MOD))[((size_t)(l * NCLS + r) * 6 * DM) + cg * 64 + lane] = s; }
    }
}
__device__ __forceinline__ void sw_job(const Params& p, const bf16_t* Bt, int nrows, int l, int which, float* sw, int N, int mode, int gw, int NGW, int lane) {
    for (int n = gw; n < nrows; n += NGW) {
        const u4 w0 = *(const u4*)(Bt + (size_t)n * DM + lane * 8), w1 = *(const u4*)(Bt + (size_t)n * DM + DM / 2 + lane * 8);
        float wf[16];
#pragma unroll
        for (int i = 0; i < 4; ++i) { wf[2 * i] = __uint_as_float(w0[i] << 16); wf[2 * i + 1] = __uint_as_float(w0[i] & 0xffff0000u); wf[8 + 2 * i] = __uint_as_float(w1[i] << 16); wf[8 + 2 * i + 1] = __uint_as_float(w1[i] & 0xffff0000u); }
        int col = n; if (mode == 1) { const int t = n >> 8, r = n & 255; col = r < 128 ? 128 * t + r : (N / 2) + 128 * t + (r - 128); }
#pragma unroll
        for (int cls = 0; cls < NCLS; ++cls) { const float* sh = modv(p, l, cls, which);
            const f4 a0 = *(const f4*)(sh + lane * 8), a1 = *(const f4*)(sh + lane * 8 + 4), b0 = *(const f4*)(sh + DM / 2 + lane * 8), b1 = *(const f4*)(sh + DM / 2 + lane * 8 + 4);
            float s = (a0[0] * wf[0] + a0[1] * wf[1]) + (a0[2] * wf[2] + a0[3] * wf[3]) + (a1[0] * wf[4] + a1[1] * wf[5]) + (a1[2] * wf[6] + a1[3] * wf[7])
                    + (b0[0] * wf[8] + b0[1] * wf[9]) + (b0[2] * wf[10] + b0[3] * wf[11]) + (b1[0] * wf[12] + b1[1] * wf[13]) + (b1[2] * wf[14] + b1[3] * wf[15]);
            s = wave_sum64(s); if (lane == 0) sw[(size_t)cls * N + col] = s; }
    }
}
static_assert(DM == 1024, "sw_job / norm passes assume 1024 = 64 lanes x 16");
__device__ __forceinline__ void phase_norm0(const Params& p, char* lds, int bx, int G) {
    const int tid = tid_opaque(), lane = tid & 63, wave = tid >> 6;
    float* WG = (float*)lds;
    __syncthreads();
    for (int i = tid; i < NGATE * DM; i += NTHREADS) { const int k = i / NGATE, g = i % NGATE; WG[g * DM + k] = p.winab[(size_t)k * ABIN + ABMAIN + g]; }
    __syncthreads();
    const int gw = bx * NWAVES + wave, NGW = G * NWAVES;
    f4 nx[4];
    if (gw < MTOK) { const f4* xr = (const f4*)xrow(p, gw) + lane;
#pragma unroll
        for (int j = 0; j < 4; ++j) nx[j] = xr[64 * j]; }
    for (int row = gw; row < MTOK; row += NGW) {
        const int cls = cls_of(row);
        const f4* g4 = (const f4*)p.n1g + lane; const f4* sc4 = (const f4*)modv(p, 0, cls, 1) + lane; const f4* sh4 = (const f4*)modv(p, 0, cls, 0) + lane;
        f4 v[4]; float s = 0.f;
#pragma unroll
        for (int j = 0; j < 4; ++j) { v[j] = nx[j]; s += (v[j][0] * v[j][0] + v[j][1] * v[j][1]) + (v[j][2] * v[j][2] + v[j][3] * v[j][3]); }
        if (row + NGW < MTOK) { const f4* xr = (const f4*)xrow(p, row + NGW) + lane;
#pragma unroll
            for (int j = 0; j < 4; ++j) nx[j] = xr[64 * j]; }
        const float rs = 1.0f / sqrtf(wave_sum64(s) * (1.0f / DM) + EPSF);
        bf16_t* xo = (bf16_t*)(p.ws + WS_XN) + (size_t)row * DM + lane * 4;
#pragma unroll
        for (int j = 0; j < 4; ++j) { const f4 gg = g4[64 * j], sc = sc4[64 * j], sh = sh4[64 * j]; v[j] = v[j] * rs * gg * (sc + 1.0f) + sh;
            u2 w; w.x = pg8::cvt_pk_bf16(v[j][0], v[j][1]); w.y = pg8::cvt_pk_bf16(v[j][2], v[j][3]); *(u2*)(xo + 256 * j) = w; }
        float mine = 0.f;
#pragma unroll
        for (int g = 0; g < NGATE; ++g) { float a = 0.f;
#pragma unroll
            for (int j = 0; j < 4; ++j) { const f4 w = *(const f4*)(WG + g * DM + 256 * j + lane * 4); a += (v[j][0] * w[0] + v[j][1] * w[1]) + (v[j][2] * w[2] + v[j][3] * w[3]); }
            a = wave_sum64(a); if (lane == g) mine = a; }
        if (lane < NGATE) { float a = mine + p.bgate[lane]; if ((lane & 7) >= 4) a = logsigmoidf_(a); ((float*)(p.ws + WS_GATES))[(size_t)row * NGATE + lane] = a; }
    }
}
__device__ __forceinline__ void phase_conv(const Params& p, char* lds, int vcu, int G) {
    const int tid = tid_opaque(), lane = tid & 63, wave = tid >> 6; constexpr int TT = 32, NR = TT + CWID - 1;
    bf16_t* X = (bf16_t*)lds; float* OUT = (float*)(lds + 65536);
    const int cp = tid & 255, tg = tid >> 8, c0 = 2 * cp;
    float w0[CWID], w1[CWID];
#pragma unroll
    for (int j = 0; j < CWID; ++j) { w0[j] = p.convw[(size_t)j * CCH + c0]; w1[j] = p.convw[(size_t)j * CCH + c0 + 1]; }
    const float b0 = p.convb[c0], b1 = p.convb[c0 + 1];
    const bf16_t* U = (const bf16_t*)(p.ws + WS_UPRE);
    for (int u = vcu; u < MTOK / TT; u += G) {
        const int row0 = u * TT, pos0 = pos_of(row0), len = seqlen_of(row0);
        __syncthreads();
        { u4 val[8];
#pragma unroll
          for (int i = 0; i < 8; ++i) { const int c = tid + NTHREADS * i, r = c / (CCH / 8), ch = (c % (CCH / 8)) * 8; const int t = pos0 + r - CWID / 2;
              val[i] = (u4){0u, 0u, 0u, 0u}; if (c < NR * (CCH / 8) && t >= 0 && t < len) val[i] = *(const u4*)(U + (size_t)(row0 + r - CWID / 2) * CCH + ch); }
#pragma unroll
          for (int i = 0; i < 8; ++i) { const int c = tid + NTHREADS * i, r = c / (CCH / 8), ch = (c % (CCH / 8)) * 8; if (c < NR * (CCH / 8)) *(u4*)(X + (size_t)r * CCH + ch) = val[i]; } }
        __syncthreads();
#pragma unroll 2
        for (int tt = 0; tt < TT / 2; ++tt) { const int t = tg * (TT / 2) + tt; float a0 = b0, a1 = b1;
#pragma unroll
            for (int j = 0; j < CWID; ++j) { const unsigned xx = *(const unsigned*)(X + (size_t)(t + j) * CCH + c0); a0 += w0[j] * __uint_as_float(xx << 16); a1 += w1[j] * __uint_as_float(xx & 0xffff0000u); }
            *(float2*)(OUT + (size_t)t * CCH + c0) = make_float2(a0, a1); }
        __syncthreads();
#pragma unroll
        for (int q = 0; q < TT / NWAVES; ++q) { const int t = wave * (TT / NWAVES) + q; const f4 x0 = *(const f4*)(OUT + (size_t)t * CCH + lane * 8), x1 = *(const f4*)(OUT + (size_t)t * CCH + lane * 8 + 4);
            const float mu = wave_sum64((x0[0] + x0[1]) + (x0[2] + x0[3]) + (x1[0] + x1[1]) + (x1[2] + x1[3])) * (1.0f / CCH);
            const f4 d0 = x0 - mu, d1 = x1 - mu;
            const float var = wave_sum64((d0[0] * d0[0] + d0[1] * d0[1]) + (d0[2] * d0[2] + d0[3] * d0[3]) + (d1[0] * d1[0] + d1[1] * d1[1]) + (d1[2] * d1[2] + d1[3] * d1[3])) * (1.0f / CCH);
            const float rs = 1.0f / sqrtf(var + EPSF);
            const f4 g0 = *(const f4*)(p.lng + lane * 8), g1 = *(const f4*)(p.lng + lane * 8 + 4), be0 = *(const f4*)(p.lnb + lane * 8), be1 = *(const f4*)(p.lnb + lane * 8 + 4);
            const f4 y0 = d0 * rs * g0 + be0, y1 = d1 * rs * g1 + be1; u4 w;
            w.x = pg8::cvt_pk_bf16(fsilu(y0[0]), fsilu(y0[1])); w.y = pg8::cvt_pk_bf16(fsilu(y0[2]), fsilu(y0[3])); w.z = pg8::cvt_pk_bf16(fsilu(y1[0]), fsilu(y1[1])); w.w = pg8::cvt_pk_bf16(fsilu(y1[2]), fsilu(y1[3]));
            *(u4*)((bf16_t*)(p.ws + WS_UH) + (size_t)(row0 + t) * DM + lane * 8) = w; }
    }
}
static_assert(CCH == 512 && CSEQ % 32 == 0 && LSEQ % 32 == 0, "conv phase geometry");
__device__ __forceinline__ void phase_cachecvt(const Params& p, int gtid, int gthreads) {
    constexpr int PER = PAST * NKV * HDIM / 8;
    for (int i = gtid; i < NLB * PER; i += gthreads) { const int b = i / PER, e = (i % PER) * 8; const size_t src = (size_t)b * PAST * NKV * HDIM + e, dst = ((size_t)b * SKVL + LSEQ) * NKV * HDIM + e;
        const f4 k0 = *(const f4*)(p.ck + src), k1 = *(const f4*)(p.ck + src + 4), v0 = *(const f4*)(p.cv + src), v1 = *(const f4*)(p.cv + src + 4); u4 wk, wv;
        wk.x = pg8::cvt_pk_bf16(k0[0], k0[1]); wk.y = pg8::cvt_pk_bf16(k0[2], k0[3]); wk.z = pg8::cvt_pk_bf16(k1[0], k1[1]); wk.w = pg8::cvt_pk_bf16(k1[2], k1[3]);
        wv.x = pg8::cvt_pk_bf16(v0[0], v0[1]); wv.y = pg8::cvt_pk_bf16(v0[2], v0[3]); wv.z = pg8::cvt_pk_bf16(v1[0], v1[1]); wv.w = pg8::cvt_pk_bf16(v1[2], v1[3]);
        *(u4*)((bf16_t*)(p.ws + WS_LATK) + dst) = wk; *(u4*)((bf16_t*)(p.ws + WS_LATV) + dst) = wv; }
}
__device__ __forceinline__ void phase_qkpost(const Params& p, int gw, int NGW, int lane) {
    const int hh = lane >> 5, l5 = lane & 31, half = l5 >> 4, f0 = (l5 & 15) * 2, d1 = half * 64 + f0, d2 = d1 + 32;
    const float inv0 = __builtin_amdgcn_exp2f(-(float)f0 * (13.287712379549449f / 32.0f)), inv1 = __builtin_amdgcn_exp2f(-(float)(f0 + 1) * (13.287712379549449f / 32.0f));
    const float qg[4] = {p.qng[d1], p.qng[d1 + 1], p.qng[d2], p.qng[d2 + 1]}, kg[4] = {p.kng[d1], p.kng[d1 + 1], p.kng[d2], p.kng[d2 + 1]};
    for (int row = gw; row < MTOK; row += NGW) {
        const bool lat = row >= MC; const int sp = pos_of(row); float cs0 = 1.f, sn0 = 0.f, cs1 = 1.f, sn1 = 0.f;
        if (lat) { const float pos = (float)(half == 0 ? sp / GRIDW : sp % GRIDW); cs0 = __cosf(pos * inv0); sn0 = __sinf(pos * inv0); cs1 = __cosf(pos * inv1); sn1 = __sinf(pos * inv1); }
        bf16_t* Q = (bf16_t*)(p.ws + WS_QRAW) + (size_t)row * NQ * HDIM; const bf16_t* KR = (const bf16_t*)(p.ws + WS_KRAW) + (size_t)row * NKV * HDIM;
        unsigned ra[NQ / 2 + 1], rb[NQ / 2 + 1];
#pragma unroll
        for (int it = 0; it <= NQ / 2; ++it) { const bf16_t* src = it < NQ / 2 ? Q + (2 * it + hh) * HDIM : KR + hh * HDIM; ra[it] = *(const unsigned*)(src + d1); rb[it] = *(const unsigned*)(src + d2); }
#pragma unroll
        for (int it = 0; it <= NQ / 2; ++it) { const bool isq = it < NQ / 2;
            const float x1a = __uint_as_float(ra[it] << 16), x1b = __uint_as_float(ra[it] & 0xffff0000u), x2a = __uint_as_float(rb[it] << 16), x2b = __uint_as_float(rb[it] & 0xffff0000u);
            float ss = (x1a * x1a + x1b * x1b) + (x2a * x2a + x2b * x2b); ss += swz_xor<1>(ss); ss += swz_xor<2>(ss); ss += swz_xor<4>(ss); ss += swz_xor<8>(ss); ss += swz_xor<16>(ss);
            const float rs = 1.0f / sqrtf(ss * (1.0f / HDIM) + EPSF); const float* g = isq ? qg : kg;
            const float a0 = x1a * rs * g[0], a1 = x1b * rs * g[1], b0 = x2a * rs * g[2], b1 = x2b * rs * g[3];
            const float y1a = a0 * cs0 - b0 * sn0, y2a = a0 * sn0 + b0 * cs0, y1b = a1 * cs1 - b1 * sn1, y2b = a1 * sn1 + b1 * cs1;
            const unsigned w1 = pg8::cvt_pk_bf16(y1a, y1b), w2 = pg8::cvt_pk_bf16(y2a, y2b);
            if (isq) { bf16_t* dst = Q + (2 * it + hh) * HDIM; *(unsigned*)(dst + d1) = w1; *(unsigned*)(dst + d2) = w2; }
            else if (!lat) { bf16_t* K = (bf16_t*)(p.ws + WS_CTXK) + (size_t)row * NKV * HDIM + hh * HDIM; *(unsigned*)(K + d1) = w1; *(unsigned*)(K + d2) = w2;
                float* fo = p.out + O_K + (size_t)row * NKV * HDIM + hh * HDIM; *(float2*)(fo + d1) = make_float2(y1a, y1b); *(float2*)(fo + d2) = make_float2(y2a, y2b); }
            else { const int b_ = (row - MC) / LSEQ, s_ = (row - MC) % LSEQ; bf16_t* K = (bf16_t*)(p.ws + WS_LATK) + ((size_t)b_ * SKVL + s_) * NKV * HDIM + hh * HDIM; *(unsigned*)(K + d1) = w1; *(unsigned*)(K + d2) = w2; } }
    }
}
static_assert(NKV == 2 && NQ % 2 == 0 && HDIM == 128, "qkpost lane mapping");
__device__ __forceinline__ void phase_final(const Params& p, int gw, int NGW, int lane) {
    const f4* g4 = (const f4*)p.fng + lane;
    f4 g[4];
#pragma unroll
    for (int j = 0; j < 4; ++j) g[j] = g4[64 * j];
    for (int row = gw; row < MTOK; row += 2 * NGW) { const int row2 = row + NGW; const bool has2 = row2 < MTOK; const int r2 = has2 ? row2 : row;
        const float* sq = (const float*)(p.ws + WS_SSQ) + (size_t)3 * SSQ_STRIDE; const float rsa = 1.0f / sqrtf(sq[row] * (1.0f / DM) + EPSF), rsb = 1.0f / sqrtf(sq[r2] * (1.0f / DM) + EPSF);
        f4* ya = (f4*)(p.out + O_Y + (size_t)row * DM) + lane; f4* yb = (f4*)(p.out + O_Y + (size_t)r2 * DM) + lane; f4 va[4], vb[4];
#pragma unroll
        for (int j = 0; j < 4; ++j) { va[j] = ya[64 * j]; vb[j] = yb[64 * j]; }
#pragma unroll
        for (int j = 0; j < 4; ++j) { ya[64 * j] = va[j] * rsa * g[j]; if (has2) yb[64 * j] = vb[j] * rsb * g[j]; } }
}
template <class Epi> __device__ __forceinline__ void gemm_call(LAS unsigned char* lds, const bf16_t* A, const bf16_t* Bt, int N, int K, const Epi& E) {
    pg8::Gemm g{A, Bt, MTOK, N, K}; pg8::StaticOrder S; S.init(MTOK, N, (int)gridDim.x, (int)blockIdx.x);
    pg8::gemm_phase<Epi, pg8::StaticOrder, true, true>((PG8_LAS unsigned char*)lds, g, S, E);
}
__global__ void __launch_bounds__(NTHREADS, 2) mega_fwd(Params p) {
    extern __shared__ __attribute__((aligned(16))) unsigned char lds[];
    LAS unsigned char* L = (LAS unsigned char*)lds;
    for (int u = threadIdx.x; u < (LDS_BYTES - LDSCTL_OFF) / 4; u += NTHREADS) ((LAS unsigned*)(L + LDSCTL_OFF))[u] = 0u;
    __syncthreads();
    volatile LAS unsigned* MISC = (volatile LAS unsigned*)(L + MISC_OFF);
    const XcdBarrier bar = xcd_barrier_post((unsigned*)(p.ws + WS_CTL) + CW_BAR, MISC + 8);
    const int G = gridDim.x, bx = blockIdx.x; const int vcu = (G % 8 == 0) ? (bx % 8) * (G / 8) + bx / 8 : bx;
    unsigned char* ws = p.ws;
    const bf16_t* XN = (const bf16_t*)(ws + WS_XN); const bf16_t* UH = (const bf16_t*)(ws + WS_UH); const bf16_t* Hh = (const bf16_t*)(ws + WS_H); const bf16_t* Ob = (const bf16_t*)(ws + WS_O);
    float* SW0 = (float*)(ws + WS_SW); float* SWC = SW0 + (size_t)NCLS * 2 * DFF; float* SW1 = SWC + (size_t)NCLS * CIN;
    float* SSQ = (float*)(ws + WS_SSQ); float* Y = p.out + O_Y;
#define WAVE_IDS() const int tid_ = tid_opaque(); const int lane_ = tid_ & 63; const int gw_ = bx * NWAVES + (tid_ >> 6); const int NGW_ = G * NWAVES
    p0_weights(p, L, vcu, G); phase_mod(p, (char*)lds, bx, G);
    xcd_barrier(bar);
    phase_norm0(p, (char*)lds, bx, G);
    { WAVE_IDS(); sw_job(p, (const bf16_t*)(ws + WB_FFI0), 2 * DFF, 0, 3, SW0, 2 * DFF, 1, gw_, NGW_, lane_); sw_job(p, (const bf16_t*)(ws + WB_INC), CIN, 1, 0, SWC, CIN, 0, gw_, NGW_, lane_);
      sw_job(p, (const bf16_t*)(ws + WB_FFI1), 2 * DFF, 1, 3, SW1, 2 * DFF, 1, gw_, NGW_, lane_); }
    xcd_barrier(bar);
    gemm_call(L, XN, (const bf16_t*)(ws + WB_AB), ABMAIN, DM, EpiAB{(bf16_t*)(ws + WS_UPRE), (bf16_t*)(ws + WS_QKVO)}); xcd_barrier(bar);
    ml_phase_A(p, lds, vcu, G); phase_conv(p, (char*)lds, vcu, G); xcd_barrier(bar);
    { WAVE_IDS(); MlScan sc{p}; for (long i = bx * (long)NTHREADS + tid_; i < MlScan::count(); i += (long)G * NTHREADS) sc(i); } xcd_barrier(bar);
    ml_phase_C(p, lds, vcu, G); xcd_barrier(bar);
    gemm_call(L, UH, (const bf16_t*)(ws + WB_OUTAB), DM, DM, EpiRes{p.xp, p.xs, Y, (bf16_t*)(ws + WS_XN), SSQ + 0 * SSQ_STRIDE, modv(p, 0, 0, 2), modv(p, 0, 0, 4), p.n2g, 1, 0}); xcd_barrier(bar);
    gemm_call(L, XN, (const bf16_t*)(ws + WB_FFI0), 2 * DFF, DM, EpiFfnIn{(bf16_t*)(ws + WS_H), SSQ + 0 * SSQ_STRIDE, SW0}); xcd_barrier(bar);
    gemm_call(L, Hh, (const bf16_t*)(ws + WB_FFO0), DM, DFF, EpiRes{p.xp, p.xs, Y, (bf16_t*)(ws + WS_XN), SSQ + 1 * SSQ_STRIDE, modv(p, 0, 0, 5), modv(p, 1, 0, 1), p.n1g + DM, 0, 0}); xcd_barrier(bar);
    gemm_call(L, XN, (const bf16_t*)(ws + WB_INC), CIN, DM, EpiQkv{(bf16_t*)(ws + WS_QRAW), (bf16_t*)(ws + WS_KRAW), (bf16_t*)(ws + WS_CTXV), (bf16_t*)(ws + WS_LATV), p.out + O_V, SSQ + 1 * SSQ_STRIDE, SWC}); xcd_barrier(bar);
    { WAVE_IDS(); phase_qkpost(p, gw_, NGW_, lane_); phase_cachecvt(p, bx * NTHREADS + tid_, G * NTHREADS); } xcd_barrier(bar);
    attn_phase(p, lds, vcu, G); xcd_barrier(bar);
    gemm_call(L, Ob, (const bf16_t*)(ws + WB_OUTC), DM, DM, EpiRes{p.xp, p.xs, Y, (bf16_t*)(ws + WS_XN), SSQ + 2 * SSQ_STRIDE, modv(p, 1, 0, 2), modv(p, 1, 0, 4), p.n2g + DM, 0, 0}); xcd_barrier(bar);
    gemm_call(L, XN, (const bf16_t*)(ws + WB_FFI1), 2 * DFF, DM, EpiFfnIn{(bf16_t*)(ws + WS_H), SSQ + 2 * SSQ_STRIDE, SW1}); xcd_barrier(bar);
    gemm_call(L, Hh, (const bf16_t*)(ws + WB_FFO1), DM, DFF, EpiRes{p.xp, p.xs, Y, (bf16_t*)(ws + WS_XN), SSQ + 3 * SSQ_STRIDE, modv(p, 1, 0, 5), modv(p, 1, 0, 1), nullptr, 0, 0}); xcd_barrier(bar);
    { WAVE_IDS(); phase_final(p, gw_, NGW_, lane_); }
#undef WAVE_IDS
}
static Params make_params(void* const* d_in, void* d_out, void* d_ws) {
    Params p{}; const float** pp = (const float**)&p; for (int i = 0; i < 28; ++i) pp[i] = (const float*)d_in[i];
    p.out = (float*)d_out; p.ws = (unsigned char*)d_ws; return p;
}
extern "C" void kernel_launch(void* const* d_in, const int* in_sizes, int n_in, void* d_out, int out_size, void* d_ws, size_t ws_size, hipStream_t stream) {
    static int grid = 0;
    if (grid == 0) {
        if (n_in != 28 || (size_t)out_size != O_END || ws_size < WS_END || in_sizes[0] != MC * DM || in_sizes[1] != ML * DM) {
            fprintf(stderr, "kernel_launch: shape mismatch n_in %d out %d (want %zu) ws %zu (want %zu)\n", n_in, out_size, (size_t)O_END, ws_size, (size_t)WS_END); grid = -1; return; }
        int dev = 0, cus = 0;
        if (hipGetDevice(&dev) != hipSuccess || hipDeviceGetAttribute(&cus, hipDeviceAttributeMultiprocessorCount, dev) != hipSuccess) { grid = -1; return; }
        if (hipFuncSetAttribute((const void*)mega_fwd, hipFuncAttributeMaxDynamicSharedMemorySize, LDS_BYTES) != hipSuccess) { fprintf(stderr, "hipFuncSetAttribute failed\n"); grid = -1; return; }
        int per_cu = 0; (void)hipOccupancyMaxActiveBlocksPerMultiprocessor(&per_cu, (const void*)mega_fwd, NTHREADS, LDS_BYTES); (void)hipGetLastError();
        if (per_cu < 1) fprintf(stderr, "kernel_launch: occupancy query says %d blocks/CU\n", per_cu);
        grid = cus;
    }
    if (grid < 0) return;
    hipMemsetAsync((char*)d_ws + WS_CTL, 0, CTL_ZERO_BYTES, stream);
    Params p = make_params(d_in, d_out, d_ws);
    hipLaunchKernelGGL(mega_fwd, dim3(grid), dim3(NTHREADS), LDS_BYTES, stream, p);
}
```

```cpp
#ifdef HOST_TEST
#include <cmath>
#include <cstdio>
#include <cstdlib>
#include <cstring>
#include <cstdint>
#include <vector>
#define HD_FN inline
#define DEV_FN inline
#else
#include <hip/hip_runtime.h>
#include <cstdio>
#include <cstdint>
#define HD_FN __host__ __device__ __forceinline__
#define DEV_FN __device__ __forceinline__
#endif

#ifdef TINY
constexpr int DM = 512, NCB = 2, CSEQ = 128, NLB = 2, LSEQ = 128, PAST = 128;
#else
constexpr int DM = 1024, NCB = 16, CSEQ = 256, NLB = 4, LSEQ = 4096, PAST = 256;
#endif
constexpr int GRIDW = 64, CCH = DM / 2, CWID = 31, MH = 4, MDK = CCH / MH, MW = CCH, NGATE = 16;
constexpr int ABIN = 2 * CCH + 4 * MW + NGATE, ABMAIN = 2 * CCH + 4 * MW;
constexpr int HDIM = 128, NQ = DM / HDIM, NKV = 2, GRP = NQ / NKV, CIN = (NQ + 2 * NKV) * HDIM;
constexpr int DFF = ((8 * DM + 3 * 256 - 1) / (3 * 256)) * 256;
constexpr int MC = NCB * CSEQ, ML = NLB * LSEQ, MTOK = MC + ML, NCLS = 1 + NLB, SKVL = LSEQ + PAST;
constexpr float EPSF = 1e-6f;
constexpr int NSEQ = NCB + NLB;

constexpr size_t O_Y = 0, O_C = (size_t)MTOK * DM, O_N = O_C + (size_t)NCB * 2 * MH * MDK * MDK, O_M = O_N + (size_t)NCB * 2 * MH * MDK,
                 O_K = O_M + (size_t)NCB * 2 * MH, O_V = O_K + (size_t)NCB * CSEQ * NKV * HDIM, O_END = O_V + (size_t)NCB * CSEQ * NKV * HDIM;

constexpr size_t MiB = 1u << 20;
#ifdef TINY
constexpr size_t WSCALE = 1;
#endif
constexpr size_t WS_CTL = 0, CTL_ZERO_BYTES = 1 * MiB;
constexpr size_t WS_MOD = 1 * MiB;
constexpr size_t WS_SW = WS_MOD + 256 * 1024;
constexpr size_t WS_SSQ = 512 * 1024;
constexpr int SSQ_STRIDE = 32768;
constexpr size_t WS_DEN = 232 * MiB;
constexpr size_t WS_WB = 2 * MiB;
constexpr size_t WS_XN = 50 * MiB;
constexpr size_t WS_UPRE = 90 * MiB;
constexpr size_t WS_QKVO = 110 * MiB;
constexpr size_t WS_UH = 190 * MiB;
constexpr size_t WS_GATES = 230 * MiB;
constexpr size_t WS_HS = 50 * MiB;
constexpr size_t WS_H = 110 * MiB;
constexpr size_t WS_QRAW = 110 * MiB;
constexpr size_t WS_LATK = 150 * MiB, WS_LATV = 159 * MiB, WS_CTXK = 168 * MiB, WS_CTXV = 170 * MiB;
constexpr size_t WS_KRAW = 172 * MiB;
constexpr size_t WS_O = 190 * MiB;
constexpr size_t WS_END = 256 * MiB;

typedef unsigned short bf16_t;
HD_FN float bf2f(bf16_t h) { unsigned u = (unsigned)h << 16; return __builtin_bit_cast(float, u); }
HD_FN bf16_t f2bf(float f) { unsigned u = __builtin_bit_cast(unsigned, f); return (bf16_t)((u + 0x7fffu + ((u >> 16) & 1u)) >> 16); }
HD_FN float rbf(float f) { return bf2f(f2bf(f)); }
HD_FN float sigmoidf_(float x) { return 1.0f / (1.0f + expf(-x)); }
HD_FN float siluf_(float x) { return x * sigmoidf_(x); }
HD_FN float logsigmoidf_(float x) { return x >= 0.f ? -log1pf(expf(-x)) : x - log1pf(expf(x)); }
HD_FN int cls_of(int row) { return row < MC ? 0 : 1 + (row - MC) / LSEQ; }
HD_FN int seqlen_of(int row) { return row < MC ? CSEQ : LSEQ; }
HD_FN int pos_of(int row) { return row < MC ? row % CSEQ : (row - MC) % LSEQ; }

struct Params {
    const float *xp, *xs, *c, *stC, *stn, *stm, *ck, *cv, *cctx, *wmod, *bmod, *n1g, *n2g, *winab, *bgate, *convw, *convb, *lng, *lnb, *mng,
        *woutab, *winc, *qng, *kng, *woutc, *wffi, *wffo, *fng;
    float* out; unsigned char* ws;
};
HD_FN const float* xrow(const Params& p, int row) { return row < MC ? p.xp + (size_t)row * DM : p.xs + (size_t)(row - MC) * DM; }
HD_FN const float* modv(const Params& p, int l, int cls, int which) { return (const float*)(p.ws + WS_MOD) + ((size_t)(l * NCLS + cls) * 6 + which) * DM; }
constexpr size_t WS_RS0 = 233 * MiB;

struct NMod {
    Params p; static HD_FN long count() { return 2L * NCLS * 6 * DM; }
    HD_FN void operator()(long idx) const {
        const int col = (int)(idx % (6 * DM)); const int cls = (int)((idx / (6 * DM)) % NCLS); const int l = (int)(idx / (6 * DM * NCLS));
        const float* cond = cls == 0 ? p.cctx : p.c + (size_t)(cls - 1) * DM;
        const float* w = p.wmod + (size_t)l * DM * 6 * DM;
        float acc = 0.f;
        for (int k = 0; k < DM; ++k) acc += siluf_(cond[k]) * w[(size_t)k * 6 * DM + col];
        ((float*)(p.ws + WS_MOD))[idx] = acc + p.bmod[(size_t)l * 6 * DM + col];
    }
};
struct NNorm0a {
    Params p; static HD_FN long count() { return MTOK; }
    HD_FN void operator()(long row) const {
        const float* x = xrow(p, (int)row); float s = 0.f;
        for (int k = 0; k < DM; ++k) s += x[k] * x[k];
        ((float*)(p.ws + WS_RS0))[row] = 1.0f / sqrtf(s / DM + EPSF);
    }
};
struct NNorm0b {
    Params p; static HD_FN long count() { return (long)MTOK * DM; }
    HD_FN void operator()(long idx) const {
        const int row = (int)(idx / DM), col = (int)(idx % DM), cls = cls_of(row);
        const float rs = ((const float*)(p.ws + WS_RS0))[row];
        const float v = xrow(p, row)[col] * rs * p.n1g[col] * (1.f + modv(p, 0, cls, 1)[col]) + modv(p, 0, cls, 0)[col];
        ((bf16_t*)(p.ws + WS_XN))[idx] = f2bf(v);
    }
};
struct NGates {
    Params p; static HD_FN long count() { return (long)MTOK * NGATE; }
    HD_FN void operator()(long idx) const {
        const int row = (int)(idx / NGATE), j = (int)(idx % NGATE), cls = cls_of(row);
        const float rs = ((const float*)(p.ws + WS_RS0))[row]; const float* x = xrow(p, row);
        const float* sc = modv(p, 0, cls, 1); const float* sh = modv(p, 0, cls, 0);
        float acc = 0.f;
        for (int k = 0; k < DM; ++k) { const float h = x[k] * rs * p.n1g[k] * (1.f + sc[k]) + sh[k]; acc += h * p.winab[(size_t)k * ABIN + ABMAIN + j]; }
        acc += p.bgate[j];
        if ((j & 7) >= 4) acc = logsigmoidf_(acc);
        ((float*)(p.ws + WS_GATES))[idx] = acc;
    }
};

template <bool DUAL, class Epi> struct NGemm {
    const bf16_t* A; const float* B; int lda, ldb, K, N, off2, pad_; Epi epi;
    HD_FN long count() const { return (long)(MTOK / 4) * (N / 4); }
    HD_FN void operator()(long idx) const {
        const int nt = (int)(idx % (N / 4)), mt = (int)(idx / (N / 4)); const int m0 = mt * 4, n0 = nt * 4;
        float acc[4][4], acc2[4][4];
#pragma unroll
        for (int i = 0; i < 4; ++i)
#pragma unroll
            for (int j = 0; j < 4; ++j) { acc[i][j] = 0.f; acc2[i][j] = 0.f; }
        for (int k0 = 0; k0 < K; k0 += 8) {
            float a[4][8];
#pragma unroll
            for (int i = 0; i < 4; ++i) {
                const bf16_t* ap = A + (size_t)(m0 + i) * lda + k0;
#pragma unroll
                for (int kk = 0; kk < 8; ++kk) a[i][kk] = bf2f(ap[kk]);
            }
#pragma unroll
            for (int kk = 0; kk < 8; ++kk) {
                const float* bp = B + (size_t)(k0 + kk) * ldb + n0;
                float b[4], b2[4];
#pragma unroll
                for (int j = 0; j < 4; ++j) { b[j] = rbf(bp[j]); b2[j] = DUAL ? rbf(bp[off2 + j]) : 0.f; }
#pragma unroll
                for (int i = 0; i < 4; ++i)
#pragma unroll
                    for (int j = 0; j < 4; ++j) { acc[i][j] += a[i][kk] * b[j]; if (DUAL) acc2[i][j] += a[i][kk] * b2[j]; }
            }
        }
#pragma unroll
        for (int i = 0; i < 4; ++i)
#pragma unroll
            for (int j = 0; j < 4; ++j) epi(m0 + i, n0 + j, acc[i][j], acc2[i][j]);
    }
};
struct EGlu { Params p; HD_FN void operator()(int row, int col, float v, float v2) const { ((bf16_t*)(p.ws + WS_UPRE))[(size_t)row * CCH + col] = f2bf(v * sigmoidf_(v2)); } };
struct EQkvo { Params p; HD_FN void operator()(int row, int col, float v, float) const {
        const int part = col / MW; if (part == 1) v *= 1.0f / sqrtf((float)MDK); if (part == 3) v = sigmoidf_(v);
        ((bf16_t*)(p.ws + WS_QKVO))[(size_t)row * 4 * MW + col] = f2bf(v); } };
struct EOut { Params p; int l; int pad_ = 0; HD_FN void operator()(int row, int col, float v, float) const {
        const int cls = cls_of(row); float* Y = p.out + O_Y + (size_t)row * DM + col;
        const float xin = l == 0 ? xrow(p, row)[col] : *Y;
        const float x1 = xin + modv(p, l, cls, 2)[col] * v; *Y = x1;
        ((bf16_t*)(p.ws + WS_XN))[(size_t)row * DM + col] = f2bf(x1 * p.n2g[(size_t)l * DM + col] * (1.f + modv(p, l, cls, 4)[col])); } };
struct EFfnIn { Params p; const float* sw; int slot; int pad_ = 0; HD_FN void operator()(int row, int col, float v, float v2) const {
        const int cls = cls_of(row); const float rs = 1.0f / sqrtf(((const float*)(p.ws + WS_SSQ))[(size_t)slot * SSQ_STRIDE + row] / DM + EPSF);
        const float a = v * rs + sw[(size_t)cls * 2 * DFF + col], b = v2 * rs + sw[(size_t)cls * 2 * DFF + DFF + col];
        ((bf16_t*)(p.ws + WS_H))[(size_t)row * DFF + col] = f2bf(siluf_(a) * b); } };
struct EFfnOut { Params p; int l; int pad_ = 0; HD_FN void operator()(int row, int col, float v, float) const {
        const int cls = cls_of(row); float* Y = p.out + O_Y + (size_t)row * DM + col;
        const float x2 = *Y + modv(p, l, cls, 5)[col] * v; *Y = x2;
        if (l == 0) ((bf16_t*)(p.ws + WS_XN))[(size_t)row * DM + col] = f2bf(x2 * p.n1g[(size_t)DM + col] * (1.f + modv(p, 1, cls, 1)[col])); } };
struct EQkv { Params p; const float* sw; int slot; int pad_ = 0; HD_FN void operator()(int row, int col, float v, float) const {
        const int cls = cls_of(row); const float rs = 1.0f / sqrtf(((const float*)(p.ws + WS_SSQ))[(size_t)slot * SSQ_STRIDE + row] / DM + EPSF);
        const float a = v * rs + sw[(size_t)cls * CIN + col];
        if (col < NQ * HDIM) ((bf16_t*)(p.ws + WS_QRAW))[(size_t)row * NQ * HDIM + col] = f2bf(a);
        else if (col < (NQ + NKV) * HDIM) ((bf16_t*)(p.ws + WS_KRAW))[(size_t)row * NKV * HDIM + (col - NQ * HDIM)] = f2bf(a);
        else { const int c2 = col - (NQ + NKV) * HDIM;
            if (row < MC) { ((bf16_t*)(p.ws + WS_CTXV))[(size_t)row * NKV * HDIM + c2] = f2bf(a); p.out[O_V + (size_t)row * NKV * HDIM + c2] = a; }
            else { const int b = (row - MC) / LSEQ, s = (row - MC) % LSEQ; ((bf16_t*)(p.ws + WS_LATV))[((size_t)b * SKVL + s) * NKV * HDIM + c2] = f2bf(a); } } } };

struct NSsq {
    Params p; int slot; int pad_ = 0; static HD_FN long count() { return MTOK; }
    HD_FN void operator()(long row) const { const float* y = p.out + O_Y + (size_t)row * DM; float s = 0.f; for (int k = 0; k < DM; ++k) s += y[k] * y[k];
        ((float*)(p.ws + WS_SSQ))[(size_t)slot * SSQ_STRIDE + row] = s; }
};
struct NSW {
    Params p; const float* W; float* sw; int l, which, N, pad_; HD_FN long count() const { return (long)NCLS * N; }
    HD_FN void operator()(long idx) const { const int n = (int)(idx % N), cls = (int)(idx / N); const float* sh = modv(p, l, cls, which); float acc = 0.f;
        for (int k = 0; k < DM; ++k) acc += sh[k] * rbf(W[(size_t)k * N + n]); sw[idx] = acc; }
};
struct NConv {
    Params p; static HD_FN long count() { return (long)MTOK * CCH; }
    HD_FN void operator()(long idx) const {
        const int row = (int)(idx / CCH), c = (int)(idx % CCH), pos = pos_of(row), len = seqlen_of(row);
        const bf16_t* U = (const bf16_t*)(p.ws + WS_UPRE); float acc = p.convb[c];
        for (int j = 0; j < CWID; ++j) { const int t = pos + j - CWID / 2; if (t >= 0 && t < len) acc += p.convw[(size_t)j * CCH + c] * bf2f(U[(size_t)(row + j - CWID / 2) * CCH + c]); }
        ((float*)(p.ws + WS_HS))[idx] = acc;
    }
};
struct NConvLN {
    Params p; static HD_FN long count() { return MTOK; }
    HD_FN void operator()(long row) const {
        const float* t = (const float*)(p.ws + WS_HS) + (size_t)row * CCH; float mu = 0.f;
        for (int c = 0; c < CCH; ++c) mu += t[c]; mu /= CCH; float var = 0.f;
        for (int c = 0; c < CCH; ++c) { const float d = t[c] - mu; var += d * d; } var /= CCH;
        const float rs = 1.0f / sqrtf(var + EPSF); bf16_t* UH = (bf16_t*)(p.ws + WS_UH) + (size_t)row * DM;
        for (int c = 0; c < CCH; ++c) UH[c] = f2bf(siluf_((t[c] - mu) * rs * p.lng[c] + p.lnb[c]));
    }
};
HD_FN int seq_base(int sid) { return sid < NCB ? sid * CSEQ : MC + (sid - NCB) * LSEQ; }
struct NMlstmDen {
    Params p; static HD_FN long count() { return (long)NSEQ * MH * 2; }
    HD_FN void operator()(long idx) const {
        const int dir = (int)(idx % 2), h = (int)((idx / 2) % MH), sid = (int)(idx / (2 * MH)); const bool isctx = sid < NCB;
        const int base = seq_base(sid), len = isctx ? CSEQ : LSEQ;
        float n[MDK]; float mrun = 0.f;
        if (isctx) {
#pragma unroll
            for (int d = 0; d < MDK; ++d) n[d] = 0.f;
        } else { const int b = sid - NCB; const float em = expf(p.stm[(size_t)(b * 2 + dir) * MH + h]);
#pragma unroll
            for (int d = 0; d < MDK; ++d) n[d] = p.stn[((size_t)(b * 2 + dir) * MH + h) * MDK + d] * em; }
        const bf16_t* QK = (const bf16_t*)(p.ws + WS_QKVO); const float* G = (const float*)(p.ws + WS_GATES); float* DEN = (float*)(p.ws + WS_DEN);
        for (int t = 0; t < len; ++t) {
            const int row = base + (dir == 0 ? t : len - 1 - t);
            const float ig = G[(size_t)row * NGATE + dir * 8 + h], lf = G[(size_t)row * NGATE + dir * 8 + 4 + h];
            const float f = expf(lf), ei = expf(ig); mrun = fmaxf(mrun + lf, ig);
            const bf16_t* q = QK + (size_t)row * 4 * MW + h * MDK; const bf16_t* k = q + MW; float den = 0.f;
#pragma unroll
            for (int d = 0; d < MDK; ++d) { n[d] = f * n[d] + ei * bf2f(k[d]); den += bf2f(q[d]) * n[d]; }
            DEN[((size_t)dir * MTOK + row) * MH + h] = den;
        }
        if (isctx) { const float em = expf(-mrun); p.out[O_M + (size_t)(sid * 2 + dir) * MH + h] = mrun;
#pragma unroll
            for (int d = 0; d < MDK; ++d) p.out[O_N + ((size_t)(sid * 2 + dir) * MH + h) * MDK + d] = n[d] * em; }
    }
};
struct NMlstmNum {
    Params p; int dir; int pad_ = 0; static HD_FN long count() { return (long)NSEQ * MH * MDK; }
    HD_FN void operator()(long idx) const {
        const int v = (int)(idx % MDK), h = (int)((idx / MDK) % MH), sid = (int)(idx / (MDK * MH)); const bool isctx = sid < NCB;
        const int base = seq_base(sid), len = isctx ? CSEQ : LSEQ;
        float C[MDK];
        if (isctx) {
#pragma unroll
            for (int d = 0; d < MDK; ++d) C[d] = 0.f;
        } else { const int b = sid - NCB; const float em = expf(p.stm[(size_t)(b * 2 + dir) * MH + h]);
#pragma unroll
            for (int d = 0; d < MDK; ++d) C[d] = p.stC[(((size_t)(b * 2 + dir) * MH + h) * MDK + d) * MDK + v] * em; }
        const bf16_t* QK = (const bf16_t*)(p.ws + WS_QKVO); const float* G = (const float*)(p.ws + WS_GATES); const float* DEN = (const float*)(p.ws + WS_DEN);
        float* HS = (float*)(p.ws + WS_HS);
        for (int t = 0; t < len; ++t) {
            const int row = base + (dir == 0 ? t : len - 1 - t);
            const float ig = G[(size_t)row * NGATE + dir * 8 + h], lf = G[(size_t)row * NGATE + dir * 8 + 4 + h];
            const float f = expf(lf), ei = expf(ig);
            const bf16_t* q = QK + (size_t)row * 4 * MW + h * MDK; const bf16_t* k = q + MW; const float vv = bf2f(q[2 * MW + v]) * ei; float num = 0.f;
#pragma unroll
            for (int d = 0; d < MDK; ++d) { C[d] = f * C[d] + bf2f(k[d]) * vv; num += bf2f(q[d]) * C[d]; }
            const float den = DEN[((size_t)dir * MTOK + row) * MH + h]; const float hv = num / fmaxf(fabsf(den), 1.0f);
            float* o = HS + (size_t)row * MW + h * MDK + v; if (dir == 0) *o = hv; else *o += hv;
        }
        if (isctx) { const float em = expf(-p.out[O_M + (size_t)(sid * 2 + dir) * MH + h]);
#pragma unroll
            for (int d = 0; d < MDK; ++d) p.out[O_C + (((size_t)(sid * 2 + dir) * MH + h) * MDK + d) * MDK + v] = C[d] * em; }
    }
};
struct NHm {
    Params p; static HD_FN long count() { return (long)MTOK * MH; }
    HD_FN void operator()(long idx) const {
        const int row = (int)(idx / MH), h = (int)(idx % MH); const float* x = (const float*)(p.ws + WS_HS) + (size_t)row * MW + h * MDK; float s = 0.f;
        for (int v = 0; v < MDK; ++v) s += x[v] * x[v];
        const float rs = 1.0f / sqrtf(s / MDK + EPSF); const bf16_t* og = (const bf16_t*)(p.ws + WS_QKVO) + (size_t)row * 4 * MW + 3 * MW + h * MDK;
        bf16_t* UH = (bf16_t*)(p.ws + WS_UH) + (size_t)row * DM + CCH + h * MDK;
        for (int v = 0; v < MDK; ++v) UH[v] = f2bf(bf2f(og[v]) * x[v] * rs * p.mng[h * MDK + v]);
    }
};
struct NCacheCvt {
    Params p; static HD_FN long count() { return (long)NLB * PAST * NKV * HDIM; }
    HD_FN void operator()(long idx) const { const int e = (int)(idx % (NKV * HDIM)), pp = (int)((idx / (NKV * HDIM)) % PAST), b = (int)(idx / ((long)NKV * HDIM * PAST));
        const size_t dst = ((size_t)b * SKVL + LSEQ + pp) * NKV * HDIM + e;
        ((bf16_t*)(p.ws + WS_LATK))[dst] = f2bf(p.ck[idx]); ((bf16_t*)(p.ws + WS_LATV))[dst] = f2bf(p.cv[idx]); }
};
struct NQkPost {
    Params p; static HD_FN long count() { return (long)MTOK * (NQ + NKV); }
    HD_FN void operator()(long idx) const {
        const int row = (int)(idx / (NQ + NKV)), j = (int)(idx % (NQ + NKV)); const bool isq = j < NQ; const bool lat = row >= MC;
        bf16_t* src = isq ? (bf16_t*)(p.ws + WS_QRAW) + (size_t)row * NQ * HDIM + j * HDIM : (bf16_t*)(p.ws + WS_KRAW) + (size_t)row * NKV * HDIM + (j - NQ) * HDIM;
        const float* g = isq ? p.qng : p.kng; float s = 0.f;
        for (int d = 0; d < HDIM; ++d) { const float x = bf2f(src[d]); s += x * x; }
        const float rs = 1.0f / sqrtf(s / HDIM + EPSF);
        bf16_t* dst; float* fo = nullptr;
        if (isq) dst = src;
        else if (!lat) { dst = (bf16_t*)(p.ws + WS_CTXK) + (size_t)row * NKV * HDIM + (j - NQ) * HDIM; fo = p.out + O_K + (size_t)row * NKV * HDIM + (j - NQ) * HDIM; }
        else { const int b = (row - MC) / LSEQ, sp = (row - MC) % LSEQ; dst = (bf16_t*)(p.ws + WS_LATK) + ((size_t)b * SKVL + sp) * NKV * HDIM + (j - NQ) * HDIM; }
        const int sp = pos_of(row); const float prow = (float)(sp / GRIDW), pcol = (float)(sp % GRIDW);
        for (int half = 0; half < 2; ++half)
            for (int d = 0; d < HDIM / 4; ++d) {
                const int i1 = half * (HDIM / 2) + d, i2 = i1 + HDIM / 4;
                const float x1 = bf2f(src[i1]) * rs * g[i1], x2 = bf2f(src[i2]) * rs * g[i2]; float y1 = x1, y2 = x2;
                if (lat) { const float inv = powf(10000.0f, -(float)d / (float)(HDIM / 4)); const float ang = (half == 0 ? prow : pcol) * inv; const float cs = cosf(ang), sn = sinf(ang);
                    y1 = x1 * cs - x2 * sn; y2 = x1 * sn + x2 * cs; }
                dst[i1] = f2bf(y1); dst[i2] = f2bf(y2); if (fo) { fo[i1] = y1; fo[i2] = y2; }
            }
    }
};
struct NAttn {
    Params p; static HD_FN long count() { return (long)MTOK * NQ * 4; }
    HD_FN void operator()(long idx) const {
        const int sl = (int)(idx % 4), hq = (int)((idx / 4) % NQ), row = (int)(idx / (4 * NQ)); const int kv = hq / GRP;
        const bf16_t *Kb, *Vb; int nk;
        if (row < MC) { const int b = row / CSEQ; Kb = (const bf16_t*)(p.ws + WS_CTXK) + (size_t)b * CSEQ * NKV * HDIM; Vb = (const bf16_t*)(p.ws + WS_CTXV) + (size_t)b * CSEQ * NKV * HDIM; nk = CSEQ; }
        else { const int b = (row - MC) / LSEQ; Kb = (const bf16_t*)(p.ws + WS_LATK) + (size_t)b * SKVL * NKV * HDIM; Vb = (const bf16_t*)(p.ws + WS_LATV) + (size_t)b * SKVL * NKV * HDIM; nk = SKVL; }
        const bf16_t* qp = (const bf16_t*)(p.ws + WS_QRAW) + (size_t)row * NQ * HDIM + hq * HDIM;
        float q[HDIM];
#pragma unroll
        for (int d = 0; d < HDIM; ++d) q[d] = bf2f(qp[d]);
        float o[32];
#pragma unroll
        for (int e = 0; e < 32; ++e) o[e] = 0.f;
        float m = -1e30f, l = 0.f; const float scale = 1.0f / sqrtf((float)HDIM);
        for (int s = 0; s < nk; ++s) {
            const bf16_t* kp = Kb + (size_t)s * NKV * HDIM + kv * HDIM; float dot = 0.f;
#pragma unroll
            for (int d = 0; d < HDIM; ++d) dot += q[d] * bf2f(kp[d]);
            dot *= scale; const float mn = fmaxf(m, dot); const float al = expf(m - mn), pe = expf(dot - mn); m = mn; l = l * al + pe;
            const bf16_t* vp = Vb + (size_t)s * NKV * HDIM + kv * HDIM + sl * 32;
#pragma unroll
            for (int e = 0; e < 32; ++e) o[e] = o[e] * al + pe * bf2f(vp[e]);
        }
        bf16_t* op = (bf16_t*)(p.ws + WS_O) + (size_t)row * DM + hq * HDIM + sl * 32;
#pragma unroll
        for (int e = 0; e < 32; ++e) op[e] = f2bf(o[e] / l);
    }
};
struct NFinal {
    Params p; static HD_FN long count() { return (long)MTOK * DM; }
    HD_FN void operator()(long idx) const { const int row = (int)(idx / DM), col = (int)(idx % DM);
        const float rs = 1.0f / sqrtf(((const float*)(p.ws + WS_SSQ))[(size_t)3 * SSQ_STRIDE + row] / DM + EPSF); p.out[O_Y + idx] *= rs * p.fng[col]; }
};
constexpr int NWAVES = 8, NTHREADS = NWAVES * 64;
constexpr int RING_OFF = 0, RING_BYTES = 131072;
constexpr int LDSCTL_OFF = RING_BYTES, MISC_OFF = LDSCTL_OFF + 320;
constexpr int LDS_BYTES = 147456;
constexpr int CW_TMO = 0, CW_CODE = 1, CW_BAR = 4096;
__device__ __forceinline__ int tid_opaque() { int t = threadIdx.x; asm volatile("" : "+v"(t)); return t; }
template <int M> __device__ __forceinline__ float swz_xor(float v) { return __int_as_float(__builtin_amdgcn_ds_swizzle(__float_as_int(v), (M << 10) | 0x1f)); }
__device__ __forceinline__ float half_sum(float v) { auto rr = __builtin_amdgcn_permlane32_swap(__float_as_uint(v), __float_as_uint(v), false, false); return __uint_as_float(rr[0]) + __uint_as_float(rr[1]); }
__device__ __forceinline__ float half_max(float v) { auto rr = __builtin_amdgcn_permlane32_swap(__float_as_uint(v), __float_as_uint(v), false, false); return fmaxf(__uint_as_float(rr[0]), __uint_as_float(rr[1])); }
__device__ __forceinline__ float lane_get(float v, int src_lane) { return __int_as_float(__builtin_amdgcn_ds_bpermute(src_lane << 2, __float_as_int(v))); }
#define GAS __attribute__((address_space(1)))
#define LAS __attribute__((address_space(3)))
typedef GAS unsigned gu32;
#define RLX_AGENT __ATOMIC_RELAXED, __HIP_MEMORY_SCOPE_AGENT
#define XB_TMO      128
#define XB_XCNT(j)  (256  + 64 * (j))
#define XB_XSUB(j)  (1280 + 64 * (j))
#define XB_XGEN(j)  (2304 + 64 * (j))
#define XB_TOP      3328
#define XB_TOPGEN   3392
#define XCD_BAR_WORDS 3456
#define XB_SPIN_CAP (1u << 22)
__device__ __forceinline__ unsigned xb_ld(unsigned* p)              { return __hip_atomic_load(p, __ATOMIC_RELAXED, __HIP_MEMORY_SCOPE_AGENT); }
__device__ __forceinline__ unsigned xb_add(unsigned* p, unsigned v) { return __hip_atomic_fetch_add(p, v, __ATOMIC_RELAXED, __HIP_MEMORY_SCOPE_AGENT); }
__device__ __forceinline__ unsigned xb_xcc_id() { return (unsigned)__builtin_amdgcn_s_getreg((3 << 11) | 20) & 0xFu; }
#define XB_SPIN(cond, bar) do { unsigned _sp = 0; while (cond) { __builtin_amdgcn_s_sleep(1); \
    if ((++_sp & 255u) == 0u) { if (xb_ld(&(bar)[XB_TMO])) break; if (_sp > XB_SPIN_CAP) { atomicAdd(&(bar)[XB_TMO], 1u); break; } } } } while (0)
struct XcdBarrier { unsigned* bar; unsigned x; volatile LAS unsigned* st; };
__device__ __forceinline__ XcdBarrier xcd_barrier_post(unsigned* bar, volatile LAS unsigned* st) {
    XcdBarrier b; b.bar = bar; b.x = xb_xcc_id(); b.st = st;
    if (threadIdx.x == 0) (void)xb_add(&bar[XB_XCNT(b.x)], 1u);
    return b;
}
__device__ __forceinline__ void xcd_barrier_complete(unsigned* bar, unsigned x, unsigned& nloc, unsigned& nx) {
    const unsigned G = gridDim.x * gridDim.y * gridDim.z;
    unsigned sum, cnt, mine, sp = 0u;
    for (;;) {
        sum = 0u; cnt = 0u; mine = 0u;
#pragma unroll
        for (unsigned j = 0; j < 16; ++j) { const unsigned c = xb_ld(&bar[XB_XCNT(j)]); sum += c; cnt += (c > 0u) ? 1u : 0u; mine = (j == x) ? c : mine; }
        if (sum == G) break;
        __builtin_amdgcn_s_sleep(1);
        if ((++sp & 255u) == 0u) { if (xb_ld(&bar[XB_TMO])) break; if (sp > XB_SPIN_CAP) { atomicAdd(&bar[XB_TMO], 1u); break; } }
    }
    nloc = mine > 0u ? mine : 1u; nx = cnt > 0u ? cnt : 1u;
}
__device__ __forceinline__ void xcd_barrier(const XcdBarrier& b) {
    asm volatile("s_waitcnt vmcnt(0)" ::: "memory");
    __syncthreads();
    if (threadIdx.x == 0) {
        unsigned* bar = b.bar;
        __builtin_amdgcn_s_waitcnt(0);
        unsigned nloc = b.st[0], nx = b.st[1];
        if (nloc == 0u) { xcd_barrier_complete(bar, b.x, nloc, nx); b.st[0] = nloc; b.st[1] = nx; }
        const unsigned old = xb_add(&bar[XB_XSUB(b.x)], 1u);
        const unsigned gen = old / nloc;
        if (old + 1u == (gen + 1u) * nloc) {
            __builtin_amdgcn_fence(__ATOMIC_RELEASE, "agent");
            asm volatile("s_waitcnt vmcnt(0)" ::: "memory");
            const unsigned og = xb_add(&bar[XB_TOP], 1u);
            const unsigned tg = og / nx;
            if (og + 1u == (tg + 1u) * nx) xb_add(&bar[XB_TOPGEN], 1u);
            else XB_SPIN(xb_ld(&bar[XB_TOPGEN]) == tg, bar);
            __builtin_amdgcn_fence(__ATOMIC_ACQUIRE, "agent");
            xb_add(&bar[XB_XGEN(b.x)], 1u);
            asm volatile("s_waitcnt vmcnt(0)" ::: "memory");
        } else {
            XB_SPIN(xb_ld(&bar[XB_XGEN(b.x)]) == gen, bar);
            __builtin_amdgcn_fence(__ATOMIC_ACQUIRE, "agent");
            asm volatile("s_waitcnt vmcnt(0)" ::: "memory");
        }
    }
    __syncthreads();
}
namespace pg8 {
#define PG8_LAS __attribute__((address_space(3)))
typedef unsigned short bf16_t;
typedef short bf16x8 __attribute__((ext_vector_type(8)));
typedef float f32x4 __attribute__((ext_vector_type(4)));
typedef unsigned u32x4 __attribute__((ext_vector_type(4)));
constexpr int BM = 256, BK = 64, HALF = 128, HTB = HALF * BK * 2  , STAGE_BYTES = 8 * HTB, NXCD = 8, WGM = 8;

__host__ __device__ __forceinline__ int lds_byte(int r, int c) { const int st = (r >> 4) * 2 + (c >> 5), rr = r & 15, cc = c & 31, ob = rr * 64 + cc * 2; return st * 1024 + (ob ^ (((ob >> 9) & 1) << 5)); }
__host__ __device__ __forceinline__ void stage_rc(int b, int& R, int& C) { const int st = b / 1024, sb = b % 1024, swz = sb ^ (((sb >> 9) & 1) << 5); R = (st >> 1) * 16 + swz / 64; C = (st & 1) * 32 + (swz % 64) / 2; }
__host__ __device__ __forceinline__ int perm32(int rho) { const int n = rho >> 4, i = rho & 15; return 8 * (i >> 2) + 4 * n + (i & 3); }

struct Unit { int pm, pn, k0, nt, role, slot; };
struct Gemm { const bf16_t* A; const bf16_t* Bt; int M, N, K; };

struct StaticOrder {
    int nM, nN, nwg, G, c, ntK;
    __host__ __device__ void init(int M, int N, int K, int G_, int c_) { nM = M / BM; nN = N / BM; nwg = nM * nN; G = G_; c = c_; ntK = K / BK; }
    __host__ __device__ void map(int L, Unit& u) const { int wgid = L; { const int q = nwg / NXCD, r = nwg % NXCD, xcd = wgid % NXCD, off = wgid / NXCD; wgid = (xcd < r ? xcd * (q + 1) : r * (q + 1) + (xcd - r) * q) + off; }
        const int nig = WGM * nN, gid = wgid / nig, fm = gid * WGM, gsz = (nM - fm) < WGM ? (nM - fm) : WGM; u.pm = fm + ((wgid % nig) % gsz); u.pn = (wgid % nig) / gsz; }
    __host__ __device__ bool next(int i, Unit& u) const {
        const long L = (long)i * G + c; if (L >= nwg) return false;
        int wgid = (int)L; { const int q = nwg / NXCD, r = nwg % NXCD, xcd = wgid % NXCD, off = wgid / NXCD; wgid = (xcd < r ? xcd * (q + 1) : r * (q + 1) + (xcd - r) * q) + off; }
        const int nig = WGM * nN, gid = wgid / nig, fm = gid * WGM, gsz = (nM - fm) < WGM ? (nM - fm) : WGM;
        u.pm = fm + ((wgid % nig) % gsz); u.pn = (wgid % nig) / gsz; u.k0 = 0; u.nt = ntK; u.role = 0; u.slot = 0; return true;
    }
    __device__ __forceinline__ void a_ready(const Unit&) const {}
    __device__ __forceinline__ void done(const Unit&) const {}
};

__device__ __forceinline__ unsigned cvt_pk_bf16(float lo, float hi) { unsigned r; asm volatile("v_cvt_pk_bf16_f32 %0, %1, %2" : "=v"(r) : "v"(lo), "v"(hi)); return r; }
typedef float f32x2 __attribute__((ext_vector_type(2)));
template <class Epi, class Sched, bool ALIGN_EPI = false, bool SP2 = false>
__device__ __forceinline__ void gemm_phase(PG8_LAS unsigned char* lds, const Gemm g, const Sched& S, const Epi& E) {
    const int tid = tid_opaque(), wid = __builtin_amdgcn_readfirstlane(tid >> 6), lane = tid & 63, wr = wid >> 2, wc = wid & 3, fr = lane & 15, fq = lane >> 4;
    const int K = g.K;
    unsigned voffA[2], voffB[2];
#pragma unroll
    for (int i = 0; i < 2; ++i) { int R, C; stage_rc(tid * 16 + i * 8192, R, C); const int Rb = Epi::PERM ? ((R & ~31) + perm32(R & 31)) : R;
        voffA[i] = (unsigned)(R * K + C) * 2u; voffB[i] = (unsigned)(Rb * K + C) * 2u; }
    const size_t kstep = (size_t)(BK * 2);
    const size_t hstep = (size_t)HALF * K * 2;
    const size_t tstep = 2 * hstep;
    const unsigned ldsw = (unsigned)wid * 1024u;
    const int aoff = lds_byte(wr * 64 + fr, fq * 8), boff = lds_byte(wc * 32 + fr, fq * 8);
#define PG8_SA(b, h) (((b) * 2 + (h)) * HTB)
#define PG8_SB(b, h) ((4 + (b) * 2 + (h)) * HTB)
#define PG8_STAGE(bufoff, gbase, voff) do { _Pragma("unroll") for (int _i = 0; _i < 2; ++_i) \
        __builtin_amdgcn_global_load_lds((const unsigned*)((const char*)(gbase) + (voff)[_i]), (PG8_LAS unsigned*)(lds + (bufoff) + ldsw + _i * 8192), 16, 0, 0); } while (0)
#define PG8_LDA(dst, b, h) do { _Pragma("unroll") for (int m = 0; m < 4; ++m) _Pragma("unroll") for (int k = 0; k < 2; ++k) dst[m][k] = *(const PG8_LAS bf16x8*)(lds + PG8_SA(b, h) + aoff + m * 2048 + k * 1024); } while (0)
#define PG8_LDB(dst, b, h) do { _Pragma("unroll") for (int n = 0; n < 2; ++n) _Pragma("unroll") for (int k = 0; k < 2; ++k) dst[n][k] = *(const PG8_LAS bf16x8*)(lds + PG8_SB(b, h) + boff + n * 2048 + k * 1024); } while (0)
#define PG8_MMA(ai, bj, At, Bt) do { __builtin_amdgcn_s_setprio(1); _Pragma("unroll") for (int m = 0; m < 4; ++m) _Pragma("unroll") for (int n = 0; n < 2; ++n) _Pragma("unroll") for (int k = 0; k < 2; ++k) \
        acc[ai][bj][m][n] = __builtin_amdgcn_mfma_f32_16x16x32_bf16(Bt[n][k], At[m][k], acc[ai][bj][m][n], 0, 0, 0); __builtin_amdgcn_s_setprio(0); } while (0)
#define PG8_WAIT_V(n) asm volatile("s_waitcnt vmcnt(" #n ")" ::: "memory")
#define PG8_WAIT_L(n) asm volatile("s_waitcnt lgkmcnt(" #n ")" ::: "memory")
#define PG8_BAR __builtin_amdgcn_s_barrier()
#define PG8_SCHED __builtin_amdgcn_sched_barrier(0)
    Unit cur, nxt; int ui = 0;
    if (!S.next(0, cur)) return;
    f32x4 acc[2][2][4][2];
#pragma unroll
    for (int a = 0; a < 2; ++a)
#pragma unroll
        for (int b = 0; b < 2; ++b)
#pragma unroll
            for (int m = 0; m < 4; ++m)
#pragma unroll
                for (int n = 0; n < 2; ++n) acc[a][b][m][n] = (f32x4){0.f, 0.f, 0.f, 0.f};
    bf16x8 At[4][2], B0[2][2], B1[2][2];
    const char* cA = (const char*)g.A + (size_t)cur.pm * tstep + (size_t)cur.k0 * kstep; const char* cB = (const char*)g.Bt + (size_t)cur.pn * tstep + (size_t)cur.k0 * kstep; int nt = cur.nt;
    S.a_ready(cur);
    if constexpr (SP2) {
        PG8_STAGE(PG8_SB(0, 0), cB, voffB); PG8_STAGE(PG8_SB(0, 1), cB + hstep, voffB); PG8_STAGE(PG8_SA(0, 0), cA, voffA); PG8_STAGE(PG8_SA(0, 1), cA + hstep, voffA);
        if (wr == 1) PG8_BAR;
        PG8_WAIT_V(2); PG8_BAR;
        PG8_STAGE(PG8_SB(1, 0), cB + kstep, voffB); PG8_STAGE(PG8_SA(1, 0), cA + kstep, voffA); PG8_STAGE(PG8_SB(1, 1), cB + hstep + kstep, voffB);
        PG8_WAIT_V(6); PG8_BAR;
    } else {
        PG8_STAGE(PG8_SB(0, 0), cB, voffB); PG8_STAGE(PG8_SA(0, 0), cA, voffA); PG8_STAGE(PG8_SB(0, 1), cB + hstep, voffB); PG8_STAGE(PG8_SA(0, 1), cA + hstep, voffA);
        if (wr == 1) PG8_BAR;
        PG8_WAIT_V(4); PG8_BAR;
        PG8_STAGE(PG8_SB(1, 0), cB + kstep, voffB); PG8_STAGE(PG8_SA(1, 0), cA + kstep, voffA); PG8_STAGE(PG8_SB(1, 1), cB + hstep + kstep, voffB);
        PG8_WAIT_V(6); PG8_BAR;
    }
    for (;;) {
        const bool has_next = S.next(ui + 1, nxt);
        const char* nA = has_next ? (const char*)g.A + (size_t)nxt.pm * tstep + (size_t)nxt.k0 * kstep : cA; const char* nB = has_next ? (const char*)g.Bt + (size_t)nxt.pn * tstep + (size_t)nxt.k0 * kstep : cB;
        for (int t = 0; t < nt; t += 2) {
            const bool last = (t == nt - 2);
            const char* a1 = cA + (size_t)(t + 1) * kstep;
            const char* a2 = last ? nA : cA + (size_t)(t + 2) * kstep; const char* b2 = last ? nB : cB + (size_t)(t + 2) * kstep;
            const char* a3 = a2 + kstep; const char* b3 = b2 + kstep;
            if (last && has_next) S.a_ready(nxt);
            if constexpr (SP2) {
            PG8_LDB(B0, 0, 0); PG8_LDB(B1, 0, 1); PG8_SCHED; PG8_LDA(At, 0, 0); PG8_STAGE(PG8_SA(1, 1), a1 + hstep, voffA);
            PG8_WAIT_V(8); PG8_WAIT_L(0); PG8_BAR; PG8_MMA(0, 0, At, B0); PG8_MMA(0, 1, At, B1); PG8_BAR; PG8_SCHED;
            PG8_LDA(At, 0, 1); PG8_STAGE(PG8_SB(0, 0), b2, voffB); PG8_STAGE(PG8_SB(0, 1), b2 + hstep, voffB); PG8_STAGE(PG8_SA(0, 0), a2, voffA);
            PG8_WAIT_V(8); PG8_WAIT_L(0); PG8_BAR; PG8_MMA(1, 0, At, B0); PG8_MMA(1, 1, At, B1); PG8_BAR; PG8_SCHED;
            PG8_LDB(B0, 1, 0); PG8_LDB(B1, 1, 1); PG8_SCHED; PG8_LDA(At, 1, 0); PG8_STAGE(PG8_SA(0, 1), a2 + hstep, voffA);
            PG8_WAIT_V(8); PG8_WAIT_L(0); PG8_BAR; PG8_MMA(0, 0, At, B0); PG8_MMA(0, 1, At, B1); PG8_BAR; PG8_SCHED;
            PG8_LDA(At, 1, 1); PG8_STAGE(PG8_SB(1, 0), b3, voffB); PG8_STAGE(PG8_SB(1, 1), b3 + hstep, voffB); PG8_STAGE(PG8_SA(1, 0), a3, voffA);
            PG8_WAIT_V(8); PG8_WAIT_L(0); PG8_BAR; PG8_MMA(1, 0, At, B0); PG8_MMA(1, 1, At, B1); PG8_BAR; PG8_SCHED;
            } else {
            PG8_LDB(B0, 0, 0); PG8_SCHED; PG8_LDA(At, 0, 0); PG8_STAGE(PG8_SA(1, 1), a1 + hstep, voffA);
            PG8_WAIT_L(8); PG8_BAR; PG8_WAIT_L(0); PG8_MMA(0, 0, At, B0); PG8_BAR; PG8_SCHED;
            PG8_LDB(B1, 0, 1); PG8_STAGE(PG8_SB(0, 0), b2, voffB);
            PG8_BAR; PG8_WAIT_L(0); PG8_MMA(0, 1, At, B1); PG8_BAR;
            PG8_LDA(At, 0, 1); PG8_STAGE(PG8_SA(0, 0), a2, voffA);
            PG8_BAR; PG8_WAIT_L(0); PG8_MMA(1, 0, At, B0); PG8_BAR; PG8_SCHED;
            PG8_STAGE(PG8_SB(0, 1), b2 + hstep, voffB);
            PG8_WAIT_V(6); PG8_BAR; PG8_MMA(1, 1, At, B1); PG8_BAR;
            PG8_LDB(B0, 1, 0); PG8_SCHED; PG8_LDA(At, 1, 0); PG8_STAGE(PG8_SA(0, 1), a2 + hstep, voffA);
            PG8_WAIT_L(8); PG8_BAR; PG8_WAIT_L(0); PG8_MMA(0, 0, At, B0); PG8_BAR; PG8_SCHED;
            PG8_LDB(B1, 1, 1); PG8_STAGE(PG8_SB(1, 0), b3, voffB);
            PG8_BAR; PG8_WAIT_L(0); PG8_MMA(0, 1, At, B1); PG8_BAR;
            PG8_LDA(At, 1, 1); PG8_STAGE(PG8_SA(1, 0), a3, voffA);
            PG8_BAR; PG8_WAIT_L(0); PG8_MMA(1, 0, At, B0); PG8_BAR; PG8_SCHED;
            PG8_STAGE(PG8_SB(1, 1), b3 + hstep, voffB);
            PG8_WAIT_V(6); PG8_BAR; PG8_MMA(1, 1, At, B1); PG8_BAR;
            }
        }
        if constexpr (ALIGN_EPI) { if (wr == 0) PG8_BAR; }
        if constexpr (!Epi::AFTER_DRAIN) { E(acc, cur, wr, wc, fr, fq); S.done(cur); }
        if (!has_next) break;
#pragma unroll
        for (int a = 0; a < 2; ++a)
#pragma unroll
            for (int b = 0; b < 2; ++b)
#pragma unroll
                for (int m = 0; m < 4; ++m)
#pragma unroll
                    for (int n = 0; n < 2; ++n) acc[a][b][m][n] = (f32x4){0.f, 0.f, 0.f, 0.f};
        cur = nxt; cA = nA; cB = nB; nt = cur.nt; ++ui;
        if constexpr (ALIGN_EPI) { if (wr == 1) PG8_BAR; }
    }
    PG8_WAIT_V(0);
    if constexpr (!ALIGN_EPI) { if (wr == 0) PG8_BAR; }
    PG8_BAR;
    if constexpr (Epi::AFTER_DRAIN) { E.fused(acc, cur, wr, wc, fr, fq, lds, wid, lane); S.done(cur); }
#undef PG8_SA
#undef PG8_SB
#undef PG8_STAGE
#undef PG8_LDA
#undef PG8_LDB
#undef PG8_MMA
#undef PG8_WAIT_V
#undef PG8_WAIT_L
#undef PG8_BAR
#undef PG8_SCHED
}
}
constexpr size_t WB_AB = 2 * MiB, WB_OUTAB = 8 * MiB, WB_FFI0 = 10 * MiB, WB_FFO0 = 21 * MiB, WB_INC = 27 * MiB, WB_OUTC = 30 * MiB, WB_FFI1 = 32 * MiB, WB_FFO1 = 43 * MiB;
static_assert(WB_FFO1 + (size_t)DM * DFF * 2 <= WS_XN && WB_AB + (size_t)ABMAIN * DM * 2 <= WB_OUTAB && WB_FFI0 + (size_t)2 * DFF * DM * 2 <= WB_FFO0 && WB_FFO0 + (size_t)DM * DFF * 2 <= WB_INC &&
              WB_INC + (size_t)CIN * DM * 2 <= WB_OUTC && WB_FFI1 + (size_t)2 * DFF * DM * 2 <= WB_FFO1, "weight copy map");

typedef unsigned v4u __attribute__((ext_vector_type(4)));
typedef unsigned v2u __attribute__((ext_vector_type(2)));
typedef float f32x4 __attribute__((ext_vector_type(4)));
__device__ __forceinline__ unsigned pk2(float lo, float hi) { return (unsigned)f2bf(lo) | ((unsigned)f2bf(hi) << 16); }
__device__ __forceinline__ float fsigmoid(float x) { return __builtin_amdgcn_rcpf(1.0f + __builtin_amdgcn_exp2f(-1.4426950408889634f * x)); }

__device__ __forceinline__ void p0_transpose_item(const float* W, int K, int ldw, int c0, int k0, bf16_t* WT, int drow, LAS float* scr, int lane) {
    { f32x4 tv[8]; const int rr = lane >> 3, cg = (lane & 7) * 4;
#pragma unroll
      for (int i = 0; i < 8; ++i) tv[i] = *(const f32x4*)(W + (size_t)(k0 + 8 * i + rr) * ldw + c0 + cg);
#pragma unroll
      for (int i = 0; i < 8; ++i) { LAS float* d = scr + (8 * i + rr) * 33 + cg; d[0] = tv[i][0]; d[1] = tv[i][1]; d[2] = tv[i][2]; d[3] = tv[i][3]; } }
    asm volatile("s_waitcnt lgkmcnt(0)" ::: "memory");
    const int c = lane & 7;
#pragma unroll
    for (int j = 0; j < 4; ++j) { const int n = (lane >> 3) + 8 * j; const LAS float* s = scr + (8 * c) * 33 + n;
        v4u o; o.x = pk2(s[0 * 33], s[1 * 33]); o.y = pk2(s[2 * 33], s[3 * 33]); o.z = pk2(s[4 * 33], s[5 * 33]); o.w = pk2(s[6 * 33], s[7 * 33]);
        *(GAS v4u*)(WT + (size_t)(drow + n) * K + k0 + 8 * c) = o; }
    asm volatile("s_waitcnt lgkmcnt(0)" ::: "memory");
}
struct CvtJob { const float* W; bf16_t* WT; int K, ldw, c0, ncols, mode, Hn, dbase; };
__device__ __forceinline__ int cvt_items(const CvtJob& j) { return (j.K / 64) * (j.ncols / 32); }
__device__ __forceinline__ void cvt_run(const CvtJob& j, int item, LAS float* scr, int lane) {
    const int nblk = j.ncols / 32, kb = item / nblk, nb = item % nblk; const int c = j.c0 + 32 * nb;
    int drow; if (j.mode == 0) drow = j.dbase + 32 * nb; else { const int cc = c < j.Hn ? c : c - j.Hn; drow = 256 * (cc / 128) + (cc % 128) + (c < j.Hn ? 0 : 128); }
    p0_transpose_item(j.W, j.K, j.ldw, c, 64 * kb, j.WT, drow, scr, lane);
}
__device__ __forceinline__ void p0_weights(const Params& p, LAS unsigned char* lds, int vcu, int G) {
    const int tid_ = tid_opaque(); const int lane = tid_ & 63, wave = __builtin_amdgcn_readfirstlane(tid_ >> 6);
    LAS float* scr = (LAS float*)(lds + wave * 16384);
    const int gw = vcu * NWAVES + wave, NGW = G * NWAVES;
    CvtJob jobs[9] = {
        {p.winab, (bf16_t*)(p.ws + WB_AB), DM, ABIN, 0, 2 * CCH, 1, CCH, 0},
        {p.winab, (bf16_t*)(p.ws + WB_AB), DM, ABIN, 2 * CCH, 4 * MW, 0, 0, 2 * CCH},
        {p.woutab, (bf16_t*)(p.ws + WB_OUTAB), DM, DM, 0, DM, 0, 0, 0},
        {p.wffi, (bf16_t*)(p.ws + WB_FFI0), DM, 2 * DFF, 0, 2 * DFF, 1, DFF, 0},
        {p.wffo, (bf16_t*)(p.ws + WB_FFO0), DFF, DM, 0, DM, 0, 0, 0},
        {p.winc, (bf16_t*)(p.ws + WB_INC), DM, CIN, 0, CIN, 0, 0, 0},
        {p.woutc, (bf16_t*)(p.ws + WB_OUTC), DM, DM, 0, DM, 0, 0, 0},
        {p.wffi + (size_t)DM * 2 * DFF, (bf16_t*)(p.ws + WB_FFI1), DM, 2 * DFF, 0, 2 * DFF, 1, DFF, 0},
        {p.wffo + (size_t)DFF * DM, (bf16_t*)(p.ws + WB_FFO1), DFF, DM, 0, DM, 0, 0, 0}};
    int base = 0;
#pragma unroll
    for (int jj = 0; jj < 9; ++jj) {
        const int n = cvt_items(jobs[jj]);
        int first = ((gw - base) % NGW + NGW) % NGW;
        for (int it = first; it < n; it += NGW) cvt_run(jobs[jj], it, scr, lane);
        base += n;
    }
}

struct EpiAB {
    static constexpr bool PERM = true, AFTER_DRAIN = false;
    bf16_t* upre; bf16_t* qkvo;
    __device__ __forceinline__ void operator()(const f32x4 (&acc)[2][2][4][2], const pg8::Unit& u, int wr, int wc, int fr, int fq) const {
        const int row0 = u.pm * 256 + wr * 64 + fr, lc = wc * 32 + 8 * fq;
        if (u.pn < 4) {
#pragma unroll
            for (int ai = 0; ai < 2; ++ai)
#pragma unroll
                for (int m = 0; m < 4; ++m) { const f32x4 a0 = acc[ai][0][m][0], a1 = acc[ai][0][m][1], g0 = acc[ai][1][m][0], g1 = acc[ai][1][m][1]; v4u w;
                    w.x = pg8::cvt_pk_bf16(a0[0] * fsigmoid(g0[0]), a0[1] * fsigmoid(g0[1])); w.y = pg8::cvt_pk_bf16(a0[2] * fsigmoid(g0[2]), a0[3] * fsigmoid(g0[3]));
                    w.z = pg8::cvt_pk_bf16(a1[0] * fsigmoid(g1[0]), a1[1] * fsigmoid(g1[1])); w.w = pg8::cvt_pk_bf16(a1[2] * fsigmoid(g1[2]), a1[3] * fsigmoid(g1[3]));
                    *(v4u*)(upre + (size_t)(row0 + ai * 128 + m * 16) * CCH + 128 * u.pn + lc) = w; }
        } else {
#pragma unroll
            for (int bj = 0; bj < 2; ++bj) { const int col = 256 * (u.pn - 4) + 128 * bj + lc; const int part = col / MW; const float sc = part == 1 ? 0.08838834764831845f : 1.0f;
#pragma unroll
                for (int ai = 0; ai < 2; ++ai)
#pragma unroll
                    for (int m = 0; m < 4; ++m) { f32x4 v0 = acc[ai][bj][m][0] * sc, v1 = acc[ai][bj][m][1] * sc;
                        if (part == 3) { v0 = (f32x4){fsigmoid(v0[0]), fsigmoid(v0[1]), fsigmoid(v0[2]), fsigmoid(v0[3])}; v1 = (f32x4){fsigmoid(v1[0]), fsigmoid(v1[1]), fsigmoid(v1[2]), fsigmoid(v1[3])}; }
                        v4u w; w.x = pg8::cvt_pk_bf16(v0[0], v0[1]); w.y = pg8::cvt_pk_bf16(v0[2], v0[3]); w.z = pg8::cvt_pk_bf16(v1[0], v1[1]); w.w = pg8::cvt_pk_bf16(v1[2], v1[3]);
                        *(v4u*)(qkvo + (size_t)(row0 + ai * 128 + m * 16) * (4 * MW) + col) = w; } }
        }
    }
};
static_assert(MDK == 128, "EpiAB hard-codes MDK^-0.5");
struct EpiRes {
    static constexpr bool PERM = false, AFTER_DRAIN = false;
    const float* xp; const float* xs;
    float* Y; bf16_t* XN; float* ssq; const float* mod_g; const float* mod_sc; const float* ng;
    int from_input; int pad_;
    __device__ __forceinline__ void operator()(const f32x4 (&acc)[2][2][4][2], const pg8::Unit& u, int wr, int wc, int fr, int fq) const {
        const int row0 = u.pm * 256 + wr * 64 + fr; const int cls = cls_of(u.pm * 256);
        const float* xin = from_input ? (u.pm * 256 < MC ? xp : xs - (size_t)MC * DM) : Y;
        const float* gv = mod_g + (size_t)cls * 6 * DM; const float* scv = mod_sc + (size_t)cls * 6 * DM;
        float sq[2][4];
#pragma unroll
        for (int ai = 0; ai < 2; ++ai)
#pragma unroll
            for (int m = 0; m < 4; ++m) sq[ai][m] = 0.f;
#pragma unroll
        for (int bj = 0; bj < 2; ++bj)
#pragma unroll
            for (int n = 0; n < 2; ++n) { const int col = u.pn * 256 + bj * 128 + wc * 32 + n * 16 + 4 * fq;
                const f32x4 g4 = *(const f32x4*)(gv + col); f32x4 gs4 = (f32x4){0.f, 0.f, 0.f, 0.f};
                if (ng) { const f32x4 n4 = *(const f32x4*)(ng + col), s4 = *(const f32x4*)(scv + col); gs4 = n4 * (s4 + 1.0f); }
#pragma unroll
                for (int ai = 0; ai < 2; ++ai)
#pragma unroll
                    for (int m = 0; m < 4; ++m) { const size_t off = (size_t)(row0 + ai * 128 + m * 16) * DM + col;
                        const f32x4 xi = *(const f32x4*)(xin + off); const f32x4 xn = xi + g4 * acc[ai][bj][m][n];
                        *(f32x4*)(Y + off) = xn; sq[ai][m] += (xn[0] * xn[0] + xn[1] * xn[1]) + (xn[2] * xn[2] + xn[3] * xn[3]);
                        if (ng) { const f32x4 t = xn * gs4; v2u w; w.x = pg8::cvt_pk_bf16(t[0], t[1]); w.y = pg8::cvt_pk_bf16(t[2], t[3]); *(v2u*)(XN + off) = w; } } }
#pragma unroll
        for (int ai = 0; ai < 2; ++ai)
#pragma unroll
            for (int m = 0; m < 4; ++m) { float s = sq[ai][m]; s += __shfl_xor(s, 16); s += __shfl_xor(s, 32);
                if (fq == 0) atomicAdd(ssq + row0 + ai * 128 + m * 16, s); }
    }
};
struct EpiFfnIn {
    static constexpr bool PERM = true, AFTER_DRAIN = false;
    bf16_t* H; const float* ssq; const float* sw;
    __device__ __forceinline__ void operator()(const f32x4 (&acc)[2][2][4][2], const pg8::Unit& u, int wr, int wc, int fr, int fq) const {
        const int row0 = u.pm * 256 + wr * 64 + fr, lc = wc * 32 + 8 * fq; const int cls = cls_of(u.pm * 256); const int col = 128 * u.pn + lc;
        const float* swr = sw + (size_t)cls * 2 * DFF;
        const f32x4 sg0 = *(const f32x4*)(swr + col), sg1 = *(const f32x4*)(swr + col + 4), su0 = *(const f32x4*)(swr + DFF + col), su1 = *(const f32x4*)(swr + DFF + col + 4);
#pragma unroll
        for (int ai = 0; ai < 2; ++ai)
#pragma unroll
            for (int m = 0; m < 4; ++m) { const int row = row0 + ai * 128 + m * 16; const float rs = 1.0f / sqrtf(ssq[row] * (1.0f / DM) + EPSF);
                const f32x4 a0 = acc[ai][0][m][0] * rs + sg0, a1 = acc[ai][0][m][1] * rs + sg1, b0 = acc[ai][1][m][0] * rs + su0, b1 = acc[ai][1][m][1] * rs + su1; v4u w;
                w.x = pg8::cvt_pk_bf16(a0[0] * fsigmoid(a0[0]) * b0[0], a0[1] * fsigmoid(a0[1]) * b0[1]); w.y = pg8::cvt_pk_bf16(a0[2] * fsigmoid(a0[2]) * b0[2], a0[3] * fsigmoid(a0[3]) * b0[3]);
                w.z = pg8::cvt_pk_bf16(a1[0] * fsigmoid(a1[0]) * b1[0], a1[1] * fsigmoid(a1[1]) * b1[1]); w.w = pg8::cvt_pk_bf16(a1[2] * fsigmoid(a1[2]) * b1[2], a1[3] * fsigmoid(a1[3]) * b1[3]);
                *(v4u*)(H + (size_t)row * DFF + col) = w; }
    }
};
struct EpiQkv {
    static constexpr bool PERM = true, AFTER_DRAIN = false;
    bf16_t* qraw; bf16_t* kraw; bf16_t* ctxv; bf16_t* latv; float* outv; const float* ssq; const float* sw;
    __device__ __forceinline__ void operator()(const f32x4 (&acc)[2][2][4][2], const pg8::Unit& u, int wr, int wc, int fr, int fq) const {
        const int row0 = u.pm * 256 + wr * 64 + fr, lc = wc * 32 + 8 * fq; const int cls = cls_of(u.pm * 256); const float* swr = sw + (size_t)cls * CIN;
        float rs[2][4];
#pragma unroll
        for (int ai = 0; ai < 2; ++ai)
#pragma unroll
            for (int m = 0; m < 4; ++m) rs[ai][m] = 1.0f / sqrtf(ssq[row0 + ai * 128 + m * 16] * (1.0f / DM) + EPSF);
#pragma unroll
        for (int bj = 0; bj < 2; ++bj) { const int col = 256 * u.pn + 128 * bj + lc; const f32x4 s0 = *(const f32x4*)(swr + col), s1 = *(const f32x4*)(swr + col + 4);
#pragma unroll
            for (int ai = 0; ai < 2; ++ai)
#pragma unroll
                for (int m = 0; m < 4; ++m) { const int row = row0 + ai * 128 + m * 16; const f32x4 v0 = acc[ai][bj][m][0] * rs[ai][m] + s0, v1 = acc[ai][bj][m][1] * rs[ai][m] + s1;
                    v4u w; w.x = pg8::cvt_pk_bf16(v0[0], v0[1]); w.y = pg8::cvt_pk_bf16(v0[2], v0[3]); w.z = pg8::cvt_pk_bf16(v1[0], v1[1]); w.w = pg8::cvt_pk_bf16(v1[2], v1[3]);
                    if (u.pn < NQ * HDIM / 256) *(v4u*)(qraw + (size_t)row * (NQ * HDIM) + col) = w;
                    else if (u.pn == NQ * HDIM / 256) *(v4u*)(kraw + (size_t)row * (NKV * HDIM) + (col - NQ * HDIM)) = w;
                    else { const int c2 = col - (NQ + NKV) * HDIM;
                        if (row < MC) { *(v4u*)(ctxv + (size_t)row * (NKV * HDIM) + c2) = w; float* o = outv + (size_t)row * (NKV * HDIM) + c2; *(f32x4*)o = v0; *(f32x4*)(o + 4) = v1; }
                        else { const int b = (row - MC) / LSEQ, s = (row - MC) % LSEQ; *(v4u*)(latv + ((size_t)b * SKVL + s) * (NKV * HDIM) + c2) = w; } } } }
    }
};
static_assert(NKV * HDIM == 256 && (NQ * HDIM) % 256 == 0, "EpiQkv tile mapping");

constexpr int CW_SPLIT = 8192;
constexpr size_t WS_SLAB_A = 110 * MiB, WS_SLAB_B = 220 * MiB;
struct RoundZeroOrder : pg8::StaticOrder {
    bool split;
    __device__ void init(int M, int N, int K, int G_, int c_) { pg8::StaticOrder::init(M, N, K, G_, c_); split = (G == 256 && nwg > 256 && nwg <= 320 && ntK >= 8); }
    __device__ bool next(int i, pg8::Unit& u) const { if (split && i > 0) return false; return pg8::StaticOrder::next(i, u); }
};
struct QuarterOrder : pg8::StaticOrder {
    __device__ bool next(int i, pg8::Unit& u) const {
        if (i > 0) return false; const int L = 256 + (c >> 2), q = c & 3; if (L >= nwg) return false;
        map(L, u); const int base = (ntK / 8) * 2, rem = (ntK - 4 * base) / 2;
        int k0 = 0; for (int j = 0; j < q; ++j) k0 += base + (j < rem ? 2 : 0);
        u.k0 = k0; u.nt = base + (q < rem ? 2 : 0); u.role = 1 + q; u.slot = c >> 2; return true;
    }
};
struct EpiPartial {
    static constexpr bool PERM = false, AFTER_DRAIN = false;
    unsigned char* slab; unsigned* cnt;
    __device__ __forceinline__ void operator()(const f32x4 (&acc)[2][2][4][2], const pg8::Unit& u, int wr, int wc, int fr, int fq) const {
        const int tid = (wr * 4 + wc) * 64 + fq * 16 + fr;
        unsigned char* dst = slab + ((size_t)u.slot * 4 + (u.role - 1)) * (16 * 512 * 16) + (size_t)tid * 16;
#pragma unroll
        for (int ai = 0; ai < 2; ++ai)
#pragma unroll
            for (int bj = 0; bj < 2; ++bj)
#pragma unroll
                for (int m = 0; m < 4; ++m) { const f32x4 a = acc[ai][bj][m][0], b = acc[ai][bj][m][1]; v4u w;
                    w.x = pg8::cvt_pk_bf16(a[0], a[1]); w.y = pg8::cvt_pk_bf16(a[2], a[3]); w.z = pg8::cvt_pk_bf16(b[0], b[1]); w.w = pg8::cvt_pk_bf16(b[2], b[3]);
                    asm volatile("global_store_dwordx4 %0, %1, off sc1\n\ts_nop 1" :: "v"(dst), "v"(w) : "memory");
                    dst += 512 * 16; asm volatile("" : "+v"(dst)); }
        asm volatile("s_waitcnt vmcnt(0)" ::: "memory");
        if (fr == 0 && fq == 0) __hip_atomic_fetch_add(cnt + (size_t)u.slot * 64, 1u, __ATOMIC_RELAXED, __HIP_MEMORY_SCOPE_AGENT);
    }
};
__device__ __forceinline__ void tail_reduce(const EpiRes& E, const unsigned char* slab, unsigned* cnt, int G, int bx, int nN, int nM) {
    pg8::StaticOrder S; S.nM = nM; S.nN = nN; S.nwg = nM * nN; S.G = G; S.c = bx; S.ntK = 0;
    const int L = 256 + (bx >> 2), q = bx & 3; if (L >= S.nwg) return;
    pg8::Unit u; S.map(L, u); const int slot = bx >> 2, ai = q >> 1, bj = q & 1;
    const int tid = tid_opaque(), wid = tid >> 6, lane = tid & 63, wr = wid >> 2, wc = wid & 3, fr = lane & 15, fq = lane >> 4;
    unsigned* c = cnt + (size_t)slot * 64; unsigned spins = 0;
    while ((unsigned)__builtin_amdgcn_readfirstlane(__hip_atomic_load(c, __ATOMIC_RELAXED, __HIP_MEMORY_SCOPE_AGENT)) < 32u) { __builtin_amdgcn_s_sleep(2); if (++spins > (1u << 22)) break; }
    __builtin_amdgcn_fence(__ATOMIC_ACQUIRE, "agent");
    const unsigned char* base = slab + (size_t)slot * 4 * (16 * 512 * 16) + (size_t)tid * 16;
    v4u w[4][4];
#pragma unroll
    for (int m = 0; m < 4; ++m)
#pragma unroll
        for (int r = 0; r < 4; ++r) w[m][r] = *(const v4u*)(base + (size_t)r * (16 * 512 * 16) + (size_t)((ai * 2 + bj) * 4 + m) * (512 * 16));
    const int row0 = u.pm * 256 + ai * 128 + wr * 64 + fr; const int cls = cls_of(u.pm * 256);
    const float* xin = E.from_input ? (u.pm * 256 < MC ? E.xp : E.xs - (size_t)MC * DM) : E.Y;
    const float* gv = E.mod_g + (size_t)cls * 6 * DM; const float* scv = E.mod_sc + (size_t)cls * 6 * DM;
#pragma unroll
    for (int m = 0; m < 4; ++m) { const int row = row0 + m * 16; float sq = 0.f; f32x4 v[2] = {(f32x4){0.f, 0.f, 0.f, 0.f}, (f32x4){0.f, 0.f, 0.f, 0.f}};
#pragma unroll
        for (int r = 0; r < 4; ++r) { const v4u x = w[m][r]; v[0] += (f32x4){__uint_as_float(x.x << 16), __uint_as_float(x.x & 0xffff0000u), __uint_as_float(x.y << 16), __uint_as_float(x.y & 0xffff0000u)};
            v[1] += (f32x4){__uint_as_float(x.z << 16), __uint_as_float(x.z & 0xffff0000u), __uint_as_float(x.w << 16), __uint_as_float(x.w & 0xffff0000u)}; }
#pragma unroll
        for (int n = 0; n < 2; ++n) { const int col = u.pn * 256 + bj * 128 + wc * 32 + n * 16 + 4 * fq; const size_t off = (size_t)row * DM + col;
            const f32x4 g4 = *(const f32x4*)(gv + col); const f32x4 xi = *(const f32x4*)(xin + off); const f32x4 xn = xi + g4 * v[n];
            *(f32x4*)(E.Y + off) = xn; sq += (xn[0] * xn[0] + xn[1] * xn[1]) + (xn[2] * xn[2] + xn[3] * xn[3]);
            if (E.ng) { const f32x4 n4 = *(const f32x4*)(E.ng + col), s4 = *(const f32x4*)(scv + col); const f32x4 t = xn * (n4 * (s4 + 1.0f)); v2u ww; ww.x = pg8::cvt_pk_bf16(t[0], t[1]); ww.y = pg8::cvt_pk_bf16(t[2], t[3]); *(v2u*)(E.XN + off) = ww; } }
        sq += __shfl_xor(sq, 16); sq += __shfl_xor(sq, 32); if (fq == 0) atomicAdd(E.ssq + row, sq); }
}
namespace att {
typedef unsigned short bf16;
constexpr int D = 128, NW = 8, QBLK = 32, KVBLK = 64; constexpr float SCALE = 0.088388347648318440f; constexpr float THR = 8.f; constexpr int SDEPTH = 1;
constexpr int LDQ = NQ * HDIM, LDK = NKV * HDIM, LDO = DM;
constexpr size_t SHM_V = KVBLK * D * 2, SHM_K = KVBLK * D * 2, SHM_ATTN = 2 * SHM_V + 2 * SHM_K + NW * 64 * 4;
using bf16x8 = __attribute__((ext_vector_type(8))) short;
using s16x4  = __attribute__((ext_vector_type(4))) short;
using f32x16 = __attribute__((ext_vector_type(16))) float;
using f32x8  = __attribute__((ext_vector_type(8))) float;
using u32x4  = __attribute__((ext_vector_type(4))) unsigned;
#define KSWZ(row, colB) ((row) * 256 + ((colB) ^ (((row) & 7) << 4)))
#define SBAR() __builtin_amdgcn_sched_barrier(0)
__device__ __forceinline__ int crow(int r, int hi) { return (r & 3) + 8 * (r >> 2) + 4 * hi; }
__device__ __forceinline__ unsigned cvtpk(float lo, float hi) {
  unsigned r; asm volatile("v_cvt_pk_bf16_f32 %0, %1, %2" : "=v"(r) : "v"(lo), "v"(hi)); return r;
}
template <typename TIn> struct Stage;
template <> struct Stage<bf16>  { using T = bf16x8;
  __device__ static __forceinline__ T ld8(const bf16* p) { return *reinterpret_cast<const bf16x8*>(p); }
  __device__ static __forceinline__ bf16x8 tobf(T x) { return x; } };
__device__ __forceinline__ void partialSM(f32x16& p0, f32x16& p1, float& m_reg, float& mn, float& alpha) {
  constexpr float C = SCALE * 1.4426950408889634f;
  float pmax = p0[0]; for (int r = 1; r < 16; ++r) pmax = fmaxf(pmax, p0[r]); for (int r = 0; r < 16; ++r) pmax = fmaxf(pmax, p1[r]);
  { auto rr = __builtin_amdgcn_permlane32_swap(__float_as_uint(pmax), __float_as_uint(pmax), false, false);
    pmax = fmaxf(__uint_as_float(rr[0]), __uint_as_float(rr[1])); }
  if (__builtin_expect(__all(pmax - m_reg <= THR / SCALE), 1)) { mn = m_reg; alpha = 1.f; }
  else { mn = fmaxf(m_reg, pmax); alpha = __builtin_amdgcn_exp2f((m_reg - mn) * C); m_reg = mn; }
  float mnC = -mn * C;
  for (int r = 0; r < 16; ++r) p0[r] = fmaf(p0[r], C, mnC); for (int r = 0; r < 16; ++r) p1[r] = fmaf(p1[r], C, mnC);
  for (int r = 0; r < 16; ++r) p0[r] = __builtin_amdgcn_exp2f(p0[r]);
}
__device__ __forceinline__ void finishSM(f32x16& p0, f32x16& p1, float alpha, float& l_reg, bf16x8& pa0, bf16x8& pa1, bf16x8& pa2, bf16x8& pa3) {
  for (int r = 0; r < 16; ++r) p1[r] = __builtin_amdgcn_exp2f(p1[r]);
  float ps = 0; for (int r = 0; r < 16; ++r) ps += p0[r]; for (int r = 0; r < 16; ++r) ps += p1[r];
  { auto rr = __builtin_amdgcn_permlane32_swap(__float_as_uint(ps), __float_as_uint(ps), false, false);
    ps = __uint_as_float(rr[0]) + __uint_as_float(rr[1]); }
  l_reg = l_reg * alpha + ps;
#define PK4(P, BASE, OUT) do { unsigned a0 = cvtpk(P[BASE + 0], P[BASE + 1]), a1 = cvtpk(P[BASE + 2], P[BASE + 3]);   \
    unsigned b0 = cvtpk(P[BASE + 4], P[BASE + 5]), b1 = cvtpk(P[BASE + 6], P[BASE + 7]);                              \
    auto r0 = __builtin_amdgcn_permlane32_swap(a0, b0, false, false); auto r1 = __builtin_amdgcn_permlane32_swap(a1, b1, false, false); \
    u32x4 w = {r0[0], r1[0], r0[1], r1[1]}; OUT = *reinterpret_cast<bf16x8*>(&w); } while (0)
  PK4(p0, 0, pa0); PK4(p0, 8, pa1); PK4(p1, 0, pa2); PK4(p1, 8, pa3);
#undef PK4
}
__device__ __forceinline__ void qkt(f32x16& p0, f32x16& p1, const bf16* Ks, const bf16x8* qr, int r32, int hi) {
  p0 = f32x16{}; p1 = f32x16{};
  for (int d0 = 0; d0 < 8; ++d0) { int cb = (d0 * 16 + hi * 8) * 2;
    bf16x8 b0 = *reinterpret_cast<const bf16x8*>((const char*)Ks + KSWZ(r32, cb));
    bf16x8 b1 = *reinterpret_cast<const bf16x8*>((const char*)Ks + KSWZ(32 + r32, cb));
    p0 = __builtin_amdgcn_mfma_f32_32x32x16_bf16(b0, qr[d0], p0, 0, 0, 0);
    p1 = __builtin_amdgcn_mfma_f32_32x32x16_bf16(b1, qr[d0], p1, 0, 0, 0); }
}
__device__ __forceinline__ int v_st(int k, int c) { const int kk = (k & ~0xC) | ((k & 4) << 1) | ((k & 8) >> 1); return ((kk >> 3) * 4 + (c >> 5)) * 512 + ((kk & 7) * 32 + (c & 31)) * 2; }
__device__ __forceinline__ int v_rd_base(int lane) { return ((lane & 3) << 3) | (((lane >> 2) & 3) << 6) | (((lane >> 4) & 1) << 5) | (((lane >> 5) & 1) << 8); }
constexpr int v_rd_off(int d0, int ks, int half) { return d0 * 512 + ks * 4096 + half * 2048; }
template <int OFF> __device__ __forceinline__ s16x4 tr_read(int vb) {
  s16x4 r; asm volatile("ds_read_b64_tr_b16 %0, %1 offset:%2" : "=&v"(r) : "v"(vb), "i"(OFF) : "memory"); return r;
}
template <int D0> __device__ __forceinline__ void pv_one(f32x16& od, int vb, bf16x8 pa0, bf16x8 pa1, bf16x8 pa2, bf16x8 pa3) {
  const s16x4 l0 = tr_read<v_rd_off(D0, 0, 0)>(vb), h0 = tr_read<v_rd_off(D0, 0, 1)>(vb), l1 = tr_read<v_rd_off(D0, 1, 0)>(vb), h1 = tr_read<v_rd_off(D0, 1, 1)>(vb);
  const s16x4 l2 = tr_read<v_rd_off(D0, 2, 0)>(vb), h2 = tr_read<v_rd_off(D0, 2, 1)>(vb), l3 = tr_read<v_rd_off(D0, 3, 0)>(vb), h3 = tr_read<v_rd_off(D0, 3, 1)>(vb);
  asm volatile("s_waitcnt lgkmcnt(0)" ::: "memory"); SBAR();
#define PK(L, H) (bf16x8){L[0], L[1], L[2], L[3], H[0], H[1], H[2], H[3]}
  od = __builtin_amdgcn_mfma_f32_32x32x16_bf16(pa0, PK(l0, h0), od, 0, 0, 0);
  od = __builtin_amdgcn_mfma_f32_32x32x16_bf16(pa1, PK(l1, h1), od, 0, 0, 0);
  od = __builtin_amdgcn_mfma_f32_32x32x16_bf16(pa2, PK(l2, h2), od, 0, 0, 0);
  od = __builtin_amdgcn_mfma_f32_32x32x16_bf16(pa3, PK(l3, h3), od, 0, 0, 0);
#undef PK
}
__device__ __forceinline__ void pv_d0(f32x16* o, int vb, bf16x8 pa0, bf16x8 pa1, bf16x8 pa2, bf16x8 pa3) {
  pv_one<0>(o[0], vb, pa0, pa1, pa2, pa3); pv_one<1>(o[1], vb, pa0, pa1, pa2, pa3); pv_one<2>(o[2], vb, pa0, pa1, pa2, pa3); pv_one<3>(o[3], vb, pa0, pa1, pa2, pa3);
}

__device__ __forceinline__ void attn_dense_body(const bf16* __restrict__ Qb, const bf16* __restrict__ Kh, const bf16* __restrict__ Vh,
                                                bf16* __restrict__ Ob, int seq, char* lds) {
  typedef bf16 TQ;
  using St = Stage<bf16>; using SQ = Stage<TQ>;
  const int tid = tid_opaque(), wid = tid >> 6, lane = tid & 63, r32 = lane & 31, hi = lane >> 5;
  bf16* V_lds = (bf16*)lds; bf16* K_lds = (bf16*)(lds + 2 * SHM_V);
  float* ws = (float*)(lds + 2 * SHM_V + 2 * SHM_K) + wid * 64; float* li_l = ws; float* al_l = ws + 32;
  float m_reg = -1e30f, l_reg = 0; f32x16 o[4] = {}; bf16x8 qr[8];
  const TQ* Qw = Qb + (long)(wid * QBLK + r32) * LDQ + hi * 8;
#pragma unroll
  for (int d0 = 0; d0 < 8; ++d0) qr[d0] = SQ::tobf(SQ::ld8(Qw + d0 * 16));
  const int sr = tid >> 4, sc = (tid & 15) * 8, vst0 = v_st(sr, sc), vst1 = v_st(32 + sr, sc);
  const int vb0 = (int)(uintptr_t)V_lds + v_rd_base(lane);
  struct { typename St::T vs0, vs1, ks0, ks1; } sr_[SDEPTH];
#define SLOAD(i, k0) do { sr_[i].vs0 = St::ld8(&Vh[(long)((k0) + sr) * LDK + sc]); sr_[i].vs1 = St::ld8(&Vh[(long)((k0) + 32 + sr) * LDK + sc]); \
    sr_[i].ks0 = St::ld8(&Kh[(long)((k0) + sr) * LDK + sc]); sr_[i].ks1 = St::ld8(&Kh[(long)((k0) + 32 + sr) * LDK + sc]); } while (0)
#define SWRITE(b, i) do { *(bf16x8*)((char*)V_lds + (b) * SHM_V + vst0) = St::tobf(sr_[i].vs0);          \
    *(bf16x8*)((char*)V_lds + (b) * SHM_V + vst1) = St::tobf(sr_[i].vs1); int kc = sc * 2;               \
    *(bf16x8*)((char*)K_lds + (b) * SHM_K + KSWZ(sr, kc)) = St::tobf(sr_[i].ks0);                       \
    *(bf16x8*)((char*)K_lds + (b) * SHM_K + KSWZ(32 + sr, kc)) = St::tobf(sr_[i].ks1); } while (0)
#define SWAIT() do { if constexpr (SDEPTH == 2) asm volatile("s_waitcnt vmcnt(4)" ::: "memory"); else asm volatile("s_waitcnt vmcnt(0)" ::: "memory"); } while (0)
#define RESC(a) do { if (__any((a) < 1.f)) { if (hi == 0) al_l[r32] = (a); asm volatile("s_waitcnt lgkmcnt(0)" ::: "memory"); \
    for (int d = 0; d < 4; ++d) for (int r = 0; r < 16; ++r) o[d][r] *= al_l[crow(r, hi)]; } } while (0)
  f32x16 pA0, pA1, pB0, pB1; float mnA, mnB, alA, alB; bf16x8 pa0, pa1, pa2, pa3; const int NT = seq / KVBLK;
  constexpr int SE = 0, SO = SDEPTH - 1;
  SLOAD(SE, 0); asm volatile("s_waitcnt vmcnt(0)" ::: "memory"); SWRITE(0, SE); __syncthreads();
  qkt(pA0, pA1, K_lds, qr, r32, hi); partialSM(pA0, pA1, m_reg, mnA, alA);
  SLOAD(SO, KVBLK); if constexpr (SDEPTH == 2) { if (2 < NT) SLOAD(SE, 2 * KVBLK); }
  SWAIT(); SWRITE(1, SO); __syncthreads();
  for (int j = 1; j + 1 < NT; j += 2) {
    SBAR(); qkt(pB0, pB1, (bf16*)((char*)K_lds + SHM_K), qr, r32, hi);
    finishSM(pA0, pA1, alA, l_reg, pa0, pa1, pa2, pa3); SBAR();
    SLOAD(SO, (j + SDEPTH) * KVBLK); SBAR();
    pv_d0(o, vb0, pa0, pa1, pa2, pa3); partialSM(pB0, pB1, m_reg, mnB, alB);
    __syncthreads(); SWAIT(); SWRITE(0, SE);
    RESC(alB); __syncthreads();
    SBAR(); qkt(pA0, pA1, K_lds, qr, r32, hi);
    finishSM(pB0, pB1, alB, l_reg, pa0, pa1, pa2, pa3); SBAR();
    if (SDEPTH == 1 || j + 3 < NT) SLOAD(SE, (j + 1 + SDEPTH) * KVBLK); SBAR();
    pv_d0(o, vb0 + (int)SHM_V, pa0, pa1, pa2, pa3); partialSM(pA0, pA1, m_reg, mnA, alA);
    __syncthreads(); SWAIT(); SWRITE(1, SO);
    RESC(alA); __syncthreads();
  }
  SBAR(); qkt(pB0, pB1, (bf16*)((char*)K_lds + SHM_K), qr, r32, hi);
  finishSM(pA0, pA1, alA, l_reg, pa0, pa1, pa2, pa3); SBAR();
  pv_d0(o, vb0, pa0, pa1, pa2, pa3); partialSM(pB0, pB1, m_reg, mnB, alB);
  __syncthreads(); RESC(alB);
  finishSM(pB0, pB1, alB, l_reg, pa0, pa1, pa2, pa3); SBAR();
  pv_d0(o, vb0 + (int)SHM_V, pa0, pa1, pa2, pa3);
  if (hi == 0) li_l[r32] = l_reg; asm volatile("s_waitcnt lgkmcnt(0)" ::: "memory");
  float rli[16];
#pragma unroll
  for (int r = 0; r < 16; ++r) rli[r] = __builtin_amdgcn_rcpf(li_l[crow(r, hi)]);
  bf16* Ow = Ob + (long)(wid * QBLK) * LDO;
#pragma unroll
  for (int r = 0; r < 16; ++r) { int orow = crow(r, hi);
    for (int d0 = 0; d0 < 4; ++d0) Ow[(long)orow * LDO + d0 * 32 + r32] = f2bf(o[d0][r] * rli[r]); }
#undef SLOAD
#undef SWRITE
#undef SWAIT
#undef RESC
}
}
__device__ __forceinline__ void attn_phase(const Params& p, unsigned char* lds, int vcu, int G) {
    constexpr int QB = 256, LQB = LSEQ / QB, CQB = CSEQ / QB;
    constexpr int NUL = NLB * NQ * LQB, NUC = NCB * NQ * CQB, NU = NUL + NUC;
    const att::bf16* QR = (const att::bf16*)(p.ws + WS_QRAW); att::bf16* OB = (att::bf16*)(p.ws + WS_O);
    for (int i = 0;; ++i) {
        int u;
        if (G == 256 && NUL == 512) { if (i < 2) u = (vcu >> 5) * 64 + (vcu & 31) + 32 * i; else u = NUL + vcu + (i - 2) * G; }
        else u = vcu + i * G;
        if (u >= NU) break;
        const att::bf16 *Q, *K, *V; att::bf16* O; int seq;
        if (u < NUL) { const int grp = u / (GRP * LQB), j = u % (GRP * LQB); const int b = grp / NKV, kvh = grp % NKV, g = j / LQB, qb = j % LQB, hq = kvh * GRP + g;
            const size_t row0 = (size_t)MC + (size_t)b * LSEQ + (size_t)qb * QB;
            Q = QR + row0 * (NQ * HDIM) + hq * HDIM; O = OB + row0 * DM + hq * HDIM;
            K = (const att::bf16*)(p.ws + WS_LATK) + (size_t)b * SKVL * (NKV * HDIM) + kvh * HDIM; V = (const att::bf16*)(p.ws + WS_LATV) + (size_t)b * SKVL * (NKV * HDIM) + kvh * HDIM; seq = SKVL; }
        else { const int uc = u - NUL; const int b = uc / (NQ * CQB), r = uc % (NQ * CQB), hq = r / CQB, qb = r % CQB, kvh = hq / GRP;
            const size_t row0 = (size_t)b * CSEQ + (size_t)qb * QB;
            Q = QR + row0 * (NQ * HDIM) + hq * HDIM; O = OB + row0 * DM + hq * HDIM;
            K = (const att::bf16*)(p.ws + WS_CTXK) + (size_t)b * CSEQ * (NKV * HDIM) + kvh * HDIM; V = (const att::bf16*)(p.ws + WS_CTXV) + (size_t)b * CSEQ * (NKV * HDIM) + kvh * HDIM; seq = CSEQ; }
        __syncthreads();
        att::attn_dense_body(Q, K, V, O, seq, (char*)lds);
    }
}
static_assert(SKVL % 128 == 0 && CSEQ % 128 == 0 && LSEQ % 256 == 0 && CSEQ % 256 == 0, "attention tiling");
constexpr size_t WS_CST = 232 * MiB;
constexpr int NBLK = LSEQ / 256;
constexpr size_t WS_NST = WS_CST + (size_t)NLB * MH * 2 * NBLK * MDK * MDK * 2;
constexpr size_t WS_FTOT = WS_NST + (size_t)NLB * MH * 2 * NBLK * MDK * 4;
static_assert(WS_FTOT + (size_t)NLB * MH * 2 * NBLK * 4 <= WS_END && MDK == 128 && CSEQ == 256 && LSEQ % 256 == 0, "mLSTM fast path geometry");
namespace att {
constexpr int ML_OFF = 132096;
constexpr int ML_SC = ML_OFF + 6144;
constexpr int ML_N = ML_SC + 128;
constexpr int ML_LI = ML_N + 1024;
static_assert(ML_LI + 1024 <= LDS_BYTES, "mLSTM LDS map");
constexpr float L2E = 1.4426950408889634f;
using f32x4v = __attribute__((ext_vector_type(4))) float;


__device__ __forceinline__ void ml_gates(const Params& p, char* lds, int row0, int h, int tid) {
    float* A = (float*)(lds + ML_OFF); float* S = (float*)(lds + ML_SC);
    const int half = tid >> 8, t = tid & 255, tok = half ? 255 - t : t, lane = tid & 63, wv = (tid >> 6) & 3;
    const float* G = (const float*)(p.ws + WS_GATES) + (size_t)(row0 + tok) * NGATE + half * 8 + h;
    const float ig = G[0], lf = G[4];
    float v = lf;
#pragma unroll
    for (int off = 1; off < 64; off <<= 1) { const float u = lane_get(v, lane - off); if (lane >= off) v += u; }
    if (lane == 63) S[4 + half * 4 + wv] = v;
    __syncthreads();
    float pre = 0.f, tot = 0.f;
#pragma unroll
    for (int w = 0; w < 4; ++w) { const float x = S[4 + half * 4 + w]; if (w < wv) pre += x; tot += x; }
    const float P = v + pre, a = ig - P;
    A[(0 + half) * 256 + tok] = P * L2E; A[(2 + half) * 256 + tok] = a * L2E; A[(4 + half) * 256 + tok] = __builtin_amdgcn_exp2f(P * L2E);
    float mx = a;
    mx = fmaxf(mx, swz_xor<1>(mx)); mx = fmaxf(mx, swz_xor<2>(mx)); mx = fmaxf(mx, swz_xor<4>(mx)); mx = fmaxf(mx, swz_xor<8>(mx)); mx = fmaxf(mx, swz_xor<16>(mx)); mx = half_max(mx);
    if (lane == 0) S[12 + half * 4 + wv] = mx;
    if (t == 0) S[half] = tot;
    __syncthreads();
    if (t == 0) S[2 + half] = fmaxf(fmaxf(S[12 + half * 4], S[13 + half * 4]), fmaxf(S[14 + half * 4], S[15 + half * 4]));
    __syncthreads();
}
#define ML_PK(L, H) (bf16x8){L[0], L[1], L[2], L[3], H[0], H[1], H[2], H[3]}
__device__ __forceinline__ s16x4 tr_read_rt(int vb) { s16x4 r; asm volatile("ds_read_b64_tr_b16 %0, %1" : "=&v"(r) : "v"(vb) : "memory"); return r; }

__device__ __forceinline__ void ml_passA_unit(const Params& p, char* lds, int sid, int h, int blk) {
    const int tid = tid_opaque(), wid = tid >> 6, lane = tid & 63, r32 = lane & 31, hi = lane >> 5;
    const bool isctx = sid < NCB; const int row0 = seq_base(sid) + 256 * blk;
    __syncthreads();
    ml_gates(p, lds, row0, h, tid);
    float* A = (float*)(lds + ML_OFF); float* S = (float*)(lds + ML_SC); float* NA = (float*)(lds + ML_N);
    const bf16* QK = (const bf16*)(p.ws + WS_QKVO) + (size_t)row0 * (4 * MW) + h * MDK;
    const int sr = tid >> 4, sc8 = (tid & 15) * 8;
    { bf16x8 tv[8];
#pragma unroll
      for (int i = 0; i < 8; ++i) tv[i] = *(const bf16x8*)(QK + (size_t)(32 * i + sr) * (4 * MW) + 2 * MW + sc8);
#pragma unroll
      for (int i = 0; i < 8; ++i) *(bf16x8*)(lds + 65536 + (i >> 1) * 16384 + v_st(32 * (i & 1) + sr, sc8)) = tv[i]; }
    if (tid < 256) NA[tid] = 0.f;
    const int a = wid >> 1, dvb0 = 2 * (wid & 1);
    const int ldsb = (int)(uintptr_t)lds; const int vbK = ldsb + v_rd_base(lane) + a * 512, vbV = ldsb + 65536 + v_rd_base(lane) + dvb0 * 512;
    for (int dir = 0; dir < 2; ++dir) {
        __syncthreads();
        const float ft = S[dir], am = S[2 + dir]; const float mT = isctx ? ft + fmaxf(am, 0.f) : 0.f; const float wl2 = (ft - mT) * L2E;
        float xs[8];
#pragma unroll
        for (int i = 0; i < 8; ++i) xs[i] = 0.f;
        bf16x8 tk[8];
#pragma unroll
        for (int i = 0; i < 8; ++i) tk[i] = *(const bf16x8*)(QK + (size_t)(32 * i + sr) * (4 * MW) + MW + sc8);
#pragma unroll
        for (int j = 0; j < 4; ++j)
#pragma unroll
            for (int hf = 0; hf < 2; ++hf) { const int row = 64 * j + 32 * hf + sr; const float w = __builtin_amdgcn_exp2f(wl2 + A[(2 + dir) * 256 + row]);
                const bf16x8 k8 = tk[2 * j + hf]; float x[8];
#pragma unroll
                for (int i = 0; i < 8; ++i) { x[i] = bf2f((unsigned short)k8[i]) * w; xs[i] += x[i]; }
                u32x4 pk = {cvtpk(x[0], x[1]), cvtpk(x[2], x[3]), cvtpk(x[4], x[5]), cvtpk(x[6], x[7])};
                *(u32x4*)(lds + j * 16384 + v_st(32 * hf + sr, sc8)) = pk; }
#pragma unroll
        for (int i = 0; i < 8; ++i) { float v = xs[i]; v += swz_xor<16>(v); v = half_sum(v); if (lane < 16) atomicAdd(&NA[dir * 128 + sc8 + i], v); }
        __syncthreads();
        f32x16 acc0 = {}, acc1 = {}; const unsigned eoff = (unsigned)((32 * a + 4 * hi) * MDK + 32 * dvb0 + r32);
#pragma unroll
        for (int j = 0; j < 4; ++j)
#pragma unroll
            for (int ks = 0; ks < 4; ++ks) { const int off = j * 16384 + ks * 4096;
                const s16x4 al = tr_read_rt(vbK + off), ah = tr_read_rt(vbK + off + 2048);
                const s16x4 bl0 = tr_read_rt(vbV + off), bh0 = tr_read_rt(vbV + off + 2048), bl1 = tr_read_rt(vbV + off + 512), bh1 = tr_read_rt(vbV + off + 512 + 2048);
                asm volatile("s_waitcnt lgkmcnt(0)" ::: "memory"); SBAR();
                acc0 = __builtin_amdgcn_mfma_f32_32x32x16_bf16(ML_PK(al, ah), ML_PK(bl0, bh0), acc0, 0, 0, 0);
                acc1 = __builtin_amdgcn_mfma_f32_32x32x16_bf16(ML_PK(al, ah), ML_PK(bl1, bh1), acc1, 0, 0, 0); }
        if (isctx) {
            float* Co = p.out + O_C + ((size_t)(sid * 2 + dir) * MH + h) * MDK * MDK;
#pragma unroll
            for (int r = 0; r < 16; ++r) { const unsigned eo = eoff + (unsigned)(((r & 3) + 8 * (r >> 2)) * MDK); Co[eo] = acc0[r]; Co[eo + 32] = acc1[r]; }
            if (tid == 0) p.out[O_M + (size_t)(sid * 2 + dir) * MH + h] = mT;
        } else {
            const int b = sid - NCB; bf16* Cs = (bf16*)(p.ws + WS_CST) + ((size_t)((b * MH + h) * 2 + dir) * NBLK + blk) * MDK * MDK;
#pragma unroll
            for (int r = 0; r < 16; ++r) { const unsigned eo = eoff + (unsigned)(((r & 3) + 8 * (r >> 2)) * MDK); Cs[eo] = f2bf(acc0[r]); Cs[eo + 32] = f2bf(acc1[r]); }
            if (tid == 0) ((float*)(p.ws + WS_FTOT))[((size_t)(b * MH + h) * 2 + dir) * NBLK + blk] = ft;
        }
    }
    __syncthreads();
    if (tid < 256) { const int dir = tid >> 7, d = tid & 127;
        if (isctx) p.out[O_N + ((size_t)(sid * 2 + dir) * MH + h) * MDK + d] = NA[tid];
        else { const int b = sid - NCB; ((float*)(p.ws + WS_NST))[(((size_t)(b * MH + h) * 2 + dir) * NBLK + blk) * MDK + d] = NA[tid]; } }
}

template <int DIR> __device__ __forceinline__ void ml_tile(f32x16* o, float& den, const bf16x8* qr, const char* Ktile, int vbV, const float* AL2, int j, float cq, int trow, bool diag, int r32, int hi) {
    SBAR(); f32x16 p0, p1; qkt(p0, p1, (const bf16*)Ktile, qr, r32, hi); SBAR();
    float ds = 0.f; const int tl = trow - 64 * j - 4 * hi;
#pragma unroll
    for (int g = 0; g < 4; ++g) { const f32x4v a0 = *(const f32x4v*)(AL2 + 64 * j + 8 * g + 4 * hi), a1 = *(const f32x4v*)(AL2 + 64 * j + 32 + 8 * g + 4 * hi);
#pragma unroll
        for (int e = 0; e < 4; ++e) { float w0 = __builtin_amdgcn_exp2f(cq + a0[e]), w1 = __builtin_amdgcn_exp2f(cq + a1[e]);
            if (diag) { if (DIR == 0 ? (8 * g + e > tl) : (8 * g + e < tl)) w0 = 0.f; if (DIR == 0 ? (8 * g + e + 32 > tl) : (8 * g + e + 32 < tl)) w1 = 0.f; }
            p0[4 * g + e] *= w0; p1[4 * g + e] *= w1; ds += p0[4 * g + e] + p1[4 * g + e]; } }
    den += ds;
    bf16x8 pa0, pa1, pa2, pa3;
#define PK4(P, BASE, OUT) do { unsigned a0_ = cvtpk(P[BASE + 0], P[BASE + 1]), a1_ = cvtpk(P[BASE + 2], P[BASE + 3]);   \
    unsigned b0_ = cvtpk(P[BASE + 4], P[BASE + 5]), b1_ = cvtpk(P[BASE + 6], P[BASE + 7]);                              \
    auto r0_ = __builtin_amdgcn_permlane32_swap(a0_, b0_, false, false); auto r1_ = __builtin_amdgcn_permlane32_swap(a1_, b1_, false, false); \
    u32x4 w_ = {r0_[0], r1_[0], r0_[1], r1_[1]}; OUT = *reinterpret_cast<bf16x8*>(&w_); } while (0)
    PK4(p0, 0, pa0); PK4(p0, 8, pa1); PK4(p1, 0, pa2); PK4(p1, 8, pa3);
#undef PK4
    SBAR(); pv_d0(o, vbV, pa0, pa1, pa2, pa3); SBAR();
}
__device__ __forceinline__ void ml_stage_kv(char* lds, const bf16* QK, int tile0, int sr, int sc8) {
    bf16x8 tk[4], tv[4];
#pragma unroll
    for (int i = 0; i < 4; ++i) { const int row = 64 * tile0 + 32 * i + sr; tk[i] = *(const bf16x8*)(QK + (size_t)row * (4 * MW) + MW + sc8); tv[i] = *(const bf16x8*)(QK + (size_t)row * (4 * MW) + 2 * MW + sc8); }
#pragma unroll
    for (int i = 0; i < 4; ++i) { const int jj = i >> 1, rl = 32 * (i & 1) + sr; *(bf16x8*)(lds + jj * 16384 + KSWZ(rl, sc8 * 2)) = tk[i]; *(bf16x8*)(lds + 32768 + jj * 16384 + v_st(rl, sc8)) = tv[i]; }
}
__device__ __forceinline__ void ml_passC_unit(const Params& p, char* lds, int sid, int h, int blk) {
    const int tid = tid_opaque(), wid = tid >> 6, lane = tid & 63, r32 = lane & 31, hi = lane >> 5;
    const bool isctx = sid < NCB; const int row0 = seq_base(sid) + 256 * blk; const int wq = wid >> 1;
    __syncthreads();
    ml_gates(p, lds, row0, h, tid);
    float* A = (float*)(lds + ML_OFF); float* NS = (float*)(lds + ML_N); float* li = (float*)(lds + ML_LI) + wid * 32;
    const bf16* QK = (const bf16*)(p.ws + WS_QKVO) + (size_t)row0 * (4 * MW) + h * MDK;
    const int sr = tid >> 4, sc8 = (tid & 15) * 8; const int b = sid - NCB;
    if (tid < 256) { const int dir = tid >> 7, d = tid & 127;
        NS[tid] = isctx ? 0.f : ((const float*)(p.ws + WS_NST))[(((size_t)(b * MH + h) * 2 + dir) * NBLK + blk) * MDK + d]; }
    if (!isctx) { bf16x8 tc[8];
#pragma unroll
        for (int i = 0; i < 8; ++i) { const int dir = i >> 2, c = tid + 512 * (i & 3); tc[i] = *(const bf16x8*)((const bf16*)(p.ws + WS_CST) + ((size_t)((b * MH + h) * 2 + dir) * NBLK + blk) * MDK * MDK + (size_t)c * 8); }
#pragma unroll
        for (int i = 0; i < 8; ++i) { const int dir = i >> 2, c = tid + 512 * (i & 3), row = c >> 4, col8 = (c & 15) * 8; *(bf16x8*)(lds + 65536 + dir * 32768 + (row >> 6) * 16384 + v_st(row & 63, col8)) = tc[i]; }
    }
    bf16x8 qr[8];
    { const bf16* Qw = QK + (size_t)(wid * 32 + r32) * (4 * MW) + hi * 8;
#pragma unroll
        for (int d0 = 0; d0 < 8; ++d0) qr[d0] = *(const bf16x8*)(Qw + d0 * 16); }
    ml_stage_kv(lds, QK, 0, sr, sc8);
    __syncthreads();
    float qn_f = 0.f, qn_b = 0.f;
#pragma unroll
    for (int d0 = 0; d0 < 8; ++d0)
#pragma unroll
        for (int i = 0; i < 8; ++i) { const float qv = bf2f((unsigned short)qr[d0][i]); qn_f += qv * NS[d0 * 16 + hi * 8 + i]; qn_b += qv * NS[128 + d0 * 16 + hi * 8 + i]; }
    qn_f = half_sum(qn_f); qn_b = half_sum(qn_b);
    const int ldsb = (int)(uintptr_t)lds; const int vbV = ldsb + 32768 + v_rd_base(lane), vbC = ldsb + 65536 + v_rd_base(lane);
    const int trow = wid * 32 + r32;
    float* HS = (float*)(p.ws + WS_HS) + (size_t)(row0 + wid * 32) * MW + h * MDK;
    f32x16 o[4]; const unsigned hso = (unsigned)(4 * hi * MW + r32), uho = (unsigned)(4 * hi * DM + r32), ogo = (unsigned)(4 * hi * 4 * MW + r32);
    {
        float qn = qn_f;
        o[0] = f32x16{}; o[1] = f32x16{}; o[2] = f32x16{}; o[3] = f32x16{};
        if (!isctx) { pv_d0(o, vbC, qr[0], qr[1], qr[2], qr[3]); pv_d0(o, vbC + 16384, qr[4], qr[5], qr[6], qr[7]);
#pragma unroll
            for (int r = 0; r < 16; ++r) { const float e = A[4 * 256 + wid * 32 + crow(r, hi)];
#pragma unroll
                for (int d0 = 0; d0 < 4; ++d0) o[d0][r] *= e; } }
        const float cq = A[0 * 256 + trow]; float den = 0.f;
        ml_tile<0>(o, den, qr, lds, vbV, A + 2 * 256, 0, cq, trow, wq == 0, r32, hi);
        if (wq >= 1) ml_tile<0>(o, den, qr, lds + 16384, vbV + 16384, A + 2 * 256, 1, cq, trow, wq == 1, r32, hi);
        __syncthreads(); ml_stage_kv(lds, QK, 2, sr, sc8); __syncthreads();
        if (wq >= 2) ml_tile<0>(o, den, qr, lds, vbV, A + 2 * 256, 2, cq, trow, wq == 2, r32, hi);
        if (wq >= 3) ml_tile<0>(o, den, qr, lds + 16384, vbV + 16384, A + 2 * 256, 3, cq, trow, wq == 3, r32, hi);
        { auto rr = __builtin_amdgcn_permlane32_swap(__float_as_uint(den), __float_as_uint(den), false, false); den = __uint_as_float(rr[0]) + __uint_as_float(rr[1]); }
        const float dn = den + __builtin_amdgcn_exp2f(cq) * qn; const float inv = 1.0f / fmaxf(fabsf(dn), 1.0f);
        if (hi == 0) li[r32] = inv; asm volatile("s_waitcnt lgkmcnt(0)" ::: "memory");
#pragma unroll
        for (int r = 0; r < 16; ++r) { const float rl = li[crow(r, hi)]; const unsigned eo = hso + (unsigned)(((r & 3) + 8 * (r >> 2)) * MW);
#pragma unroll
            for (int d0 = 0; d0 < 4; ++d0) HS[eo + d0 * 32] = o[d0][r] * rl;
            asm volatile("" ::: "memory"); }
    }
    {
        float qn = qn_b;
        o[0] = f32x16{}; o[1] = f32x16{}; o[2] = f32x16{}; o[3] = f32x16{};
        if (!isctx) { pv_d0(o, vbC + 32768, qr[0], qr[1], qr[2], qr[3]); pv_d0(o, vbC + 32768 + 16384, qr[4], qr[5], qr[6], qr[7]);
#pragma unroll
            for (int r = 0; r < 16; ++r) { const float e = A[5 * 256 + wid * 32 + crow(r, hi)];
#pragma unroll
                for (int d0 = 0; d0 < 4; ++d0) o[d0][r] *= e; } }
        const float cq = A[1 * 256 + trow]; float den = 0.f;
        ml_tile<1>(o, den, qr, lds + 16384, vbV + 16384, A + 3 * 256, 3, cq, trow, wq == 3, r32, hi);
        if (wq <= 2) ml_tile<1>(o, den, qr, lds, vbV, A + 3 * 256, 2, cq, trow, wq == 2, r32, hi);
        __syncthreads(); ml_stage_kv(lds, QK, 0, sr, sc8); __syncthreads();
        if (wq <= 1) ml_tile<1>(o, den, qr, lds + 16384, vbV + 16384, A + 3 * 256, 1, cq, trow, wq == 1, r32, hi);
        if (wq <= 0) ml_tile<1>(o, den, qr, lds, vbV, A + 3 * 256, 0, cq, trow, wq == 0, r32, hi);
        { auto rr = __builtin_amdgcn_permlane32_swap(__float_as_uint(den), __float_as_uint(den), false, false); den = __uint_as_float(rr[0]) + __uint_as_float(rr[1]); }
        const float dn = den + __builtin_amdgcn_exp2f(cq) * qn; const float inv = 1.0f / fmaxf(fabsf(dn), 1.0f);
        asm volatile("s_waitcnt vmcnt(0)" ::: "memory");
        if (hi == 0) li[r32] = inv; asm volatile("s_waitcnt lgkmcnt(0)" ::: "memory");
        float mg[4];
#pragma unroll
        for (int d0 = 0; d0 < 4; ++d0) mg[d0] = p.mng[h * MDK + d0 * 32 + r32];
        const bf16* OG = QK + (size_t)(wid * 32) * (4 * MW) + 3 * MW; bf16* UHo = (bf16*)(p.ws + WS_UH) + (size_t)(row0 + wid * 32) * DM + CCH + h * MDK;
#pragma unroll
        for (int r = 0; r < 16; ++r) { const float rl = li[crow(r, hi)]; const int rc = (r & 3) + 8 * (r >> 2); float ss = 0.f;
#pragma unroll
            for (int d0 = 0; d0 < 4; ++d0) { const float hf = __hip_atomic_load(HS + hso + (unsigned)(rc * MW + d0 * 32), __ATOMIC_RELAXED, __HIP_MEMORY_SCOPE_AGENT); const float x = hf + o[d0][r] * rl; o[d0][r] = x; ss += x * x; }
            ss += swz_xor<1>(ss); ss += swz_xor<2>(ss); ss += swz_xor<4>(ss); ss += swz_xor<8>(ss); ss += swz_xor<16>(ss);
            const float rs = 1.0f / sqrtf(ss * (1.0f / MDK) + EPSF);
#pragma unroll
            for (int d0 = 0; d0 < 4; ++d0) UHo[uho + (unsigned)(rc * DM + d0 * 32)] = f2bf(bf2f(OG[ogo + (unsigned)(rc * 4 * MW + d0 * 32)]) * o[d0][r] * rs * mg[d0]);
            asm volatile("" ::: "memory"); }
    }
}
}

template <int DIR> __device__ __forceinline__ void ml_scan_item(const Params& p, int ch, int b, int h, int e8) {
    const float em = expf(p.stm[(size_t)(b * 2 + DIR) * MH + h]); const float* FT = (const float*)(p.ws + WS_FTOT) + (size_t)ch * NBLK;
    float fd[NBLK];
#pragma unroll
    for (int i = 0; i < NBLK; ++i) fd[i] = expf(FT[i]);
    if (e8 < MDK * MDK) { bf16_t* Cs = (bf16_t*)(p.ws + WS_CST) + (size_t)ch * NBLK * MDK * MDK + e8; const float* c0 = p.stC + ((size_t)(b * 2 + DIR) * MH + h) * MDK * MDK + e8;
        v4u d[NBLK];
#pragma unroll
        for (int i = 0; i < NBLK; ++i) d[i] = *(const v4u*)(Cs + (size_t)i * MDK * MDK);
        const f32x4 ca = *(const f32x4*)c0, cb = *(const f32x4*)(c0 + 4); float c[8] = {ca[0] * em, ca[1] * em, ca[2] * em, ca[3] * em, cb[0] * em, cb[1] * em, cb[2] * em, cb[3] * em};
#pragma unroll
        for (int i = 0; i < NBLK; ++i) { const int blk = DIR == 0 ? i : NBLK - 1 - i; v4u o;
#pragma unroll
            for (int w = 0; w < 4; ++w) { const float lo = __uint_as_float(d[blk][w] << 16), hi = __uint_as_float(d[blk][w] & 0xffff0000u); o[w] = pg8::cvt_pk_bf16(c[2 * w], c[2 * w + 1]);
                c[2 * w] = fd[blk] * c[2 * w] + lo; c[2 * w + 1] = fd[blk] * c[2 * w + 1] + hi; }
            *(v4u*)(Cs + (size_t)blk * MDK * MDK) = o; } }
    else { const int d_ = e8 - MDK * MDK; float* Ns = (float*)(p.ws + WS_NST) + (size_t)ch * NBLK * MDK + d_; const float* n0 = p.stn + ((size_t)(b * 2 + DIR) * MH + h) * MDK + d_;
        f32x4 da[NBLK], db[NBLK];
#pragma unroll
        for (int i = 0; i < NBLK; ++i) { da[i] = *(const f32x4*)(Ns + (size_t)i * MDK); db[i] = *(const f32x4*)(Ns + (size_t)i * MDK + 4); }
        f32x4 ca = *(const f32x4*)n0 * em, cb = *(const f32x4*)(n0 + 4) * em;
#pragma unroll
        for (int i = 0; i < NBLK; ++i) { const int blk = DIR == 0 ? i : NBLK - 1 - i;
            *(f32x4*)(Ns + (size_t)blk * MDK) = ca; *(f32x4*)(Ns + (size_t)blk * MDK + 4) = cb; ca = ca * fd[blk] + da[blk]; cb = cb * fd[blk] + db[blk]; } }
}
struct MlScan {
    Params p; static HD_FN long count() { return (long)NLB * MH * 2 * ((MDK * MDK + MDK) / 8); }
    __device__ __forceinline__ void operator()(long idx) const {
        constexpr int per = (MDK * MDK + MDK) / 8; const int e8 = (int)(idx % per) * 8; const int ch = (int)(idx / per); const int dir = ch & 1, h = (ch >> 1) % MH, b = ch / (2 * MH);
        if (dir == 0) ml_scan_item<0>(p, ch, b, h, e8); else ml_scan_item<1>(p, ch, b, h, e8);
    }
};
__device__ __forceinline__ void ml_phase_A(const Params& p, unsigned char* lds, int vcu, int G) {
    constexpr int NUL = NLB * MH * NBLK, NU = NUL + NCB * MH;
    for (int u = vcu; u < NU; u += G) {
        if (u < NUL) att::ml_passA_unit(p, (char*)lds, NCB + u / (MH * NBLK), (u / NBLK) % MH, u % NBLK);
        else att::ml_passA_unit(p, (char*)lds, (u - NUL) / MH, (u - NUL) % MH, 0); }
}
__device__ __forceinline__ void ml_phase_C(const Params& p, unsigned char* lds, int vcu, int G) {
    constexpr int NUL = NLB * MH * NBLK, NU = NUL + NCB * MH;
    for (int u = vcu; u < NU; u += G) {
        if (u < NUL) att::ml_passC_unit(p, (char*)lds, NCB + u / (MH * NBLK), (u / NBLK) % MH, u % NBLK);
        else att::ml_passC_unit(p, (char*)lds, (u - NUL) / MH, (u - NUL) % MH, 0); }
}
typedef float f4 __attribute__((ext_vector_type(4)));
typedef unsigned u4 __attribute__((ext_vector_type(4)));
typedef unsigned u2 __attribute__((ext_vector_type(2)));
__device__ __forceinline__ float wave_sum64(float v) { v += swz_xor<1>(v); v += swz_xor<2>(v); v += swz_xor<4>(v); v += swz_xor<8>(v); v += swz_xor<16>(v); return half_sum(v); }
__device__ __forceinline__ float fsilu(float x) { return x * fsigmoid(x); }

__device__ __forceinline__ void phase_mod(const Params& p, char* lds, int bx, int G) {
    const int tid = tid_opaque(), lane = tid & 63, wave = tid >> 6;
    float* SL = (float*)lds; float* PT = (float*)(lds + 32768);
    constexpr int NCG = 6 * DM / 64, NIT = 2 * NCG;
    if (bx >= NIT) return;
    __syncthreads();
    for (int i = tid; i < NCLS * DM; i += NTHREADS) { const int cls = i / DM, k = i % DM; const float cv = cls == 0 ? p.cctx[k] : p.c[(size_t)(cls - 1) * DM + k]; SL[i] = fsilu(cv); }
    for (int item = bx; item < NIT; item += G) {
        __syncthreads();
        const int l = item / NCG, cg = item % NCG; const float* w = p.wmod + (size_t)l * DM * 6 * DM + cg * 64 + lane;
        float acc[NCLS];
#pragma unroll
        for (int r = 0; r < NCLS; ++r) acc[r] = 0.f;
        const int k0 = wave * (DM / 8);
#pragma unroll 8
        for (int k = k0; k < k0 + DM / 8; ++k) { const float wv = w[(size_t)k * 6 * DM];
#pragma unroll
            for (int r = 0; r < NCLS; ++r) acc[r] += SL[r * DM + k] * wv; }
#pragma unroll
        for (int r = 0; r < NCLS; ++r) PT[(wave * NCLS + r) * 64 + lane] = acc[r];
        __syncthreads();
        if (tid < NCLS * 64) { const int r = tid >> 6; float s = p.bmod[(size_t)l * 6 * DM + cg * 64 + lane];
#pragma unroll
            for (int w8 = 0; w8 < 8; ++w8) s += PT[(w8 * NCLS + r) * 64 + lane];
            ((float*)(p.ws + WS_MOD))[((size_t)(l * NCLS + r) * 6 * DM) + cg * 64 + lane] = s; }
    }
}
__device__ __forceinline__ void sw_job(const Params& p, const bf16_t* Bt, int nrows, int l, int which, float* sw, int N, int mode, int gw, int NGW, int lane) {
    for (int n = gw; n < nrows; n += NGW) {
        const u4 w0 = *(const u4*)(Bt + (size_t)n * DM + lane * 8), w1 = *(const u4*)(Bt + (size_t)n * DM + DM / 2 + lane * 8);
        float wf[16];
#pragma unroll
        for (int i = 0; i < 4; ++i) { wf[2 * i] = __uint_as_float(w0[i] << 16); wf[2 * i + 1] = __uint_as_float(w0[i] & 0xffff0000u); wf[8 + 2 * i] = __uint_as_float(w1[i] << 16); wf[8 + 2 * i + 1] = __uint_as_float(w1[i] & 0xffff0000u); }
        int col = n; if (mode == 1) { const int t = n >> 8, r = n & 255; col = r < 128 ? 128 * t + r : (N / 2) + 128 * t + (r - 128); }
#pragma unroll
        for (int cls = 0; cls < NCLS; ++cls) { const float* sh = modv(p, l, cls, which);
            const f4 a0 = *(const f4*)(sh + lane * 8), a1 = *(const f4*)(sh + lane * 8 + 4), b0 = *(const f4*)(sh + DM / 2 + lane * 8), b1 = *(const f4*)(sh + DM / 2 + lane * 8 + 4);
            float s = (a0[0] * wf[0] + a0[1] * wf[1]) + (a0[2] * wf[2] + a0[3] * wf[3]) + (a1[0] * wf[4] + a1[1] * wf[5]) + (a1[2] * wf[6] + a1[3] * wf[7])
                    + (b0[0] * wf[8] + b0[1] * wf[9]) + (b0[2] * wf[10] + b0[3] * wf[11]) + (b1[0] * wf[12] + b1[1] * wf[13]) + (b1[2] * wf[14] + b1[3] * wf[15]);
            s = wave_sum64(s); if (lane == 0) sw[(size_t)cls * N + col] = s; }
    }
}
static_assert(DM == 1024, "sw_job / norm passes assume 1024 = 64 lanes x 16");
__device__ __forceinline__ void phase_norm0(const Params& p, char* lds, int bx, int G) {
    const int tid = tid_opaque(), lane = tid & 63, wave = tid >> 6;
    float* WG = (float*)lds;
    __syncthreads();
    for (int i = tid; i < NGATE * DM; i += NTHREADS) { const int k = i / NGATE, g = i % NGATE; WG[g * DM + k] = p.winab[(size_t)k * ABIN + ABMAIN + g]; }
    __syncthreads();
    const int gw = bx * NWAVES + wave, NGW = G * NWAVES;
    f4 nx[4];
    if (gw < MTOK) { const f4* xr = (const f4*)xrow(p, gw) + lane;
#pragma unroll
        for (int j = 0; j < 4; ++j) nx[j] = xr[64 * j]; }
    for (int row = gw; row < MTOK; row += NGW) {
        const int cls = cls_of(row);
        const f4* g4 = (const f4*)p.n1g + lane; const f4* sc4 = (const f4*)modv(p, 0, cls, 1) + lane; const f4* sh4 = (const f4*)modv(p, 0, cls, 0) + lane;
        f4 v[4]; float s = 0.f;
#pragma unroll
        for (int j = 0; j < 4; ++j) { v[j] = nx[j]; s += (v[j][0] * v[j][0] + v[j][1] * v[j][1]) + (v[j][2] * v[j][2] + v[j][3] * v[j][3]); }
        if (row + NGW < MTOK) { const f4* xr = (const f4*)xrow(p, row + NGW) + lane;
#pragma unroll
            for (int j = 0; j < 4; ++j) nx[j] = xr[64 * j]; }
        const float rs = 1.0f / sqrtf(wave_sum64(s) * (1.0f / DM) + EPSF);
        bf16_t* xo = (bf16_t*)(p.ws + WS_XN) + (size_t)row * DM + lane * 4;
#pragma unroll
        for (int j = 0; j < 4; ++j) { const f4 gg = g4[64 * j], sc = sc4[64 * j], sh = sh4[64 * j]; v[j] = v[j] * rs * gg * (sc + 1.0f) + sh;
            u2 w; w.x = pg8::cvt_pk_bf16(v[j][0], v[j][1]); w.y = pg8::cvt_pk_bf16(v[j][2], v[j][3]); *(u2*)(xo + 256 * j) = w; }
        float mine = 0.f;
#pragma unroll
        for (int g = 0; g < NGATE; ++g) { float a = 0.f;
#pragma unroll
            for (int j = 0; j < 4; ++j) { const f4 w = *(const f4*)(WG + g * DM + 256 * j + lane * 4); a += (v[j][0] * w[0] + v[j][1] * w[1]) + (v[j][2] * w[2] + v[j][3] * w[3]); }
            a = wave_sum64(a); if (lane == g) mine = a; }
        if (lane < NGATE) { float a = mine + p.bgate[lane]; if ((lane & 7) >= 4) a = logsigmoidf_(a); ((float*)(p.ws + WS_GATES))[(size_t)row * NGATE + lane] = a; }
    }
}
__device__ __forceinline__ void phase_conv(const Params& p, char* lds, int vcu, int G) {
    const int tid = tid_opaque(), lane = tid & 63, wave = tid >> 6; constexpr int TT = 32, NR = TT + CWID - 1;
    bf16_t* X = (bf16_t*)lds; float* OUT = (float*)(lds + 65536);
    const int cp = tid & 255, tg = tid >> 8, c0 = 2 * cp;
    float w0[CWID], w1[CWID];
#pragma unroll
    for (int j = 0; j < CWID; ++j) { w0[j] = p.convw[(size_t)j * CCH + c0]; w1[j] = p.convw[(size_t)j * CCH + c0 + 1]; }
    const float b0 = p.convb[c0], b1 = p.convb[c0 + 1];
    const bf16_t* U = (const bf16_t*)(p.ws + WS_UPRE);
    for (int u = vcu; u < MTOK / TT; u += G) {
        const int row0 = u * TT, pos0 = pos_of(row0), len = seqlen_of(row0);
        __syncthreads();
        { u4 val[8];
#pragma unroll
          for (int i = 0; i < 8; ++i) { const int c = tid + NTHREADS * i, r = c / (CCH / 8), ch = (c % (CCH / 8)) * 8; const int t = pos0 + r - CWID / 2;
              val[i] = (u4){0u, 0u, 0u, 0u}; if (c < NR * (CCH / 8) && t >= 0 && t < len) val[i] = *(const u4*)(U + (size_t)(row0 + r - CWID / 2) * CCH + ch); }
#pragma unroll
          for (int i = 0; i < 8; ++i) { const int c = tid + NTHREADS * i, r = c / (CCH / 8), ch = (c % (CCH / 8)) * 8; if (c < NR * (CCH / 8)) *(u4*)(X + (size_t)r * CCH + ch) = val[i]; } }
        __syncthreads();
#pragma unroll 2
        for (int tt = 0; tt < TT / 2; ++tt) { const int t = tg * (TT / 2) + tt; float a0 = b0, a1 = b1;
#pragma unroll
            for (int j = 0; j < CWID; ++j) { const unsigned xx = *(const unsigned*)(X + (size_t)(t + j) * CCH + c0); a0 += w0[j] * __uint_as_float(xx << 16); a1 += w1[j] * __uint_as_float(xx & 0xffff0000u); }
            *(float2*)(OUT + (size_t)t * CCH + c0) = make_float2(a0, a1); }
        __syncthreads();
#pragma unroll
        for (int q = 0; q < TT / NWAVES; ++q) { const int t = wave * (TT / NWAVES) + q; const f4 x0 = *(const f4*)(OUT + (size_t)t * CCH + lane * 8), x1 = *(const f4*)(OUT + (size_t)t * CCH + lane * 8 + 4);
            const float mu = wave_sum64((x0[0] + x0[1]) + (x0[2] + x0[3]) + (x1[0] + x1[1]) + (x1[2] + x1[3])) * (1.0f / CCH);
            const f4 d0 = x0 - mu, d1 = x1 - mu;
            const float var = wave_sum64((d0[0] * d0[0] + d0[1] * d0[1]) + (d0[2] * d0[2] + d0[3] * d0[3]) + (d1[0] * d1[0] + d1[1] * d1[1]) + (d1[2] * d1[2] + d1[3] * d1[3])) * (1.0f / CCH);
            const float rs = 1.0f / sqrtf(var + EPSF);
            const f4 g0 = *(const f4*)(p.lng + lane * 8), g1 = *(const f4*)(p.lng + lane * 8 + 4), be0 = *(const f4*)(p.lnb + lane * 8), be1 = *(const f4*)(p.lnb + lane * 8 + 4);
            const f4 y0 = d0 * rs * g0 + be0, y1 = d1 * rs * g1 + be1; u4 w;
            w.x = pg8::cvt_pk_bf16(fsilu(y0[0]), fsilu(y0[1])); w.y = pg8::cvt_pk_bf16(fsilu(y0[2]), fsilu(y0[3])); w.z = pg8::cvt_pk_bf16(fsilu(y1[0]), fsilu(y1[1])); w.w = pg8::cvt_pk_bf16(fsilu(y1[2]), fsilu(y1[3]));
            *(u4*)((bf16_t*)(p.ws + WS_UH) + (size_t)(row0 + t) * DM + lane * 8) = w; }
    }
}
static_assert(CCH == 512 && CSEQ % 32 == 0 && LSEQ % 32 == 0, "conv phase geometry");
__device__ __forceinline__ void phase_cachecvt(const Params& p, int gtid, int gthreads) {
    constexpr int PER = PAST * NKV * HDIM / 8;
    for (int i = gtid; i < NLB * PER; i += gthreads) { const int b = i / PER, e = (i % PER) * 8; const size_t src = (size_t)b * PAST * NKV * HDIM + e, dst = ((size_t)b * SKVL + LSEQ) * NKV * HDIM + e;
        const f4 k0 = *(const f4*)(p.ck + src), k1 = *(const f4*)(p.ck + src + 4), v0 = *(const f4*)(p.cv + src), v1 = *(const f4*)(p.cv + src + 4); u4 wk, wv;
        wk.x = pg8::cvt_pk_bf16(k0[0], k0[1]); wk.y = pg8::cvt_pk_bf16(k0[2], k0[3]); wk.z = pg8::cvt_pk_bf16(k1[0], k1[1]); wk.w = pg8::cvt_pk_bf16(k1[2], k1[3]);
        wv.x = pg8::cvt_pk_bf16(v0[0], v0[1]); wv.y = pg8::cvt_pk_bf16(v0[2], v0[3]); wv.z = pg8::cvt_pk_bf16(v1[0], v1[1]); wv.w = pg8::cvt_pk_bf16(v1[2], v1[3]);
        *(u4*)((bf16_t*)(p.ws + WS_LATK) + dst) = wk; *(u4*)((bf16_t*)(p.ws + WS_LATV) + dst) = wv; }
}
__device__ __forceinline__ void phase_qkpost(const Params& p, int gw, int NGW, int lane) {
    const int hh = lane >> 5, l5 = lane & 31, half = l5 >> 4, f0 = (l5 & 15) * 2, d1 = half * 64 + f0, d2 = d1 + 32;
    const float inv0 = __builtin_amdgcn_exp2f(-(float)f0 * (13.287712379549449f / 32.0f)), inv1 = __builtin_amdgcn_exp2f(-(float)(f0 + 1) * (13.287712379549449f / 32.0f));
    const float qg[4] = {p.qng[d1], p.qng[d1 + 1], p.qng[d2], p.qng[d2 + 1]}, kg[4] = {p.kng[d1], p.kng[d1 + 1], p.kng[d2], p.kng[d2 + 1]};
    for (int row = gw; row < MTOK; row += NGW) {
        const bool lat = row >= MC; const int sp = pos_of(row); float cs0 = 1.f, sn0 = 0.f, cs1 = 1.f, sn1 = 0.f;
        if (lat) { const float pos = (float)(half == 0 ? sp / GRIDW : sp % GRIDW); cs0 = __cosf(pos * inv0); sn0 = __sinf(pos * inv0); cs1 = __cosf(pos * inv1); sn1 = __sinf(pos * inv1); }
        bf16_t* Q = (bf16_t*)(p.ws + WS_QRAW) + (size_t)row * NQ * HDIM; const bf16_t* KR = (const bf16_t*)(p.ws + WS_KRAW) + (size_t)row * NKV * HDIM;
        unsigned ra[NQ / 2 + 1], rb[NQ / 2 + 1];
#pragma unroll
        for (int it = 0; it <= NQ / 2; ++it) { const bf16_t* src = it < NQ / 2 ? Q + (2 * it + hh) * HDIM : KR + hh * HDIM; ra[it] = *(const unsigned*)(src + d1); rb[it] = *(const unsigned*)(src + d2); }
#pragma unroll
        for (int it = 0; it <= NQ / 2; ++it) { const bool isq = it < NQ / 2;
            const float x1a = __uint_as_float(ra[it] << 16), x1b = __uint_as_float(ra[it] & 0xffff0000u), x2a = __uint_as_float(rb[it] << 16), x2b = __uint_as_float(rb[it] & 0xffff0000u);
            float ss = (x1a * x1a + x1b * x1b) + (x2a * x2a + x2b * x2b); ss += swz_xor<1>(ss); ss += swz_xor<2>(ss); ss += swz_xor<4>(ss); ss += swz_xor<8>(ss); ss += swz_xor<16>(ss);
            const float rs = 1.0f / sqrtf(ss * (1.0f / HDIM) + EPSF); const float* g = isq ? qg : kg;
            const float a0 = x1a * rs * g[0], a1 = x1b * rs * g[1], b0 = x2a * rs * g[2], b1 = x2b * rs * g[3];
            const float y1a = a0 * cs0 - b0 * sn0, y2a = a0 * sn0 + b0 * cs0, y1b = a1 * cs1 - b1 * sn1, y2b = a1 * sn1 + b1 * cs1;
            const unsigned w1 = pg8::cvt_pk_bf16(y1a, y1b), w2 = pg8::cvt_pk_bf16(y2a, y2b);
            if (isq) { bf16_t* dst = Q + (2 * it + hh) * HDIM; *(unsigned*)(dst + d1) = w1; *(unsigned*)(dst + d2) = w2; }
            else if (!lat) { bf16_t* K = (bf16_t*)(p.ws + WS_CTXK) + (size_t)row * NKV * HDIM + hh * HDIM; *(unsigned*)(K + d1) = w1; *(unsigned*)(K + d2) = w2;
                float* fo = p.out + O_K + (size_t)row * NKV * HDIM + hh * HDIM; *(float2*)(fo + d1) = make_float2(y1a, y1b); *(float2*)(fo + d2) = make_float2(y2a, y2b); }
            else { const int b_ = (row - MC) / LSEQ, s_ = (row - MC) % LSEQ; bf16_t* K = (bf16_t*)(p.ws + WS_LATK) + ((size_t)b_ * SKVL + s_) * NKV * HDIM + hh * HDIM; *(unsigned*)(K + d1) = w1; *(unsigned*)(K + d2) = w2; } }
    }
}
static_assert(NKV == 2 && NQ % 2 == 0 && HDIM == 128, "qkpost lane mapping");
__device__ __forceinline__ void phase_final(const Params& p, int gw, int NGW, int lane) {
    const f4* g4 = (const f4*)p.fng + lane;
    f4 g[4];
#pragma unroll
    for (int j = 0; j < 4; ++j) g[j] = g4[64 * j];
    for (int row = gw; row < MTOK; row += 2 * NGW) { const int row2 = row + NGW; const bool has2 = row2 < MTOK; const int r2 = has2 ? row2 : row;
        const float* sq = (const float*)(p.ws + WS_SSQ) + (size_t)3 * SSQ_STRIDE; const float rsa = 1.0f / sqrtf(sq[row] * (1.0f / DM) + EPSF), rsb = 1.0f / sqrtf(sq[r2] * (1.0f / DM) + EPSF);
        f4* ya = (f4*)(p.out + O_Y + (size_t)row * DM) + lane; f4* yb = (f4*)(p.out + O_Y + (size_t)r2 * DM) + lane; f4 va[4], vb[4];
#pragma unroll
        for (int j = 0; j < 4; ++j) { va[j] = ya[64 * j]; vb[j] = yb[64 * j]; }
#pragma unroll
        for (int j = 0; j < 4; ++j) { ya[64 * j] = va[j] * rsa * g[j]; if (has2) yb[64 * j] = vb[j] * rsb * g[j]; } }
}
template <class Epi> __device__ __forceinline__ void gemm_call(LAS unsigned char* lds, const bf16_t* A, const bf16_t* Bt, int N, int K, const Epi& E) {
    pg8::Gemm g{A, Bt, MTOK, N, K}; pg8::StaticOrder S; S.init(MTOK, N, K, (int)gridDim.x, (int)blockIdx.x);
    pg8::gemm_phase<Epi, pg8::StaticOrder, true, true>((PG8_LAS unsigned char*)lds, g, S, E);
}
__device__ __forceinline__ void gemm_call_split(LAS unsigned char* lds, const bf16_t* A, const bf16_t* Bt, int N, int K, const EpiRes& E, unsigned char* slab, unsigned* cnt) {
    pg8::Gemm g{A, Bt, MTOK, N, K}; RoundZeroOrder S0; S0.init(MTOK, N, K, (int)gridDim.x, (int)blockIdx.x);
    pg8::gemm_phase<EpiRes, RoundZeroOrder, true, true>((PG8_LAS unsigned char*)lds, g, S0, E);
    if (S0.split) { QuarterOrder S1; S1.init(MTOK, N, K, (int)gridDim.x, (int)blockIdx.x);
        pg8::gemm_phase<EpiPartial, QuarterOrder, true, true>((PG8_LAS unsigned char*)lds, g, S1, EpiPartial{slab, cnt});
        tail_reduce(E, slab, cnt, (int)gridDim.x, (int)blockIdx.x, N / 256, MTOK / 256); }
}
__global__ void __launch_bounds__(NTHREADS, 2) mega_fwd(Params p) {
    extern __shared__ __attribute__((aligned(16))) unsigned char lds[];
    LAS unsigned char* L = (LAS unsigned char*)lds;
    for (int u = threadIdx.x; u < (LDS_BYTES - LDSCTL_OFF) / 4; u += NTHREADS) ((LAS unsigned*)(L + LDSCTL_OFF))[u] = 0u;
    __syncthreads();
    volatile LAS unsigned* MISC = (volatile LAS unsigned*)(L + MISC_OFF);
    const XcdBarrier bar = xcd_barrier_post((unsigned*)(p.ws + WS_CTL) + CW_BAR, MISC + 8);
    const int G = gridDim.x, bx = blockIdx.x; const int vcu = (G % 8 == 0) ? (bx % 8) * (G / 8) + bx / 8 : bx;
    unsigned char* ws = p.ws;
    const bf16_t* XN = (const bf16_t*)(ws + WS_XN); const bf16_t* UH = (const bf16_t*)(ws + WS_UH); const bf16_t* Hh = (const bf16_t*)(ws + WS_H); const bf16_t* Ob = (const bf16_t*)(ws + WS_O);
    float* SW0 = (float*)(ws + WS_SW); float* SWC = SW0 + (size_t)NCLS * 2 * DFF; float* SW1 = SWC + (size_t)NCLS * CIN;
    float* SSQ = (float*)(ws + WS_SSQ); float* Y = p.out + O_Y; unsigned* SPLITC = (unsigned*)(ws + WS_CTL) + CW_SPLIT;
#define WAVE_IDS() const int tid_ = tid_opaque(); const int lane_ = tid_ & 63; const int gw_ = bx * NWAVES + (tid_ >> 6); const int NGW_ = G * NWAVES
    p0_weights(p, L, vcu, G); phase_mod(p, (char*)lds, bx, G);
    xcd_barrier(bar);
    phase_norm0(p, (char*)lds, bx, G);
    { WAVE_IDS(); sw_job(p, (const bf16_t*)(ws + WB_FFI0), 2 * DFF, 0, 3, SW0, 2 * DFF, 1, gw_, NGW_, lane_); sw_job(p, (const bf16_t*)(ws + WB_INC), CIN, 1, 0, SWC, CIN, 0, gw_, NGW_, lane_);
      sw_job(p, (const bf16_t*)(ws + WB_FFI1), 2 * DFF, 1, 3, SW1, 2 * DFF, 1, gw_, NGW_, lane_); }
    xcd_barrier(bar);
    gemm_call(L, XN, (const bf16_t*)(ws + WB_AB), ABMAIN, DM, EpiAB{(bf16_t*)(ws + WS_UPRE), (bf16_t*)(ws + WS_QKVO)}); xcd_barrier(bar);
    ml_phase_A(p, lds, vcu, G); phase_conv(p, (char*)lds, vcu, G); xcd_barrier(bar);
    { WAVE_IDS(); MlScan sc{p}; for (long i = bx * (long)NTHREADS + tid_; i < MlScan::count(); i += (long)G * NTHREADS) sc(i); } xcd_barrier(bar);
    ml_phase_C(p, lds, vcu, G); xcd_barrier(bar);
    gemm_call_split(L, UH, (const bf16_t*)(ws + WB_OUTAB), DM, DM, EpiRes{p.xp, p.xs, Y, (bf16_t*)(ws + WS_XN), SSQ + 0 * SSQ_STRIDE, modv(p, 0, 0, 2), modv(p, 0, 0, 4), p.n2g, 1, 0}, ws + WS_SLAB_A, SPLITC + 0 * 4096); xcd_barrier(bar);
    gemm_call(L, XN, (const bf16_t*)(ws + WB_FFI0), 2 * DFF, DM, EpiFfnIn{(bf16_t*)(ws + WS_H), SSQ + 0 * SSQ_STRIDE, SW0}); xcd_barrier(bar);
    gemm_call_split(L, Hh, (const bf16_t*)(ws + WB_FFO0), DM, DFF, EpiRes{p.xp, p.xs, Y, (bf16_t*)(ws + WS_XN), SSQ + 1 * SSQ_STRIDE, modv(p, 0, 0, 5), modv(p, 1, 0, 1), p.n1g + DM, 0, 0}, ws + WS_SLAB_B, SPLITC + 1 * 4096); xcd_barrier(bar);
    gemm_call(L, XN, (const bf16_t*)(ws + WB_INC), CIN, DM, EpiQkv{(bf16_t*)(ws + WS_QRAW), (bf16_t*)(ws + WS_KRAW), (bf16_t*)(ws + WS_CTXV), (bf16_t*)(ws + WS_LATV), p.out + O_V, SSQ + 1 * SSQ_STRIDE, SWC}); xcd_barrier(bar);
    { WAVE_IDS(); phase_qkpost(p, gw_, NGW_, lane_); phase_cachecvt(p, bx * NTHREADS + tid_, G * NTHREADS); } xcd_barrier(bar);
    attn_phase(p, lds, vcu, G); xcd_barrier(bar);
    gemm_call_split(L, Ob, (const bf16_t*)(ws + WB_OUTC), DM, DM, EpiRes{p.xp, p.xs, Y, (bf16_t*)(ws + WS_XN), SSQ + 2 * SSQ_STRIDE, modv(p, 1, 0, 2), modv(p, 1, 0, 4), p.n2g + DM, 0, 0}, ws + WS_SLAB_A, SPLITC + 2 * 4096); xcd_barrier(bar);
    gemm_call(L, XN, (const bf16_t*)(ws + WB_FFI1), 2 * DFF, DM, EpiFfnIn{(bf16_t*)(ws + WS_H), SSQ + 2 * SSQ_STRIDE, SW1}); xcd_barrier(bar);
    gemm_call_split(L, Hh, (const bf16_t*)(ws + WB_FFO1), DM, DFF, EpiRes{p.xp, p.xs, Y, (bf16_t*)(ws + WS_XN), SSQ + 3 * SSQ_STRIDE, modv(p, 1, 0, 5), modv(p, 1, 0, 1), nullptr, 0, 0}, ws + WS_SLAB_B, SPLITC + 3 * 4096); xcd_barrier(bar);
    { WAVE_IDS(); phase_final(p, gw_, NGW_, lane_); }
#undef WAVE_IDS
}
static Params make_params(void* const* d_in, void* d_out, void* d_ws) {
    Params p{}; const float** pp = (const float**)&p; for (int i = 0; i < 28; ++i) pp[i] = (const float*)d_in[i];
    p.out = (float*)d_out; p.ws = (unsigned char*)d_ws; return p;
}
extern "C" void kernel_launch(void* const* d_in, const int* in_sizes, int n_in, void* d_out, int out_size, void* d_ws, size_t ws_size, hipStream_t stream) {
    static int grid = 0;
    if (grid == 0) {
        if (n_in != 28 || (size_t)out_size != O_END || ws_size < WS_END || in_sizes[0] != MC * DM || in_sizes[1] != ML * DM) {
            fprintf(stderr, "kernel_launch: shape mismatch n_in %d out %d (want %zu) ws %zu (want %zu)\n", n_in, out_size, (size_t)O_END, ws_size, (size_t)WS_END); grid = -1; return; }
        int dev = 0, cus = 0;
        if (hipGetDevice(&dev) != hipSuccess || hipDeviceGetAttribute(&cus, hipDeviceAttributeMultiprocessorCount, dev) != hipSuccess) { grid = -1; return; }
        if (hipFuncSetAttribute((const void*)mega_fwd, hipFuncAttributeMaxDynamicSharedMemorySize, LDS_BYTES) != hipSuccess) { fprintf(stderr, "hipFuncSetAttribute failed\n"); grid = -1; return; }
        int per_cu = 0; (void)hipOccupancyMaxActiveBlocksPerMultiprocessor(&per_cu, (const void*)mega_fwd, NTHREADS, LDS_BYTES); (void)hipGetLastError();
        if (per_cu < 1) fprintf(stderr, "kernel_launch: occupancy query says %d blocks/CU\n", per_cu);
        grid = cus;
    }
    if (grid < 0) return;
    hipMemsetAsync((char*)d_ws + WS_CTL, 0, CTL_ZERO_BYTES, stream);
    Params p = make_params(d_in, d_out, d_ws);
    hipLaunchKernelGGL(mega_fwd, dim3(grid), dim3(NTHREADS), LDS_BYTES, stream, p);
}
```

```cpp
#ifdef HOST_TEST
#include <cmath>
#include <cstdio>
#include <cstdlib>
#include <cstring>
#include <cstdint>
#include <vector>
#define HD_FN inline
#define DEV_FN inline
#else
#include <hip/hip_runtime.h>
#include <cstdio>
#include <cstdint>
#define HD_FN __host__ __device__ __forceinline__
#define DEV_FN __device__ __forceinline__
#endif

#ifdef TINY
constexpr int DM = 512, NCB = 2, CSEQ = 128, NLB = 2, LSEQ = 128, PAST = 128;
#else
constexpr int DM = 1024, NCB = 16, CSEQ = 256, NLB = 4, LSEQ = 4096, PAST = 256;
#endif
constexpr int GRIDW = 64, CCH = DM / 2, CWID = 31, MH = 4, MDK = CCH / MH, MW = CCH, NGATE = 16;
constexpr int ABIN = 2 * CCH + 4 * MW + NGATE, ABMAIN = 2 * CCH + 4 * MW;
constexpr int HDIM = 128, NQ = DM / HDIM, NKV = 2, GRP = NQ / NKV, CIN = (NQ + 2 * NKV) * HDIM;
constexpr int DFF = ((8 * DM + 3 * 256 - 1) / (3 * 256)) * 256;
constexpr int MC = NCB * CSEQ, ML = NLB * LSEQ, MTOK = MC + ML, NCLS = 1 + NLB, SKVL = LSEQ + PAST;
constexpr float EPSF = 1e-6f;
constexpr int NSEQ = NCB + NLB;

constexpr size_t O_Y = 0, O_C = (size_t)MTOK * DM, O_N = O_C + (size_t)NCB * 2 * MH * MDK * MDK, O_M = O_N + (size_t)NCB * 2 * MH * MDK,
                 O_K = O_M + (size_t)NCB * 2 * MH, O_V = O_K + (size_t)NCB * CSEQ * NKV * HDIM, O_END = O_V + (size_t)NCB * CSEQ * NKV * HDIM;

constexpr size_t MiB = 1u << 20;
#ifdef TINY
constexpr size_t WSCALE = 1;
#endif
constexpr size_t WS_CTL = 0, CTL_ZERO_BYTES = 1 * MiB;
constexpr size_t WS_MOD = 1 * MiB;
constexpr size_t WS_SW = WS_MOD + 256 * 1024;
constexpr size_t WS_SSQ = 512 * 1024;
constexpr int SSQ_STRIDE = 32768;
constexpr size_t WS_DEN = 232 * MiB;
constexpr size_t WS_WB = 2 * MiB;
constexpr size_t WS_XN = 50 * MiB;
constexpr size_t WS_UPRE = 90 * MiB;
constexpr size_t WS_QKVO = 110 * MiB;
constexpr size_t WS_UH = 190 * MiB;
constexpr size_t WS_GATES = 230 * MiB;
constexpr size_t WS_HS = 50 * MiB;
constexpr size_t WS_Y16 = 90 * MiB;
constexpr size_t WS_H = 130 * MiB;
constexpr size_t WS_QRAW = 130 * MiB;
constexpr size_t WS_LATK = 170 * MiB, WS_LATV = 179 * MiB, WS_CTXK = 188 * MiB, WS_CTXV = 190 * MiB;
constexpr size_t WS_KRAW = 192 * MiB;
constexpr size_t WS_O = 202 * MiB;
constexpr size_t WS_END = 256 * MiB;

typedef unsigned short bf16_t;
HD_FN float bf2f(bf16_t h) { unsigned u = (unsigned)h << 16; return __builtin_bit_cast(float, u); }
HD_FN bf16_t f2bf(float f) { unsigned u = __builtin_bit_cast(unsigned, f); return (bf16_t)((u + 0x7fffu + ((u >> 16) & 1u)) >> 16); }
HD_FN float rbf(float f) { return bf2f(f2bf(f)); }
HD_FN float sigmoidf_(float x) { return 1.0f / (1.0f + expf(-x)); }
HD_FN float siluf_(float x) { return x * sigmoidf_(x); }
HD_FN float logsigmoidf_(float x) { return x >= 0.f ? -log1pf(expf(-x)) : x - log1pf(expf(x)); }
HD_FN int cls_of(int row) { return row < MC ? 0 : 1 + (row - MC) / LSEQ; }
HD_FN int seqlen_of(int row) { return row < MC ? CSEQ : LSEQ; }
HD_FN int pos_of(int row) { return row < MC ? row % CSEQ : (row - MC) % LSEQ; }

struct Params {
    const float *xp, *xs, *c, *stC, *stn, *stm, *ck, *cv, *cctx, *wmod, *bmod, *n1g, *n2g, *winab, *bgate, *convw, *convb, *lng, *lnb, *mng,
        *woutab, *winc, *qng, *kng, *woutc, *wffi, *wffo, *fng;
    float* out; unsigned char* ws;
};
HD_FN const float* xrow(const Params& p, int row) { return row < MC ? p.xp + (size_t)row * DM : p.xs + (size_t)(row - MC) * DM; }
HD_FN const float* modv(const Params& p, int l, int cls, int which) { return (const float*)(p.ws + WS_MOD) + ((size_t)(l * NCLS + cls) * 6 + which) * DM; }
constexpr size_t WS_RS0 = 233 * MiB;

struct NMod {
    Params p; static HD_FN long count() { return 2L * NCLS * 6 * DM; }
    HD_FN void operator()(long idx) const {
        const int col = (int)(idx % (6 * DM)); const int cls = (int)((idx / (6 * DM)) % NCLS); const int l = (int)(idx / (6 * DM * NCLS));
        const float* cond = cls == 0 ? p.cctx : p.c + (size_t)(cls - 1) * DM;
        const float* w = p.wmod + (size_t)l * DM * 6 * DM;
        float acc = 0.f;
        for (int k = 0; k < DM; ++k) acc += siluf_(cond[k]) * w[(size_t)k * 6 * DM + col];
        ((float*)(p.ws + WS_MOD))[idx] = acc + p.bmod[(size_t)l * 6 * DM + col];
    }
};
struct NNorm0a {
    Params p; static HD_FN long count() { return MTOK; }
    HD_FN void operator()(long row) const {
        const float* x = xrow(p, (int)row); float s = 0.f;
        for (int k = 0; k < DM; ++k) s += x[k] * x[k];
        ((float*)(p.ws + WS_RS0))[row] = 1.0f / sqrtf(s / DM + EPSF);
    }
};
struct NNorm0b {
    Params p; static HD_FN long count() { return (long)MTOK * DM; }
    HD_FN void operator()(long idx) const {
        const int row = (int)(idx / DM), col = (int)(idx % DM), cls = cls_of(row);
        const float rs = ((const float*)(p.ws + WS_RS0))[row];
        const float v = xrow(p, row)[col] * rs * p.n1g[col] * (1.f + modv(p, 0, cls, 1)[col]) + modv(p, 0, cls, 0)[col];
        ((bf16_t*)(p.ws + WS_XN))[idx] = f2bf(v);
    }
};
struct NGates {
    Params p; static HD_FN long count() { return (long)MTOK * NGATE; }
    HD_FN void operator()(long idx) const {
        const int row = (int)(idx / NGATE), j = (int)(idx % NGATE), cls = cls_of(row);
        const float rs = ((const float*)(p.ws + WS_RS0))[row]; const float* x = xrow(p, row);
        const float* sc = modv(p, 0, cls, 1); const float* sh = modv(p, 0, cls, 0);
        float acc = 0.f;
        for (int k = 0; k < DM; ++k) { const float h = x[k] * rs * p.n1g[k] * (1.f + sc[k]) + sh[k]; acc += h * p.winab[(size_t)k * ABIN + ABMAIN + j]; }
        acc += p.bgate[j];
        if ((j & 7) >= 4) acc = logsigmoidf_(acc);
        ((float*)(p.ws + WS_GATES))[idx] = acc;
    }
};

template <bool DUAL, class Epi> struct NGemm {
    const bf16_t* A; const float* B; int lda, ldb, K, N, off2, pad_; Epi epi;
    HD_FN long count() const { return (long)(MTOK / 4) * (N / 4); }
    HD_FN void operator()(long idx) const {
        const int nt = (int)(idx % (N / 4)), mt = (int)(idx / (N / 4)); const int m0 = mt * 4, n0 = nt * 4;
        float acc[4][4], acc2[4][4];
#pragma unroll
        for (int i = 0; i < 4; ++i)
#pragma unroll
            for (int j = 0; j < 4; ++j) { acc[i][j] = 0.f; acc2[i][j] = 0.f; }
        for (int k0 = 0; k0 < K; k0 += 8) {
            float a[4][8];
#pragma unroll
            for (int i = 0; i < 4; ++i) {
                const bf16_t* ap = A + (size_t)(m0 + i) * lda + k0;
#pragma unroll
                for (int kk = 0; kk < 8; ++kk) a[i][kk] = bf2f(ap[kk]);
            }
#pragma unroll
            for (int kk = 0; kk < 8; ++kk) {
                const float* bp = B + (size_t)(k0 + kk) * ldb + n0;
                float b[4], b2[4];
#pragma unroll
                for (int j = 0; j < 4; ++j) { b[j] = rbf(bp[j]); b2[j] = DUAL ? rbf(bp[off2 + j]) : 0.f; }
#pragma unroll
                for (int i = 0; i < 4; ++i)
#pragma unroll
                    for (int j = 0; j < 4; ++j) { acc[i][j] += a[i][kk] * b[j]; if (DUAL) acc2[i][j] += a[i][kk] * b2[j]; }
            }
        }
#pragma unroll
        for (int i = 0; i < 4; ++i)
#pragma unroll
            for (int j = 0; j < 4; ++j) epi(m0 + i, n0 + j, acc[i][j], acc2[i][j]);
    }
};
struct EGlu { Params p; HD_FN void operator()(int row, int col, float v, float v2) const { ((bf16_t*)(p.ws + WS_UPRE))[(size_t)row * CCH + col] = f2bf(v * sigmoidf_(v2)); } };
struct EQkvo { Params p; HD_FN void operator()(int row, int col, float v, float) const {
        const int part = col / MW; if (part == 1) v *= 1.0f / sqrtf((float)MDK); if (part == 3) v = sigmoidf_(v);
        ((bf16_t*)(p.ws + WS_QKVO))[(size_t)row * 4 * MW + col] = f2bf(v); } };
struct EOut { Params p; int l; int pad_ = 0; HD_FN void operator()(int row, int col, float v, float) const {
        const int cls = cls_of(row); float* Y = p.out + O_Y + (size_t)row * DM + col;
        const float xin = l == 0 ? xrow(p, row)[col] : *Y;
        const float x1 = xin + modv(p, l, cls, 2)[col] * v; *Y = x1;
        ((bf16_t*)(p.ws + WS_XN))[(size_t)row * DM + col] = f2bf(x1 * p.n2g[(size_t)l * DM + col] * (1.f + modv(p, l, cls, 4)[col])); } };
struct EFfnIn { Params p; const float* sw; int slot; int pad_ = 0; HD_FN void operator()(int row, int col, float v, float v2) const {
        const int cls = cls_of(row); const float rs = 1.0f / sqrtf(((const float*)(p.ws + WS_SSQ))[(size_t)slot * SSQ_STRIDE + row] / DM + EPSF);
        const float a = v * rs + sw[(size_t)cls * 2 * DFF + col], b = v2 * rs + sw[(size_t)cls * 2 * DFF + DFF + col];
        ((bf16_t*)(p.ws + WS_H))[(size_t)row * DFF + col] = f2bf(siluf_(a) * b); } };
struct EFfnOut { Params p; int l; int pad_ = 0; HD_FN void operator()(int row, int col, float v, float) const {
        const int cls = cls_of(row); float* Y = p.out + O_Y + (size_t)row * DM + col;
        const float x2 = *Y + modv(p, l, cls, 5)[col] * v; *Y = x2;
        if (l == 0) ((bf16_t*)(p.ws + WS_XN))[(size_t)row * DM + col] = f2bf(x2 * p.n1g[(size_t)DM + col] * (1.f + modv(p, 1, cls, 1)[col])); } };
struct EQkv { Params p; const float* sw; int slot; int pad_ = 0; HD_FN void operator()(int row, int col, float v, float) const {
        const int cls = cls_of(row); const float rs = 1.0f / sqrtf(((const float*)(p.ws + WS_SSQ))[(size_t)slot * SSQ_STRIDE + row] / DM + EPSF);
        const float a = v * rs + sw[(size_t)cls * CIN + col];
        if (col < NQ * HDIM) ((bf16_t*)(p.ws + WS_QRAW))[(size_t)row * NQ * HDIM + col] = f2bf(a);
        else if (col < (NQ + NKV) * HDIM) ((bf16_t*)(p.ws + WS_KRAW))[(size_t)row * NKV * HDIM + (col - NQ * HDIM)] = f2bf(a);
        else { const int c2 = col - (NQ + NKV) * HDIM;
            if (row < MC) { ((bf16_t*)(p.ws + WS_CTXV))[(size_t)row * NKV * HDIM + c2] = f2bf(a); p.out[O_V + (size_t)row * NKV * HDIM + c2] = a; }
            else { const int b = (row - MC) / LSEQ, s = (row - MC) % LSEQ; ((bf16_t*)(p.ws + WS_LATV))[((size_t)b * SKVL + s) * NKV * HDIM + c2] = f2bf(a); } } } };

struct NSsq {
    Params p; int slot; int pad_ = 0; static HD_FN long count() { return MTOK; }
    HD_FN void operator()(long row) const { const float* y = p.out + O_Y + (size_t)row * DM; float s = 0.f; for (int k = 0; k < DM; ++k) s += y[k] * y[k];
        ((float*)(p.ws + WS_SSQ))[(size_t)slot * SSQ_STRIDE + row] = s; }
};
struct NSW {
    Params p; const float* W; float* sw; int l, which, N, pad_; HD_FN long count() const { return (long)NCLS * N; }
    HD_FN void operator()(long idx) const { const int n = (int)(idx % N), cls = (int)(idx / N); const float* sh = modv(p, l, cls, which); float acc = 0.f;
        for (int k = 0; k < DM; ++k) acc += sh[k] * rbf(W[(size_t)k * N + n]); sw[idx] = acc; }
};
struct NConv {
    Params p; static HD_FN long count() { return (long)MTOK * CCH; }
    HD_FN void operator()(long idx) const {
        const int row = (int)(idx / CCH), c = (int)(idx % CCH), pos = pos_of(row), len = seqlen_of(row);
        const bf16_t* U = (const bf16_t*)(p.ws + WS_UPRE); float acc = p.convb[c];
        for (int j = 0; j < CWID; ++j) { const int t = pos + j - CWID / 2; if (t >= 0 && t < len) acc += p.convw[(size_t)j * CCH + c] * bf2f(U[(size_t)(row + j - CWID / 2) * CCH + c]); }
        ((float*)(p.ws + WS_HS))[idx] = acc;
    }
};
struct NConvLN {
    Params p; static HD_FN long count() { return MTOK; }
    HD_FN void operator()(long row) const {
        const float* t = (const float*)(p.ws + WS_HS) + (size_t)row * CCH; float mu = 0.f;
        for (int c = 0; c < CCH; ++c) mu += t[c]; mu /= CCH; float var = 0.f;
        for (int c = 0; c < CCH; ++c) { const float d = t[c] - mu; var += d * d; } var /= CCH;
        const float rs = 1.0f / sqrtf(var + EPSF); bf16_t* UH = (bf16_t*)(p.ws + WS_UH) + (size_t)row * DM;
        for (int c = 0; c < CCH; ++c) UH[c] = f2bf(siluf_((t[c] - mu) * rs * p.lng[c] + p.lnb[c]));
    }
};
HD_FN int seq_base(int sid) { return sid < NCB ? sid * CSEQ : MC + (sid - NCB) * LSEQ; }
struct NMlstmDen {
    Params p; static HD_FN long count() { return (long)NSEQ * MH * 2; }
    HD_FN void operator()(long idx) const {
        const int dir = (int)(idx % 2), h = (int)((idx / 2) % MH), sid = (int)(idx / (2 * MH)); const bool isctx = sid < NCB;
        const int base = seq_base(sid), len = isctx ? CSEQ : LSEQ;
        float n[MDK]; float mrun = 0.f;
        if (isctx) {
#pragma unroll
            for (int d = 0; d < MDK; ++d) n[d] = 0.f;
        } else { const int b = sid - NCB; const float em = expf(p.stm[(size_t)(b * 2 + dir) * MH + h]);
#pragma unroll
            for (int d = 0; d < MDK; ++d) n[d] = p.stn[((size_t)(b * 2 + dir) * MH + h) * MDK + d] * em; }
        const bf16_t* QK = (const bf16_t*)(p.ws + WS_QKVO); const float* G = (const float*)(p.ws + WS_GATES); float* DEN = (float*)(p.ws + WS_DEN);
        for (int t = 0; t < len; ++t) {
            const int row = base + (dir == 0 ? t : len - 1 - t);
            const float ig = G[(size_t)row * NGATE + dir * 8 + h], lf = G[(size_t)row * NGATE + dir * 8 + 4 + h];
            const float f = expf(lf), ei = expf(ig); mrun = fmaxf(mrun + lf, ig);
            const bf16_t* q = QK + (size_t)row * 4 * MW + h * MDK; const bf16_t* k = q + MW; float den = 0.f;
#pragma unroll
            for (int d = 0; d < MDK; ++d) { n[d] = f * n[d] + ei * bf2f(k[d]); den += bf2f(q[d]) * n[d]; }
            DEN[((size_t)dir * MTOK + row) * MH + h] = den;
        }
        if (isctx) { const float em = expf(-mrun); p.out[O_M + (size_t)(sid * 2 + dir) * MH + h] = mrun;
#pragma unroll
            for (int d = 0; d < MDK; ++d) p.out[O_N + ((size_t)(sid * 2 + dir) * MH + h) * MDK + d] = n[d] * em; }
    }
};
struct NMlstmNum {
    Params p; int dir; int pad_ = 0; static HD_FN long count() { return (long)NSEQ * MH * MDK; }
    HD_FN void operator()(long idx) const {
        const int v = (int)(idx % MDK), h = (int)((idx / MDK) % MH), sid = (int)(idx / (MDK * MH)); const bool isctx = sid < NCB;
        const int base = seq_base(sid), len = isctx ? CSEQ : LSEQ;
        float C[MDK];
        if (isctx) {
#pragma unroll
            for (int d = 0; d < MDK; ++d) C[d] = 0.f;
        } else { const int b = sid - NCB; const float em = expf(p.stm[(size_t)(b * 2 + dir) * MH + h]);
#pragma unroll
            for (int d = 0; d < MDK; ++d) C[d] = p.stC[(((size_t)(b * 2 + dir) * MH + h) * MDK + d) * MDK + v] * em; }
        const bf16_t* QK = (const bf16_t*)(p.ws + WS_QKVO); const float* G = (const float*)(p.ws + WS_GATES); const float* DEN = (const float*)(p.ws + WS_DEN);
        float* HS = (float*)(p.ws + WS_HS);
        for (int t = 0; t < len; ++t) {
            const int row = base + (dir == 0 ? t : len - 1 - t);
            const float ig = G[(size_t)row * NGATE + dir * 8 + h], lf = G[(size_t)row * NGATE + dir * 8 + 4 + h];
            const float f = expf(lf), ei = expf(ig);
            const bf16_t* q = QK + (size_t)row * 4 * MW + h * MDK; const bf16_t* k = q + MW; const float vv = bf2f(q[2 * MW + v]) * ei; float num = 0.f;
#pragma unroll
            for (int d = 0; d < MDK; ++d) { C[d] = f * C[d] + bf2f(k[d]) * vv; num += bf2f(q[d]) * C[d]; }
            const float den = DEN[((size_t)dir * MTOK + row) * MH + h]; const float hv = num / fmaxf(fabsf(den), 1.0f);
            float* o = HS + (size_t)row * MW + h * MDK + v; if (dir == 0) *o = hv; else *o += hv;
        }
        if (isctx) { const float em = expf(-p.out[O_M + (size_t)(sid * 2 + dir) * MH + h]);
#pragma unroll
            for (int d = 0; d < MDK; ++d) p.out[O_C + (((size_t)(sid * 2 + dir) * MH + h) * MDK + d) * MDK + v] = C[d] * em; }
    }
};
struct NHm {
    Params p; static HD_FN long count() { return (long)MTOK * MH; }
    HD_FN void operator()(long idx) const {
        const int row = (int)(idx / MH), h = (int)(idx % MH); const float* x = (const float*)(p.ws + WS_HS) + (size_t)row * MW + h * MDK; float s = 0.f;
        for (int v = 0; v < MDK; ++v) s += x[v] * x[v];
        const float rs = 1.0f / sqrtf(s / MDK + EPSF); const bf16_t* og = (const bf16_t*)(p.ws + WS_QKVO) + (size_t)row * 4 * MW + 3 * MW + h * MDK;
        bf16_t* UH = (bf16_t*)(p.ws + WS_UH) + (size_t)row * DM + CCH + h * MDK;
        for (int v = 0; v < MDK; ++v) UH[v] = f2bf(bf2f(og[v]) * x[v] * rs * p.mng[h * MDK + v]);
    }
};
struct NCacheCvt {
    Params p; static HD_FN long count() { return (long)NLB * PAST * NKV * HDIM; }
    HD_FN void operator()(long idx) const { const int e = (int)(idx % (NKV * HDIM)), pp = (int)((idx / (NKV * HDIM)) % PAST), b = (int)(idx / ((long)NKV * HDIM * PAST));
        const size_t dst = ((size_t)b * SKVL + LSEQ + pp) * NKV * HDIM + e;
        ((bf16_t*)(p.ws + WS_LATK))[dst] = f2bf(p.ck[idx]); ((bf16_t*)(p.ws + WS_LATV))[dst] = f2bf(p.cv[idx]); }
};
struct NQkPost {
    Params p; static HD_FN long count() { return (long)MTOK * (NQ + NKV); }
    HD_FN void operator()(long idx) const {
        const int row = (int)(idx / (NQ + NKV)), j = (int)(idx % (NQ + NKV)); const bool isq = j < NQ; const bool lat = row >= MC;
        bf16_t* src = isq ? (bf16_t*)(p.ws + WS_QRAW) + (size_t)row * NQ * HDIM + j * HDIM : (bf16_t*)(p.ws + WS_KRAW) + (size_t)row * NKV * HDIM + (j - NQ) * HDIM;
        const float* g = isq ? p.qng : p.kng; float s = 0.f;
        for (int d = 0; d < HDIM; ++d) { const float x = bf2f(src[d]); s += x * x; }
        const float rs = 1.0f / sqrtf(s / HDIM + EPSF);
        bf16_t* dst; float* fo = nullptr;
        if (isq) dst = src;
        else if (!lat) { dst = (bf16_t*)(p.ws + WS_CTXK) + (size_t)row * NKV * HDIM + (j - NQ) * HDIM; fo = p.out + O_K + (size_t)row * NKV * HDIM + (j - NQ) * HDIM; }
        else { const int b = (row - MC) / LSEQ, sp = (row - MC) % LSEQ; dst = (bf16_t*)(p.ws + WS_LATK) + ((size_t)b * SKVL + sp) * NKV * HDIM + (j - NQ) * HDIM; }
        const int sp = pos_of(row); const float prow = (float)(sp / GRIDW), pcol = (float)(sp % GRIDW);
        for (int half = 0; half < 2; ++half)
            for (int d = 0; d < HDIM / 4; ++d) {
                const int i1 = half * (HDIM / 2) + d, i2 = i1 + HDIM / 4;
                const float x1 = bf2f(src[i1]) * rs * g[i1], x2 = bf2f(src[i2]) * rs * g[i2]; float y1 = x1, y2 = x2;
                if (lat) { const float inv = powf(10000.0f, -(float)d / (float)(HDIM / 4)); const float ang = (half == 0 ? prow : pcol) * inv; const float cs = cosf(ang), sn = sinf(ang);
                    y1 = x1 * cs - x2 * sn; y2 = x1 * sn + x2 * cs; }
                dst[i1] = f2bf(y1); dst[i2] = f2bf(y2); if (fo) { fo[i1] = y1; fo[i2] = y2; }
            }
    }
};
struct NAttn {
    Params p; static HD_FN long count() { return (long)MTOK * NQ * 4; }
    HD_FN void operator()(long idx) const {
        const int sl = (int)(idx % 4), hq = (int)((idx / 4) % NQ), row = (int)(idx / (4 * NQ)); const int kv = hq / GRP;
        const bf16_t *Kb, *Vb; int nk;
        if (row < MC) { const int b = row / CSEQ; Kb = (const bf16_t*)(p.ws + WS_CTXK) + (size_t)b * CSEQ * NKV * HDIM; Vb = (const bf16_t*)(p.ws + WS_CTXV) + (size_t)b * CSEQ * NKV * HDIM; nk = CSEQ; }
        else { const int b = (row - MC) / LSEQ; Kb = (const bf16_t*)(p.ws + WS_LATK) + (size_t)b * SKVL * NKV * HDIM; Vb = (const bf16_t*)(p.ws + WS_LATV) + (size_t)b * SKVL * NKV * HDIM; nk = SKVL; }
        const bf16_t* qp = (const bf16_t*)(p.ws + WS_QRAW) + (size_t)row * NQ * HDIM + hq * HDIM;
        float q[HDIM];
#pragma unroll
        for (int d = 0; d < HDIM; ++d) q[d] = bf2f(qp[d]);
        float o[32];
#pragma unroll
        for (int e = 0; e < 32; ++e) o[e] = 0.f;
        float m = -1e30f, l = 0.f; const float scale = 1.0f / sqrtf((float)HDIM);
        for (int s = 0; s < nk; ++s) {
            const bf16_t* kp = Kb + (size_t)s * NKV * HDIM + kv * HDIM; float dot = 0.f;
#pragma unroll
            for (int d = 0; d < HDIM; ++d) dot += q[d] * bf2f(kp[d]);
            dot *= scale; const float mn = fmaxf(m, dot); const float al = expf(m - mn), pe = expf(dot - mn); m = mn; l = l * al + pe;
            const bf16_t* vp = Vb + (size_t)s * NKV * HDIM + kv * HDIM + sl * 32;
#pragma unroll
            for (int e = 0; e < 32; ++e) o[e] = o[e] * al + pe * bf2f(vp[e]);
        }
        bf16_t* op = (bf16_t*)(p.ws + WS_O) + (size_t)row * DM + hq * HDIM + sl * 32;
#pragma unroll
        for (int e = 0; e < 32; ++e) op[e] = f2bf(o[e] / l);
    }
};
struct NFinal {
    Params p; static HD_FN long count() { return (long)MTOK * DM; }
    HD_FN void operator()(long idx) const { const int row = (int)(idx / DM), col = (int)(idx % DM);
        const float rs = 1.0f / sqrtf(((const float*)(p.ws + WS_SSQ))[(size_t)3 * SSQ_STRIDE + row] / DM + EPSF); p.out[O_Y + idx] *= rs * p.fng[col]; }
};
constexpr int NWAVES = 8, NTHREADS = NWAVES * 64;
constexpr int RING_OFF = 0, RING_BYTES = 131072;
constexpr int LDSCTL_OFF = RING_BYTES, MISC_OFF = LDSCTL_OFF + 320;
constexpr int LDS_BYTES = 147456;
constexpr int CW_TMO = 0, CW_CODE = 1, CW_BAR = 4096;
__device__ __forceinline__ int tid_opaque() { int t = threadIdx.x; asm volatile("" : "+v"(t)); return t; }
template <int M> __device__ __forceinline__ float swz_xor(float v) { return __int_as_float(__builtin_amdgcn_ds_swizzle(__float_as_int(v), (M << 10) | 0x1f)); }
__device__ __forceinline__ float half_sum(float v) { auto rr = __builtin_amdgcn_permlane32_swap(__float_as_uint(v), __float_as_uint(v), false, false); return __uint_as_float(rr[0]) + __uint_as_float(rr[1]); }
__device__ __forceinline__ float half_max(float v) { auto rr = __builtin_amdgcn_permlane32_swap(__float_as_uint(v), __float_as_uint(v), false, false); return fmaxf(__uint_as_float(rr[0]), __uint_as_float(rr[1])); }
__device__ __forceinline__ float lane_get(float v, int src_lane) { return __int_as_float(__builtin_amdgcn_ds_bpermute(src_lane << 2, __float_as_int(v))); }
#define GAS __attribute__((address_space(1)))
#define LAS __attribute__((address_space(3)))
typedef GAS unsigned gu32;
#define RLX_AGENT __ATOMIC_RELAXED, __HIP_MEMORY_SCOPE_AGENT
#define XB_TMO      128
#define XB_XCNT(j)  (256  + 64 * (j))
#define XB_XSUB(j)  (1280 + 64 * (j))
#define XB_XGEN(j)  (2304 + 64 * (j))
#define XB_TOP      3328
#define XB_TOPGEN   3392
#define XCD_BAR_WORDS 3456
#define XB_SPIN_CAP (1u << 22)
__device__ __forceinline__ unsigned xb_ld(unsigned* p)              { return __hip_atomic_load(p, __ATOMIC_RELAXED, __HIP_MEMORY_SCOPE_AGENT); }
__device__ __forceinline__ unsigned xb_add(unsigned* p, unsigned v) { return __hip_atomic_fetch_add(p, v, __ATOMIC_RELAXED, __HIP_MEMORY_SCOPE_AGENT); }
__device__ __forceinline__ unsigned xb_xcc_id() { return (unsigned)__builtin_amdgcn_s_getreg((3 << 11) | 20) & 0xFu; }
#define XB_SPIN(cond, bar) do { unsigned _sp = 0; while (cond) { __builtin_amdgcn_s_sleep(1); \
    if ((++_sp & 255u) == 0u) { if (xb_ld(&(bar)[XB_TMO])) break; if (_sp > XB_SPIN_CAP) { atomicAdd(&(bar)[XB_TMO], 1u); break; } } } } while (0)
struct XcdBarrier { unsigned* bar; unsigned x; volatile LAS unsigned* st; };
__device__ __forceinline__ XcdBarrier xcd_barrier_post(unsigned* bar, volatile LAS unsigned* st) {
    XcdBarrier b; b.bar = bar; b.x = xb_xcc_id(); b.st = st;
    if (threadIdx.x == 0) (void)xb_add(&bar[XB_XCNT(b.x)], 1u);
    return b;
}
__device__ __forceinline__ void xcd_barrier_complete(unsigned* bar, unsigned x, unsigned& nloc, unsigned& nx) {
    const unsigned G = gridDim.x * gridDim.y * gridDim.z;
    unsigned sum, cnt, mine, sp = 0u;
    for (;;) {
        sum = 0u; cnt = 0u; mine = 0u;
#pragma unroll
        for (unsigned j = 0; j < 16; ++j) { const unsigned c = xb_ld(&bar[XB_XCNT(j)]); sum += c; cnt += (c > 0u) ? 1u : 0u; mine = (j == x) ? c : mine; }
        if (sum == G) break;
        __builtin_amdgcn_s_sleep(1);
        if ((++sp & 255u) == 0u) { if (xb_ld(&bar[XB_TMO])) break; if (sp > XB_SPIN_CAP) { atomicAdd(&bar[XB_TMO], 1u); break; } }
    }
    nloc = mine > 0u ? mine : 1u; nx = cnt > 0u ? cnt : 1u;
}
__device__ __forceinline__ void xcd_barrier(const XcdBarrier& b) {
    asm volatile("s_waitcnt vmcnt(0)" ::: "memory");
    __syncthreads();
    if (threadIdx.x == 0) {
        unsigned* bar = b.bar;
        __builtin_amdgcn_s_waitcnt(0);
        unsigned nloc = b.st[0], nx = b.st[1];
        if (nloc == 0u) { xcd_barrier_complete(bar, b.x, nloc, nx); b.st[0] = nloc; b.st[1] = nx; }
        const unsigned old = xb_add(&bar[XB_XSUB(b.x)], 1u);
        const unsigned gen = old / nloc;
        if (old + 1u == (gen + 1u) * nloc) {
            __builtin_amdgcn_fence(__ATOMIC_RELEASE, "agent");
            asm volatile("s_waitcnt vmcnt(0)" ::: "memory");
            const unsigned og = xb_add(&bar[XB_TOP], 1u);
            const unsigned tg = og / nx;
            if (og + 1u == (tg + 1u) * nx) xb_add(&bar[XB_TOPGEN], 1u);
            else XB_SPIN(xb_ld(&bar[XB_TOPGEN]) == tg, bar);
            __builtin_amdgcn_fence(__ATOMIC_ACQUIRE, "agent");
            xb_add(&bar[XB_XGEN(b.x)], 1u);
            asm volatile("s_waitcnt vmcnt(0)" ::: "memory");
        } else {
            XB_SPIN(xb_ld(&bar[XB_XGEN(b.x)]) == gen, bar);
            __builtin_amdgcn_fence(__ATOMIC_ACQUIRE, "agent");
            asm volatile("s_waitcnt vmcnt(0)" ::: "memory");
        }
    }
    __syncthreads();
}
namespace pg8 {
#define PG8_LAS __attribute__((address_space(3)))
typedef unsigned short bf16_t;
typedef short bf16x8 __attribute__((ext_vector_type(8)));
typedef float f32x4 __attribute__((ext_vector_type(4)));
typedef unsigned u32x4 __attribute__((ext_vector_type(4)));
constexpr int BM = 256, BK = 64, HALF = 128, HTB = HALF * BK * 2  , STAGE_BYTES = 8 * HTB, NXCD = 8, WGM = 8;

__host__ __device__ __forceinline__ int lds_byte(int r, int c) { const int st = (r >> 4) * 2 + (c >> 5), rr = r & 15, cc = c & 31, ob = rr * 64 + cc * 2; return st * 1024 + (ob ^ (((ob >> 9) & 1) << 5)); }
__host__ __device__ __forceinline__ void stage_rc(int b, int& R, int& C) { const int st = b / 1024, sb = b % 1024, swz = sb ^ (((sb >> 9) & 1) << 5); R = (st >> 1) * 16 + swz / 64; C = (st & 1) * 32 + (swz % 64) / 2; }
__host__ __device__ __forceinline__ int perm32(int rho) { const int n = rho >> 4, i = rho & 15; return 8 * (i >> 2) + 4 * n + (i & 3); }

struct Unit { int pm, pn, k0, nt, role, slot; };
struct Gemm { const bf16_t* A; const bf16_t* Bt; int M, N, K; };

struct StaticOrder {
    int nM, nN, nwg, G, c, ntK;
    __host__ __device__ void init(int M, int N, int K, int G_, int c_) { nM = M / BM; nN = N / BM; nwg = nM * nN; G = G_; c = c_; ntK = K / BK; }
    __host__ __device__ void map(int L, Unit& u) const { int wgid = L; { const int q = nwg / NXCD, r = nwg % NXCD, xcd = wgid % NXCD, off = wgid / NXCD; wgid = (xcd < r ? xcd * (q + 1) : r * (q + 1) + (xcd - r) * q) + off; }
        const int nig = WGM * nN, gid = wgid / nig, fm = gid * WGM, gsz = (nM - fm) < WGM ? (nM - fm) : WGM; u.pm = fm + ((wgid % nig) % gsz); u.pn = (wgid % nig) / gsz; }
    __host__ __device__ bool next(int i, Unit& u) const {
        const long L = (long)i * G + c; if (L >= nwg) return false;
        int wgid = (int)L; { const int q = nwg / NXCD, r = nwg % NXCD, xcd = wgid % NXCD, off = wgid / NXCD; wgid = (xcd < r ? xcd * (q + 1) : r * (q + 1) + (xcd - r) * q) + off; }
        const int nig = WGM * nN, gid = wgid / nig, fm = gid * WGM, gsz = (nM - fm) < WGM ? (nM - fm) : WGM;
        u.pm = fm + ((wgid % nig) % gsz); u.pn = (wgid % nig) / gsz; u.k0 = 0; u.nt = ntK; u.role = 0; u.slot = 0; return true;
    }
    __device__ __forceinline__ void a_ready(const Unit&) const {}
    __device__ __forceinline__ void done(const Unit&) const {}
};

__device__ __forceinline__ unsigned cvt_pk_bf16(float lo, float hi) { unsigned r; asm volatile("v_cvt_pk_bf16_f32 %0, %1, %2" : "=v"(r) : "v"(lo), "v"(hi)); return r; }
typedef float f32x2 __attribute__((ext_vector_type(2)));
template <class Epi, class Sched, bool ALIGN_EPI = false, bool SP2 = false>
__device__ __forceinline__ void gemm_phase(PG8_LAS unsigned char* lds, const Gemm g, const Sched& S, const Epi& E) {
    const int tid = tid_opaque(), wid = __builtin_amdgcn_readfirstlane(tid >> 6), lane = tid & 63, wr = wid >> 2, wc = wid & 3, fr = lane & 15, fq = lane >> 4;
    const int K = g.K;
    unsigned voffA[2], voffB[2];
#pragma unroll
    for (int i = 0; i < 2; ++i) { int R, C; stage_rc(tid * 16 + i * 8192, R, C); const int Rb = Epi::PERM ? ((R & ~31) + perm32(R & 31)) : R;
        voffA[i] = (unsigned)(R * K + C) * 2u; voffB[i] = (unsigned)(Rb * K + C) * 2u; }
    const size_t kstep = (size_t)(BK * 2);
    const size_t hstep = (size_t)HALF * K * 2;
    const size_t tstep = 2 * hstep;
    const unsigned ldsw = (unsigned)wid * 1024u;
    const int aoff = lds_byte(wr * 64 + fr, fq * 8), boff = lds_byte(wc * 32 + fr, fq * 8);
#define PG8_SA(b, h) (((b) * 2 + (h)) * HTB)
#define PG8_SB(b, h) ((4 + (b) * 2 + (h)) * HTB)
#define PG8_STAGE(bufoff, gbase, voff) do { _Pragma("unroll") for (int _i = 0; _i < 2; ++_i) \
        __builtin_amdgcn_global_load_lds((const unsigned*)((const char*)(gbase) + (voff)[_i]), (PG8_LAS unsigned*)(lds + (bufoff) + ldsw + _i * 8192), 16, 0, 0); } while (0)
#define PG8_LDA(dst, b, h) do { _Pragma("unroll") for (int m = 0; m < 4; ++m) _Pragma("unroll") for (int k = 0; k < 2; ++k) dst[m][k] = *(const PG8_LAS bf16x8*)(lds + PG8_SA(b, h) + aoff + m * 2048 + k * 1024); } while (0)
#define PG8_LDB(dst, b, h) do { _Pragma("unroll") for (int n = 0; n < 2; ++n) _Pragma("unroll") for (int k = 0; k < 2; ++k) dst[n][k] = *(const PG8_LAS bf16x8*)(lds + PG8_SB(b, h) + boff + n * 2048 + k * 1024); } while (0)
#define PG8_MMA(ai, bj, At, Bt) do { __builtin_amdgcn_s_setprio(1); _Pragma("unroll") for (int m = 0; m < 4; ++m) _Pragma("unroll") for (int n = 0; n < 2; ++n) _Pragma("unroll") for (int k = 0; k < 2; ++k) \
        acc[ai][bj][m][n] = __builtin_amdgcn_mfma_f32_16x16x32_bf16(Bt[n][k], At[m][k], acc[ai][bj][m][n], 0, 0, 0); __builtin_amdgcn_s_setprio(0); } while (0)
#define PG8_WAIT_V(n) asm volatile("s_waitcnt vmcnt(" #n ")" ::: "memory")
#define PG8_WAIT_L(n) asm volatile("s_waitcnt lgkmcnt(" #n ")" ::: "memory")
#define PG8_BAR __builtin_amdgcn_s_barrier()
#define PG8_SCHED __builtin_amdgcn_sched_barrier(0)
    Unit cur, nxt; int ui = 0;
    if (!S.next(0, cur)) return;
    f32x4 acc[2][2][4][2];
#pragma unroll
    for (int a = 0; a < 2; ++a)
#pragma unroll
        for (int b = 0; b < 2; ++b)
#pragma unroll
            for (int m = 0; m < 4; ++m)
#pragma unroll
                for (int n = 0; n < 2; ++n) acc[a][b][m][n] = (f32x4){0.f, 0.f, 0.f, 0.f};
    bf16x8 At[4][2], B0[2][2], B1[2][2];
    const char* cA = (const char*)g.A + (size_t)cur.pm * tstep + (size_t)cur.k0 * kstep; const char* cB = (const char*)g.Bt + (size_t)cur.pn * tstep + (size_t)cur.k0 * kstep; int nt = cur.nt;
    S.a_ready(cur);
    if constexpr (SP2) {
        PG8_STAGE(PG8_SB(0, 0), cB, voffB); PG8_STAGE(PG8_SB(0, 1), cB + hstep, voffB); PG8_STAGE(PG8_SA(0, 0), cA, voffA); PG8_STAGE(PG8_SA(0, 1), cA + hstep, voffA);
        if (wr == 1) PG8_BAR;
        PG8_WAIT_V(2); PG8_BAR;
        PG8_STAGE(PG8_SB(1, 0), cB + kstep, voffB); PG8_STAGE(PG8_SA(1, 0), cA + kstep, voffA); PG8_STAGE(PG8_SB(1, 1), cB + hstep + kstep, voffB);
        PG8_WAIT_V(6); PG8_BAR;
    } else {
        PG8_STAGE(PG8_SB(0, 0), cB, voffB); PG8_STAGE(PG8_SA(0, 0), cA, voffA); PG8_STAGE(PG8_SB(0, 1), cB + hstep, voffB); PG8_STAGE(PG8_SA(0, 1), cA + hstep, voffA);
        if (wr == 1) PG8_BAR;
        PG8_WAIT_V(4); PG8_BAR;
        PG8_STAGE(PG8_SB(1, 0), cB + kstep, voffB); PG8_STAGE(PG8_SA(1, 0), cA + kstep, voffA); PG8_STAGE(PG8_SB(1, 1), cB + hstep + kstep, voffB);
        PG8_WAIT_V(6); PG8_BAR;
    }
    for (;;) {
        const bool has_next = S.next(ui + 1, nxt);
        const char* nA = has_next ? (const char*)g.A + (size_t)nxt.pm * tstep + (size_t)nxt.k0 * kstep : cA; const char* nB = has_next ? (const char*)g.Bt + (size_t)nxt.pn * tstep + (size_t)nxt.k0 * kstep : cB;
        for (int t = 0; t < nt; t += 2) {
            const bool last = (t == nt - 2);
            const char* a1 = cA + (size_t)(t + 1) * kstep;
            const char* a2 = last ? nA : cA + (size_t)(t + 2) * kstep; const char* b2 = last ? nB : cB + (size_t)(t + 2) * kstep;
            const char* a3 = a2 + kstep; const char* b3 = b2 + kstep;
            if (last && has_next) S.a_ready(nxt);
            if constexpr (SP2) {
            PG8_LDB(B0, 0, 0); PG8_LDB(B1, 0, 1); PG8_SCHED; PG8_LDA(At, 0, 0); PG8_STAGE(PG8_SA(1, 1), a1 + hstep, voffA);
            PG8_WAIT_V(8); PG8_WAIT_L(0); PG8_BAR; PG8_MMA(0, 0, At, B0); PG8_MMA(0, 1, At, B1); PG8_BAR; PG8_SCHED;
            PG8_LDA(At, 0, 1); PG8_STAGE(PG8_SB(0, 0), b2, voffB); PG8_STAGE(PG8_SB(0, 1), b2 + hstep, voffB); PG8_STAGE(PG8_SA(0, 0), a2, voffA);
            PG8_WAIT_V(8); PG8_WAIT_L(0); PG8_BAR; PG8_MMA(1, 0, At, B0); PG8_MMA(1, 1, At, B1); PG8_BAR; PG8_SCHED;
            PG8_LDB(B0, 1, 0); PG8_LDB(B1, 1, 1); PG8_SCHED; PG8_LDA(At, 1, 0); PG8_STAGE(PG8_SA(0, 1), a2 + hstep, voffA);
            PG8_WAIT_V(8); PG8_WAIT_L(0); PG8_BAR; PG8_MMA(0, 0, At, B0); PG8_MMA(0, 1, At, B1); PG8_BAR; PG8_SCHED;
            PG8_LDA(At, 1, 1); PG8_STAGE(PG8_SB(1, 0), b3, voffB); PG8_STAGE(PG8_SB(1, 1), b3 + hstep, voffB); PG8_STAGE(PG8_SA(1, 0), a3, voffA);
            PG8_WAIT_V(8); PG8_WAIT_L(0); PG8_BAR; PG8_MMA(1, 0, At, B0); PG8_MMA(1, 1, At, B1); PG8_BAR; PG8_SCHED;
            } else {
            PG8_LDB(B0, 0, 0); PG8_SCHED; PG8_LDA(At, 0, 0); PG8_STAGE(PG8_SA(1, 1), a1 + hstep, voffA);
            PG8_WAIT_L(8); PG8_BAR; PG8_WAIT_L(0); PG8_MMA(0, 0, At, B0); PG8_BAR; PG8_SCHED;
            PG8_LDB(B1, 0, 1); PG8_STAGE(PG8_SB(0, 0), b2, voffB);
            PG8_BAR; PG8_WAIT_L(0); PG8_MMA(0, 1, At, B1); PG8_BAR;
            PG8_LDA(At, 0, 1); PG8_STAGE(PG8_SA(0, 0), a2, voffA);
            PG8_BAR; PG8_WAIT_L(0); PG8_MMA(1, 0, At, B0); PG8_BAR; PG8_SCHED;
            PG8_STAGE(PG8_SB(0, 1), b2 + hstep, voffB);
            PG8_WAIT_V(6); PG8_BAR; PG8_MMA(1, 1, At, B1); PG8_BAR;
            PG8_LDB(B0, 1, 0); PG8_SCHED; PG8_LDA(At, 1, 0); PG8_STAGE(PG8_SA(0, 1), a2 + hstep, voffA);
            PG8_WAIT_L(8); PG8_BAR; PG8_WAIT_L(0); PG8_MMA(0, 0, At, B0); PG8_BAR; PG8_SCHED;
            PG8_LDB(B1, 1, 1); PG8_STAGE(PG8_SB(1, 0), b3, voffB);
            PG8_BAR; PG8_WAIT_L(0); PG8_MMA(0, 1, At, B1); PG8_BAR;
            PG8_LDA(At, 1, 1); PG8_STAGE(PG8_SA(1, 0), a3, voffA);
            PG8_BAR; PG8_WAIT_L(0); PG8_MMA(1, 0, At, B0); PG8_BAR; PG8_SCHED;
            PG8_STAGE(PG8_SB(1, 1), b3 + hstep, voffB);
            PG8_WAIT_V(6); PG8_BAR; PG8_MMA(1, 1, At, B1); PG8_BAR;
            }
        }
        if constexpr (ALIGN_EPI) { if (wr == 0) PG8_BAR; }
        if constexpr (!Epi::AFTER_DRAIN) { E(acc, cur, wr, wc, fr, fq); S.done(cur); }
        if (!has_next) break;
#pragma unroll
        for (int a = 0; a < 2; ++a)
#pragma unroll
            for (int b = 0; b < 2; ++b)
#pragma unroll
                for (int m = 0; m < 4; ++m)
#pragma unroll
                    for (int n = 0; n < 2; ++n) acc[a][b][m][n] = (f32x4){0.f, 0.f, 0.f, 0.f};
        cur = nxt; cA = nA; cB = nB; nt = cur.nt; ++ui;
        if constexpr (ALIGN_EPI) { if (wr == 1) PG8_BAR; }
    }
    PG8_WAIT_V(0);
    if constexpr (!ALIGN_EPI) { if (wr == 0) PG8_BAR; }
    PG8_BAR;
    if constexpr (Epi::AFTER_DRAIN) { E.fused(acc, cur, wr, wc, fr, fq, lds, wid, lane); S.done(cur); }
#undef PG8_SA
#undef PG8_SB
#undef PG8_STAGE
#undef PG8_LDA
#undef PG8_LDB
#undef PG8_MMA
#undef PG8_WAIT_V
#undef PG8_WAIT_L
#undef PG8_BAR
#undef PG8_SCHED
}
}
constexpr size_t WB_AB = 2 * MiB, WB_OUTAB = 8 * MiB, WB_FFI0 = 10 * MiB, WB_FFO0 = 21 * MiB, WB_INC = 27 * MiB, WB_OUTC = 30 * MiB, WB_FFI1 = 32 * MiB, WB_FFO1 = 43 * MiB;
static_assert(WB_FFO1 + (size_t)DM * DFF * 2 <= WS_XN && WB_AB + (size_t)ABMAIN * DM * 2 <= WB_OUTAB && WB_FFI0 + (size_t)2 * DFF * DM * 2 <= WB_FFO0 && WB_FFO0 + (size_t)DM * DFF * 2 <= WB_INC &&
              WB_INC + (size_t)CIN * DM * 2 <= WB_OUTC && WB_FFI1 + (size_t)2 * DFF * DM * 2 <= WB_FFO1, "weight copy map");

typedef unsigned v4u __attribute__((ext_vector_type(4)));
typedef unsigned v2u __attribute__((ext_vector_type(2)));
typedef float f32x4 __attribute__((ext_vector_type(4)));
__device__ __forceinline__ unsigned pk2(float lo, float hi) { return (unsigned)f2bf(lo) | ((unsigned)f2bf(hi) << 16); }
__device__ __forceinline__ float fsigmoid(float x) { return __builtin_amdgcn_rcpf(1.0f + __builtin_amdgcn_exp2f(-1.4426950408889634f * x)); }

__device__ __forceinline__ void p0_transpose_item(const float* W, int K, int ldw, int c0, int k0, bf16_t* WT, int drow, LAS float* scr, int lane) {
    { f32x4 tv[8]; const int rr = lane >> 3, cg = (lane & 7) * 4;
#pragma unroll
      for (int i = 0; i < 8; ++i) tv[i] = *(const f32x4*)(W + (size_t)(k0 + 8 * i + rr) * ldw + c0 + cg);
#pragma unroll
      for (int i = 0; i < 8; ++i) { LAS float* d = scr + (8 * i + rr) * 33 + cg; d[0] = tv[i][0]; d[1] = tv[i][1]; d[2] = tv[i][2]; d[3] = tv[i][3]; } }
    asm volatile("s_waitcnt lgkmcnt(0)" ::: "memory");
    const int c = lane & 7;
#pragma unroll
    for (int j = 0; j < 4; ++j) { const int n = (lane >> 3) + 8 * j; const LAS float* s = scr + (8 * c) * 33 + n;
        v4u o; o.x = pk2(s[0 * 33], s[1 * 33]); o.y = pk2(s[2 * 33], s[3 * 33]); o.z = pk2(s[4 * 33], s[5 * 33]); o.w = pk2(s[6 * 33], s[7 * 33]);
        *(GAS v4u*)(WT + (size_t)(drow + n) * K + k0 + 8 * c) = o; }
    asm volatile("s_waitcnt lgkmcnt(0)" ::: "memory");
}
struct CvtJob { const float* W; bf16_t* WT; int K, ldw, c0, ncols, mode, Hn, dbase; };
__device__ __forceinline__ int cvt_items(const CvtJob& j) { return (j.K / 64) * (j.ncols / 32); }
__device__ __forceinline__ void cvt_run(const CvtJob& j, int item, LAS float* scr, int lane) {
    const int nblk = j.ncols / 32, kb = item / nblk, nb = item % nblk; const int c = j.c0 + 32 * nb;
    int drow; if (j.mode == 0) drow = j.dbase + 32 * nb; else { const int cc = c < j.Hn ? c : c - j.Hn; drow = 256 * (cc / 128) + (cc % 128) + (c < j.Hn ? 0 : 128); }
    p0_transpose_item(j.W, j.K, j.ldw, c, 64 * kb, j.WT, drow, scr, lane);
}
__device__ __forceinline__ void p0_weights(const Params& p, LAS unsigned char* lds, int vcu, int G) {
    const int tid_ = tid_opaque(); const int lane = tid_ & 63, wave = __builtin_amdgcn_readfirstlane(tid_ >> 6);
    LAS float* scr = (LAS float*)(lds + wave * 16384);
    const int gw = vcu * NWAVES + wave, NGW = G * NWAVES;
    CvtJob jobs[9] = {
        {p.winab, (bf16_t*)(p.ws + WB_AB), DM, ABIN, 0, 2 * CCH, 1, CCH, 0},
        {p.winab, (bf16_t*)(p.ws + WB_AB), DM, ABIN, 2 * CCH, 4 * MW, 0, 0, 2 * CCH},
        {p.woutab, (bf16_t*)(p.ws + WB_OUTAB), DM, DM, 0, DM, 0, 0, 0},
        {p.wffi, (bf16_t*)(p.ws + WB_FFI0), DM, 2 * DFF, 0, 2 * DFF, 1, DFF, 0},
        {p.wffo, (bf16_t*)(p.ws + WB_FFO0), DFF, DM, 0, DM, 0, 0, 0},
        {p.winc, (bf16_t*)(p.ws + WB_INC), DM, CIN, 0, CIN, 0, 0, 0},
        {p.woutc, (bf16_t*)(p.ws + WB_OUTC), DM, DM, 0, DM, 0, 0, 0},
        {p.wffi + (size_t)DM * 2 * DFF, (bf16_t*)(p.ws + WB_FFI1), DM, 2 * DFF, 0, 2 * DFF, 1, DFF, 0},
        {p.wffo + (size_t)DFF * DM, (bf16_t*)(p.ws + WB_FFO1), DFF, DM, 0, DM, 0, 0, 0}};
    int base = 0;
#pragma unroll
    for (int jj = 0; jj < 9; ++jj) {
        const int n = cvt_items(jobs[jj]);
        int first = ((gw - base) % NGW + NGW) % NGW;
        for (int it = first; it < n; it += NGW) cvt_run(jobs[jj], it, scr, lane);
        base += n;
    }
}

struct EpiAB {
    static constexpr bool PERM = true, AFTER_DRAIN = false;
    bf16_t* upre; bf16_t* qkvo;
    __device__ __forceinline__ void operator()(const f32x4 (&acc)[2][2][4][2], const pg8::Unit& u, int wr, int wc, int fr, int fq) const {
        const int row0 = u.pm * 256 + wr * 64 + fr, lc = wc * 32 + 8 * fq;
        if (u.pn < 4) {
#pragma unroll
            for (int ai = 0; ai < 2; ++ai)
#pragma unroll
                for (int m = 0; m < 4; ++m) { const f32x4 a0 = acc[ai][0][m][0], a1 = acc[ai][0][m][1], g0 = acc[ai][1][m][0], g1 = acc[ai][1][m][1]; v4u w;
                    w.x = pg8::cvt_pk_bf16(a0[0] * fsigmoid(g0[0]), a0[1] * fsigmoid(g0[1])); w.y = pg8::cvt_pk_bf16(a0[2] * fsigmoid(g0[2]), a0[3] * fsigmoid(g0[3]));
                    w.z = pg8::cvt_pk_bf16(a1[0] * fsigmoid(g1[0]), a1[1] * fsigmoid(g1[1])); w.w = pg8::cvt_pk_bf16(a1[2] * fsigmoid(g1[2]), a1[3] * fsigmoid(g1[3]));
                    *(v4u*)(upre + (size_t)(row0 + ai * 128 + m * 16) * CCH + 128 * u.pn + lc) = w; }
        } else {
#pragma unroll
            for (int bj = 0; bj < 2; ++bj) { const int col = 256 * (u.pn - 4) + 128 * bj + lc; const int part = col / MW; const float sc = part == 1 ? 0.08838834764831845f : 1.0f;
#pragma unroll
                for (int ai = 0; ai < 2; ++ai)
#pragma unroll
                    for (int m = 0; m < 4; ++m) { f32x4 v0 = acc[ai][bj][m][0] * sc, v1 = acc[ai][bj][m][1] * sc;
                        if (part == 3) { v0 = (f32x4){fsigmoid(v0[0]), fsigmoid(v0[1]), fsigmoid(v0[2]), fsigmoid(v0[3])}; v1 = (f32x4){fsigmoid(v1[0]), fsigmoid(v1[1]), fsigmoid(v1[2]), fsigmoid(v1[3])}; }
                        v4u w; w.x = pg8::cvt_pk_bf16(v0[0], v0[1]); w.y = pg8::cvt_pk_bf16(v0[2], v0[3]); w.z = pg8::cvt_pk_bf16(v1[0], v1[1]); w.w = pg8::cvt_pk_bf16(v1[2], v1[3]);
                        *(v4u*)(qkvo + (size_t)(row0 + ai * 128 + m * 16) * (4 * MW) + col) = w; } }
        }
    }
};
static_assert(MDK == 128, "EpiAB hard-codes MDK^-0.5");
struct EpiRes {
    static constexpr bool PERM = true, AFTER_DRAIN = false;
    const float* xp; const float* xs;
    bf16_t* Y16; bf16_t* XN; float* ssq; const float* mod_g; const float* mod_sc; const float* ng;
    int from_input; int pad_;
    __device__ __forceinline__ float piece(int row, int col, int cls, f32x4 v0, f32x4 v1) const {
        const float* gv = mod_g + (size_t)cls * 6 * DM + col; const size_t off = (size_t)row * DM + col; f32x4 x0, x1;
        if (from_input) { const float* xin = (row < MC ? xp : xs - (size_t)MC * DM) + off; x0 = *(const f32x4*)xin; x1 = *(const f32x4*)(xin + 4); }
        else { const v4u r = *(const v4u*)(Y16 + off); x0 = (f32x4){__uint_as_float(r.x << 16), __uint_as_float(r.x & 0xffff0000u), __uint_as_float(r.y << 16), __uint_as_float(r.y & 0xffff0000u)};
            x1 = (f32x4){__uint_as_float(r.z << 16), __uint_as_float(r.z & 0xffff0000u), __uint_as_float(r.w << 16), __uint_as_float(r.w & 0xffff0000u)}; }
        x0 += *(const f32x4*)gv * v0; x1 += *(const f32x4*)(gv + 4) * v1;
        v4u w; w.x = pg8::cvt_pk_bf16(x0[0], x0[1]); w.y = pg8::cvt_pk_bf16(x0[2], x0[3]); w.z = pg8::cvt_pk_bf16(x1[0], x1[1]); w.w = pg8::cvt_pk_bf16(x1[2], x1[3]); *(v4u*)(Y16 + off) = w;
        if (ng) { const float* scv = mod_sc + (size_t)cls * 6 * DM + col; const f32x4 t0 = x0 * (*(const f32x4*)(ng + col) * (*(const f32x4*)scv + 1.0f)), t1 = x1 * (*(const f32x4*)(ng + col + 4) * (*(const f32x4*)(scv + 4) + 1.0f));
            v4u q; q.x = pg8::cvt_pk_bf16(t0[0], t0[1]); q.y = pg8::cvt_pk_bf16(t0[2], t0[3]); q.z = pg8::cvt_pk_bf16(t1[0], t1[1]); q.w = pg8::cvt_pk_bf16(t1[2], t1[3]); *(v4u*)(XN + off) = q; }
        return ((x0[0] * x0[0] + x0[1] * x0[1]) + (x0[2] * x0[2] + x0[3] * x0[3])) + ((x1[0] * x1[0] + x1[1] * x1[1]) + (x1[2] * x1[2] + x1[3] * x1[3]));
    }
    __device__ __forceinline__ void operator()(const f32x4 (&acc)[2][2][4][2], const pg8::Unit& u, int wr, int wc, int fr, int fq) const {
        const int row0 = u.pm * 256 + wr * 64 + fr; const int cls = cls_of(u.pm * 256); const int colb = u.pn * 256 + wc * 32 + 8 * fq;
#pragma unroll
        for (int ai = 0; ai < 2; ++ai)
#pragma unroll
            for (int m = 0; m < 4; ++m) { const int row = row0 + ai * 128 + m * 16; float s = 0.f;
#pragma unroll
                for (int bj = 0; bj < 2; ++bj) s += piece(row, colb + bj * 128, cls, acc[ai][bj][m][0], acc[ai][bj][m][1]);
                s += __shfl_xor(s, 16); s += __shfl_xor(s, 32); if (fq == 0) atomicAdd(ssq + row, s);
                if (m & 1) asm volatile("" ::: "memory"); }
    }
};
struct EpiFfnIn {
    static constexpr bool PERM = true, AFTER_DRAIN = false;
    bf16_t* H; const float* ssq; const float* sw;
    __device__ __forceinline__ void operator()(const f32x4 (&acc)[2][2][4][2], const pg8::Unit& u, int wr, int wc, int fr, int fq) const {
        const int row0 = u.pm * 256 + wr * 64 + fr, lc = wc * 32 + 8 * fq; const int cls = cls_of(u.pm * 256); const int col = 128 * u.pn + lc;
        const float* swr = sw + (size_t)cls * 2 * DFF;
        const f32x4 sg0 = *(const f32x4*)(swr + col), sg1 = *(const f32x4*)(swr + col + 4), su0 = *(const f32x4*)(swr + DFF + col), su1 = *(const f32x4*)(swr + DFF + col + 4);
#pragma unroll
        for (int ai = 0; ai < 2; ++ai)
#pragma unroll
            for (int m = 0; m < 4; ++m) { const int row = row0 + ai * 128 + m * 16; const float rs = 1.0f / sqrtf(ssq[row] * (1.0f / DM) + EPSF);
                const f32x4 a0 = acc[ai][0][m][0] * rs + sg0, a1 = acc[ai][0][m][1] * rs + sg1, b0 = acc[ai][1][m][0] * rs + su0, b1 = acc[ai][1][m][1] * rs + su1; v4u w;
                w.x = pg8::cvt_pk_bf16(a0[0] * fsigmoid(a0[0]) * b0[0], a0[1] * fsigmoid(a0[1]) * b0[1]); w.y = pg8::cvt_pk_bf16(a0[2] * fsigmoid(a0[2]) * b0[2], a0[3] * fsigmoid(a0[3]) * b0[3]);
                w.z = pg8::cvt_pk_bf16(a1[0] * fsigmoid(a1[0]) * b1[0], a1[1] * fsigmoid(a1[1]) * b1[1]); w.w = pg8::cvt_pk_bf16(a1[2] * fsigmoid(a1[2]) * b1[2], a1[3] * fsigmoid(a1[3]) * b1[3]);
                *(v4u*)(H + (size_t)row * DFF + col) = w; }
    }
};
struct EpiQkv {
    static constexpr bool PERM = true, AFTER_DRAIN = false;
    bf16_t* qraw; bf16_t* kraw; bf16_t* ctxv; bf16_t* latv; float* outv; const float* ssq; const float* sw;
    __device__ __forceinline__ void operator()(const f32x4 (&acc)[2][2][4][2], const pg8::Unit& u, int wr, int wc, int fr, int fq) const {
        const int row0 = u.pm * 256 + wr * 64 + fr, lc = wc * 32 + 8 * fq; const int cls = cls_of(u.pm * 256); const float* swr = sw + (size_t)cls * CIN;
        float rs[2][4];
#pragma unroll
        for (int ai = 0; ai < 2; ++ai)
#pragma unroll
            for (int m = 0; m < 4; ++m) rs[ai][m] = 1.0f / sqrtf(ssq[row0 + ai * 128 + m * 16] * (1.0f / DM) + EPSF);
#pragma unroll
        for (int bj = 0; bj < 2; ++bj) { const int col = 256 * u.pn + 128 * bj + lc; const f32x4 s0 = *(const f32x4*)(swr + col), s1 = *(const f32x4*)(swr + col + 4);
#pragma unroll
            for (int ai = 0; ai < 2; ++ai)
#pragma unroll
                for (int m = 0; m < 4; ++m) { const int row = row0 + ai * 128 + m * 16; const f32x4 v0 = acc[ai][bj][m][0] * rs[ai][m] + s0, v1 = acc[ai][bj][m][1] * rs[ai][m] + s1;
                    v4u w; w.x = pg8::cvt_pk_bf16(v0[0], v0[1]); w.y = pg8::cvt_pk_bf16(v0[2], v0[3]); w.z = pg8::cvt_pk_bf16(v1[0], v1[1]); w.w = pg8::cvt_pk_bf16(v1[2], v1[3]);
                    if (u.pn < NQ * HDIM / 256) *(v4u*)(qraw + (size_t)row * (NQ * HDIM) + col) = w;
                    else if (u.pn == NQ * HDIM / 256) *(v4u*)(kraw + (size_t)row * (NKV * HDIM) + (col - NQ * HDIM)) = w;
                    else { const int c2 = col - (NQ + NKV) * HDIM;
                        if (row < MC) { *(v4u*)(ctxv + (size_t)row * (NKV * HDIM) + c2) = w; float* o = outv + (size_t)row * (NKV * HDIM) + c2; *(f32x4*)o = v0; *(f32x4*)(o + 4) = v1; }
                        else { const int b = (row - MC) / LSEQ, s = (row - MC) % LSEQ; *(v4u*)(latv + ((size_t)b * SKVL + s) * (NKV * HDIM) + c2) = w; } } } }
    }
};
static_assert(NKV * HDIM == 256 && (NQ * HDIM) % 256 == 0, "EpiQkv tile mapping");

constexpr int CW_SPLIT = 8192;
constexpr size_t SLAB_BYTES = (size_t)64 * 4 * 16 * 512 * 16;
struct RoundZeroOrder : pg8::StaticOrder {
    bool split;
    __device__ void init(int M, int N, int K, int G_, int c_) { pg8::StaticOrder::init(M, N, K, G_, c_); split = (G == 256 && nwg > 256 && nwg <= 320 && ntK >= 8); }
    __device__ bool next(int i, pg8::Unit& u) const { if (split && i > 0) return false; return pg8::StaticOrder::next(i, u); }
};
struct QuarterOrder : pg8::StaticOrder {
    __device__ bool next(int i, pg8::Unit& u) const {
        if (i > 0) return false; const int L = 256 + (c >> 2), q = c & 3; if (L >= nwg) return false;
        map(L, u); const int base = (ntK / 8) * 2, rem = (ntK - 4 * base) / 2;
        int k0 = 0; for (int j = 0; j < q; ++j) k0 += base + (j < rem ? 2 : 0);
        u.k0 = k0; u.nt = base + (q < rem ? 2 : 0); u.role = 1 + q; u.slot = c >> 2; return true;
    }
};
struct EpiPartial {
    static constexpr bool PERM = true, AFTER_DRAIN = false;
    unsigned char* slab; unsigned* cnt;
    __device__ __forceinline__ void operator()(const f32x4 (&acc)[2][2][4][2], const pg8::Unit& u, int wr, int wc, int fr, int fq) const {
        const int tid = (wr * 4 + wc) * 64 + fq * 16 + fr;
        unsigned char* dst = slab + ((size_t)u.slot * 4 + (u.role - 1)) * (16 * 512 * 16) + (size_t)tid * 16;
#pragma unroll
        for (int ai = 0; ai < 2; ++ai)
#pragma unroll
            for (int bj = 0; bj < 2; ++bj)
#pragma unroll
                for (int m = 0; m < 4; ++m) { const f32x4 a = acc[ai][bj][m][0], b = acc[ai][bj][m][1]; v4u w;
                    w.x = pg8::cvt_pk_bf16(a[0], a[1]); w.y = pg8::cvt_pk_bf16(a[2], a[3]); w.z = pg8::cvt_pk_bf16(b[0], b[1]); w.w = pg8::cvt_pk_bf16(b[2], b[3]);
                    asm volatile("global_store_dwordx4 %0, %1, off sc1\n\ts_nop 1" :: "v"(dst), "v"(w) : "memory");
                    dst += 512 * 16; asm volatile("" : "+v"(dst)); }
        asm volatile("s_waitcnt vmcnt(0)" ::: "memory");
        if (fr == 0 && fq == 0) __hip_atomic_fetch_add(cnt + (size_t)u.slot * 64, 1u, __ATOMIC_RELAXED, __HIP_MEMORY_SCOPE_AGENT);
    }
};
__device__ __forceinline__ void tail_reduce(const EpiRes& E, const unsigned char* slab, unsigned* cnt, int G, int bx, int nN, int nM) {
    pg8::StaticOrder S; S.nM = nM; S.nN = nN; S.nwg = nM * nN; S.G = G; S.c = bx; S.ntK = 0;
    const int L = 256 + (bx >> 2), q = bx & 3; if (L >= S.nwg) return;
    pg8::Unit u; S.map(L, u); const int slot = bx >> 2, ai = q >> 1, bj = q & 1;
    const int tid = tid_opaque(), wid = tid >> 6, lane = tid & 63, wr = wid >> 2, wc = wid & 3, fr = lane & 15, fq = lane >> 4;
    unsigned* c = cnt + (size_t)slot * 64; unsigned spins = 0;
    while ((unsigned)__builtin_amdgcn_readfirstlane(__hip_atomic_load(c, __ATOMIC_RELAXED, __HIP_MEMORY_SCOPE_AGENT)) < 32u) { __builtin_amdgcn_s_sleep(2); if (++spins > (1u << 22)) break; }
    __builtin_amdgcn_fence(__ATOMIC_ACQUIRE, "agent");
    const unsigned char* base = slab + (size_t)slot * 4 * (16 * 512 * 16) + (size_t)tid * 16;
    v4u w[4][4];
#pragma unroll
    for (int m = 0; m < 4; ++m)
#pragma unroll
        for (int r = 0; r < 4; ++r) w[m][r] = *(const v4u*)(base + (size_t)r * (16 * 512 * 16) + (size_t)((ai * 2 + bj) * 4 + m) * (512 * 16));
    const int row0 = u.pm * 256 + ai * 128 + wr * 64 + fr; const int cls = cls_of(u.pm * 256); const int col = u.pn * 256 + bj * 128 + wc * 32 + 8 * fq;
#pragma unroll
    for (int m = 0; m < 4; ++m) { const int row = row0 + m * 16; f32x4 v[2] = {(f32x4){0.f, 0.f, 0.f, 0.f}, (f32x4){0.f, 0.f, 0.f, 0.f}};
#pragma unroll
        for (int r = 0; r < 4; ++r) { const v4u x = w[m][r]; v[0] += (f32x4){__uint_as_float(x.x << 16), __uint_as_float(x.x & 0xffff0000u), __uint_as_float(x.y << 16), __uint_as_float(x.y & 0xffff0000u)};
            v[1] += (f32x4){__uint_as_float(x.z << 16), __uint_as_float(x.z & 0xffff0000u), __uint_as_float(x.w << 16), __uint_as_float(x.w & 0xffff0000u)}; }
        float sq = E.piece(row, col, cls, v[0], v[1]);
        sq += __shfl_xor(sq, 16); sq += __shfl_xor(sq, 32); if (fq == 0) atomicAdd(E.ssq + row, sq); }
}
namespace att {
typedef unsigned short bf16;
constexpr int D = 128, NW = 8, QBLK = 32, KVBLK = 64; constexpr float SCALE = 0.088388347648318440f; constexpr float THR = 8.f; constexpr int SDEPTH = 1;
constexpr int LDQ = NQ * HDIM, LDK = NKV * HDIM, LDO = DM;
constexpr size_t SHM_V = KVBLK * D * 2, SHM_K = KVBLK * D * 2, SHM_ATTN = 2 * SHM_V + 2 * SHM_K + NW * 64 * 4;
using bf16x8 = __attribute__((ext_vector_type(8))) short;
using s16x4  = __attribute__((ext_vector_type(4))) short;
using f32x16 = __attribute__((ext_vector_type(16))) float;
using f32x8  = __attribute__((ext_vector_type(8))) float;
using u32x4  = __attribute__((ext_vector_type(4))) unsigned;
#define KSWZ(row, colB) ((row) * 256 + ((colB) ^ (((row) & 7) << 4)))
#define SBAR() __builtin_amdgcn_sched_barrier(0)
__device__ __forceinline__ int crow(int r, int hi) { return (r & 3) + 8 * (r >> 2) + 4 * hi; }
__device__ __forceinline__ unsigned cvtpk(float lo, float hi) {
  unsigned r; asm volatile("v_cvt_pk_bf16_f32 %0, %1, %2" : "=v"(r) : "v"(lo), "v"(hi)); return r;
}
template <typename TIn> struct Stage;
template <> struct Stage<bf16>  { using T = bf16x8;
  __device__ static __forceinline__ T ld8(const bf16* p) { return *reinterpret_cast<const bf16x8*>(p); }
  __device__ static __forceinline__ bf16x8 tobf(T x) { return x; } };
__device__ __forceinline__ void partialSM(f32x16& p0, f32x16& p1, float& m_reg, float& mn, float& alpha) {
  constexpr float C = SCALE * 1.4426950408889634f;
  float pmax = p0[0]; for (int r = 1; r < 16; ++r) pmax = fmaxf(pmax, p0[r]); for (int r = 0; r < 16; ++r) pmax = fmaxf(pmax, p1[r]);
  { auto rr = __builtin_amdgcn_permlane32_swap(__float_as_uint(pmax), __float_as_uint(pmax), false, false);
    pmax = fmaxf(__uint_as_float(rr[0]), __uint_as_float(rr[1])); }
  if (__builtin_expect(__all(pmax - m_reg <= THR / SCALE), 1)) { mn = m_reg; alpha = 1.f; }
  else { mn = fmaxf(m_reg, pmax); alpha = __builtin_amdgcn_exp2f((m_reg - mn) * C); m_reg = mn; }
  float mnC = -mn * C;
  for (int r = 0; r < 16; ++r) p0[r] = fmaf(p0[r], C, mnC); for (int r = 0; r < 16; ++r) p1[r] = fmaf(p1[r], C, mnC);
  for (int r = 0; r < 16; ++r) p0[r] = __builtin_amdgcn_exp2f(p0[r]);
}
__device__ __forceinline__ void finishSM(f32x16& p0, f32x16& p1, float alpha, float& l_reg, bf16x8& pa0, bf16x8& pa1, bf16x8& pa2, bf16x8& pa3) {
  for (int r = 0; r < 16; ++r) p1[r] = __builtin_amdgcn_exp2f(p1[r]);
  float ps = 0; for (int r = 0; r < 16; ++r) ps += p0[r]; for (int r = 0; r < 16; ++r) ps += p1[r];
  { auto rr = __builtin_amdgcn_permlane32_swap(__float_as_uint(ps), __float_as_uint(ps), false, false);
    ps = __uint_as_float(rr[0]) + __uint_as_float(rr[1]); }
  l_reg = l_reg * alpha + ps;
#define PK4(P, BASE, OUT) do { unsigned a0 = cvtpk(P[BASE + 0], P[BASE + 1]), a1 = cvtpk(P[BASE + 2], P[BASE + 3]);   \
    unsigned b0 = cvtpk(P[BASE + 4], P[BASE + 5]), b1 = cvtpk(P[BASE + 6], P[BASE + 7]);                              \
    auto r0 = __builtin_amdgcn_permlane32_swap(a0, b0, false, false); auto r1 = __builtin_amdgcn_permlane32_swap(a1, b1, false, false); \
    u32x4 w = {r0[0], r1[0], r0[1], r1[1]}; OUT = *reinterpret_cast<bf16x8*>(&w); } while (0)
  PK4(p0, 0, pa0); PK4(p0, 8, pa1); PK4(p1, 0, pa2); PK4(p1, 8, pa3);
#undef PK4
}
__device__ __forceinline__ void qkt(f32x16& p0, f32x16& p1, const bf16* Ks, const bf16x8* qr, int r32, int hi) {
  p0 = f32x16{}; p1 = f32x16{};
  for (int d0 = 0; d0 < 8; ++d0) { int cb = (d0 * 16 + hi * 8) * 2;
    bf16x8 b0 = *reinterpret_cast<const bf16x8*>((const char*)Ks + KSWZ(r32, cb));
    bf16x8 b1 = *reinterpret_cast<const bf16x8*>((const char*)Ks + KSWZ(32 + r32, cb));
    p0 = __builtin_amdgcn_mfma_f32_32x32x16_bf16(b0, qr[d0], p0, 0, 0, 0);
    p1 = __builtin_amdgcn_mfma_f32_32x32x16_bf16(b1, qr[d0], p1, 0, 0, 0); }
}
__device__ __forceinline__ int v_st(int k, int c) { const int kk = (k & ~0xC) | ((k & 4) << 1) | ((k & 8) >> 1); return ((kk >> 3) * 4 + (c >> 5)) * 512 + ((kk & 7) * 32 + (c & 31)) * 2; }
__device__ __forceinline__ int v_rd_base(int lane) { return ((lane & 3) << 3) | (((lane >> 2) & 3) << 6) | (((lane >> 4) & 1) << 5) | (((lane >> 5) & 1) << 8); }
constexpr int v_rd_off(int d0, int ks, int half) { return d0 * 512 + ks * 4096 + half * 2048; }
template <int OFF> __device__ __forceinline__ s16x4 tr_read(int vb) {
  s16x4 r; asm volatile("ds_read_b64_tr_b16 %0, %1 offset:%2" : "=&v"(r) : "v"(vb), "i"(OFF) : "memory"); return r;
}
template <int D0> __device__ __forceinline__ void pv_one(f32x16& od, int vb, bf16x8 pa0, bf16x8 pa1, bf16x8 pa2, bf16x8 pa3) {
  const s16x4 l0 = tr_read<v_rd_off(D0, 0, 0)>(vb), h0 = tr_read<v_rd_off(D0, 0, 1)>(vb), l1 = tr_read<v_rd_off(D0, 1, 0)>(vb), h1 = tr_read<v_rd_off(D0, 1, 1)>(vb);
  const s16x4 l2 = tr_read<v_rd_off(D0, 2, 0)>(vb), h2 = tr_read<v_rd_off(D0, 2, 1)>(vb), l3 = tr_read<v_rd_off(D0, 3, 0)>(vb), h3 = tr_read<v_rd_off(D0, 3, 1)>(vb);
  asm volatile("s_waitcnt lgkmcnt(0)" ::: "memory"); SBAR();
#define PK(L, H) (bf16x8){L[0], L[1], L[2], L[3], H[0], H[1], H[2], H[3]}
  od = __builtin_amdgcn_mfma_f32_32x32x16_bf16(pa0, PK(l0, h0), od, 0, 0, 0);
  od = __builtin_amdgcn_mfma_f32_32x32x16_bf16(pa1, PK(l1, h1), od, 0, 0, 0);
  od = __builtin_amdgcn_mfma_f32_32x32x16_bf16(pa2, PK(l2, h2), od, 0, 0, 0);
  od = __builtin_amdgcn_mfma_f32_32x32x16_bf16(pa3, PK(l3, h3), od, 0, 0, 0);
#undef PK
}
__device__ __forceinline__ void pv_d0(f32x16* o, int vb, bf16x8 pa0, bf16x8 pa1, bf16x8 pa2, bf16x8 pa3) {
  pv_one<0>(o[0], vb, pa0, pa1, pa2, pa3); pv_one<1>(o[1], vb, pa0, pa1, pa2, pa3); pv_one<2>(o[2], vb, pa0, pa1, pa2, pa3); pv_one<3>(o[3], vb, pa0, pa1, pa2, pa3);
}

__device__ __forceinline__ void attn_dense_body(const bf16* __restrict__ Qb, const bf16* __restrict__ Kh, const bf16* __restrict__ Vh,
                                                bf16* __restrict__ Ob, int seq, char* lds) {
  typedef bf16 TQ;
  using St = Stage<bf16>; using SQ = Stage<TQ>;
  const int tid = tid_opaque(), wid = tid >> 6, lane = tid & 63, r32 = lane & 31, hi = lane >> 5;
  bf16* V_lds = (bf16*)lds; bf16* K_lds = (bf16*)(lds + 2 * SHM_V);
  float* ws = (float*)(lds + 2 * SHM_V + 2 * SHM_K) + wid * 64; float* li_l = ws; float* al_l = ws + 32;
  float m_reg = -1e30f, l_reg = 0; f32x16 o[4] = {}; bf16x8 qr[8];
  const TQ* Qw = Qb + (long)(wid * QBLK + r32) * LDQ + hi * 8;
#pragma unroll
  for (int d0 = 0; d0 < 8; ++d0) qr[d0] = SQ::tobf(SQ::ld8(Qw + d0 * 16));
  const int sr = tid >> 4, sc = (tid & 15) * 8, vst0 = v_st(sr, sc), vst1 = v_st(32 + sr, sc);
  const int vb0 = (int)(uintptr_t)V_lds + v_rd_base(lane);
  struct { typename St::T vs0, vs1, ks0, ks1; } sr_[SDEPTH];
#define SLOAD(i, k0) do { sr_[i].vs0 = St::ld8(&Vh[(long)((k0) + sr) * LDK + sc]); sr_[i].vs1 = St::ld8(&Vh[(long)((k0) + 32 + sr) * LDK + sc]); \
    sr_[i].ks0 = St::ld8(&Kh[(long)((k0) + sr) * LDK + sc]); sr_[i].ks1 = St::ld8(&Kh[(long)((k0) + 32 + sr) * LDK + sc]); } while (0)
#define SWRITE(b, i) do { *(bf16x8*)((char*)V_lds + (b) * SHM_V + vst0) = St::tobf(sr_[i].vs0);          \
    *(bf16x8*)((char*)V_lds + (b) * SHM_V + vst1) = St::tobf(sr_[i].vs1); int kc = sc * 2;               \
    *(bf16x8*)((char*)K_lds + (b) * SHM_K + KSWZ(sr, kc)) = St::tobf(sr_[i].ks0);                       \
    *(bf16x8*)((char*)K_lds + (b) * SHM_K + KSWZ(32 + sr, kc)) = St::tobf(sr_[i].ks1); } while (0)
#define SWAIT() do { if constexpr (SDEPTH == 2) asm volatile("s_waitcnt vmcnt(4)" ::: "memory"); else asm volatile("s_waitcnt vmcnt(0)" ::: "memory"); } while (0)
#define RESC(a) do { if (__any((a) < 1.f)) { if (hi == 0) al_l[r32] = (a); asm volatile("s_waitcnt lgkmcnt(0)" ::: "memory"); \
    for (int d = 0; d < 4; ++d) for (int r = 0; r < 16; ++r) o[d][r] *= al_l[crow(r, hi)]; } } while (0)
  f32x16 pA0, pA1, pB0, pB1; float mnA, mnB, alA, alB; bf16x8 pa0, pa1, pa2, pa3; const int NT = seq / KVBLK;
  constexpr int SE = 0, SO = SDEPTH - 1;
  SLOAD(SE, 0); asm volatile("s_waitcnt vmcnt(0)" ::: "memory"); SWRITE(0, SE); __syncthreads();
  qkt(pA0, pA1, K_lds, qr, r32, hi); partialSM(pA0, pA1, m_reg, mnA, alA);
  SLOAD(SO, KVBLK); if constexpr (SDEPTH == 2) { if (2 < NT) SLOAD(SE, 2 * KVBLK); }
  SWAIT(); SWRITE(1, SO); __syncthreads();
  for (int j = 1; j + 1 < NT; j += 2) {
    SBAR(); qkt(pB0, pB1, (bf16*)((char*)K_lds + SHM_K), qr, r32, hi);
    finishSM(pA0, pA1, alA, l_reg, pa0, pa1, pa2, pa3); SBAR();
    SLOAD(SO, (j + SDEPTH) * KVBLK); SBAR();
    pv_d0(o, vb0, pa0, pa1, pa2, pa3); partialSM(pB0, pB1, m_reg, mnB, alB);
    __syncthreads(); SWAIT(); SWRITE(0, SE);
    RESC(alB); __syncthreads();
    SBAR(); qkt(pA0, pA1, K_lds, qr, r32, hi);
    finishSM(pB0, pB1, alB, l_reg, pa0, pa1, pa2, pa3); SBAR();
    if (SDEPTH == 1 || j + 3 < NT) SLOAD(SE, (j + 1 + SDEPTH) * KVBLK); SBAR();
    pv_d0(o, vb0 + (int)SHM_V, pa0, pa1, pa2, pa3); partialSM(pA0, pA1, m_reg, mnA, alA);
    __syncthreads(); SWAIT(); SWRITE(1, SO);
    RESC(alA); __syncthreads();
  }
  SBAR(); qkt(pB0, pB1, (bf16*)((char*)K_lds + SHM_K), qr, r32, hi);
  finishSM(pA0, pA1, alA, l_reg, pa0, pa1, pa2, pa3); SBAR();
  pv_d0(o, vb0, pa0, pa1, pa2, pa3); partialSM(pB0, pB1, m_reg, mnB, alB);
  __syncthreads(); RESC(alB);
  finishSM(pB0, pB1, alB, l_reg, pa0, pa1, pa2, pa3); SBAR();
  pv_d0(o, vb0 + (int)SHM_V, pa0, pa1, pa2, pa3);
  if (hi == 0) li_l[r32] = l_reg; asm volatile("s_waitcnt lgkmcnt(0)" ::: "memory");
  float rli[16];
#pragma unroll
  for (int r = 0; r < 16; ++r) rli[r] = __builtin_amdgcn_rcpf(li_l[crow(r, hi)]);
  bf16* Ow = Ob + (long)(wid * QBLK) * LDO;
#pragma unroll
  for (int r = 0; r < 16; ++r) { int orow = crow(r, hi);
    for (int d0 = 0; d0 < 4; ++d0) Ow[(long)orow * LDO + d0 * 32 + r32] = f2bf(o[d0][r] * rli[r]); }
#undef SLOAD
#undef SWRITE
#undef SWAIT
#undef RESC
}
}
__device__ __forceinline__ void attn_phase(const Params& p, unsigned char* lds, int vcu, int G) {
    constexpr int QB = 256, LQB = LSEQ / QB, CQB = CSEQ / QB;
    constexpr int NUL = NLB * NQ * LQB, NUC = NCB * NQ * CQB, NU = NUL + NUC;
    const att::bf16* QR = (const att::bf16*)(p.ws + WS_QRAW); att::bf16* OB = (att::bf16*)(p.ws + WS_O);
    for (int i = 0;; ++i) {
        int u;
        if (G == 256 && NUL == 512) { if (i < 2) u = (vcu >> 5) * 64 + (vcu & 31) + 32 * i; else u = NUL + vcu + (i - 2) * G; }
        else u = vcu + i * G;
        if (u >= NU) break;
        const att::bf16 *Q, *K, *V; att::bf16* O; int seq;
        if (u < NUL) { const int grp = u / (GRP * LQB), j = u % (GRP * LQB); const int b = grp / NKV, kvh = grp % NKV, g = j / LQB, qb = j % LQB, hq = kvh * GRP + g;
            const size_t row0 = (size_t)MC + (size_t)b * LSEQ + (size_t)qb * QB;
            Q = QR + row0 * (NQ * HDIM) + hq * HDIM; O = OB + row0 * DM + hq * HDIM;
            K = (const att::bf16*)(p.ws + WS_LATK) + (size_t)b * SKVL * (NKV * HDIM) + kvh * HDIM; V = (const att::bf16*)(p.ws + WS_LATV) + (size_t)b * SKVL * (NKV * HDIM) + kvh * HDIM; seq = SKVL; }
        else { const int uc = u - NUL; const int b = uc / (NQ * CQB), r = uc % (NQ * CQB), hq = r / CQB, qb = r % CQB, kvh = hq / GRP;
            const size_t row0 = (size_t)b * CSEQ + (size_t)qb * QB;
            Q = QR + row0 * (NQ * HDIM) + hq * HDIM; O = OB + row0 * DM + hq * HDIM;
            K = (const att::bf16*)(p.ws + WS_CTXK) + (size_t)b * CSEQ * (NKV * HDIM) + kvh * HDIM; V = (const att::bf16*)(p.ws + WS_CTXV) + (size_t)b * CSEQ * (NKV * HDIM) + kvh * HDIM; seq = CSEQ; }
        __syncthreads();
        att::attn_dense_body(Q, K, V, O, seq, (char*)lds);
    }
}
static_assert(SKVL % 128 == 0 && CSEQ % 128 == 0 && LSEQ % 256 == 0 && CSEQ % 256 == 0, "attention tiling");
constexpr size_t WS_CST = 232 * MiB;
constexpr int NBLK = LSEQ / 256;
constexpr size_t WS_NST = WS_CST + (size_t)NLB * MH * 2 * NBLK * MDK * MDK * 2;
constexpr size_t WS_FTOT = WS_NST + (size_t)NLB * MH * 2 * NBLK * MDK * 4;
static_assert(WS_FTOT + (size_t)NLB * MH * 2 * NBLK * 4 <= WS_END && MDK == 128 && CSEQ == 256 && LSEQ % 256 == 0, "mLSTM fast path geometry");
namespace att {
constexpr int ML_OFF = 132096;
constexpr int ML_SC = ML_OFF + 6144;
constexpr int ML_N = ML_SC + 128;
constexpr int ML_LI = ML_N + 1024;
static_assert(ML_LI + 1024 <= LDS_BYTES, "mLSTM LDS map");
constexpr float L2E = 1.4426950408889634f;
using f32x4v = __attribute__((ext_vector_type(4))) float;


__device__ __forceinline__ void ml_gates(const Params& p, char* lds, int row0, int h, int tid) {
    float* A = (float*)(lds + ML_OFF); float* S = (float*)(lds + ML_SC);
    const int half = tid >> 8, t = tid & 255, tok = half ? 255 - t : t, lane = tid & 63, wv = (tid >> 6) & 3;
    const float* G = (const float*)(p.ws + WS_GATES) + (size_t)(row0 + tok) * NGATE + half * 8 + h;
    const float ig = G[0], lf = G[4];
    float v = lf;
#pragma unroll
    for (int off = 1; off < 64; off <<= 1) { const float u = lane_get(v, lane - off); if (lane >= off) v += u; }
    if (lane == 63) S[4 + half * 4 + wv] = v;
    __syncthreads();
    float pre = 0.f, tot = 0.f;
#pragma unroll
    for (int w = 0; w < 4; ++w) { const float x = S[4 + half * 4 + w]; if (w < wv) pre += x; tot += x; }
    const float P = v + pre, a = ig - P;
    A[(0 + half) * 256 + tok] = P * L2E; A[(2 + half) * 256 + tok] = a * L2E; A[(4 + half) * 256 + tok] = __builtin_amdgcn_exp2f(P * L2E);
    float mx = a;
    mx = fmaxf(mx, swz_xor<1>(mx)); mx = fmaxf(mx, swz_xor<2>(mx)); mx = fmaxf(mx, swz_xor<4>(mx)); mx = fmaxf(mx, swz_xor<8>(mx)); mx = fmaxf(mx, swz_xor<16>(mx)); mx = half_max(mx);
    if (lane == 0) S[12 + half * 4 + wv] = mx;
    if (t == 0) S[half] = tot;
    __syncthreads();
    if (t == 0) S[2 + half] = fmaxf(fmaxf(S[12 + half * 4], S[13 + half * 4]), fmaxf(S[14 + half * 4], S[15 + half * 4]));
    __syncthreads();
}
#define ML_PK(L, H) (bf16x8){L[0], L[1], L[2], L[3], H[0], H[1], H[2], H[3]}
__device__ __forceinline__ s16x4 tr_read_rt(int vb) { s16x4 r; asm volatile("ds_read_b64_tr_b16 %0, %1" : "=&v"(r) : "v"(vb) : "memory"); return r; }

__device__ __forceinline__ void ml_passA_unit(const Params& p, char* lds, int sid, int h, int blk) {
    const int tid = tid_opaque(), wid = tid >> 6, lane = tid & 63, r32 = lane & 31, hi = lane >> 5;
    const bool isctx = sid < NCB; const int row0 = seq_base(sid) + 256 * blk;
    __syncthreads();
    ml_gates(p, lds, row0, h, tid);
    float* A = (float*)(lds + ML_OFF); float* S = (float*)(lds + ML_SC); float* NA = (float*)(lds + ML_N);
    const bf16* QK = (const bf16*)(p.ws + WS_QKVO) + (size_t)row0 * (4 * MW) + h * MDK;
    const int sr = tid >> 4, sc8 = (tid & 15) * 8;
    { bf16x8 tv[8];
#pragma unroll
      for (int i = 0; i < 8; ++i) tv[i] = *(const bf16x8*)(QK + (size_t)(32 * i + sr) * (4 * MW) + 2 * MW + sc8);
#pragma unroll
      for (int i = 0; i < 8; ++i) *(bf16x8*)(lds + 65536 + (i >> 1) * 16384 + v_st(32 * (i & 1) + sr, sc8)) = tv[i]; }
    if (tid < 256) NA[tid] = 0.f;
    const int a = wid >> 1, dvb0 = 2 * (wid & 1);
    const int ldsb = (int)(uintptr_t)lds; const int vbK = ldsb + v_rd_base(lane) + a * 512, vbV = ldsb + 65536 + v_rd_base(lane) + dvb0 * 512;
    for (int dir = 0; dir < 2; ++dir) {
        __syncthreads();
        const float ft = S[dir], am = S[2 + dir]; const float mT = isctx ? ft + fmaxf(am, 0.f) : 0.f; const float wl2 = (ft - mT) * L2E;
        float xs[8];
#pragma unroll
        for (int i = 0; i < 8; ++i) xs[i] = 0.f;
        bf16x8 tk[8];
#pragma unroll
        for (int i = 0; i < 8; ++i) tk[i] = *(const bf16x8*)(QK + (size_t)(32 * i + sr) * (4 * MW) + MW + sc8);
#pragma unroll
        for (int j = 0; j < 4; ++j)
#pragma unroll
            for (int hf = 0; hf < 2; ++hf) { const int row = 64 * j + 32 * hf + sr; const float w = __builtin_amdgcn_exp2f(wl2 + A[(2 + dir) * 256 + row]);
                const bf16x8 k8 = tk[2 * j + hf]; float x[8];
#pragma unroll
                for (int i = 0; i < 8; ++i) { x[i] = bf2f((unsigned short)k8[i]) * w; xs[i] += x[i]; }
                u32x4 pk = {cvtpk(x[0], x[1]), cvtpk(x[2], x[3]), cvtpk(x[4], x[5]), cvtpk(x[6], x[7])};
                *(u32x4*)(lds + j * 16384 + v_st(32 * hf + sr, sc8)) = pk; }
#pragma unroll
        for (int i = 0; i < 8; ++i) { float v = xs[i]; v += swz_xor<16>(v); v = half_sum(v); if (lane < 16) atomicAdd(&NA[dir * 128 + sc8 + i], v); }
        __syncthreads();
        f32x16 acc0 = {}, acc1 = {}; const unsigned eoff = (unsigned)((32 * a + 4 * hi) * MDK + 32 * dvb0 + r32);
#pragma unroll
        for (int j = 0; j < 4; ++j)
#pragma unroll
            for (int ks = 0; ks < 4; ++ks) { const int off = j * 16384 + ks * 4096;
                const s16x4 al = tr_read_rt(vbK + off), ah = tr_read_rt(vbK + off + 2048);
                const s16x4 bl0 = tr_read_rt(vbV + off), bh0 = tr_read_rt(vbV + off + 2048), bl1 = tr_read_rt(vbV + off + 512), bh1 = tr_read_rt(vbV + off + 512 + 2048);
                asm volatile("s_waitcnt lgkmcnt(0)" ::: "memory"); SBAR();
                acc0 = __builtin_amdgcn_mfma_f32_32x32x16_bf16(ML_PK(al, ah), ML_PK(bl0, bh0), acc0, 0, 0, 0);
                acc1 = __builtin_amdgcn_mfma_f32_32x32x16_bf16(ML_PK(al, ah), ML_PK(bl1, bh1), acc1, 0, 0, 0); }
        if (isctx) {
            float* Co = p.out + O_C + ((size_t)(sid * 2 + dir) * MH + h) * MDK * MDK;
#pragma unroll
            for (int r = 0; r < 16; ++r) { const unsigned eo = eoff + (unsigned)(((r & 3) + 8 * (r >> 2)) * MDK); Co[eo] = acc0[r]; Co[eo + 32] = acc1[r]; }
            if (tid == 0) p.out[O_M + (size_t)(sid * 2 + dir) * MH + h] = mT;
        } else {
            const int b = sid - NCB; bf16* Cs = (bf16*)(p.ws + WS_CST) + ((size_t)((b * MH + h) * 2 + dir) * NBLK + blk) * MDK * MDK;
#pragma unroll
            for (int r = 0; r < 16; ++r) { const unsigned eo = eoff + (unsigned)(((r & 3) + 8 * (r >> 2)) * MDK); Cs[eo] = f2bf(acc0[r]); Cs[eo + 32] = f2bf(acc1[r]); }
            if (tid == 0) ((float*)(p.ws + WS_FTOT))[((size_t)(b * MH + h) * 2 + dir) * NBLK + blk] = ft;
        }
    }
    __syncthreads();
    if (tid < 256) { const int dir = tid >> 7, d = tid & 127;
        if (isctx) p.out[O_N + ((size_t)(sid * 2 + dir) * MH + h) * MDK + d] = NA[tid];
        else { const int b = sid - NCB; ((float*)(p.ws + WS_NST))[(((size_t)(b * MH + h) * 2 + dir) * NBLK + blk) * MDK + d] = NA[tid]; } }
}

template <int DIR> __device__ __forceinline__ void ml_tile(f32x16* o, float& den, const bf16x8* qr, const char* Ktile, int vbV, const float* AL2, int j, float cq, int trow, bool diag, int r32, int hi) {
    SBAR(); f32x16 p0, p1; qkt(p0, p1, (const bf16*)Ktile, qr, r32, hi); SBAR();
    float ds = 0.f; const int tl = trow - 64 * j - 4 * hi;
#pragma unroll
    for (int g = 0; g < 4; ++g) { const f32x4v a0 = *(const f32x4v*)(AL2 + 64 * j + 8 * g + 4 * hi), a1 = *(const f32x4v*)(AL2 + 64 * j + 32 + 8 * g + 4 * hi);
#pragma unroll
        for (int e = 0; e < 4; ++e) { float w0 = __builtin_amdgcn_exp2f(cq + a0[e]), w1 = __builtin_amdgcn_exp2f(cq + a1[e]);
            if (diag) { if (DIR == 0 ? (8 * g + e > tl) : (8 * g + e < tl)) w0 = 0.f; if (DIR == 0 ? (8 * g + e + 32 > tl) : (8 * g + e + 32 < tl)) w1 = 0.f; }
            p0[4 * g + e] *= w0; p1[4 * g + e] *= w1; ds += p0[4 * g + e] + p1[4 * g + e]; } }
    den += ds;
    bf16x8 pa0, pa1, pa2, pa3;
#define PK4(P, BASE, OUT) do { unsigned a0_ = cvtpk(P[BASE + 0], P[BASE + 1]), a1_ = cvtpk(P[BASE + 2], P[BASE + 3]);   \
    unsigned b0_ = cvtpk(P[BASE + 4], P[BASE + 5]), b1_ = cvtpk(P[BASE + 6], P[BASE + 7]);                              \
    auto r0_ = __builtin_amdgcn_permlane32_swap(a0_, b0_, false, false); auto r1_ = __builtin_amdgcn_permlane32_swap(a1_, b1_, false, false); \
    u32x4 w_ = {r0_[0], r1_[0], r0_[1], r1_[1]}; OUT = *reinterpret_cast<bf16x8*>(&w_); } while (0)
    PK4(p0, 0, pa0); PK4(p0, 8, pa1); PK4(p1, 0, pa2); PK4(p1, 8, pa3);
#undef PK4
    SBAR(); pv_d0(o, vbV, pa0, pa1, pa2, pa3); SBAR();
}
__device__ __forceinline__ void ml_stage_kv(char* lds, const bf16* QK, int tile0, int sr, int sc8) {
    bf16x8 tk[4], tv[4];
#pragma unroll
    for (int i = 0; i < 4; ++i) { const int row = 64 * tile0 + 32 * i + sr; tk[i] = *(const bf16x8*)(QK + (size_t)row * (4 * MW) + MW + sc8); tv[i] = *(const bf16x8*)(QK + (size_t)row * (4 * MW) + 2 * MW + sc8); }
#pragma unroll
    for (int i = 0; i < 4; ++i) { const int jj = i >> 1, rl = 32 * (i & 1) + sr; *(bf16x8*)(lds + jj * 16384 + KSWZ(rl, sc8 * 2)) = tk[i]; *(bf16x8*)(lds + 32768 + jj * 16384 + v_st(rl, sc8)) = tv[i]; }
}
__device__ __forceinline__ void ml_passC_unit(const Params& p, char* lds, int sid, int h, int blk) {
    const int tid = tid_opaque(), wid = tid >> 6, lane = tid & 63, r32 = lane & 31, hi = lane >> 5;
    const bool isctx = sid < NCB; const int row0 = seq_base(sid) + 256 * blk; const int wq = wid >> 1;
    __syncthreads();
    ml_gates(p, lds, row0, h, tid);
    float* A = (float*)(lds + ML_OFF); float* NS = (float*)(lds + ML_N); float* li = (float*)(lds + ML_LI) + wid * 32;
    const bf16* QK = (const bf16*)(p.ws + WS_QKVO) + (size_t)row0 * (4 * MW) + h * MDK;
    const int sr = tid >> 4, sc8 = (tid & 15) * 8; const int b = sid - NCB;
    if (tid < 256) { const int dir = tid >> 7, d = tid & 127;
        NS[tid] = isctx ? 0.f : ((const float*)(p.ws + WS_NST))[(((size_t)(b * MH + h) * 2 + dir) * NBLK + blk) * MDK + d]; }
    if (!isctx) { bf16x8 tc[8];
#pragma unroll
        for (int i = 0; i < 8; ++i) { const int dir = i >> 2, c = tid + 512 * (i & 3); tc[i] = *(const bf16x8*)((const bf16*)(p.ws + WS_CST) + ((size_t)((b * MH + h) * 2 + dir) * NBLK + blk) * MDK * MDK + (size_t)c * 8); }
#pragma unroll
        for (int i = 0; i < 8; ++i) { const int dir = i >> 2, c = tid + 512 * (i & 3), row = c >> 4, col8 = (c & 15) * 8; *(bf16x8*)(lds + 65536 + dir * 32768 + (row >> 6) * 16384 + v_st(row & 63, col8)) = tc[i]; }
    }
    bf16x8 qr[8];
    { const bf16* Qw = QK + (size_t)(wid * 32 + r32) * (4 * MW) + hi * 8;
#pragma unroll
        for (int d0 = 0; d0 < 8; ++d0) qr[d0] = *(const bf16x8*)(Qw + d0 * 16); }
    ml_stage_kv(lds, QK, 0, sr, sc8);
    __syncthreads();
    float qn_f = 0.f, qn_b = 0.f;
#pragma unroll
    for (int d0 = 0; d0 < 8; ++d0)
#pragma unroll
        for (int i = 0; i < 8; ++i) { const float qv = bf2f((unsigned short)qr[d0][i]); qn_f += qv * NS[d0 * 16 + hi * 8 + i]; qn_b += qv * NS[128 + d0 * 16 + hi * 8 + i]; }
    qn_f = half_sum(qn_f); qn_b = half_sum(qn_b);
    const int ldsb = (int)(uintptr_t)lds; const int vbV = ldsb + 32768 + v_rd_base(lane), vbC = ldsb + 65536 + v_rd_base(lane);
    const int trow = wid * 32 + r32;
    float* HS = (float*)(p.ws + WS_HS) + (size_t)(row0 + wid * 32) * MW + h * MDK;
    f32x16 o[4]; const unsigned hso = (unsigned)(4 * hi * MW + r32), uho = (unsigned)(4 * hi * DM + r32), ogo = (unsigned)(4 * hi * 4 * MW + r32);
    {
        float qn = qn_f;
        o[0] = f32x16{}; o[1] = f32x16{}; o[2] = f32x16{}; o[3] = f32x16{};
        if (!isctx) { pv_d0(o, vbC, qr[0], qr[1], qr[2], qr[3]); pv_d0(o, vbC + 16384, qr[4], qr[5], qr[6], qr[7]);
#pragma unroll
            for (int r = 0; r < 16; ++r) { const float e = A[4 * 256 + wid * 32 + crow(r, hi)];
#pragma unroll
                for (int d0 = 0; d0 < 4; ++d0) o[d0][r] *= e; } }
        const float cq = A[0 * 256 + trow]; float den = 0.f;
        ml_tile<0>(o, den, qr, lds, vbV, A + 2 * 256, 0, cq, trow, wq == 0, r32, hi);
        if (wq >= 1) ml_tile<0>(o, den, qr, lds + 16384, vbV + 16384, A + 2 * 256, 1, cq, trow, wq == 1, r32, hi);
        __syncthreads(); ml_stage_kv(lds, QK, 2, sr, sc8); __syncthreads();
        if (wq >= 2) ml_tile<0>(o, den, qr, lds, vbV, A + 2 * 256, 2, cq, trow, wq == 2, r32, hi);
        if (wq >= 3) ml_tile<0>(o, den, qr, lds + 16384, vbV + 16384, A + 2 * 256, 3, cq, trow, wq == 3, r32, hi);
        { auto rr = __builtin_amdgcn_permlane32_swap(__float_as_uint(den), __float_as_uint(den), false, false); den = __uint_as_float(rr[0]) + __uint_as_float(rr[1]); }
        const float dn = den + __builtin_amdgcn_exp2f(cq) * qn; const float inv = 1.0f / fmaxf(fabsf(dn), 1.0f);
        if (hi == 0) li[r32] = inv; asm volatile("s_waitcnt lgkmcnt(0)" ::: "memory");
#pragma unroll
        for (int r = 0; r < 16; ++r) { const float rl = li[crow(r, hi)]; const unsigned eo = hso + (unsigned)(((r & 3) + 8 * (r >> 2)) * MW);
#pragma unroll
            for (int d0 = 0; d0 < 4; ++d0) HS[eo + d0 * 32] = o[d0][r] * rl;
            asm volatile("" ::: "memory"); }
    }
    {
        float qn = qn_b;
        o[0] = f32x16{}; o[1] = f32x16{}; o[2] = f32x16{}; o[3] = f32x16{};
        if (!isctx) { pv_d0(o, vbC + 32768, qr[0], qr[1], qr[2], qr[3]); pv_d0(o, vbC + 32768 + 16384, qr[4], qr[5], qr[6], qr[7]);
#pragma unroll
            for (int r = 0; r < 16; ++r) { const float e = A[5 * 256 + wid * 32 + crow(r, hi)];
#pragma unroll
                for (int d0 = 0; d0 < 4; ++d0) o[d0][r] *= e; } }
        const float cq = A[1 * 256 + trow]; float den = 0.f;
        ml_tile<1>(o, den, qr, lds + 16384, vbV + 16384, A + 3 * 256, 3, cq, trow, wq == 3, r32, hi);
        if (wq <= 2) ml_tile<1>(o, den, qr, lds, vbV, A + 3 * 256, 2, cq, trow, wq == 2, r32, hi);
        __syncthreads(); ml_stage_kv(lds, QK, 0, sr, sc8); __syncthreads();
        if (wq <= 1) ml_tile<1>(o, den, qr, lds + 16384, vbV + 16384, A + 3 * 256, 1, cq, trow, wq == 1, r32, hi);
        if (wq <= 0) ml_tile<1>(o, den, qr, lds, vbV, A + 3 * 256, 0, cq, trow, wq == 0, r32, hi);
        { auto rr = __builtin_amdgcn_permlane32_swap(__float_as_uint(den), __float_as_uint(den), false, false); den = __uint_as_float(rr[0]) + __uint_as_float(rr[1]); }
        const float dn = den + __builtin_amdgcn_exp2f(cq) * qn; const float inv = 1.0f / fmaxf(fabsf(dn), 1.0f);
        asm volatile("s_waitcnt vmcnt(0)" ::: "memory");
        if (hi == 0) li[r32] = inv; asm volatile("s_waitcnt lgkmcnt(0)" ::: "memory");
        float mg[4];
#pragma unroll
        for (int d0 = 0; d0 < 4; ++d0) mg[d0] = p.mng[h * MDK + d0 * 32 + r32];
        const bf16* OG = QK + (size_t)(wid * 32) * (4 * MW) + 3 * MW; bf16* UHo = (bf16*)(p.ws + WS_UH) + (size_t)(row0 + wid * 32) * DM + CCH + h * MDK;
#pragma unroll
        for (int r = 0; r < 16; ++r) { const float rl = li[crow(r, hi)]; const int rc = (r & 3) + 8 * (r >> 2); float ss = 0.f;
#pragma unroll
            for (int d0 = 0; d0 < 4; ++d0) { const float hf = __hip_atomic_load(HS + hso + (unsigned)(rc * MW + d0 * 32), __ATOMIC_RELAXED, __HIP_MEMORY_SCOPE_AGENT); const float x = hf + o[d0][r] * rl; o[d0][r] = x; ss += x * x; }
            ss += swz_xor<1>(ss); ss += swz_xor<2>(ss); ss += swz_xor<4>(ss); ss += swz_xor<8>(ss); ss += swz_xor<16>(ss);
            const float rs = 1.0f / sqrtf(ss * (1.0f / MDK) + EPSF);
#pragma unroll
            for (int d0 = 0; d0 < 4; ++d0) UHo[uho + (unsigned)(rc * DM + d0 * 32)] = f2bf(bf2f(OG[ogo + (unsigned)(rc * 4 * MW + d0 * 32)]) * o[d0][r] * rs * mg[d0]);
            asm volatile("" ::: "memory"); }
    }
}
}

template <int DIR> __device__ __forceinline__ void ml_scan_item(const Params& p, int ch, int b, int h, int e8) {
    const float em = expf(p.stm[(size_t)(b * 2 + DIR) * MH + h]); const float* FT = (const float*)(p.ws + WS_FTOT) + (size_t)ch * NBLK;
    float fd[NBLK];
#pragma unroll
    for (int i = 0; i < NBLK; ++i) fd[i] = expf(FT[i]);
    if (e8 < MDK * MDK) { bf16_t* Cs = (bf16_t*)(p.ws + WS_CST) + (size_t)ch * NBLK * MDK * MDK + e8; const float* c0 = p.stC + ((size_t)(b * 2 + DIR) * MH + h) * MDK * MDK + e8;
        v4u d[NBLK];
#pragma unroll
        for (int i = 0; i < NBLK; ++i) d[i] = *(const v4u*)(Cs + (size_t)i * MDK * MDK);
        const f32x4 ca = *(const f32x4*)c0, cb = *(const f32x4*)(c0 + 4); float c[8] = {ca[0] * em, ca[1] * em, ca[2] * em, ca[3] * em, cb[0] * em, cb[1] * em, cb[2] * em, cb[3] * em};
#pragma unroll
        for (int i = 0; i < NBLK; ++i) { const int blk = DIR == 0 ? i : NBLK - 1 - i; v4u o;
#pragma unroll
            for (int w = 0; w < 4; ++w) { const float lo = __uint_as_float(d[blk][w] << 16), hi = __uint_as_float(d[blk][w] & 0xffff0000u); o[w] = pg8::cvt_pk_bf16(c[2 * w], c[2 * w + 1]);
                c[2 * w] = fd[blk] * c[2 * w] + lo; c[2 * w + 1] = fd[blk] * c[2 * w + 1] + hi; }
            *(v4u*)(Cs + (size_t)blk * MDK * MDK) = o; } }
    else { const int d_ = e8 - MDK * MDK; float* Ns = (float*)(p.ws + WS_NST) + (size_t)ch * NBLK * MDK + d_; const float* n0 = p.stn + ((size_t)(b * 2 + DIR) * MH + h) * MDK + d_;
        f32x4 da[NBLK], db[NBLK];
#pragma unroll
        for (int i = 0; i < NBLK; ++i) { da[i] = *(const f32x4*)(Ns + (size_t)i * MDK); db[i] = *(const f32x4*)(Ns + (size_t)i * MDK + 4); }
        f32x4 ca = *(const f32x4*)n0 * em, cb = *(const f32x4*)(n0 + 4) * em;
#pragma unroll
        for (int i = 0; i < NBLK; ++i) { const int blk = DIR == 0 ? i : NBLK - 1 - i;
            *(f32x4*)(Ns + (size_t)blk * MDK) = ca; *(f32x4*)(Ns + (size_t)blk * MDK + 4) = cb; ca = ca * fd[blk] + da[blk]; cb = cb * fd[blk] + db[blk]; } }
}
struct MlScan {
    Params p; static HD_FN long count() { return (long)NLB * MH * 2 * ((MDK * MDK + MDK) / 8); }
    __device__ __forceinline__ void operator()(long idx) const {
        constexpr int per = (MDK * MDK + MDK) / 8; const int e8 = (int)(idx % per) * 8; const int ch = (int)(idx / per); const int dir = ch & 1, h = (ch >> 1) % MH, b = ch / (2 * MH);
        if (dir == 0) ml_scan_item<0>(p, ch, b, h, e8); else ml_scan_item<1>(p, ch, b, h, e8);
    }
};
__device__ __forceinline__ void ml_phase_A(const Params& p, unsigned char* lds, int vcu, int G) {
    constexpr int NUL = NLB * MH * NBLK, NU = NUL + NCB * MH;
    for (int u = vcu; u < NU; u += G) {
        if (u < NUL) att::ml_passA_unit(p, (char*)lds, NCB + u / (MH * NBLK), (u / NBLK) % MH, u % NBLK);
        else att::ml_passA_unit(p, (char*)lds, (u - NUL) / MH, (u - NUL) % MH, 0); }
}
__device__ __forceinline__ void ml_phase_C(const Params& p, unsigned char* lds, int vcu, int G) {
    constexpr int NUL = NLB * MH * NBLK, NU = NUL + NCB * MH;
    for (int u = vcu; u < NU; u += G) {
        if (u < NUL) att::ml_passC_unit(p, (char*)lds, NCB + u / (MH * NBLK), (u / NBLK) % MH, u % NBLK);
        else att::ml_passC_unit(p, (char*)lds, (u - NUL) / MH, (u - NUL) % MH, 0); }
}
typedef float f4 __attribute__((ext_vector_type(4)));
typedef unsigned u4 __attribute__((ext_vector_type(4)));
typedef unsigned u2 __attribute__((ext_vector_type(2)));
__device__ __forceinline__ float wave_sum64(float v) { v += swz_xor<1>(v); v += swz_xor<2>(v); v += swz_xor<4>(v); v += swz_xor<8>(v); v += swz_xor<16>(v); return half_sum(v); }
__device__ __forceinline__ float fsilu(float x) { return x * fsigmoid(x); }

__device__ __forceinline__ void phase_mod(const Params& p, char* lds, int bx, int G) {
    const int tid = tid_opaque(), lane = tid & 63, wave = tid >> 6;
    float* SL = (float*)lds; float* PT = (float*)(lds + 32768);
    constexpr int NCG = 6 * DM / 64, NIT = 2 * NCG;
    if (bx >= NIT) return;
    __syncthreads();
    for (int i = tid; i < NCLS * DM; i += NTHREADS) { const int cls = i / DM, k = i % DM; const float cv = cls == 0 ? p.cctx[k] : p.c[(size_t)(cls - 1) * DM + k]; SL[i] = fsilu(cv); }
    for (int item = bx; item < NIT; item += G) {
        __syncthreads();
        const int l = item / NCG, cg = item % NCG; const float* w = p.wmod + (size_t)l * DM * 6 * DM + cg * 64 + lane;
        float acc[NCLS];
#pragma unroll
        for (int r = 0; r < NCLS; ++r) acc[r] = 0.f;
        const int k0 = wave * (DM / 8);
#pragma unroll 8
        for (int k = k0; k < k0 + DM / 8; ++k) { const float wv = w[(size_t)k * 6 * DM];
#pragma unroll
            for (int r = 0; r < NCLS; ++r) acc[r] += SL[r * DM + k] * wv; }
#pragma unroll
        for (int r = 0; r < NCLS; ++r) PT[(wave * NCLS + r) * 64 + lane] = acc[r];
        __syncthreads();
        if (tid < NCLS * 64) { const int r = tid >> 6; float s = p.bmod[(size_t)l * 6 * DM + cg * 64 + lane];
#pragma unroll
            for (int w8 = 0; w8 < 8; ++w8) s += PT[(w8 * NCLS + r) * 64 + lane];
            ((float*)(p.ws + WS_MOD))[((size_t)(l * NCLS + r) * 6 * DM) + cg * 64 + lane] = s; }
    }
}
__device__ __forceinline__ void sw_job(const Params& p, const bf16_t* Bt, int nrows, int l, int which, float* sw, int N, int mode, int gw, int NGW, int lane) {
    for (int n = gw; n < nrows; n += NGW) {
        const u4 w0 = *(const u4*)(Bt + (size_t)n * DM + lane * 8), w1 = *(const u4*)(Bt + (size_t)n * DM + DM / 2 + lane * 8);
        float wf[16];
#pragma unroll
        for (int i = 0; i < 4; ++i) { wf[2 * i] = __uint_as_float(w0[i] << 16); wf[2 * i + 1] = __uint_as_float(w0[i] & 0xffff0000u); wf[8 + 2 * i] = __uint_as_float(w1[i] << 16); wf[8 + 2 * i + 1] = __uint_as_float(w1[i] & 0xffff0000u); }
        int col = n; if (mode == 1) { const int t = n >> 8, r = n & 255; col = r < 128 ? 128 * t + r : (N / 2) + 128 * t + (r - 128); }
#pragma unroll
        for (int cls = 0; cls < NCLS; ++cls) { const float* sh = modv(p, l, cls, which);
            const f4 a0 = *(const f4*)(sh + lane * 8), a1 = *(const f4*)(sh + lane * 8 + 4), b0 = *(const f4*)(sh + DM / 2 + lane * 8), b1 = *(const f4*)(sh + DM / 2 + lane * 8 + 4);
            float s = (a0[0] * wf[0] + a0[1] * wf[1]) + (a0[2] * wf[2] + a0[3] * wf[3]) + (a1[0] * wf[4] + a1[1] * wf[5]) + (a1[2] * wf[6] + a1[3] * wf[7])
                    + (b0[0] * wf[8] + b0[1] * wf[9]) + (b0[2] * wf[10] + b0[3] * wf[11]) + (b1[0] * wf[12] + b1[1] * wf[13]) + (b1[2] * wf[14] + b1[3] * wf[15]);
            s = wave_sum64(s); if (lane == 0) sw[(size_t)cls * N + col] = s; }
    }
}
static_assert(DM == 1024, "sw_job / norm passes assume 1024 = 64 lanes x 16");
__device__ __forceinline__ void phase_norm0(const Params& p, char* lds, int bx, int G) {
    const int tid = tid_opaque(), lane = tid & 63, wave = tid >> 6;
    float* WG = (float*)lds;
    __syncthreads();
    for (int i = tid; i < NGATE * DM; i += NTHREADS) { const int k = i / NGATE, g = i % NGATE; WG[g * DM + k] = p.winab[(size_t)k * ABIN + ABMAIN + g]; }
    __syncthreads();
    const int gw = bx * NWAVES + wave, NGW = G * NWAVES;
    f4 nx[4];
    if (gw < MTOK) { const f4* xr = (const f4*)xrow(p, gw) + lane;
#pragma unroll
        for (int j = 0; j < 4; ++j) nx[j] = xr[64 * j]; }
    for (int row = gw; row < MTOK; row += NGW) {
        const int cls = cls_of(row);
        const f4* g4 = (const f4*)p.n1g + lane; const f4* sc4 = (const f4*)modv(p, 0, cls, 1) + lane; const f4* sh4 = (const f4*)modv(p, 0, cls, 0) + lane;
        f4 v[4]; float s = 0.f;
#pragma unroll
        for (int j = 0; j < 4; ++j) { v[j] = nx[j]; s += (v[j][0] * v[j][0] + v[j][1] * v[j][1]) + (v[j][2] * v[j][2] + v[j][3] * v[j][3]); }
        if (row + NGW < MTOK) { const f4* xr = (const f4*)xrow(p, row + NGW) + lane;
#pragma unroll
            for (int j = 0; j < 4; ++j) nx[j] = xr[64 * j]; }
        const float rs = 1.0f / sqrtf(wave_sum64(s) * (1.0f / DM) + EPSF);
        bf16_t* xo = (bf16_t*)(p.ws + WS_XN) + (size_t)row * DM + lane * 4;
#pragma unroll
        for (int j = 0; j < 4; ++j) { const f4 gg = g4[64 * j], sc = sc4[64 * j], sh = sh4[64 * j]; v[j] = v[j] * rs * gg * (sc + 1.0f) + sh;
            u2 w; w.x = pg8::cvt_pk_bf16(v[j][0], v[j][1]); w.y = pg8::cvt_pk_bf16(v[j][2], v[j][3]); *(u2*)(xo + 256 * j) = w; }
        float mine = 0.f;
#pragma unroll
        for (int g = 0; g < NGATE; ++g) { float a = 0.f;
#pragma unroll
            for (int j = 0; j < 4; ++j) { const f4 w = *(const f4*)(WG + g * DM + 256 * j + lane * 4); a += (v[j][0] * w[0] + v[j][1] * w[1]) + (v[j][2] * w[2] + v[j][3] * w[3]); }
            a = wave_sum64(a); if (lane == g) mine = a; }
        if (lane < NGATE) { float a = mine + p.bgate[lane]; if ((lane & 7) >= 4) a = logsigmoidf_(a); ((float*)(p.ws + WS_GATES))[(size_t)row * NGATE + lane] = a; }
    }
}
__device__ __forceinline__ void phase_conv(const Params& p, char* lds, int vcu, int G) {
    const int tid = tid_opaque(), lane = tid & 63, wave = tid >> 6; constexpr int TT = 32, NR = TT + CWID - 1;
    bf16_t* X = (bf16_t*)lds; float* OUT = (float*)(lds + 65536);
    const int cp = tid & 255, tg = tid >> 8, c0 = 2 * cp;
    float w0[CWID], w1[CWID];
#pragma unroll
    for (int j = 0; j < CWID; ++j) { w0[j] = p.convw[(size_t)j * CCH + c0]; w1[j] = p.convw[(size_t)j * CCH + c0 + 1]; }
    const float b0 = p.convb[c0], b1 = p.convb[c0 + 1];
    const bf16_t* U = (const bf16_t*)(p.ws + WS_UPRE);
    for (int u = vcu; u < MTOK / TT; u += G) {
        const int row0 = u * TT, pos0 = pos_of(row0), len = seqlen_of(row0);
        __syncthreads();
        { u4 val[8];
#pragma unroll
          for (int i = 0; i < 8; ++i) { const int c = tid + NTHREADS * i, r = c / (CCH / 8), ch = (c % (CCH / 8)) * 8; const int t = pos0 + r - CWID / 2;
              val[i] = (u4){0u, 0u, 0u, 0u}; if (c < NR * (CCH / 8) && t >= 0 && t < len) val[i] = *(const u4*)(U + (size_t)(row0 + r - CWID / 2) * CCH + ch); }
#pragma unroll
          for (int i = 0; i < 8; ++i) { const int c = tid + NTHREADS * i, r = c / (CCH / 8), ch = (c % (CCH / 8)) * 8; if (c < NR * (CCH / 8)) *(u4*)(X + (size_t)r * CCH + ch) = val[i]; } }
        __syncthreads();
#pragma unroll 2
        for (int tt = 0; tt < TT / 2; ++tt) { const int t = tg * (TT / 2) + tt; float a0 = b0, a1 = b1;
#pragma unroll
            for (int j = 0; j < CWID; ++j) { const unsigned xx = *(const unsigned*)(X + (size_t)(t + j) * CCH + c0); a0 += w0[j] * __uint_as_float(xx << 16); a1 += w1[j] * __uint_as_float(xx & 0xffff0000u); }
            *(float2*)(OUT + (size_t)t * CCH + c0) = make_float2(a0, a1); }
        __syncthreads();
#pragma unroll
        for (int q = 0; q < TT / NWAVES; ++q) { const int t = wave * (TT / NWAVES) + q; const f4 x0 = *(const f4*)(OUT + (size_t)t * CCH + lane * 8), x1 = *(const f4*)(OUT + (size_t)t * CCH + lane * 8 + 4);
            const float mu = wave_sum64((x0[0] + x0[1]) + (x0[2] + x0[3]) + (x1[0] + x1[1]) + (x1[2] + x1[3])) * (1.0f / CCH);
            const f4 d0 = x0 - mu, d1 = x1 - mu;
            const float var = wave_sum64((d0[0] * d0[0] + d0[1] * d0[1]) + (d0[2] * d0[2] + d0[3] * d0[3]) + (d1[0] * d1[0] + d1[1] * d1[1]) + (d1[2] * d1[2] + d1[3] * d1[3])) * (1.0f / CCH);
            const float rs = 1.0f / sqrtf(var + EPSF);
            const f4 g0 = *(const f4*)(p.lng + lane * 8), g1 = *(const f4*)(p.lng + lane * 8 + 4), be0 = *(const f4*)(p.lnb + lane * 8), be1 = *(const f4*)(p.lnb + lane * 8 + 4);
            const f4 y0 = d0 * rs * g0 + be0, y1 = d1 * rs * g1 + be1; u4 w;
            w.x = pg8::cvt_pk_bf16(fsilu(y0[0]), fsilu(y0[1])); w.y = pg8::cvt_pk_bf16(fsilu(y0[2]), fsilu(y0[3])); w.z = pg8::cvt_pk_bf16(fsilu(y1[0]), fsilu(y1[1])); w.w = pg8::cvt_pk_bf16(fsilu(y1[2]), fsilu(y1[3]));
            *(u4*)((bf16_t*)(p.ws + WS_UH) + (size_t)(row0 + t) * DM + lane * 8) = w; }
    }
}
static_assert(CCH == 512 && CSEQ % 32 == 0 && LSEQ % 32 == 0, "conv phase geometry");
__device__ __forceinline__ void phase_cachecvt(const Params& p, int gtid, int gthreads) {
    constexpr int PER = PAST * NKV * HDIM / 8;
    for (int i = gtid; i < NLB * PER; i += gthreads) { const int b = i / PER, e = (i % PER) * 8; const size_t src = (size_t)b * PAST * NKV * HDIM + e, dst = ((size_t)b * SKVL + LSEQ) * NKV * HDIM + e;
        const f4 k0 = *(const f4*)(p.ck + src), k1 = *(const f4*)(p.ck + src + 4), v0 = *(const f4*)(p.cv + src), v1 = *(const f4*)(p.cv + src + 4); u4 wk, wv;
        wk.x = pg8::cvt_pk_bf16(k0[0], k0[1]); wk.y = pg8::cvt_pk_bf16(k0[2], k0[3]); wk.z = pg8::cvt_pk_bf16(k1[0], k1[1]); wk.w = pg8::cvt_pk_bf16(k1[2], k1[3]);
        wv.x = pg8::cvt_pk_bf16(v0[0], v0[1]); wv.y = pg8::cvt_pk_bf16(v0[2], v0[3]); wv.z = pg8::cvt_pk_bf16(v1[0], v1[1]); wv.w = pg8::cvt_pk_bf16(v1[2], v1[3]);
        *(u4*)((bf16_t*)(p.ws + WS_LATK) + dst) = wk; *(u4*)((bf16_t*)(p.ws + WS_LATV) + dst) = wv; }
}
__device__ __forceinline__ void phase_qkpost(const Params& p, int gw, int NGW, int lane) {
    const int hh = lane >> 5, l5 = lane & 31, half = l5 >> 4, f0 = (l5 & 15) * 2, d1 = half * 64 + f0, d2 = d1 + 32;
    const float inv0 = __builtin_amdgcn_exp2f(-(float)f0 * (13.287712379549449f / 32.0f)), inv1 = __builtin_amdgcn_exp2f(-(float)(f0 + 1) * (13.287712379549449f / 32.0f));
    const float qg[4] = {p.qng[d1], p.qng[d1 + 1], p.qng[d2], p.qng[d2 + 1]}, kg[4] = {p.kng[d1], p.kng[d1 + 1], p.kng[d2], p.kng[d2 + 1]};
    for (int row = gw; row < MTOK; row += NGW) {
        const bool lat = row >= MC; const int sp = pos_of(row); float cs0 = 1.f, sn0 = 0.f, cs1 = 1.f, sn1 = 0.f;
        if (lat) { const float pos = (float)(half == 0 ? sp / GRIDW : sp % GRIDW); cs0 = __cosf(pos * inv0); sn0 = __sinf(pos * inv0); cs1 = __cosf(pos * inv1); sn1 = __sinf(pos * inv1); }
        bf16_t* Q = (bf16_t*)(p.ws + WS_QRAW) + (size_t)row * NQ * HDIM; const bf16_t* KR = (const bf16_t*)(p.ws + WS_KRAW) + (size_t)row * NKV * HDIM;
        unsigned ra[NQ / 2 + 1], rb[NQ / 2 + 1];
#pragma unroll
        for (int it = 0; it <= NQ / 2; ++it) { const bf16_t* src = it < NQ / 2 ? Q + (2 * it + hh) * HDIM : KR + hh * HDIM; ra[it] = *(const unsigned*)(src + d1); rb[it] = *(const unsigned*)(src + d2); }
#pragma unroll
        for (int it = 0; it <= NQ / 2; ++it) { const bool isq = it < NQ / 2;
            const float x1a = __uint_as_float(ra[it] << 16), x1b = __uint_as_float(ra[it] & 0xffff0000u), x2a = __uint_as_float(rb[it] << 16), x2b = __uint_as_float(rb[it] & 0xffff0000u);
            float ss = (x1a * x1a + x1b * x1b) + (x2a * x2a + x2b * x2b); ss += swz_xor<1>(ss); ss += swz_xor<2>(ss); ss += swz_xor<4>(ss); ss += swz_xor<8>(ss); ss += swz_xor<16>(ss);
            const float rs = 1.0f / sqrtf(ss * (1.0f / HDIM) + EPSF); const float* g = isq ? qg : kg;
            const float a0 = x1a * rs * g[0], a1 = x1b * rs * g[1], b0 = x2a * rs * g[2], b1 = x2b * rs * g[3];
            const float y1a = a0 * cs0 - b0 * sn0, y2a = a0 * sn0 + b0 * cs0, y1b = a1 * cs1 - b1 * sn1, y2b = a1 * sn1 + b1 * cs1;
            const unsigned w1 = pg8::cvt_pk_bf16(y1a, y1b), w2 = pg8::cvt_pk_bf16(y2a, y2b);
            if (isq) { bf16_t* dst = Q + (2 * it + hh) * HDIM; *(unsigned*)(dst + d1) = w1; *(unsigned*)(dst + d2) = w2; }
            else if (!lat) { bf16_t* K = (bf16_t*)(p.ws + WS_CTXK) + (size_t)row * NKV * HDIM + hh * HDIM; *(unsigned*)(K + d1) = w1; *(unsigned*)(K + d2) = w2;
                float* fo = p.out + O_K + (size_t)row * NKV * HDIM + hh * HDIM; *(float2*)(fo + d1) = make_float2(y1a, y1b); *(float2*)(fo + d2) = make_float2(y2a, y2b); }
            else { const int b_ = (row - MC) / LSEQ, s_ = (row - MC) % LSEQ; bf16_t* K = (bf16_t*)(p.ws + WS_LATK) + ((size_t)b_ * SKVL + s_) * NKV * HDIM + hh * HDIM; *(unsigned*)(K + d1) = w1; *(unsigned*)(K + d2) = w2; } }
    }
}
static_assert(NKV == 2 && NQ % 2 == 0 && HDIM == 128, "qkpost lane mapping");
__device__ __forceinline__ void phase_final(const Params& p, int gw, int NGW, int lane) {
    const f4 g0 = *((const f4*)p.fng + 2 * lane), g1 = *((const f4*)p.fng + 2 * lane + 1), g2 = *((const f4*)p.fng + 128 + 2 * lane), g3 = *((const f4*)p.fng + 128 + 2 * lane + 1);
    const float* sq = (const float*)(p.ws + WS_SSQ) + (size_t)3 * SSQ_STRIDE;
    for (int row = gw; row < MTOK; row += 2 * NGW) { const int row2 = row + NGW; const bool has2 = row2 < MTOK; const int r2 = has2 ? row2 : row;
        const float rsa = 1.0f / sqrtf(sq[row] * (1.0f / DM) + EPSF), rsb = 1.0f / sqrtf(sq[r2] * (1.0f / DM) + EPSF);
        const u4* ya = (const u4*)((const bf16_t*)(p.ws + WS_Y16) + (size_t)row * DM) + lane; const u4* yb = (const u4*)((const bf16_t*)(p.ws + WS_Y16) + (size_t)r2 * DM) + lane;
        const u4 a0 = ya[0], a1 = ya[64], b0 = yb[0], b1 = yb[64];
        f4* oa = (f4*)(p.out + O_Y + (size_t)row * DM) + 2 * lane; f4* ob = (f4*)(p.out + O_Y + (size_t)r2 * DM) + 2 * lane;
#define UNP_LO(V_) (f4){__uint_as_float((V_).x << 16), __uint_as_float((V_).x & 0xffff0000u), __uint_as_float((V_).y << 16), __uint_as_float((V_).y & 0xffff0000u)}
#define UNP_HI(V_) (f4){__uint_as_float((V_).z << 16), __uint_as_float((V_).z & 0xffff0000u), __uint_as_float((V_).w << 16), __uint_as_float((V_).w & 0xffff0000u)}
        oa[0] = UNP_LO(a0) * rsa * g0; oa[1] = UNP_HI(a0) * rsa * g1; oa[128] = UNP_LO(a1) * rsa * g2; oa[129] = UNP_HI(a1) * rsa * g3;
        if (has2) { ob[0] = UNP_LO(b0) * rsb * g0; ob[1] = UNP_HI(b0) * rsb * g1; ob[128] = UNP_LO(b1) * rsb * g2; ob[129] = UNP_HI(b1) * rsb * g3; }
#undef UNP_LO
#undef UNP_HI
    }
}
template <class Epi> __device__ __forceinline__ void gemm_call(LAS unsigned char* lds, const bf16_t* A, const bf16_t* Bt, int N, int K, const Epi& E) {
    pg8::Gemm g{A, Bt, MTOK, N, K}; pg8::StaticOrder S; S.init(MTOK, N, K, (int)gridDim.x, (int)blockIdx.x);
    pg8::gemm_phase<Epi, pg8::StaticOrder, true, true>((PG8_LAS unsigned char*)lds, g, S, E);
}
__device__ __forceinline__ void gemm_call_split(LAS unsigned char* lds, const bf16_t* A, const bf16_t* Bt, int N, int K, const EpiRes& E, unsigned char* slab, unsigned* cnt) {
    pg8::Gemm g{A, Bt, MTOK, N, K}; RoundZeroOrder S0; S0.init(MTOK, N, K, (int)gridDim.x, (int)blockIdx.x);
    pg8::gemm_phase<EpiRes, RoundZeroOrder, true, true>((PG8_LAS unsigned char*)lds, g, S0, E);
    if (S0.split) { QuarterOrder S1; S1.init(MTOK, N, K, (int)gridDim.x, (int)blockIdx.x);
        pg8::gemm_phase<EpiPartial, QuarterOrder, true, true>((PG8_LAS unsigned char*)lds, g, S1, EpiPartial{slab, cnt});
        tail_reduce(E, slab, cnt, (int)gridDim.x, (int)blockIdx.x, N / 256, MTOK / 256); }
}
__global__ void __launch_bounds__(NTHREADS, 2) mega_fwd(Params p) {
    extern __shared__ __attribute__((aligned(16))) unsigned char lds[];
    LAS unsigned char* L = (LAS unsigned char*)lds;
    for (int u = threadIdx.x; u < (LDS_BYTES - LDSCTL_OFF) / 4; u += NTHREADS) ((LAS unsigned*)(L + LDSCTL_OFF))[u] = 0u;
    __syncthreads();
    volatile LAS unsigned* MISC = (volatile LAS unsigned*)(L + MISC_OFF);
    const XcdBarrier bar = xcd_barrier_post((unsigned*)(p.ws + WS_CTL) + CW_BAR, MISC + 8);
    const int G = gridDim.x, bx = blockIdx.x; const int vcu = (G % 8 == 0) ? (bx % 8) * (G / 8) + bx / 8 : bx;
    unsigned char* ws = p.ws;
    const bf16_t* XN = (const bf16_t*)(ws + WS_XN); const bf16_t* UH = (const bf16_t*)(ws + WS_UH); const bf16_t* Hh = (const bf16_t*)(ws + WS_H); const bf16_t* Ob = (const bf16_t*)(ws + WS_O);
    float* SW0 = (float*)(ws + WS_SW); float* SWC = SW0 + (size_t)NCLS * 2 * DFF; float* SW1 = SWC + (size_t)NCLS * CIN;
    float* SSQ = (float*)(ws + WS_SSQ); float* Y = p.out + O_Y; unsigned* SPLITC = (unsigned*)(ws + WS_CTL) + CW_SPLIT;
#define WAVE_IDS() const int tid_ = tid_opaque(); const int lane_ = tid_ & 63; const int gw_ = bx * NWAVES + (tid_ >> 6); const int NGW_ = G * NWAVES
    p0_weights(p, L, vcu, G); phase_mod(p, (char*)lds, bx, G);
    xcd_barrier(bar);
    phase_norm0(p, (char*)lds, bx, G);
    { WAVE_IDS(); sw_job(p, (const bf16_t*)(ws + WB_FFI0), 2 * DFF, 0, 3, SW0, 2 * DFF, 1, gw_, NGW_, lane_); sw_job(p, (const bf16_t*)(ws + WB_INC), CIN, 1, 0, SWC, CIN, 0, gw_, NGW_, lane_);
      sw_job(p, (const bf16_t*)(ws + WB_FFI1), 2 * DFF, 1, 3, SW1, 2 * DFF, 1, gw_, NGW_, lane_); }
    xcd_barrier(bar);
    gemm_call(L, XN, (const bf16_t*)(ws + WB_AB), ABMAIN, DM, EpiAB{(bf16_t*)(ws + WS_UPRE), (bf16_t*)(ws + WS_QKVO)}); xcd_barrier(bar);
    ml_phase_A(p, lds, vcu, G); phase_conv(p, (char*)lds, vcu, G); xcd_barrier(bar);
    { WAVE_IDS(); MlScan sc{p}; for (long i = bx * (long)NTHREADS + tid_; i < MlScan::count(); i += (long)G * NTHREADS) sc(i); } xcd_barrier(bar);
    ml_phase_C(p, lds, vcu, G); xcd_barrier(bar);
    gemm_call_split(L, UH, (const bf16_t*)(ws + WB_OUTAB), DM, DM, EpiRes{p.xp, p.xs, (bf16_t*)(ws + WS_Y16), (bf16_t*)(ws + WS_XN), SSQ + 0 * SSQ_STRIDE, modv(p, 0, 0, 2), modv(p, 0, 0, 4), p.n2g, 1, 0}, (unsigned char*)Y, SPLITC + 0 * 4096); xcd_barrier(bar);
    gemm_call(L, XN, (const bf16_t*)(ws + WB_FFI0), 2 * DFF, DM, EpiFfnIn{(bf16_t*)(ws + WS_H), SSQ + 0 * SSQ_STRIDE, SW0}); xcd_barrier(bar);
    gemm_call_split(L, Hh, (const bf16_t*)(ws + WB_FFO0), DM, DFF, EpiRes{p.xp, p.xs, (bf16_t*)(ws + WS_Y16), (bf16_t*)(ws + WS_XN), SSQ + 1 * SSQ_STRIDE, modv(p, 0, 0, 5), modv(p, 1, 0, 1), p.n1g + DM, 0, 0}, (unsigned char*)Y + SLAB_BYTES, SPLITC + 1 * 4096); xcd_barrier(bar);
    gemm_call(L, XN, (const bf16_t*)(ws + WB_INC), CIN, DM, EpiQkv{(bf16_t*)(ws + WS_QRAW), (bf16_t*)(ws + WS_KRAW), (bf16_t*)(ws + WS_CTXV), (bf16_t*)(ws + WS_LATV), p.out + O_V, SSQ + 1 * SSQ_STRIDE, SWC}); xcd_barrier(bar);
    { WAVE_IDS(); phase_qkpost(p, gw_, NGW_, lane_); phase_cachecvt(p, bx * NTHREADS + tid_, G * NTHREADS); } xcd_barrier(bar);
    attn_phase(p, lds, vcu, G); xcd_barrier(bar);
    gemm_call_split(L, Ob, (const bf16_t*)(ws + WB_OUTC), DM, DM, EpiRes{p.xp, p.xs, (bf16_t*)(ws + WS_Y16), (bf16_t*)(ws + WS_XN), SSQ + 2 * SSQ_STRIDE, modv(p, 1, 0, 2), modv(p, 1, 0, 4), p.n2g + DM, 0, 0}, (unsigned char*)Y, SPLITC + 2 * 4096); xcd_barrier(bar);
    gemm_call(L, XN, (const bf16_t*)(ws + WB_FFI1), 2 * DFF, DM, EpiFfnIn{(bf16_t*)(ws + WS_H), SSQ + 2 * SSQ_STRIDE, SW1}); xcd_barrier(bar);
    gemm_call_split(L, Hh, (const bf16_t*)(ws + WB_FFO1), DM, DFF, EpiRes{p.xp, p.xs, (bf16_t*)(ws + WS_Y16), (bf16_t*)(ws + WS_XN), SSQ + 3 * SSQ_STRIDE, modv(p, 1, 0, 5), modv(p, 1, 0, 1), nullptr, 0, 0}, (unsigned char*)Y + SLAB_BYTES, SPLITC + 3 * 4096); xcd_barrier(bar);
    { WAVE_IDS(); phase_final(p, gw_, NGW_, lane_); }
#undef WAVE_IDS
}
static Params make_params(void* const* d_in, void* d_out, void* d_ws) {
    Params p{}; const float** pp = (const float**)&p; for (int i = 0; i < 28; ++i) pp[i] = (const float*)d_in[i];
    p.out = (float*)d_out; p.ws = (unsigned char*)d_ws; return p;
}
extern "C" void kernel_launch(void* const* d_in, const int* in_sizes, int n_in, void* d_out, int out_size, void* d_ws, size_t ws_size, hipStream_t stream) {
    static int grid = 0;
    if (grid == 0) {
        if (n_in != 28 || (size_t)out_size != O_END || ws_size < WS_END || in_sizes[0] != MC * DM || in_sizes[1] != ML * DM) {
            fprintf(stderr, "kernel_launch: shape mismatch n_in %d out %d (want %zu) ws %zu (want %zu)\n", n_in, out_size, (size_t)O_END, ws_size, (size_t)WS_END); grid = -1; return; }
        int dev = 0, cus = 0;
        if (hipGetDevice(&dev) != hipSuccess || hipDeviceGetAttribute(&cus, hipDeviceAttributeMultiprocessorCount, dev) != hipSuccess) { grid = -1; return; }
        if (hipFuncSetAttribute((const void*)mega_fwd, hipFuncAttributeMaxDynamicSharedMemorySize, LDS_BYTES) != hipSuccess) { fprintf(stderr, "hipFuncSetAttribute failed\n"); grid = -1; return; }
        int per_cu = 0; (void)hipOccupancyMaxActiveBlocksPerMultiprocessor(&per_cu, (const void*)mega_fwd, NTHREADS, LDS_BYTES); (void)hipGetLastError();
        if (per_cu < 1) fprintf(stderr, "kernel_launch: occupancy query says %d blocks/CU\n", per_cu);
        grid = cus;
    }
    if (grid < 0) return;
    hipMemsetAsync((char*)d_ws + WS_CTL, 0, CTL_ZERO_BYTES, stream);
    Params p = make_params(d_in, d_out, d_ws);
    hipLaunchKernelGGL(mega_fwd, dim3(grid), dim3(NTHREADS), LDS_BYTES, stream, p);
}
```

```cpp
#ifdef HOST_TEST
#include <cmath>
#include <cstdio>
#include <cstdlib>
#include <cstring>
#include <cstdint>
#include <vector>
#define HD_FN inline
#define DEV_FN inline
#else
#include <hip/hip_runtime.h>
#include <cstdio>
#include <cstdint>
#define HD_FN __host__ __device__ __forceinline__
#define DEV_FN __device__ __forceinline__
#endif

#ifdef TINY
constexpr int DM = 512, NCB = 2, CSEQ = 128, NLB = 2, LSEQ = 128, PAST = 128;
#else
constexpr int DM = 1024, NCB = 16, CSEQ = 256, NLB = 4, LSEQ = 4096, PAST = 256;
#endif
constexpr int GRIDW = 64, CCH = DM / 2, CWID = 31, MH = 4, MDK = CCH / MH, MW = CCH, NGATE = 16;
constexpr int ABIN = 2 * CCH + 4 * MW + NGATE, ABMAIN = 2 * CCH + 4 * MW;
constexpr int HDIM = 128, NQ = DM / HDIM, NKV = 2, GRP = NQ / NKV, CIN = (NQ + 2 * NKV) * HDIM;
constexpr int DFF = ((8 * DM + 3 * 256 - 1) / (3 * 256)) * 256;
constexpr int MC = NCB * CSEQ, ML = NLB * LSEQ, MTOK = MC + ML, NCLS = 1 + NLB, SKVL = LSEQ + PAST;
constexpr float EPSF = 1e-6f;
constexpr int NSEQ = NCB + NLB;

constexpr size_t O_Y = 0, O_C = (size_t)MTOK * DM, O_N = O_C + (size_t)NCB * 2 * MH * MDK * MDK, O_M = O_N + (size_t)NCB * 2 * MH * MDK,
                 O_K = O_M + (size_t)NCB * 2 * MH, O_V = O_K + (size_t)NCB * CSEQ * NKV * HDIM, O_END = O_V + (size_t)NCB * CSEQ * NKV * HDIM;

constexpr size_t MiB = 1u << 20;
#ifdef TINY
constexpr size_t WSCALE = 1;
#endif
constexpr size_t WS_CTL = 0, CTL_ZERO_BYTES = 1 * MiB;
constexpr size_t WS_MOD = 1 * MiB;
constexpr size_t WS_SW = WS_MOD + 256 * 1024;
constexpr size_t WS_SSQ = 512 * 1024;
constexpr int SSQ_STRIDE = 32768;
constexpr size_t WS_DEN = 232 * MiB;
constexpr size_t WS_WB = 2 * MiB;
constexpr size_t WS_XN = 50 * MiB;
constexpr size_t WS_UPRE = 90 * MiB;
constexpr size_t WS_QKVO = 110 * MiB;
constexpr size_t WS_UH = 190 * MiB;
constexpr size_t WS_GATES = 230 * MiB;
constexpr size_t WS_HS = 50 * MiB;
constexpr size_t WS_Y16 = 90 * MiB;
constexpr size_t WS_H = 130 * MiB;
constexpr size_t WS_QRAW = 130 * MiB;
constexpr size_t WS_LATK = 170 * MiB, WS_LATV = 179 * MiB, WS_CTXK = 188 * MiB, WS_CTXV = 190 * MiB;
constexpr size_t WS_KRAW = 192 * MiB;
constexpr size_t WS_O = 202 * MiB;
constexpr size_t WS_END = 256 * MiB;

typedef unsigned short bf16_t;
HD_FN float bf2f(bf16_t h) { unsigned u = (unsigned)h << 16; return __builtin_bit_cast(float, u); }
HD_FN bf16_t f2bf(float f) { unsigned u = __builtin_bit_cast(unsigned, f); return (bf16_t)((u + 0x7fffu + ((u >> 16) & 1u)) >> 16); }
HD_FN float rbf(float f) { return bf2f(f2bf(f)); }
HD_FN float sigmoidf_(float x) { return 1.0f / (1.0f + expf(-x)); }
HD_FN float siluf_(float x) { return x * sigmoidf_(x); }
HD_FN float logsigmoidf_(float x) { return x >= 0.f ? -log1pf(expf(-x)) : x - log1pf(expf(x)); }
HD_FN int cls_of(int row) { return row < MC ? 0 : 1 + (row - MC) / LSEQ; }
HD_FN int seqlen_of(int row) { return row < MC ? CSEQ : LSEQ; }
HD_FN int pos_of(int row) { return row < MC ? row % CSEQ : (row - MC) % LSEQ; }

struct Params {
    const float *xp, *xs, *c, *stC, *stn, *stm, *ck, *cv, *cctx, *wmod, *bmod, *n1g, *n2g, *winab, *bgate, *convw, *convb, *lng, *lnb, *mng,
        *woutab, *winc, *qng, *kng, *woutc, *wffi, *wffo, *fng;
    float* out; unsigned char* ws;
};
HD_FN const float* xrow(const Params& p, int row) { return row < MC ? p.xp + (size_t)row * DM : p.xs + (size_t)(row - MC) * DM; }
HD_FN const float* modv(const Params& p, int l, int cls, int which) { return (const float*)(p.ws + WS_MOD) + ((size_t)(l * NCLS + cls) * 6 + which) * DM; }
constexpr size_t WS_RS0 = 233 * MiB;

struct NMod {
    Params p; static HD_FN long count() { return 2L * NCLS * 6 * DM; }
    HD_FN void operator()(long idx) const {
        const int col = (int)(idx % (6 * DM)); const int cls = (int)((idx / (6 * DM)) % NCLS); const int l = (int)(idx / (6 * DM * NCLS));
        const float* cond = cls == 0 ? p.cctx : p.c + (size_t)(cls - 1) * DM;
        const float* w = p.wmod + (size_t)l * DM * 6 * DM;
        float acc = 0.f;
        for (int k = 0; k < DM; ++k) acc += siluf_(cond[k]) * w[(size_t)k * 6 * DM + col];
        ((float*)(p.ws + WS_MOD))[idx] = acc + p.bmod[(size_t)l * 6 * DM + col];
    }
};
struct NNorm0a {
    Params p; static HD_FN long count() { return MTOK; }
    HD_FN void operator()(long row) const {
        const float* x = xrow(p, (int)row); float s = 0.f;
        for (int k = 0; k < DM; ++k) s += x[k] * x[k];
        ((float*)(p.ws + WS_RS0))[row] = 1.0f / sqrtf(s / DM + EPSF);
    }
};
struct NNorm0b {
    Params p; static HD_FN long count() { return (long)MTOK * DM; }
    HD_FN void operator()(long idx) const {
        const int row = (int)(idx / DM), col = (int)(idx % DM), cls = cls_of(row);
        const float rs = ((const float*)(p.ws + WS_RS0))[row];
        const float v = xrow(p, row)[col] * rs * p.n1g[col] * (1.f + modv(p, 0, cls, 1)[col]) + modv(p, 0, cls, 0)[col];
        ((bf16_t*)(p.ws + WS_XN))[idx] = f2bf(v);
    }
};
struct NGates {
    Params p; static HD_FN long count() { return (long)MTOK * NGATE; }
    HD_FN void operator()(long idx) const {
        const int row = (int)(idx / NGATE), j = (int)(idx % NGATE), cls = cls_of(row);
        const float rs = ((const float*)(p.ws + WS_RS0))[row]; const float* x = xrow(p, row);
        const float* sc = modv(p, 0, cls, 1); const float* sh = modv(p, 0, cls, 0);
        float acc = 0.f;
        for (int k = 0; k < DM; ++k) { const float h = x[k] * rs * p.n1g[k] * (1.f + sc[k]) + sh[k]; acc += h * p.winab[(size_t)k * ABIN + ABMAIN + j]; }
        acc += p.bgate[j];
        if ((j & 7) >= 4) acc = logsigmoidf_(acc);
        ((float*)(p.ws + WS_GATES))[idx] = acc;
    }
};

template <bool DUAL, class Epi> struct NGemm {
    const bf16_t* A; const float* B; int lda, ldb, K, N, off2, pad_; Epi epi;
    HD_FN long count() const { return (long)(MTOK / 4) * (N / 4); }
    HD_FN void operator()(long idx) const {
        const int nt = (int)(idx % (N / 4)), mt = (int)(idx / (N / 4)); const int m0 = mt * 4, n0 = nt * 4;
        float acc[4][4], acc2[4][4];
#pragma unroll
        for (int i = 0; i < 4; ++i)
#pragma unroll
            for (int j = 0; j < 4; ++j) { acc[i][j] = 0.f; acc2[i][j] = 0.f; }
        for (int k0 = 0; k0 < K; k0 += 8) {
            float a[4][8];
#pragma unroll
            for (int i = 0; i < 4; ++i) {
                const bf16_t* ap = A + (size_t)(m0 + i) * lda + k0;
#pragma unroll
                for (int kk = 0; kk < 8; ++kk) a[i][kk] = bf2f(ap[kk]);
            }
#pragma unroll
            for (int kk = 0; kk < 8; ++kk) {
                const float* bp = B + (size_t)(k0 + kk) * ldb + n0;
                float b[4], b2[4];
#pragma unroll
                for (int j = 0; j < 4; ++j) { b[j] = rbf(bp[j]); b2[j] = DUAL ? rbf(bp[off2 + j]) : 0.f; }
#pragma unroll
                for (int i = 0; i < 4; ++i)
#pragma unroll
                    for (int j = 0; j < 4; ++j) { acc[i][j] += a[i][kk] * b[j]; if (DUAL) acc2[i][j] += a[i][kk] * b2[j]; }
            }
        }
#pragma unroll
        for (int i = 0; i < 4; ++i)
#pragma unroll
            for (int j = 0; j < 4; ++j) epi(m0 + i, n0 + j, acc[i][j], acc2[i][j]);
    }
};
struct EGlu { Params p; HD_FN void operator()(int row, int col, float v, float v2) const { ((bf16_t*)(p.ws + WS_UPRE))[(size_t)row * CCH + col] = f2bf(v * sigmoidf_(v2)); } };
struct EQkvo { Params p; HD_FN void operator()(int row, int col, float v, float) const {
        const int part = col / MW; if (part == 1) v *= 1.0f / sqrtf((float)MDK); if (part == 3) v = sigmoidf_(v);
        ((bf16_t*)(p.ws + WS_QKVO))[(size_t)row * 4 * MW + col] = f2bf(v); } };
struct EOut { Params p; int l; int pad_ = 0; HD_FN void operator()(int row, int col, float v, float) const {
        const int cls = cls_of(row); float* Y = p.out + O_Y + (size_t)row * DM + col;
        const float xin = l == 0 ? xrow(p, row)[col] : *Y;
        const float x1 = xin + modv(p, l, cls, 2)[col] * v; *Y = x1;
        ((bf16_t*)(p.ws + WS_XN))[(size_t)row * DM + col] = f2bf(x1 * p.n2g[(size_t)l * DM + col] * (1.f + modv(p, l, cls, 4)[col])); } };
struct EFfnIn { Params p; const float* sw; int slot; int pad_ = 0; HD_FN void operator()(int row, int col, float v, float v2) const {
        const int cls = cls_of(row); const float rs = 1.0f / sqrtf(((const float*)(p.ws + WS_SSQ))[(size_t)slot * SSQ_STRIDE + row] / DM + EPSF);
        const float a = v * rs + sw[(size_t)cls * 2 * DFF + col], b = v2 * rs + sw[(size_t)cls * 2 * DFF + DFF + col];
        ((bf16_t*)(p.ws + WS_H))[(size_t)row * DFF + col] = f2bf(siluf_(a) * b); } };
struct EFfnOut { Params p; int l; int pad_ = 0; HD_FN void operator()(int row, int col, float v, float) const {
        const int cls = cls_of(row); float* Y = p.out + O_Y + (size_t)row * DM + col;
        const float x2 = *Y + modv(p, l, cls, 5)[col] * v; *Y = x2;
        if (l == 0) ((bf16_t*)(p.ws + WS_XN))[(size_t)row * DM + col] = f2bf(x2 * p.n1g[(size_t)DM + col] * (1.f + modv(p, 1, cls, 1)[col])); } };
struct EQkv { Params p; const float* sw; int slot; int pad_ = 0; HD_FN void operator()(int row, int col, float v, float) const {
        const int cls = cls_of(row); const float rs = 1.0f / sqrtf(((const float*)(p.ws + WS_SSQ))[(size_t)slot * SSQ_STRIDE + row] / DM + EPSF);
        const float a = v * rs + sw[(size_t)cls * CIN + col];
        if (col < NQ * HDIM) ((bf16_t*)(p.ws + WS_QRAW))[(size_t)row * NQ * HDIM + col] = f2bf(a);
        else if (col < (NQ + NKV) * HDIM) ((bf16_t*)(p.ws + WS_KRAW))[(size_t)row * NKV * HDIM + (col - NQ * HDIM)] = f2bf(a);
        else { const int c2 = col - (NQ + NKV) * HDIM;
            if (row < MC) { ((bf16_t*)(p.ws + WS_CTXV))[(size_t)row * NKV * HDIM + c2] = f2bf(a); p.out[O_V + (size_t)row * NKV * HDIM + c2] = a; }
            else { const int b = (row - MC) / LSEQ, s = (row - MC) % LSEQ; ((bf16_t*)(p.ws + WS_LATV))[((size_t)b * SKVL + s) * NKV * HDIM + c2] = f2bf(a); } } } };

struct NSsq {
    Params p; int slot; int pad_ = 0; static HD_FN long count() { return MTOK; }
    HD_FN void operator()(long row) const { const float* y = p.out + O_Y + (size_t)row * DM; float s = 0.f; for (int k = 0; k < DM; ++k) s += y[k] * y[k];
        ((float*)(p.ws + WS_SSQ))[(size_t)slot * SSQ_STRIDE + row] = s; }
};
struct NSW {
    Params p; const float* W; float* sw; int l, which, N, pad_; HD_FN long count() const { return (long)NCLS * N; }
    HD_FN void operator()(long idx) const { const int n = (int)(idx % N), cls = (int)(idx / N); const float* sh = modv(p, l, cls, which); float acc = 0.f;
        for (int k = 0; k < DM; ++k) acc += sh[k] * rbf(W[(size_t)k * N + n]); sw[idx] = acc; }
};
struct NConv {
    Params p; static HD_FN long count() { return (long)MTOK * CCH; }
    HD_FN void operator()(long idx) const {
        const int row = (int)(idx / CCH), c = (int)(idx % CCH), pos = pos_of(row), len = seqlen_of(row);
        const bf16_t* U = (const bf16_t*)(p.ws + WS_UPRE); float acc = p.convb[c];
        for (int j = 0; j < CWID; ++j) { const int t = pos + j - CWID / 2; if (t >= 0 && t < len) acc += p.convw[(size_t)j * CCH + c] * bf2f(U[(size_t)(row + j - CWID / 2) * CCH + c]); }
        ((float*)(p.ws + WS_HS))[idx] = acc;
    }
};
struct NConvLN {
    Params p; static HD_FN long count() { return MTOK; }
    HD_FN void operator()(long row) const {
        const float* t = (const float*)(p.ws + WS_HS) + (size_t)row * CCH; float mu = 0.f;
        for (int c = 0; c < CCH; ++c) mu += t[c]; mu /= CCH; float var = 0.f;
        for (int c = 0; c < CCH; ++c) { const float d = t[c] - mu; var += d * d; } var /= CCH;
        const float rs = 1.0f / sqrtf(var + EPSF); bf16_t* UH = (bf16_t*)(p.ws + WS_UH) + (size_t)row * DM;
        for (int c = 0; c < CCH; ++c) UH[c] = f2bf(siluf_((t[c] - mu) * rs * p.lng[c] + p.lnb[c]));
    }
};
HD_FN int seq_base(int sid) { return sid < NCB ? sid * CSEQ : MC + (sid - NCB) * LSEQ; }
struct NMlstmDen {
    Params p; static HD_FN long count() { return (long)NSEQ * MH * 2; }
    HD_FN void operator()(long idx) const {
        const int dir = (int)(idx % 2), h = (int)((idx / 2) % MH), sid = (int)(idx / (2 * MH)); const bool isctx = sid < NCB;
        const int base = seq_base(sid), len = isctx ? CSEQ : LSEQ;
        float n[MDK]; float mrun = 0.f;
        if (isctx) {
#pragma unroll
            for (int d = 0; d < MDK; ++d) n[d] = 0.f;
        } else { const int b = sid - NCB; const float em = expf(p.stm[(size_t)(b * 2 + dir) * MH + h]);
#pragma unroll
            for (int d = 0; d < MDK; ++d) n[d] = p.stn[((size_t)(b * 2 + dir) * MH + h) * MDK + d] * em; }
        const bf16_t* QK = (const bf16_t*)(p.ws + WS_QKVO); const float* G = (const float*)(p.ws + WS_GATES); float* DEN = (float*)(p.ws + WS_DEN);
        for (int t = 0; t < len; ++t) {
            const int row = base + (dir == 0 ? t : len - 1 - t);
            const float ig = G[(size_t)row * NGATE + dir * 8 + h], lf = G[(size_t)row * NGATE + dir * 8 + 4 + h];
            const float f = expf(lf), ei = expf(ig); mrun = fmaxf(mrun + lf, ig);
            const bf16_t* q = QK + (size_t)row * 4 * MW + h * MDK; const bf16_t* k = q + MW; float den = 0.f;
#pragma unroll
            for (int d = 0; d < MDK; ++d) { n[d] = f * n[d] + ei * bf2f(k[d]); den += bf2f(q[d]) * n[d]; }
            DEN[((size_t)dir * MTOK + row) * MH + h] = den;
        }
        if (isctx) { const float em = expf(-mrun); p.out[O_M + (size_t)(sid * 2 + dir) * MH + h] = mrun;
#pragma unroll
            for (int d = 0; d < MDK; ++d) p.out[O_N + ((size_t)(sid * 2 + dir) * MH + h) * MDK + d] = n[d] * em; }
    }
};
struct NMlstmNum {
    Params p; int dir; int pad_ = 0; static HD_FN long count() { return (long)NSEQ * MH * MDK; }
    HD_FN void operator()(long idx) const {
        const int v = (int)(idx % MDK), h = (int)((idx / MDK) % MH), sid = (int)(idx / (MDK * MH)); const bool isctx = sid < NCB;
        const int base = seq_base(sid), len = isctx ? CSEQ : LSEQ;
        float C[MDK];
        if (isctx) {
#pragma unroll
            for (int d = 0; d < MDK; ++d) C[d] = 0.f;
        } else { const int b = sid - NCB; const float em = expf(p.stm[(size_t)(b * 2 + dir) * MH + h]);
#pragma unroll
            for (int d = 0; d < MDK; ++d) C[d] = p.stC[(((size_t)(b * 2 + dir) * MH + h) * MDK + d) * MDK + v] * em; }
        const bf16_t* QK = (const bf16_t*)(p.ws + WS_QKVO); const float* G = (const float*)(p.ws + WS_GATES); const float* DEN = (const float*)(p.ws + WS_DEN);
        float* HS = (float*)(p.ws + WS_HS);
        for (int t = 0; t < len; ++t) {
            const int row = base + (dir == 0 ? t : len - 1 - t);
            const float ig = G[(size_t)row * NGATE + dir * 8 + h], lf = G[(size_t)row * NGATE + dir * 8 + 4 + h];
            const float f = expf(lf), ei = expf(ig);
            const bf16_t* q = QK + (size_t)row * 4 * MW + h * MDK; const bf16_t* k = q + MW; const float vv = bf2f(q[2 * MW + v]) * ei; float num = 0.f;
#pragma unroll
            for (int d = 0; d < MDK; ++d) { C[d] = f * C[d] + bf2f(k[d]) * vv; num += bf2f(q[d]) * C[d]; }
            const float den = DEN[((size_t)dir * MTOK + row) * MH + h]; const float hv = num / fmaxf(fabsf(den), 1.0f);
            float* o = HS + (size_t)row * MW + h * MDK + v; if (dir == 0) *o = hv; else *o += hv;
        }
        if (isctx) { const float em = expf(-p.out[O_M + (size_t)(sid * 2 + dir) * MH + h]);
#pragma unroll
            for (int d = 0; d < MDK; ++d) p.out[O_C + (((size_t)(sid * 2 + dir) * MH + h) * MDK + d) * MDK + v] = C[d] * em; }
    }
};
struct NHm {
    Params p; static HD_FN long count() { return (long)MTOK * MH; }
    HD_FN void operator()(long idx) const {
        const int row = (int)(idx / MH), h = (int)(idx % MH); const float* x = (const float*)(p.ws + WS_HS) + (size_t)row * MW + h * MDK; float s = 0.f;
        for (int v = 0; v < MDK; ++v) s += x[v] * x[v];
        const float rs = 1.0f / sqrtf(s / MDK + EPSF); const bf16_t* og = (const bf16_t*)(p.ws + WS_QKVO) + (size_t)row * 4 * MW + 3 * MW + h * MDK;
        bf16_t* UH = (bf16_t*)(p.ws + WS_UH) + (size_t)row * DM + CCH + h * MDK;
        for (int v = 0; v < MDK; ++v) UH[v] = f2bf(bf2f(og[v]) * x[v] * rs * p.mng[h * MDK + v]);
    }
};
struct NCacheCvt {
    Params p; static HD_FN long count() { return (long)NLB * PAST * NKV * HDIM; }
    HD_FN void operator()(long idx) const { const int e = (int)(idx % (NKV * HDIM)), pp = (int)((idx / (NKV * HDIM)) % PAST), b = (int)(idx / ((long)NKV * HDIM * PAST));
        const size_t dst = ((size_t)b * SKVL + LSEQ + pp) * NKV * HDIM + e;
        ((bf16_t*)(p.ws + WS_LATK))[dst] = f2bf(p.ck[idx]); ((bf16_t*)(p.ws + WS_LATV))[dst] = f2bf(p.cv[idx]); }
};
struct NQkPost {
    Params p; static HD_FN long count() { return (long)MTOK * (NQ + NKV); }
    HD_FN void operator()(long idx) const {
        const int row = (int)(idx / (NQ + NKV)), j = (int)(idx % (NQ + NKV)); const bool isq = j < NQ; const bool lat = row >= MC;
        bf16_t* src = isq ? (bf16_t*)(p.ws + WS_QRAW) + (size_t)row * NQ * HDIM + j * HDIM : (bf16_t*)(p.ws + WS_KRAW) + (size_t)row * NKV * HDIM + (j - NQ) * HDIM;
        const float* g = isq ? p.qng : p.kng; float s = 0.f;
        for (int d = 0; d < HDIM; ++d) { const float x = bf2f(src[d]); s += x * x; }
        const float rs = 1.0f / sqrtf(s / HDIM + EPSF);
        bf16_t* dst; float* fo = nullptr;
        if (isq) dst = src;
        else if (!lat) { dst = (bf16_t*)(p.ws + WS_CTXK) + (size_t)row * NKV * HDIM + (j - NQ) * HDIM; fo = p.out + O_K + (size_t)row * NKV * HDIM + (j - NQ) * HDIM; }
        else { const int b = (row - MC) / LSEQ, sp = (row - MC) % LSEQ; dst = (bf16_t*)(p.ws + WS_LATK) + ((size_t)b * SKVL + sp) * NKV * HDIM + (j - NQ) * HDIM; }
        const int sp = pos_of(row); const float prow = (float)(sp / GRIDW), pcol = (float)(sp % GRIDW);
        for (int half = 0; half < 2; ++half)
            for (int d = 0; d < HDIM / 4; ++d) {
                const int i1 = half * (HDIM / 2) + d, i2 = i1 + HDIM / 4;
                const float x1 = bf2f(src[i1]) * rs * g[i1], x2 = bf2f(src[i2]) * rs * g[i2]; float y1 = x1, y2 = x2;
                if (lat) { const float inv = powf(10000.0f, -(float)d / (float)(HDIM / 4)); const float ang = (half == 0 ? prow : pcol) * inv; const float cs = cosf(ang), sn = sinf(ang);
                    y1 = x1 * cs - x2 * sn; y2 = x1 * sn + x2 * cs; }
                dst[i1] = f2bf(y1); dst[i2] = f2bf(y2); if (fo) { fo[i1] = y1; fo[i2] = y2; }
            }
    }
};
struct NAttn {
    Params p; static HD_FN long count() { return (long)MTOK * NQ * 4; }
    HD_FN void operator()(long idx) const {
        const int sl = (int)(idx % 4), hq = (int)((idx / 4) % NQ), row = (int)(idx / (4 * NQ)); const int kv = hq / GRP;
        const bf16_t *Kb, *Vb; int nk;
        if (row < MC) { const int b = row / CSEQ; Kb = (const bf16_t*)(p.ws + WS_CTXK) + (size_t)b * CSEQ * NKV * HDIM; Vb = (const bf16_t*)(p.ws + WS_CTXV) + (size_t)b * CSEQ * NKV * HDIM; nk = CSEQ; }
        else { const int b = (row - MC) / LSEQ; Kb = (const bf16_t*)(p.ws + WS_LATK) + (size_t)b * SKVL * NKV * HDIM; Vb = (const bf16_t*)(p.ws + WS_LATV) + (size_t)b * SKVL * NKV * HDIM; nk = SKVL; }
        const bf16_t* qp = (const bf16_t*)(p.ws + WS_QRAW) + (size_t)row * NQ * HDIM + hq * HDIM;
        float q[HDIM];
#pragma unroll
        for (int d = 0; d < HDIM; ++d) q[d] = bf2f(qp[d]);
        float o[32];
#pragma unroll
        for (int e = 0; e < 32; ++e) o[e] = 0.f;
        float m = -1e30f, l = 0.f; const float scale = 1.0f / sqrtf((float)HDIM);
        for (int s = 0; s < nk; ++s) {
            const bf16_t* kp = Kb + (size_t)s * NKV * HDIM + kv * HDIM; float dot = 0.f;
#pragma unroll
            for (int d = 0; d < HDIM; ++d) dot += q[d] * bf2f(kp[d]);
            dot *= scale; const float mn = fmaxf(m, dot); const float al = expf(m - mn), pe = expf(dot - mn); m = mn; l = l * al + pe;
            const bf16_t* vp = Vb + (size_t)s * NKV * HDIM + kv * HDIM + sl * 32;
#pragma unroll
            for (int e = 0; e < 32; ++e) o[e] = o[e] * al + pe * bf2f(vp[e]);
        }
        bf16_t* op = (bf16_t*)(p.ws + WS_O) + (size_t)row * DM + hq * HDIM + sl * 32;
#pragma unroll
        for (int e = 0; e < 32; ++e) op[e] = f2bf(o[e] / l);
    }
};
struct NFinal {
    Params p; static HD_FN long count() { return (long)MTOK * DM; }
    HD_FN void operator()(long idx) const { const int row = (int)(idx / DM), col = (int)(idx % DM);
        const float rs = 1.0f / sqrtf(((const float*)(p.ws + WS_SSQ))[(size_t)3 * SSQ_STRIDE + row] / DM + EPSF); p.out[O_Y + idx] *= rs * p.fng[col]; }
};
constexpr int NWAVES = 8, NTHREADS = NWAVES * 64;
constexpr int RING_OFF = 0, RING_BYTES = 131072;
constexpr int LDSCTL_OFF = RING_BYTES, MISC_OFF = LDSCTL_OFF + 320;
constexpr int LDS_BYTES = 147456;
constexpr int CW_TMO = 0, CW_CODE = 1, CW_BAR = 4096;
__device__ __forceinline__ int tid_opaque() { int t = threadIdx.x; asm volatile("" : "+v"(t)); return t; }
template <int M> __device__ __forceinline__ float swz_xor(float v) { return __int_as_float(__builtin_amdgcn_ds_swizzle(__float_as_int(v), (M << 10) | 0x1f)); }
__device__ __forceinline__ float half_sum(float v) { auto rr = __builtin_amdgcn_permlane32_swap(__float_as_uint(v), __float_as_uint(v), false, false); return __uint_as_float(rr[0]) + __uint_as_float(rr[1]); }
__device__ __forceinline__ float half_max(float v) { auto rr = __builtin_amdgcn_permlane32_swap(__float_as_uint(v), __float_as_uint(v), false, false); return fmaxf(__uint_as_float(rr[0]), __uint_as_float(rr[1])); }
__device__ __forceinline__ float lane_get(float v, int src_lane) { return __int_as_float(__builtin_amdgcn_ds_bpermute(src_lane << 2, __float_as_int(v))); }
#define GAS __attribute__((address_space(1)))
#define LAS __attribute__((address_space(3)))
typedef GAS unsigned gu32;
#define RLX_AGENT __ATOMIC_RELAXED, __HIP_MEMORY_SCOPE_AGENT
#define XB_TMO      128
#define XB_XCNT(j)  (256  + 64 * (j))
#define XB_XSUB(j)  (1280 + 64 * (j))
#define XB_XGEN(j)  (2304 + 64 * (j))
#define XB_TOP      3328
#define XB_TOPGEN   3392
#define XCD_BAR_WORDS 3456
#define XB_SPIN_CAP (1u << 22)
__device__ __forceinline__ unsigned xb_ld(unsigned* p)              { return __hip_atomic_load(p, __ATOMIC_RELAXED, __HIP_MEMORY_SCOPE_AGENT); }
__device__ __forceinline__ unsigned xb_add(unsigned* p, unsigned v) { return __hip_atomic_fetch_add(p, v, __ATOMIC_RELAXED, __HIP_MEMORY_SCOPE_AGENT); }
__device__ __forceinline__ unsigned xb_xcc_id() { return (unsigned)__builtin_amdgcn_s_getreg((3 << 11) | 20) & 0xFu; }
#define XB_SPIN(cond, bar) do { unsigned _sp = 0; while (cond) { __builtin_amdgcn_s_sleep(1); \
    if ((++_sp & 255u) == 0u) { if (xb_ld(&(bar)[XB_TMO])) break; if (_sp > XB_SPIN_CAP) { atomicAdd(&(bar)[XB_TMO], 1u); break; } } } } while (0)
struct XcdBarrier { unsigned* bar; unsigned x; volatile LAS unsigned* st; };
__device__ __forceinline__ XcdBarrier xcd_barrier_post(unsigned* bar, volatile LAS unsigned* st) {
    XcdBarrier b; b.bar = bar; b.x = xb_xcc_id(); b.st = st;
    if (threadIdx.x == 0) (void)xb_add(&bar[XB_XCNT(b.x)], 1u);
    return b;
}
__device__ __forceinline__ void xcd_barrier_complete(unsigned* bar, unsigned x, unsigned& nloc, unsigned& nx) {
    const unsigned G = gridDim.x * gridDim.y * gridDim.z;
    unsigned sum, cnt, mine, sp = 0u;
    for (;;) {
        sum = 0u; cnt = 0u; mine = 0u;
#pragma unroll
        for (unsigned j = 0; j < 16; ++j) { const unsigned c = xb_ld(&bar[XB_XCNT(j)]); sum += c; cnt += (c > 0u) ? 1u : 0u; mine = (j == x) ? c : mine; }
        if (sum == G) break;
        __builtin_amdgcn_s_sleep(1);
        if ((++sp & 255u) == 0u) { if (xb_ld(&bar[XB_TMO])) break; if (sp > XB_SPIN_CAP) { atomicAdd(&bar[XB_TMO], 1u); break; } }
    }
    nloc = mine > 0u ? mine : 1u; nx = cnt > 0u ? cnt : 1u;
}
__device__ __forceinline__ void xcd_barrier(const XcdBarrier& b) {
    asm volatile("s_waitcnt vmcnt(0)" ::: "memory");
    __syncthreads();
    if (threadIdx.x == 0) {
        unsigned* bar = b.bar;
        __builtin_amdgcn_s_waitcnt(0);
        unsigned nloc = b.st[0], nx = b.st[1];
        if (nloc == 0u) { xcd_barrier_complete(bar, b.x, nloc, nx); b.st[0] = nloc; b.st[1] = nx; }
        const unsigned old = xb_add(&bar[XB_XSUB(b.x)], 1u);
        const unsigned gen = old / nloc;
        if (old + 1u == (gen + 1u) * nloc) {
            __builtin_amdgcn_fence(__ATOMIC_RELEASE, "agent");
            asm volatile("s_waitcnt vmcnt(0)" ::: "memory");
            const unsigned og = xb_add(&bar[XB_TOP], 1u);
            const unsigned tg = og / nx;
            if (og + 1u == (tg + 1u) * nx) xb_add(&bar[XB_TOPGEN], 1u);
            else XB_SPIN(xb_ld(&bar[XB_TOPGEN]) == tg, bar);
            __builtin_amdgcn_fence(__ATOMIC_ACQUIRE, "agent");
            xb_add(&bar[XB_XGEN(b.x)], 1u);
            asm volatile("s_waitcnt vmcnt(0)" ::: "memory");
        } else {
            XB_SPIN(xb_ld(&bar[XB_XGEN(b.x)]) == gen, bar);
            __builtin_amdgcn_fence(__ATOMIC_ACQUIRE, "agent");
            asm volatile("s_waitcnt vmcnt(0)" ::: "memory");
        }
    }
    __syncthreads();
}
namespace pg8 {
#define PG8_LAS __attribute__((address_space(3)))
typedef unsigned short bf16_t;
typedef short bf16x8 __attribute__((ext_vector_type(8)));
typedef float f32x4 __attribute__((ext_vector_type(4)));
typedef unsigned u32x4 __attribute__((ext_vector_type(4)));
constexpr int BM = 256, BK = 64, HALF = 128, HTB = HALF * BK * 2  , STAGE_BYTES = 8 * HTB, NXCD = 8, WGM = 8;

__host__ __device__ __forceinline__ int lds_byte(int r, int c) { const int st = (r >> 4) * 2 + (c >> 5), rr = r & 15, cc = c & 31, ob = rr * 64 + cc * 2; return st * 1024 + (ob ^ (((ob >> 9) & 1) << 5)); }
__host__ __device__ __forceinline__ void stage_rc(int b, int& R, int& C) { const int st = b / 1024, sb = b % 1024, swz = sb ^ (((sb >> 9) & 1) << 5); R = (st >> 1) * 16 + swz / 64; C = (st & 1) * 32 + (swz % 64) / 2; }
__host__ __device__ __forceinline__ int perm32(int rho) { const int n = rho >> 4, i = rho & 15; return 8 * (i >> 2) + 4 * n + (i & 3); }

struct Unit { int pm, pn, k0, nt, role, slot; };
struct Gemm { const bf16_t* A; const bf16_t* Bt; int M, N, K; };

struct StaticOrder {
    int nM, nN, nwg, G, c, ntK;
    __host__ __device__ void init(int M, int N, int K, int G_, int c_) { nM = M / BM; nN = N / BM; nwg = nM * nN; G = G_; c = c_; ntK = K / BK; }
    __host__ __device__ void map(int L, Unit& u) const { int wgid = L; { const int q = nwg / NXCD, r = nwg % NXCD, xcd = wgid % NXCD, off = wgid / NXCD; wgid = (xcd < r ? xcd * (q + 1) : r * (q + 1) + (xcd - r) * q) + off; }
        const int nig = WGM * nN, gid = wgid / nig, fm = gid * WGM, gsz = (nM - fm) < WGM ? (nM - fm) : WGM; u.pm = fm + ((wgid % nig) % gsz); u.pn = (wgid % nig) / gsz; }
    __host__ __device__ bool next(int i, Unit& u) const {
        const long L = (long)i * G + c; if (L >= nwg) return false;
        int wgid = (int)L; { const int q = nwg / NXCD, r = nwg % NXCD, xcd = wgid % NXCD, off = wgid / NXCD; wgid = (xcd < r ? xcd * (q + 1) : r * (q + 1) + (xcd - r) * q) + off; }
        const int nig = WGM * nN, gid = wgid / nig, fm = gid * WGM, gsz = (nM - fm) < WGM ? (nM - fm) : WGM;
        u.pm = fm + ((wgid % nig) % gsz); u.pn = (wgid % nig) / gsz; u.k0 = 0; u.nt = ntK; u.role = 0; u.slot = 0; return true;
    }
    __device__ __forceinline__ void a_ready(const Unit&) const {}
    __device__ __forceinline__ void done(const Unit&) const {}
};

__device__ __forceinline__ unsigned cvt_pk_bf16(float lo, float hi) { unsigned r; asm volatile("v_cvt_pk_bf16_f32 %0, %1, %2" : "=v"(r) : "v"(lo), "v"(hi)); return r; }
typedef float f32x2 __attribute__((ext_vector_type(2)));
template <class Epi, class Sched, bool ALIGN_EPI = false, bool SP2 = false>
__device__ __forceinline__ void gemm_phase(PG8_LAS unsigned char* lds, const Gemm g, const Sched& S, const Epi& E) {
    const int tid = tid_opaque(), wid = __builtin_amdgcn_readfirstlane(tid >> 6), lane = tid & 63, wr = wid >> 2, wc = wid & 3, fr = lane & 15, fq = lane >> 4;
    const int K = g.K;
    unsigned voffA[2], voffB[2];
#pragma unroll
    for (int i = 0; i < 2; ++i) { int R, C; stage_rc(tid * 16 + i * 8192, R, C); const int Rb = Epi::PERM ? ((R & ~31) + perm32(R & 31)) : R;
        voffA[i] = (unsigned)(R * K + C) * 2u; voffB[i] = (unsigned)(Rb * K + C) * 2u; }
    const size_t kstep = (size_t)(BK * 2);
    const size_t hstep = (size_t)HALF * K * 2;
    const size_t tstep = 2 * hstep;
    const unsigned ldsw = (unsigned)wid * 1024u;
    const int aoff = lds_byte(wr * 64 + fr, fq * 8), boff = lds_byte(wc * 32 + fr, fq * 8);
#define PG8_SA(b, h) (((b) * 2 + (h)) * HTB)
#define PG8_SB(b, h) ((4 + (b) * 2 + (h)) * HTB)
#define PG8_STAGE(bufoff, gbase, voff) do { _Pragma("unroll") for (int _i = 0; _i < 2; ++_i) \
        __builtin_amdgcn_global_load_lds((const unsigned*)((const char*)(gbase) + (voff)[_i]), (PG8_LAS unsigned*)(lds + (bufoff) + ldsw + _i * 8192), 16, 0, 0); } while (0)
#define PG8_LDA(dst, b, h) do { _Pragma("unroll") for (int m = 0; m < 4; ++m) _Pragma("unroll") for (int k = 0; k < 2; ++k) dst[m][k] = *(const PG8_LAS bf16x8*)(lds + PG8_SA(b, h) + aoff + m * 2048 + k * 1024); } while (0)
#define PG8_LDB(dst, b, h) do { _Pragma("unroll") for (int n = 0; n < 2; ++n) _Pragma("unroll") for (int k = 0; k < 2; ++k) dst[n][k] = *(const PG8_LAS bf16x8*)(lds + PG8_SB(b, h) + boff + n * 2048 + k * 1024); } while (0)
#define PG8_MMA(ai, bj, At, Bt) do { __builtin_amdgcn_s_setprio(1); _Pragma("unroll") for (int m = 0; m < 4; ++m) _Pragma("unroll") for (int n = 0; n < 2; ++n) _Pragma("unroll") for (int k = 0; k < 2; ++k) \
        acc[ai][bj][m][n] = __builtin_amdgcn_mfma_f32_16x16x32_bf16(Bt[n][k], At[m][k], acc[ai][bj][m][n], 0, 0, 0); __builtin_amdgcn_s_setprio(0); } while (0)
#define PG8_WAIT_V(n) asm volatile("s_waitcnt vmcnt(" #n ")" ::: "memory")
#define PG8_WAIT_L(n) asm volatile("s_waitcnt lgkmcnt(" #n ")" ::: "memory")
#define PG8_BAR __builtin_amdgcn_s_barrier()
#define PG8_SCHED __builtin_amdgcn_sched_barrier(0)
    Unit cur, nxt; int ui = 0;
    if (!S.next(0, cur)) return;
    f32x4 acc[2][2][4][2];
#pragma unroll
    for (int a = 0; a < 2; ++a)
#pragma unroll
        for (int b = 0; b < 2; ++b)
#pragma unroll
            for (int m = 0; m < 4; ++m)
#pragma unroll
                for (int n = 0; n < 2; ++n) acc[a][b][m][n] = (f32x4){0.f, 0.f, 0.f, 0.f};
    bf16x8 At[4][2], B0[2][2], B1[2][2];
    const char* cA = (const char*)g.A + (size_t)cur.pm * tstep + (size_t)cur.k0 * kstep; const char* cB = (const char*)g.Bt + (size_t)cur.pn * tstep + (size_t)cur.k0 * kstep; int nt = cur.nt;
    S.a_ready(cur);
    if constexpr (SP2) {
        PG8_STAGE(PG8_SB(0, 0), cB, voffB); PG8_STAGE(PG8_SB(0, 1), cB + hstep, voffB); PG8_STAGE(PG8_SA(0, 0), cA, voffA); PG8_STAGE(PG8_SA(0, 1), cA + hstep, voffA);
        if (wr == 1) PG8_BAR;
        PG8_WAIT_V(2); PG8_BAR;
        PG8_STAGE(PG8_SB(1, 0), cB + kstep, voffB); PG8_STAGE(PG8_SA(1, 0), cA + kstep, voffA); PG8_STAGE(PG8_SB(1, 1), cB + hstep + kstep, voffB);
        PG8_WAIT_V(6); PG8_BAR;
    } else {
        PG8_STAGE(PG8_SB(0, 0), cB, voffB); PG8_STAGE(PG8_SA(0, 0), cA, voffA); PG8_STAGE(PG8_SB(0, 1), cB + hstep, voffB); PG8_STAGE(PG8_SA(0, 1), cA + hstep, voffA);
        if (wr == 1) PG8_BAR;
        PG8_WAIT_V(4); PG8_BAR;
        PG8_STAGE(PG8_SB(1, 0), cB + kstep, voffB); PG8_STAGE(PG8_SA(1, 0), cA + kstep, voffA); PG8_STAGE(PG8_SB(1, 1), cB + hstep + kstep, voffB);
        PG8_WAIT_V(6); PG8_BAR;
    }
    for (;;) {
        const bool has_next = S.next(ui + 1, nxt);
        const char* nA = has_next ? (const char*)g.A + (size_t)nxt.pm * tstep + (size_t)nxt.k0 * kstep : cA; const char* nB = has_next ? (const char*)g.Bt + (size_t)nxt.pn * tstep + (size_t)nxt.k0 * kstep : cB;
        for (int t = 0; t < nt; t += 2) {
            const bool last = (t == nt - 2);
            const char* a1 = cA + (size_t)(t + 1) * kstep;
            const char* a2 = last ? nA : cA + (size_t)(t + 2) * kstep; const char* b2 = last ? nB : cB + (size_t)(t + 2) * kstep;
            const char* a3 = a2 + kstep; const char* b3 = b2 + kstep;
            if (last && has_next) S.a_ready(nxt);
            if constexpr (SP2) {
            PG8_LDB(B0, 0, 0); PG8_LDB(B1, 0, 1); PG8_SCHED; PG8_LDA(At, 0, 0); PG8_STAGE(PG8_SA(1, 1), a1 + hstep, voffA);
            PG8_WAIT_V(8); PG8_WAIT_L(0); PG8_BAR; PG8_MMA(0, 0, At, B0); PG8_MMA(0, 1, At, B1); PG8_BAR; PG8_SCHED;
            PG8_LDA(At, 0, 1); PG8_STAGE(PG8_SB(0, 0), b2, voffB); PG8_STAGE(PG8_SB(0, 1), b2 + hstep, voffB); PG8_STAGE(PG8_SA(0, 0), a2, voffA);
            PG8_WAIT_V(8); PG8_WAIT_L(0); PG8_BAR; PG8_MMA(1, 0, At, B0); PG8_MMA(1, 1, At, B1); PG8_BAR; PG8_SCHED;
            PG8_LDB(B0, 1, 0); PG8_LDB(B1, 1, 1); PG8_SCHED; PG8_LDA(At, 1, 0); PG8_STAGE(PG8_SA(0, 1), a2 + hstep, voffA);
            PG8_WAIT_V(8); PG8_WAIT_L(0); PG8_BAR; PG8_MMA(0, 0, At, B0); PG8_MMA(0, 1, At, B1); PG8_BAR; PG8_SCHED;
            PG8_LDA(At, 1, 1); PG8_STAGE(PG8_SB(1, 0), b3, voffB); PG8_STAGE(PG8_SB(1, 1), b3 + hstep, voffB); PG8_STAGE(PG8_SA(1, 0), a3, voffA);
            PG8_WAIT_V(8); PG8_WAIT_L(0); PG8_BAR; PG8_MMA(1, 0, At, B0); PG8_MMA(1, 1, At, B1); PG8_BAR; PG8_SCHED;
            } else {
            PG8_LDB(B0, 0, 0); PG8_SCHED; PG8_LDA(At, 0, 0); PG8_STAGE(PG8_SA(1, 1), a1 + hstep, voffA);
            PG8_WAIT_L(8); PG8_BAR; PG8_WAIT_L(0); PG8_MMA(0, 0, At, B0); PG8_BAR; PG8_SCHED;
            PG8_LDB(B1, 0, 1); PG8_STAGE(PG8_SB(0, 0), b2, voffB);
            PG8_BAR; PG8_WAIT_L(0); PG8_MMA(0, 1, At, B1); PG8_BAR;
            PG8_LDA(At, 0, 1); PG8_STAGE(PG8_SA(0, 0), a2, voffA);
            PG8_BAR; PG8_WAIT_L(0); PG8_MMA(1, 0, At, B0); PG8_BAR; PG8_SCHED;
            PG8_STAGE(PG8_SB(0, 1), b2 + hstep, voffB);
            PG8_WAIT_V(6); PG8_BAR; PG8_MMA(1, 1, At, B1); PG8_BAR;
            PG8_LDB(B0, 1, 0); PG8_SCHED; PG8_LDA(At, 1, 0); PG8_STAGE(PG8_SA(0, 1), a2 + hstep, voffA);
            PG8_WAIT_L(8); PG8_BAR; PG8_WAIT_L(0); PG8_MMA(0, 0, At, B0); PG8_BAR; PG8_SCHED;
            PG8_LDB(B1, 1, 1); PG8_STAGE(PG8_SB(1, 0), b3, voffB);
            PG8_BAR; PG8_WAIT_L(0); PG8_MMA(0, 1, At, B1); PG8_BAR;
            PG8_LDA(At, 1, 1); PG8_STAGE(PG8_SA(1, 0), a3, voffA);
            PG8_BAR; PG8_WAIT_L(0); PG8_MMA(1, 0, At, B0); PG8_BAR; PG8_SCHED;
            PG8_STAGE(PG8_SB(1, 1), b3 + hstep, voffB);
            PG8_WAIT_V(6); PG8_BAR; PG8_MMA(1, 1, At, B1); PG8_BAR;
            }
        }
        if constexpr (ALIGN_EPI) { if (wr == 0) PG8_BAR; }
        if constexpr (!Epi::AFTER_DRAIN) { E(acc, cur, wr, wc, fr, fq); S.done(cur); }
        if (!has_next) break;
#pragma unroll
        for (int a = 0; a < 2; ++a)
#pragma unroll
            for (int b = 0; b < 2; ++b)
#pragma unroll
                for (int m = 0; m < 4; ++m)
#pragma unroll
                    for (int n = 0; n < 2; ++n) acc[a][b][m][n] = (f32x4){0.f, 0.f, 0.f, 0.f};
        cur = nxt; cA = nA; cB = nB; nt = cur.nt; ++ui;
        if constexpr (ALIGN_EPI) { if (wr == 1) PG8_BAR; }
    }
    PG8_WAIT_V(0);
    if constexpr (!ALIGN_EPI) { if (wr == 0) PG8_BAR; }
    PG8_BAR;
    if constexpr (Epi::AFTER_DRAIN) { E.fused(acc, cur, wr, wc, fr, fq, lds, wid, lane); S.done(cur); }
#undef PG8_SA
#undef PG8_SB
#undef PG8_STAGE
#undef PG8_LDA
#undef PG8_LDB
#undef PG8_MMA
#undef PG8_WAIT_V
#undef PG8_WAIT_L
#undef PG8_BAR
#undef PG8_SCHED
}
}
constexpr size_t WB_AB = 2 * MiB, WB_OUTAB = 8 * MiB, WB_FFI0 = 10 * MiB, WB_FFO0 = 21 * MiB, WB_INC = 27 * MiB, WB_OUTC = 30 * MiB, WB_FFI1 = 32 * MiB, WB_FFO1 = 43 * MiB;
static_assert(WB_FFO1 + (size_t)DM * DFF * 2 <= WS_XN && WB_AB + (size_t)ABMAIN * DM * 2 <= WB_OUTAB && WB_FFI0 + (size_t)2 * DFF * DM * 2 <= WB_FFO0 && WB_FFO0 + (size_t)DM * DFF * 2 <= WB_INC &&
              WB_INC + (size_t)CIN * DM * 2 <= WB_OUTC && WB_FFI1 + (size_t)2 * DFF * DM * 2 <= WB_FFO1, "weight copy map");

typedef unsigned v4u __attribute__((ext_vector_type(4)));
typedef unsigned v2u __attribute__((ext_vector_type(2)));
typedef float f32x4 __attribute__((ext_vector_type(4)));
__device__ __forceinline__ unsigned pk2(float lo, float hi) { return (unsigned)f2bf(lo) | ((unsigned)f2bf(hi) << 16); }
__device__ __forceinline__ float fsigmoid(float x) { return __builtin_amdgcn_rcpf(1.0f + __builtin_amdgcn_exp2f(-1.4426950408889634f * x)); }

__device__ __forceinline__ void p0_transpose_item(const float* W, int K, int ldw, int c0, int k0, bf16_t* WT, int drow, LAS float* scr, int lane) {
    { f32x4 tv[8]; const int rr = lane >> 3, cg = (lane & 7) * 4;
#pragma unroll
      for (int i = 0; i < 8; ++i) tv[i] = *(const f32x4*)(W + (size_t)(k0 + 8 * i + rr) * ldw + c0 + cg);
#pragma unroll
      for (int i = 0; i < 8; ++i) { LAS float* d = scr + (8 * i + rr) * 33 + cg; d[0] = tv[i][0]; d[1] = tv[i][1]; d[2] = tv[i][2]; d[3] = tv[i][3]; } }
    asm volatile("s_waitcnt lgkmcnt(0)" ::: "memory");
    const int c = lane & 7;
#pragma unroll
    for (int j = 0; j < 4; ++j) { const int n = (lane >> 3) + 8 * j; const LAS float* s = scr + (8 * c) * 33 + n;
        v4u o; o.x = pk2(s[0 * 33], s[1 * 33]); o.y = pk2(s[2 * 33], s[3 * 33]); o.z = pk2(s[4 * 33], s[5 * 33]); o.w = pk2(s[6 * 33], s[7 * 33]);
        *(GAS v4u*)(WT + (size_t)(drow + n) * K + k0 + 8 * c) = o; }
    asm volatile("s_waitcnt lgkmcnt(0)" ::: "memory");
}
struct CvtJob { const float* W; bf16_t* WT; int K, ldw, c0, ncols, mode, Hn, dbase; };
__device__ __forceinline__ int cvt_items(const CvtJob& j) { return (j.K / 64) * (j.ncols / 32); }
__device__ __forceinline__ void cvt_run(const CvtJob& j, int item, LAS float* scr, int lane) {
    const int nblk = j.ncols / 32, kb = item / nblk, nb = item % nblk; const int c = j.c0 + 32 * nb;
    int drow; if (j.mode == 0) drow = j.dbase + 32 * nb; else { const int cc = c < j.Hn ? c : c - j.Hn; drow = 256 * (cc / 128) + (cc % 128) + (c < j.Hn ? 0 : 128); }
    p0_transpose_item(j.W, j.K, j.ldw, c, 64 * kb, j.WT, drow, scr, lane);
}
__device__ __forceinline__ void p0_weights(const Params& p, LAS unsigned char* lds, int vcu, int G) {
    const int tid_ = tid_opaque(); const int lane = tid_ & 63, wave = __builtin_amdgcn_readfirstlane(tid_ >> 6);
    LAS float* scr = (LAS float*)(lds + wave * 16384);
    const int gw = vcu * NWAVES + wave, NGW = G * NWAVES;
    CvtJob jobs[9] = {
        {p.winab, (bf16_t*)(p.ws + WB_AB), DM, ABIN, 0, 2 * CCH, 1, CCH, 0},
        {p.winab, (bf16_t*)(p.ws + WB_AB), DM, ABIN, 2 * CCH, 4 * MW, 0, 0, 2 * CCH},
        {p.woutab, (bf16_t*)(p.ws + WB_OUTAB), DM, DM, 0, DM, 0, 0, 0},
        {p.wffi, (bf16_t*)(p.ws + WB_FFI0), DM, 2 * DFF, 0, 2 * DFF, 1, DFF, 0},
        {p.wffo, (bf16_t*)(p.ws + WB_FFO0), DFF, DM, 0, DM, 0, 0, 0},
        {p.winc, (bf16_t*)(p.ws + WB_INC), DM, CIN, 0, CIN, 0, 0, 0},
        {p.woutc, (bf16_t*)(p.ws + WB_OUTC), DM, DM, 0, DM, 0, 0, 0},
        {p.wffi + (size_t)DM * 2 * DFF, (bf16_t*)(p.ws + WB_FFI1), DM, 2 * DFF, 0, 2 * DFF, 1, DFF, 0},
        {p.wffo + (size_t)DFF * DM, (bf16_t*)(p.ws + WB_FFO1), DFF, DM, 0, DM, 0, 0, 0}};
    int base = 0;
#pragma unroll
    for (int jj = 0; jj < 9; ++jj) {
        const int n = cvt_items(jobs[jj]);
        int first = ((gw - base) % NGW + NGW) % NGW;
        for (int it = first; it < n; it += NGW) cvt_run(jobs[jj], it, scr, lane);
        base += n;
    }
}

struct EpiAB {
    static constexpr bool PERM = true, AFTER_DRAIN = false;
    bf16_t* upre; bf16_t* qkvo;
    __device__ __forceinline__ void operator()(const f32x4 (&acc)[2][2][4][2], const pg8::Unit& u, int wr, int wc, int fr, int fq) const {
        const int row0 = u.pm * 256 + wr * 64 + fr, lc = wc * 32 + 8 * fq;
        if (u.pn < 4) {
#pragma unroll
            for (int ai = 0; ai < 2; ++ai)
#pragma unroll
                for (int m = 0; m < 4; ++m) { const f32x4 a0 = acc[ai][0][m][0], a1 = acc[ai][0][m][1], g0 = acc[ai][1][m][0], g1 = acc[ai][1][m][1]; v4u w;
                    w.x = pg8::cvt_pk_bf16(a0[0] * fsigmoid(g0[0]), a0[1] * fsigmoid(g0[1])); w.y = pg8::cvt_pk_bf16(a0[2] * fsigmoid(g0[2]), a0[3] * fsigmoid(g0[3]));
                    w.z = pg8::cvt_pk_bf16(a1[0] * fsigmoid(g1[0]), a1[1] * fsigmoid(g1[1])); w.w = pg8::cvt_pk_bf16(a1[2] * fsigmoid(g1[2]), a1[3] * fsigmoid(g1[3]));
                    *(v4u*)(upre + (size_t)(row0 + ai * 128 + m * 16) * CCH + 128 * u.pn + lc) = w; }
        } else {
#pragma unroll
            for (int bj = 0; bj < 2; ++bj) { const int col = 256 * (u.pn - 4) + 128 * bj + lc; const int part = col / MW; const float sc = part == 1 ? 0.08838834764831845f : 1.0f;
#pragma unroll
                for (int ai = 0; ai < 2; ++ai)
#pragma unroll
                    for (int m = 0; m < 4; ++m) { f32x4 v0 = acc[ai][bj][m][0] * sc, v1 = acc[ai][bj][m][1] * sc;
                        if (part == 3) { v0 = (f32x4){fsigmoid(v0[0]), fsigmoid(v0[1]), fsigmoid(v0[2]), fsigmoid(v0[3])}; v1 = (f32x4){fsigmoid(v1[0]), fsigmoid(v1[1]), fsigmoid(v1[2]), fsigmoid(v1[3])}; }
                        v4u w; w.x = pg8::cvt_pk_bf16(v0[0], v0[1]); w.y = pg8::cvt_pk_bf16(v0[2], v0[3]); w.z = pg8::cvt_pk_bf16(v1[0], v1[1]); w.w = pg8::cvt_pk_bf16(v1[2], v1[3]);
                        *(v4u*)(qkvo + (size_t)(row0 + ai * 128 + m * 16) * (4 * MW) + col) = w; } }
        }
    }
};
static_assert(MDK == 128, "EpiAB hard-codes MDK^-0.5");
struct EpiRes {
    static constexpr bool PERM = true, AFTER_DRAIN = false;
    const float* xp; const float* xs;
    bf16_t* Y16; bf16_t* XN; float* ssq; const float* mod_g; const float* mod_sc; const float* ng;
    int from_input; int pad_;
    __device__ __forceinline__ float piece(int row, int col, int cls, f32x4 v0, f32x4 v1) const {
        const float* gv = mod_g + (size_t)cls * 6 * DM + col; const size_t off = (size_t)row * DM + col; f32x4 x0, x1;
        if (from_input) { const float* xin = (row < MC ? xp : xs - (size_t)MC * DM) + off; x0 = *(const f32x4*)xin; x1 = *(const f32x4*)(xin + 4); }
        else { const v4u r = *(const v4u*)(Y16 + off); x0 = (f32x4){__uint_as_float(r.x << 16), __uint_as_float(r.x & 0xffff0000u), __uint_as_float(r.y << 16), __uint_as_float(r.y & 0xffff0000u)};
            x1 = (f32x4){__uint_as_float(r.z << 16), __uint_as_float(r.z & 0xffff0000u), __uint_as_float(r.w << 16), __uint_as_float(r.w & 0xffff0000u)}; }
        x0 += *(const f32x4*)gv * v0; x1 += *(const f32x4*)(gv + 4) * v1;
        v4u w; w.x = pg8::cvt_pk_bf16(x0[0], x0[1]); w.y = pg8::cvt_pk_bf16(x0[2], x0[3]); w.z = pg8::cvt_pk_bf16(x1[0], x1[1]); w.w = pg8::cvt_pk_bf16(x1[2], x1[3]); *(v4u*)(Y16 + off) = w;
        if (ng) { const float* scv = mod_sc + (size_t)cls * 6 * DM + col; const f32x4 t0 = x0 * (*(const f32x4*)(ng + col) * (*(const f32x4*)scv + 1.0f)), t1 = x1 * (*(const f32x4*)(ng + col + 4) * (*(const f32x4*)(scv + 4) + 1.0f));
            v4u q; q.x = pg8::cvt_pk_bf16(t0[0], t0[1]); q.y = pg8::cvt_pk_bf16(t0[2], t0[3]); q.z = pg8::cvt_pk_bf16(t1[0], t1[1]); q.w = pg8::cvt_pk_bf16(t1[2], t1[3]); *(v4u*)(XN + off) = q; }
        return ((x0[0] * x0[0] + x0[1] * x0[1]) + (x0[2] * x0[2] + x0[3] * x0[3])) + ((x1[0] * x1[0] + x1[1] * x1[1]) + (x1[2] * x1[2] + x1[3] * x1[3]));
    }
    __device__ __forceinline__ void operator()(const f32x4 (&acc)[2][2][4][2], const pg8::Unit& u, int wr, int wc, int fr, int fq) const {
        const int row0 = u.pm * 256 + wr * 64 + fr; const int cls = cls_of(u.pm * 256); const int colb = u.pn * 256 + wc * 32 + 8 * fq;
#pragma unroll
        for (int ai = 0; ai < 2; ++ai)
#pragma unroll
            for (int m = 0; m < 4; ++m) { const int row = row0 + ai * 128 + m * 16; float s = 0.f;
#pragma unroll
                for (int bj = 0; bj < 2; ++bj) s += piece(row, colb + bj * 128, cls, acc[ai][bj][m][0], acc[ai][bj][m][1]);
                s += __shfl_xor(s, 16); s += __shfl_xor(s, 32); if (fq == 0) atomicAdd(ssq + row, s);
                if (m & 1) asm volatile("" ::: "memory"); }
    }
};
struct EpiFfnIn {
    static constexpr bool PERM = true, AFTER_DRAIN = false;
    bf16_t* H; const float* ssq; const float* sw;
    __device__ __forceinline__ void operator()(const f32x4 (&acc)[2][2][4][2], const pg8::Unit& u, int wr, int wc, int fr, int fq) const {
        const int row0 = u.pm * 256 + wr * 64 + fr, lc = wc * 32 + 8 * fq; const int cls = cls_of(u.pm * 256); const int col = 128 * u.pn + lc;
        const float* swr = sw + (size_t)cls * 2 * DFF;
        const f32x4 sg0 = *(const f32x4*)(swr + col), sg1 = *(const f32x4*)(swr + col + 4), su0 = *(const f32x4*)(swr + DFF + col), su1 = *(const f32x4*)(swr + DFF + col + 4);
#pragma unroll
        for (int ai = 0; ai < 2; ++ai)
#pragma unroll
            for (int m = 0; m < 4; ++m) { const int row = row0 + ai * 128 + m * 16; const float rs = 1.0f / sqrtf(ssq[row] * (1.0f / DM) + EPSF);
                const f32x4 a0 = acc[ai][0][m][0] * rs + sg0, a1 = acc[ai][0][m][1] * rs + sg1, b0 = acc[ai][1][m][0] * rs + su0, b1 = acc[ai][1][m][1] * rs + su1; v4u w;
                w.x = pg8::cvt_pk_bf16(a0[0] * fsigmoid(a0[0]) * b0[0], a0[1] * fsigmoid(a0[1]) * b0[1]); w.y = pg8::cvt_pk_bf16(a0[2] * fsigmoid(a0[2]) * b0[2], a0[3] * fsigmoid(a0[3]) * b0[3]);
                w.z = pg8::cvt_pk_bf16(a1[0] * fsigmoid(a1[0]) * b1[0], a1[1] * fsigmoid(a1[1]) * b1[1]); w.w = pg8::cvt_pk_bf16(a1[2] * fsigmoid(a1[2]) * b1[2], a1[3] * fsigmoid(a1[3]) * b1[3]);
                *(v4u*)(H + (size_t)row * DFF + col) = w; }
    }
};
struct EpiQkv {
    static constexpr bool PERM = true, AFTER_DRAIN = false;
    bf16_t* qraw; bf16_t* kraw; bf16_t* ctxv; bf16_t* latv; float* outv; const float* ssq; const float* sw;
    __device__ __forceinline__ void operator()(const f32x4 (&acc)[2][2][4][2], const pg8::Unit& u, int wr, int wc, int fr, int fq) const {
        const int row0 = u.pm * 256 + wr * 64 + fr, lc = wc * 32 + 8 * fq; const int cls = cls_of(u.pm * 256); const float* swr = sw + (size_t)cls * CIN;
        float rs[2][4];
#pragma unroll
        for (int ai = 0; ai < 2; ++ai)
#pragma unroll
            for (int m = 0; m < 4; ++m) rs[ai][m] = 1.0f / sqrtf(ssq[row0 + ai * 128 + m * 16] * (1.0f / DM) + EPSF);
#pragma unroll
        for (int bj = 0; bj < 2; ++bj) { const int col = 256 * u.pn + 128 * bj + lc; const f32x4 s0 = *(const f32x4*)(swr + col), s1 = *(const f32x4*)(swr + col + 4);
#pragma unroll
            for (int ai = 0; ai < 2; ++ai)
#pragma unroll
                for (int m = 0; m < 4; ++m) { const int row = row0 + ai * 128 + m * 16; const f32x4 v0 = acc[ai][bj][m][0] * rs[ai][m] + s0, v1 = acc[ai][bj][m][1] * rs[ai][m] + s1;
                    v4u w; w.x = pg8::cvt_pk_bf16(v0[0], v0[1]); w.y = pg8::cvt_pk_bf16(v0[2], v0[3]); w.z = pg8::cvt_pk_bf16(v1[0], v1[1]); w.w = pg8::cvt_pk_bf16(v1[2], v1[3]);
                    if (u.pn < NQ * HDIM / 256) *(v4u*)(qraw + (size_t)row * (NQ * HDIM) + col) = w;
                    else if (u.pn == NQ * HDIM / 256) *(v4u*)(kraw + (size_t)row * (NKV * HDIM) + (col - NQ * HDIM)) = w;
                    else { const int c2 = col - (NQ + NKV) * HDIM;
                        if (row < MC) { *(v4u*)(ctxv + (size_t)row * (NKV * HDIM) + c2) = w; float* o = outv + (size_t)row * (NKV * HDIM) + c2; *(f32x4*)o = v0; *(f32x4*)(o + 4) = v1; }
                        else { const int b = (row - MC) / LSEQ, s = (row - MC) % LSEQ; *(v4u*)(latv + ((size_t)b * SKVL + s) * (NKV * HDIM) + c2) = w; } } } }
    }
};
static_assert(NKV * HDIM == 256 && (NQ * HDIM) % 256 == 0, "EpiQkv tile mapping");

constexpr int CW_SPLIT = 8192;
constexpr size_t SLAB_BYTES = (size_t)64 * 4 * 16 * 512 * 16;
struct RoundZeroOrder : pg8::StaticOrder {
    bool split;
    __device__ void init(int M, int N, int K, int G_, int c_) { pg8::StaticOrder::init(M, N, K, G_, c_); split = (G == 256 && nwg > 256 && nwg <= 320 && ntK >= 8); }
    __device__ bool next(int i, pg8::Unit& u) const { if (split && i > 0) return false; return pg8::StaticOrder::next(i, u); }
};
struct QuarterOrder : pg8::StaticOrder {
    __device__ bool next(int i, pg8::Unit& u) const {
        if (i > 0) return false; const int L = 256 + (c >> 2), q = c & 3; if (L >= nwg) return false;
        map(L, u); const int base = (ntK / 8) * 2, rem = (ntK - 4 * base) / 2;
        int k0 = 0; for (int j = 0; j < q; ++j) k0 += base + (j < rem ? 2 : 0);
        u.k0 = k0; u.nt = base + (q < rem ? 2 : 0); u.role = 1 + q; u.slot = c >> 2; return true;
    }
};
struct EpiPartial {
    static constexpr bool PERM = true, AFTER_DRAIN = false;
    unsigned char* slab; unsigned* cnt;
    __device__ __forceinline__ void operator()(const f32x4 (&acc)[2][2][4][2], const pg8::Unit& u, int wr, int wc, int fr, int fq) const {
        const int tid = (wr * 4 + wc) * 64 + fq * 16 + fr;
        unsigned char* dst = slab + ((size_t)u.slot * 4 + (u.role - 1)) * (16 * 512 * 16) + (size_t)tid * 16;
#pragma unroll
        for (int ai = 0; ai < 2; ++ai)
#pragma unroll
            for (int bj = 0; bj < 2; ++bj)
#pragma unroll
                for (int m = 0; m < 4; ++m) { const f32x4 a = acc[ai][bj][m][0], b = acc[ai][bj][m][1]; v4u w;
                    w.x = pg8::cvt_pk_bf16(a[0], a[1]); w.y = pg8::cvt_pk_bf16(a[2], a[3]); w.z = pg8::cvt_pk_bf16(b[0], b[1]); w.w = pg8::cvt_pk_bf16(b[2], b[3]);
                    asm volatile("global_store_dwordx4 %0, %1, off sc1\n\ts_nop 1" :: "v"(dst), "v"(w) : "memory");
                    dst += 512 * 16; asm volatile("" : "+v"(dst)); }
        asm volatile("s_waitcnt vmcnt(0)" ::: "memory");
        if (fr == 0 && fq == 0) __hip_atomic_fetch_add(cnt + (size_t)u.slot * 64, 1u, __ATOMIC_RELAXED, __HIP_MEMORY_SCOPE_AGENT);
    }
};
__device__ __forceinline__ void tail_reduce(const EpiRes& E, const unsigned char* slab, unsigned* cnt, int G, int bx, int nN, int nM) {
    pg8::StaticOrder S; S.nM = nM; S.nN = nN; S.nwg = nM * nN; S.G = G; S.c = bx; S.ntK = 0;
    const int L = 256 + (bx >> 2), q = bx & 3; if (L >= S.nwg) return;
    pg8::Unit u; S.map(L, u); const int slot = bx >> 2, ai = q >> 1, bj = q & 1;
    const int tid = tid_opaque(), wid = tid >> 6, lane = tid & 63, wr = wid >> 2, wc = wid & 3, fr = lane & 15, fq = lane >> 4;
    unsigned* c = cnt + (size_t)slot * 64; unsigned spins = 0;
    while ((unsigned)__builtin_amdgcn_readfirstlane(__hip_atomic_load(c, __ATOMIC_RELAXED, __HIP_MEMORY_SCOPE_AGENT)) < 32u) { __builtin_amdgcn_s_sleep(2); if (++spins > (1u << 22)) break; }
    __builtin_amdgcn_fence(__ATOMIC_ACQUIRE, "agent");
    const unsigned char* base = slab + (size_t)slot * 4 * (16 * 512 * 16) + (size_t)tid * 16;
    v4u w[4][4];
#pragma unroll
    for (int m = 0; m < 4; ++m)
#pragma unroll
        for (int r = 0; r < 4; ++r) w[m][r] = *(const v4u*)(base + (size_t)r * (16 * 512 * 16) + (size_t)((ai * 2 + bj) * 4 + m) * (512 * 16));
    const int row0 = u.pm * 256 + ai * 128 + wr * 64 + fr; const int cls = cls_of(u.pm * 256); const int col = u.pn * 256 + bj * 128 + wc * 32 + 8 * fq;
#pragma unroll
    for (int m = 0; m < 4; ++m) { const int row = row0 + m * 16; f32x4 v[2] = {(f32x4){0.f, 0.f, 0.f, 0.f}, (f32x4){0.f, 0.f, 0.f, 0.f}};
#pragma unroll
        for (int r = 0; r < 4; ++r) { const v4u x = w[m][r]; v[0] += (f32x4){__uint_as_float(x.x << 16), __uint_as_float(x.x & 0xffff0000u), __uint_as_float(x.y << 16), __uint_as_float(x.y & 0xffff0000u)};
            v[1] += (f32x4){__uint_as_float(x.z << 16), __uint_as_float(x.z & 0xffff0000u), __uint_as_float(x.w << 16), __uint_as_float(x.w & 0xffff0000u)}; }
        float sq = E.piece(row, col, cls, v[0], v[1]);
        sq += __shfl_xor(sq, 16); sq += __shfl_xor(sq, 32); if (fq == 0) atomicAdd(E.ssq + row, sq); }
}
namespace att {
typedef unsigned short bf16;
constexpr int D = 128, NW = 8, QBLK = 32, KVBLK = 64; constexpr float SCALE = 0.088388347648318440f; constexpr float THR = 8.f; constexpr int SDEPTH = 1;
constexpr int LDQ = NQ * HDIM, LDK = NKV * HDIM, LDO = DM;
constexpr size_t SHM_V = KVBLK * D * 2, SHM_K = KVBLK * D * 2, SHM_ATTN = 2 * SHM_V + 2 * SHM_K + NW * 64 * 4;
using bf16x8 = __attribute__((ext_vector_type(8))) short;
using s16x4  = __attribute__((ext_vector_type(4))) short;
using f32x16 = __attribute__((ext_vector_type(16))) float;
using f32x8  = __attribute__((ext_vector_type(8))) float;
using u32x4  = __attribute__((ext_vector_type(4))) unsigned;
#define KSWZ(row, colB) ((row) * 256 + ((colB) ^ (((row) & 7) << 4)))
#define SBAR() __builtin_amdgcn_sched_barrier(0)
__device__ __forceinline__ int crow(int r, int hi) { return (r & 3) + 8 * (r >> 2) + 4 * hi; }
__device__ __forceinline__ unsigned cvtpk(float lo, float hi) {
  unsigned r; asm volatile("v_cvt_pk_bf16_f32 %0, %1, %2" : "=v"(r) : "v"(lo), "v"(hi)); return r;
}
template <typename TIn> struct Stage;
template <> struct Stage<bf16>  { using T = bf16x8;
  __device__ static __forceinline__ T ld8(const bf16* p) { return *reinterpret_cast<const bf16x8*>(p); }
  __device__ static __forceinline__ bf16x8 tobf(T x) { return x; } };
__device__ __forceinline__ void partialSM(f32x16& p0, f32x16& p1, float& m_reg, float& mn, float& alpha) {
  constexpr float C = SCALE * 1.4426950408889634f;
  float pmax = p0[0]; for (int r = 1; r < 16; ++r) pmax = fmaxf(pmax, p0[r]); for (int r = 0; r < 16; ++r) pmax = fmaxf(pmax, p1[r]);
  { auto rr = __builtin_amdgcn_permlane32_swap(__float_as_uint(pmax), __float_as_uint(pmax), false, false);
    pmax = fmaxf(__uint_as_float(rr[0]), __uint_as_float(rr[1])); }
  if (__builtin_expect(__all(pmax - m_reg <= THR / SCALE), 1)) { mn = m_reg; alpha = 1.f; }
  else { mn = fmaxf(m_reg, pmax); alpha = __builtin_amdgcn_exp2f((m_reg - mn) * C); m_reg = mn; }
  float mnC = -mn * C;
  for (int r = 0; r < 16; ++r) p0[r] = fmaf(p0[r], C, mnC); for (int r = 0; r < 16; ++r) p1[r] = fmaf(p1[r], C, mnC);
  for (int r = 0; r < 16; ++r) p0[r] = __builtin_amdgcn_exp2f(p0[r]);
}
__device__ __forceinline__ void finishSM(f32x16& p0, f32x16& p1, float alpha, float& l_reg, bf16x8& pa0, bf16x8& pa1, bf16x8& pa2, bf16x8& pa3) {
  for (int r = 0; r < 16; ++r) p1[r] = __builtin_amdgcn_exp2f(p1[r]);
  float ps = 0; for (int r = 0; r < 16; ++r) ps += p0[r]; for (int r = 0; r < 16; ++r) ps += p1[r];
  { auto rr = __builtin_amdgcn_permlane32_swap(__float_as_uint(ps), __float_as_uint(ps), false, false);
    ps = __uint_as_float(rr[0]) + __uint_as_float(rr[1]); }
  l_reg = l_reg * alpha + ps;
#define PK4(P, BASE, OUT) do { unsigned a0 = cvtpk(P[BASE + 0], P[BASE + 1]), a1 = cvtpk(P[BASE + 2], P[BASE + 3]);   \
    unsigned b0 = cvtpk(P[BASE + 4], P[BASE + 5]), b1 = cvtpk(P[BASE + 6], P[BASE + 7]);                              \
    auto r0 = __builtin_amdgcn_permlane32_swap(a0, b0, false, false); auto r1 = __builtin_amdgcn_permlane32_swap(a1, b1, false, false); \
    u32x4 w = {r0[0], r1[0], r0[1], r1[1]}; OUT = *reinterpret_cast<bf16x8*>(&w); } while (0)
  PK4(p0, 0, pa0); PK4(p0, 8, pa1); PK4(p1, 0, pa2); PK4(p1, 8, pa3);
#undef PK4
}
__device__ __forceinline__ void qkt(f32x16& p0, f32x16& p1, const bf16* Ks, const bf16x8* qr, int r32, int hi) {
  p0 = f32x16{}; p1 = f32x16{};
  for (int d0 = 0; d0 < 8; ++d0) { int cb = (d0 * 16 + hi * 8) * 2;
    bf16x8 b0 = *reinterpret_cast<const bf16x8*>((const char*)Ks + KSWZ(r32, cb));
    bf16x8 b1 = *reinterpret_cast<const bf16x8*>((const char*)Ks + KSWZ(32 + r32, cb));
    p0 = __builtin_amdgcn_mfma_f32_32x32x16_bf16(b0, qr[d0], p0, 0, 0, 0);
    p1 = __builtin_amdgcn_mfma_f32_32x32x16_bf16(b1, qr[d0], p1, 0, 0, 0); }
}
__device__ __forceinline__ int v_st(int k, int c) { const int kk = (k & ~0xC) | ((k & 4) << 1) | ((k & 8) >> 1); return ((kk >> 3) * 4 + (c >> 5)) * 512 + ((kk & 7) * 32 + (c & 31)) * 2; }
__device__ __forceinline__ int v_rd_base(int lane) { return ((lane & 3) << 3) | (((lane >> 2) & 3) << 6) | (((lane >> 4) & 1) << 5) | (((lane >> 5) & 1) << 8); }
constexpr int v_rd_off(int d0, int ks, int half) { return d0 * 512 + ks * 4096 + half * 2048; }
template <int OFF> __device__ __forceinline__ s16x4 tr_read(int vb) {
  s16x4 r; asm volatile("ds_read_b64_tr_b16 %0, %1 offset:%2" : "=&v"(r) : "v"(vb), "i"(OFF) : "memory"); return r;
}
template <int D0> __device__ __forceinline__ void pv_one(f32x16& od, int vb, bf16x8 pa0, bf16x8 pa1, bf16x8 pa2, bf16x8 pa3) {
  const s16x4 l0 = tr_read<v_rd_off(D0, 0, 0)>(vb), h0 = tr_read<v_rd_off(D0, 0, 1)>(vb), l1 = tr_read<v_rd_off(D0, 1, 0)>(vb), h1 = tr_read<v_rd_off(D0, 1, 1)>(vb);
  const s16x4 l2 = tr_read<v_rd_off(D0, 2, 0)>(vb), h2 = tr_read<v_rd_off(D0, 2, 1)>(vb), l3 = tr_read<v_rd_off(D0, 3, 0)>(vb), h3 = tr_read<v_rd_off(D0, 3, 1)>(vb);
  asm volatile("s_waitcnt lgkmcnt(0)" ::: "memory"); SBAR();
#define PK(L, H) (bf16x8){L[0], L[1], L[2], L[3], H[0], H[1], H[2], H[3]}
  od = __builtin_amdgcn_mfma_f32_32x32x16_bf16(pa0, PK(l0, h0), od, 0, 0, 0);
  od = __builtin_amdgcn_mfma_f32_32x32x16_bf16(pa1, PK(l1, h1), od, 0, 0, 0);
  od = __builtin_amdgcn_mfma_f32_32x32x16_bf16(pa2, PK(l2, h2), od, 0, 0, 0);
  od = __builtin_amdgcn_mfma_f32_32x32x16_bf16(pa3, PK(l3, h3), od, 0, 0, 0);
#undef PK
}
__device__ __forceinline__ void pv_d0(f32x16* o, int vb, bf16x8 pa0, bf16x8 pa1, bf16x8 pa2, bf16x8 pa3) {
  pv_one<0>(o[0], vb, pa0, pa1, pa2, pa3); pv_one<1>(o[1], vb, pa0, pa1, pa2, pa3); pv_one<2>(o[2], vb, pa0, pa1, pa2, pa3); pv_one<3>(o[3], vb, pa0, pa1, pa2, pa3);
}

__device__ __forceinline__ void attn_dense_body(const bf16* __restrict__ Qb, const bf16* __restrict__ Kh, const bf16* __restrict__ Vh,
                                                bf16* __restrict__ Ob, int seq, char* lds) {
  typedef bf16 TQ;
  using St = Stage<bf16>; using SQ = Stage<TQ>;
  const int tid = tid_opaque(), wid = tid >> 6, lane = tid & 63, r32 = lane & 31, hi = lane >> 5;
  bf16* V_lds = (bf16*)lds; bf16* K_lds = (bf16*)(lds + 2 * SHM_V);
  float* ws = (float*)(lds + 2 * SHM_V + 2 * SHM_K) + wid * 64; float* li_l = ws; float* al_l = ws + 32;
  float m_reg = -1e30f, l_reg = 0; f32x16 o[4] = {}; bf16x8 qr[8];
  const TQ* Qw = Qb + (long)(wid * QBLK + r32) * LDQ + hi * 8;
#pragma unroll
  for (int d0 = 0; d0 < 8; ++d0) qr[d0] = SQ::tobf(SQ::ld8(Qw + d0 * 16));
  const int sr = tid >> 4, sc = (tid & 15) * 8, vst0 = v_st(sr, sc), vst1 = v_st(32 + sr, sc);
  const int vb0 = (int)(uintptr_t)V_lds + v_rd_base(lane);
  struct { typename St::T vs0, vs1, ks0, ks1; } sr_[SDEPTH];
#define SLOAD(i, k0) do { sr_[i].vs0 = St::ld8(&Vh[(long)((k0) + sr) * LDK + sc]); sr_[i].vs1 = St::ld8(&Vh[(long)((k0) + 32 + sr) * LDK + sc]); \
    sr_[i].ks0 = St::ld8(&Kh[(long)((k0) + sr) * LDK + sc]); sr_[i].ks1 = St::ld8(&Kh[(long)((k0) + 32 + sr) * LDK + sc]); } while (0)
#define SWRITE(b, i) do { *(bf16x8*)((char*)V_lds + (b) * SHM_V + vst0) = St::tobf(sr_[i].vs0);          \
    *(bf16x8*)((char*)V_lds + (b) * SHM_V + vst1) = St::tobf(sr_[i].vs1); int kc = sc * 2;               \
    *(bf16x8*)((char*)K_lds + (b) * SHM_K + KSWZ(sr, kc)) = St::tobf(sr_[i].ks0);                       \
    *(bf16x8*)((char*)K_lds + (b) * SHM_K + KSWZ(32 + sr, kc)) = St::tobf(sr_[i].ks1); } while (0)
#define SWAIT() do { if constexpr (SDEPTH == 2) asm volatile("s_waitcnt vmcnt(4)" ::: "memory"); else asm volatile("s_waitcnt vmcnt(0)" ::: "memory"); } while (0)
#define RESC(a) do { if (__any((a) < 1.f)) { if (hi == 0) al_l[r32] = (a); asm volatile("s_waitcnt lgkmcnt(0)" ::: "memory"); \
    for (int d = 0; d < 4; ++d) for (int r = 0; r < 16; ++r) o[d][r] *= al_l[crow(r, hi)]; } } while (0)
  f32x16 pA0, pA1, pB0, pB1; float mnA, mnB, alA, alB; bf16x8 pa0, pa1, pa2, pa3; const int NT = seq / KVBLK;
  constexpr int SE = 0, SO = SDEPTH - 1;
  SLOAD(SE, 0); asm volatile("s_waitcnt vmcnt(0)" ::: "memory"); SWRITE(0, SE); __syncthreads();
  qkt(pA0, pA1, K_lds, qr, r32, hi); partialSM(pA0, pA1, m_reg, mnA, alA);
  SLOAD(SO, KVBLK); if constexpr (SDEPTH == 2) { if (2 < NT) SLOAD(SE, 2 * KVBLK); }
  SWAIT(); SWRITE(1, SO); __syncthreads();
  for (int j = 1; j + 1 < NT; j += 2) {
    SBAR(); qkt(pB0, pB1, (bf16*)((char*)K_lds + SHM_K), qr, r32, hi);
    finishSM(pA0, pA1, alA, l_reg, pa0, pa1, pa2, pa3); SBAR();
    SLOAD(SO, (j + SDEPTH) * KVBLK); SBAR();
    pv_d0(o, vb0, pa0, pa1, pa2, pa3); partialSM(pB0, pB1, m_reg, mnB, alB);
    __syncthreads(); SWAIT(); SWRITE(0, SE);
    RESC(alB); __syncthreads();
    SBAR(); qkt(pA0, pA1, K_lds, qr, r32, hi);
    finishSM(pB0, pB1, alB, l_reg, pa0, pa1, pa2, pa3); SBAR();
    if (SDEPTH == 1 || j + 3 < NT) SLOAD(SE, (j + 1 + SDEPTH) * KVBLK); SBAR();
    pv_d0(o, vb0 + (int)SHM_V, pa0, pa1, pa2, pa3); partialSM(pA0, pA1, m_reg, mnA, alA);
    __syncthreads(); SWAIT(); SWRITE(1, SO);
    RESC(alA); __syncthreads();
  }
  SBAR(); qkt(pB0, pB1, (bf16*)((char*)K_lds + SHM_K), qr, r32, hi);
  finishSM(pA0, pA1, alA, l_reg, pa0, pa1, pa2, pa3); SBAR();
  pv_d0(o, vb0, pa0, pa1, pa2, pa3); partialSM(pB0, pB1, m_reg, mnB, alB);
  __syncthreads(); RESC(alB);
  finishSM(pB0, pB1, alB, l_reg, pa0, pa1, pa2, pa3); SBAR();
  pv_d0(o, vb0 + (int)SHM_V, pa0, pa1, pa2, pa3);
  if (hi == 0) li_l[r32] = l_reg; asm volatile("s_waitcnt lgkmcnt(0)" ::: "memory");
  float rli[16];
#pragma unroll
  for (int r = 0; r < 16; ++r) rli[r] = __builtin_amdgcn_rcpf(li_l[crow(r, hi)]);
  bf16* Ow = Ob + (long)(wid * QBLK) * LDO;
#pragma unroll
  for (int r = 0; r < 16; ++r) { int orow = crow(r, hi);
    for (int d0 = 0; d0 < 4; ++d0) Ow[(long)orow * LDO + d0 * 32 + r32] = f2bf(o[d0][r] * rli[r]); }
#undef SLOAD
#undef SWRITE
#undef SWAIT
#undef RESC
}
}
__device__ __forceinline__ void attn_phase(const Params& p, unsigned char* lds, int vcu, int G) {
    constexpr int QB = 256, LQB = LSEQ / QB, CQB = CSEQ / QB;
    constexpr int NUL = NLB * NQ * LQB, NUC = NCB * NQ * CQB, NU = NUL + NUC;
    const att::bf16* QR = (const att::bf16*)(p.ws + WS_QRAW); att::bf16* OB = (att::bf16*)(p.ws + WS_O);
    for (int i = 0;; ++i) {
        int u;
        if (G == 256 && NUL == 512) { if (i < 2) u = (vcu >> 5) * 64 + (vcu & 31) + 32 * i; else u = NUL + vcu + (i - 2) * G; }
        else u = vcu + i * G;
        if (u >= NU) break;
        const att::bf16 *Q, *K, *V; att::bf16* O; int seq;
        if (u < NUL) { const int grp = u / (GRP * LQB), j = u % (GRP * LQB); const int b = grp / NKV, kvh = grp % NKV, g = j / LQB, qb = j % LQB, hq = kvh * GRP + g;
            const size_t row0 = (size_t)MC + (size_t)b * LSEQ + (size_t)qb * QB;
            Q = QR + row0 * (NQ * HDIM) + hq * HDIM; O = OB + row0 * DM + hq * HDIM;
            K = (const att::bf16*)(p.ws + WS_LATK) + (size_t)b * SKVL * (NKV * HDIM) + kvh * HDIM; V = (const att::bf16*)(p.ws + WS_LATV) + (size_t)b * SKVL * (NKV * HDIM) + kvh * HDIM; seq = SKVL; }
        else { const int uc = u - NUL; const int b = uc / (NQ * CQB), r = uc % (NQ * CQB), hq = r / CQB, qb = r % CQB, kvh = hq / GRP;
            const size_t row0 = (size_t)b * CSEQ + (size_t)qb * QB;
            Q = QR + row0 * (NQ * HDIM) + hq * HDIM; O = OB + row0 * DM + hq * HDIM;
            K = (const att::bf16*)(p.ws + WS_CTXK) + (size_t)b * CSEQ * (NKV * HDIM) + kvh * HDIM; V = (const att::bf16*)(p.ws + WS_CTXV) + (size_t)b * CSEQ * (NKV * HDIM) + kvh * HDIM; seq = CSEQ; }
        __syncthreads();
        att::attn_dense_body(Q, K, V, O, seq, (char*)lds);
    }
}
static_assert(SKVL % 128 == 0 && CSEQ % 128 == 0 && LSEQ % 256 == 0 && CSEQ % 256 == 0, "attention tiling");
constexpr size_t WS_CST = 232 * MiB;
constexpr int NBLK = LSEQ / 256;
constexpr size_t WS_NST = WS_CST + (size_t)NLB * MH * 2 * NBLK * MDK * MDK * 2;
constexpr size_t WS_FTOT = WS_NST + (size_t)NLB * MH * 2 * NBLK * MDK * 4;
static_assert(WS_FTOT + (size_t)NLB * MH * 2 * NBLK * 4 <= WS_END && MDK == 128 && CSEQ == 256 && LSEQ % 256 == 0, "mLSTM fast path geometry");
namespace att {
constexpr int ML_OFF = 132096;
constexpr int ML_SC = ML_OFF + 6144;
constexpr int ML_N = ML_SC + 128;
constexpr int ML_LI = ML_N + 1024;
static_assert(ML_LI + 1024 <= LDS_BYTES, "mLSTM LDS map");
constexpr float L2E = 1.4426950408889634f;
using f32x4v = __attribute__((ext_vector_type(4))) float;


__device__ __forceinline__ void ml_gates(const Params& p, char* lds, int row0, int h, int tid) {
    float* A = (float*)(lds + ML_OFF); float* S = (float*)(lds + ML_SC);
    const int half = tid >> 8, t = tid & 255, tok = half ? 255 - t : t, lane = tid & 63, wv = (tid >> 6) & 3;
    const float* G = (const float*)(p.ws + WS_GATES) + (size_t)(row0 + tok) * NGATE + half * 8 + h;
    const float ig = G[0], lf = G[4];
    float v = lf;
#pragma unroll
    for (int off = 1; off < 64; off <<= 1) { const float u = lane_get(v, lane - off); if (lane >= off) v += u; }
    if (lane == 63) S[4 + half * 4 + wv] = v;
    __syncthreads();
    float pre = 0.f, tot = 0.f;
#pragma unroll
    for (int w = 0; w < 4; ++w) { const float x = S[4 + half * 4 + w]; if (w < wv) pre += x; tot += x; }
    const float P = v + pre, a = ig - P;
    A[(0 + half) * 256 + tok] = P * L2E; A[(2 + half) * 256 + tok] = a * L2E; A[(4 + half) * 256 + tok] = __builtin_amdgcn_exp2f(P * L2E);
    float mx = a;
    mx = fmaxf(mx, swz_xor<1>(mx)); mx = fmaxf(mx, swz_xor<2>(mx)); mx = fmaxf(mx, swz_xor<4>(mx)); mx = fmaxf(mx, swz_xor<8>(mx)); mx = fmaxf(mx, swz_xor<16>(mx)); mx = half_max(mx);
    if (lane == 0) S[12 + half * 4 + wv] = mx;
    if (t == 0) S[half] = tot;
    __syncthreads();
    if (t == 0) S[2 + half] = fmaxf(fmaxf(S[12 + half * 4], S[13 + half * 4]), fmaxf(S[14 + half * 4], S[15 + half * 4]));
    __syncthreads();
}
#define ML_PK(L, H) (bf16x8){L[0], L[1], L[2], L[3], H[0], H[1], H[2], H[3]}
__device__ __forceinline__ s16x4 tr_read_rt(int vb) { s16x4 r; asm volatile("ds_read_b64_tr_b16 %0, %1" : "=&v"(r) : "v"(vb) : "memory"); return r; }

__device__ __forceinline__ void ml_passA_unit(const Params& p, char* lds, int sid, int h, int blk) {
    const int tid = tid_opaque(), wid = tid >> 6, lane = tid & 63, r32 = lane & 31, hi = lane >> 5;
    const bool isctx = sid < NCB; const int row0 = seq_base(sid) + 256 * blk;
    __syncthreads();
    ml_gates(p, lds, row0, h, tid);
    float* A = (float*)(lds + ML_OFF); float* S = (float*)(lds + ML_SC); float* NA = (float*)(lds + ML_N);
    const bf16* QK = (const bf16*)(p.ws + WS_QKVO) + (size_t)row0 * (4 * MW) + h * MDK;
    const int sr = tid >> 4, sc8 = (tid & 15) * 8;
    { bf16x8 tv[8];
#pragma unroll
      for (int i = 0; i < 8; ++i) tv[i] = *(const bf16x8*)(QK + (size_t)(32 * i + sr) * (4 * MW) + 2 * MW + sc8);
#pragma unroll
      for (int i = 0; i < 8; ++i) *(bf16x8*)(lds + 65536 + (i >> 1) * 16384 + v_st(32 * (i & 1) + sr, sc8)) = tv[i]; }
    if (tid < 256) NA[tid] = 0.f;
    const int a = wid >> 1, dvb0 = 2 * (wid & 1);
    const int ldsb = (int)(uintptr_t)lds; const int vbK = ldsb + v_rd_base(lane) + a * 512, vbV = ldsb + 65536 + v_rd_base(lane) + dvb0 * 512;
    for (int dir = 0; dir < 2; ++dir) {
        __syncthreads();
        const float ft = S[dir], am = S[2 + dir]; const float mT = isctx ? ft + fmaxf(am, 0.f) : 0.f; const float wl2 = (ft - mT) * L2E;
        float xs[8];
#pragma unroll
        for (int i = 0; i < 8; ++i) xs[i] = 0.f;
        bf16x8 tk[8];
#pragma unroll
        for (int i = 0; i < 8; ++i) tk[i] = *(const bf16x8*)(QK + (size_t)(32 * i + sr) * (4 * MW) + MW + sc8);
#pragma unroll
        for (int j = 0; j < 4; ++j)
#pragma unroll
            for (int hf = 0; hf < 2; ++hf) { const int row = 64 * j + 32 * hf + sr; const float w = __builtin_amdgcn_exp2f(wl2 + A[(2 + dir) * 256 + row]);
                const bf16x8 k8 = tk[2 * j + hf]; float x[8];
#pragma unroll
                for (int i = 0; i < 8; ++i) { x[i] = bf2f((unsigned short)k8[i]) * w; xs[i] += x[i]; }
                u32x4 pk = {cvtpk(x[0], x[1]), cvtpk(x[2], x[3]), cvtpk(x[4], x[5]), cvtpk(x[6], x[7])};
                *(u32x4*)(lds + j * 16384 + v_st(32 * hf + sr, sc8)) = pk; }
#pragma unroll
        for (int i = 0; i < 8; ++i) { float v = xs[i]; v += swz_xor<16>(v); v = half_sum(v); if (lane < 16) atomicAdd(&NA[dir * 128 + sc8 + i], v); }
        __syncthreads();
        f32x16 acc0 = {}, acc1 = {}; const unsigned eoff = (unsigned)((32 * a + 4 * hi) * MDK + 32 * dvb0 + r32);
#pragma unroll
        for (int j = 0; j < 4; ++j)
#pragma unroll
            for (int ks = 0; ks < 4; ++ks) { const int off = j * 16384 + ks * 4096;
                const s16x4 al = tr_read_rt(vbK + off), ah = tr_read_rt(vbK + off + 2048);
                const s16x4 bl0 = tr_read_rt(vbV + off), bh0 = tr_read_rt(vbV + off + 2048), bl1 = tr_read_rt(vbV + off + 512), bh1 = tr_read_rt(vbV + off + 512 + 2048);
                asm volatile("s_waitcnt lgkmcnt(0)" ::: "memory"); SBAR();
                acc0 = __builtin_amdgcn_mfma_f32_32x32x16_bf16(ML_PK(al, ah), ML_PK(bl0, bh0), acc0, 0, 0, 0);
                acc1 = __builtin_amdgcn_mfma_f32_32x32x16_bf16(ML_PK(al, ah), ML_PK(bl1, bh1), acc1, 0, 0, 0); }
        if (isctx) {
            float* Co = p.out + O_C + ((size_t)(sid * 2 + dir) * MH + h) * MDK * MDK;
#pragma unroll
            for (int r = 0; r < 16; ++r) { const unsigned eo = eoff + (unsigned)(((r & 3) + 8 * (r >> 2)) * MDK); Co[eo] = acc0[r]; Co[eo + 32] = acc1[r]; }
            if (tid == 0) p.out[O_M + (size_t)(sid * 2 + dir) * MH + h] = mT;
        } else {
            const int b = sid - NCB; bf16* Cs = (bf16*)(p.ws + WS_CST) + ((size_t)((b * MH + h) * 2 + dir) * NBLK + blk) * MDK * MDK;
#pragma unroll
            for (int r = 0; r < 16; ++r) { const unsigned eo = eoff + (unsigned)(((r & 3) + 8 * (r >> 2)) * MDK); Cs[eo] = f2bf(acc0[r]); Cs[eo + 32] = f2bf(acc1[r]); }
            if (tid == 0) ((float*)(p.ws + WS_FTOT))[((size_t)(b * MH + h) * 2 + dir) * NBLK + blk] = ft;
        }
    }
    __syncthreads();
    if (tid < 256) { const int dir = tid >> 7, d = tid & 127;
        if (isctx) p.out[O_N + ((size_t)(sid * 2 + dir) * MH + h) * MDK + d] = NA[tid];
        else { const int b = sid - NCB; ((float*)(p.ws + WS_NST))[(((size_t)(b * MH + h) * 2 + dir) * NBLK + blk) * MDK + d] = NA[tid]; } }
}

template <int DIR> __device__ __forceinline__ void ml_tile(f32x16* o, float& den, const bf16x8* qr, const char* Ktile, int vbV, const float* AL2, int j, float cq, int trow, bool diag, int r32, int hi) {
    SBAR(); f32x16 p0, p1; qkt(p0, p1, (const bf16*)Ktile, qr, r32, hi); SBAR();
    float ds = 0.f; const int tl = trow - 64 * j - 4 * hi;
#pragma unroll
    for (int g = 0; g < 4; ++g) { const f32x4v a0 = *(const f32x4v*)(AL2 + 64 * j + 8 * g + 4 * hi), a1 = *(const f32x4v*)(AL2 + 64 * j + 32 + 8 * g + 4 * hi);
#pragma unroll
        for (int e = 0; e < 4; ++e) { float w0 = __builtin_amdgcn_exp2f(cq + a0[e]), w1 = __builtin_amdgcn_exp2f(cq + a1[e]);
            if (diag) { if (DIR == 0 ? (8 * g + e > tl) : (8 * g + e < tl)) w0 = 0.f; if (DIR == 0 ? (8 * g + e + 32 > tl) : (8 * g + e + 32 < tl)) w1 = 0.f; }
            p0[4 * g + e] *= w0; p1[4 * g + e] *= w1; ds += p0[4 * g + e] + p1[4 * g + e]; } }
    den += ds;
    bf16x8 pa0, pa1, pa2, pa3;
#define PK4(P, BASE, OUT) do { unsigned a0_ = cvtpk(P[BASE + 0], P[BASE + 1]), a1_ = cvtpk(P[BASE + 2], P[BASE + 3]);   \
    unsigned b0_ = cvtpk(P[BASE + 4], P[BASE + 5]), b1_ = cvtpk(P[BASE + 6], P[BASE + 7]);                              \
    auto r0_ = __builtin_amdgcn_permlane32_swap(a0_, b0_, false, false); auto r1_ = __builtin_amdgcn_permlane32_swap(a1_, b1_, false, false); \
    u32x4 w_ = {r0_[0], r1_[0], r0_[1], r1_[1]}; OUT = *reinterpret_cast<bf16x8*>(&w_); } while (0)
    PK4(p0, 0, pa0); PK4(p0, 8, pa1); PK4(p1, 0, pa2); PK4(p1, 8, pa3);
#undef PK4
    SBAR(); pv_d0(o, vbV, pa0, pa1, pa2, pa3); SBAR();
}
__device__ __forceinline__ void ml_stage_kv(char* lds, const bf16* QK, int tile0, int sr, int sc8) {
    bf16x8 tk[4], tv[4];
#pragma unroll
    for (int i = 0; i < 4; ++i) { const int row = 64 * tile0 + 32 * i + sr; tk[i] = *(const bf16x8*)(QK + (size_t)row * (4 * MW) + MW + sc8); tv[i] = *(const bf16x8*)(QK + (size_t)row * (4 * MW) + 2 * MW + sc8); }
#pragma unroll
    for (int i = 0; i < 4; ++i) { const int jj = i >> 1, rl = 32 * (i & 1) + sr; *(bf16x8*)(lds + jj * 16384 + KSWZ(rl, sc8 * 2)) = tk[i]; *(bf16x8*)(lds + 32768 + jj * 16384 + v_st(rl, sc8)) = tv[i]; }
}
__device__ __forceinline__ void ml_passC_unit(const Params& p, char* lds, int sid, int h, int blk) {
    const int tid = tid_opaque(), wid = tid >> 6, lane = tid & 63, r32 = lane & 31, hi = lane >> 5;
    const bool isctx = sid < NCB; const int row0 = seq_base(sid) + 256 * blk; const int wq = wid >> 1;
    __syncthreads();
    ml_gates(p, lds, row0, h, tid);
    float* A = (float*)(lds + ML_OFF); float* NS = (float*)(lds + ML_N); float* li = (float*)(lds + ML_LI) + wid * 32;
    const bf16* QK = (const bf16*)(p.ws + WS_QKVO) + (size_t)row0 * (4 * MW) + h * MDK;
    const int sr = tid >> 4, sc8 = (tid & 15) * 8; const int b = sid - NCB;
    if (tid < 256) { const int dir = tid >> 7, d = tid & 127;
        NS[tid] = isctx ? 0.f : ((const float*)(p.ws + WS_NST))[(((size_t)(b * MH + h) * 2 + dir) * NBLK + blk) * MDK + d]; }
    if (!isctx) { bf16x8 tc[8];
#pragma unroll
        for (int i = 0; i < 8; ++i) { const int dir = i >> 2, c = tid + 512 * (i & 3); tc[i] = *(const bf16x8*)((const bf16*)(p.ws + WS_CST) + ((size_t)((b * MH + h) * 2 + dir) * NBLK + blk) * MDK * MDK + (size_t)c * 8); }
#pragma unroll
        for (int i = 0; i < 8; ++i) { const int dir = i >> 2, c = tid + 512 * (i & 3), row = c >> 4, col8 = (c & 15) * 8; *(bf16x8*)(lds + 65536 + dir * 32768 + (row >> 6) * 16384 + v_st(row & 63, col8)) = tc[i]; }
    }
    bf16x8 qr[8];
    { const bf16* Qw = QK + (size_t)(wid * 32 + r32) * (4 * MW) + hi * 8;
#pragma unroll
        for (int d0 = 0; d0 < 8; ++d0) qr[d0] = *(const bf16x8*)(Qw + d0 * 16); }
    ml_stage_kv(lds, QK, 0, sr, sc8);
    __syncthreads();
    float qn_f = 0.f, qn_b = 0.f;
#pragma unroll
    for (int d0 = 0; d0 < 8; ++d0)
#pragma unroll
        for (int i = 0; i < 8; ++i) { const float qv = bf2f((unsigned short)qr[d0][i]); qn_f += qv * NS[d0 * 16 + hi * 8 + i]; qn_b += qv * NS[128 + d0 * 16 + hi * 8 + i]; }
    qn_f = half_sum(qn_f); qn_b = half_sum(qn_b);
    const int ldsb = (int)(uintptr_t)lds; const int vbV = ldsb + 32768 + v_rd_base(lane), vbC = ldsb + 65536 + v_rd_base(lane);
    const int trow = wid * 32 + r32;
    float* HS = (float*)(p.ws + WS_HS) + (size_t)(row0 + wid * 32) * MW + h * MDK;
    f32x16 o[4]; const unsigned hso = (unsigned)(4 * hi * MW + r32), uho = (unsigned)(4 * hi * DM + r32), ogo = (unsigned)(4 * hi * 4 * MW + r32);
    {
        float qn = qn_f;
        o[0] = f32x16{}; o[1] = f32x16{}; o[2] = f32x16{}; o[3] = f32x16{};
        if (!isctx) { pv_d0(o, vbC, qr[0], qr[1], qr[2], qr[3]); pv_d0(o, vbC + 16384, qr[4], qr[5], qr[6], qr[7]);
#pragma unroll
            for (int r = 0; r < 16; ++r) { const float e = A[4 * 256 + wid * 32 + crow(r, hi)];
#pragma unroll
                for (int d0 = 0; d0 < 4; ++d0) o[d0][r] *= e; } }
        const float cq = A[0 * 256 + trow]; float den = 0.f;
        ml_tile<0>(o, den, qr, lds, vbV, A + 2 * 256, 0, cq, trow, wq == 0, r32, hi);
        if (wq >= 1) ml_tile<0>(o, den, qr, lds + 16384, vbV + 16384, A + 2 * 256, 1, cq, trow, wq == 1, r32, hi);
        __syncthreads(); ml_stage_kv(lds, QK, 2, sr, sc8); __syncthreads();
        if (wq >= 2) ml_tile<0>(o, den, qr, lds, vbV, A + 2 * 256, 2, cq, trow, wq == 2, r32, hi);
        if (wq >= 3) ml_tile<0>(o, den, qr, lds + 16384, vbV + 16384, A + 2 * 256, 3, cq, trow, wq == 3, r32, hi);
        { auto rr = __builtin_amdgcn_permlane32_swap(__float_as_uint(den), __float_as_uint(den), false, false); den = __uint_as_float(rr[0]) + __uint_as_float(rr[1]); }
        const float dn = den + __builtin_amdgcn_exp2f(cq) * qn; const float inv = 1.0f / fmaxf(fabsf(dn), 1.0f);
        if (hi == 0) li[r32] = inv; asm volatile("s_waitcnt lgkmcnt(0)" ::: "memory");
#pragma unroll
        for (int r = 0; r < 16; ++r) { const float rl = li[crow(r, hi)]; const unsigned eo = hso + (unsigned)(((r & 3) + 8 * (r >> 2)) * MW);
#pragma unroll
            for (int d0 = 0; d0 < 4; ++d0) HS[eo + d0 * 32] = o[d0][r] * rl;
            asm volatile("" ::: "memory"); }
    }
    {
        float qn = qn_b;
        o[0] = f32x16{}; o[1] = f32x16{}; o[2] = f32x16{}; o[3] = f32x16{};
        if (!isctx) { pv_d0(o, vbC + 32768, qr[0], qr[1], qr[2], qr[3]); pv_d0(o, vbC + 32768 + 16384, qr[4], qr[5], qr[6], qr[7]);
#pragma unroll
            for (int r = 0; r < 16; ++r) { const float e = A[5 * 256 + wid * 32 + crow(r, hi)];
#pragma unroll
                for (int d0 = 0; d0 < 4; ++d0) o[d0][r] *= e; } }
        const float cq = A[1 * 256 + trow]; float den = 0.f;
        ml_tile<1>(o, den, qr, lds + 16384, vbV + 16384, A + 3 * 256, 3, cq, trow, wq == 3, r32, hi);
        if (wq <= 2) ml_tile<1>(o, den, qr, lds, vbV, A + 3 * 256, 2, cq, trow, wq == 2, r32, hi);
        __syncthreads(); ml_stage_kv(lds, QK, 0, sr, sc8); __syncthreads();
        if (wq <= 1) ml_tile<1>(o, den, qr, lds + 16384, vbV + 16384, A + 3 * 256, 1, cq, trow, wq == 1, r32, hi);
        if (wq <= 0) ml_tile<1>(o, den, qr, lds, vbV, A + 3 * 256, 0, cq, trow, wq == 0, r32, hi);
        { auto rr = __builtin_amdgcn_permlane32_swap(__float_as_uint(den), __float_as_uint(den), false, false); den = __uint_as_float(rr[0]) + __uint_as_float(rr[1]); }
        const float dn = den + __builtin_amdgcn_exp2f(cq) * qn; const float inv = 1.0f / fmaxf(fabsf(dn), 1.0f);
        asm volatile("s_waitcnt vmcnt(0)" ::: "memory");
        if (hi == 0) li[r32] = inv; asm volatile("s_waitcnt lgkmcnt(0)" ::: "memory");
        float mg[4];
#pragma unroll
        for (int d0 = 0; d0 < 4; ++d0) mg[d0] = p.mng[h * MDK + d0 * 32 + r32];
        const bf16* OG = QK + (size_t)(wid * 32) * (4 * MW) + 3 * MW; bf16* UHo = (bf16*)(p.ws + WS_UH) + (size_t)(row0 + wid * 32) * DM + CCH + h * MDK;
#pragma unroll
        for (int r = 0; r < 16; ++r) { const float rl = li[crow(r, hi)]; const int rc = (r & 3) + 8 * (r >> 2); float ss = 0.f;
#pragma unroll
            for (int d0 = 0; d0 < 4; ++d0) { const float hf = __hip_atomic_load(HS + hso + (unsigned)(rc * MW + d0 * 32), __ATOMIC_RELAXED, __HIP_MEMORY_SCOPE_AGENT); const float x = hf + o[d0][r] * rl; o[d0][r] = x; ss += x * x; }
            ss += swz_xor<1>(ss); ss += swz_xor<2>(ss); ss += swz_xor<4>(ss); ss += swz_xor<8>(ss); ss += swz_xor<16>(ss);
            const float rs = 1.0f / sqrtf(ss * (1.0f / MDK) + EPSF);
#pragma unroll
            for (int d0 = 0; d0 < 4; ++d0) UHo[uho + (unsigned)(rc * DM + d0 * 32)] = f2bf(bf2f(OG[ogo + (unsigned)(rc * 4 * MW + d0 * 32)]) * o[d0][r] * rs * mg[d0]);
            asm volatile("" ::: "memory"); }
    }
}
}

template <int DIR> __device__ __forceinline__ void ml_scan_item(const Params& p, int ch, int b, int h, int e8) {
    const float em = expf(p.stm[(size_t)(b * 2 + DIR) * MH + h]); const float* FT = (const float*)(p.ws + WS_FTOT) + (size_t)ch * NBLK;
    float fd[NBLK];
#pragma unroll
    for (int i = 0; i < NBLK; ++i) fd[i] = expf(FT[i]);
    if (e8 < MDK * MDK) { bf16_t* Cs = (bf16_t*)(p.ws + WS_CST) + (size_t)ch * NBLK * MDK * MDK + e8; const float* c0 = p.stC + ((size_t)(b * 2 + DIR) * MH + h) * MDK * MDK + e8;
        v4u d[NBLK];
#pragma unroll
        for (int i = 0; i < NBLK; ++i) d[i] = *(const v4u*)(Cs + (size_t)i * MDK * MDK);
        const f32x4 ca = *(const f32x4*)c0, cb = *(const f32x4*)(c0 + 4); float c[8] = {ca[0] * em, ca[1] * em, ca[2] * em, ca[3] * em, cb[0] * em, cb[1] * em, cb[2] * em, cb[3] * em};
#pragma unroll
        for (int i = 0; i < NBLK; ++i) { const int blk = DIR == 0 ? i : NBLK - 1 - i; v4u o;
#pragma unroll
            for (int w = 0; w < 4; ++w) { const float lo = __uint_as_float(d[blk][w] << 16), hi = __uint_as_float(d[blk][w] & 0xffff0000u); o[w] = pg8::cvt_pk_bf16(c[2 * w], c[2 * w + 1]);
                c[2 * w] = fd[blk] * c[2 * w] + lo; c[2 * w + 1] = fd[blk] * c[2 * w + 1] + hi; }
            *(v4u*)(Cs + (size_t)blk * MDK * MDK) = o; } }
    else { const int d_ = e8 - MDK * MDK; float* Ns = (float*)(p.ws + WS_NST) + (size_t)ch * NBLK * MDK + d_; const float* n0 = p.stn + ((size_t)(b * 2 + DIR) * MH + h) * MDK + d_;
        f32x4 da[NBLK], db[NBLK];
#pragma unroll
        for (int i = 0; i < NBLK; ++i) { da[i] = *(const f32x4*)(Ns + (size_t)i * MDK); db[i] = *(const f32x4*)(Ns + (size_t)i * MDK + 4); }
        f32x4 ca = *(const f32x4*)n0 * em, cb = *(const f32x4*)(n0 + 4) * em;
#pragma unroll
        for (int i = 0; i < NBLK; ++i) { const int blk = DIR == 0 ? i : NBLK - 1 - i;
            *(f32x4*)(Ns + (size_t)blk * MDK) = ca; *(f32x4*)(Ns + (size_t)blk * MDK + 4) = cb; ca = ca * fd[blk] + da[blk]; cb = cb * fd[blk] + db[blk]; } }
}
struct MlScan {
    Params p; static HD_FN long count() { return (long)NLB * MH * 2 * ((MDK * MDK + MDK) / 8); }
    __device__ __forceinline__ void operator()(long idx) const {
        constexpr int per = (MDK * MDK + MDK) / 8; const int e8 = (int)(idx % per) * 8; const int ch = (int)(idx / per); const int dir = ch & 1, h = (ch >> 1) % MH, b = ch / (2 * MH);
        if (dir == 0) ml_scan_item<0>(p, ch, b, h, e8); else ml_scan_item<1>(p, ch, b, h, e8);
    }
};
__device__ __forceinline__ void ml_phase_A(const Params& p, unsigned char* lds, int vcu, int G) {
    constexpr int NUL = NLB * MH * NBLK, NU = NUL + NCB * MH;
    for (int u = vcu; u < NU; u += G) {
        if (u < NUL) att::ml_passA_unit(p, (char*)lds, NCB + u / (MH * NBLK), (u / NBLK) % MH, u % NBLK);
        else att::ml_passA_unit(p, (char*)lds, (u - NUL) / MH, (u - NUL) % MH, 0); }
}
__device__ __forceinline__ void ml_phase_C(const Params& p, unsigned char* lds, int vcu, int G) {
    constexpr int NUL = NLB * MH * NBLK, NU = NUL + NCB * MH;
    for (int u = vcu; u < NU; u += G) {
        if (u < NUL) att::ml_passC_unit(p, (char*)lds, NCB + u / (MH * NBLK), (u / NBLK) % MH, u % NBLK);
        else att::ml_passC_unit(p, (char*)lds, (u - NUL) / MH, (u - NUL) % MH, 0); }
}
typedef float f4 __attribute__((ext_vector_type(4)));
typedef unsigned u4 __attribute__((ext_vector_type(4)));
typedef unsigned u2 __attribute__((ext_vector_type(2)));
__device__ __forceinline__ float wave_sum64(float v) { v += swz_xor<1>(v); v += swz_xor<2>(v); v += swz_xor<4>(v); v += swz_xor<8>(v); v += swz_xor<16>(v); return half_sum(v); }
__device__ __forceinline__ float fsilu(float x) { return x * fsigmoid(x); }

__device__ __forceinline__ void phase_mod(const Params& p, char* lds, int bx, int G) {
    const int tid = tid_opaque(), lane = tid & 63, wave = tid >> 6;
    float* SL = (float*)lds; float* PT = (float*)(lds + 32768);
    constexpr int NCG = 6 * DM / 64, NIT = 2 * NCG;
    if (bx >= NIT) return;
    __syncthreads();
    for (int i = tid; i < NCLS * DM; i += NTHREADS) { const int cls = i / DM, k = i % DM; const float cv = cls == 0 ? p.cctx[k] : p.c[(size_t)(cls - 1) * DM + k]; SL[i] = fsilu(cv); }
    for (int item = bx; item < NIT; item += G) {
        __syncthreads();
        const int l = item / NCG, cg = item % NCG; const float* w = p.wmod + (size_t)l * DM * 6 * DM + cg * 64 + lane;
        float acc[NCLS];
#pragma unroll
        for (int r = 0; r < NCLS; ++r) acc[r] = 0.f;
        const int k0 = wave * (DM / 8);
#pragma unroll 8
        for (int k = k0; k < k0 + DM / 8; ++k) { const float wv = w[(size_t)k * 6 * DM];
#pragma unroll
            for (int r = 0; r < NCLS; ++r) acc[r] += SL[r * DM + k] * wv; }
#pragma unroll
        for (int r = 0; r < NCLS; ++r) PT[(wave * NCLS + r) * 64 + lane] = acc[r];
        __syncthreads();
        if (tid < NCLS * 64) { const int r = tid >> 6; float s = p.bmod[(size_t)l * 6 * DM + cg * 64 + lane];
#pragma unroll
            for (int w8 = 0; w8 < 8; ++w8) s += PT[(w8 * NCLS + r) * 64 + lane];
            ((float*)(p.ws + WS_MOD))[((size_t)(l * NCLS + r) * 6 * DM) + cg * 64 + lane] = s; }
    }
}
__device__ __forceinline__ void sw_job(const Params& p, const bf16_t* Bt, int nrows, int l, int which, float* sw, int N, int mode, int gw, int NGW, int lane) {
    if (gw >= nrows) return;
    f4 sh[NCLS][4];
#pragma unroll
    for (int cls = 0; cls < NCLS; ++cls) { const float* s_ = modv(p, l, cls, which); sh[cls][0] = *(const f4*)(s_ + lane * 8); sh[cls][1] = *(const f4*)(s_ + lane * 8 + 4); sh[cls][2] = *(const f4*)(s_ + DM / 2 + lane * 8); sh[cls][3] = *(const f4*)(s_ + DM / 2 + lane * 8 + 4); }
    u4 w0 = *(const u4*)(Bt + (size_t)gw * DM + lane * 8), w1 = *(const u4*)(Bt + (size_t)gw * DM + DM / 2 + lane * 8);
    for (int n = gw; n < nrows; n += NGW) {
        const u4 c0 = w0, c1 = w1; const int nn = n + NGW; if (nn < nrows) { w0 = *(const u4*)(Bt + (size_t)nn * DM + lane * 8); w1 = *(const u4*)(Bt + (size_t)nn * DM + DM / 2 + lane * 8); }
        f4 wa, wb, wc, wd; wa = (f4){__uint_as_float(c0.x << 16), __uint_as_float(c0.x & 0xffff0000u), __uint_as_float(c0.y << 16), __uint_as_float(c0.y & 0xffff0000u)};
        wb = (f4){__uint_as_float(c0.z << 16), __uint_as_float(c0.z & 0xffff0000u), __uint_as_float(c0.w << 16), __uint_as_float(c0.w & 0xffff0000u)};
        wc = (f4){__uint_as_float(c1.x << 16), __uint_as_float(c1.x & 0xffff0000u), __uint_as_float(c1.y << 16), __uint_as_float(c1.y & 0xffff0000u)};
        wd = (f4){__uint_as_float(c1.z << 16), __uint_as_float(c1.z & 0xffff0000u), __uint_as_float(c1.w << 16), __uint_as_float(c1.w & 0xffff0000u)};
        int col = n; if (mode == 1) { const int t = n >> 8, r = n & 255; col = r < 128 ? 128 * t + r : (N / 2) + 128 * t + (r - 128); }
        float mine = 0.f;
#pragma unroll
        for (int cls = 0; cls < NCLS; ++cls) { const f4 t4 = sh[cls][0] * wa + sh[cls][1] * wb + sh[cls][2] * wc + sh[cls][3] * wd; float s = (t4[0] + t4[1]) + (t4[2] + t4[3]); s = wave_sum64(s); if (lane == cls) mine = s; }
        if (lane < NCLS) sw[(size_t)lane * N + col] = mine;
    }
}
static_assert(DM == 1024, "sw_job / norm passes assume 1024 = 64 lanes x 16");
typedef float f32x4g __attribute__((ext_vector_type(4)));
__device__ __forceinline__ void phase_norm0(const Params& p, char* lds, int bx, int G) {
    const int tid = tid_opaque(), lane = tid & 63, wave = tid >> 6; constexpr int WLD = DM + 4;
    float* WG = (float*)lds;
    __syncthreads();
    { f4 tv[DM * 4 / NTHREADS];
#pragma unroll
      for (int it = 0; it < DM * 4 / NTHREADS; ++it) { const int k = it * (NTHREADS / 4) + (tid >> 2); tv[it] = *(const f4*)(p.winab + (size_t)k * ABIN + ABMAIN + 4 * (tid & 3)); }
#pragma unroll
      for (int it = 0; it < DM * 4 / NTHREADS; ++it) { const int k = it * (NTHREADS / 4) + (tid >> 2), g0 = 4 * (tid & 3); WG[(g0 + 0) * WLD + k] = tv[it][0]; WG[(g0 + 1) * WLD + k] = tv[it][1]; WG[(g0 + 2) * WLD + k] = tv[it][2]; WG[(g0 + 3) * WLD + k] = tv[it][3]; } }
    __syncthreads();
    const int r = lane & 15, kq = lane >> 4; const int gw = bx * NWAVES + wave, NGW = G * NWAVES;
    for (int blk = gw; blk < MTOK / 16; blk += NGW) {
        const int row = blk * 16 + r; const int cls = cls_of(blk * 16); const float* xr = xrow(p, row) + 4 * kq;
        float s = 0.f;
#pragma unroll 16
        for (int q = 0; q < DM / 16; ++q) { const f4 v = *(const f4*)(xr + 16 * q); s += (v[0] * v[0] + v[1] * v[1]) + (v[2] * v[2] + v[3] * v[3]); }
        s += swz_xor<16>(s); s = half_sum(s);
        const float rs = 1.0f / sqrtf(s * (1.0f / DM) + EPSF);
        const float* gp = p.n1g + 4 * kq; const float* scp = modv(p, 0, cls, 1) + 4 * kq; const float* shp = modv(p, 0, cls, 0) + 4 * kq; const float* wp = WG + r * WLD + 4 * kq;
        bf16_t* xo = (bf16_t*)(p.ws + WS_XN) + (size_t)row * DM + 4 * kq;
        f32x4g acc = {0.f, 0.f, 0.f, 0.f};
#pragma unroll 8
        for (int q = 0; q < DM / 16; ++q) { const f4 v = *(const f4*)(xr + 16 * q), gg = *(const f4*)(gp + 16 * q), sc = *(const f4*)(scp + 16 * q), sh = *(const f4*)(shp + 16 * q), w = *(const f4*)(wp + 16 * q);
            const f4 h = v * rs * gg * (sc + 1.0f) + sh;
            u2 o; o.x = pg8::cvt_pk_bf16(h[0], h[1]); o.y = pg8::cvt_pk_bf16(h[2], h[3]); *(u2*)(xo + 16 * q) = o;
            acc = __builtin_amdgcn_mfma_f32_16x16x4f32(h[0], w[0], acc, 0, 0, 0); acc = __builtin_amdgcn_mfma_f32_16x16x4f32(h[1], w[1], acc, 0, 0, 0);
            acc = __builtin_amdgcn_mfma_f32_16x16x4f32(h[2], w[2], acc, 0, 0, 0); acc = __builtin_amdgcn_mfma_f32_16x16x4f32(h[3], w[3], acc, 0, 0, 0); }
        const float bg = p.bgate[r];
#pragma unroll
        for (int e = 0; e < 4; ++e) { float a = acc[e] + bg; if ((r & 7) >= 4) a = logsigmoidf_(a); ((float*)(p.ws + WS_GATES))[(size_t)(blk * 16 + 4 * kq + e) * NGATE + r] = a; }
    }
}
static_assert(MTOK % 16 == 0 && MC % 16 == 0 && LSEQ % 16 == 0, "norm0 row blocks");
__device__ __forceinline__ void phase_conv(const Params& p, char* lds, int ufirst, int ustride) {
    const int tid = tid_opaque(), lane = tid & 63, wave = tid >> 6; constexpr int TT = 32, NR = TT + CWID - 1;
    bf16_t* X = (bf16_t*)lds; float* OUT = (float*)(lds + 65536);
    const int cp = tid & 255, tg = tid >> 8, c0 = 2 * cp;
    float w0[CWID], w1[CWID];
#pragma unroll
    for (int j = 0; j < CWID; ++j) { w0[j] = p.convw[(size_t)j * CCH + c0]; w1[j] = p.convw[(size_t)j * CCH + c0 + 1]; }
    const float b0 = p.convb[c0], b1 = p.convb[c0 + 1];
    const bf16_t* U = (const bf16_t*)(p.ws + WS_UPRE);
    if (ufirst < 0) return;
    for (int u = ufirst; u < MTOK / TT; u += ustride) {
        const int row0 = u * TT, pos0 = pos_of(row0), len = seqlen_of(row0);
        __syncthreads();
        { u4 val[8];
#pragma unroll
          for (int i = 0; i < 8; ++i) { const int c = tid + NTHREADS * i, r = c / (CCH / 8), ch = (c % (CCH / 8)) * 8; const int t = pos0 + r - CWID / 2;
              val[i] = (u4){0u, 0u, 0u, 0u}; if (c < NR * (CCH / 8) && t >= 0 && t < len) val[i] = *(const u4*)(U + (size_t)(row0 + r - CWID / 2) * CCH + ch); }
#pragma unroll
          for (int i = 0; i < 8; ++i) { const int c = tid + NTHREADS * i, r = c / (CCH / 8), ch = (c % (CCH / 8)) * 8; if (c < NR * (CCH / 8)) *(u4*)(X + (size_t)r * CCH + ch) = val[i]; } }
        __syncthreads();
#pragma unroll 2
        for (int tt = 0; tt < TT / 2; ++tt) { const int t = tg * (TT / 2) + tt; float a0 = b0, a1 = b1;
#pragma unroll
            for (int j = 0; j < CWID; ++j) { const unsigned xx = *(const unsigned*)(X + (size_t)(t + j) * CCH + c0); a0 += w0[j] * __uint_as_float(xx << 16); a1 += w1[j] * __uint_as_float(xx & 0xffff0000u); }
            *(float2*)(OUT + (size_t)t * CCH + c0) = make_float2(a0, a1); }
        __syncthreads();
#pragma unroll
        for (int q = 0; q < TT / NWAVES; ++q) { const int t = wave * (TT / NWAVES) + q; const f4 x0 = *(const f4*)(OUT + (size_t)t * CCH + lane * 8), x1 = *(const f4*)(OUT + (size_t)t * CCH + lane * 8 + 4);
            const float mu = wave_sum64((x0[0] + x0[1]) + (x0[2] + x0[3]) + (x1[0] + x1[1]) + (x1[2] + x1[3])) * (1.0f / CCH);
            const f4 d0 = x0 - mu, d1 = x1 - mu;
            const float var = wave_sum64((d0[0] * d0[0] + d0[1] * d0[1]) + (d0[2] * d0[2] + d0[3] * d0[3]) + (d1[0] * d1[0] + d1[1] * d1[1]) + (d1[2] * d1[2] + d1[3] * d1[3])) * (1.0f / CCH);
            const float rs = 1.0f / sqrtf(var + EPSF);
            const f4 g0 = *(const f4*)(p.lng + lane * 8), g1 = *(const f4*)(p.lng + lane * 8 + 4), be0 = *(const f4*)(p.lnb + lane * 8), be1 = *(const f4*)(p.lnb + lane * 8 + 4);
            const f4 y0 = d0 * rs * g0 + be0, y1 = d1 * rs * g1 + be1; u4 w;
            w.x = pg8::cvt_pk_bf16(fsilu(y0[0]), fsilu(y0[1])); w.y = pg8::cvt_pk_bf16(fsilu(y0[2]), fsilu(y0[3])); w.z = pg8::cvt_pk_bf16(fsilu(y1[0]), fsilu(y1[1])); w.w = pg8::cvt_pk_bf16(fsilu(y1[2]), fsilu(y1[3]));
            *(u4*)((bf16_t*)(p.ws + WS_UH) + (size_t)(row0 + t) * DM + lane * 8) = w; }
    }
}
static_assert(CCH == 512 && CSEQ % 32 == 0 && LSEQ % 32 == 0, "conv phase geometry");
__device__ __forceinline__ void phase_cachecvt(const Params& p, int gtid, int gthreads) {
    constexpr int PER = PAST * NKV * HDIM / 8;
    for (int i = gtid; i < NLB * PER; i += gthreads) { const int b = i / PER, e = (i % PER) * 8; const size_t src = (size_t)b * PAST * NKV * HDIM + e, dst = ((size_t)b * SKVL + LSEQ) * NKV * HDIM + e;
        const f4 k0 = *(const f4*)(p.ck + src), k1 = *(const f4*)(p.ck + src + 4), v0 = *(const f4*)(p.cv + src), v1 = *(const f4*)(p.cv + src + 4); u4 wk, wv;
        wk.x = pg8::cvt_pk_bf16(k0[0], k0[1]); wk.y = pg8::cvt_pk_bf16(k0[2], k0[3]); wk.z = pg8::cvt_pk_bf16(k1[0], k1[1]); wk.w = pg8::cvt_pk_bf16(k1[2], k1[3]);
        wv.x = pg8::cvt_pk_bf16(v0[0], v0[1]); wv.y = pg8::cvt_pk_bf16(v0[2], v0[3]); wv.z = pg8::cvt_pk_bf16(v1[0], v1[1]); wv.w = pg8::cvt_pk_bf16(v1[2], v1[3]);
        *(u4*)((bf16_t*)(p.ws + WS_LATK) + dst) = wk; *(u4*)((bf16_t*)(p.ws + WS_LATV) + dst) = wv; }
}
__device__ __forceinline__ void phase_qkpost(const Params& p, int gw, int NGW, int lane) {
    const int hh = lane >> 5, l5 = lane & 31, half = l5 >> 4, f0 = (l5 & 15) * 2, d1 = half * 64 + f0, d2 = d1 + 32;
    const float inv0 = __builtin_amdgcn_exp2f(-(float)f0 * (13.287712379549449f / 32.0f)), inv1 = __builtin_amdgcn_exp2f(-(float)(f0 + 1) * (13.287712379549449f / 32.0f));
    const float qg[4] = {p.qng[d1], p.qng[d1 + 1], p.qng[d2], p.qng[d2 + 1]}, kg[4] = {p.kng[d1], p.kng[d1 + 1], p.kng[d2], p.kng[d2 + 1]};
    for (int row = gw; row < MTOK; row += NGW) {
        const bool lat = row >= MC; const int sp = pos_of(row); float cs0 = 1.f, sn0 = 0.f, cs1 = 1.f, sn1 = 0.f;
        if (lat) { const float pos = (float)(half == 0 ? sp / GRIDW : sp % GRIDW); cs0 = __cosf(pos * inv0); sn0 = __sinf(pos * inv0); cs1 = __cosf(pos * inv1); sn1 = __sinf(pos * inv1); }
        bf16_t* Q = (bf16_t*)(p.ws + WS_QRAW) + (size_t)row * NQ * HDIM; const bf16_t* KR = (const bf16_t*)(p.ws + WS_KRAW) + (size_t)row * NKV * HDIM;
        unsigned ra[NQ / 2 + 1], rb[NQ / 2 + 1];
#pragma unroll
        for (int it = 0; it <= NQ / 2; ++it) { const bf16_t* src = it < NQ / 2 ? Q + (2 * it + hh) * HDIM : KR + hh * HDIM; ra[it] = *(const unsigned*)(src + d1); rb[it] = *(const unsigned*)(src + d2); }
#pragma unroll
        for (int it = 0; it <= NQ / 2; ++it) { const bool isq = it < NQ / 2;
            const float x1a = __uint_as_float(ra[it] << 16), x1b = __uint_as_float(ra[it] & 0xffff0000u), x2a = __uint_as_float(rb[it] << 16), x2b = __uint_as_float(rb[it] & 0xffff0000u);
            float ss = (x1a * x1a + x1b * x1b) + (x2a * x2a + x2b * x2b); ss += swz_xor<1>(ss); ss += swz_xor<2>(ss); ss += swz_xor<4>(ss); ss += swz_xor<8>(ss); ss += swz_xor<16>(ss);
            const float rs = 1.0f / sqrtf(ss * (1.0f / HDIM) + EPSF); const float* g = isq ? qg : kg;
            const float a0 = x1a * rs * g[0], a1 = x1b * rs * g[1], b0 = x2a * rs * g[2], b1 = x2b * rs * g[3];
            const float y1a = a0 * cs0 - b0 * sn0, y2a = a0 * sn0 + b0 * cs0, y1b = a1 * cs1 - b1 * sn1, y2b = a1 * sn1 + b1 * cs1;
            const unsigned w1 = pg8::cvt_pk_bf16(y1a, y1b), w2 = pg8::cvt_pk_bf16(y2a, y2b);
            if (isq) { bf16_t* dst = Q + (2 * it + hh) * HDIM; *(unsigned*)(dst + d1) = w1; *(unsigned*)(dst + d2) = w2; }
            else if (!lat) { bf16_t* K = (bf16_t*)(p.ws + WS_CTXK) + (size_t)row * NKV * HDIM + hh * HDIM; *(unsigned*)(K + d1) = w1; *(unsigned*)(K + d2) = w2;
                float* fo = p.out + O_K + (size_t)row * NKV * HDIM + hh * HDIM; *(float2*)(fo + d1) = make_float2(y1a, y1b); *(float2*)(fo + d2) = make_float2(y2a, y2b); }
            else { const int b_ = (row - MC) / LSEQ, s_ = (row - MC) % LSEQ; bf16_t* K = (bf16_t*)(p.ws + WS_LATK) + ((size_t)b_ * SKVL + s_) * NKV * HDIM + hh * HDIM; *(unsigned*)(K + d1) = w1; *(unsigned*)(K + d2) = w2; } }
    }
}
static_assert(NKV == 2 && NQ % 2 == 0 && HDIM == 128, "qkpost lane mapping");
__device__ __forceinline__ void phase_final(const Params& p, int gw, int NGW, int lane) {
    const f4 g0 = *((const f4*)p.fng + 2 * lane), g1 = *((const f4*)p.fng + 2 * lane + 1), g2 = *((const f4*)p.fng + 128 + 2 * lane), g3 = *((const f4*)p.fng + 128 + 2 * lane + 1);
    const float* sq = (const float*)(p.ws + WS_SSQ) + (size_t)3 * SSQ_STRIDE;
    for (int row = gw; row < MTOK; row += 2 * NGW) { const int row2 = row + NGW; const bool has2 = row2 < MTOK; const int r2 = has2 ? row2 : row;
        const float rsa = 1.0f / sqrtf(sq[row] * (1.0f / DM) + EPSF), rsb = 1.0f / sqrtf(sq[r2] * (1.0f / DM) + EPSF);
        const u4* ya = (const u4*)((const bf16_t*)(p.ws + WS_Y16) + (size_t)row * DM) + lane; const u4* yb = (const u4*)((const bf16_t*)(p.ws + WS_Y16) + (size_t)r2 * DM) + lane;
        const u4 a0 = ya[0], a1 = ya[64], b0 = yb[0], b1 = yb[64];
        f4* oa = (f4*)(p.out + O_Y + (size_t)row * DM) + 2 * lane; f4* ob = (f4*)(p.out + O_Y + (size_t)r2 * DM) + 2 * lane;
#define UNP_LO(V_) (f4){__uint_as_float((V_).x << 16), __uint_as_float((V_).x & 0xffff0000u), __uint_as_float((V_).y << 16), __uint_as_float((V_).y & 0xffff0000u)}
#define UNP_HI(V_) (f4){__uint_as_float((V_).z << 16), __uint_as_float((V_).z & 0xffff0000u), __uint_as_float((V_).w << 16), __uint_as_float((V_).w & 0xffff0000u)}
        oa[0] = UNP_LO(a0) * rsa * g0; oa[1] = UNP_HI(a0) * rsa * g1; oa[128] = UNP_LO(a1) * rsa * g2; oa[129] = UNP_HI(a1) * rsa * g3;
        if (has2) { ob[0] = UNP_LO(b0) * rsb * g0; ob[1] = UNP_HI(b0) * rsb * g1; ob[128] = UNP_LO(b1) * rsb * g2; ob[129] = UNP_HI(b1) * rsb * g3; }
#undef UNP_LO
#undef UNP_HI
    }
}
template <class Epi> __device__ __forceinline__ void gemm_call(LAS unsigned char* lds, const bf16_t* A, const bf16_t* Bt, int N, int K, const Epi& E) {
    pg8::Gemm g{A, Bt, MTOK, N, K}; pg8::StaticOrder S; S.init(MTOK, N, K, (int)gridDim.x, (int)blockIdx.x);
    pg8::gemm_phase<Epi, pg8::StaticOrder, true, true>((PG8_LAS unsigned char*)lds, g, S, E);
}
__device__ __forceinline__ void gemm_call_split(LAS unsigned char* lds, const bf16_t* A, const bf16_t* Bt, int N, int K, const EpiRes& E, unsigned char* slab, unsigned* cnt) {
    pg8::Gemm g{A, Bt, MTOK, N, K}; RoundZeroOrder S0; S0.init(MTOK, N, K, (int)gridDim.x, (int)blockIdx.x);
    pg8::gemm_phase<EpiRes, RoundZeroOrder, true, true>((PG8_LAS unsigned char*)lds, g, S0, E);
    if (S0.split) { QuarterOrder S1; S1.init(MTOK, N, K, (int)gridDim.x, (int)blockIdx.x);
        pg8::gemm_phase<EpiPartial, QuarterOrder, true, true>((PG8_LAS unsigned char*)lds, g, S1, EpiPartial{slab, cnt});
        tail_reduce(E, slab, cnt, (int)gridDim.x, (int)blockIdx.x, N / 256, MTOK / 256); }
}
__global__ void __launch_bounds__(NTHREADS, 2) mega_fwd(Params p) {
    extern __shared__ __attribute__((aligned(16))) unsigned char lds[];
    LAS unsigned char* L = (LAS unsigned char*)lds;
    for (int u = threadIdx.x; u < (LDS_BYTES - LDSCTL_OFF) / 4; u += NTHREADS) ((LAS unsigned*)(L + LDSCTL_OFF))[u] = 0u;
    __syncthreads();
    volatile LAS unsigned* MISC = (volatile LAS unsigned*)(L + MISC_OFF);
    const XcdBarrier bar = xcd_barrier_post((unsigned*)(p.ws + WS_CTL) + CW_BAR, MISC + 8);
    const int G = gridDim.x, bx = blockIdx.x; const int vcu = (G % 8 == 0) ? (bx % 8) * (G / 8) + bx / 8 : bx;
    unsigned char* ws = p.ws;
    const bf16_t* XN = (const bf16_t*)(ws + WS_XN); const bf16_t* UH = (const bf16_t*)(ws + WS_UH); const bf16_t* Hh = (const bf16_t*)(ws + WS_H); const bf16_t* Ob = (const bf16_t*)(ws + WS_O);
    float* SW0 = (float*)(ws + WS_SW); float* SWC = SW0 + (size_t)NCLS * 2 * DFF; float* SW1 = SWC + (size_t)NCLS * CIN;
    float* SSQ = (float*)(ws + WS_SSQ); float* Y = p.out + O_Y; unsigned* SPLITC = (unsigned*)(ws + WS_CTL) + CW_SPLIT;
#define WAVE_IDS() const int tid_ = tid_opaque(); const int lane_ = tid_ & 63; const int gw_ = bx * NWAVES + (tid_ >> 6); const int NGW_ = G * NWAVES
    p0_weights(p, L, vcu, G); phase_mod(p, (char*)lds, bx, G);
    xcd_barrier(bar);
    phase_norm0(p, (char*)lds, bx, G);
    xcd_barrier(bar);
    gemm_call(L, XN, (const bf16_t*)(ws + WB_AB), ABMAIN, DM, EpiAB{(bf16_t*)(ws + WS_UPRE), (bf16_t*)(ws + WS_QKVO)}); xcd_barrier(bar);
    ml_phase_A(p, lds, vcu, G);
    { WAVE_IDS(); sw_job(p, (const bf16_t*)(ws + WB_FFI0), 2 * DFF, 0, 3, SW0, 2 * DFF, 1, gw_, NGW_, lane_); sw_job(p, (const bf16_t*)(ws + WB_INC), CIN, 1, 0, SWC, CIN, 0, gw_, NGW_, lane_);
      sw_job(p, (const bf16_t*)(ws + WB_FFI1), 2 * DFF, 1, 3, SW1, 2 * DFF, 1, gw_, NGW_, lane_); }
    xcd_barrier(bar);
    { WAVE_IDS(); MlScan sc{p}; for (long i = bx * (long)NTHREADS + tid_; i < MlScan::count(); i += (long)G * NTHREADS) sc(i); } xcd_barrier(bar);
    ml_phase_C(p, lds, vcu, G);
    { constexpr int NU_ML = NLB * MH * NBLK + NCB * MH; const int nsecond = NU_ML > G ? NU_ML - G : 0;
      if (nsecond < G) phase_conv(p, (char*)lds, vcu >= nsecond ? vcu - nsecond : -1, G - nsecond); else phase_conv(p, (char*)lds, vcu, G); }
    xcd_barrier(bar);
    gemm_call_split(L, UH, (const bf16_t*)(ws + WB_OUTAB), DM, DM, EpiRes{p.xp, p.xs, (bf16_t*)(ws + WS_Y16), (bf16_t*)(ws + WS_XN), SSQ + 0 * SSQ_STRIDE, modv(p, 0, 0, 2), modv(p, 0, 0, 4), p.n2g, 1, 0}, (unsigned char*)Y, SPLITC + 0 * 4096); xcd_barrier(bar);
    gemm_call(L, XN, (const bf16_t*)(ws + WB_FFI0), 2 * DFF, DM, EpiFfnIn{(bf16_t*)(ws + WS_H), SSQ + 0 * SSQ_STRIDE, SW0}); xcd_barrier(bar);
    gemm_call_split(L, Hh, (const bf16_t*)(ws + WB_FFO0), DM, DFF, EpiRes{p.xp, p.xs, (bf16_t*)(ws + WS_Y16), (bf16_t*)(ws + WS_XN), SSQ + 1 * SSQ_STRIDE, modv(p, 0, 0, 5), modv(p, 1, 0, 1), p.n1g + DM, 0, 0}, (unsigned char*)Y + SLAB_BYTES, SPLITC + 1 * 4096); xcd_barrier(bar);
    gemm_call(L, XN, (const bf16_t*)(ws + WB_INC), CIN, DM, EpiQkv{(bf16_t*)(ws + WS_QRAW), (bf16_t*)(ws + WS_KRAW), (bf16_t*)(ws + WS_CTXV), (bf16_t*)(ws + WS_LATV), p.out + O_V, SSQ + 1 * SSQ_STRIDE, SWC}); xcd_barrier(bar);
    { WAVE_IDS(); phase_qkpost(p, gw_, NGW_, lane_); phase_cachecvt(p, bx * NTHREADS + tid_, G * NTHREADS); } xcd_barrier(bar);
    attn_phase(p, lds, vcu, G); xcd_barrier(bar);
    gemm_call_split(L, Ob, (const bf16_t*)(ws + WB_OUTC), DM, DM, EpiRes{p.xp, p.xs, (bf16_t*)(ws + WS_Y16), (bf16_t*)(ws + WS_XN), SSQ + 2 * SSQ_STRIDE, modv(p, 1, 0, 2), modv(p, 1, 0, 4), p.n2g + DM, 0, 0}, (unsigned char*)Y, SPLITC + 2 * 4096); xcd_barrier(bar);
    gemm_call(L, XN, (const bf16_t*)(ws + WB_FFI1), 2 * DFF, DM, EpiFfnIn{(bf16_t*)(ws + WS_H), SSQ + 2 * SSQ_STRIDE, SW1}); xcd_barrier(bar);
    gemm_call_split(L, Hh, (const bf16_t*)(ws + WB_FFO1), DM, DFF, EpiRes{p.xp, p.xs, (bf16_t*)(ws + WS_Y16), (bf16_t*)(ws + WS_XN), SSQ + 3 * SSQ_STRIDE, modv(p, 1, 0, 5), modv(p, 1, 0, 1), nullptr, 0, 0}, (unsigned char*)Y + SLAB_BYTES, SPLITC + 3 * 4096); xcd_barrier(bar);
    { WAVE_IDS(); phase_final(p, gw_, NGW_, lane_); }
#undef WAVE_IDS
}
static Params make_params(void* const* d_in, void* d_out, void* d_ws) {
    Params p{}; const float** pp = (const float**)&p; for (int i = 0; i < 28; ++i) pp[i] = (const float*)d_in[i];
    p.out = (float*)d_out; p.ws = (unsigned char*)d_ws; return p;
}
extern "C" void kernel_launch(void* const* d_in, const int* in_sizes, int n_in, void* d_out, int out_size, void* d_ws, size_t ws_size, hipStream_t stream) {
    static int grid = 0;
    if (grid == 0) {
        if (n_in != 28 || (size_t)out_size != O_END || ws_size < WS_END || in_sizes[0] != MC * DM || in_sizes[1] != ML * DM) {
            fprintf(stderr, "kernel_launch: shape mismatch n_in %d out %d (want %zu) ws %zu (want %zu)\n", n_in, out_size, (size_t)O_END, ws_size, (size_t)WS_END); grid = -1; return; }
        int dev = 0, cus = 0;
        if (hipGetDevice(&dev) != hipSuccess || hipDeviceGetAttribute(&cus, hipDeviceAttributeMultiprocessorCount, dev) != hipSuccess) { grid = -1; return; }
        if (hipFuncSetAttribute((const void*)mega_fwd, hipFuncAttributeMaxDynamicSharedMemorySize, LDS_BYTES) != hipSuccess) { fprintf(stderr, "hipFuncSetAttribute failed\n"); grid = -1; return; }
        int per_cu = 0; (void)hipOccupancyMaxActiveBlocksPerMultiprocessor(&per_cu, (const void*)mega_fwd, NTHREADS, LDS_BYTES); (void)hipGetLastError();
        if (per_cu < 1) fprintf(stderr, "kernel_launch: occupancy query says %d blocks/CU\n", per_cu);
        grid = cus;
    }
    if (grid < 0) return;
    hipMemsetAsync((char*)d_ws + WS_CTL, 0, CTL_ZERO_BYTES, stream);
    Params p = make_params(d_in, d_out, d_ws);
    hipLaunchKernelGGL(mega_fwd, dim3(grid), dim3(NTHREADS), LDS_BYTES, stream, p);
}
```

```cpp
#ifdef HOST_TEST
#include <cmath>
#include <cstdio>
#include <cstdlib>
#include <cstring>
#include <cstdint>
#include <vector>
#define HD_FN inline
#define DEV_FN inline
#else
#include <hip/hip_runtime.h>
#include <cstdio>
#include <cstdint>
#define HD_FN __host__ __device__ __forceinline__
#define DEV_FN __device__ __forceinline__
#endif

#ifdef TINY
constexpr int DM = 512, NCB = 2, CSEQ = 128, NLB = 2, LSEQ = 128, PAST = 128;
#else
constexpr int DM = 1024, NCB = 16, CSEQ = 256, NLB = 4, LSEQ = 4096, PAST = 256;
#endif
constexpr int GRIDW = 64, CCH = DM / 2, CWID = 31, MH = 4, MDK = CCH / MH, MW = CCH, NGATE = 16;
constexpr int ABIN = 2 * CCH + 4 * MW + NGATE, ABMAIN = 2 * CCH + 4 * MW;
constexpr int HDIM = 128, NQ = DM / HDIM, NKV = 2, GRP = NQ / NKV, CIN = (NQ + 2 * NKV) * HDIM;
constexpr int DFF = ((8 * DM + 3 * 256 - 1) / (3 * 256)) * 256;
constexpr int MC = NCB * CSEQ, ML = NLB * LSEQ, MTOK = MC + ML, NCLS = 1 + NLB, SKVL = LSEQ + PAST;
constexpr float EPSF = 1e-6f;
constexpr int NSEQ = NCB + NLB;

constexpr size_t O_Y = 0, O_C = (size_t)MTOK * DM, O_N = O_C + (size_t)NCB * 2 * MH * MDK * MDK, O_M = O_N + (size_t)NCB * 2 * MH * MDK,
                 O_K = O_M + (size_t)NCB * 2 * MH, O_V = O_K + (size_t)NCB * CSEQ * NKV * HDIM, O_END = O_V + (size_t)NCB * CSEQ * NKV * HDIM;

constexpr size_t MiB = 1u << 20;
#ifdef TINY
constexpr size_t WSCALE = 1;
#endif
constexpr size_t WS_CTL = 0, CTL_ZERO_BYTES = 1 * MiB;
constexpr size_t WS_MOD = 1 * MiB;
constexpr size_t WS_SW = WS_MOD + 256 * 1024;
constexpr size_t WS_SSQ = 512 * 1024;
constexpr int SSQ_STRIDE = 32768;
constexpr size_t WS_DEN = 232 * MiB;
constexpr size_t WS_WB = 2 * MiB;
constexpr size_t WS_XN = 50 * MiB;
constexpr size_t WS_UPRE = 90 * MiB;
constexpr size_t WS_QKVO = 110 * MiB;
constexpr size_t WS_UH = 190 * MiB;
constexpr size_t WS_GATES = 230 * MiB;
constexpr size_t WS_HS = 50 * MiB;
constexpr size_t WS_Y16 = 90 * MiB;
constexpr size_t WS_H = 130 * MiB;
constexpr size_t WS_QRAW = 130 * MiB;
constexpr size_t WS_LATK = 170 * MiB, WS_LATV = 179 * MiB, WS_CTXK = 188 * MiB, WS_CTXV = 190 * MiB;
constexpr size_t WS_KRAW = 192 * MiB;
constexpr size_t WS_O = 202 * MiB;
constexpr size_t WS_END = 256 * MiB;

typedef unsigned short bf16_t;
HD_FN float bf2f(bf16_t h) { unsigned u = (unsigned)h << 16; return __builtin_bit_cast(float, u); }
HD_FN bf16_t f2bf(float f) { unsigned u = __builtin_bit_cast(unsigned, f); return (bf16_t)((u + 0x7fffu + ((u >> 16) & 1u)) >> 16); }
HD_FN float rbf(float f) { return bf2f(f2bf(f)); }
HD_FN float sigmoidf_(float x) { return 1.0f / (1.0f + expf(-x)); }
HD_FN float siluf_(float x) { return x * sigmoidf_(x); }
HD_FN float logsigmoidf_(float x) { return x >= 0.f ? -log1pf(expf(-x)) : x - log1pf(expf(x)); }
HD_FN int cls_of(int row) { return row < MC ? 0 : 1 + (row - MC) / LSEQ; }
HD_FN int seqlen_of(int row) { return row < MC ? CSEQ : LSEQ; }
HD_FN int pos_of(int row) { return row < MC ? row % CSEQ : (row - MC) % LSEQ; }

struct Params {
    const float *xp, *xs, *c, *stC, *stn, *stm, *ck, *cv, *cctx, *wmod, *bmod, *n1g, *n2g, *winab, *bgate, *convw, *convb, *lng, *lnb, *mng,
        *woutab, *winc, *qng, *kng, *woutc, *wffi, *wffo, *fng;
    float* out; unsigned char* ws;
};
HD_FN const float* xrow(const Params& p, int row) { return row < MC ? p.xp + (size_t)row * DM : p.xs + (size_t)(row - MC) * DM; }
HD_FN const float* modv(const Params& p, int l, int cls, int which) { return (const float*)(p.ws + WS_MOD) + ((size_t)(l * NCLS + cls) * 6 + which) * DM; }
constexpr size_t WS_RS0 = 233 * MiB;

struct NMod {
    Params p; static HD_FN long count() { return 2L * NCLS * 6 * DM; }
    HD_FN void operator()(long idx) const {
        const int col = (int)(idx % (6 * DM)); const int cls = (int)((idx / (6 * DM)) % NCLS); const int l = (int)(idx / (6 * DM * NCLS));
        const float* cond = cls == 0 ? p.cctx : p.c + (size_t)(cls - 1) * DM;
        const float* w = p.wmod + (size_t)l * DM * 6 * DM;
        float acc = 0.f;
        for (int k = 0; k < DM; ++k) acc += siluf_(cond[k]) * w[(size_t)k * 6 * DM + col];
        ((float*)(p.ws + WS_MOD))[idx] = acc + p.bmod[(size_t)l * 6 * DM + col];
    }
};
struct NNorm0a {
    Params p; static HD_FN long count() { return MTOK; }
    HD_FN void operator()(long row) const {
        const float* x = xrow(p, (int)row); float s = 0.f;
        for (int k = 0; k < DM; ++k) s += x[k] * x[k];
        ((float*)(p.ws + WS_RS0))[row] = 1.0f / sqrtf(s / DM + EPSF);
    }
};
struct NNorm0b {
    Params p; static HD_FN long count() { return (long)MTOK * DM; }
    HD_FN void operator()(long idx) const {
        const int row = (int)(idx / DM), col = (int)(idx % DM), cls = cls_of(row);
        const float rs = ((const float*)(p.ws + WS_RS0))[row];
        const float v = xrow(p, row)[col] * rs * p.n1g[col] * (1.f + modv(p, 0, cls, 1)[col]) + modv(p, 0, cls, 0)[col];
        ((bf16_t*)(p.ws + WS_XN))[idx] = f2bf(v);
    }
};
struct NGates {
    Params p; static HD_FN long count() { return (long)MTOK * NGATE; }
    HD_FN void operator()(long idx) const {
        const int row = (int)(idx / NGATE), j = (int)(idx % NGATE), cls = cls_of(row);
        const float rs = ((const float*)(p.ws + WS_RS0))[row]; const float* x = xrow(p, row);
        const float* sc = modv(p, 0, cls, 1); const float* sh = modv(p, 0, cls, 0);
        float acc = 0.f;
        for (int k = 0; k < DM; ++k) { const float h = x[k] * rs * p.n1g[k] * (1.f + sc[k]) + sh[k]; acc += h * p.winab[(size_t)k * ABIN + ABMAIN + j]; }
        acc += p.bgate[j];
        if ((j & 7) >= 4) acc = logsigmoidf_(acc);
        ((float*)(p.ws + WS_GATES))[idx] = acc;
    }
};

template <bool DUAL, class Epi> struct NGemm {
    const bf16_t* A; const float* B; int lda, ldb, K, N, off2, pad_; Epi epi;
    HD_FN long count() const { return (long)(MTOK / 4) * (N / 4); }
    HD_FN void operator()(long idx) const {
        const int nt = (int)(idx % (N / 4)), mt = (int)(idx / (N / 4)); const int m0 = mt * 4, n0 = nt * 4;
        float acc[4][4], acc2[4][4];
#pragma unroll
        for (int i = 0; i < 4; ++i)
#pragma unroll
            for (int j = 0; j < 4; ++j) { acc[i][j] = 0.f; acc2[i][j] = 0.f; }
        for (int k0 = 0; k0 < K; k0 += 8) {
            float a[4][8];
#pragma unroll
            for (int i = 0; i < 4; ++i) {
                const bf16_t* ap = A + (size_t)(m0 + i) * lda + k0;
#pragma unroll
                for (int kk = 0; kk < 8; ++kk) a[i][kk] = bf2f(ap[kk]);
            }
#pragma unroll
            for (int kk = 0; kk < 8; ++kk) {
                const float* bp = B + (size_t)(k0 + kk) * ldb + n0;
                float b[4], b2[4];
#pragma unroll
                for (int j = 0; j < 4; ++j) { b[j] = rbf(bp[j]); b2[j] = DUAL ? rbf(bp[off2 + j]) : 0.f; }
#pragma unroll
                for (int i = 0; i < 4; ++i)
#pragma unroll
                    for (int j = 0; j < 4; ++j) { acc[i][j] += a[i][kk] * b[j]; if (DUAL) acc2[i][j] += a[i][kk] * b2[j]; }
            }
        }
#pragma unroll
        for (int i = 0; i < 4; ++i)
#pragma unroll
            for (int j = 0; j < 4; ++j) epi(m0 + i, n0 + j, acc[i][j], acc2[i][j]);
    }
};
struct EGlu { Params p; HD_FN void operator()(int row, int col, float v, float v2) const { ((bf16_t*)(p.ws + WS_UPRE))[(size_t)row * CCH + col] = f2bf(v * sigmoidf_(v2)); } };
struct EQkvo { Params p; HD_FN void operator()(int row, int col, float v, float) const {
        const int part = col / MW; if (part == 1) v *= 1.0f / sqrtf((float)MDK); if (part == 3) v = sigmoidf_(v);
        ((bf16_t*)(p.ws + WS_QKVO))[(size_t)row * 4 * MW + col] = f2bf(v); } };
struct EOut { Params p; int l; int pad_ = 0; HD_FN void operator()(int row, int col, float v, float) const {
        const int cls = cls_of(row); float* Y = p.out + O_Y + (size_t)row * DM + col;
        const float xin = l == 0 ? xrow(p, row)[col] : *Y;
        const float x1 = xin + modv(p, l, cls, 2)[col] * v; *Y = x1;
        ((bf16_t*)(p.ws + WS_XN))[(size_t)row * DM + col] = f2bf(x1 * p.n2g[(size_t)l * DM + col] * (1.f + modv(p, l, cls, 4)[col])); } };
struct EFfnIn { Params p; const float* sw; int slot; int pad_ = 0; HD_FN void operator()(int row, int col, float v, float v2) const {
        const int cls = cls_of(row); const float rs = 1.0f / sqrtf(((const float*)(p.ws + WS_SSQ))[(size_t)slot * SSQ_STRIDE + row] / DM + EPSF);
        const float a = v * rs + sw[(size_t)cls * 2 * DFF + col], b = v2 * rs + sw[(size_t)cls * 2 * DFF + DFF + col];
        ((bf16_t*)(p.ws + WS_H))[(size_t)row * DFF + col] = f2bf(siluf_(a) * b); } };
struct EFfnOut { Params p; int l; int pad_ = 0; HD_FN void operator()(int row, int col, float v, float) const {
        const int cls = cls_of(row); float* Y = p.out + O_Y + (size_t)row * DM + col;
        const float x2 = *Y + modv(p, l, cls, 5)[col] * v; *Y = x2;
        if (l == 0) ((bf16_t*)(p.ws + WS_XN))[(size_t)row * DM + col] = f2bf(x2 * p.n1g[(size_t)DM + col] * (1.f + modv(p, 1, cls, 1)[col])); } };
struct EQkv { Params p; const float* sw; int slot; int pad_ = 0; HD_FN void operator()(int row, int col, float v, float) const {
        const int cls = cls_of(row); const float rs = 1.0f / sqrtf(((const float*)(p.ws + WS_SSQ))[(size_t)slot * SSQ_STRIDE + row] / DM + EPSF);
        const float a = v * rs + sw[(size_t)cls * CIN + col];
        if (col < NQ * HDIM) ((bf16_t*)(p.ws + WS_QRAW))[(size_t)row * NQ * HDIM + col] = f2bf(a);
        else if (col < (NQ + NKV) * HDIM) ((bf16_t*)(p.ws + WS_KRAW))[(size_t)row * NKV * HDIM + (col - NQ * HDIM)] = f2bf(a);
        else { const int c2 = col - (NQ + NKV) * HDIM;
            if (row < MC) { ((bf16_t*)(p.ws + WS_CTXV))[(size_t)row * NKV * HDIM + c2] = f2bf(a); p.out[O_V + (size_t)row * NKV * HDIM + c2] = a; }
            else { const int b = (row - MC) / LSEQ, s = (row - MC) % LSEQ; ((bf16_t*)(p.ws + WS_LATV))[((size_t)b * SKVL + s) * NKV * HDIM + c2] = f2bf(a); } } } };

struct NSsq {
    Params p; int slot; int pad_ = 0; static HD_FN long count() { return MTOK; }
    HD_FN void operator()(long row) const { const float* y = p.out + O_Y + (size_t)row * DM; float s = 0.f; for (int k = 0; k < DM; ++k) s += y[k] * y[k];
        ((float*)(p.ws + WS_SSQ))[(size_t)slot * SSQ_STRIDE + row] = s; }
};
struct NSW {
    Params p; const float* W; float* sw; int l, which, N, pad_; HD_FN long count() const { return (long)NCLS * N; }
    HD_FN void operator()(long idx) const { const int n = (int)(idx % N), cls = (int)(idx / N); const float* sh = modv(p, l, cls, which); float acc = 0.f;
        for (int k = 0; k < DM; ++k) acc += sh[k] * rbf(W[(size_t)k * N + n]); sw[idx] = acc; }
};
struct NConv {
    Params p; static HD_FN long count() { return (long)MTOK * CCH; }
    HD_FN void operator()(long idx) const {
        const int row = (int)(idx / CCH), c = (int)(idx % CCH), pos = pos_of(row), len = seqlen_of(row);
        const bf16_t* U = (const bf16_t*)(p.ws + WS_UPRE); float acc = p.convb[c];
        for (int j = 0; j < CWID; ++j) { const int t = pos + j - CWID / 2; if (t >= 0 && t < len) acc += p.convw[(size_t)j * CCH + c] * bf2f(U[(size_t)(row + j - CWID / 2) * CCH + c]); }
        ((float*)(p.ws + WS_HS))[idx] = acc;
    }
};
struct NConvLN {
    Params p; static HD_FN long count() { return MTOK; }
    HD_FN void operator()(long row) const {
        const float* t = (const float*)(p.ws + WS_HS) + (size_t)row * CCH; float mu = 0.f;
        for (int c = 0; c < CCH; ++c) mu += t[c]; mu /= CCH; float var = 0.f;
        for (int c = 0; c < CCH; ++c) { const float d = t[c] - mu; var += d * d; } var /= CCH;
        const float rs = 1.0f / sqrtf(var + EPSF); bf16_t* UH = (bf16_t*)(p.ws + WS_UH) + (size_t)row * DM;
        for (int c = 0; c < CCH; ++c) UH[c] = f2bf(siluf_((t[c] - mu) * rs * p.lng[c] + p.lnb[c]));
    }
};
HD_FN int seq_base(int sid) { return sid < NCB ? sid * CSEQ : MC + (sid - NCB) * LSEQ; }
struct NMlstmDen {
    Params p; static HD_FN long count() { return (long)NSEQ * MH * 2; }
    HD_FN void operator()(long idx) const {
        const int dir = (int)(idx % 2), h = (int)((idx / 2) % MH), sid = (int)(idx / (2 * MH)); const bool isctx = sid < NCB;
        const int base = seq_base(sid), len = isctx ? CSEQ : LSEQ;
        float n[MDK]; float mrun = 0.f;
        if (isctx) {
#pragma unroll
            for (int d = 0; d < MDK; ++d) n[d] = 0.f;
        } else { const int b = sid - NCB; const float em = expf(p.stm[(size_t)(b * 2 + dir) * MH + h]);
#pragma unroll
            for (int d = 0; d < MDK; ++d) n[d] = p.stn[((size_t)(b * 2 + dir) * MH + h) * MDK + d] * em; }
        const bf16_t* QK = (const bf16_t*)(p.ws + WS_QKVO); const float* G = (const float*)(p.ws + WS_GATES); float* DEN = (float*)(p.ws + WS_DEN);
        for (int t = 0; t < len; ++t) {
            const int row = base + (dir == 0 ? t : len - 1 - t);
            const float ig = G[(size_t)row * NGATE + dir * 8 + h], lf = G[(size_t)row * NGATE + dir * 8 + 4 + h];
            const float f = expf(lf), ei = expf(ig); mrun = fmaxf(mrun + lf, ig);
            const bf16_t* q = QK + (size_t)row * 4 * MW + h * MDK; const bf16_t* k = q + MW; float den = 0.f;
#pragma unroll
            for (int d = 0; d < MDK; ++d) { n[d] = f * n[d] + ei * bf2f(k[d]); den += bf2f(q[d]) * n[d]; }
            DEN[((size_t)dir * MTOK + row) * MH + h] = den;
        }
        if (isctx) { const float em = expf(-mrun); p.out[O_M + (size_t)(sid * 2 + dir) * MH + h] = mrun;
#pragma unroll
            for (int d = 0; d < MDK; ++d) p.out[O_N + ((size_t)(sid * 2 + dir) * MH + h) * MDK + d] = n[d] * em; }
    }
};
struct NMlstmNum {
    Params p; int dir; int pad_ = 0; static HD_FN long count() { return (long)NSEQ * MH * MDK; }
    HD_FN void operator()(long idx) const {
        const int v = (int)(idx % MDK), h = (int)((idx / MDK) % MH), sid = (int)(idx / (MDK * MH)); const bool isctx = sid < NCB;
        const int base = seq_base(sid), len = isctx ? CSEQ : LSEQ;
        float C[MDK];
        if (isctx) {
#pragma unroll
            for (int d = 0; d < MDK; ++d) C[d] = 0.f;
        } else { const int b = sid - NCB; const float em = expf(p.stm[(size_t)(b * 2 + dir) * MH + h]);
#pragma unroll
            for (int d = 0; d < MDK; ++d) C[d] = p.stC[(((size_t)(b * 2 + dir) * MH + h) * MDK + d) * MDK + v] * em; }
        const bf16_t* QK = (const bf16_t*)(p.ws + WS_QKVO); const float* G = (const float*)(p.ws + WS_GATES); const float* DEN = (const float*)(p.ws + WS_DEN);
        float* HS = (float*)(p.ws + WS_HS);
        for (int t = 0; t < len; ++t) {
            const int row = base + (dir == 0 ? t : len - 1 - t);
            const float ig = G[(size_t)row * NGATE + dir * 8 + h], lf = G[(size_t)row * NGATE + dir * 8 + 4 + h];
            const float f = expf(lf), ei = expf(ig);
            const bf16_t* q = QK + (size_t)row * 4 * MW + h * MDK; const bf16_t* k = q + MW; const float vv = bf2f(q[2 * MW + v]) * ei; float num = 0.f;
#pragma unroll
            for (int d = 0; d < MDK; ++d) { C[d] = f * C[d] + bf2f(k[d]) * vv; num += bf2f(q[d]) * C[d]; }
            const float den = DEN[((size_t)dir * MTOK + row) * MH + h]; const float hv = num / fmaxf(fabsf(den), 1.0f);
            float* o = HS + (size_t)row * MW + h * MDK + v; if (dir == 0) *o = hv; else *o += hv;
        }
        if (isctx) { const float em = expf(-p.out[O_M + (size_t)(sid * 2 + dir) * MH + h]);
#pragma unroll
            for (int d = 0; d < MDK; ++d) p.out[O_C + (((size_t)(sid * 2 + dir) * MH + h) * MDK + d) * MDK + v] = C[d] * em; }
    }
};
struct NHm {
    Params p; static HD_FN long count() { return (long)MTOK * MH; }
    HD_FN void operator()(long idx) const {
        const int row = (int)(idx / MH), h = (int)(idx % MH); const float* x = (const float*)(p.ws + WS_HS) + (size_t)row * MW + h * MDK; float s = 0.f;
        for (int v = 0; v < MDK; ++v) s += x[v] * x[v];
        const float rs = 1.0f / sqrtf(s / MDK + EPSF); const bf16_t* og = (const bf16_t*)(p.ws + WS_QKVO) + (size_t)row * 4 * MW + 3 * MW + h * MDK;
        bf16_t* UH = (bf16_t*)(p.ws + WS_UH) + (size_t)row * DM + CCH + h * MDK;
        for (int v = 0; v < MDK; ++v) UH[v] = f2bf(bf2f(og[v]) * x[v] * rs * p.mng[h * MDK + v]);
    }
};
struct NCacheCvt {
    Params p; static HD_FN long count() { return (long)NLB * PAST * NKV * HDIM; }
    HD_FN void operator()(long idx) const { const int e = (int)(idx % (NKV * HDIM)), pp = (int)((idx / (NKV * HDIM)) % PAST), b = (int)(idx / ((long)NKV * HDIM * PAST));
        const size_t dst = ((size_t)b * SKVL + LSEQ + pp) * NKV * HDIM + e;
        ((bf16_t*)(p.ws + WS_LATK))[dst] = f2bf(p.ck[idx]); ((bf16_t*)(p.ws + WS_LATV))[dst] = f2bf(p.cv[idx]); }
};
struct NQkPost {
    Params p; static HD_FN long count() { return (long)MTOK * (NQ + NKV); }
    HD_FN void operator()(long idx) const {
        const int row = (int)(idx / (NQ + NKV)), j = (int)(idx % (NQ + NKV)); const bool isq = j < NQ; const bool lat = row >= MC;
        bf16_t* src = isq ? (bf16_t*)(p.ws + WS_QRAW) + (size_t)row * NQ * HDIM + j * HDIM : (bf16_t*)(p.ws + WS_KRAW) + (size_t)row * NKV * HDIM + (j - NQ) * HDIM;
        const float* g = isq ? p.qng : p.kng; float s = 0.f;
        for (int d = 0; d < HDIM; ++d) { const float x = bf2f(src[d]); s += x * x; }
        const float rs = 1.0f / sqrtf(s / HDIM + EPSF);
        bf16_t* dst; float* fo = nullptr;
        if (isq) dst = src;
        else if (!lat) { dst = (bf16_t*)(p.ws + WS_CTXK) + (size_t)row * NKV * HDIM + (j - NQ) * HDIM; fo = p.out + O_K + (size_t)row * NKV * HDIM + (j - NQ) * HDIM; }
        else { const int b = (row - MC) / LSEQ, sp = (row - MC) % LSEQ; dst = (bf16_t*)(p.ws + WS_LATK) + ((size_t)b * SKVL + sp) * NKV * HDIM + (j - NQ) * HDIM; }
        const int sp = pos_of(row); const float prow = (float)(sp / GRIDW), pcol = (float)(sp % GRIDW);
        for (int half = 0; half < 2; ++half)
            for (int d = 0; d < HDIM / 4; ++d) {
                const int i1 = half * (HDIM / 2) + d, i2 = i1 + HDIM / 4;
                const float x1 = bf2f(src[i1]) * rs * g[i1], x2 = bf2f(src[i2]) * rs * g[i2]; float y1 = x1, y2 = x2;
                if (lat) { const float inv = powf(10000.0f, -(float)d / (float)(HDIM / 4)); const float ang = (half == 0 ? prow : pcol) * inv; const float cs = cosf(ang), sn = sinf(ang);
                    y1 = x1 * cs - x2 * sn; y2 = x1 * sn + x2 * cs; }
                dst[i1] = f2bf(y1); dst[i2] = f2bf(y2); if (fo) { fo[i1] = y1; fo[i2] = y2; }
            }
    }
};
struct NAttn {
    Params p; static HD_FN long count() { return (long)MTOK * NQ * 4; }
    HD_FN void operator()(long idx) const {
        const int sl = (int)(idx % 4), hq = (int)((idx / 4) % NQ), row = (int)(idx / (4 * NQ)); const int kv = hq / GRP;
        const bf16_t *Kb, *Vb; int nk;
        if (row < MC) { const int b = row / CSEQ; Kb = (const bf16_t*)(p.ws + WS_CTXK) + (size_t)b * CSEQ * NKV * HDIM; Vb = (const bf16_t*)(p.ws + WS_CTXV) + (size_t)b * CSEQ * NKV * HDIM; nk = CSEQ; }
        else { const int b = (row - MC) / LSEQ; Kb = (const bf16_t*)(p.ws + WS_LATK) + (size_t)b * SKVL * NKV * HDIM; Vb = (const bf16_t*)(p.ws + WS_LATV) + (size_t)b * SKVL * NKV * HDIM; nk = SKVL; }
        const bf16_t* qp = (const bf16_t*)(p.ws + WS_QRAW) + (size_t)row * NQ * HDIM + hq * HDIM;
        float q[HDIM];
#pragma unroll
        for (int d = 0; d < HDIM; ++d) q[d] = bf2f(qp[d]);
        float o[32];
#pragma unroll
        for (int e = 0; e < 32; ++e) o[e] = 0.f;
        float m = -1e30f, l = 0.f; const float scale = 1.0f / sqrtf((float)HDIM);
        for (int s = 0; s < nk; ++s) {
            const bf16_t* kp = Kb + (size_t)s * NKV * HDIM + kv * HDIM; float dot = 0.f;
#pragma unroll
            for (int d = 0; d < HDIM; ++d) dot += q[d] * bf2f(kp[d]);
            dot *= scale; const float mn = fmaxf(m, dot); const float al = expf(m - mn), pe = expf(dot - mn); m = mn; l = l * al + pe;
            const bf16_t* vp = Vb + (size_t)s * NKV * HDIM + kv * HDIM + sl * 32;
#pragma unroll
            for (int e = 0; e < 32; ++e) o[e] = o[e] * al + pe * bf2f(vp[e]);
        }
        bf16_t* op = (bf16_t*)(p.ws + WS_O) + (size_t)row * DM + hq * HDIM + sl * 32;
#pragma unroll
        for (int e = 0; e < 32; ++e) op[e] = f2bf(o[e] / l);
    }
};
struct NFinal {
    Params p; static HD_FN long count() { return (long)MTOK * DM; }
    HD_FN void operator()(long idx) const { const int row = (int)(idx / DM), col = (int)(idx % DM);
        const float rs = 1.0f / sqrtf(((const float*)(p.ws + WS_SSQ))[(size_t)3 * SSQ_STRIDE + row] / DM + EPSF); p.out[O_Y + idx] *= rs * p.fng[col]; }
};
constexpr int NWAVES = 8, NTHREADS = NWAVES * 64;
constexpr int RING_OFF = 0, RING_BYTES = 131072;
constexpr int LDSCTL_OFF = RING_BYTES, MISC_OFF = LDSCTL_OFF + 320;
constexpr int LDS_BYTES = 147456;
constexpr int CW_TMO = 0, CW_CODE = 1, CW_BAR = 4096;
__device__ __forceinline__ int tid_opaque() { int t = threadIdx.x; asm volatile("" : "+v"(t)); return t; }
template <int M> __device__ __forceinline__ float swz_xor(float v) { return __int_as_float(__builtin_amdgcn_ds_swizzle(__float_as_int(v), (M << 10) | 0x1f)); }
__device__ __forceinline__ float half_sum(float v) { auto rr = __builtin_amdgcn_permlane32_swap(__float_as_uint(v), __float_as_uint(v), false, false); return __uint_as_float(rr[0]) + __uint_as_float(rr[1]); }
__device__ __forceinline__ float half_max(float v) { auto rr = __builtin_amdgcn_permlane32_swap(__float_as_uint(v), __float_as_uint(v), false, false); return fmaxf(__uint_as_float(rr[0]), __uint_as_float(rr[1])); }
__device__ __forceinline__ float lane_get(float v, int src_lane) { return __int_as_float(__builtin_amdgcn_ds_bpermute(src_lane << 2, __float_as_int(v))); }
#define GAS __attribute__((address_space(1)))
#define LAS __attribute__((address_space(3)))
typedef GAS unsigned gu32;
#define RLX_AGENT __ATOMIC_RELAXED, __HIP_MEMORY_SCOPE_AGENT
#define XB_TMO      128
#define XB_XCNT(j)  (256  + 64 * (j))
#define XB_XSUB(j)  (1280 + 64 * (j))
#define XB_XGEN(j)  (2304 + 64 * (j))
#define XB_TOP      3328
#define XB_TOPGEN   3392
#define XCD_BAR_WORDS 3456
#define XB_SPIN_CAP (1u << 22)
__device__ __forceinline__ unsigned xb_ld(unsigned* p)              { return __hip_atomic_load(p, __ATOMIC_RELAXED, __HIP_MEMORY_SCOPE_AGENT); }
__device__ __forceinline__ unsigned xb_add(unsigned* p, unsigned v) { return __hip_atomic_fetch_add(p, v, __ATOMIC_RELAXED, __HIP_MEMORY_SCOPE_AGENT); }
__device__ __forceinline__ unsigned xb_xcc_id() { return (unsigned)__builtin_amdgcn_s_getreg((3 << 11) | 20) & 0xFu; }
#define XB_SPIN(cond, bar) do { unsigned _sp = 0; while (cond) { __builtin_amdgcn_s_sleep(1); \
    if ((++_sp & 255u) == 0u) { if (xb_ld(&(bar)[XB_TMO])) break; if (_sp > XB_SPIN_CAP) { atomicAdd(&(bar)[XB_TMO], 1u); break; } } } } while (0)
struct XcdBarrier { unsigned* bar; unsigned x; volatile LAS unsigned* st; };
__device__ __forceinline__ XcdBarrier xcd_barrier_post(unsigned* bar, volatile LAS unsigned* st) {
    XcdBarrier b; b.bar = bar; b.x = xb_xcc_id(); b.st = st;
    if (threadIdx.x == 0) (void)xb_add(&bar[XB_XCNT(b.x)], 1u);
    return b;
}
__device__ __forceinline__ void xcd_barrier_complete(unsigned* bar, unsigned x, unsigned& nloc, unsigned& nx) {
    const unsigned G = gridDim.x * gridDim.y * gridDim.z;
    unsigned sum, cnt, mine, sp = 0u;
    for (;;) {
        sum = 0u; cnt = 0u; mine = 0u;
#pragma unroll
        for (unsigned j = 0; j < 16; ++j) { const unsigned c = xb_ld(&bar[XB_XCNT(j)]); sum += c; cnt += (c > 0u) ? 1u : 0u; mine = (j == x) ? c : mine; }
        if (sum == G) break;
        __builtin_amdgcn_s_sleep(1);
        if ((++sp & 255u) == 0u) { if (xb_ld(&bar[XB_TMO])) break; if (sp > XB_SPIN_CAP) { atomicAdd(&bar[XB_TMO], 1u); break; } }
    }
    nloc = mine > 0u ? mine : 1u; nx = cnt > 0u ? cnt : 1u;
}
__device__ __forceinline__ void xcd_barrier(const XcdBarrier& b) {
    asm volatile("s_waitcnt vmcnt(0)" ::: "memory");
    __syncthreads();
    if (threadIdx.x == 0) {
        unsigned* bar = b.bar;
        __builtin_amdgcn_s_waitcnt(0);
        unsigned nloc = b.st[0], nx = b.st[1];
        if (nloc == 0u) { xcd_barrier_complete(bar, b.x, nloc, nx); b.st[0] = nloc; b.st[1] = nx; }
        const unsigned old = xb_add(&bar[XB_XSUB(b.x)], 1u);
        const unsigned gen = old / nloc;
        if (old + 1u == (gen + 1u) * nloc) {
            __builtin_amdgcn_fence(__ATOMIC_RELEASE, "agent");
            asm volatile("s_waitcnt vmcnt(0)" ::: "memory");
            const unsigned og = xb_add(&bar[XB_TOP], 1u);
            const unsigned tg = og / nx;
            if (og + 1u == (tg + 1u) * nx) xb_add(&bar[XB_TOPGEN], 1u);
            else XB_SPIN(xb_ld(&bar[XB_TOPGEN]) == tg, bar);
            __builtin_amdgcn_fence(__ATOMIC_ACQUIRE, "agent");
            xb_add(&bar[XB_XGEN(b.x)], 1u);
            asm volatile("s_waitcnt vmcnt(0)" ::: "memory");
        } else {
            XB_SPIN(xb_ld(&bar[XB_XGEN(b.x)]) == gen, bar);
            __builtin_amdgcn_fence(__ATOMIC_ACQUIRE, "agent");
            asm volatile("s_waitcnt vmcnt(0)" ::: "memory");
        }
    }
    __syncthreads();
}
namespace pg8 {
#define PG8_LAS __attribute__((address_space(3)))
typedef unsigned short bf16_t;
typedef short bf16x8 __attribute__((ext_vector_type(8)));
typedef float f32x4 __attribute__((ext_vector_type(4)));
typedef unsigned u32x4 __attribute__((ext_vector_type(4)));
constexpr int BM = 256, BK = 64, HALF = 128, HTB = HALF * BK * 2  , STAGE_BYTES = 8 * HTB, NXCD = 8, WGM = 8;

__host__ __device__ __forceinline__ int lds_byte(int r, int c) { const int st = (r >> 4) * 2 + (c >> 5), rr = r & 15, cc = c & 31, ob = rr * 64 + cc * 2; return st * 1024 + (ob ^ (((ob >> 9) & 1) << 5)); }
__host__ __device__ __forceinline__ void stage_rc(int b, int& R, int& C) { const int st = b / 1024, sb = b % 1024, swz = sb ^ (((sb >> 9) & 1) << 5); R = (st >> 1) * 16 + swz / 64; C = (st & 1) * 32 + (swz % 64) / 2; }
__host__ __device__ __forceinline__ int perm32(int rho) { const int n = rho >> 4, i = rho & 15; return 8 * (i >> 2) + 4 * n + (i & 3); }

struct Unit { int pm, pn, k0, nt, role, slot; };
struct Gemm { const bf16_t* A; const bf16_t* Bt; int M, N, K; };

struct StaticOrder {
    int nM, nN, nwg, G, c, ntK;
    __host__ __device__ void init(int M, int N, int K, int G_, int c_) { nM = M / BM; nN = N / BM; nwg = nM * nN; G = G_; c = c_; ntK = K / BK; }
    __host__ __device__ void map(int L, Unit& u) const { int wgid = L; { const int q = nwg / NXCD, r = nwg % NXCD, xcd = wgid % NXCD, off = wgid / NXCD; wgid = (xcd < r ? xcd * (q + 1) : r * (q + 1) + (xcd - r) * q) + off; }
        const int nig = WGM * nN, gid = wgid / nig, fm = gid * WGM, gsz = (nM - fm) < WGM ? (nM - fm) : WGM; u.pm = fm + ((wgid % nig) % gsz); u.pn = (wgid % nig) / gsz; }
    __host__ __device__ bool next(int i, Unit& u) const {
        const long L = (long)i * G + c; if (L >= nwg) return false;
        int wgid = (int)L; { const int q = nwg / NXCD, r = nwg % NXCD, xcd = wgid % NXCD, off = wgid / NXCD; wgid = (xcd < r ? xcd * (q + 1) : r * (q + 1) + (xcd - r) * q) + off; }
        const int nig = WGM * nN, gid = wgid / nig, fm = gid * WGM, gsz = (nM - fm) < WGM ? (nM - fm) : WGM;
        u.pm = fm + ((wgid % nig) % gsz); u.pn = (wgid % nig) / gsz; u.k0 = 0; u.nt = ntK; u.role = 0; u.slot = 0; return true;
    }
    __device__ __forceinline__ void a_ready(const Unit&) const {}
    __device__ __forceinline__ void done(const Unit&) const {}
};

__device__ __forceinline__ unsigned cvt_pk_bf16(float lo, float hi) { unsigned r; asm volatile("v_cvt_pk_bf16_f32 %0, %1, %2" : "=v"(r) : "v"(lo), "v"(hi)); return r; }
typedef float f32x2 __attribute__((ext_vector_type(2)));
template <class Epi, class Sched, bool ALIGN_EPI = false, bool SP2 = false>
__device__ __forceinline__ void gemm_phase(PG8_LAS unsigned char* lds, const Gemm g, const Sched& S, const Epi& E) {
    const int tid = tid_opaque(), wid = __builtin_amdgcn_readfirstlane(tid >> 6), lane = tid & 63, wr = wid >> 2, wc = wid & 3, fr = lane & 15, fq = lane >> 4;
    const int K = g.K;
    unsigned voffA[2], voffB[2];
#pragma unroll
    for (int i = 0; i < 2; ++i) { int R, C; stage_rc(tid * 16 + i * 8192, R, C); const int Rb = Epi::PERM ? ((R & ~31) + perm32(R & 31)) : R;
        voffA[i] = (unsigned)(R * K + C) * 2u; voffB[i] = (unsigned)(Rb * K + C) * 2u; }
    const size_t kstep = (size_t)(BK * 2);
    const size_t hstep = (size_t)HALF * K * 2;
    const size_t tstep = 2 * hstep;
    const unsigned ldsw = (unsigned)wid * 1024u;
    const int aoff = lds_byte(wr * 64 + fr, fq * 8), boff = lds_byte(wc * 32 + fr, fq * 8);
#define PG8_SA(b, h) (((b) * 2 + (h)) * HTB)
#define PG8_SB(b, h) ((4 + (b) * 2 + (h)) * HTB)
#define PG8_STAGE(bufoff, gbase, voff) do { _Pragma("unroll") for (int _i = 0; _i < 2; ++_i) \
        __builtin_amdgcn_global_load_lds((const unsigned*)((const char*)(gbase) + (voff)[_i]), (PG8_LAS unsigned*)(lds + (bufoff) + ldsw + _i * 8192), 16, 0, 0); } while (0)
#define PG8_LDA(dst, b, h) do { _Pragma("unroll") for (int m = 0; m < 4; ++m) _Pragma("unroll") for (int k = 0; k < 2; ++k) dst[m][k] = *(const PG8_LAS bf16x8*)(lds + PG8_SA(b, h) + aoff + m * 2048 + k * 1024); } while (0)
#define PG8_LDB(dst, b, h) do { _Pragma("unroll") for (int n = 0; n < 2; ++n) _Pragma("unroll") for (int k = 0; k < 2; ++k) dst[n][k] = *(const PG8_LAS bf16x8*)(lds + PG8_SB(b, h) + boff + n * 2048 + k * 1024); } while (0)
#define PG8_MMA(ai, bj, At, Bt) do { __builtin_amdgcn_s_setprio(1); _Pragma("unroll") for (int m = 0; m < 4; ++m) _Pragma("unroll") for (int n = 0; n < 2; ++n) _Pragma("unroll") for (int k = 0; k < 2; ++k) \
        acc[ai][bj][m][n] = __builtin_amdgcn_mfma_f32_16x16x32_bf16(Bt[n][k], At[m][k], acc[ai][bj][m][n], 0, 0, 0); __builtin_amdgcn_s_setprio(0); } while (0)
#define PG8_WAIT_V(n) asm volatile("s_waitcnt vmcnt(" #n ")" ::: "memory")
#define PG8_WAIT_L(n) asm volatile("s_waitcnt lgkmcnt(" #n ")" ::: "memory")
#define PG8_BAR __builtin_amdgcn_s_barrier()
#define PG8_SCHED __builtin_amdgcn_sched_barrier(0)
    Unit cur, nxt; int ui = 0;
    if (!S.next(0, cur)) return;
    f32x4 acc[2][2][4][2];
#pragma unroll
    for (int a = 0; a < 2; ++a)
#pragma unroll
        for (int b = 0; b < 2; ++b)
#pragma unroll
            for (int m = 0; m < 4; ++m)
#pragma unroll
                for (int n = 0; n < 2; ++n) acc[a][b][m][n] = (f32x4){0.f, 0.f, 0.f, 0.f};
    bf16x8 At[4][2], B0[2][2], B1[2][2];
    const char* cA = (const char*)g.A + (size_t)cur.pm * tstep + (size_t)cur.k0 * kstep; const char* cB = (const char*)g.Bt + (size_t)cur.pn * tstep + (size_t)cur.k0 * kstep; int nt = cur.nt;
    S.a_ready(cur);
    if constexpr (SP2) {
        PG8_STAGE(PG8_SB(0, 0), cB, voffB); PG8_STAGE(PG8_SB(0, 1), cB + hstep, voffB); PG8_STAGE(PG8_SA(0, 0), cA, voffA); PG8_STAGE(PG8_SA(0, 1), cA + hstep, voffA);
        if (wr == 1) PG8_BAR;
        PG8_WAIT_V(2); PG8_BAR;
        PG8_STAGE(PG8_SB(1, 0), cB + kstep, voffB); PG8_STAGE(PG8_SA(1, 0), cA + kstep, voffA); PG8_STAGE(PG8_SB(1, 1), cB + hstep + kstep, voffB);
        PG8_WAIT_V(6); PG8_BAR;
    } else {
        PG8_STAGE(PG8_SB(0, 0), cB, voffB); PG8_STAGE(PG8_SA(0, 0), cA, voffA); PG8_STAGE(PG8_SB(0, 1), cB + hstep, voffB); PG8_STAGE(PG8_SA(0, 1), cA + hstep, voffA);
        if (wr == 1) PG8_BAR;
        PG8_WAIT_V(4); PG8_BAR;
        PG8_STAGE(PG8_SB(1, 0), cB + kstep, voffB); PG8_STAGE(PG8_SA(1, 0), cA + kstep, voffA); PG8_STAGE(PG8_SB(1, 1), cB + hstep + kstep, voffB);
        PG8_WAIT_V(6); PG8_BAR;
    }
    for (;;) {
        const bool has_next = S.next(ui + 1, nxt);
        const char* nA = has_next ? (const char*)g.A + (size_t)nxt.pm * tstep + (size_t)nxt.k0 * kstep : cA; const char* nB = has_next ? (const char*)g.Bt + (size_t)nxt.pn * tstep + (size_t)nxt.k0 * kstep : cB;
        for (int t = 0; t < nt; t += 2) {
            const bool last = (t == nt - 2);
            const char* a1 = cA + (size_t)(t + 1) * kstep;
            const char* a2 = last ? nA : cA + (size_t)(t + 2) * kstep; const char* b2 = last ? nB : cB + (size_t)(t + 2) * kstep;
            const char* a3 = a2 + kstep; const char* b3 = b2 + kstep;
            if (last && has_next) S.a_ready(nxt);
            if constexpr (SP2) {
            PG8_LDB(B0, 0, 0); PG8_LDB(B1, 0, 1); PG8_SCHED; PG8_LDA(At, 0, 0); PG8_STAGE(PG8_SA(1, 1), a1 + hstep, voffA);
            PG8_WAIT_V(8); PG8_WAIT_L(0); PG8_BAR; PG8_MMA(0, 0, At, B0); PG8_MMA(0, 1, At, B1); PG8_BAR; PG8_SCHED;
            PG8_LDA(At, 0, 1); PG8_STAGE(PG8_SB(0, 0), b2, voffB); PG8_STAGE(PG8_SB(0, 1), b2 + hstep, voffB); PG8_STAGE(PG8_SA(0, 0), a2, voffA);
            PG8_WAIT_V(8); PG8_WAIT_L(0); PG8_BAR; PG8_MMA(1, 0, At, B0); PG8_MMA(1, 1, At, B1); PG8_BAR; PG8_SCHED;
            PG8_LDB(B0, 1, 0); PG8_LDB(B1, 1, 1); PG8_SCHED; PG8_LDA(At, 1, 0); PG8_STAGE(PG8_SA(0, 1), a2 + hstep, voffA);
            PG8_WAIT_V(8); PG8_WAIT_L(0); PG8_BAR; PG8_MMA(0, 0, At, B0); PG8_MMA(0, 1, At, B1); PG8_BAR; PG8_SCHED;
            PG8_LDA(At, 1, 1); PG8_STAGE(PG8_SB(1, 0), b3, voffB); PG8_STAGE(PG8_SB(1, 1), b3 + hstep, voffB); PG8_STAGE(PG8_SA(1, 0), a3, voffA);
            PG8_WAIT_V(8); PG8_WAIT_L(0); PG8_BAR; PG8_MMA(1, 0, At, B0); PG8_MMA(1, 1, At, B1); PG8_BAR; PG8_SCHED;
            } else {
            PG8_LDB(B0, 0, 0); PG8_SCHED; PG8_LDA(At, 0, 0); PG8_STAGE(PG8_SA(1, 1), a1 + hstep, voffA);
            PG8_WAIT_L(8); PG8_BAR; PG8_WAIT_L(0); PG8_MMA(0, 0, At, B0); PG8_BAR; PG8_SCHED;
            PG8_LDB(B1, 0, 1); PG8_STAGE(PG8_SB(0, 0), b2, voffB);
            PG8_BAR; PG8_WAIT_L(0); PG8_MMA(0, 1, At, B1); PG8_BAR;
            PG8_LDA(At, 0, 1); PG8_STAGE(PG8_SA(0, 0), a2, voffA);
            PG8_BAR; PG8_WAIT_L(0); PG8_MMA(1, 0, At, B0); PG8_BAR; PG8_SCHED;
            PG8_STAGE(PG8_SB(0, 1), b2 + hstep, voffB);
            PG8_WAIT_V(6); PG8_BAR; PG8_MMA(1, 1, At, B1); PG8_BAR;
            PG8_LDB(B0, 1, 0); PG8_SCHED; PG8_LDA(At, 1, 0); PG8_STAGE(PG8_SA(0, 1), a2 + hstep, voffA);
            PG8_WAIT_L(8); PG8_BAR; PG8_WAIT_L(0); PG8_MMA(0, 0, At, B0); PG8_BAR; PG8_SCHED;
            PG8_LDB(B1, 1, 1); PG8_STAGE(PG8_SB(1, 0), b3, voffB);
            PG8_BAR; PG8_WAIT_L(0); PG8_MMA(0, 1, At, B1); PG8_BAR;
            PG8_LDA(At, 1, 1); PG8_STAGE(PG8_SA(1, 0), a3, voffA);
            PG8_BAR; PG8_WAIT_L(0); PG8_MMA(1, 0, At, B0); PG8_BAR; PG8_SCHED;
            PG8_STAGE(PG8_SB(1, 1), b3 + hstep, voffB);
            PG8_WAIT_V(6); PG8_BAR; PG8_MMA(1, 1, At, B1); PG8_BAR;
            }
        }
        if constexpr (ALIGN_EPI) { if (wr == 0) PG8_BAR; }
        if constexpr (!Epi::AFTER_DRAIN) { E(acc, cur, wr, wc, fr, fq); S.done(cur); }
        if (!has_next) break;
#pragma unroll
        for (int a = 0; a < 2; ++a)
#pragma unroll
            for (int b = 0; b < 2; ++b)
#pragma unroll
                for (int m = 0; m < 4; ++m)
#pragma unroll
                    for (int n = 0; n < 2; ++n) acc[a][b][m][n] = (f32x4){0.f, 0.f, 0.f, 0.f};
        cur = nxt; cA = nA; cB = nB; nt = cur.nt; ++ui;
        if constexpr (ALIGN_EPI) { if (wr == 1) PG8_BAR; }
    }
    PG8_WAIT_V(0);
    if constexpr (!ALIGN_EPI) { if (wr == 0) PG8_BAR; }
    PG8_BAR;
    if constexpr (Epi::AFTER_DRAIN) { E.fused(acc, cur, wr, wc, fr, fq, lds, wid, lane); S.done(cur); }
#undef PG8_SA
#undef PG8_SB
#undef PG8_STAGE
#undef PG8_LDA
#undef PG8_LDB
#undef PG8_MMA
#undef PG8_WAIT_V
#undef PG8_WAIT_L
#undef PG8_BAR
#undef PG8_SCHED
}
}
constexpr size_t WB_AB = 2 * MiB, WB_OUTAB = 8 * MiB, WB_FFI0 = 10 * MiB, WB_FFO0 = 21 * MiB, WB_INC = 27 * MiB, WB_OUTC = 30 * MiB, WB_FFI1 = 32 * MiB, WB_FFO1 = 43 * MiB;
static_assert(WB_FFO1 + (size_t)DM * DFF * 2 <= WS_XN && WB_AB + (size_t)ABMAIN * DM * 2 <= WB_OUTAB && WB_FFI0 + (size_t)2 * DFF * DM * 2 <= WB_FFO0 && WB_FFO0 + (size_t)DM * DFF * 2 <= WB_INC &&
              WB_INC + (size_t)CIN * DM * 2 <= WB_OUTC && WB_FFI1 + (size_t)2 * DFF * DM * 2 <= WB_FFO1, "weight copy map");

typedef unsigned v4u __attribute__((ext_vector_type(4)));
typedef unsigned v2u __attribute__((ext_vector_type(2)));
typedef float f32x4 __attribute__((ext_vector_type(4)));
__device__ __forceinline__ unsigned pk2(float lo, float hi) { return (unsigned)f2bf(lo) | ((unsigned)f2bf(hi) << 16); }
__device__ __forceinline__ float fsigmoid(float x) { return __builtin_amdgcn_rcpf(1.0f + __builtin_amdgcn_exp2f(-1.4426950408889634f * x)); }

__device__ __forceinline__ void p0_transpose_item(const float* W, int K, int ldw, int c0, int k0, bf16_t* WT, int drow, LAS float* scr, int lane) {
    { f32x4 tv[8]; const int rr = lane >> 3, cg = (lane & 7) * 4;
#pragma unroll
      for (int i = 0; i < 8; ++i) tv[i] = *(const f32x4*)(W + (size_t)(k0 + 8 * i + rr) * ldw + c0 + cg);
#pragma unroll
      for (int i = 0; i < 8; ++i) { LAS float* d = scr + (8 * i + rr) * 33 + cg; d[0] = tv[i][0]; d[1] = tv[i][1]; d[2] = tv[i][2]; d[3] = tv[i][3]; } }
    asm volatile("s_waitcnt lgkmcnt(0)" ::: "memory");
    const int c = lane & 7;
#pragma unroll
    for (int j = 0; j < 4; ++j) { const int n = (lane >> 3) + 8 * j; const LAS float* s = scr + (8 * c) * 33 + n;
        v4u o; o.x = pk2(s[0 * 33], s[1 * 33]); o.y = pk2(s[2 * 33], s[3 * 33]); o.z = pk2(s[4 * 33], s[5 * 33]); o.w = pk2(s[6 * 33], s[7 * 33]);
        *(GAS v4u*)(WT + (size_t)(drow + n) * K + k0 + 8 * c) = o; }
    asm volatile("s_waitcnt lgkmcnt(0)" ::: "memory");
}
struct CvtJob { const float* W; bf16_t* WT; int K, ldw, c0, ncols, mode, Hn, dbase; };
__device__ __forceinline__ int cvt_items(const CvtJob& j) { return (j.K / 64) * (j.ncols / 32); }
__device__ __forceinline__ void cvt_run(const CvtJob& j, int item, LAS float* scr, int lane) {
    const int nblk = j.ncols / 32, kb = item / nblk, nb = item % nblk; const int c = j.c0 + 32 * nb;
    int drow; if (j.mode == 0) drow = j.dbase + 32 * nb; else { const int cc = c < j.Hn ? c : c - j.Hn; drow = 256 * (cc / 128) + (cc % 128) + (c < j.Hn ? 0 : 128); }
    p0_transpose_item(j.W, j.K, j.ldw, c, 64 * kb, j.WT, drow, scr, lane);
}
__device__ __forceinline__ void p0_weights(const Params& p, LAS unsigned char* lds, int vcu, int G) {
    const int tid_ = tid_opaque(); const int lane = tid_ & 63, wave = __builtin_amdgcn_readfirstlane(tid_ >> 6);
    LAS float* scr = (LAS float*)(lds + wave * 16384);
    const int gw = vcu * NWAVES + wave, NGW = G * NWAVES;
    CvtJob jobs[9] = {
        {p.winab, (bf16_t*)(p.ws + WB_AB), DM, ABIN, 0, 2 * CCH, 1, CCH, 0},
        {p.winab, (bf16_t*)(p.ws + WB_AB), DM, ABIN, 2 * CCH, 4 * MW, 0, 0, 2 * CCH},
        {p.woutab, (bf16_t*)(p.ws + WB_OUTAB), DM, DM, 0, DM, 0, 0, 0},
        {p.wffi, (bf16_t*)(p.ws + WB_FFI0), DM, 2 * DFF, 0, 2 * DFF, 1, DFF, 0},
        {p.wffo, (bf16_t*)(p.ws + WB_FFO0), DFF, DM, 0, DM, 0, 0, 0},
        {p.winc, (bf16_t*)(p.ws + WB_INC), DM, CIN, 0, CIN, 0, 0, 0},
        {p.woutc, (bf16_t*)(p.ws + WB_OUTC), DM, DM, 0, DM, 0, 0, 0},
        {p.wffi + (size_t)DM * 2 * DFF, (bf16_t*)(p.ws + WB_FFI1), DM, 2 * DFF, 0, 2 * DFF, 1, DFF, 0},
        {p.wffo + (size_t)DFF * DM, (bf16_t*)(p.ws + WB_FFO1), DFF, DM, 0, DM, 0, 0, 0}};
    int base = 0;
#pragma unroll
    for (int jj = 0; jj < 9; ++jj) {
        const int n = cvt_items(jobs[jj]);
        int first = ((gw - base) % NGW + NGW) % NGW;
        for (int it = first; it < n; it += NGW) cvt_run(jobs[jj], it, scr, lane);
        base += n;
    }
}

struct EpiAB {
    static constexpr bool PERM = true, AFTER_DRAIN = false;
    bf16_t* upre; bf16_t* qkvo;
    __device__ __forceinline__ void operator()(const f32x4 (&acc)[2][2][4][2], const pg8::Unit& u, int wr, int wc, int fr, int fq) const {
        const int row0 = u.pm * 256 + wr * 64 + fr, lc = wc * 32 + 8 * fq;
        if (u.pn < 4) {
#pragma unroll
            for (int ai = 0; ai < 2; ++ai)
#pragma unroll
                for (int m = 0; m < 4; ++m) { const f32x4 a0 = acc[ai][0][m][0], a1 = acc[ai][0][m][1], g0 = acc[ai][1][m][0], g1 = acc[ai][1][m][1]; v4u w;
                    w.x = pg8::cvt_pk_bf16(a0[0] * fsigmoid(g0[0]), a0[1] * fsigmoid(g0[1])); w.y = pg8::cvt_pk_bf16(a0[2] * fsigmoid(g0[2]), a0[3] * fsigmoid(g0[3]));
                    w.z = pg8::cvt_pk_bf16(a1[0] * fsigmoid(g1[0]), a1[1] * fsigmoid(g1[1])); w.w = pg8::cvt_pk_bf16(a1[2] * fsigmoid(g1[2]), a1[3] * fsigmoid(g1[3]));
                    *(v4u*)(upre + (size_t)(row0 + ai * 128 + m * 16) * CCH + 128 * u.pn + lc) = w; }
        } else {
#pragma unroll
            for (int bj = 0; bj < 2; ++bj) { const int col = 256 * (u.pn - 4) + 128 * bj + lc; const int part = col / MW; const float sc = part == 1 ? 0.08838834764831845f : 1.0f;
#pragma unroll
                for (int ai = 0; ai < 2; ++ai)
#pragma unroll
                    for (int m = 0; m < 4; ++m) { f32x4 v0 = acc[ai][bj][m][0] * sc, v1 = acc[ai][bj][m][1] * sc;
                        if (part == 3) { v0 = (f32x4){fsigmoid(v0[0]), fsigmoid(v0[1]), fsigmoid(v0[2]), fsigmoid(v0[3])}; v1 = (f32x4){fsigmoid(v1[0]), fsigmoid(v1[1]), fsigmoid(v1[2]), fsigmoid(v1[3])}; }
                        v4u w; w.x = pg8::cvt_pk_bf16(v0[0], v0[1]); w.y = pg8::cvt_pk_bf16(v0[2], v0[3]); w.z = pg8::cvt_pk_bf16(v1[0], v1[1]); w.w = pg8::cvt_pk_bf16(v1[2], v1[3]);
                        *(v4u*)(qkvo + (size_t)(row0 + ai * 128 + m * 16) * (4 * MW) + col) = w; } }
        }
    }
};
static_assert(MDK == 128, "EpiAB hard-codes MDK^-0.5");
struct EpiRes {
    static constexpr bool PERM = true, AFTER_DRAIN = false;
    const float* xp; const float* xs;
    bf16_t* Y16; bf16_t* XN; float* ssq; const float* mod_g; const float* mod_sc; const float* ng;
    int from_input; int pad_;
    __device__ __forceinline__ float piece(int row, int col, int cls, f32x4 v0, f32x4 v1) const {
        const float* gv = mod_g + (size_t)cls * 6 * DM + col; const size_t off = (size_t)row * DM + col; f32x4 x0, x1;
        if (from_input) { const float* xin = (row < MC ? xp : xs - (size_t)MC * DM) + off; x0 = *(const f32x4*)xin; x1 = *(const f32x4*)(xin + 4); }
        else { const v4u r = *(const v4u*)(Y16 + off); x0 = (f32x4){__uint_as_float(r.x << 16), __uint_as_float(r.x & 0xffff0000u), __uint_as_float(r.y << 16), __uint_as_float(r.y & 0xffff0000u)};
            x1 = (f32x4){__uint_as_float(r.z << 16), __uint_as_float(r.z & 0xffff0000u), __uint_as_float(r.w << 16), __uint_as_float(r.w & 0xffff0000u)}; }
        x0 += *(const f32x4*)gv * v0; x1 += *(const f32x4*)(gv + 4) * v1;
        v4u w; w.x = pg8::cvt_pk_bf16(x0[0], x0[1]); w.y = pg8::cvt_pk_bf16(x0[2], x0[3]); w.z = pg8::cvt_pk_bf16(x1[0], x1[1]); w.w = pg8::cvt_pk_bf16(x1[2], x1[3]); *(v4u*)(Y16 + off) = w;
        if (ng) { const float* scv = mod_sc + (size_t)cls * 6 * DM + col; const f32x4 t0 = x0 * (*(const f32x4*)(ng + col) * (*(const f32x4*)scv + 1.0f)), t1 = x1 * (*(const f32x4*)(ng + col + 4) * (*(const f32x4*)(scv + 4) + 1.0f));
            v4u q; q.x = pg8::cvt_pk_bf16(t0[0], t0[1]); q.y = pg8::cvt_pk_bf16(t0[2], t0[3]); q.z = pg8::cvt_pk_bf16(t1[0], t1[1]); q.w = pg8::cvt_pk_bf16(t1[2], t1[3]); *(v4u*)(XN + off) = q; }
        return ((x0[0] * x0[0] + x0[1] * x0[1]) + (x0[2] * x0[2] + x0[3] * x0[3])) + ((x1[0] * x1[0] + x1[1] * x1[1]) + (x1[2] * x1[2] + x1[3] * x1[3]));
    }
    __device__ __forceinline__ void operator()(const f32x4 (&acc)[2][2][4][2], const pg8::Unit& u, int wr, int wc, int fr, int fq) const {
        const int row0 = u.pm * 256 + wr * 64 + fr; const int cls = cls_of(u.pm * 256); const int colb = u.pn * 256 + wc * 32 + 8 * fq;
        f32x4 g4[2][2], gs4[2][2];
#pragma unroll
        for (int bj = 0; bj < 2; ++bj)
#pragma unroll
            for (int n = 0; n < 2; ++n) { const int col = colb + bj * 128 + 4 * n; g4[bj][n] = *(const f32x4*)(mod_g + (size_t)cls * 6 * DM + col);
                gs4[bj][n] = ng ? *(const f32x4*)(ng + col) * (*(const f32x4*)(mod_sc + (size_t)cls * 6 * DM + col) + 1.0f) : (f32x4){0.f, 0.f, 0.f, 0.f}; }
        if (from_input) run_rows<2>(acc, row0, colb, g4, gs4); else run_rows<4>(acc, row0, colb, g4, gs4);
    }
    template <int MB> __device__ __forceinline__ void run_rows(const f32x4 (&acc)[2][2][4][2], int row0, int colb, const f32x4 (&g4)[2][2], const f32x4 (&gs4)[2][2]) const {
#pragma unroll
        for (int ai = 0; ai < 2; ++ai)
#pragma unroll
            for (int mb = 0; mb < 4; mb += MB) {
                f32x4 x[MB][2][2];
                if (from_input) {
#pragma unroll
                    for (int mm = 0; mm < MB; ++mm)
#pragma unroll
                        for (int bj = 0; bj < 2; ++bj) { const int row = row0 + ai * 128 + (mb + mm) * 16; const float* xin = (row < MC ? xp : xs - (size_t)MC * DM) + (size_t)row * DM + colb + bj * 128; x[mm][bj][0] = *(const f32x4*)xin; x[mm][bj][1] = *(const f32x4*)(xin + 4); }
                } else { v4u r[MB][2];
#pragma unroll
                    for (int mm = 0; mm < MB; ++mm)
#pragma unroll
                        for (int bj = 0; bj < 2; ++bj) r[mm][bj] = *(const v4u*)(Y16 + (size_t)(row0 + ai * 128 + (mb + mm) * 16) * DM + colb + bj * 128);
#pragma unroll
                    for (int mm = 0; mm < MB; ++mm)
#pragma unroll
                        for (int bj = 0; bj < 2; ++bj) { const v4u q = r[mm][bj]; x[mm][bj][0] = (f32x4){__uint_as_float(q.x << 16), __uint_as_float(q.x & 0xffff0000u), __uint_as_float(q.y << 16), __uint_as_float(q.y & 0xffff0000u)};
                            x[mm][bj][1] = (f32x4){__uint_as_float(q.z << 16), __uint_as_float(q.z & 0xffff0000u), __uint_as_float(q.w << 16), __uint_as_float(q.w & 0xffff0000u)}; }
                }
#pragma unroll
                for (int mm = 0; mm < MB; ++mm) { const int m = mb + mm; const int row = row0 + ai * 128 + m * 16; float s = 0.f;
#pragma unroll
                    for (int bj = 0; bj < 2; ++bj) { const size_t off = (size_t)row * DM + colb + bj * 128;
                        const f32x4 x0 = x[mm][bj][0] + g4[bj][0] * acc[ai][bj][m][0], x1 = x[mm][bj][1] + g4[bj][1] * acc[ai][bj][m][1];
                        v4u w; w.x = pg8::cvt_pk_bf16(x0[0], x0[1]); w.y = pg8::cvt_pk_bf16(x0[2], x0[3]); w.z = pg8::cvt_pk_bf16(x1[0], x1[1]); w.w = pg8::cvt_pk_bf16(x1[2], x1[3]); *(v4u*)(Y16 + off) = w;
                        if (ng) { const f32x4 t0 = x0 * gs4[bj][0], t1 = x1 * gs4[bj][1]; v4u q; q.x = pg8::cvt_pk_bf16(t0[0], t0[1]); q.y = pg8::cvt_pk_bf16(t0[2], t0[3]); q.z = pg8::cvt_pk_bf16(t1[0], t1[1]); q.w = pg8::cvt_pk_bf16(t1[2], t1[3]); *(v4u*)(XN + off) = q; }
                        s += ((x0[0] * x0[0] + x0[1] * x0[1]) + (x0[2] * x0[2] + x0[3] * x0[3])) + ((x1[0] * x1[0] + x1[1] * x1[1]) + (x1[2] * x1[2] + x1[3] * x1[3])); }
                    s += __shfl_xor(s, 16); s += __shfl_xor(s, 32); if (fq_() == 0) atomicAdd(ssq + row, s); }
                asm volatile("" ::: "memory");
            }
    }
    __device__ __forceinline__ static int fq_() { return (threadIdx.x >> 4) & 3; }
};
struct EpiFfnIn {
    static constexpr bool PERM = true, AFTER_DRAIN = false;
    bf16_t* H; const float* ssq; const float* sw;
    __device__ __forceinline__ void operator()(const f32x4 (&acc)[2][2][4][2], const pg8::Unit& u, int wr, int wc, int fr, int fq) const {
        const int row0 = u.pm * 256 + wr * 64 + fr, lc = wc * 32 + 8 * fq; const int cls = cls_of(u.pm * 256); const int col = 128 * u.pn + lc;
        const float* swr = sw + (size_t)cls * 2 * DFF;
        const f32x4 sg0 = *(const f32x4*)(swr + col), sg1 = *(const f32x4*)(swr + col + 4), su0 = *(const f32x4*)(swr + DFF + col), su1 = *(const f32x4*)(swr + DFF + col + 4);
#pragma unroll
        for (int ai = 0; ai < 2; ++ai)
#pragma unroll
            for (int m = 0; m < 4; ++m) { const int row = row0 + ai * 128 + m * 16; const float rs = 1.0f / sqrtf(ssq[row] * (1.0f / DM) + EPSF);
                const f32x4 a0 = acc[ai][0][m][0] * rs + sg0, a1 = acc[ai][0][m][1] * rs + sg1, b0 = acc[ai][1][m][0] * rs + su0, b1 = acc[ai][1][m][1] * rs + su1; v4u w;
                w.x = pg8::cvt_pk_bf16(a0[0] * fsigmoid(a0[0]) * b0[0], a0[1] * fsigmoid(a0[1]) * b0[1]); w.y = pg8::cvt_pk_bf16(a0[2] * fsigmoid(a0[2]) * b0[2], a0[3] * fsigmoid(a0[3]) * b0[3]);
                w.z = pg8::cvt_pk_bf16(a1[0] * fsigmoid(a1[0]) * b1[0], a1[1] * fsigmoid(a1[1]) * b1[1]); w.w = pg8::cvt_pk_bf16(a1[2] * fsigmoid(a1[2]) * b1[2], a1[3] * fsigmoid(a1[3]) * b1[3]);
                *(v4u*)(H + (size_t)row * DFF + col) = w; }
    }
};
struct EpiQkv {
    static constexpr bool PERM = true, AFTER_DRAIN = false;
    bf16_t* qraw; bf16_t* kraw; bf16_t* ctxv; bf16_t* latv; float* outv; const float* ssq; const float* sw;
    __device__ __forceinline__ void operator()(const f32x4 (&acc)[2][2][4][2], const pg8::Unit& u, int wr, int wc, int fr, int fq) const {
        const int row0 = u.pm * 256 + wr * 64 + fr, lc = wc * 32 + 8 * fq; const int cls = cls_of(u.pm * 256); const float* swr = sw + (size_t)cls * CIN;
        float rs[2][4];
#pragma unroll
        for (int ai = 0; ai < 2; ++ai)
#pragma unroll
            for (int m = 0; m < 4; ++m) rs[ai][m] = 1.0f / sqrtf(ssq[row0 + ai * 128 + m * 16] * (1.0f / DM) + EPSF);
#pragma unroll
        for (int bj = 0; bj < 2; ++bj) { const int col = 256 * u.pn + 128 * bj + lc; const f32x4 s0 = *(const f32x4*)(swr + col), s1 = *(const f32x4*)(swr + col + 4);
#pragma unroll
            for (int ai = 0; ai < 2; ++ai)
#pragma unroll
                for (int m = 0; m < 4; ++m) { const int row = row0 + ai * 128 + m * 16; const f32x4 v0 = acc[ai][bj][m][0] * rs[ai][m] + s0, v1 = acc[ai][bj][m][1] * rs[ai][m] + s1;
                    v4u w; w.x = pg8::cvt_pk_bf16(v0[0], v0[1]); w.y = pg8::cvt_pk_bf16(v0[2], v0[3]); w.z = pg8::cvt_pk_bf16(v1[0], v1[1]); w.w = pg8::cvt_pk_bf16(v1[2], v1[3]);
                    if (u.pn < NQ * HDIM / 256) *(v4u*)(qraw + (size_t)row * (NQ * HDIM) + col) = w;
                    else if (u.pn == NQ * HDIM / 256) *(v4u*)(kraw + (size_t)row * (NKV * HDIM) + (col - NQ * HDIM)) = w;
                    else { const int c2 = col - (NQ + NKV) * HDIM;
                        if (row < MC) { *(v4u*)(ctxv + (size_t)row * (NKV * HDIM) + c2) = w; float* o = outv + (size_t)row * (NKV * HDIM) + c2; *(f32x4*)o = v0; *(f32x4*)(o + 4) = v1; }
                        else { const int b = (row - MC) / LSEQ, s = (row - MC) % LSEQ; *(v4u*)(latv + ((size_t)b * SKVL + s) * (NKV * HDIM) + c2) = w; } } } }
    }
};
static_assert(NKV * HDIM == 256 && (NQ * HDIM) % 256 == 0, "EpiQkv tile mapping");

constexpr int CW_SPLIT = 8192;
constexpr size_t SLAB_BYTES = (size_t)64 * 4 * 16 * 512 * 16;
struct RoundZeroOrder : pg8::StaticOrder {
    bool split;
    __device__ void init(int M, int N, int K, int G_, int c_) { pg8::StaticOrder::init(M, N, K, G_, c_); split = (G == 256 && nwg > 256 && nwg <= 320 && ntK >= 8); }
    __device__ bool next(int i, pg8::Unit& u) const { if (split && i > 0) return false; return pg8::StaticOrder::next(i, u); }
};
struct QuarterOrder : pg8::StaticOrder {
    __device__ bool next(int i, pg8::Unit& u) const {
        if (i > 0) return false; const int L = 256 + (c >> 2), q = c & 3; if (L >= nwg) return false;
        map(L, u); const int base = (ntK / 8) * 2, rem = (ntK - 4 * base) / 2;
        int k0 = 0; for (int j = 0; j < q; ++j) k0 += base + (j < rem ? 2 : 0);
        u.k0 = k0; u.nt = base + (q < rem ? 2 : 0); u.role = 1 + q; u.slot = c >> 2; return true;
    }
};
struct EpiPartial {
    static constexpr bool PERM = true, AFTER_DRAIN = false;
    unsigned char* slab; unsigned* cnt;
    __device__ __forceinline__ void operator()(const f32x4 (&acc)[2][2][4][2], const pg8::Unit& u, int wr, int wc, int fr, int fq) const {
        const int tid = (wr * 4 + wc) * 64 + fq * 16 + fr;
        unsigned char* dst = slab + ((size_t)u.slot * 4 + (u.role - 1)) * (16 * 512 * 16) + (size_t)tid * 16;
#pragma unroll
        for (int ai = 0; ai < 2; ++ai)
#pragma unroll
            for (int bj = 0; bj < 2; ++bj)
#pragma unroll
                for (int m = 0; m < 4; ++m) { const f32x4 a = acc[ai][bj][m][0], b = acc[ai][bj][m][1]; v4u w;
                    w.x = pg8::cvt_pk_bf16(a[0], a[1]); w.y = pg8::cvt_pk_bf16(a[2], a[3]); w.z = pg8::cvt_pk_bf16(b[0], b[1]); w.w = pg8::cvt_pk_bf16(b[2], b[3]);
                    asm volatile("global_store_dwordx4 %0, %1, off sc1\n\ts_nop 1" :: "v"(dst), "v"(w) : "memory");
                    dst += 512 * 16; asm volatile("" : "+v"(dst)); }
        asm volatile("s_waitcnt vmcnt(0)" ::: "memory");
        if (fr == 0 && fq == 0) __hip_atomic_fetch_add(cnt + (size_t)u.slot * 64, 1u, __ATOMIC_RELAXED, __HIP_MEMORY_SCOPE_AGENT);
    }
};
__device__ __forceinline__ void tail_reduce(const EpiRes& E, const unsigned char* slab, unsigned* cnt, int G, int bx, int nN, int nM) {
    pg8::StaticOrder S; S.nM = nM; S.nN = nN; S.nwg = nM * nN; S.G = G; S.c = bx; S.ntK = 0;
    const int L = 256 + (bx >> 2), q = bx & 3; if (L >= S.nwg) return;
    pg8::Unit u; S.map(L, u); const int slot = bx >> 2, ai = q >> 1, bj = q & 1;
    const int tid = tid_opaque(), wid = tid >> 6, lane = tid & 63, wr = wid >> 2, wc = wid & 3, fr = lane & 15, fq = lane >> 4;
    unsigned* c = cnt + (size_t)slot * 64; unsigned spins = 0;
    while ((unsigned)__builtin_amdgcn_readfirstlane(__hip_atomic_load(c, __ATOMIC_RELAXED, __HIP_MEMORY_SCOPE_AGENT)) < 32u) { __builtin_amdgcn_s_sleep(2); if (++spins > (1u << 22)) break; }
    __builtin_amdgcn_fence(__ATOMIC_ACQUIRE, "agent");
    const unsigned char* base = slab + (size_t)slot * 4 * (16 * 512 * 16) + (size_t)tid * 16;
    v4u w[4][4];
#pragma unroll
    for (int m = 0; m < 4; ++m)
#pragma unroll
        for (int r = 0; r < 4; ++r) w[m][r] = *(const v4u*)(base + (size_t)r * (16 * 512 * 16) + (size_t)((ai * 2 + bj) * 4 + m) * (512 * 16));
    const int row0 = u.pm * 256 + ai * 128 + wr * 64 + fr; const int cls = cls_of(u.pm * 256); const int col = u.pn * 256 + bj * 128 + wc * 32 + 8 * fq;
#pragma unroll
    for (int m = 0; m < 4; ++m) { const int row = row0 + m * 16; f32x4 v[2] = {(f32x4){0.f, 0.f, 0.f, 0.f}, (f32x4){0.f, 0.f, 0.f, 0.f}};
#pragma unroll
        for (int r = 0; r < 4; ++r) { const v4u x = w[m][r]; v[0] += (f32x4){__uint_as_float(x.x << 16), __uint_as_float(x.x & 0xffff0000u), __uint_as_float(x.y << 16), __uint_as_float(x.y & 0xffff0000u)};
            v[1] += (f32x4){__uint_as_float(x.z << 16), __uint_as_float(x.z & 0xffff0000u), __uint_as_float(x.w << 16), __uint_as_float(x.w & 0xffff0000u)}; }
        float sq = E.piece(row, col, cls, v[0], v[1]);
        sq += __shfl_xor(sq, 16); sq += __shfl_xor(sq, 32); if (fq == 0) atomicAdd(E.ssq + row, sq); }
}
namespace att {
typedef unsigned short bf16;
constexpr int D = 128, NW = 8, QBLK = 32, KVBLK = 64; constexpr float SCALE = 0.088388347648318440f; constexpr float THR = 8.f; constexpr int SDEPTH = 1;
constexpr int LDQ = NQ * HDIM, LDK = NKV * HDIM, LDO = DM;
constexpr size_t SHM_V = KVBLK * D * 2, SHM_K = KVBLK * D * 2, SHM_ATTN = 2 * SHM_V + 2 * SHM_K + NW * 64 * 4;
using bf16x8 = __attribute__((ext_vector_type(8))) short;
using s16x4  = __attribute__((ext_vector_type(4))) short;
using f32x16 = __attribute__((ext_vector_type(16))) float;
using f32x8  = __attribute__((ext_vector_type(8))) float;
using u32x4  = __attribute__((ext_vector_type(4))) unsigned;
#define KSWZ(row, colB) ((row) * 256 + ((colB) ^ (((row) & 7) << 4)))
#define SBAR() __builtin_amdgcn_sched_barrier(0)
__device__ __forceinline__ int crow(int r, int hi) { return (r & 3) + 8 * (r >> 2) + 4 * hi; }
__device__ __forceinline__ unsigned cvtpk(float lo, float hi) {
  unsigned r; asm volatile("v_cvt_pk_bf16_f32 %0, %1, %2" : "=v"(r) : "v"(lo), "v"(hi)); return r;
}
template <typename TIn> struct Stage;
template <> struct Stage<bf16>  { using T = bf16x8;
  __device__ static __forceinline__ T ld8(const bf16* p) { return *reinterpret_cast<const bf16x8*>(p); }
  __device__ static __forceinline__ bf16x8 tobf(T x) { return x; } };
__device__ __forceinline__ void partialSM(f32x16& p0, f32x16& p1, float& m_reg, float& mn, float& alpha) {
  constexpr float C = SCALE * 1.4426950408889634f;
  float pmax = p0[0]; for (int r = 1; r < 16; ++r) pmax = fmaxf(pmax, p0[r]); for (int r = 0; r < 16; ++r) pmax = fmaxf(pmax, p1[r]);
  { auto rr = __builtin_amdgcn_permlane32_swap(__float_as_uint(pmax), __float_as_uint(pmax), false, false);
    pmax = fmaxf(__uint_as_float(rr[0]), __uint_as_float(rr[1])); }
  if (__builtin_expect(__all(pmax - m_reg <= THR / SCALE), 1)) { mn = m_reg; alpha = 1.f; }
  else { mn = fmaxf(m_reg, pmax); alpha = __builtin_amdgcn_exp2f((m_reg - mn) * C); m_reg = mn; }
  float mnC = -mn * C;
  for (int r = 0; r < 16; ++r) p0[r] = fmaf(p0[r], C, mnC); for (int r = 0; r < 16; ++r) p1[r] = fmaf(p1[r], C, mnC);
  for (int r = 0; r < 16; ++r) p0[r] = __builtin_amdgcn_exp2f(p0[r]);
}
__device__ __forceinline__ void finishSM(f32x16& p0, f32x16& p1, float alpha, float& l_reg, bf16x8& pa0, bf16x8& pa1, bf16x8& pa2, bf16x8& pa3) {
  for (int r = 0; r < 16; ++r) p1[r] = __builtin_amdgcn_exp2f(p1[r]);
  float ps = 0; for (int r = 0; r < 16; ++r) ps += p0[r]; for (int r = 0; r < 16; ++r) ps += p1[r];
  { auto rr = __builtin_amdgcn_permlane32_swap(__float_as_uint(ps), __float_as_uint(ps), false, false);
    ps = __uint_as_float(rr[0]) + __uint_as_float(rr[1]); }
  l_reg = l_reg * alpha + ps;
#define PK4(P, BASE, OUT) do { unsigned a0 = cvtpk(P[BASE + 0], P[BASE + 1]), a1 = cvtpk(P[BASE + 2], P[BASE + 3]);   \
    unsigned b0 = cvtpk(P[BASE + 4], P[BASE + 5]), b1 = cvtpk(P[BASE + 6], P[BASE + 7]);                              \
    auto r0 = __builtin_amdgcn_permlane32_swap(a0, b0, false, false); auto r1 = __builtin_amdgcn_permlane32_swap(a1, b1, false, false); \
    u32x4 w = {r0[0], r1[0], r0[1], r1[1]}; OUT = *reinterpret_cast<bf16x8*>(&w); } while (0)
  PK4(p0, 0, pa0); PK4(p0, 8, pa1); PK4(p1, 0, pa2); PK4(p1, 8, pa3);
#undef PK4
}
__device__ __forceinline__ void qkt(f32x16& p0, f32x16& p1, const bf16* Ks, const bf16x8* qr, int r32, int hi) {
  p0 = f32x16{}; p1 = f32x16{};
  for (int d0 = 0; d0 < 8; ++d0) { int cb = (d0 * 16 + hi * 8) * 2;
    bf16x8 b0 = *reinterpret_cast<const bf16x8*>((const char*)Ks + KSWZ(r32, cb));
    bf16x8 b1 = *reinterpret_cast<const bf16x8*>((const char*)Ks + KSWZ(32 + r32, cb));
    p0 = __builtin_amdgcn_mfma_f32_32x32x16_bf16(b0, qr[d0], p0, 0, 0, 0);
    p1 = __builtin_amdgcn_mfma_f32_32x32x16_bf16(b1, qr[d0], p1, 0, 0, 0); }
}
__device__ __forceinline__ int v_st(int k, int c) { const int kk = (k & ~0xC) | ((k & 4) << 1) | ((k & 8) >> 1); return ((kk >> 3) * 4 + (c >> 5)) * 512 + ((kk & 7) * 32 + (c & 31)) * 2; }
__device__ __forceinline__ int v_rd_base(int lane) { return ((lane & 3) << 3) | (((lane >> 2) & 3) << 6) | (((lane >> 4) & 1) << 5) | (((lane >> 5) & 1) << 8); }
constexpr int v_rd_off(int d0, int ks, int half) { return d0 * 512 + ks * 4096 + half * 2048; }
template <int OFF> __device__ __forceinline__ s16x4 tr_read(int vb) {
  s16x4 r; asm volatile("ds_read_b64_tr_b16 %0, %1 offset:%2" : "=&v"(r) : "v"(vb), "i"(OFF) : "memory"); return r;
}
template <int D0> __device__ __forceinline__ void pv_one(f32x16& od, int vb, bf16x8 pa0, bf16x8 pa1, bf16x8 pa2, bf16x8 pa3) {
  const s16x4 l0 = tr_read<v_rd_off(D0, 0, 0)>(vb), h0 = tr_read<v_rd_off(D0, 0, 1)>(vb), l1 = tr_read<v_rd_off(D0, 1, 0)>(vb), h1 = tr_read<v_rd_off(D0, 1, 1)>(vb);
  const s16x4 l2 = tr_read<v_rd_off(D0, 2, 0)>(vb), h2 = tr_read<v_rd_off(D0, 2, 1)>(vb), l3 = tr_read<v_rd_off(D0, 3, 0)>(vb), h3 = tr_read<v_rd_off(D0, 3, 1)>(vb);
  asm volatile("s_waitcnt lgkmcnt(0)" ::: "memory"); SBAR();
#define PK(L, H) (bf16x8){L[0], L[1], L[2], L[3], H[0], H[1], H[2], H[3]}
  od = __builtin_amdgcn_mfma_f32_32x32x16_bf16(pa0, PK(l0, h0), od, 0, 0, 0);
  od = __builtin_amdgcn_mfma_f32_32x32x16_bf16(pa1, PK(l1, h1), od, 0, 0, 0);
  od = __builtin_amdgcn_mfma_f32_32x32x16_bf16(pa2, PK(l2, h2), od, 0, 0, 0);
  od = __builtin_amdgcn_mfma_f32_32x32x16_bf16(pa3, PK(l3, h3), od, 0, 0, 0);
#undef PK
}
__device__ __forceinline__ void pv_d0(f32x16* o, int vb, bf16x8 pa0, bf16x8 pa1, bf16x8 pa2, bf16x8 pa3) {
  pv_one<0>(o[0], vb, pa0, pa1, pa2, pa3); pv_one<1>(o[1], vb, pa0, pa1, pa2, pa3); pv_one<2>(o[2], vb, pa0, pa1, pa2, pa3); pv_one<3>(o[3], vb, pa0, pa1, pa2, pa3);
}

__device__ __forceinline__ void attn_dense_body(const bf16* __restrict__ Qb, const bf16* __restrict__ Kh, const bf16* __restrict__ Vh,
                                                bf16* __restrict__ Ob, int seq, char* lds) {
  typedef bf16 TQ;
  using St = Stage<bf16>; using SQ = Stage<TQ>;
  const int tid = tid_opaque(), wid = tid >> 6, lane = tid & 63, r32 = lane & 31, hi = lane >> 5;
  bf16* V_lds = (bf16*)lds; bf16* K_lds = (bf16*)(lds + 2 * SHM_V);
  float* ws = (float*)(lds + 2 * SHM_V + 2 * SHM_K) + wid * 64; float* li_l = ws; float* al_l = ws + 32;
  float m_reg = -1e30f, l_reg = 0; f32x16 o[4] = {}; bf16x8 qr[8];
  const TQ* Qw = Qb + (long)(wid * QBLK + r32) * LDQ + hi * 8;
#pragma unroll
  for (int d0 = 0; d0 < 8; ++d0) qr[d0] = SQ::tobf(SQ::ld8(Qw + d0 * 16));
  const int sr = tid >> 4, sc = (tid & 15) * 8, vst0 = v_st(sr, sc), vst1 = v_st(32 + sr, sc);
  const int vb0 = (int)(uintptr_t)V_lds + v_rd_base(lane);
  struct { typename St::T vs0, vs1, ks0, ks1; } sr_[SDEPTH];
#define SLOAD(i, k0) do { sr_[i].vs0 = St::ld8(&Vh[(long)((k0) + sr) * LDK + sc]); sr_[i].vs1 = St::ld8(&Vh[(long)((k0) + 32 + sr) * LDK + sc]); \
    sr_[i].ks0 = St::ld8(&Kh[(long)((k0) + sr) * LDK + sc]); sr_[i].ks1 = St::ld8(&Kh[(long)((k0) + 32 + sr) * LDK + sc]); } while (0)
#define SWRITE(b, i) do { *(bf16x8*)((char*)V_lds + (b) * SHM_V + vst0) = St::tobf(sr_[i].vs0);          \
    *(bf16x8*)((char*)V_lds + (b) * SHM_V + vst1) = St::tobf(sr_[i].vs1); int kc = sc * 2;               \
    *(bf16x8*)((char*)K_lds + (b) * SHM_K + KSWZ(sr, kc)) = St::tobf(sr_[i].ks0);                       \
    *(bf16x8*)((char*)K_lds + (b) * SHM_K + KSWZ(32 + sr, kc)) = St::tobf(sr_[i].ks1); } while (0)
#define SWAIT() do { if constexpr (SDEPTH == 2) asm volatile("s_waitcnt vmcnt(4)" ::: "memory"); else asm volatile("s_waitcnt vmcnt(0)" ::: "memory"); } while (0)
#define RESC(a) do { if (__any((a) < 1.f)) { if (hi == 0) al_l[r32] = (a); asm volatile("s_waitcnt lgkmcnt(0)" ::: "memory"); \
    for (int d = 0; d < 4; ++d) for (int r = 0; r < 16; ++r) o[d][r] *= al_l[crow(r, hi)]; } } while (0)
  f32x16 pA0, pA1, pB0, pB1; float mnA, mnB, alA, alB; bf16x8 pa0, pa1, pa2, pa3; const int NT = seq / KVBLK;
  constexpr int SE = 0, SO = SDEPTH - 1;
  SLOAD(SE, 0); asm volatile("s_waitcnt vmcnt(0)" ::: "memory"); SWRITE(0, SE); __syncthreads();
  qkt(pA0, pA1, K_lds, qr, r32, hi); partialSM(pA0, pA1, m_reg, mnA, alA);
  SLOAD(SO, KVBLK); if constexpr (SDEPTH == 2) { if (2 < NT) SLOAD(SE, 2 * KVBLK); }
  SWAIT(); SWRITE(1, SO); __syncthreads();
  for (int j = 1; j + 1 < NT; j += 2) {
    SBAR(); qkt(pB0, pB1, (bf16*)((char*)K_lds + SHM_K), qr, r32, hi);
    finishSM(pA0, pA1, alA, l_reg, pa0, pa1, pa2, pa3); SBAR();
    SLOAD(SO, (j + SDEPTH) * KVBLK); SBAR();
    pv_d0(o, vb0, pa0, pa1, pa2, pa3); partialSM(pB0, pB1, m_reg, mnB, alB);
    __syncthreads(); SWAIT(); SWRITE(0, SE);
    RESC(alB); __syncthreads();
    SBAR(); qkt(pA0, pA1, K_lds, qr, r32, hi);
    finishSM(pB0, pB1, alB, l_reg, pa0, pa1, pa2, pa3); SBAR();
    if (SDEPTH == 1 || j + 3 < NT) SLOAD(SE, (j + 1 + SDEPTH) * KVBLK); SBAR();
    pv_d0(o, vb0 + (int)SHM_V, pa0, pa1, pa2, pa3); partialSM(pA0, pA1, m_reg, mnA, alA);
    __syncthreads(); SWAIT(); SWRITE(1, SO);
    RESC(alA); __syncthreads();
  }
  SBAR(); qkt(pB0, pB1, (bf16*)((char*)K_lds + SHM_K), qr, r32, hi);
  finishSM(pA0, pA1, alA, l_reg, pa0, pa1, pa2, pa3); SBAR();
  pv_d0(o, vb0, pa0, pa1, pa2, pa3); partialSM(pB0, pB1, m_reg, mnB, alB);
  __syncthreads(); RESC(alB);
  finishSM(pB0, pB1, alB, l_reg, pa0, pa1, pa2, pa3); SBAR();
  pv_d0(o, vb0 + (int)SHM_V, pa0, pa1, pa2, pa3);
  if (hi == 0) li_l[r32] = l_reg; asm volatile("s_waitcnt lgkmcnt(0)" ::: "memory");
  float rli[16];
#pragma unroll
  for (int r = 0; r < 16; ++r) rli[r] = __builtin_amdgcn_rcpf(li_l[crow(r, hi)]);
  bf16* Ow = Ob + (long)(wid * QBLK) * LDO;
#pragma unroll
  for (int r = 0; r < 16; ++r) { int orow = crow(r, hi);
    for (int d0 = 0; d0 < 4; ++d0) Ow[(long)orow * LDO + d0 * 32 + r32] = f2bf(o[d0][r] * rli[r]); }
#undef SLOAD
#undef SWRITE
#undef SWAIT
#undef RESC
}
}
__device__ __forceinline__ void attn_phase(const Params& p, unsigned char* lds, int vcu, int G) {
    constexpr int QB = 256, LQB = LSEQ / QB, CQB = CSEQ / QB;
    constexpr int NUL = NLB * NQ * LQB, NUC = NCB * NQ * CQB, NU = NUL + NUC;
    const att::bf16* QR = (const att::bf16*)(p.ws + WS_QRAW); att::bf16* OB = (att::bf16*)(p.ws + WS_O);
    for (int i = 0;; ++i) {
        int u;
        if (G == 256 && NUL == 512) { if (i < 2) u = (vcu >> 5) * 64 + (vcu & 31) + 32 * i; else u = NUL + vcu + (i - 2) * G; }
        else u = vcu + i * G;
        if (u >= NU) break;
        const att::bf16 *Q, *K, *V; att::bf16* O; int seq;
        if (u < NUL) { const int grp = u / (GRP * LQB), j = u % (GRP * LQB); const int b = grp / NKV, kvh = grp % NKV, g = j / LQB, qb = j % LQB, hq = kvh * GRP + g;
            const size_t row0 = (size_t)MC + (size_t)b * LSEQ + (size_t)qb * QB;
            Q = QR + row0 * (NQ * HDIM) + hq * HDIM; O = OB + row0 * DM + hq * HDIM;
            K = (const att::bf16*)(p.ws + WS_LATK) + (size_t)b * SKVL * (NKV * HDIM) + kvh * HDIM; V = (const att::bf16*)(p.ws + WS_LATV) + (size_t)b * SKVL * (NKV * HDIM) + kvh * HDIM; seq = SKVL; }
        else { const int uc = u - NUL; const int b = uc / (NQ * CQB), r = uc % (NQ * CQB), hq = r / CQB, qb = r % CQB, kvh = hq / GRP;
            const size_t row0 = (size_t)b * CSEQ + (size_t)qb * QB;
            Q = QR + row0 * (NQ * HDIM) + hq * HDIM; O = OB + row0 * DM + hq * HDIM;
            K = (const att::bf16*)(p.ws + WS_CTXK) + (size_t)b * CSEQ * (NKV * HDIM) + kvh * HDIM; V = (const att::bf16*)(p.ws + WS_CTXV) + (size_t)b * CSEQ * (NKV * HDIM) + kvh * HDIM; seq = CSEQ; }
        __syncthreads();
        att::attn_dense_body(Q, K, V, O, seq, (char*)lds);
    }
}
static_assert(SKVL % 128 == 0 && CSEQ % 128 == 0 && LSEQ % 256 == 0 && CSEQ % 256 == 0, "attention tiling");
constexpr size_t WS_CST = 232 * MiB;
constexpr int NBLK = LSEQ / 256;
constexpr size_t WS_NST = WS_CST + (size_t)NLB * MH * 2 * NBLK * MDK * MDK * 2;
constexpr size_t WS_FTOT = WS_NST + (size_t)NLB * MH * 2 * NBLK * MDK * 4;
static_assert(WS_FTOT + (size_t)NLB * MH * 2 * NBLK * 4 <= WS_END && MDK == 128 && CSEQ == 256 && LSEQ % 256 == 0, "mLSTM fast path geometry");
namespace att {
constexpr int ML_OFF = 132096;
constexpr int ML_SC = ML_OFF + 6144;
constexpr int ML_N = ML_SC + 128;
constexpr int ML_LI = ML_N + 1024;
static_assert(ML_LI + 1024 <= LDS_BYTES, "mLSTM LDS map");
constexpr float L2E = 1.4426950408889634f;
using f32x4v = __attribute__((ext_vector_type(4))) float;


__device__ __forceinline__ void ml_gates(const Params& p, char* lds, int row0, int h, int tid) {
    float* A = (float*)(lds + ML_OFF); float* S = (float*)(lds + ML_SC);
    const int half = tid >> 8, t = tid & 255, tok = half ? 255 - t : t, lane = tid & 63, wv = (tid >> 6) & 3;
    const float* G = (const float*)(p.ws + WS_GATES) + (size_t)(row0 + tok) * NGATE + half * 8 + h;
    const float ig = G[0], lf = G[4];
    float v = lf;
#pragma unroll
    for (int off = 1; off < 64; off <<= 1) { const float u = lane_get(v, lane - off); if (lane >= off) v += u; }
    if (lane == 63) S[4 + half * 4 + wv] = v;
    __syncthreads();
    float pre = 0.f, tot = 0.f;
#pragma unroll
    for (int w = 0; w < 4; ++w) { const float x = S[4 + half * 4 + w]; if (w < wv) pre += x; tot += x; }
    const float P = v + pre, a = ig - P;
    A[(0 + half) * 256 + tok] = P * L2E; A[(2 + half) * 256 + tok] = a * L2E; A[(4 + half) * 256 + tok] = __builtin_amdgcn_exp2f(P * L2E);
    float mx = a;
    mx = fmaxf(mx, swz_xor<1>(mx)); mx = fmaxf(mx, swz_xor<2>(mx)); mx = fmaxf(mx, swz_xor<4>(mx)); mx = fmaxf(mx, swz_xor<8>(mx)); mx = fmaxf(mx, swz_xor<16>(mx)); mx = half_max(mx);
    if (lane == 0) S[12 + half * 4 + wv] = mx;
    if (t == 0) S[half] = tot;
    __syncthreads();
    if (t == 0) S[2 + half] = fmaxf(fmaxf(S[12 + half * 4], S[13 + half * 4]), fmaxf(S[14 + half * 4], S[15 + half * 4]));
    __syncthreads();
}
#define ML_PK(L, H) (bf16x8){L[0], L[1], L[2], L[3], H[0], H[1], H[2], H[3]}
__device__ __forceinline__ s16x4 tr_read_rt(int vb) { s16x4 r; asm volatile("ds_read_b64_tr_b16 %0, %1" : "=&v"(r) : "v"(vb) : "memory"); return r; }

__device__ __forceinline__ void ml_passA_unit(const Params& p, char* lds, int sid, int h, int blk) {
    const int tid = tid_opaque(), wid = tid >> 6, lane = tid & 63, r32 = lane & 31, hi = lane >> 5;
    const bool isctx = sid < NCB; const int row0 = seq_base(sid) + 256 * blk;
    __syncthreads();
    ml_gates(p, lds, row0, h, tid);
    float* A = (float*)(lds + ML_OFF); float* S = (float*)(lds + ML_SC); float* NA = (float*)(lds + ML_N);
    const bf16* QK = (const bf16*)(p.ws + WS_QKVO) + (size_t)row0 * (4 * MW) + h * MDK;
    const int sr = tid >> 4, sc8 = (tid & 15) * 8;
    { bf16x8 tv[8];
#pragma unroll
      for (int i = 0; i < 8; ++i) tv[i] = *(const bf16x8*)(QK + (size_t)(32 * i + sr) * (4 * MW) + 2 * MW + sc8);
#pragma unroll
      for (int i = 0; i < 8; ++i) *(bf16x8*)(lds + 65536 + (i >> 1) * 16384 + v_st(32 * (i & 1) + sr, sc8)) = tv[i]; }
    if (tid < 256) NA[tid] = 0.f;
    const int a = wid >> 1, dvb0 = 2 * (wid & 1);
    const int ldsb = (int)(uintptr_t)lds; const int vbK = ldsb + v_rd_base(lane) + a * 512, vbV = ldsb + 65536 + v_rd_base(lane) + dvb0 * 512;
    for (int dir = 0; dir < 2; ++dir) {
        __syncthreads();
        const float ft = S[dir], am = S[2 + dir]; const float mT = isctx ? ft + fmaxf(am, 0.f) : 0.f; const float wl2 = (ft - mT) * L2E;
        float xs[8];
#pragma unroll
        for (int i = 0; i < 8; ++i) xs[i] = 0.f;
        bf16x8 tk[8];
#pragma unroll
        for (int i = 0; i < 8; ++i) tk[i] = *(const bf16x8*)(QK + (size_t)(32 * i + sr) * (4 * MW) + MW + sc8);
#pragma unroll
        for (int j = 0; j < 4; ++j)
#pragma unroll
            for (int hf = 0; hf < 2; ++hf) { const int row = 64 * j + 32 * hf + sr; const float w = __builtin_amdgcn_exp2f(wl2 + A[(2 + dir) * 256 + row]);
                const bf16x8 k8 = tk[2 * j + hf]; float x[8];
#pragma unroll
                for (int i = 0; i < 8; ++i) { x[i] = bf2f((unsigned short)k8[i]) * w; xs[i] += x[i]; }
                u32x4 pk = {cvtpk(x[0], x[1]), cvtpk(x[2], x[3]), cvtpk(x[4], x[5]), cvtpk(x[6], x[7])};
                *(u32x4*)(lds + j * 16384 + v_st(32 * hf + sr, sc8)) = pk; }
#pragma unroll
        for (int i = 0; i < 8; ++i) { float v = xs[i]; v += swz_xor<16>(v); v = half_sum(v); if (lane < 16) atomicAdd(&NA[dir * 128 + sc8 + i], v); }
        __syncthreads();
        f32x16 acc0 = {}, acc1 = {}; const unsigned eoff = (unsigned)((32 * a + 4 * hi) * MDK + 32 * dvb0 + r32);
#pragma unroll
        for (int j = 0; j < 4; ++j)
#pragma unroll
            for (int ks = 0; ks < 4; ++ks) { const int off = j * 16384 + ks * 4096;
                const s16x4 al = tr_read_rt(vbK + off), ah = tr_read_rt(vbK + off + 2048);
                const s16x4 bl0 = tr_read_rt(vbV + off), bh0 = tr_read_rt(vbV + off + 2048), bl1 = tr_read_rt(vbV + off + 512), bh1 = tr_read_rt(vbV + off + 512 + 2048);
                asm volatile("s_waitcnt lgkmcnt(0)" ::: "memory"); SBAR();
                acc0 = __builtin_amdgcn_mfma_f32_32x32x16_bf16(ML_PK(al, ah), ML_PK(bl0, bh0), acc0, 0, 0, 0);
                acc1 = __builtin_amdgcn_mfma_f32_32x32x16_bf16(ML_PK(al, ah), ML_PK(bl1, bh1), acc1, 0, 0, 0); }
        if (isctx) {
            float* Co = p.out + O_C + ((size_t)(sid * 2 + dir) * MH + h) * MDK * MDK;
#pragma unroll
            for (int r = 0; r < 16; ++r) { const unsigned eo = eoff + (unsigned)(((r & 3) + 8 * (r >> 2)) * MDK); Co[eo] = acc0[r]; Co[eo + 32] = acc1[r]; }
            if (tid == 0) p.out[O_M + (size_t)(sid * 2 + dir) * MH + h] = mT;
        } else {
            const int b = sid - NCB; bf16* Cs = (bf16*)(p.ws + WS_CST) + ((size_t)((b * MH + h) * 2 + dir) * NBLK + blk) * MDK * MDK;
#pragma unroll
            for (int r = 0; r < 16; ++r) { const unsigned eo = eoff + (unsigned)(((r & 3) + 8 * (r >> 2)) * MDK); Cs[eo] = f2bf(acc0[r]); Cs[eo + 32] = f2bf(acc1[r]); }
            if (tid == 0) ((float*)(p.ws + WS_FTOT))[((size_t)(b * MH + h) * 2 + dir) * NBLK + blk] = ft;
        }
    }
    __syncthreads();
    if (tid < 256) { const int dir = tid >> 7, d = tid & 127;
        if (isctx) p.out[O_N + ((size_t)(sid * 2 + dir) * MH + h) * MDK + d] = NA[tid];
        else { const int b = sid - NCB; ((float*)(p.ws + WS_NST))[(((size_t)(b * MH + h) * 2 + dir) * NBLK + blk) * MDK + d] = NA[tid]; } }
}

template <int DIR> __device__ __forceinline__ void ml_tile(f32x16* o, float& den, const bf16x8* qr, const char* Ktile, int vbV, const float* AL2, int j, float cq, int trow, bool diag, int r32, int hi) {
    SBAR(); f32x16 p0, p1; qkt(p0, p1, (const bf16*)Ktile, qr, r32, hi); SBAR();
    float ds = 0.f; const int tl = trow - 64 * j - 4 * hi;
#pragma unroll
    for (int g = 0; g < 4; ++g) { const f32x4v a0 = *(const f32x4v*)(AL2 + 64 * j + 8 * g + 4 * hi), a1 = *(const f32x4v*)(AL2 + 64 * j + 32 + 8 * g + 4 * hi);
#pragma unroll
        for (int e = 0; e < 4; ++e) { float w0 = __builtin_amdgcn_exp2f(cq + a0[e]), w1 = __builtin_amdgcn_exp2f(cq + a1[e]);
            if (diag) { if (DIR == 0 ? (8 * g + e > tl) : (8 * g + e < tl)) w0 = 0.f; if (DIR == 0 ? (8 * g + e + 32 > tl) : (8 * g + e + 32 < tl)) w1 = 0.f; }
            p0[4 * g + e] *= w0; p1[4 * g + e] *= w1; ds += p0[4 * g + e] + p1[4 * g + e]; } }
    den += ds;
    bf16x8 pa0, pa1, pa2, pa3;
#define PK4(P, BASE, OUT) do { unsigned a0_ = cvtpk(P[BASE + 0], P[BASE + 1]), a1_ = cvtpk(P[BASE + 2], P[BASE + 3]);   \
    unsigned b0_ = cvtpk(P[BASE + 4], P[BASE + 5]), b1_ = cvtpk(P[BASE + 6], P[BASE + 7]);                              \
    auto r0_ = __builtin_amdgcn_permlane32_swap(a0_, b0_, false, false); auto r1_ = __builtin_amdgcn_permlane32_swap(a1_, b1_, false, false); \
    u32x4 w_ = {r0_[0], r1_[0], r0_[1], r1_[1]}; OUT = *reinterpret_cast<bf16x8*>(&w_); } while (0)
    PK4(p0, 0, pa0); PK4(p0, 8, pa1); PK4(p1, 0, pa2); PK4(p1, 8, pa3);
#undef PK4
    SBAR(); pv_d0(o, vbV, pa0, pa1, pa2, pa3); SBAR();
}
__device__ __forceinline__ void ml_stage_kv(char* lds, const bf16* QK, int tile0, int sr, int sc8) {
    bf16x8 tk[4], tv[4];
#pragma unroll
    for (int i = 0; i < 4; ++i) { const int row = 64 * tile0 + 32 * i + sr; tk[i] = *(const bf16x8*)(QK + (size_t)row * (4 * MW) + MW + sc8); tv[i] = *(const bf16x8*)(QK + (size_t)row * (4 * MW) + 2 * MW + sc8); }
#pragma unroll
    for (int i = 0; i < 4; ++i) { const int jj = i >> 1, rl = 32 * (i & 1) + sr; *(bf16x8*)(lds + jj * 16384 + KSWZ(rl, sc8 * 2)) = tk[i]; *(bf16x8*)(lds + 32768 + jj * 16384 + v_st(rl, sc8)) = tv[i]; }
}
__device__ __forceinline__ void ml_passC_unit(const Params& p, char* lds, int sid, int h, int blk) {
    const int tid = tid_opaque(), wid = tid >> 6, lane = tid & 63, r32 = lane & 31, hi = lane >> 5;
    const bool isctx = sid < NCB; const int row0 = seq_base(sid) + 256 * blk; const int wq = wid >> 1;
    __syncthreads();
    ml_gates(p, lds, row0, h, tid);
    float* A = (float*)(lds + ML_OFF); float* NS = (float*)(lds + ML_N); float* li = (float*)(lds + ML_LI) + wid * 32;
    const bf16* QK = (const bf16*)(p.ws + WS_QKVO) + (size_t)row0 * (4 * MW) + h * MDK;
    const int sr = tid >> 4, sc8 = (tid & 15) * 8; const int b = sid - NCB;
    if (tid < 256) { const int dir = tid >> 7, d = tid & 127;
        NS[tid] = isctx ? 0.f : ((const float*)(p.ws + WS_NST))[(((size_t)(b * MH + h) * 2 + dir) * NBLK + blk) * MDK + d]; }
    if (!isctx) { bf16x8 tc[8];
#pragma unroll
        for (int i = 0; i < 8; ++i) { const int dir = i >> 2, c = tid + 512 * (i & 3); tc[i] = *(const bf16x8*)((const bf16*)(p.ws + WS_CST) + ((size_t)((b * MH + h) * 2 + dir) * NBLK + blk) * MDK * MDK + (size_t)c * 8); }
#pragma unroll
        for (int i = 0; i < 8; ++i) { const int dir = i >> 2, c = tid + 512 * (i & 3), row = c >> 4, col8 = (c & 15) * 8; *(bf16x8*)(lds + 65536 + dir * 32768 + (row >> 6) * 16384 + v_st(row & 63, col8)) = tc[i]; }
    }
    bf16x8 qr[8];
    { const bf16* Qw = QK + (size_t)(wid * 32 + r32) * (4 * MW) + hi * 8;
#pragma unroll
        for (int d0 = 0; d0 < 8; ++d0) qr[d0] = *(const bf16x8*)(Qw + d0 * 16); }
    ml_stage_kv(lds, QK, 0, sr, sc8);
    __syncthreads();
    float qn_f = 0.f, qn_b = 0.f;
#pragma unroll
    for (int d0 = 0; d0 < 8; ++d0)
#pragma unroll
        for (int i = 0; i < 8; ++i) { const float qv = bf2f((unsigned short)qr[d0][i]); qn_f += qv * NS[d0 * 16 + hi * 8 + i]; qn_b += qv * NS[128 + d0 * 16 + hi * 8 + i]; }
    qn_f = half_sum(qn_f); qn_b = half_sum(qn_b);
    const int ldsb = (int)(uintptr_t)lds; const int vbV = ldsb + 32768 + v_rd_base(lane), vbC = ldsb + 65536 + v_rd_base(lane);
    const int trow = wid * 32 + r32;
    float* HS = (float*)(p.ws + WS_HS) + (size_t)(row0 + wid * 32) * MW + h * MDK;
    f32x16 o[4]; const unsigned hso = (unsigned)(4 * hi * MW + r32), uho = (unsigned)(4 * hi * DM + r32), ogo = (unsigned)(4 * hi * 4 * MW + r32);
    {
        float qn = qn_f;
        o[0] = f32x16{}; o[1] = f32x16{}; o[2] = f32x16{}; o[3] = f32x16{};
        if (!isctx) { pv_d0(o, vbC, qr[0], qr[1], qr[2], qr[3]); pv_d0(o, vbC + 16384, qr[4], qr[5], qr[6], qr[7]);
#pragma unroll
            for (int r = 0; r < 16; ++r) { const float e = A[4 * 256 + wid * 32 + crow(r, hi)];
#pragma unroll
                for (int d0 = 0; d0 < 4; ++d0) o[d0][r] *= e; } }
        const float cq = A[0 * 256 + trow]; float den = 0.f;
        ml_tile<0>(o, den, qr, lds, vbV, A + 2 * 256, 0, cq, trow, wq == 0, r32, hi);
        if (wq >= 1) ml_tile<0>(o, den, qr, lds + 16384, vbV + 16384, A + 2 * 256, 1, cq, trow, wq == 1, r32, hi);
        __syncthreads(); ml_stage_kv(lds, QK, 2, sr, sc8); __syncthreads();
        if (wq >= 2) ml_tile<0>(o, den, qr, lds, vbV, A + 2 * 256, 2, cq, trow, wq == 2, r32, hi);
        if (wq >= 3) ml_tile<0>(o, den, qr, lds + 16384, vbV + 16384, A + 2 * 256, 3, cq, trow, wq == 3, r32, hi);
        { auto rr = __builtin_amdgcn_permlane32_swap(__float_as_uint(den), __float_as_uint(den), false, false); den = __uint_as_float(rr[0]) + __uint_as_float(rr[1]); }
        const float dn = den + __builtin_amdgcn_exp2f(cq) * qn; const float inv = 1.0f / fmaxf(fabsf(dn), 1.0f);
        if (hi == 0) li[r32] = inv; asm volatile("s_waitcnt lgkmcnt(0)" ::: "memory");
#pragma unroll
        for (int r = 0; r < 16; ++r) { const float rl = li[crow(r, hi)]; const unsigned eo = hso + (unsigned)(((r & 3) + 8 * (r >> 2)) * MW);
#pragma unroll
            for (int d0 = 0; d0 < 4; ++d0) HS[eo + d0 * 32] = o[d0][r] * rl;
            asm volatile("" ::: "memory"); }
    }
    {
        float qn = qn_b;
        o[0] = f32x16{}; o[1] = f32x16{}; o[2] = f32x16{}; o[3] = f32x16{};
        if (!isctx) { pv_d0(o, vbC + 32768, qr[0], qr[1], qr[2], qr[3]); pv_d0(o, vbC + 32768 + 16384, qr[4], qr[5], qr[6], qr[7]);
#pragma unroll
            for (int r = 0; r < 16; ++r) { const float e = A[5 * 256 + wid * 32 + crow(r, hi)];
#pragma unroll
                for (int d0 = 0; d0 < 4; ++d0) o[d0][r] *= e; } }
        const float cq = A[1 * 256 + trow]; float den = 0.f;
        ml_tile<1>(o, den, qr, lds + 16384, vbV + 16384, A + 3 * 256, 3, cq, trow, wq == 3, r32, hi);
        if (wq <= 2) ml_tile<1>(o, den, qr, lds, vbV, A + 3 * 256, 2, cq, trow, wq == 2, r32, hi);
        __syncthreads(); ml_stage_kv(lds, QK, 0, sr, sc8); __syncthreads();
        if (wq <= 1) ml_tile<1>(o, den, qr, lds + 16384, vbV + 16384, A + 3 * 256, 1, cq, trow, wq == 1, r32, hi);
        if (wq <= 0) ml_tile<1>(o, den, qr, lds, vbV, A + 3 * 256, 0, cq, trow, wq == 0, r32, hi);
        { auto rr = __builtin_amdgcn_permlane32_swap(__float_as_uint(den), __float_as_uint(den), false, false); den = __uint_as_float(rr[0]) + __uint_as_float(rr[1]); }
        const float dn = den + __builtin_amdgcn_exp2f(cq) * qn; const float inv = 1.0f / fmaxf(fabsf(dn), 1.0f);
        asm volatile("s_waitcnt vmcnt(0)" ::: "memory");
        if (hi == 0) li[r32] = inv; asm volatile("s_waitcnt lgkmcnt(0)" ::: "memory");
        float mg[4];
#pragma unroll
        for (int d0 = 0; d0 < 4; ++d0) mg[d0] = p.mng[h * MDK + d0 * 32 + r32];
        const bf16* OG = QK + (size_t)(wid * 32) * (4 * MW) + 3 * MW; bf16* UHo = (bf16*)(p.ws + WS_UH) + (size_t)(row0 + wid * 32) * DM + CCH + h * MDK;
#pragma unroll
        for (int r = 0; r < 16; ++r) { const float rl = li[crow(r, hi)]; const int rc = (r & 3) + 8 * (r >> 2); float ss = 0.f;
#pragma unroll
            for (int d0 = 0; d0 < 4; ++d0) { const float hf = __hip_atomic_load(HS + hso + (unsigned)(rc * MW + d0 * 32), __ATOMIC_RELAXED, __HIP_MEMORY_SCOPE_AGENT); const float x = hf + o[d0][r] * rl; o[d0][r] = x; ss += x * x; }
            ss += swz_xor<1>(ss); ss += swz_xor<2>(ss); ss += swz_xor<4>(ss); ss += swz_xor<8>(ss); ss += swz_xor<16>(ss);
            const float rs = 1.0f / sqrtf(ss * (1.0f / MDK) + EPSF);
#pragma unroll
            for (int d0 = 0; d0 < 4; ++d0) UHo[uho + (unsigned)(rc * DM + d0 * 32)] = f2bf(bf2f(OG[ogo + (unsigned)(rc * 4 * MW + d0 * 32)]) * o[d0][r] * rs * mg[d0]);
            asm volatile("" ::: "memory"); }
    }
}
}

template <int DIR> __device__ __forceinline__ void ml_scan_item(const Params& p, int ch, int b, int h, int e8) {
    const float em = expf(p.stm[(size_t)(b * 2 + DIR) * MH + h]); const float* FT = (const float*)(p.ws + WS_FTOT) + (size_t)ch * NBLK;
    float fd[NBLK];
#pragma unroll
    for (int i = 0; i < NBLK; ++i) fd[i] = expf(FT[i]);
    if (e8 < MDK * MDK) { bf16_t* Cs = (bf16_t*)(p.ws + WS_CST) + (size_t)ch * NBLK * MDK * MDK + e8; const float* c0 = p.stC + ((size_t)(b * 2 + DIR) * MH + h) * MDK * MDK + e8;
        v4u d[NBLK];
#pragma unroll
        for (int i = 0; i < NBLK; ++i) d[i] = *(const v4u*)(Cs + (size_t)i * MDK * MDK);
        const f32x4 ca = *(const f32x4*)c0, cb = *(const f32x4*)(c0 + 4); float c[8] = {ca[0] * em, ca[1] * em, ca[2] * em, ca[3] * em, cb[0] * em, cb[1] * em, cb[2] * em, cb[3] * em};
#pragma unroll
        for (int i = 0; i < NBLK; ++i) { const int blk = DIR == 0 ? i : NBLK - 1 - i; v4u o;
#pragma unroll
            for (int w = 0; w < 4; ++w) { const float lo = __uint_as_float(d[blk][w] << 16), hi = __uint_as_float(d[blk][w] & 0xffff0000u); o[w] = pg8::cvt_pk_bf16(c[2 * w], c[2 * w + 1]);
                c[2 * w] = fd[blk] * c[2 * w] + lo; c[2 * w + 1] = fd[blk] * c[2 * w + 1] + hi; }
            *(v4u*)(Cs + (size_t)blk * MDK * MDK) = o; } }
    else { const int d_ = e8 - MDK * MDK; float* Ns = (float*)(p.ws + WS_NST) + (size_t)ch * NBLK * MDK + d_; const float* n0 = p.stn + ((size_t)(b * 2 + DIR) * MH + h) * MDK + d_;
        f32x4 da[NBLK], db[NBLK];
#pragma unroll
        for (int i = 0; i < NBLK; ++i) { da[i] = *(const f32x4*)(Ns + (size_t)i * MDK); db[i] = *(const f32x4*)(Ns + (size_t)i * MDK + 4); }
        f32x4 ca = *(const f32x4*)n0 * em, cb = *(const f32x4*)(n0 + 4) * em;
#pragma unroll
        for (int i = 0; i < NBLK; ++i) { const int blk = DIR == 0 ? i : NBLK - 1 - i;
            *(f32x4*)(Ns + (size_t)blk * MDK) = ca; *(f32x4*)(Ns + (size_t)blk * MDK + 4) = cb; ca = ca * fd[blk] + da[blk]; cb = cb * fd[blk] + db[blk]; } }
}
struct MlScan {
    Params p; static HD_FN long count() { return (long)NLB * MH * 2 * ((MDK * MDK + MDK) / 8); }
    __device__ __forceinline__ void operator()(long idx) const {
        constexpr int per = (MDK * MDK + MDK) / 8; const int e8 = (int)(idx % per) * 8; const int ch = (int)(idx / per); const int dir = ch & 1, h = (ch >> 1) % MH, b = ch / (2 * MH);
        if (dir == 0) ml_scan_item<0>(p, ch, b, h, e8); else ml_scan_item<1>(p, ch, b, h, e8);
    }
};
__device__ __forceinline__ void ml_phase_A(const Params& p, unsigned char* lds, int vcu, int G) {
    constexpr int NUL = NLB * MH * NBLK, NU = NUL + NCB * MH;
    for (int u = vcu; u < NU; u += G) {
        if (u < NUL) att::ml_passA_unit(p, (char*)lds, NCB + u / (MH * NBLK), (u / NBLK) % MH, u % NBLK);
        else att::ml_passA_unit(p, (char*)lds, (u - NUL) / MH, (u - NUL) % MH, 0); }
}
__device__ __forceinline__ void ml_phase_C(const Params& p, unsigned char* lds, int vcu, int G) {
    constexpr int NUL = NLB * MH * NBLK, NU = NUL + NCB * MH;
    for (int u = vcu; u < NU; u += G) {
        if (u < NUL) att::ml_passC_unit(p, (char*)lds, NCB + u / (MH * NBLK), (u / NBLK) % MH, u % NBLK);
        else att::ml_passC_unit(p, (char*)lds, (u - NUL) / MH, (u - NUL) % MH, 0); }
}
typedef float f4 __attribute__((ext_vector_type(4)));
typedef unsigned u4 __attribute__((ext_vector_type(4)));
typedef unsigned u2 __attribute__((ext_vector_type(2)));
__device__ __forceinline__ float wave_sum64(float v) { v += swz_xor<1>(v); v += swz_xor<2>(v); v += swz_xor<4>(v); v += swz_xor<8>(v); v += swz_xor<16>(v); return half_sum(v); }
__device__ __forceinline__ float fsilu(float x) { return x * fsigmoid(x); }

__device__ __forceinline__ void phase_mod(const Params& p, char* lds, int bx, int G) {
    const int tid = tid_opaque(), lane = tid & 63, wave = tid >> 6;
    float* SL = (float*)lds; float* PT = (float*)(lds + 32768);
    constexpr int NCG = 6 * DM / 64, NIT = 2 * NCG;
    if (bx >= NIT) return;
    __syncthreads();
    for (int i = tid; i < NCLS * DM; i += NTHREADS) { const int cls = i / DM, k = i % DM; const float cv = cls == 0 ? p.cctx[k] : p.c[(size_t)(cls - 1) * DM + k]; SL[i] = fsilu(cv); }
    for (int item = bx; item < NIT; item += G) {
        __syncthreads();
        const int l = item / NCG, cg = item % NCG; const float* w = p.wmod + (size_t)l * DM * 6 * DM + cg * 64 + lane;
        float acc[NCLS];
#pragma unroll
        for (int r = 0; r < NCLS; ++r) acc[r] = 0.f;
        const int k0 = wave * (DM / 8);
#pragma unroll 8
        for (int k = k0; k < k0 + DM / 8; ++k) { const float wv = w[(size_t)k * 6 * DM];
#pragma unroll
            for (int r = 0; r < NCLS; ++r) acc[r] += SL[r * DM + k] * wv; }
#pragma unroll
        for (int r = 0; r < NCLS; ++r) PT[(wave * NCLS + r) * 64 + lane] = acc[r];
        __syncthreads();
        if (tid < NCLS * 64) { const int r = tid >> 6; float s = p.bmod[(size_t)l * 6 * DM + cg * 64 + lane];
#pragma unroll
            for (int w8 = 0; w8 < 8; ++w8) s += PT[(w8 * NCLS + r) * 64 + lane];
            ((float*)(p.ws + WS_MOD))[((size_t)(l * NCLS + r) * 6 * DM) + cg * 64 + lane] = s; }
    }
}
__device__ __forceinline__ void sw_job(const Params& p, const bf16_t* Bt, int nrows, int l, int which, float* sw, int N, int mode, int gw, int NGW, int lane) {
    if (gw >= nrows) return;
    f4 sh[NCLS][4];
#pragma unroll
    for (int cls = 0; cls < NCLS; ++cls) { const float* s_ = modv(p, l, cls, which); sh[cls][0] = *(const f4*)(s_ + lane * 8); sh[cls][1] = *(const f4*)(s_ + lane * 8 + 4); sh[cls][2] = *(const f4*)(s_ + DM / 2 + lane * 8); sh[cls][3] = *(const f4*)(s_ + DM / 2 + lane * 8 + 4); }
    u4 w0 = *(const u4*)(Bt + (size_t)gw * DM + lane * 8), w1 = *(const u4*)(Bt + (size_t)gw * DM + DM / 2 + lane * 8);
    for (int n = gw; n < nrows; n += NGW) {
        const u4 c0 = w0, c1 = w1; const int nn = n + NGW; if (nn < nrows) { w0 = *(const u4*)(Bt + (size_t)nn * DM + lane * 8); w1 = *(const u4*)(Bt + (size_t)nn * DM + DM / 2 + lane * 8); }
        f4 wa, wb, wc, wd; wa = (f4){__uint_as_float(c0.x << 16), __uint_as_float(c0.x & 0xffff0000u), __uint_as_float(c0.y << 16), __uint_as_float(c0.y & 0xffff0000u)};
        wb = (f4){__uint_as_float(c0.z << 16), __uint_as_float(c0.z & 0xffff0000u), __uint_as_float(c0.w << 16), __uint_as_float(c0.w & 0xffff0000u)};
        wc = (f4){__uint_as_float(c1.x << 16), __uint_as_float(c1.x & 0xffff0000u), __uint_as_float(c1.y << 16), __uint_as_float(c1.y & 0xffff0000u)};
        wd = (f4){__uint_as_float(c1.z << 16), __uint_as_float(c1.z & 0xffff0000u), __uint_as_float(c1.w << 16), __uint_as_float(c1.w & 0xffff0000u)};
        int col = n; if (mode == 1) { const int t = n >> 8, r = n & 255; col = r < 128 ? 128 * t + r : (N / 2) + 128 * t + (r - 128); }
        float mine = 0.f;
#pragma unroll
        for (int cls = 0; cls < NCLS; ++cls) { const f4 t4 = sh[cls][0] * wa + sh[cls][1] * wb + sh[cls][2] * wc + sh[cls][3] * wd; float s = (t4[0] + t4[1]) + (t4[2] + t4[3]); s = wave_sum64(s); if (lane == cls) mine = s; }
        if (lane < NCLS) sw[(size_t)lane * N + col] = mine;
    }
}
static_assert(DM == 1024, "sw_job / norm passes assume 1024 = 64 lanes x 16");
typedef float f32x4g __attribute__((ext_vector_type(4)));
__device__ __forceinline__ void phase_norm0(const Params& p, char* lds, int bx, int G) {
    const int tid = tid_opaque(), lane = tid & 63, wave = tid >> 6; constexpr int WLD = DM + 4;
    float* WG = (float*)lds;
    __syncthreads();
    { f4 tv[DM * 4 / NTHREADS];
#pragma unroll
      for (int it = 0; it < DM * 4 / NTHREADS; ++it) { const int k = it * (NTHREADS / 4) + (tid >> 2); tv[it] = *(const f4*)(p.winab + (size_t)k * ABIN + ABMAIN + 4 * (tid & 3)); }
#pragma unroll
      for (int it = 0; it < DM * 4 / NTHREADS; ++it) { const int k = it * (NTHREADS / 4) + (tid >> 2), g0 = 4 * (tid & 3); WG[(g0 + 0) * WLD + k] = tv[it][0]; WG[(g0 + 1) * WLD + k] = tv[it][1]; WG[(g0 + 2) * WLD + k] = tv[it][2]; WG[(g0 + 3) * WLD + k] = tv[it][3]; } }
    __syncthreads();
    const int r = lane & 15, kq = lane >> 4; const int gw = bx * NWAVES + wave, NGW = G * NWAVES;
    for (int blk = gw; blk < MTOK / 16; blk += NGW) {
        const int row = blk * 16 + r; const int cls = cls_of(blk * 16); const float* xr = xrow(p, row) + 4 * kq;
        float s = 0.f;
#pragma unroll 16
        for (int q = 0; q < DM / 16; ++q) { const f4 v = *(const f4*)(xr + 16 * q); s += (v[0] * v[0] + v[1] * v[1]) + (v[2] * v[2] + v[3] * v[3]); }
        s += swz_xor<16>(s); s = half_sum(s);
        const float rs = 1.0f / sqrtf(s * (1.0f / DM) + EPSF);
        const float* gp = p.n1g + 4 * kq; const float* scp = modv(p, 0, cls, 1) + 4 * kq; const float* shp = modv(p, 0, cls, 0) + 4 * kq; const float* wp = WG + r * WLD + 4 * kq;
        bf16_t* xo = (bf16_t*)(p.ws + WS_XN) + (size_t)row * DM + 4 * kq;
        f32x4g acc = {0.f, 0.f, 0.f, 0.f};
#pragma unroll 8
        for (int q = 0; q < DM / 16; ++q) { const f4 v = *(const f4*)(xr + 16 * q), gg = *(const f4*)(gp + 16 * q), sc = *(const f4*)(scp + 16 * q), sh = *(const f4*)(shp + 16 * q), w = *(const f4*)(wp + 16 * q);
            const f4 h = v * rs * gg * (sc + 1.0f) + sh;
            u2 o; o.x = pg8::cvt_pk_bf16(h[0], h[1]); o.y = pg8::cvt_pk_bf16(h[2], h[3]); *(u2*)(xo + 16 * q) = o;
            acc = __builtin_amdgcn_mfma_f32_16x16x4f32(h[0], w[0], acc, 0, 0, 0); acc = __builtin_amdgcn_mfma_f32_16x16x4f32(h[1], w[1], acc, 0, 0, 0);
            acc = __builtin_amdgcn_mfma_f32_16x16x4f32(h[2], w[2], acc, 0, 0, 0); acc = __builtin_amdgcn_mfma_f32_16x16x4f32(h[3], w[3], acc, 0, 0, 0); }
        const float bg = p.bgate[r];
#pragma unroll
        for (int e = 0; e < 4; ++e) { float a = acc[e] + bg; if ((r & 7) >= 4) a = logsigmoidf_(a); ((float*)(p.ws + WS_GATES))[(size_t)(blk * 16 + 4 * kq + e) * NGATE + r] = a; }
    }
}
static_assert(MTOK % 16 == 0 && MC % 16 == 0 && LSEQ % 16 == 0, "norm0 row blocks");
__device__ __forceinline__ void phase_conv(const Params& p, char* lds, int ufirst, int ustride) {
    const int tid = tid_opaque(), lane = tid & 63, wave = tid >> 6; constexpr int TT = 32, NR = TT + CWID - 1;
    bf16_t* X = (bf16_t*)lds; float* OUT = (float*)(lds + 65536);
    const int cp = tid & 255, tg = tid >> 8, c0 = 2 * cp;
    float w0[CWID], w1[CWID];
#pragma unroll
    for (int j = 0; j < CWID; ++j) { w0[j] = p.convw[(size_t)j * CCH + c0]; w1[j] = p.convw[(size_t)j * CCH + c0 + 1]; }
    const float b0 = p.convb[c0], b1 = p.convb[c0 + 1];
    const bf16_t* U = (const bf16_t*)(p.ws + WS_UPRE);
    if (ufirst < 0) return;
    for (int u = ufirst; u < MTOK / TT; u += ustride) {
        const int row0 = u * TT, pos0 = pos_of(row0), len = seqlen_of(row0);
        __syncthreads();
        { u4 val[8];
#pragma unroll
          for (int i = 0; i < 8; ++i) { const int c = tid + NTHREADS * i, r = c / (CCH / 8), ch = (c % (CCH / 8)) * 8; const int t = pos0 + r - CWID / 2;
              val[i] = (u4){0u, 0u, 0u, 0u}; if (c < NR * (CCH / 8) && t >= 0 && t < len) val[i] = *(const u4*)(U + (size_t)(row0 + r - CWID / 2) * CCH + ch); }
#pragma unroll
          for (int i = 0; i < 8; ++i) { const int c = tid + NTHREADS * i, r = c / (CCH / 8), ch = (c % (CCH / 8)) * 8; if (c < NR * (CCH / 8)) *(u4*)(X + (size_t)r * CCH + ch) = val[i]; } }
        __syncthreads();
#pragma unroll 2
        for (int tt = 0; tt < TT / 2; ++tt) { const int t = tg * (TT / 2) + tt; float a0 = b0, a1 = b1;
#pragma unroll
            for (int j = 0; j < CWID; ++j) { const unsigned xx = *(const unsigned*)(X + (size_t)(t + j) * CCH + c0); a0 += w0[j] * __uint_as_float(xx << 16); a1 += w1[j] * __uint_as_float(xx & 0xffff0000u); }
            *(float2*)(OUT + (size_t)t * CCH + c0) = make_float2(a0, a1); }
        __syncthreads();
#pragma unroll
        for (int q = 0; q < TT / NWAVES; ++q) { const int t = wave * (TT / NWAVES) + q; const f4 x0 = *(const f4*)(OUT + (size_t)t * CCH + lane * 8), x1 = *(const f4*)(OUT + (size_t)t * CCH + lane * 8 + 4);
            const float mu = wave_sum64((x0[0] + x0[1]) + (x0[2] + x0[3]) + (x1[0] + x1[1]) + (x1[2] + x1[3])) * (1.0f / CCH);
            const f4 d0 = x0 - mu, d1 = x1 - mu;
            const float var = wave_sum64((d0[0] * d0[0] + d0[1] * d0[1]) + (d0[2] * d0[2] + d0[3] * d0[3]) + (d1[0] * d1[0] + d1[1] * d1[1]) + (d1[2] * d1[2] + d1[3] * d1[3])) * (1.0f / CCH);
            const float rs = 1.0f / sqrtf(var + EPSF);
            const f4 g0 = *(const f4*)(p.lng + lane * 8), g1 = *(const f4*)(p.lng + lane * 8 + 4), be0 = *(const f4*)(p.lnb + lane * 8), be1 = *(const f4*)(p.lnb + lane * 8 + 4);
            const f4 y0 = d0 * rs * g0 + be0, y1 = d1 * rs * g1 + be1; u4 w;
            w.x = pg8::cvt_pk_bf16(fsilu(y0[0]), fsilu(y0[1])); w.y = pg8::cvt_pk_bf16(fsilu(y0[2]), fsilu(y0[3])); w.z = pg8::cvt_pk_bf16(fsilu(y1[0]), fsilu(y1[1])); w.w = pg8::cvt_pk_bf16(fsilu(y1[2]), fsilu(y1[3]));
            *(u4*)((bf16_t*)(p.ws + WS_UH) + (size_t)(row0 + t) * DM + lane * 8) = w; }
    }
}
static_assert(CCH == 512 && CSEQ % 32 == 0 && LSEQ % 32 == 0, "conv phase geometry");
__device__ __forceinline__ void phase_cachecvt(const Params& p, int gtid, int gthreads) {
    constexpr int PER = PAST * NKV * HDIM / 8;
    for (int i = gtid; i < NLB * PER; i += gthreads) { const int b = i / PER, e = (i % PER) * 8; const size_t src = (size_t)b * PAST * NKV * HDIM + e, dst = ((size_t)b * SKVL + LSEQ) * NKV * HDIM + e;
        const f4 k0 = *(const f4*)(p.ck + src), k1 = *(const f4*)(p.ck + src + 4), v0 = *(const f4*)(p.cv + src), v1 = *(const f4*)(p.cv + src + 4); u4 wk, wv;
        wk.x = pg8::cvt_pk_bf16(k0[0], k0[1]); wk.y = pg8::cvt_pk_bf16(k0[2], k0[3]); wk.z = pg8::cvt_pk_bf16(k1[0], k1[1]); wk.w = pg8::cvt_pk_bf16(k1[2], k1[3]);
        wv.x = pg8::cvt_pk_bf16(v0[0], v0[1]); wv.y = pg8::cvt_pk_bf16(v0[2], v0[3]); wv.z = pg8::cvt_pk_bf16(v1[0], v1[1]); wv.w = pg8::cvt_pk_bf16(v1[2], v1[3]);
        *(u4*)((bf16_t*)(p.ws + WS_LATK) + dst) = wk; *(u4*)((bf16_t*)(p.ws + WS_LATV) + dst) = wv; }
}
__device__ __forceinline__ void phase_qkpost(const Params& p, int gw, int NGW, int lane) {
    const int hh = lane >> 5, l5 = lane & 31, half = l5 >> 4, f0 = (l5 & 15) * 2, d1 = half * 64 + f0, d2 = d1 + 32;
    const float inv0 = __builtin_amdgcn_exp2f(-(float)f0 * (13.287712379549449f / 32.0f)), inv1 = __builtin_amdgcn_exp2f(-(float)(f0 + 1) * (13.287712379549449f / 32.0f));
    const float qg[4] = {p.qng[d1], p.qng[d1 + 1], p.qng[d2], p.qng[d2 + 1]}, kg[4] = {p.kng[d1], p.kng[d1 + 1], p.kng[d2], p.kng[d2 + 1]};
    for (int row = gw; row < MTOK; row += NGW) {
        const bool lat = row >= MC; const int sp = pos_of(row); float cs0 = 1.f, sn0 = 0.f, cs1 = 1.f, sn1 = 0.f;
        if (lat) { const float pos = (float)(half == 0 ? sp / GRIDW : sp % GRIDW); cs0 = __cosf(pos * inv0); sn0 = __sinf(pos * inv0); cs1 = __cosf(pos * inv1); sn1 = __sinf(pos * inv1); }
        bf16_t* Q = (bf16_t*)(p.ws + WS_QRAW) + (size_t)row * NQ * HDIM; const bf16_t* KR = (const bf16_t*)(p.ws + WS_KRAW) + (size_t)row * NKV * HDIM;
        unsigned ra[NQ / 2 + 1], rb[NQ / 2 + 1];
#pragma unroll
        for (int it = 0; it <= NQ / 2; ++it) { const bf16_t* src = it < NQ / 2 ? Q + (2 * it + hh) * HDIM : KR + hh * HDIM; ra[it] = *(const unsigned*)(src + d1); rb[it] = *(const unsigned*)(src + d2); }
#pragma unroll
        for (int it = 0; it <= NQ / 2; ++it) { const bool isq = it < NQ / 2;
            const float x1a = __uint_as_float(ra[it] << 16), x1b = __uint_as_float(ra[it] & 0xffff0000u), x2a = __uint_as_float(rb[it] << 16), x2b = __uint_as_float(rb[it] & 0xffff0000u);
            float ss = (x1a * x1a + x1b * x1b) + (x2a * x2a + x2b * x2b); ss += swz_xor<1>(ss); ss += swz_xor<2>(ss); ss += swz_xor<4>(ss); ss += swz_xor<8>(ss); ss += swz_xor<16>(ss);
            const float rs = 1.0f / sqrtf(ss * (1.0f / HDIM) + EPSF); const float* g = isq ? qg : kg;
            const float a0 = x1a * rs * g[0], a1 = x1b * rs * g[1], b0 = x2a * rs * g[2], b1 = x2b * rs * g[3];
            const float y1a = a0 * cs0 - b0 * sn0, y2a = a0 * sn0 + b0 * cs0, y1b = a1 * cs1 - b1 * sn1, y2b = a1 * sn1 + b1 * cs1;
            const unsigned w1 = pg8::cvt_pk_bf16(y1a, y1b), w2 = pg8::cvt_pk_bf16(y2a, y2b);
            if (isq) { bf16_t* dst = Q + (2 * it + hh) * HDIM; *(unsigned*)(dst + d1) = w1; *(unsigned*)(dst + d2) = w2; }
            else if (!lat) { bf16_t* K = (bf16_t*)(p.ws + WS_CTXK) + (size_t)row * NKV * HDIM + hh * HDIM; *(unsigned*)(K + d1) = w1; *(unsigned*)(K + d2) = w2;
                float* fo = p.out + O_K + (size_t)row * NKV * HDIM + hh * HDIM; *(float2*)(fo + d1) = make_float2(y1a, y1b); *(float2*)(fo + d2) = make_float2(y2a, y2b); }
            else { const int b_ = (row - MC) / LSEQ, s_ = (row - MC) % LSEQ; bf16_t* K = (bf16_t*)(p.ws + WS_LATK) + ((size_t)b_ * SKVL + s_) * NKV * HDIM + hh * HDIM; *(unsigned*)(K + d1) = w1; *(unsigned*)(K + d2) = w2; } }
    }
}
static_assert(NKV == 2 && NQ % 2 == 0 && HDIM == 128, "qkpost lane mapping");
__device__ __forceinline__ void phase_final(const Params& p, int gw, int NGW, int lane) {
    const f4 g0 = *((const f4*)p.fng + 2 * lane), g1 = *((const f4*)p.fng + 2 * lane + 1), g2 = *((const f4*)p.fng + 128 + 2 * lane), g3 = *((const f4*)p.fng + 128 + 2 * lane + 1);
    const float* sq = (const float*)(p.ws + WS_SSQ) + (size_t)3 * SSQ_STRIDE;
    for (int row = gw; row < MTOK; row += 2 * NGW) { const int row2 = row + NGW; const bool has2 = row2 < MTOK; const int r2 = has2 ? row2 : row;
        const float rsa = 1.0f / sqrtf(sq[row] * (1.0f / DM) + EPSF), rsb = 1.0f / sqrtf(sq[r2] * (1.0f / DM) + EPSF);
        const u4* ya = (const u4*)((const bf16_t*)(p.ws + WS_Y16) + (size_t)row * DM) + lane; const u4* yb = (const u4*)((const bf16_t*)(p.ws + WS_Y16) + (size_t)r2 * DM) + lane;
        const u4 a0 = ya[0], a1 = ya[64], b0 = yb[0], b1 = yb[64];
        f4* oa = (f4*)(p.out + O_Y + (size_t)row * DM) + 2 * lane; f4* ob = (f4*)(p.out + O_Y + (size_t)r2 * DM) + 2 * lane;
#define UNP_LO(V_) (f4){__uint_as_float((V_).x << 16), __uint_as_float((V_).x & 0xffff0000u), __uint_as_float((V_).y << 16), __uint_as_float((V_).y & 0xffff0000u)}
#define UNP_HI(V_) (f4){__uint_as_float((V_).z << 16), __uint_as_float((V_).z & 0xffff0000u), __uint_as_float((V_).w << 16), __uint_as_float((V_).w & 0xffff0000u)}
        oa[0] = UNP_LO(a0) * rsa * g0; oa[1] = UNP_HI(a0) * rsa * g1; oa[128] = UNP_LO(a1) * rsa * g2; oa[129] = UNP_HI(a1) * rsa * g3;
        if (has2) { ob[0] = UNP_LO(b0) * rsb * g0; ob[1] = UNP_HI(b0) * rsb * g1; ob[128] = UNP_LO(b1) * rsb * g2; ob[129] = UNP_HI(b1) * rsb * g3; }
#undef UNP_LO
#undef UNP_HI
    }
}
template <class Epi> __device__ __forceinline__ void gemm_call(LAS unsigned char* lds, const bf16_t* A, const bf16_t* Bt, int N, int K, const Epi& E) {
    pg8::Gemm g{A, Bt, MTOK, N, K}; pg8::StaticOrder S; S.init(MTOK, N, K, (int)gridDim.x, (int)blockIdx.x);
    pg8::gemm_phase<Epi, pg8::StaticOrder, true, true>((PG8_LAS unsigned char*)lds, g, S, E);
}
#ifdef PROBE_A
#define ISTAMP(i) do { if (blockIdx.x == 0 && threadIdx.x == 0 && K == PROBE_K) *(volatile LAS unsigned*)(uintptr_t)(MISC_OFF + 4 * (i)) = (unsigned)__builtin_amdgcn_s_memrealtime(); } while (0)
#else
#define ISTAMP(i) do {} while (0)
#endif
__device__ __forceinline__ void gemm_call_split(LAS unsigned char* lds, const bf16_t* A, const bf16_t* Bt, int N, int K, const EpiRes& E, unsigned char* slab, unsigned* cnt) {
    pg8::Gemm g{A, Bt, MTOK, N, K}; RoundZeroOrder S0; S0.init(MTOK, N, K, (int)gridDim.x, (int)blockIdx.x);
    ISTAMP(0);
    pg8::gemm_phase<EpiRes, RoundZeroOrder, true, true>((PG8_LAS unsigned char*)lds, g, S0, E);
    ISTAMP(1);
    if (S0.split) { QuarterOrder S1; S1.init(MTOK, N, K, (int)gridDim.x, (int)blockIdx.x);
        pg8::gemm_phase<EpiPartial, QuarterOrder, true, true>((PG8_LAS unsigned char*)lds, g, S1, EpiPartial{slab, cnt});
        ISTAMP(2);
        tail_reduce(E, slab, cnt, (int)gridDim.x, (int)blockIdx.x, N / 256, MTOK / 256); ISTAMP(3); }
}
__global__ void __launch_bounds__(NTHREADS, 2) mega_fwd(Params p) {
    extern __shared__ __attribute__((aligned(16))) unsigned char lds[];
    LAS unsigned char* L = (LAS unsigned char*)lds;
    for (int u = threadIdx.x; u < (LDS_BYTES - LDSCTL_OFF) / 4; u += NTHREADS) ((LAS unsigned*)(L + LDSCTL_OFF))[u] = 0u;
    __syncthreads();
    volatile LAS unsigned* MISC = (volatile LAS unsigned*)(L + MISC_OFF);
    const XcdBarrier bar = xcd_barrier_post((unsigned*)(p.ws + WS_CTL) + CW_BAR, MISC + 8);
    const int G = gridDim.x, bx = blockIdx.x; const int vcu = (G % 8 == 0) ? (bx % 8) * (G / 8) + bx / 8 : bx;
    unsigned char* ws = p.ws;
    const bf16_t* XN = (const bf16_t*)(ws + WS_XN); const bf16_t* UH = (const bf16_t*)(ws + WS_UH); const bf16_t* Hh = (const bf16_t*)(ws + WS_H); const bf16_t* Ob = (const bf16_t*)(ws + WS_O);
    float* SW0 = (float*)(ws + WS_SW); float* SWC = SW0 + (size_t)NCLS * 2 * DFF; float* SW1 = SWC + (size_t)NCLS * CIN;
    float* SSQ = (float*)(ws + WS_SSQ); float* Y = p.out + O_Y; unsigned* SPLITC = (unsigned*)(ws + WS_CTL) + CW_SPLIT;
#define WAVE_IDS() const int tid_ = tid_opaque(); const int lane_ = tid_ & 63; const int gw_ = bx * NWAVES + (tid_ >> 6); const int NGW_ = G * NWAVES
    p0_weights(p, L, vcu, G); phase_mod(p, (char*)lds, bx, G);
    xcd_barrier(bar);
    phase_norm0(p, (char*)lds, bx, G);
    xcd_barrier(bar);
    gemm_call(L, XN, (const bf16_t*)(ws + WB_AB), ABMAIN, DM, EpiAB{(bf16_t*)(ws + WS_UPRE), (bf16_t*)(ws + WS_QKVO)}); xcd_barrier(bar);
    ml_phase_A(p, lds, vcu, G);
    { WAVE_IDS(); sw_job(p, (const bf16_t*)(ws + WB_FFI0), 2 * DFF, 0, 3, SW0, 2 * DFF, 1, gw_, NGW_, lane_); sw_job(p, (const bf16_t*)(ws + WB_INC), CIN, 1, 0, SWC, CIN, 0, gw_, NGW_, lane_);
      sw_job(p, (const bf16_t*)(ws + WB_FFI1), 2 * DFF, 1, 3, SW1, 2 * DFF, 1, gw_, NGW_, lane_); }
    xcd_barrier(bar);
    { WAVE_IDS(); MlScan sc{p}; for (long i = bx * (long)NTHREADS + tid_; i < MlScan::count(); i += (long)G * NTHREADS) sc(i); } xcd_barrier(bar);
    ml_phase_C(p, lds, vcu, G);
    { constexpr int NU_ML = NLB * MH * NBLK + NCB * MH; const int nsecond = NU_ML > G ? NU_ML - G : 0;
      if (nsecond < G) phase_conv(p, (char*)lds, vcu >= nsecond ? vcu - nsecond : -1, G - nsecond); else phase_conv(p, (char*)lds, vcu, G); }
    xcd_barrier(bar);
    gemm_call_split(L, UH, (const bf16_t*)(ws + WB_OUTAB), DM, DM, EpiRes{p.xp, p.xs, (bf16_t*)(ws + WS_Y16), (bf16_t*)(ws + WS_XN), SSQ + 0 * SSQ_STRIDE, modv(p, 0, 0, 2), modv(p, 0, 0, 4), p.n2g, 1, 0}, (unsigned char*)Y, SPLITC + 0 * 4096); xcd_barrier(bar);
    gemm_call(L, XN, (const bf16_t*)(ws + WB_FFI0), 2 * DFF, DM, EpiFfnIn{(bf16_t*)(ws + WS_H), SSQ + 0 * SSQ_STRIDE, SW0}); xcd_barrier(bar);
    gemm_call_split(L, Hh, (const bf16_t*)(ws + WB_FFO0), DM, DFF, EpiRes{p.xp, p.xs, (bf16_t*)(ws + WS_Y16), (bf16_t*)(ws + WS_XN), SSQ + 1 * SSQ_STRIDE, modv(p, 0, 0, 5), modv(p, 1, 0, 1), p.n1g + DM, 0, 0}, (unsigned char*)Y + SLAB_BYTES, SPLITC + 1 * 4096); xcd_barrier(bar);
    gemm_call(L, XN, (const bf16_t*)(ws + WB_INC), CIN, DM, EpiQkv{(bf16_t*)(ws + WS_QRAW), (bf16_t*)(ws + WS_KRAW), (bf16_t*)(ws + WS_CTXV), (bf16_t*)(ws + WS_LATV), p.out + O_V, SSQ + 1 * SSQ_STRIDE, SWC}); xcd_barrier(bar);
    { WAVE_IDS(); phase_qkpost(p, gw_, NGW_, lane_); phase_cachecvt(p, bx * NTHREADS + tid_, G * NTHREADS); } xcd_barrier(bar);
    attn_phase(p, lds, vcu, G); xcd_barrier(bar);
    gemm_call_split(L, Ob, (const bf16_t*)(ws + WB_OUTC), DM, DM, EpiRes{p.xp, p.xs, (bf16_t*)(ws + WS_Y16), (bf16_t*)(ws + WS_XN), SSQ + 2 * SSQ_STRIDE, modv(p, 1, 0, 2), modv(p, 1, 0, 4), p.n2g + DM, 0, 0}, (unsigned char*)Y, SPLITC + 2 * 4096); xcd_barrier(bar);
    gemm_call(L, XN, (const bf16_t*)(ws + WB_FFI1), 2 * DFF, DM, EpiFfnIn{(bf16_t*)(ws + WS_H), SSQ + 2 * SSQ_STRIDE, SW1}); xcd_barrier(bar);
    gemm_call_split(L, Hh, (const bf16_t*)(ws + WB_FFO1), DM, DFF, EpiRes{p.xp, p.xs, (bf16_t*)(ws + WS_Y16), (bf16_t*)(ws + WS_XN), SSQ + 3 * SSQ_STRIDE, modv(p, 1, 0, 5), modv(p, 1, 0, 1), nullptr, 0, 0}, (unsigned char*)Y + SLAB_BYTES, SPLITC + 3 * 4096); xcd_barrier(bar);
    { WAVE_IDS(); phase_final(p, gw_, NGW_, lane_); }
#undef WAVE_IDS
}
static Params make_params(void* const* d_in, void* d_out, void* d_ws) {
    Params p{}; const float** pp = (const float**)&p; for (int i = 0; i < 28; ++i) pp[i] = (const float*)d_in[i];
    p.out = (float*)d_out; p.ws = (unsigned char*)d_ws; return p;
}
extern "C" void kernel_launch(void* const* d_in, const int* in_sizes, int n_in, void* d_out, int out_size, void* d_ws, size_t ws_size, hipStream_t stream) {
    static int grid = 0;
    if (grid == 0) {
        if (n_in != 28 || (size_t)out_size != O_END || ws_size < WS_END || in_sizes[0] != MC * DM || in_sizes[1] != ML * DM) {
            fprintf(stderr, "kernel_launch: shape mismatch n_in %d out %d (want %zu) ws %zu (want %zu)\n", n_in, out_size, (size_t)O_END, ws_size, (size_t)WS_END); grid = -1; return; }
        int dev = 0, cus = 0;
        if (hipGetDevice(&dev) != hipSuccess || hipDeviceGetAttribute(&cus, hipDeviceAttributeMultiprocessorCount, dev) != hipSuccess) { grid = -1; return; }
        if (hipFuncSetAttribute((const void*)mega_fwd, hipFuncAttributeMaxDynamicSharedMemorySize, LDS_BYTES) != hipSuccess) { fprintf(stderr, "hipFuncSetAttribute failed\n"); grid = -1; return; }
        int per_cu = 0; (void)hipOccupancyMaxActiveBlocksPerMultiprocessor(&per_cu, (const void*)mega_fwd, NTHREADS, LDS_BYTES); (void)hipGetLastError();
        if (per_cu < 1) fprintf(stderr, "kernel_launch: occupancy query says %d blocks/CU\n", per_cu);
        grid = cus;
    }
    if (grid < 0) return;
    hipMemsetAsync((char*)d_ws + WS_CTL, 0, CTL_ZERO_BYTES, stream);
    Params p = make_params(d_in, d_out, d_ws);
    hipLaunchKernelGGL(mega_fwd, dim3(grid), dim3(NTHREADS), LDS_BYTES, stream, p);
}
```

```cpp
#ifdef HOST_TEST
#include <cmath>
#include <cstdio>
#include <cstdlib>
#include <cstring>
#include <cstdint>
#include <vector>
#define HD_FN inline
#define DEV_FN inline
#else
#include <hip/hip_runtime.h>
#include <cstdio>
#include <cstdint>
#define HD_FN __host__ __device__ __forceinline__
#define DEV_FN __device__ __forceinline__
#endif

#ifdef TINY
constexpr int DM = 512, NCB = 2, CSEQ = 128, NLB = 2, LSEQ = 128, PAST = 128;
#else
constexpr int DM = 1024, NCB = 16, CSEQ = 256, NLB = 4, LSEQ = 4096, PAST = 256;
#endif
constexpr int GRIDW = 64, CCH = DM / 2, CWID = 31, MH = 4, MDK = CCH / MH, MW = CCH, NGATE = 16;
constexpr int ABIN = 2 * CCH + 4 * MW + NGATE, ABMAIN = 2 * CCH + 4 * MW;
constexpr int HDIM = 128, NQ = DM / HDIM, NKV = 2, GRP = NQ / NKV, CIN = (NQ + 2 * NKV) * HDIM;
constexpr int DFF = ((8 * DM + 3 * 256 - 1) / (3 * 256)) * 256;
constexpr int MC = NCB * CSEQ, ML = NLB * LSEQ, MTOK = MC + ML, NCLS = 1 + NLB, SKVL = LSEQ + PAST;
constexpr float EPSF = 1e-6f;
constexpr int NSEQ = NCB + NLB;

constexpr size_t O_Y = 0, O_C = (size_t)MTOK * DM, O_N = O_C + (size_t)NCB * 2 * MH * MDK * MDK, O_M = O_N + (size_t)NCB * 2 * MH * MDK,
                 O_K = O_M + (size_t)NCB * 2 * MH, O_V = O_K + (size_t)NCB * CSEQ * NKV * HDIM, O_END = O_V + (size_t)NCB * CSEQ * NKV * HDIM;

constexpr size_t MiB = 1u << 20;
#ifdef TINY
constexpr size_t WSCALE = 1;
#endif
constexpr size_t WS_CTL = 0, CTL_ZERO_BYTES = 1 * MiB;
constexpr size_t WS_MOD = 1 * MiB;
constexpr size_t WS_SW = WS_MOD + 256 * 1024;
constexpr size_t WS_SSQ = 512 * 1024;
constexpr int SSQ_STRIDE = 32768;
constexpr size_t WS_DEN = 232 * MiB;
constexpr size_t WS_WB = 2 * MiB;
constexpr size_t WS_XN = 50 * MiB;
constexpr size_t WS_UPRE = 90 * MiB;
constexpr size_t WS_QKVO = 110 * MiB;
constexpr size_t WS_UH = 190 * MiB;
constexpr size_t WS_GATES = 230 * MiB;
constexpr size_t WS_HS = 50 * MiB;
constexpr size_t WS_Y16 = 90 * MiB;
constexpr size_t WS_H = 130 * MiB;
constexpr size_t WS_QRAW = 130 * MiB;
constexpr size_t WS_LATK = 170 * MiB, WS_LATV = 179 * MiB, WS_CTXK = 188 * MiB, WS_CTXV = 190 * MiB;
constexpr size_t WS_KRAW = 192 * MiB;
constexpr size_t WS_O = 202 * MiB;
constexpr size_t WS_END = 256 * MiB;

typedef unsigned short bf16_t;
HD_FN float bf2f(bf16_t h) { unsigned u = (unsigned)h << 16; return __builtin_bit_cast(float, u); }
HD_FN bf16_t f2bf(float f) { unsigned u = __builtin_bit_cast(unsigned, f); return (bf16_t)((u + 0x7fffu + ((u >> 16) & 1u)) >> 16); }
HD_FN float rbf(float f) { return bf2f(f2bf(f)); }
HD_FN float sigmoidf_(float x) { return 1.0f / (1.0f + expf(-x)); }
HD_FN float siluf_(float x) { return x * sigmoidf_(x); }
HD_FN float logsigmoidf_(float x) { return x >= 0.f ? -log1pf(expf(-x)) : x - log1pf(expf(x)); }
HD_FN int cls_of(int row) { return row < MC ? 0 : 1 + (row - MC) / LSEQ; }
HD_FN int seqlen_of(int row) { return row < MC ? CSEQ : LSEQ; }
HD_FN int pos_of(int row) { return row < MC ? row % CSEQ : (row - MC) % LSEQ; }

struct Params {
    const float *xp, *xs, *c, *stC, *stn, *stm, *ck, *cv, *cctx, *wmod, *bmod, *n1g, *n2g, *winab, *bgate, *convw, *convb, *lng, *lnb, *mng,
        *woutab, *winc, *qng, *kng, *woutc, *wffi, *wffo, *fng;
    float* out; unsigned char* ws;
};
HD_FN const float* xrow(const Params& p, int row) { return row < MC ? p.xp + (size_t)row * DM : p.xs + (size_t)(row - MC) * DM; }
HD_FN const float* modv(const Params& p, int l, int cls, int which) { return (const float*)(p.ws + WS_MOD) + ((size_t)(l * NCLS + cls) * 6 + which) * DM; }
constexpr size_t WS_RS0 = 233 * MiB;

struct NMod {
    Params p; static HD_FN long count() { return 2L * NCLS * 6 * DM; }
    HD_FN void operator()(long idx) const {
        const int col = (int)(idx % (6 * DM)); const int cls = (int)((idx / (6 * DM)) % NCLS); const int l = (int)(idx / (6 * DM * NCLS));
        const float* cond = cls == 0 ? p.cctx : p.c + (size_t)(cls - 1) * DM;
        const float* w = p.wmod + (size_t)l * DM * 6 * DM;
        float acc = 0.f;
        for (int k = 0; k < DM; ++k) acc += siluf_(cond[k]) * w[(size_t)k * 6 * DM + col];
        ((float*)(p.ws + WS_MOD))[idx] = acc + p.bmod[(size_t)l * 6 * DM + col];
    }
};
struct NNorm0a {
    Params p; static HD_FN long count() { return MTOK; }
    HD_FN void operator()(long row) const {
        const float* x = xrow(p, (int)row); float s = 0.f;
        for (int k = 0; k < DM; ++k) s += x[k] * x[k];
        ((float*)(p.ws + WS_RS0))[row] = 1.0f / sqrtf(s / DM + EPSF);
    }
};
struct NNorm0b {
    Params p; static HD_FN long count() { return (long)MTOK * DM; }
    HD_FN void operator()(long idx) const {
        const int row = (int)(idx / DM), col = (int)(idx % DM), cls = cls_of(row);
        const float rs = ((const float*)(p.ws + WS_RS0))[row];
        const float v = xrow(p, row)[col] * rs * p.n1g[col] * (1.f + modv(p, 0, cls, 1)[col]) + modv(p, 0, cls, 0)[col];
        ((bf16_t*)(p.ws + WS_XN))[idx] = f2bf(v);
    }
};
struct NGates {
    Params p; static HD_FN long count() { return (long)MTOK * NGATE; }
    HD_FN void operator()(long idx) const {
        const int row = (int)(idx / NGATE), j = (int)(idx % NGATE), cls = cls_of(row);
        const float rs = ((const float*)(p.ws + WS_RS0))[row]; const float* x = xrow(p, row);
        const float* sc = modv(p, 0, cls, 1); const float* sh = modv(p, 0, cls, 0);
        float acc = 0.f;
        for (int k = 0; k < DM; ++k) { const float h = x[k] * rs * p.n1g[k] * (1.f + sc[k]) + sh[k]; acc += h * p.winab[(size_t)k * ABIN + ABMAIN + j]; }
        acc += p.bgate[j];
        if ((j & 7) >= 4) acc = logsigmoidf_(acc);
        ((float*)(p.ws + WS_GATES))[idx] = acc;
    }
};

template <bool DUAL, class Epi> struct NGemm {
    const bf16_t* A; const float* B; int lda, ldb, K, N, off2, pad_; Epi epi;
    HD_FN long count() const { return (long)(MTOK / 4) * (N / 4); }
    HD_FN void operator()(long idx) const {
        const int nt = (int)(idx % (N / 4)), mt = (int)(idx / (N / 4)); const int m0 = mt * 4, n0 = nt * 4;
        float acc[4][4], acc2[4][4];
#pragma unroll
        for (int i = 0; i < 4; ++i)
#pragma unroll
            for (int j = 0; j < 4; ++j) { acc[i][j] = 0.f; acc2[i][j] = 0.f; }
        for (int k0 = 0; k0 < K; k0 += 8) {
            float a[4][8];
#pragma unroll
            for (int i = 0; i < 4; ++i) {
                const bf16_t* ap = A + (size_t)(m0 + i) * lda + k0;
#pragma unroll
                for (int kk = 0; kk < 8; ++kk) a[i][kk] = bf2f(ap[kk]);
            }
#pragma unroll
            for (int kk = 0; kk < 8; ++kk) {
                const float* bp = B + (size_t)(k0 + kk) * ldb + n0;
                float b[4], b2[4];
#pragma unroll
                for (int j = 0; j < 4; ++j) { b[j] = rbf(bp[j]); b2[j] = DUAL ? rbf(bp[off2 + j]) : 0.f; }
#pragma unroll
                for (int i = 0; i < 4; ++i)
#pragma unroll
                    for (int j = 0; j < 4; ++j) { acc[i][j] += a[i][kk] * b[j]; if (DUAL) acc2[i][j] += a[i][kk] * b2[j]; }
            }
        }
#pragma unroll
        for (int i = 0; i < 4; ++i)
#pragma unroll
            for (int j = 0; j < 4; ++j) epi(m0 + i, n0 + j, acc[i][j], acc2[i][j]);
    }
};
struct EGlu { Params p; HD_FN void operator()(int row, int col, float v, float v2) const { ((bf16_t*)(p.ws + WS_UPRE))[(size_t)row * CCH + col] = f2bf(v * sigmoidf_(v2)); } };
struct EQkvo { Params p; HD_FN void operator()(int row, int col, float v, float) const {
        const int part = col / MW; if (part == 1) v *= 1.0f / sqrtf((float)MDK); if (part == 3) v = sigmoidf_(v);
        ((bf16_t*)(p.ws + WS_QKVO))[(size_t)row * 4 * MW + col] = f2bf(v); } };
struct EOut { Params p; int l; int pad_ = 0; HD_FN void operator()(int row, int col, float v, float) const {
        const int cls = cls_of(row); float* Y = p.out + O_Y + (size_t)row * DM + col;
        const float xin = l == 0 ? xrow(p, row)[col] : *Y;
        const float x1 = xin + modv(p, l, cls, 2)[col] * v; *Y = x1;
        ((bf16_t*)(p.ws + WS_XN))[(size_t)row * DM + col] = f2bf(x1 * p.n2g[(size_t)l * DM + col] * (1.f + modv(p, l, cls, 4)[col])); } };
struct EFfnIn { Params p; const float* sw; int slot; int pad_ = 0; HD_FN void operator()(int row, int col, float v, float v2) const {
        const int cls = cls_of(row); const float rs = 1.0f / sqrtf(((const float*)(p.ws + WS_SSQ))[(size_t)slot * SSQ_STRIDE + row] / DM + EPSF);
        const float a = v * rs + sw[(size_t)cls * 2 * DFF + col], b = v2 * rs + sw[(size_t)cls * 2 * DFF + DFF + col];
        ((bf16_t*)(p.ws + WS_H))[(size_t)row * DFF + col] = f2bf(siluf_(a) * b); } };
struct EFfnOut { Params p; int l; int pad_ = 0; HD_FN void operator()(int row, int col, float v, float) const {
        const int cls = cls_of(row); float* Y = p.out + O_Y + (size_t)row * DM + col;
        const float x2 = *Y + modv(p, l, cls, 5)[col] * v; *Y = x2;
        if (l == 0) ((bf16_t*)(p.ws + WS_XN))[(size_t)row * DM + col] = f2bf(x2 * p.n1g[(size_t)DM + col] * (1.f + modv(p, 1, cls, 1)[col])); } };
struct EQkv { Params p; const float* sw; int slot; int pad_ = 0; HD_FN void operator()(int row, int col, float v, float) const {
        const int cls = cls_of(row); const float rs = 1.0f / sqrtf(((const float*)(p.ws + WS_SSQ))[(size_t)slot * SSQ_STRIDE + row] / DM + EPSF);
        const float a = v * rs + sw[(size_t)cls * CIN + col];
        if (col < NQ * HDIM) ((bf16_t*)(p.ws + WS_QRAW))[(size_t)row * NQ * HDIM + col] = f2bf(a);
        else if (col < (NQ + NKV) * HDIM) ((bf16_t*)(p.ws + WS_KRAW))[(size_t)row * NKV * HDIM + (col - NQ * HDIM)] = f2bf(a);
        else { const int c2 = col - (NQ + NKV) * HDIM;
            if (row < MC) { ((bf16_t*)(p.ws + WS_CTXV))[(size_t)row * NKV * HDIM + c2] = f2bf(a); p.out[O_V + (size_t)row * NKV * HDIM + c2] = a; }
            else { const int b = (row - MC) / LSEQ, s = (row - MC) % LSEQ; ((bf16_t*)(p.ws + WS_LATV))[((size_t)b * SKVL + s) * NKV * HDIM + c2] = f2bf(a); } } } };

struct NSsq {
    Params p; int slot; int pad_ = 0; static HD_FN long count() { return MTOK; }
    HD_FN void operator()(long row) const { const float* y = p.out + O_Y + (size_t)row * DM; float s = 0.f; for (int k = 0; k < DM; ++k) s += y[k] * y[k];
        ((float*)(p.ws + WS_SSQ))[(size_t)slot * SSQ_STRIDE + row] = s; }
};
struct NSW {
    Params p; const float* W; float* sw; int l, which, N, pad_; HD_FN long count() const { return (long)NCLS * N; }
    HD_FN void operator()(long idx) const { const int n = (int)(idx % N), cls = (int)(idx / N); const float* sh = modv(p, l, cls, which); float acc = 0.f;
        for (int k = 0; k < DM; ++k) acc += sh[k] * rbf(W[(size_t)k * N + n]); sw[idx] = acc; }
};
struct NConv {
    Params p; static HD_FN long count() { return (long)MTOK * CCH; }
    HD_FN void operator()(long idx) const {
        const int row = (int)(idx / CCH), c = (int)(idx % CCH), pos = pos_of(row), len = seqlen_of(row);
        const bf16_t* U = (const bf16_t*)(p.ws + WS_UPRE); float acc = p.convb[c];
        for (int j = 0; j < CWID; ++j) { const int t = pos + j - CWID / 2; if (t >= 0 && t < len) acc += p.convw[(size_t)j * CCH + c] * bf2f(U[(size_t)(row + j - CWID / 2) * CCH + c]); }
        ((float*)(p.ws + WS_HS))[idx] = acc;
    }
};
struct NConvLN {
    Params p; static HD_FN long count() { return MTOK; }
    HD_FN void operator()(long row) const {
        const float* t = (const float*)(p.ws + WS_HS) + (size_t)row * CCH; float mu = 0.f;
        for (int c = 0; c < CCH; ++c) mu += t[c]; mu /= CCH; float var = 0.f;
        for (int c = 0; c < CCH; ++c) { const float d = t[c] - mu; var += d * d; } var /= CCH;
        const float rs = 1.0f / sqrtf(var + EPSF); bf16_t* UH = (bf16_t*)(p.ws + WS_UH) + (size_t)row * DM;
        for (int c = 0; c < CCH; ++c) UH[c] = f2bf(siluf_((t[c] - mu) * rs * p.lng[c] + p.lnb[c]));
    }
};
HD_FN int seq_base(int sid) { return sid < NCB ? sid * CSEQ : MC + (sid - NCB) * LSEQ; }
struct NMlstmDen {
    Params p; static HD_FN long count() { return (long)NSEQ * MH * 2; }
    HD_FN void operator()(long idx) const {
        const int dir = (int)(idx % 2), h = (int)((idx / 2) % MH), sid = (int)(idx / (2 * MH)); const bool isctx = sid < NCB;
        const int base = seq_base(sid), len = isctx ? CSEQ : LSEQ;
        float n[MDK]; float mrun = 0.f;
        if (isctx) {
#pragma unroll
            for (int d = 0; d < MDK; ++d) n[d] = 0.f;
        } else { const int b = sid - NCB; const float em = expf(p.stm[(size_t)(b * 2 + dir) * MH + h]);
#pragma unroll
            for (int d = 0; d < MDK; ++d) n[d] = p.stn[((size_t)(b * 2 + dir) * MH + h) * MDK + d] * em; }
        const bf16_t* QK = (const bf16_t*)(p.ws + WS_QKVO); const float* G = (const float*)(p.ws + WS_GATES); float* DEN = (float*)(p.ws + WS_DEN);
        for (int t = 0; t < len; ++t) {
            const int row = base + (dir == 0 ? t : len - 1 - t);
            const float ig = G[(size_t)row * NGATE + dir * 8 + h], lf = G[(size_t)row * NGATE + dir * 8 + 4 + h];
            const float f = expf(lf), ei = expf(ig); mrun = fmaxf(mrun + lf, ig);
            const bf16_t* q = QK + (size_t)row * 4 * MW + h * MDK; const bf16_t* k = q + MW; float den = 0.f;
#pragma unroll
            for (int d = 0; d < MDK; ++d) { n[d] = f * n[d] + ei * bf2f(k[d]); den += bf2f(q[d]) * n[d]; }
            DEN[((size_t)dir * MTOK + row) * MH + h] = den;
        }
        if (isctx) { const float em = expf(-mrun); p.out[O_M + (size_t)(sid * 2 + dir) * MH + h] = mrun;
#pragma unroll
            for (int d = 0; d < MDK; ++d) p.out[O_N + ((size_t)(sid * 2 + dir) * MH + h) * MDK + d] = n[d] * em; }
    }
};
struct NMlstmNum {
    Params p; int dir; int pad_ = 0; static HD_FN long count() { return (long)NSEQ * MH * MDK; }
    HD_FN void operator()(long idx) const {
        const int v = (int)(idx % MDK), h = (int)((idx / MDK) % MH), sid = (int)(idx / (MDK * MH)); const bool isctx = sid < NCB;
        const int base = seq_base(sid), len = isctx ? CSEQ : LSEQ;
        float C[MDK];
        if (isctx) {
#pragma unroll
            for (int d = 0; d < MDK; ++d) C[d] = 0.f;
        } else { const int b = sid - NCB; const float em = expf(p.stm[(size_t)(b * 2 + dir) * MH + h]);
#pragma unroll
            for (int d = 0; d < MDK; ++d) C[d] = p.stC[(((size_t)(b * 2 + dir) * MH + h) * MDK + d) * MDK + v] * em; }
        const bf16_t* QK = (const bf16_t*)(p.ws + WS_QKVO); const float* G = (const float*)(p.ws + WS_GATES); const float* DEN = (const float*)(p.ws + WS_DEN);
        float* HS = (float*)(p.ws + WS_HS);
        for (int t = 0; t < len; ++t) {
            const int row = base + (dir == 0 ? t : len - 1 - t);
            const float ig = G[(size_t)row * NGATE + dir * 8 + h], lf = G[(size_t)row * NGATE + dir * 8 + 4 + h];
            const float f = expf(lf), ei = expf(ig);
            const bf16_t* q = QK + (size_t)row * 4 * MW + h * MDK; const bf16_t* k = q + MW; const float vv = bf2f(q[2 * MW + v]) * ei; float num = 0.f;
#pragma unroll
            for (int d = 0; d < MDK; ++d) { C[d] = f * C[d] + bf2f(k[d]) * vv; num += bf2f(q[d]) * C[d]; }
            const float den = DEN[((size_t)dir * MTOK + row) * MH + h]; const float hv = num / fmaxf(fabsf(den), 1.0f);
            float* o = HS + (size_t)row * MW + h * MDK + v; if (dir == 0) *o = hv; else *o += hv;
        }
        if (isctx) { const float em = expf(-p.out[O_M + (size_t)(sid * 2 + dir) * MH + h]);
#pragma unroll
            for (int d = 0; d < MDK; ++d) p.out[O_C + (((size_t)(sid * 2 + dir) * MH + h) * MDK + d) * MDK + v] = C[d] * em; }
    }
};
struct NHm {
    Params p; static HD_FN long count() { return (long)MTOK * MH; }
    HD_FN void operator()(long idx) const {
        const int row = (int)(idx / MH), h = (int)(idx % MH); const float* x = (const float*)(p.ws + WS_HS) + (size_t)row * MW + h * MDK; float s = 0.f;
        for (int v = 0; v < MDK; ++v) s += x[v] * x[v];
        const float rs = 1.0f / sqrtf(s / MDK + EPSF); const bf16_t* og = (const bf16_t*)(p.ws + WS_QKVO) + (size_t)row * 4 * MW + 3 * MW + h * MDK;
        bf16_t* UH = (bf16_t*)(p.ws + WS_UH) + (size_t)row * DM + CCH + h * MDK;
        for (int v = 0; v < MDK; ++v) UH[v] = f2bf(bf2f(og[v]) * x[v] * rs * p.mng[h * MDK + v]);
    }
};
struct NCacheCvt {
    Params p; static HD_FN long count() { return (long)NLB * PAST * NKV * HDIM; }
    HD_FN void operator()(long idx) const { const int e = (int)(idx % (NKV * HDIM)), pp = (int)((idx / (NKV * HDIM)) % PAST), b = (int)(idx / ((long)NKV * HDIM * PAST));
        const size_t dst = ((size_t)b * SKVL + LSEQ + pp) * NKV * HDIM + e;
        ((bf16_t*)(p.ws + WS_LATK))[dst] = f2bf(p.ck[idx]); ((bf16_t*)(p.ws + WS_LATV))[dst] = f2bf(p.cv[idx]); }
};
struct NQkPost {
    Params p; static HD_FN long count() { return (long)MTOK * (NQ + NKV); }
    HD_FN void operator()(long idx) const {
        const int row = (int)(idx / (NQ + NKV)), j = (int)(idx % (NQ + NKV)); const bool isq = j < NQ; const bool lat = row >= MC;
        bf16_t* src = isq ? (bf16_t*)(p.ws + WS_QRAW) + (size_t)row * NQ * HDIM + j * HDIM : (bf16_t*)(p.ws + WS_KRAW) + (size_t)row * NKV * HDIM + (j - NQ) * HDIM;
        const float* g = isq ? p.qng : p.kng; float s = 0.f;
        for (int d = 0; d < HDIM; ++d) { const float x = bf2f(src[d]); s += x * x; }
        const float rs = 1.0f / sqrtf(s / HDIM + EPSF);
        bf16_t* dst; float* fo = nullptr;
        if (isq) dst = src;
        else if (!lat) { dst = (bf16_t*)(p.ws + WS_CTXK) + (size_t)row * NKV * HDIM + (j - NQ) * HDIM; fo = p.out + O_K + (size_t)row * NKV * HDIM + (j - NQ) * HDIM; }
        else { const int b = (row - MC) / LSEQ, sp = (row - MC) % LSEQ; dst = (bf16_t*)(p.ws + WS_LATK) + ((size_t)b * SKVL + sp) * NKV * HDIM + (j - NQ) * HDIM; }
        const int sp = pos_of(row); const float prow = (float)(sp / GRIDW), pcol = (float)(sp % GRIDW);
        for (int half = 0; half < 2; ++half)
            for (int d = 0; d < HDIM / 4; ++d) {
                const int i1 = half * (HDIM / 2) + d, i2 = i1 + HDIM / 4;
                const float x1 = bf2f(src[i1]) * rs * g[i1], x2 = bf2f(src[i2]) * rs * g[i2]; float y1 = x1, y2 = x2;
                if (lat) { const float inv = powf(10000.0f, -(float)d / (float)(HDIM / 4)); const float ang = (half == 0 ? prow : pcol) * inv; const float cs = cosf(ang), sn = sinf(ang);
                    y1 = x1 * cs - x2 * sn; y2 = x1 * sn + x2 * cs; }
                dst[i1] = f2bf(y1); dst[i2] = f2bf(y2); if (fo) { fo[i1] = y1; fo[i2] = y2; }
            }
    }
};
struct NAttn {
    Params p; static HD_FN long count() { return (long)MTOK * NQ * 4; }
    HD_FN void operator()(long idx) const {
        const int sl = (int)(idx % 4), hq = (int)((idx / 4) % NQ), row = (int)(idx / (4 * NQ)); const int kv = hq / GRP;
        const bf16_t *Kb, *Vb; int nk;
        if (row < MC) { const int b = row / CSEQ; Kb = (const bf16_t*)(p.ws + WS_CTXK) + (size_t)b * CSEQ * NKV * HDIM; Vb = (const bf16_t*)(p.ws + WS_CTXV) + (size_t)b * CSEQ * NKV * HDIM; nk = CSEQ; }
        else { const int b = (row - MC) / LSEQ; Kb = (const bf16_t*)(p.ws + WS_LATK) + (size_t)b * SKVL * NKV * HDIM; Vb = (const bf16_t*)(p.ws + WS_LATV) + (size_t)b * SKVL * NKV * HDIM; nk = SKVL; }
        const bf16_t* qp = (const bf16_t*)(p.ws + WS_QRAW) + (size_t)row * NQ * HDIM + hq * HDIM;
        float q[HDIM];
#pragma unroll
        for (int d = 0; d < HDIM; ++d) q[d] = bf2f(qp[d]);
        float o[32];
#pragma unroll
        for (int e = 0; e < 32; ++e) o[e] = 0.f;
        float m = -1e30f, l = 0.f; const float scale = 1.0f / sqrtf((float)HDIM);
        for (int s = 0; s < nk; ++s) {
            const bf16_t* kp = Kb + (size_t)s * NKV * HDIM + kv * HDIM; float dot = 0.f;
#pragma unroll
            for (int d = 0; d < HDIM; ++d) dot += q[d] * bf2f(kp[d]);
            dot *= scale; const float mn = fmaxf(m, dot); const float al = expf(m - mn), pe = expf(dot - mn); m = mn; l = l * al + pe;
            const bf16_t* vp = Vb + (size_t)s * NKV * HDIM + kv * HDIM + sl * 32;
#pragma unroll
            for (int e = 0; e < 32; ++e) o[e] = o[e] * al + pe * bf2f(vp[e]);
        }
        bf16_t* op = (bf16_t*)(p.ws + WS_O) + (size_t)row * DM + hq * HDIM + sl * 32;
#pragma unroll
        for (int e = 0; e < 32; ++e) op[e] = f2bf(o[e] / l);
    }
};
struct NFinal {
    Params p; static HD_FN long count() { return (long)MTOK * DM; }
    HD_FN void operator()(long idx) const { const int row = (int)(idx / DM), col = (int)(idx % DM);
        const float rs = 1.0f / sqrtf(((const float*)(p.ws + WS_SSQ))[(size_t)3 * SSQ_STRIDE + row] / DM + EPSF); p.out[O_Y + idx] *= rs * p.fng[col]; }
};
constexpr int NWAVES = 8, NTHREADS = NWAVES * 64;
constexpr int RING_OFF = 0, RING_BYTES = 131072;
constexpr int LDSCTL_OFF = RING_BYTES, MISC_OFF = LDSCTL_OFF + 320;
constexpr int LDS_BYTES = 147456;
constexpr int CW_TMO = 0, CW_CODE = 1, CW_BAR = 4096;
__device__ __forceinline__ int tid_opaque() { int t = threadIdx.x; asm volatile("" : "+v"(t)); return t; }
template <int M> __device__ __forceinline__ float swz_xor(float v) { return __int_as_float(__builtin_amdgcn_ds_swizzle(__float_as_int(v), (M << 10) | 0x1f)); }
__device__ __forceinline__ float half_sum(float v) { auto rr = __builtin_amdgcn_permlane32_swap(__float_as_uint(v), __float_as_uint(v), false, false); return __uint_as_float(rr[0]) + __uint_as_float(rr[1]); }
__device__ __forceinline__ float half_max(float v) { auto rr = __builtin_amdgcn_permlane32_swap(__float_as_uint(v), __float_as_uint(v), false, false); return fmaxf(__uint_as_float(rr[0]), __uint_as_float(rr[1])); }
__device__ __forceinline__ float lane_get(float v, int src_lane) { return __int_as_float(__builtin_amdgcn_ds_bpermute(src_lane << 2, __float_as_int(v))); }
#define GAS __attribute__((address_space(1)))
#define LAS __attribute__((address_space(3)))
typedef GAS unsigned gu32;
#define RLX_AGENT __ATOMIC_RELAXED, __HIP_MEMORY_SCOPE_AGENT
#define XB_TMO      128
#define XB_XCNT(j)  (256  + 64 * (j))
#define XB_XSUB(j)  (1280 + 64 * (j))
#define XB_XGEN(j)  (2304 + 64 * (j))
#define XB_TOP      3328
#define XB_TOPGEN   3392
#define XCD_BAR_WORDS 3456
#define XB_SPIN_CAP (1u << 22)
__device__ __forceinline__ unsigned xb_ld(unsigned* p)              { return __hip_atomic_load(p, __ATOMIC_RELAXED, __HIP_MEMORY_SCOPE_AGENT); }
__device__ __forceinline__ unsigned xb_add(unsigned* p, unsigned v) { return __hip_atomic_fetch_add(p, v, __ATOMIC_RELAXED, __HIP_MEMORY_SCOPE_AGENT); }
__device__ __forceinline__ unsigned xb_xcc_id() { return (unsigned)__builtin_amdgcn_s_getreg((3 << 11) | 20) & 0xFu; }
#define XB_SPIN(cond, bar) do { unsigned _sp = 0; while (cond) { __builtin_amdgcn_s_sleep(1); \
    if ((++_sp & 255u) == 0u) { if (xb_ld(&(bar)[XB_TMO])) break; if (_sp > XB_SPIN_CAP) { atomicAdd(&(bar)[XB_TMO], 1u); break; } } } } while (0)
struct XcdBarrier { unsigned* bar; unsigned x; volatile LAS unsigned* st; };
__device__ __forceinline__ XcdBarrier xcd_barrier_post(unsigned* bar, volatile LAS unsigned* st) {
    XcdBarrier b; b.bar = bar; b.x = xb_xcc_id(); b.st = st;
    if (threadIdx.x == 0) (void)xb_add(&bar[XB_XCNT(b.x)], 1u);
    return b;
}
__device__ __forceinline__ void xcd_barrier_complete(unsigned* bar, unsigned x, unsigned& nloc, unsigned& nx) {
    const unsigned G = gridDim.x * gridDim.y * gridDim.z;
    unsigned sum, cnt, mine, sp = 0u;
    for (;;) {
        sum = 0u; cnt = 0u; mine = 0u;
#pragma unroll
        for (unsigned j = 0; j < 16; ++j) { const unsigned c = xb_ld(&bar[XB_XCNT(j)]); sum += c; cnt += (c > 0u) ? 1u : 0u; mine = (j == x) ? c : mine; }
        if (sum == G) break;
        __builtin_amdgcn_s_sleep(1);
        if ((++sp & 255u) == 0u) { if (xb_ld(&bar[XB_TMO])) break; if (sp > XB_SPIN_CAP) { atomicAdd(&bar[XB_TMO], 1u); break; } }
    }
    nloc = mine > 0u ? mine : 1u; nx = cnt > 0u ? cnt : 1u;
}
__device__ __forceinline__ void xcd_barrier(const XcdBarrier& b) {
    asm volatile("s_waitcnt vmcnt(0)" ::: "memory");
    __syncthreads();
    if (threadIdx.x == 0) {
        unsigned* bar = b.bar;
        __builtin_amdgcn_s_waitcnt(0);
        unsigned nloc = b.st[0], nx = b.st[1];
        if (nloc == 0u) { xcd_barrier_complete(bar, b.x, nloc, nx); b.st[0] = nloc; b.st[1] = nx; }
        const unsigned old = xb_add(&bar[XB_XSUB(b.x)], 1u);
        const unsigned gen = old / nloc;
        if (old + 1u == (gen + 1u) * nloc) {
            __builtin_amdgcn_fence(__ATOMIC_RELEASE, "agent");
            asm volatile("s_waitcnt vmcnt(0)" ::: "memory");
            const unsigned og = xb_add(&bar[XB_TOP], 1u);
            const unsigned tg = og / nx;
            if (og + 1u == (tg + 1u) * nx) xb_add(&bar[XB_TOPGEN], 1u);
            else XB_SPIN(xb_ld(&bar[XB_TOPGEN]) == tg, bar);
            __builtin_amdgcn_fence(__ATOMIC_ACQUIRE, "agent");
            xb_add(&bar[XB_XGEN(b.x)], 1u);
            asm volatile("s_waitcnt vmcnt(0)" ::: "memory");
        } else {
            XB_SPIN(xb_ld(&bar[XB_XGEN(b.x)]) == gen, bar);
            __builtin_amdgcn_fence(__ATOMIC_ACQUIRE, "agent");
            asm volatile("s_waitcnt vmcnt(0)" ::: "memory");
        }
    }
    __syncthreads();
}
namespace pg8 {
#define PG8_LAS __attribute__((address_space(3)))
typedef unsigned short bf16_t;
typedef short bf16x8 __attribute__((ext_vector_type(8)));
typedef float f32x4 __attribute__((ext_vector_type(4)));
typedef unsigned u32x4 __attribute__((ext_vector_type(4)));
constexpr int BM = 256, BK = 64, HALF = 128, HTB = HALF * BK * 2  , STAGE_BYTES = 8 * HTB, NXCD = 8, WGM = 8;

__host__ __device__ __forceinline__ int lds_byte(int r, int c) { const int st = (r >> 4) * 2 + (c >> 5), rr = r & 15, cc = c & 31, ob = rr * 64 + cc * 2; return st * 1024 + (ob ^ (((ob >> 9) & 1) << 5)); }
__host__ __device__ __forceinline__ void stage_rc(int b, int& R, int& C) { const int st = b / 1024, sb = b % 1024, swz = sb ^ (((sb >> 9) & 1) << 5); R = (st >> 1) * 16 + swz / 64; C = (st & 1) * 32 + (swz % 64) / 2; }
__host__ __device__ __forceinline__ int perm32(int rho) { const int n = rho >> 4, i = rho & 15; return 8 * (i >> 2) + 4 * n + (i & 3); }

struct Unit { int pm, pn, k0, nt, role, slot; };
struct Gemm { const bf16_t* A; const bf16_t* Bt; int M, N, K; };

struct StaticOrder {
    int nM, nN, nwg, G, c, ntK;
    __host__ __device__ void init(int M, int N, int K, int G_, int c_) { nM = M / BM; nN = N / BM; nwg = nM * nN; G = G_; c = c_; ntK = K / BK; }
    __host__ __device__ void map(int L, Unit& u) const { int wgid = L; { const int q = nwg / NXCD, r = nwg % NXCD, xcd = wgid % NXCD, off = wgid / NXCD; wgid = (xcd < r ? xcd * (q + 1) : r * (q + 1) + (xcd - r) * q) + off; }
        const int nig = WGM * nN, gid = wgid / nig, fm = gid * WGM, gsz = (nM - fm) < WGM ? (nM - fm) : WGM; u.pm = fm + ((wgid % nig) % gsz); u.pn = (wgid % nig) / gsz; }
    __host__ __device__ bool next(int i, Unit& u) const {
        const long L = (long)i * G + c; if (L >= nwg) return false;
        int wgid = (int)L; { const int q = nwg / NXCD, r = nwg % NXCD, xcd = wgid % NXCD, off = wgid / NXCD; wgid = (xcd < r ? xcd * (q + 1) : r * (q + 1) + (xcd - r) * q) + off; }
        const int nig = WGM * nN, gid = wgid / nig, fm = gid * WGM, gsz = (nM - fm) < WGM ? (nM - fm) : WGM;
        u.pm = fm + ((wgid % nig) % gsz); u.pn = (wgid % nig) / gsz; u.k0 = 0; u.nt = ntK; u.role = 0; u.slot = 0; return true;
    }
    __device__ __forceinline__ void a_ready(const Unit&) const {}
    __device__ __forceinline__ void done(const Unit&) const {}
};

__device__ __forceinline__ unsigned cvt_pk_bf16(float lo, float hi) { unsigned r; asm volatile("v_cvt_pk_bf16_f32 %0, %1, %2" : "=v"(r) : "v"(lo), "v"(hi)); return r; }
typedef float f32x2 __attribute__((ext_vector_type(2)));
template <class Epi, class Sched, bool ALIGN_EPI = false, bool SP2 = false>
__device__ __forceinline__ void gemm_phase(PG8_LAS unsigned char* lds, const Gemm g, const Sched& S, const Epi& E) {
    const int tid = tid_opaque(), wid = __builtin_amdgcn_readfirstlane(tid >> 6), lane = tid & 63, wr = wid >> 2, wc = wid & 3, fr = lane & 15, fq = lane >> 4;
    const int K = g.K;
    unsigned voffA[2], voffB[2];
#pragma unroll
    for (int i = 0; i < 2; ++i) { int R, C; stage_rc(tid * 16 + i * 8192, R, C); const int Rb = Epi::PERM ? ((R & ~31) + perm32(R & 31)) : R;
        voffA[i] = (unsigned)(R * K + C) * 2u; voffB[i] = (unsigned)(Rb * K + C) * 2u; }
    const size_t kstep = (size_t)(BK * 2);
    const size_t hstep = (size_t)HALF * K * 2;
    const size_t tstep = 2 * hstep;
    const unsigned ldsw = (unsigned)wid * 1024u;
    const int aoff = lds_byte(wr * 64 + fr, fq * 8), boff = lds_byte(wc * 32 + fr, fq * 8);
#define PG8_SA(b, h) (((b) * 2 + (h)) * HTB)
#define PG8_SB(b, h) ((4 + (b) * 2 + (h)) * HTB)
#define PG8_STAGE(bufoff, gbase, voff) do { _Pragma("unroll") for (int _i = 0; _i < 2; ++_i) \
        __builtin_amdgcn_global_load_lds((const unsigned*)((const char*)(gbase) + (voff)[_i]), (PG8_LAS unsigned*)(lds + (bufoff) + ldsw + _i * 8192), 16, 0, 0); } while (0)
#define PG8_LDA(dst, b, h) do { _Pragma("unroll") for (int m = 0; m < 4; ++m) _Pragma("unroll") for (int k = 0; k < 2; ++k) dst[m][k] = *(const PG8_LAS bf16x8*)(lds + PG8_SA(b, h) + aoff + m * 2048 + k * 1024); } while (0)
#define PG8_LDB(dst, b, h) do { _Pragma("unroll") for (int n = 0; n < 2; ++n) _Pragma("unroll") for (int k = 0; k < 2; ++k) dst[n][k] = *(const PG8_LAS bf16x8*)(lds + PG8_SB(b, h) + boff + n * 2048 + k * 1024); } while (0)
#define PG8_MMA(ai, bj, At, Bt) do { __builtin_amdgcn_s_setprio(1); _Pragma("unroll") for (int m = 0; m < 4; ++m) _Pragma("unroll") for (int n = 0; n < 2; ++n) _Pragma("unroll") for (int k = 0; k < 2; ++k) \
        acc[ai][bj][m][n] = __builtin_amdgcn_mfma_f32_16x16x32_bf16(Bt[n][k], At[m][k], acc[ai][bj][m][n], 0, 0, 0); __builtin_amdgcn_s_setprio(0); } while (0)
#define PG8_WAIT_V(n) asm volatile("s_waitcnt vmcnt(" #n ")" ::: "memory")
#define PG8_WAIT_L(n) asm volatile("s_waitcnt lgkmcnt(" #n ")" ::: "memory")
#define PG8_BAR __builtin_amdgcn_s_barrier()
#define PG8_SCHED __builtin_amdgcn_sched_barrier(0)
    Unit cur, nxt; int ui = 0;
    if (!S.next(0, cur)) return;
    f32x4 acc[2][2][4][2];
#pragma unroll
    for (int a = 0; a < 2; ++a)
#pragma unroll
        for (int b = 0; b < 2; ++b)
#pragma unroll
            for (int m = 0; m < 4; ++m)
#pragma unroll
                for (int n = 0; n < 2; ++n) acc[a][b][m][n] = (f32x4){0.f, 0.f, 0.f, 0.f};
    bf16x8 At[4][2], B0[2][2], B1[2][2];
    const char* cA = (const char*)g.A + (size_t)cur.pm * tstep + (size_t)cur.k0 * kstep; const char* cB = (const char*)g.Bt + (size_t)cur.pn * tstep + (size_t)cur.k0 * kstep; int nt = cur.nt;
    S.a_ready(cur);
    if constexpr (SP2) {
        PG8_STAGE(PG8_SB(0, 0), cB, voffB); PG8_STAGE(PG8_SB(0, 1), cB + hstep, voffB); PG8_STAGE(PG8_SA(0, 0), cA, voffA); PG8_STAGE(PG8_SA(0, 1), cA + hstep, voffA);
        if (wr == 1) PG8_BAR;
        PG8_WAIT_V(2); PG8_BAR;
        PG8_STAGE(PG8_SB(1, 0), cB + kstep, voffB); PG8_STAGE(PG8_SA(1, 0), cA + kstep, voffA); PG8_STAGE(PG8_SB(1, 1), cB + hstep + kstep, voffB);
        PG8_WAIT_V(6); PG8_BAR;
    } else {
        PG8_STAGE(PG8_SB(0, 0), cB, voffB); PG8_STAGE(PG8_SA(0, 0), cA, voffA); PG8_STAGE(PG8_SB(0, 1), cB + hstep, voffB); PG8_STAGE(PG8_SA(0, 1), cA + hstep, voffA);
        if (wr == 1) PG8_BAR;
        PG8_WAIT_V(4); PG8_BAR;
        PG8_STAGE(PG8_SB(1, 0), cB + kstep, voffB); PG8_STAGE(PG8_SA(1, 0), cA + kstep, voffA); PG8_STAGE(PG8_SB(1, 1), cB + hstep + kstep, voffB);
        PG8_WAIT_V(6); PG8_BAR;
    }
    for (;;) {
        const bool has_next = S.next(ui + 1, nxt);
        const char* nA = has_next ? (const char*)g.A + (size_t)nxt.pm * tstep + (size_t)nxt.k0 * kstep : cA; const char* nB = has_next ? (const char*)g.Bt + (size_t)nxt.pn * tstep + (size_t)nxt.k0 * kstep : cB;
        for (int t = 0; t < nt; t += 2) {
            const bool last = (t == nt - 2);
            const char* a1 = cA + (size_t)(t + 1) * kstep;
            const char* a2 = last ? nA : cA + (size_t)(t + 2) * kstep; const char* b2 = last ? nB : cB + (size_t)(t + 2) * kstep;
            const char* a3 = a2 + kstep; const char* b3 = b2 + kstep;
            if (last && has_next) S.a_ready(nxt);
            if constexpr (SP2) {
            PG8_LDB(B0, 0, 0); PG8_LDB(B1, 0, 1); PG8_SCHED; PG8_LDA(At, 0, 0); PG8_STAGE(PG8_SA(1, 1), a1 + hstep, voffA);
            PG8_WAIT_V(8); PG8_WAIT_L(0); PG8_BAR; PG8_MMA(0, 0, At, B0); PG8_MMA(0, 1, At, B1); PG8_BAR; PG8_SCHED;
            PG8_LDA(At, 0, 1); PG8_STAGE(PG8_SB(0, 0), b2, voffB); PG8_STAGE(PG8_SB(0, 1), b2 + hstep, voffB); PG8_STAGE(PG8_SA(0, 0), a2, voffA);
            PG8_WAIT_V(8); PG8_WAIT_L(0); PG8_BAR; PG8_MMA(1, 0, At, B0); PG8_MMA(1, 1, At, B1); PG8_BAR; PG8_SCHED;
            PG8_LDB(B0, 1, 0); PG8_LDB(B1, 1, 1); PG8_SCHED; PG8_LDA(At, 1, 0); PG8_STAGE(PG8_SA(0, 1), a2 + hstep, voffA);
            PG8_WAIT_V(8); PG8_WAIT_L(0); PG8_BAR; PG8_MMA(0, 0, At, B0); PG8_MMA(0, 1, At, B1); PG8_BAR; PG8_SCHED;
            PG8_LDA(At, 1, 1); PG8_STAGE(PG8_SB(1, 0), b3, voffB); PG8_STAGE(PG8_SB(1, 1), b3 + hstep, voffB); PG8_STAGE(PG8_SA(1, 0), a3, voffA);
            PG8_WAIT_V(8); PG8_WAIT_L(0); PG8_BAR; PG8_MMA(1, 0, At, B0); PG8_MMA(1, 1, At, B1); PG8_BAR; PG8_SCHED;
            } else {
            PG8_LDB(B0, 0, 0); PG8_SCHED; PG8_LDA(At, 0, 0); PG8_STAGE(PG8_SA(1, 1), a1 + hstep, voffA);
            PG8_WAIT_L(8); PG8_BAR; PG8_WAIT_L(0); PG8_MMA(0, 0, At, B0); PG8_BAR; PG8_SCHED;
            PG8_LDB(B1, 0, 1); PG8_STAGE(PG8_SB(0, 0), b2, voffB);
            PG8_BAR; PG8_WAIT_L(0); PG8_MMA(0, 1, At, B1); PG8_BAR;
            PG8_LDA(At, 0, 1); PG8_STAGE(PG8_SA(0, 0), a2, voffA);
            PG8_BAR; PG8_WAIT_L(0); PG8_MMA(1, 0, At, B0); PG8_BAR; PG8_SCHED;
            PG8_STAGE(PG8_SB(0, 1), b2 + hstep, voffB);
            PG8_WAIT_V(6); PG8_BAR; PG8_MMA(1, 1, At, B1); PG8_BAR;
            PG8_LDB(B0, 1, 0); PG8_SCHED; PG8_LDA(At, 1, 0); PG8_STAGE(PG8_SA(0, 1), a2 + hstep, voffA);
            PG8_WAIT_L(8); PG8_BAR; PG8_WAIT_L(0); PG8_MMA(0, 0, At, B0); PG8_BAR; PG8_SCHED;
            PG8_LDB(B1, 1, 1); PG8_STAGE(PG8_SB(1, 0), b3, voffB);
            PG8_BAR; PG8_WAIT_L(0); PG8_MMA(0, 1, At, B1); PG8_BAR;
            PG8_LDA(At, 1, 1); PG8_STAGE(PG8_SA(1, 0), a3, voffA);
            PG8_BAR; PG8_WAIT_L(0); PG8_MMA(1, 0, At, B0); PG8_BAR; PG8_SCHED;
            PG8_STAGE(PG8_SB(1, 1), b3 + hstep, voffB);
            PG8_WAIT_V(6); PG8_BAR; PG8_MMA(1, 1, At, B1); PG8_BAR;
            }
        }
        if constexpr (ALIGN_EPI) { if (wr == 0) PG8_BAR; }
        if constexpr (!Epi::AFTER_DRAIN) { E(acc, cur, wr, wc, fr, fq); S.done(cur); }
        if (!has_next) break;
#pragma unroll
        for (int a = 0; a < 2; ++a)
#pragma unroll
            for (int b = 0; b < 2; ++b)
#pragma unroll
                for (int m = 0; m < 4; ++m)
#pragma unroll
                    for (int n = 0; n < 2; ++n) acc[a][b][m][n] = (f32x4){0.f, 0.f, 0.f, 0.f};
        cur = nxt; cA = nA; cB = nB; nt = cur.nt; ++ui;
        if constexpr (ALIGN_EPI) { if (wr == 1) PG8_BAR; }
    }
    PG8_WAIT_V(0);
    if constexpr (!ALIGN_EPI) { if (wr == 0) PG8_BAR; }
    PG8_BAR;
    if constexpr (Epi::AFTER_DRAIN) { E.fused(acc, cur, wr, wc, fr, fq, lds, wid, lane); S.done(cur); }
#undef PG8_SA
#undef PG8_SB
#undef PG8_STAGE
#undef PG8_LDA
#undef PG8_LDB
#undef PG8_MMA
#undef PG8_WAIT_V
#undef PG8_WAIT_L
#undef PG8_BAR
#undef PG8_SCHED
}
}
constexpr size_t WB_AB = 2 * MiB, WB_OUTAB = 8 * MiB, WB_FFI0 = 10 * MiB, WB_FFO0 = 21 * MiB, WB_INC = 27 * MiB, WB_OUTC = 30 * MiB, WB_FFI1 = 32 * MiB, WB_FFO1 = 43 * MiB;
static_assert(WB_FFO1 + (size_t)DM * DFF * 2 <= WS_XN && WB_AB + (size_t)ABMAIN * DM * 2 <= WB_OUTAB && WB_FFI0 + (size_t)2 * DFF * DM * 2 <= WB_FFO0 && WB_FFO0 + (size_t)DM * DFF * 2 <= WB_INC &&
              WB_INC + (size_t)CIN * DM * 2 <= WB_OUTC && WB_FFI1 + (size_t)2 * DFF * DM * 2 <= WB_FFO1, "weight copy map");

typedef unsigned v4u __attribute__((ext_vector_type(4)));
typedef unsigned v2u __attribute__((ext_vector_type(2)));
typedef float f32x4 __attribute__((ext_vector_type(4)));
__device__ __forceinline__ unsigned pk2(float lo, float hi) { return (unsigned)f2bf(lo) | ((unsigned)f2bf(hi) << 16); }
__device__ __forceinline__ float fsigmoid(float x) { return __builtin_amdgcn_rcpf(1.0f + __builtin_amdgcn_exp2f(-1.4426950408889634f * x)); }

__device__ __forceinline__ void p0_transpose_item(const float* W, int K, int ldw, int c0, int k0, bf16_t* WT, int drow, LAS float* scr, int lane) {
    { f32x4 tv[8]; const int rr = lane >> 3, cg = (lane & 7) * 4;
#pragma unroll
      for (int i = 0; i < 8; ++i) tv[i] = *(const f32x4*)(W + (size_t)(k0 + 8 * i + rr) * ldw + c0 + cg);
#pragma unroll
      for (int i = 0; i < 8; ++i) { LAS float* d = scr + (8 * i + rr) * 33 + cg; d[0] = tv[i][0]; d[1] = tv[i][1]; d[2] = tv[i][2]; d[3] = tv[i][3]; } }
    asm volatile("s_waitcnt lgkmcnt(0)" ::: "memory");
    const int c = lane & 7;
#pragma unroll
    for (int j = 0; j < 4; ++j) { const int n = (lane >> 3) + 8 * j; const LAS float* s = scr + (8 * c) * 33 + n;
        v4u o; o.x = pk2(s[0 * 33], s[1 * 33]); o.y = pk2(s[2 * 33], s[3 * 33]); o.z = pk2(s[4 * 33], s[5 * 33]); o.w = pk2(s[6 * 33], s[7 * 33]);
        *(GAS v4u*)(WT + (size_t)(drow + n) * K + k0 + 8 * c) = o; }
    asm volatile("s_waitcnt lgkmcnt(0)" ::: "memory");
}
struct CvtJob { const float* W; bf16_t* WT; int K, ldw, c0, ncols, mode, Hn, dbase; };
__device__ __forceinline__ int cvt_items(const CvtJob& j) { return (j.K / 64) * (j.ncols / 32); }
__device__ __forceinline__ void cvt_run(const CvtJob& j, int item, LAS float* scr, int lane) {
    const int nblk = j.ncols / 32, kb = item / nblk, nb = item % nblk; const int c = j.c0 + 32 * nb;
    int drow; if (j.mode == 0) drow = j.dbase + 32 * nb; else { const int cc = c < j.Hn ? c : c - j.Hn; drow = 256 * (cc / 128) + (cc % 128) + (c < j.Hn ? 0 : 128); }
    p0_transpose_item(j.W, j.K, j.ldw, c, 64 * kb, j.WT, drow, scr, lane);
}
__device__ __forceinline__ void p0_weights(const Params& p, LAS unsigned char* lds, int vcu, int G) {
    const int tid_ = tid_opaque(); const int lane = tid_ & 63, wave = __builtin_amdgcn_readfirstlane(tid_ >> 6);
    LAS float* scr = (LAS float*)(lds + wave * 16384);
    const int gw = vcu * NWAVES + wave, NGW = G * NWAVES;
    CvtJob jobs[9] = {
        {p.winab, (bf16_t*)(p.ws + WB_AB), DM, ABIN, 0, 2 * CCH, 1, CCH, 0},
        {p.winab, (bf16_t*)(p.ws + WB_AB), DM, ABIN, 2 * CCH, 4 * MW, 0, 0, 2 * CCH},
        {p.woutab, (bf16_t*)(p.ws + WB_OUTAB), DM, DM, 0, DM, 0, 0, 0},
        {p.wffi, (bf16_t*)(p.ws + WB_FFI0), DM, 2 * DFF, 0, 2 * DFF, 1, DFF, 0},
        {p.wffo, (bf16_t*)(p.ws + WB_FFO0), DFF, DM, 0, DM, 0, 0, 0},
        {p.winc, (bf16_t*)(p.ws + WB_INC), DM, CIN, 0, CIN, 0, 0, 0},
        {p.woutc, (bf16_t*)(p.ws + WB_OUTC), DM, DM, 0, DM, 0, 0, 0},
        {p.wffi + (size_t)DM * 2 * DFF, (bf16_t*)(p.ws + WB_FFI1), DM, 2 * DFF, 0, 2 * DFF, 1, DFF, 0},
        {p.wffo + (size_t)DFF * DM, (bf16_t*)(p.ws + WB_FFO1), DFF, DM, 0, DM, 0, 0, 0}};
    int base = 0;
#pragma unroll
    for (int jj = 0; jj < 9; ++jj) {
        const int n = cvt_items(jobs[jj]);
        int first = ((gw - base) % NGW + NGW) % NGW;
        for (int it = first; it < n; it += NGW) cvt_run(jobs[jj], it, scr, lane);
        base += n;
    }
}

struct EpiAB {
    static constexpr bool PERM = true, AFTER_DRAIN = false;
    bf16_t* upre; bf16_t* qkvo;
    __device__ __forceinline__ void operator()(const f32x4 (&acc)[2][2][4][2], const pg8::Unit& u, int wr, int wc, int fr, int fq) const {
        const int row0 = u.pm * 256 + wr * 64 + fr, lc = wc * 32 + 8 * fq;
        if (u.pn < 4) {
#pragma unroll
            for (int ai = 0; ai < 2; ++ai)
#pragma unroll
                for (int m = 0; m < 4; ++m) { const f32x4 a0 = acc[ai][0][m][0], a1 = acc[ai][0][m][1], g0 = acc[ai][1][m][0], g1 = acc[ai][1][m][1]; v4u w;
                    w.x = pg8::cvt_pk_bf16(a0[0] * fsigmoid(g0[0]), a0[1] * fsigmoid(g0[1])); w.y = pg8::cvt_pk_bf16(a0[2] * fsigmoid(g0[2]), a0[3] * fsigmoid(g0[3]));
                    w.z = pg8::cvt_pk_bf16(a1[0] * fsigmoid(g1[0]), a1[1] * fsigmoid(g1[1])); w.w = pg8::cvt_pk_bf16(a1[2] * fsigmoid(g1[2]), a1[3] * fsigmoid(g1[3]));
                    *(v4u*)(upre + (size_t)(row0 + ai * 128 + m * 16) * CCH + 128 * u.pn + lc) = w; }
        } else {
#pragma unroll
            for (int bj = 0; bj < 2; ++bj) { const int col = 256 * (u.pn - 4) + 128 * bj + lc; const int part = col / MW; const float sc = part == 1 ? 0.08838834764831845f : 1.0f;
#pragma unroll
                for (int ai = 0; ai < 2; ++ai)
#pragma unroll
                    for (int m = 0; m < 4; ++m) { f32x4 v0 = acc[ai][bj][m][0] * sc, v1 = acc[ai][bj][m][1] * sc;
                        if (part == 3) { v0 = (f32x4){fsigmoid(v0[0]), fsigmoid(v0[1]), fsigmoid(v0[2]), fsigmoid(v0[3])}; v1 = (f32x4){fsigmoid(v1[0]), fsigmoid(v1[1]), fsigmoid(v1[2]), fsigmoid(v1[3])}; }
                        v4u w; w.x = pg8::cvt_pk_bf16(v0[0], v0[1]); w.y = pg8::cvt_pk_bf16(v0[2], v0[3]); w.z = pg8::cvt_pk_bf16(v1[0], v1[1]); w.w = pg8::cvt_pk_bf16(v1[2], v1[3]);
                        *(v4u*)(qkvo + (size_t)(row0 + ai * 128 + m * 16) * (4 * MW) + col) = w; } }
        }
    }
};
static_assert(MDK == 128, "EpiAB hard-codes MDK^-0.5");
struct EpiRes {
    static constexpr bool PERM = true, AFTER_DRAIN = false;
    const float* xp; const float* xs;
    bf16_t* Y16; bf16_t* XN; float* ssq; const float* mod_g; const float* mod_sc; const float* ng;
    int from_input; int pad_;
    __device__ __forceinline__ float piece(int row, int col, int cls, f32x4 v0, f32x4 v1) const {
        const float* gv = mod_g + (size_t)cls * 6 * DM + col; const size_t off = (size_t)row * DM + col; f32x4 x0, x1;
        if (from_input) { const float* xin = (row < MC ? xp : xs - (size_t)MC * DM) + off; x0 = *(const f32x4*)xin; x1 = *(const f32x4*)(xin + 4); }
        else { const v4u r = *(const v4u*)(Y16 + off); x0 = (f32x4){__uint_as_float(r.x << 16), __uint_as_float(r.x & 0xffff0000u), __uint_as_float(r.y << 16), __uint_as_float(r.y & 0xffff0000u)};
            x1 = (f32x4){__uint_as_float(r.z << 16), __uint_as_float(r.z & 0xffff0000u), __uint_as_float(r.w << 16), __uint_as_float(r.w & 0xffff0000u)}; }
        x0 += *(const f32x4*)gv * v0; x1 += *(const f32x4*)(gv + 4) * v1;
        v4u w; w.x = pg8::cvt_pk_bf16(x0[0], x0[1]); w.y = pg8::cvt_pk_bf16(x0[2], x0[3]); w.z = pg8::cvt_pk_bf16(x1[0], x1[1]); w.w = pg8::cvt_pk_bf16(x1[2], x1[3]); *(v4u*)(Y16 + off) = w;
        if (ng) { const float* scv = mod_sc + (size_t)cls * 6 * DM + col; const f32x4 t0 = x0 * (*(const f32x4*)(ng + col) * (*(const f32x4*)scv + 1.0f)), t1 = x1 * (*(const f32x4*)(ng + col + 4) * (*(const f32x4*)(scv + 4) + 1.0f));
            v4u q; q.x = pg8::cvt_pk_bf16(t0[0], t0[1]); q.y = pg8::cvt_pk_bf16(t0[2], t0[3]); q.z = pg8::cvt_pk_bf16(t1[0], t1[1]); q.w = pg8::cvt_pk_bf16(t1[2], t1[3]); *(v4u*)(XN + off) = q; }
        return ((x0[0] * x0[0] + x0[1] * x0[1]) + (x0[2] * x0[2] + x0[3] * x0[3])) + ((x1[0] * x1[0] + x1[1] * x1[1]) + (x1[2] * x1[2] + x1[3] * x1[3]));
    }
    __device__ __forceinline__ void operator()(const f32x4 (&acc)[2][2][4][2], const pg8::Unit& u, int wr, int wc, int fr, int fq) const {
        const int row0 = u.pm * 256 + wr * 64 + fr; const int cls = cls_of(u.pm * 256); const int colb = u.pn * 256 + wc * 32 + 8 * fq;
        f32x4 g4[2][2], gs4[2][2];
#pragma unroll
        for (int bj = 0; bj < 2; ++bj)
#pragma unroll
            for (int n = 0; n < 2; ++n) { const int col = colb + bj * 128 + 4 * n; g4[bj][n] = *(const f32x4*)(mod_g + (size_t)cls * 6 * DM + col);
                gs4[bj][n] = ng ? *(const f32x4*)(ng + col) * (*(const f32x4*)(mod_sc + (size_t)cls * 6 * DM + col) + 1.0f) : (f32x4){0.f, 0.f, 0.f, 0.f}; }
        if (from_input) run_rows<2>(acc, row0, colb, g4, gs4); else run_rows<4>(acc, row0, colb, g4, gs4);
    }
    template <int MB> __device__ __forceinline__ void run_rows(const f32x4 (&acc)[2][2][4][2], int row0, int colb, const f32x4 (&g4)[2][2], const f32x4 (&gs4)[2][2]) const {
#pragma unroll
        for (int ai = 0; ai < 2; ++ai)
#pragma unroll
            for (int mb = 0; mb < 4; mb += MB) {
                f32x4 x[MB][2][2];
                if (from_input) {
#pragma unroll
                    for (int mm = 0; mm < MB; ++mm)
#pragma unroll
                        for (int bj = 0; bj < 2; ++bj) { const int row = row0 + ai * 128 + (mb + mm) * 16; const float* xin = (row < MC ? xp : xs - (size_t)MC * DM) + (size_t)row * DM + colb + bj * 128; x[mm][bj][0] = *(const f32x4*)xin; x[mm][bj][1] = *(const f32x4*)(xin + 4); }
                } else { v4u r[MB][2];
#pragma unroll
                    for (int mm = 0; mm < MB; ++mm)
#pragma unroll
                        for (int bj = 0; bj < 2; ++bj) r[mm][bj] = *(const v4u*)(Y16 + (size_t)(row0 + ai * 128 + (mb + mm) * 16) * DM + colb + bj * 128);
#pragma unroll
                    for (int mm = 0; mm < MB; ++mm)
#pragma unroll
                        for (int bj = 0; bj < 2; ++bj) { const v4u q = r[mm][bj]; x[mm][bj][0] = (f32x4){__uint_as_float(q.x << 16), __uint_as_float(q.x & 0xffff0000u), __uint_as_float(q.y << 16), __uint_as_float(q.y & 0xffff0000u)};
                            x[mm][bj][1] = (f32x4){__uint_as_float(q.z << 16), __uint_as_float(q.z & 0xffff0000u), __uint_as_float(q.w << 16), __uint_as_float(q.w & 0xffff0000u)}; }
                }
#pragma unroll
                for (int mm = 0; mm < MB; ++mm) { const int m = mb + mm; const int row = row0 + ai * 128 + m * 16; float s = 0.f;
#pragma unroll
                    for (int bj = 0; bj < 2; ++bj) { const size_t off = (size_t)row * DM + colb + bj * 128;
                        const f32x4 x0 = x[mm][bj][0] + g4[bj][0] * acc[ai][bj][m][0], x1 = x[mm][bj][1] + g4[bj][1] * acc[ai][bj][m][1];
                        v4u w; w.x = pg8::cvt_pk_bf16(x0[0], x0[1]); w.y = pg8::cvt_pk_bf16(x0[2], x0[3]); w.z = pg8::cvt_pk_bf16(x1[0], x1[1]); w.w = pg8::cvt_pk_bf16(x1[2], x1[3]); *(v4u*)(Y16 + off) = w;
                        if (ng) { const f32x4 t0 = x0 * gs4[bj][0], t1 = x1 * gs4[bj][1]; v4u q; q.x = pg8::cvt_pk_bf16(t0[0], t0[1]); q.y = pg8::cvt_pk_bf16(t0[2], t0[3]); q.z = pg8::cvt_pk_bf16(t1[0], t1[1]); q.w = pg8::cvt_pk_bf16(t1[2], t1[3]); *(v4u*)(XN + off) = q; }
                        s += ((x0[0] * x0[0] + x0[1] * x0[1]) + (x0[2] * x0[2] + x0[3] * x0[3])) + ((x1[0] * x1[0] + x1[1] * x1[1]) + (x1[2] * x1[2] + x1[3] * x1[3])); }
                    s += __shfl_xor(s, 16); s += __shfl_xor(s, 32); if (fq_() == 0) atomicAdd(ssq + row, s); }
                asm volatile("" ::: "memory");
            }
    }
    __device__ __forceinline__ static int fq_() { return (threadIdx.x >> 4) & 3; }
};
struct EpiFfnIn {
    static constexpr bool PERM = true, AFTER_DRAIN = false;
    bf16_t* H; const float* ssq; const float* sw;
    __device__ __forceinline__ void operator()(const f32x4 (&acc)[2][2][4][2], const pg8::Unit& u, int wr, int wc, int fr, int fq) const {
        const int row0 = u.pm * 256 + wr * 64 + fr, lc = wc * 32 + 8 * fq; const int cls = cls_of(u.pm * 256); const int col = 128 * u.pn + lc;
        const float* swr = sw + (size_t)cls * 2 * DFF;
        const f32x4 sg0 = *(const f32x4*)(swr + col), sg1 = *(const f32x4*)(swr + col + 4), su0 = *(const f32x4*)(swr + DFF + col), su1 = *(const f32x4*)(swr + DFF + col + 4);
#pragma unroll
        for (int ai = 0; ai < 2; ++ai)
#pragma unroll
            for (int m = 0; m < 4; ++m) { const int row = row0 + ai * 128 + m * 16; const float rs = 1.0f / sqrtf(ssq[row] * (1.0f / DM) + EPSF);
                const f32x4 a0 = acc[ai][0][m][0] * rs + sg0, a1 = acc[ai][0][m][1] * rs + sg1, b0 = acc[ai][1][m][0] * rs + su0, b1 = acc[ai][1][m][1] * rs + su1; v4u w;
                w.x = pg8::cvt_pk_bf16(a0[0] * fsigmoid(a0[0]) * b0[0], a0[1] * fsigmoid(a0[1]) * b0[1]); w.y = pg8::cvt_pk_bf16(a0[2] * fsigmoid(a0[2]) * b0[2], a0[3] * fsigmoid(a0[3]) * b0[3]);
                w.z = pg8::cvt_pk_bf16(a1[0] * fsigmoid(a1[0]) * b1[0], a1[1] * fsigmoid(a1[1]) * b1[1]); w.w = pg8::cvt_pk_bf16(a1[2] * fsigmoid(a1[2]) * b1[2], a1[3] * fsigmoid(a1[3]) * b1[3]);
                *(v4u*)(H + (size_t)row * DFF + col) = w; }
    }
};
struct EpiQkv {
    static constexpr bool PERM = true, AFTER_DRAIN = false;
    bf16_t* qraw; bf16_t* kraw; bf16_t* ctxv; bf16_t* latv; float* outv; const float* ssq; const float* sw;
    __device__ __forceinline__ void operator()(const f32x4 (&acc)[2][2][4][2], const pg8::Unit& u, int wr, int wc, int fr, int fq) const {
        const int row0 = u.pm * 256 + wr * 64 + fr, lc = wc * 32 + 8 * fq; const int cls = cls_of(u.pm * 256); const float* swr = sw + (size_t)cls * CIN;
        float rs[2][4];
#pragma unroll
        for (int ai = 0; ai < 2; ++ai)
#pragma unroll
            for (int m = 0; m < 4; ++m) rs[ai][m] = 1.0f / sqrtf(ssq[row0 + ai * 128 + m * 16] * (1.0f / DM) + EPSF);
#pragma unroll
        for (int bj = 0; bj < 2; ++bj) { const int col = 256 * u.pn + 128 * bj + lc; const f32x4 s0 = *(const f32x4*)(swr + col), s1 = *(const f32x4*)(swr + col + 4);
#pragma unroll
            for (int ai = 0; ai < 2; ++ai)
#pragma unroll
                for (int m = 0; m < 4; ++m) { const int row = row0 + ai * 128 + m * 16; const f32x4 v0 = acc[ai][bj][m][0] * rs[ai][m] + s0, v1 = acc[ai][bj][m][1] * rs[ai][m] + s1;
                    v4u w; w.x = pg8::cvt_pk_bf16(v0[0], v0[1]); w.y = pg8::cvt_pk_bf16(v0[2], v0[3]); w.z = pg8::cvt_pk_bf16(v1[0], v1[1]); w.w = pg8::cvt_pk_bf16(v1[2], v1[3]);
                    if (u.pn < NQ * HDIM / 256) *(v4u*)(qraw + (size_t)row * (NQ * HDIM) + col) = w;
                    else if (u.pn == NQ * HDIM / 256) *(v4u*)(kraw + (size_t)row * (NKV * HDIM) + (col - NQ * HDIM)) = w;
                    else { const int c2 = col - (NQ + NKV) * HDIM;
                        if (row < MC) { *(v4u*)(ctxv + (size_t)row * (NKV * HDIM) + c2) = w; float* o = outv + (size_t)row * (NKV * HDIM) + c2; *(f32x4*)o = v0; *(f32x4*)(o + 4) = v1; }
                        else { const int b = (row - MC) / LSEQ, s = (row - MC) % LSEQ; *(v4u*)(latv + ((size_t)b * SKVL + s) * (NKV * HDIM) + c2) = w; } } } }
    }
};
static_assert(NKV * HDIM == 256 && (NQ * HDIM) % 256 == 0, "EpiQkv tile mapping");

constexpr int CW_SPLIT = 8192;
constexpr size_t SLAB_BYTES = (size_t)64 * 4 * 16 * 512 * 16;
struct RoundZeroOrder : pg8::StaticOrder {
    bool split;
    __device__ void init(int M, int N, int K, int G_, int c_) { pg8::StaticOrder::init(M, N, K, G_, c_); split = (G == 256 && nwg > 256 && nwg <= 320 && ntK >= 8); }
    __device__ bool next(int i, pg8::Unit& u) const { if (split && i > 0) return false; return pg8::StaticOrder::next(i, u); }
};
struct QuarterOrder : pg8::StaticOrder {
    __device__ bool next(int i, pg8::Unit& u) const {
        if (i > 0) return false; const int L = 256 + (c >> 2), q = c & 3; if (L >= nwg) return false;
        map(L, u); const int base = (ntK / 8) * 2, rem = (ntK - 4 * base) / 2;
        int k0 = 0; for (int j = 0; j < q; ++j) k0 += base + (j < rem ? 2 : 0);
        u.k0 = k0; u.nt = base + (q < rem ? 2 : 0); u.role = 1 + q; u.slot = c >> 2; return true;
    }
};
struct EpiPartial {
    static constexpr bool PERM = true, AFTER_DRAIN = false;
    unsigned char* slab; unsigned* cnt;
    __device__ __forceinline__ void operator()(const f32x4 (&acc)[2][2][4][2], const pg8::Unit& u, int wr, int wc, int fr, int fq) const {
        const int tid = (wr * 4 + wc) * 64 + fq * 16 + fr;
        unsigned char* dst = slab + ((size_t)u.slot * 4 + (u.role - 1)) * (16 * 512 * 16) + (size_t)tid * 16;
#pragma unroll
        for (int ai = 0; ai < 2; ++ai)
#pragma unroll
            for (int bj = 0; bj < 2; ++bj)
#pragma unroll
                for (int m = 0; m < 4; ++m) { const f32x4 a = acc[ai][bj][m][0], b = acc[ai][bj][m][1]; v4u w;
                    w.x = pg8::cvt_pk_bf16(a[0], a[1]); w.y = pg8::cvt_pk_bf16(a[2], a[3]); w.z = pg8::cvt_pk_bf16(b[0], b[1]); w.w = pg8::cvt_pk_bf16(b[2], b[3]);
                    asm volatile("global_store_dwordx4 %0, %1, off sc1\n\ts_nop 1" :: "v"(dst), "v"(w) : "memory");
                    dst += 512 * 16; asm volatile("" : "+v"(dst)); }
        asm volatile("s_waitcnt vmcnt(0)" ::: "memory");
        if (fr == 0 && fq == 0) __hip_atomic_fetch_add(cnt + (size_t)u.slot * 64, 1u, __ATOMIC_RELAXED, __HIP_MEMORY_SCOPE_AGENT);
    }
};
__device__ __forceinline__ void tail_reduce(const EpiRes& E, const unsigned char* slab, unsigned* cnt, int G, int bx, int nN, int nM) {
    pg8::StaticOrder S; S.nM = nM; S.nN = nN; S.nwg = nM * nN; S.G = G; S.c = bx; S.ntK = 0;
    const int L = 256 + (bx >> 2), q = bx & 3; if (L >= S.nwg) return;
    pg8::Unit u; S.map(L, u); const int slot = bx >> 2, ai = q >> 1, bj = q & 1;
    const int tid = tid_opaque(), wid = tid >> 6, lane = tid & 63, wr = wid >> 2, wc = wid & 3, fr = lane & 15, fq = lane >> 4;
    unsigned* c = cnt + (size_t)slot * 64; unsigned spins = 0;
    while ((unsigned)__builtin_amdgcn_readfirstlane(__hip_atomic_load(c, __ATOMIC_RELAXED, __HIP_MEMORY_SCOPE_AGENT)) < 32u) { __builtin_amdgcn_s_sleep(2); if (++spins > (1u << 22)) break; }
    __builtin_amdgcn_fence(__ATOMIC_ACQUIRE, "agent");
    const unsigned char* base = slab + (size_t)slot * 4 * (16 * 512 * 16) + (size_t)tid * 16;
    v4u w[4][4];
#pragma unroll
    for (int m = 0; m < 4; ++m)
#pragma unroll
        for (int r = 0; r < 4; ++r) w[m][r] = *(const v4u*)(base + (size_t)r * (16 * 512 * 16) + (size_t)((ai * 2 + bj) * 4 + m) * (512 * 16));
    const int row0 = u.pm * 256 + ai * 128 + wr * 64 + fr; const int cls = cls_of(u.pm * 256); const int col = u.pn * 256 + bj * 128 + wc * 32 + 8 * fq;
#pragma unroll
    for (int m = 0; m < 4; ++m) { const int row = row0 + m * 16; f32x4 v[2] = {(f32x4){0.f, 0.f, 0.f, 0.f}, (f32x4){0.f, 0.f, 0.f, 0.f}};
#pragma unroll
        for (int r = 0; r < 4; ++r) { const v4u x = w[m][r]; v[0] += (f32x4){__uint_as_float(x.x << 16), __uint_as_float(x.x & 0xffff0000u), __uint_as_float(x.y << 16), __uint_as_float(x.y & 0xffff0000u)};
            v[1] += (f32x4){__uint_as_float(x.z << 16), __uint_as_float(x.z & 0xffff0000u), __uint_as_float(x.w << 16), __uint_as_float(x.w & 0xffff0000u)}; }
        float sq = E.piece(row, col, cls, v[0], v[1]);
        sq += __shfl_xor(sq, 16); sq += __shfl_xor(sq, 32); if (fq == 0) atomicAdd(E.ssq + row, sq); }
}
namespace att {
typedef unsigned short bf16;
constexpr int D = 128, NW = 8, QBLK = 32, KVBLK = 64; constexpr float SCALE = 0.088388347648318440f; constexpr float THR = 8.f; constexpr int SDEPTH = 1;
constexpr int LDQ = NQ * HDIM, LDK = NKV * HDIM, LDO = DM;
constexpr size_t SHM_V = KVBLK * D * 2, SHM_K = KVBLK * D * 2, SHM_ATTN = 2 * SHM_V + 2 * SHM_K + NW * 64 * 4;
using bf16x8 = __attribute__((ext_vector_type(8))) short;
using s16x4  = __attribute__((ext_vector_type(4))) short;
using f32x16 = __attribute__((ext_vector_type(16))) float;
using f32x8  = __attribute__((ext_vector_type(8))) float;
using u32x4  = __attribute__((ext_vector_type(4))) unsigned;
#define KSWZ(row, colB) ((row) * 256 + ((colB) ^ (((row) & 7) << 4)))
#define SBAR() __builtin_amdgcn_sched_barrier(0)
__device__ __forceinline__ int crow(int r, int hi) { return (r & 3) + 8 * (r >> 2) + 4 * hi; }
__device__ __forceinline__ unsigned cvtpk(float lo, float hi) {
  unsigned r; asm volatile("v_cvt_pk_bf16_f32 %0, %1, %2" : "=v"(r) : "v"(lo), "v"(hi)); return r;
}
template <typename TIn> struct Stage;
template <> struct Stage<bf16>  { using T = bf16x8;
  __device__ static __forceinline__ T ld8(const bf16* p) { return *reinterpret_cast<const bf16x8*>(p); }
  __device__ static __forceinline__ bf16x8 tobf(T x) { return x; } };
__device__ __forceinline__ void partialSM(f32x16& p0, f32x16& p1, float& m_reg, float& mn, float& alpha) {
  constexpr float C = SCALE * 1.4426950408889634f;
  float pmax = p0[0]; for (int r = 1; r < 16; ++r) pmax = fmaxf(pmax, p0[r]); for (int r = 0; r < 16; ++r) pmax = fmaxf(pmax, p1[r]);
  { auto rr = __builtin_amdgcn_permlane32_swap(__float_as_uint(pmax), __float_as_uint(pmax), false, false);
    pmax = fmaxf(__uint_as_float(rr[0]), __uint_as_float(rr[1])); }
  if (__builtin_expect(__all(pmax - m_reg <= THR / SCALE), 1)) { mn = m_reg; alpha = 1.f; }
  else { mn = fmaxf(m_reg, pmax); alpha = __builtin_amdgcn_exp2f((m_reg - mn) * C); m_reg = mn; }
  float mnC = -mn * C;
  for (int r = 0; r < 16; ++r) p0[r] = fmaf(p0[r], C, mnC); for (int r = 0; r < 16; ++r) p1[r] = fmaf(p1[r], C, mnC);
  for (int r = 0; r < 16; ++r) p0[r] = __builtin_amdgcn_exp2f(p0[r]);
}
__device__ __forceinline__ void finishSM(f32x16& p0, f32x16& p1, float alpha, float& l_reg, bf16x8& pa0, bf16x8& pa1, bf16x8& pa2, bf16x8& pa3) {
  for (int r = 0; r < 16; ++r) p1[r] = __builtin_amdgcn_exp2f(p1[r]);
  float ps = 0; for (int r = 0; r < 16; ++r) ps += p0[r]; for (int r = 0; r < 16; ++r) ps += p1[r];
  { auto rr = __builtin_amdgcn_permlane32_swap(__float_as_uint(ps), __float_as_uint(ps), false, false);
    ps = __uint_as_float(rr[0]) + __uint_as_float(rr[1]); }
  l_reg = l_reg * alpha + ps;
#define PK4(P, BASE, OUT) do { unsigned a0 = cvtpk(P[BASE + 0], P[BASE + 1]), a1 = cvtpk(P[BASE + 2], P[BASE + 3]);   \
    unsigned b0 = cvtpk(P[BASE + 4], P[BASE + 5]), b1 = cvtpk(P[BASE + 6], P[BASE + 7]);                              \
    auto r0 = __builtin_amdgcn_permlane32_swap(a0, b0, false, false); auto r1 = __builtin_amdgcn_permlane32_swap(a1, b1, false, false); \
    u32x4 w = {r0[0], r1[0], r0[1], r1[1]}; OUT = *reinterpret_cast<bf16x8*>(&w); } while (0)
  PK4(p0, 0, pa0); PK4(p0, 8, pa1); PK4(p1, 0, pa2); PK4(p1, 8, pa3);
#undef PK4
}
__device__ __forceinline__ void qkt(f32x16& p0, f32x16& p1, const bf16* Ks, const bf16x8* qr, int r32, int hi) {
  p0 = f32x16{}; p1 = f32x16{};
  for (int d0 = 0; d0 < 8; ++d0) { int cb = (d0 * 16 + hi * 8) * 2;
    bf16x8 b0 = *reinterpret_cast<const bf16x8*>((const char*)Ks + KSWZ(r32, cb));
    bf16x8 b1 = *reinterpret_cast<const bf16x8*>((const char*)Ks + KSWZ(32 + r32, cb));
    p0 = __builtin_amdgcn_mfma_f32_32x32x16_bf16(b0, qr[d0], p0, 0, 0, 0);
    p1 = __builtin_amdgcn_mfma_f32_32x32x16_bf16(b1, qr[d0], p1, 0, 0, 0); }
}
__device__ __forceinline__ int v_st(int k, int c) { const int kk = (k & ~0xC) | ((k & 4) << 1) | ((k & 8) >> 1); return ((kk >> 3) * 4 + (c >> 5)) * 512 + ((kk & 7) * 32 + (c & 31)) * 2; }
__device__ __forceinline__ int v_rd_base(int lane) { return ((lane & 3) << 3) | (((lane >> 2) & 3) << 6) | (((lane >> 4) & 1) << 5) | (((lane >> 5) & 1) << 8); }
constexpr int v_rd_off(int d0, int ks, int half) { return d0 * 512 + ks * 4096 + half * 2048; }
template <int OFF> __device__ __forceinline__ s16x4 tr_read(int vb) {
  s16x4 r; asm volatile("ds_read_b64_tr_b16 %0, %1 offset:%2" : "=&v"(r) : "v"(vb), "i"(OFF) : "memory"); return r;
}
template <int D0> __device__ __forceinline__ void pv_one(f32x16& od, int vb, bf16x8 pa0, bf16x8 pa1, bf16x8 pa2, bf16x8 pa3) {
  const s16x4 l0 = tr_read<v_rd_off(D0, 0, 0)>(vb), h0 = tr_read<v_rd_off(D0, 0, 1)>(vb), l1 = tr_read<v_rd_off(D0, 1, 0)>(vb), h1 = tr_read<v_rd_off(D0, 1, 1)>(vb);
  const s16x4 l2 = tr_read<v_rd_off(D0, 2, 0)>(vb), h2 = tr_read<v_rd_off(D0, 2, 1)>(vb), l3 = tr_read<v_rd_off(D0, 3, 0)>(vb), h3 = tr_read<v_rd_off(D0, 3, 1)>(vb);
  asm volatile("s_waitcnt lgkmcnt(0)" ::: "memory"); SBAR();
#define PK(L, H) (bf16x8){L[0], L[1], L[2], L[3], H[0], H[1], H[2], H[3]}
  od = __builtin_amdgcn_mfma_f32_32x32x16_bf16(pa0, PK(l0, h0), od, 0, 0, 0);
  od = __builtin_amdgcn_mfma_f32_32x32x16_bf16(pa1, PK(l1, h1), od, 0, 0, 0);
  od = __builtin_amdgcn_mfma_f32_32x32x16_bf16(pa2, PK(l2, h2), od, 0, 0, 0);
  od = __builtin_amdgcn_mfma_f32_32x32x16_bf16(pa3, PK(l3, h3), od, 0, 0, 0);
#undef PK
}
__device__ __forceinline__ void pv_d0(f32x16* o, int vb, bf16x8 pa0, bf16x8 pa1, bf16x8 pa2, bf16x8 pa3) {
  pv_one<0>(o[0], vb, pa0, pa1, pa2, pa3); pv_one<1>(o[1], vb, pa0, pa1, pa2, pa3); pv_one<2>(o[2], vb, pa0, pa1, pa2, pa3); pv_one<3>(o[3], vb, pa0, pa1, pa2, pa3);
}

__device__ __forceinline__ void attn_dense_body(const bf16* __restrict__ Qb, const bf16* __restrict__ Kh, const bf16* __restrict__ Vh,
                                                bf16* __restrict__ Ob, int seq, char* lds) {
  typedef bf16 TQ;
  using St = Stage<bf16>; using SQ = Stage<TQ>;
  const int tid = tid_opaque(), wid = tid >> 6, lane = tid & 63, r32 = lane & 31, hi = lane >> 5;
  bf16* V_lds = (bf16*)lds; bf16* K_lds = (bf16*)(lds + 2 * SHM_V);
  float* ws = (float*)(lds + 2 * SHM_V + 2 * SHM_K) + wid * 64; float* li_l = ws; float* al_l = ws + 32;
  float m_reg = -1e30f, l_reg = 0; f32x16 o[4] = {}; bf16x8 qr[8];
  const TQ* Qw = Qb + (long)(wid * QBLK + r32) * LDQ + hi * 8;
#pragma unroll
  for (int d0 = 0; d0 < 8; ++d0) qr[d0] = SQ::tobf(SQ::ld8(Qw + d0 * 16));
  const int sr = tid >> 4, sc = (tid & 15) * 8, vst0 = v_st(sr, sc), vst1 = v_st(32 + sr, sc);
  const int vb0 = (int)(uintptr_t)V_lds + v_rd_base(lane);
  struct { typename St::T vs0, vs1, ks0, ks1; } sr_[SDEPTH];
#define SLOAD(i, k0) do { sr_[i].vs0 = St::ld8(&Vh[(long)((k0) + sr) * LDK + sc]); sr_[i].vs1 = St::ld8(&Vh[(long)((k0) + 32 + sr) * LDK + sc]); \
    sr_[i].ks0 = St::ld8(&Kh[(long)((k0) + sr) * LDK + sc]); sr_[i].ks1 = St::ld8(&Kh[(long)((k0) + 32 + sr) * LDK + sc]); } while (0)
#define SWRITE(b, i) do { *(bf16x8*)((char*)V_lds + (b) * SHM_V + vst0) = St::tobf(sr_[i].vs0);          \
    *(bf16x8*)((char*)V_lds + (b) * SHM_V + vst1) = St::tobf(sr_[i].vs1); int kc = sc * 2;               \
    *(bf16x8*)((char*)K_lds + (b) * SHM_K + KSWZ(sr, kc)) = St::tobf(sr_[i].ks0);                       \
    *(bf16x8*)((char*)K_lds + (b) * SHM_K + KSWZ(32 + sr, kc)) = St::tobf(sr_[i].ks1); } while (0)
#define SWAIT() do { if constexpr (SDEPTH == 2) asm volatile("s_waitcnt vmcnt(4)" ::: "memory"); else asm volatile("s_waitcnt vmcnt(0)" ::: "memory"); } while (0)
#define RESC(a) do { if (__any((a) < 1.f)) { if (hi == 0) al_l[r32] = (a); asm volatile("s_waitcnt lgkmcnt(0)" ::: "memory"); \
    for (int d = 0; d < 4; ++d) for (int r = 0; r < 16; ++r) o[d][r] *= al_l[crow(r, hi)]; } } while (0)
  f32x16 pA0, pA1, pB0, pB1; float mnA, mnB, alA, alB; bf16x8 pa0, pa1, pa2, pa3; const int NT = seq / KVBLK;
  constexpr int SE = 0, SO = SDEPTH - 1;
  SLOAD(SE, 0); asm volatile("s_waitcnt vmcnt(0)" ::: "memory"); SWRITE(0, SE); __syncthreads();
  qkt(pA0, pA1, K_lds, qr, r32, hi); partialSM(pA0, pA1, m_reg, mnA, alA);
  SLOAD(SO, KVBLK); if constexpr (SDEPTH == 2) { if (2 < NT) SLOAD(SE, 2 * KVBLK); }
  SWAIT(); SWRITE(1, SO); __syncthreads();
  for (int j = 1; j + 1 < NT; j += 2) {
    SBAR(); qkt(pB0, pB1, (bf16*)((char*)K_lds + SHM_K), qr, r32, hi);
    finishSM(pA0, pA1, alA, l_reg, pa0, pa1, pa2, pa3); SBAR();
    SLOAD(SO, (j + SDEPTH) * KVBLK); SBAR();
    pv_d0(o, vb0, pa0, pa1, pa2, pa3); partialSM(pB0, pB1, m_reg, mnB, alB);
    __syncthreads(); SWAIT(); SWRITE(0, SE);
    RESC(alB); __syncthreads();
    SBAR(); qkt(pA0, pA1, K_lds, qr, r32, hi);
    finishSM(pB0, pB1, alB, l_reg, pa0, pa1, pa2, pa3); SBAR();
    if (SDEPTH == 1 || j + 3 < NT) SLOAD(SE, (j + 1 + SDEPTH) * KVBLK); SBAR();
    pv_d0(o, vb0 + (int)SHM_V, pa0, pa1, pa2, pa3); partialSM(pA0, pA1, m_reg, mnA, alA);
    __syncthreads(); SWAIT(); SWRITE(1, SO);
    RESC(alA); __syncthreads();
  }
  SBAR(); qkt(pB0, pB1, (bf16*)((char*)K_lds + SHM_K), qr, r32, hi);
  finishSM(pA0, pA1, alA, l_reg, pa0, pa1, pa2, pa3); SBAR();
  pv_d0(o, vb0, pa0, pa1, pa2, pa3); partialSM(pB0, pB1, m_reg, mnB, alB);
  __syncthreads(); RESC(alB);
  finishSM(pB0, pB1, alB, l_reg, pa0, pa1, pa2, pa3); SBAR();
  pv_d0(o, vb0 + (int)SHM_V, pa0, pa1, pa2, pa3);
  if (hi == 0) li_l[r32] = l_reg; asm volatile("s_waitcnt lgkmcnt(0)" ::: "memory");
  float rli[16];
#pragma unroll
  for (int r = 0; r < 16; ++r) rli[r] = __builtin_amdgcn_rcpf(li_l[crow(r, hi)]);
  bf16* Ow = Ob + (long)(wid * QBLK) * LDO;
#pragma unroll
  for (int r = 0; r < 16; ++r) { int orow = crow(r, hi);
    for (int d0 = 0; d0 < 4; ++d0) Ow[(long)orow * LDO + d0 * 32 + r32] = f2bf(o[d0][r] * rli[r]); }
#undef SLOAD
#undef SWRITE
#undef SWAIT
#undef RESC
}
}
__device__ __forceinline__ void attn_phase(const Params& p, unsigned char* lds, int vcu, int G) {
    constexpr int QB = 256, LQB = LSEQ / QB, CQB = CSEQ / QB;
    constexpr int NUL = NLB * NQ * LQB, NUC = NCB * NQ * CQB, NU = NUL + NUC;
    const att::bf16* QR = (const att::bf16*)(p.ws + WS_QRAW); att::bf16* OB = (att::bf16*)(p.ws + WS_O);
    for (int i = 0;; ++i) {
        int u;
        if (G == 256 && NUL == 512) { if (i < 2) u = (vcu >> 5) * 64 + (vcu & 31) + 32 * i; else u = NUL + vcu + (i - 2) * G; }
        else u = vcu + i * G;
        if (u >= NU) break;
        const att::bf16 *Q, *K, *V; att::bf16* O; int seq;
        if (u < NUL) { const int grp = u / (GRP * LQB), j = u % (GRP * LQB); const int b = grp / NKV, kvh = grp % NKV, g = j / LQB, qb = j % LQB, hq = kvh * GRP + g;
            const size_t row0 = (size_t)MC + (size_t)b * LSEQ + (size_t)qb * QB;
            Q = QR + row0 * (NQ * HDIM) + hq * HDIM; O = OB + row0 * DM + hq * HDIM;
            K = (const att::bf16*)(p.ws + WS_LATK) + (size_t)b * SKVL * (NKV * HDIM) + kvh * HDIM; V = (const att::bf16*)(p.ws + WS_LATV) + (size_t)b * SKVL * (NKV * HDIM) + kvh * HDIM; seq = SKVL; }
        else { const int uc = u - NUL; const int b = uc / (NQ * CQB), r = uc % (NQ * CQB), hq = r / CQB, qb = r % CQB, kvh = hq / GRP;
            const size_t row0 = (size_t)b * CSEQ + (size_t)qb * QB;
            Q = QR + row0 * (NQ * HDIM) + hq * HDIM; O = OB + row0 * DM + hq * HDIM;
            K = (const att::bf16*)(p.ws + WS_CTXK) + (size_t)b * CSEQ * (NKV * HDIM) + kvh * HDIM; V = (const att::bf16*)(p.ws + WS_CTXV) + (size_t)b * CSEQ * (NKV * HDIM) + kvh * HDIM; seq = CSEQ; }
        __syncthreads();
        att::attn_dense_body(Q, K, V, O, seq, (char*)lds);
    }
}
static_assert(SKVL % 128 == 0 && CSEQ % 128 == 0 && LSEQ % 256 == 0 && CSEQ % 256 == 0, "attention tiling");
constexpr size_t WS_CST = 232 * MiB;
constexpr int NBLK = LSEQ / 256;
constexpr size_t WS_NST = WS_CST + (size_t)NLB * MH * 2 * NBLK * MDK * MDK * 2;
constexpr size_t WS_FTOT = WS_NST + (size_t)NLB * MH * 2 * NBLK * MDK * 4;
static_assert(WS_FTOT + (size_t)NLB * MH * 2 * NBLK * 4 <= WS_END && MDK == 128 && CSEQ == 256 && LSEQ % 256 == 0, "mLSTM fast path geometry");
namespace att {
constexpr int ML_OFF = 132096;
constexpr int ML_SC = ML_OFF + 6144;
constexpr int ML_N = ML_SC + 128;
constexpr int ML_LI = ML_N + 1024;
static_assert(ML_LI + 1024 <= LDS_BYTES, "mLSTM LDS map");
constexpr float L2E = 1.4426950408889634f;
using f32x4v = __attribute__((ext_vector_type(4))) float;


__device__ __forceinline__ void ml_gates(const Params& p, char* lds, int row0, int h, int tid) {
    float* A = (float*)(lds + ML_OFF); float* S = (float*)(lds + ML_SC);
    const int half = tid >> 8, t = tid & 255, tok = half ? 255 - t : t, lane = tid & 63, wv = (tid >> 6) & 3;
    const float* G = (const float*)(p.ws + WS_GATES) + (size_t)(row0 + tok) * NGATE + half * 8 + h;
    const float ig = G[0], lf = G[4];
    float v = lf;
#pragma unroll
    for (int off = 1; off < 64; off <<= 1) { const float u = lane_get(v, lane - off); if (lane >= off) v += u; }
    if (lane == 63) S[4 + half * 4 + wv] = v;
    __syncthreads();
    float pre = 0.f, tot = 0.f;
#pragma unroll
    for (int w = 0; w < 4; ++w) { const float x = S[4 + half * 4 + w]; if (w < wv) pre += x; tot += x; }
    const float P = v + pre, a = ig - P;
    A[(0 + half) * 256 + tok] = P * L2E; A[(2 + half) * 256 + tok] = a * L2E; A[(4 + half) * 256 + tok] = __builtin_amdgcn_exp2f(P * L2E);
    float mx = a;
    mx = fmaxf(mx, swz_xor<1>(mx)); mx = fmaxf(mx, swz_xor<2>(mx)); mx = fmaxf(mx, swz_xor<4>(mx)); mx = fmaxf(mx, swz_xor<8>(mx)); mx = fmaxf(mx, swz_xor<16>(mx)); mx = half_max(mx);
    if (lane == 0) S[12 + half * 4 + wv] = mx;
    if (t == 0) S[half] = tot;
    __syncthreads();
    if (t == 0) S[2 + half] = fmaxf(fmaxf(S[12 + half * 4], S[13 + half * 4]), fmaxf(S[14 + half * 4], S[15 + half * 4]));
    __syncthreads();
}
#define ML_PK(L, H) (bf16x8){L[0], L[1], L[2], L[3], H[0], H[1], H[2], H[3]}
__device__ __forceinline__ s16x4 tr_read_rt(int vb) { s16x4 r; asm volatile("ds_read_b64_tr_b16 %0, %1" : "=&v"(r) : "v"(vb) : "memory"); return r; }

__device__ __forceinline__ void ml_passA_unit(const Params& p, char* lds, int sid, int h, int blk) {
    const int tid = tid_opaque(), wid = tid >> 6, lane = tid & 63, r32 = lane & 31, hi = lane >> 5;
    const bool isctx = sid < NCB; const int row0 = seq_base(sid) + 256 * blk;
    __syncthreads();
    ml_gates(p, lds, row0, h, tid);
    float* A = (float*)(lds + ML_OFF); float* S = (float*)(lds + ML_SC); float* NA = (float*)(lds + ML_N);
    const bf16* QK = (const bf16*)(p.ws + WS_QKVO) + (size_t)row0 * (4 * MW) + h * MDK;
    const int sr = tid >> 4, sc8 = (tid & 15) * 8;
    { bf16x8 tv[8];
#pragma unroll
      for (int i = 0; i < 8; ++i) tv[i] = *(const bf16x8*)(QK + (size_t)(32 * i + sr) * (4 * MW) + 2 * MW + sc8);
#pragma unroll
      for (int i = 0; i < 8; ++i) *(bf16x8*)(lds + 65536 + (i >> 1) * 16384 + v_st(32 * (i & 1) + sr, sc8)) = tv[i]; }
    if (tid < 256) NA[tid] = 0.f;
    const int a = wid >> 1, dvb0 = 2 * (wid & 1);
    const int ldsb = (int)(uintptr_t)lds; const int vbK = ldsb + v_rd_base(lane) + a * 512, vbV = ldsb + 65536 + v_rd_base(lane) + dvb0 * 512;
    for (int dir = 0; dir < 2; ++dir) {
        __syncthreads();
        const float ft = S[dir], am = S[2 + dir]; const float mT = isctx ? ft + fmaxf(am, 0.f) : 0.f; const float wl2 = (ft - mT) * L2E;
        float xs[8];
#pragma unroll
        for (int i = 0; i < 8; ++i) xs[i] = 0.f;
        bf16x8 tk[8];
#pragma unroll
        for (int i = 0; i < 8; ++i) tk[i] = *(const bf16x8*)(QK + (size_t)(32 * i + sr) * (4 * MW) + MW + sc8);
#pragma unroll
        for (int j = 0; j < 4; ++j)
#pragma unroll
            for (int hf = 0; hf < 2; ++hf) { const int row = 64 * j + 32 * hf + sr; const float w = __builtin_amdgcn_exp2f(wl2 + A[(2 + dir) * 256 + row]);
                const bf16x8 k8 = tk[2 * j + hf]; float x[8];
#pragma unroll
                for (int i = 0; i < 8; ++i) { x[i] = bf2f((unsigned short)k8[i]) * w; xs[i] += x[i]; }
                u32x4 pk = {cvtpk(x[0], x[1]), cvtpk(x[2], x[3]), cvtpk(x[4], x[5]), cvtpk(x[6], x[7])};
                *(u32x4*)(lds + j * 16384 + v_st(32 * hf + sr, sc8)) = pk; }
#pragma unroll
        for (int i = 0; i < 8; ++i) { float v = xs[i]; v += swz_xor<16>(v); v = half_sum(v); if (lane < 16) atomicAdd(&NA[dir * 128 + sc8 + i], v); }
        __syncthreads();
        f32x16 acc0 = {}, acc1 = {}; const unsigned eoff = (unsigned)((32 * a + 4 * hi) * MDK + 32 * dvb0 + r32);
#pragma unroll
        for (int j = 0; j < 4; ++j)
#pragma unroll
            for (int ks = 0; ks < 4; ++ks) { const int off = j * 16384 + ks * 4096;
                const s16x4 al = tr_read_rt(vbK + off), ah = tr_read_rt(vbK + off + 2048);
                const s16x4 bl0 = tr_read_rt(vbV + off), bh0 = tr_read_rt(vbV + off + 2048), bl1 = tr_read_rt(vbV + off + 512), bh1 = tr_read_rt(vbV + off + 512 + 2048);
                asm volatile("s_waitcnt lgkmcnt(0)" ::: "memory"); SBAR();
                acc0 = __builtin_amdgcn_mfma_f32_32x32x16_bf16(ML_PK(al, ah), ML_PK(bl0, bh0), acc0, 0, 0, 0);
                acc1 = __builtin_amdgcn_mfma_f32_32x32x16_bf16(ML_PK(al, ah), ML_PK(bl1, bh1), acc1, 0, 0, 0); }
        if (isctx) {
            float* Co = p.out + O_C + ((size_t)(sid * 2 + dir) * MH + h) * MDK * MDK;
#pragma unroll
            for (int r = 0; r < 16; ++r) { const unsigned eo = eoff + (unsigned)(((r & 3) + 8 * (r >> 2)) * MDK); Co[eo] = acc0[r]; Co[eo + 32] = acc1[r]; }
            if (tid == 0) p.out[O_M + (size_t)(sid * 2 + dir) * MH + h] = mT;
        } else {
            const int b = sid - NCB; bf16* Cs = (bf16*)(p.ws + WS_CST) + ((size_t)((b * MH + h) * 2 + dir) * NBLK + blk) * MDK * MDK;
#pragma unroll
            for (int r = 0; r < 16; ++r) { const unsigned eo = eoff + (unsigned)(((r & 3) + 8 * (r >> 2)) * MDK); Cs[eo] = f2bf(acc0[r]); Cs[eo + 32] = f2bf(acc1[r]); }
            if (tid == 0) ((float*)(p.ws + WS_FTOT))[((size_t)(b * MH + h) * 2 + dir) * NBLK + blk] = ft;
        }
    }
    __syncthreads();
    if (tid < 256) { const int dir = tid >> 7, d = tid & 127;
        if (isctx) p.out[O_N + ((size_t)(sid * 2 + dir) * MH + h) * MDK + d] = NA[tid];
        else { const int b = sid - NCB; ((float*)(p.ws + WS_NST))[(((size_t)(b * MH + h) * 2 + dir) * NBLK + blk) * MDK + d] = NA[tid]; } }
}

template <int DIR> __device__ __forceinline__ void ml_tile(f32x16* o, float& den, const bf16x8* qr, const char* Ktile, int vbV, const float* AL2, int j, float cq, int trow, bool diag, int r32, int hi) {
    SBAR(); f32x16 p0, p1; qkt(p0, p1, (const bf16*)Ktile, qr, r32, hi); SBAR();
    float ds = 0.f; const int tl = trow - 64 * j - 4 * hi;
#pragma unroll
    for (int g = 0; g < 4; ++g) { const f32x4v a0 = *(const f32x4v*)(AL2 + 64 * j + 8 * g + 4 * hi), a1 = *(const f32x4v*)(AL2 + 64 * j + 32 + 8 * g + 4 * hi);
#pragma unroll
        for (int e = 0; e < 4; ++e) { float w0 = __builtin_amdgcn_exp2f(cq + a0[e]), w1 = __builtin_amdgcn_exp2f(cq + a1[e]);
            if (diag) { if (DIR == 0 ? (8 * g + e > tl) : (8 * g + e < tl)) w0 = 0.f; if (DIR == 0 ? (8 * g + e + 32 > tl) : (8 * g + e + 32 < tl)) w1 = 0.f; }
            p0[4 * g + e] *= w0; p1[4 * g + e] *= w1; ds += p0[4 * g + e] + p1[4 * g + e]; } }
    den += ds;
    bf16x8 pa0, pa1, pa2, pa3;
#define PK4(P, BASE, OUT) do { unsigned a0_ = cvtpk(P[BASE + 0], P[BASE + 1]), a1_ = cvtpk(P[BASE + 2], P[BASE + 3]);   \
    unsigned b0_ = cvtpk(P[BASE + 4], P[BASE + 5]), b1_ = cvtpk(P[BASE + 6], P[BASE + 7]);                              \
    auto r0_ = __builtin_amdgcn_permlane32_swap(a0_, b0_, false, false); auto r1_ = __builtin_amdgcn_permlane32_swap(a1_, b1_, false, false); \
    u32x4 w_ = {r0_[0], r1_[0], r0_[1], r1_[1]}; OUT = *reinterpret_cast<bf16x8*>(&w_); } while (0)
    PK4(p0, 0, pa0); PK4(p0, 8, pa1); PK4(p1, 0, pa2); PK4(p1, 8, pa3);
#undef PK4
    SBAR(); pv_d0(o, vbV, pa0, pa1, pa2, pa3); SBAR();
}
struct MlKv { bf16x8 tk[4], tv[4]; };
__device__ __forceinline__ void ml_kv_load(MlKv& r, const bf16* QK, int tile0, int sr, int sc8) {
#pragma unroll
    for (int i = 0; i < 4; ++i) { const int row = 64 * tile0 + 32 * i + sr; r.tk[i] = *(const bf16x8*)(QK + (size_t)row * (4 * MW) + MW + sc8); r.tv[i] = *(const bf16x8*)(QK + (size_t)row * (4 * MW) + 2 * MW + sc8); }
}
__device__ __forceinline__ void ml_kv_write(const MlKv& r, char* lds, int sr, int sc8) {
#pragma unroll
    for (int i = 0; i < 4; ++i) { const int jj = i >> 1, rl = 32 * (i & 1) + sr; *(bf16x8*)(lds + jj * 16384 + KSWZ(rl, sc8 * 2)) = r.tk[i]; *(bf16x8*)(lds + 32768 + jj * 16384 + v_st(rl, sc8)) = r.tv[i]; }
}
__device__ __forceinline__ void ml_passC_unit(const Params& p, char* lds, int sid, int h, int blk) {
    const int tid = tid_opaque(), wid = tid >> 6, lane = tid & 63, r32 = lane & 31, hi = lane >> 5;
    const bool isctx = sid < NCB; const int row0 = seq_base(sid) + 256 * blk; const int wq = wid >> 1;
    __syncthreads();
    ml_gates(p, lds, row0, h, tid);
    float* A = (float*)(lds + ML_OFF); float* NS = (float*)(lds + ML_N); float* li = (float*)(lds + ML_LI) + wid * 32;
    const bf16* QK = (const bf16*)(p.ws + WS_QKVO) + (size_t)row0 * (4 * MW) + h * MDK;
    const int sr = tid >> 4, sc8 = (tid & 15) * 8; const int b = sid - NCB;
    if (tid < 256) { const int dir = tid >> 7, d = tid & 127;
        NS[tid] = isctx ? 0.f : ((const float*)(p.ws + WS_NST))[(((size_t)(b * MH + h) * 2 + dir) * NBLK + blk) * MDK + d]; }
    if (!isctx) { bf16x8 tc[8];
#pragma unroll
        for (int i = 0; i < 8; ++i) { const int dir = i >> 2, c = tid + 512 * (i & 3); tc[i] = *(const bf16x8*)((const bf16*)(p.ws + WS_CST) + ((size_t)((b * MH + h) * 2 + dir) * NBLK + blk) * MDK * MDK + (size_t)c * 8); }
#pragma unroll
        for (int i = 0; i < 8; ++i) { const int dir = i >> 2, c = tid + 512 * (i & 3), row = c >> 4, col8 = (c & 15) * 8; *(bf16x8*)(lds + 65536 + dir * 32768 + (row >> 6) * 16384 + v_st(row & 63, col8)) = tc[i]; }
    }
    bf16x8 qr[8];
    { const bf16* Qw = QK + (size_t)(wid * 32 + r32) * (4 * MW) + hi * 8;
#pragma unroll
        for (int d0 = 0; d0 < 8; ++d0) qr[d0] = *(const bf16x8*)(Qw + d0 * 16); }
    MlKv kv; ml_kv_load(kv, QK, 0, sr, sc8); ml_kv_write(kv, lds, sr, sc8);
    __syncthreads();
    float qn_f = 0.f, qn_b = 0.f;
#pragma unroll
    for (int d0 = 0; d0 < 8; ++d0)
#pragma unroll
        for (int i = 0; i < 8; ++i) { const float qv = bf2f((unsigned short)qr[d0][i]); qn_f += qv * NS[d0 * 16 + hi * 8 + i]; qn_b += qv * NS[128 + d0 * 16 + hi * 8 + i]; }
    qn_f = half_sum(qn_f); qn_b = half_sum(qn_b);
    const int ldsb = (int)(uintptr_t)lds; const int vbV = ldsb + 32768 + v_rd_base(lane), vbC = ldsb + 65536 + v_rd_base(lane);
    const int trow = wid * 32 + r32;
    float* HS = (float*)(p.ws + WS_HS) + (size_t)(row0 + wid * 32) * MW + h * MDK;
    f32x16 o[4]; const unsigned hso = (unsigned)(4 * hi * MW + r32), uho = (unsigned)(4 * hi * DM + r32), ogo = (unsigned)(4 * hi * 4 * MW + r32);
    {
        float qn = qn_f;
        o[0] = f32x16{}; o[1] = f32x16{}; o[2] = f32x16{}; o[3] = f32x16{};
        if (!isctx) { pv_d0(o, vbC, qr[0], qr[1], qr[2], qr[3]); pv_d0(o, vbC + 16384, qr[4], qr[5], qr[6], qr[7]);
#pragma unroll
            for (int r = 0; r < 16; ++r) { const float e = A[4 * 256 + wid * 32 + crow(r, hi)];
#pragma unroll
                for (int d0 = 0; d0 < 4; ++d0) o[d0][r] *= e; } }
        const float cq = A[0 * 256 + trow]; float den = 0.f;
        ml_kv_load(kv, QK, 2, sr, sc8);
        ml_tile<0>(o, den, qr, lds, vbV, A + 2 * 256, 0, cq, trow, wq == 0, r32, hi);
        if (wq >= 1) ml_tile<0>(o, den, qr, lds + 16384, vbV + 16384, A + 2 * 256, 1, cq, trow, wq == 1, r32, hi);
        __syncthreads(); ml_kv_write(kv, lds, sr, sc8); __syncthreads();
        if (wq >= 2) ml_tile<0>(o, den, qr, lds, vbV, A + 2 * 256, 2, cq, trow, wq == 2, r32, hi);
        if (wq >= 3) ml_tile<0>(o, den, qr, lds + 16384, vbV + 16384, A + 2 * 256, 3, cq, trow, wq == 3, r32, hi);
        { auto rr = __builtin_amdgcn_permlane32_swap(__float_as_uint(den), __float_as_uint(den), false, false); den = __uint_as_float(rr[0]) + __uint_as_float(rr[1]); }
        const float dn = den + __builtin_amdgcn_exp2f(cq) * qn; const float inv = 1.0f / fmaxf(fabsf(dn), 1.0f);
        if (hi == 0) li[r32] = inv; asm volatile("s_waitcnt lgkmcnt(0)" ::: "memory");
#pragma unroll
        for (int r = 0; r < 16; ++r) { const float rl = li[crow(r, hi)]; const unsigned eo = hso + (unsigned)(((r & 3) + 8 * (r >> 2)) * MW);
#pragma unroll
            for (int d0 = 0; d0 < 4; ++d0) HS[eo + d0 * 32] = o[d0][r] * rl;
            asm volatile("" ::: "memory"); }
    }
    {
        float qn = qn_b;
        o[0] = f32x16{}; o[1] = f32x16{}; o[2] = f32x16{}; o[3] = f32x16{};
        if (!isctx) { pv_d0(o, vbC + 32768, qr[0], qr[1], qr[2], qr[3]); pv_d0(o, vbC + 32768 + 16384, qr[4], qr[5], qr[6], qr[7]);
#pragma unroll
            for (int r = 0; r < 16; ++r) { const float e = A[5 * 256 + wid * 32 + crow(r, hi)];
#pragma unroll
                for (int d0 = 0; d0 < 4; ++d0) o[d0][r] *= e; } }
        const float cq = A[1 * 256 + trow]; float den = 0.f;
        ml_kv_load(kv, QK, 0, sr, sc8);
        ml_tile<1>(o, den, qr, lds + 16384, vbV + 16384, A + 3 * 256, 3, cq, trow, wq == 3, r32, hi);
        if (wq <= 2) ml_tile<1>(o, den, qr, lds, vbV, A + 3 * 256, 2, cq, trow, wq == 2, r32, hi);
        __syncthreads(); ml_kv_write(kv, lds, sr, sc8); __syncthreads();
        if (wq <= 1) ml_tile<1>(o, den, qr, lds + 16384, vbV + 16384, A + 3 * 256, 1, cq, trow, wq == 1, r32, hi);
        if (wq <= 0) ml_tile<1>(o, den, qr, lds, vbV, A + 3 * 256, 0, cq, trow, wq == 0, r32, hi);
        { auto rr = __builtin_amdgcn_permlane32_swap(__float_as_uint(den), __float_as_uint(den), false, false); den = __uint_as_float(rr[0]) + __uint_as_float(rr[1]); }
        const float dn = den + __builtin_amdgcn_exp2f(cq) * qn; const float inv = 1.0f / fmaxf(fabsf(dn), 1.0f);
        asm volatile("s_waitcnt vmcnt(0)" ::: "memory");
        if (hi == 0) li[r32] = inv; asm volatile("s_waitcnt lgkmcnt(0)" ::: "memory");
        float mg[4];
#pragma unroll
        for (int d0 = 0; d0 < 4; ++d0) mg[d0] = p.mng[h * MDK + d0 * 32 + r32];
        const bf16* OG = QK + (size_t)(wid * 32) * (4 * MW) + 3 * MW; bf16* UHo = (bf16*)(p.ws + WS_UH) + (size_t)(row0 + wid * 32) * DM + CCH + h * MDK;
#pragma unroll
        for (int r = 0; r < 16; ++r) { const float rl = li[crow(r, hi)]; const int rc = (r & 3) + 8 * (r >> 2); float ss = 0.f;
#pragma unroll
            for (int d0 = 0; d0 < 4; ++d0) { const float hf = __hip_atomic_load(HS + hso + (unsigned)(rc * MW + d0 * 32), __ATOMIC_RELAXED, __HIP_MEMORY_SCOPE_AGENT); const float x = hf + o[d0][r] * rl; o[d0][r] = x; ss += x * x; }
            ss += swz_xor<1>(ss); ss += swz_xor<2>(ss); ss += swz_xor<4>(ss); ss += swz_xor<8>(ss); ss += swz_xor<16>(ss);
            const float rs = 1.0f / sqrtf(ss * (1.0f / MDK) + EPSF);
#pragma unroll
            for (int d0 = 0; d0 < 4; ++d0) UHo[uho + (unsigned)(rc * DM + d0 * 32)] = f2bf(bf2f(OG[ogo + (unsigned)(rc * 4 * MW + d0 * 32)]) * o[d0][r] * rs * mg[d0]);
            asm volatile("" ::: "memory"); }
    }
}
}

template <int DIR> __device__ __forceinline__ void ml_scan_item(const Params& p, int ch, int b, int h, int e8) {
    const float em = expf(p.stm[(size_t)(b * 2 + DIR) * MH + h]); const float* FT = (const float*)(p.ws + WS_FTOT) + (size_t)ch * NBLK;
    float fd[NBLK];
#pragma unroll
    for (int i = 0; i < NBLK; ++i) fd[i] = expf(FT[i]);
    if (e8 < MDK * MDK) { bf16_t* Cs = (bf16_t*)(p.ws + WS_CST) + (size_t)ch * NBLK * MDK * MDK + e8; const float* c0 = p.stC + ((size_t)(b * 2 + DIR) * MH + h) * MDK * MDK + e8;
        v4u d[NBLK];
#pragma unroll
        for (int i = 0; i < NBLK; ++i) d[i] = *(const v4u*)(Cs + (size_t)i * MDK * MDK);
        const f32x4 ca = *(const f32x4*)c0, cb = *(const f32x4*)(c0 + 4); float c[8] = {ca[0] * em, ca[1] * em, ca[2] * em, ca[3] * em, cb[0] * em, cb[1] * em, cb[2] * em, cb[3] * em};
#pragma unroll
        for (int i = 0; i < NBLK; ++i) { const int blk = DIR == 0 ? i : NBLK - 1 - i; v4u o;
#pragma unroll
            for (int w = 0; w < 4; ++w) { const float lo = __uint_as_float(d[blk][w] << 16), hi = __uint_as_float(d[blk][w] & 0xffff0000u); o[w] = pg8::cvt_pk_bf16(c[2 * w], c[2 * w + 1]);
                c[2 * w] = fd[blk] * c[2 * w] + lo; c[2 * w + 1] = fd[blk] * c[2 * w + 1] + hi; }
            *(v4u*)(Cs + (size_t)blk * MDK * MDK) = o; } }
    else { const int d_ = e8 - MDK * MDK; float* Ns = (float*)(p.ws + WS_NST) + (size_t)ch * NBLK * MDK + d_; const float* n0 = p.stn + ((size_t)(b * 2 + DIR) * MH + h) * MDK + d_;
        f32x4 da[NBLK], db[NBLK];
#pragma unroll
        for (int i = 0; i < NBLK; ++i) { da[i] = *(const f32x4*)(Ns + (size_t)i * MDK); db[i] = *(const f32x4*)(Ns + (size_t)i * MDK + 4); }
        f32x4 ca = *(const f32x4*)n0 * em, cb = *(const f32x4*)(n0 + 4) * em;
#pragma unroll
        for (int i = 0; i < NBLK; ++i) { const int blk = DIR == 0 ? i : NBLK - 1 - i;
            *(f32x4*)(Ns + (size_t)blk * MDK) = ca; *(f32x4*)(Ns + (size_t)blk * MDK + 4) = cb; ca = ca * fd[blk] + da[blk]; cb = cb * fd[blk] + db[blk]; } }
}
struct MlScan {
    Params p; static HD_FN long count() { return (long)NLB * MH * 2 * ((MDK * MDK + MDK) / 8); }
    __device__ __forceinline__ void operator()(long idx) const {
        constexpr int per = (MDK * MDK + MDK) / 8; const int e8 = (int)(idx % per) * 8; const int ch = (int)(idx / per); const int dir = ch & 1, h = (ch >> 1) % MH, b = ch / (2 * MH);
        if (dir == 0) ml_scan_item<0>(p, ch, b, h, e8); else ml_scan_item<1>(p, ch, b, h, e8);
    }
};
__device__ __forceinline__ void ml_phase_A(const Params& p, unsigned char* lds, int vcu, int G) {
    constexpr int NUL = NLB * MH * NBLK, NU = NUL + NCB * MH;
    for (int u = vcu; u < NU; u += G) {
        if (u < NUL) att::ml_passA_unit(p, (char*)lds, NCB + u / (MH * NBLK), (u / NBLK) % MH, u % NBLK);
        else att::ml_passA_unit(p, (char*)lds, (u - NUL) / MH, (u - NUL) % MH, 0); }
}
__device__ __forceinline__ void ml_phase_C(const Params& p, unsigned char* lds, int vcu, int G) {
    constexpr int NUL = NLB * MH * NBLK, NU = NUL + NCB * MH;
    for (int u = vcu; u < NU; u += G) {
        if (u < NUL) att::ml_passC_unit(p, (char*)lds, NCB + u / (MH * NBLK), (u / NBLK) % MH, u % NBLK);
        else att::ml_passC_unit(p, (char*)lds, (u - NUL) / MH, (u - NUL) % MH, 0); }
}
typedef float f4 __attribute__((ext_vector_type(4)));
typedef unsigned u4 __attribute__((ext_vector_type(4)));
typedef unsigned u2 __attribute__((ext_vector_type(2)));
__device__ __forceinline__ float wave_sum64(float v) { v += swz_xor<1>(v); v += swz_xor<2>(v); v += swz_xor<4>(v); v += swz_xor<8>(v); v += swz_xor<16>(v); return half_sum(v); }
__device__ __forceinline__ float fsilu(float x) { return x * fsigmoid(x); }

__device__ __forceinline__ void phase_mod(const Params& p, char* lds, int bx, int G) {
    const int tid = tid_opaque(), lane = tid & 63, wave = tid >> 6;
    float* SL = (float*)lds; float* PT = (float*)(lds + 32768);
    constexpr int NCG = 6 * DM / 64, NIT = 2 * NCG;
    if (bx >= NIT) return;
    __syncthreads();
    for (int i = tid; i < NCLS * DM; i += NTHREADS) { const int cls = i / DM, k = i % DM; const float cv = cls == 0 ? p.cctx[k] : p.c[(size_t)(cls - 1) * DM + k]; SL[i] = fsilu(cv); }
    for (int item = bx; item < NIT; item += G) {
        __syncthreads();
        const int l = item / NCG, cg = item % NCG; const float* w = p.wmod + (size_t)l * DM * 6 * DM + cg * 64 + lane;
        float acc[NCLS];
#pragma unroll
        for (int r = 0; r < NCLS; ++r) acc[r] = 0.f;
        const int k0 = wave * (DM / 8);
#pragma unroll 8
        for (int k = k0; k < k0 + DM / 8; ++k) { const float wv = w[(size_t)k * 6 * DM];
#pragma unroll
            for (int r = 0; r < NCLS; ++r) acc[r] += SL[r * DM + k] * wv; }
#pragma unroll
        for (int r = 0; r < NCLS; ++r) PT[(wave * NCLS + r) * 64 + lane] = acc[r];
        __syncthreads();
        if (tid < NCLS * 64) { const int r = tid >> 6; float s = p.bmod[(size_t)l * 6 * DM + cg * 64 + lane];
#pragma unroll
            for (int w8 = 0; w8 < 8; ++w8) s += PT[(w8 * NCLS + r) * 64 + lane];
            ((float*)(p.ws + WS_MOD))[((size_t)(l * NCLS + r) * 6 * DM) + cg * 64 + lane] = s; }
    }
}
__device__ __forceinline__ void sw_job(const Params& p, const bf16_t* Bt, int nrows, int l, int which, float* sw, int N, int mode, int gw, int NGW, int lane) {
    if (gw >= nrows) return;
    f4 sh[NCLS][4];
#pragma unroll
    for (int cls = 0; cls < NCLS; ++cls) { const float* s_ = modv(p, l, cls, which); sh[cls][0] = *(const f4*)(s_ + lane * 8); sh[cls][1] = *(const f4*)(s_ + lane * 8 + 4); sh[cls][2] = *(const f4*)(s_ + DM / 2 + lane * 8); sh[cls][3] = *(const f4*)(s_ + DM / 2 + lane * 8 + 4); }
    u4 w0 = *(const u4*)(Bt + (size_t)gw * DM + lane * 8), w1 = *(const u4*)(Bt + (size_t)gw * DM + DM / 2 + lane * 8);
    for (int n = gw; n < nrows; n += NGW) {
        const u4 c0 = w0, c1 = w1; const int nn = n + NGW; if (nn < nrows) { w0 = *(const u4*)(Bt + (size_t)nn * DM + lane * 8); w1 = *(const u4*)(Bt + (size_t)nn * DM + DM / 2 + lane * 8); }
        f4 wa, wb, wc, wd; wa = (f4){__uint_as_float(c0.x << 16), __uint_as_float(c0.x & 0xffff0000u), __uint_as_float(c0.y << 16), __uint_as_float(c0.y & 0xffff0000u)};
        wb = (f4){__uint_as_float(c0.z << 16), __uint_as_float(c0.z & 0xffff0000u), __uint_as_float(c0.w << 16), __uint_as_float(c0.w & 0xffff0000u)};
        wc = (f4){__uint_as_float(c1.x << 16), __uint_as_float(c1.x & 0xffff0000u), __uint_as_float(c1.y << 16), __uint_as_float(c1.y & 0xffff0000u)};
        wd = (f4){__uint_as_float(c1.z << 16), __uint_as_float(c1.z & 0xffff0000u), __uint_as_float(c1.w << 16), __uint_as_float(c1.w & 0xffff0000u)};
        int col = n; if (mode == 1) { const int t = n >> 8, r = n & 255; col = r < 128 ? 128 * t + r : (N / 2) + 128 * t + (r - 128); }
        float mine = 0.f;
#pragma unroll
        for (int cls = 0; cls < NCLS; ++cls) { const f4 t4 = sh[cls][0] * wa + sh[cls][1] * wb + sh[cls][2] * wc + sh[cls][3] * wd; float s = (t4[0] + t4[1]) + (t4[2] + t4[3]); s = wave_sum64(s); if (lane == cls) mine = s; }
        if (lane < NCLS) sw[(size_t)lane * N + col] = mine;
    }
}
static_assert(DM == 1024, "sw_job / norm passes assume 1024 = 64 lanes x 16");
typedef float f32x4g __attribute__((ext_vector_type(4)));
__device__ __forceinline__ void phase_norm0(const Params& p, char* lds, int bx, int G) {
    const int tid = tid_opaque(), lane = tid & 63, wave = tid >> 6; constexpr int WLD = DM + 4;
    float* WG = (float*)lds; float* XS = (float*)(lds + 16 * WLD * 4);
    __syncthreads();
    { f4 tv[DM * 4 / NTHREADS];
#pragma unroll
      for (int it = 0; it < DM * 4 / NTHREADS; ++it) { const int k = it * (NTHREADS / 4) + (tid >> 2); tv[it] = *(const f4*)(p.winab + (size_t)k * ABIN + ABMAIN + 4 * (tid & 3)); }
#pragma unroll
      for (int it = 0; it < DM * 4 / NTHREADS; ++it) { const int k = it * (NTHREADS / 4) + (tid >> 2), g0 = 4 * (tid & 3); WG[(g0 + 0) * WLD + k] = tv[it][0]; WG[(g0 + 1) * WLD + k] = tv[it][1]; WG[(g0 + 2) * WLD + k] = tv[it][2]; WG[(g0 + 3) * WLD + k] = tv[it][3]; } }
    const int r = lane & 15, kq = lane >> 4, pair = wave >> 1, kh = wave & 1;
    float* SQ = XS + pair * 32; float* GP = XS + 128 + pair * 256;
    for (int it = 0;; ++it) {
        const int rb0 = (it * G + bx) * (NWAVES / 2); if (rb0 >= MTOK / 16) break;
        const int rb = rb0 + pair; const int row = rb * 16 + r; const int cls = cls_of(rb * 16); const int kb = 512 * kh + 4 * kq;
        const float* xr = xrow(p, row) + kb;
        f4 x[32]; float s = 0.f;
#pragma unroll
        for (int q = 0; q < 32; ++q) x[q] = *(const f4*)(xr + 16 * q);
#pragma unroll
        for (int q = 0; q < 32; ++q) s += (x[q][0] * x[q][0] + x[q][1] * x[q][1]) + (x[q][2] * x[q][2] + x[q][3] * x[q][3]);
        s += swz_xor<16>(s); s = half_sum(s);
        __syncthreads();
        if (kq == 0) SQ[kh * 16 + r] = s;
        __syncthreads();
        const float rs = 1.0f / sqrtf((SQ[r] + SQ[16 + r]) * (1.0f / DM) + EPSF);
        const float* gp = p.n1g + kb; const float* scp = modv(p, 0, cls, 1) + kb; const float* shp = modv(p, 0, cls, 0) + kb; const float* wp = WG + r * WLD + kb;
        bf16_t* xo = (bf16_t*)(p.ws + WS_XN) + (size_t)row * DM + kb;
        f32x4g acc = {0.f, 0.f, 0.f, 0.f};
#pragma unroll
        for (int q = 0; q < 32; ++q) { const f4 gg = *(const f4*)(gp + 16 * q), sc = *(const f4*)(scp + 16 * q), sh = *(const f4*)(shp + 16 * q), w = *(const f4*)(wp + 16 * q);
            const f4 h = x[q] * rs * gg * (sc + 1.0f) + sh;
            u2 o; o.x = pg8::cvt_pk_bf16(h[0], h[1]); o.y = pg8::cvt_pk_bf16(h[2], h[3]); *(u2*)(xo + 16 * q) = o;
            acc = __builtin_amdgcn_mfma_f32_16x16x4f32(h[0], w[0], acc, 0, 0, 0); acc = __builtin_amdgcn_mfma_f32_16x16x4f32(h[1], w[1], acc, 0, 0, 0);
            acc = __builtin_amdgcn_mfma_f32_16x16x4f32(h[2], w[2], acc, 0, 0, 0); acc = __builtin_amdgcn_mfma_f32_16x16x4f32(h[3], w[3], acc, 0, 0, 0); }
        if (kh == 1) *(f32x4g*)(GP + lane * 4) = acc;
        __syncthreads();
        if (kh == 0) { const f32x4g o2 = *(const f32x4g*)(GP + lane * 4); const float bg = p.bgate[r];
#pragma unroll
            for (int e = 0; e < 4; ++e) { float a = acc[e] + o2[e] + bg; if ((r & 7) >= 4) a = logsigmoidf_(a); ((float*)(p.ws + WS_GATES))[(size_t)(rb * 16 + 4 * kq + e) * NGATE + r] = a; } }
    }
}
static_assert(MTOK % 64 == 0 && MC % 16 == 0 && LSEQ % 16 == 0 && DM == 1024, "norm0 row blocks");
__device__ __forceinline__ void phase_conv(const Params& p, char* lds, int ufirst, int ustride) {
    const int tid = tid_opaque(), lane = tid & 63, wave = tid >> 6; constexpr int TT = 32, NR = TT + CWID - 1;
    bf16_t* X = (bf16_t*)lds; float* OUT = (float*)(lds + 65536);
    const int cp = tid & 255, tg = tid >> 8, c0 = 2 * cp;
    float w0[CWID], w1[CWID];
#pragma unroll
    for (int j = 0; j < CWID; ++j) { w0[j] = p.convw[(size_t)j * CCH + c0]; w1[j] = p.convw[(size_t)j * CCH + c0 + 1]; }
    const float b0 = p.convb[c0], b1 = p.convb[c0 + 1];
    const bf16_t* U = (const bf16_t*)(p.ws + WS_UPRE);
    if (ufirst < 0) return;
    for (int u = ufirst; u < MTOK / TT; u += ustride) {
        const int row0 = u * TT, pos0 = pos_of(row0), len = seqlen_of(row0);
        __syncthreads();
        { u4 val[8];
#pragma unroll
          for (int i = 0; i < 8; ++i) { const int c = tid + NTHREADS * i, r = c / (CCH / 8), ch = (c % (CCH / 8)) * 8; const int t = pos0 + r - CWID / 2;
              val[i] = (u4){0u, 0u, 0u, 0u}; if (c < NR * (CCH / 8) && t >= 0 && t < len) val[i] = *(const u4*)(U + (size_t)(row0 + r - CWID / 2) * CCH + ch); }
#pragma unroll
          for (int i = 0; i < 8; ++i) { const int c = tid + NTHREADS * i, r = c / (CCH / 8), ch = (c % (CCH / 8)) * 8; if (c < NR * (CCH / 8)) *(u4*)(X + (size_t)r * CCH + ch) = val[i]; } }
        __syncthreads();
#pragma unroll 2
        for (int tt = 0; tt < TT / 2; ++tt) { const int t = tg * (TT / 2) + tt; float a0 = b0, a1 = b1;
#pragma unroll
            for (int j = 0; j < CWID; ++j) { const unsigned xx = *(const unsigned*)(X + (size_t)(t + j) * CCH + c0); a0 += w0[j] * __uint_as_float(xx << 16); a1 += w1[j] * __uint_as_float(xx & 0xffff0000u); }
            *(float2*)(OUT + (size_t)t * CCH + c0) = make_float2(a0, a1); }
        __syncthreads();
#pragma unroll
        for (int q = 0; q < TT / NWAVES; ++q) { const int t = wave * (TT / NWAVES) + q; const f4 x0 = *(const f4*)(OUT + (size_t)t * CCH + lane * 8), x1 = *(const f4*)(OUT + (size_t)t * CCH + lane * 8 + 4);
            const float mu = wave_sum64((x0[0] + x0[1]) + (x0[2] + x0[3]) + (x1[0] + x1[1]) + (x1[2] + x1[3])) * (1.0f / CCH);
            const f4 d0 = x0 - mu, d1 = x1 - mu;
            const float var = wave_sum64((d0[0] * d0[0] + d0[1] * d0[1]) + (d0[2] * d0[2] + d0[3] * d0[3]) + (d1[0] * d1[0] + d1[1] * d1[1]) + (d1[2] * d1[2] + d1[3] * d1[3])) * (1.0f / CCH);
            const float rs = 1.0f / sqrtf(var + EPSF);
            const f4 g0 = *(const f4*)(p.lng + lane * 8), g1 = *(const f4*)(p.lng + lane * 8 + 4), be0 = *(const f4*)(p.lnb + lane * 8), be1 = *(const f4*)(p.lnb + lane * 8 + 4);
            const f4 y0 = d0 * rs * g0 + be0, y1 = d1 * rs * g1 + be1; u4 w;
            w.x = pg8::cvt_pk_bf16(fsilu(y0[0]), fsilu(y0[1])); w.y = pg8::cvt_pk_bf16(fsilu(y0[2]), fsilu(y0[3])); w.z = pg8::cvt_pk_bf16(fsilu(y1[0]), fsilu(y1[1])); w.w = pg8::cvt_pk_bf16(fsilu(y1[2]), fsilu(y1[3]));
            *(u4*)((bf16_t*)(p.ws + WS_UH) + (size_t)(row0 + t) * DM + lane * 8) = w; }
    }
}
static_assert(CCH == 512 && CSEQ % 32 == 0 && LSEQ % 32 == 0, "conv phase geometry");
__device__ __forceinline__ void phase_cachecvt(const Params& p, int gtid, int gthreads) {
    constexpr int PER = PAST * NKV * HDIM / 8;
    for (int i = gtid; i < NLB * PER; i += gthreads) { const int b = i / PER, e = (i % PER) * 8; const size_t src = (size_t)b * PAST * NKV * HDIM + e, dst = ((size_t)b * SKVL + LSEQ) * NKV * HDIM + e;
        const f4 k0 = *(const f4*)(p.ck + src), k1 = *(const f4*)(p.ck + src + 4), v0 = *(const f4*)(p.cv + src), v1 = *(const f4*)(p.cv + src + 4); u4 wk, wv;
        wk.x = pg8::cvt_pk_bf16(k0[0], k0[1]); wk.y = pg8::cvt_pk_bf16(k0[2], k0[3]); wk.z = pg8::cvt_pk_bf16(k1[0], k1[1]); wk.w = pg8::cvt_pk_bf16(k1[2], k1[3]);
        wv.x = pg8::cvt_pk_bf16(v0[0], v0[1]); wv.y = pg8::cvt_pk_bf16(v0[2], v0[3]); wv.z = pg8::cvt_pk_bf16(v1[0], v1[1]); wv.w = pg8::cvt_pk_bf16(v1[2], v1[3]);
        *(u4*)((bf16_t*)(p.ws + WS_LATK) + dst) = wk; *(u4*)((bf16_t*)(p.ws + WS_LATV) + dst) = wv; }
}
__device__ __forceinline__ void phase_qkpost(const Params& p, int gw, int NGW, int lane) {
    const int hh = lane >> 5, l5 = lane & 31, half = l5 >> 4, f0 = (l5 & 15) * 2, d1 = half * 64 + f0, d2 = d1 + 32;
    const float inv0 = __builtin_amdgcn_exp2f(-(float)f0 * (13.287712379549449f / 32.0f)), inv1 = __builtin_amdgcn_exp2f(-(float)(f0 + 1) * (13.287712379549449f / 32.0f));
    const float qg[4] = {p.qng[d1], p.qng[d1 + 1], p.qng[d2], p.qng[d2 + 1]}, kg[4] = {p.kng[d1], p.kng[d1 + 1], p.kng[d2], p.kng[d2 + 1]};
    for (int row = gw; row < MTOK; row += NGW) {
        const bool lat = row >= MC; const int sp = pos_of(row); float cs0 = 1.f, sn0 = 0.f, cs1 = 1.f, sn1 = 0.f;
        if (lat) { const float pos = (float)(half == 0 ? sp / GRIDW : sp % GRIDW); cs0 = __cosf(pos * inv0); sn0 = __sinf(pos * inv0); cs1 = __cosf(pos * inv1); sn1 = __sinf(pos * inv1); }
        bf16_t* Q = (bf16_t*)(p.ws + WS_QRAW) + (size_t)row * NQ * HDIM; const bf16_t* KR = (const bf16_t*)(p.ws + WS_KRAW) + (size_t)row * NKV * HDIM;
        unsigned ra[NQ / 2 + 1], rb[NQ / 2 + 1];
#pragma unroll
        for (int it = 0; it <= NQ / 2; ++it) { const bf16_t* src = it < NQ / 2 ? Q + (2 * it + hh) * HDIM : KR + hh * HDIM; ra[it] = *(const unsigned*)(src + d1); rb[it] = *(const unsigned*)(src + d2); }
#pragma unroll
        for (int it = 0; it <= NQ / 2; ++it) { const bool isq = it < NQ / 2;
            const float x1a = __uint_as_float(ra[it] << 16), x1b = __uint_as_float(ra[it] & 0xffff0000u), x2a = __uint_as_float(rb[it] << 16), x2b = __uint_as_float(rb[it] & 0xffff0000u);
            float ss = (x1a * x1a + x1b * x1b) + (x2a * x2a + x2b * x2b); ss += swz_xor<1>(ss); ss += swz_xor<2>(ss); ss += swz_xor<4>(ss); ss += swz_xor<8>(ss); ss += swz_xor<16>(ss);
            const float rs = 1.0f / sqrtf(ss * (1.0f / HDIM) + EPSF); const float* g = isq ? qg : kg;
            const float a0 = x1a * rs * g[0], a1 = x1b * rs * g[1], b0 = x2a * rs * g[2], b1 = x2b * rs * g[3];
            const float y1a = a0 * cs0 - b0 * sn0, y2a = a0 * sn0 + b0 * cs0, y1b = a1 * cs1 - b1 * sn1, y2b = a1 * sn1 + b1 * cs1;
            const unsigned w1 = pg8::cvt_pk_bf16(y1a, y1b), w2 = pg8::cvt_pk_bf16(y2a, y2b);
            if (isq) { bf16_t* dst = Q + (2 * it + hh) * HDIM; *(unsigned*)(dst + d1) = w1; *(unsigned*)(dst + d2) = w2; }
            else if (!lat) { bf16_t* K = (bf16_t*)(p.ws + WS_CTXK) + (size_t)row * NKV * HDIM + hh * HDIM; *(unsigned*)(K + d1) = w1; *(unsigned*)(K + d2) = w2;
                float* fo = p.out + O_K + (size_t)row * NKV * HDIM + hh * HDIM; *(float2*)(fo + d1) = make_float2(y1a, y1b); *(float2*)(fo + d2) = make_float2(y2a, y2b); }
            else { const int b_ = (row - MC) / LSEQ, s_ = (row - MC) % LSEQ; bf16_t* K = (bf16_t*)(p.ws + WS_LATK) + ((size_t)b_ * SKVL + s_) * NKV * HDIM + hh * HDIM; *(unsigned*)(K + d1) = w1; *(unsigned*)(K + d2) = w2; } }
    }
}
static_assert(NKV == 2 && NQ % 2 == 0 && HDIM == 128, "qkpost lane mapping");
__device__ __forceinline__ void phase_final(const Params& p, int gw, int NGW, int lane) {
    const f4 g0 = *((const f4*)p.fng + 2 * lane), g1 = *((const f4*)p.fng + 2 * lane + 1), g2 = *((const f4*)p.fng + 128 + 2 * lane), g3 = *((const f4*)p.fng + 128 + 2 * lane + 1);
    const float* sq = (const float*)(p.ws + WS_SSQ) + (size_t)3 * SSQ_STRIDE;
    for (int row = gw; row < MTOK; row += 2 * NGW) { const int row2 = row + NGW; const bool has2 = row2 < MTOK; const int r2 = has2 ? row2 : row;
        const float rsa = 1.0f / sqrtf(sq[row] * (1.0f / DM) + EPSF), rsb = 1.0f / sqrtf(sq[r2] * (1.0f / DM) + EPSF);
        const u4* ya = (const u4*)((const bf16_t*)(p.ws + WS_Y16) + (size_t)row * DM) + lane; const u4* yb = (const u4*)((const bf16_t*)(p.ws + WS_Y16) + (size_t)r2 * DM) + lane;
        const u4 a0 = ya[0], a1 = ya[64], b0 = yb[0], b1 = yb[64];
        f4* oa = (f4*)(p.out + O_Y + (size_t)row * DM) + 2 * lane; f4* ob = (f4*)(p.out + O_Y + (size_t)r2 * DM) + 2 * lane;
#define UNP_LO(V_) (f4){__uint_as_float((V_).x << 16), __uint_as_float((V_).x & 0xffff0000u), __uint_as_float((V_).y << 16), __uint_as_float((V_).y & 0xffff0000u)}
#define UNP_HI(V_) (f4){__uint_as_float((V_).z << 16), __uint_as_float((V_).z & 0xffff0000u), __uint_as_float((V_).w << 16), __uint_as_float((V_).w & 0xffff0000u)}
        oa[0] = UNP_LO(a0) * rsa * g0; oa[1] = UNP_HI(a0) * rsa * g1; oa[128] = UNP_LO(a1) * rsa * g2; oa[129] = UNP_HI(a1) * rsa * g3;
        if (has2) { ob[0] = UNP_LO(b0) * rsb * g0; ob[1] = UNP_HI(b0) * rsb * g1; ob[128] = UNP_LO(b1) * rsb * g2; ob[129] = UNP_HI(b1) * rsb * g3; }
#undef UNP_LO
#undef UNP_HI
    }
}
template <class Epi> __device__ __forceinline__ void gemm_call(LAS unsigned char* lds, const bf16_t* A, const bf16_t* Bt, int N, int K, const Epi& E) {
    pg8::Gemm g{A, Bt, MTOK, N, K}; pg8::StaticOrder S; S.init(MTOK, N, K, (int)gridDim.x, (int)blockIdx.x);
    pg8::gemm_phase<Epi, pg8::StaticOrder, true, true>((PG8_LAS unsigned char*)lds, g, S, E);
}
#ifdef PROBE_A
#define ISTAMP(i) do { if (blockIdx.x == 0 && threadIdx.x == 0 && K == PROBE_K) *(volatile LAS unsigned*)(uintptr_t)(MISC_OFF + 4 * (i)) = (unsigned)__builtin_amdgcn_s_memrealtime(); } while (0)
#else
#define ISTAMP(i) do {} while (0)
#endif
__device__ __forceinline__ void gemm_call_split(LAS unsigned char* lds, const bf16_t* A, const bf16_t* Bt, int N, int K, const EpiRes& E, unsigned char* slab, unsigned* cnt) {
    pg8::Gemm g{A, Bt, MTOK, N, K}; RoundZeroOrder S0; S0.init(MTOK, N, K, (int)gridDim.x, (int)blockIdx.x);
    ISTAMP(0);
    pg8::gemm_phase<EpiRes, RoundZeroOrder, true, true>((PG8_LAS unsigned char*)lds, g, S0, E);
    ISTAMP(1);
    if (S0.split) { QuarterOrder S1; S1.init(MTOK, N, K, (int)gridDim.x, (int)blockIdx.x);
        pg8::gemm_phase<EpiPartial, QuarterOrder, true, true>((PG8_LAS unsigned char*)lds, g, S1, EpiPartial{slab, cnt});
        ISTAMP(2);
        tail_reduce(E, slab, cnt, (int)gridDim.x, (int)blockIdx.x, N / 256, MTOK / 256); ISTAMP(3); }
}
__global__ void __launch_bounds__(NTHREADS, 2) mega_fwd(Params p) {
    extern __shared__ __attribute__((aligned(16))) unsigned char lds[];
    LAS unsigned char* L = (LAS unsigned char*)lds;
    for (int u = threadIdx.x; u < (LDS_BYTES - LDSCTL_OFF) / 4; u += NTHREADS) ((LAS unsigned*)(L + LDSCTL_OFF))[u] = 0u;
    __syncthreads();
    volatile LAS unsigned* MISC = (volatile LAS unsigned*)(L + MISC_OFF);
    const XcdBarrier bar = xcd_barrier_post((unsigned*)(p.ws + WS_CTL) + CW_BAR, MISC + 8);
    const int G = gridDim.x, bx = blockIdx.x; const int vcu = (G % 8 == 0) ? (bx % 8) * (G / 8) + bx / 8 : bx;
    unsigned char* ws = p.ws;
    const bf16_t* XN = (const bf16_t*)(ws + WS_XN); const bf16_t* UH = (const bf16_t*)(ws + WS_UH); const bf16_t* Hh = (const bf16_t*)(ws + WS_H); const bf16_t* Ob = (const bf16_t*)(ws + WS_O);
    float* SW0 = (float*)(ws + WS_SW); float* SWC = SW0 + (size_t)NCLS * 2 * DFF; float* SW1 = SWC + (size_t)NCLS * CIN;
    float* SSQ = (float*)(ws + WS_SSQ); float* Y = p.out + O_Y; unsigned* SPLITC = (unsigned*)(ws + WS_CTL) + CW_SPLIT;
#define WAVE_IDS() const int tid_ = tid_opaque(); const int lane_ = tid_ & 63; const int gw_ = bx * NWAVES + (tid_ >> 6); const int NGW_ = G * NWAVES
    p0_weights(p, L, vcu, G); phase_mod(p, (char*)lds, bx, G);
    xcd_barrier(bar);
    phase_norm0(p, (char*)lds, bx, G);
    xcd_barrier(bar);
    gemm_call(L, XN, (const bf16_t*)(ws + WB_AB), ABMAIN, DM, EpiAB{(bf16_t*)(ws + WS_UPRE), (bf16_t*)(ws + WS_QKVO)}); xcd_barrier(bar);
    ml_phase_A(p, lds, vcu, G);
    { WAVE_IDS(); constexpr int NU_ML = NLB * MH * NBLK + NCB * MH; const int nsecond = (NU_ML > G && NU_ML - G < G) ? NU_ML - G : 0;
      if (vcu >= nsecond) { const int gw2 = (vcu - nsecond) * NWAVES + (tid_ >> 6), ngw2 = (G - nsecond) * NWAVES;
        sw_job(p, (const bf16_t*)(ws + WB_FFI0), 2 * DFF, 0, 3, SW0, 2 * DFF, 1, gw2, ngw2, lane_); sw_job(p, (const bf16_t*)(ws + WB_INC), CIN, 1, 0, SWC, CIN, 0, gw2, ngw2, lane_);
        sw_job(p, (const bf16_t*)(ws + WB_FFI1), 2 * DFF, 1, 3, SW1, 2 * DFF, 1, gw2, ngw2, lane_); } }
    xcd_barrier(bar);
    { WAVE_IDS(); MlScan sc{p}; for (long i = bx * (long)NTHREADS + tid_; i < MlScan::count(); i += (long)G * NTHREADS) sc(i); } xcd_barrier(bar);
    ml_phase_C(p, lds, vcu, G);
    { constexpr int NU_ML = NLB * MH * NBLK + NCB * MH; const int nsecond = NU_ML > G ? NU_ML - G : 0;
      if (nsecond < G) phase_conv(p, (char*)lds, vcu >= nsecond ? vcu - nsecond : -1, G - nsecond); else phase_conv(p, (char*)lds, vcu, G); }
    xcd_barrier(bar);
    gemm_call_split(L, UH, (const bf16_t*)(ws + WB_OUTAB), DM, DM, EpiRes{p.xp, p.xs, (bf16_t*)(ws + WS_Y16), (bf16_t*)(ws + WS_XN), SSQ + 0 * SSQ_STRIDE, modv(p, 0, 0, 2), modv(p, 0, 0, 4), p.n2g, 1, 0}, (unsigned char*)Y, SPLITC + 0 * 4096); xcd_barrier(bar);
    gemm_call(L, XN, (const bf16_t*)(ws + WB_FFI0), 2 * DFF, DM, EpiFfnIn{(bf16_t*)(ws + WS_H), SSQ + 0 * SSQ_STRIDE, SW0}); xcd_barrier(bar);
    gemm_call_split(L, Hh, (const bf16_t*)(ws + WB_FFO0), DM, DFF, EpiRes{p.xp, p.xs, (bf16_t*)(ws + WS_Y16), (bf16_t*)(ws + WS_XN), SSQ + 1 * SSQ_STRIDE, modv(p, 0, 0, 5), modv(p, 1, 0, 1), p.n1g + DM, 0, 0}, (unsigned char*)Y + SLAB_BYTES, SPLITC + 1 * 4096); xcd_barrier(bar);
    gemm_call(L, XN, (const bf16_t*)(ws + WB_INC), CIN, DM, EpiQkv{(bf16_t*)(ws + WS_QRAW), (bf16_t*)(ws + WS_KRAW), (bf16_t*)(ws + WS_CTXV), (bf16_t*)(ws + WS_LATV), p.out + O_V, SSQ + 1 * SSQ_STRIDE, SWC}); xcd_barrier(bar);
    { WAVE_IDS(); phase_qkpost(p, gw_, NGW_, lane_); phase_cachecvt(p, bx * NTHREADS + tid_, G * NTHREADS); } xcd_barrier(bar);
    attn_phase(p, lds, vcu, G); xcd_barrier(bar);
    gemm_call_split(L, Ob, (const bf16_t*)(ws + WB_OUTC), DM, DM, EpiRes{p.xp, p.xs, (bf16_t*)(ws + WS_Y16), (bf16_t*)(ws + WS_XN), SSQ + 2 * SSQ_STRIDE, modv(p, 1, 0, 2), modv(p, 1, 0, 4), p.n2g + DM, 0, 0}, (unsigned char*)Y, SPLITC + 2 * 4096); xcd_barrier(bar);
    gemm_call(L, XN, (const bf16_t*)(ws + WB_FFI1), 2 * DFF, DM, EpiFfnIn{(bf16_t*)(ws + WS_H), SSQ + 2 * SSQ_STRIDE, SW1}); xcd_barrier(bar);
    gemm_call_split(L, Hh, (const bf16_t*)(ws + WB_FFO1), DM, DFF, EpiRes{p.xp, p.xs, (bf16_t*)(ws + WS_Y16), (bf16_t*)(ws + WS_XN), SSQ + 3 * SSQ_STRIDE, modv(p, 1, 0, 5), modv(p, 1, 0, 1), nullptr, 0, 0}, (unsigned char*)Y + SLAB_BYTES, SPLITC + 3 * 4096); xcd_barrier(bar);
    { WAVE_IDS(); phase_final(p, gw_, NGW_, lane_); }
#undef WAVE_IDS
}
static Params make_params(void* const* d_in, void* d_out, void* d_ws) {
    Params p{}; const float** pp = (const float**)&p; for (int i = 0; i < 28; ++i) pp[i] = (const float*)d_in[i];
    p.out = (float*)d_out; p.ws = (unsigned char*)d_ws; return p;
}
extern "C" void kernel_launch(void* const* d_in, const int* in_sizes, int n_in, void* d_out, int out_size, void* d_ws, size_t ws_size, hipStream_t stream) {
    static int grid = 0;
    if (grid == 0) {
        if (n_in != 28 || (size_t)out_size != O_END || ws_size < WS_END || in_sizes[0] != MC * DM || in_sizes[1] != ML * DM) {
            fprintf(stderr, "kernel_launch: shape mismatch n_in %d out %d (want %zu) ws %zu (want %zu)\n", n_in, out_size, (size_t)O_END, ws_size, (size_t)WS_END); grid = -1; return; }
        int dev = 0, cus = 0;
        if (hipGetDevice(&dev) != hipSuccess || hipDeviceGetAttribute(&cus, hipDeviceAttributeMultiprocessorCount, dev) != hipSuccess) { grid = -1; return; }
        if (hipFuncSetAttribute((const void*)mega_fwd, hipFuncAttributeMaxDynamicSharedMemorySize, LDS_BYTES) != hipSuccess) { fprintf(stderr, "hipFuncSetAttribute failed\n"); grid = -1; return; }
        int per_cu = 0; (void)hipOccupancyMaxActiveBlocksPerMultiprocessor(&per_cu, (const void*)mega_fwd, NTHREADS, LDS_BYTES); (void)hipGetLastError();
        if (per_cu < 1) fprintf(stderr, "kernel_launch: occupancy query says %d blocks/CU\n", per_cu);
        grid = cus;
    }
    if (grid < 0) return;
    hipMemsetAsync((char*)d_ws + WS_CTL, 0, CTL_ZERO_BYTES, stream);
    Params p = make_params(d_in, d_out, d_ws);
    hipLaunchKernelGGL(mega_fwd, dim3(grid), dim3(NTHREADS), LDS_BYTES, stream, p);
}
```

```cpp
#ifdef HOST_TEST
#include <cmath>
#include <cstdio>
#include <cstdlib>
#include <cstring>
#include <cstdint>
#include <vector>
#define HD_FN inline
#define DEV_FN inline
#else
#include <hip/hip_runtime.h>
#include <cstdio>
#include <cstdint>
#define HD_FN __host__ __device__ __forceinline__
#define DEV_FN __device__ __forceinline__
#endif

#ifdef TINY
constexpr int DM = 512, NCB = 2, CSEQ = 128, NLB = 2, LSEQ = 128, PAST = 128;
#else
constexpr int DM = 1024, NCB = 16, CSEQ = 256, NLB = 4, LSEQ = 4096, PAST = 256;
#endif
constexpr int GRIDW = 64, CCH = DM / 2, CWID = 31, MH = 4, MDK = CCH / MH, MW = CCH, NGATE = 16;
constexpr int ABIN = 2 * CCH + 4 * MW + NGATE, ABMAIN = 2 * CCH + 4 * MW;
constexpr int HDIM = 128, NQ = DM / HDIM, NKV = 2, GRP = NQ / NKV, CIN = (NQ + 2 * NKV) * HDIM;
constexpr int DFF = ((8 * DM + 3 * 256 - 1) / (3 * 256)) * 256;
constexpr int MC = NCB * CSEQ, ML = NLB * LSEQ, MTOK = MC + ML, NCLS = 1 + NLB, SKVL = LSEQ + PAST;
constexpr float EPSF = 1e-6f;
constexpr int NSEQ = NCB + NLB;

constexpr size_t O_Y = 0, O_C = (size_t)MTOK * DM, O_N = O_C + (size_t)NCB * 2 * MH * MDK * MDK, O_M = O_N + (size_t)NCB * 2 * MH * MDK,
                 O_K = O_M + (size_t)NCB * 2 * MH, O_V = O_K + (size_t)NCB * CSEQ * NKV * HDIM, O_END = O_V + (size_t)NCB * CSEQ * NKV * HDIM;

constexpr size_t MiB = 1u << 20;
#ifdef TINY
constexpr size_t WSCALE = 1;
#endif
constexpr size_t WS_CTL = 0, CTL_ZERO_BYTES = 1 * MiB;
constexpr size_t WS_MOD = 1 * MiB;
constexpr size_t WS_SW = WS_MOD + 256 * 1024;
constexpr size_t WS_SSQ = 512 * 1024;
constexpr int SSQ_STRIDE = 32768;
constexpr size_t WS_DEN = 232 * MiB;
constexpr size_t WS_WB = 2 * MiB;
constexpr size_t WS_XN = 50 * MiB;
constexpr size_t WS_UPRE = 90 * MiB;
constexpr size_t WS_QKVO = 110 * MiB;
constexpr size_t WS_UH = 190 * MiB;
constexpr size_t WS_GATES = 230 * MiB;
constexpr size_t WS_HS = 50 * MiB;
constexpr size_t WS_Y16 = 90 * MiB;
constexpr size_t WS_H = 130 * MiB;
constexpr size_t WS_QRAW = 130 * MiB;
constexpr size_t WS_LATK = 170 * MiB, WS_LATV = 179 * MiB, WS_CTXK = 188 * MiB, WS_CTXV = 190 * MiB;
constexpr size_t WS_KRAW = 192 * MiB;
constexpr size_t WS_O = 202 * MiB;
constexpr size_t WS_END = 256 * MiB;

typedef unsigned short bf16_t;
HD_FN float bf2f(bf16_t h) { unsigned u = (unsigned)h << 16; return __builtin_bit_cast(float, u); }
HD_FN bf16_t f2bf(float f) { unsigned u = __builtin_bit_cast(unsigned, f); return (bf16_t)((u + 0x7fffu + ((u >> 16) & 1u)) >> 16); }
HD_FN float rbf(float f) { return bf2f(f2bf(f)); }
HD_FN float sigmoidf_(float x) { return 1.0f / (1.0f + expf(-x)); }
HD_FN float siluf_(float x) { return x * sigmoidf_(x); }
HD_FN float logsigmoidf_(float x) { return x >= 0.f ? -log1pf(expf(-x)) : x - log1pf(expf(x)); }
HD_FN int cls_of(int row) { return row < MC ? 0 : 1 + (row - MC) / LSEQ; }
HD_FN int seqlen_of(int row) { return row < MC ? CSEQ : LSEQ; }
HD_FN int pos_of(int row) { return row < MC ? row % CSEQ : (row - MC) % LSEQ; }

struct Params {
    const float *xp, *xs, *c, *stC, *stn, *stm, *ck, *cv, *cctx, *wmod, *bmod, *n1g, *n2g, *winab, *bgate, *convw, *convb, *lng, *lnb, *mng,
        *woutab, *winc, *qng, *kng, *woutc, *wffi, *wffo, *fng;
    float* out; unsigned char* ws;
};
HD_FN const float* xrow(const Params& p, int row) { return row < MC ? p.xp + (size_t)row * DM : p.xs + (size_t)(row - MC) * DM; }
HD_FN const float* modv(const Params& p, int l, int cls, int which) { return (const float*)(p.ws + WS_MOD) + ((size_t)(l * NCLS + cls) * 6 + which) * DM; }
constexpr size_t WS_RS0 = 233 * MiB;

struct NMod {
    Params p; static HD_FN long count() { return 2L * NCLS * 6 * DM; }
    HD_FN void operator()(long idx) const {
        const int col = (int)(idx % (6 * DM)); const int cls = (int)((idx / (6 * DM)) % NCLS); const int l = (int)(idx / (6 * DM * NCLS));
        const float* cond = cls == 0 ? p.cctx : p.c + (size_t)(cls - 1) * DM;
        const float* w = p.wmod + (size_t)l * DM * 6 * DM;
        float acc = 0.f;
        for (int k = 0; k < DM; ++k) acc += siluf_(cond[k]) * w[(size_t)k * 6 * DM + col];
        ((float*)(p.ws + WS_MOD))[idx] = acc + p.bmod[(size_t)l * 6 * DM + col];
    }
};
struct NNorm0a {
    Params p; static HD_FN long count() { return MTOK; }
    HD_FN void operator()(long row) const {
        const float* x = xrow(p, (int)row); float s = 0.f;
        for (int k = 0; k < DM; ++k) s += x[k] * x[k];
        ((float*)(p.ws + WS_RS0))[row] = 1.0f / sqrtf(s / DM + EPSF);
    }
};
struct NNorm0b {
    Params p; static HD_FN long count() { return (long)MTOK * DM; }
    HD_FN void operator()(long idx) const {
        const int row = (int)(idx / DM), col = (int)(idx % DM), cls = cls_of(row);
        const float rs = ((const float*)(p.ws + WS_RS0))[row];
        const float v = xrow(p, row)[col] * rs * p.n1g[col] * (1.f + modv(p, 0, cls, 1)[col]) + modv(p, 0, cls, 0)[col];
        ((bf16_t*)(p.ws + WS_XN))[idx] = f2bf(v);
    }
};
struct NGates {
    Params p; static HD_FN long count() { return (long)MTOK * NGATE; }
    HD_FN void operator()(long idx) const {
        const int row = (int)(idx / NGATE), j = (int)(idx % NGATE), cls = cls_of(row);
        const float rs = ((const float*)(p.ws + WS_RS0))[row]; const float* x = xrow(p, row);
        const float* sc = modv(p, 0, cls, 1); const float* sh = modv(p, 0, cls, 0);
        float acc = 0.f;
        for (int k = 0; k < DM; ++k) { const float h = x[k] * rs * p.n1g[k] * (1.f + sc[k]) + sh[k]; acc += h * p.winab[(size_t)k * ABIN + ABMAIN + j]; }
        acc += p.bgate[j];
        if ((j & 7) >= 4) acc = logsigmoidf_(acc);
        ((float*)(p.ws + WS_GATES))[idx] = acc;
    }
};

template <bool DUAL, class Epi> struct NGemm {
    const bf16_t* A; const float* B; int lda, ldb, K, N, off2, pad_; Epi epi;
    HD_FN long count() const { return (long)(MTOK / 4) * (N / 4); }
    HD_FN void operator()(long idx) const {
        const int nt = (int)(idx % (N / 4)), mt = (int)(idx / (N / 4)); const int m0 = mt * 4, n0 = nt * 4;
        float acc[4][4], acc2[4][4];
#pragma unroll
        for (int i = 0; i < 4; ++i)
#pragma unroll
            for (int j = 0; j < 4; ++j) { acc[i][j] = 0.f; acc2[i][j] = 0.f; }
        for (int k0 = 0; k0 < K; k0 += 8) {
            float a[4][8];
#pragma unroll
            for (int i = 0; i < 4; ++i) {
                const bf16_t* ap = A + (size_t)(m0 + i) * lda + k0;
#pragma unroll
                for (int kk = 0; kk < 8; ++kk) a[i][kk] = bf2f(ap[kk]);
            }
#pragma unroll
            for (int kk = 0; kk < 8; ++kk) {
                const float* bp = B + (size_t)(k0 + kk) * ldb + n0;
                float b[4], b2[4];
#pragma unroll
                for (int j = 0; j < 4; ++j) { b[j] = rbf(bp[j]); b2[j] = DUAL ? rbf(bp[off2 + j]) : 0.f; }
#pragma unroll
                for (int i = 0; i < 4; ++i)
#pragma unroll
                    for (int j = 0; j < 4; ++j) { acc[i][j] += a[i][kk] * b[j]; if (DUAL) acc2[i][j] += a[i][kk] * b2[j]; }
            }
        }
#pragma unroll
        for (int i = 0; i < 4; ++i)
#pragma unroll
            for (int j = 0; j < 4; ++j) epi(m0 + i, n0 + j, acc[i][j], acc2[i][j]);
    }
};
struct EGlu { Params p; HD_FN void operator()(int row, int col, float v, float v2) const { ((bf16_t*)(p.ws + WS_UPRE))[(size_t)row * CCH + col] = f2bf(v * sigmoidf_(v2)); } };
struct EQkvo { Params p; HD_FN void operator()(int row, int col, float v, float) const {
        const int part = col / MW; if (part == 1) v *= 1.0f / sqrtf((float)MDK); if (part == 3) v = sigmoidf_(v);
        ((bf16_t*)(p.ws + WS_QKVO))[(size_t)row * 4 * MW + col] = f2bf(v); } };
struct EOut { Params p; int l; int pad_ = 0; HD_FN void operator()(int row, int col, float v, float) const {
        const int cls = cls_of(row); float* Y = p.out + O_Y + (size_t)row * DM + col;
        const float xin = l == 0 ? xrow(p, row)[col] : *Y;
        const float x1 = xin + modv(p, l, cls, 2)[col] * v; *Y = x1;
        ((bf16_t*)(p.ws + WS_XN))[(size_t)row * DM + col] = f2bf(x1 * p.n2g[(size_t)l * DM + col] * (1.f + modv(p, l, cls, 4)[col])); } };
struct EFfnIn { Params p; const float* sw; int slot; int pad_ = 0; HD_FN void operator()(int row, int col, float v, float v2) const {
        const int cls = cls_of(row); const float rs = 1.0f / sqrtf(((const float*)(p.ws + WS_SSQ))[(size_t)slot * SSQ_STRIDE + row] / DM + EPSF);
        const float a = v * rs + sw[(size_t)cls * 2 * DFF + col], b = v2 * rs + sw[(size_t)cls * 2 * DFF + DFF + col];
        ((bf16_t*)(p.ws + WS_H))[(size_t)row * DFF + col] = f2bf(siluf_(a) * b); } };
struct EFfnOut { Params p; int l; int pad_ = 0; HD_FN void operator()(int row, int col, float v, float) const {
        const int cls = cls_of(row); float* Y = p.out + O_Y + (size_t)row * DM + col;
        const float x2 = *Y + modv(p, l, cls, 5)[col] * v; *Y = x2;
        if (l == 0) ((bf16_t*)(p.ws + WS_XN))[(size_t)row * DM + col] = f2bf(x2 * p.n1g[(size_t)DM + col] * (1.f + modv(p, 1, cls, 1)[col])); } };
struct EQkv { Params p; const float* sw; int slot; int pad_ = 0; HD_FN void operator()(int row, int col, float v, float) const {
        const int cls = cls_of(row); const float rs = 1.0f / sqrtf(((const float*)(p.ws + WS_SSQ))[(size_t)slot * SSQ_STRIDE + row] / DM + EPSF);
        const float a = v * rs + sw[(size_t)cls * CIN + col];
        if (col < NQ * HDIM) ((bf16_t*)(p.ws + WS_QRAW))[(size_t)row * NQ * HDIM + col] = f2bf(a);
        else if (col < (NQ + NKV) * HDIM) ((bf16_t*)(p.ws + WS_KRAW))[(size_t)row * NKV * HDIM + (col - NQ * HDIM)] = f2bf(a);
        else { const int c2 = col - (NQ + NKV) * HDIM;
            if (row < MC) { ((bf16_t*)(p.ws + WS_CTXV))[(size_t)row * NKV * HDIM + c2] = f2bf(a); p.out[O_V + (size_t)row * NKV * HDIM + c2] = a; }
            else { const int b = (row - MC) / LSEQ, s = (row - MC) % LSEQ; ((bf16_t*)(p.ws + WS_LATV))[((size_t)b * SKVL + s) * NKV * HDIM + c2] = f2bf(a); } } } };

struct NSsq {
    Params p; int slot; int pad_ = 0; static HD_FN long count() { return MTOK; }
    HD_FN void operator()(long row) const { const float* y = p.out + O_Y + (size_t)row * DM; float s = 0.f; for (int k = 0; k < DM; ++k) s += y[k] * y[k];
        ((float*)(p.ws + WS_SSQ))[(size_t)slot * SSQ_STRIDE + row] = s; }
};
struct NSW {
    Params p; const float* W; float* sw; int l, which, N, pad_; HD_FN long count() const { return (long)NCLS * N; }
    HD_FN void operator()(long idx) const { const int n = (int)(idx % N), cls = (int)(idx / N); const float* sh = modv(p, l, cls, which); float acc = 0.f;
        for (int k = 0; k < DM; ++k) acc += sh[k] * rbf(W[(size_t)k * N + n]); sw[idx] = acc; }
};
struct NConv {
    Params p; static HD_FN long count() { return (long)MTOK * CCH; }
    HD_FN void operator()(long idx) const {
        const int row = (int)(idx / CCH), c = (int)(idx % CCH), pos = pos_of(row), len = seqlen_of(row);
        const bf16_t* U = (const bf16_t*)(p.ws + WS_UPRE); float acc = p.convb[c];
        for (int j = 0; j < CWID; ++j) { const int t = pos + j - CWID / 2; if (t >= 0 && t < len) acc += p.convw[(size_t)j * CCH + c] * bf2f(U[(size_t)(row + j - CWID / 2) * CCH + c]); }
        ((float*)(p.ws + WS_HS))[idx] = acc;
    }
};
struct NConvLN {
    Params p; static HD_FN long count() { return MTOK; }
    HD_FN void operator()(long row) const {
        const float* t = (const float*)(p.ws + WS_HS) + (size_t)row * CCH; float mu = 0.f;
        for (int c = 0; c < CCH; ++c) mu += t[c]; mu /= CCH; float var = 0.f;
        for (int c = 0; c < CCH; ++c) { const float d = t[c] - mu; var += d * d; } var /= CCH;
        const float rs = 1.0f / sqrtf(var + EPSF); bf16_t* UH = (bf16_t*)(p.ws + WS_UH) + (size_t)row * DM;
        for (int c = 0; c < CCH; ++c) UH[c] = f2bf(siluf_((t[c] - mu) * rs * p.lng[c] + p.lnb[c]));
    }
};
HD_FN int seq_base(int sid) { return sid < NCB ? sid * CSEQ : MC + (sid - NCB) * LSEQ; }
struct NMlstmDen {
    Params p; static HD_FN long count() { return (long)NSEQ * MH * 2; }
    HD_FN void operator()(long idx) const {
        const int dir = (int)(idx % 2), h = (int)((idx / 2) % MH), sid = (int)(idx / (2 * MH)); const bool isctx = sid < NCB;
        const int base = seq_base(sid), len = isctx ? CSEQ : LSEQ;
        float n[MDK]; float mrun = 0.f;
        if (isctx) {
#pragma unroll
            for (int d = 0; d < MDK; ++d) n[d] = 0.f;
        } else { const int b = sid - NCB; const float em = expf(p.stm[(size_t)(b * 2 + dir) * MH + h]);
#pragma unroll
            for (int d = 0; d < MDK; ++d) n[d] = p.stn[((size_t)(b * 2 + dir) * MH + h) * MDK + d] * em; }
        const bf16_t* QK = (const bf16_t*)(p.ws + WS_QKVO); const float* G = (const float*)(p.ws + WS_GATES); float* DEN = (float*)(p.ws + WS_DEN);
        for (int t = 0; t < len; ++t) {
            const int row = base + (dir == 0 ? t : len - 1 - t);
            const float ig = G[(size_t)row * NGATE + dir * 8 + h], lf = G[(size_t)row * NGATE + dir * 8 + 4 + h];
            const float f = expf(lf), ei = expf(ig); mrun = fmaxf(mrun + lf, ig);
            const bf16_t* q = QK + (size_t)row * 4 * MW + h * MDK; const bf16_t* k = q + MW; float den = 0.f;
#pragma unroll
            for (int d = 0; d < MDK; ++d) { n[d] = f * n[d] + ei * bf2f(k[d]); den += bf2f(q[d]) * n[d]; }
            DEN[((size_t)dir * MTOK + row) * MH + h] = den;
        }
        if (isctx) { const float em = expf(-mrun); p.out[O_M + (size_t)(sid * 2 + dir) * MH + h] = mrun;
#pragma unroll
            for (int d = 0; d < MDK; ++d) p.out[O_N + ((size_t)(sid * 2 + dir) * MH + h) * MDK + d] = n[d] * em; }
    }
};
struct NMlstmNum {
    Params p; int dir; int pad_ = 0; static HD_FN long count() { return (long)NSEQ * MH * MDK; }
    HD_FN void operator()(long idx) const {
        const int v = (int)(idx % MDK), h = (int)((idx / MDK) % MH), sid = (int)(idx / (MDK * MH)); const bool isctx = sid < NCB;
        const int base = seq_base(sid), len = isctx ? CSEQ : LSEQ;
        float C[MDK];
        if (isctx) {
#pragma unroll
            for (int d = 0; d < MDK; ++d) C[d] = 0.f;
        } else { const int b = sid - NCB; const float em = expf(p.stm[(size_t)(b * 2 + dir) * MH + h]);
#pragma unroll
            for (int d = 0; d < MDK; ++d) C[d] = p.stC[(((size_t)(b * 2 + dir) * MH + h) * MDK + d) * MDK + v] * em; }
        const bf16_t* QK = (const bf16_t*)(p.ws + WS_QKVO); const float* G = (const float*)(p.ws + WS_GATES); const float* DEN = (const float*)(p.ws + WS_DEN);
        float* HS = (float*)(p.ws + WS_HS);
        for (int t = 0; t < len; ++t) {
            const int row = base + (dir == 0 ? t : len - 1 - t);
            const float ig = G[(size_t)row * NGATE + dir * 8 + h], lf = G[(size_t)row * NGATE + dir * 8 + 4 + h];
            const float f = expf(lf), ei = expf(ig);
            const bf16_t* q = QK + (size_t)row * 4 * MW + h * MDK; const bf16_t* k = q + MW; const float vv = bf2f(q[2 * MW + v]) * ei; float num = 0.f;
#pragma unroll
            for (int d = 0; d < MDK; ++d) { C[d] = f * C[d] + bf2f(k[d]) * vv; num += bf2f(q[d]) * C[d]; }
            const float den = DEN[((size_t)dir * MTOK + row) * MH + h]; const float hv = num / fmaxf(fabsf(den), 1.0f);
            float* o = HS + (size_t)row * MW + h * MDK + v; if (dir == 0) *o = hv; else *o += hv;
        }
        if (isctx) { const float em = expf(-p.out[O_M + (size_t)(sid * 2 + dir) * MH + h]);
#pragma unroll
            for (int d = 0; d < MDK; ++d) p.out[O_C + (((size_t)(sid * 2 + dir) * MH + h) * MDK + d) * MDK + v] = C[d] * em; }
    }
};
struct NHm {
    Params p; static HD_FN long count() { return (long)MTOK * MH; }
    HD_FN void operator()(long idx) const {
        const int row = (int)(idx / MH), h = (int)(idx % MH); const float* x = (const float*)(p.ws + WS_HS) + (size_t)row * MW + h * MDK; float s = 0.f;
        for (int v = 0; v < MDK; ++v) s += x[v] * x[v];
        const float rs = 1.0f / sqrtf(s / MDK + EPSF); const bf16_t* og = (const bf16_t*)(p.ws + WS_QKVO) + (size_t)row * 4 * MW + 3 * MW + h * MDK;
        bf16_t* UH = (bf16_t*)(p.ws + WS_UH) + (size_t)row * DM + CCH + h * MDK;
        for (int v = 0; v < MDK; ++v) UH[v] = f2bf(bf2f(og[v]) * x[v] * rs * p.mng[h * MDK + v]);
    }
};
struct NCacheCvt {
    Params p; static HD_FN long count() { return (long)NLB * PAST * NKV * HDIM; }
    HD_FN void operator()(long idx) const { const int e = (int)(idx % (NKV * HDIM)), pp = (int)((idx / (NKV * HDIM)) % PAST), b = (int)(idx / ((long)NKV * HDIM * PAST));
        const size_t dst = ((size_t)b * SKVL + LSEQ + pp) * NKV * HDIM + e;
        ((bf16_t*)(p.ws + WS_LATK))[dst] = f2bf(p.ck[idx]); ((bf16_t*)(p.ws + WS_LATV))[dst] = f2bf(p.cv[idx]); }
};
struct NQkPost {
    Params p; static HD_FN long count() { return (long)MTOK * (NQ + NKV); }
    HD_FN void operator()(long idx) const {
        const int row = (int)(idx / (NQ + NKV)), j = (int)(idx % (NQ + NKV)); const bool isq = j < NQ; const bool lat = row >= MC;
        bf16_t* src = isq ? (bf16_t*)(p.ws + WS_QRAW) + (size_t)row * NQ * HDIM + j * HDIM : (bf16_t*)(p.ws + WS_KRAW) + (size_t)row * NKV * HDIM + (j - NQ) * HDIM;
        const float* g = isq ? p.qng : p.kng; float s = 0.f;
        for (int d = 0; d < HDIM; ++d) { const float x = bf2f(src[d]); s += x * x; }
        const float rs = 1.0f / sqrtf(s / HDIM + EPSF);
        bf16_t* dst; float* fo = nullptr;
        if (isq) dst = src;
        else if (!lat) { dst = (bf16_t*)(p.ws + WS_CTXK) + (size_t)row * NKV * HDIM + (j - NQ) * HDIM; fo = p.out + O_K + (size_t)row * NKV * HDIM + (j - NQ) * HDIM; }
        else { const int b = (row - MC) / LSEQ, sp = (row - MC) % LSEQ; dst = (bf16_t*)(p.ws + WS_LATK) + ((size_t)b * SKVL + sp) * NKV * HDIM + (j - NQ) * HDIM; }
        const int sp = pos_of(row); const float prow = (float)(sp / GRIDW), pcol = (float)(sp % GRIDW);
        for (int half = 0; half < 2; ++half)
            for (int d = 0; d < HDIM / 4; ++d) {
                const int i1 = half * (HDIM / 2) + d, i2 = i1 + HDIM / 4;
                const float x1 = bf2f(src[i1]) * rs * g[i1], x2 = bf2f(src[i2]) * rs * g[i2]; float y1 = x1, y2 = x2;
                if (lat) { const float inv = powf(10000.0f, -(float)d / (float)(HDIM / 4)); const float ang = (half == 0 ? prow : pcol) * inv; const float cs = cosf(ang), sn = sinf(ang);
                    y1 = x1 * cs - x2 * sn; y2 = x1 * sn + x2 * cs; }
                dst[i1] = f2bf(y1); dst[i2] = f2bf(y2); if (fo) { fo[i1] = y1; fo[i2] = y2; }
            }
    }
};
struct NAttn {
    Params p; static HD_FN long count() { return (long)MTOK * NQ * 4; }
    HD_FN void operator()(long idx) const {
        const int sl = (int)(idx % 4), hq = (int)((idx / 4) % NQ), row = (int)(idx / (4 * NQ)); const int kv = hq / GRP;
        const bf16_t *Kb, *Vb; int nk;
        if (row < MC) { const int b = row / CSEQ; Kb = (const bf16_t*)(p.ws + WS_CTXK) + (size_t)b * CSEQ * NKV * HDIM; Vb = (const bf16_t*)(p.ws + WS_CTXV) + (size_t)b * CSEQ * NKV * HDIM; nk = CSEQ; }
        else { const int b = (row - MC) / LSEQ; Kb = (const bf16_t*)(p.ws + WS_LATK) + (size_t)b * SKVL * NKV * HDIM; Vb = (const bf16_t*)(p.ws + WS_LATV) + (size_t)b * SKVL * NKV * HDIM; nk = SKVL; }
        const bf16_t* qp = (const bf16_t*)(p.ws + WS_QRAW) + (size_t)row * NQ * HDIM + hq * HDIM;
        float q[HDIM];
#pragma unroll
        for (int d = 0; d < HDIM; ++d) q[d] = bf2f(qp[d]);
        float o[32];
#pragma unroll
        for (int e = 0; e < 32; ++e) o[e] = 0.f;
        float m = -1e30f, l = 0.f; const float scale = 1.0f / sqrtf((float)HDIM);
        for (int s = 0; s < nk; ++s) {
            const bf16_t* kp = Kb + (size_t)s * NKV * HDIM + kv * HDIM; float dot = 0.f;
#pragma unroll
            for (int d = 0; d < HDIM; ++d) dot += q[d] * bf2f(kp[d]);
            dot *= scale; const float mn = fmaxf(m, dot); const float al = expf(m - mn), pe = expf(dot - mn); m = mn; l = l * al + pe;
            const bf16_t* vp = Vb + (size_t)s * NKV * HDIM + kv * HDIM + sl * 32;
#pragma unroll
            for (int e = 0; e < 32; ++e) o[e] = o[e] * al + pe * bf2f(vp[e]);
        }
        bf16_t* op = (bf16_t*)(p.ws + WS_O) + (size_t)row * DM + hq * HDIM + sl * 32;
#pragma unroll
        for (int e = 0; e < 32; ++e) op[e] = f2bf(o[e] / l);
    }
};
struct NFinal {
    Params p; static HD_FN long count() { return (long)MTOK * DM; }
    HD_FN void operator()(long idx) const { const int row = (int)(idx / DM), col = (int)(idx % DM);
        const float rs = 1.0f / sqrtf(((const float*)(p.ws + WS_SSQ))[(size_t)3 * SSQ_STRIDE + row] / DM + EPSF); p.out[O_Y + idx] *= rs * p.fng[col]; }
};
constexpr int NWAVES = 8, NTHREADS = NWAVES * 64;
constexpr int RING_OFF = 0, RING_BYTES = 131072;
constexpr int LDSCTL_OFF = RING_BYTES, MISC_OFF = LDSCTL_OFF + 320;
constexpr int LDS_BYTES = 147456;
constexpr int CW_TMO = 0, CW_CODE = 1, CW_BAR = 4096;
__device__ __forceinline__ int tid_opaque() { int t = threadIdx.x; asm volatile("" : "+v"(t)); return t; }
template <int M> __device__ __forceinline__ float swz_xor(float v) { return __int_as_float(__builtin_amdgcn_ds_swizzle(__float_as_int(v), (M << 10) | 0x1f)); }
__device__ __forceinline__ float half_sum(float v) { auto rr = __builtin_amdgcn_permlane32_swap(__float_as_uint(v), __float_as_uint(v), false, false); return __uint_as_float(rr[0]) + __uint_as_float(rr[1]); }
__device__ __forceinline__ float half_max(float v) { auto rr = __builtin_amdgcn_permlane32_swap(__float_as_uint(v), __float_as_uint(v), false, false); return fmaxf(__uint_as_float(rr[0]), __uint_as_float(rr[1])); }
__device__ __forceinline__ float lane_get(float v, int src_lane) { return __int_as_float(__builtin_amdgcn_ds_bpermute(src_lane << 2, __float_as_int(v))); }
#define GAS __attribute__((address_space(1)))
#define LAS __attribute__((address_space(3)))
typedef GAS unsigned gu32;
#define RLX_AGENT __ATOMIC_RELAXED, __HIP_MEMORY_SCOPE_AGENT
#define XB_TMO      128
#define XB_XCNT(j)  (256  + 64 * (j))
#define XB_XSUB(j)  (1280 + 64 * (j))
#define XB_XGEN(j)  (2304 + 64 * (j))
#define XB_TOP      3328
#define XB_TOPGEN   3392
#define XCD_BAR_WORDS 3456
#define XB_SPIN_CAP (1u << 22)
__device__ __forceinline__ unsigned xb_ld(unsigned* p)              { return __hip_atomic_load(p, __ATOMIC_RELAXED, __HIP_MEMORY_SCOPE_AGENT); }
__device__ __forceinline__ unsigned xb_add(unsigned* p, unsigned v) { return __hip_atomic_fetch_add(p, v, __ATOMIC_RELAXED, __HIP_MEMORY_SCOPE_AGENT); }
__device__ __forceinline__ unsigned xb_xcc_id() { return (unsigned)__builtin_amdgcn_s_getreg((3 << 11) | 20) & 0xFu; }
#define XB_SPIN(cond, bar) do { unsigned _sp = 0; while (cond) { __builtin_amdgcn_s_sleep(1); \
    if ((++_sp & 255u) == 0u) { if (xb_ld(&(bar)[XB_TMO])) break; if (_sp > XB_SPIN_CAP) { atomicAdd(&(bar)[XB_TMO], 1u); break; } } } } while (0)
struct XcdBarrier { unsigned* bar; unsigned x; volatile LAS unsigned* st; };
__device__ __forceinline__ XcdBarrier xcd_barrier_post(unsigned* bar, volatile LAS unsigned* st) {
    XcdBarrier b; b.bar = bar; b.x = xb_xcc_id(); b.st = st;
    if (threadIdx.x == 0) (void)xb_add(&bar[XB_XCNT(b.x)], 1u);
    return b;
}
__device__ __forceinline__ void xcd_barrier_complete(unsigned* bar, unsigned x, unsigned& nloc, unsigned& nx) {
    const unsigned G = gridDim.x * gridDim.y * gridDim.z;
    unsigned sum, cnt, mine, sp = 0u;
    for (;;) {
        sum = 0u; cnt = 0u; mine = 0u;
#pragma unroll
        for (unsigned j = 0; j < 16; ++j) { const unsigned c = xb_ld(&bar[XB_XCNT(j)]); sum += c; cnt += (c > 0u) ? 1u : 0u; mine = (j == x) ? c : mine; }
        if (sum == G) break;
        __builtin_amdgcn_s_sleep(1);
        if ((++sp & 255u) == 0u) { if (xb_ld(&bar[XB_TMO])) break; if (sp > XB_SPIN_CAP) { atomicAdd(&bar[XB_TMO], 1u); break; } }
    }
    nloc = mine > 0u ? mine : 1u; nx = cnt > 0u ? cnt : 1u;
}
__device__ __forceinline__ void xcd_barrier(const XcdBarrier& b) {
    asm volatile("s_waitcnt vmcnt(0)" ::: "memory");
    __syncthreads();
    if (threadIdx.x == 0) {
        unsigned* bar = b.bar;
        __builtin_amdgcn_s_waitcnt(0);
        unsigned nloc = b.st[0], nx = b.st[1];
        if (nloc == 0u) { xcd_barrier_complete(bar, b.x, nloc, nx); b.st[0] = nloc; b.st[1] = nx; }
        const unsigned old = xb_add(&bar[XB_XSUB(b.x)], 1u);
        const unsigned gen = old / nloc;
        if (old + 1u == (gen + 1u) * nloc) {
            __builtin_amdgcn_fence(__ATOMIC_RELEASE, "agent");
            asm volatile("s_waitcnt vmcnt(0)" ::: "memory");
            const unsigned og = xb_add(&bar[XB_TOP], 1u);
            const unsigned tg = og / nx;
            if (og + 1u == (tg + 1u) * nx) xb_add(&bar[XB_TOPGEN], 1u);
            else XB_SPIN(xb_ld(&bar[XB_TOPGEN]) == tg, bar);
            __builtin_amdgcn_fence(__ATOMIC_ACQUIRE, "agent");
            xb_add(&bar[XB_XGEN(b.x)], 1u);
            asm volatile("s_waitcnt vmcnt(0)" ::: "memory");
        } else {
            XB_SPIN(xb_ld(&bar[XB_XGEN(b.x)]) == gen, bar);
            __builtin_amdgcn_fence(__ATOMIC_ACQUIRE, "agent");
            asm volatile("s_waitcnt vmcnt(0)" ::: "memory");
        }
    }
    __syncthreads();
}
namespace pg8 {
#define PG8_LAS __attribute__((address_space(3)))
typedef unsigned short bf16_t;
typedef short bf16x8 __attribute__((ext_vector_type(8)));
typedef float f32x4 __attribute__((ext_vector_type(4)));
typedef unsigned u32x4 __attribute__((ext_vector_type(4)));
constexpr int BM = 256, BK = 64, HALF = 128, HTB = HALF * BK * 2  , STAGE_BYTES = 8 * HTB, NXCD = 8, WGM = 8;

__host__ __device__ __forceinline__ int lds_byte(int r, int c) { const int st = (r >> 4) * 2 + (c >> 5), rr = r & 15, cc = c & 31, ob = rr * 64 + cc * 2; return st * 1024 + (ob ^ (((ob >> 9) & 1) << 5)); }
__host__ __device__ __forceinline__ void stage_rc(int b, int& R, int& C) { const int st = b / 1024, sb = b % 1024, swz = sb ^ (((sb >> 9) & 1) << 5); R = (st >> 1) * 16 + swz / 64; C = (st & 1) * 32 + (swz % 64) / 2; }
__host__ __device__ __forceinline__ int perm32(int rho) { const int n = rho >> 4, i = rho & 15; return 8 * (i >> 2) + 4 * n + (i & 3); }

struct Unit { int pm, pn, k0, nt, role, slot; };
struct Gemm { const bf16_t* A; const bf16_t* Bt; int M, N, K; };

struct StaticOrder {
    int nM, nN, nwg, G, c, ntK;
    __host__ __device__ void init(int M, int N, int K, int G_, int c_) { nM = M / BM; nN = N / BM; nwg = nM * nN; G = G_; c = c_; ntK = K / BK; }
    __host__ __device__ void map(int L, Unit& u) const { int wgid = L; { const int q = nwg / NXCD, r = nwg % NXCD, xcd = wgid % NXCD, off = wgid / NXCD; wgid = (xcd < r ? xcd * (q + 1) : r * (q + 1) + (xcd - r) * q) + off; }
        const int nig = WGM * nN, gid = wgid / nig, fm = gid * WGM, gsz = (nM - fm) < WGM ? (nM - fm) : WGM; u.pm = fm + ((wgid % nig) % gsz); u.pn = (wgid % nig) / gsz; }
    __host__ __device__ bool next(int i, Unit& u) const {
        const long L = (long)i * G + c; if (L >= nwg) return false;
        int wgid = (int)L; { const int q = nwg / NXCD, r = nwg % NXCD, xcd = wgid % NXCD, off = wgid / NXCD; wgid = (xcd < r ? xcd * (q + 1) : r * (q + 1) + (xcd - r) * q) + off; }
        const int nig = WGM * nN, gid = wgid / nig, fm = gid * WGM, gsz = (nM - fm) < WGM ? (nM - fm) : WGM;
        u.pm = fm + ((wgid % nig) % gsz); u.pn = (wgid % nig) / gsz; u.k0 = 0; u.nt = ntK; u.role = 0; u.slot = 0; return true;
    }
    __device__ __forceinline__ void a_ready(const Unit&) const {}
    __device__ __forceinline__ void done(const Unit&) const {}
};

__device__ __forceinline__ unsigned cvt_pk_bf16(float lo, float hi) { unsigned r; asm volatile("v_cvt_pk_bf16_f32 %0, %1, %2" : "=v"(r) : "v"(lo), "v"(hi)); return r; }
typedef float f32x2 __attribute__((ext_vector_type(2)));
template <class Epi, class Sched, bool ALIGN_EPI = false, bool SP2 = false>
__device__ __forceinline__ void gemm_phase(PG8_LAS unsigned char* lds, const Gemm g, const Sched& S, const Epi& E) {
    const int tid = tid_opaque(), wid = __builtin_amdgcn_readfirstlane(tid >> 6), lane = tid & 63, wr = wid >> 2, wc = wid & 3, fr = lane & 15, fq = lane >> 4;
    const int K = g.K;
    unsigned voffA[2], voffB[2];
#pragma unroll
    for (int i = 0; i < 2; ++i) { int R, C; stage_rc(tid * 16 + i * 8192, R, C); const int Rb = Epi::PERM ? ((R & ~31) + perm32(R & 31)) : R;
        voffA[i] = (unsigned)(R * K + C) * 2u; voffB[i] = (unsigned)(Rb * K + C) * 2u; }
    const size_t kstep = (size_t)(BK * 2);
    const size_t hstep = (size_t)HALF * K * 2;
    const size_t tstep = 2 * hstep;
    const unsigned ldsw = (unsigned)wid * 1024u;
    const int aoff = lds_byte(wr * 64 + fr, fq * 8), boff = lds_byte(wc * 32 + fr, fq * 8);
#define PG8_SA(b, h) (((b) * 2 + (h)) * HTB)
#define PG8_SB(b, h) ((4 + (b) * 2 + (h)) * HTB)
#define PG8_STAGE(bufoff, gbase, voff) do { _Pragma("unroll") for (int _i = 0; _i < 2; ++_i) \
        __builtin_amdgcn_global_load_lds((const unsigned*)((const char*)(gbase) + (voff)[_i]), (PG8_LAS unsigned*)(lds + (bufoff) + ldsw + _i * 8192), 16, 0, 0); } while (0)
#define PG8_LDA(dst, b, h) do { _Pragma("unroll") for (int m = 0; m < 4; ++m) _Pragma("unroll") for (int k = 0; k < 2; ++k) dst[m][k] = *(const PG8_LAS bf16x8*)(lds + PG8_SA(b, h) + aoff + m * 2048 + k * 1024); } while (0)
#define PG8_LDB(dst, b, h) do { _Pragma("unroll") for (int n = 0; n < 2; ++n) _Pragma("unroll") for (int k = 0; k < 2; ++k) dst[n][k] = *(const PG8_LAS bf16x8*)(lds + PG8_SB(b, h) + boff + n * 2048 + k * 1024); } while (0)
#define PG8_MMA(ai, bj, At, Bt) do { __builtin_amdgcn_s_setprio(1); _Pragma("unroll") for (int m = 0; m < 4; ++m) _Pragma("unroll") for (int n = 0; n < 2; ++n) _Pragma("unroll") for (int k = 0; k < 2; ++k) \
        acc[ai][bj][m][n] = __builtin_amdgcn_mfma_f32_16x16x32_bf16(Bt[n][k], At[m][k], acc[ai][bj][m][n], 0, 0, 0); __builtin_amdgcn_s_setprio(0); } while (0)
#define PG8_WAIT_V(n) asm volatile("s_waitcnt vmcnt(" #n ")" ::: "memory")
#define PG8_WAIT_L(n) asm volatile("s_waitcnt lgkmcnt(" #n ")" ::: "memory")
#define PG8_BAR __builtin_amdgcn_s_barrier()
#define PG8_SCHED __builtin_amdgcn_sched_barrier(0)
    Unit cur, nxt; int ui = 0;
    if (!S.next(0, cur)) return;
    f32x4 acc[2][2][4][2];
#pragma unroll
    for (int a = 0; a < 2; ++a)
#pragma unroll
        for (int b = 0; b < 2; ++b)
#pragma unroll
            for (int m = 0; m < 4; ++m)
#pragma unroll
                for (int n = 0; n < 2; ++n) acc[a][b][m][n] = (f32x4){0.f, 0.f, 0.f, 0.f};
    bf16x8 At[4][2], B0[2][2], B1[2][2];
    const char* cA = (const char*)g.A + (size_t)cur.pm * tstep + (size_t)cur.k0 * kstep; const char* cB = (const char*)g.Bt + (size_t)cur.pn * tstep + (size_t)cur.k0 * kstep; int nt = cur.nt;
    S.a_ready(cur);
    if constexpr (SP2) {
        PG8_STAGE(PG8_SB(0, 0), cB, voffB); PG8_STAGE(PG8_SB(0, 1), cB + hstep, voffB); PG8_STAGE(PG8_SA(0, 0), cA, voffA); PG8_STAGE(PG8_SA(0, 1), cA + hstep, voffA);
        if (wr == 1) PG8_BAR;
        PG8_WAIT_V(2); PG8_BAR;
        PG8_STAGE(PG8_SB(1, 0), cB + kstep, voffB); PG8_STAGE(PG8_SA(1, 0), cA + kstep, voffA); PG8_STAGE(PG8_SB(1, 1), cB + hstep + kstep, voffB);
        PG8_WAIT_V(6); PG8_BAR;
    } else {
        PG8_STAGE(PG8_SB(0, 0), cB, voffB); PG8_STAGE(PG8_SA(0, 0), cA, voffA); PG8_STAGE(PG8_SB(0, 1), cB + hstep, voffB); PG8_STAGE(PG8_SA(0, 1), cA + hstep, voffA);
        if (wr == 1) PG8_BAR;
        PG8_WAIT_V(4); PG8_BAR;
        PG8_STAGE(PG8_SB(1, 0), cB + kstep, voffB); PG8_STAGE(PG8_SA(1, 0), cA + kstep, voffA); PG8_STAGE(PG8_SB(1, 1), cB + hstep + kstep, voffB);
        PG8_WAIT_V(6); PG8_BAR;
    }
    for (;;) {
        const bool has_next = S.next(ui + 1, nxt);
        const char* nA = has_next ? (const char*)g.A + (size_t)nxt.pm * tstep + (size_t)nxt.k0 * kstep : cA; const char* nB = has_next ? (const char*)g.Bt + (size_t)nxt.pn * tstep + (size_t)nxt.k0 * kstep : cB;
        for (int t = 0; t < nt; t += 2) {
            const bool last = (t == nt - 2);
            const char* a1 = cA + (size_t)(t + 1) * kstep;
            const char* a2 = last ? nA : cA + (size_t)(t + 2) * kstep; const char* b2 = last ? nB : cB + (size_t)(t + 2) * kstep;
            const char* a3 = a2 + kstep; const char* b3 = b2 + kstep;
            if (last && has_next) S.a_ready(nxt);
            if constexpr (SP2) {
            PG8_LDB(B0, 0, 0); PG8_LDB(B1, 0, 1); PG8_SCHED; PG8_LDA(At, 0, 0); PG8_STAGE(PG8_SA(1, 1), a1 + hstep, voffA);
            PG8_WAIT_V(8); PG8_WAIT_L(0); PG8_BAR; PG8_MMA(0, 0, At, B0); PG8_MMA(0, 1, At, B1); PG8_BAR; PG8_SCHED;
            PG8_LDA(At, 0, 1); PG8_STAGE(PG8_SB(0, 0), b2, voffB); PG8_STAGE(PG8_SB(0, 1), b2 + hstep, voffB); PG8_STAGE(PG8_SA(0, 0), a2, voffA);
            PG8_WAIT_V(8); PG8_WAIT_L(0); PG8_BAR; PG8_MMA(1, 0, At, B0); PG8_MMA(1, 1, At, B1); PG8_BAR; PG8_SCHED;
            PG8_LDB(B0, 1, 0); PG8_LDB(B1, 1, 1); PG8_SCHED; PG8_LDA(At, 1, 0); PG8_STAGE(PG8_SA(0, 1), a2 + hstep, voffA);
            PG8_WAIT_V(8); PG8_WAIT_L(0); PG8_BAR; PG8_MMA(0, 0, At, B0); PG8_MMA(0, 1, At, B1); PG8_BAR; PG8_SCHED;
            PG8_LDA(At, 1, 1); PG8_STAGE(PG8_SB(1, 0), b3, voffB); PG8_STAGE(PG8_SB(1, 1), b3 + hstep, voffB); PG8_STAGE(PG8_SA(1, 0), a3, voffA);
            PG8_WAIT_V(8); PG8_WAIT_L(0); PG8_BAR; PG8_MMA(1, 0, At, B0); PG8_MMA(1, 1, At, B1); PG8_BAR; PG8_SCHED;
            } else {
            PG8_LDB(B0, 0, 0); PG8_SCHED; PG8_LDA(At, 0, 0); PG8_STAGE(PG8_SA(1, 1), a1 + hstep, voffA);
            PG8_WAIT_L(8); PG8_BAR; PG8_WAIT_L(0); PG8_MMA(0, 0, At, B0); PG8_BAR; PG8_SCHED;
            PG8_LDB(B1, 0, 1); PG8_STAGE(PG8_SB(0, 0), b2, voffB);
            PG8_BAR; PG8_WAIT_L(0); PG8_MMA(0, 1, At, B1); PG8_BAR;
            PG8_LDA(At, 0, 1); PG8_STAGE(PG8_SA(0, 0), a2, voffA);
            PG8_BAR; PG8_WAIT_L(0); PG8_MMA(1, 0, At, B0); PG8_BAR; PG8_SCHED;
            PG8_STAGE(PG8_SB(0, 1), b2 + hstep, voffB);
            PG8_WAIT_V(6); PG8_BAR; PG8_MMA(1, 1, At, B1); PG8_BAR;
            PG8_LDB(B0, 1, 0); PG8_SCHED; PG8_LDA(At, 1, 0); PG8_STAGE(PG8_SA(0, 1), a2 + hstep, voffA);
            PG8_WAIT_L(8); PG8_BAR; PG8_WAIT_L(0); PG8_MMA(0, 0, At, B0); PG8_BAR; PG8_SCHED;
            PG8_LDB(B1, 1, 1); PG8_STAGE(PG8_SB(1, 0), b3, voffB);
            PG8_BAR; PG8_WAIT_L(0); PG8_MMA(0, 1, At, B1); PG8_BAR;
            PG8_LDA(At, 1, 1); PG8_STAGE(PG8_SA(1, 0), a3, voffA);
            PG8_BAR; PG8_WAIT_L(0); PG8_MMA(1, 0, At, B0); PG8_BAR; PG8_SCHED;
            PG8_STAGE(PG8_SB(1, 1), b3 + hstep, voffB);
            PG8_WAIT_V(6); PG8_BAR; PG8_MMA(1, 1, At, B1); PG8_BAR;
            }
        }
        if constexpr (ALIGN_EPI) { if (wr == 0) PG8_BAR; }
        if constexpr (!Epi::AFTER_DRAIN) { E(acc, cur, wr, wc, fr, fq); S.done(cur); }
        if (!has_next) break;
#pragma unroll
        for (int a = 0; a < 2; ++a)
#pragma unroll
            for (int b = 0; b < 2; ++b)
#pragma unroll
                for (int m = 0; m < 4; ++m)
#pragma unroll
                    for (int n = 0; n < 2; ++n) acc[a][b][m][n] = (f32x4){0.f, 0.f, 0.f, 0.f};
        cur = nxt; cA = nA; cB = nB; nt = cur.nt; ++ui;
        if constexpr (ALIGN_EPI) { if (wr == 1) PG8_BAR; }
    }
    PG8_WAIT_V(0);
    if constexpr (!ALIGN_EPI) { if (wr == 0) PG8_BAR; }
    PG8_BAR;
    if constexpr (Epi::AFTER_DRAIN) { E.fused(acc, cur, wr, wc, fr, fq, lds, wid, lane); S.done(cur); }
#undef PG8_SA
#undef PG8_SB
#undef PG8_STAGE
#undef PG8_LDA
#undef PG8_LDB
#undef PG8_MMA
#undef PG8_WAIT_V
#undef PG8_WAIT_L
#undef PG8_BAR
#undef PG8_SCHED
}
}
constexpr size_t WB_AB = 2 * MiB, WB_OUTAB = 8 * MiB, WB_FFI0 = 10 * MiB, WB_FFO0 = 21 * MiB, WB_INC = 27 * MiB, WB_OUTC = 30 * MiB, WB_FFI1 = 32 * MiB, WB_FFO1 = 43 * MiB;
static_assert(WB_FFO1 + (size_t)DM * DFF * 2 <= WS_XN && WB_AB + (size_t)ABMAIN * DM * 2 <= WB_OUTAB && WB_FFI0 + (size_t)2 * DFF * DM * 2 <= WB_FFO0 && WB_FFO0 + (size_t)DM * DFF * 2 <= WB_INC &&
              WB_INC + (size_t)CIN * DM * 2 <= WB_OUTC && WB_FFI1 + (size_t)2 * DFF * DM * 2 <= WB_FFO1, "weight copy map");

typedef unsigned v4u __attribute__((ext_vector_type(4)));
typedef unsigned v2u __attribute__((ext_vector_type(2)));
typedef float f32x4 __attribute__((ext_vector_type(4)));
__device__ __forceinline__ unsigned pk2(float lo, float hi) { return (unsigned)f2bf(lo) | ((unsigned)f2bf(hi) << 16); }
__device__ __forceinline__ float fsigmoid(float x) { return __builtin_amdgcn_rcpf(1.0f + __builtin_amdgcn_exp2f(-1.4426950408889634f * x)); }

__device__ __forceinline__ void p0_transpose_item(const float* W, int K, int ldw, int c0, int k0, bf16_t* WT, int drow, LAS float* scr, int lane) {
    { f32x4 tv[8]; const int rr = lane >> 3, cg = (lane & 7) * 4;
#pragma unroll
      for (int i = 0; i < 8; ++i) tv[i] = *(const f32x4*)(W + (size_t)(k0 + 8 * i + rr) * ldw + c0 + cg);
#pragma unroll
      for (int i = 0; i < 8; ++i) { LAS float* d = scr + (8 * i + rr) * 33 + cg; d[0] = tv[i][0]; d[1] = tv[i][1]; d[2] = tv[i][2]; d[3] = tv[i][3]; } }
    asm volatile("s_waitcnt lgkmcnt(0)" ::: "memory");
    const int c = lane & 7;
#pragma unroll
    for (int j = 0; j < 4; ++j) { const int n = (lane >> 3) + 8 * j; const LAS float* s = scr + (8 * c) * 33 + n;
        v4u o; o.x = pk2(s[0 * 33], s[1 * 33]); o.y = pk2(s[2 * 33], s[3 * 33]); o.z = pk2(s[4 * 33], s[5 * 33]); o.w = pk2(s[6 * 33], s[7 * 33]);
        *(GAS v4u*)(WT + (size_t)(drow + n) * K + k0 + 8 * c) = o; }
    asm volatile("s_waitcnt lgkmcnt(0)" ::: "memory");
}
struct CvtJob { const float* W; bf16_t* WT; int K, ldw, c0, ncols, mode, Hn, dbase; };
__device__ __forceinline__ int cvt_items(const CvtJob& j) { return (j.K / 64) * (j.ncols / 32); }
__device__ __forceinline__ void cvt_run(const CvtJob& j, int item, LAS float* scr, int lane) {
    const int nblk = j.ncols / 32, kb = item / nblk, nb = item % nblk; const int c = j.c0 + 32 * nb;
    int drow; if (j.mode == 0) drow = j.dbase + 32 * nb; else { const int cc = c < j.Hn ? c : c - j.Hn; drow = 256 * (cc / 128) + (cc % 128) + (c < j.Hn ? 0 : 128); }
    p0_transpose_item(j.W, j.K, j.ldw, c, 64 * kb, j.WT, drow, scr, lane);
}
__device__ __forceinline__ void p0_weights(const Params& p, LAS unsigned char* lds, int vcu, int G) {
    const int tid_ = tid_opaque(); const int lane = tid_ & 63, wave = __builtin_amdgcn_readfirstlane(tid_ >> 6);
    LAS float* scr = (LAS float*)(lds + wave * 16384);
    const int gw = vcu * NWAVES + wave, NGW = G * NWAVES;
    CvtJob jobs[9] = {
        {p.winab, (bf16_t*)(p.ws + WB_AB), DM, ABIN, 0, 2 * CCH, 1, CCH, 0},
        {p.winab, (bf16_t*)(p.ws + WB_AB), DM, ABIN, 2 * CCH, 4 * MW, 0, 0, 2 * CCH},
        {p.woutab, (bf16_t*)(p.ws + WB_OUTAB), DM, DM, 0, DM, 0, 0, 0},
        {p.wffi, (bf16_t*)(p.ws + WB_FFI0), DM, 2 * DFF, 0, 2 * DFF, 1, DFF, 0},
        {p.wffo, (bf16_t*)(p.ws + WB_FFO0), DFF, DM, 0, DM, 0, 0, 0},
        {p.winc, (bf16_t*)(p.ws + WB_INC), DM, CIN, 0, CIN, 0, 0, 0},
        {p.woutc, (bf16_t*)(p.ws + WB_OUTC), DM, DM, 0, DM, 0, 0, 0},
        {p.wffi + (size_t)DM * 2 * DFF, (bf16_t*)(p.ws + WB_FFI1), DM, 2 * DFF, 0, 2 * DFF, 1, DFF, 0},
        {p.wffo + (size_t)DFF * DM, (bf16_t*)(p.ws + WB_FFO1), DFF, DM, 0, DM, 0, 0, 0}};
    int base = 0;
#pragma unroll
    for (int jj = 0; jj < 9; ++jj) {
        const int n = cvt_items(jobs[jj]);
        int first = ((gw - base) % NGW + NGW) % NGW;
        for (int it = first; it < n; it += NGW) cvt_run(jobs[jj], it, scr, lane);
        base += n;
    }
}

struct EpiAB {
    static constexpr bool PERM = true, AFTER_DRAIN = false;
    bf16_t* upre; bf16_t* qkvo;
    __device__ __forceinline__ void operator()(const f32x4 (&acc)[2][2][4][2], const pg8::Unit& u, int wr, int wc, int fr, int fq) const {
        const int row0 = u.pm * 256 + wr * 64 + fr, lc = wc * 32 + 8 * fq;
        if (u.pn < 4) {
#pragma unroll
            for (int ai = 0; ai < 2; ++ai)
#pragma unroll
                for (int m = 0; m < 4; ++m) { const f32x4 a0 = acc[ai][0][m][0], a1 = acc[ai][0][m][1], g0 = acc[ai][1][m][0], g1 = acc[ai][1][m][1]; v4u w;
                    w.x = pg8::cvt_pk_bf16(a0[0] * fsigmoid(g0[0]), a0[1] * fsigmoid(g0[1])); w.y = pg8::cvt_pk_bf16(a0[2] * fsigmoid(g0[2]), a0[3] * fsigmoid(g0[3]));
                    w.z = pg8::cvt_pk_bf16(a1[0] * fsigmoid(g1[0]), a1[1] * fsigmoid(g1[1])); w.w = pg8::cvt_pk_bf16(a1[2] * fsigmoid(g1[2]), a1[3] * fsigmoid(g1[3]));
                    *(v4u*)(upre + (size_t)(row0 + ai * 128 + m * 16) * CCH + 128 * u.pn + lc) = w; }
        } else {
#pragma unroll
            for (int bj = 0; bj < 2; ++bj) { const int col = 256 * (u.pn - 4) + 128 * bj + lc; const int part = col / MW; const float sc = part == 1 ? 0.08838834764831845f : 1.0f;
#pragma unroll
                for (int ai = 0; ai < 2; ++ai)
#pragma unroll
                    for (int m = 0; m < 4; ++m) { f32x4 v0 = acc[ai][bj][m][0] * sc, v1 = acc[ai][bj][m][1] * sc;
                        if (part == 3) { v0 = (f32x4){fsigmoid(v0[0]), fsigmoid(v0[1]), fsigmoid(v0[2]), fsigmoid(v0[3])}; v1 = (f32x4){fsigmoid(v1[0]), fsigmoid(v1[1]), fsigmoid(v1[2]), fsigmoid(v1[3])}; }
                        v4u w; w.x = pg8::cvt_pk_bf16(v0[0], v0[1]); w.y = pg8::cvt_pk_bf16(v0[2], v0[3]); w.z = pg8::cvt_pk_bf16(v1[0], v1[1]); w.w = pg8::cvt_pk_bf16(v1[2], v1[3]);
                        *(v4u*)(qkvo + (size_t)(row0 + ai * 128 + m * 16) * (4 * MW) + col) = w; } }
        }
    }
};
static_assert(MDK == 128, "EpiAB hard-codes MDK^-0.5");
struct EpiRes {
    static constexpr bool PERM = true, AFTER_DRAIN = false;
    const float* xp; const float* xs;
    bf16_t* Y16; bf16_t* XN; float* ssq; const float* mod_g; const float* mod_sc; const float* ng;
    int from_input; int pad_;
    __device__ __forceinline__ float piece(int row, int col, int cls, f32x4 v0, f32x4 v1) const {
        const float* gv = mod_g + (size_t)cls * 6 * DM + col; const size_t off = (size_t)row * DM + col; f32x4 x0, x1;
        if (from_input) { const float* xin = (row < MC ? xp : xs - (size_t)MC * DM) + off; x0 = *(const f32x4*)xin; x1 = *(const f32x4*)(xin + 4); }
        else { const v4u r = *(const v4u*)(Y16 + off); x0 = (f32x4){__uint_as_float(r.x << 16), __uint_as_float(r.x & 0xffff0000u), __uint_as_float(r.y << 16), __uint_as_float(r.y & 0xffff0000u)};
            x1 = (f32x4){__uint_as_float(r.z << 16), __uint_as_float(r.z & 0xffff0000u), __uint_as_float(r.w << 16), __uint_as_float(r.w & 0xffff0000u)}; }
        x0 += *(const f32x4*)gv * v0; x1 += *(const f32x4*)(gv + 4) * v1;
        v4u w; w.x = pg8::cvt_pk_bf16(x0[0], x0[1]); w.y = pg8::cvt_pk_bf16(x0[2], x0[3]); w.z = pg8::cvt_pk_bf16(x1[0], x1[1]); w.w = pg8::cvt_pk_bf16(x1[2], x1[3]); *(v4u*)(Y16 + off) = w;
        if (ng) { const float* scv = mod_sc + (size_t)cls * 6 * DM + col; const f32x4 t0 = x0 * (*(const f32x4*)(ng + col) * (*(const f32x4*)scv + 1.0f)), t1 = x1 * (*(const f32x4*)(ng + col + 4) * (*(const f32x4*)(scv + 4) + 1.0f));
            v4u q; q.x = pg8::cvt_pk_bf16(t0[0], t0[1]); q.y = pg8::cvt_pk_bf16(t0[2], t0[3]); q.z = pg8::cvt_pk_bf16(t1[0], t1[1]); q.w = pg8::cvt_pk_bf16(t1[2], t1[3]); *(v4u*)(XN + off) = q; }
        return ((x0[0] * x0[0] + x0[1] * x0[1]) + (x0[2] * x0[2] + x0[3] * x0[3])) + ((x1[0] * x1[0] + x1[1] * x1[1]) + (x1[2] * x1[2] + x1[3] * x1[3]));
    }
    __device__ __forceinline__ void operator()(const f32x4 (&acc)[2][2][4][2], const pg8::Unit& u, int wr, int wc, int fr, int fq) const {
        const int row0 = u.pm * 256 + wr * 64 + fr; const int cls = cls_of(u.pm * 256); const int colb = u.pn * 256 + wc * 32 + 8 * fq;
        f32x4 g4[2][2], gs4[2][2];
#pragma unroll
        for (int bj = 0; bj < 2; ++bj)
#pragma unroll
            for (int n = 0; n < 2; ++n) { const int col = colb + bj * 128 + 4 * n; g4[bj][n] = *(const f32x4*)(mod_g + (size_t)cls * 6 * DM + col);
                gs4[bj][n] = ng ? *(const f32x4*)(ng + col) * (*(const f32x4*)(mod_sc + (size_t)cls * 6 * DM + col) + 1.0f) : (f32x4){0.f, 0.f, 0.f, 0.f}; }
        if (from_input) run_rows<2>(acc, row0, colb, g4, gs4); else run_rows<4>(acc, row0, colb, g4, gs4);
    }
    template <int MB> __device__ __forceinline__ void run_rows(const f32x4 (&acc)[2][2][4][2], int row0, int colb, const f32x4 (&g4)[2][2], const f32x4 (&gs4)[2][2]) const {
#pragma unroll
        for (int ai = 0; ai < 2; ++ai)
#pragma unroll
            for (int mb = 0; mb < 4; mb += MB) {
                f32x4 x[MB][2][2];
                if (from_input) {
#pragma unroll
                    for (int mm = 0; mm < MB; ++mm)
#pragma unroll
                        for (int bj = 0; bj < 2; ++bj) { const int row = row0 + ai * 128 + (mb + mm) * 16; const float* xin = (row < MC ? xp : xs - (size_t)MC * DM) + (size_t)row * DM + colb + bj * 128; x[mm][bj][0] = *(const f32x4*)xin; x[mm][bj][1] = *(const f32x4*)(xin + 4); }
                } else { v4u r[MB][2];
#pragma unroll
                    for (int mm = 0; mm < MB; ++mm)
#pragma unroll
                        for (int bj = 0; bj < 2; ++bj) r[mm][bj] = *(const v4u*)(Y16 + (size_t)(row0 + ai * 128 + (mb + mm) * 16) * DM + colb + bj * 128);
#pragma unroll
                    for (int mm = 0; mm < MB; ++mm)
#pragma unroll
                        for (int bj = 0; bj < 2; ++bj) { const v4u q = r[mm][bj]; x[mm][bj][0] = (f32x4){__uint_as_float(q.x << 16), __uint_as_float(q.x & 0xffff0000u), __uint_as_float(q.y << 16), __uint_as_float(q.y & 0xffff0000u)};
                            x[mm][bj][1] = (f32x4){__uint_as_float(q.z << 16), __uint_as_float(q.z & 0xffff0000u), __uint_as_float(q.w << 16), __uint_as_float(q.w & 0xffff0000u)}; }
                }
#pragma unroll
                for (int mm = 0; mm < MB; ++mm) { const int m = mb + mm; const int row = row0 + ai * 128 + m * 16; float s = 0.f;
#pragma unroll
                    for (int bj = 0; bj < 2; ++bj) { const size_t off = (size_t)row * DM + colb + bj * 128;
                        const f32x4 x0 = x[mm][bj][0] + g4[bj][0] * acc[ai][bj][m][0], x1 = x[mm][bj][1] + g4[bj][1] * acc[ai][bj][m][1];
                        v4u w; w.x = pg8::cvt_pk_bf16(x0[0], x0[1]); w.y = pg8::cvt_pk_bf16(x0[2], x0[3]); w.z = pg8::cvt_pk_bf16(x1[0], x1[1]); w.w = pg8::cvt_pk_bf16(x1[2], x1[3]); *(v4u*)(Y16 + off) = w;
                        if (ng) { const f32x4 t0 = x0 * gs4[bj][0], t1 = x1 * gs4[bj][1]; v4u q; q.x = pg8::cvt_pk_bf16(t0[0], t0[1]); q.y = pg8::cvt_pk_bf16(t0[2], t0[3]); q.z = pg8::cvt_pk_bf16(t1[0], t1[1]); q.w = pg8::cvt_pk_bf16(t1[2], t1[3]); *(v4u*)(XN + off) = q; }
                        s += ((x0[0] * x0[0] + x0[1] * x0[1]) + (x0[2] * x0[2] + x0[3] * x0[3])) + ((x1[0] * x1[0] + x1[1] * x1[1]) + (x1[2] * x1[2] + x1[3] * x1[3])); }
                    s += __shfl_xor(s, 16); s += __shfl_xor(s, 32); if (fq_() == 0) atomicAdd(ssq + row, s); }
                asm volatile("" ::: "memory");
            }
    }
    __device__ __forceinline__ static int fq_() { return (threadIdx.x >> 4) & 3; }
};
struct EpiFfnIn {
    static constexpr bool PERM = true, AFTER_DRAIN = false;
    bf16_t* H; const float* ssq; const float* sw;
    __device__ __forceinline__ void operator()(const f32x4 (&acc)[2][2][4][2], const pg8::Unit& u, int wr, int wc, int fr, int fq) const {
        const int row0 = u.pm * 256 + wr * 64 + fr, lc = wc * 32 + 8 * fq; const int cls = cls_of(u.pm * 256); const int col = 128 * u.pn + lc;
        const float* swr = sw + (size_t)cls * 2 * DFF;
        const f32x4 sg0 = *(const f32x4*)(swr + col), sg1 = *(const f32x4*)(swr + col + 4), su0 = *(const f32x4*)(swr + DFF + col), su1 = *(const f32x4*)(swr + DFF + col + 4);
#pragma unroll
        for (int ai = 0; ai < 2; ++ai)
#pragma unroll
            for (int m = 0; m < 4; ++m) { const int row = row0 + ai * 128 + m * 16; const float rs = 1.0f / sqrtf(ssq[row] * (1.0f / DM) + EPSF);
                const f32x4 a0 = acc[ai][0][m][0] * rs + sg0, a1 = acc[ai][0][m][1] * rs + sg1, b0 = acc[ai][1][m][0] * rs + su0, b1 = acc[ai][1][m][1] * rs + su1; v4u w;
                w.x = pg8::cvt_pk_bf16(a0[0] * fsigmoid(a0[0]) * b0[0], a0[1] * fsigmoid(a0[1]) * b0[1]); w.y = pg8::cvt_pk_bf16(a0[2] * fsigmoid(a0[2]) * b0[2], a0[3] * fsigmoid(a0[3]) * b0[3]);
                w.z = pg8::cvt_pk_bf16(a1[0] * fsigmoid(a1[0]) * b1[0], a1[1] * fsigmoid(a1[1]) * b1[1]); w.w = pg8::cvt_pk_bf16(a1[2] * fsigmoid(a1[2]) * b1[2], a1[3] * fsigmoid(a1[3]) * b1[3]);
                *(v4u*)(H + (size_t)row * DFF + col) = w; }
    }
};
struct EpiQkv {
    static constexpr bool PERM = true, AFTER_DRAIN = false;
    bf16_t* qraw; bf16_t* kraw; bf16_t* ctxv; bf16_t* latv; float* outv; const float* ssq; const float* sw;
    __device__ __forceinline__ void operator()(const f32x4 (&acc)[2][2][4][2], const pg8::Unit& u, int wr, int wc, int fr, int fq) const {
        const int row0 = u.pm * 256 + wr * 64 + fr, lc = wc * 32 + 8 * fq; const int cls = cls_of(u.pm * 256); const float* swr = sw + (size_t)cls * CIN;
        float rs[2][4];
#pragma unroll
        for (int ai = 0; ai < 2; ++ai)
#pragma unroll
            for (int m = 0; m < 4; ++m) rs[ai][m] = 1.0f / sqrtf(ssq[row0 + ai * 128 + m * 16] * (1.0f / DM) + EPSF);
#pragma unroll
        for (int bj = 0; bj < 2; ++bj) { const int col = 256 * u.pn + 128 * bj + lc; const f32x4 s0 = *(const f32x4*)(swr + col), s1 = *(const f32x4*)(swr + col + 4);
#pragma unroll
            for (int ai = 0; ai < 2; ++ai)
#pragma unroll
                for (int m = 0; m < 4; ++m) { const int row = row0 + ai * 128 + m * 16; const f32x4 v0 = acc[ai][bj][m][0] * rs[ai][m] + s0, v1 = acc[ai][bj][m][1] * rs[ai][m] + s1;
                    v4u w; w.x = pg8::cvt_pk_bf16(v0[0], v0[1]); w.y = pg8::cvt_pk_bf16(v0[2], v0[3]); w.z = pg8::cvt_pk_bf16(v1[0], v1[1]); w.w = pg8::cvt_pk_bf16(v1[2], v1[3]);
                    if (u.pn < NQ * HDIM / 256) *(v4u*)(qraw + (size_t)row * (NQ * HDIM) + col) = w;
                    else if (u.pn == NQ * HDIM / 256) *(v4u*)(kraw + (size_t)row * (NKV * HDIM) + (col - NQ * HDIM)) = w;
                    else { const int c2 = col - (NQ + NKV) * HDIM;
                        if (row < MC) { *(v4u*)(ctxv + (size_t)row * (NKV * HDIM) + c2) = w; float* o = outv + (size_t)row * (NKV * HDIM) + c2; *(f32x4*)o = v0; *(f32x4*)(o + 4) = v1; }
                        else { const int b = (row - MC) / LSEQ, s = (row - MC) % LSEQ; *(v4u*)(latv + ((size_t)b * SKVL + s) * (NKV * HDIM) + c2) = w; } } } }
    }
};
static_assert(NKV * HDIM == 256 && (NQ * HDIM) % 256 == 0, "EpiQkv tile mapping");

constexpr int CW_SPLIT = 8192;
constexpr size_t SLAB_BYTES = (size_t)64 * 4 * 16 * 512 * 16;
struct RoundZeroOrder : pg8::StaticOrder {
    bool split;
    __device__ void init(int M, int N, int K, int G_, int c_) { pg8::StaticOrder::init(M, N, K, G_, c_); split = (G == 256 && nwg > 256 && nwg <= 320 && ntK >= 8); }
    __device__ bool next(int i, pg8::Unit& u) const { if (split && i > 0) return false; return pg8::StaticOrder::next(i, u); }
};
struct QuarterOrder : pg8::StaticOrder {
    __device__ bool next(int i, pg8::Unit& u) const {
        if (i > 0) return false; const int L = 256 + (c >> 2), q = c & 3; if (L >= nwg) return false;
        map(L, u); const int base = (ntK / 8) * 2, rem = (ntK - 4 * base) / 2;
        int k0 = 0; for (int j = 0; j < q; ++j) k0 += base + (j < rem ? 2 : 0);
        u.k0 = k0; u.nt = base + (q < rem ? 2 : 0); u.role = 1 + q; u.slot = c >> 2; return true;
    }
};
struct EpiPartial {
    static constexpr bool PERM = true, AFTER_DRAIN = false;
    unsigned char* slab; unsigned* cnt;
    __device__ __forceinline__ void operator()(const f32x4 (&acc)[2][2][4][2], const pg8::Unit& u, int wr, int wc, int fr, int fq) const {
        const int tid = (wr * 4 + wc) * 64 + fq * 16 + fr;
        unsigned char* dst = slab + ((size_t)u.slot * 4 + (u.role - 1)) * (16 * 512 * 16) + (size_t)tid * 16;
#pragma unroll
        for (int ai = 0; ai < 2; ++ai)
#pragma unroll
            for (int bj = 0; bj < 2; ++bj)
#pragma unroll
                for (int m = 0; m < 4; ++m) { const f32x4 a = acc[ai][bj][m][0], b = acc[ai][bj][m][1]; v4u w;
                    w.x = pg8::cvt_pk_bf16(a[0], a[1]); w.y = pg8::cvt_pk_bf16(a[2], a[3]); w.z = pg8::cvt_pk_bf16(b[0], b[1]); w.w = pg8::cvt_pk_bf16(b[2], b[3]);
                    asm volatile("global_store_dwordx4 %0, %1, off sc1\n\ts_nop 1" :: "v"(dst), "v"(w) : "memory");
                    dst += 512 * 16; asm volatile("" : "+v"(dst)); }
        asm volatile("s_waitcnt vmcnt(0)" ::: "memory");
        if (fr == 0 && fq == 0) __hip_atomic_fetch_add(cnt + (size_t)u.slot * 64, 1u, __ATOMIC_RELAXED, __HIP_MEMORY_SCOPE_AGENT);
    }
};
__device__ __forceinline__ void tail_reduce(const EpiRes& E, const unsigned char* slab, unsigned* cnt, int G, int bx, int nN, int nM) {
    pg8::StaticOrder S; S.nM = nM; S.nN = nN; S.nwg = nM * nN; S.G = G; S.c = bx; S.ntK = 0;
    const int L = 256 + (bx >> 2), q = bx & 3; if (L >= S.nwg) return;
    pg8::Unit u; S.map(L, u); const int slot = bx >> 2, ai = q >> 1, bj = q & 1;
    const int tid = tid_opaque(), wid = tid >> 6, lane = tid & 63, wr = wid >> 2, wc = wid & 3, fr = lane & 15, fq = lane >> 4;
    unsigned* c = cnt + (size_t)slot * 64; unsigned spins = 0;
    while ((unsigned)__builtin_amdgcn_readfirstlane(__hip_atomic_load(c, __ATOMIC_RELAXED, __HIP_MEMORY_SCOPE_AGENT)) < 32u) { __builtin_amdgcn_s_sleep(2); if (++spins > (1u << 22)) break; }
    __builtin_amdgcn_fence(__ATOMIC_ACQUIRE, "agent");
    const unsigned char* base = slab + (size_t)slot * 4 * (16 * 512 * 16) + (size_t)tid * 16;
    v4u w[4][4];
#pragma unroll
    for (int m = 0; m < 4; ++m)
#pragma unroll
        for (int r = 0; r < 4; ++r) w[m][r] = *(const v4u*)(base + (size_t)r * (16 * 512 * 16) + (size_t)((ai * 2 + bj) * 4 + m) * (512 * 16));
    const int row0 = u.pm * 256 + ai * 128 + wr * 64 + fr; const int cls = cls_of(u.pm * 256); const int col = u.pn * 256 + bj * 128 + wc * 32 + 8 * fq;
#pragma unroll
    for (int m = 0; m < 4; ++m) { const int row = row0 + m * 16; f32x4 v[2] = {(f32x4){0.f, 0.f, 0.f, 0.f}, (f32x4){0.f, 0.f, 0.f, 0.f}};
#pragma unroll
        for (int r = 0; r < 4; ++r) { const v4u x = w[m][r]; v[0] += (f32x4){__uint_as_float(x.x << 16), __uint_as_float(x.x & 0xffff0000u), __uint_as_float(x.y << 16), __uint_as_float(x.y & 0xffff0000u)};
            v[1] += (f32x4){__uint_as_float(x.z << 16), __uint_as_float(x.z & 0xffff0000u), __uint_as_float(x.w << 16), __uint_as_float(x.w & 0xffff0000u)}; }
        float sq = E.piece(row, col, cls, v[0], v[1]);
        sq += __shfl_xor(sq, 16); sq += __shfl_xor(sq, 32); if (fq == 0) atomicAdd(E.ssq + row, sq); }
}
namespace att {
typedef unsigned short bf16;
constexpr int D = 128, NW = 8, QBLK = 32, KVBLK = 64; constexpr float SCALE = 0.088388347648318440f; constexpr float THR = 8.f; constexpr int SDEPTH = 1;
constexpr int LDQ = NQ * HDIM, LDK = NKV * HDIM, LDO = DM;
constexpr size_t SHM_V = KVBLK * D * 2, SHM_K = KVBLK * D * 2, SHM_ATTN = 2 * SHM_V + 2 * SHM_K + NW * 64 * 4;
using bf16x8 = __attribute__((ext_vector_type(8))) short;
using s16x4  = __attribute__((ext_vector_type(4))) short;
using f32x16 = __attribute__((ext_vector_type(16))) float;
using f32x8  = __attribute__((ext_vector_type(8))) float;
using u32x4  = __attribute__((ext_vector_type(4))) unsigned;
#define KSWZ(row, colB) ((row) * 256 + ((colB) ^ (((row) & 7) << 4)))
#define SBAR() __builtin_amdgcn_sched_barrier(0)
__device__ __forceinline__ int crow(int r, int hi) { return (r & 3) + 8 * (r >> 2) + 4 * hi; }
__device__ __forceinline__ unsigned cvtpk(float lo, float hi) {
  unsigned r; asm volatile("v_cvt_pk_bf16_f32 %0, %1, %2" : "=v"(r) : "v"(lo), "v"(hi)); return r;
}
template <typename TIn> struct Stage;
template <> struct Stage<bf16>  { using T = bf16x8;
  __device__ static __forceinline__ T ld8(const bf16* p) { return *reinterpret_cast<const bf16x8*>(p); }
  __device__ static __forceinline__ bf16x8 tobf(T x) { return x; } };
__device__ __forceinline__ void partialSM(f32x16& p0, f32x16& p1, float& m_reg, float& mn, float& alpha) {
  constexpr float C = SCALE * 1.4426950408889634f;
  float pmax = p0[0]; for (int r = 1; r < 16; ++r) pmax = fmaxf(pmax, p0[r]); for (int r = 0; r < 16; ++r) pmax = fmaxf(pmax, p1[r]);
  { auto rr = __builtin_amdgcn_permlane32_swap(__float_as_uint(pmax), __float_as_uint(pmax), false, false);
    pmax = fmaxf(__uint_as_float(rr[0]), __uint_as_float(rr[1])); }
  if (__builtin_expect(__all(pmax - m_reg <= THR / SCALE), 1)) { mn = m_reg; alpha = 1.f; }
  else { mn = fmaxf(m_reg, pmax); alpha = __builtin_amdgcn_exp2f((m_reg - mn) * C); m_reg = mn; }
  float mnC = -mn * C;
  for (int r = 0; r < 16; ++r) p0[r] = fmaf(p0[r], C, mnC); for (int r = 0; r < 16; ++r) p1[r] = fmaf(p1[r], C, mnC);
  for (int r = 0; r < 16; ++r) p0[r] = __builtin_amdgcn_exp2f(p0[r]);
}
__device__ __forceinline__ void finishSM(f32x16& p0, f32x16& p1, float alpha, float& l_reg, bf16x8& pa0, bf16x8& pa1, bf16x8& pa2, bf16x8& pa3) {
  for (int r = 0; r < 16; ++r) p1[r] = __builtin_amdgcn_exp2f(p1[r]);
  float ps = 0; for (int r = 0; r < 16; ++r) ps += p0[r]; for (int r = 0; r < 16; ++r) ps += p1[r];
  { auto rr = __builtin_amdgcn_permlane32_swap(__float_as_uint(ps), __float_as_uint(ps), false, false);
    ps = __uint_as_float(rr[0]) + __uint_as_float(rr[1]); }
  l_reg = l_reg * alpha + ps;
#define PK4(P, BASE, OUT) do { unsigned a0 = cvtpk(P[BASE + 0], P[BASE + 1]), a1 = cvtpk(P[BASE + 2], P[BASE + 3]);   \
    unsigned b0 = cvtpk(P[BASE + 4], P[BASE + 5]), b1 = cvtpk(P[BASE + 6], P[BASE + 7]);                              \
    auto r0 = __builtin_amdgcn_permlane32_swap(a0, b0, false, false); auto r1 = __builtin_amdgcn_permlane32_swap(a1, b1, false, false); \
    u32x4 w = {r0[0], r1[0], r0[1], r1[1]}; OUT = *reinterpret_cast<bf16x8*>(&w); } while (0)
  PK4(p0, 0, pa0); PK4(p0, 8, pa1); PK4(p1, 0, pa2); PK4(p1, 8, pa3);
#undef PK4
}
__device__ __forceinline__ void qkt(f32x16& p0, f32x16& p1, const bf16* Ks, const bf16x8* qr, int r32, int hi) {
  p0 = f32x16{}; p1 = f32x16{};
  for (int d0 = 0; d0 < 8; ++d0) { int cb = (d0 * 16 + hi * 8) * 2;
    bf16x8 b0 = *reinterpret_cast<const bf16x8*>((const char*)Ks + KSWZ(r32, cb));
    bf16x8 b1 = *reinterpret_cast<const bf16x8*>((const char*)Ks + KSWZ(32 + r32, cb));
    p0 = __builtin_amdgcn_mfma_f32_32x32x16_bf16(b0, qr[d0], p0, 0, 0, 0);
    p1 = __builtin_amdgcn_mfma_f32_32x32x16_bf16(b1, qr[d0], p1, 0, 0, 0); }
}
__device__ __forceinline__ int v_st(int k, int c) { const int kk = (k & ~0xC) | ((k & 4) << 1) | ((k & 8) >> 1); return ((kk >> 3) * 4 + (c >> 5)) * 512 + ((kk & 7) * 32 + (c & 31)) * 2; }
__device__ __forceinline__ int v_rd_base(int lane) { return ((lane & 3) << 3) | (((lane >> 2) & 3) << 6) | (((lane >> 4) & 1) << 5) | (((lane >> 5) & 1) << 8); }
constexpr int v_rd_off(int d0, int ks, int half) { return d0 * 512 + ks * 4096 + half * 2048; }
template <int OFF> __device__ __forceinline__ s16x4 tr_read(int vb) {
  s16x4 r; asm volatile("ds_read_b64_tr_b16 %0, %1 offset:%2" : "=&v"(r) : "v"(vb), "i"(OFF) : "memory"); return r;
}
template <int D0> __device__ __forceinline__ void pv_one(f32x16& od, int vb, bf16x8 pa0, bf16x8 pa1, bf16x8 pa2, bf16x8 pa3) {
  const s16x4 l0 = tr_read<v_rd_off(D0, 0, 0)>(vb), h0 = tr_read<v_rd_off(D0, 0, 1)>(vb), l1 = tr_read<v_rd_off(D0, 1, 0)>(vb), h1 = tr_read<v_rd_off(D0, 1, 1)>(vb);
  const s16x4 l2 = tr_read<v_rd_off(D0, 2, 0)>(vb), h2 = tr_read<v_rd_off(D0, 2, 1)>(vb), l3 = tr_read<v_rd_off(D0, 3, 0)>(vb), h3 = tr_read<v_rd_off(D0, 3, 1)>(vb);
  asm volatile("s_waitcnt lgkmcnt(0)" ::: "memory"); SBAR();
#define PK(L, H) (bf16x8){L[0], L[1], L[2], L[3], H[0], H[1], H[2], H[3]}
  od = __builtin_amdgcn_mfma_f32_32x32x16_bf16(pa0, PK(l0, h0), od, 0, 0, 0);
  od = __builtin_amdgcn_mfma_f32_32x32x16_bf16(pa1, PK(l1, h1), od, 0, 0, 0);
  od = __builtin_amdgcn_mfma_f32_32x32x16_bf16(pa2, PK(l2, h2), od, 0, 0, 0);
  od = __builtin_amdgcn_mfma_f32_32x32x16_bf16(pa3, PK(l3, h3), od, 0, 0, 0);
#undef PK
}
__device__ __forceinline__ void pv_d0(f32x16* o, int vb, bf16x8 pa0, bf16x8 pa1, bf16x8 pa2, bf16x8 pa3) {
  pv_one<0>(o[0], vb, pa0, pa1, pa2, pa3); pv_one<1>(o[1], vb, pa0, pa1, pa2, pa3); pv_one<2>(o[2], vb, pa0, pa1, pa2, pa3); pv_one<3>(o[3], vb, pa0, pa1, pa2, pa3);
}

__device__ __forceinline__ void attn_dense_body(const bf16* __restrict__ Qb, const bf16* __restrict__ Kh, const bf16* __restrict__ Vh,
                                                bf16* __restrict__ Ob, int seq, char* lds) {
  typedef bf16 TQ;
  using St = Stage<bf16>; using SQ = Stage<TQ>;
  const int tid = tid_opaque(), wid = tid >> 6, lane = tid & 63, r32 = lane & 31, hi = lane >> 5;
  bf16* V_lds = (bf16*)lds; bf16* K_lds = (bf16*)(lds + 2 * SHM_V);
  float* ws = (float*)(lds + 2 * SHM_V + 2 * SHM_K) + wid * 64; float* li_l = ws; float* al_l = ws + 32;
  float m_reg = -1e30f, l_reg = 0; f32x16 o[4] = {}; bf16x8 qr[8];
  const TQ* Qw = Qb + (long)(wid * QBLK + r32) * LDQ + hi * 8;
#pragma unroll
  for (int d0 = 0; d0 < 8; ++d0) qr[d0] = SQ::tobf(SQ::ld8(Qw + d0 * 16));
  const int sr = tid >> 4, sc = (tid & 15) * 8, vst0 = v_st(sr, sc), vst1 = v_st(32 + sr, sc);
  const int vb0 = (int)(uintptr_t)V_lds + v_rd_base(lane);
  struct { typename St::T vs0, vs1, ks0, ks1; } sr_[SDEPTH];
#define SLOAD(i, k0) do { sr_[i].vs0 = St::ld8(&Vh[(long)((k0) + sr) * LDK + sc]); sr_[i].vs1 = St::ld8(&Vh[(long)((k0) + 32 + sr) * LDK + sc]); \
    sr_[i].ks0 = St::ld8(&Kh[(long)((k0) + sr) * LDK + sc]); sr_[i].ks1 = St::ld8(&Kh[(long)((k0) + 32 + sr) * LDK + sc]); } while (0)
#define SWRITE(b, i) do { *(bf16x8*)((char*)V_lds + (b) * SHM_V + vst0) = St::tobf(sr_[i].vs0);          \
    *(bf16x8*)((char*)V_lds + (b) * SHM_V + vst1) = St::tobf(sr_[i].vs1); int kc = sc * 2;               \
    *(bf16x8*)((char*)K_lds + (b) * SHM_K + KSWZ(sr, kc)) = St::tobf(sr_[i].ks0);                       \
    *(bf16x8*)((char*)K_lds + (b) * SHM_K + KSWZ(32 + sr, kc)) = St::tobf(sr_[i].ks1); } while (0)
#define SWAIT() do { if constexpr (SDEPTH == 2) asm volatile("s_waitcnt vmcnt(4)" ::: "memory"); else asm volatile("s_waitcnt vmcnt(0)" ::: "memory"); } while (0)
#define RESC(a) do { if (__any((a) < 1.f)) { if (hi == 0) al_l[r32] = (a); asm volatile("s_waitcnt lgkmcnt(0)" ::: "memory"); \
    for (int d = 0; d < 4; ++d) for (int r = 0; r < 16; ++r) o[d][r] *= al_l[crow(r, hi)]; } } while (0)
  f32x16 pA0, pA1, pB0, pB1; float mnA, mnB, alA, alB; bf16x8 pa0, pa1, pa2, pa3; const int NT = seq / KVBLK;
  constexpr int SE = 0, SO = SDEPTH - 1;
  SLOAD(SE, 0); asm volatile("s_waitcnt vmcnt(0)" ::: "memory"); SWRITE(0, SE); __syncthreads();
  qkt(pA0, pA1, K_lds, qr, r32, hi); partialSM(pA0, pA1, m_reg, mnA, alA);
  SLOAD(SO, KVBLK); if constexpr (SDEPTH == 2) { if (2 < NT) SLOAD(SE, 2 * KVBLK); }
  SWAIT(); SWRITE(1, SO); __syncthreads();
  for (int j = 1; j + 1 < NT; j += 2) {
    SBAR(); qkt(pB0, pB1, (bf16*)((char*)K_lds + SHM_K), qr, r32, hi);
    finishSM(pA0, pA1, alA, l_reg, pa0, pa1, pa2, pa3); SBAR();
    SLOAD(SO, (j + SDEPTH) * KVBLK); SBAR();
    pv_d0(o, vb0, pa0, pa1, pa2, pa3); partialSM(pB0, pB1, m_reg, mnB, alB);
    __syncthreads(); SWAIT(); SWRITE(0, SE);
    RESC(alB); __syncthreads();
    SBAR(); qkt(pA0, pA1, K_lds, qr, r32, hi);
    finishSM(pB0, pB1, alB, l_reg, pa0, pa1, pa2, pa3); SBAR();
    if (SDEPTH == 1 || j + 3 < NT) SLOAD(SE, (j + 1 + SDEPTH) * KVBLK); SBAR();
    pv_d0(o, vb0 + (int)SHM_V, pa0, pa1, pa2, pa3); partialSM(pA0, pA1, m_reg, mnA, alA);
    __syncthreads(); SWAIT(); SWRITE(1, SO);
    RESC(alA); __syncthreads();
  }
  SBAR(); qkt(pB0, pB1, (bf16*)((char*)K_lds + SHM_K), qr, r32, hi);
  finishSM(pA0, pA1, alA, l_reg, pa0, pa1, pa2, pa3); SBAR();
  pv_d0(o, vb0, pa0, pa1, pa2, pa3); partialSM(pB0, pB1, m_reg, mnB, alB);
  __syncthreads(); RESC(alB);
  finishSM(pB0, pB1, alB, l_reg, pa0, pa1, pa2, pa3); SBAR();
  pv_d0(o, vb0 + (int)SHM_V, pa0, pa1, pa2, pa3);
  if (hi == 0) li_l[r32] = l_reg; asm volatile("s_waitcnt lgkmcnt(0)" ::: "memory");
  float rli[16];
#pragma unroll
  for (int r = 0; r < 16; ++r) rli[r] = __builtin_amdgcn_rcpf(li_l[crow(r, hi)]);
  bf16* Ow = Ob + (long)(wid * QBLK) * LDO;
#pragma unroll
  for (int r = 0; r < 16; ++r) { int orow = crow(r, hi);
    for (int d0 = 0; d0 < 4; ++d0) Ow[(long)orow * LDO + d0 * 32 + r32] = f2bf(o[d0][r] * rli[r]); }
#undef SLOAD
#undef SWRITE
#undef SWAIT
#undef RESC
}
}
__device__ __forceinline__ void attn_phase(const Params& p, unsigned char* lds, int vcu, int G) {
    constexpr int QB = 256, LQB = LSEQ / QB, CQB = CSEQ / QB;
    constexpr int NUL = NLB * NQ * LQB, NUC = NCB * NQ * CQB, NU = NUL + NUC;
    const att::bf16* QR = (const att::bf16*)(p.ws + WS_QRAW); att::bf16* OB = (att::bf16*)(p.ws + WS_O);
    for (int i = 0;; ++i) {
        int u;
        if (G == 256 && NUL == 512) { if (i < 2) u = (vcu >> 5) * 64 + (vcu & 31) + 32 * i; else u = NUL + vcu + (i - 2) * G; }
        else u = vcu + i * G;
        if (u >= NU) break;
        const att::bf16 *Q, *K, *V; att::bf16* O; int seq;
        if (u < NUL) { const int grp = u / (GRP * LQB), j = u % (GRP * LQB); const int b = grp / NKV, kvh = grp % NKV, g = j / LQB, qb = j % LQB, hq = kvh * GRP + g;
            const size_t row0 = (size_t)MC + (size_t)b * LSEQ + (size_t)qb * QB;
            Q = QR + row0 * (NQ * HDIM) + hq * HDIM; O = OB + row0 * DM + hq * HDIM;
            K = (const att::bf16*)(p.ws + WS_LATK) + (size_t)b * SKVL * (NKV * HDIM) + kvh * HDIM; V = (const att::bf16*)(p.ws + WS_LATV) + (size_t)b * SKVL * (NKV * HDIM) + kvh * HDIM; seq = SKVL; }
        else { const int uc = u - NUL; const int b = uc / (NQ * CQB), r = uc % (NQ * CQB), hq = r / CQB, qb = r % CQB, kvh = hq / GRP;
            const size_t row0 = (size_t)b * CSEQ + (size_t)qb * QB;
            Q = QR + row0 * (NQ * HDIM) + hq * HDIM; O = OB + row0 * DM + hq * HDIM;
            K = (const att::bf16*)(p.ws + WS_CTXK) + (size_t)b * CSEQ * (NKV * HDIM) + kvh * HDIM; V = (const att::bf16*)(p.ws + WS_CTXV) + (size_t)b * CSEQ * (NKV * HDIM) + kvh * HDIM; seq = CSEQ; }
        __syncthreads();
        att::attn_dense_body(Q, K, V, O, seq, (char*)lds);
    }
}
static_assert(SKVL % 128 == 0 && CSEQ % 128 == 0 && LSEQ % 256 == 0 && CSEQ % 256 == 0, "attention tiling");
constexpr size_t WS_CST = 232 * MiB;
constexpr int NBLK = LSEQ / 256;
constexpr size_t WS_NST = WS_CST + (size_t)NLB * MH * 2 * NBLK * MDK * MDK * 2;
constexpr size_t WS_FTOT = WS_NST + (size_t)NLB * MH * 2 * NBLK * MDK * 4;
static_assert(WS_FTOT + (size_t)NLB * MH * 2 * NBLK * 4 <= WS_END && MDK == 128 && CSEQ == 256 && LSEQ % 256 == 0, "mLSTM fast path geometry");
namespace att {
constexpr int ML_OFF = 132096;
constexpr int ML_SC = ML_OFF + 6144;
constexpr int ML_N = ML_SC + 128;
constexpr int ML_LI = ML_N + 1024;
constexpr int ML_LI2 = ML_LI + 1024;
static_assert(ML_LI2 + 1024 <= LDS_BYTES, "mLSTM LDS map");
constexpr float L2E = 1.4426950408889634f;
using f32x4v = __attribute__((ext_vector_type(4))) float;


__device__ __forceinline__ void ml_gates(const Params& p, char* lds, int row0, int h, int tid) {
    float* A = (float*)(lds + ML_OFF); float* S = (float*)(lds + ML_SC);
    const int half = tid >> 8, t = tid & 255, tok = half ? 255 - t : t, lane = tid & 63, wv = (tid >> 6) & 3;
    const float* G = (const float*)(p.ws + WS_GATES) + (size_t)(row0 + tok) * NGATE + half * 8 + h;
    const float ig = G[0], lf = G[4];
    float v = lf;
#pragma unroll
    for (int off = 1; off < 64; off <<= 1) { const float u = lane_get(v, lane - off); if (lane >= off) v += u; }
    if (lane == 63) S[4 + half * 4 + wv] = v;
    __syncthreads();
    float pre = 0.f, tot = 0.f;
#pragma unroll
    for (int w = 0; w < 4; ++w) { const float x = S[4 + half * 4 + w]; if (w < wv) pre += x; tot += x; }
    const float P = v + pre, a = ig - P;
    A[(0 + half) * 256 + tok] = P * L2E; A[(2 + half) * 256 + tok] = a * L2E; A[(4 + half) * 256 + tok] = __builtin_amdgcn_exp2f(P * L2E);
    float mx = a;
    mx = fmaxf(mx, swz_xor<1>(mx)); mx = fmaxf(mx, swz_xor<2>(mx)); mx = fmaxf(mx, swz_xor<4>(mx)); mx = fmaxf(mx, swz_xor<8>(mx)); mx = fmaxf(mx, swz_xor<16>(mx)); mx = half_max(mx);
    if (lane == 0) S[12 + half * 4 + wv] = mx;
    if (t == 0) S[half] = tot;
    __syncthreads();
    if (t == 0) S[2 + half] = fmaxf(fmaxf(S[12 + half * 4], S[13 + half * 4]), fmaxf(S[14 + half * 4], S[15 + half * 4]));
    __syncthreads();
}
#define ML_PK(L, H) (bf16x8){L[0], L[1], L[2], L[3], H[0], H[1], H[2], H[3]}
__device__ __forceinline__ s16x4 tr_read_rt(int vb) { s16x4 r; asm volatile("ds_read_b64_tr_b16 %0, %1" : "=&v"(r) : "v"(vb) : "memory"); return r; }

__device__ __forceinline__ void ml_passA_unit(const Params& p, char* lds, int sid, int h, int blk) {
    const int tid = tid_opaque(), wid = tid >> 6, lane = tid & 63, r32 = lane & 31, hi = lane >> 5;
    const bool isctx = sid < NCB; const int row0 = seq_base(sid) + 256 * blk;
    __syncthreads();
    ml_gates(p, lds, row0, h, tid);
    float* A = (float*)(lds + ML_OFF); float* S = (float*)(lds + ML_SC); float* NA = (float*)(lds + ML_N);
    const bf16* QK = (const bf16*)(p.ws + WS_QKVO) + (size_t)row0 * (4 * MW) + h * MDK;
    const int sr = tid >> 4, sc8 = (tid & 15) * 8;
    { bf16x8 tv[8];
#pragma unroll
      for (int i = 0; i < 8; ++i) tv[i] = *(const bf16x8*)(QK + (size_t)(32 * i + sr) * (4 * MW) + 2 * MW + sc8);
#pragma unroll
      for (int i = 0; i < 8; ++i) *(bf16x8*)(lds + 65536 + (i >> 1) * 16384 + v_st(32 * (i & 1) + sr, sc8)) = tv[i]; }
    if (tid < 256) NA[tid] = 0.f;
    const int a = wid >> 1, dvb0 = 2 * (wid & 1);
    const int ldsb = (int)(uintptr_t)lds; const int vbK = ldsb + v_rd_base(lane) + a * 512, vbV = ldsb + 65536 + v_rd_base(lane) + dvb0 * 512;
    for (int dir = 0; dir < 2; ++dir) {
        __syncthreads();
        const float ft = S[dir], am = S[2 + dir]; const float mT = isctx ? ft + fmaxf(am, 0.f) : 0.f; const float wl2 = (ft - mT) * L2E;
        float xs[8];
#pragma unroll
        for (int i = 0; i < 8; ++i) xs[i] = 0.f;
        bf16x8 tk[8];
#pragma unroll
        for (int i = 0; i < 8; ++i) tk[i] = *(const bf16x8*)(QK + (size_t)(32 * i + sr) * (4 * MW) + MW + sc8);
#pragma unroll
        for (int j = 0; j < 4; ++j)
#pragma unroll
            for (int hf = 0; hf < 2; ++hf) { const int row = 64 * j + 32 * hf + sr; const float w = __builtin_amdgcn_exp2f(wl2 + A[(2 + dir) * 256 + row]);
                const bf16x8 k8 = tk[2 * j + hf]; float x[8];
#pragma unroll
                for (int i = 0; i < 8; ++i) { x[i] = bf2f((unsigned short)k8[i]) * w; xs[i] += x[i]; }
                u32x4 pk = {cvtpk(x[0], x[1]), cvtpk(x[2], x[3]), cvtpk(x[4], x[5]), cvtpk(x[6], x[7])};
                *(u32x4*)(lds + j * 16384 + v_st(32 * hf + sr, sc8)) = pk; }
#pragma unroll
        for (int i = 0; i < 8; ++i) { float v = xs[i]; v += swz_xor<16>(v); v = half_sum(v); if (lane < 16) atomicAdd(&NA[dir * 128 + sc8 + i], v); }
        __syncthreads();
        f32x16 acc0 = {}, acc1 = {}; const unsigned eoff = (unsigned)((32 * a + 4 * hi) * MDK + 32 * dvb0 + r32);
#pragma unroll
        for (int j = 0; j < 4; ++j)
#pragma unroll
            for (int ks = 0; ks < 4; ++ks) { const int off = j * 16384 + ks * 4096;
                const s16x4 al = tr_read_rt(vbK + off), ah = tr_read_rt(vbK + off + 2048);
                const s16x4 bl0 = tr_read_rt(vbV + off), bh0 = tr_read_rt(vbV + off + 2048), bl1 = tr_read_rt(vbV + off + 512), bh1 = tr_read_rt(vbV + off + 512 + 2048);
                asm volatile("s_waitcnt lgkmcnt(0)" ::: "memory"); SBAR();
                acc0 = __builtin_amdgcn_mfma_f32_32x32x16_bf16(ML_PK(al, ah), ML_PK(bl0, bh0), acc0, 0, 0, 0);
                acc1 = __builtin_amdgcn_mfma_f32_32x32x16_bf16(ML_PK(al, ah), ML_PK(bl1, bh1), acc1, 0, 0, 0); }
        if (isctx) {
            float* Co = p.out + O_C + ((size_t)(sid * 2 + dir) * MH + h) * MDK * MDK;
#pragma unroll
            for (int r = 0; r < 16; ++r) { const unsigned eo = eoff + (unsigned)(((r & 3) + 8 * (r >> 2)) * MDK); Co[eo] = acc0[r]; Co[eo + 32] = acc1[r]; }
            if (tid == 0) p.out[O_M + (size_t)(sid * 2 + dir) * MH + h] = mT;
        } else {
            const int b = sid - NCB; bf16* Cs = (bf16*)(p.ws + WS_CST) + ((size_t)((b * MH + h) * 2 + dir) * NBLK + blk) * MDK * MDK;
#pragma unroll
            for (int r = 0; r < 16; ++r) { const unsigned eo = eoff + (unsigned)(((r & 3) + 8 * (r >> 2)) * MDK); Cs[eo] = f2bf(acc0[r]); Cs[eo + 32] = f2bf(acc1[r]); }
            if (tid == 0) ((float*)(p.ws + WS_FTOT))[((size_t)(b * MH + h) * 2 + dir) * NBLK + blk] = ft;
        }
    }
    __syncthreads();
    if (tid < 256) { const int dir = tid >> 7, d = tid & 127;
        if (isctx) p.out[O_N + ((size_t)(sid * 2 + dir) * MH + h) * MDK + d] = NA[tid];
        else { const int b = sid - NCB; ((float*)(p.ws + WS_NST))[(((size_t)(b * MH + h) * 2 + dir) * NBLK + blk) * MDK + d] = NA[tid]; } }
}

template <int DIR> __device__ __forceinline__ void ml_tile(f32x16* o, float& den, const bf16x8* qr, const char* Ktile, int vbV, const float* AL2, int j, float cq, int trow, bool diag, int r32, int hi) {
    SBAR(); f32x16 p0, p1; qkt(p0, p1, (const bf16*)Ktile, qr, r32, hi); SBAR();
    float ds = 0.f; const int tl = trow - 64 * j - 4 * hi;
#pragma unroll
    for (int g = 0; g < 4; ++g) { const f32x4v a0 = *(const f32x4v*)(AL2 + 64 * j + 8 * g + 4 * hi), a1 = *(const f32x4v*)(AL2 + 64 * j + 32 + 8 * g + 4 * hi);
#pragma unroll
        for (int e = 0; e < 4; ++e) { float w0 = __builtin_amdgcn_exp2f(cq + a0[e]), w1 = __builtin_amdgcn_exp2f(cq + a1[e]);
            if (diag) { if (DIR == 0 ? (8 * g + e > tl) : (8 * g + e < tl)) w0 = 0.f; if (DIR == 0 ? (8 * g + e + 32 > tl) : (8 * g + e + 32 < tl)) w1 = 0.f; }
            p0[4 * g + e] *= w0; p1[4 * g + e] *= w1; ds += p0[4 * g + e] + p1[4 * g + e]; } }
    den += ds;
    bf16x8 pa0, pa1, pa2, pa3;
#define PK4(P, BASE, OUT) do { unsigned a0_ = cvtpk(P[BASE + 0], P[BASE + 1]), a1_ = cvtpk(P[BASE + 2], P[BASE + 3]);   \
    unsigned b0_ = cvtpk(P[BASE + 4], P[BASE + 5]), b1_ = cvtpk(P[BASE + 6], P[BASE + 7]);                              \
    auto r0_ = __builtin_amdgcn_permlane32_swap(a0_, b0_, false, false); auto r1_ = __builtin_amdgcn_permlane32_swap(a1_, b1_, false, false); \
    u32x4 w_ = {r0_[0], r1_[0], r0_[1], r1_[1]}; OUT = *reinterpret_cast<bf16x8*>(&w_); } while (0)
    PK4(p0, 0, pa0); PK4(p0, 8, pa1); PK4(p1, 0, pa2); PK4(p1, 8, pa3);
#undef PK4
    SBAR(); pv_d0(o, vbV, pa0, pa1, pa2, pa3); SBAR();
}
struct MlKv { bf16x8 tk[4], tv[4]; };
__device__ __forceinline__ void ml_kv_load(MlKv& r, const bf16* QK, int tile0, int sr, int sc8) {
#pragma unroll
    for (int i = 0; i < 4; ++i) { const int row = 64 * tile0 + 32 * i + sr; r.tk[i] = *(const bf16x8*)(QK + (size_t)row * (4 * MW) + MW + sc8); r.tv[i] = *(const bf16x8*)(QK + (size_t)row * (4 * MW) + 2 * MW + sc8); }
}
__device__ __forceinline__ void ml_kv_write(const MlKv& r, char* lds, int sr, int sc8) {
#pragma unroll
    for (int i = 0; i < 4; ++i) { const int jj = i >> 1, rl = 32 * (i & 1) + sr; *(bf16x8*)(lds + jj * 16384 + KSWZ(rl, sc8 * 2)) = r.tk[i]; *(bf16x8*)(lds + 32768 + jj * 16384 + v_st(rl, sc8)) = r.tv[i]; }
}
__device__ __forceinline__ void ml_passC_unit(const Params& p, char* lds, int sid, int h, int blk) {
    const int tid = tid_opaque(), wid = tid >> 6, lane = tid & 63, r32 = lane & 31, hi = lane >> 5;
    const bool isctx = sid < NCB; const int row0 = seq_base(sid) + 256 * blk; const int wq = wid >> 1;
    __syncthreads();
    ml_gates(p, lds, row0, h, tid);
    float* A = (float*)(lds + ML_OFF); float* NS = (float*)(lds + ML_N); float* li = (float*)(lds + ML_LI) + wid * 32;
    const bf16* QK = (const bf16*)(p.ws + WS_QKVO) + (size_t)row0 * (4 * MW) + h * MDK;
    const int sr = tid >> 4, sc8 = (tid & 15) * 8; const int b = sid - NCB;
    if (tid < 256) { const int dir = tid >> 7, d = tid & 127;
        NS[tid] = isctx ? 0.f : ((const float*)(p.ws + WS_NST))[(((size_t)(b * MH + h) * 2 + dir) * NBLK + blk) * MDK + d]; }
    if (!isctx) { bf16x8 tc[8];
#pragma unroll
        for (int i = 0; i < 8; ++i) { const int dir = i >> 2, c = tid + 512 * (i & 3); tc[i] = *(const bf16x8*)((const bf16*)(p.ws + WS_CST) + ((size_t)((b * MH + h) * 2 + dir) * NBLK + blk) * MDK * MDK + (size_t)c * 8); }
#pragma unroll
        for (int i = 0; i < 8; ++i) { const int dir = i >> 2, c = tid + 512 * (i & 3), row = c >> 4, col8 = (c & 15) * 8; *(bf16x8*)(lds + 65536 + dir * 32768 + (row >> 6) * 16384 + v_st(row & 63, col8)) = tc[i]; }
    }
    bf16x8 qr[8];
    { const bf16* Qw = QK + (size_t)(wid * 32 + r32) * (4 * MW) + hi * 8;
#pragma unroll
        for (int d0 = 0; d0 < 8; ++d0) qr[d0] = *(const bf16x8*)(Qw + d0 * 16); }
    { MlKv kv; ml_kv_load(kv, QK, 0, sr, sc8); ml_kv_write(kv, lds, sr, sc8); }
    __syncthreads();
    float qn_f = 0.f, qn_b = 0.f;
#pragma unroll
    for (int d0 = 0; d0 < 8; ++d0)
#pragma unroll
        for (int i = 0; i < 8; ++i) { const float qv = bf2f((unsigned short)qr[d0][i]); qn_f += qv * NS[d0 * 16 + hi * 8 + i]; qn_b += qv * NS[128 + d0 * 16 + hi * 8 + i]; }
    qn_f = half_sum(qn_f); qn_b = half_sum(qn_b);
    const int ldsb = (int)(uintptr_t)lds; const int vbV = ldsb + 32768 + v_rd_base(lane), vbC = ldsb + 65536 + v_rd_base(lane);
    const int trow = wid * 32 + r32;
    f32x16 of[4], ob[4];
#pragma unroll
    for (int d0 = 0; d0 < 4; ++d0) { of[d0] = f32x16{}; ob[d0] = f32x16{}; }
    if (!isctx) { pv_d0(of, vbC, qr[0], qr[1], qr[2], qr[3]); pv_d0(of, vbC + 16384, qr[4], qr[5], qr[6], qr[7]);
        pv_d0(ob, vbC + 32768, qr[0], qr[1], qr[2], qr[3]); pv_d0(ob, vbC + 32768 + 16384, qr[4], qr[5], qr[6], qr[7]);
#pragma unroll
        for (int r = 0; r < 16; ++r) { const float ef = A[4 * 256 + wid * 32 + crow(r, hi)], eb = A[5 * 256 + wid * 32 + crow(r, hi)];
#pragma unroll
            for (int d0 = 0; d0 < 4; ++d0) { of[d0][r] *= ef; ob[d0][r] *= eb; } } }
    const float cqf = A[0 * 256 + trow], cqb = A[1 * 256 + trow]; float denf = 0.f, denb = 0.f;
    ml_tile<0>(of, denf, qr, lds, vbV, A + 2 * 256, 0, cqf, trow, wq == 0, r32, hi);
    if (wq >= 1) ml_tile<0>(of, denf, qr, lds + 16384, vbV + 16384, A + 2 * 256, 1, cqf, trow, wq == 1, r32, hi);
    if (wq <= 1) ml_tile<1>(ob, denb, qr, lds + 16384, vbV + 16384, A + 3 * 256, 1, cqb, trow, wq == 1, r32, hi);
    if (wq <= 0) ml_tile<1>(ob, denb, qr, lds, vbV, A + 3 * 256, 0, cqb, trow, wq == 0, r32, hi);
    __syncthreads();
    { MlKv kv; ml_kv_load(kv, QK, 2, sr, sc8); ml_kv_write(kv, lds, sr, sc8); }
    __syncthreads();
    if (wq >= 2) ml_tile<0>(of, denf, qr, lds, vbV, A + 2 * 256, 2, cqf, trow, wq == 2, r32, hi);
    if (wq >= 3) ml_tile<0>(of, denf, qr, lds + 16384, vbV + 16384, A + 2 * 256, 3, cqf, trow, wq == 3, r32, hi);
    ml_tile<1>(ob, denb, qr, lds + 16384, vbV + 16384, A + 3 * 256, 3, cqb, trow, wq == 3, r32, hi);
    if (wq <= 2) ml_tile<1>(ob, denb, qr, lds, vbV, A + 3 * 256, 2, cqb, trow, wq == 2, r32, hi);
    denf = half_sum(denf); denb = half_sum(denb);
    const float invf = 1.0f / fmaxf(fabsf(denf + __builtin_amdgcn_exp2f(cqf) * qn_f), 1.0f), invb = 1.0f / fmaxf(fabsf(denb + __builtin_amdgcn_exp2f(cqb) * qn_b), 1.0f);
    float* li2 = (float*)(lds + ML_LI2) + wid * 32;
    if (hi == 0) { li[r32] = invf; li2[r32] = invb; } asm volatile("s_waitcnt lgkmcnt(0)" ::: "memory");
    const unsigned uho = (unsigned)(4 * hi * DM + r32), ogo = (unsigned)(4 * hi * 4 * MW + r32);
    float mg[4];
#pragma unroll
    for (int d0 = 0; d0 < 4; ++d0) mg[d0] = p.mng[h * MDK + d0 * 32 + r32];
    const bf16* OG = QK + (size_t)(wid * 32) * (4 * MW) + 3 * MW; bf16* UHo = (bf16*)(p.ws + WS_UH) + (size_t)(row0 + wid * 32) * DM + CCH + h * MDK;
#pragma unroll
    for (int r = 0; r < 16; ++r) { const float rlf = li[crow(r, hi)], rlb = li2[crow(r, hi)]; const int rc = (r & 3) + 8 * (r >> 2); float ss = 0.f; float x[4];
#pragma unroll
        for (int d0 = 0; d0 < 4; ++d0) { x[d0] = of[d0][r] * rlf + ob[d0][r] * rlb; ss += x[d0] * x[d0]; }
        ss += swz_xor<1>(ss); ss += swz_xor<2>(ss); ss += swz_xor<4>(ss); ss += swz_xor<8>(ss); ss += swz_xor<16>(ss);
        const float rs = 1.0f / sqrtf(ss * (1.0f / MDK) + EPSF);
#pragma unroll
        for (int d0 = 0; d0 < 4; ++d0) UHo[uho + (unsigned)(rc * DM + d0 * 32)] = f2bf(bf2f(OG[ogo + (unsigned)(rc * 4 * MW + d0 * 32)]) * x[d0] * rs * mg[d0]);
        if ((r & 3) == 3) asm volatile("" ::: "memory"); }
}
}

template <int DIR> __device__ __forceinline__ void ml_scan_item(const Params& p, int ch, int b, int h, int e8) {
    const float em = expf(p.stm[(size_t)(b * 2 + DIR) * MH + h]); const float* FT = (const float*)(p.ws + WS_FTOT) + (size_t)ch * NBLK;
    float fd[NBLK];
#pragma unroll
    for (int i = 0; i < NBLK; ++i) fd[i] = expf(FT[i]);
    if (e8 < MDK * MDK) { bf16_t* Cs = (bf16_t*)(p.ws + WS_CST) + (size_t)ch * NBLK * MDK * MDK + e8; const float* c0 = p.stC + ((size_t)(b * 2 + DIR) * MH + h) * MDK * MDK + e8;
        v4u d[NBLK];
#pragma unroll
        for (int i = 0; i < NBLK; ++i) d[i] = *(const v4u*)(Cs + (size_t)i * MDK * MDK);
        const f32x4 ca = *(const f32x4*)c0, cb = *(const f32x4*)(c0 + 4); float c[8] = {ca[0] * em, ca[1] * em, ca[2] * em, ca[3] * em, cb[0] * em, cb[1] * em, cb[2] * em, cb[3] * em};
#pragma unroll
        for (int i = 0; i < NBLK; ++i) { const int blk = DIR == 0 ? i : NBLK - 1 - i; v4u o;
#pragma unroll
            for (int w = 0; w < 4; ++w) { const float lo = __uint_as_float(d[blk][w] << 16), hi = __uint_as_float(d[blk][w] & 0xffff0000u); o[w] = pg8::cvt_pk_bf16(c[2 * w], c[2 * w + 1]);
                c[2 * w] = fd[blk] * c[2 * w] + lo; c[2 * w + 1] = fd[blk] * c[2 * w + 1] + hi; }
            *(v4u*)(Cs + (size_t)blk * MDK * MDK) = o; } }
    else { const int d_ = e8 - MDK * MDK; float* Ns = (float*)(p.ws + WS_NST) + (size_t)ch * NBLK * MDK + d_; const float* n0 = p.stn + ((size_t)(b * 2 + DIR) * MH + h) * MDK + d_;
        f32x4 da[NBLK], db[NBLK];
#pragma unroll
        for (int i = 0; i < NBLK; ++i) { da[i] = *(const f32x4*)(Ns + (size_t)i * MDK); db[i] = *(const f32x4*)(Ns + (size_t)i * MDK + 4); }
        f32x4 ca = *(const f32x4*)n0 * em, cb = *(const f32x4*)(n0 + 4) * em;
#pragma unroll
        for (int i = 0; i < NBLK; ++i) { const int blk = DIR == 0 ? i : NBLK - 1 - i;
            *(f32x4*)(Ns + (size_t)blk * MDK) = ca; *(f32x4*)(Ns + (size_t)blk * MDK + 4) = cb; ca = ca * fd[blk] + da[blk]; cb = cb * fd[blk] + db[blk]; } }
}
struct MlScan {
    Params p; static HD_FN long count() { return (long)NLB * MH * 2 * ((MDK * MDK + MDK) / 8); }
    __device__ __forceinline__ void operator()(long idx) const {
        constexpr int per = (MDK * MDK + MDK) / 8; const int e8 = (int)(idx % per) * 8; const int ch = (int)(idx / per); const int dir = ch & 1, h = (ch >> 1) % MH, b = ch / (2 * MH);
        if (dir == 0) ml_scan_item<0>(p, ch, b, h, e8); else ml_scan_item<1>(p, ch, b, h, e8);
    }
};
__device__ __forceinline__ void ml_phase_A(const Params& p, unsigned char* lds, int vcu, int G) {
    constexpr int NUL = NLB * MH * NBLK, NU = NUL + NCB * MH;
    for (int u = vcu; u < NU; u += G) {
        if (u < NUL) att::ml_passA_unit(p, (char*)lds, NCB + u / (MH * NBLK), (u / NBLK) % MH, u % NBLK);
        else att::ml_passA_unit(p, (char*)lds, (u - NUL) / MH, (u - NUL) % MH, 0); }
}
__device__ __forceinline__ void ml_phase_C(const Params& p, unsigned char* lds, int vcu, int G) {
    constexpr int NUL = NLB * MH * NBLK, NU = NUL + NCB * MH;
    for (int u = vcu; u < NU; u += G) {
        if (u < NUL) att::ml_passC_unit(p, (char*)lds, NCB + u / (MH * NBLK), (u / NBLK) % MH, u % NBLK);
        else att::ml_passC_unit(p, (char*)lds, (u - NUL) / MH, (u - NUL) % MH, 0); }
}
typedef float f4 __attribute__((ext_vector_type(4)));
typedef unsigned u4 __attribute__((ext_vector_type(4)));
typedef unsigned u2 __attribute__((ext_vector_type(2)));
__device__ __forceinline__ float wave_sum64(float v) { v += swz_xor<1>(v); v += swz_xor<2>(v); v += swz_xor<4>(v); v += swz_xor<8>(v); v += swz_xor<16>(v); return half_sum(v); }
__device__ __forceinline__ float fsilu(float x) { return x * fsigmoid(x); }

__device__ __forceinline__ void phase_mod(const Params& p, char* lds, int bx, int G) {
    const int tid = tid_opaque(), lane = tid & 63, wave = tid >> 6;
    float* SL = (float*)lds; float* PT = (float*)(lds + 32768);
    constexpr int NCG = 6 * DM / 64, NIT = 2 * NCG;
    if (bx >= NIT) return;
    __syncthreads();
    for (int i = tid; i < NCLS * DM; i += NTHREADS) { const int cls = i / DM, k = i % DM; const float cv = cls == 0 ? p.cctx[k] : p.c[(size_t)(cls - 1) * DM + k]; SL[i] = fsilu(cv); }
    for (int item = bx; item < NIT; item += G) {
        __syncthreads();
        const int l = item / NCG, cg = item % NCG; const float* w = p.wmod + (size_t)l * DM * 6 * DM + cg * 64 + lane;
        float acc[NCLS];
#pragma unroll
        for (int r = 0; r < NCLS; ++r) acc[r] = 0.f;
        const int k0 = wave * (DM / 8);
#pragma unroll 8
        for (int k = k0; k < k0 + DM / 8; ++k) { const float wv = w[(size_t)k * 6 * DM];
#pragma unroll
            for (int r = 0; r < NCLS; ++r) acc[r] += SL[r * DM + k] * wv; }
#pragma unroll
        for (int r = 0; r < NCLS; ++r) PT[(wave * NCLS + r) * 64 + lane] = acc[r];
        __syncthreads();
        if (tid < NCLS * 64) { const int r = tid >> 6; float s = p.bmod[(size_t)l * 6 * DM + cg * 64 + lane];
#pragma unroll
            for (int w8 = 0; w8 < 8; ++w8) s += PT[(w8 * NCLS + r) * 64 + lane];
            ((float*)(p.ws + WS_MOD))[((size_t)(l * NCLS + r) * 6 * DM) + cg * 64 + lane] = s; }
    }
}
__device__ __forceinline__ void sw_job(const Params& p, const bf16_t* Bt, int nrows, int l, int which, float* sw, int N, int mode, int gw, int NGW, int lane) {
    if (gw >= nrows) return;
    f4 sh[NCLS][4];
#pragma unroll
    for (int cls = 0; cls < NCLS; ++cls) { const float* s_ = modv(p, l, cls, which); sh[cls][0] = *(const f4*)(s_ + lane * 8); sh[cls][1] = *(const f4*)(s_ + lane * 8 + 4); sh[cls][2] = *(const f4*)(s_ + DM / 2 + lane * 8); sh[cls][3] = *(const f4*)(s_ + DM / 2 + lane * 8 + 4); }
    u4 w0 = *(const u4*)(Bt + (size_t)gw * DM + lane * 8), w1 = *(const u4*)(Bt + (size_t)gw * DM + DM / 2 + lane * 8);
    for (int n = gw; n < nrows; n += NGW) {
        const u4 c0 = w0, c1 = w1; const int nn = n + NGW; if (nn < nrows) { w0 = *(const u4*)(Bt + (size_t)nn * DM + lane * 8); w1 = *(const u4*)(Bt + (size_t)nn * DM + DM / 2 + lane * 8); }
        f4 wa, wb, wc, wd; wa = (f4){__uint_as_float(c0.x << 16), __uint_as_float(c0.x & 0xffff0000u), __uint_as_float(c0.y << 16), __uint_as_float(c0.y & 0xffff0000u)};
        wb = (f4){__uint_as_float(c0.z << 16), __uint_as_float(c0.z & 0xffff0000u), __uint_as_float(c0.w << 16), __uint_as_float(c0.w & 0xffff0000u)};
        wc = (f4){__uint_as_float(c1.x << 16), __uint_as_float(c1.x & 0xffff0000u), __uint_as_float(c1.y << 16), __uint_as_float(c1.y & 0xffff0000u)};
        wd = (f4){__uint_as_float(c1.z << 16), __uint_as_float(c1.z & 0xffff0000u), __uint_as_float(c1.w << 16), __uint_as_float(c1.w & 0xffff0000u)};
        int col = n; if (mode == 1) { const int t = n >> 8, r = n & 255; col = r < 128 ? 128 * t + r : (N / 2) + 128 * t + (r - 128); }
        float mine = 0.f;
#pragma unroll
        for (int cls = 0; cls < NCLS; ++cls) { const f4 t4 = sh[cls][0] * wa + sh[cls][1] * wb + sh[cls][2] * wc + sh[cls][3] * wd; float s = (t4[0] + t4[1]) + (t4[2] + t4[3]); s = wave_sum64(s); if (lane == cls) mine = s; }
        if (lane < NCLS) sw[(size_t)lane * N + col] = mine;
    }
}
static_assert(DM == 1024, "sw_job / norm passes assume 1024 = 64 lanes x 16");
typedef float f32x4g __attribute__((ext_vector_type(4)));
__device__ __forceinline__ void phase_norm0(const Params& p, char* lds, int bx, int G) {
    const int tid = tid_opaque(), lane = tid & 63, wave = tid >> 6; constexpr int WLD = DM + 4;
    float* WG = (float*)lds; float* XS = (float*)(lds + 16 * WLD * 4);
    __syncthreads();
    { f4 tv[DM * 4 / NTHREADS];
#pragma unroll
      for (int it = 0; it < DM * 4 / NTHREADS; ++it) { const int k = it * (NTHREADS / 4) + (tid >> 2); tv[it] = *(const f4*)(p.winab + (size_t)k * ABIN + ABMAIN + 4 * (tid & 3)); }
#pragma unroll
      for (int it = 0; it < DM * 4 / NTHREADS; ++it) { const int k = it * (NTHREADS / 4) + (tid >> 2), g0 = 4 * (tid & 3); WG[(g0 + 0) * WLD + k] = tv[it][0]; WG[(g0 + 1) * WLD + k] = tv[it][1]; WG[(g0 + 2) * WLD + k] = tv[it][2]; WG[(g0 + 3) * WLD + k] = tv[it][3]; } }
    const int r = lane & 15, kq = lane >> 4, pair = wave >> 1, kh = wave & 1;
    float* SQ = XS + pair * 32; float* GP = XS + 128 + pair * 256;
    for (int it = 0;; ++it) {
        const int rb0 = (it * G + bx) * (NWAVES / 2); if (rb0 >= MTOK / 16) break;
        const int rb = rb0 + pair; const int row = rb * 16 + r; const int cls = cls_of(rb * 16); const int kb = 512 * kh + 4 * kq;
        const float* xr = xrow(p, row) + kb;
        f4 x[32]; float s = 0.f;
#pragma unroll
        for (int q = 0; q < 32; ++q) x[q] = *(const f4*)(xr + 16 * q);
#pragma unroll
        for (int q = 0; q < 32; ++q) s += (x[q][0] * x[q][0] + x[q][1] * x[q][1]) + (x[q][2] * x[q][2] + x[q][3] * x[q][3]);
        s += swz_xor<16>(s); s = half_sum(s);
        __syncthreads();
        if (kq == 0) SQ[kh * 16 + r] = s;
        __syncthreads();
        const float rs = 1.0f / sqrtf((SQ[r] + SQ[16 + r]) * (1.0f / DM) + EPSF);
        const float* gp = p.n1g + kb; const float* scp = modv(p, 0, cls, 1) + kb; const float* shp = modv(p, 0, cls, 0) + kb; const float* wp = WG + r * WLD + kb;
        bf16_t* xo = (bf16_t*)(p.ws + WS_XN) + (size_t)row * DM + kb;
        f32x4g acc = {0.f, 0.f, 0.f, 0.f};
#pragma unroll
        for (int q = 0; q < 32; ++q) { const f4 gg = *(const f4*)(gp + 16 * q), sc = *(const f4*)(scp + 16 * q), sh = *(const f4*)(shp + 16 * q), w = *(const f4*)(wp + 16 * q);
            const f4 h = x[q] * rs * gg * (sc + 1.0f) + sh;
            u2 o; o.x = pg8::cvt_pk_bf16(h[0], h[1]); o.y = pg8::cvt_pk_bf16(h[2], h[3]); *(u2*)(xo + 16 * q) = o;
            acc = __builtin_amdgcn_mfma_f32_16x16x4f32(h[0], w[0], acc, 0, 0, 0); acc = __builtin_amdgcn_mfma_f32_16x16x4f32(h[1], w[1], acc, 0, 0, 0);
            acc = __builtin_amdgcn_mfma_f32_16x16x4f32(h[2], w[2], acc, 0, 0, 0); acc = __builtin_amdgcn_mfma_f32_16x16x4f32(h[3], w[3], acc, 0, 0, 0); }
        if (kh == 1) *(f32x4g*)(GP + lane * 4) = acc;
        __syncthreads();
        if (kh == 0) { const f32x4g o2 = *(const f32x4g*)(GP + lane * 4); const float bg = p.bgate[r];
#pragma unroll
            for (int e = 0; e < 4; ++e) { float a = acc[e] + o2[e] + bg; if ((r & 7) >= 4) a = logsigmoidf_(a); ((float*)(p.ws + WS_GATES))[(size_t)(rb * 16 + 4 * kq + e) * NGATE + r] = a; } }
    }
}
static_assert(MTOK % 64 == 0 && MC % 16 == 0 && LSEQ % 16 == 0 && DM == 1024, "norm0 row blocks");
__device__ __forceinline__ void phase_conv(const Params& p, char* lds, int ufirst, int ustride) {
    const int tid = tid_opaque(), lane = tid & 63, wave = tid >> 6; constexpr int TT = 32, NR = TT + CWID - 1;
    bf16_t* X = (bf16_t*)lds; float* OUT = (float*)(lds + 65536);
    const int cp = tid & 255, tg = tid >> 8, c0 = 2 * cp;
    float w0[CWID], w1[CWID];
#pragma unroll
    for (int j = 0; j < CWID; ++j) { w0[j] = p.convw[(size_t)j * CCH + c0]; w1[j] = p.convw[(size_t)j * CCH + c0 + 1]; }
    const float b0 = p.convb[c0], b1 = p.convb[c0 + 1];
    const bf16_t* U = (const bf16_t*)(p.ws + WS_UPRE);
    if (ufirst < 0) return;
    for (int u = ufirst; u < MTOK / TT; u += ustride) {
        const int row0 = u * TT, pos0 = pos_of(row0), len = seqlen_of(row0);
        __syncthreads();
        { u4 val[8];
#pragma unroll
          for (int i = 0; i < 8; ++i) { const int c = tid + NTHREADS * i, r = c / (CCH / 8), ch = (c % (CCH / 8)) * 8; const int t = pos0 + r - CWID / 2;
              val[i] = (u4){0u, 0u, 0u, 0u}; if (c < NR * (CCH / 8) && t >= 0 && t < len) val[i] = *(const u4*)(U + (size_t)(row0 + r - CWID / 2) * CCH + ch); }
#pragma unroll
          for (int i = 0; i < 8; ++i) { const int c = tid + NTHREADS * i, r = c / (CCH / 8), ch = (c % (CCH / 8)) * 8; if (c < NR * (CCH / 8)) *(u4*)(X + (size_t)r * CCH + ch) = val[i]; } }
        __syncthreads();
#pragma unroll 2
        for (int tt = 0; tt < TT / 2; ++tt) { const int t = tg * (TT / 2) + tt; float a0 = b0, a1 = b1;
#pragma unroll
            for (int j = 0; j < CWID; ++j) { const unsigned xx = *(const unsigned*)(X + (size_t)(t + j) * CCH + c0); a0 += w0[j] * __uint_as_float(xx << 16); a1 += w1[j] * __uint_as_float(xx & 0xffff0000u); }
            *(float2*)(OUT + (size_t)t * CCH + c0) = make_float2(a0, a1); }
        __syncthreads();
#pragma unroll
        for (int q = 0; q < TT / NWAVES; ++q) { const int t = wave * (TT / NWAVES) + q; const f4 x0 = *(const f4*)(OUT + (size_t)t * CCH + lane * 8), x1 = *(const f4*)(OUT + (size_t)t * CCH + lane * 8 + 4);
            const float mu = wave_sum64((x0[0] + x0[1]) + (x0[2] + x0[3]) + (x1[0] + x1[1]) + (x1[2] + x1[3])) * (1.0f / CCH);
            const f4 d0 = x0 - mu, d1 = x1 - mu;
            const float var = wave_sum64((d0[0] * d0[0] + d0[1] * d0[1]) + (d0[2] * d0[2] + d0[3] * d0[3]) + (d1[0] * d1[0] + d1[1] * d1[1]) + (d1[2] * d1[2] + d1[3] * d1[3])) * (1.0f / CCH);
            const float rs = 1.0f / sqrtf(var + EPSF);
            const f4 g0 = *(const f4*)(p.lng + lane * 8), g1 = *(const f4*)(p.lng + lane * 8 + 4), be0 = *(const f4*)(p.lnb + lane * 8), be1 = *(const f4*)(p.lnb + lane * 8 + 4);
            const f4 y0 = d0 * rs * g0 + be0, y1 = d1 * rs * g1 + be1; u4 w;
            w.x = pg8::cvt_pk_bf16(fsilu(y0[0]), fsilu(y0[1])); w.y = pg8::cvt_pk_bf16(fsilu(y0[2]), fsilu(y0[3])); w.z = pg8::cvt_pk_bf16(fsilu(y1[0]), fsilu(y1[1])); w.w = pg8::cvt_pk_bf16(fsilu(y1[2]), fsilu(y1[3]));
            *(u4*)((bf16_t*)(p.ws + WS_UH) + (size_t)(row0 + t) * DM + lane * 8) = w; }
    }
}
static_assert(CCH == 512 && CSEQ % 32 == 0 && LSEQ % 32 == 0, "conv phase geometry");
__device__ __forceinline__ void phase_cachecvt(const Params& p, int gtid, int gthreads) {
    constexpr int PER = PAST * NKV * HDIM / 8;
    for (int i = gtid; i < NLB * PER; i += gthreads) { const int b = i / PER, e = (i % PER) * 8; const size_t src = (size_t)b * PAST * NKV * HDIM + e, dst = ((size_t)b * SKVL + LSEQ) * NKV * HDIM + e;
        const f4 k0 = *(const f4*)(p.ck + src), k1 = *(const f4*)(p.ck + src + 4), v0 = *(const f4*)(p.cv + src), v1 = *(const f4*)(p.cv + src + 4); u4 wk, wv;
        wk.x = pg8::cvt_pk_bf16(k0[0], k0[1]); wk.y = pg8::cvt_pk_bf16(k0[2], k0[3]); wk.z = pg8::cvt_pk_bf16(k1[0], k1[1]); wk.w = pg8::cvt_pk_bf16(k1[2], k1[3]);
        wv.x = pg8::cvt_pk_bf16(v0[0], v0[1]); wv.y = pg8::cvt_pk_bf16(v0[2], v0[3]); wv.z = pg8::cvt_pk_bf16(v1[0], v1[1]); wv.w = pg8::cvt_pk_bf16(v1[2], v1[3]);
        *(u4*)((bf16_t*)(p.ws + WS_LATK) + dst) = wk; *(u4*)((bf16_t*)(p.ws + WS_LATV) + dst) = wv; }
}
__device__ __forceinline__ void phase_qkpost(const Params& p, int gw, int NGW, int lane) {
    const int hh = lane >> 5, l5 = lane & 31, half = l5 >> 4, f0 = (l5 & 15) * 2, d1 = half * 64 + f0, d2 = d1 + 32;
    const float inv0 = __builtin_amdgcn_exp2f(-(float)f0 * (13.287712379549449f / 32.0f)), inv1 = __builtin_amdgcn_exp2f(-(float)(f0 + 1) * (13.287712379549449f / 32.0f));
    const float qg[4] = {p.qng[d1], p.qng[d1 + 1], p.qng[d2], p.qng[d2 + 1]}, kg[4] = {p.kng[d1], p.kng[d1 + 1], p.kng[d2], p.kng[d2 + 1]};
    for (int row = gw; row < MTOK; row += NGW) {
        const bool lat = row >= MC; const int sp = pos_of(row); float cs0 = 1.f, sn0 = 0.f, cs1 = 1.f, sn1 = 0.f;
        if (lat) { const float pos = (float)(half == 0 ? sp / GRIDW : sp % GRIDW); cs0 = __cosf(pos * inv0); sn0 = __sinf(pos * inv0); cs1 = __cosf(pos * inv1); sn1 = __sinf(pos * inv1); }
        bf16_t* Q = (bf16_t*)(p.ws + WS_QRAW) + (size_t)row * NQ * HDIM; const bf16_t* KR = (const bf16_t*)(p.ws + WS_KRAW) + (size_t)row * NKV * HDIM;
        unsigned ra[NQ / 2 + 1], rb[NQ / 2 + 1];
#pragma unroll
        for (int it = 0; it <= NQ / 2; ++it) { const bf16_t* src = it < NQ / 2 ? Q + (2 * it + hh) * HDIM : KR + hh * HDIM; ra[it] = *(const unsigned*)(src + d1); rb[it] = *(const unsigned*)(src + d2); }
#pragma unroll
        for (int it = 0; it <= NQ / 2; ++it) { const bool isq = it < NQ / 2;
            const float x1a = __uint_as_float(ra[it] << 16), x1b = __uint_as_float(ra[it] & 0xffff0000u), x2a = __uint_as_float(rb[it] << 16), x2b = __uint_as_float(rb[it] & 0xffff0000u);
            float ss = (x1a * x1a + x1b * x1b) + (x2a * x2a + x2b * x2b); ss += swz_xor<1>(ss); ss += swz_xor<2>(ss); ss += swz_xor<4>(ss); ss += swz_xor<8>(ss); ss += swz_xor<16>(ss);
            const float rs = 1.0f / sqrtf(ss * (1.0f / HDIM) + EPSF); const float* g = isq ? qg : kg;
            const float a0 = x1a * rs * g[0], a1 = x1b * rs * g[1], b0 = x2a * rs * g[2], b1 = x2b * rs * g[3];
            const float y1a = a0 * cs0 - b0 * sn0, y2a = a0 * sn0 + b0 * cs0, y1b = a1 * cs1 - b1 * sn1, y2b = a1 * sn1 + b1 * cs1;
            const unsigned w1 = pg8::cvt_pk_bf16(y1a, y1b), w2 = pg8::cvt_pk_bf16(y2a, y2b);
            if (isq) { bf16_t* dst = Q + (2 * it + hh) * HDIM; *(unsigned*)(dst + d1) = w1; *(unsigned*)(dst + d2) = w2; }
            else if (!lat) { bf16_t* K = (bf16_t*)(p.ws + WS_CTXK) + (size_t)row * NKV * HDIM + hh * HDIM; *(unsigned*)(K + d1) = w1; *(unsigned*)(K + d2) = w2;
                float* fo = p.out + O_K + (size_t)row * NKV * HDIM + hh * HDIM; *(float2*)(fo + d1) = make_float2(y1a, y1b); *(float2*)(fo + d2) = make_float2(y2a, y2b); }
            else { const int b_ = (row - MC) / LSEQ, s_ = (row - MC) % LSEQ; bf16_t* K = (bf16_t*)(p.ws + WS_LATK) + ((size_t)b_ * SKVL + s_) * NKV * HDIM + hh * HDIM; *(unsigned*)(K + d1) = w1; *(unsigned*)(K + d2) = w2; } }
    }
}
static_assert(NKV == 2 && NQ % 2 == 0 && HDIM == 128, "qkpost lane mapping");
__device__ __forceinline__ void phase_final(const Params& p, int gw, int NGW, int lane) {
    const f4 g0 = *((const f4*)p.fng + 2 * lane), g1 = *((const f4*)p.fng + 2 * lane + 1), g2 = *((const f4*)p.fng + 128 + 2 * lane), g3 = *((const f4*)p.fng + 128 + 2 * lane + 1);
    const float* sq = (const float*)(p.ws + WS_SSQ) + (size_t)3 * SSQ_STRIDE;
    for (int row = gw; row < MTOK; row += 2 * NGW) { const int row2 = row + NGW; const bool has2 = row2 < MTOK; const int r2 = has2 ? row2 : row;
        const float rsa = 1.0f / sqrtf(sq[row] * (1.0f / DM) + EPSF), rsb = 1.0f / sqrtf(sq[r2] * (1.0f / DM) + EPSF);
        const u4* ya = (const u4*)((const bf16_t*)(p.ws + WS_Y16) + (size_t)row * DM) + lane; const u4* yb = (const u4*)((const bf16_t*)(p.ws + WS_Y16) + (size_t)r2 * DM) + lane;
        const u4 a0 = ya[0], a1 = ya[64], b0 = yb[0], b1 = yb[64];
        f4* oa = (f4*)(p.out + O_Y + (size_t)row * DM) + 2 * lane; f4* ob = (f4*)(p.out + O_Y + (size_t)r2 * DM) + 2 * lane;
#define UNP_LO(V_) (f4){__uint_as_float((V_).x << 16), __uint_as_float((V_).x & 0xffff0000u), __uint_as_float((V_).y << 16), __uint_as_float((V_).y & 0xffff0000u)}
#define UNP_HI(V_) (f4){__uint_as_float((V_).z << 16), __uint_as_float((V_).z & 0xffff0000u), __uint_as_float((V_).w << 16), __uint_as_float((V_).w & 0xffff0000u)}
        oa[0] = UNP_LO(a0) * rsa * g0; oa[1] = UNP_HI(a0) * rsa * g1; oa[128] = UNP_LO(a1) * rsa * g2; oa[129] = UNP_HI(a1) * rsa * g3;
        if (has2) { ob[0] = UNP_LO(b0) * rsb * g0; ob[1] = UNP_HI(b0) * rsb * g1; ob[128] = UNP_LO(b1) * rsb * g2; ob[129] = UNP_HI(b1) * rsb * g3; }
#undef UNP_LO
#undef UNP_HI
    }
}
template <class Epi> __device__ __forceinline__ void gemm_call(LAS unsigned char* lds, const bf16_t* A, const bf16_t* Bt, int N, int K, const Epi& E) {
    pg8::Gemm g{A, Bt, MTOK, N, K}; pg8::StaticOrder S; S.init(MTOK, N, K, (int)gridDim.x, (int)blockIdx.x);
    pg8::gemm_phase<Epi, pg8::StaticOrder, true, true>((PG8_LAS unsigned char*)lds, g, S, E);
}
#ifdef PROBE_A
#define ISTAMP(i) do { if (blockIdx.x == 0 && threadIdx.x == 0 && K == PROBE_K) *(volatile LAS unsigned*)(uintptr_t)(MISC_OFF + 4 * (i)) = (unsigned)__builtin_amdgcn_s_memrealtime(); } while (0)
#else
#define ISTAMP(i) do {} while (0)
#endif
__device__ __forceinline__ void gemm_call_split(LAS unsigned char* lds, const bf16_t* A, const bf16_t* Bt, int N, int K, const EpiRes& E, unsigned char* slab, unsigned* cnt) {
    pg8::Gemm g{A, Bt, MTOK, N, K}; RoundZeroOrder S0; S0.init(MTOK, N, K, (int)gridDim.x, (int)blockIdx.x);
    ISTAMP(0);
    pg8::gemm_phase<EpiRes, RoundZeroOrder, true, true>((PG8_LAS unsigned char*)lds, g, S0, E);
    ISTAMP(1);
    if (S0.split) { QuarterOrder S1; S1.init(MTOK, N, K, (int)gridDim.x, (int)blockIdx.x);
        pg8::gemm_phase<EpiPartial, QuarterOrder, true, true>((PG8_LAS unsigned char*)lds, g, S1, EpiPartial{slab, cnt});
        ISTAMP(2);
        tail_reduce(E, slab, cnt, (int)gridDim.x, (int)blockIdx.x, N / 256, MTOK / 256); ISTAMP(3); }
}
__global__ void __launch_bounds__(NTHREADS, 2) mega_fwd(Params p) {
    extern __shared__ __attribute__((aligned(16))) unsigned char lds[];
    LAS unsigned char* L = (LAS unsigned char*)lds;
    for (int u = threadIdx.x; u < (LDS_BYTES - LDSCTL_OFF) / 4; u += NTHREADS) ((LAS unsigned*)(L + LDSCTL_OFF))[u] = 0u;
    __syncthreads();
    volatile LAS unsigned* MISC = (volatile LAS unsigned*)(L + MISC_OFF);
    const XcdBarrier bar = xcd_barrier_post((unsigned*)(p.ws + WS_CTL) + CW_BAR, MISC + 8);
    const int G = gridDim.x, bx = blockIdx.x; const int vcu = (G % 8 == 0) ? (bx % 8) * (G / 8) + bx / 8 : bx;
    unsigned char* ws = p.ws;
    const bf16_t* XN = (const bf16_t*)(ws + WS_XN); const bf16_t* UH = (const bf16_t*)(ws + WS_UH); const bf16_t* Hh = (const bf16_t*)(ws + WS_H); const bf16_t* Ob = (const bf16_t*)(ws + WS_O);
    float* SW0 = (float*)(ws + WS_SW); float* SWC = SW0 + (size_t)NCLS * 2 * DFF; float* SW1 = SWC + (size_t)NCLS * CIN;
    float* SSQ = (float*)(ws + WS_SSQ); float* Y = p.out + O_Y; unsigned* SPLITC = (unsigned*)(ws + WS_CTL) + CW_SPLIT;
#define WAVE_IDS() const int tid_ = tid_opaque(); const int lane_ = tid_ & 63; const int gw_ = bx * NWAVES + (tid_ >> 6); const int NGW_ = G * NWAVES
    p0_weights(p, L, vcu, G); phase_mod(p, (char*)lds, bx, G);
    xcd_barrier(bar);
    phase_norm0(p, (char*)lds, bx, G);
    xcd_barrier(bar);
    gemm_call(L, XN, (const bf16_t*)(ws + WB_AB), ABMAIN, DM, EpiAB{(bf16_t*)(ws + WS_UPRE), (bf16_t*)(ws + WS_QKVO)}); xcd_barrier(bar);
    ml_phase_A(p, lds, vcu, G);
    { WAVE_IDS(); constexpr int NU_ML = NLB * MH * NBLK + NCB * MH; const int nsecond = (NU_ML > G && NU_ML - G < G) ? NU_ML - G : 0;
      if (vcu >= nsecond) { const int gw2 = (vcu - nsecond) * NWAVES + (tid_ >> 6), ngw2 = (G - nsecond) * NWAVES;
        sw_job(p, (const bf16_t*)(ws + WB_FFI0), 2 * DFF, 0, 3, SW0, 2 * DFF, 1, gw2, ngw2, lane_); sw_job(p, (const bf16_t*)(ws + WB_INC), CIN, 1, 0, SWC, CIN, 0, gw2, ngw2, lane_);
        sw_job(p, (const bf16_t*)(ws + WB_FFI1), 2 * DFF, 1, 3, SW1, 2 * DFF, 1, gw2, ngw2, lane_); } }
    xcd_barrier(bar);
    { WAVE_IDS(); MlScan sc{p}; for (long i = bx * (long)NTHREADS + tid_; i < MlScan::count(); i += (long)G * NTHREADS) sc(i); } xcd_barrier(bar);
    ml_phase_C(p, lds, vcu, G);
    { constexpr int NU_ML = NLB * MH * NBLK + NCB * MH; const int nsecond = NU_ML > G ? NU_ML - G : 0;
      if (nsecond < G) phase_conv(p, (char*)lds, vcu >= nsecond ? vcu - nsecond : -1, G - nsecond); else phase_conv(p, (char*)lds, vcu, G); }
    xcd_barrier(bar);
    gemm_call_split(L, UH, (const bf16_t*)(ws + WB_OUTAB), DM, DM, EpiRes{p.xp, p.xs, (bf16_t*)(ws + WS_Y16), (bf16_t*)(ws + WS_XN), SSQ + 0 * SSQ_STRIDE, modv(p, 0, 0, 2), modv(p, 0, 0, 4), p.n2g, 1, 0}, (unsigned char*)Y, SPLITC + 0 * 4096); xcd_barrier(bar);
    gemm_call(L, XN, (const bf16_t*)(ws + WB_FFI0), 2 * DFF, DM, EpiFfnIn{(bf16_t*)(ws + WS_H), SSQ + 0 * SSQ_STRIDE, SW0}); xcd_barrier(bar);
    gemm_call_split(L, Hh, (const bf16_t*)(ws + WB_FFO0), DM, DFF, EpiRes{p.xp, p.xs, (bf16_t*)(ws + WS_Y16), (bf16_t*)(ws + WS_XN), SSQ + 1 * SSQ_STRIDE, modv(p, 0, 0, 5), modv(p, 1, 0, 1), p.n1g + DM, 0, 0}, (unsigned char*)Y + SLAB_BYTES, SPLITC + 1 * 4096); xcd_barrier(bar);
    gemm_call(L, XN, (const bf16_t*)(ws + WB_INC), CIN, DM, EpiQkv{(bf16_t*)(ws + WS_QRAW), (bf16_t*)(ws + WS_KRAW), (bf16_t*)(ws + WS_CTXV), (bf16_t*)(ws + WS_LATV), p.out + O_V, SSQ + 1 * SSQ_STRIDE, SWC}); xcd_barrier(bar);
    { WAVE_IDS(); phase_qkpost(p, gw_, NGW_, lane_); phase_cachecvt(p, bx * NTHREADS + tid_, G * NTHREADS); } xcd_barrier(bar);
    attn_phase(p, lds, vcu, G); xcd_barrier(bar);
    gemm_call_split(L, Ob, (const bf16_t*)(ws + WB_OUTC), DM, DM, EpiRes{p.xp, p.xs, (bf16_t*)(ws + WS_Y16), (bf16_t*)(ws + WS_XN), SSQ + 2 * SSQ_STRIDE, modv(p, 1, 0, 2), modv(p, 1, 0, 4), p.n2g + DM, 0, 0}, (unsigned char*)Y, SPLITC + 2 * 4096); xcd_barrier(bar);
    gemm_call(L, XN, (const bf16_t*)(ws + WB_FFI1), 2 * DFF, DM, EpiFfnIn{(bf16_t*)(ws + WS_H), SSQ + 2 * SSQ_STRIDE, SW1}); xcd_barrier(bar);
    gemm_call_split(L, Hh, (const bf16_t*)(ws + WB_FFO1), DM, DFF, EpiRes{p.xp, p.xs, (bf16_t*)(ws + WS_Y16), (bf16_t*)(ws + WS_XN), SSQ + 3 * SSQ_STRIDE, modv(p, 1, 0, 5), modv(p, 1, 0, 1), nullptr, 0, 0}, (unsigned char*)Y + SLAB_BYTES, SPLITC + 3 * 4096); xcd_barrier(bar);
    { WAVE_IDS(); phase_final(p, gw_, NGW_, lane_); }
#undef WAVE_IDS
}
static Params make_params(void* const* d_in, void* d_out, void* d_ws) {
    Params p{}; const float** pp = (const float**)&p; for (int i = 0; i < 28; ++i) pp[i] = (const float*)d_in[i];
    p.out = (float*)d_out; p.ws = (unsigned char*)d_ws; return p;
}
extern "C" void kernel_launch(void* const* d_in, const int* in_sizes, int n_in, void* d_out, int out_size, void* d_ws, size_t ws_size, hipStream_t stream) {
    static int grid = 0;
    if (grid == 0) {
        if (n_in != 28 || (size_t)out_size != O_END || ws_size < WS_END || in_sizes[0] != MC * DM || in_sizes[1] != ML * DM) {
            fprintf(stderr, "kernel_launch: shape mismatch n_in %d out %d (want %zu) ws %zu (want %zu)\n", n_in, out_size, (size_t)O_END, ws_size, (size_t)WS_END); grid = -1; return; }
        int dev = 0, cus = 0;
        if (hipGetDevice(&dev) != hipSuccess || hipDeviceGetAttribute(&cus, hipDeviceAttributeMultiprocessorCount, dev) != hipSuccess) { grid = -1; return; }
        if (hipFuncSetAttribute((const void*)mega_fwd, hipFuncAttributeMaxDynamicSharedMemorySize, LDS_BYTES) != hipSuccess) { fprintf(stderr, "hipFuncSetAttribute failed\n"); grid = -1; return; }
        int per_cu = 0; (void)hipOccupancyMaxActiveBlocksPerMultiprocessor(&per_cu, (const void*)mega_fwd, NTHREADS, LDS_BYTES); (void)hipGetLastError();
        if (per_cu < 1) fprintf(stderr, "kernel_launch: occupancy query says %d blocks/CU\n", per_cu);
        grid = cus;
    }
    if (grid < 0) return;
    hipMemsetAsync((char*)d_ws + WS_CTL, 0, CTL_ZERO_BYTES, stream);
    Params p = make_params(d_in, d_out, d_ws);
    hipLaunchKernelGGL(mega_fwd, dim3(grid), dim3(NTHREADS), LDS_BYTES, stream, p);
}
```

```cpp
#ifdef HOST_TEST
#include <cmath>
#include <cstdio>
#include <cstdlib>
#include <cstring>
#include <cstdint>
#include <vector>
#define HD_FN inline
#define DEV_FN inline
#else
#include <hip/hip_runtime.h>
#include <cstdio>
#include <cstdint>
#define HD_FN __host__ __device__ __forceinline__
#define DEV_FN __device__ __forceinline__
#endif

#ifdef TINY
constexpr int DM = 512, NCB = 2, CSEQ = 128, NLB = 2, LSEQ = 128, PAST = 128;
#else
constexpr int DM = 1024, NCB = 16, CSEQ = 256, NLB = 4, LSEQ = 4096, PAST = 256;
#endif
constexpr int GRIDW = 64, CCH = DM / 2, CWID = 31, MH = 4, MDK = CCH / MH, MW = CCH, NGATE = 16;
constexpr int ABIN = 2 * CCH + 4 * MW + NGATE, ABMAIN = 2 * CCH + 4 * MW;
constexpr int HDIM = 128, NQ = DM / HDIM, NKV = 2, GRP = NQ / NKV, CIN = (NQ + 2 * NKV) * HDIM;
constexpr int DFF = ((8 * DM + 3 * 256 - 1) / (3 * 256)) * 256;
constexpr int MC = NCB * CSEQ, ML = NLB * LSEQ, MTOK = MC + ML, NCLS = 1 + NLB, SKVL = LSEQ + PAST;
constexpr float EPSF = 1e-6f;
constexpr int NSEQ = NCB + NLB;

constexpr size_t O_Y = 0, O_C = (size_t)MTOK * DM, O_N = O_C + (size_t)NCB * 2 * MH * MDK * MDK, O_M = O_N + (size_t)NCB * 2 * MH * MDK,
                 O_K = O_M + (size_t)NCB * 2 * MH, O_V = O_K + (size_t)NCB * CSEQ * NKV * HDIM, O_END = O_V + (size_t)NCB * CSEQ * NKV * HDIM;

constexpr size_t MiB = 1u << 20;
#ifdef TINY
constexpr size_t WSCALE = 1;
#endif
constexpr size_t WS_CTL = 0, CTL_ZERO_BYTES = 1 * MiB;
constexpr size_t WS_MOD = 1 * MiB;
constexpr size_t WS_SW = WS_MOD + 256 * 1024;
constexpr size_t WS_SSQ = 512 * 1024;
constexpr int SSQ_STRIDE = 32768;
constexpr size_t WS_DEN = 232 * MiB;
constexpr size_t WS_WB = 2 * MiB;
constexpr size_t WS_XN = 50 * MiB;
constexpr size_t WS_UPRE = 90 * MiB;
constexpr size_t WS_QKVO = 110 * MiB;
constexpr size_t WS_UH = 190 * MiB;
constexpr size_t WS_GATES = 230 * MiB;
constexpr size_t WS_HS = 50 * MiB;
constexpr size_t WS_Y16 = 90 * MiB;
constexpr size_t WS_H = 130 * MiB;
constexpr size_t WS_QRAW = 130 * MiB;
constexpr size_t WS_LATK = 170 * MiB, WS_LATV = 179 * MiB, WS_CTXK = 188 * MiB, WS_CTXV = 190 * MiB;
constexpr size_t WS_KRAW = 192 * MiB;
constexpr size_t WS_O = 202 * MiB;
constexpr size_t WS_END = 256 * MiB;

typedef unsigned short bf16_t;
HD_FN float bf2f(bf16_t h) { unsigned u = (unsigned)h << 16; return __builtin_bit_cast(float, u); }
HD_FN bf16_t f2bf(float f) { unsigned u = __builtin_bit_cast(unsigned, f); return (bf16_t)((u + 0x7fffu + ((u >> 16) & 1u)) >> 16); }
HD_FN float rbf(float f) { return bf2f(f2bf(f)); }
HD_FN float sigmoidf_(float x) { return 1.0f / (1.0f + expf(-x)); }
HD_FN float siluf_(float x) { return x * sigmoidf_(x); }
HD_FN float logsigmoidf_(float x) { return x >= 0.f ? -log1pf(expf(-x)) : x - log1pf(expf(x)); }
HD_FN int cls_of(int row) { return row < MC ? 0 : 1 + (row - MC) / LSEQ; }
HD_FN int seqlen_of(int row) { return row < MC ? CSEQ : LSEQ; }
HD_FN int pos_of(int row) { return row < MC ? row % CSEQ : (row - MC) % LSEQ; }

struct Params {
    const float *xp, *xs, *c, *stC, *stn, *stm, *ck, *cv, *cctx, *wmod, *bmod, *n1g, *n2g, *winab, *bgate, *convw, *convb, *lng, *lnb, *mng,
        *woutab, *winc, *qng, *kng, *woutc, *wffi, *wffo, *fng;
    float* out; unsigned char* ws;
};
HD_FN const float* xrow(const Params& p, int row) { return row < MC ? p.xp + (size_t)row * DM : p.xs + (size_t)(row - MC) * DM; }
HD_FN const float* modv(const Params& p, int l, int cls, int which) { return (const float*)(p.ws + WS_MOD) + ((size_t)(l * NCLS + cls) * 6 + which) * DM; }
constexpr size_t WS_RS0 = 233 * MiB;

struct NMod {
    Params p; static HD_FN long count() { return 2L * NCLS * 6 * DM; }
    HD_FN void operator()(long idx) const {
        const int col = (int)(idx % (6 * DM)); const int cls = (int)((idx / (6 * DM)) % NCLS); const int l = (int)(idx / (6 * DM * NCLS));
        const float* cond = cls == 0 ? p.cctx : p.c + (size_t)(cls - 1) * DM;
        const float* w = p.wmod + (size_t)l * DM * 6 * DM;
        float acc = 0.f;
        for (int k = 0; k < DM; ++k) acc += siluf_(cond[k]) * w[(size_t)k * 6 * DM + col];
        ((float*)(p.ws + WS_MOD))[idx] = acc + p.bmod[(size_t)l * 6 * DM + col];
    }
};
struct NNorm0a {
    Params p; static HD_FN long count() { return MTOK; }
    HD_FN void operator()(long row) const {
        const float* x = xrow(p, (int)row); float s = 0.f;
        for (int k = 0; k < DM; ++k) s += x[k] * x[k];
        ((float*)(p.ws + WS_RS0))[row] = 1.0f / sqrtf(s / DM + EPSF);
    }
};
struct NNorm0b {
    Params p; static HD_FN long count() { return (long)MTOK * DM; }
    HD_FN void operator()(long idx) const {
        const int row = (int)(idx / DM), col = (int)(idx % DM), cls = cls_of(row);
        const float rs = ((const float*)(p.ws + WS_RS0))[row];
        const float v = xrow(p, row)[col] * rs * p.n1g[col] * (1.f + modv(p, 0, cls, 1)[col]) + modv(p, 0, cls, 0)[col];
        ((bf16_t*)(p.ws + WS_XN))[idx] = f2bf(v);
    }
};
struct NGates {
    Params p; static HD_FN long count() { return (long)MTOK * NGATE; }
    HD_FN void operator()(long idx) const {
        const int row = (int)(idx / NGATE), j = (int)(idx % NGATE), cls = cls_of(row);
        const float rs = ((const float*)(p.ws + WS_RS0))[row]; const float* x = xrow(p, row);
        const float* sc = modv(p, 0, cls, 1); const float* sh = modv(p, 0, cls, 0);
        float acc = 0.f;
        for (int k = 0; k < DM; ++k) { const float h = x[k] * rs * p.n1g[k] * (1.f + sc[k]) + sh[k]; acc += h * p.winab[(size_t)k * ABIN + ABMAIN + j]; }
        acc += p.bgate[j];
        if ((j & 7) >= 4) acc = logsigmoidf_(acc);
        ((float*)(p.ws + WS_GATES))[idx] = acc;
    }
};

template <bool DUAL, class Epi> struct NGemm {
    const bf16_t* A; const float* B; int lda, ldb, K, N, off2, pad_; Epi epi;
    HD_FN long count() const { return (long)(MTOK / 4) * (N / 4); }
    HD_FN void operator()(long idx) const {
        const int nt = (int)(idx % (N / 4)), mt = (int)(idx / (N / 4)); const int m0 = mt * 4, n0 = nt * 4;
        float acc[4][4], acc2[4][4];
#pragma unroll
        for (int i = 0; i < 4; ++i)
#pragma unroll
            for (int j = 0; j < 4; ++j) { acc[i][j] = 0.f; acc2[i][j] = 0.f; }
        for (int k0 = 0; k0 < K; k0 += 8) {
            float a[4][8];
#pragma unroll
            for (int i = 0; i < 4; ++i) {
                const bf16_t* ap = A + (size_t)(m0 + i) * lda + k0;
#pragma unroll
                for (int kk = 0; kk < 8; ++kk) a[i][kk] = bf2f(ap[kk]);
            }
#pragma unroll
            for (int kk = 0; kk < 8; ++kk) {
                const float* bp = B + (size_t)(k0 + kk) * ldb + n0;
                float b[4], b2[4];
#pragma unroll
                for (int j = 0; j < 4; ++j) { b[j] = rbf(bp[j]); b2[j] = DUAL ? rbf(bp[off2 + j]) : 0.f; }
#pragma unroll
                for (int i = 0; i < 4; ++i)
#pragma unroll
                    for (int j = 0; j < 4; ++j) { acc[i][j] += a[i][kk] * b[j]; if (DUAL) acc2[i][j] += a[i][kk] * b2[j]; }
            }
        }
#pragma unroll
        for (int i = 0; i < 4; ++i)
#pragma unroll
            for (int j = 0; j < 4; ++j) epi(m0 + i, n0 + j, acc[i][j], acc2[i][j]);
    }
};
struct EGlu { Params p; HD_FN void operator()(int row, int col, float v, float v2) const { ((bf16_t*)(p.ws + WS_UPRE))[(size_t)row * CCH + col] = f2bf(v * sigmoidf_(v2)); } };
struct EQkvo { Params p; HD_FN void operator()(int row, int col, float v, float) const {
        const int part = col / MW; if (part == 1) v *= 1.0f / sqrtf((float)MDK); if (part == 3) v = sigmoidf_(v);
        ((bf16_t*)(p.ws + WS_QKVO))[(size_t)row * 4 * MW + col] = f2bf(v); } };
struct EOut { Params p; int l; int pad_ = 0; HD_FN void operator()(int row, int col, float v, float) const {
        const int cls = cls_of(row); float* Y = p.out + O_Y + (size_t)row * DM + col;
        const float xin = l == 0 ? xrow(p, row)[col] : *Y;
        const float x1 = xin + modv(p, l, cls, 2)[col] * v; *Y = x1;
        ((bf16_t*)(p.ws + WS_XN))[(size_t)row * DM + col] = f2bf(x1 * p.n2g[(size_t)l * DM + col] * (1.f + modv(p, l, cls, 4)[col])); } };
struct EFfnIn { Params p; const float* sw; int slot; int pad_ = 0; HD_FN void operator()(int row, int col, float v, float v2) const {
        const int cls = cls_of(row); const float rs = 1.0f / sqrtf(((const float*)(p.ws + WS_SSQ))[(size_t)slot * SSQ_STRIDE + row] / DM + EPSF);
        const float a = v * rs + sw[(size_t)cls * 2 * DFF + col], b = v2 * rs + sw[(size_t)cls * 2 * DFF + DFF + col];
        ((bf16_t*)(p.ws + WS_H))[(size_t)row * DFF + col] = f2bf(siluf_(a) * b); } };
struct EFfnOut { Params p; int l; int pad_ = 0; HD_FN void operator()(int row, int col, float v, float) const {
        const int cls = cls_of(row); float* Y = p.out + O_Y + (size_t)row * DM + col;
        const float x2 = *Y + modv(p, l, cls, 5)[col] * v; *Y = x2;
        if (l == 0) ((bf16_t*)(p.ws + WS_XN))[(size_t)row * DM + col] = f2bf(x2 * p.n1g[(size_t)DM + col] * (1.f + modv(p, 1, cls, 1)[col])); } };
struct EQkv { Params p; const float* sw; int slot; int pad_ = 0; HD_FN void operator()(int row, int col, float v, float) const {
        const int cls = cls_of(row); const float rs = 1.0f / sqrtf(((const float*)(p.ws + WS_SSQ))[(size_t)slot * SSQ_STRIDE + row] / DM + EPSF);
        const float a = v * rs + sw[(size_t)cls * CIN + col];
        if (col < NQ * HDIM) ((bf16_t*)(p.ws + WS_QRAW))[(size_t)row * NQ * HDIM + col] = f2bf(a);
        else if (col < (NQ + NKV) * HDIM) ((bf16_t*)(p.ws + WS_KRAW))[(size_t)row * NKV * HDIM + (col - NQ * HDIM)] = f2bf(a);
        else { const int c2 = col - (NQ + NKV) * HDIM;
            if (row < MC) { ((bf16_t*)(p.ws + WS_CTXV))[(size_t)row * NKV * HDIM + c2] = f2bf(a); p.out[O_V + (size_t)row * NKV * HDIM + c2] = a; }
            else { const int b = (row - MC) / LSEQ, s = (row - MC) % LSEQ; ((bf16_t*)(p.ws + WS_LATV))[((size_t)b * SKVL + s) * NKV * HDIM + c2] = f2bf(a); } } } };

struct NSsq {
    Params p; int slot; int pad_ = 0; static HD_FN long count() { return MTOK; }
    HD_FN void operator()(long row) const { const float* y = p.out + O_Y + (size_t)row * DM; float s = 0.f; for (int k = 0; k < DM; ++k) s += y[k] * y[k];
        ((float*)(p.ws + WS_SSQ))[(size_t)slot * SSQ_STRIDE + row] = s; }
};
struct NSW {
    Params p; const float* W; float* sw; int l, which, N, pad_; HD_FN long count() const { return (long)NCLS * N; }
    HD_FN void operator()(long idx) const { const int n = (int)(idx % N), cls = (int)(idx / N); const float* sh = modv(p, l, cls, which); float acc = 0.f;
        for (int k = 0; k < DM; ++k) acc += sh[k] * rbf(W[(size_t)k * N + n]); sw[idx] = acc; }
};
struct NConv {
    Params p; static HD_FN long count() { return (long)MTOK * CCH; }
    HD_FN void operator()(long idx) const {
        const int row = (int)(idx / CCH), c = (int)(idx % CCH), pos = pos_of(row), len = seqlen_of(row);
        const bf16_t* U = (const bf16_t*)(p.ws + WS_UPRE); float acc = p.convb[c];
        for (int j = 0; j < CWID; ++j) { const int t = pos + j - CWID / 2; if (t >= 0 && t < len) acc += p.convw[(size_t)j * CCH + c] * bf2f(U[(size_t)(row + j - CWID / 2) * CCH + c]); }
        ((float*)(p.ws + WS_HS))[idx] = acc;
    }
};
struct NConvLN {
    Params p; static HD_FN long count() { return MTOK; }
    HD_FN void operator()(long row) const {
        const float* t = (const float*)(p.ws + WS_HS) + (size_t)row * CCH; float mu = 0.f;
        for (int c = 0; c < CCH; ++c) mu += t[c]; mu /= CCH; float var = 0.f;
        for (int c = 0; c < CCH; ++c) { const float d = t[c] - mu; var += d * d; } var /= CCH;
        const float rs = 1.0f / sqrtf(var + EPSF); bf16_t* UH = (bf16_t*)(p.ws + WS_UH) + (size_t)row * DM;
        for (int c = 0; c < CCH; ++c) UH[c] = f2bf(siluf_((t[c] - mu) * rs * p.lng[c] + p.lnb[c]));
    }
};
HD_FN int seq_base(int sid) { return sid < NCB ? sid * CSEQ : MC + (sid - NCB) * LSEQ; }
struct NMlstmDen {
    Params p; static HD_FN long count() { return (long)NSEQ * MH * 2; }
    HD_FN void operator()(long idx) const {
        const int dir = (int)(idx % 2), h = (int)((idx / 2) % MH), sid = (int)(idx / (2 * MH)); const bool isctx = sid < NCB;
        const int base = seq_base(sid), len = isctx ? CSEQ : LSEQ;
        float n[MDK]; float mrun = 0.f;
        if (isctx) {
#pragma unroll
            for (int d = 0; d < MDK; ++d) n[d] = 0.f;
        } else { const int b = sid - NCB; const float em = expf(p.stm[(size_t)(b * 2 + dir) * MH + h]);
#pragma unroll
            for (int d = 0; d < MDK; ++d) n[d] = p.stn[((size_t)(b * 2 + dir) * MH + h) * MDK + d] * em; }
        const bf16_t* QK = (const bf16_t*)(p.ws + WS_QKVO); const float* G = (const float*)(p.ws + WS_GATES); float* DEN = (float*)(p.ws + WS_DEN);
        for (int t = 0; t < len; ++t) {
            const int row = base + (dir == 0 ? t : len - 1 - t);
            const float ig = G[(size_t)row * NGATE + dir * 8 + h], lf = G[(size_t)row * NGATE + dir * 8 + 4 + h];
            const float f = expf(lf), ei = expf(ig); mrun = fmaxf(mrun + lf, ig);
            const bf16_t* q = QK + (size_t)row * 4 * MW + h * MDK; const bf16_t* k = q + MW; float den = 0.f;
#pragma unroll
            for (int d = 0; d < MDK; ++d) { n[d] = f * n[d] + ei * bf2f(k[d]); den += bf2f(q[d]) * n[d]; }
            DEN[((size_t)dir * MTOK + row) * MH + h] = den;
        }
        if (isctx) { const float em = expf(-mrun); p.out[O_M + (size_t)(sid * 2 + dir) * MH + h] = mrun;
#pragma unroll
            for (int d = 0; d < MDK; ++d) p.out[O_N + ((size_t)(sid * 2 + dir) * MH + h) * MDK + d] = n[d] * em; }
    }
};
struct NMlstmNum {
    Params p; int dir; int pad_ = 0; static HD_FN long count() { return (long)NSEQ * MH * MDK; }
    HD_FN void operator()(long idx) const {
        const int v = (int)(idx % MDK), h = (int)((idx / MDK) % MH), sid = (int)(idx / (MDK * MH)); const bool isctx = sid < NCB;
        const int base = seq_base(sid), len = isctx ? CSEQ : LSEQ;
        float C[MDK];
        if (isctx) {
#pragma unroll
            for (int d = 0; d < MDK; ++d) C[d] = 0.f;
        } else { const int b = sid - NCB; const float em = expf(p.stm[(size_t)(b * 2 + dir) * MH + h]);
#pragma unroll
            for (int d = 0; d < MDK; ++d) C[d] = p.stC[(((size_t)(b * 2 + dir) * MH + h) * MDK + d) * MDK + v] * em; }
        const bf16_t* QK = (const bf16_t*)(p.ws + WS_QKVO); const float* G = (const float*)(p.ws + WS_GATES); const float* DEN = (const float*)(p.ws + WS_DEN);
        float* HS = (float*)(p.ws + WS_HS);
        for (int t = 0; t < len; ++t) {
            const int row = base + (dir == 0 ? t : len - 1 - t);
            const float ig = G[(size_t)row * NGATE + dir * 8 + h], lf = G[(size_t)row * NGATE + dir * 8 + 4 + h];
            const float f = expf(lf), ei = expf(ig);
            const bf16_t* q = QK + (size_t)row * 4 * MW + h * MDK; const bf16_t* k = q + MW; const float vv = bf2f(q[2 * MW + v]) * ei; float num = 0.f;
#pragma unroll
            for (int d = 0; d < MDK; ++d) { C[d] = f * C[d] + bf2f(k[d]) * vv; num += bf2f(q[d]) * C[d]; }
            const float den = DEN[((size_t)dir * MTOK + row) * MH + h]; const float hv = num / fmaxf(fabsf(den), 1.0f);
            float* o = HS + (size_t)row * MW + h * MDK + v; if (dir == 0) *o = hv; else *o += hv;
        }
        if (isctx) { const float em = expf(-p.out[O_M + (size_t)(sid * 2 + dir) * MH + h]);
#pragma unroll
            for (int d = 0; d < MDK; ++d) p.out[O_C + (((size_t)(sid * 2 + dir) * MH + h) * MDK + d) * MDK + v] = C[d] * em; }
    }
};
struct NHm {
    Params p; static HD_FN long count() { return (long)MTOK * MH; }
    HD_FN void operator()(long idx) const {
        const int row = (int)(idx / MH), h = (int)(idx % MH); const float* x = (const float*)(p.ws + WS_HS) + (size_t)row * MW + h * MDK; float s = 0.f;
        for (int v = 0; v < MDK; ++v) s += x[v] * x[v];
        const float rs = 1.0f / sqrtf(s / MDK + EPSF); const bf16_t* og = (const bf16_t*)(p.ws + WS_QKVO) + (size_t)row * 4 * MW + 3 * MW + h * MDK;
        bf16_t* UH = (bf16_t*)(p.ws + WS_UH) + (size_t)row * DM + CCH + h * MDK;
        for (int v = 0; v < MDK; ++v) UH[v] = f2bf(bf2f(og[v]) * x[v] * rs * p.mng[h * MDK + v]);
    }
};
struct NCacheCvt {
    Params p; static HD_FN long count() { return (long)NLB * PAST * NKV * HDIM; }
    HD_FN void operator()(long idx) const { const int e = (int)(idx % (NKV * HDIM)), pp = (int)((idx / (NKV * HDIM)) % PAST), b = (int)(idx / ((long)NKV * HDIM * PAST));
        const size_t dst = ((size_t)b * SKVL + LSEQ + pp) * NKV * HDIM + e;
        ((bf16_t*)(p.ws + WS_LATK))[dst] = f2bf(p.ck[idx]); ((bf16_t*)(p.ws + WS_LATV))[dst] = f2bf(p.cv[idx]); }
};
struct NQkPost {
    Params p; static HD_FN long count() { return (long)MTOK * (NQ + NKV); }
    HD_FN void operator()(long idx) const {
        const int row = (int)(idx / (NQ + NKV)), j = (int)(idx % (NQ + NKV)); const bool isq = j < NQ; const bool lat = row >= MC;
        bf16_t* src = isq ? (bf16_t*)(p.ws + WS_QRAW) + (size_t)row * NQ * HDIM + j * HDIM : (bf16_t*)(p.ws + WS_KRAW) + (size_t)row * NKV * HDIM + (j - NQ) * HDIM;
        const float* g = isq ? p.qng : p.kng; float s = 0.f;
        for (int d = 0; d < HDIM; ++d) { const float x = bf2f(src[d]); s += x * x; }
        const float rs = 1.0f / sqrtf(s / HDIM + EPSF);
        bf16_t* dst; float* fo = nullptr;
        if (isq) dst = src;
        else if (!lat) { dst = (bf16_t*)(p.ws + WS_CTXK) + (size_t)row * NKV * HDIM + (j - NQ) * HDIM; fo = p.out + O_K + (size_t)row * NKV * HDIM + (j - NQ) * HDIM; }
        else { const int b = (row - MC) / LSEQ, sp = (row - MC) % LSEQ; dst = (bf16_t*)(p.ws + WS_LATK) + ((size_t)b * SKVL + sp) * NKV * HDIM + (j - NQ) * HDIM; }
        const int sp = pos_of(row); const float prow = (float)(sp / GRIDW), pcol = (float)(sp % GRIDW);
        for (int half = 0; half < 2; ++half)
            for (int d = 0; d < HDIM / 4; ++d) {
                const int i1 = half * (HDIM / 2) + d, i2 = i1 + HDIM / 4;
                const float x1 = bf2f(src[i1]) * rs * g[i1], x2 = bf2f(src[i2]) * rs * g[i2]; float y1 = x1, y2 = x2;
                if (lat) { const float inv = powf(10000.0f, -(float)d / (float)(HDIM / 4)); const float ang = (half == 0 ? prow : pcol) * inv; const float cs = cosf(ang), sn = sinf(ang);
                    y1 = x1 * cs - x2 * sn; y2 = x1 * sn + x2 * cs; }
                dst[i1] = f2bf(y1); dst[i2] = f2bf(y2); if (fo) { fo[i1] = y1; fo[i2] = y2; }
            }
    }
};
struct NAttn {
    Params p; static HD_FN long count() { return (long)MTOK * NQ * 4; }
    HD_FN void operator()(long idx) const {
        const int sl = (int)(idx % 4), hq = (int)((idx / 4) % NQ), row = (int)(idx / (4 * NQ)); const int kv = hq / GRP;
        const bf16_t *Kb, *Vb; int nk;
        if (row < MC) { const int b = row / CSEQ; Kb = (const bf16_t*)(p.ws + WS_CTXK) + (size_t)b * CSEQ * NKV * HDIM; Vb = (const bf16_t*)(p.ws + WS_CTXV) + (size_t)b * CSEQ * NKV * HDIM; nk = CSEQ; }
        else { const int b = (row - MC) / LSEQ; Kb = (const bf16_t*)(p.ws + WS_LATK) + (size_t)b * SKVL * NKV * HDIM; Vb = (const bf16_t*)(p.ws + WS_LATV) + (size_t)b * SKVL * NKV * HDIM; nk = SKVL; }
        const bf16_t* qp = (const bf16_t*)(p.ws + WS_QRAW) + (size_t)row * NQ * HDIM + hq * HDIM;
        float q[HDIM];
#pragma unroll
        for (int d = 0; d < HDIM; ++d) q[d] = bf2f(qp[d]);
        float o[32];
#pragma unroll
        for (int e = 0; e < 32; ++e) o[e] = 0.f;
        float m = -1e30f, l = 0.f; const float scale = 1.0f / sqrtf((float)HDIM);
        for (int s = 0; s < nk; ++s) {
            const bf16_t* kp = Kb + (size_t)s * NKV * HDIM + kv * HDIM; float dot = 0.f;
#pragma unroll
            for (int d = 0; d < HDIM; ++d) dot += q[d] * bf2f(kp[d]);
            dot *= scale; const float mn = fmaxf(m, dot); const float al = expf(m - mn), pe = expf(dot - mn); m = mn; l = l * al + pe;
            const bf16_t* vp = Vb + (size_t)s * NKV * HDIM + kv * HDIM + sl * 32;
#pragma unroll
            for (int e = 0; e < 32; ++e) o[e] = o[e] * al + pe * bf2f(vp[e]);
        }
        bf16_t* op = (bf16_t*)(p.ws + WS_O) + (size_t)row * DM + hq * HDIM + sl * 32;
#pragma unroll
        for (int e = 0; e < 32; ++e) op[e] = f2bf(o[e] / l);
    }
};
struct NFinal {
    Params p; static HD_FN long count() { return (long)MTOK * DM; }
    HD_FN void operator()(long idx) const { const int row = (int)(idx / DM), col = (int)(idx % DM);
        const float rs = 1.0f / sqrtf(((const float*)(p.ws + WS_SSQ))[(size_t)3 * SSQ_STRIDE + row] / DM + EPSF); p.out[O_Y + idx] *= rs * p.fng[col]; }
};
constexpr int NWAVES = 8, NTHREADS = NWAVES * 64;
constexpr int RING_OFF = 0, RING_BYTES = 131072;
constexpr int LDSCTL_OFF = RING_BYTES, MISC_OFF = LDSCTL_OFF + 320;
constexpr int LDS_BYTES = 147456;
constexpr int CW_TMO = 0, CW_CODE = 1, CW_BAR = 4096;
__device__ __forceinline__ int tid_opaque() { int t = threadIdx.x; asm volatile("" : "+v"(t)); return t; }
template <int M> __device__ __forceinline__ float swz_xor(float v) { return __int_as_float(__builtin_amdgcn_ds_swizzle(__float_as_int(v), (M << 10) | 0x1f)); }
__device__ __forceinline__ float half_sum(float v) { auto rr = __builtin_amdgcn_permlane32_swap(__float_as_uint(v), __float_as_uint(v), false, false); return __uint_as_float(rr[0]) + __uint_as_float(rr[1]); }
__device__ __forceinline__ float half_max(float v) { auto rr = __builtin_amdgcn_permlane32_swap(__float_as_uint(v), __float_as_uint(v), false, false); return fmaxf(__uint_as_float(rr[0]), __uint_as_float(rr[1])); }
__device__ __forceinline__ float lane_get(float v, int src_lane) { return __int_as_float(__builtin_amdgcn_ds_bpermute(src_lane << 2, __float_as_int(v))); }
#define GAS __attribute__((address_space(1)))
#define LAS __attribute__((address_space(3)))
typedef GAS unsigned gu32;
#define RLX_AGENT __ATOMIC_RELAXED, __HIP_MEMORY_SCOPE_AGENT
#define XB_TMO      128
#define XB_XCNT(j)  (256  + 64 * (j))
#define XB_XSUB(j)  (1280 + 64 * (j))
#define XB_XGEN(j)  (2304 + 64 * (j))
#define XB_TOP      3328
#define XB_TOPGEN   3392
#define XCD_BAR_WORDS 3456
#define XB_SPIN_CAP (1u << 22)
__device__ __forceinline__ unsigned xb_ld(unsigned* p)              { return __hip_atomic_load(p, __ATOMIC_RELAXED, __HIP_MEMORY_SCOPE_AGENT); }
__device__ __forceinline__ unsigned xb_add(unsigned* p, unsigned v) { return __hip_atomic_fetch_add(p, v, __ATOMIC_RELAXED, __HIP_MEMORY_SCOPE_AGENT); }
__device__ __forceinline__ unsigned xb_xcc_id() { return (unsigned)__builtin_amdgcn_s_getreg((3 << 11) | 20) & 0xFu; }
#define XB_SPIN(cond, bar) do { unsigned _sp = 0; while (cond) { __builtin_amdgcn_s_sleep(1); \
    if ((++_sp & 255u) == 0u) { if (xb_ld(&(bar)[XB_TMO])) break; if (_sp > XB_SPIN_CAP) { atomicAdd(&(bar)[XB_TMO], 1u); break; } } } } while (0)
struct XcdBarrier { unsigned* bar; unsigned x; volatile LAS unsigned* st; };
__device__ __forceinline__ XcdBarrier xcd_barrier_post(unsigned* bar, volatile LAS unsigned* st) {
    XcdBarrier b; b.bar = bar; b.x = xb_xcc_id(); b.st = st;
    if (threadIdx.x == 0) (void)xb_add(&bar[XB_XCNT(b.x)], 1u);
    return b;
}
__device__ __forceinline__ void xcd_barrier_complete(unsigned* bar, unsigned x, unsigned& nloc, unsigned& nx) {
    const unsigned G = gridDim.x * gridDim.y * gridDim.z;
    unsigned sum, cnt, mine, sp = 0u;
    for (;;) {
        sum = 0u; cnt = 0u; mine = 0u;
#pragma unroll
        for (unsigned j = 0; j < 16; ++j) { const unsigned c = xb_ld(&bar[XB_XCNT(j)]); sum += c; cnt += (c > 0u) ? 1u : 0u; mine = (j == x) ? c : mine; }
        if (sum == G) break;
        __builtin_amdgcn_s_sleep(1);
        if ((++sp & 255u) == 0u) { if (xb_ld(&bar[XB_TMO])) break; if (sp > XB_SPIN_CAP) { atomicAdd(&bar[XB_TMO], 1u); break; } }
    }
    nloc = mine > 0u ? mine : 1u; nx = cnt > 0u ? cnt : 1u;
}
__device__ __forceinline__ void xcd_barrier(const XcdBarrier& b) {
    asm volatile("s_waitcnt vmcnt(0)" ::: "memory");
    __syncthreads();
    if (threadIdx.x == 0) {
        unsigned* bar = b.bar;
        __builtin_amdgcn_s_waitcnt(0);
        unsigned nloc = b.st[0], nx = b.st[1];
        if (nloc == 0u) { xcd_barrier_complete(bar, b.x, nloc, nx); b.st[0] = nloc; b.st[1] = nx; }
        const unsigned old = xb_add(&bar[XB_XSUB(b.x)], 1u);
        const unsigned gen = old / nloc;
        if (old + 1u == (gen + 1u) * nloc) {
            __builtin_amdgcn_fence(__ATOMIC_RELEASE, "agent");
            asm volatile("s_waitcnt vmcnt(0)" ::: "memory");
            const unsigned og = xb_add(&bar[XB_TOP], 1u);
            const unsigned tg = og / nx;
            if (og + 1u == (tg + 1u) * nx) xb_add(&bar[XB_TOPGEN], 1u);
            else XB_SPIN(xb_ld(&bar[XB_TOPGEN]) == tg, bar);
            __builtin_amdgcn_fence(__ATOMIC_ACQUIRE, "agent");
            xb_add(&bar[XB_XGEN(b.x)], 1u);
            asm volatile("s_waitcnt vmcnt(0)" ::: "memory");
        } else {
            XB_SPIN(xb_ld(&bar[XB_XGEN(b.x)]) == gen, bar);
            __builtin_amdgcn_fence(__ATOMIC_ACQUIRE, "agent");
            asm volatile("s_waitcnt vmcnt(0)" ::: "memory");
        }
    }
    __syncthreads();
}
namespace pg8 {
#define PG8_LAS __attribute__((address_space(3)))
typedef unsigned short bf16_t;
typedef short bf16x8 __attribute__((ext_vector_type(8)));
typedef float f32x4 __attribute__((ext_vector_type(4)));
typedef unsigned u32x4 __attribute__((ext_vector_type(4)));
constexpr int BM = 256, BK = 64, HALF = 128, HTB = HALF * BK * 2  , STAGE_BYTES = 8 * HTB, NXCD = 8, WGM = 8;

__host__ __device__ __forceinline__ int lds_byte(int r, int c) { const int st = (r >> 4) * 2 + (c >> 5), rr = r & 15, cc = c & 31, ob = rr * 64 + cc * 2; return st * 1024 + (ob ^ (((ob >> 9) & 1) << 5)); }
__host__ __device__ __forceinline__ void stage_rc(int b, int& R, int& C) { const int st = b / 1024, sb = b % 1024, swz = sb ^ (((sb >> 9) & 1) << 5); R = (st >> 1) * 16 + swz / 64; C = (st & 1) * 32 + (swz % 64) / 2; }
__host__ __device__ __forceinline__ int perm32(int rho) { const int n = rho >> 4, i = rho & 15; return 8 * (i >> 2) + 4 * n + (i & 3); }

struct Unit { int pm, pn, k0, nt, role, slot; };
struct Gemm { const bf16_t* A; const bf16_t* Bt; int M, N, K; };

struct StaticOrder {
    int nM, nN, nwg, G, c, ntK;
    __host__ __device__ void init(int M, int N, int K, int G_, int c_) { nM = M / BM; nN = N / BM; nwg = nM * nN; G = G_; c = c_; ntK = K / BK; }
    __host__ __device__ void map(int L, Unit& u) const { int wgid = L; { const int q = nwg / NXCD, r = nwg % NXCD, xcd = wgid % NXCD, off = wgid / NXCD; wgid = (xcd < r ? xcd * (q + 1) : r * (q + 1) + (xcd - r) * q) + off; }
        const int nig = WGM * nN, gid = wgid / nig, fm = gid * WGM, gsz = (nM - fm) < WGM ? (nM - fm) : WGM; u.pm = fm + ((wgid % nig) % gsz); u.pn = (wgid % nig) / gsz; }
    __host__ __device__ bool next(int i, Unit& u) const {
        const long L = (long)i * G + c; if (L >= nwg) return false;
        int wgid = (int)L; { const int q = nwg / NXCD, r = nwg % NXCD, xcd = wgid % NXCD, off = wgid / NXCD; wgid = (xcd < r ? xcd * (q + 1) : r * (q + 1) + (xcd - r) * q) + off; }
        const int nig = WGM * nN, gid = wgid / nig, fm = gid * WGM, gsz = (nM - fm) < WGM ? (nM - fm) : WGM;
        u.pm = fm + ((wgid % nig) % gsz); u.pn = (wgid % nig) / gsz; u.k0 = 0; u.nt = ntK; u.role = 0; u.slot = 0; return true;
    }
    __device__ __forceinline__ void a_ready(const Unit&) const {}
    __device__ __forceinline__ void done(const Unit&) const {}
};

__device__ __forceinline__ unsigned cvt_pk_bf16(float lo, float hi) { unsigned r; asm volatile("v_cvt_pk_bf16_f32 %0, %1, %2" : "=v"(r) : "v"(lo), "v"(hi)); return r; }
typedef float f32x2 __attribute__((ext_vector_type(2)));
template <class Epi, class Sched, bool ALIGN_EPI = false, bool SP2 = false>
__device__ __forceinline__ void gemm_phase(PG8_LAS unsigned char* lds, const Gemm g, const Sched& S, const Epi& E) {
    const int tid = tid_opaque(), wid = __builtin_amdgcn_readfirstlane(tid >> 6), lane = tid & 63, wr = wid >> 2, wc = wid & 3, fr = lane & 15, fq = lane >> 4;
    const int K = g.K;
    unsigned voffA[2], voffB[2];
#pragma unroll
    for (int i = 0; i < 2; ++i) { int R, C; stage_rc(tid * 16 + i * 8192, R, C); const int Rb = Epi::PERM ? ((R & ~31) + perm32(R & 31)) : R;
        voffA[i] = (unsigned)(R * K + C) * 2u; voffB[i] = (unsigned)(Rb * K + C) * 2u; }
    const size_t kstep = (size_t)(BK * 2);
    const size_t hstep = (size_t)HALF * K * 2;
    const size_t tstep = 2 * hstep;
    const unsigned ldsw = (unsigned)wid * 1024u;
    const int aoff = lds_byte(wr * 64 + fr, fq * 8), boff = lds_byte(wc * 32 + fr, fq * 8);
#define PG8_SA(b, h) (((b) * 2 + (h)) * HTB)
#define PG8_SB(b, h) ((4 + (b) * 2 + (h)) * HTB)
#define PG8_STAGE(bufoff, gbase, voff) do { _Pragma("unroll") for (int _i = 0; _i < 2; ++_i) \
        __builtin_amdgcn_global_load_lds((const unsigned*)((const char*)(gbase) + (voff)[_i]), (PG8_LAS unsigned*)(lds + (bufoff) + ldsw + _i * 8192), 16, 0, 0); } while (0)
#define PG8_LDA(dst, b, h) do { _Pragma("unroll") for (int m = 0; m < 4; ++m) _Pragma("unroll") for (int k = 0; k < 2; ++k) dst[m][k] = *(const PG8_LAS bf16x8*)(lds + PG8_SA(b, h) + aoff + m * 2048 + k * 1024); } while (0)
#define PG8_LDB(dst, b, h) do { _Pragma("unroll") for (int n = 0; n < 2; ++n) _Pragma("unroll") for (int k = 0; k < 2; ++k) dst[n][k] = *(const PG8_LAS bf16x8*)(lds + PG8_SB(b, h) + boff + n * 2048 + k * 1024); } while (0)
#define PG8_MMA(ai, bj, At, Bt) do { __builtin_amdgcn_s_setprio(1); _Pragma("unroll") for (int m = 0; m < 4; ++m) _Pragma("unroll") for (int n = 0; n < 2; ++n) _Pragma("unroll") for (int k = 0; k < 2; ++k) \
        acc[ai][bj][m][n] = __builtin_amdgcn_mfma_f32_16x16x32_bf16(Bt[n][k], At[m][k], acc[ai][bj][m][n], 0, 0, 0); __builtin_amdgcn_s_setprio(0); } while (0)
#define PG8_WAIT_V(n) asm volatile("s_waitcnt vmcnt(" #n ")" ::: "memory")
#define PG8_WAIT_L(n) asm volatile("s_waitcnt lgkmcnt(" #n ")" ::: "memory")
#define PG8_BAR __builtin_amdgcn_s_barrier()
#define PG8_SCHED __builtin_amdgcn_sched_barrier(0)
    Unit cur, nxt; int ui = 0;
    if (!S.next(0, cur)) return;
    f32x4 acc[2][2][4][2];
#pragma unroll
    for (int a = 0; a < 2; ++a)
#pragma unroll
        for (int b = 0; b < 2; ++b)
#pragma unroll
            for (int m = 0; m < 4; ++m)
#pragma unroll
                for (int n = 0; n < 2; ++n) acc[a][b][m][n] = (f32x4){0.f, 0.f, 0.f, 0.f};
    bf16x8 At[4][2], B0[2][2], B1[2][2];
    const char* cA = (const char*)g.A + (size_t)cur.pm * tstep + (size_t)cur.k0 * kstep; const char* cB = (const char*)g.Bt + (size_t)cur.pn * tstep + (size_t)cur.k0 * kstep; int nt = cur.nt;
    S.a_ready(cur);
    if constexpr (SP2) {
        PG8_STAGE(PG8_SB(0, 0), cB, voffB); PG8_STAGE(PG8_SB(0, 1), cB + hstep, voffB); PG8_STAGE(PG8_SA(0, 0), cA, voffA); PG8_STAGE(PG8_SA(0, 1), cA + hstep, voffA);
        if (wr == 1) PG8_BAR;
        PG8_WAIT_V(2); PG8_BAR;
        PG8_STAGE(PG8_SB(1, 0), cB + kstep, voffB); PG8_STAGE(PG8_SA(1, 0), cA + kstep, voffA); PG8_STAGE(PG8_SB(1, 1), cB + hstep + kstep, voffB);
        PG8_WAIT_V(6); PG8_BAR;
    } else {
        PG8_STAGE(PG8_SB(0, 0), cB, voffB); PG8_STAGE(PG8_SA(0, 0), cA, voffA); PG8_STAGE(PG8_SB(0, 1), cB + hstep, voffB); PG8_STAGE(PG8_SA(0, 1), cA + hstep, voffA);
        if (wr == 1) PG8_BAR;
        PG8_WAIT_V(4); PG8_BAR;
        PG8_STAGE(PG8_SB(1, 0), cB + kstep, voffB); PG8_STAGE(PG8_SA(1, 0), cA + kstep, voffA); PG8_STAGE(PG8_SB(1, 1), cB + hstep + kstep, voffB);
        PG8_WAIT_V(6); PG8_BAR;
    }
    for (;;) {
        const bool has_next = S.next(ui + 1, nxt);
        const char* nA = has_next ? (const char*)g.A + (size_t)nxt.pm * tstep + (size_t)nxt.k0 * kstep : cA; const char* nB = has_next ? (const char*)g.Bt + (size_t)nxt.pn * tstep + (size_t)nxt.k0 * kstep : cB;
        for (int t = 0; t < nt; t += 2) {
            const bool last = (t == nt - 2);
            const char* a1 = cA + (size_t)(t + 1) * kstep;
            const char* a2 = last ? nA : cA + (size_t)(t + 2) * kstep; const char* b2 = last ? nB : cB + (size_t)(t + 2) * kstep;
            const char* a3 = a2 + kstep; const char* b3 = b2 + kstep;
            if (last && has_next) S.a_ready(nxt);
            if constexpr (SP2) {
            PG8_LDB(B0, 0, 0); PG8_LDB(B1, 0, 1); PG8_SCHED; PG8_LDA(At, 0, 0); PG8_STAGE(PG8_SA(1, 1), a1 + hstep, voffA);
            PG8_WAIT_V(8); PG8_WAIT_L(0); PG8_BAR; PG8_MMA(0, 0, At, B0); PG8_MMA(0, 1, At, B1); PG8_BAR; PG8_SCHED;
            PG8_LDA(At, 0, 1); PG8_STAGE(PG8_SB(0, 0), b2, voffB); PG8_STAGE(PG8_SB(0, 1), b2 + hstep, voffB); PG8_STAGE(PG8_SA(0, 0), a2, voffA);
            PG8_WAIT_V(8); PG8_WAIT_L(0); PG8_BAR; PG8_MMA(1, 0, At, B0); PG8_MMA(1, 1, At, B1); PG8_BAR; PG8_SCHED;
            PG8_LDB(B0, 1, 0); PG8_LDB(B1, 1, 1); PG8_SCHED; PG8_LDA(At, 1, 0); PG8_STAGE(PG8_SA(0, 1), a2 + hstep, voffA);
            PG8_WAIT_V(8); PG8_WAIT_L(0); PG8_BAR; PG8_MMA(0, 0, At, B0); PG8_MMA(0, 1, At, B1); PG8_BAR; PG8_SCHED;
            PG8_LDA(At, 1, 1); PG8_STAGE(PG8_SB(1, 0), b3, voffB); PG8_STAGE(PG8_SB(1, 1), b3 + hstep, voffB); PG8_STAGE(PG8_SA(1, 0), a3, voffA);
            PG8_WAIT_V(8); PG8_WAIT_L(0); PG8_BAR; PG8_MMA(1, 0, At, B0); PG8_MMA(1, 1, At, B1); PG8_BAR; PG8_SCHED;
            } else {
            PG8_LDB(B0, 0, 0); PG8_SCHED; PG8_LDA(At, 0, 0); PG8_STAGE(PG8_SA(1, 1), a1 + hstep, voffA);
            PG8_WAIT_L(8); PG8_BAR; PG8_WAIT_L(0); PG8_MMA(0, 0, At, B0); PG8_BAR; PG8_SCHED;
            PG8_LDB(B1, 0, 1); PG8_STAGE(PG8_SB(0, 0), b2, voffB);
            PG8_BAR; PG8_WAIT_L(0); PG8_MMA(0, 1, At, B1); PG8_BAR;
            PG8_LDA(At, 0, 1); PG8_STAGE(PG8_SA(0, 0), a2, voffA);
            PG8_BAR; PG8_WAIT_L(0); PG8_MMA(1, 0, At, B0); PG8_BAR; PG8_SCHED;
            PG8_STAGE(PG8_SB(0, 1), b2 + hstep, voffB);
            PG8_WAIT_V(6); PG8_BAR; PG8_MMA(1, 1, At, B1); PG8_BAR;
            PG8_LDB(B0, 1, 0); PG8_SCHED; PG8_LDA(At, 1, 0); PG8_STAGE(PG8_SA(0, 1), a2 + hstep, voffA);
            PG8_WAIT_L(8); PG8_BAR; PG8_WAIT_L(0); PG8_MMA(0, 0, At, B0); PG8_BAR; PG8_SCHED;
            PG8_LDB(B1, 1, 1); PG8_STAGE(PG8_SB(1, 0), b3, voffB);
            PG8_BAR; PG8_WAIT_L(0); PG8_MMA(0, 1, At, B1); PG8_BAR;
            PG8_LDA(At, 1, 1); PG8_STAGE(PG8_SA(1, 0), a3, voffA);
            PG8_BAR; PG8_WAIT_L(0); PG8_MMA(1, 0, At, B0); PG8_BAR; PG8_SCHED;
            PG8_STAGE(PG8_SB(1, 1), b3 + hstep, voffB);
            PG8_WAIT_V(6); PG8_BAR; PG8_MMA(1, 1, At, B1); PG8_BAR;
            }
        }
        if constexpr (ALIGN_EPI) { if (wr == 0) PG8_BAR; }
        if constexpr (!Epi::AFTER_DRAIN) { E(acc, cur, wr, wc, fr, fq); S.done(cur); }
        if (!has_next) break;
#pragma unroll
        for (int a = 0; a < 2; ++a)
#pragma unroll
            for (int b = 0; b < 2; ++b)
#pragma unroll
                for (int m = 0; m < 4; ++m)
#pragma unroll
                    for (int n = 0; n < 2; ++n) acc[a][b][m][n] = (f32x4){0.f, 0.f, 0.f, 0.f};
        cur = nxt; cA = nA; cB = nB; nt = cur.nt; ++ui;
        if constexpr (ALIGN_EPI) { if (wr == 1) PG8_BAR; }
    }
    PG8_WAIT_V(0);
    if constexpr (!ALIGN_EPI) { if (wr == 0) PG8_BAR; }
    PG8_BAR;
    if constexpr (Epi::AFTER_DRAIN) { E.fused(acc, cur, wr, wc, fr, fq, lds, wid, lane); S.done(cur); }
#undef PG8_SA
#undef PG8_SB
#undef PG8_STAGE
#undef PG8_LDA
#undef PG8_LDB
#undef PG8_MMA
#undef PG8_WAIT_V
#undef PG8_WAIT_L
#undef PG8_BAR
#undef PG8_SCHED
}
}
constexpr size_t WB_AB = 2 * MiB, WB_OUTAB = 8 * MiB, WB_FFI0 = 10 * MiB, WB_FFO0 = 21 * MiB, WB_INC = 27 * MiB, WB_OUTC = 30 * MiB, WB_FFI1 = 32 * MiB, WB_FFO1 = 43 * MiB;
static_assert(WB_FFO1 + (size_t)DM * DFF * 2 <= WS_XN && WB_AB + (size_t)ABMAIN * DM * 2 <= WB_OUTAB && WB_FFI0 + (size_t)2 * DFF * DM * 2 <= WB_FFO0 && WB_FFO0 + (size_t)DM * DFF * 2 <= WB_INC &&
              WB_INC + (size_t)CIN * DM * 2 <= WB_OUTC && WB_FFI1 + (size_t)2 * DFF * DM * 2 <= WB_FFO1, "weight copy map");

typedef unsigned v4u __attribute__((ext_vector_type(4)));
typedef unsigned v2u __attribute__((ext_vector_type(2)));
typedef float f32x4 __attribute__((ext_vector_type(4)));
__device__ __forceinline__ unsigned pk2(float lo, float hi) { return (unsigned)f2bf(lo) | ((unsigned)f2bf(hi) << 16); }
__device__ __forceinline__ float fsigmoid(float x) { return __builtin_amdgcn_rcpf(1.0f + __builtin_amdgcn_exp2f(-1.4426950408889634f * x)); }

__device__ __forceinline__ void p0_transpose_item(const float* W, int K, int ldw, int c0, int k0, bf16_t* WT, int drow, LAS float* scr, int lane) {
    { f32x4 tv[8]; const int rr = lane >> 3, cg = (lane & 7) * 4;
#pragma unroll
      for (int i = 0; i < 8; ++i) tv[i] = *(const f32x4*)(W + (size_t)(k0 + 8 * i + rr) * ldw + c0 + cg);
#pragma unroll
      for (int i = 0; i < 8; ++i) { LAS float* d = scr + (8 * i + rr) * 33 + cg; d[0] = tv[i][0]; d[1] = tv[i][1]; d[2] = tv[i][2]; d[3] = tv[i][3]; } }
    asm volatile("s_waitcnt lgkmcnt(0)" ::: "memory");
    const int c = lane & 7;
#pragma unroll
    for (int j = 0; j < 4; ++j) { const int n = (lane >> 3) + 8 * j; const LAS float* s = scr + (8 * c) * 33 + n;
        v4u o; o.x = pk2(s[0 * 33], s[1 * 33]); o.y = pk2(s[2 * 33], s[3 * 33]); o.z = pk2(s[4 * 33], s[5 * 33]); o.w = pk2(s[6 * 33], s[7 * 33]);
        *(GAS v4u*)(WT + (size_t)(drow + n) * K + k0 + 8 * c) = o; }
    asm volatile("s_waitcnt lgkmcnt(0)" ::: "memory");
}
struct CvtJob { const float* W; bf16_t* WT; int K, ldw, c0, ncols, mode, Hn, dbase; };
__device__ __forceinline__ int cvt_items(const CvtJob& j) { return (j.K / 64) * (j.ncols / 32); }
__device__ __forceinline__ void cvt_run(const CvtJob& j, int item, LAS float* scr, int lane) {
    const int nblk = j.ncols / 32, kb = item / nblk, nb = item % nblk; const int c = j.c0 + 32 * nb;
    int drow; if (j.mode == 0) drow = j.dbase + 32 * nb; else { const int cc = c < j.Hn ? c : c - j.Hn; drow = 256 * (cc / 128) + (cc % 128) + (c < j.Hn ? 0 : 128); }
    p0_transpose_item(j.W, j.K, j.ldw, c, 64 * kb, j.WT, drow, scr, lane);
}
__device__ __forceinline__ void p0_weights(const Params& p, LAS unsigned char* lds, int vcu, int G) {
    const int tid_ = tid_opaque(); const int lane = tid_ & 63, wave = __builtin_amdgcn_readfirstlane(tid_ >> 6);
    LAS float* scr = (LAS float*)(lds + wave * 16384);
    const int gw = vcu * NWAVES + wave, NGW = G * NWAVES;
    CvtJob jobs[9] = {
        {p.winab, (bf16_t*)(p.ws + WB_AB), DM, ABIN, 0, 2 * CCH, 1, CCH, 0},
        {p.winab, (bf16_t*)(p.ws + WB_AB), DM, ABIN, 2 * CCH, 4 * MW, 0, 0, 2 * CCH},
        {p.woutab, (bf16_t*)(p.ws + WB_OUTAB), DM, DM, 0, DM, 0, 0, 0},
        {p.wffi, (bf16_t*)(p.ws + WB_FFI0), DM, 2 * DFF, 0, 2 * DFF, 1, DFF, 0},
        {p.wffo, (bf16_t*)(p.ws + WB_FFO0), DFF, DM, 0, DM, 0, 0, 0},
        {p.winc, (bf16_t*)(p.ws + WB_INC), DM, CIN, 0, CIN, 0, 0, 0},
        {p.woutc, (bf16_t*)(p.ws + WB_OUTC), DM, DM, 0, DM, 0, 0, 0},
        {p.wffi + (size_t)DM * 2 * DFF, (bf16_t*)(p.ws + WB_FFI1), DM, 2 * DFF, 0, 2 * DFF, 1, DFF, 0},
        {p.wffo + (size_t)DFF * DM, (bf16_t*)(p.ws + WB_FFO1), DFF, DM, 0, DM, 0, 0, 0}};
    int base = 0;
#pragma unroll
    for (int jj = 0; jj < 9; ++jj) {
        const int n = cvt_items(jobs[jj]);
        int first = ((gw - base) % NGW + NGW) % NGW;
        for (int it = first; it < n; it += NGW) cvt_run(jobs[jj], it, scr, lane);
        base += n;
    }
}

struct EpiAB {
    static constexpr bool PERM = true, AFTER_DRAIN = false;
    bf16_t* upre; bf16_t* qkvo;
    __device__ __forceinline__ void operator()(const f32x4 (&acc)[2][2][4][2], const pg8::Unit& u, int wr, int wc, int fr, int fq) const {
        const int row0 = u.pm * 256 + wr * 64 + fr, lc = wc * 32 + 8 * fq;
        if (u.pn < 4) {
#pragma unroll
            for (int ai = 0; ai < 2; ++ai)
#pragma unroll
                for (int m = 0; m < 4; ++m) { const f32x4 a0 = acc[ai][0][m][0], a1 = acc[ai][0][m][1], g0 = acc[ai][1][m][0], g1 = acc[ai][1][m][1]; v4u w;
                    w.x = pg8::cvt_pk_bf16(a0[0] * fsigmoid(g0[0]), a0[1] * fsigmoid(g0[1])); w.y = pg8::cvt_pk_bf16(a0[2] * fsigmoid(g0[2]), a0[3] * fsigmoid(g0[3]));
                    w.z = pg8::cvt_pk_bf16(a1[0] * fsigmoid(g1[0]), a1[1] * fsigmoid(g1[1])); w.w = pg8::cvt_pk_bf16(a1[2] * fsigmoid(g1[2]), a1[3] * fsigmoid(g1[3]));
                    *(v4u*)(upre + (size_t)(row0 + ai * 128 + m * 16) * CCH + 128 * u.pn + lc) = w; }
        } else {
#pragma unroll
            for (int bj = 0; bj < 2; ++bj) { const int col = 256 * (u.pn - 4) + 128 * bj + lc; const int part = col / MW; const float sc = part == 1 ? 0.08838834764831845f : 1.0f;
#pragma unroll
                for (int ai = 0; ai < 2; ++ai)
#pragma unroll
                    for (int m = 0; m < 4; ++m) { f32x4 v0 = acc[ai][bj][m][0] * sc, v1 = acc[ai][bj][m][1] * sc;
                        if (part == 3) { v0 = (f32x4){fsigmoid(v0[0]), fsigmoid(v0[1]), fsigmoid(v0[2]), fsigmoid(v0[3])}; v1 = (f32x4){fsigmoid(v1[0]), fsigmoid(v1[1]), fsigmoid(v1[2]), fsigmoid(v1[3])}; }
                        v4u w; w.x = pg8::cvt_pk_bf16(v0[0], v0[1]); w.y = pg8::cvt_pk_bf16(v0[2], v0[3]); w.z = pg8::cvt_pk_bf16(v1[0], v1[1]); w.w = pg8::cvt_pk_bf16(v1[2], v1[3]);
                        *(v4u*)(qkvo + (size_t)(row0 + ai * 128 + m * 16) * (4 * MW) + col) = w; } }
        }
    }
};
static_assert(MDK == 128, "EpiAB hard-codes MDK^-0.5");
struct EpiRes {
    static constexpr bool PERM = true, AFTER_DRAIN = false;
    const float* xp; const float* xs;
    bf16_t* Y16; bf16_t* XN; float* ssq; const float* mod_g; const float* mod_sc; const float* ng;
    int from_input; int pad_;
    __device__ __forceinline__ float piece(int row, int col, int cls, f32x4 v0, f32x4 v1) const {
        const float* gv = mod_g + (size_t)cls * 6 * DM + col; const size_t off = (size_t)row * DM + col; f32x4 x0, x1;
        if (from_input) { const float* xin = (row < MC ? xp : xs - (size_t)MC * DM) + off; x0 = *(const f32x4*)xin; x1 = *(const f32x4*)(xin + 4); }
        else { const v4u r = *(const v4u*)(Y16 + off); x0 = (f32x4){__uint_as_float(r.x << 16), __uint_as_float(r.x & 0xffff0000u), __uint_as_float(r.y << 16), __uint_as_float(r.y & 0xffff0000u)};
            x1 = (f32x4){__uint_as_float(r.z << 16), __uint_as_float(r.z & 0xffff0000u), __uint_as_float(r.w << 16), __uint_as_float(r.w & 0xffff0000u)}; }
        x0 += *(const f32x4*)gv * v0; x1 += *(const f32x4*)(gv + 4) * v1;
        v4u w; w.x = pg8::cvt_pk_bf16(x0[0], x0[1]); w.y = pg8::cvt_pk_bf16(x0[2], x0[3]); w.z = pg8::cvt_pk_bf16(x1[0], x1[1]); w.w = pg8::cvt_pk_bf16(x1[2], x1[3]); *(v4u*)(Y16 + off) = w;
        if (ng) { const float* scv = mod_sc + (size_t)cls * 6 * DM + col; const f32x4 t0 = x0 * (*(const f32x4*)(ng + col) * (*(const f32x4*)scv + 1.0f)), t1 = x1 * (*(const f32x4*)(ng + col + 4) * (*(const f32x4*)(scv + 4) + 1.0f));
            v4u q; q.x = pg8::cvt_pk_bf16(t0[0], t0[1]); q.y = pg8::cvt_pk_bf16(t0[2], t0[3]); q.z = pg8::cvt_pk_bf16(t1[0], t1[1]); q.w = pg8::cvt_pk_bf16(t1[2], t1[3]); *(v4u*)(XN + off) = q; }
        return ((x0[0] * x0[0] + x0[1] * x0[1]) + (x0[2] * x0[2] + x0[3] * x0[3])) + ((x1[0] * x1[0] + x1[1] * x1[1]) + (x1[2] * x1[2] + x1[3] * x1[3]));
    }
    __device__ __forceinline__ void operator()(const f32x4 (&acc)[2][2][4][2], const pg8::Unit& u, int wr, int wc, int fr, int fq) const {
        const int row0 = u.pm * 256 + wr * 64 + fr; const int cls = cls_of(u.pm * 256); const int colb = u.pn * 256 + wc * 32 + 8 * fq;
        f32x4 g4[2][2], gs4[2][2];
#pragma unroll
        for (int bj = 0; bj < 2; ++bj)
#pragma unroll
            for (int n = 0; n < 2; ++n) { const int col = colb + bj * 128 + 4 * n; g4[bj][n] = *(const f32x4*)(mod_g + (size_t)cls * 6 * DM + col);
                gs4[bj][n] = ng ? *(const f32x4*)(ng + col) * (*(const f32x4*)(mod_sc + (size_t)cls * 6 * DM + col) + 1.0f) : (f32x4){0.f, 0.f, 0.f, 0.f}; }
        if (from_input) run_rows<2>(acc, row0, colb, g4, gs4); else run_rows<4>(acc, row0, colb, g4, gs4);
    }
    template <int MB> __device__ __forceinline__ void run_rows(const f32x4 (&acc)[2][2][4][2], int row0, int colb, const f32x4 (&g4)[2][2], const f32x4 (&gs4)[2][2]) const {
#pragma unroll
        for (int ai = 0; ai < 2; ++ai)
#pragma unroll
            for (int mb = 0; mb < 4; mb += MB) {
                f32x4 x[MB][2][2];
                if (from_input) {
#pragma unroll
                    for (int mm = 0; mm < MB; ++mm)
#pragma unroll
                        for (int bj = 0; bj < 2; ++bj) { const int row = row0 + ai * 128 + (mb + mm) * 16; const float* xin = (row < MC ? xp : xs - (size_t)MC * DM) + (size_t)row * DM + colb + bj * 128; x[mm][bj][0] = *(const f32x4*)xin; x[mm][bj][1] = *(const f32x4*)(xin + 4); }
                } else { v4u r[MB][2];
#pragma unroll
                    for (int mm = 0; mm < MB; ++mm)
#pragma unroll
                        for (int bj = 0; bj < 2; ++bj) r[mm][bj] = *(const v4u*)(Y16 + (size_t)(row0 + ai * 128 + (mb + mm) * 16) * DM + colb + bj * 128);
#pragma unroll
                    for (int mm = 0; mm < MB; ++mm)
#pragma unroll
                        for (int bj = 0; bj < 2; ++bj) { const v4u q = r[mm][bj]; x[mm][bj][0] = (f32x4){__uint_as_float(q.x << 16), __uint_as_float(q.x & 0xffff0000u), __uint_as_float(q.y << 16), __uint_as_float(q.y & 0xffff0000u)};
                            x[mm][bj][1] = (f32x4){__uint_as_float(q.z << 16), __uint_as_float(q.z & 0xffff0000u), __uint_as_float(q.w << 16), __uint_as_float(q.w & 0xffff0000u)}; }
                }
#pragma unroll
                for (int mm = 0; mm < MB; ++mm) { const int m = mb + mm; const int row = row0 + ai * 128 + m * 16; float s = 0.f;
#pragma unroll
                    for (int bj = 0; bj < 2; ++bj) { const size_t off = (size_t)row * DM + colb + bj * 128;
                        const f32x4 x0 = x[mm][bj][0] + g4[bj][0] * acc[ai][bj][m][0], x1 = x[mm][bj][1] + g4[bj][1] * acc[ai][bj][m][1];
                        v4u w; w.x = pg8::cvt_pk_bf16(x0[0], x0[1]); w.y = pg8::cvt_pk_bf16(x0[2], x0[3]); w.z = pg8::cvt_pk_bf16(x1[0], x1[1]); w.w = pg8::cvt_pk_bf16(x1[2], x1[3]); *(v4u*)(Y16 + off) = w;
                        if (ng) { const f32x4 t0 = x0 * gs4[bj][0], t1 = x1 * gs4[bj][1]; v4u q; q.x = pg8::cvt_pk_bf16(t0[0], t0[1]); q.y = pg8::cvt_pk_bf16(t0[2], t0[3]); q.z = pg8::cvt_pk_bf16(t1[0], t1[1]); q.w = pg8::cvt_pk_bf16(t1[2], t1[3]); *(v4u*)(XN + off) = q; }
                        s += ((x0[0] * x0[0] + x0[1] * x0[1]) + (x0[2] * x0[2] + x0[3] * x0[3])) + ((x1[0] * x1[0] + x1[1] * x1[1]) + (x1[2] * x1[2] + x1[3] * x1[3])); }
                    s += __shfl_xor(s, 16); s += __shfl_xor(s, 32); if (fq_() == 0) atomicAdd(ssq + row, s); }
                asm volatile("" ::: "memory");
            }
    }
    __device__ __forceinline__ static int fq_() { return (threadIdx.x >> 4) & 3; }
};
struct EpiFfnIn {
    static constexpr bool PERM = true, AFTER_DRAIN = false;
    bf16_t* H; const float* ssq; const float* sw;
    __device__ __forceinline__ void operator()(const f32x4 (&acc)[2][2][4][2], const pg8::Unit& u, int wr, int wc, int fr, int fq) const {
        const int row0 = u.pm * 256 + wr * 64 + fr, lc = wc * 32 + 8 * fq; const int cls = cls_of(u.pm * 256); const int col = 128 * u.pn + lc;
        const float* swr = sw + (size_t)cls * 2 * DFF;
        const f32x4 sg0 = *(const f32x4*)(swr + col), sg1 = *(const f32x4*)(swr + col + 4), su0 = *(const f32x4*)(swr + DFF + col), su1 = *(const f32x4*)(swr + DFF + col + 4);
#pragma unroll
        for (int ai = 0; ai < 2; ++ai)
#pragma unroll
            for (int m = 0; m < 4; ++m) { const int row = row0 + ai * 128 + m * 16; const float rs = 1.0f / sqrtf(ssq[row] * (1.0f / DM) + EPSF);
                const f32x4 a0 = acc[ai][0][m][0] * rs + sg0, a1 = acc[ai][0][m][1] * rs + sg1, b0 = acc[ai][1][m][0] * rs + su0, b1 = acc[ai][1][m][1] * rs + su1; v4u w;
                w.x = pg8::cvt_pk_bf16(a0[0] * fsigmoid(a0[0]) * b0[0], a0[1] * fsigmoid(a0[1]) * b0[1]); w.y = pg8::cvt_pk_bf16(a0[2] * fsigmoid(a0[2]) * b0[2], a0[3] * fsigmoid(a0[3]) * b0[3]);
                w.z = pg8::cvt_pk_bf16(a1[0] * fsigmoid(a1[0]) * b1[0], a1[1] * fsigmoid(a1[1]) * b1[1]); w.w = pg8::cvt_pk_bf16(a1[2] * fsigmoid(a1[2]) * b1[2], a1[3] * fsigmoid(a1[3]) * b1[3]);
                *(v4u*)(H + (size_t)row * DFF + col) = w; }
    }
};
struct EpiQkv {
    static constexpr bool PERM = true, AFTER_DRAIN = false;
    bf16_t* qraw; bf16_t* kraw; bf16_t* ctxv; bf16_t* latv; float* outv; const float* ssq; const float* sw;
    __device__ __forceinline__ void operator()(const f32x4 (&acc)[2][2][4][2], const pg8::Unit& u, int wr, int wc, int fr, int fq) const {
        const int row0 = u.pm * 256 + wr * 64 + fr, lc = wc * 32 + 8 * fq; const int cls = cls_of(u.pm * 256); const float* swr = sw + (size_t)cls * CIN;
        float rs[2][4];
#pragma unroll
        for (int ai = 0; ai < 2; ++ai)
#pragma unroll
            for (int m = 0; m < 4; ++m) rs[ai][m] = 1.0f / sqrtf(ssq[row0 + ai * 128 + m * 16] * (1.0f / DM) + EPSF);
#pragma unroll
        for (int bj = 0; bj < 2; ++bj) { const int col = 256 * u.pn + 128 * bj + lc; const f32x4 s0 = *(const f32x4*)(swr + col), s1 = *(const f32x4*)(swr + col + 4);
#pragma unroll
            for (int ai = 0; ai < 2; ++ai)
#pragma unroll
                for (int m = 0; m < 4; ++m) { const int row = row0 + ai * 128 + m * 16; const f32x4 v0 = acc[ai][bj][m][0] * rs[ai][m] + s0, v1 = acc[ai][bj][m][1] * rs[ai][m] + s1;
                    v4u w; w.x = pg8::cvt_pk_bf16(v0[0], v0[1]); w.y = pg8::cvt_pk_bf16(v0[2], v0[3]); w.z = pg8::cvt_pk_bf16(v1[0], v1[1]); w.w = pg8::cvt_pk_bf16(v1[2], v1[3]);
                    if (u.pn < NQ * HDIM / 256) *(v4u*)(qraw + (size_t)row * (NQ * HDIM) + col) = w;
                    else if (u.pn == NQ * HDIM / 256) *(v4u*)(kraw + (size_t)row * (NKV * HDIM) + (col - NQ * HDIM)) = w;
                    else { const int c2 = col - (NQ + NKV) * HDIM;
                        if (row < MC) { *(v4u*)(ctxv + (size_t)row * (NKV * HDIM) + c2) = w; float* o = outv + (size_t)row * (NKV * HDIM) + c2; *(f32x4*)o = v0; *(f32x4*)(o + 4) = v1; }
                        else { const int b = (row - MC) / LSEQ, s = (row - MC) % LSEQ; *(v4u*)(latv + ((size_t)b * SKVL + s) * (NKV * HDIM) + c2) = w; } } } }
    }
};
static_assert(NKV * HDIM == 256 && (NQ * HDIM) % 256 == 0, "EpiQkv tile mapping");

constexpr int CW_SPLIT = 8192;
constexpr size_t SLAB_BYTES = (size_t)64 * 4 * 16 * 512 * 16;
struct RoundZeroOrder : pg8::StaticOrder {
    bool split;
    __device__ void init(int M, int N, int K, int G_, int c_) { pg8::StaticOrder::init(M, N, K, G_, c_); split = (G == 256 && nwg > 256 && nwg <= 320 && ntK >= 8); }
    __device__ bool next(int i, pg8::Unit& u) const { if (split && i > 0) return false; return pg8::StaticOrder::next(i, u); }
};
struct QuarterOrder : pg8::StaticOrder {
    __device__ bool next(int i, pg8::Unit& u) const {
        if (i > 0) return false; const int L = 256 + (c >> 2), q = c & 3; if (L >= nwg) return false;
        map(L, u); const int base = (ntK / 8) * 2, rem = (ntK - 4 * base) / 2;
        int k0 = 0; for (int j = 0; j < q; ++j) k0 += base + (j < rem ? 2 : 0);
        u.k0 = k0; u.nt = base + (q < rem ? 2 : 0); u.role = 1 + q; u.slot = c >> 2; return true;
    }
};
struct EpiPartial {
    static constexpr bool PERM = true, AFTER_DRAIN = false;
    unsigned char* slab; unsigned* cnt;
    __device__ __forceinline__ void operator()(const f32x4 (&acc)[2][2][4][2], const pg8::Unit& u, int wr, int wc, int fr, int fq) const {
        const int tid = (wr * 4 + wc) * 64 + fq * 16 + fr;
        unsigned char* dst = slab + ((size_t)u.slot * 4 + (u.role - 1)) * (16 * 512 * 16) + (size_t)tid * 16;
#pragma unroll
        for (int ai = 0; ai < 2; ++ai)
#pragma unroll
            for (int bj = 0; bj < 2; ++bj)
#pragma unroll
                for (int m = 0; m < 4; ++m) { const f32x4 a = acc[ai][bj][m][0], b = acc[ai][bj][m][1]; v4u w;
                    w.x = pg8::cvt_pk_bf16(a[0], a[1]); w.y = pg8::cvt_pk_bf16(a[2], a[3]); w.z = pg8::cvt_pk_bf16(b[0], b[1]); w.w = pg8::cvt_pk_bf16(b[2], b[3]);
                    asm volatile("global_store_dwordx4 %0, %1, off sc1\n\ts_nop 1" :: "v"(dst), "v"(w) : "memory");
                    dst += 512 * 16; asm volatile("" : "+v"(dst)); }
        asm volatile("s_waitcnt vmcnt(0)" ::: "memory");
        if (fr == 0 && fq == 0) __hip_atomic_fetch_add(cnt + (size_t)u.slot * 64, 1u, __ATOMIC_RELAXED, __HIP_MEMORY_SCOPE_AGENT);
    }
};
__device__ __forceinline__ void tail_reduce(const EpiRes& E, const unsigned char* slab, unsigned* cnt, int G, int bx, int nN, int nM) {
    pg8::StaticOrder S; S.nM = nM; S.nN = nN; S.nwg = nM * nN; S.G = G; S.c = bx; S.ntK = 0;
    const int L = 256 + (bx >> 2), q = bx & 3; if (L >= S.nwg) return;
    pg8::Unit u; S.map(L, u); const int slot = bx >> 2, ai = q >> 1, bj = q & 1;
    const int tid = tid_opaque(), wid = tid >> 6, lane = tid & 63, wr = wid >> 2, wc = wid & 3, fr = lane & 15, fq = lane >> 4;
    unsigned* c = cnt + (size_t)slot * 64; unsigned spins = 0;
    while ((unsigned)__builtin_amdgcn_readfirstlane(__hip_atomic_load(c, __ATOMIC_RELAXED, __HIP_MEMORY_SCOPE_AGENT)) < 32u) { __builtin_amdgcn_s_sleep(2); if (++spins > (1u << 22)) break; }
    __builtin_amdgcn_fence(__ATOMIC_ACQUIRE, "agent");
    const unsigned char* base = slab + (size_t)slot * 4 * (16 * 512 * 16) + (size_t)tid * 16;
    v4u w[4][4];
#pragma unroll
    for (int m = 0; m < 4; ++m)
#pragma unroll
        for (int r = 0; r < 4; ++r) w[m][r] = *(const v4u*)(base + (size_t)r * (16 * 512 * 16) + (size_t)((ai * 2 + bj) * 4 + m) * (512 * 16));
    const int row0 = u.pm * 256 + ai * 128 + wr * 64 + fr; const int cls = cls_of(u.pm * 256); const int col = u.pn * 256 + bj * 128 + wc * 32 + 8 * fq;
#pragma unroll
    for (int m = 0; m < 4; ++m) { const int row = row0 + m * 16; f32x4 v[2] = {(f32x4){0.f, 0.f, 0.f, 0.f}, (f32x4){0.f, 0.f, 0.f, 0.f}};
#pragma unroll
        for (int r = 0; r < 4; ++r) { const v4u x = w[m][r]; v[0] += (f32x4){__uint_as_float(x.x << 16), __uint_as_float(x.x & 0xffff0000u), __uint_as_float(x.y << 16), __uint_as_float(x.y & 0xffff0000u)};
            v[1] += (f32x4){__uint_as_float(x.z << 16), __uint_as_float(x.z & 0xffff0000u), __uint_as_float(x.w << 16), __uint_as_float(x.w & 0xffff0000u)}; }
        float sq = E.piece(row, col, cls, v[0], v[1]);
        sq += __shfl_xor(sq, 16); sq += __shfl_xor(sq, 32); if (fq == 0) atomicAdd(E.ssq + row, sq); }
}
namespace att {
typedef unsigned short bf16;
constexpr int D = 128, NW = 8, QBLK = 32, KVBLK = 64; constexpr float SCALE = 0.088388347648318440f; constexpr float THR = 8.f; constexpr int SDEPTH = 1;
constexpr int LDQ = NQ * HDIM, LDK = NKV * HDIM, LDO = DM;
constexpr size_t SHM_V = KVBLK * D * 2, SHM_K = KVBLK * D * 2, SHM_ATTN = 2 * SHM_V + 2 * SHM_K + NW * 64 * 4;
using bf16x8 = __attribute__((ext_vector_type(8))) short;
using s16x4  = __attribute__((ext_vector_type(4))) short;
using f32x16 = __attribute__((ext_vector_type(16))) float;
using f32x8  = __attribute__((ext_vector_type(8))) float;
using u32x4  = __attribute__((ext_vector_type(4))) unsigned;
#define KSWZ(row, colB) ((row) * 256 + ((colB) ^ (((row) & 7) << 4)))
#define SBAR() __builtin_amdgcn_sched_barrier(0)
__device__ __forceinline__ int crow(int r, int hi) { return (r & 3) + 8 * (r >> 2) + 4 * hi; }
__device__ __forceinline__ unsigned cvtpk(float lo, float hi) {
  unsigned r; asm volatile("v_cvt_pk_bf16_f32 %0, %1, %2" : "=v"(r) : "v"(lo), "v"(hi)); return r;
}
template <typename TIn> struct Stage;
template <> struct Stage<bf16>  { using T = bf16x8;
  __device__ static __forceinline__ T ld8(const bf16* p) { return *reinterpret_cast<const bf16x8*>(p); }
  __device__ static __forceinline__ bf16x8 tobf(T x) { return x; } };
__device__ __forceinline__ void partialSM(f32x16& p0, f32x16& p1, float& m_reg, float& mn, float& alpha) {
  constexpr float C = SCALE * 1.4426950408889634f;
  float pmax = p0[0]; for (int r = 1; r < 16; ++r) pmax = fmaxf(pmax, p0[r]); for (int r = 0; r < 16; ++r) pmax = fmaxf(pmax, p1[r]);
  { auto rr = __builtin_amdgcn_permlane32_swap(__float_as_uint(pmax), __float_as_uint(pmax), false, false);
    pmax = fmaxf(__uint_as_float(rr[0]), __uint_as_float(rr[1])); }
  if (__builtin_expect(__all(pmax - m_reg <= THR / SCALE), 1)) { mn = m_reg; alpha = 1.f; }
  else { mn = fmaxf(m_reg, pmax); alpha = __builtin_amdgcn_exp2f((m_reg - mn) * C); m_reg = mn; }
  float mnC = -mn * C;
  for (int r = 0; r < 16; ++r) p0[r] = fmaf(p0[r], C, mnC); for (int r = 0; r < 16; ++r) p1[r] = fmaf(p1[r], C, mnC);
  for (int r = 0; r < 16; ++r) p0[r] = __builtin_amdgcn_exp2f(p0[r]);
}
__device__ __forceinline__ void finishSM(f32x16& p0, f32x16& p1, float alpha, float& l_reg, bf16x8& pa0, bf16x8& pa1, bf16x8& pa2, bf16x8& pa3) {
  for (int r = 0; r < 16; ++r) p1[r] = __builtin_amdgcn_exp2f(p1[r]);
  float ps = 0; for (int r = 0; r < 16; ++r) ps += p0[r]; for (int r = 0; r < 16; ++r) ps += p1[r];
  { auto rr = __builtin_amdgcn_permlane32_swap(__float_as_uint(ps), __float_as_uint(ps), false, false);
    ps = __uint_as_float(rr[0]) + __uint_as_float(rr[1]); }
  l_reg = l_reg * alpha + ps;
#define PK4(P, BASE, OUT) do { unsigned a0 = cvtpk(P[BASE + 0], P[BASE + 1]), a1 = cvtpk(P[BASE + 2], P[BASE + 3]);   \
    unsigned b0 = cvtpk(P[BASE + 4], P[BASE + 5]), b1 = cvtpk(P[BASE + 6], P[BASE + 7]);                              \
    auto r0 = __builtin_amdgcn_permlane32_swap(a0, b0, false, false); auto r1 = __builtin_amdgcn_permlane32_swap(a1, b1, false, false); \
    u32x4 w = {r0[0], r1[0], r0[1], r1[1]}; OUT = *reinterpret_cast<bf16x8*>(&w); } while (0)
  PK4(p0, 0, pa0); PK4(p0, 8, pa1); PK4(p1, 0, pa2); PK4(p1, 8, pa3);
#undef PK4
}
__device__ __forceinline__ void qkt(f32x16& p0, f32x16& p1, const bf16* Ks, const bf16x8* qr, int r32, int hi) {
  p0 = f32x16{}; p1 = f32x16{};
  for (int d0 = 0; d0 < 8; ++d0) { int cb = (d0 * 16 + hi * 8) * 2;
    bf16x8 b0 = *reinterpret_cast<const bf16x8*>((const char*)Ks + KSWZ(r32, cb));
    bf16x8 b1 = *reinterpret_cast<const bf16x8*>((const char*)Ks + KSWZ(32 + r32, cb));
    p0 = __builtin_amdgcn_mfma_f32_32x32x16_bf16(b0, qr[d0], p0, 0, 0, 0);
    p1 = __builtin_amdgcn_mfma_f32_32x32x16_bf16(b1, qr[d0], p1, 0, 0, 0); }
}
__device__ __forceinline__ int v_st(int k, int c) { const int kk = (k & ~0xC) | ((k & 4) << 1) | ((k & 8) >> 1); return ((kk >> 3) * 4 + (c >> 5)) * 512 + ((kk & 7) * 32 + (c & 31)) * 2; }
__device__ __forceinline__ int v_rd_base(int lane) { return ((lane & 3) << 3) | (((lane >> 2) & 3) << 6) | (((lane >> 4) & 1) << 5) | (((lane >> 5) & 1) << 8); }
constexpr int v_rd_off(int d0, int ks, int half) { return d0 * 512 + ks * 4096 + half * 2048; }
template <int OFF> __device__ __forceinline__ s16x4 tr_read(int vb) {
  s16x4 r; asm volatile("ds_read_b64_tr_b16 %0, %1 offset:%2" : "=&v"(r) : "v"(vb), "i"(OFF) : "memory"); return r;
}
template <int D0> __device__ __forceinline__ void pv_one(f32x16& od, int vb, bf16x8 pa0, bf16x8 pa1, bf16x8 pa2, bf16x8 pa3) {
  const s16x4 l0 = tr_read<v_rd_off(D0, 0, 0)>(vb), h0 = tr_read<v_rd_off(D0, 0, 1)>(vb), l1 = tr_read<v_rd_off(D0, 1, 0)>(vb), h1 = tr_read<v_rd_off(D0, 1, 1)>(vb);
  const s16x4 l2 = tr_read<v_rd_off(D0, 2, 0)>(vb), h2 = tr_read<v_rd_off(D0, 2, 1)>(vb), l3 = tr_read<v_rd_off(D0, 3, 0)>(vb), h3 = tr_read<v_rd_off(D0, 3, 1)>(vb);
  asm volatile("s_waitcnt lgkmcnt(0)" ::: "memory"); SBAR();
#define PK(L, H) (bf16x8){L[0], L[1], L[2], L[3], H[0], H[1], H[2], H[3]}
  od = __builtin_amdgcn_mfma_f32_32x32x16_bf16(pa0, PK(l0, h0), od, 0, 0, 0);
  od = __builtin_amdgcn_mfma_f32_32x32x16_bf16(pa1, PK(l1, h1), od, 0, 0, 0);
  od = __builtin_amdgcn_mfma_f32_32x32x16_bf16(pa2, PK(l2, h2), od, 0, 0, 0);
  od = __builtin_amdgcn_mfma_f32_32x32x16_bf16(pa3, PK(l3, h3), od, 0, 0, 0);
#undef PK
}
__device__ __forceinline__ void pv_d0(f32x16* o, int vb, bf16x8 pa0, bf16x8 pa1, bf16x8 pa2, bf16x8 pa3) {
  pv_one<0>(o[0], vb, pa0, pa1, pa2, pa3); pv_one<1>(o[1], vb, pa0, pa1, pa2, pa3); pv_one<2>(o[2], vb, pa0, pa1, pa2, pa3); pv_one<3>(o[3], vb, pa0, pa1, pa2, pa3);
}

__device__ __forceinline__ void attn_dense_body(const bf16* __restrict__ Qb, const bf16* __restrict__ Kh, const bf16* __restrict__ Vh,
                                                bf16* __restrict__ Ob, int seq, char* lds, const float* __restrict__ qgain, int spos0) {
  typedef bf16 TQ;
  using St = Stage<bf16>; using SQ = Stage<TQ>;
  const int tid = tid_opaque(), wid = tid >> 6, lane = tid & 63, r32 = lane & 31, hi = lane >> 5;
  bf16* V_lds = (bf16*)lds; bf16* K_lds = (bf16*)(lds + 2 * SHM_V);
  float* ws = (float*)(lds + 2 * SHM_V + 2 * SHM_K) + wid * 64; float* li_l = ws; float* al_l = ws + 32;
  float m_reg = -1e30f, l_reg = 0; f32x16 o[4] = {}; bf16x8 qr[8];
  const TQ* Qw = Qb + (long)(wid * QBLK + r32) * LDQ + hi * 8;
#pragma unroll
  for (int d0 = 0; d0 < 8; ++d0) qr[d0] = SQ::tobf(SQ::ld8(Qw + d0 * 16));
  { float qf[8][8]; float ss = 0.f;
#pragma unroll
    for (int d0 = 0; d0 < 8; ++d0)
#pragma unroll
      for (int j = 0; j < 8; ++j) { qf[d0][j] = bf2f((unsigned short)qr[d0][j]); ss += qf[d0][j] * qf[d0][j]; }
    { auto rr = __builtin_amdgcn_permlane32_swap(__float_as_uint(ss), __float_as_uint(ss), false, false); ss = __uint_as_float(rr[0]) + __uint_as_float(rr[1]); }
    const float rsq = 1.0f / sqrtf(ss * (1.0f / D) + 1e-6f);
#pragma unroll
    for (int d0 = 0; d0 < 8; ++d0) { const float* gq = qgain + d0 * 16 + hi * 8; const f32x8 g8 = *reinterpret_cast<const f32x8*>(gq);
#pragma unroll
      for (int j = 0; j < 8; ++j) qf[d0][j] *= rsq * g8[j]; }
    if (spos0 >= 0) { const int sp = spos0 + wid * QBLK + r32; const float prow = (float)(sp / GRIDW), pcol = (float)(sp % GRIDW);
#pragma unroll
      for (int d0 = 0; d0 < 2; ++d0)
#pragma unroll
        for (int j = 0; j < 8; ++j) { const float inv = __builtin_amdgcn_exp2f(-(float)(16 * d0 + 8 * hi + j) * (13.287712379549449f / 32.0f));
          const float cr = __cosf(prow * inv), sr_ = __sinf(prow * inv), cc = __cosf(pcol * inv), sc_ = __sinf(pcol * inv);
          const float a = qf[d0][j], b2 = qf[d0 + 2][j]; qf[d0][j] = a * cr - b2 * sr_; qf[d0 + 2][j] = a * sr_ + b2 * cr;
          const float c = qf[4 + d0][j], e = qf[6 + d0][j]; qf[4 + d0][j] = c * cc - e * sc_; qf[6 + d0][j] = c * sc_ + e * cc; } }
#pragma unroll
    for (int d0 = 0; d0 < 8; ++d0) { u32x4 w = {cvtpk(qf[d0][0], qf[d0][1]), cvtpk(qf[d0][2], qf[d0][3]), cvtpk(qf[d0][4], qf[d0][5]), cvtpk(qf[d0][6], qf[d0][7])}; qr[d0] = *reinterpret_cast<bf16x8*>(&w); } }
  const int sr = tid >> 4, sc = (tid & 15) * 8, vst0 = v_st(sr, sc), vst1 = v_st(32 + sr, sc);
  const int vb0 = (int)(uintptr_t)V_lds + v_rd_base(lane);
  struct { typename St::T vs0, vs1, ks0, ks1; } sr_[SDEPTH];
#define SLOAD(i, k0) do { sr_[i].vs0 = St::ld8(&Vh[(long)((k0) + sr) * LDK + sc]); sr_[i].vs1 = St::ld8(&Vh[(long)((k0) + 32 + sr) * LDK + sc]); \
    sr_[i].ks0 = St::ld8(&Kh[(long)((k0) + sr) * LDK + sc]); sr_[i].ks1 = St::ld8(&Kh[(long)((k0) + 32 + sr) * LDK + sc]); } while (0)
#define SWRITE(b, i) do { *(bf16x8*)((char*)V_lds + (b) * SHM_V + vst0) = St::tobf(sr_[i].vs0);          \
    *(bf16x8*)((char*)V_lds + (b) * SHM_V + vst1) = St::tobf(sr_[i].vs1); int kc = sc * 2;               \
    *(bf16x8*)((char*)K_lds + (b) * SHM_K + KSWZ(sr, kc)) = St::tobf(sr_[i].ks0);                       \
    *(bf16x8*)((char*)K_lds + (b) * SHM_K + KSWZ(32 + sr, kc)) = St::tobf(sr_[i].ks1); } while (0)
#define SWAIT() do { if constexpr (SDEPTH == 2) asm volatile("s_waitcnt vmcnt(4)" ::: "memory"); else asm volatile("s_waitcnt vmcnt(0)" ::: "memory"); } while (0)
#define RESC(a) do { if (__any((a) < 1.f)) { if (hi == 0) al_l[r32] = (a); asm volatile("s_waitcnt lgkmcnt(0)" ::: "memory"); \
    for (int d = 0; d < 4; ++d) for (int r = 0; r < 16; ++r) o[d][r] *= al_l[crow(r, hi)]; } } while (0)
  f32x16 pA0, pA1, pB0, pB1; float mnA, mnB, alA, alB; bf16x8 pa0, pa1, pa2, pa3; const int NT = seq / KVBLK;
  constexpr int SE = 0, SO = SDEPTH - 1;
  SLOAD(SE, 0); asm volatile("s_waitcnt vmcnt(0)" ::: "memory"); SWRITE(0, SE); __syncthreads();
  qkt(pA0, pA1, K_lds, qr, r32, hi); partialSM(pA0, pA1, m_reg, mnA, alA);
  SLOAD(SO, KVBLK); if constexpr (SDEPTH == 2) { if (2 < NT) SLOAD(SE, 2 * KVBLK); }
  SWAIT(); SWRITE(1, SO); __syncthreads();
  for (int j = 1; j + 1 < NT; j += 2) {
    SBAR(); qkt(pB0, pB1, (bf16*)((char*)K_lds + SHM_K), qr, r32, hi);
    finishSM(pA0, pA1, alA, l_reg, pa0, pa1, pa2, pa3); SBAR();
    SLOAD(SO, (j + SDEPTH) * KVBLK); SBAR();
    pv_d0(o, vb0, pa0, pa1, pa2, pa3); partialSM(pB0, pB1, m_reg, mnB, alB);
    __syncthreads(); SWAIT(); SWRITE(0, SE);
    RESC(alB); __syncthreads();
    SBAR(); qkt(pA0, pA1, K_lds, qr, r32, hi);
    finishSM(pB0, pB1, alB, l_reg, pa0, pa1, pa2, pa3); SBAR();
    if (SDEPTH == 1 || j + 3 < NT) SLOAD(SE, (j + 1 + SDEPTH) * KVBLK); SBAR();
    pv_d0(o, vb0 + (int)SHM_V, pa0, pa1, pa2, pa3); partialSM(pA0, pA1, m_reg, mnA, alA);
    __syncthreads(); SWAIT(); SWRITE(1, SO);
    RESC(alA); __syncthreads();
  }
  SBAR(); qkt(pB0, pB1, (bf16*)((char*)K_lds + SHM_K), qr, r32, hi);
  finishSM(pA0, pA1, alA, l_reg, pa0, pa1, pa2, pa3); SBAR();
  pv_d0(o, vb0, pa0, pa1, pa2, pa3); partialSM(pB0, pB1, m_reg, mnB, alB);
  __syncthreads(); RESC(alB);
  finishSM(pB0, pB1, alB, l_reg, pa0, pa1, pa2, pa3); SBAR();
  pv_d0(o, vb0 + (int)SHM_V, pa0, pa1, pa2, pa3);
  if (hi == 0) li_l[r32] = l_reg; asm volatile("s_waitcnt lgkmcnt(0)" ::: "memory");
  float rli[16];
#pragma unroll
  for (int r = 0; r < 16; ++r) rli[r] = __builtin_amdgcn_rcpf(li_l[crow(r, hi)]);
  bf16* Ow = Ob + (long)(wid * QBLK) * LDO;
#pragma unroll
  for (int r = 0; r < 16; ++r) { int orow = crow(r, hi);
    for (int d0 = 0; d0 < 4; ++d0) Ow[(long)orow * LDO + d0 * 32 + r32] = f2bf(o[d0][r] * rli[r]); }
#undef SLOAD
#undef SWRITE
#undef SWAIT
#undef RESC
}
}
__device__ __forceinline__ void attn_phase(const Params& p, unsigned char* lds, int vcu, int G) {
    constexpr int QB = 256, LQB = LSEQ / QB, CQB = CSEQ / QB;
    constexpr int NUL = NLB * NQ * LQB, NUC = NCB * NQ * CQB, NU = NUL + NUC;
    const att::bf16* QR = (const att::bf16*)(p.ws + WS_QRAW); att::bf16* OB = (att::bf16*)(p.ws + WS_O);
    for (int i = 0;; ++i) {
        int u;
        if (G == 256 && NUL == 512) { if (i < 2) u = (vcu >> 5) * 64 + (vcu & 31) + 32 * i; else u = NUL + vcu + (i - 2) * G; }
        else u = vcu + i * G;
        if (u >= NU) break;
        const att::bf16 *Q, *K, *V; att::bf16* O; int seq; int spos0 = -1;
        if (u < NUL) { const int grp = u / (GRP * LQB), j = u % (GRP * LQB); const int b = grp / NKV, kvh = grp % NKV, g = j / LQB, qb = j % LQB, hq = kvh * GRP + g;
            const size_t row0 = (size_t)MC + (size_t)b * LSEQ + (size_t)qb * QB; spos0 = qb * QB;
            Q = QR + row0 * (NQ * HDIM) + hq * HDIM; O = OB + row0 * DM + hq * HDIM;
            K = (const att::bf16*)(p.ws + WS_LATK) + (size_t)b * SKVL * (NKV * HDIM) + kvh * HDIM; V = (const att::bf16*)(p.ws + WS_LATV) + (size_t)b * SKVL * (NKV * HDIM) + kvh * HDIM; seq = SKVL; }
        else { const int uc = u - NUL; const int b = uc / (NQ * CQB), r = uc % (NQ * CQB), hq = r / CQB, qb = r % CQB, kvh = hq / GRP;
            const size_t row0 = (size_t)b * CSEQ + (size_t)qb * QB;
            Q = QR + row0 * (NQ * HDIM) + hq * HDIM; O = OB + row0 * DM + hq * HDIM;
            K = (const att::bf16*)(p.ws + WS_CTXK) + (size_t)b * CSEQ * (NKV * HDIM) + kvh * HDIM; V = (const att::bf16*)(p.ws + WS_CTXV) + (size_t)b * CSEQ * (NKV * HDIM) + kvh * HDIM; seq = CSEQ; }
        __syncthreads();
        att::attn_dense_body(Q, K, V, O, seq, (char*)lds, p.qng, spos0);
    }
}
static_assert(SKVL % 128 == 0 && CSEQ % 128 == 0 && LSEQ % 256 == 0 && CSEQ % 256 == 0, "attention tiling");
constexpr size_t WS_CST = 232 * MiB;
constexpr int NBLK = LSEQ / 256;
constexpr size_t WS_NST = WS_CST + (size_t)NLB * MH * 2 * NBLK * MDK * MDK * 2;
constexpr size_t WS_FTOT = WS_NST + (size_t)NLB * MH * 2 * NBLK * MDK * 4;
static_assert(WS_FTOT + (size_t)NLB * MH * 2 * NBLK * 4 <= WS_END && MDK == 128 && CSEQ == 256 && LSEQ % 256 == 0, "mLSTM fast path geometry");
namespace att {
constexpr int ML_OFF = 132096;
constexpr int ML_SC = ML_OFF + 6144;
constexpr int ML_N = ML_SC + 128;
constexpr int ML_LI = ML_N + 1024;
constexpr int ML_LI2 = ML_LI + 1024;
static_assert(ML_LI2 + 1024 <= LDS_BYTES, "mLSTM LDS map");
constexpr float L2E = 1.4426950408889634f;
using f32x4v = __attribute__((ext_vector_type(4))) float;


__device__ __forceinline__ void ml_gates(const Params& p, char* lds, int row0, int h, int tid) {
    float* A = (float*)(lds + ML_OFF); float* S = (float*)(lds + ML_SC);
    const int half = tid >> 8, t = tid & 255, tok = half ? 255 - t : t, lane = tid & 63, wv = (tid >> 6) & 3;
    const float* G = (const float*)(p.ws + WS_GATES) + (size_t)(row0 + tok) * NGATE + half * 8 + h;
    const float ig = G[0], lf = G[4];
    float v = lf;
#pragma unroll
    for (int off = 1; off < 64; off <<= 1) { const float u = lane_get(v, lane - off); if (lane >= off) v += u; }
    if (lane == 63) S[4 + half * 4 + wv] = v;
    __syncthreads();
    float pre = 0.f, tot = 0.f;
#pragma unroll
    for (int w = 0; w < 4; ++w) { const float x = S[4 + half * 4 + w]; if (w < wv) pre += x; tot += x; }
    const float P = v + pre, a = ig - P;
    A[(0 + half) * 256 + tok] = P * L2E; A[(2 + half) * 256 + tok] = a * L2E; A[(4 + half) * 256 + tok] = __builtin_amdgcn_exp2f(P * L2E);
    float mx = a;
    mx = fmaxf(mx, swz_xor<1>(mx)); mx = fmaxf(mx, swz_xor<2>(mx)); mx = fmaxf(mx, swz_xor<4>(mx)); mx = fmaxf(mx, swz_xor<8>(mx)); mx = fmaxf(mx, swz_xor<16>(mx)); mx = half_max(mx);
    if (lane == 0) S[12 + half * 4 + wv] = mx;
    if (t == 0) S[half] = tot;
    __syncthreads();
    if (t == 0) S[2 + half] = fmaxf(fmaxf(S[12 + half * 4], S[13 + half * 4]), fmaxf(S[14 + half * 4], S[15 + half * 4]));
    __syncthreads();
}
#define ML_PK(L, H) (bf16x8){L[0], L[1], L[2], L[3], H[0], H[1], H[2], H[3]}
__device__ __forceinline__ s16x4 tr_read_rt(int vb) { s16x4 r; asm volatile("ds_read_b64_tr_b16 %0, %1" : "=&v"(r) : "v"(vb) : "memory"); return r; }

__device__ __forceinline__ void ml_passA_unit(const Params& p, char* lds, int sid, int h, int blk) {
    const int tid = tid_opaque(), wid = tid >> 6, lane = tid & 63, r32 = lane & 31, hi = lane >> 5;
    const bool isctx = sid < NCB; const int row0 = seq_base(sid) + 256 * blk;
    __syncthreads();
    ml_gates(p, lds, row0, h, tid);
    float* A = (float*)(lds + ML_OFF); float* S = (float*)(lds + ML_SC); float* NA = (float*)(lds + ML_N);
    const bf16* QK = (const bf16*)(p.ws + WS_QKVO) + (size_t)row0 * (4 * MW) + h * MDK;
    const int sr = tid >> 4, sc8 = (tid & 15) * 8;
    { bf16x8 tv[8];
#pragma unroll
      for (int i = 0; i < 8; ++i) tv[i] = *(const bf16x8*)(QK + (size_t)(32 * i + sr) * (4 * MW) + 2 * MW + sc8);
#pragma unroll
      for (int i = 0; i < 8; ++i) *(bf16x8*)(lds + 65536 + (i >> 1) * 16384 + v_st(32 * (i & 1) + sr, sc8)) = tv[i]; }
    if (tid < 256) NA[tid] = 0.f;
    const int a = wid >> 1, dvb0 = 2 * (wid & 1);
    const int ldsb = (int)(uintptr_t)lds; const int vbK = ldsb + v_rd_base(lane) + a * 512, vbV = ldsb + 65536 + v_rd_base(lane) + dvb0 * 512;
    for (int dir = 0; dir < 2; ++dir) {
        __syncthreads();
        const float ft = S[dir], am = S[2 + dir]; const float mT = isctx ? ft + fmaxf(am, 0.f) : 0.f; const float wl2 = (ft - mT) * L2E;
        float xs[8];
#pragma unroll
        for (int i = 0; i < 8; ++i) xs[i] = 0.f;
        bf16x8 tk[8];
#pragma unroll
        for (int i = 0; i < 8; ++i) tk[i] = *(const bf16x8*)(QK + (size_t)(32 * i + sr) * (4 * MW) + MW + sc8);
#pragma unroll
        for (int j = 0; j < 4; ++j)
#pragma unroll
            for (int hf = 0; hf < 2; ++hf) { const int row = 64 * j + 32 * hf + sr; const float w = __builtin_amdgcn_exp2f(wl2 + A[(2 + dir) * 256 + row]);
                const bf16x8 k8 = tk[2 * j + hf]; float x[8];
#pragma unroll
                for (int i = 0; i < 8; ++i) { x[i] = bf2f((unsigned short)k8[i]) * w; xs[i] += x[i]; }
                u32x4 pk = {cvtpk(x[0], x[1]), cvtpk(x[2], x[3]), cvtpk(x[4], x[5]), cvtpk(x[6], x[7])};
                *(u32x4*)(lds + j * 16384 + v_st(32 * hf + sr, sc8)) = pk; }
#pragma unroll
        for (int i = 0; i < 8; ++i) { float v = xs[i]; v += swz_xor<16>(v); v = half_sum(v); if (lane < 16) atomicAdd(&NA[dir * 128 + sc8 + i], v); }
        __syncthreads();
        f32x16 acc0 = {}, acc1 = {}; const unsigned eoff = (unsigned)((32 * a + 4 * hi) * MDK + 32 * dvb0 + r32);
#pragma unroll
        for (int j = 0; j < 4; ++j)
#pragma unroll
            for (int ks = 0; ks < 4; ++ks) { const int off = j * 16384 + ks * 4096;
                const s16x4 al = tr_read_rt(vbK + off), ah = tr_read_rt(vbK + off + 2048);
                const s16x4 bl0 = tr_read_rt(vbV + off), bh0 = tr_read_rt(vbV + off + 2048), bl1 = tr_read_rt(vbV + off + 512), bh1 = tr_read_rt(vbV + off + 512 + 2048);
                asm volatile("s_waitcnt lgkmcnt(0)" ::: "memory"); SBAR();
                acc0 = __builtin_amdgcn_mfma_f32_32x32x16_bf16(ML_PK(al, ah), ML_PK(bl0, bh0), acc0, 0, 0, 0);
                acc1 = __builtin_amdgcn_mfma_f32_32x32x16_bf16(ML_PK(al, ah), ML_PK(bl1, bh1), acc1, 0, 0, 0); }
        if (isctx) {
            float* Co = p.out + O_C + ((size_t)(sid * 2 + dir) * MH + h) * MDK * MDK;
#pragma unroll
            for (int r = 0; r < 16; ++r) { const unsigned eo = eoff + (unsigned)(((r & 3) + 8 * (r >> 2)) * MDK); Co[eo] = acc0[r]; Co[eo + 32] = acc1[r]; }
            if (tid == 0) p.out[O_M + (size_t)(sid * 2 + dir) * MH + h] = mT;
        } else {
            const int b = sid - NCB; bf16* Cs = (bf16*)(p.ws + WS_CST) + ((size_t)((b * MH + h) * 2 + dir) * NBLK + blk) * MDK * MDK;
#pragma unroll
            for (int r = 0; r < 16; ++r) { const unsigned eo = eoff + (unsigned)(((r & 3) + 8 * (r >> 2)) * MDK); Cs[eo] = f2bf(acc0[r]); Cs[eo + 32] = f2bf(acc1[r]); }
            if (tid == 0) ((float*)(p.ws + WS_FTOT))[((size_t)(b * MH + h) * 2 + dir) * NBLK + blk] = ft;
        }
    }
    __syncthreads();
    if (tid < 256) { const int dir = tid >> 7, d = tid & 127;
        if (isctx) p.out[O_N + ((size_t)(sid * 2 + dir) * MH + h) * MDK + d] = NA[tid];
        else { const int b = sid - NCB; ((float*)(p.ws + WS_NST))[(((size_t)(b * MH + h) * 2 + dir) * NBLK + blk) * MDK + d] = NA[tid]; } }
}

template <int DIR> __device__ __forceinline__ void ml_tile(f32x16* o, float& den, const bf16x8* qr, const char* Ktile, int vbV, const float* AL2, int j, float cq, int trow, bool diag, int r32, int hi) {
    SBAR(); f32x16 p0, p1; qkt(p0, p1, (const bf16*)Ktile, qr, r32, hi); SBAR();
    float ds = 0.f; const int tl = trow - 64 * j - 4 * hi;
#pragma unroll
    for (int g = 0; g < 4; ++g) { const f32x4v a0 = *(const f32x4v*)(AL2 + 64 * j + 8 * g + 4 * hi), a1 = *(const f32x4v*)(AL2 + 64 * j + 32 + 8 * g + 4 * hi);
#pragma unroll
        for (int e = 0; e < 4; ++e) { float w0 = __builtin_amdgcn_exp2f(cq + a0[e]), w1 = __builtin_amdgcn_exp2f(cq + a1[e]);
            if (diag) { if (DIR == 0 ? (8 * g + e > tl) : (8 * g + e < tl)) w0 = 0.f; if (DIR == 0 ? (8 * g + e + 32 > tl) : (8 * g + e + 32 < tl)) w1 = 0.f; }
            p0[4 * g + e] *= w0; p1[4 * g + e] *= w1; ds += p0[4 * g + e] + p1[4 * g + e]; } }
    den += ds;
    bf16x8 pa0, pa1, pa2, pa3;
#define PK4(P, BASE, OUT) do { unsigned a0_ = cvtpk(P[BASE + 0], P[BASE + 1]), a1_ = cvtpk(P[BASE + 2], P[BASE + 3]);   \
    unsigned b0_ = cvtpk(P[BASE + 4], P[BASE + 5]), b1_ = cvtpk(P[BASE + 6], P[BASE + 7]);                              \
    auto r0_ = __builtin_amdgcn_permlane32_swap(a0_, b0_, false, false); auto r1_ = __builtin_amdgcn_permlane32_swap(a1_, b1_, false, false); \
    u32x4 w_ = {r0_[0], r1_[0], r0_[1], r1_[1]}; OUT = *reinterpret_cast<bf16x8*>(&w_); } while (0)
    PK4(p0, 0, pa0); PK4(p0, 8, pa1); PK4(p1, 0, pa2); PK4(p1, 8, pa3);
#undef PK4
    SBAR(); pv_d0(o, vbV, pa0, pa1, pa2, pa3); SBAR();
}
struct MlKv { bf16x8 tk[4], tv[4]; };
__device__ __forceinline__ void ml_kv_load(MlKv& r, const bf16* QK, int tile0, int sr, int sc8) {
#pragma unroll
    for (int i = 0; i < 4; ++i) { const int row = 64 * tile0 + 32 * i + sr; r.tk[i] = *(const bf16x8*)(QK + (size_t)row * (4 * MW) + MW + sc8); r.tv[i] = *(const bf16x8*)(QK + (size_t)row * (4 * MW) + 2 * MW + sc8); }
}
__device__ __forceinline__ void ml_kv_write(const MlKv& r, char* lds, int sr, int sc8) {
#pragma unroll
    for (int i = 0; i < 4; ++i) { const int jj = i >> 1, rl = 32 * (i & 1) + sr; *(bf16x8*)(lds + jj * 16384 + KSWZ(rl, sc8 * 2)) = r.tk[i]; *(bf16x8*)(lds + 32768 + jj * 16384 + v_st(rl, sc8)) = r.tv[i]; }
}
__device__ __forceinline__ void ml_passC_unit(const Params& p, char* lds, int sid, int h, int blk) {
    const int tid = tid_opaque(), wid = tid >> 6, lane = tid & 63, r32 = lane & 31, hi = lane >> 5;
    const bool isctx = sid < NCB; const int row0 = seq_base(sid) + 256 * blk; const int wq = wid >> 1;
    __syncthreads();
    ml_gates(p, lds, row0, h, tid);
    float* A = (float*)(lds + ML_OFF); float* NS = (float*)(lds + ML_N); float* li = (float*)(lds + ML_LI) + wid * 32;
    const bf16* QK = (const bf16*)(p.ws + WS_QKVO) + (size_t)row0 * (4 * MW) + h * MDK;
    const int sr = tid >> 4, sc8 = (tid & 15) * 8; const int b = sid - NCB;
    if (tid < 256) { const int dir = tid >> 7, d = tid & 127;
        NS[tid] = isctx ? 0.f : ((const float*)(p.ws + WS_NST))[(((size_t)(b * MH + h) * 2 + dir) * NBLK + blk) * MDK + d]; }
    if (!isctx) { bf16x8 tc[8];
#pragma unroll
        for (int i = 0; i < 8; ++i) { const int dir = i >> 2, c = tid + 512 * (i & 3); tc[i] = *(const bf16x8*)((const bf16*)(p.ws + WS_CST) + ((size_t)((b * MH + h) * 2 + dir) * NBLK + blk) * MDK * MDK + (size_t)c * 8); }
#pragma unroll
        for (int i = 0; i < 8; ++i) { const int dir = i >> 2, c = tid + 512 * (i & 3), row = c >> 4, col8 = (c & 15) * 8; *(bf16x8*)(lds + 65536 + dir * 32768 + (row >> 6) * 16384 + v_st(row & 63, col8)) = tc[i]; }
    }
    bf16x8 qr[8];
    { const bf16* Qw = QK + (size_t)(wid * 32 + r32) * (4 * MW) + hi * 8;
#pragma unroll
        for (int d0 = 0; d0 < 8; ++d0) qr[d0] = *(const bf16x8*)(Qw + d0 * 16); }
    { MlKv kv; ml_kv_load(kv, QK, 0, sr, sc8); ml_kv_write(kv, lds, sr, sc8); }
    __syncthreads();
    float qn_f = 0.f, qn_b = 0.f;
#pragma unroll
    for (int d0 = 0; d0 < 8; ++d0)
#pragma unroll
        for (int i = 0; i < 8; ++i) { const float qv = bf2f((unsigned short)qr[d0][i]); qn_f += qv * NS[d0 * 16 + hi * 8 + i]; qn_b += qv * NS[128 + d0 * 16 + hi * 8 + i]; }
    qn_f = half_sum(qn_f); qn_b = half_sum(qn_b);
    const int ldsb = (int)(uintptr_t)lds; const int vbV = ldsb + 32768 + v_rd_base(lane), vbC = ldsb + 65536 + v_rd_base(lane);
    const int trow = wid * 32 + r32;
    f32x16 of[4], ob[4];
#pragma unroll
    for (int d0 = 0; d0 < 4; ++d0) { of[d0] = f32x16{}; ob[d0] = f32x16{}; }
    if (!isctx) { pv_d0(of, vbC, qr[0], qr[1], qr[2], qr[3]); pv_d0(of, vbC + 16384, qr[4], qr[5], qr[6], qr[7]);
        pv_d0(ob, vbC + 32768, qr[0], qr[1], qr[2], qr[3]); pv_d0(ob, vbC + 32768 + 16384, qr[4], qr[5], qr[6], qr[7]);
#pragma unroll
        for (int r = 0; r < 16; ++r) { const float ef = A[4 * 256 + wid * 32 + crow(r, hi)], eb = A[5 * 256 + wid * 32 + crow(r, hi)];
#pragma unroll
            for (int d0 = 0; d0 < 4; ++d0) { of[d0][r] *= ef; ob[d0][r] *= eb; } } }
    const float cqf = A[0 * 256 + trow], cqb = A[1 * 256 + trow]; float denf = 0.f, denb = 0.f;
    ml_tile<0>(of, denf, qr, lds, vbV, A + 2 * 256, 0, cqf, trow, wq == 0, r32, hi);
    if (wq >= 1) ml_tile<0>(of, denf, qr, lds + 16384, vbV + 16384, A + 2 * 256, 1, cqf, trow, wq == 1, r32, hi);
    if (wq <= 1) ml_tile<1>(ob, denb, qr, lds + 16384, vbV + 16384, A + 3 * 256, 1, cqb, trow, wq == 1, r32, hi);
    if (wq <= 0) ml_tile<1>(ob, denb, qr, lds, vbV, A + 3 * 256, 0, cqb, trow, wq == 0, r32, hi);
    __syncthreads();
    { MlKv kv; ml_kv_load(kv, QK, 2, sr, sc8); ml_kv_write(kv, lds, sr, sc8); }
    __syncthreads();
    if (wq >= 2) ml_tile<0>(of, denf, qr, lds, vbV, A + 2 * 256, 2, cqf, trow, wq == 2, r32, hi);
    if (wq >= 3) ml_tile<0>(of, denf, qr, lds + 16384, vbV + 16384, A + 2 * 256, 3, cqf, trow, wq == 3, r32, hi);
    ml_tile<1>(ob, denb, qr, lds + 16384, vbV + 16384, A + 3 * 256, 3, cqb, trow, wq == 3, r32, hi);
    if (wq <= 2) ml_tile<1>(ob, denb, qr, lds, vbV, A + 3 * 256, 2, cqb, trow, wq == 2, r32, hi);
    denf = half_sum(denf); denb = half_sum(denb);
    const float invf = 1.0f / fmaxf(fabsf(denf + __builtin_amdgcn_exp2f(cqf) * qn_f), 1.0f), invb = 1.0f / fmaxf(fabsf(denb + __builtin_amdgcn_exp2f(cqb) * qn_b), 1.0f);
    float* li2 = (float*)(lds + ML_LI2) + wid * 32;
    if (hi == 0) { li[r32] = invf; li2[r32] = invb; } asm volatile("s_waitcnt lgkmcnt(0)" ::: "memory");
    const unsigned uho = (unsigned)(4 * hi * DM + r32), ogo = (unsigned)(4 * hi * 4 * MW + r32);
    float mg[4];
#pragma unroll
    for (int d0 = 0; d0 < 4; ++d0) mg[d0] = p.mng[h * MDK + d0 * 32 + r32];
    const bf16* OG = QK + (size_t)(wid * 32) * (4 * MW) + 3 * MW; bf16* UHo = (bf16*)(p.ws + WS_UH) + (size_t)(row0 + wid * 32) * DM + CCH + h * MDK;
#pragma unroll
    for (int r = 0; r < 16; ++r) { const float rlf = li[crow(r, hi)], rlb = li2[crow(r, hi)]; const int rc = (r & 3) + 8 * (r >> 2); float ss = 0.f; float x[4];
#pragma unroll
        for (int d0 = 0; d0 < 4; ++d0) { x[d0] = of[d0][r] * rlf + ob[d0][r] * rlb; ss += x[d0] * x[d0]; }
        ss += swz_xor<1>(ss); ss += swz_xor<2>(ss); ss += swz_xor<4>(ss); ss += swz_xor<8>(ss); ss += swz_xor<16>(ss);
        const float rs = 1.0f / sqrtf(ss * (1.0f / MDK) + EPSF);
#pragma unroll
        for (int d0 = 0; d0 < 4; ++d0) UHo[uho + (unsigned)(rc * DM + d0 * 32)] = f2bf(bf2f(OG[ogo + (unsigned)(rc * 4 * MW + d0 * 32)]) * x[d0] * rs * mg[d0]);
        if ((r & 3) == 3) asm volatile("" ::: "memory"); }
}
}

template <int DIR> __device__ __forceinline__ void ml_scan_item(const Params& p, int ch, int b, int h, int e8) {
    const float em = expf(p.stm[(size_t)(b * 2 + DIR) * MH + h]); const float* FT = (const float*)(p.ws + WS_FTOT) + (size_t)ch * NBLK;
    float fd[NBLK];
#pragma unroll
    for (int i = 0; i < NBLK; ++i) fd[i] = expf(FT[i]);
    if (e8 < MDK * MDK) { bf16_t* Cs = (bf16_t*)(p.ws + WS_CST) + (size_t)ch * NBLK * MDK * MDK + e8; const float* c0 = p.stC + ((size_t)(b * 2 + DIR) * MH + h) * MDK * MDK + e8;
        v4u d[NBLK];
#pragma unroll
        for (int i = 0; i < NBLK; ++i) d[i] = *(const v4u*)(Cs + (size_t)i * MDK * MDK);
        const f32x4 ca = *(const f32x4*)c0, cb = *(const f32x4*)(c0 + 4); float c[8] = {ca[0] * em, ca[1] * em, ca[2] * em, ca[3] * em, cb[0] * em, cb[1] * em, cb[2] * em, cb[3] * em};
#pragma unroll
        for (int i = 0; i < NBLK; ++i) { const int blk = DIR == 0 ? i : NBLK - 1 - i; v4u o;
#pragma unroll
            for (int w = 0; w < 4; ++w) { const float lo = __uint_as_float(d[blk][w] << 16), hi = __uint_as_float(d[blk][w] & 0xffff0000u); o[w] = pg8::cvt_pk_bf16(c[2 * w], c[2 * w + 1]);
                c[2 * w] = fd[blk] * c[2 * w] + lo; c[2 * w + 1] = fd[blk] * c[2 * w + 1] + hi; }
            *(v4u*)(Cs + (size_t)blk * MDK * MDK) = o; } }
    else { const int d_ = e8 - MDK * MDK; float* Ns = (float*)(p.ws + WS_NST) + (size_t)ch * NBLK * MDK + d_; const float* n0 = p.stn + ((size_t)(b * 2 + DIR) * MH + h) * MDK + d_;
        f32x4 da[NBLK], db[NBLK];
#pragma unroll
        for (int i = 0; i < NBLK; ++i) { da[i] = *(const f32x4*)(Ns + (size_t)i * MDK); db[i] = *(const f32x4*)(Ns + (size_t)i * MDK + 4); }
        f32x4 ca = *(const f32x4*)n0 * em, cb = *(const f32x4*)(n0 + 4) * em;
#pragma unroll
        for (int i = 0; i < NBLK; ++i) { const int blk = DIR == 0 ? i : NBLK - 1 - i;
            *(f32x4*)(Ns + (size_t)blk * MDK) = ca; *(f32x4*)(Ns + (size_t)blk * MDK + 4) = cb; ca = ca * fd[blk] + da[blk]; cb = cb * fd[blk] + db[blk]; } }
}
struct MlScan {
    Params p; static HD_FN long count() { return (long)NLB * MH * 2 * ((MDK * MDK + MDK) / 8); }
    __device__ __forceinline__ void operator()(long idx) const {
        constexpr int per = (MDK * MDK + MDK) / 8; const int e8 = (int)(idx % per) * 8; const int ch = (int)(idx / per); const int dir = ch & 1, h = (ch >> 1) % MH, b = ch / (2 * MH);
        if (dir == 0) ml_scan_item<0>(p, ch, b, h, e8); else ml_scan_item<1>(p, ch, b, h, e8);
    }
};
__device__ __forceinline__ void ml_phase_A(const Params& p, unsigned char* lds, int vcu, int G) {
    constexpr int NUL = NLB * MH * NBLK, NU = NUL + NCB * MH;
    for (int u = vcu; u < NU; u += G) {
        if (u < NUL) att::ml_passA_unit(p, (char*)lds, NCB + u / (MH * NBLK), (u / NBLK) % MH, u % NBLK);
        else att::ml_passA_unit(p, (char*)lds, (u - NUL) / MH, (u - NUL) % MH, 0); }
}
__device__ __forceinline__ void ml_phase_C(const Params& p, unsigned char* lds, int vcu, int G) {
    constexpr int NUL = NLB * MH * NBLK, NU = NUL + NCB * MH;
    for (int u = vcu; u < NU; u += G) {
        if (u < NUL) att::ml_passC_unit(p, (char*)lds, NCB + u / (MH * NBLK), (u / NBLK) % MH, u % NBLK);
        else att::ml_passC_unit(p, (char*)lds, (u - NUL) / MH, (u - NUL) % MH, 0); }
}
typedef float f4 __attribute__((ext_vector_type(4)));
typedef unsigned u4 __attribute__((ext_vector_type(4)));
typedef unsigned u2 __attribute__((ext_vector_type(2)));
__device__ __forceinline__ float wave_sum64(float v) { v += swz_xor<1>(v); v += swz_xor<2>(v); v += swz_xor<4>(v); v += swz_xor<8>(v); v += swz_xor<16>(v); return half_sum(v); }
__device__ __forceinline__ float fsilu(float x) { return x * fsigmoid(x); }

__device__ __forceinline__ void phase_mod(const Params& p, char* lds, int bx, int G) {
    const int tid = tid_opaque(), lane = tid & 63, wave = tid >> 6;
    float* SL = (float*)lds; float* PT = (float*)(lds + 32768);
    constexpr int NCG = 6 * DM / 64, NIT = 2 * NCG;
    if (bx >= NIT) return;
    __syncthreads();
    for (int i = tid; i < NCLS * DM; i += NTHREADS) { const int cls = i / DM, k = i % DM; const float cv = cls == 0 ? p.cctx[k] : p.c[(size_t)(cls - 1) * DM + k]; SL[i] = fsilu(cv); }
    for (int item = bx; item < NIT; item += G) {
        __syncthreads();
        const int l = item / NCG, cg = item % NCG; const float* w = p.wmod + (size_t)l * DM * 6 * DM + cg * 64 + lane;
        float acc[NCLS];
#pragma unroll
        for (int r = 0; r < NCLS; ++r) acc[r] = 0.f;
        const int k0 = wave * (DM / 8);
#pragma unroll 8
        for (int k = k0; k < k0 + DM / 8; ++k) { const float wv = w[(size_t)k * 6 * DM];
#pragma unroll
            for (int r = 0; r < NCLS; ++r) acc[r] += SL[r * DM + k] * wv; }
#pragma unroll
        for (int r = 0; r < NCLS; ++r) PT[(wave * NCLS + r) * 64 + lane] = acc[r];
        __syncthreads();
        if (tid < NCLS * 64) { const int r = tid >> 6; float s = p.bmod[(size_t)l * 6 * DM + cg * 64 + lane];
#pragma unroll
            for (int w8 = 0; w8 < 8; ++w8) s += PT[(w8 * NCLS + r) * 64 + lane];
            ((float*)(p.ws + WS_MOD))[((size_t)(l * NCLS + r) * 6 * DM) + cg * 64 + lane] = s; }
    }
}
__device__ __forceinline__ void sw_job(const Params& p, const bf16_t* Bt, int nrows, int l, int which, float* sw, int N, int mode, int gw, int NGW, int lane) {
    if (gw >= nrows) return;
    f4 sh[NCLS][4];
#pragma unroll
    for (int cls = 0; cls < NCLS; ++cls) { const float* s_ = modv(p, l, cls, which); sh[cls][0] = *(const f4*)(s_ + lane * 8); sh[cls][1] = *(const f4*)(s_ + lane * 8 + 4); sh[cls][2] = *(const f4*)(s_ + DM / 2 + lane * 8); sh[cls][3] = *(const f4*)(s_ + DM / 2 + lane * 8 + 4); }
    u4 w0 = *(const u4*)(Bt + (size_t)gw * DM + lane * 8), w1 = *(const u4*)(Bt + (size_t)gw * DM + DM / 2 + lane * 8);
    for (int n = gw; n < nrows; n += NGW) {
        const u4 c0 = w0, c1 = w1; const int nn = n + NGW; if (nn < nrows) { w0 = *(const u4*)(Bt + (size_t)nn * DM + lane * 8); w1 = *(const u4*)(Bt + (size_t)nn * DM + DM / 2 + lane * 8); }
        f4 wa, wb, wc, wd; wa = (f4){__uint_as_float(c0.x << 16), __uint_as_float(c0.x & 0xffff0000u), __uint_as_float(c0.y << 16), __uint_as_float(c0.y & 0xffff0000u)};
        wb = (f4){__uint_as_float(c0.z << 16), __uint_as_float(c0.z & 0xffff0000u), __uint_as_float(c0.w << 16), __uint_as_float(c0.w & 0xffff0000u)};
        wc = (f4){__uint_as_float(c1.x << 16), __uint_as_float(c1.x & 0xffff0000u), __uint_as_float(c1.y << 16), __uint_as_float(c1.y & 0xffff0000u)};
        wd = (f4){__uint_as_float(c1.z << 16), __uint_as_float(c1.z & 0xffff0000u), __uint_as_float(c1.w << 16), __uint_as_float(c1.w & 0xffff0000u)};
        int col = n; if (mode == 1) { const int t = n >> 8, r = n & 255; col = r < 128 ? 128 * t + r : (N / 2) + 128 * t + (r - 128); }
        float mine = 0.f;
#pragma unroll
        for (int cls = 0; cls < NCLS; ++cls) { const f4 t4 = sh[cls][0] * wa + sh[cls][1] * wb + sh[cls][2] * wc + sh[cls][3] * wd; float s = (t4[0] + t4[1]) + (t4[2] + t4[3]); s = wave_sum64(s); if (lane == cls) mine = s; }
        if (lane < NCLS) sw[(size_t)lane * N + col] = mine;
    }
}
static_assert(DM == 1024, "sw_job / norm passes assume 1024 = 64 lanes x 16");
typedef float f32x4g __attribute__((ext_vector_type(4)));
__device__ __forceinline__ void phase_norm0(const Params& p, char* lds, int bx, int G) {
    const int tid = tid_opaque(), lane = tid & 63, wave = tid >> 6; constexpr int WLD = DM + 4;
    float* WG = (float*)lds; float* XS = (float*)(lds + 16 * WLD * 4);
    __syncthreads();
    { f4 tv[DM * 4 / NTHREADS];
#pragma unroll
      for (int it = 0; it < DM * 4 / NTHREADS; ++it) { const int k = it * (NTHREADS / 4) + (tid >> 2); tv[it] = *(const f4*)(p.winab + (size_t)k * ABIN + ABMAIN + 4 * (tid & 3)); }
#pragma unroll
      for (int it = 0; it < DM * 4 / NTHREADS; ++it) { const int k = it * (NTHREADS / 4) + (tid >> 2), g0 = 4 * (tid & 3); WG[(g0 + 0) * WLD + k] = tv[it][0]; WG[(g0 + 1) * WLD + k] = tv[it][1]; WG[(g0 + 2) * WLD + k] = tv[it][2]; WG[(g0 + 3) * WLD + k] = tv[it][3]; } }
    const int r = lane & 15, kq = lane >> 4, pair = wave >> 1, kh = wave & 1;
    float* SQ = XS + pair * 32; float* GP = XS + 128 + pair * 256;
    for (int it = 0;; ++it) {
        const int rb0 = (it * G + bx) * (NWAVES / 2); if (rb0 >= MTOK / 16) break;
        const int rb = rb0 + pair; const int row = rb * 16 + r; const int cls = cls_of(rb * 16); const int kb = 512 * kh + 4 * kq;
        const float* xr = xrow(p, row) + kb;
        f4 x[32]; float s = 0.f;
#pragma unroll
        for (int q = 0; q < 32; ++q) x[q] = *(const f4*)(xr + 16 * q);
#pragma unroll
        for (int q = 0; q < 32; ++q) s += (x[q][0] * x[q][0] + x[q][1] * x[q][1]) + (x[q][2] * x[q][2] + x[q][3] * x[q][3]);
        s += swz_xor<16>(s); s = half_sum(s);
        __syncthreads();
        if (kq == 0) SQ[kh * 16 + r] = s;
        __syncthreads();
        const float rs = 1.0f / sqrtf((SQ[r] + SQ[16 + r]) * (1.0f / DM) + EPSF);
        const float* gp = p.n1g + kb; const float* scp = modv(p, 0, cls, 1) + kb; const float* shp = modv(p, 0, cls, 0) + kb; const float* wp = WG + r * WLD + kb;
        bf16_t* xo = (bf16_t*)(p.ws + WS_XN) + (size_t)row * DM + kb;
        f32x4g acc = {0.f, 0.f, 0.f, 0.f};
#pragma unroll
        for (int q = 0; q < 32; ++q) { const f4 gg = *(const f4*)(gp + 16 * q), sc = *(const f4*)(scp + 16 * q), sh = *(const f4*)(shp + 16 * q), w = *(const f4*)(wp + 16 * q);
            const f4 h = x[q] * rs * gg * (sc + 1.0f) + sh;
            u2 o; o.x = pg8::cvt_pk_bf16(h[0], h[1]); o.y = pg8::cvt_pk_bf16(h[2], h[3]); *(u2*)(xo + 16 * q) = o;
            acc = __builtin_amdgcn_mfma_f32_16x16x4f32(h[0], w[0], acc, 0, 0, 0); acc = __builtin_amdgcn_mfma_f32_16x16x4f32(h[1], w[1], acc, 0, 0, 0);
            acc = __builtin_amdgcn_mfma_f32_16x16x4f32(h[2], w[2], acc, 0, 0, 0); acc = __builtin_amdgcn_mfma_f32_16x16x4f32(h[3], w[3], acc, 0, 0, 0); }
        if (kh == 1) *(f32x4g*)(GP + lane * 4) = acc;
        __syncthreads();
        if (kh == 0) { const f32x4g o2 = *(const f32x4g*)(GP + lane * 4); const float bg = p.bgate[r];
#pragma unroll
            for (int e = 0; e < 4; ++e) { float a = acc[e] + o2[e] + bg; if ((r & 7) >= 4) a = logsigmoidf_(a); ((float*)(p.ws + WS_GATES))[(size_t)(rb * 16 + 4 * kq + e) * NGATE + r] = a; } }
    }
}
static_assert(MTOK % 64 == 0 && MC % 16 == 0 && LSEQ % 16 == 0 && DM == 1024, "norm0 row blocks");
__device__ __forceinline__ void phase_conv(const Params& p, char* lds, int ufirst, int ustride, int uend) {
    const int tid = tid_opaque(), lane = tid & 63, wave = tid >> 6; constexpr int TT = 32, NR = TT + CWID - 1;
    bf16_t* X = (bf16_t*)lds; float* OUT = (float*)(lds + 65536);
    const int cp = tid & 255, tg = tid >> 8, c0 = 2 * cp;
    float w0[CWID], w1[CWID];
#pragma unroll
    for (int j = 0; j < CWID; ++j) { w0[j] = p.convw[(size_t)j * CCH + c0]; w1[j] = p.convw[(size_t)j * CCH + c0 + 1]; }
    const float b0 = p.convb[c0], b1 = p.convb[c0 + 1];
    const bf16_t* U = (const bf16_t*)(p.ws + WS_UPRE);
    for (int u = ufirst; u < uend; u += ustride) {
        const int row0 = u * TT, pos0 = pos_of(row0), len = seqlen_of(row0);
        __syncthreads();
        { u4 val[8];
#pragma unroll
          for (int i = 0; i < 8; ++i) { const int c = tid + NTHREADS * i, r = c / (CCH / 8), ch = (c % (CCH / 8)) * 8; const int t = pos0 + r - CWID / 2;
              val[i] = (u4){0u, 0u, 0u, 0u}; if (c < NR * (CCH / 8) && t >= 0 && t < len) val[i] = *(const u4*)(U + (size_t)(row0 + r - CWID / 2) * CCH + ch); }
#pragma unroll
          for (int i = 0; i < 8; ++i) { const int c = tid + NTHREADS * i, r = c / (CCH / 8), ch = (c % (CCH / 8)) * 8; if (c < NR * (CCH / 8)) *(u4*)(X + (size_t)r * CCH + ch) = val[i]; } }
        __syncthreads();
#pragma unroll 2
        for (int tt = 0; tt < TT / 2; ++tt) { const int t = tg * (TT / 2) + tt; float a0 = b0, a1 = b1;
#pragma unroll
            for (int j = 0; j < CWID; ++j) { const unsigned xx = *(const unsigned*)(X + (size_t)(t + j) * CCH + c0); a0 += w0[j] * __uint_as_float(xx << 16); a1 += w1[j] * __uint_as_float(xx & 0xffff0000u); }
            *(float2*)(OUT + (size_t)t * CCH + c0) = make_float2(a0, a1); }
        __syncthreads();
#pragma unroll
        for (int q = 0; q < TT / NWAVES; ++q) { const int t = wave * (TT / NWAVES) + q; const f4 x0 = *(const f4*)(OUT + (size_t)t * CCH + lane * 8), x1 = *(const f4*)(OUT + (size_t)t * CCH + lane * 8 + 4);
            const float mu = wave_sum64((x0[0] + x0[1]) + (x0[2] + x0[3]) + (x1[0] + x1[1]) + (x1[2] + x1[3])) * (1.0f / CCH);
            const f4 d0 = x0 - mu, d1 = x1 - mu;
            const float var = wave_sum64((d0[0] * d0[0] + d0[1] * d0[1]) + (d0[2] * d0[2] + d0[3] * d0[3]) + (d1[0] * d1[0] + d1[1] * d1[1]) + (d1[2] * d1[2] + d1[3] * d1[3])) * (1.0f / CCH);
            const float rs = 1.0f / sqrtf(var + EPSF);
            const f4 g0 = *(const f4*)(p.lng + lane * 8), g1 = *(const f4*)(p.lng + lane * 8 + 4), be0 = *(const f4*)(p.lnb + lane * 8), be1 = *(const f4*)(p.lnb + lane * 8 + 4);
            const f4 y0 = d0 * rs * g0 + be0, y1 = d1 * rs * g1 + be1; u4 w;
            w.x = pg8::cvt_pk_bf16(fsilu(y0[0]), fsilu(y0[1])); w.y = pg8::cvt_pk_bf16(fsilu(y0[2]), fsilu(y0[3])); w.z = pg8::cvt_pk_bf16(fsilu(y1[0]), fsilu(y1[1])); w.w = pg8::cvt_pk_bf16(fsilu(y1[2]), fsilu(y1[3]));
            *(u4*)((bf16_t*)(p.ws + WS_UH) + (size_t)(row0 + t) * DM + lane * 8) = w; }
    }
}
static_assert(CCH == 512 && CSEQ % 32 == 0 && LSEQ % 32 == 0, "conv phase geometry");
__device__ __forceinline__ void phase_cachecvt(const Params& p, int gtid, int gthreads) {
    constexpr int PER = PAST * NKV * HDIM / 8;
    for (int i = gtid; i < NLB * PER; i += gthreads) { const int b = i / PER, e = (i % PER) * 8; const size_t src = (size_t)b * PAST * NKV * HDIM + e, dst = ((size_t)b * SKVL + LSEQ) * NKV * HDIM + e;
        const f4 k0 = *(const f4*)(p.ck + src), k1 = *(const f4*)(p.ck + src + 4), v0 = *(const f4*)(p.cv + src), v1 = *(const f4*)(p.cv + src + 4); u4 wk, wv;
        wk.x = pg8::cvt_pk_bf16(k0[0], k0[1]); wk.y = pg8::cvt_pk_bf16(k0[2], k0[3]); wk.z = pg8::cvt_pk_bf16(k1[0], k1[1]); wk.w = pg8::cvt_pk_bf16(k1[2], k1[3]);
        wv.x = pg8::cvt_pk_bf16(v0[0], v0[1]); wv.y = pg8::cvt_pk_bf16(v0[2], v0[3]); wv.z = pg8::cvt_pk_bf16(v1[0], v1[1]); wv.w = pg8::cvt_pk_bf16(v1[2], v1[3]);
        *(u4*)((bf16_t*)(p.ws + WS_LATK) + dst) = wk; *(u4*)((bf16_t*)(p.ws + WS_LATV) + dst) = wv; }
}
__device__ __forceinline__ void phase_qkpost(const Params& p, int gw, int NGW, int lane) {
    const int hh = lane >> 5, l5 = lane & 31, half = l5 >> 4, f0 = (l5 & 15) * 2, d1 = half * 64 + f0, d2 = d1 + 32;
    const float inv0 = __builtin_amdgcn_exp2f(-(float)f0 * (13.287712379549449f / 32.0f)), inv1 = __builtin_amdgcn_exp2f(-(float)(f0 + 1) * (13.287712379549449f / 32.0f));
    const float qg[4] = {p.qng[d1], p.qng[d1 + 1], p.qng[d2], p.qng[d2 + 1]}, kg[4] = {p.kng[d1], p.kng[d1 + 1], p.kng[d2], p.kng[d2 + 1]};
    for (int row = gw; row < MTOK; row += NGW) {
        const bool lat = row >= MC; const int sp = pos_of(row); float cs0 = 1.f, sn0 = 0.f, cs1 = 1.f, sn1 = 0.f;
        if (lat) { const float pos = (float)(half == 0 ? sp / GRIDW : sp % GRIDW); cs0 = __cosf(pos * inv0); sn0 = __sinf(pos * inv0); cs1 = __cosf(pos * inv1); sn1 = __sinf(pos * inv1); }
        bf16_t* Q = (bf16_t*)(p.ws + WS_QRAW) + (size_t)row * NQ * HDIM; const bf16_t* KR = (const bf16_t*)(p.ws + WS_KRAW) + (size_t)row * NKV * HDIM;
        unsigned ra[NQ / 2 + 1], rb[NQ / 2 + 1];
#pragma unroll
        for (int it = NQ / 2; it <= NQ / 2; ++it) { const bf16_t* src = it < NQ / 2 ? Q + (2 * it + hh) * HDIM : KR + hh * HDIM; ra[it] = *(const unsigned*)(src + d1); rb[it] = *(const unsigned*)(src + d2); }
#pragma unroll
        for (int it = NQ / 2; it <= NQ / 2; ++it) { const bool isq = it < NQ / 2;
            const float x1a = __uint_as_float(ra[it] << 16), x1b = __uint_as_float(ra[it] & 0xffff0000u), x2a = __uint_as_float(rb[it] << 16), x2b = __uint_as_float(rb[it] & 0xffff0000u);
            float ss = (x1a * x1a + x1b * x1b) + (x2a * x2a + x2b * x2b); ss += swz_xor<1>(ss); ss += swz_xor<2>(ss); ss += swz_xor<4>(ss); ss += swz_xor<8>(ss); ss += swz_xor<16>(ss);
            const float rs = 1.0f / sqrtf(ss * (1.0f / HDIM) + EPSF); const float* g = isq ? qg : kg;
            const float a0 = x1a * rs * g[0], a1 = x1b * rs * g[1], b0 = x2a * rs * g[2], b1 = x2b * rs * g[3];
            const float y1a = a0 * cs0 - b0 * sn0, y2a = a0 * sn0 + b0 * cs0, y1b = a1 * cs1 - b1 * sn1, y2b = a1 * sn1 + b1 * cs1;
            const unsigned w1 = pg8::cvt_pk_bf16(y1a, y1b), w2 = pg8::cvt_pk_bf16(y2a, y2b);
            if (isq) { bf16_t* dst = Q + (2 * it + hh) * HDIM; *(unsigned*)(dst + d1) = w1; *(unsigned*)(dst + d2) = w2; }
            else if (!lat) { bf16_t* K = (bf16_t*)(p.ws + WS_CTXK) + (size_t)row * NKV * HDIM + hh * HDIM; *(unsigned*)(K + d1) = w1; *(unsigned*)(K + d2) = w2;
                float* fo = p.out + O_K + (size_t)row * NKV * HDIM + hh * HDIM; *(float2*)(fo + d1) = make_float2(y1a, y1b); *(float2*)(fo + d2) = make_float2(y2a, y2b); }
            else { const int b_ = (row - MC) / LSEQ, s_ = (row - MC) % LSEQ; bf16_t* K = (bf16_t*)(p.ws + WS_LATK) + ((size_t)b_ * SKVL + s_) * NKV * HDIM + hh * HDIM; *(unsigned*)(K + d1) = w1; *(unsigned*)(K + d2) = w2; } }
    }
}
static_assert(NKV == 2 && NQ % 2 == 0 && HDIM == 128, "qkpost lane mapping");
__device__ __forceinline__ void phase_final(const Params& p, int gw, int NGW, int lane) {
    const f4 g0 = *((const f4*)p.fng + 2 * lane), g1 = *((const f4*)p.fng + 2 * lane + 1), g2 = *((const f4*)p.fng + 128 + 2 * lane), g3 = *((const f4*)p.fng + 128 + 2 * lane + 1);
    const float* sq = (const float*)(p.ws + WS_SSQ) + (size_t)3 * SSQ_STRIDE;
    for (int row = gw; row < MTOK; row += 2 * NGW) { const int row2 = row + NGW; const bool has2 = row2 < MTOK; const int r2 = has2 ? row2 : row;
        const float rsa = 1.0f / sqrtf(sq[row] * (1.0f / DM) + EPSF), rsb = 1.0f / sqrtf(sq[r2] * (1.0f / DM) + EPSF);
        const u4* ya = (const u4*)((const bf16_t*)(p.ws + WS_Y16) + (size_t)row * DM) + lane; const u4* yb = (const u4*)((const bf16_t*)(p.ws + WS_Y16) + (size_t)r2 * DM) + lane;
        const u4 a0 = ya[0], a1 = ya[64], b0 = yb[0], b1 = yb[64];
        f4* oa = (f4*)(p.out + O_Y + (size_t)row * DM) + 2 * lane; f4* ob = (f4*)(p.out + O_Y + (size_t)r2 * DM) + 2 * lane;
#define UNP_LO(V_) (f4){__uint_as_float((V_).x << 16), __uint_as_float((V_).x & 0xffff0000u), __uint_as_float((V_).y << 16), __uint_as_float((V_).y & 0xffff0000u)}
#define UNP_HI(V_) (f4){__uint_as_float((V_).z << 16), __uint_as_float((V_).z & 0xffff0000u), __uint_as_float((V_).w << 16), __uint_as_float((V_).w & 0xffff0000u)}
        oa[0] = UNP_LO(a0) * rsa * g0; oa[1] = UNP_HI(a0) * rsa * g1; oa[128] = UNP_LO(a1) * rsa * g2; oa[129] = UNP_HI(a1) * rsa * g3;
        if (has2) { ob[0] = UNP_LO(b0) * rsb * g0; ob[1] = UNP_HI(b0) * rsb * g1; ob[128] = UNP_LO(b1) * rsb * g2; ob[129] = UNP_HI(b1) * rsb * g3; }
#undef UNP_LO
#undef UNP_HI
    }
}
template <class Epi> __device__ __forceinline__ void gemm_call(LAS unsigned char* lds, const bf16_t* A, const bf16_t* Bt, int N, int K, const Epi& E) {
    pg8::Gemm g{A, Bt, MTOK, N, K}; pg8::StaticOrder S; S.init(MTOK, N, K, (int)gridDim.x, (int)blockIdx.x);
    pg8::gemm_phase<Epi, pg8::StaticOrder, true, true>((PG8_LAS unsigned char*)lds, g, S, E);
}
#ifdef PROBE_A
#define ISTAMP(i) do { if (blockIdx.x == 0 && threadIdx.x == 0 && K == PROBE_K) *(volatile LAS unsigned*)(uintptr_t)(MISC_OFF + 4 * (i)) = (unsigned)__builtin_amdgcn_s_memrealtime(); } while (0)
#else
#define ISTAMP(i) do {} while (0)
#endif
__device__ __forceinline__ void gemm_call_split(LAS unsigned char* lds, const bf16_t* A, const bf16_t* Bt, int N, int K, const EpiRes& E, unsigned char* slab, unsigned* cnt) {
    pg8::Gemm g{A, Bt, MTOK, N, K}; RoundZeroOrder S0; S0.init(MTOK, N, K, (int)gridDim.x, (int)blockIdx.x);
    ISTAMP(0);
    pg8::gemm_phase<EpiRes, RoundZeroOrder, true, true>((PG8_LAS unsigned char*)lds, g, S0, E);
    ISTAMP(1);
    if (S0.split) { QuarterOrder S1; S1.init(MTOK, N, K, (int)gridDim.x, (int)blockIdx.x);
        pg8::gemm_phase<EpiPartial, QuarterOrder, true, true>((PG8_LAS unsigned char*)lds, g, S1, EpiPartial{slab, cnt});
        ISTAMP(2);
        tail_reduce(E, slab, cnt, (int)gridDim.x, (int)blockIdx.x, N / 256, MTOK / 256); ISTAMP(3); }
}
__global__ void __launch_bounds__(NTHREADS, 2) mega_fwd(Params p) {
    extern __shared__ __attribute__((aligned(16))) unsigned char lds[];
    LAS unsigned char* L = (LAS unsigned char*)lds;
    for (int u = threadIdx.x; u < (LDS_BYTES - LDSCTL_OFF) / 4; u += NTHREADS) ((LAS unsigned*)(L + LDSCTL_OFF))[u] = 0u;
    __syncthreads();
    volatile LAS unsigned* MISC = (volatile LAS unsigned*)(L + MISC_OFF);
    const XcdBarrier bar = xcd_barrier_post((unsigned*)(p.ws + WS_CTL) + CW_BAR, MISC + 8);
    const int G = gridDim.x, bx = blockIdx.x; const int vcu = (G % 8 == 0) ? (bx % 8) * (G / 8) + bx / 8 : bx;
    unsigned char* ws = p.ws;
    const bf16_t* XN = (const bf16_t*)(ws + WS_XN); const bf16_t* UH = (const bf16_t*)(ws + WS_UH); const bf16_t* Hh = (const bf16_t*)(ws + WS_H); const bf16_t* Ob = (const bf16_t*)(ws + WS_O);
    float* SW0 = (float*)(ws + WS_SW); float* SWC = SW0 + (size_t)NCLS * 2 * DFF; float* SW1 = SWC + (size_t)NCLS * CIN;
    float* SSQ = (float*)(ws + WS_SSQ); float* Y = p.out + O_Y; unsigned* SPLITC = (unsigned*)(ws + WS_CTL) + CW_SPLIT;
#define WAVE_IDS() const int tid_ = tid_opaque(); const int lane_ = tid_ & 63; const int gw_ = bx * NWAVES + (tid_ >> 6); const int NGW_ = G * NWAVES
    p0_weights(p, L, vcu, G); phase_mod(p, (char*)lds, bx, G);
    xcd_barrier(bar);
    phase_norm0(p, (char*)lds, bx, G);
    xcd_barrier(bar);
    gemm_call(L, XN, (const bf16_t*)(ws + WB_AB), ABMAIN, DM, EpiAB{(bf16_t*)(ws + WS_UPRE), (bf16_t*)(ws + WS_QKVO)}); xcd_barrier(bar);
    ml_phase_A(p, lds, vcu, G);
    { WAVE_IDS(); constexpr int NU_ML = NLB * MH * NBLK + NCB * MH; const int nsecond = (NU_ML > G && NU_ML - G < G) ? NU_ML - G : 0;
      if (vcu >= nsecond) { const int gw2 = (vcu - nsecond) * NWAVES + (tid_ >> 6), ngw2 = (G - nsecond) * NWAVES;
        sw_job(p, (const bf16_t*)(ws + WB_FFI0), 2 * DFF, 0, 3, SW0, 2 * DFF, 1, gw2, ngw2, lane_); sw_job(p, (const bf16_t*)(ws + WB_INC), CIN, 1, 0, SWC, CIN, 0, gw2, ngw2, lane_);
        sw_job(p, (const bf16_t*)(ws + WB_FFI1), 2 * DFF, 1, 3, SW1, 2 * DFF, 1, gw2, ngw2, lane_); } }
    xcd_barrier(bar);
    { WAVE_IDS(); MlScan sc{p}; for (long i = bx * (long)NTHREADS + tid_; i < MlScan::count(); i += (long)G * NTHREADS) sc(i); } xcd_barrier(bar);
    ml_phase_C(p, lds, vcu, G);
    { constexpr int NU_ML = NLB * MH * NBLK + NCB * MH, NU_CV = MTOK / 32; const int nsecond = (NU_ML > G && NU_ML - G < G) ? NU_ML - G : 0;
      if (G == 256 && nsecond == 64 && NU_CV == 640) { if (vcu < 64) phase_conv(p, (char*)lds, vcu, 1 << 30, NU_CV); else phase_conv(p, (char*)lds, 64 + (vcu - 64), 192, NU_CV); }
      else phase_conv(p, (char*)lds, vcu, G, NU_CV); }
    xcd_barrier(bar);
    gemm_call_split(L, UH, (const bf16_t*)(ws + WB_OUTAB), DM, DM, EpiRes{p.xp, p.xs, (bf16_t*)(ws + WS_Y16), (bf16_t*)(ws + WS_XN), SSQ + 0 * SSQ_STRIDE, modv(p, 0, 0, 2), modv(p, 0, 0, 4), p.n2g, 1, 0}, (unsigned char*)Y, SPLITC + 0 * 4096); xcd_barrier(bar);
    gemm_call(L, XN, (const bf16_t*)(ws + WB_FFI0), 2 * DFF, DM, EpiFfnIn{(bf16_t*)(ws + WS_H), SSQ + 0 * SSQ_STRIDE, SW0}); xcd_barrier(bar);
    gemm_call_split(L, Hh, (const bf16_t*)(ws + WB_FFO0), DM, DFF, EpiRes{p.xp, p.xs, (bf16_t*)(ws + WS_Y16), (bf16_t*)(ws + WS_XN), SSQ + 1 * SSQ_STRIDE, modv(p, 0, 0, 5), modv(p, 1, 0, 1), p.n1g + DM, 0, 0}, (unsigned char*)Y + SLAB_BYTES, SPLITC + 1 * 4096); xcd_barrier(bar);
    gemm_call(L, XN, (const bf16_t*)(ws + WB_INC), CIN, DM, EpiQkv{(bf16_t*)(ws + WS_QRAW), (bf16_t*)(ws + WS_KRAW), (bf16_t*)(ws + WS_CTXV), (bf16_t*)(ws + WS_LATV), p.out + O_V, SSQ + 1 * SSQ_STRIDE, SWC}); xcd_barrier(bar);
    { WAVE_IDS(); phase_qkpost(p, gw_, NGW_, lane_); phase_cachecvt(p, bx * NTHREADS + tid_, G * NTHREADS); } xcd_barrier(bar);
    attn_phase(p, lds, vcu, G); xcd_barrier(bar);
    gemm_call_split(L, Ob, (const bf16_t*)(ws + WB_OUTC), DM, DM, EpiRes{p.xp, p.xs, (bf16_t*)(ws + WS_Y16), (bf16_t*)(ws + WS_XN), SSQ + 2 * SSQ_STRIDE, modv(p, 1, 0, 2), modv(p, 1, 0, 4), p.n2g + DM, 0, 0}, (unsigned char*)Y, SPLITC + 2 * 4096); xcd_barrier(bar);
    gemm_call(L, XN, (const bf16_t*)(ws + WB_FFI1), 2 * DFF, DM, EpiFfnIn{(bf16_t*)(ws + WS_H), SSQ + 2 * SSQ_STRIDE, SW1}); xcd_barrier(bar);
    gemm_call_split(L, Hh, (const bf16_t*)(ws + WB_FFO1), DM, DFF, EpiRes{p.xp, p.xs, (bf16_t*)(ws + WS_Y16), (bf16_t*)(ws + WS_XN), SSQ + 3 * SSQ_STRIDE, modv(p, 1, 0, 5), modv(p, 1, 0, 1), nullptr, 0, 0}, (unsigned char*)Y + SLAB_BYTES, SPLITC + 3 * 4096); xcd_barrier(bar);
    { WAVE_IDS(); phase_final(p, gw_, NGW_, lane_); }
#undef WAVE_IDS
}
static Params make_params(void* const* d_in, void* d_out, void* d_ws) {
    Params p{}; const float** pp = (const float**)&p; for (int i = 0; i < 28; ++i) pp[i] = (const float*)d_in[i];
    p.out = (float*)d_out; p.ws = (unsigned char*)d_ws; return p;
}
extern "C" void kernel_launch(void* const* d_in, const int* in_sizes, int n_in, void* d_out, int out_size, void* d_ws, size_t ws_size, hipStream_t stream) {
    static int grid = 0;
    if (grid == 0) {
        if (n_in != 28 || (size_t)out_size != O_END || ws_size < WS_END || in_sizes[0] != MC * DM || in_sizes[1] != ML * DM) {
            fprintf(stderr, "kernel_launch: shape mismatch n_in %d out %d (want %zu) ws %zu (want %zu)\n", n_in, out_size, (size_t)O_END, ws_size, (size_t)WS_END); grid = -1; return; }
        int dev = 0, cus = 0;
        if (hipGetDevice(&dev) != hipSuccess || hipDeviceGetAttribute(&cus, hipDeviceAttributeMultiprocessorCount, dev) != hipSuccess) { grid = -1; return; }
        if (hipFuncSetAttribute((const void*)mega_fwd, hipFuncAttributeMaxDynamicSharedMemorySize, LDS_BYTES) != hipSuccess) { fprintf(stderr, "hipFuncSetAttribute failed\n"); grid = -1; return; }
        int per_cu = 0; (void)hipOccupancyMaxActiveBlocksPerMultiprocessor(&per_cu, (const void*)mega_fwd, NTHREADS, LDS_BYTES); (void)hipGetLastError();
        if (per_cu < 1) fprintf(stderr, "kernel_launch: occupancy query says %d blocks/CU\n", per_cu);
        grid = cus;
    }
    if (grid < 0) return;
    hipMemsetAsync((char*)d_ws + WS_CTL, 0, CTL_ZERO_BYTES, stream);
    Params p = make_params(d_in, d_out, d_ws);
    hipLaunchKernelGGL(mega_fwd, dim3(grid), dim3(NTHREADS), LDS_BYTES, stream, p);
}
```

```cpp
#ifdef HOST_TEST
#include <cmath>
#include <cstdio>
#include <cstdlib>
#include <cstring>
#include <cstdint>
#include <vector>
#define HD_FN inline
#define DEV_FN inline
#else
#include <hip/hip_runtime.h>
#include <cstdio>
#include <cstdint>
#define HD_FN __host__ __device__ __forceinline__
#define DEV_FN __device__ __forceinline__
#endif

#ifdef TINY
constexpr int DM = 512, NCB = 2, CSEQ = 128, NLB = 2, LSEQ = 128, PAST = 128;
#else
constexpr int DM = 1024, NCB = 16, CSEQ = 256, NLB = 4, LSEQ = 4096, PAST = 256;
#endif
constexpr int GRIDW = 64, CCH = DM / 2, CWID = 31, MH = 4, MDK = CCH / MH, MW = CCH, NGATE = 16;
constexpr int ABIN = 2 * CCH + 4 * MW + NGATE, ABMAIN = 2 * CCH + 4 * MW;
constexpr int HDIM = 128, NQ = DM / HDIM, NKV = 2, GRP = NQ / NKV, CIN = (NQ + 2 * NKV) * HDIM;
constexpr int DFF = ((8 * DM + 3 * 256 - 1) / (3 * 256)) * 256;
constexpr int MC = NCB * CSEQ, ML = NLB * LSEQ, MTOK = MC + ML, NCLS = 1 + NLB, SKVL = LSEQ + PAST;
constexpr float EPSF = 1e-6f;
constexpr int NSEQ = NCB + NLB;

constexpr size_t O_Y = 0, O_C = (size_t)MTOK * DM, O_N = O_C + (size_t)NCB * 2 * MH * MDK * MDK, O_M = O_N + (size_t)NCB * 2 * MH * MDK,
                 O_K = O_M + (size_t)NCB * 2 * MH, O_V = O_K + (size_t)NCB * CSEQ * NKV * HDIM, O_END = O_V + (size_t)NCB * CSEQ * NKV * HDIM;

constexpr size_t MiB = 1u << 20;
#ifdef TINY
constexpr size_t WSCALE = 1;
#endif
constexpr size_t WS_CTL = 0, CTL_ZERO_BYTES = 1 * MiB;
constexpr size_t WS_MOD = 1 * MiB;
constexpr size_t WS_SW = WS_MOD + 256 * 1024;
constexpr size_t WS_SSQ = 512 * 1024;
constexpr int SSQ_STRIDE = 32768;
constexpr size_t WS_DEN = 232 * MiB;
constexpr size_t WS_WB = 2 * MiB;
constexpr size_t WS_XN = 50 * MiB;
constexpr size_t WS_UPRE = 90 * MiB;
constexpr size_t WS_QKVO = 110 * MiB;
constexpr size_t WS_UH = 190 * MiB;
constexpr size_t WS_GATES = 230 * MiB;
constexpr size_t WS_HS = 50 * MiB;
constexpr size_t WS_Y16 = 90 * MiB;
constexpr size_t WS_H = 130 * MiB;
constexpr size_t WS_QRAW = 130 * MiB;
constexpr size_t WS_LATK = 170 * MiB, WS_LATV = 179 * MiB, WS_CTXK = 188 * MiB, WS_CTXV = 190 * MiB;
constexpr size_t WS_KRAW = 192 * MiB;
constexpr size_t WS_O = 202 * MiB;
constexpr size_t WS_END = 256 * MiB;

typedef unsigned short bf16_t;
HD_FN float bf2f(bf16_t h) { unsigned u = (unsigned)h << 16; return __builtin_bit_cast(float, u); }
HD_FN bf16_t f2bf(float f) { unsigned u = __builtin_bit_cast(unsigned, f); return (bf16_t)((u + 0x7fffu + ((u >> 16) & 1u)) >> 16); }
HD_FN float rbf(float f) { return bf2f(f2bf(f)); }
HD_FN float sigmoidf_(float x) { return 1.0f / (1.0f + expf(-x)); }
HD_FN float siluf_(float x) { return x * sigmoidf_(x); }
HD_FN float logsigmoidf_(float x) { return x >= 0.f ? -log1pf(expf(-x)) : x - log1pf(expf(x)); }
HD_FN int cls_of(int row) { return row < MC ? 0 : 1 + (row - MC) / LSEQ; }
HD_FN int seqlen_of(int row) { return row < MC ? CSEQ : LSEQ; }
HD_FN int pos_of(int row) { return row < MC ? row % CSEQ : (row - MC) % LSEQ; }

struct Params {
    const float *xp, *xs, *c, *stC, *stn, *stm, *ck, *cv, *cctx, *wmod, *bmod, *n1g, *n2g, *winab, *bgate, *convw, *convb, *lng, *lnb, *mng,
        *woutab, *winc, *qng, *kng, *woutc, *wffi, *wffo, *fng;
    float* out; unsigned char* ws;
};
HD_FN const float* xrow(const Params& p, int row) { return row < MC ? p.xp + (size_t)row * DM : p.xs + (size_t)(row - MC) * DM; }
HD_FN const float* modv(const Params& p, int l, int cls, int which) { return (const float*)(p.ws + WS_MOD) + ((size_t)(l * NCLS + cls) * 6 + which) * DM; }
constexpr size_t WS_RS0 = 233 * MiB;

struct NMod {
    Params p; static HD_FN long count() { return 2L * NCLS * 6 * DM; }
    HD_FN void operator()(long idx) const {
        const int col = (int)(idx % (6 * DM)); const int cls = (int)((idx / (6 * DM)) % NCLS); const int l = (int)(idx / (6 * DM * NCLS));
        const float* cond = cls == 0 ? p.cctx : p.c + (size_t)(cls - 1) * DM;
        const float* w = p.wmod + (size_t)l * DM * 6 * DM;
        float acc = 0.f;
        for (int k = 0; k < DM; ++k) acc += siluf_(cond[k]) * w[(size_t)k * 6 * DM + col];
        ((float*)(p.ws + WS_MOD))[idx] = acc + p.bmod[(size_t)l * 6 * DM + col];
    }
};
struct NNorm0a {
    Params p; static HD_FN long count() { return MTOK; }
    HD_FN void operator()(long row) const {
        const float* x = xrow(p, (int)row); float s = 0.f;
        for (int k = 0; k < DM; ++k) s += x[k] * x[k];
        ((float*)(p.ws + WS_RS0))[row] = 1.0f / sqrtf(s / DM + EPSF);
    }
};
struct NNorm0b {
    Params p; static HD_FN long count() { return (long)MTOK * DM; }
    HD_FN void operator()(long idx) const {
        const int row = (int)(idx / DM), col = (int)(idx % DM), cls = cls_of(row);
        const float rs = ((const float*)(p.ws + WS_RS0))[row];
        const float v = xrow(p, row)[col] * rs * p.n1g[col] * (1.f + modv(p, 0, cls, 1)[col]) + modv(p, 0, cls, 0)[col];
        ((bf16_t*)(p.ws + WS_XN))[idx] = f2bf(v);
    }
};
struct NGates {
    Params p; static HD_FN long count() { return (long)MTOK * NGATE; }
    HD_FN void operator()(long idx) const {
        const int row = (int)(idx / NGATE), j = (int)(idx % NGATE), cls = cls_of(row);
        const float rs = ((const float*)(p.ws + WS_RS0))[row]; const float* x = xrow(p, row);
        const float* sc = modv(p, 0, cls, 1); const float* sh = modv(p, 0, cls, 0);
        float acc = 0.f;
        for (int k = 0; k < DM; ++k) { const float h = x[k] * rs * p.n1g[k] * (1.f + sc[k]) + sh[k]; acc += h * p.winab[(size_t)k * ABIN + ABMAIN + j]; }
        acc += p.bgate[j];
        if ((j & 7) >= 4) acc = logsigmoidf_(acc);
        ((float*)(p.ws + WS_GATES))[idx] = acc;
    }
};

template <bool DUAL, class Epi> struct NGemm {
    const bf16_t* A; const float* B; int lda, ldb, K, N, off2, pad_; Epi epi;
    HD_FN long count() const { return (long)(MTOK / 4) * (N / 4); }
    HD_FN void operator()(long idx) const {
        const int nt = (int)(idx % (N / 4)), mt = (int)(idx / (N / 4)); const int m0 = mt * 4, n0 = nt * 4;
        float acc[4][4], acc2[4][4];
#pragma unroll
        for (int i = 0; i < 4; ++i)
#pragma unroll
            for (int j = 0; j < 4; ++j) { acc[i][j] = 0.f; acc2[i][j] = 0.f; }
        for (int k0 = 0; k0 < K; k0 += 8) {
            float a[4][8];
#pragma unroll
            for (int i = 0; i < 4; ++i) {
                const bf16_t* ap = A + (size_t)(m0 + i) * lda + k0;
#pragma unroll
                for (int kk = 0; kk < 8; ++kk) a[i][kk] = bf2f(ap[kk]);
            }
#pragma unroll
            for (int kk = 0; kk < 8; ++kk) {
                const float* bp = B + (size_t)(k0 + kk) * ldb + n0;
                float b[4], b2[4];
#pragma unroll
                for (int j = 0; j < 4; ++j) { b[j] = rbf(bp[j]); b2[j] = DUAL ? rbf(bp[off2 + j]) : 0.f; }
#pragma unroll
                for (int i = 0; i < 4; ++i)
#pragma unroll
                    for (int j = 0; j < 4; ++j) { acc[i][j] += a[i][kk] * b[j]; if (DUAL) acc2[i][j] += a[i][kk] * b2[j]; }
            }
        }
#pragma unroll
        for (int i = 0; i < 4; ++i)
#pragma unroll
            for (int j = 0; j < 4; ++j) epi(m0 + i, n0 + j, acc[i][j], acc2[i][j]);
    }
};
struct EGlu { Params p; HD_FN void operator()(int row, int col, float v, float v2) const { ((bf16_t*)(p.ws + WS_UPRE))[(size_t)row * CCH + col] = f2bf(v * sigmoidf_(v2)); } };
struct EQkvo { Params p; HD_FN void operator()(int row, int col, float v, float) const {
        const int part = col / MW; if (part == 1) v *= 1.0f / sqrtf((float)MDK); if (part == 3) v = sigmoidf_(v);
        ((bf16_t*)(p.ws + WS_QKVO))[(size_t)row * 4 * MW + col] = f2bf(v); } };
struct EOut { Params p; int l; int pad_ = 0; HD_FN void operator()(int row, int col, float v, float) const {
        const int cls = cls_of(row); float* Y = p.out + O_Y + (size_t)row * DM + col;
        const float xin = l == 0 ? xrow(p, row)[col] : *Y;
        const float x1 = xin + modv(p, l, cls, 2)[col] * v; *Y = x1;
        ((bf16_t*)(p.ws + WS_XN))[(size_t)row * DM + col] = f2bf(x1 * p.n2g[(size_t)l * DM + col] * (1.f + modv(p, l, cls, 4)[col])); } };
struct EFfnIn { Params p; const float* sw; int slot; int pad_ = 0; HD_FN void operator()(int row, int col, float v, float v2) const {
        const int cls = cls_of(row); const float rs = 1.0f / sqrtf(((const float*)(p.ws + WS_SSQ))[(size_t)slot * SSQ_STRIDE + row] / DM + EPSF);
        const float a = v * rs + sw[(size_t)cls * 2 * DFF + col], b = v2 * rs + sw[(size_t)cls * 2 * DFF + DFF + col];
        ((bf16_t*)(p.ws + WS_H))[(size_t)row * DFF + col] = f2bf(siluf_(a) * b); } };
struct EFfnOut { Params p; int l; int pad_ = 0; HD_FN void operator()(int row, int col, float v, float) const {
        const int cls = cls_of(row); float* Y = p.out + O_Y + (size_t)row * DM + col;
        const float x2 = *Y + modv(p, l, cls, 5)[col] * v; *Y = x2;
        if (l == 0) ((bf16_t*)(p.ws + WS_XN))[(size_t)row * DM + col] = f2bf(x2 * p.n1g[(size_t)DM + col] * (1.f + modv(p, 1, cls, 1)[col])); } };
struct EQkv { Params p; const float* sw; int slot; int pad_ = 0; HD_FN void operator()(int row, int col, float v, float) const {
        const int cls = cls_of(row); const float rs = 1.0f / sqrtf(((const float*)(p.ws + WS_SSQ))[(size_t)slot * SSQ_STRIDE + row] / DM + EPSF);
        const float a = v * rs + sw[(size_t)cls * CIN + col];
        if (col < NQ * HDIM) ((bf16_t*)(p.ws + WS_QRAW))[(size_t)row * NQ * HDIM + col] = f2bf(a);
        else if (col < (NQ + NKV) * HDIM) ((bf16_t*)(p.ws + WS_KRAW))[(size_t)row * NKV * HDIM + (col - NQ * HDIM)] = f2bf(a);
        else { const int c2 = col - (NQ + NKV) * HDIM;
            if (row < MC) { ((bf16_t*)(p.ws + WS_CTXV))[(size_t)row * NKV * HDIM + c2] = f2bf(a); p.out[O_V + (size_t)row * NKV * HDIM + c2] = a; }
            else { const int b = (row - MC) / LSEQ, s = (row - MC) % LSEQ; ((bf16_t*)(p.ws + WS_LATV))[((size_t)b * SKVL + s) * NKV * HDIM + c2] = f2bf(a); } } } };

struct NSsq {
    Params p; int slot; int pad_ = 0; static HD_FN long count() { return MTOK; }
    HD_FN void operator()(long row) const { const float* y = p.out + O_Y + (size_t)row * DM; float s = 0.f; for (int k = 0; k < DM; ++k) s += y[k] * y[k];
        ((float*)(p.ws + WS_SSQ))[(size_t)slot * SSQ_STRIDE + row] = s; }
};
struct NSW {
    Params p; const float* W; float* sw; int l, which, N, pad_; HD_FN long count() const { return (long)NCLS * N; }
    HD_FN void operator()(long idx) const { const int n = (int)(idx % N), cls = (int)(idx / N); const float* sh = modv(p, l, cls, which); float acc = 0.f;
        for (int k = 0; k < DM; ++k) acc += sh[k] * rbf(W[(size_t)k * N + n]); sw[idx] = acc; }
};
struct NConv {
    Params p; static HD_FN long count() { return (long)MTOK * CCH; }
    HD_FN void operator()(long idx) const {
        const int row = (int)(idx / CCH), c = (int)(idx % CCH), pos = pos_of(row), len = seqlen_of(row);
        const bf16_t* U = (const bf16_t*)(p.ws + WS_UPRE); float acc = p.convb[c];
        for (int j = 0; j < CWID; ++j) { const int t = pos + j - CWID / 2; if (t >= 0 && t < len) acc += p.convw[(size_t)j * CCH + c] * bf2f(U[(size_t)(row + j - CWID / 2) * CCH + c]); }
        ((float*)(p.ws + WS_HS))[idx] = acc;
    }
};
struct NConvLN {
    Params p; static HD_FN long count() { return MTOK; }
    HD_FN void operator()(long row) const {
        const float* t = (const float*)(p.ws + WS_HS) + (size_t)row * CCH; float mu = 0.f;
        for (int c = 0; c < CCH; ++c) mu += t[c]; mu /= CCH; float var = 0.f;
        for (int c = 0; c < CCH; ++c) { const float d = t[c] - mu; var += d * d; } var /= CCH;
        const float rs = 1.0f / sqrtf(var + EPSF); bf16_t* UH = (bf16_t*)(p.ws + WS_UH) + (size_t)row * DM;
        for (int c = 0; c < CCH; ++c) UH[c] = f2bf(siluf_((t[c] - mu) * rs * p.lng[c] + p.lnb[c]));
    }
};
HD_FN int seq_base(int sid) { return sid < NCB ? sid * CSEQ : MC + (sid - NCB) * LSEQ; }
struct NMlstmDen {
    Params p; static HD_FN long count() { return (long)NSEQ * MH * 2; }
    HD_FN void operator()(long idx) const {
        const int dir = (int)(idx % 2), h = (int)((idx / 2) % MH), sid = (int)(idx / (2 * MH)); const bool isctx = sid < NCB;
        const int base = seq_base(sid), len = isctx ? CSEQ : LSEQ;
        float n[MDK]; float mrun = 0.f;
        if (isctx) {
#pragma unroll
            for (int d = 0; d < MDK; ++d) n[d] = 0.f;
        } else { const int b = sid - NCB; const float em = expf(p.stm[(size_t)(b * 2 + dir) * MH + h]);
#pragma unroll
            for (int d = 0; d < MDK; ++d) n[d] = p.stn[((size_t)(b * 2 + dir) * MH + h) * MDK + d] * em; }
        const bf16_t* QK = (const bf16_t*)(p.ws + WS_QKVO); const float* G = (const float*)(p.ws + WS_GATES); float* DEN = (float*)(p.ws + WS_DEN);
        for (int t = 0; t < len; ++t) {
            const int row = base + (dir == 0 ? t : len - 1 - t);
            const float ig = G[(size_t)row * NGATE + dir * 8 + h], lf = G[(size_t)row * NGATE + dir * 8 + 4 + h];
            const float f = expf(lf), ei = expf(ig); mrun = fmaxf(mrun + lf, ig);
            const bf16_t* q = QK + (size_t)row * 4 * MW + h * MDK; const bf16_t* k = q + MW; float den = 0.f;
#pragma unroll
            for (int d = 0; d < MDK; ++d) { n[d] = f * n[d] + ei * bf2f(k[d]); den += bf2f(q[d]) * n[d]; }
            DEN[((size_t)dir * MTOK + row) * MH + h] = den;
        }
        if (isctx) { const float em = expf(-mrun); p.out[O_M + (size_t)(sid * 2 + dir) * MH + h] = mrun;
#pragma unroll
            for (int d = 0; d < MDK; ++d) p.out[O_N + ((size_t)(sid * 2 + dir) * MH + h) * MDK + d] = n[d] * em; }
    }
};
struct NMlstmNum {
    Params p; int dir; int pad_ = 0; static HD_FN long count() { return (long)NSEQ * MH * MDK; }
    HD_FN void operator()(long idx) const {
        const int v = (int)(idx % MDK), h = (int)((idx / MDK) % MH), sid = (int)(idx / (MDK * MH)); const bool isctx = sid < NCB;
        const int base = seq_base(sid), len = isctx ? CSEQ : LSEQ;
        float C[MDK];
        if (isctx) {
#pragma unroll
            for (int d = 0; d < MDK; ++d) C[d] = 0.f;
        } else { const int b = sid - NCB; const float em = expf(p.stm[(size_t)(b * 2 + dir) * MH + h]);
#pragma unroll
            for (int d = 0; d < MDK; ++d) C[d] = p.stC[(((size_t)(b * 2 + dir) * MH + h) * MDK + d) * MDK + v] * em; }
        const bf16_t* QK = (const bf16_t*)(p.ws + WS_QKVO); const float* G = (const float*)(p.ws + WS_GATES); const float* DEN = (const float*)(p.ws + WS_DEN);
        float* HS = (float*)(p.ws + WS_HS);
        for (int t = 0; t < len; ++t) {
            const int row = base + (dir == 0 ? t : len - 1 - t);
            const float ig = G[(size_t)row * NGATE + dir * 8 + h], lf = G[(size_t)row * NGATE + dir * 8 + 4 + h];
            const float f = expf(lf), ei = expf(ig);
            const bf16_t* q = QK + (size_t)row * 4 * MW + h * MDK; const bf16_t* k = q + MW; const float vv = bf2f(q[2 * MW + v]) * ei; float num = 0.f;
#pragma unroll
            for (int d = 0; d < MDK; ++d) { C[d] = f * C[d] + bf2f(k[d]) * vv; num += bf2f(q[d]) * C[d]; }
            const float den = DEN[((size_t)dir * MTOK + row) * MH + h]; const float hv = num / fmaxf(fabsf(den), 1.0f);
            float* o = HS + (size_t)row * MW + h * MDK + v; if (dir == 0) *o = hv; else *o += hv;
        }
        if (isctx) { const float em = expf(-p.out[O_M + (size_t)(sid * 2 + dir) * MH + h]);
#pragma unroll
            for (int d = 0; d < MDK; ++d) p.out[O_C + (((size_t)(sid * 2 + dir) * MH + h) * MDK + d) * MDK + v] = C[d] * em; }
    }
};
struct NHm {
    Params p; static HD_FN long count() { return (long)MTOK * MH; }
    HD_FN void operator()(long idx) const {
        const int row = (int)(idx / MH), h = (int)(idx % MH); const float* x = (const float*)(p.ws + WS_HS) + (size_t)row * MW + h * MDK; float s = 0.f;
        for (int v = 0; v < MDK; ++v) s += x[v] * x[v];
        const float rs = 1.0f / sqrtf(s / MDK + EPSF); const bf16_t* og = (const bf16_t*)(p.ws + WS_QKVO) + (size_t)row * 4 * MW + 3 * MW + h * MDK;
        bf16_t* UH = (bf16_t*)(p.ws + WS_UH) + (size_t)row * DM + CCH + h * MDK;
        for (int v = 0; v < MDK; ++v) UH[v] = f2bf(bf2f(og[v]) * x[v] * rs * p.mng[h * MDK + v]);
    }
};
struct NCacheCvt {
    Params p; static HD_FN long count() { return (long)NLB * PAST * NKV * HDIM; }
    HD_FN void operator()(long idx) const { const int e = (int)(idx % (NKV * HDIM)), pp = (int)((idx / (NKV * HDIM)) % PAST), b = (int)(idx / ((long)NKV * HDIM * PAST));
        const size_t dst = ((size_t)b * SKVL + LSEQ + pp) * NKV * HDIM + e;
        ((bf16_t*)(p.ws + WS_LATK))[dst] = f2bf(p.ck[idx]); ((bf16_t*)(p.ws + WS_LATV))[dst] = f2bf(p.cv[idx]); }
};
struct NQkPost {
    Params p; static HD_FN long count() { return (long)MTOK * (NQ + NKV); }
    HD_FN void operator()(long idx) const {
        const int row = (int)(idx / (NQ + NKV)), j = (int)(idx % (NQ + NKV)); const bool isq = j < NQ; const bool lat = row >= MC;
        bf16_t* src = isq ? (bf16_t*)(p.ws + WS_QRAW) + (size_t)row * NQ * HDIM + j * HDIM : (bf16_t*)(p.ws + WS_KRAW) + (size_t)row * NKV * HDIM + (j - NQ) * HDIM;
        const float* g = isq ? p.qng : p.kng; float s = 0.f;
        for (int d = 0; d < HDIM; ++d) { const float x = bf2f(src[d]); s += x * x; }
        const float rs = 1.0f / sqrtf(s / HDIM + EPSF);
        bf16_t* dst; float* fo = nullptr;
        if (isq) dst = src;
        else if (!lat) { dst = (bf16_t*)(p.ws + WS_CTXK) + (size_t)row * NKV * HDIM + (j - NQ) * HDIM; fo = p.out + O_K + (size_t)row * NKV * HDIM + (j - NQ) * HDIM; }
        else { const int b = (row - MC) / LSEQ, sp = (row - MC) % LSEQ; dst = (bf16_t*)(p.ws + WS_LATK) + ((size_t)b * SKVL + sp) * NKV * HDIM + (j - NQ) * HDIM; }
        const int sp = pos_of(row); const float prow = (float)(sp / GRIDW), pcol = (float)(sp % GRIDW);
        for (int half = 0; half < 2; ++half)
            for (int d = 0; d < HDIM / 4; ++d) {
                const int i1 = half * (HDIM / 2) + d, i2 = i1 + HDIM / 4;
                const float x1 = bf2f(src[i1]) * rs * g[i1], x2 = bf2f(src[i2]) * rs * g[i2]; float y1 = x1, y2 = x2;
                if (lat) { const float inv = powf(10000.0f, -(float)d / (float)(HDIM / 4)); const float ang = (half == 0 ? prow : pcol) * inv; const float cs = cosf(ang), sn = sinf(ang);
                    y1 = x1 * cs - x2 * sn; y2 = x1 * sn + x2 * cs; }
                dst[i1] = f2bf(y1); dst[i2] = f2bf(y2); if (fo) { fo[i1] = y1; fo[i2] = y2; }
            }
    }
};
struct NAttn {
    Params p; static HD_FN long count() { return (long)MTOK * NQ * 4; }
    HD_FN void operator()(long idx) const {
        const int sl = (int)(idx % 4), hq = (int)((idx / 4) % NQ), row = (int)(idx / (4 * NQ)); const int kv = hq / GRP;
        const bf16_t *Kb, *Vb; int nk;
        if (row < MC) { const int b = row / CSEQ; Kb = (const bf16_t*)(p.ws + WS_CTXK) + (size_t)b * CSEQ * NKV * HDIM; Vb = (const bf16_t*)(p.ws + WS_CTXV) + (size_t)b * CSEQ * NKV * HDIM; nk = CSEQ; }
        else { const int b = (row - MC) / LSEQ; Kb = (const bf16_t*)(p.ws + WS_LATK) + (size_t)b * SKVL * NKV * HDIM; Vb = (const bf16_t*)(p.ws + WS_LATV) + (size_t)b * SKVL * NKV * HDIM; nk = SKVL; }
        const bf16_t* qp = (const bf16_t*)(p.ws + WS_QRAW) + (size_t)row * NQ * HDIM + hq * HDIM;
        float q[HDIM];
#pragma unroll
        for (int d = 0; d < HDIM; ++d) q[d] = bf2f(qp[d]);
        float o[32];
#pragma unroll
        for (int e = 0; e < 32; ++e) o[e] = 0.f;
        float m = -1e30f, l = 0.f; const float scale = 1.0f / sqrtf((float)HDIM);
        for (int s = 0; s < nk; ++s) {
            const bf16_t* kp = Kb + (size_t)s * NKV * HDIM + kv * HDIM; float dot = 0.f;
#pragma unroll
            for (int d = 0; d < HDIM; ++d) dot += q[d] * bf2f(kp[d]);
            dot *= scale; const float mn = fmaxf(m, dot); const float al = expf(m - mn), pe = expf(dot - mn); m = mn; l = l * al + pe;
            const bf16_t* vp = Vb + (size_t)s * NKV * HDIM + kv * HDIM + sl * 32;
#pragma unroll
            for (int e = 0; e < 32; ++e) o[e] = o[e] * al + pe * bf2f(vp[e]);
        }
        bf16_t* op = (bf16_t*)(p.ws + WS_O) + (size_t)row * DM + hq * HDIM + sl * 32;
#pragma unroll
        for (int e = 0; e < 32; ++e) op[e] = f2bf(o[e] / l);
    }
};
struct NFinal {
    Params p; static HD_FN long count() { return (long)MTOK * DM; }
    HD_FN void operator()(long idx) const { const int row = (int)(idx / DM), col = (int)(idx % DM);
        const float rs = 1.0f / sqrtf(((const float*)(p.ws + WS_SSQ))[(size_t)3 * SSQ_STRIDE + row] / DM + EPSF); p.out[O_Y + idx] *= rs * p.fng[col]; }
};
constexpr int NWAVES = 8, NTHREADS = NWAVES * 64;
constexpr int RING_OFF = 0, RING_BYTES = 131072;
constexpr int LDSCTL_OFF = RING_BYTES, MISC_OFF = LDSCTL_OFF + 320;
constexpr int LDS_BYTES = 147456;
constexpr int CW_TMO = 0, CW_CODE = 1, CW_BAR = 4096;
__device__ __forceinline__ int tid_opaque() { int t = threadIdx.x; asm volatile("" : "+v"(t)); return t; }
template <int M> __device__ __forceinline__ float swz_xor(float v) { return __int_as_float(__builtin_amdgcn_ds_swizzle(__float_as_int(v), (M << 10) | 0x1f)); }
__device__ __forceinline__ float half_sum(float v) { auto rr = __builtin_amdgcn_permlane32_swap(__float_as_uint(v), __float_as_uint(v), false, false); return __uint_as_float(rr[0]) + __uint_as_float(rr[1]); }
__device__ __forceinline__ float half_max(float v) { auto rr = __builtin_amdgcn_permlane32_swap(__float_as_uint(v), __float_as_uint(v), false, false); return fmaxf(__uint_as_float(rr[0]), __uint_as_float(rr[1])); }
__device__ __forceinline__ float lane_get(float v, int src_lane) { return __int_as_float(__builtin_amdgcn_ds_bpermute(src_lane << 2, __float_as_int(v))); }
#define GAS __attribute__((address_space(1)))
#define LAS __attribute__((address_space(3)))
typedef GAS unsigned gu32;
#define RLX_AGENT __ATOMIC_RELAXED, __HIP_MEMORY_SCOPE_AGENT
#define XB_TMO      128
#define XB_XCNT(j)  (256  + 64 * (j))
#define XB_XSUB(j)  (1280 + 64 * (j))
#define XB_XGEN(j)  (2304 + 64 * (j))
#define XB_TOP      3328
#define XB_TOPGEN   3392
#define XCD_BAR_WORDS 3456
#define XB_SPIN_CAP (1u << 22)
__device__ __forceinline__ unsigned xb_ld(unsigned* p)              { return __hip_atomic_load(p, __ATOMIC_RELAXED, __HIP_MEMORY_SCOPE_AGENT); }
__device__ __forceinline__ unsigned xb_add(unsigned* p, unsigned v) { return __hip_atomic_fetch_add(p, v, __ATOMIC_RELAXED, __HIP_MEMORY_SCOPE_AGENT); }
__device__ __forceinline__ unsigned xb_xcc_id() { return (unsigned)__builtin_amdgcn_s_getreg((3 << 11) | 20) & 0xFu; }
#define XB_SPIN(cond, bar) do { unsigned _sp = 0; while (cond) { __builtin_amdgcn_s_sleep(1); \
    if ((++_sp & 255u) == 0u) { if (xb_ld(&(bar)[XB_TMO])) break; if (_sp > XB_SPIN_CAP) { atomicAdd(&(bar)[XB_TMO], 1u); break; } } } } while (0)
struct XcdBarrier { unsigned* bar; unsigned x; volatile LAS unsigned* st; };
__device__ __forceinline__ XcdBarrier xcd_barrier_post(unsigned* bar, volatile LAS unsigned* st) {
    XcdBarrier b; b.bar = bar; b.x = xb_xcc_id(); b.st = st;
    if (threadIdx.x == 0) (void)xb_add(&bar[XB_XCNT(b.x)], 1u);
    return b;
}
__device__ __forceinline__ void xcd_barrier_complete(unsigned* bar, unsigned x, unsigned& nloc, unsigned& nx) {
    const unsigned G = gridDim.x * gridDim.y * gridDim.z;
    unsigned sum, cnt, mine, sp = 0u;
    for (;;) {
        sum = 0u; cnt = 0u; mine = 0u;
#pragma unroll
        for (unsigned j = 0; j < 16; ++j) { const unsigned c = xb_ld(&bar[XB_XCNT(j)]); sum += c; cnt += (c > 0u) ? 1u : 0u; mine = (j == x) ? c : mine; }
        if (sum == G) break;
        __builtin_amdgcn_s_sleep(1);
        if ((++sp & 255u) == 0u) { if (xb_ld(&bar[XB_TMO])) break; if (sp > XB_SPIN_CAP) { atomicAdd(&bar[XB_TMO], 1u); break; } }
    }
    nloc = mine > 0u ? mine : 1u; nx = cnt > 0u ? cnt : 1u;
}
__device__ __forceinline__ void xcd_barrier(const XcdBarrier& b) {
    asm volatile("s_waitcnt vmcnt(0)" ::: "memory");
    __syncthreads();
    if (threadIdx.x == 0) {
        unsigned* bar = b.bar;
        __builtin_amdgcn_s_waitcnt(0);
        unsigned nloc = b.st[0], nx = b.st[1];
        if (nloc == 0u) { xcd_barrier_complete(bar, b.x, nloc, nx); b.st[0] = nloc; b.st[1] = nx; }
        const unsigned old = xb_add(&bar[XB_XSUB(b.x)], 1u);
        const unsigned gen = old / nloc;
        if (old + 1u == (gen + 1u) * nloc) {
            __builtin_amdgcn_fence(__ATOMIC_RELEASE, "agent");
            asm volatile("s_waitcnt vmcnt(0)" ::: "memory");
            const unsigned og = xb_add(&bar[XB_TOP], 1u);
            const unsigned tg = og / nx;
            if (og + 1u == (tg + 1u) * nx) xb_add(&bar[XB_TOPGEN], 1u);
            else XB_SPIN(xb_ld(&bar[XB_TOPGEN]) == tg, bar);
            __builtin_amdgcn_fence(__ATOMIC_ACQUIRE, "agent");
            xb_add(&bar[XB_XGEN(b.x)], 1u);
            asm volatile("s_waitcnt vmcnt(0)" ::: "memory");
        } else {
            XB_SPIN(xb_ld(&bar[XB_XGEN(b.x)]) == gen, bar);
            __builtin_amdgcn_fence(__ATOMIC_ACQUIRE, "agent");
            asm volatile("s_waitcnt vmcnt(0)" ::: "memory");
        }
    }
    __syncthreads();
}
namespace pg8 {
#define PG8_LAS __attribute__((address_space(3)))
typedef unsigned short bf16_t;
typedef short bf16x8 __attribute__((ext_vector_type(8)));
typedef float f32x4 __attribute__((ext_vector_type(4)));
typedef unsigned u32x4 __attribute__((ext_vector_type(4)));
constexpr int BM = 256, BK = 64, HALF = 128, HTB = HALF * BK * 2  , STAGE_BYTES = 8 * HTB, NXCD = 8, WGM = 8;

__host__ __device__ __forceinline__ int lds_byte(int r, int c) { const int st = (r >> 4) * 2 + (c >> 5), rr = r & 15, cc = c & 31, ob = rr * 64 + cc * 2; return st * 1024 + (ob ^ (((ob >> 9) & 1) << 5)); }
__host__ __device__ __forceinline__ void stage_rc(int b, int& R, int& C) { const int st = b / 1024, sb = b % 1024, swz = sb ^ (((sb >> 9) & 1) << 5); R = (st >> 1) * 16 + swz / 64; C = (st & 1) * 32 + (swz % 64) / 2; }
__host__ __device__ __forceinline__ int perm32(int rho) { const int n = rho >> 4, i = rho & 15; return 8 * (i >> 2) + 4 * n + (i & 3); }

struct Unit { int pm, pn, k0, nt, role, slot; };
struct Gemm { const bf16_t* A; const bf16_t* Bt; int M, N, K; };

struct StaticOrder {
    int nM, nN, nwg, G, c, ntK;
    __host__ __device__ void init(int M, int N, int K, int G_, int c_) { nM = M / BM; nN = N / BM; nwg = nM * nN; G = G_; c = c_; ntK = K / BK; }
    __host__ __device__ void map(int L, Unit& u) const { int wgid = L; { const int q = nwg / NXCD, r = nwg % NXCD, xcd = wgid % NXCD, off = wgid / NXCD; wgid = (xcd < r ? xcd * (q + 1) : r * (q + 1) + (xcd - r) * q) + off; }
        const int nig = WGM * nN, gid = wgid / nig, fm = gid * WGM, gsz = (nM - fm) < WGM ? (nM - fm) : WGM; u.pm = fm + ((wgid % nig) % gsz); u.pn = (wgid % nig) / gsz; }
    __host__ __device__ bool next(int i, Unit& u) const {
        const long L = (long)i * G + c; if (L >= nwg) return false;
        int wgid = (int)L; { const int q = nwg / NXCD, r = nwg % NXCD, xcd = wgid % NXCD, off = wgid / NXCD; wgid = (xcd < r ? xcd * (q + 1) : r * (q + 1) + (xcd - r) * q) + off; }
        const int nig = WGM * nN, gid = wgid / nig, fm = gid * WGM, gsz = (nM - fm) < WGM ? (nM - fm) : WGM;
        u.pm = fm + ((wgid % nig) % gsz); u.pn = (wgid % nig) / gsz; u.k0 = 0; u.nt = ntK; u.role = 0; u.slot = 0; return true;
    }
    __device__ __forceinline__ void a_ready(const Unit&) const {}
    __device__ __forceinline__ void done(const Unit&) const {}
};

__device__ __forceinline__ unsigned cvt_pk_bf16(float lo, float hi) { unsigned r; asm volatile("v_cvt_pk_bf16_f32 %0, %1, %2" : "=v"(r) : "v"(lo), "v"(hi)); return r; }
typedef float f32x2 __attribute__((ext_vector_type(2)));
template <class Epi, class Sched, bool ALIGN_EPI = false, bool SP2 = false>
__device__ __forceinline__ void gemm_phase(PG8_LAS unsigned char* lds, const Gemm g, const Sched& S, const Epi& E) {
    const int tid = tid_opaque(), wid = __builtin_amdgcn_readfirstlane(tid >> 6), lane = tid & 63, wr = wid >> 2, wc = wid & 3, fr = lane & 15, fq = lane >> 4;
    const int K = g.K;
    unsigned voffA[2], voffB[2];
#pragma unroll
    for (int i = 0; i < 2; ++i) { int R, C; stage_rc(tid * 16 + i * 8192, R, C); const int Rb = Epi::PERM ? ((R & ~31) + perm32(R & 31)) : R;
        voffA[i] = (unsigned)(R * K + C) * 2u; voffB[i] = (unsigned)(Rb * K + C) * 2u; }
    const size_t kstep = (size_t)(BK * 2);
    const size_t hstep = (size_t)HALF * K * 2;
    const size_t tstep = 2 * hstep;
    const unsigned ldsw = (unsigned)wid * 1024u;
    const int aoff = lds_byte(wr * 64 + fr, fq * 8), boff = lds_byte(wc * 32 + fr, fq * 8);
#define PG8_SA(b, h) (((b) * 2 + (h)) * HTB)
#define PG8_SB(b, h) ((4 + (b) * 2 + (h)) * HTB)
#define PG8_STAGE(bufoff, gbase, voff) do { _Pragma("unroll") for (int _i = 0; _i < 2; ++_i) \
        __builtin_amdgcn_global_load_lds((const unsigned*)((const char*)(gbase) + (voff)[_i]), (PG8_LAS unsigned*)(lds + (bufoff) + ldsw + _i * 8192), 16, 0, 0); } while (0)
#define PG8_LDA(dst, b, h) do { _Pragma("unroll") for (int m = 0; m < 4; ++m) _Pragma("unroll") for (int k = 0; k < 2; ++k) dst[m][k] = *(const PG8_LAS bf16x8*)(lds + PG8_SA(b, h) + aoff + m * 2048 + k * 1024); } while (0)
#define PG8_LDB(dst, b, h) do { _Pragma("unroll") for (int n = 0; n < 2; ++n) _Pragma("unroll") for (int k = 0; k < 2; ++k) dst[n][k] = *(const PG8_LAS bf16x8*)(lds + PG8_SB(b, h) + boff + n * 2048 + k * 1024); } while (0)
#define PG8_MMA(ai, bj, At, Bt) do { __builtin_amdgcn_s_setprio(1); _Pragma("unroll") for (int m = 0; m < 4; ++m) _Pragma("unroll") for (int n = 0; n < 2; ++n) _Pragma("unroll") for (int k = 0; k < 2; ++k) \
        acc[ai][bj][m][n] = __builtin_amdgcn_mfma_f32_16x16x32_bf16(Bt[n][k], At[m][k], acc[ai][bj][m][n], 0, 0, 0); __builtin_amdgcn_s_setprio(0); } while (0)
#define PG8_WAIT_V(n) asm volatile("s_waitcnt vmcnt(" #n ")" ::: "memory")
#define PG8_WAIT_L(n) asm volatile("s_waitcnt lgkmcnt(" #n ")" ::: "memory")
#define PG8_BAR __builtin_amdgcn_s_barrier()
#define PG8_SCHED __builtin_amdgcn_sched_barrier(0)
    Unit cur, nxt; int ui = 0;
    if (!S.next(0, cur)) return;
    f32x4 acc[2][2][4][2];
#pragma unroll
    for (int a = 0; a < 2; ++a)
#pragma unroll
        for (int b = 0; b < 2; ++b)
#pragma unroll
            for (int m = 0; m < 4; ++m)
#pragma unroll
                for (int n = 0; n < 2; ++n) acc[a][b][m][n] = (f32x4){0.f, 0.f, 0.f, 0.f};
    bf16x8 At[4][2], B0[2][2], B1[2][2];
    const char* cA = (const char*)g.A + (size_t)cur.pm * tstep + (size_t)cur.k0 * kstep; const char* cB = (const char*)g.Bt + (size_t)cur.pn * tstep + (size_t)cur.k0 * kstep; int nt = cur.nt;
    S.a_ready(cur);
    if constexpr (SP2) {
        PG8_STAGE(PG8_SB(0, 0), cB, voffB); PG8_STAGE(PG8_SB(0, 1), cB + hstep, voffB); PG8_STAGE(PG8_SA(0, 0), cA, voffA); PG8_STAGE(PG8_SA(0, 1), cA + hstep, voffA);
        if (wr == 1) PG8_BAR;
        PG8_WAIT_V(2); PG8_BAR;
        PG8_STAGE(PG8_SB(1, 0), cB + kstep, voffB); PG8_STAGE(PG8_SA(1, 0), cA + kstep, voffA); PG8_STAGE(PG8_SB(1, 1), cB + hstep + kstep, voffB);
        PG8_WAIT_V(6); PG8_BAR;
    } else {
        PG8_STAGE(PG8_SB(0, 0), cB, voffB); PG8_STAGE(PG8_SA(0, 0), cA, voffA); PG8_STAGE(PG8_SB(0, 1), cB + hstep, voffB); PG8_STAGE(PG8_SA(0, 1), cA + hstep, voffA);
        if (wr == 1) PG8_BAR;
        PG8_WAIT_V(4); PG8_BAR;
        PG8_STAGE(PG8_SB(1, 0), cB + kstep, voffB); PG8_STAGE(PG8_SA(1, 0), cA + kstep, voffA); PG8_STAGE(PG8_SB(1, 1), cB + hstep + kstep, voffB);
        PG8_WAIT_V(6); PG8_BAR;
    }
    for (;;) {
        const bool has_next = S.next(ui + 1, nxt);
        const char* nA = has_next ? (const char*)g.A + (size_t)nxt.pm * tstep + (size_t)nxt.k0 * kstep : cA; const char* nB = has_next ? (const char*)g.Bt + (size_t)nxt.pn * tstep + (size_t)nxt.k0 * kstep : cB;
        for (int t = 0; t < nt; t += 2) {
            const bool last = (t == nt - 2);
            const char* a1 = cA + (size_t)(t + 1) * kstep;
            const char* a2 = last ? nA : cA + (size_t)(t + 2) * kstep; const char* b2 = last ? nB : cB + (size_t)(t + 2) * kstep;
            const char* a3 = a2 + kstep; const char* b3 = b2 + kstep;
            if (last && has_next) S.a_ready(nxt);
            if constexpr (SP2) {
            PG8_LDB(B0, 0, 0); PG8_LDB(B1, 0, 1); PG8_SCHED; PG8_LDA(At, 0, 0); PG8_STAGE(PG8_SA(1, 1), a1 + hstep, voffA);
            PG8_WAIT_V(8); PG8_WAIT_L(0); PG8_BAR; PG8_MMA(0, 0, At, B0); PG8_MMA(0, 1, At, B1); PG8_BAR; PG8_SCHED;
            PG8_LDA(At, 0, 1); PG8_STAGE(PG8_SB(0, 0), b2, voffB); PG8_STAGE(PG8_SB(0, 1), b2 + hstep, voffB); PG8_STAGE(PG8_SA(0, 0), a2, voffA);
            PG8_WAIT_V(8); PG8_WAIT_L(0); PG8_BAR; PG8_MMA(1, 0, At, B0); PG8_MMA(1, 1, At, B1); PG8_BAR; PG8_SCHED;
            PG8_LDB(B0, 1, 0); PG8_LDB(B1, 1, 1); PG8_SCHED; PG8_LDA(At, 1, 0); PG8_STAGE(PG8_SA(0, 1), a2 + hstep, voffA);
            PG8_WAIT_V(8); PG8_WAIT_L(0); PG8_BAR; PG8_MMA(0, 0, At, B0); PG8_MMA(0, 1, At, B1); PG8_BAR; PG8_SCHED;
            PG8_LDA(At, 1, 1); PG8_STAGE(PG8_SB(1, 0), b3, voffB); PG8_STAGE(PG8_SB(1, 1), b3 + hstep, voffB); PG8_STAGE(PG8_SA(1, 0), a3, voffA);
            PG8_WAIT_V(8); PG8_WAIT_L(0); PG8_BAR; PG8_MMA(1, 0, At, B0); PG8_MMA(1, 1, At, B1); PG8_BAR; PG8_SCHED;
            } else {
            PG8_LDB(B0, 0, 0); PG8_SCHED; PG8_LDA(At, 0, 0); PG8_STAGE(PG8_SA(1, 1), a1 + hstep, voffA);
            PG8_WAIT_L(8); PG8_BAR; PG8_WAIT_L(0); PG8_MMA(0, 0, At, B0); PG8_BAR; PG8_SCHED;
            PG8_LDB(B1, 0, 1); PG8_STAGE(PG8_SB(0, 0), b2, voffB);
            PG8_BAR; PG8_WAIT_L(0); PG8_MMA(0, 1, At, B1); PG8_BAR;
            PG8_LDA(At, 0, 1); PG8_STAGE(PG8_SA(0, 0), a2, voffA);
            PG8_BAR; PG8_WAIT_L(0); PG8_MMA(1, 0, At, B0); PG8_BAR; PG8_SCHED;
            PG8_STAGE(PG8_SB(0, 1), b2 + hstep, voffB);
            PG8_WAIT_V(6); PG8_BAR; PG8_MMA(1, 1, At, B1); PG8_BAR;
            PG8_LDB(B0, 1, 0); PG8_SCHED; PG8_LDA(At, 1, 0); PG8_STAGE(PG8_SA(0, 1), a2 + hstep, voffA);
            PG8_WAIT_L(8); PG8_BAR; PG8_WAIT_L(0); PG8_MMA(0, 0, At, B0); PG8_BAR; PG8_SCHED;
            PG8_LDB(B1, 1, 1); PG8_STAGE(PG8_SB(1, 0), b3, voffB);
            PG8_BAR; PG8_WAIT_L(0); PG8_MMA(0, 1, At, B1); PG8_BAR;
            PG8_LDA(At, 1, 1); PG8_STAGE(PG8_SA(1, 0), a3, voffA);
            PG8_BAR; PG8_WAIT_L(0); PG8_MMA(1, 0, At, B0); PG8_BAR; PG8_SCHED;
            PG8_STAGE(PG8_SB(1, 1), b3 + hstep, voffB);
            PG8_WAIT_V(6); PG8_BAR; PG8_MMA(1, 1, At, B1); PG8_BAR;
            }
        }
        if constexpr (ALIGN_EPI) { if (wr == 0) PG8_BAR; }
        if constexpr (!Epi::AFTER_DRAIN) { E(acc, cur, wr, wc, fr, fq); S.done(cur); }
        if (!has_next) break;
#pragma unroll
        for (int a = 0; a < 2; ++a)
#pragma unroll
            for (int b = 0; b < 2; ++b)
#pragma unroll
                for (int m = 0; m < 4; ++m)
#pragma unroll
                    for (int n = 0; n < 2; ++n) acc[a][b][m][n] = (f32x4){0.f, 0.f, 0.f, 0.f};
        cur = nxt; cA = nA; cB = nB; nt = cur.nt; ++ui;
        if constexpr (ALIGN_EPI) { if (wr == 1) PG8_BAR; }
    }
    PG8_WAIT_V(0);
    if constexpr (!ALIGN_EPI) { if (wr == 0) PG8_BAR; }
    PG8_BAR;
    if constexpr (Epi::AFTER_DRAIN) { E.fused(acc, cur, wr, wc, fr, fq, lds, wid, lane); S.done(cur); }
#undef PG8_SA
#undef PG8_SB
#undef PG8_STAGE
#undef PG8_LDA
#undef PG8_LDB
#undef PG8_MMA
#undef PG8_WAIT_V
#undef PG8_WAIT_L
#undef PG8_BAR
#undef PG8_SCHED
}
}
constexpr size_t WB_AB = 2 * MiB, WB_OUTAB = 8 * MiB, WB_FFI0 = 10 * MiB, WB_FFO0 = 21 * MiB, WB_INC = 27 * MiB, WB_OUTC = 30 * MiB, WB_FFI1 = 32 * MiB, WB_FFO1 = 43 * MiB;
static_assert(WB_FFO1 + (size_t)DM * DFF * 2 <= WS_XN && WB_AB + (size_t)ABMAIN * DM * 2 <= WB_OUTAB && WB_FFI0 + (size_t)2 * DFF * DM * 2 <= WB_FFO0 && WB_FFO0 + (size_t)DM * DFF * 2 <= WB_INC &&
              WB_INC + (size_t)CIN * DM * 2 <= WB_OUTC && WB_FFI1 + (size_t)2 * DFF * DM * 2 <= WB_FFO1, "weight copy map");

typedef unsigned v4u __attribute__((ext_vector_type(4)));
typedef unsigned v2u __attribute__((ext_vector_type(2)));
typedef float f32x4 __attribute__((ext_vector_type(4)));
__device__ __forceinline__ unsigned pk2(float lo, float hi) { return (unsigned)f2bf(lo) | ((unsigned)f2bf(hi) << 16); }
__device__ __forceinline__ float fsigmoid(float x) { return __builtin_amdgcn_rcpf(1.0f + __builtin_amdgcn_exp2f(-1.4426950408889634f * x)); }

__device__ __forceinline__ void p0_transpose_item(const float* W, int K, int ldw, int c0, int k0, bf16_t* WT, int drow, LAS float* scr, int lane) {
    { f32x4 tv[8]; const int rr = lane >> 3, cg = (lane & 7) * 4;
#pragma unroll
      for (int i = 0; i < 8; ++i) tv[i] = *(const f32x4*)(W + (size_t)(k0 + 8 * i + rr) * ldw + c0 + cg);
#pragma unroll
      for (int i = 0; i < 8; ++i) { LAS float* d = scr + (8 * i + rr) * 33 + cg; d[0] = tv[i][0]; d[1] = tv[i][1]; d[2] = tv[i][2]; d[3] = tv[i][3]; } }
    asm volatile("s_waitcnt lgkmcnt(0)" ::: "memory");
    const int c = lane & 7;
#pragma unroll
    for (int j = 0; j < 4; ++j) { const int n = (lane >> 3) + 8 * j; const LAS float* s = scr + (8 * c) * 33 + n;
        v4u o; o.x = pk2(s[0 * 33], s[1 * 33]); o.y = pk2(s[2 * 33], s[3 * 33]); o.z = pk2(s[4 * 33], s[5 * 33]); o.w = pk2(s[6 * 33], s[7 * 33]);
        *(GAS v4u*)(WT + (size_t)(drow + n) * K + k0 + 8 * c) = o; }
    asm volatile("s_waitcnt lgkmcnt(0)" ::: "memory");
}
struct CvtJob { const float* W; bf16_t* WT; int K, ldw, c0, ncols, mode, Hn, dbase; };
__device__ __forceinline__ int cvt_items(const CvtJob& j) { return (j.K / 64) * (j.ncols / 32); }
__device__ __forceinline__ void cvt_run(const CvtJob& j, int item, LAS float* scr, int lane) {
    const int nblk = j.ncols / 32, kb = item / nblk, nb = item % nblk; const int c = j.c0 + 32 * nb;
    int drow; if (j.mode == 0) drow = j.dbase + 32 * nb; else { const int cc = c < j.Hn ? c : c - j.Hn; drow = 256 * (cc / 128) + (cc % 128) + (c < j.Hn ? 0 : 128); }
    p0_transpose_item(j.W, j.K, j.ldw, c, 64 * kb, j.WT, drow, scr, lane);
}
__device__ __forceinline__ void p0_weights(const Params& p, LAS unsigned char* lds, int vcu, int G) {
    const int tid_ = tid_opaque(); const int lane = tid_ & 63, wave = __builtin_amdgcn_readfirstlane(tid_ >> 6);
    LAS float* scr = (LAS float*)(lds + wave * 16384);
    const int gw = vcu * NWAVES + wave, NGW = G * NWAVES;
    CvtJob jobs[9] = {
        {p.winab, (bf16_t*)(p.ws + WB_AB), DM, ABIN, 0, 2 * CCH, 1, CCH, 0},
        {p.winab, (bf16_t*)(p.ws + WB_AB), DM, ABIN, 2 * CCH, 4 * MW, 0, 0, 2 * CCH},
        {p.woutab, (bf16_t*)(p.ws + WB_OUTAB), DM, DM, 0, DM, 0, 0, 0},
        {p.wffi, (bf16_t*)(p.ws + WB_FFI0), DM, 2 * DFF, 0, 2 * DFF, 1, DFF, 0},
        {p.wffo, (bf16_t*)(p.ws + WB_FFO0), DFF, DM, 0, DM, 0, 0, 0},
        {p.winc, (bf16_t*)(p.ws + WB_INC), DM, CIN, 0, CIN, 0, 0, 0},
        {p.woutc, (bf16_t*)(p.ws + WB_OUTC), DM, DM, 0, DM, 0, 0, 0},
        {p.wffi + (size_t)DM * 2 * DFF, (bf16_t*)(p.ws + WB_FFI1), DM, 2 * DFF, 0, 2 * DFF, 1, DFF, 0},
        {p.wffo + (size_t)DFF * DM, (bf16_t*)(p.ws + WB_FFO1), DFF, DM, 0, DM, 0, 0, 0}};
    int base = 0;
#pragma unroll
    for (int jj = 0; jj < 9; ++jj) {
        const int n = cvt_items(jobs[jj]);
        int first = ((gw - base) % NGW + NGW) % NGW;
        for (int it = first; it < n; it += NGW) cvt_run(jobs[jj], it, scr, lane);
        base += n;
    }
}

struct EpiAB {
    static constexpr bool PERM = true, AFTER_DRAIN = false;
    bf16_t* upre; bf16_t* qkvo;
    __device__ __forceinline__ void operator()(const f32x4 (&acc)[2][2][4][2], const pg8::Unit& u, int wr, int wc, int fr, int fq) const {
        const int row0 = u.pm * 256 + wr * 64 + fr, lc = wc * 32 + 8 * fq;
        if (u.pn < 4) {
#pragma unroll
            for (int ai = 0; ai < 2; ++ai)
#pragma unroll
                for (int m = 0; m < 4; ++m) { const f32x4 a0 = acc[ai][0][m][0], a1 = acc[ai][0][m][1], g0 = acc[ai][1][m][0], g1 = acc[ai][1][m][1]; v4u w;
                    w.x = pg8::cvt_pk_bf16(a0[0] * fsigmoid(g0[0]), a0[1] * fsigmoid(g0[1])); w.y = pg8::cvt_pk_bf16(a0[2] * fsigmoid(g0[2]), a0[3] * fsigmoid(g0[3]));
                    w.z = pg8::cvt_pk_bf16(a1[0] * fsigmoid(g1[0]), a1[1] * fsigmoid(g1[1])); w.w = pg8::cvt_pk_bf16(a1[2] * fsigmoid(g1[2]), a1[3] * fsigmoid(g1[3]));
                    *(v4u*)(upre + (size_t)(row0 + ai * 128 + m * 16) * CCH + 128 * u.pn + lc) = w; }
        } else {
#pragma unroll
            for (int bj = 0; bj < 2; ++bj) { const int col = 256 * (u.pn - 4) + 128 * bj + lc; const int part = col / MW; const float sc = part == 1 ? 0.08838834764831845f : 1.0f;
#pragma unroll
                for (int ai = 0; ai < 2; ++ai)
#pragma unroll
                    for (int m = 0; m < 4; ++m) { f32x4 v0 = acc[ai][bj][m][0] * sc, v1 = acc[ai][bj][m][1] * sc;
                        if (part == 3) { v0 = (f32x4){fsigmoid(v0[0]), fsigmoid(v0[1]), fsigmoid(v0[2]), fsigmoid(v0[3])}; v1 = (f32x4){fsigmoid(v1[0]), fsigmoid(v1[1]), fsigmoid(v1[2]), fsigmoid(v1[3])}; }
                        v4u w; w.x = pg8::cvt_pk_bf16(v0[0], v0[1]); w.y = pg8::cvt_pk_bf16(v0[2], v0[3]); w.z = pg8::cvt_pk_bf16(v1[0], v1[1]); w.w = pg8::cvt_pk_bf16(v1[2], v1[3]);
                        *(v4u*)(qkvo + (size_t)(row0 + ai * 128 + m * 16) * (4 * MW) + col) = w; } }
        }
    }
};
static_assert(MDK == 128, "EpiAB hard-codes MDK^-0.5");
struct EpiRes {
    static constexpr bool PERM = true, AFTER_DRAIN = false;
    const float* xp; const float* xs;
    bf16_t* Y16; bf16_t* XN; float* ssq; const float* mod_g; const float* mod_sc; const float* ng;
    int from_input; int pad_;
    __device__ __forceinline__ float piece(int row, int col, int cls, f32x4 v0, f32x4 v1) const {
        const float* gv = mod_g + (size_t)cls * 6 * DM + col; const size_t off = (size_t)row * DM + col; f32x4 x0, x1;
        if (from_input) { const float* xin = (row < MC ? xp : xs - (size_t)MC * DM) + off; x0 = *(const f32x4*)xin; x1 = *(const f32x4*)(xin + 4); }
        else { const v4u r = *(const v4u*)(Y16 + off); x0 = (f32x4){__uint_as_float(r.x << 16), __uint_as_float(r.x & 0xffff0000u), __uint_as_float(r.y << 16), __uint_as_float(r.y & 0xffff0000u)};
            x1 = (f32x4){__uint_as_float(r.z << 16), __uint_as_float(r.z & 0xffff0000u), __uint_as_float(r.w << 16), __uint_as_float(r.w & 0xffff0000u)}; }
        x0 += *(const f32x4*)gv * v0; x1 += *(const f32x4*)(gv + 4) * v1;
        v4u w; w.x = pg8::cvt_pk_bf16(x0[0], x0[1]); w.y = pg8::cvt_pk_bf16(x0[2], x0[3]); w.z = pg8::cvt_pk_bf16(x1[0], x1[1]); w.w = pg8::cvt_pk_bf16(x1[2], x1[3]); *(v4u*)(Y16 + off) = w;
        if (ng) { const float* scv = mod_sc + (size_t)cls * 6 * DM + col; const f32x4 t0 = x0 * (*(const f32x4*)(ng + col) * (*(const f32x4*)scv + 1.0f)), t1 = x1 * (*(const f32x4*)(ng + col + 4) * (*(const f32x4*)(scv + 4) + 1.0f));
            v4u q; q.x = pg8::cvt_pk_bf16(t0[0], t0[1]); q.y = pg8::cvt_pk_bf16(t0[2], t0[3]); q.z = pg8::cvt_pk_bf16(t1[0], t1[1]); q.w = pg8::cvt_pk_bf16(t1[2], t1[3]); *(v4u*)(XN + off) = q; }
        return ((x0[0] * x0[0] + x0[1] * x0[1]) + (x0[2] * x0[2] + x0[3] * x0[3])) + ((x1[0] * x1[0] + x1[1] * x1[1]) + (x1[2] * x1[2] + x1[3] * x1[3]));
    }
    __device__ __forceinline__ void operator()(const f32x4 (&acc)[2][2][4][2], const pg8::Unit& u, int wr, int wc, int fr, int fq) const {
        const int row0 = u.pm * 256 + wr * 64 + fr; const int cls = cls_of(u.pm * 256); const int colb = u.pn * 256 + wc * 32 + 8 * fq;
        f32x4 g4[2][2], gs4[2][2];
#pragma unroll
        for (int bj = 0; bj < 2; ++bj)
#pragma unroll
            for (int n = 0; n < 2; ++n) { const int col = colb + bj * 128 + 4 * n; g4[bj][n] = *(const f32x4*)(mod_g + (size_t)cls * 6 * DM + col);
                gs4[bj][n] = ng ? *(const f32x4*)(ng + col) * (*(const f32x4*)(mod_sc + (size_t)cls * 6 * DM + col) + 1.0f) : (f32x4){0.f, 0.f, 0.f, 0.f}; }
        if (from_input) run_rows<2>(acc, row0, colb, g4, gs4); else run_rows<4>(acc, row0, colb, g4, gs4);
    }
    template <int MB> __device__ __forceinline__ void run_rows(const f32x4 (&acc)[2][2][4][2], int row0, int colb, const f32x4 (&g4)[2][2], const f32x4 (&gs4)[2][2]) const {
#pragma unroll
        for (int ai = 0; ai < 2; ++ai)
#pragma unroll
            for (int mb = 0; mb < 4; mb += MB) {
                f32x4 x[MB][2][2];
                if (from_input) {
#pragma unroll
                    for (int mm = 0; mm < MB; ++mm)
#pragma unroll
                        for (int bj = 0; bj < 2; ++bj) { const int row = row0 + ai * 128 + (mb + mm) * 16; const float* xin = (row < MC ? xp : xs - (size_t)MC * DM) + (size_t)row * DM + colb + bj * 128; x[mm][bj][0] = *(const f32x4*)xin; x[mm][bj][1] = *(const f32x4*)(xin + 4); }
                } else { v4u r[MB][2];
#pragma unroll
                    for (int mm = 0; mm < MB; ++mm)
#pragma unroll
                        for (int bj = 0; bj < 2; ++bj) r[mm][bj] = *(const v4u*)(Y16 + (size_t)(row0 + ai * 128 + (mb + mm) * 16) * DM + colb + bj * 128);
#pragma unroll
                    for (int mm = 0; mm < MB; ++mm)
#pragma unroll
                        for (int bj = 0; bj < 2; ++bj) { const v4u q = r[mm][bj]; x[mm][bj][0] = (f32x4){__uint_as_float(q.x << 16), __uint_as_float(q.x & 0xffff0000u), __uint_as_float(q.y << 16), __uint_as_float(q.y & 0xffff0000u)};
                            x[mm][bj][1] = (f32x4){__uint_as_float(q.z << 16), __uint_as_float(q.z & 0xffff0000u), __uint_as_float(q.w << 16), __uint_as_float(q.w & 0xffff0000u)}; }
                }
#pragma unroll
                for (int mm = 0; mm < MB; ++mm) { const int m = mb + mm; const int row = row0 + ai * 128 + m * 16; float s = 0.f;
#pragma unroll
                    for (int bj = 0; bj < 2; ++bj) { const size_t off = (size_t)row * DM + colb + bj * 128;
                        const f32x4 x0 = x[mm][bj][0] + g4[bj][0] * acc[ai][bj][m][0], x1 = x[mm][bj][1] + g4[bj][1] * acc[ai][bj][m][1];
                        v4u w; w.x = pg8::cvt_pk_bf16(x0[0], x0[1]); w.y = pg8::cvt_pk_bf16(x0[2], x0[3]); w.z = pg8::cvt_pk_bf16(x1[0], x1[1]); w.w = pg8::cvt_pk_bf16(x1[2], x1[3]); *(v4u*)(Y16 + off) = w;
                        if (ng) { const f32x4 t0 = x0 * gs4[bj][0], t1 = x1 * gs4[bj][1]; v4u q; q.x = pg8::cvt_pk_bf16(t0[0], t0[1]); q.y = pg8::cvt_pk_bf16(t0[2], t0[3]); q.z = pg8::cvt_pk_bf16(t1[0], t1[1]); q.w = pg8::cvt_pk_bf16(t1[2], t1[3]); *(v4u*)(XN + off) = q; }
                        s += ((x0[0] * x0[0] + x0[1] * x0[1]) + (x0[2] * x0[2] + x0[3] * x0[3])) + ((x1[0] * x1[0] + x1[1] * x1[1]) + (x1[2] * x1[2] + x1[3] * x1[3])); }
                    s += __shfl_xor(s, 16); s += __shfl_xor(s, 32); if (fq_() == 0) atomicAdd(ssq + row, s); }
                asm volatile("" ::: "memory");
            }
    }
    __device__ __forceinline__ static int fq_() { return (threadIdx.x >> 4) & 3; }
};
struct EpiFfnIn {
    static constexpr bool PERM = true, AFTER_DRAIN = false;
    bf16_t* H; const float* ssq; const float* sw;
    __device__ __forceinline__ void operator()(const f32x4 (&acc)[2][2][4][2], const pg8::Unit& u, int wr, int wc, int fr, int fq) const {
        const int row0 = u.pm * 256 + wr * 64 + fr, lc = wc * 32 + 8 * fq; const int cls = cls_of(u.pm * 256); const int col = 128 * u.pn + lc;
        const float* swr = sw + (size_t)cls * 2 * DFF;
        const f32x4 sg0 = *(const f32x4*)(swr + col), sg1 = *(const f32x4*)(swr + col + 4), su0 = *(const f32x4*)(swr + DFF + col), su1 = *(const f32x4*)(swr + DFF + col + 4);
#pragma unroll
        for (int ai = 0; ai < 2; ++ai)
#pragma unroll
            for (int m = 0; m < 4; ++m) { const int row = row0 + ai * 128 + m * 16; const float rs = __builtin_amdgcn_rsqf(ssq[row] * (1.0f / DM) + EPSF);
                const f32x4 a0 = acc[ai][0][m][0] * rs + sg0, a1 = acc[ai][0][m][1] * rs + sg1, b0 = acc[ai][1][m][0] * rs + su0, b1 = acc[ai][1][m][1] * rs + su1; v4u w;
                w.x = pg8::cvt_pk_bf16(a0[0] * fsigmoid(a0[0]) * b0[0], a0[1] * fsigmoid(a0[1]) * b0[1]); w.y = pg8::cvt_pk_bf16(a0[2] * fsigmoid(a0[2]) * b0[2], a0[3] * fsigmoid(a0[3]) * b0[3]);
                w.z = pg8::cvt_pk_bf16(a1[0] * fsigmoid(a1[0]) * b1[0], a1[1] * fsigmoid(a1[1]) * b1[1]); w.w = pg8::cvt_pk_bf16(a1[2] * fsigmoid(a1[2]) * b1[2], a1[3] * fsigmoid(a1[3]) * b1[3]);
                *(v4u*)(H + (size_t)row * DFF + col) = w; }
    }
};
struct EpiQkv {
    static constexpr bool PERM = true, AFTER_DRAIN = false;
    bf16_t* qraw; bf16_t* kraw; bf16_t* ctxv; bf16_t* latv; float* outv; const float* ssq; const float* sw;
    __device__ __forceinline__ void operator()(const f32x4 (&acc)[2][2][4][2], const pg8::Unit& u, int wr, int wc, int fr, int fq) const {
        const int row0 = u.pm * 256 + wr * 64 + fr, lc = wc * 32 + 8 * fq; const int cls = cls_of(u.pm * 256); const float* swr = sw + (size_t)cls * CIN;
        float rs[2][4];
#pragma unroll
        for (int ai = 0; ai < 2; ++ai)
#pragma unroll
            for (int m = 0; m < 4; ++m) rs[ai][m] = __builtin_amdgcn_rsqf(ssq[row0 + ai * 128 + m * 16] * (1.0f / DM) + EPSF);
#pragma unroll
        for (int bj = 0; bj < 2; ++bj) { const int col = 256 * u.pn + 128 * bj + lc; const f32x4 s0 = *(const f32x4*)(swr + col), s1 = *(const f32x4*)(swr + col + 4);
#pragma unroll
            for (int ai = 0; ai < 2; ++ai)
#pragma unroll
                for (int m = 0; m < 4; ++m) { const int row = row0 + ai * 128 + m * 16; const f32x4 v0 = acc[ai][bj][m][0] * rs[ai][m] + s0, v1 = acc[ai][bj][m][1] * rs[ai][m] + s1;
                    v4u w; w.x = pg8::cvt_pk_bf16(v0[0], v0[1]); w.y = pg8::cvt_pk_bf16(v0[2], v0[3]); w.z = pg8::cvt_pk_bf16(v1[0], v1[1]); w.w = pg8::cvt_pk_bf16(v1[2], v1[3]);
                    if (u.pn < NQ * HDIM / 256) *(v4u*)(qraw + (size_t)row * (NQ * HDIM) + col) = w;
                    else if (u.pn == NQ * HDIM / 256) *(v4u*)(kraw + (size_t)row * (NKV * HDIM) + (col - NQ * HDIM)) = w;
                    else { const int c2 = col - (NQ + NKV) * HDIM;
                        if (row < MC) { *(v4u*)(ctxv + (size_t)row * (NKV * HDIM) + c2) = w; float* o = outv + (size_t)row * (NKV * HDIM) + c2; *(f32x4*)o = v0; *(f32x4*)(o + 4) = v1; }
                        else { const int b = (row - MC) / LSEQ, s = (row - MC) % LSEQ; *(v4u*)(latv + ((size_t)b * SKVL + s) * (NKV * HDIM) + c2) = w; } } } }
    }
};
static_assert(NKV * HDIM == 256 && (NQ * HDIM) % 256 == 0, "EpiQkv tile mapping");

constexpr int CW_SPLIT = 8192;
constexpr size_t SLAB_BYTES = (size_t)64 * 4 * 16 * 512 * 16;
struct RoundZeroOrder : pg8::StaticOrder {
    bool split;
    __device__ void init(int M, int N, int K, int G_, int c_) { pg8::StaticOrder::init(M, N, K, G_, c_); split = (G == 256 && nwg > 256 && nwg <= 320 && ntK >= 8); }
    __device__ bool next(int i, pg8::Unit& u) const { if (split && i > 0) return false; return pg8::StaticOrder::next(i, u); }
};
struct QuarterOrder : pg8::StaticOrder {
    __device__ bool next(int i, pg8::Unit& u) const {
        if (i > 0) return false; const int L = 256 + (c >> 2), q = c & 3; if (L >= nwg) return false;
        map(L, u); const int base = (ntK / 8) * 2, rem = (ntK - 4 * base) / 2;
        int k0 = 0; for (int j = 0; j < q; ++j) k0 += base + (j < rem ? 2 : 0);
        u.k0 = k0; u.nt = base + (q < rem ? 2 : 0); u.role = 1 + q; u.slot = c >> 2; return true;
    }
};
struct EpiPartial {
    static constexpr bool PERM = true, AFTER_DRAIN = false;
    unsigned char* slab; unsigned* cnt;
    __device__ __forceinline__ void operator()(const f32x4 (&acc)[2][2][4][2], const pg8::Unit& u, int wr, int wc, int fr, int fq) const {
        const int tid = (wr * 4 + wc) * 64 + fq * 16 + fr;
        unsigned char* dst = slab + ((size_t)u.slot * 4 + (u.role - 1)) * (16 * 512 * 16) + (size_t)tid * 16;
#pragma unroll
        for (int ai = 0; ai < 2; ++ai)
#pragma unroll
            for (int bj = 0; bj < 2; ++bj)
#pragma unroll
                for (int m = 0; m < 4; ++m) { const f32x4 a = acc[ai][bj][m][0], b = acc[ai][bj][m][1]; v4u w;
                    w.x = pg8::cvt_pk_bf16(a[0], a[1]); w.y = pg8::cvt_pk_bf16(a[2], a[3]); w.z = pg8::cvt_pk_bf16(b[0], b[1]); w.w = pg8::cvt_pk_bf16(b[2], b[3]);
                    asm volatile("global_store_dwordx4 %0, %1, off sc1\n\ts_nop 1" :: "v"(dst), "v"(w) : "memory");
                    dst += 512 * 16; asm volatile("" : "+v"(dst)); }
        asm volatile("s_waitcnt vmcnt(0)" ::: "memory");
        if (fr == 0 && fq == 0) __hip_atomic_fetch_add(cnt + (size_t)u.slot * 64, 1u, __ATOMIC_RELAXED, __HIP_MEMORY_SCOPE_AGENT);
    }
};
__device__ __forceinline__ void tail_reduce(const EpiRes& E, const unsigned char* slab, unsigned* cnt, int G, int bx, int nN, int nM) {
    pg8::StaticOrder S; S.nM = nM; S.nN = nN; S.nwg = nM * nN; S.G = G; S.c = bx; S.ntK = 0;
    const int L = 256 + (bx >> 2), q = bx & 3; if (L >= S.nwg) return;
    pg8::Unit u; S.map(L, u); const int slot = bx >> 2, ai = q >> 1, bj = q & 1;
    const int tid = tid_opaque(), wid = tid >> 6, lane = tid & 63, wr = wid >> 2, wc = wid & 3, fr = lane & 15, fq = lane >> 4;
    unsigned* c = cnt + (size_t)slot * 64; unsigned spins = 0;
    while ((unsigned)__builtin_amdgcn_readfirstlane(__hip_atomic_load(c, __ATOMIC_RELAXED, __HIP_MEMORY_SCOPE_AGENT)) < 32u) { __builtin_amdgcn_s_sleep(2); if (++spins > (1u << 22)) break; }
    __builtin_amdgcn_fence(__ATOMIC_ACQUIRE, "agent");
    const unsigned char* base = slab + (size_t)slot * 4 * (16 * 512 * 16) + (size_t)tid * 16;
    v4u w[4][4];
#pragma unroll
    for (int m = 0; m < 4; ++m)
#pragma unroll
        for (int r = 0; r < 4; ++r) w[m][r] = *(const v4u*)(base + (size_t)r * (16 * 512 * 16) + (size_t)((ai * 2 + bj) * 4 + m) * (512 * 16));
    const int row0 = u.pm * 256 + ai * 128 + wr * 64 + fr; const int cls = cls_of(u.pm * 256); const int col = u.pn * 256 + bj * 128 + wc * 32 + 8 * fq;
#pragma unroll
    for (int m = 0; m < 4; ++m) { const int row = row0 + m * 16; f32x4 v[2] = {(f32x4){0.f, 0.f, 0.f, 0.f}, (f32x4){0.f, 0.f, 0.f, 0.f}};
#pragma unroll
        for (int r = 0; r < 4; ++r) { const v4u x = w[m][r]; v[0] += (f32x4){__uint_as_float(x.x << 16), __uint_as_float(x.x & 0xffff0000u), __uint_as_float(x.y << 16), __uint_as_float(x.y & 0xffff0000u)};
            v[1] += (f32x4){__uint_as_float(x.z << 16), __uint_as_float(x.z & 0xffff0000u), __uint_as_float(x.w << 16), __uint_as_float(x.w & 0xffff0000u)}; }
        float sq = E.piece(row, col, cls, v[0], v[1]);
        sq += __shfl_xor(sq, 16); sq += __shfl_xor(sq, 32); if (fq == 0) atomicAdd(E.ssq + row, sq); }
}
namespace att {
typedef unsigned short bf16;
constexpr int D = 128, NW = 8, QBLK = 32, KVBLK = 64; constexpr float SCALE = 0.088388347648318440f; constexpr float THR = 8.f; constexpr int SDEPTH = 1;
constexpr int LDQ = NQ * HDIM, LDK = NKV * HDIM, LDO = DM;
constexpr size_t SHM_V = KVBLK * D * 2, SHM_K = KVBLK * D * 2, SHM_ATTN = 2 * SHM_V + 2 * SHM_K + NW * 64 * 4;
using bf16x8 = __attribute__((ext_vector_type(8))) short;
using s16x4  = __attribute__((ext_vector_type(4))) short;
using f32x16 = __attribute__((ext_vector_type(16))) float;
using f32x8  = __attribute__((ext_vector_type(8))) float;
using u32x4  = __attribute__((ext_vector_type(4))) unsigned;
#define KSWZ(row, colB) ((row) * 256 + ((colB) ^ (((row) & 7) << 4)))
#define SBAR() __builtin_amdgcn_sched_barrier(0)
__device__ __forceinline__ int crow(int r, int hi) { return (r & 3) + 8 * (r >> 2) + 4 * hi; }
__device__ __forceinline__ unsigned cvtpk(float lo, float hi) {
  unsigned r; asm volatile("v_cvt_pk_bf16_f32 %0, %1, %2" : "=v"(r) : "v"(lo), "v"(hi)); return r;
}
template <typename TIn> struct Stage;
template <> struct Stage<bf16>  { using T = bf16x8;
  __device__ static __forceinline__ T ld8(const bf16* p) { return *reinterpret_cast<const bf16x8*>(p); }
  __device__ static __forceinline__ bf16x8 tobf(T x) { return x; } };
__device__ __forceinline__ void partialSM(f32x16& p0, f32x16& p1, float& m_reg, float& mn, float& alpha) {
  constexpr float C = SCALE * 1.4426950408889634f;
  float pmax = p0[0]; for (int r = 1; r < 16; ++r) pmax = fmaxf(pmax, p0[r]); for (int r = 0; r < 16; ++r) pmax = fmaxf(pmax, p1[r]);
  { auto rr = __builtin_amdgcn_permlane32_swap(__float_as_uint(pmax), __float_as_uint(pmax), false, false);
    pmax = fmaxf(__uint_as_float(rr[0]), __uint_as_float(rr[1])); }
  if (__builtin_expect(__all(pmax - m_reg <= THR / SCALE), 1)) { mn = m_reg; alpha = 1.f; }
  else { mn = fmaxf(m_reg, pmax); alpha = __builtin_amdgcn_exp2f((m_reg - mn) * C); m_reg = mn; }
  float mnC = -mn * C;
  for (int r = 0; r < 16; ++r) p0[r] = fmaf(p0[r], C, mnC); for (int r = 0; r < 16; ++r) p1[r] = fmaf(p1[r], C, mnC);
  for (int r = 0; r < 16; ++r) p0[r] = __builtin_amdgcn_exp2f(p0[r]);
}
__device__ __forceinline__ void finishSM(f32x16& p0, f32x16& p1, float alpha, float& l_reg, bf16x8& pa0, bf16x8& pa1, bf16x8& pa2, bf16x8& pa3) {
  for (int r = 0; r < 16; ++r) p1[r] = __builtin_amdgcn_exp2f(p1[r]);
  float ps = 0; for (int r = 0; r < 16; ++r) ps += p0[r]; for (int r = 0; r < 16; ++r) ps += p1[r];
  { auto rr = __builtin_amdgcn_permlane32_swap(__float_as_uint(ps), __float_as_uint(ps), false, false);
    ps = __uint_as_float(rr[0]) + __uint_as_float(rr[1]); }
  l_reg = l_reg * alpha + ps;
#define PK4(P, BASE, OUT) do { unsigned a0 = cvtpk(P[BASE + 0], P[BASE + 1]), a1 = cvtpk(P[BASE + 2], P[BASE + 3]);   \
    unsigned b0 = cvtpk(P[BASE + 4], P[BASE + 5]), b1 = cvtpk(P[BASE + 6], P[BASE + 7]);                              \
    auto r0 = __builtin_amdgcn_permlane32_swap(a0, b0, false, false); auto r1 = __builtin_amdgcn_permlane32_swap(a1, b1, false, false); \
    u32x4 w = {r0[0], r1[0], r0[1], r1[1]}; OUT = *reinterpret_cast<bf16x8*>(&w); } while (0)
  PK4(p0, 0, pa0); PK4(p0, 8, pa1); PK4(p1, 0, pa2); PK4(p1, 8, pa3);
#undef PK4
}
__device__ __forceinline__ void qkt(f32x16& p0, f32x16& p1, const bf16* Ks, const bf16x8* qr, int r32, int hi) {
  p0 = f32x16{}; p1 = f32x16{};
  for (int d0 = 0; d0 < 8; ++d0) { int cb = (d0 * 16 + hi * 8) * 2;
    bf16x8 b0 = *reinterpret_cast<const bf16x8*>((const char*)Ks + KSWZ(r32, cb));
    bf16x8 b1 = *reinterpret_cast<const bf16x8*>((const char*)Ks + KSWZ(32 + r32, cb));
    p0 = __builtin_amdgcn_mfma_f32_32x32x16_bf16(b0, qr[d0], p0, 0, 0, 0);
    p1 = __builtin_amdgcn_mfma_f32_32x32x16_bf16(b1, qr[d0], p1, 0, 0, 0); }
}
__device__ __forceinline__ int v_st(int k, int c) { const int kk = (k & ~0xC) | ((k & 4) << 1) | ((k & 8) >> 1); return ((kk >> 3) * 4 + (c >> 5)) * 512 + ((kk & 7) * 32 + (c & 31)) * 2; }
__device__ __forceinline__ int v_rd_base(int lane) { return ((lane & 3) << 3) | (((lane >> 2) & 3) << 6) | (((lane >> 4) & 1) << 5) | (((lane >> 5) & 1) << 8); }
constexpr int v_rd_off(int d0, int ks, int half) { return d0 * 512 + ks * 4096 + half * 2048; }
template <int OFF> __device__ __forceinline__ s16x4 tr_read(int vb) {
  s16x4 r; asm volatile("ds_read_b64_tr_b16 %0, %1 offset:%2" : "=&v"(r) : "v"(vb), "i"(OFF) : "memory"); return r;
}
template <int D0> __device__ __forceinline__ void pv_one(f32x16& od, int vb, bf16x8 pa0, bf16x8 pa1, bf16x8 pa2, bf16x8 pa3) {
  const s16x4 l0 = tr_read<v_rd_off(D0, 0, 0)>(vb), h0 = tr_read<v_rd_off(D0, 0, 1)>(vb), l1 = tr_read<v_rd_off(D0, 1, 0)>(vb), h1 = tr_read<v_rd_off(D0, 1, 1)>(vb);
  const s16x4 l2 = tr_read<v_rd_off(D0, 2, 0)>(vb), h2 = tr_read<v_rd_off(D0, 2, 1)>(vb), l3 = tr_read<v_rd_off(D0, 3, 0)>(vb), h3 = tr_read<v_rd_off(D0, 3, 1)>(vb);
  asm volatile("s_waitcnt lgkmcnt(0)" ::: "memory"); SBAR();
#define PK(L, H) (bf16x8){L[0], L[1], L[2], L[3], H[0], H[1], H[2], H[3]}
  od = __builtin_amdgcn_mfma_f32_32x32x16_bf16(pa0, PK(l0, h0), od, 0, 0, 0);
  od = __builtin_amdgcn_mfma_f32_32x32x16_bf16(pa1, PK(l1, h1), od, 0, 0, 0);
  od = __builtin_amdgcn_mfma_f32_32x32x16_bf16(pa2, PK(l2, h2), od, 0, 0, 0);
  od = __builtin_amdgcn_mfma_f32_32x32x16_bf16(pa3, PK(l3, h3), od, 0, 0, 0);
#undef PK
}
__device__ __forceinline__ void pv_d0(f32x16* o, int vb, bf16x8 pa0, bf16x8 pa1, bf16x8 pa2, bf16x8 pa3) {
  pv_one<0>(o[0], vb, pa0, pa1, pa2, pa3); pv_one<1>(o[1], vb, pa0, pa1, pa2, pa3); pv_one<2>(o[2], vb, pa0, pa1, pa2, pa3); pv_one<3>(o[3], vb, pa0, pa1, pa2, pa3);
}

__device__ __forceinline__ void attn_dense_body(const bf16* __restrict__ Qb, const bf16* __restrict__ Kh, const bf16* __restrict__ Vh,
                                                bf16* __restrict__ Ob, int seq, char* lds, const float* __restrict__ qgain, int spos0) {
  typedef bf16 TQ;
  using St = Stage<bf16>; using SQ = Stage<TQ>;
  const int tid = tid_opaque(), wid = tid >> 6, lane = tid & 63, r32 = lane & 31, hi = lane >> 5;
  bf16* V_lds = (bf16*)lds; bf16* K_lds = (bf16*)(lds + 2 * SHM_V);
  float* ws = (float*)(lds + 2 * SHM_V + 2 * SHM_K) + wid * 64; float* li_l = ws; float* al_l = ws + 32;
  float m_reg = -1e30f, l_reg = 0; f32x16 o[4] = {}; bf16x8 qr[8];
  const TQ* Qw = Qb + (long)(wid * QBLK + r32) * LDQ + hi * 8;
#pragma unroll
  for (int d0 = 0; d0 < 8; ++d0) qr[d0] = SQ::tobf(SQ::ld8(Qw + d0 * 16));
  { float qf[8][8]; float ss = 0.f;
#pragma unroll
    for (int d0 = 0; d0 < 8; ++d0)
#pragma unroll
      for (int j = 0; j < 8; ++j) { qf[d0][j] = bf2f((unsigned short)qr[d0][j]); ss += qf[d0][j] * qf[d0][j]; }
    { auto rr = __builtin_amdgcn_permlane32_swap(__float_as_uint(ss), __float_as_uint(ss), false, false); ss = __uint_as_float(rr[0]) + __uint_as_float(rr[1]); }
    const float rsq = 1.0f / sqrtf(ss * (1.0f / D) + 1e-6f);
#pragma unroll
    for (int d0 = 0; d0 < 8; ++d0) { const float* gq = qgain + d0 * 16 + hi * 8; const f32x8 g8 = *reinterpret_cast<const f32x8*>(gq);
#pragma unroll
      for (int j = 0; j < 8; ++j) qf[d0][j] *= rsq * g8[j]; }
    if (spos0 >= 0) { const int sp = spos0 + wid * QBLK + r32; const float prow = (float)(sp / GRIDW), pcol = (float)(sp % GRIDW);
#pragma unroll
      for (int d0 = 0; d0 < 2; ++d0)
#pragma unroll
        for (int j = 0; j < 8; ++j) { const float inv = __builtin_amdgcn_exp2f(-(float)(16 * d0 + 8 * hi + j) * (13.287712379549449f / 32.0f));
          const float cr = __cosf(prow * inv), sr_ = __sinf(prow * inv), cc = __cosf(pcol * inv), sc_ = __sinf(pcol * inv);
          const float a = qf[d0][j], b2 = qf[d0 + 2][j]; qf[d0][j] = a * cr - b2 * sr_; qf[d0 + 2][j] = a * sr_ + b2 * cr;
          const float c = qf[4 + d0][j], e = qf[6 + d0][j]; qf[4 + d0][j] = c * cc - e * sc_; qf[6 + d0][j] = c * sc_ + e * cc; } }
#pragma unroll
    for (int d0 = 0; d0 < 8; ++d0) { u32x4 w = {cvtpk(qf[d0][0], qf[d0][1]), cvtpk(qf[d0][2], qf[d0][3]), cvtpk(qf[d0][4], qf[d0][5]), cvtpk(qf[d0][6], qf[d0][7])}; qr[d0] = *reinterpret_cast<bf16x8*>(&w); } }
  const int sr = tid >> 4, sc = (tid & 15) * 8, vst0 = v_st(sr, sc), vst1 = v_st(32 + sr, sc);
  const int vb0 = (int)(uintptr_t)V_lds + v_rd_base(lane);
  struct { typename St::T vs0, vs1, ks0, ks1; } sr_[SDEPTH];
#define SLOAD(i, k0) do { sr_[i].vs0 = St::ld8(&Vh[(long)((k0) + sr) * LDK + sc]); sr_[i].vs1 = St::ld8(&Vh[(long)((k0) + 32 + sr) * LDK + sc]); \
    sr_[i].ks0 = St::ld8(&Kh[(long)((k0) + sr) * LDK + sc]); sr_[i].ks1 = St::ld8(&Kh[(long)((k0) + 32 + sr) * LDK + sc]); } while (0)
#define SWRITE(b, i) do { *(bf16x8*)((char*)V_lds + (b) * SHM_V + vst0) = St::tobf(sr_[i].vs0);          \
    *(bf16x8*)((char*)V_lds + (b) * SHM_V + vst1) = St::tobf(sr_[i].vs1); int kc = sc * 2;               \
    *(bf16x8*)((char*)K_lds + (b) * SHM_K + KSWZ(sr, kc)) = St::tobf(sr_[i].ks0);                       \
    *(bf16x8*)((char*)K_lds + (b) * SHM_K + KSWZ(32 + sr, kc)) = St::tobf(sr_[i].ks1); } while (0)
#define SWAIT() do { if constexpr (SDEPTH == 2) asm volatile("s_waitcnt vmcnt(4)" ::: "memory"); else asm volatile("s_waitcnt vmcnt(0)" ::: "memory"); } while (0)
#define RESC(a) do { if (__any((a) < 1.f)) { if (hi == 0) al_l[r32] = (a); asm volatile("s_waitcnt lgkmcnt(0)" ::: "memory"); \
    for (int d = 0; d < 4; ++d) for (int r = 0; r < 16; ++r) o[d][r] *= al_l[crow(r, hi)]; } } while (0)
  f32x16 pA0, pA1, pB0, pB1; float mnA, mnB, alA, alB; bf16x8 pa0, pa1, pa2, pa3; const int NT = seq / KVBLK;
  constexpr int SE = 0, SO = SDEPTH - 1;
  SLOAD(SE, 0); asm volatile("s_waitcnt vmcnt(0)" ::: "memory"); SWRITE(0, SE); __syncthreads();
  qkt(pA0, pA1, K_lds, qr, r32, hi); partialSM(pA0, pA1, m_reg, mnA, alA);
  SLOAD(SO, KVBLK); if constexpr (SDEPTH == 2) { if (2 < NT) SLOAD(SE, 2 * KVBLK); }
  SWAIT(); SWRITE(1, SO); __syncthreads();
  for (int j = 1; j + 1 < NT; j += 2) {
    SBAR(); qkt(pB0, pB1, (bf16*)((char*)K_lds + SHM_K), qr, r32, hi);
    finishSM(pA0, pA1, alA, l_reg, pa0, pa1, pa2, pa3); SBAR();
    SLOAD(SO, (j + SDEPTH) * KVBLK); SBAR();
    pv_d0(o, vb0, pa0, pa1, pa2, pa3); partialSM(pB0, pB1, m_reg, mnB, alB);
    __syncthreads(); SWAIT(); SWRITE(0, SE);
    RESC(alB); __syncthreads();
    SBAR(); qkt(pA0, pA1, K_lds, qr, r32, hi);
    finishSM(pB0, pB1, alB, l_reg, pa0, pa1, pa2, pa3); SBAR();
    if (SDEPTH == 1 || j + 3 < NT) SLOAD(SE, (j + 1 + SDEPTH) * KVBLK); SBAR();
    pv_d0(o, vb0 + (int)SHM_V, pa0, pa1, pa2, pa3); partialSM(pA0, pA1, m_reg, mnA, alA);
    __syncthreads(); SWAIT(); SWRITE(1, SO);
    RESC(alA); __syncthreads();
  }
  SBAR(); qkt(pB0, pB1, (bf16*)((char*)K_lds + SHM_K), qr, r32, hi);
  finishSM(pA0, pA1, alA, l_reg, pa0, pa1, pa2, pa3); SBAR();
  pv_d0(o, vb0, pa0, pa1, pa2, pa3); partialSM(pB0, pB1, m_reg, mnB, alB);
  __syncthreads(); RESC(alB);
  finishSM(pB0, pB1, alB, l_reg, pa0, pa1, pa2, pa3); SBAR();
  pv_d0(o, vb0 + (int)SHM_V, pa0, pa1, pa2, pa3);
  if (hi == 0) li_l[r32] = l_reg; asm volatile("s_waitcnt lgkmcnt(0)" ::: "memory");
  float rli[16];
#pragma unroll
  for (int r = 0; r < 16; ++r) rli[r] = __builtin_amdgcn_rcpf(li_l[crow(r, hi)]);
  bf16* Ow = Ob + (long)(wid * QBLK) * LDO;
#pragma unroll
  for (int r = 0; r < 16; ++r) { int orow = crow(r, hi);
    for (int d0 = 0; d0 < 4; ++d0) Ow[(long)orow * LDO + d0 * 32 + r32] = f2bf(o[d0][r] * rli[r]); }
#undef SLOAD
#undef SWRITE
#undef SWAIT
#undef RESC
}
}
__device__ __forceinline__ void attn_phase(const Params& p, unsigned char* lds, int vcu, int G) {
    constexpr int QB = 256, LQB = LSEQ / QB, CQB = CSEQ / QB;
    constexpr int NUL = NLB * NQ * LQB, NUC = NCB * NQ * CQB, NU = NUL + NUC;
    const att::bf16* QR = (const att::bf16*)(p.ws + WS_QRAW); att::bf16* OB = (att::bf16*)(p.ws + WS_O);
    for (int i = 0;; ++i) {
        int u;
        if (G == 256 && NUL == 512) { if (i < 2) u = (vcu >> 5) * 64 + (vcu & 31) + 32 * i; else u = NUL + vcu + (i - 2) * G; }
        else u = vcu + i * G;
        if (u >= NU) break;
        const att::bf16 *Q, *K, *V; att::bf16* O; int seq; int spos0 = -1;
        if (u < NUL) { const int grp = u / (GRP * LQB), j = u % (GRP * LQB); const int b = grp / NKV, kvh = grp % NKV, g = j / LQB, qb = j % LQB, hq = kvh * GRP + g;
            const size_t row0 = (size_t)MC + (size_t)b * LSEQ + (size_t)qb * QB; spos0 = qb * QB;
            Q = QR + row0 * (NQ * HDIM) + hq * HDIM; O = OB + row0 * DM + hq * HDIM;
            K = (const att::bf16*)(p.ws + WS_LATK) + (size_t)b * SKVL * (NKV * HDIM) + kvh * HDIM; V = (const att::bf16*)(p.ws + WS_LATV) + (size_t)b * SKVL * (NKV * HDIM) + kvh * HDIM; seq = SKVL; }
        else { const int uc = u - NUL; const int b = uc / (NQ * CQB), r = uc % (NQ * CQB), hq = r / CQB, qb = r % CQB, kvh = hq / GRP;
            const size_t row0 = (size_t)b * CSEQ + (size_t)qb * QB;
            Q = QR + row0 * (NQ * HDIM) + hq * HDIM; O = OB + row0 * DM + hq * HDIM;
            K = (const att::bf16*)(p.ws + WS_CTXK) + (size_t)b * CSEQ * (NKV * HDIM) + kvh * HDIM; V = (const att::bf16*)(p.ws + WS_CTXV) + (size_t)b * CSEQ * (NKV * HDIM) + kvh * HDIM; seq = CSEQ; }
        __syncthreads();
        att::attn_dense_body(Q, K, V, O, seq, (char*)lds, p.qng, spos0);
    }
}
static_assert(SKVL % 128 == 0 && CSEQ % 128 == 0 && LSEQ % 256 == 0 && CSEQ % 256 == 0, "attention tiling");
constexpr size_t WS_CST = 232 * MiB;
constexpr int NBLK = LSEQ / 256;
constexpr size_t WS_NST = WS_CST + (size_t)NLB * MH * 2 * NBLK * MDK * MDK * 2;
constexpr size_t WS_FTOT = WS_NST + (size_t)NLB * MH * 2 * NBLK * MDK * 4;
static_assert(WS_FTOT + (size_t)NLB * MH * 2 * NBLK * 4 <= WS_END && MDK == 128 && CSEQ == 256 && LSEQ % 256 == 0, "mLSTM fast path geometry");
namespace att {
constexpr int ML_OFF = 132096;
constexpr int ML_SC = ML_OFF + 6144;
constexpr int ML_N = ML_SC + 128;
constexpr int ML_LI = ML_N + 1024;
constexpr int ML_LI2 = ML_LI + 1024;
static_assert(ML_LI2 + 1024 <= LDS_BYTES, "mLSTM LDS map");
constexpr float L2E = 1.4426950408889634f;
using f32x4v = __attribute__((ext_vector_type(4))) float;


__device__ __forceinline__ void ml_gates(const Params& p, char* lds, int row0, int h, int tid) {
    float* A = (float*)(lds + ML_OFF); float* S = (float*)(lds + ML_SC);
    const int half = tid >> 8, t = tid & 255, tok = half ? 255 - t : t, lane = tid & 63, wv = (tid >> 6) & 3;
    const float* G = (const float*)(p.ws + WS_GATES) + (size_t)(row0 + tok) * NGATE + half * 8 + h;
    const float ig = G[0], lf = G[4];
    float v = lf;
#pragma unroll
    for (int off = 1; off < 64; off <<= 1) { const float u = lane_get(v, lane - off); if (lane >= off) v += u; }
    if (lane == 63) S[4 + half * 4 + wv] = v;
    __syncthreads();
    float pre = 0.f, tot = 0.f;
#pragma unroll
    for (int w = 0; w < 4; ++w) { const float x = S[4 + half * 4 + w]; if (w < wv) pre += x; tot += x; }
    const float P = v + pre, a = ig - P;
    A[(0 + half) * 256 + tok] = P * L2E; A[(2 + half) * 256 + tok] = a * L2E; A[(4 + half) * 256 + tok] = __builtin_amdgcn_exp2f(P * L2E);
    float mx = a;
    mx = fmaxf(mx, swz_xor<1>(mx)); mx = fmaxf(mx, swz_xor<2>(mx)); mx = fmaxf(mx, swz_xor<4>(mx)); mx = fmaxf(mx, swz_xor<8>(mx)); mx = fmaxf(mx, swz_xor<16>(mx)); mx = half_max(mx);
    if (lane == 0) S[12 + half * 4 + wv] = mx;
    if (t == 0) S[half] = tot;
    __syncthreads();
    if (t == 0) S[2 + half] = fmaxf(fmaxf(S[12 + half * 4], S[13 + half * 4]), fmaxf(S[14 + half * 4], S[15 + half * 4]));
    __syncthreads();
}
#define ML_PK(L, H) (bf16x8){L[0], L[1], L[2], L[3], H[0], H[1], H[2], H[3]}
__device__ __forceinline__ s16x4 tr_read_rt(int vb) { s16x4 r; asm volatile("ds_read_b64_tr_b16 %0, %1" : "=&v"(r) : "v"(vb) : "memory"); return r; }

__device__ __forceinline__ void ml_passA_unit(const Params& p, char* lds, int sid, int h, int blk) {
    const int tid = tid_opaque(), wid = tid >> 6, lane = tid & 63, r32 = lane & 31, hi = lane >> 5;
    const bool isctx = sid < NCB; const int row0 = seq_base(sid) + 256 * blk;
    __syncthreads();
    ml_gates(p, lds, row0, h, tid);
    float* A = (float*)(lds + ML_OFF); float* S = (float*)(lds + ML_SC); float* NA = (float*)(lds + ML_N);
    const bf16* QK = (const bf16*)(p.ws + WS_QKVO) + (size_t)row0 * (4 * MW) + h * MDK;
    const int sr = tid >> 4, sc8 = (tid & 15) * 8;
    { bf16x8 tv[8];
#pragma unroll
      for (int i = 0; i < 8; ++i) tv[i] = *(const bf16x8*)(QK + (size_t)(32 * i + sr) * (4 * MW) + 2 * MW + sc8);
#pragma unroll
      for (int i = 0; i < 8; ++i) *(bf16x8*)(lds + 65536 + (i >> 1) * 16384 + v_st(32 * (i & 1) + sr, sc8)) = tv[i]; }
    if (tid < 256) NA[tid] = 0.f;
    const int a = wid >> 1, dvb0 = 2 * (wid & 1);
    const int ldsb = (int)(uintptr_t)lds; const int vbK = ldsb + v_rd_base(lane) + a * 512, vbV = ldsb + 65536 + v_rd_base(lane) + dvb0 * 512;
    for (int dir = 0; dir < 2; ++dir) {
        __syncthreads();
        const float ft = S[dir], am = S[2 + dir]; const float mT = isctx ? ft + fmaxf(am, 0.f) : 0.f; const float wl2 = (ft - mT) * L2E;
        float xs[8];
#pragma unroll
        for (int i = 0; i < 8; ++i) xs[i] = 0.f;
        bf16x8 tk[8];
#pragma unroll
        for (int i = 0; i < 8; ++i) tk[i] = *(const bf16x8*)(QK + (size_t)(32 * i + sr) * (4 * MW) + MW + sc8);
#pragma unroll
        for (int j = 0; j < 4; ++j)
#pragma unroll
            for (int hf = 0; hf < 2; ++hf) { const int row = 64 * j + 32 * hf + sr; const float w = __builtin_amdgcn_exp2f(wl2 + A[(2 + dir) * 256 + row]);
                const bf16x8 k8 = tk[2 * j + hf]; float x[8];
#pragma unroll
                for (int i = 0; i < 8; ++i) { x[i] = bf2f((unsigned short)k8[i]) * w; xs[i] += x[i]; }
                u32x4 pk = {cvtpk(x[0], x[1]), cvtpk(x[2], x[3]), cvtpk(x[4], x[5]), cvtpk(x[6], x[7])};
                *(u32x4*)(lds + j * 16384 + v_st(32 * hf + sr, sc8)) = pk; }
#pragma unroll
        for (int i = 0; i < 8; ++i) { float v = xs[i]; v += swz_xor<16>(v); v = half_sum(v); if (lane < 16) atomicAdd(&NA[dir * 128 + sc8 + i], v); }
        __syncthreads();
        f32x16 acc0 = {}, acc1 = {}; const unsigned eoff = (unsigned)((32 * a + 4 * hi) * MDK + 32 * dvb0 + r32);
#pragma unroll
        for (int j = 0; j < 4; ++j)
#pragma unroll
            for (int ks = 0; ks < 4; ++ks) { const int off = j * 16384 + ks * 4096;
                const s16x4 al = tr_read_rt(vbK + off), ah = tr_read_rt(vbK + off + 2048);
                const s16x4 bl0 = tr_read_rt(vbV + off), bh0 = tr_read_rt(vbV + off + 2048), bl1 = tr_read_rt(vbV + off + 512), bh1 = tr_read_rt(vbV + off + 512 + 2048);
                asm volatile("s_waitcnt lgkmcnt(0)" ::: "memory"); SBAR();
                acc0 = __builtin_amdgcn_mfma_f32_32x32x16_bf16(ML_PK(al, ah), ML_PK(bl0, bh0), acc0, 0, 0, 0);
                acc1 = __builtin_amdgcn_mfma_f32_32x32x16_bf16(ML_PK(al, ah), ML_PK(bl1, bh1), acc1, 0, 0, 0); }
        if (isctx) {
            float* Co = p.out + O_C + ((size_t)(sid * 2 + dir) * MH + h) * MDK * MDK;
#pragma unroll
            for (int r = 0; r < 16; ++r) { const unsigned eo = eoff + (unsigned)(((r & 3) + 8 * (r >> 2)) * MDK); Co[eo] = acc0[r]; Co[eo + 32] = acc1[r]; }
            if (tid == 0) p.out[O_M + (size_t)(sid * 2 + dir) * MH + h] = mT;
        } else {
            const int b = sid - NCB; bf16* Cs = (bf16*)(p.ws + WS_CST) + ((size_t)((b * MH + h) * 2 + dir) * NBLK + blk) * MDK * MDK;
#pragma unroll
            for (int r = 0; r < 16; ++r) { const unsigned eo = eoff + (unsigned)(((r & 3) + 8 * (r >> 2)) * MDK); Cs[eo] = f2bf(acc0[r]); Cs[eo + 32] = f2bf(acc1[r]); }
            if (tid == 0) ((float*)(p.ws + WS_FTOT))[((size_t)(b * MH + h) * 2 + dir) * NBLK + blk] = ft;
        }
    }
    __syncthreads();
    if (tid < 256) { const int dir = tid >> 7, d = tid & 127;
        if (isctx) p.out[O_N + ((size_t)(sid * 2 + dir) * MH + h) * MDK + d] = NA[tid];
        else { const int b = sid - NCB; ((float*)(p.ws + WS_NST))[(((size_t)(b * MH + h) * 2 + dir) * NBLK + blk) * MDK + d] = NA[tid]; } }
}

template <int DIR> __device__ __forceinline__ void ml_tile(f32x16* o, float& den, const bf16x8* qr, const char* Ktile, int vbV, const float* AL2, int j, float cq, int trow, bool diag, int r32, int hi) {
    SBAR(); f32x16 p0, p1; qkt(p0, p1, (const bf16*)Ktile, qr, r32, hi); SBAR();
    float ds = 0.f; const int tl = trow - 64 * j - 4 * hi;
#pragma unroll
    for (int g = 0; g < 4; ++g) { const f32x4v a0 = *(const f32x4v*)(AL2 + 64 * j + 8 * g + 4 * hi), a1 = *(const f32x4v*)(AL2 + 64 * j + 32 + 8 * g + 4 * hi);
#pragma unroll
        for (int e = 0; e < 4; ++e) { float w0 = __builtin_amdgcn_exp2f(cq + a0[e]), w1 = __builtin_amdgcn_exp2f(cq + a1[e]);
            if (diag) { if (DIR == 0 ? (8 * g + e > tl) : (8 * g + e < tl)) w0 = 0.f; if (DIR == 0 ? (8 * g + e + 32 > tl) : (8 * g + e + 32 < tl)) w1 = 0.f; }
            p0[4 * g + e] *= w0; p1[4 * g + e] *= w1; ds += p0[4 * g + e] + p1[4 * g + e]; } }
    den += ds;
    bf16x8 pa0, pa1, pa2, pa3;
#define PK4(P, BASE, OUT) do { unsigned a0_ = cvtpk(P[BASE + 0], P[BASE + 1]), a1_ = cvtpk(P[BASE + 2], P[BASE + 3]);   \
    unsigned b0_ = cvtpk(P[BASE + 4], P[BASE + 5]), b1_ = cvtpk(P[BASE + 6], P[BASE + 7]);                              \
    auto r0_ = __builtin_amdgcn_permlane32_swap(a0_, b0_, false, false); auto r1_ = __builtin_amdgcn_permlane32_swap(a1_, b1_, false, false); \
    u32x4 w_ = {r0_[0], r1_[0], r0_[1], r1_[1]}; OUT = *reinterpret_cast<bf16x8*>(&w_); } while (0)
    PK4(p0, 0, pa0); PK4(p0, 8, pa1); PK4(p1, 0, pa2); PK4(p1, 8, pa3);
#undef PK4
    SBAR(); pv_d0(o, vbV, pa0, pa1, pa2, pa3); SBAR();
}
struct MlKv { bf16x8 tk[4], tv[4]; };
__device__ __forceinline__ void ml_kv_load(MlKv& r, const bf16* QK, int tile0, int sr, int sc8) {
#pragma unroll
    for (int i = 0; i < 4; ++i) { const int row = 64 * tile0 + 32 * i + sr; r.tk[i] = *(const bf16x8*)(QK + (size_t)row * (4 * MW) + MW + sc8); r.tv[i] = *(const bf16x8*)(QK + (size_t)row * (4 * MW) + 2 * MW + sc8); }
}
__device__ __forceinline__ void ml_kv_write(const MlKv& r, char* lds, int sr, int sc8) {
#pragma unroll
    for (int i = 0; i < 4; ++i) { const int jj = i >> 1, rl = 32 * (i & 1) + sr; *(bf16x8*)(lds + jj * 16384 + KSWZ(rl, sc8 * 2)) = r.tk[i]; *(bf16x8*)(lds + 32768 + jj * 16384 + v_st(rl, sc8)) = r.tv[i]; }
}
__device__ __forceinline__ void ml_passC_unit(const Params& p, char* lds, int sid, int h, int blk) {
    const int tid = tid_opaque(), wid = tid >> 6, lane = tid & 63, r32 = lane & 31, hi = lane >> 5;
    const bool isctx = sid < NCB; const int row0 = seq_base(sid) + 256 * blk; const int wq = wid >> 1;
    __syncthreads();
    ml_gates(p, lds, row0, h, tid);
    float* A = (float*)(lds + ML_OFF); float* NS = (float*)(lds + ML_N); float* li = (float*)(lds + ML_LI) + wid * 32;
    const bf16* QK = (const bf16*)(p.ws + WS_QKVO) + (size_t)row0 * (4 * MW) + h * MDK;
    const int sr = tid >> 4, sc8 = (tid & 15) * 8; const int b = sid - NCB;
    if (tid < 256) { const int dir = tid >> 7, d = tid & 127;
        NS[tid] = isctx ? 0.f : ((const float*)(p.ws + WS_NST))[(((size_t)(b * MH + h) * 2 + dir) * NBLK + blk) * MDK + d]; }
    if (!isctx) { bf16x8 tc[8];
#pragma unroll
        for (int i = 0; i < 8; ++i) { const int dir = i >> 2, c = tid + 512 * (i & 3); tc[i] = *(const bf16x8*)((const bf16*)(p.ws + WS_CST) + ((size_t)((b * MH + h) * 2 + dir) * NBLK + blk) * MDK * MDK + (size_t)c * 8); }
#pragma unroll
        for (int i = 0; i < 8; ++i) { const int dir = i >> 2, c = tid + 512 * (i & 3), row = c >> 4, col8 = (c & 15) * 8; *(bf16x8*)(lds + 65536 + dir * 32768 + (row >> 6) * 16384 + v_st(row & 63, col8)) = tc[i]; }
    }
    bf16x8 qr[8];
    { const bf16* Qw = QK + (size_t)(wid * 32 + r32) * (4 * MW) + hi * 8;
#pragma unroll
        for (int d0 = 0; d0 < 8; ++d0) qr[d0] = *(const bf16x8*)(Qw + d0 * 16); }
    { MlKv kv; ml_kv_load(kv, QK, 0, sr, sc8); ml_kv_write(kv, lds, sr, sc8); }
    __syncthreads();
    float qn_f = 0.f, qn_b = 0.f;
#pragma unroll
    for (int d0 = 0; d0 < 8; ++d0)
#pragma unroll
        for (int i = 0; i < 8; ++i) { const float qv = bf2f((unsigned short)qr[d0][i]); qn_f += qv * NS[d0 * 16 + hi * 8 + i]; qn_b += qv * NS[128 + d0 * 16 + hi * 8 + i]; }
    qn_f = half_sum(qn_f); qn_b = half_sum(qn_b);
    const int ldsb = (int)(uintptr_t)lds; const int vbV = ldsb + 32768 + v_rd_base(lane), vbC = ldsb + 65536 + v_rd_base(lane);
    const int trow = wid * 32 + r32;
    f32x16 of[4], ob[4];
#pragma unroll
    for (int d0 = 0; d0 < 4; ++d0) { of[d0] = f32x16{}; ob[d0] = f32x16{}; }
    if (!isctx) { pv_d0(of, vbC, qr[0], qr[1], qr[2], qr[3]); pv_d0(of, vbC + 16384, qr[4], qr[5], qr[6], qr[7]);
        pv_d0(ob, vbC + 32768, qr[0], qr[1], qr[2], qr[3]); pv_d0(ob, vbC + 32768 + 16384, qr[4], qr[5], qr[6], qr[7]);
#pragma unroll
        for (int r = 0; r < 16; ++r) { const float ef = A[4 * 256 + wid * 32 + crow(r, hi)], eb = A[5 * 256 + wid * 32 + crow(r, hi)];
#pragma unroll
            for (int d0 = 0; d0 < 4; ++d0) { of[d0][r] *= ef; ob[d0][r] *= eb; } } }
    const float cqf = A[0 * 256 + trow], cqb = A[1 * 256 + trow]; float denf = 0.f, denb = 0.f;
    ml_tile<0>(of, denf, qr, lds, vbV, A + 2 * 256, 0, cqf, trow, wq == 0, r32, hi);
    if (wq >= 1) ml_tile<0>(of, denf, qr, lds + 16384, vbV + 16384, A + 2 * 256, 1, cqf, trow, wq == 1, r32, hi);
    if (wq <= 1) ml_tile<1>(ob, denb, qr, lds + 16384, vbV + 16384, A + 3 * 256, 1, cqb, trow, wq == 1, r32, hi);
    if (wq <= 0) ml_tile<1>(ob, denb, qr, lds, vbV, A + 3 * 256, 0, cqb, trow, wq == 0, r32, hi);
    __syncthreads();
    { MlKv kv; ml_kv_load(kv, QK, 2, sr, sc8); ml_kv_write(kv, lds, sr, sc8); }
    __syncthreads();
    if (wq >= 2) ml_tile<0>(of, denf, qr, lds, vbV, A + 2 * 256, 2, cqf, trow, wq == 2, r32, hi);
    if (wq >= 3) ml_tile<0>(of, denf, qr, lds + 16384, vbV + 16384, A + 2 * 256, 3, cqf, trow, wq == 3, r32, hi);
    ml_tile<1>(ob, denb, qr, lds + 16384, vbV + 16384, A + 3 * 256, 3, cqb, trow, wq == 3, r32, hi);
    if (wq <= 2) ml_tile<1>(ob, denb, qr, lds, vbV, A + 3 * 256, 2, cqb, trow, wq == 2, r32, hi);
    denf = half_sum(denf); denb = half_sum(denb);
    const float invf = 1.0f / fmaxf(fabsf(denf + __builtin_amdgcn_exp2f(cqf) * qn_f), 1.0f), invb = 1.0f / fmaxf(fabsf(denb + __builtin_amdgcn_exp2f(cqb) * qn_b), 1.0f);
    float* li2 = (float*)(lds + ML_LI2) + wid * 32;
    if (hi == 0) { li[r32] = invf; li2[r32] = invb; } asm volatile("s_waitcnt lgkmcnt(0)" ::: "memory");
    const unsigned uho = (unsigned)(4 * hi * DM + r32), ogo = (unsigned)(4 * hi * 4 * MW + r32);
    float mg[4];
#pragma unroll
    for (int d0 = 0; d0 < 4; ++d0) mg[d0] = p.mng[h * MDK + d0 * 32 + r32];
    const bf16* OG = QK + (size_t)(wid * 32) * (4 * MW) + 3 * MW; bf16* UHo = (bf16*)(p.ws + WS_UH) + (size_t)(row0 + wid * 32) * DM + CCH + h * MDK;
#pragma unroll
    for (int r = 0; r < 16; ++r) { const float rlf = li[crow(r, hi)], rlb = li2[crow(r, hi)]; const int rc = (r & 3) + 8 * (r >> 2); float ss = 0.f; float x[4];
#pragma unroll
        for (int d0 = 0; d0 < 4; ++d0) { x[d0] = of[d0][r] * rlf + ob[d0][r] * rlb; ss += x[d0] * x[d0]; }
        ss += swz_xor<1>(ss); ss += swz_xor<2>(ss); ss += swz_xor<4>(ss); ss += swz_xor<8>(ss); ss += swz_xor<16>(ss);
        const float rs = 1.0f / sqrtf(ss * (1.0f / MDK) + EPSF);
#pragma unroll
        for (int d0 = 0; d0 < 4; ++d0) UHo[uho + (unsigned)(rc * DM + d0 * 32)] = f2bf(bf2f(OG[ogo + (unsigned)(rc * 4 * MW + d0 * 32)]) * x[d0] * rs * mg[d0]);
        if ((r & 3) == 3) asm volatile("" ::: "memory"); }
}
}

template <int DIR> __device__ __forceinline__ void ml_scan_item(const Params& p, int ch, int b, int h, int e8) {
    const float em = expf(p.stm[(size_t)(b * 2 + DIR) * MH + h]); const float* FT = (const float*)(p.ws + WS_FTOT) + (size_t)ch * NBLK;
    float fd[NBLK];
#pragma unroll
    for (int i = 0; i < NBLK; ++i) fd[i] = expf(FT[i]);
    if (e8 < MDK * MDK) { bf16_t* Cs = (bf16_t*)(p.ws + WS_CST) + (size_t)ch * NBLK * MDK * MDK + e8; const float* c0 = p.stC + ((size_t)(b * 2 + DIR) * MH + h) * MDK * MDK + e8;
        v4u d[NBLK];
#pragma unroll
        for (int i = 0; i < NBLK; ++i) d[i] = *(const v4u*)(Cs + (size_t)i * MDK * MDK);
        const f32x4 ca = *(const f32x4*)c0, cb = *(const f32x4*)(c0 + 4); float c[8] = {ca[0] * em, ca[1] * em, ca[2] * em, ca[3] * em, cb[0] * em, cb[1] * em, cb[2] * em, cb[3] * em};
#pragma unroll
        for (int i = 0; i < NBLK; ++i) { const int blk = DIR == 0 ? i : NBLK - 1 - i; v4u o;
#pragma unroll
            for (int w = 0; w < 4; ++w) { const float lo = __uint_as_float(d[blk][w] << 16), hi = __uint_as_float(d[blk][w] & 0xffff0000u); o[w] = pg8::cvt_pk_bf16(c[2 * w], c[2 * w + 1]);
                c[2 * w] = fd[blk] * c[2 * w] + lo; c[2 * w + 1] = fd[blk] * c[2 * w + 1] + hi; }
            *(v4u*)(Cs + (size_t)blk * MDK * MDK) = o; } }
    else { const int d_ = e8 - MDK * MDK; float* Ns = (float*)(p.ws + WS_NST) + (size_t)ch * NBLK * MDK + d_; const float* n0 = p.stn + ((size_t)(b * 2 + DIR) * MH + h) * MDK + d_;
        f32x4 da[NBLK], db[NBLK];
#pragma unroll
        for (int i = 0; i < NBLK; ++i) { da[i] = *(const f32x4*)(Ns + (size_t)i * MDK); db[i] = *(const f32x4*)(Ns + (size_t)i * MDK + 4); }
        f32x4 ca = *(const f32x4*)n0 * em, cb = *(const f32x4*)(n0 + 4) * em;
#pragma unroll
        for (int i = 0; i < NBLK; ++i) { const int blk = DIR == 0 ? i : NBLK - 1 - i;
            *(f32x4*)(Ns + (size_t)blk * MDK) = ca; *(f32x4*)(Ns + (size_t)blk * MDK + 4) = cb; ca = ca * fd[blk] + da[blk]; cb = cb * fd[blk] + db[blk]; } }
}
struct MlScan {
    Params p; static HD_FN long count() { return (long)NLB * MH * 2 * ((MDK * MDK + MDK) / 8); }
    __device__ __forceinline__ void operator()(long idx) const {
        constexpr int per = (MDK * MDK + MDK) / 8; const int e8 = (int)(idx % per) * 8; const int ch = (int)(idx / per); const int dir = ch & 1, h = (ch >> 1) % MH, b = ch / (2 * MH);
        if (dir == 0) ml_scan_item<0>(p, ch, b, h, e8); else ml_scan_item<1>(p, ch, b, h, e8);
    }
};
__device__ __forceinline__ void ml_phase_A(const Params& p, unsigned char* lds, int vcu, int G) {
    constexpr int NUL = NLB * MH * NBLK, NU = NUL + NCB * MH;
    for (int u = vcu; u < NU; u += G) {
        if (u < NUL) att::ml_passA_unit(p, (char*)lds, NCB + u / (MH * NBLK), (u / NBLK) % MH, u % NBLK);
        else att::ml_passA_unit(p, (char*)lds, (u - NUL) / MH, (u - NUL) % MH, 0); }
}
__device__ __forceinline__ void ml_phase_C(const Params& p, unsigned char* lds, int vcu, int G) {
    constexpr int NUL = NLB * MH * NBLK, NU = NUL + NCB * MH;
    for (int u = vcu; u < NU; u += G) {
        if (u < NUL) att::ml_passC_unit(p, (char*)lds, NCB + u / (MH * NBLK), (u / NBLK) % MH, u % NBLK);
        else att::ml_passC_unit(p, (char*)lds, (u - NUL) / MH, (u - NUL) % MH, 0); }
}
typedef float f4 __attribute__((ext_vector_type(4)));
typedef unsigned u4 __attribute__((ext_vector_type(4)));
typedef unsigned u2 __attribute__((ext_vector_type(2)));
__device__ __forceinline__ float wave_sum64(float v) { v += swz_xor<1>(v); v += swz_xor<2>(v); v += swz_xor<4>(v); v += swz_xor<8>(v); v += swz_xor<16>(v); return half_sum(v); }
__device__ __forceinline__ float fsilu(float x) { return x * fsigmoid(x); }

__device__ __forceinline__ void phase_mod(const Params& p, char* lds, int bx, int G) {
    const int tid = tid_opaque(), lane = tid & 63, wave = tid >> 6;
    float* SL = (float*)lds; float* PT = (float*)(lds + 32768);
    constexpr int NCG = 6 * DM / 64, NIT = 2 * NCG;
    if (bx >= NIT) return;
    __syncthreads();
    for (int i = tid; i < NCLS * DM; i += NTHREADS) { const int cls = i / DM, k = i % DM; const float cv = cls == 0 ? p.cctx[k] : p.c[(size_t)(cls - 1) * DM + k]; SL[i] = fsilu(cv); }
    for (int item = bx; item < NIT; item += G) {
        __syncthreads();
        const int l = item / NCG, cg = item % NCG; const float* w = p.wmod + (size_t)l * DM * 6 * DM + cg * 64 + lane;
        float acc[NCLS];
#pragma unroll
        for (int r = 0; r < NCLS; ++r) acc[r] = 0.f;
        const int k0 = wave * (DM / 8);
#pragma unroll 8
        for (int k = k0; k < k0 + DM / 8; ++k) { const float wv = w[(size_t)k * 6 * DM];
#pragma unroll
            for (int r = 0; r < NCLS; ++r) acc[r] += SL[r * DM + k] * wv; }
#pragma unroll
        for (int r = 0; r < NCLS; ++r) PT[(wave * NCLS + r) * 64 + lane] = acc[r];
        __syncthreads();
        if (tid < NCLS * 64) { const int r = tid >> 6; float s = p.bmod[(size_t)l * 6 * DM + cg * 64 + lane];
#pragma unroll
            for (int w8 = 0; w8 < 8; ++w8) s += PT[(w8 * NCLS + r) * 64 + lane];
            ((float*)(p.ws + WS_MOD))[((size_t)(l * NCLS + r) * 6 * DM) + cg * 64 + lane] = s; }
    }
}
__device__ __forceinline__ void sw_job(const Params& p, const bf16_t* Bt, int nrows, int l, int which, float* sw, int N, int mode, int gw, int NGW, int lane) {
    if (gw >= nrows) return;
    f4 sh[NCLS][4];
#pragma unroll
    for (int cls = 0; cls < NCLS; ++cls) { const float* s_ = modv(p, l, cls, which); sh[cls][0] = *(const f4*)(s_ + lane * 8); sh[cls][1] = *(const f4*)(s_ + lane * 8 + 4); sh[cls][2] = *(const f4*)(s_ + DM / 2 + lane * 8); sh[cls][3] = *(const f4*)(s_ + DM / 2 + lane * 8 + 4); }
    u4 w0 = *(const u4*)(Bt + (size_t)gw * DM + lane * 8), w1 = *(const u4*)(Bt + (size_t)gw * DM + DM / 2 + lane * 8);
    for (int n = gw; n < nrows; n += NGW) {
        const u4 c0 = w0, c1 = w1; const int nn = n + NGW; if (nn < nrows) { w0 = *(const u4*)(Bt + (size_t)nn * DM + lane * 8); w1 = *(const u4*)(Bt + (size_t)nn * DM + DM / 2 + lane * 8); }
        f4 wa, wb, wc, wd; wa = (f4){__uint_as_float(c0.x << 16), __uint_as_float(c0.x & 0xffff0000u), __uint_as_float(c0.y << 16), __uint_as_float(c0.y & 0xffff0000u)};
        wb = (f4){__uint_as_float(c0.z << 16), __uint_as_float(c0.z & 0xffff0000u), __uint_as_float(c0.w << 16), __uint_as_float(c0.w & 0xffff0000u)};
        wc = (f4){__uint_as_float(c1.x << 16), __uint_as_float(c1.x & 0xffff0000u), __uint_as_float(c1.y << 16), __uint_as_float(c1.y & 0xffff0000u)};
        wd = (f4){__uint_as_float(c1.z << 16), __uint_as_float(c1.z & 0xffff0000u), __uint_as_float(c1.w << 16), __uint_as_float(c1.w & 0xffff0000u)};
        int col = n; if (mode == 1) { const int t = n >> 8, r = n & 255; col = r < 128 ? 128 * t + r : (N / 2) + 128 * t + (r - 128); }
        float mine = 0.f;
#pragma unroll
        for (int cls = 0; cls < NCLS; ++cls) { const f4 t4 = sh[cls][0] * wa + sh[cls][1] * wb + sh[cls][2] * wc + sh[cls][3] * wd; float s = (t4[0] + t4[1]) + (t4[2] + t4[3]); s = wave_sum64(s); if (lane == cls) mine = s; }
        if (lane < NCLS) sw[(size_t)lane * N + col] = mine;
    }
}
static_assert(DM == 1024, "sw_job / norm passes assume 1024 = 64 lanes x 16");
typedef float f32x4g __attribute__((ext_vector_type(4)));
__device__ __forceinline__ void phase_norm0(const Params& p, char* lds, int bx, int G) {
    const int tid = tid_opaque(), lane = tid & 63, wave = tid >> 6; constexpr int WLD = DM + 4;
    float* WG = (float*)lds; float* XS = (float*)(lds + 16 * WLD * 4);
    __syncthreads();
    { f4 tv[DM * 4 / NTHREADS];
#pragma unroll
      for (int it = 0; it < DM * 4 / NTHREADS; ++it) { const int k = it * (NTHREADS / 4) + (tid >> 2); tv[it] = *(const f4*)(p.winab + (size_t)k * ABIN + ABMAIN + 4 * (tid & 3)); }
#pragma unroll
      for (int it = 0; it < DM * 4 / NTHREADS; ++it) { const int k = it * (NTHREADS / 4) + (tid >> 2), g0 = 4 * (tid & 3); WG[(g0 + 0) * WLD + k] = tv[it][0]; WG[(g0 + 1) * WLD + k] = tv[it][1]; WG[(g0 + 2) * WLD + k] = tv[it][2]; WG[(g0 + 3) * WLD + k] = tv[it][3]; } }
    const int r = lane & 15, kq = lane >> 4, pair = wave >> 1, kh = wave & 1;
    float* SQ = XS + pair * 32; float* GP = XS + 128 + pair * 256;
    for (int it = 0;; ++it) {
        const int rb0 = (it * G + bx) * (NWAVES / 2); if (rb0 >= MTOK / 16) break;
        const int rb = rb0 + pair; const int row = rb * 16 + r; const int cls = cls_of(rb * 16); const int kb = 512 * kh + 4 * kq;
        const float* xr = xrow(p, row) + kb;
        f4 x[32]; float s = 0.f;
#pragma unroll
        for (int q = 0; q < 32; ++q) x[q] = *(const f4*)(xr + 16 * q);
#pragma unroll
        for (int q = 0; q < 32; ++q) s += (x[q][0] * x[q][0] + x[q][1] * x[q][1]) + (x[q][2] * x[q][2] + x[q][3] * x[q][3]);
        s += swz_xor<16>(s); s = half_sum(s);
        __syncthreads();
        if (kq == 0) SQ[kh * 16 + r] = s;
        __syncthreads();
        const float rs = 1.0f / sqrtf((SQ[r] + SQ[16 + r]) * (1.0f / DM) + EPSF);
        const float* gp = p.n1g + kb; const float* scp = modv(p, 0, cls, 1) + kb; const float* shp = modv(p, 0, cls, 0) + kb; const float* wp = WG + r * WLD + kb;
        bf16_t* xo = (bf16_t*)(p.ws + WS_XN) + (size_t)row * DM + kb;
        f32x4g acc = {0.f, 0.f, 0.f, 0.f};
#pragma unroll
        for (int q = 0; q < 32; ++q) { const f4 gg = *(const f4*)(gp + 16 * q), sc = *(const f4*)(scp + 16 * q), sh = *(const f4*)(shp + 16 * q), w = *(const f4*)(wp + 16 * q);
            const f4 h = x[q] * rs * gg * (sc + 1.0f) + sh;
            u2 o; o.x = pg8::cvt_pk_bf16(h[0], h[1]); o.y = pg8::cvt_pk_bf16(h[2], h[3]); *(u2*)(xo + 16 * q) = o;
            acc = __builtin_amdgcn_mfma_f32_16x16x4f32(h[0], w[0], acc, 0, 0, 0); acc = __builtin_amdgcn_mfma_f32_16x16x4f32(h[1], w[1], acc, 0, 0, 0);
            acc = __builtin_amdgcn_mfma_f32_16x16x4f32(h[2], w[2], acc, 0, 0, 0); acc = __builtin_amdgcn_mfma_f32_16x16x4f32(h[3], w[3], acc, 0, 0, 0); }
        if (kh == 1) *(f32x4g*)(GP + lane * 4) = acc;
        __syncthreads();
        if (kh == 0) { const f32x4g o2 = *(const f32x4g*)(GP + lane * 4); const float bg = p.bgate[r];
#pragma unroll
            for (int e = 0; e < 4; ++e) { float a = acc[e] + o2[e] + bg; if ((r & 7) >= 4) a = logsigmoidf_(a); ((float*)(p.ws + WS_GATES))[(size_t)(rb * 16 + 4 * kq + e) * NGATE + r] = a; } }
    }
}
static_assert(MTOK % 64 == 0 && MC % 16 == 0 && LSEQ % 16 == 0 && DM == 1024, "norm0 row blocks");
__device__ __forceinline__ void phase_conv(const Params& p, char* lds, int ufirst, int ustride, int uend) {
    const int tid = tid_opaque(), lane = tid & 63, wave = tid >> 6; constexpr int TT = 32, NR = TT + CWID - 1;
    bf16_t* X = (bf16_t*)lds; float* OUT = (float*)(lds + 65536);
    const int cp = tid & 255, tg = tid >> 8, c0 = 2 * cp;
    float w0[CWID], w1[CWID];
#pragma unroll
    for (int j = 0; j < CWID; ++j) { w0[j] = p.convw[(size_t)j * CCH + c0]; w1[j] = p.convw[(size_t)j * CCH + c0 + 1]; }
    const float b0 = p.convb[c0], b1 = p.convb[c0 + 1];
    const bf16_t* U = (const bf16_t*)(p.ws + WS_UPRE);
    for (int u = ufirst; u < uend; u += ustride) {
        const int row0 = u * TT, pos0 = pos_of(row0), len = seqlen_of(row0);
        __syncthreads();
        { u4 val[8];
#pragma unroll
          for (int i = 0; i < 8; ++i) { const int c = tid + NTHREADS * i, r = c / (CCH / 8), ch = (c % (CCH / 8)) * 8; const int t = pos0 + r - CWID / 2;
              val[i] = (u4){0u, 0u, 0u, 0u}; if (c < NR * (CCH / 8) && t >= 0 && t < len) val[i] = *(const u4*)(U + (size_t)(row0 + r - CWID / 2) * CCH + ch); }
#pragma unroll
          for (int i = 0; i < 8; ++i) { const int c = tid + NTHREADS * i, r = c / (CCH / 8), ch = (c % (CCH / 8)) * 8; if (c < NR * (CCH / 8)) *(u4*)(X + (size_t)r * CCH + ch) = val[i]; } }
        __syncthreads();
#pragma unroll 2
        for (int tt = 0; tt < TT / 2; ++tt) { const int t = tg * (TT / 2) + tt; float a0 = b0, a1 = b1;
#pragma unroll
            for (int j = 0; j < CWID; ++j) { const unsigned xx = *(const unsigned*)(X + (size_t)(t + j) * CCH + c0); a0 += w0[j] * __uint_as_float(xx << 16); a1 += w1[j] * __uint_as_float(xx & 0xffff0000u); }
            *(float2*)(OUT + (size_t)t * CCH + c0) = make_float2(a0, a1); }
        __syncthreads();
#pragma unroll
        for (int q = 0; q < TT / NWAVES; ++q) { const int t = wave * (TT / NWAVES) + q; const f4 x0 = *(const f4*)(OUT + (size_t)t * CCH + lane * 8), x1 = *(const f4*)(OUT + (size_t)t * CCH + lane * 8 + 4);
            const float mu = wave_sum64((x0[0] + x0[1]) + (x0[2] + x0[3]) + (x1[0] + x1[1]) + (x1[2] + x1[3])) * (1.0f / CCH);
            const f4 d0 = x0 - mu, d1 = x1 - mu;
            const float var = wave_sum64((d0[0] * d0[0] + d0[1] * d0[1]) + (d0[2] * d0[2] + d0[3] * d0[3]) + (d1[0] * d1[0] + d1[1] * d1[1]) + (d1[2] * d1[2] + d1[3] * d1[3])) * (1.0f / CCH);
            const float rs = 1.0f / sqrtf(var + EPSF);
            const f4 g0 = *(const f4*)(p.lng + lane * 8), g1 = *(const f4*)(p.lng + lane * 8 + 4), be0 = *(const f4*)(p.lnb + lane * 8), be1 = *(const f4*)(p.lnb + lane * 8 + 4);
            const f4 y0 = d0 * rs * g0 + be0, y1 = d1 * rs * g1 + be1; u4 w;
            w.x = pg8::cvt_pk_bf16(fsilu(y0[0]), fsilu(y0[1])); w.y = pg8::cvt_pk_bf16(fsilu(y0[2]), fsilu(y0[3])); w.z = pg8::cvt_pk_bf16(fsilu(y1[0]), fsilu(y1[1])); w.w = pg8::cvt_pk_bf16(fsilu(y1[2]), fsilu(y1[3]));
            *(u4*)((bf16_t*)(p.ws + WS_UH) + (size_t)(row0 + t) * DM + lane * 8) = w; }
    }
}
static_assert(CCH == 512 && CSEQ % 32 == 0 && LSEQ % 32 == 0, "conv phase geometry");
__device__ __forceinline__ void phase_cachecvt(const Params& p, int gtid, int gthreads) {
    constexpr int PER = PAST * NKV * HDIM / 8;
    for (int i = gtid; i < NLB * PER; i += gthreads) { const int b = i / PER, e = (i % PER) * 8; const size_t src = (size_t)b * PAST * NKV * HDIM + e, dst = ((size_t)b * SKVL + LSEQ) * NKV * HDIM + e;
        const f4 k0 = *(const f4*)(p.ck + src), k1 = *(const f4*)(p.ck + src + 4), v0 = *(const f4*)(p.cv + src), v1 = *(const f4*)(p.cv + src + 4); u4 wk, wv;
        wk.x = pg8::cvt_pk_bf16(k0[0], k0[1]); wk.y = pg8::cvt_pk_bf16(k0[2], k0[3]); wk.z = pg8::cvt_pk_bf16(k1[0], k1[1]); wk.w = pg8::cvt_pk_bf16(k1[2], k1[3]);
        wv.x = pg8::cvt_pk_bf16(v0[0], v0[1]); wv.y = pg8::cvt_pk_bf16(v0[2], v0[3]); wv.z = pg8::cvt_pk_bf16(v1[0], v1[1]); wv.w = pg8::cvt_pk_bf16(v1[2], v1[3]);
        *(u4*)((bf16_t*)(p.ws + WS_LATK) + dst) = wk; *(u4*)((bf16_t*)(p.ws + WS_LATV) + dst) = wv; }
}
__device__ __forceinline__ void phase_qkpost(const Params& p, int gw, int NGW, int lane) {
    const int hh = lane >> 5, l5 = lane & 31, half = l5 >> 4, f0 = (l5 & 15) * 2, d1 = half * 64 + f0, d2 = d1 + 32;
    const float inv0 = __builtin_amdgcn_exp2f(-(float)f0 * (13.287712379549449f / 32.0f)), inv1 = __builtin_amdgcn_exp2f(-(float)(f0 + 1) * (13.287712379549449f / 32.0f));
    const float qg[4] = {p.qng[d1], p.qng[d1 + 1], p.qng[d2], p.qng[d2 + 1]}, kg[4] = {p.kng[d1], p.kng[d1 + 1], p.kng[d2], p.kng[d2 + 1]};
    for (int row = gw; row < MTOK; row += NGW) {
        const bool lat = row >= MC; const int sp = pos_of(row); float cs0 = 1.f, sn0 = 0.f, cs1 = 1.f, sn1 = 0.f;
        if (lat) { const float pos = (float)(half == 0 ? sp / GRIDW : sp % GRIDW); cs0 = __cosf(pos * inv0); sn0 = __sinf(pos * inv0); cs1 = __cosf(pos * inv1); sn1 = __sinf(pos * inv1); }
        bf16_t* Q = (bf16_t*)(p.ws + WS_QRAW) + (size_t)row * NQ * HDIM; const bf16_t* KR = (const bf16_t*)(p.ws + WS_KRAW) + (size_t)row * NKV * HDIM;
        unsigned ra[NQ / 2 + 1], rb[NQ / 2 + 1];
#pragma unroll
        for (int it = NQ / 2; it <= NQ / 2; ++it) { const bf16_t* src = it < NQ / 2 ? Q + (2 * it + hh) * HDIM : KR + hh * HDIM; ra[it] = *(const unsigned*)(src + d1); rb[it] = *(const unsigned*)(src + d2); }
#pragma unroll
        for (int it = NQ / 2; it <= NQ / 2; ++it) { const bool isq = it < NQ / 2;
            const float x1a = __uint_as_float(ra[it] << 16), x1b = __uint_as_float(ra[it] & 0xffff0000u), x2a = __uint_as_float(rb[it] << 16), x2b = __uint_as_float(rb[it] & 0xffff0000u);
            float ss = (x1a * x1a + x1b * x1b) + (x2a * x2a + x2b * x2b); ss += swz_xor<1>(ss); ss += swz_xor<2>(ss); ss += swz_xor<4>(ss); ss += swz_xor<8>(ss); ss += swz_xor<16>(ss);
            const float rs = 1.0f / sqrtf(ss * (1.0f / HDIM) + EPSF); const float* g = isq ? qg : kg;
            const float a0 = x1a * rs * g[0], a1 = x1b * rs * g[1], b0 = x2a * rs * g[2], b1 = x2b * rs * g[3];
            const float y1a = a0 * cs0 - b0 * sn0, y2a = a0 * sn0 + b0 * cs0, y1b = a1 * cs1 - b1 * sn1, y2b = a1 * sn1 + b1 * cs1;
            const unsigned w1 = pg8::cvt_pk_bf16(y1a, y1b), w2 = pg8::cvt_pk_bf16(y2a, y2b);
            if (isq) { bf16_t* dst = Q + (2 * it + hh) * HDIM; *(unsigned*)(dst + d1) = w1; *(unsigned*)(dst + d2) = w2; }
            else if (!lat) { bf16_t* K = (bf16_t*)(p.ws + WS_CTXK) + (size_t)row * NKV * HDIM + hh * HDIM; *(unsigned*)(K + d1) = w1; *(unsigned*)(K + d2) = w2;
                float* fo = p.out + O_K + (size_t)row * NKV * HDIM + hh * HDIM; *(float2*)(fo + d1) = make_float2(y1a, y1b); *(float2*)(fo + d2) = make_float2(y2a, y2b); }
            else { const int b_ = (row - MC) / LSEQ, s_ = (row - MC) % LSEQ; bf16_t* K = (bf16_t*)(p.ws + WS_LATK) + ((size_t)b_ * SKVL + s_) * NKV * HDIM + hh * HDIM; *(unsigned*)(K + d1) = w1; *(unsigned*)(K + d2) = w2; } }
    }
}
static_assert(NKV == 2 && NQ % 2 == 0 && HDIM == 128, "qkpost lane mapping");
__device__ __forceinline__ void phase_final(const Params& p, int gw, int NGW, int lane) {
    const f4 g0 = *((const f4*)p.fng + 2 * lane), g1 = *((const f4*)p.fng + 2 * lane + 1), g2 = *((const f4*)p.fng + 128 + 2 * lane), g3 = *((const f4*)p.fng + 128 + 2 * lane + 1);
    const float* sq = (const float*)(p.ws + WS_SSQ) + (size_t)3 * SSQ_STRIDE;
    for (int row = gw; row < MTOK; row += 2 * NGW) { const int row2 = row + NGW; const bool has2 = row2 < MTOK; const int r2 = has2 ? row2 : row;
        const float rsa = 1.0f / sqrtf(sq[row] * (1.0f / DM) + EPSF), rsb = 1.0f / sqrtf(sq[r2] * (1.0f / DM) + EPSF);
        const u4* ya = (const u4*)((const bf16_t*)(p.ws + WS_Y16) + (size_t)row * DM) + lane; const u4* yb = (const u4*)((const bf16_t*)(p.ws + WS_Y16) + (size_t)r2 * DM) + lane;
        const u4 a0 = ya[0], a1 = ya[64], b0 = yb[0], b1 = yb[64];
        f4* oa = (f4*)(p.out + O_Y + (size_t)row * DM) + 2 * lane; f4* ob = (f4*)(p.out + O_Y + (size_t)r2 * DM) + 2 * lane;
#define UNP_LO(V_) (f4){__uint_as_float((V_).x << 16), __uint_as_float((V_).x & 0xffff0000u), __uint_as_float((V_).y << 16), __uint_as_float((V_).y & 0xffff0000u)}
#define UNP_HI(V_) (f4){__uint_as_float((V_).z << 16), __uint_as_float((V_).z & 0xffff0000u), __uint_as_float((V_).w << 16), __uint_as_float((V_).w & 0xffff0000u)}
        oa[0] = UNP_LO(a0) * rsa * g0; oa[1] = UNP_HI(a0) * rsa * g1; oa[128] = UNP_LO(a1) * rsa * g2; oa[129] = UNP_HI(a1) * rsa * g3;
        if (has2) { ob[0] = UNP_LO(b0) * rsb * g0; ob[1] = UNP_HI(b0) * rsb * g1; ob[128] = UNP_LO(b1) * rsb * g2; ob[129] = UNP_HI(b1) * rsb * g3; }
#undef UNP_LO
#undef UNP_HI
    }
}
template <class Epi> __device__ __forceinline__ void gemm_call(LAS unsigned char* lds, const bf16_t* A, const bf16_t* Bt, int N, int K, const Epi& E) {
    pg8::Gemm g{A, Bt, MTOK, N, K}; pg8::StaticOrder S; S.init(MTOK, N, K, (int)gridDim.x, (int)blockIdx.x);
    pg8::gemm_phase<Epi, pg8::StaticOrder, true, true>((PG8_LAS unsigned char*)lds, g, S, E);
}
#ifdef PROBE_A
#define ISTAMP(i) do { if (blockIdx.x == 0 && threadIdx.x == 0 && K == PROBE_K) *(volatile LAS unsigned*)(uintptr_t)(MISC_OFF + 4 * (i)) = (unsigned)__builtin_amdgcn_s_memrealtime(); } while (0)
#else
#define ISTAMP(i) do {} while (0)
#endif
__device__ __forceinline__ void gemm_call_split(LAS unsigned char* lds, const bf16_t* A, const bf16_t* Bt, int N, int K, const EpiRes& E, unsigned char* slab, unsigned* cnt) {
    pg8::Gemm g{A, Bt, MTOK, N, K}; RoundZeroOrder S0; S0.init(MTOK, N, K, (int)gridDim.x, (int)blockIdx.x);
    ISTAMP(0);
    pg8::gemm_phase<EpiRes, RoundZeroOrder, true, true>((PG8_LAS unsigned char*)lds, g, S0, E);
    ISTAMP(1);
    if (S0.split) { QuarterOrder S1; S1.init(MTOK, N, K, (int)gridDim.x, (int)blockIdx.x);
        pg8::gemm_phase<EpiPartial, QuarterOrder, true, true>((PG8_LAS unsigned char*)lds, g, S1, EpiPartial{slab, cnt});
        ISTAMP(2);
        tail_reduce(E, slab, cnt, (int)gridDim.x, (int)blockIdx.x, N / 256, MTOK / 256); ISTAMP(3); }
}
__global__ void __launch_bounds__(NTHREADS, 2) mega_fwd(Params p) {
    extern __shared__ __attribute__((aligned(16))) unsigned char lds[];
    LAS unsigned char* L = (LAS unsigned char*)lds;
    for (int u = threadIdx.x; u < (LDS_BYTES - LDSCTL_OFF) / 4; u += NTHREADS) ((LAS unsigned*)(L + LDSCTL_OFF))[u] = 0u;
    __syncthreads();
    volatile LAS unsigned* MISC = (volatile LAS unsigned*)(L + MISC_OFF);
    const XcdBarrier bar = xcd_barrier_post((unsigned*)(p.ws + WS_CTL) + CW_BAR, MISC + 8);
    const int G = gridDim.x, bx = blockIdx.x; const int vcu = (G % 8 == 0) ? (bx % 8) * (G / 8) + bx / 8 : bx;
    unsigned char* ws = p.ws;
    const bf16_t* XN = (const bf16_t*)(ws + WS_XN); const bf16_t* UH = (const bf16_t*)(ws + WS_UH); const bf16_t* Hh = (const bf16_t*)(ws + WS_H); const bf16_t* Ob = (const bf16_t*)(ws + WS_O);
    float* SW0 = (float*)(ws + WS_SW); float* SWC = SW0 + (size_t)NCLS * 2 * DFF; float* SW1 = SWC + (size_t)NCLS * CIN;
    float* SSQ = (float*)(ws + WS_SSQ); float* Y = p.out + O_Y; unsigned* SPLITC = (unsigned*)(ws + WS_CTL) + CW_SPLIT;
#define WAVE_IDS() const int tid_ = tid_opaque(); const int lane_ = tid_ & 63; const int gw_ = bx * NWAVES + (tid_ >> 6); const int NGW_ = G * NWAVES
    p0_weights(p, L, vcu, G); phase_mod(p, (char*)lds, bx, G);
    xcd_barrier(bar);
    phase_norm0(p, (char*)lds, bx, G);
    xcd_barrier(bar);
    gemm_call(L, XN, (const bf16_t*)(ws + WB_AB), ABMAIN, DM, EpiAB{(bf16_t*)(ws + WS_UPRE), (bf16_t*)(ws + WS_QKVO)}); xcd_barrier(bar);
    ml_phase_A(p, lds, vcu, G);
    { WAVE_IDS(); constexpr int NU_ML = NLB * MH * NBLK + NCB * MH; const int nsecond = (NU_ML > G && NU_ML - G < G) ? NU_ML - G : 0;
      if (vcu >= nsecond) { const int gw2 = (vcu - nsecond) * NWAVES + (tid_ >> 6), ngw2 = (G - nsecond) * NWAVES;
        sw_job(p, (const bf16_t*)(ws + WB_FFI0), 2 * DFF, 0, 3, SW0, 2 * DFF, 1, gw2, ngw2, lane_); sw_job(p, (const bf16_t*)(ws + WB_INC), CIN, 1, 0, SWC, CIN, 0, gw2, ngw2, lane_);
        sw_job(p, (const bf16_t*)(ws + WB_FFI1), 2 * DFF, 1, 3, SW1, 2 * DFF, 1, gw2, ngw2, lane_); } }
    xcd_barrier(bar);
    { WAVE_IDS(); MlScan sc{p}; for (long i = bx * (long)NTHREADS + tid_; i < MlScan::count(); i += (long)G * NTHREADS) sc(i); } xcd_barrier(bar);
    ml_phase_C(p, lds, vcu, G);
    { constexpr int NU_ML = NLB * MH * NBLK + NCB * MH, NU_CV = MTOK / 32; const int nsecond = (NU_ML > G && NU_ML - G < G) ? NU_ML - G : 0;
      if (G == 256 && nsecond == 64 && NU_CV == 640) { if (vcu < 64) phase_conv(p, (char*)lds, vcu, 1 << 30, NU_CV); else phase_conv(p, (char*)lds, 64 + (vcu - 64), 192, NU_CV); }
      else phase_conv(p, (char*)lds, vcu, G, NU_CV); }
    xcd_barrier(bar);
    gemm_call_split(L, UH, (const bf16_t*)(ws + WB_OUTAB), DM, DM, EpiRes{p.xp, p.xs, (bf16_t*)(ws + WS_Y16), (bf16_t*)(ws + WS_XN), SSQ + 0 * SSQ_STRIDE, modv(p, 0, 0, 2), modv(p, 0, 0, 4), p.n2g, 1, 0}, (unsigned char*)Y, SPLITC + 0 * 4096); xcd_barrier(bar);
    gemm_call(L, XN, (const bf16_t*)(ws + WB_FFI0), 2 * DFF, DM, EpiFfnIn{(bf16_t*)(ws + WS_H), SSQ + 0 * SSQ_STRIDE, SW0}); xcd_barrier(bar);
    gemm_call_split(L, Hh, (const bf16_t*)(ws + WB_FFO0), DM, DFF, EpiRes{p.xp, p.xs, (bf16_t*)(ws + WS_Y16), (bf16_t*)(ws + WS_XN), SSQ + 1 * SSQ_STRIDE, modv(p, 0, 0, 5), modv(p, 1, 0, 1), p.n1g + DM, 0, 0}, (unsigned char*)Y + SLAB_BYTES, SPLITC + 1 * 4096); xcd_barrier(bar);
    gemm_call(L, XN, (const bf16_t*)(ws + WB_INC), CIN, DM, EpiQkv{(bf16_t*)(ws + WS_QRAW), (bf16_t*)(ws + WS_KRAW), (bf16_t*)(ws + WS_CTXV), (bf16_t*)(ws + WS_LATV), p.out + O_V, SSQ + 1 * SSQ_STRIDE, SWC}); xcd_barrier(bar);
    { WAVE_IDS(); phase_qkpost(p, gw_, NGW_, lane_); phase_cachecvt(p, bx * NTHREADS + tid_, G * NTHREADS); } xcd_barrier(bar);
    attn_phase(p, lds, vcu, G); xcd_barrier(bar);
    gemm_call_split(L, Ob, (const bf16_t*)(ws + WB_OUTC), DM, DM, EpiRes{p.xp, p.xs, (bf16_t*)(ws + WS_Y16), (bf16_t*)(ws + WS_XN), SSQ + 2 * SSQ_STRIDE, modv(p, 1, 0, 2), modv(p, 1, 0, 4), p.n2g + DM, 0, 0}, (unsigned char*)Y, SPLITC + 2 * 4096); xcd_barrier(bar);
    gemm_call(L, XN, (const bf16_t*)(ws + WB_FFI1), 2 * DFF, DM, EpiFfnIn{(bf16_t*)(ws + WS_H), SSQ + 2 * SSQ_STRIDE, SW1}); xcd_barrier(bar);
    gemm_call_split(L, Hh, (const bf16_t*)(ws + WB_FFO1), DM, DFF, EpiRes{p.xp, p.xs, (bf16_t*)(ws + WS_Y16), (bf16_t*)(ws + WS_XN), SSQ + 3 * SSQ_STRIDE, modv(p, 1, 0, 5), modv(p, 1, 0, 1), nullptr, 0, 0}, (unsigned char*)Y + SLAB_BYTES, SPLITC + 3 * 4096); xcd_barrier(bar);
    { WAVE_IDS(); phase_final(p, gw_, NGW_, lane_); }
#undef WAVE_IDS
}
static Params make_params(void* const* d_in, void* d_out, void* d_ws) {
    Params p{}; const float** pp = (const float**)&p; for (int i = 0; i < 28; ++i) pp[i] = (const float*)d_in[i];
    p.out = (float*)d_out; p.ws = (unsigned char*)d_ws; return p;
}
extern "C" void kernel_launch(void* const* d_in, const int* in_sizes, int n_in, void* d_out, int out_size, void* d_ws, size_t ws_size, hipStream_t stream) {
    static int grid = 0;
    if (grid == 0) {
        if (n_in != 28 || (size_t)out_size != O_END || ws_size < WS_END || in_sizes[0] != MC * DM || in_sizes[1] != ML * DM) {
            fprintf(stderr, "kernel_launch: shape mismatch n_in %d out %d (want %zu) ws %zu (want %zu)\n", n_in, out_size, (size_t)O_END, ws_size, (size_t)WS_END); grid = -1; return; }
        int dev = 0, cus = 0;
        if (hipGetDevice(&dev) != hipSuccess || hipDeviceGetAttribute(&cus, hipDeviceAttributeMultiprocessorCount, dev) != hipSuccess) { grid = -1; return; }
        if (hipFuncSetAttribute((const void*)mega_fwd, hipFuncAttributeMaxDynamicSharedMemorySize, LDS_BYTES) != hipSuccess) { fprintf(stderr, "hipFuncSetAttribute failed\n"); grid = -1; return; }
        int per_cu = 0; (void)hipOccupancyMaxActiveBlocksPerMultiprocessor(&per_cu, (const void*)mega_fwd, NTHREADS, LDS_BYTES); (void)hipGetLastError();
        if (per_cu < 1) fprintf(stderr, "kernel_launch: occupancy query says %d blocks/CU\n", per_cu);
        grid = cus;
    }
    if (grid < 0) return;
    hipMemsetAsync((char*)d_ws + WS_CTL, 0, CTL_ZERO_BYTES, stream);
    Params p = make_params(d_in, d_out, d_ws);
    hipLaunchKernelGGL(mega_fwd, dim3(grid), dim3(NTHREADS), LDS_BYTES, stream, p);
}
```

```cpp
#ifdef HOST_TEST
#include <cmath>
#include <cstdio>
#include <cstdlib>
#include <cstring>
#include <cstdint>
#include <vector>
#define HD_FN inline
#define DEV_FN inline
#else
#include <hip/hip_runtime.h>
#include <cstdio>
#include <cstdint>
#define HD_FN __host__ __device__ __forceinline__
#define DEV_FN __device__ __forceinline__
#endif

#ifdef TINY
constexpr int DM = 512, NCB = 2, CSEQ = 128, NLB = 2, LSEQ = 128, PAST = 128;
#else
constexpr int DM = 1024, NCB = 16, CSEQ = 256, NLB = 4, LSEQ = 4096, PAST = 256;
#endif
constexpr int GRIDW = 64, CCH = DM / 2, CWID = 31, MH = 4, MDK = CCH / MH, MW = CCH, NGATE = 16;
constexpr int ABIN = 2 * CCH + 4 * MW + NGATE, ABMAIN = 2 * CCH + 4 * MW;
constexpr int HDIM = 128, NQ = DM / HDIM, NKV = 2, GRP = NQ / NKV, CIN = (NQ + 2 * NKV) * HDIM;
constexpr int DFF = ((8 * DM + 3 * 256 - 1) / (3 * 256)) * 256;
constexpr int MC = NCB * CSEQ, ML = NLB * LSEQ, MTOK = MC + ML, NCLS = 1 + NLB, SKVL = LSEQ + PAST;
constexpr float EPSF = 1e-6f;
constexpr int NSEQ = NCB + NLB;

constexpr size_t O_Y = 0, O_C = (size_t)MTOK * DM, O_N = O_C + (size_t)NCB * 2 * MH * MDK * MDK, O_M = O_N + (size_t)NCB * 2 * MH * MDK,
                 O_K = O_M + (size_t)NCB * 2 * MH, O_V = O_K + (size_t)NCB * CSEQ * NKV * HDIM, O_END = O_V + (size_t)NCB * CSEQ * NKV * HDIM;

constexpr size_t MiB = 1u << 20;
#ifdef TINY
constexpr size_t WSCALE = 1;
#endif
constexpr size_t WS_CTL = 0, CTL_ZERO_BYTES = 1 * MiB;
constexpr size_t WS_MOD = 1 * MiB;
constexpr size_t WS_SW = WS_MOD + 256 * 1024;
constexpr size_t WS_SSQ = 512 * 1024;
constexpr int SSQ_STRIDE = 32768;
constexpr size_t WS_DEN = 232 * MiB;
constexpr size_t WS_WB = 2 * MiB;
constexpr size_t WS_XN = 50 * MiB;
constexpr size_t WS_UPRE = 90 * MiB;
constexpr size_t WS_QKVO = 110 * MiB;
constexpr size_t WS_UH = 190 * MiB;
constexpr size_t WS_GATES = 230 * MiB;
constexpr size_t WS_HS = 50 * MiB;
constexpr size_t WS_Y16 = 90 * MiB;
constexpr size_t WS_H = 130 * MiB;
constexpr size_t WS_QRAW = 130 * MiB;
constexpr size_t WS_LATK = 170 * MiB, WS_LATV = 179 * MiB, WS_CTXK = 188 * MiB, WS_CTXV = 190 * MiB;
constexpr size_t WS_KRAW = 192 * MiB;
constexpr size_t WS_O = 202 * MiB;
constexpr size_t WS_END = 256 * MiB;

typedef unsigned short bf16_t;
HD_FN float bf2f(bf16_t h) { unsigned u = (unsigned)h << 16; return __builtin_bit_cast(float, u); }
HD_FN bf16_t f2bf(float f) { unsigned u = __builtin_bit_cast(unsigned, f); return (bf16_t)((u + 0x7fffu + ((u >> 16) & 1u)) >> 16); }
HD_FN float rbf(float f) { return bf2f(f2bf(f)); }
HD_FN float sigmoidf_(float x) { return 1.0f / (1.0f + expf(-x)); }
HD_FN float siluf_(float x) { return x * sigmoidf_(x); }
HD_FN float logsigmoidf_(float x) { return x >= 0.f ? -log1pf(expf(-x)) : x - log1pf(expf(x)); }
HD_FN int cls_of(int row) { return row < MC ? 0 : 1 + (row - MC) / LSEQ; }
HD_FN int seqlen_of(int row) { return row < MC ? CSEQ : LSEQ; }
HD_FN int pos_of(int row) { return row < MC ? row % CSEQ : (row - MC) % LSEQ; }

struct Params {
    const float *xp, *xs, *c, *stC, *stn, *stm, *ck, *cv, *cctx, *wmod, *bmod, *n1g, *n2g, *winab, *bgate, *convw, *convb, *lng, *lnb, *mng,
        *woutab, *winc, *qng, *kng, *woutc, *wffi, *wffo, *fng;
    float* out; unsigned char* ws;
};
HD_FN const float* xrow(const Params& p, int row) { return row < MC ? p.xp + (size_t)row * DM : p.xs + (size_t)(row - MC) * DM; }
HD_FN const float* modv(const Params& p, int l, int cls, int which) { return (const float*)(p.ws + WS_MOD) + ((size_t)(l * NCLS + cls) * 6 + which) * DM; }
constexpr size_t WS_RS0 = 233 * MiB;

struct NMod {
    Params p; static HD_FN long count() { return 2L * NCLS * 6 * DM; }
    HD_FN void operator()(long idx) const {
        const int col = (int)(idx % (6 * DM)); const int cls = (int)((idx / (6 * DM)) % NCLS); const int l = (int)(idx / (6 * DM * NCLS));
        const float* cond = cls == 0 ? p.cctx : p.c + (size_t)(cls - 1) * DM;
        const float* w = p.wmod + (size_t)l * DM * 6 * DM;
        float acc = 0.f;
        for (int k = 0; k < DM; ++k) acc += siluf_(cond[k]) * w[(size_t)k * 6 * DM + col];
        ((float*)(p.ws + WS_MOD))[idx] = acc + p.bmod[(size_t)l * 6 * DM + col];
    }
};
struct NNorm0a {
    Params p; static HD_FN long count() { return MTOK; }
    HD_FN void operator()(long row) const {
        const float* x = xrow(p, (int)row); float s = 0.f;
        for (int k = 0; k < DM; ++k) s += x[k] * x[k];
        ((float*)(p.ws + WS_RS0))[row] = 1.0f / sqrtf(s / DM + EPSF);
    }
};
struct NNorm0b {
    Params p; static HD_FN long count() { return (long)MTOK * DM; }
    HD_FN void operator()(long idx) const {
        const int row = (int)(idx / DM), col = (int)(idx % DM), cls = cls_of(row);
        const float rs = ((const float*)(p.ws + WS_RS0))[row];
        const float v = xrow(p, row)[col] * rs * p.n1g[col] * (1.f + modv(p, 0, cls, 1)[col]) + modv(p, 0, cls, 0)[col];
        ((bf16_t*)(p.ws + WS_XN))[idx] = f2bf(v);
    }
};
struct NGates {
    Params p; static HD_FN long count() { return (long)MTOK * NGATE; }
    HD_FN void operator()(long idx) const {
        const int row = (int)(idx / NGATE), j = (int)(idx % NGATE), cls = cls_of(row);
        const float rs = ((const float*)(p.ws + WS_RS0))[row]; const float* x = xrow(p, row);
        const float* sc = modv(p, 0, cls, 1); const float* sh = modv(p, 0, cls, 0);
        float acc = 0.f;
        for (int k = 0; k < DM; ++k) { const float h = x[k] * rs * p.n1g[k] * (1.f + sc[k]) + sh[k]; acc += h * p.winab[(size_t)k * ABIN + ABMAIN + j]; }
        acc += p.bgate[j];
        if ((j & 7) >= 4) acc = logsigmoidf_(acc);
        ((float*)(p.ws + WS_GATES))[idx] = acc;
    }
};

template <bool DUAL, class Epi> struct NGemm {
    const bf16_t* A; const float* B; int lda, ldb, K, N, off2, pad_; Epi epi;
    HD_FN long count() const { return (long)(MTOK / 4) * (N / 4); }
    HD_FN void operator()(long idx) const {
        const int nt = (int)(idx % (N / 4)), mt = (int)(idx / (N / 4)); const int m0 = mt * 4, n0 = nt * 4;
        float acc[4][4], acc2[4][4];
#pragma unroll
        for (int i = 0; i < 4; ++i)
#pragma unroll
            for (int j = 0; j < 4; ++j) { acc[i][j] = 0.f; acc2[i][j] = 0.f; }
        for (int k0 = 0; k0 < K; k0 += 8) {
            float a[4][8];
#pragma unroll
            for (int i = 0; i < 4; ++i) {
                const bf16_t* ap = A + (size_t)(m0 + i) * lda + k0;
#pragma unroll
                for (int kk = 0; kk < 8; ++kk) a[i][kk] = bf2f(ap[kk]);
            }
#pragma unroll
            for (int kk = 0; kk < 8; ++kk) {
                const float* bp = B + (size_t)(k0 + kk) * ldb + n0;
                float b[4], b2[4];
#pragma unroll
                for (int j = 0; j < 4; ++j) { b[j] = rbf(bp[j]); b2[j] = DUAL ? rbf(bp[off2 + j]) : 0.f; }
#pragma unroll
                for (int i = 0; i < 4; ++i)
#pragma unroll
                    for (int j = 0; j < 4; ++j) { acc[i][j] += a[i][kk] * b[j]; if (DUAL) acc2[i][j] += a[i][kk] * b2[j]; }
            }
        }
#pragma unroll
        for (int i = 0; i < 4; ++i)
#pragma unroll
            for (int j = 0; j < 4; ++j) epi(m0 + i, n0 + j, acc[i][j], acc2[i][j]);
    }
};
struct EGlu { Params p; HD_FN void operator()(int row, int col, float v, float v2) const { ((bf16_t*)(p.ws + WS_UPRE))[(size_t)row * CCH + col] = f2bf(v * sigmoidf_(v2)); } };
struct EQkvo { Params p; HD_FN void operator()(int row, int col, float v, float) const {
        const int part = col / MW; if (part == 1) v *= 1.0f / sqrtf((float)MDK); if (part == 3) v = sigmoidf_(v);
        ((bf16_t*)(p.ws + WS_QKVO))[(size_t)row * 4 * MW + col] = f2bf(v); } };
struct EOut { Params p; int l; int pad_ = 0; HD_FN void operator()(int row, int col, float v, float) const {
        const int cls = cls_of(row); float* Y = p.out + O_Y + (size_t)row * DM + col;
        const float xin = l == 0 ? xrow(p, row)[col] : *Y;
        const float x1 = xin + modv(p, l, cls, 2)[col] * v; *Y = x1;
        ((bf16_t*)(p.ws + WS_XN))[(size_t)row * DM + col] = f2bf(x1 * p.n2g[(size_t)l * DM + col] * (1.f + modv(p, l, cls, 4)[col])); } };
struct EFfnIn { Params p; const float* sw; int slot; int pad_ = 0; HD_FN void operator()(int row, int col, float v, float v2) const {
        const int cls = cls_of(row); const float rs = 1.0f / sqrtf(((const float*)(p.ws + WS_SSQ))[(size_t)slot * SSQ_STRIDE + row] / DM + EPSF);
        const float a = v * rs + sw[(size_t)cls * 2 * DFF + col], b = v2 * rs + sw[(size_t)cls * 2 * DFF + DFF + col];
        ((bf16_t*)(p.ws + WS_H))[(size_t)row * DFF + col] = f2bf(siluf_(a) * b); } };
struct EFfnOut { Params p; int l; int pad_ = 0; HD_FN void operator()(int row, int col, float v, float) const {
        const int cls = cls_of(row); float* Y = p.out + O_Y + (size_t)row * DM + col;
        const float x2 = *Y + modv(p, l, cls, 5)[col] * v; *Y = x2;
        if (l == 0) ((bf16_t*)(p.ws + WS_XN))[(size_t)row * DM + col] = f2bf(x2 * p.n1g[(size_t)DM + col] * (1.f + modv(p, 1, cls, 1)[col])); } };
struct EQkv { Params p; const float* sw; int slot; int pad_ = 0; HD_FN void operator()(int row, int col, float v, float) const {
        const int cls = cls_of(row); const float rs = 1.0f / sqrtf(((const float*)(p.ws + WS_SSQ))[(size_t)slot * SSQ_STRIDE + row] / DM + EPSF);
        const float a = v * rs + sw[(size_t)cls * CIN + col];
        if (col < NQ * HDIM) ((bf16_t*)(p.ws + WS_QRAW))[(size_t)row * NQ * HDIM + col] = f2bf(a);
        else if (col < (NQ + NKV) * HDIM) ((bf16_t*)(p.ws + WS_KRAW))[(size_t)row * NKV * HDIM + (col - NQ * HDIM)] = f2bf(a);
        else { const int c2 = col - (NQ + NKV) * HDIM;
            if (row < MC) { ((bf16_t*)(p.ws + WS_CTXV))[(size_t)row * NKV * HDIM + c2] = f2bf(a); p.out[O_V + (size_t)row * NKV * HDIM + c2] = a; }
            else { const int b = (row - MC) / LSEQ, s = (row - MC) % LSEQ; ((bf16_t*)(p.ws + WS_LATV))[((size_t)b * SKVL + s) * NKV * HDIM + c2] = f2bf(a); } } } };

struct NSsq {
    Params p; int slot; int pad_ = 0; static HD_FN long count() { return MTOK; }
    HD_FN void operator()(long row) const { const float* y = p.out + O_Y + (size_t)row * DM; float s = 0.f; for (int k = 0; k < DM; ++k) s += y[k] * y[k];
        ((float*)(p.ws + WS_SSQ))[(size_t)slot * SSQ_STRIDE + row] = s; }
};
struct NSW {
    Params p; const float* W; float* sw; int l, which, N, pad_; HD_FN long count() const { return (long)NCLS * N; }
    HD_FN void operator()(long idx) const { const int n = (int)(idx % N), cls = (int)(idx / N); const float* sh = modv(p, l, cls, which); float acc = 0.f;
        for (int k = 0; k < DM; ++k) acc += sh[k] * rbf(W[(size_t)k * N + n]); sw[idx] = acc; }
};
struct NConv {
    Params p; static HD_FN long count() { return (long)MTOK * CCH; }
    HD_FN void operator()(long idx) const {
        const int row = (int)(idx / CCH), c = (int)(idx % CCH), pos = pos_of(row), len = seqlen_of(row);
        const bf16_t* U = (const bf16_t*)(p.ws + WS_UPRE); float acc = p.convb[c];
        for (int j = 0; j < CWID; ++j) { const int t = pos + j - CWID / 2; if (t >= 0 && t < len) acc += p.convw[(size_t)j * CCH + c] * bf2f(U[(size_t)(row + j - CWID / 2) * CCH + c]); }
        ((float*)(p.ws + WS_HS))[idx] = acc;
    }
};
struct NConvLN {
    Params p; static HD_FN long count() { return MTOK; }
    HD_FN void operator()(long row) const {
        const float* t = (const float*)(p.ws + WS_HS) + (size_t)row * CCH; float mu = 0.f;
        for (int c = 0; c < CCH; ++c) mu += t[c]; mu /= CCH; float var = 0.f;
        for (int c = 0; c < CCH; ++c) { const float d = t[c] - mu; var += d * d; } var /= CCH;
        const float rs = 1.0f / sqrtf(var + EPSF); bf16_t* UH = (bf16_t*)(p.ws + WS_UH) + (size_t)row * DM;
        for (int c = 0; c < CCH; ++c) UH[c] = f2bf(siluf_((t[c] - mu) * rs * p.lng[c] + p.lnb[c]));
    }
};
HD_FN int seq_base(int sid) { return sid < NCB ? sid * CSEQ : MC + (sid - NCB) * LSEQ; }
struct NMlstmDen {
    Params p; static HD_FN long count() { return (long)NSEQ * MH * 2; }
    HD_FN void operator()(long idx) const {
        const int dir = (int)(idx % 2), h = (int)((idx / 2) % MH), sid = (int)(idx / (2 * MH)); const bool isctx = sid < NCB;
        const int base = seq_base(sid), len = isctx ? CSEQ : LSEQ;
        float n[MDK]; float mrun = 0.f;
        if (isctx) {
#pragma unroll
            for (int d = 0; d < MDK; ++d) n[d] = 0.f;
        } else { const int b = sid - NCB; const float em = expf(p.stm[(size_t)(b * 2 + dir) * MH + h]);
#pragma unroll
            for (int d = 0; d < MDK; ++d) n[d] = p.stn[((size_t)(b * 2 + dir) * MH + h) * MDK + d] * em; }
        const bf16_t* QK = (const bf16_t*)(p.ws + WS_QKVO); const float* G = (const float*)(p.ws + WS_GATES); float* DEN = (float*)(p.ws + WS_DEN);
        for (int t = 0; t < len; ++t) {
            const int row = base + (dir == 0 ? t : len - 1 - t);
            const float ig = G[(size_t)row * NGATE + dir * 8 + h], lf = G[(size_t)row * NGATE + dir * 8 + 4 + h];
            const float f = expf(lf), ei = expf(ig); mrun = fmaxf(mrun + lf, ig);
            const bf16_t* q = QK + (size_t)row * 4 * MW + h * MDK; const bf16_t* k = q + MW; float den = 0.f;
#pragma unroll
            for (int d = 0; d < MDK; ++d) { n[d] = f * n[d] + ei * bf2f(k[d]); den += bf2f(q[d]) * n[d]; }
            DEN[((size_t)dir * MTOK + row) * MH + h] = den;
        }
        if (isctx) { const float em = expf(-mrun); p.out[O_M + (size_t)(sid * 2 + dir) * MH + h] = mrun;
#pragma unroll
            for (int d = 0; d < MDK; ++d) p.out[O_N + ((size_t)(sid * 2 + dir) * MH + h) * MDK + d] = n[d] * em; }
    }
};
struct NMlstmNum {
    Params p; int dir; int pad_ = 0; static HD_FN long count() { return (long)NSEQ * MH * MDK; }
    HD_FN void operator()(long idx) const {
        const int v = (int)(idx % MDK), h = (int)((idx / MDK) % MH), sid = (int)(idx / (MDK * MH)); const bool isctx = sid < NCB;
        const int base = seq_base(sid), len = isctx ? CSEQ : LSEQ;
        float C[MDK];
        if (isctx) {
#pragma unroll
            for (int d = 0; d < MDK; ++d) C[d] = 0.f;
        } else { const int b = sid - NCB; const float em = expf(p.stm[(size_t)(b * 2 + dir) * MH + h]);
#pragma unroll
            for (int d = 0; d < MDK; ++d) C[d] = p.stC[(((size_t)(b * 2 + dir) * MH + h) * MDK + d) * MDK + v] * em; }
        const bf16_t* QK = (const bf16_t*)(p.ws + WS_QKVO); const float* G = (const float*)(p.ws + WS_GATES); const float* DEN = (const float*)(p.ws + WS_DEN);
        float* HS = (float*)(p.ws + WS_HS);
        for (int t = 0; t < len; ++t) {
            const int row = base + (dir == 0 ? t : len - 1 - t);
            const float ig = G[(size_t)row * NGATE + dir * 8 + h], lf = G[(size_t)row * NGATE + dir * 8 + 4 + h];
            const float f = expf(lf), ei = expf(ig);
            const bf16_t* q = QK + (size_t)row * 4 * MW + h * MDK; const bf16_t* k = q + MW; const float vv = bf2f(q[2 * MW + v]) * ei; float num = 0.f;
#pragma unroll
            for (int d = 0; d < MDK; ++d) { C[d] = f * C[d] + bf2f(k[d]) * vv; num += bf2f(q[d]) * C[d]; }
            const float den = DEN[((size_t)dir * MTOK + row) * MH + h]; const float hv = num / fmaxf(fabsf(den), 1.0f);
            float* o = HS + (size_t)row * MW + h * MDK + v; if (dir == 0) *o = hv; else *o += hv;
        }
        if (isctx) { const float em = expf(-p.out[O_M + (size_t)(sid * 2 + dir) * MH + h]);
#pragma unroll
            for (int d = 0; d < MDK; ++d) p.out[O_C + (((size_t)(sid * 2 + dir) * MH + h) * MDK + d) * MDK + v] = C[d] * em; }
    }
};
struct NHm {
    Params p; static HD_FN long count() { return (long)MTOK * MH; }
    HD_FN void operator()(long idx) const {
        const int row = (int)(idx / MH), h = (int)(idx % MH); const float* x = (const float*)(p.ws + WS_HS) + (size_t)row * MW + h * MDK; float s = 0.f;
        for (int v = 0; v < MDK; ++v) s += x[v] * x[v];
        const float rs = 1.0f / sqrtf(s / MDK + EPSF); const bf16_t* og = (const bf16_t*)(p.ws + WS_QKVO) + (size_t)row * 4 * MW + 3 * MW + h * MDK;
        bf16_t* UH = (bf16_t*)(p.ws + WS_UH) + (size_t)row * DM + CCH + h * MDK;
        for (int v = 0; v < MDK; ++v) UH[v] = f2bf(bf2f(og[v]) * x[v] * rs * p.mng[h * MDK + v]);
    }
};
struct NCacheCvt {
    Params p; static HD_FN long count() { return (long)NLB * PAST * NKV * HDIM; }
    HD_FN void operator()(long idx) const { const int e = (int)(idx % (NKV * HDIM)), pp = (int)((idx / (NKV * HDIM)) % PAST), b = (int)(idx / ((long)NKV * HDIM * PAST));
        const size_t dst = ((size_t)b * SKVL + LSEQ + pp) * NKV * HDIM + e;
        ((bf16_t*)(p.ws + WS_LATK))[dst] = f2bf(p.ck[idx]); ((bf16_t*)(p.ws + WS_LATV))[dst] = f2bf(p.cv[idx]); }
};
struct NQkPost {
    Params p; static HD_FN long count() { return (long)MTOK * (NQ + NKV); }
    HD_FN void operator()(long idx) const {
        const int row = (int)(idx / (NQ + NKV)), j = (int)(idx % (NQ + NKV)); const bool isq = j < NQ; const bool lat = row >= MC;
        bf16_t* src = isq ? (bf16_t*)(p.ws + WS_QRAW) + (size_t)row * NQ * HDIM + j * HDIM : (bf16_t*)(p.ws + WS_KRAW) + (size_t)row * NKV * HDIM + (j - NQ) * HDIM;
        const float* g = isq ? p.qng : p.kng; float s = 0.f;
        for (int d = 0; d < HDIM; ++d) { const float x = bf2f(src[d]); s += x * x; }
        const float rs = 1.0f / sqrtf(s / HDIM + EPSF);
        bf16_t* dst; float* fo = nullptr;
        if (isq) dst = src;
        else if (!lat) { dst = (bf16_t*)(p.ws + WS_CTXK) + (size_t)row * NKV * HDIM + (j - NQ) * HDIM; fo = p.out + O_K + (size_t)row * NKV * HDIM + (j - NQ) * HDIM; }
        else { const int b = (row - MC) / LSEQ, sp = (row - MC) % LSEQ; dst = (bf16_t*)(p.ws + WS_LATK) + ((size_t)b * SKVL + sp) * NKV * HDIM + (j - NQ) * HDIM; }
        const int sp = pos_of(row); const float prow = (float)(sp / GRIDW), pcol = (float)(sp % GRIDW);
        for (int half = 0; half < 2; ++half)
            for (int d = 0; d < HDIM / 4; ++d) {
                const int i1 = half * (HDIM / 2) + d, i2 = i1 + HDIM / 4;
                const float x1 = bf2f(src[i1]) * rs * g[i1], x2 = bf2f(src[i2]) * rs * g[i2]; float y1 = x1, y2 = x2;
                if (lat) { const float inv = powf(10000.0f, -(float)d / (float)(HDIM / 4)); const float ang = (half == 0 ? prow : pcol) * inv; const float cs = cosf(ang), sn = sinf(ang);
                    y1 = x1 * cs - x2 * sn; y2 = x1 * sn + x2 * cs; }
                dst[i1] = f2bf(y1); dst[i2] = f2bf(y2); if (fo) { fo[i1] = y1; fo[i2] = y2; }
            }
    }
};
struct NAttn {
    Params p; static HD_FN long count() { return (long)MTOK * NQ * 4; }
    HD_FN void operator()(long idx) const {
        const int sl = (int)(idx % 4), hq = (int)((idx / 4) % NQ), row = (int)(idx / (4 * NQ)); const int kv = hq / GRP;
        const bf16_t *Kb, *Vb; int nk;
        if (row < MC) { const int b = row / CSEQ; Kb = (const bf16_t*)(p.ws + WS_CTXK) + (size_t)b * CSEQ * NKV * HDIM; Vb = (const bf16_t*)(p.ws + WS_CTXV) + (size_t)b * CSEQ * NKV * HDIM; nk = CSEQ; }
        else { const int b = (row - MC) / LSEQ; Kb = (const bf16_t*)(p.ws + WS_LATK) + (size_t)b * SKVL * NKV * HDIM; Vb = (const bf16_t*)(p.ws + WS_LATV) + (size_t)b * SKVL * NKV * HDIM; nk = SKVL; }
        const bf16_t* qp = (const bf16_t*)(p.ws + WS_QRAW) + (size_t)row * NQ * HDIM + hq * HDIM;
        float q[HDIM];
#pragma unroll
        for (int d = 0; d < HDIM; ++d) q[d] = bf2f(qp[d]);
        float o[32];
#pragma unroll
        for (int e = 0; e < 32; ++e) o[e] = 0.f;
        float m = -1e30f, l = 0.f; const float scale = 1.0f / sqrtf((float)HDIM);
        for (int s = 0; s < nk; ++s) {
            const bf16_t* kp = Kb + (size_t)s * NKV * HDIM + kv * HDIM; float dot = 0.f;
#pragma unroll
            for (int d = 0; d < HDIM; ++d) dot += q[d] * bf2f(kp[d]);
            dot *= scale; const float mn = fmaxf(m, dot); const float al = expf(m - mn), pe = expf(dot - mn); m = mn; l = l * al + pe;
            const bf16_t* vp = Vb + (size_t)s * NKV * HDIM + kv * HDIM + sl * 32;
#pragma unroll
            for (int e = 0; e < 32; ++e) o[e] = o[e] * al + pe * bf2f(vp[e]);
        }
        bf16_t* op = (bf16_t*)(p.ws + WS_O) + (size_t)row * DM + hq * HDIM + sl * 32;
#pragma unroll
        for (int e = 0; e < 32; ++e) op[e] = f2bf(o[e] / l);
    }
};
struct NFinal {
    Params p; static HD_FN long count() { return (long)MTOK * DM; }
    HD_FN void operator()(long idx) const { const int row = (int)(idx / DM), col = (int)(idx % DM);
        const float rs = 1.0f / sqrtf(((const float*)(p.ws + WS_SSQ))[(size_t)3 * SSQ_STRIDE + row] / DM + EPSF); p.out[O_Y + idx] *= rs * p.fng[col]; }
};
constexpr int NWAVES = 8, NTHREADS = NWAVES * 64;
constexpr int RING_OFF = 0, RING_BYTES = 131072;
constexpr int LDSCTL_OFF = RING_BYTES, MISC_OFF = LDSCTL_OFF + 320;
constexpr int LDS_BYTES = 147456;
constexpr int CW_TMO = 0, CW_CODE = 1, CW_BAR = 4096;
__device__ __forceinline__ int tid_opaque() { int t = threadIdx.x; asm volatile("" : "+v"(t)); return t; }
template <int M> __device__ __forceinline__ float swz_xor(float v) { return __int_as_float(__builtin_amdgcn_ds_swizzle(__float_as_int(v), (M << 10) | 0x1f)); }
__device__ __forceinline__ float half_sum(float v) { auto rr = __builtin_amdgcn_permlane32_swap(__float_as_uint(v), __float_as_uint(v), false, false); return __uint_as_float(rr[0]) + __uint_as_float(rr[1]); }
__device__ __forceinline__ float half_max(float v) { auto rr = __builtin_amdgcn_permlane32_swap(__float_as_uint(v), __float_as_uint(v), false, false); return fmaxf(__uint_as_float(rr[0]), __uint_as_float(rr[1])); }
__device__ __forceinline__ float lane_get(float v, int src_lane) { return __int_as_float(__builtin_amdgcn_ds_bpermute(src_lane << 2, __float_as_int(v))); }
#define GAS __attribute__((address_space(1)))
#define LAS __attribute__((address_space(3)))
typedef GAS unsigned gu32;
#define RLX_AGENT __ATOMIC_RELAXED, __HIP_MEMORY_SCOPE_AGENT
#define XB_TMO      128
#define XB_XCNT(j)  (256  + 64 * (j))
#define XB_XSUB(j)  (1280 + 64 * (j))
#define XB_XGEN(j)  (2304 + 64 * (j))
#define XB_TOP      3328
#define XB_TOPGEN   3392
#define XCD_BAR_WORDS 3456
#define XB_SPIN_CAP (1u << 22)
__device__ __forceinline__ unsigned xb_ld(unsigned* p)              { return __hip_atomic_load(p, __ATOMIC_RELAXED, __HIP_MEMORY_SCOPE_AGENT); }
__device__ __forceinline__ unsigned xb_add(unsigned* p, unsigned v) { return __hip_atomic_fetch_add(p, v, __ATOMIC_RELAXED, __HIP_MEMORY_SCOPE_AGENT); }
__device__ __forceinline__ unsigned xb_xcc_id() { return (unsigned)__builtin_amdgcn_s_getreg((3 << 11) | 20) & 0xFu; }
#define XB_SPIN(cond, bar) do { unsigned _sp = 0; while (cond) { __builtin_amdgcn_s_sleep(1); \
    if ((++_sp & 255u) == 0u) { if (xb_ld(&(bar)[XB_TMO])) break; if (_sp > XB_SPIN_CAP) { atomicAdd(&(bar)[XB_TMO], 1u); break; } } } } while (0)
struct XcdBarrier { unsigned* bar; unsigned x; volatile LAS unsigned* st; };
__device__ __forceinline__ XcdBarrier xcd_barrier_post(unsigned* bar, volatile LAS unsigned* st) {
    XcdBarrier b; b.bar = bar; b.x = xb_xcc_id(); b.st = st;
    if (threadIdx.x == 0) (void)xb_add(&bar[XB_XCNT(b.x)], 1u);
    return b;
}
__device__ __forceinline__ void xcd_barrier_complete(unsigned* bar, unsigned x, unsigned& nloc, unsigned& nx) {
    const unsigned G = gridDim.x * gridDim.y * gridDim.z;
    unsigned sum, cnt, mine, sp = 0u;
    for (;;) {
        sum = 0u; cnt = 0u; mine = 0u;
#pragma unroll
        for (unsigned j = 0; j < 16; ++j) { const unsigned c = xb_ld(&bar[XB_XCNT(j)]); sum += c; cnt += (c > 0u) ? 1u : 0u; mine = (j == x) ? c : mine; }
        if (sum == G) break;
        __builtin_amdgcn_s_sleep(1);
        if ((++sp & 255u) == 0u) { if (xb_ld(&bar[XB_TMO])) break; if (sp > XB_SPIN_CAP) { atomicAdd(&bar[XB_TMO], 1u); break; } }
    }
    nloc = mine > 0u ? mine : 1u; nx = cnt > 0u ? cnt : 1u;
}
__device__ __forceinline__ void xcd_barrier(const XcdBarrier& b) {
    asm volatile("s_waitcnt vmcnt(0)" ::: "memory");
    __syncthreads();
    if (threadIdx.x == 0) {
        unsigned* bar = b.bar;
        __builtin_amdgcn_s_waitcnt(0);
        unsigned nloc = b.st[0], nx = b.st[1];
        if (nloc == 0u) { xcd_barrier_complete(bar, b.x, nloc, nx); b.st[0] = nloc; b.st[1] = nx; }
        const unsigned old = xb_add(&bar[XB_XSUB(b.x)], 1u);
        const unsigned gen = old / nloc;
        if (old + 1u == (gen + 1u) * nloc) {
            __builtin_amdgcn_fence(__ATOMIC_RELEASE, "agent");
            asm volatile("s_waitcnt vmcnt(0)" ::: "memory");
            const unsigned og = xb_add(&bar[XB_TOP], 1u);
            const unsigned tg = og / nx;
            if (og + 1u == (tg + 1u) * nx) xb_add(&bar[XB_TOPGEN], 1u);
            else XB_SPIN(xb_ld(&bar[XB_TOPGEN]) == tg, bar);
            __builtin_amdgcn_fence(__ATOMIC_ACQUIRE, "agent");
            xb_add(&bar[XB_XGEN(b.x)], 1u);
            asm volatile("s_waitcnt vmcnt(0)" ::: "memory");
        } else {
            XB_SPIN(xb_ld(&bar[XB_XGEN(b.x)]) == gen, bar);
            __builtin_amdgcn_fence(__ATOMIC_ACQUIRE, "agent");
            asm volatile("s_waitcnt vmcnt(0)" ::: "memory");
        }
    }
    __syncthreads();
}
namespace pg8 {
#define PG8_LAS __attribute__((address_space(3)))
typedef unsigned short bf16_t;
typedef short bf16x8 __attribute__((ext_vector_type(8)));
typedef float f32x4 __attribute__((ext_vector_type(4)));
typedef unsigned u32x4 __attribute__((ext_vector_type(4)));
constexpr int BM = 256, BK = 64, HALF = 128, HTB = HALF * BK * 2  , STAGE_BYTES = 8 * HTB, NXCD = 8, WGM = 8;

__host__ __device__ __forceinline__ int lds_byte(int r, int c) { const int st = (r >> 4) * 2 + (c >> 5), rr = r & 15, cc = c & 31, ob = rr * 64 + cc * 2; return st * 1024 + (ob ^ (((ob >> 9) & 1) << 5)); }
__host__ __device__ __forceinline__ void stage_rc(int b, int& R, int& C) { const int st = b / 1024, sb = b % 1024, swz = sb ^ (((sb >> 9) & 1) << 5); R = (st >> 1) * 16 + swz / 64; C = (st & 1) * 32 + (swz % 64) / 2; }
__host__ __device__ __forceinline__ int perm32(int rho) { const int n = rho >> 4, i = rho & 15; return 8 * (i >> 2) + 4 * n + (i & 3); }

struct Unit { int pm, pn, k0, nt, role, slot; };
struct Gemm { const bf16_t* A; const bf16_t* Bt; int M, N, K; };

struct StaticOrder {
    int nM, nN, nwg, G, c, ntK;
    __host__ __device__ void init(int M, int N, int K, int G_, int c_) { nM = M / BM; nN = N / BM; nwg = nM * nN; G = G_; c = c_; ntK = K / BK; }
    __host__ __device__ void map(int L, Unit& u) const { int wgid = L; { const int q = nwg / NXCD, r = nwg % NXCD, xcd = wgid % NXCD, off = wgid / NXCD; wgid = (xcd < r ? xcd * (q + 1) : r * (q + 1) + (xcd - r) * q) + off; }
        const int nig = WGM * nN, gid = wgid / nig, fm = gid * WGM, gsz = (nM - fm) < WGM ? (nM - fm) : WGM; u.pm = fm + ((wgid % nig) % gsz); u.pn = (wgid % nig) / gsz; }
    __host__ __device__ bool next(int i, Unit& u) const {
        const long L = (long)i * G + c; if (L >= nwg) return false;
        int wgid = (int)L; { const int q = nwg / NXCD, r = nwg % NXCD, xcd = wgid % NXCD, off = wgid / NXCD; wgid = (xcd < r ? xcd * (q + 1) : r * (q + 1) + (xcd - r) * q) + off; }
        const int nig = WGM * nN, gid = wgid / nig, fm = gid * WGM, gsz = (nM - fm) < WGM ? (nM - fm) : WGM;
        u.pm = fm + ((wgid % nig) % gsz); u.pn = (wgid % nig) / gsz; u.k0 = 0; u.nt = ntK; u.role = 0; u.slot = 0; return true;
    }
    __device__ __forceinline__ void a_ready(const Unit&) const {}
    __device__ __forceinline__ void done(const Unit&) const {}
};

__device__ __forceinline__ unsigned cvt_pk_bf16(float lo, float hi) { unsigned r; asm volatile("v_cvt_pk_bf16_f32 %0, %1, %2" : "=v"(r) : "v"(lo), "v"(hi)); return r; }
typedef float f32x2 __attribute__((ext_vector_type(2)));
template <class Epi, class Sched, bool ALIGN_EPI = false, bool SP2 = false>
__device__ __forceinline__ void gemm_phase(PG8_LAS unsigned char* lds, const Gemm g, const Sched& S, const Epi& E) {
    const int tid = tid_opaque(), wid = __builtin_amdgcn_readfirstlane(tid >> 6), lane = tid & 63, wr = wid >> 2, wc = wid & 3, fr = lane & 15, fq = lane >> 4;
    const int K = g.K;
    unsigned voffA[2], voffB[2];
#pragma unroll
    for (int i = 0; i < 2; ++i) { int R, C; stage_rc(tid * 16 + i * 8192, R, C); const int Rb = Epi::PERM ? ((R & ~31) + perm32(R & 31)) : R;
        voffA[i] = (unsigned)(R * K + C) * 2u; voffB[i] = (unsigned)(Rb * K + C) * 2u; }
    const size_t kstep = (size_t)(BK * 2);
    const size_t hstep = (size_t)HALF * K * 2;
    const size_t tstep = 2 * hstep;
    const unsigned ldsw = (unsigned)wid * 1024u;
    const int aoff = lds_byte(wr * 64 + fr, fq * 8), boff = lds_byte(wc * 32 + fr, fq * 8);
#define PG8_SA(b, h) (((b) * 2 + (h)) * HTB)
#define PG8_SB(b, h) ((4 + (b) * 2 + (h)) * HTB)
#define PG8_STAGE(bufoff, gbase, voff) do { _Pragma("unroll") for (int _i = 0; _i < 2; ++_i) \
        __builtin_amdgcn_global_load_lds((const unsigned*)((const char*)(gbase) + (voff)[_i]), (PG8_LAS unsigned*)(lds + (bufoff) + ldsw + _i * 8192), 16, 0, 0); } while (0)
#define PG8_LDA(dst, b, h) do { _Pragma("unroll") for (int m = 0; m < 4; ++m) _Pragma("unroll") for (int k = 0; k < 2; ++k) dst[m][k] = *(const PG8_LAS bf16x8*)(lds + PG8_SA(b, h) + aoff + m * 2048 + k * 1024); } while (0)
#define PG8_LDB(dst, b, h) do { _Pragma("unroll") for (int n = 0; n < 2; ++n) _Pragma("unroll") for (int k = 0; k < 2; ++k) dst[n][k] = *(const PG8_LAS bf16x8*)(lds + PG8_SB(b, h) + boff + n * 2048 + k * 1024); } while (0)
#define PG8_MMA(ai, bj, At, Bt) do { __builtin_amdgcn_s_setprio(1); _Pragma("unroll") for (int m = 0; m < 4; ++m) _Pragma("unroll") for (int n = 0; n < 2; ++n) _Pragma("unroll") for (int k = 0; k < 2; ++k) \
        acc[ai][bj][m][n] = __builtin_amdgcn_mfma_f32_16x16x32_bf16(Bt[n][k], At[m][k], acc[ai][bj][m][n], 0, 0, 0); __builtin_amdgcn_s_setprio(0); } while (0)
#define PG8_WAIT_V(n) asm volatile("s_waitcnt vmcnt(" #n ")" ::: "memory")
#define PG8_WAIT_L(n) asm volatile("s_waitcnt lgkmcnt(" #n ")" ::: "memory")
#define PG8_BAR __builtin_amdgcn_s_barrier()
#define PG8_SCHED __builtin_amdgcn_sched_barrier(0)
    Unit cur, nxt; int ui = 0;
    if (!S.next(0, cur)) return;
    f32x4 acc[2][2][4][2];
#pragma unroll
    for (int a = 0; a < 2; ++a)
#pragma unroll
        for (int b = 0; b < 2; ++b)
#pragma unroll
            for (int m = 0; m < 4; ++m)
#pragma unroll
                for (int n = 0; n < 2; ++n) acc[a][b][m][n] = (f32x4){0.f, 0.f, 0.f, 0.f};
    bf16x8 At[4][2], B0[2][2], B1[2][2];
    const char* cA = (const char*)g.A + (size_t)cur.pm * tstep + (size_t)cur.k0 * kstep; const char* cB = (const char*)g.Bt + (size_t)cur.pn * tstep + (size_t)cur.k0 * kstep; int nt = cur.nt;
    S.a_ready(cur);
    if constexpr (SP2) {
        PG8_STAGE(PG8_SB(0, 0), cB, voffB); PG8_STAGE(PG8_SB(0, 1), cB + hstep, voffB); PG8_STAGE(PG8_SA(0, 0), cA, voffA); PG8_STAGE(PG8_SA(0, 1), cA + hstep, voffA);
        if (wr == 1) PG8_BAR;
        PG8_WAIT_V(2); PG8_BAR;
        PG8_STAGE(PG8_SB(1, 0), cB + kstep, voffB); PG8_STAGE(PG8_SA(1, 0), cA + kstep, voffA); PG8_STAGE(PG8_SB(1, 1), cB + hstep + kstep, voffB);
        PG8_WAIT_V(6); PG8_BAR;
    } else {
        PG8_STAGE(PG8_SB(0, 0), cB, voffB); PG8_STAGE(PG8_SA(0, 0), cA, voffA); PG8_STAGE(PG8_SB(0, 1), cB + hstep, voffB); PG8_STAGE(PG8_SA(0, 1), cA + hstep, voffA);
        if (wr == 1) PG8_BAR;
        PG8_WAIT_V(4); PG8_BAR;
        PG8_STAGE(PG8_SB(1, 0), cB + kstep, voffB); PG8_STAGE(PG8_SA(1, 0), cA + kstep, voffA); PG8_STAGE(PG8_SB(1, 1), cB + hstep + kstep, voffB);
        PG8_WAIT_V(6); PG8_BAR;
    }
    for (;;) {
        const bool has_next = S.next(ui + 1, nxt);
        const char* nA = has_next ? (const char*)g.A + (size_t)nxt.pm * tstep + (size_t)nxt.k0 * kstep : cA; const char* nB = has_next ? (const char*)g.Bt + (size_t)nxt.pn * tstep + (size_t)nxt.k0 * kstep : cB;
        for (int t = 0; t < nt; t += 2) {
            const bool last = (t == nt - 2);
            const char* a1 = cA + (size_t)(t + 1) * kstep;
            const char* a2 = last ? nA : cA + (size_t)(t + 2) * kstep; const char* b2 = last ? nB : cB + (size_t)(t + 2) * kstep;
            const char* a3 = a2 + kstep; const char* b3 = b2 + kstep;
            if (last && has_next) S.a_ready(nxt);
            if constexpr (SP2) {
            PG8_LDB(B0, 0, 0); PG8_LDB(B1, 0, 1); PG8_SCHED; PG8_LDA(At, 0, 0); PG8_STAGE(PG8_SA(1, 1), a1 + hstep, voffA);
            PG8_WAIT_V(8); PG8_WAIT_L(0); PG8_BAR; PG8_MMA(0, 0, At, B0); PG8_MMA(0, 1, At, B1); PG8_BAR; PG8_SCHED;
            PG8_LDA(At, 0, 1); PG8_STAGE(PG8_SB(0, 0), b2, voffB); PG8_STAGE(PG8_SB(0, 1), b2 + hstep, voffB); PG8_STAGE(PG8_SA(0, 0), a2, voffA);
            PG8_WAIT_V(8); PG8_WAIT_L(0); PG8_BAR; PG8_MMA(1, 0, At, B0); PG8_MMA(1, 1, At, B1); PG8_BAR; PG8_SCHED;
            PG8_LDB(B0, 1, 0); PG8_LDB(B1, 1, 1); PG8_SCHED; PG8_LDA(At, 1, 0); PG8_STAGE(PG8_SA(0, 1), a2 + hstep, voffA);
            PG8_WAIT_V(8); PG8_WAIT_L(0); PG8_BAR; PG8_MMA(0, 0, At, B0); PG8_MMA(0, 1, At, B1); PG8_BAR; PG8_SCHED;
            PG8_LDA(At, 1, 1); PG8_STAGE(PG8_SB(1, 0), b3, voffB); PG8_STAGE(PG8_SB(1, 1), b3 + hstep, voffB); PG8_STAGE(PG8_SA(1, 0), a3, voffA);
            PG8_WAIT_V(8); PG8_WAIT_L(0); PG8_BAR; PG8_MMA(1, 0, At, B0); PG8_MMA(1, 1, At, B1); PG8_BAR; PG8_SCHED;
            } else {
            PG8_LDB(B0, 0, 0); PG8_SCHED; PG8_LDA(At, 0, 0); PG8_STAGE(PG8_SA(1, 1), a1 + hstep, voffA);
            PG8_WAIT_L(8); PG8_BAR; PG8_WAIT_L(0); PG8_MMA(0, 0, At, B0); PG8_BAR; PG8_SCHED;
            PG8_LDB(B1, 0, 1); PG8_STAGE(PG8_SB(0, 0), b2, voffB);
            PG8_BAR; PG8_WAIT_L(0); PG8_MMA(0, 1, At, B1); PG8_BAR;
            PG8_LDA(At, 0, 1); PG8_STAGE(PG8_SA(0, 0), a2, voffA);
            PG8_BAR; PG8_WAIT_L(0); PG8_MMA(1, 0, At, B0); PG8_BAR; PG8_SCHED;
            PG8_STAGE(PG8_SB(0, 1), b2 + hstep, voffB);
            PG8_WAIT_V(6); PG8_BAR; PG8_MMA(1, 1, At, B1); PG8_BAR;
            PG8_LDB(B0, 1, 0); PG8_SCHED; PG8_LDA(At, 1, 0); PG8_STAGE(PG8_SA(0, 1), a2 + hstep, voffA);
            PG8_WAIT_L(8); PG8_BAR; PG8_WAIT_L(0); PG8_MMA(0, 0, At, B0); PG8_BAR; PG8_SCHED;
            PG8_LDB(B1, 1, 1); PG8_STAGE(PG8_SB(1, 0), b3, voffB);
            PG8_BAR; PG8_WAIT_L(0); PG8_MMA(0, 1, At, B1); PG8_BAR;
            PG8_LDA(At, 1, 1); PG8_STAGE(PG8_SA(1, 0), a3, voffA);
            PG8_BAR; PG8_WAIT_L(0); PG8_MMA(1, 0, At, B0); PG8_BAR; PG8_SCHED;
            PG8_STAGE(PG8_SB(1, 1), b3 + hstep, voffB);
            PG8_WAIT_V(6); PG8_BAR; PG8_MMA(1, 1, At, B1); PG8_BAR;
            }
        }
        if constexpr (ALIGN_EPI) { if (wr == 0) PG8_BAR; }
        if constexpr (!Epi::AFTER_DRAIN) { E(acc, cur, wr, wc, fr, fq); S.done(cur); }
        if (!has_next) break;
#pragma unroll
        for (int a = 0; a < 2; ++a)
#pragma unroll
            for (int b = 0; b < 2; ++b)
#pragma unroll
                for (int m = 0; m < 4; ++m)
#pragma unroll
                    for (int n = 0; n < 2; ++n) acc[a][b][m][n] = (f32x4){0.f, 0.f, 0.f, 0.f};
        cur = nxt; cA = nA; cB = nB; nt = cur.nt; ++ui;
        if constexpr (ALIGN_EPI) { if (wr == 1) PG8_BAR; }
    }
    PG8_WAIT_V(0);
    if constexpr (!ALIGN_EPI) { if (wr == 0) PG8_BAR; }
    PG8_BAR;
    if constexpr (Epi::AFTER_DRAIN) { E.fused(acc, cur, wr, wc, fr, fq, lds, wid, lane); S.done(cur); }
#undef PG8_SA
#undef PG8_SB
#undef PG8_STAGE
#undef PG8_LDA
#undef PG8_LDB
#undef PG8_MMA
#undef PG8_WAIT_V
#undef PG8_WAIT_L
#undef PG8_BAR
#undef PG8_SCHED
}
}
constexpr size_t WB_AB = 2 * MiB, WB_OUTAB = 8 * MiB, WB_FFI0 = 10 * MiB, WB_FFO0 = 21 * MiB, WB_INC = 27 * MiB, WB_OUTC = 30 * MiB, WB_FFI1 = 32 * MiB, WB_FFO1 = 43 * MiB;
static_assert(WB_FFO1 + (size_t)DM * DFF * 2 <= WS_XN && WB_AB + (size_t)ABMAIN * DM * 2 <= WB_OUTAB && WB_FFI0 + (size_t)2 * DFF * DM * 2 <= WB_FFO0 && WB_FFO0 + (size_t)DM * DFF * 2 <= WB_INC &&
              WB_INC + (size_t)CIN * DM * 2 <= WB_OUTC && WB_FFI1 + (size_t)2 * DFF * DM * 2 <= WB_FFO1, "weight copy map");

typedef unsigned v4u __attribute__((ext_vector_type(4)));
typedef unsigned v2u __attribute__((ext_vector_type(2)));
typedef float f32x4 __attribute__((ext_vector_type(4)));
__device__ __forceinline__ unsigned pk2(float lo, float hi) { return (unsigned)f2bf(lo) | ((unsigned)f2bf(hi) << 16); }
__device__ __forceinline__ float fsigmoid(float x) { return __builtin_amdgcn_rcpf(1.0f + __builtin_amdgcn_exp2f(-1.4426950408889634f * x)); }

__device__ __forceinline__ void p0_transpose_item(const float* W, int K, int ldw, int c0, int k0, bf16_t* WT, int drow, LAS float* scr, int lane) {
    { f32x4 tv[8]; const int rr = lane >> 3, cg = (lane & 7) * 4;
#pragma unroll
      for (int i = 0; i < 8; ++i) tv[i] = *(const f32x4*)(W + (size_t)(k0 + 8 * i + rr) * ldw + c0 + cg);
#pragma unroll
      for (int i = 0; i < 8; ++i) { LAS float* d = scr + (8 * i + rr) * 33 + cg; d[0] = tv[i][0]; d[1] = tv[i][1]; d[2] = tv[i][2]; d[3] = tv[i][3]; } }
    asm volatile("s_waitcnt lgkmcnt(0)" ::: "memory");
    const int c = lane & 7;
#pragma unroll
    for (int j = 0; j < 4; ++j) { const int n = (lane >> 3) + 8 * j; const LAS float* s = scr + (8 * c) * 33 + n;
        v4u o; o.x = pk2(s[0 * 33], s[1 * 33]); o.y = pk2(s[2 * 33], s[3 * 33]); o.z = pk2(s[4 * 33], s[5 * 33]); o.w = pk2(s[6 * 33], s[7 * 33]);
        *(GAS v4u*)(WT + (size_t)(drow + n) * K + k0 + 8 * c) = o; }
    asm volatile("s_waitcnt lgkmcnt(0)" ::: "memory");
}
struct CvtJob { const float* W; bf16_t* WT; int K, ldw, c0, ncols, mode, Hn, dbase; };
__device__ __forceinline__ int cvt_items(const CvtJob& j) { return (j.K / 64) * (j.ncols / 32); }
__device__ __forceinline__ void cvt_run(const CvtJob& j, int item, LAS float* scr, int lane) {
    const int nblk = j.ncols / 32, kb = item / nblk, nb = item % nblk; const int c = j.c0 + 32 * nb;
    int drow; if (j.mode == 0) drow = j.dbase + 32 * nb; else { const int cc = c < j.Hn ? c : c - j.Hn; drow = 256 * (cc / 128) + (cc % 128) + (c < j.Hn ? 0 : 128); }
    p0_transpose_item(j.W, j.K, j.ldw, c, 64 * kb, j.WT, drow, scr, lane);
}
__device__ __forceinline__ void p0_weights(const Params& p, LAS unsigned char* lds, int vcu, int G) {
    const int tid_ = tid_opaque(); const int lane = tid_ & 63, wave = __builtin_amdgcn_readfirstlane(tid_ >> 6);
    LAS float* scr = (LAS float*)(lds + wave * 16384);
    const int gw = vcu * NWAVES + wave, NGW = G * NWAVES;
    CvtJob jobs[9] = {
        {p.winab, (bf16_t*)(p.ws + WB_AB), DM, ABIN, 0, 2 * CCH, 1, CCH, 0},
        {p.winab, (bf16_t*)(p.ws + WB_AB), DM, ABIN, 2 * CCH, 4 * MW, 0, 0, 2 * CCH},
        {p.woutab, (bf16_t*)(p.ws + WB_OUTAB), DM, DM, 0, DM, 0, 0, 0},
        {p.wffi, (bf16_t*)(p.ws + WB_FFI0), DM, 2 * DFF, 0, 2 * DFF, 1, DFF, 0},
        {p.wffo, (bf16_t*)(p.ws + WB_FFO0), DFF, DM, 0, DM, 0, 0, 0},
        {p.winc, (bf16_t*)(p.ws + WB_INC), DM, CIN, 0, CIN, 0, 0, 0},
        {p.woutc, (bf16_t*)(p.ws + WB_OUTC), DM, DM, 0, DM, 0, 0, 0},
        {p.wffi + (size_t)DM * 2 * DFF, (bf16_t*)(p.ws + WB_FFI1), DM, 2 * DFF, 0, 2 * DFF, 1, DFF, 0},
        {p.wffo + (size_t)DFF * DM, (bf16_t*)(p.ws + WB_FFO1), DFF, DM, 0, DM, 0, 0, 0}};
    int base = 0;
#pragma unroll
    for (int jj = 0; jj < 9; ++jj) {
        const int n = cvt_items(jobs[jj]);
        int first = ((gw - base) % NGW + NGW) % NGW;
        for (int it = first; it < n; it += NGW) cvt_run(jobs[jj], it, scr, lane);
        base += n;
    }
}

struct EpiAB {
    static constexpr bool PERM = true, AFTER_DRAIN = false;
    bf16_t* upre; bf16_t* qkvo;
    __device__ __forceinline__ void operator()(const f32x4 (&acc)[2][2][4][2], const pg8::Unit& u, int wr, int wc, int fr, int fq) const {
        const int row0 = u.pm * 256 + wr * 64 + fr, lc = wc * 32 + 8 * fq;
        if (u.pn < 4) {
#pragma unroll
            for (int ai = 0; ai < 2; ++ai)
#pragma unroll
                for (int m = 0; m < 4; ++m) { const f32x4 a0 = acc[ai][0][m][0], a1 = acc[ai][0][m][1], g0 = acc[ai][1][m][0], g1 = acc[ai][1][m][1]; v4u w;
                    w.x = pg8::cvt_pk_bf16(a0[0] * fsigmoid(g0[0]), a0[1] * fsigmoid(g0[1])); w.y = pg8::cvt_pk_bf16(a0[2] * fsigmoid(g0[2]), a0[3] * fsigmoid(g0[3]));
                    w.z = pg8::cvt_pk_bf16(a1[0] * fsigmoid(g1[0]), a1[1] * fsigmoid(g1[1])); w.w = pg8::cvt_pk_bf16(a1[2] * fsigmoid(g1[2]), a1[3] * fsigmoid(g1[3]));
                    *(v4u*)(upre + (size_t)(row0 + ai * 128 + m * 16) * CCH + 128 * u.pn + lc) = w; }
        } else {
#pragma unroll
            for (int bj = 0; bj < 2; ++bj) { const int col = 256 * (u.pn - 4) + 128 * bj + lc; const int part = col / MW; const float sc = part == 1 ? 0.08838834764831845f : 1.0f;
#pragma unroll
                for (int ai = 0; ai < 2; ++ai)
#pragma unroll
                    for (int m = 0; m < 4; ++m) { f32x4 v0 = acc[ai][bj][m][0] * sc, v1 = acc[ai][bj][m][1] * sc;
                        if (part == 3) { v0 = (f32x4){fsigmoid(v0[0]), fsigmoid(v0[1]), fsigmoid(v0[2]), fsigmoid(v0[3])}; v1 = (f32x4){fsigmoid(v1[0]), fsigmoid(v1[1]), fsigmoid(v1[2]), fsigmoid(v1[3])}; }
                        v4u w; w.x = pg8::cvt_pk_bf16(v0[0], v0[1]); w.y = pg8::cvt_pk_bf16(v0[2], v0[3]); w.z = pg8::cvt_pk_bf16(v1[0], v1[1]); w.w = pg8::cvt_pk_bf16(v1[2], v1[3]);
                        *(v4u*)(qkvo + (size_t)(row0 + ai * 128 + m * 16) * (4 * MW) + col) = w; } }
        }
    }
};
static_assert(MDK == 128, "EpiAB hard-codes MDK^-0.5");
struct EpiRes {
    static constexpr bool PERM = true, AFTER_DRAIN = false;
    const float* xp; const float* xs;
    bf16_t* Y16; bf16_t* XN; float* ssq; const float* mod_g; const float* mod_sc; const float* ng;
    int from_input; int pad_;
    __device__ __forceinline__ float piece(int row, int col, int cls, f32x4 v0, f32x4 v1) const {
        const float* gv = mod_g + (size_t)cls * 6 * DM + col; const size_t off = (size_t)row * DM + col; f32x4 x0, x1;
        if (from_input) { const float* xin = (row < MC ? xp : xs - (size_t)MC * DM) + off; x0 = *(const f32x4*)xin; x1 = *(const f32x4*)(xin + 4); }
        else { const v4u r = *(const v4u*)(Y16 + off); x0 = (f32x4){__uint_as_float(r.x << 16), __uint_as_float(r.x & 0xffff0000u), __uint_as_float(r.y << 16), __uint_as_float(r.y & 0xffff0000u)};
            x1 = (f32x4){__uint_as_float(r.z << 16), __uint_as_float(r.z & 0xffff0000u), __uint_as_float(r.w << 16), __uint_as_float(r.w & 0xffff0000u)}; }
        x0 += *(const f32x4*)gv * v0; x1 += *(const f32x4*)(gv + 4) * v1;
        v4u w; w.x = pg8::cvt_pk_bf16(x0[0], x0[1]); w.y = pg8::cvt_pk_bf16(x0[2], x0[3]); w.z = pg8::cvt_pk_bf16(x1[0], x1[1]); w.w = pg8::cvt_pk_bf16(x1[2], x1[3]); *(v4u*)(Y16 + off) = w;
        if (ng) { const float* scv = mod_sc + (size_t)cls * 6 * DM + col; const f32x4 t0 = x0 * (*(const f32x4*)(ng + col) * (*(const f32x4*)scv + 1.0f)), t1 = x1 * (*(const f32x4*)(ng + col + 4) * (*(const f32x4*)(scv + 4) + 1.0f));
            v4u q; q.x = pg8::cvt_pk_bf16(t0[0], t0[1]); q.y = pg8::cvt_pk_bf16(t0[2], t0[3]); q.z = pg8::cvt_pk_bf16(t1[0], t1[1]); q.w = pg8::cvt_pk_bf16(t1[2], t1[3]); *(v4u*)(XN + off) = q; }
        return ((x0[0] * x0[0] + x0[1] * x0[1]) + (x0[2] * x0[2] + x0[3] * x0[3])) + ((x1[0] * x1[0] + x1[1] * x1[1]) + (x1[2] * x1[2] + x1[3] * x1[3]));
    }
    __device__ __forceinline__ void operator()(const f32x4 (&acc)[2][2][4][2], const pg8::Unit& u, int wr, int wc, int fr, int fq) const {
        const int row0 = u.pm * 256 + wr * 64 + fr; const int cls = cls_of(u.pm * 256); const int colb = u.pn * 256 + wc * 32 + 8 * fq;
        f32x4 g4[2][2], gs4[2][2];
#pragma unroll
        for (int bj = 0; bj < 2; ++bj)
#pragma unroll
            for (int n = 0; n < 2; ++n) { const int col = colb + bj * 128 + 4 * n; g4[bj][n] = *(const f32x4*)(mod_g + (size_t)cls * 6 * DM + col);
                gs4[bj][n] = ng ? *(const f32x4*)(ng + col) * (*(const f32x4*)(mod_sc + (size_t)cls * 6 * DM + col) + 1.0f) : (f32x4){0.f, 0.f, 0.f, 0.f}; }
        if (from_input) run_rows<2>(acc, row0, colb, g4, gs4); else run_rows<4>(acc, row0, colb, g4, gs4);
    }
    template <int MB> __device__ __forceinline__ void run_rows(const f32x4 (&acc)[2][2][4][2], int row0, int colb, const f32x4 (&g4)[2][2], const f32x4 (&gs4)[2][2]) const {
#pragma unroll
        for (int ai = 0; ai < 2; ++ai)
#pragma unroll
            for (int mb = 0; mb < 4; mb += MB) {
                f32x4 x[MB][2][2];
                if (from_input) {
#pragma unroll
                    for (int mm = 0; mm < MB; ++mm)
#pragma unroll
                        for (int bj = 0; bj < 2; ++bj) { const int row = row0 + ai * 128 + (mb + mm) * 16; const float* xin = (row < MC ? xp : xs - (size_t)MC * DM) + (size_t)row * DM + colb + bj * 128; x[mm][bj][0] = *(const f32x4*)xin; x[mm][bj][1] = *(const f32x4*)(xin + 4); }
                } else { v4u r[MB][2];
#pragma unroll
                    for (int mm = 0; mm < MB; ++mm)
#pragma unroll
                        for (int bj = 0; bj < 2; ++bj) r[mm][bj] = *(const v4u*)(Y16 + (size_t)(row0 + ai * 128 + (mb + mm) * 16) * DM + colb + bj * 128);
#pragma unroll
                    for (int mm = 0; mm < MB; ++mm)
#pragma unroll
                        for (int bj = 0; bj < 2; ++bj) { const v4u q = r[mm][bj]; x[mm][bj][0] = (f32x4){__uint_as_float(q.x << 16), __uint_as_float(q.x & 0xffff0000u), __uint_as_float(q.y << 16), __uint_as_float(q.y & 0xffff0000u)};
                            x[mm][bj][1] = (f32x4){__uint_as_float(q.z << 16), __uint_as_float(q.z & 0xffff0000u), __uint_as_float(q.w << 16), __uint_as_float(q.w & 0xffff0000u)}; }
                }
#pragma unroll
                for (int mm = 0; mm < MB; ++mm) { const int m = mb + mm; const int row = row0 + ai * 128 + m * 16; float s = 0.f;
#pragma unroll
                    for (int bj = 0; bj < 2; ++bj) { const size_t off = (size_t)row * DM + colb + bj * 128;
                        const f32x4 x0 = x[mm][bj][0] + g4[bj][0] * acc[ai][bj][m][0], x1 = x[mm][bj][1] + g4[bj][1] * acc[ai][bj][m][1];
                        v4u w; w.x = pg8::cvt_pk_bf16(x0[0], x0[1]); w.y = pg8::cvt_pk_bf16(x0[2], x0[3]); w.z = pg8::cvt_pk_bf16(x1[0], x1[1]); w.w = pg8::cvt_pk_bf16(x1[2], x1[3]); *(v4u*)(Y16 + off) = w;
                        if (ng) { const f32x4 t0 = x0 * gs4[bj][0], t1 = x1 * gs4[bj][1]; v4u q; q.x = pg8::cvt_pk_bf16(t0[0], t0[1]); q.y = pg8::cvt_pk_bf16(t0[2], t0[3]); q.z = pg8::cvt_pk_bf16(t1[0], t1[1]); q.w = pg8::cvt_pk_bf16(t1[2], t1[3]); *(v4u*)(XN + off) = q; }
                        s += ((x0[0] * x0[0] + x0[1] * x0[1]) + (x0[2] * x0[2] + x0[3] * x0[3])) + ((x1[0] * x1[0] + x1[1] * x1[1]) + (x1[2] * x1[2] + x1[3] * x1[3])); }
                    s += __shfl_xor(s, 16); s += __shfl_xor(s, 32); if (fq_() == 0) atomicAdd(ssq + row, s); }
                asm volatile("" ::: "memory");
            }
    }
    __device__ __forceinline__ static int fq_() { return (threadIdx.x >> 4) & 3; }
};
struct EpiFfnIn {
    static constexpr bool PERM = true, AFTER_DRAIN = false;
    bf16_t* H; const float* ssq; const float* sw;
    __device__ __forceinline__ void operator()(const f32x4 (&acc)[2][2][4][2], const pg8::Unit& u, int wr, int wc, int fr, int fq) const {
        const int row0 = u.pm * 256 + wr * 64 + fr, lc = wc * 32 + 8 * fq; const int cls = cls_of(u.pm * 256); const int col = 128 * u.pn + lc;
        const float* swr = sw + (size_t)cls * 2 * DFF;
        const f32x4 sg0 = *(const f32x4*)(swr + col), sg1 = *(const f32x4*)(swr + col + 4), su0 = *(const f32x4*)(swr + DFF + col), su1 = *(const f32x4*)(swr + DFF + col + 4);
#pragma unroll
        for (int ai = 0; ai < 2; ++ai)
#pragma unroll
            for (int m = 0; m < 4; ++m) { const int row = row0 + ai * 128 + m * 16; const float rs = __builtin_amdgcn_rsqf(ssq[row] * (1.0f / DM) + EPSF);
                const f32x4 a0 = acc[ai][0][m][0] * rs + sg0, a1 = acc[ai][0][m][1] * rs + sg1, b0 = acc[ai][1][m][0] * rs + su0, b1 = acc[ai][1][m][1] * rs + su1; v4u w;
                w.x = pg8::cvt_pk_bf16(a0[0] * fsigmoid(a0[0]) * b0[0], a0[1] * fsigmoid(a0[1]) * b0[1]); w.y = pg8::cvt_pk_bf16(a0[2] * fsigmoid(a0[2]) * b0[2], a0[3] * fsigmoid(a0[3]) * b0[3]);
                w.z = pg8::cvt_pk_bf16(a1[0] * fsigmoid(a1[0]) * b1[0], a1[1] * fsigmoid(a1[1]) * b1[1]); w.w = pg8::cvt_pk_bf16(a1[2] * fsigmoid(a1[2]) * b1[2], a1[3] * fsigmoid(a1[3]) * b1[3]);
                *(v4u*)(H + (size_t)row * DFF + col) = w; }
    }
};
struct EpiQkv {
    static constexpr bool PERM = true, AFTER_DRAIN = false;
    bf16_t* qraw; bf16_t* kraw; bf16_t* ctxv; bf16_t* latv; float* outv; const float* ssq; const float* sw;
    __device__ __forceinline__ void operator()(const f32x4 (&acc)[2][2][4][2], const pg8::Unit& u, int wr, int wc, int fr, int fq) const {
        const int row0 = u.pm * 256 + wr * 64 + fr, lc = wc * 32 + 8 * fq; const int cls = cls_of(u.pm * 256); const float* swr = sw + (size_t)cls * CIN;
        float rs[2][4];
#pragma unroll
        for (int ai = 0; ai < 2; ++ai)
#pragma unroll
            for (int m = 0; m < 4; ++m) rs[ai][m] = __builtin_amdgcn_rsqf(ssq[row0 + ai * 128 + m * 16] * (1.0f / DM) + EPSF);
#pragma unroll
        for (int bj = 0; bj < 2; ++bj) { const int col = 256 * u.pn + 128 * bj + lc; const f32x4 s0 = *(const f32x4*)(swr + col), s1 = *(const f32x4*)(swr + col + 4);
#pragma unroll
            for (int ai = 0; ai < 2; ++ai)
#pragma unroll
                for (int m = 0; m < 4; ++m) { const int row = row0 + ai * 128 + m * 16; const f32x4 v0 = acc[ai][bj][m][0] * rs[ai][m] + s0, v1 = acc[ai][bj][m][1] * rs[ai][m] + s1;
                    v4u w; w.x = pg8::cvt_pk_bf16(v0[0], v0[1]); w.y = pg8::cvt_pk_bf16(v0[2], v0[3]); w.z = pg8::cvt_pk_bf16(v1[0], v1[1]); w.w = pg8::cvt_pk_bf16(v1[2], v1[3]);
                    if (u.pn < NQ * HDIM / 256) *(v4u*)(qraw + (size_t)row * (NQ * HDIM) + col) = w;
                    else if (u.pn == NQ * HDIM / 256) *(v4u*)(kraw + (size_t)row * (NKV * HDIM) + (col - NQ * HDIM)) = w;
                    else { const int c2 = col - (NQ + NKV) * HDIM;
                        if (row < MC) { *(v4u*)(ctxv + (size_t)row * (NKV * HDIM) + c2) = w; float* o = outv + (size_t)row * (NKV * HDIM) + c2; *(f32x4*)o = v0; *(f32x4*)(o + 4) = v1; }
                        else { const int b = (row - MC) / LSEQ, s = (row - MC) % LSEQ; *(v4u*)(latv + ((size_t)b * SKVL + s) * (NKV * HDIM) + c2) = w; } } } }
    }
};
static_assert(NKV * HDIM == 256 && (NQ * HDIM) % 256 == 0, "EpiQkv tile mapping");

constexpr int CW_SPLIT = 8192;
constexpr size_t SLAB_BYTES = (size_t)64 * 4 * 16 * 512 * 16;
struct RoundZeroOrder : pg8::StaticOrder {
    bool split;
    __device__ void init(int M, int N, int K, int G_, int c_) { pg8::StaticOrder::init(M, N, K, G_, c_); split = (G == 256 && nwg > 256 && nwg <= 320 && ntK >= 8); }
    __device__ bool next(int i, pg8::Unit& u) const { if (split && i > 0) return false; return pg8::StaticOrder::next(i, u); }
};
struct QuarterOrder : pg8::StaticOrder {
    __device__ bool next(int i, pg8::Unit& u) const {
        if (i > 0) return false; const int L = 256 + (c >> 2), q = c & 3; if (L >= nwg) return false;
        map(L, u); const int base = (ntK / 8) * 2, rem = (ntK - 4 * base) / 2;
        int k0 = 0; for (int j = 0; j < q; ++j) k0 += base + (j < rem ? 2 : 0);
        u.k0 = k0; u.nt = base + (q < rem ? 2 : 0); u.role = 1 + q; u.slot = c >> 2; return true;
    }
};
struct EpiPartial {
    static constexpr bool PERM = true, AFTER_DRAIN = false;
    unsigned char* slab; unsigned* cnt;
    __device__ __forceinline__ void operator()(const f32x4 (&acc)[2][2][4][2], const pg8::Unit& u, int wr, int wc, int fr, int fq) const {
        const int tid = (wr * 4 + wc) * 64 + fq * 16 + fr;
        unsigned char* dst = slab + ((size_t)u.slot * 4 + (u.role - 1)) * (16 * 512 * 16) + (size_t)tid * 16;
#pragma unroll
        for (int ai = 0; ai < 2; ++ai)
#pragma unroll
            for (int bj = 0; bj < 2; ++bj)
#pragma unroll
                for (int m = 0; m < 4; ++m) { const f32x4 a = acc[ai][bj][m][0], b = acc[ai][bj][m][1]; v4u w;
                    w.x = pg8::cvt_pk_bf16(a[0], a[1]); w.y = pg8::cvt_pk_bf16(a[2], a[3]); w.z = pg8::cvt_pk_bf16(b[0], b[1]); w.w = pg8::cvt_pk_bf16(b[2], b[3]);
                    asm volatile("global_store_dwordx4 %0, %1, off sc1\n\ts_nop 1" :: "v"(dst), "v"(w) : "memory");
                    dst += 512 * 16; asm volatile("" : "+v"(dst)); }
        asm volatile("s_waitcnt vmcnt(0)" ::: "memory");
        if (fr == 0 && fq == 0) __hip_atomic_fetch_add(cnt + (size_t)u.slot * 64, 1u, __ATOMIC_RELAXED, __HIP_MEMORY_SCOPE_AGENT);
    }
};
__device__ __forceinline__ void tail_reduce(const EpiRes& E, const unsigned char* slab, unsigned* cnt, int G, int bx, int nN, int nM) {
    pg8::StaticOrder S; S.nM = nM; S.nN = nN; S.nwg = nM * nN; S.G = G; S.c = bx; S.ntK = 0;
    const int L = 256 + (bx >> 2), q = bx & 3; if (L >= S.nwg) return;
    pg8::Unit u; S.map(L, u); const int slot = bx >> 2, ai = q >> 1, bj = q & 1;
    const int tid = tid_opaque(), wid = tid >> 6, lane = tid & 63, wr = wid >> 2, wc = wid & 3, fr = lane & 15, fq = lane >> 4;
    unsigned* c = cnt + (size_t)slot * 64; unsigned spins = 0;
    while ((unsigned)__builtin_amdgcn_readfirstlane(__hip_atomic_load(c, __ATOMIC_RELAXED, __HIP_MEMORY_SCOPE_AGENT)) < 32u) { __builtin_amdgcn_s_sleep(2); if (++spins > (1u << 22)) break; }
    __builtin_amdgcn_fence(__ATOMIC_ACQUIRE, "agent");
    const unsigned char* base = slab + (size_t)slot * 4 * (16 * 512 * 16) + (size_t)tid * 16;
    v4u w[4][4];
#pragma unroll
    for (int m = 0; m < 4; ++m)
#pragma unroll
        for (int r = 0; r < 4; ++r) w[m][r] = *(const v4u*)(base + (size_t)r * (16 * 512 * 16) + (size_t)((ai * 2 + bj) * 4 + m) * (512 * 16));
    const int row0 = u.pm * 256 + ai * 128 + wr * 64 + fr; const int cls = cls_of(u.pm * 256); const int col = u.pn * 256 + bj * 128 + wc * 32 + 8 * fq;
#pragma unroll
    for (int m = 0; m < 4; ++m) { const int row = row0 + m * 16; f32x4 v[2] = {(f32x4){0.f, 0.f, 0.f, 0.f}, (f32x4){0.f, 0.f, 0.f, 0.f}};
#pragma unroll
        for (int r = 0; r < 4; ++r) { const v4u x = w[m][r]; v[0] += (f32x4){__uint_as_float(x.x << 16), __uint_as_float(x.x & 0xffff0000u), __uint_as_float(x.y << 16), __uint_as_float(x.y & 0xffff0000u)};
            v[1] += (f32x4){__uint_as_float(x.z << 16), __uint_as_float(x.z & 0xffff0000u), __uint_as_float(x.w << 16), __uint_as_float(x.w & 0xffff0000u)}; }
        float sq = E.piece(row, col, cls, v[0], v[1]);
        sq += __shfl_xor(sq, 16); sq += __shfl_xor(sq, 32); if (fq == 0) atomicAdd(E.ssq + row, sq); }
}
namespace att {
typedef unsigned short bf16;
constexpr int D = 128, NW = 8, QBLK = 32, KVBLK = 64; constexpr float SCALE = 0.088388347648318440f; constexpr float THR = 8.f; constexpr int SDEPTH = 1;
constexpr int LDQ = NQ * HDIM, LDK = NKV * HDIM, LDO = DM;
constexpr size_t SHM_V = KVBLK * D * 2, SHM_K = KVBLK * D * 2, SHM_ATTN = 2 * SHM_V + 2 * SHM_K + NW * 64 * 4;
using bf16x8 = __attribute__((ext_vector_type(8))) short;
using s16x4  = __attribute__((ext_vector_type(4))) short;
using f32x16 = __attribute__((ext_vector_type(16))) float;
using f32x8  = __attribute__((ext_vector_type(8))) float;
using u32x4  = __attribute__((ext_vector_type(4))) unsigned;
#define KSWZ(row, colB) ((row) * 256 + ((colB) ^ (((row) & 7) << 4)))
#define SBAR() __builtin_amdgcn_sched_barrier(0)
__device__ __forceinline__ int crow(int r, int hi) { return (r & 3) + 8 * (r >> 2) + 4 * hi; }
__device__ __forceinline__ unsigned cvtpk(float lo, float hi) {
  unsigned r; asm volatile("v_cvt_pk_bf16_f32 %0, %1, %2" : "=v"(r) : "v"(lo), "v"(hi)); return r;
}
template <typename TIn> struct Stage;
template <> struct Stage<bf16>  { using T = bf16x8;
  __device__ static __forceinline__ T ld8(const bf16* p) { return *reinterpret_cast<const bf16x8*>(p); }
  __device__ static __forceinline__ bf16x8 tobf(T x) { return x; } };
__device__ __forceinline__ void partialSM(f32x16& p0, f32x16& p1, float& m_reg, float& mn, float& alpha) {
  constexpr float C = SCALE * 1.4426950408889634f;
  float pmax = p0[0]; for (int r = 1; r < 16; ++r) pmax = fmaxf(pmax, p0[r]); for (int r = 0; r < 16; ++r) pmax = fmaxf(pmax, p1[r]);
  { auto rr = __builtin_amdgcn_permlane32_swap(__float_as_uint(pmax), __float_as_uint(pmax), false, false);
    pmax = fmaxf(__uint_as_float(rr[0]), __uint_as_float(rr[1])); }
  if (__builtin_expect(__all(pmax - m_reg <= THR / SCALE), 1)) { mn = m_reg; alpha = 1.f; }
  else { mn = fmaxf(m_reg, pmax); alpha = __builtin_amdgcn_exp2f((m_reg - mn) * C); m_reg = mn; }
  float mnC = -mn * C;
  for (int r = 0; r < 16; ++r) p0[r] = fmaf(p0[r], C, mnC); for (int r = 0; r < 16; ++r) p1[r] = fmaf(p1[r], C, mnC);
  for (int r = 0; r < 16; ++r) p0[r] = __builtin_amdgcn_exp2f(p0[r]);
}
__device__ __forceinline__ void finishSM(f32x16& p0, f32x16& p1, float alpha, float& l_reg, bf16x8& pa0, bf16x8& pa1, bf16x8& pa2, bf16x8& pa3) {
  for (int r = 0; r < 16; ++r) p1[r] = __builtin_amdgcn_exp2f(p1[r]);
  float ps = 0; for (int r = 0; r < 16; ++r) ps += p0[r]; for (int r = 0; r < 16; ++r) ps += p1[r];
  { auto rr = __builtin_amdgcn_permlane32_swap(__float_as_uint(ps), __float_as_uint(ps), false, false);
    ps = __uint_as_float(rr[0]) + __uint_as_float(rr[1]); }
  l_reg = l_reg * alpha + ps;
#define PK4(P, BASE, OUT) do { unsigned a0 = cvtpk(P[BASE + 0], P[BASE + 1]), a1 = cvtpk(P[BASE + 2], P[BASE + 3]);   \
    unsigned b0 = cvtpk(P[BASE + 4], P[BASE + 5]), b1 = cvtpk(P[BASE + 6], P[BASE + 7]);                              \
    auto r0 = __builtin_amdgcn_permlane32_swap(a0, b0, false, false); auto r1 = __builtin_amdgcn_permlane32_swap(a1, b1, false, false); \
    u32x4 w = {r0[0], r1[0], r0[1], r1[1]}; OUT = *reinterpret_cast<bf16x8*>(&w); } while (0)
  PK4(p0, 0, pa0); PK4(p0, 8, pa1); PK4(p1, 0, pa2); PK4(p1, 8, pa3);
#undef PK4
}
__device__ __forceinline__ void qkt(f32x16& p0, f32x16& p1, const bf16* Ks, const bf16x8* qr, int r32, int hi) {
  p0 = f32x16{}; p1 = f32x16{};
  for (int d0 = 0; d0 < 8; ++d0) { int cb = (d0 * 16 + hi * 8) * 2;
    bf16x8 b0 = *reinterpret_cast<const bf16x8*>((const char*)Ks + KSWZ(r32, cb));
    bf16x8 b1 = *reinterpret_cast<const bf16x8*>((const char*)Ks + KSWZ(32 + r32, cb));
    p0 = __builtin_amdgcn_mfma_f32_32x32x16_bf16(b0, qr[d0], p0, 0, 0, 0);
    p1 = __builtin_amdgcn_mfma_f32_32x32x16_bf16(b1, qr[d0], p1, 0, 0, 0); }
}
__device__ __forceinline__ int v_st(int k, int c) { const int kk = (k & ~0xC) | ((k & 4) << 1) | ((k & 8) >> 1); return ((kk >> 3) * 4 + (c >> 5)) * 512 + ((kk & 7) * 32 + (c & 31)) * 2; }
__device__ __forceinline__ int v_rd_base(int lane) { return ((lane & 3) << 3) | (((lane >> 2) & 3) << 6) | (((lane >> 4) & 1) << 5) | (((lane >> 5) & 1) << 8); }
constexpr int v_rd_off(int d0, int ks, int half) { return d0 * 512 + ks * 4096 + half * 2048; }
template <int OFF> __device__ __forceinline__ s16x4 tr_read(int vb) {
  s16x4 r; asm volatile("ds_read_b64_tr_b16 %0, %1 offset:%2" : "=&v"(r) : "v"(vb), "i"(OFF) : "memory"); return r;
}
template <int D0> __device__ __forceinline__ void pv_one(f32x16& od, int vb, bf16x8 pa0, bf16x8 pa1, bf16x8 pa2, bf16x8 pa3) {
  const s16x4 l0 = tr_read<v_rd_off(D0, 0, 0)>(vb), h0 = tr_read<v_rd_off(D0, 0, 1)>(vb), l1 = tr_read<v_rd_off(D0, 1, 0)>(vb), h1 = tr_read<v_rd_off(D0, 1, 1)>(vb);
  const s16x4 l2 = tr_read<v_rd_off(D0, 2, 0)>(vb), h2 = tr_read<v_rd_off(D0, 2, 1)>(vb), l3 = tr_read<v_rd_off(D0, 3, 0)>(vb), h3 = tr_read<v_rd_off(D0, 3, 1)>(vb);
  asm volatile("s_waitcnt lgkmcnt(0)" ::: "memory"); SBAR();
#define PK(L, H) (bf16x8){L[0], L[1], L[2], L[3], H[0], H[1], H[2], H[3]}
  od = __builtin_amdgcn_mfma_f32_32x32x16_bf16(pa0, PK(l0, h0), od, 0, 0, 0);
  od = __builtin_amdgcn_mfma_f32_32x32x16_bf16(pa1, PK(l1, h1), od, 0, 0, 0);
  od = __builtin_amdgcn_mfma_f32_32x32x16_bf16(pa2, PK(l2, h2), od, 0, 0, 0);
  od = __builtin_amdgcn_mfma_f32_32x32x16_bf16(pa3, PK(l3, h3), od, 0, 0, 0);
#undef PK
}
__device__ __forceinline__ void pv_d0(f32x16* o, int vb, bf16x8 pa0, bf16x8 pa1, bf16x8 pa2, bf16x8 pa3) {
  pv_one<0>(o[0], vb, pa0, pa1, pa2, pa3); pv_one<1>(o[1], vb, pa0, pa1, pa2, pa3); pv_one<2>(o[2], vb, pa0, pa1, pa2, pa3); pv_one<3>(o[3], vb, pa0, pa1, pa2, pa3);
}

__device__ __forceinline__ void attn_dense_body(const bf16* __restrict__ Qb, const bf16* __restrict__ Kh, const bf16* __restrict__ Vh,
                                                bf16* __restrict__ Ob, int seq, char* lds, const float* __restrict__ qgain, int spos0) {
  typedef bf16 TQ;
  using St = Stage<bf16>; using SQ = Stage<TQ>;
  const int tid = tid_opaque(), wid = tid >> 6, lane = tid & 63, r32 = lane & 31, hi = lane >> 5;
  bf16* V_lds = (bf16*)lds; bf16* K_lds = (bf16*)(lds + 2 * SHM_V);
  float* ws = (float*)(lds + 2 * SHM_V + 2 * SHM_K) + wid * 64; float* li_l = ws; float* al_l = ws + 32;
  float m_reg = -1e30f, l_reg = 0; f32x16 o[4] = {}; bf16x8 qr[8];
  const TQ* Qw = Qb + (long)(wid * QBLK + r32) * LDQ + hi * 8;
#pragma unroll
  for (int d0 = 0; d0 < 8; ++d0) qr[d0] = SQ::tobf(SQ::ld8(Qw + d0 * 16));
  { float qf[8][8]; float ss = 0.f;
#pragma unroll
    for (int d0 = 0; d0 < 8; ++d0)
#pragma unroll
      for (int j = 0; j < 8; ++j) { qf[d0][j] = bf2f((unsigned short)qr[d0][j]); ss += qf[d0][j] * qf[d0][j]; }
    { auto rr = __builtin_amdgcn_permlane32_swap(__float_as_uint(ss), __float_as_uint(ss), false, false); ss = __uint_as_float(rr[0]) + __uint_as_float(rr[1]); }
    const float rsq = 1.0f / sqrtf(ss * (1.0f / D) + 1e-6f);
#pragma unroll
    for (int d0 = 0; d0 < 8; ++d0) { const float* gq = qgain + d0 * 16 + hi * 8; const f32x8 g8 = *reinterpret_cast<const f32x8*>(gq);
#pragma unroll
      for (int j = 0; j < 8; ++j) qf[d0][j] *= rsq * g8[j]; }
    if (spos0 >= 0) { const int sp = spos0 + wid * QBLK + r32; const float prow = (float)(sp / GRIDW), pcol = (float)(sp % GRIDW);
#pragma unroll
      for (int d0 = 0; d0 < 2; ++d0)
#pragma unroll
        for (int j = 0; j < 8; ++j) { const float inv = __builtin_amdgcn_exp2f(-(float)(16 * d0 + 8 * hi + j) * (13.287712379549449f / 32.0f));
          const float cr = __cosf(prow * inv), sr_ = __sinf(prow * inv), cc = __cosf(pcol * inv), sc_ = __sinf(pcol * inv);
          const float a = qf[d0][j], b2 = qf[d0 + 2][j]; qf[d0][j] = a * cr - b2 * sr_; qf[d0 + 2][j] = a * sr_ + b2 * cr;
          const float c = qf[4 + d0][j], e = qf[6 + d0][j]; qf[4 + d0][j] = c * cc - e * sc_; qf[6 + d0][j] = c * sc_ + e * cc; } }
#pragma unroll
    for (int d0 = 0; d0 < 8; ++d0) { u32x4 w = {cvtpk(qf[d0][0], qf[d0][1]), cvtpk(qf[d0][2], qf[d0][3]), cvtpk(qf[d0][4], qf[d0][5]), cvtpk(qf[d0][6], qf[d0][7])}; qr[d0] = *reinterpret_cast<bf16x8*>(&w); } }
  const int sr = tid >> 4, sc = (tid & 15) * 8, vst0 = v_st(sr, sc), vst1 = v_st(32 + sr, sc);
  const int vb0 = (int)(uintptr_t)V_lds + v_rd_base(lane);
  struct { typename St::T vs0, vs1, ks0, ks1; } sr_[SDEPTH];
#define SLOAD(i, k0) do { sr_[i].vs0 = St::ld8(&Vh[(long)((k0) + sr) * LDK + sc]); sr_[i].vs1 = St::ld8(&Vh[(long)((k0) + 32 + sr) * LDK + sc]); \
    sr_[i].ks0 = St::ld8(&Kh[(long)((k0) + sr) * LDK + sc]); sr_[i].ks1 = St::ld8(&Kh[(long)((k0) + 32 + sr) * LDK + sc]); } while (0)
#define SWRITE(b, i) do { *(bf16x8*)((char*)V_lds + (b) * SHM_V + vst0) = St::tobf(sr_[i].vs0);          \
    *(bf16x8*)((char*)V_lds + (b) * SHM_V + vst1) = St::tobf(sr_[i].vs1); int kc = sc * 2;               \
    *(bf16x8*)((char*)K_lds + (b) * SHM_K + KSWZ(sr, kc)) = St::tobf(sr_[i].ks0);                       \
    *(bf16x8*)((char*)K_lds + (b) * SHM_K + KSWZ(32 + sr, kc)) = St::tobf(sr_[i].ks1); } while (0)
#define SWAIT() do { if constexpr (SDEPTH == 2) asm volatile("s_waitcnt vmcnt(4)" ::: "memory"); else asm volatile("s_waitcnt vmcnt(0)" ::: "memory"); } while (0)
#define RESC(a) do { if (__any((a) < 1.f)) { if (hi == 0) al_l[r32] = (a); asm volatile("s_waitcnt lgkmcnt(0)" ::: "memory"); \
    for (int d = 0; d < 4; ++d) for (int r = 0; r < 16; ++r) o[d][r] *= al_l[crow(r, hi)]; } } while (0)
  f32x16 pA0, pA1, pB0, pB1; float mnA, mnB, alA, alB; bf16x8 pa0, pa1, pa2, pa3; const int NT = seq / KVBLK;
  constexpr int SE = 0, SO = SDEPTH - 1;
  SLOAD(SE, 0); asm volatile("s_waitcnt vmcnt(0)" ::: "memory"); SWRITE(0, SE); __syncthreads();
  qkt(pA0, pA1, K_lds, qr, r32, hi); partialSM(pA0, pA1, m_reg, mnA, alA);
  SLOAD(SO, KVBLK); if constexpr (SDEPTH == 2) { if (2 < NT) SLOAD(SE, 2 * KVBLK); }
  SWAIT(); SWRITE(1, SO); __syncthreads();
  for (int j = 1; j + 1 < NT; j += 2) {
    SBAR(); qkt(pB0, pB1, (bf16*)((char*)K_lds + SHM_K), qr, r32, hi);
    finishSM(pA0, pA1, alA, l_reg, pa0, pa1, pa2, pa3); SBAR();
    SLOAD(SO, (j + SDEPTH) * KVBLK); SBAR();
    pv_d0(o, vb0, pa0, pa1, pa2, pa3); partialSM(pB0, pB1, m_reg, mnB, alB);
    __syncthreads(); SWAIT(); SWRITE(0, SE);
    RESC(alB); __syncthreads();
    SBAR(); qkt(pA0, pA1, K_lds, qr, r32, hi);
    finishSM(pB0, pB1, alB, l_reg, pa0, pa1, pa2, pa3); SBAR();
    if (SDEPTH == 1 || j + 3 < NT) SLOAD(SE, (j + 1 + SDEPTH) * KVBLK); SBAR();
    pv_d0(o, vb0 + (int)SHM_V, pa0, pa1, pa2, pa3); partialSM(pA0, pA1, m_reg, mnA, alA);
    __syncthreads(); SWAIT(); SWRITE(1, SO);
    RESC(alA); __syncthreads();
  }
  SBAR(); qkt(pB0, pB1, (bf16*)((char*)K_lds + SHM_K), qr, r32, hi);
  finishSM(pA0, pA1, alA, l_reg, pa0, pa1, pa2, pa3); SBAR();
  pv_d0(o, vb0, pa0, pa1, pa2, pa3); partialSM(pB0, pB1, m_reg, mnB, alB);
  __syncthreads(); RESC(alB);
  finishSM(pB0, pB1, alB, l_reg, pa0, pa1, pa2, pa3); SBAR();
  pv_d0(o, vb0 + (int)SHM_V, pa0, pa1, pa2, pa3);
  if (hi == 0) li_l[r32] = l_reg; asm volatile("s_waitcnt lgkmcnt(0)" ::: "memory");
  float rli[16];
#pragma unroll
  for (int r = 0; r < 16; ++r) rli[r] = __builtin_amdgcn_rcpf(li_l[crow(r, hi)]);
  bf16* Ow = Ob + (long)(wid * QBLK) * LDO;
#pragma unroll
  for (int r = 0; r < 16; ++r) { int orow = crow(r, hi);
    for (int d0 = 0; d0 < 4; ++d0) Ow[(long)orow * LDO + d0 * 32 + r32] = f2bf(o[d0][r] * rli[r]); }
#undef SLOAD
#undef SWRITE
#undef SWAIT
#undef RESC
}
}
__device__ __forceinline__ void attn_phase(const Params& p, unsigned char* lds, int vcu, int G) {
    constexpr int QB = 256, LQB = LSEQ / QB, CQB = CSEQ / QB;
    constexpr int NUL = NLB * NQ * LQB, NUC = NCB * NQ * CQB, NU = NUL + NUC;
    const att::bf16* QR = (const att::bf16*)(p.ws + WS_QRAW); att::bf16* OB = (att::bf16*)(p.ws + WS_O);
    for (int i = 0;; ++i) {
        int u;
        if (G == 256 && NUL == 512) { if (i < 2) u = (vcu >> 5) * 64 + (vcu & 31) + 32 * i; else u = NUL + vcu + (i - 2) * G; }
        else u = vcu + i * G;
        if (u >= NU) break;
        const att::bf16 *Q, *K, *V; att::bf16* O; int seq; int spos0 = -1;
        if (u < NUL) { const int grp = u / (GRP * LQB), j = u % (GRP * LQB); const int b = grp / NKV, kvh = grp % NKV, g = j / LQB, qb = j % LQB, hq = kvh * GRP + g;
            const size_t row0 = (size_t)MC + (size_t)b * LSEQ + (size_t)qb * QB; spos0 = qb * QB;
            Q = QR + row0 * (NQ * HDIM) + hq * HDIM; O = OB + row0 * DM + hq * HDIM;
            K = (const att::bf16*)(p.ws + WS_LATK) + (size_t)b * SKVL * (NKV * HDIM) + kvh * HDIM; V = (const att::bf16*)(p.ws + WS_LATV) + (size_t)b * SKVL * (NKV * HDIM) + kvh * HDIM; seq = SKVL; }
        else { const int uc = u - NUL; const int b = uc / (NQ * CQB), r = uc % (NQ * CQB), hq = r / CQB, qb = r % CQB, kvh = hq / GRP;
            const size_t row0 = (size_t)b * CSEQ + (size_t)qb * QB;
            Q = QR + row0 * (NQ * HDIM) + hq * HDIM; O = OB + row0 * DM + hq * HDIM;
            K = (const att::bf16*)(p.ws + WS_CTXK) + (size_t)b * CSEQ * (NKV * HDIM) + kvh * HDIM; V = (const att::bf16*)(p.ws + WS_CTXV) + (size_t)b * CSEQ * (NKV * HDIM) + kvh * HDIM; seq = CSEQ; }
        __syncthreads();
        att::attn_dense_body(Q, K, V, O, seq, (char*)lds, p.qng, spos0);
    }
}
static_assert(SKVL % 128 == 0 && CSEQ % 128 == 0 && LSEQ % 256 == 0 && CSEQ % 256 == 0, "attention tiling");
constexpr size_t WS_CST = 232 * MiB;
constexpr int NBLK = LSEQ / 256;
constexpr size_t WS_NST = WS_CST + (size_t)NLB * MH * 2 * NBLK * MDK * MDK * 2;
constexpr size_t WS_FTOT = WS_NST + (size_t)NLB * MH * 2 * NBLK * MDK * 4;
static_assert(WS_FTOT + (size_t)NLB * MH * 2 * NBLK * 4 <= WS_END && MDK == 128 && CSEQ == 256 && LSEQ % 256 == 0, "mLSTM fast path geometry");
namespace att {
constexpr int ML_OFF = 132096;
constexpr int ML_SC = ML_OFF + 6144;
constexpr int ML_N = ML_SC + 128;
constexpr int ML_LI = ML_N + 1024;
constexpr int ML_LI2 = ML_LI + 1024;
static_assert(ML_LI2 + 1024 <= LDS_BYTES, "mLSTM LDS map");
constexpr float L2E = 1.4426950408889634f;
using f32x4v = __attribute__((ext_vector_type(4))) float;


__device__ __forceinline__ void ml_gates(const Params& p, char* lds, int row0, int h, int tid) {
    float* A = (float*)(lds + ML_OFF); float* S = (float*)(lds + ML_SC);
    const int half = tid >> 8, t = tid & 255, tok = half ? 255 - t : t, lane = tid & 63, wv = (tid >> 6) & 3;
    const float* G = (const float*)(p.ws + WS_GATES) + (size_t)(row0 + tok) * NGATE + half * 8 + h;
    const float ig = G[0], lf = G[4];
    float v = lf;
#pragma unroll
    for (int off = 1; off < 64; off <<= 1) { const float u = lane_get(v, lane - off); if (lane >= off) v += u; }
    if (lane == 63) S[4 + half * 4 + wv] = v;
    __syncthreads();
    float pre = 0.f, tot = 0.f;
#pragma unroll
    for (int w = 0; w < 4; ++w) { const float x = S[4 + half * 4 + w]; if (w < wv) pre += x; tot += x; }
    const float P = v + pre, a = ig - P;
    A[(0 + half) * 256 + tok] = P * L2E; A[(2 + half) * 256 + tok] = a * L2E; A[(4 + half) * 256 + tok] = __builtin_amdgcn_exp2f(P * L2E);
    float mx = a;
    mx = fmaxf(mx, swz_xor<1>(mx)); mx = fmaxf(mx, swz_xor<2>(mx)); mx = fmaxf(mx, swz_xor<4>(mx)); mx = fmaxf(mx, swz_xor<8>(mx)); mx = fmaxf(mx, swz_xor<16>(mx)); mx = half_max(mx);
    if (lane == 0) S[12 + half * 4 + wv] = mx;
    if (t == 0) S[half] = tot;
    __syncthreads();
    if (t == 0) S[2 + half] = fmaxf(fmaxf(S[12 + half * 4], S[13 + half * 4]), fmaxf(S[14 + half * 4], S[15 + half * 4]));
    __syncthreads();
}
#define ML_PK(L, H) (bf16x8){L[0], L[1], L[2], L[3], H[0], H[1], H[2], H[3]}
__device__ __forceinline__ s16x4 tr_read_rt(int vb) { s16x4 r; asm volatile("ds_read_b64_tr_b16 %0, %1" : "=&v"(r) : "v"(vb) : "memory"); return r; }

__device__ __forceinline__ void ml_passA_unit(const Params& p, char* lds, int sid, int h, int blk) {
    const int tid = tid_opaque(), wid = tid >> 6, lane = tid & 63, r32 = lane & 31, hi = lane >> 5;
    const bool isctx = sid < NCB; const int row0 = seq_base(sid) + 256 * blk;
    __syncthreads();
    ml_gates(p, lds, row0, h, tid);
    float* A = (float*)(lds + ML_OFF); float* S = (float*)(lds + ML_SC); float* NA = (float*)(lds + ML_N);
    const bf16* QK = (const bf16*)(p.ws + WS_QKVO) + (size_t)row0 * (4 * MW) + h * MDK;
    const int sr = tid >> 4, sc8 = (tid & 15) * 8;
    { bf16x8 tv[8];
#pragma unroll
      for (int i = 0; i < 8; ++i) tv[i] = *(const bf16x8*)(QK + (size_t)(32 * i + sr) * (4 * MW) + 2 * MW + sc8);
#pragma unroll
      for (int i = 0; i < 8; ++i) *(bf16x8*)(lds + 65536 + (i >> 1) * 16384 + v_st(32 * (i & 1) + sr, sc8)) = tv[i]; }
    if (tid < 256) NA[tid] = 0.f;
    const int a = wid >> 1, dvb0 = 2 * (wid & 1);
    const int ldsb = (int)(uintptr_t)lds; const int vbK = ldsb + v_rd_base(lane) + a * 512, vbV = ldsb + 65536 + v_rd_base(lane) + dvb0 * 512;
    for (int dir = 0; dir < 2; ++dir) {
        __syncthreads();
        const float ft = S[dir], am = S[2 + dir]; const float mT = isctx ? ft + fmaxf(am, 0.f) : 0.f; const float wl2 = (ft - mT) * L2E;
        float xs[8];
#pragma unroll
        for (int i = 0; i < 8; ++i) xs[i] = 0.f;
        bf16x8 tk[8];
#pragma unroll
        for (int i = 0; i < 8; ++i) tk[i] = *(const bf16x8*)(QK + (size_t)(32 * i + sr) * (4 * MW) + MW + sc8);
#pragma unroll
        for (int j = 0; j < 4; ++j)
#pragma unroll
            for (int hf = 0; hf < 2; ++hf) { const int row = 64 * j + 32 * hf + sr; const float w = __builtin_amdgcn_exp2f(wl2 + A[(2 + dir) * 256 + row]);
                const bf16x8 k8 = tk[2 * j + hf]; float x[8];
#pragma unroll
                for (int i = 0; i < 8; ++i) { x[i] = bf2f((unsigned short)k8[i]) * w; xs[i] += x[i]; }
                u32x4 pk = {cvtpk(x[0], x[1]), cvtpk(x[2], x[3]), cvtpk(x[4], x[5]), cvtpk(x[6], x[7])};
                *(u32x4*)(lds + j * 16384 + v_st(32 * hf + sr, sc8)) = pk; }
#pragma unroll
        for (int i = 0; i < 8; ++i) { float v = xs[i]; v += swz_xor<16>(v); v = half_sum(v); if (lane < 16) atomicAdd(&NA[dir * 128 + sc8 + i], v); }
        __syncthreads();
        f32x16 acc0 = {}, acc1 = {}; const unsigned eoff = (unsigned)((32 * a + 4 * hi) * MDK + 32 * dvb0 + r32);
#pragma unroll
        for (int j = 0; j < 4; ++j)
#pragma unroll
            for (int ks = 0; ks < 4; ++ks) { const int off = j * 16384 + ks * 4096;
                const s16x4 al = tr_read_rt(vbK + off), ah = tr_read_rt(vbK + off + 2048);
                const s16x4 bl0 = tr_read_rt(vbV + off), bh0 = tr_read_rt(vbV + off + 2048), bl1 = tr_read_rt(vbV + off + 512), bh1 = tr_read_rt(vbV + off + 512 + 2048);
                asm volatile("s_waitcnt lgkmcnt(0)" ::: "memory"); SBAR();
                acc0 = __builtin_amdgcn_mfma_f32_32x32x16_bf16(ML_PK(al, ah), ML_PK(bl0, bh0), acc0, 0, 0, 0);
                acc1 = __builtin_amdgcn_mfma_f32_32x32x16_bf16(ML_PK(al, ah), ML_PK(bl1, bh1), acc1, 0, 0, 0); }
        if (isctx) {
            float* Co = p.out + O_C + ((size_t)(sid * 2 + dir) * MH + h) * MDK * MDK;
#pragma unroll
            for (int r = 0; r < 16; ++r) { const unsigned eo = eoff + (unsigned)(((r & 3) + 8 * (r >> 2)) * MDK); Co[eo] = acc0[r]; Co[eo + 32] = acc1[r]; }
            if (tid == 0) p.out[O_M + (size_t)(sid * 2 + dir) * MH + h] = mT;
        } else {
            const int b = sid - NCB; bf16* Cs = (bf16*)(p.ws + WS_CST) + ((size_t)((b * MH + h) * 2 + dir) * NBLK + blk) * MDK * MDK;
#pragma unroll
            for (int r = 0; r < 16; ++r) { const unsigned eo = eoff + (unsigned)(((r & 3) + 8 * (r >> 2)) * MDK); Cs[eo] = f2bf(acc0[r]); Cs[eo + 32] = f2bf(acc1[r]); }
            if (tid == 0) ((float*)(p.ws + WS_FTOT))[((size_t)(b * MH + h) * 2 + dir) * NBLK + blk] = ft;
        }
    }
    __syncthreads();
    if (tid < 256) { const int dir = tid >> 7, d = tid & 127;
        if (isctx) p.out[O_N + ((size_t)(sid * 2 + dir) * MH + h) * MDK + d] = NA[tid];
        else { const int b = sid - NCB; ((float*)(p.ws + WS_NST))[(((size_t)(b * MH + h) * 2 + dir) * NBLK + blk) * MDK + d] = NA[tid]; } }
}

template <int DIR> __device__ __forceinline__ void ml_tile(f32x16* o, float& den, const bf16x8* qr, const char* Ktile, int vbV, const float* AL2, int j, float cq, int trow, bool diag, int r32, int hi) {
    SBAR(); f32x16 p0, p1; qkt(p0, p1, (const bf16*)Ktile, qr, r32, hi); SBAR();
    float ds = 0.f; const int tl = trow - 64 * j - 4 * hi;
#pragma unroll
    for (int g = 0; g < 4; ++g) { const f32x4v a0 = *(const f32x4v*)(AL2 + 64 * j + 8 * g + 4 * hi), a1 = *(const f32x4v*)(AL2 + 64 * j + 32 + 8 * g + 4 * hi);
#pragma unroll
        for (int e = 0; e < 4; ++e) { float w0 = __builtin_amdgcn_exp2f(cq + a0[e]), w1 = __builtin_amdgcn_exp2f(cq + a1[e]);
            if (diag) { if (DIR == 0 ? (8 * g + e > tl) : (8 * g + e < tl)) w0 = 0.f; if (DIR == 0 ? (8 * g + e + 32 > tl) : (8 * g + e + 32 < tl)) w1 = 0.f; }
            p0[4 * g + e] *= w0; p1[4 * g + e] *= w1; ds += p0[4 * g + e] + p1[4 * g + e]; } }
    den += ds;
    bf16x8 pa0, pa1, pa2, pa3;
#define PK4(P, BASE, OUT) do { unsigned a0_ = cvtpk(P[BASE + 0], P[BASE + 1]), a1_ = cvtpk(P[BASE + 2], P[BASE + 3]);   \
    unsigned b0_ = cvtpk(P[BASE + 4], P[BASE + 5]), b1_ = cvtpk(P[BASE + 6], P[BASE + 7]);                              \
    auto r0_ = __builtin_amdgcn_permlane32_swap(a0_, b0_, false, false); auto r1_ = __builtin_amdgcn_permlane32_swap(a1_, b1_, false, false); \
    u32x4 w_ = {r0_[0], r1_[0], r0_[1], r1_[1]}; OUT = *reinterpret_cast<bf16x8*>(&w_); } while (0)
    PK4(p0, 0, pa0); PK4(p0, 8, pa1); PK4(p1, 0, pa2); PK4(p1, 8, pa3);
#undef PK4
    SBAR(); pv_d0(o, vbV, pa0, pa1, pa2, pa3); SBAR();
}
struct MlKv { bf16x8 tk[4], tv[4]; };
__device__ __forceinline__ void ml_kv_load(MlKv& r, const bf16* QK, int tile0, int sr, int sc8) {
#pragma unroll
    for (int i = 0; i < 4; ++i) { const int row = 64 * tile0 + 32 * i + sr; r.tk[i] = *(const bf16x8*)(QK + (size_t)row * (4 * MW) + MW + sc8); r.tv[i] = *(const bf16x8*)(QK + (size_t)row * (4 * MW) + 2 * MW + sc8); }
}
__device__ __forceinline__ void ml_kv_write(const MlKv& r, char* lds, int sr, int sc8) {
#pragma unroll
    for (int i = 0; i < 4; ++i) { const int jj = i >> 1, rl = 32 * (i & 1) + sr; *(bf16x8*)(lds + jj * 16384 + KSWZ(rl, sc8 * 2)) = r.tk[i]; *(bf16x8*)(lds + 32768 + jj * 16384 + v_st(rl, sc8)) = r.tv[i]; }
}
__device__ __forceinline__ void ml_passC_unit(const Params& p, char* lds, int sid, int h, int blk) {
    const int tid = tid_opaque(), wid = tid >> 6, lane = tid & 63, r32 = lane & 31, hi = lane >> 5;
    const bool isctx = sid < NCB; const int row0 = seq_base(sid) + 256 * blk; const int wq = wid >> 1;
    const bf16* QK = (const bf16*)(p.ws + WS_QKVO) + (size_t)row0 * (4 * MW) + h * MDK;
    const int sr = tid >> 4, sc8 = (tid & 15) * 8; const int b = sid - NCB;
    bf16x8 tc[8]; float nsv = 0.f; MlKv kv0; bf16x8 qr[8];
    if (!isctx) {
#pragma unroll
        for (int i = 0; i < 8; ++i) { const int dir = i >> 2, c = tid + 512 * (i & 3); tc[i] = *(const bf16x8*)((const bf16*)(p.ws + WS_CST) + ((size_t)((b * MH + h) * 2 + dir) * NBLK + blk) * MDK * MDK + (size_t)c * 8); }
        if (tid < 256) { const int dir = tid >> 7, d = tid & 127; nsv = ((const float*)(p.ws + WS_NST))[(((size_t)(b * MH + h) * 2 + dir) * NBLK + blk) * MDK + d]; } }
    ml_kv_load(kv0, QK, 0, sr, sc8);
    { const bf16* Qw = QK + (size_t)(wid * 32 + r32) * (4 * MW) + hi * 8;
#pragma unroll
        for (int d0 = 0; d0 < 8; ++d0) qr[d0] = *(const bf16x8*)(Qw + d0 * 16); }
    __syncthreads();
    ml_gates(p, lds, row0, h, tid);
    float* A = (float*)(lds + ML_OFF); float* NS = (float*)(lds + ML_N); float* li = (float*)(lds + ML_LI) + wid * 32;
    if (tid < 256) NS[tid] = nsv;
    if (!isctx) {
#pragma unroll
        for (int i = 0; i < 8; ++i) { const int dir = i >> 2, c = tid + 512 * (i & 3), row = c >> 4, col8 = (c & 15) * 8; *(bf16x8*)(lds + 65536 + dir * 32768 + (row >> 6) * 16384 + v_st(row & 63, col8)) = tc[i]; }
    }
    ml_kv_write(kv0, lds, sr, sc8);
    __syncthreads();
    float qn_f = 0.f, qn_b = 0.f;
#pragma unroll
    for (int d0 = 0; d0 < 8; ++d0)
#pragma unroll
        for (int i = 0; i < 8; ++i) { const float qv = bf2f((unsigned short)qr[d0][i]); qn_f += qv * NS[d0 * 16 + hi * 8 + i]; qn_b += qv * NS[128 + d0 * 16 + hi * 8 + i]; }
    qn_f = half_sum(qn_f); qn_b = half_sum(qn_b);
    const int ldsb = (int)(uintptr_t)lds; const int vbV = ldsb + 32768 + v_rd_base(lane), vbC = ldsb + 65536 + v_rd_base(lane);
    const int trow = wid * 32 + r32;
    f32x16 of[4], ob[4];
#pragma unroll
    for (int d0 = 0; d0 < 4; ++d0) { of[d0] = f32x16{}; ob[d0] = f32x16{}; }
    if (!isctx) { pv_d0(of, vbC, qr[0], qr[1], qr[2], qr[3]); pv_d0(of, vbC + 16384, qr[4], qr[5], qr[6], qr[7]);
        pv_d0(ob, vbC + 32768, qr[0], qr[1], qr[2], qr[3]); pv_d0(ob, vbC + 32768 + 16384, qr[4], qr[5], qr[6], qr[7]);
#pragma unroll
        for (int r = 0; r < 16; ++r) { const float ef = A[4 * 256 + wid * 32 + crow(r, hi)], eb = A[5 * 256 + wid * 32 + crow(r, hi)];
#pragma unroll
            for (int d0 = 0; d0 < 4; ++d0) { of[d0][r] *= ef; ob[d0][r] *= eb; } } }
    const float cqf = A[0 * 256 + trow], cqb = A[1 * 256 + trow]; float denf = 0.f, denb = 0.f;
    ml_tile<0>(of, denf, qr, lds, vbV, A + 2 * 256, 0, cqf, trow, wq == 0, r32, hi);
    if (wq >= 1) ml_tile<0>(of, denf, qr, lds + 16384, vbV + 16384, A + 2 * 256, 1, cqf, trow, wq == 1, r32, hi);
    if (wq <= 1) ml_tile<1>(ob, denb, qr, lds + 16384, vbV + 16384, A + 3 * 256, 1, cqb, trow, wq == 1, r32, hi);
    if (wq <= 0) ml_tile<1>(ob, denb, qr, lds, vbV, A + 3 * 256, 0, cqb, trow, wq == 0, r32, hi);
    __syncthreads();
    { MlKv kv; ml_kv_load(kv, QK, 2, sr, sc8); ml_kv_write(kv, lds, sr, sc8); }
    __syncthreads();
    if (wq >= 2) ml_tile<0>(of, denf, qr, lds, vbV, A + 2 * 256, 2, cqf, trow, wq == 2, r32, hi);
    if (wq >= 3) ml_tile<0>(of, denf, qr, lds + 16384, vbV + 16384, A + 2 * 256, 3, cqf, trow, wq == 3, r32, hi);
    ml_tile<1>(ob, denb, qr, lds + 16384, vbV + 16384, A + 3 * 256, 3, cqb, trow, wq == 3, r32, hi);
    if (wq <= 2) ml_tile<1>(ob, denb, qr, lds, vbV, A + 3 * 256, 2, cqb, trow, wq == 2, r32, hi);
    denf = half_sum(denf); denb = half_sum(denb);
    const float invf = 1.0f / fmaxf(fabsf(denf + __builtin_amdgcn_exp2f(cqf) * qn_f), 1.0f), invb = 1.0f / fmaxf(fabsf(denb + __builtin_amdgcn_exp2f(cqb) * qn_b), 1.0f);
    float* li2 = (float*)(lds + ML_LI2) + wid * 32;
    if (hi == 0) { li[r32] = invf; li2[r32] = invb; } asm volatile("s_waitcnt lgkmcnt(0)" ::: "memory");
    const unsigned uho = (unsigned)(4 * hi * DM + r32), ogo = (unsigned)(4 * hi * 4 * MW + r32);
    float mg[4];
#pragma unroll
    for (int d0 = 0; d0 < 4; ++d0) mg[d0] = p.mng[h * MDK + d0 * 32 + r32];
    const bf16* OG = QK + (size_t)(wid * 32) * (4 * MW) + 3 * MW; bf16* UHo = (bf16*)(p.ws + WS_UH) + (size_t)(row0 + wid * 32) * DM + CCH + h * MDK;
#pragma unroll
    for (int r = 0; r < 16; ++r) { const float rlf = li[crow(r, hi)], rlb = li2[crow(r, hi)]; const int rc = (r & 3) + 8 * (r >> 2); float ss = 0.f; float x[4];
#pragma unroll
        for (int d0 = 0; d0 < 4; ++d0) { x[d0] = of[d0][r] * rlf + ob[d0][r] * rlb; ss += x[d0] * x[d0]; }
        ss += swz_xor<1>(ss); ss += swz_xor<2>(ss); ss += swz_xor<4>(ss); ss += swz_xor<8>(ss); ss += swz_xor<16>(ss);
        const float rs = 1.0f / sqrtf(ss * (1.0f / MDK) + EPSF);
#pragma unroll
        for (int d0 = 0; d0 < 4; ++d0) UHo[uho + (unsigned)(rc * DM + d0 * 32)] = f2bf(bf2f(OG[ogo + (unsigned)(rc * 4 * MW + d0 * 32)]) * x[d0] * rs * mg[d0]);
        if ((r & 3) == 3) asm volatile("" ::: "memory"); }
}
}

template <int DIR> __device__ __forceinline__ void ml_scan_item(const Params& p, int ch, int b, int h, int e8) {
    const float em = expf(p.stm[(size_t)(b * 2 + DIR) * MH + h]); const float* FT = (const float*)(p.ws + WS_FTOT) + (size_t)ch * NBLK;
    float fd[NBLK];
#pragma unroll
    for (int i = 0; i < NBLK; ++i) fd[i] = expf(FT[i]);
    if (e8 < MDK * MDK) { bf16_t* Cs = (bf16_t*)(p.ws + WS_CST) + (size_t)ch * NBLK * MDK * MDK + e8; const float* c0 = p.stC + ((size_t)(b * 2 + DIR) * MH + h) * MDK * MDK + e8;
        v4u d[NBLK];
#pragma unroll
        for (int i = 0; i < NBLK; ++i) d[i] = *(const v4u*)(Cs + (size_t)i * MDK * MDK);
        const f32x4 ca = *(const f32x4*)c0, cb = *(const f32x4*)(c0 + 4); float c[8] = {ca[0] * em, ca[1] * em, ca[2] * em, ca[3] * em, cb[0] * em, cb[1] * em, cb[2] * em, cb[3] * em};
#pragma unroll
        for (int i = 0; i < NBLK; ++i) { const int blk = DIR == 0 ? i : NBLK - 1 - i; v4u o;
#pragma unroll
            for (int w = 0; w < 4; ++w) { const float lo = __uint_as_float(d[blk][w] << 16), hi = __uint_as_float(d[blk][w] & 0xffff0000u); o[w] = pg8::cvt_pk_bf16(c[2 * w], c[2 * w + 1]);
                c[2 * w] = fd[blk] * c[2 * w] + lo; c[2 * w + 1] = fd[blk] * c[2 * w + 1] + hi; }
            *(v4u*)(Cs + (size_t)blk * MDK * MDK) = o; } }
    else { const int d_ = e8 - MDK * MDK; float* Ns = (float*)(p.ws + WS_NST) + (size_t)ch * NBLK * MDK + d_; const float* n0 = p.stn + ((size_t)(b * 2 + DIR) * MH + h) * MDK + d_;
        f32x4 da[NBLK], db[NBLK];
#pragma unroll
        for (int i = 0; i < NBLK; ++i) { da[i] = *(const f32x4*)(Ns + (size_t)i * MDK); db[i] = *(const f32x4*)(Ns + (size_t)i * MDK + 4); }
        f32x4 ca = *(const f32x4*)n0 * em, cb = *(const f32x4*)(n0 + 4) * em;
#pragma unroll
        for (int i = 0; i < NBLK; ++i) { const int blk = DIR == 0 ? i : NBLK - 1 - i;
            *(f32x4*)(Ns + (size_t)blk * MDK) = ca; *(f32x4*)(Ns + (size_t)blk * MDK + 4) = cb; ca = ca * fd[blk] + da[blk]; cb = cb * fd[blk] + db[blk]; } }
}
struct MlScan {
    Params p; static HD_FN long count() { return (long)NLB * MH * 2 * ((MDK * MDK + MDK) / 8); }
    __device__ __forceinline__ void operator()(long idx) const {
        constexpr int per = (MDK * MDK + MDK) / 8; const int e8 = (int)(idx % per) * 8; const int ch = (int)(idx / per); const int dir = ch & 1, h = (ch >> 1) % MH, b = ch / (2 * MH);
        if (dir == 0) ml_scan_item<0>(p, ch, b, h, e8); else ml_scan_item<1>(p, ch, b, h, e8);
    }
};
__device__ __forceinline__ void ml_phase_A(const Params& p, unsigned char* lds, int vcu, int G) {
    constexpr int NUL = NLB * MH * NBLK, NU = NUL + NCB * MH;
    for (int u = vcu; u < NU; u += G) {
        if (u < NUL) att::ml_passA_unit(p, (char*)lds, NCB + u / (MH * NBLK), (u / NBLK) % MH, u % NBLK);
        else att::ml_passA_unit(p, (char*)lds, (u - NUL) / MH, (u - NUL) % MH, 0); }
}
__device__ __forceinline__ void ml_phase_C(const Params& p, unsigned char* lds, int vcu, int G) {
    constexpr int NUL = NLB * MH * NBLK, NU = NUL + NCB * MH;
    for (int u = vcu; u < NU; u += G) {
        if (u < NUL) att::ml_passC_unit(p, (char*)lds, NCB + u / (MH * NBLK), (u / NBLK) % MH, u % NBLK);
        else att::ml_passC_unit(p, (char*)lds, (u - NUL) / MH, (u - NUL) % MH, 0); }
}
typedef float f4 __attribute__((ext_vector_type(4)));
typedef unsigned u4 __attribute__((ext_vector_type(4)));
typedef unsigned u2 __attribute__((ext_vector_type(2)));
__device__ __forceinline__ float wave_sum64(float v) { v += swz_xor<1>(v); v += swz_xor<2>(v); v += swz_xor<4>(v); v += swz_xor<8>(v); v += swz_xor<16>(v); return half_sum(v); }
__device__ __forceinline__ float fsilu(float x) { return x * fsigmoid(x); }

__device__ __forceinline__ void phase_mod(const Params& p, char* lds, int bx, int G) {
    const int tid = tid_opaque(), lane = tid & 63, wave = tid >> 6;
    float* SL = (float*)lds; float* PT = (float*)(lds + 32768);
    constexpr int NCG = 6 * DM / 64, NIT = 2 * NCG;
    if (bx >= NIT) return;
    __syncthreads();
    for (int i = tid; i < NCLS * DM; i += NTHREADS) { const int cls = i / DM, k = i % DM; const float cv = cls == 0 ? p.cctx[k] : p.c[(size_t)(cls - 1) * DM + k]; SL[i] = fsilu(cv); }
    for (int item = bx; item < NIT; item += G) {
        __syncthreads();
        const int l = item / NCG, cg = item % NCG; const float* w = p.wmod + (size_t)l * DM * 6 * DM + cg * 64 + lane;
        float acc[NCLS];
#pragma unroll
        for (int r = 0; r < NCLS; ++r) acc[r] = 0.f;
        const int k0 = wave * (DM / 8);
#pragma unroll 8
        for (int k = k0; k < k0 + DM / 8; ++k) { const float wv = w[(size_t)k * 6 * DM];
#pragma unroll
            for (int r = 0; r < NCLS; ++r) acc[r] += SL[r * DM + k] * wv; }
#pragma unroll
        for (int r = 0; r < NCLS; ++r) PT[(wave * NCLS + r) * 64 + lane] = acc[r];
        __syncthreads();
        if (tid < NCLS * 64) { const int r = tid >> 6; float s = p.bmod[(size_t)l * 6 * DM + cg * 64 + lane];
#pragma unroll
            for (int w8 = 0; w8 < 8; ++w8) s += PT[(w8 * NCLS + r) * 64 + lane];
            ((float*)(p.ws + WS_MOD))[((size_t)(l * NCLS + r) * 6 * DM) + cg * 64 + lane] = s; }
    }
}
__device__ __forceinline__ void sw_job(const Params& p, const bf16_t* Bt, int nrows, int l, int which, float* sw, int N, int mode, int gw, int NGW, int lane) {
    if (gw >= nrows) return;
    f4 sh[NCLS][4];
#pragma unroll
    for (int cls = 0; cls < NCLS; ++cls) { const float* s_ = modv(p, l, cls, which); sh[cls][0] = *(const f4*)(s_ + lane * 8); sh[cls][1] = *(const f4*)(s_ + lane * 8 + 4); sh[cls][2] = *(const f4*)(s_ + DM / 2 + lane * 8); sh[cls][3] = *(const f4*)(s_ + DM / 2 + lane * 8 + 4); }
    u4 w0 = *(const u4*)(Bt + (size_t)gw * DM + lane * 8), w1 = *(const u4*)(Bt + (size_t)gw * DM + DM / 2 + lane * 8);
    for (int n = gw; n < nrows; n += NGW) {
        const u4 c0 = w0, c1 = w1; const int nn = n + NGW; if (nn < nrows) { w0 = *(const u4*)(Bt + (size_t)nn * DM + lane * 8); w1 = *(const u4*)(Bt + (size_t)nn * DM + DM / 2 + lane * 8); }
        f4 wa, wb, wc, wd; wa = (f4){__uint_as_float(c0.x << 16), __uint_as_float(c0.x & 0xffff0000u), __uint_as_float(c0.y << 16), __uint_as_float(c0.y & 0xffff0000u)};
        wb = (f4){__uint_as_float(c0.z << 16), __uint_as_float(c0.z & 0xffff0000u), __uint_as_float(c0.w << 16), __uint_as_float(c0.w & 0xffff0000u)};
        wc = (f4){__uint_as_float(c1.x << 16), __uint_as_float(c1.x & 0xffff0000u), __uint_as_float(c1.y << 16), __uint_as_float(c1.y & 0xffff0000u)};
        wd = (f4){__uint_as_float(c1.z << 16), __uint_as_float(c1.z & 0xffff0000u), __uint_as_float(c1.w << 16), __uint_as_float(c1.w & 0xffff0000u)};
        int col = n; if (mode == 1) { const int t = n >> 8, r = n & 255; col = r < 128 ? 128 * t + r : (N / 2) + 128 * t + (r - 128); }
        float mine = 0.f;
#pragma unroll
        for (int cls = 0; cls < NCLS; ++cls) { const f4 t4 = sh[cls][0] * wa + sh[cls][1] * wb + sh[cls][2] * wc + sh[cls][3] * wd; float s = (t4[0] + t4[1]) + (t4[2] + t4[3]); s = wave_sum64(s); if (lane == cls) mine = s; }
        if (lane < NCLS) sw[(size_t)lane * N + col] = mine;
    }
}
static_assert(DM == 1024, "sw_job / norm passes assume 1024 = 64 lanes x 16");
typedef float f32x4g __attribute__((ext_vector_type(4)));
struct Norm0Pre { f4 x[32]; };
__device__ __forceinline__ void norm0_rowptr(const Params& p, int it, int bx, int G, int wave, int lane, bool& any, int& rb, const float*& xr) {
    const int rb0 = (it * G + bx) * (NWAVES / 2); any = rb0 < MTOK / 16; rb = rb0 + (wave >> 1);
    const int row = (any ? rb : 0) * 16 + (lane & 15); xr = xrow(p, row) + 512 * (wave & 1) + 4 * (lane >> 4);
}
__device__ __forceinline__ void phase_norm0_pre(const Params& p, char* lds, int bx, int G, Norm0Pre& st) {
    const int tid = tid_opaque(), lane = tid & 63, wave = tid >> 6; constexpr int WLD = DM + 4;
    float* WG = (float*)lds;
    __syncthreads();
    { f4 tv[DM * 4 / NTHREADS];
#pragma unroll
      for (int it = 0; it < DM * 4 / NTHREADS; ++it) { const int k = it * (NTHREADS / 4) + (tid >> 2); tv[it] = *(const f4*)(p.winab + (size_t)k * ABIN + ABMAIN + 4 * (tid & 3)); }
#pragma unroll
      for (int it = 0; it < DM * 4 / NTHREADS; ++it) { const int k = it * (NTHREADS / 4) + (tid >> 2), g0 = 4 * (tid & 3); WG[(g0 + 0) * WLD + k] = tv[it][0]; WG[(g0 + 1) * WLD + k] = tv[it][1]; WG[(g0 + 2) * WLD + k] = tv[it][2]; WG[(g0 + 3) * WLD + k] = tv[it][3]; } }
    bool any; int rb; const float* xr; norm0_rowptr(p, 0, bx, G, wave, lane, any, rb, xr);
#pragma unroll
    for (int q = 0; q < 32; ++q) st.x[q] = *(const f4*)(xr + 16 * q);
}
__device__ __forceinline__ void phase_norm0(const Params& p, char* lds, int bx, int G, Norm0Pre& st) {
    const int tid = tid_opaque(), lane = tid & 63, wave = tid >> 6; constexpr int WLD = DM + 4;
    float* WG = (float*)lds; float* XS = (float*)(lds + 16 * WLD * 4);
    const int r = lane & 15, kq = lane >> 4, pair = wave >> 1, kh = wave & 1;
    float* SQ = XS + pair * 32; float* GP = XS + 128 + pair * 256;
    for (int it = 0;; ++it) {
        bool any; int rb; const float* xr; norm0_rowptr(p, it, bx, G, wave, lane, any, rb, xr); if (!any) break;
        const int row = rb * 16 + r; const int cls = cls_of(rb * 16); const int kb = 512 * kh + 4 * kq;
        f4 (&x)[32] = st.x; float s = 0.f;
#pragma unroll
        for (int q = 0; q < 32; ++q) s += (x[q][0] * x[q][0] + x[q][1] * x[q][1]) + (x[q][2] * x[q][2] + x[q][3] * x[q][3]);
        s += swz_xor<16>(s); s = half_sum(s);
        __syncthreads();
        if (kq == 0) SQ[kh * 16 + r] = s;
        __syncthreads();
        const float rs = 1.0f / sqrtf((SQ[r] + SQ[16 + r]) * (1.0f / DM) + EPSF);
        const float* gp = p.n1g + kb; const float* scp = modv(p, 0, cls, 1) + kb; const float* shp = modv(p, 0, cls, 0) + kb; const float* wp = WG + r * WLD + kb;
        bf16_t* xo = (bf16_t*)(p.ws + WS_XN) + (size_t)row * DM + kb;
        f32x4g acc = {0.f, 0.f, 0.f, 0.f};
#pragma unroll
        for (int q = 0; q < 32; ++q) { const f4 gg = *(const f4*)(gp + 16 * q), sc = *(const f4*)(scp + 16 * q), sh = *(const f4*)(shp + 16 * q), w = *(const f4*)(wp + 16 * q);
            const f4 h = x[q] * rs * gg * (sc + 1.0f) + sh;
            u2 o; o.x = pg8::cvt_pk_bf16(h[0], h[1]); o.y = pg8::cvt_pk_bf16(h[2], h[3]); *(u2*)(xo + 16 * q) = o;
            acc = __builtin_amdgcn_mfma_f32_16x16x4f32(h[0], w[0], acc, 0, 0, 0); acc = __builtin_amdgcn_mfma_f32_16x16x4f32(h[1], w[1], acc, 0, 0, 0);
            acc = __builtin_amdgcn_mfma_f32_16x16x4f32(h[2], w[2], acc, 0, 0, 0); acc = __builtin_amdgcn_mfma_f32_16x16x4f32(h[3], w[3], acc, 0, 0, 0); }
        if (kh == 1) *(f32x4g*)(GP + lane * 4) = acc;
        __syncthreads();
        if (kh == 0) { const f32x4g o2 = *(const f32x4g*)(GP + lane * 4); const float bg = p.bgate[r];
#pragma unroll
            for (int e = 0; e < 4; ++e) { float a = acc[e] + o2[e] + bg; if ((r & 7) >= 4) a = logsigmoidf_(a); ((float*)(p.ws + WS_GATES))[(size_t)(rb * 16 + 4 * kq + e) * NGATE + r] = a; } }
        { bool any2; int rb2; const float* xr2; norm0_rowptr(p, it + 1, bx, G, wave, lane, any2, rb2, xr2);
          if (any2) {
#pragma unroll
              for (int q = 0; q < 32; ++q) st.x[q] = *(const f4*)(xr2 + 16 * q); } }
    }
}
static_assert(MTOK % 64 == 0 && MC % 16 == 0 && LSEQ % 16 == 0 && DM == 1024, "norm0 row blocks");
__device__ __forceinline__ void phase_conv(const Params& p, char* lds, int ufirst, int ustride, int uend) {
    const int tid = tid_opaque(), lane = tid & 63, wave = tid >> 6; constexpr int TT = 32, NR = TT + CWID - 1;
    bf16_t* X = (bf16_t*)lds; float* OUT = (float*)(lds + 65536);
    const int cp = tid & 255, tg = tid >> 8, c0 = 2 * cp;
    float w0[CWID], w1[CWID];
#pragma unroll
    for (int j = 0; j < CWID; ++j) { w0[j] = p.convw[(size_t)j * CCH + c0]; w1[j] = p.convw[(size_t)j * CCH + c0 + 1]; }
    const float b0 = p.convb[c0], b1 = p.convb[c0 + 1];
    const bf16_t* U = (const bf16_t*)(p.ws + WS_UPRE);
    for (int u = ufirst; u < uend; u += ustride) {
        const int row0 = u * TT, pos0 = pos_of(row0), len = seqlen_of(row0);
        __syncthreads();
        { u4 val[8];
#pragma unroll
          for (int i = 0; i < 8; ++i) { const int c = tid + NTHREADS * i, r = c / (CCH / 8), ch = (c % (CCH / 8)) * 8; const int t = pos0 + r - CWID / 2;
              val[i] = (u4){0u, 0u, 0u, 0u}; if (c < NR * (CCH / 8) && t >= 0 && t < len) val[i] = *(const u4*)(U + (size_t)(row0 + r - CWID / 2) * CCH + ch); }
#pragma unroll
          for (int i = 0; i < 8; ++i) { const int c = tid + NTHREADS * i, r = c / (CCH / 8), ch = (c % (CCH / 8)) * 8; if (c < NR * (CCH / 8)) *(u4*)(X + (size_t)r * CCH + ch) = val[i]; } }
        __syncthreads();
#pragma unroll 2
        for (int tt = 0; tt < TT / 2; ++tt) { const int t = tg * (TT / 2) + tt; float a0 = b0, a1 = b1;
#pragma unroll
            for (int j = 0; j < CWID; ++j) { const unsigned xx = *(const unsigned*)(X + (size_t)(t + j) * CCH + c0); a0 += w0[j] * __uint_as_float(xx << 16); a1 += w1[j] * __uint_as_float(xx & 0xffff0000u); }
            *(float2*)(OUT + (size_t)t * CCH + c0) = make_float2(a0, a1); }
        __syncthreads();
#pragma unroll
        for (int q = 0; q < TT / NWAVES; ++q) { const int t = wave * (TT / NWAVES) + q; const f4 x0 = *(const f4*)(OUT + (size_t)t * CCH + lane * 8), x1 = *(const f4*)(OUT + (size_t)t * CCH + lane * 8 + 4);
            const float mu = wave_sum64((x0[0] + x0[1]) + (x0[2] + x0[3]) + (x1[0] + x1[1]) + (x1[2] + x1[3])) * (1.0f / CCH);
            const f4 d0 = x0 - mu, d1 = x1 - mu;
            const float var = wave_sum64((d0[0] * d0[0] + d0[1] * d0[1]) + (d0[2] * d0[2] + d0[3] * d0[3]) + (d1[0] * d1[0] + d1[1] * d1[1]) + (d1[2] * d1[2] + d1[3] * d1[3])) * (1.0f / CCH);
            const float rs = 1.0f / sqrtf(var + EPSF);
            const f4 g0 = *(const f4*)(p.lng + lane * 8), g1 = *(const f4*)(p.lng + lane * 8 + 4), be0 = *(const f4*)(p.lnb + lane * 8), be1 = *(const f4*)(p.lnb + lane * 8 + 4);
            const f4 y0 = d0 * rs * g0 + be0, y1 = d1 * rs * g1 + be1; u4 w;
            w.x = pg8::cvt_pk_bf16(fsilu(y0[0]), fsilu(y0[1])); w.y = pg8::cvt_pk_bf16(fsilu(y0[2]), fsilu(y0[3])); w.z = pg8::cvt_pk_bf16(fsilu(y1[0]), fsilu(y1[1])); w.w = pg8::cvt_pk_bf16(fsilu(y1[2]), fsilu(y1[3]));
            *(u4*)((bf16_t*)(p.ws + WS_UH) + (size_t)(row0 + t) * DM + lane * 8) = w; }
    }
}
static_assert(CCH == 512 && CSEQ % 32 == 0 && LSEQ % 32 == 0, "conv phase geometry");
__device__ __forceinline__ void phase_cachecvt(const Params& p, int gtid, int gthreads) {
    constexpr int PER = PAST * NKV * HDIM / 8;
    for (int i = gtid; i < NLB * PER; i += gthreads) { const int b = i / PER, e = (i % PER) * 8; const size_t src = (size_t)b * PAST * NKV * HDIM + e, dst = ((size_t)b * SKVL + LSEQ) * NKV * HDIM + e;
        const f4 k0 = *(const f4*)(p.ck + src), k1 = *(const f4*)(p.ck + src + 4), v0 = *(const f4*)(p.cv + src), v1 = *(const f4*)(p.cv + src + 4); u4 wk, wv;
        wk.x = pg8::cvt_pk_bf16(k0[0], k0[1]); wk.y = pg8::cvt_pk_bf16(k0[2], k0[3]); wk.z = pg8::cvt_pk_bf16(k1[0], k1[1]); wk.w = pg8::cvt_pk_bf16(k1[2], k1[3]);
        wv.x = pg8::cvt_pk_bf16(v0[0], v0[1]); wv.y = pg8::cvt_pk_bf16(v0[2], v0[3]); wv.z = pg8::cvt_pk_bf16(v1[0], v1[1]); wv.w = pg8::cvt_pk_bf16(v1[2], v1[3]);
        *(u4*)((bf16_t*)(p.ws + WS_LATK) + dst) = wk; *(u4*)((bf16_t*)(p.ws + WS_LATV) + dst) = wv; }
}
__device__ __forceinline__ void phase_qkpost(const Params& p, int gw, int NGW, int lane) {
    const int hh = lane >> 5, l5 = lane & 31, half = l5 >> 4, f0 = (l5 & 15) * 2, d1 = half * 64 + f0, d2 = d1 + 32;
    const float inv0 = __builtin_amdgcn_exp2f(-(float)f0 * (13.287712379549449f / 32.0f)), inv1 = __builtin_amdgcn_exp2f(-(float)(f0 + 1) * (13.287712379549449f / 32.0f));
    const float qg[4] = {p.qng[d1], p.qng[d1 + 1], p.qng[d2], p.qng[d2 + 1]}, kg[4] = {p.kng[d1], p.kng[d1 + 1], p.kng[d2], p.kng[d2 + 1]};
    for (int row = gw; row < MTOK; row += NGW) {
        const bool lat = row >= MC; const int sp = pos_of(row); float cs0 = 1.f, sn0 = 0.f, cs1 = 1.f, sn1 = 0.f;
        if (lat) { const float pos = (float)(half == 0 ? sp / GRIDW : sp % GRIDW); cs0 = __cosf(pos * inv0); sn0 = __sinf(pos * inv0); cs1 = __cosf(pos * inv1); sn1 = __sinf(pos * inv1); }
        bf16_t* Q = (bf16_t*)(p.ws + WS_QRAW) + (size_t)row * NQ * HDIM; const bf16_t* KR = (const bf16_t*)(p.ws + WS_KRAW) + (size_t)row * NKV * HDIM;
        unsigned ra[NQ / 2 + 1], rb[NQ / 2 + 1];
#pragma unroll
        for (int it = NQ / 2; it <= NQ / 2; ++it) { const bf16_t* src = it < NQ / 2 ? Q + (2 * it + hh) * HDIM : KR + hh * HDIM; ra[it] = *(const unsigned*)(src + d1); rb[it] = *(const unsigned*)(src + d2); }
#pragma unroll
        for (int it = NQ / 2; it <= NQ / 2; ++it) { const bool isq = it < NQ / 2;
            const float x1a = __uint_as_float(ra[it] << 16), x1b = __uint_as_float(ra[it] & 0xffff0000u), x2a = __uint_as_float(rb[it] << 16), x2b = __uint_as_float(rb[it] & 0xffff0000u);
            float ss = (x1a * x1a + x1b * x1b) + (x2a * x2a + x2b * x2b); ss += swz_xor<1>(ss); ss += swz_xor<2>(ss); ss += swz_xor<4>(ss); ss += swz_xor<8>(ss); ss += swz_xor<16>(ss);
            const float rs = 1.0f / sqrtf(ss * (1.0f / HDIM) + EPSF); const float* g = isq ? qg : kg;
            const float a0 = x1a * rs * g[0], a1 = x1b * rs * g[1], b0 = x2a * rs * g[2], b1 = x2b * rs * g[3];
            const float y1a = a0 * cs0 - b0 * sn0, y2a = a0 * sn0 + b0 * cs0, y1b = a1 * cs1 - b1 * sn1, y2b = a1 * sn1 + b1 * cs1;
            const unsigned w1 = pg8::cvt_pk_bf16(y1a, y1b), w2 = pg8::cvt_pk_bf16(y2a, y2b);
            if (isq) { bf16_t* dst = Q + (2 * it + hh) * HDIM; *(unsigned*)(dst + d1) = w1; *(unsigned*)(dst + d2) = w2; }
            else if (!lat) { bf16_t* K = (bf16_t*)(p.ws + WS_CTXK) + (size_t)row * NKV * HDIM + hh * HDIM; *(unsigned*)(K + d1) = w1; *(unsigned*)(K + d2) = w2;
                float* fo = p.out + O_K + (size_t)row * NKV * HDIM + hh * HDIM; *(float2*)(fo + d1) = make_float2(y1a, y1b); *(float2*)(fo + d2) = make_float2(y2a, y2b); }
            else { const int b_ = (row - MC) / LSEQ, s_ = (row - MC) % LSEQ; bf16_t* K = (bf16_t*)(p.ws + WS_LATK) + ((size_t)b_ * SKVL + s_) * NKV * HDIM + hh * HDIM; *(unsigned*)(K + d1) = w1; *(unsigned*)(K + d2) = w2; } }
    }
}
static_assert(NKV == 2 && NQ % 2 == 0 && HDIM == 128, "qkpost lane mapping");
__device__ __forceinline__ void phase_final(const Params& p, int gw, int NGW, int lane) {
    const f4 g0 = *((const f4*)p.fng + 2 * lane), g1 = *((const f4*)p.fng + 2 * lane + 1), g2 = *((const f4*)p.fng + 128 + 2 * lane), g3 = *((const f4*)p.fng + 128 + 2 * lane + 1);
    const float* sq = (const float*)(p.ws + WS_SSQ) + (size_t)3 * SSQ_STRIDE;
    for (int row = gw; row < MTOK; row += 2 * NGW) { const int row2 = row + NGW; const bool has2 = row2 < MTOK; const int r2 = has2 ? row2 : row;
        const float rsa = 1.0f / sqrtf(sq[row] * (1.0f / DM) + EPSF), rsb = 1.0f / sqrtf(sq[r2] * (1.0f / DM) + EPSF);
        const u4* ya = (const u4*)((const bf16_t*)(p.ws + WS_Y16) + (size_t)row * DM) + lane; const u4* yb = (const u4*)((const bf16_t*)(p.ws + WS_Y16) + (size_t)r2 * DM) + lane;
        const u4 a0 = ya[0], a1 = ya[64], b0 = yb[0], b1 = yb[64];
        f4* oa = (f4*)(p.out + O_Y + (size_t)row * DM) + 2 * lane; f4* ob = (f4*)(p.out + O_Y + (size_t)r2 * DM) + 2 * lane;
#define UNP_LO(V_) (f4){__uint_as_float((V_).x << 16), __uint_as_float((V_).x & 0xffff0000u), __uint_as_float((V_).y << 16), __uint_as_float((V_).y & 0xffff0000u)}
#define UNP_HI(V_) (f4){__uint_as_float((V_).z << 16), __uint_as_float((V_).z & 0xffff0000u), __uint_as_float((V_).w << 16), __uint_as_float((V_).w & 0xffff0000u)}
        oa[0] = UNP_LO(a0) * rsa * g0; oa[1] = UNP_HI(a0) * rsa * g1; oa[128] = UNP_LO(a1) * rsa * g2; oa[129] = UNP_HI(a1) * rsa * g3;
        if (has2) { ob[0] = UNP_LO(b0) * rsb * g0; ob[1] = UNP_HI(b0) * rsb * g1; ob[128] = UNP_LO(b1) * rsb * g2; ob[129] = UNP_HI(b1) * rsb * g3; }
#undef UNP_LO
#undef UNP_HI
    }
}
template <class Epi> __device__ __forceinline__ void gemm_call(LAS unsigned char* lds, const bf16_t* A, const bf16_t* Bt, int N, int K, const Epi& E) {
    pg8::Gemm g{A, Bt, MTOK, N, K}; pg8::StaticOrder S; S.init(MTOK, N, K, (int)gridDim.x, (int)blockIdx.x);
    pg8::gemm_phase<Epi, pg8::StaticOrder, true, true>((PG8_LAS unsigned char*)lds, g, S, E);
}
#ifdef PROBE_A
#define ISTAMP(i) do { if (blockIdx.x == 0 && threadIdx.x == 0 && K == PROBE_K) *(volatile LAS unsigned*)(uintptr_t)(MISC_OFF + 4 * (i)) = (unsigned)__builtin_amdgcn_s_memrealtime(); } while (0)
#else
#define ISTAMP(i) do {} while (0)
#endif
__device__ __forceinline__ void gemm_call_split(LAS unsigned char* lds, const bf16_t* A, const bf16_t* Bt, int N, int K, const EpiRes& E, unsigned char* slab, unsigned* cnt) {
    pg8::Gemm g{A, Bt, MTOK, N, K}; RoundZeroOrder S0; S0.init(MTOK, N, K, (int)gridDim.x, (int)blockIdx.x);
    ISTAMP(0);
    pg8::gemm_phase<EpiRes, RoundZeroOrder, true, true>((PG8_LAS unsigned char*)lds, g, S0, E);
    ISTAMP(1);
    if (S0.split) { QuarterOrder S1; S1.init(MTOK, N, K, (int)gridDim.x, (int)blockIdx.x);
        pg8::gemm_phase<EpiPartial, QuarterOrder, true, true>((PG8_LAS unsigned char*)lds, g, S1, EpiPartial{slab, cnt});
        ISTAMP(2);
        tail_reduce(E, slab, cnt, (int)gridDim.x, (int)blockIdx.x, N / 256, MTOK / 256); ISTAMP(3); }
}
__global__ void __launch_bounds__(NTHREADS, 2) mega_fwd(Params p) {
    extern __shared__ __attribute__((aligned(16))) unsigned char lds[];
    LAS unsigned char* L = (LAS unsigned char*)lds;
    for (int u = threadIdx.x; u < (LDS_BYTES - LDSCTL_OFF) / 4; u += NTHREADS) ((LAS unsigned*)(L + LDSCTL_OFF))[u] = 0u;
    __syncthreads();
    volatile LAS unsigned* MISC = (volatile LAS unsigned*)(L + MISC_OFF);
    const XcdBarrier bar = xcd_barrier_post((unsigned*)(p.ws + WS_CTL) + CW_BAR, MISC + 8);
    const int G = gridDim.x, bx = blockIdx.x; const int vcu = (G % 8 == 0) ? (bx % 8) * (G / 8) + bx / 8 : bx;
    unsigned char* ws = p.ws;
    const bf16_t* XN = (const bf16_t*)(ws + WS_XN); const bf16_t* UH = (const bf16_t*)(ws + WS_UH); const bf16_t* Hh = (const bf16_t*)(ws + WS_H); const bf16_t* Ob = (const bf16_t*)(ws + WS_O);
    float* SW0 = (float*)(ws + WS_SW); float* SWC = SW0 + (size_t)NCLS * 2 * DFF; float* SW1 = SWC + (size_t)NCLS * CIN;
    float* SSQ = (float*)(ws + WS_SSQ); float* Y = p.out + O_Y; unsigned* SPLITC = (unsigned*)(ws + WS_CTL) + CW_SPLIT;
#define WAVE_IDS() const int tid_ = tid_opaque(); const int lane_ = tid_ & 63; const int gw_ = bx * NWAVES + (tid_ >> 6); const int NGW_ = G * NWAVES
    p0_weights(p, L, vcu, G); phase_mod(p, (char*)lds, bx, G);
    Norm0Pre n0pre; phase_norm0_pre(p, (char*)lds, bx, G, n0pre);
    xcd_barrier(bar);
    phase_norm0(p, (char*)lds, bx, G, n0pre);
    xcd_barrier(bar);
    gemm_call(L, XN, (const bf16_t*)(ws + WB_AB), ABMAIN, DM, EpiAB{(bf16_t*)(ws + WS_UPRE), (bf16_t*)(ws + WS_QKVO)}); xcd_barrier(bar);
    ml_phase_A(p, lds, vcu, G);
    { WAVE_IDS(); constexpr int NU_ML = NLB * MH * NBLK + NCB * MH; const int nsecond = (NU_ML > G && NU_ML - G < G) ? NU_ML - G : 0;
      if (vcu >= nsecond) { const int gw2 = (vcu - nsecond) * NWAVES + (tid_ >> 6), ngw2 = (G - nsecond) * NWAVES;
        sw_job(p, (const bf16_t*)(ws + WB_FFI0), 2 * DFF, 0, 3, SW0, 2 * DFF, 1, gw2, ngw2, lane_); sw_job(p, (const bf16_t*)(ws + WB_INC), CIN, 1, 0, SWC, CIN, 0, gw2, ngw2, lane_);
        sw_job(p, (const bf16_t*)(ws + WB_FFI1), 2 * DFF, 1, 3, SW1, 2 * DFF, 1, gw2, ngw2, lane_); } }
    xcd_barrier(bar);
    { WAVE_IDS(); MlScan sc{p}; for (long i = bx * (long)NTHREADS + tid_; i < MlScan::count(); i += (long)G * NTHREADS) sc(i); } xcd_barrier(bar);
    ml_phase_C(p, lds, vcu, G);
    { constexpr int NU_ML = NLB * MH * NBLK + NCB * MH, NU_CV = MTOK / 32; const int nsecond = (NU_ML > G && NU_ML - G < G) ? NU_ML - G : 0;
      if (G == 256 && nsecond == 64 && NU_CV == 640) { if (vcu < 64) phase_conv(p, (char*)lds, vcu, 1 << 30, NU_CV); else phase_conv(p, (char*)lds, 64 + (vcu - 64), 192, NU_CV); }
      else phase_conv(p, (char*)lds, vcu, G, NU_CV); }
    xcd_barrier(bar);
    gemm_call_split(L, UH, (const bf16_t*)(ws + WB_OUTAB), DM, DM, EpiRes{p.xp, p.xs, (bf16_t*)(ws + WS_Y16), (bf16_t*)(ws + WS_XN), SSQ + 0 * SSQ_STRIDE, modv(p, 0, 0, 2), modv(p, 0, 0, 4), p.n2g, 1, 0}, (unsigned char*)Y, SPLITC + 0 * 4096); xcd_barrier(bar);
    gemm_call(L, XN, (const bf16_t*)(ws + WB_FFI0), 2 * DFF, DM, EpiFfnIn{(bf16_t*)(ws + WS_H), SSQ + 0 * SSQ_STRIDE, SW0}); xcd_barrier(bar);
    gemm_call_split(L, Hh, (const bf16_t*)(ws + WB_FFO0), DM, DFF, EpiRes{p.xp, p.xs, (bf16_t*)(ws + WS_Y16), (bf16_t*)(ws + WS_XN), SSQ + 1 * SSQ_STRIDE, modv(p, 0, 0, 5), modv(p, 1, 0, 1), p.n1g + DM, 0, 0}, (unsigned char*)Y + SLAB_BYTES, SPLITC + 1 * 4096); xcd_barrier(bar);
    gemm_call(L, XN, (const bf16_t*)(ws + WB_INC), CIN, DM, EpiQkv{(bf16_t*)(ws + WS_QRAW), (bf16_t*)(ws + WS_KRAW), (bf16_t*)(ws + WS_CTXV), (bf16_t*)(ws + WS_LATV), p.out + O_V, SSQ + 1 * SSQ_STRIDE, SWC}); xcd_barrier(bar);
    { WAVE_IDS(); phase_qkpost(p, gw_, NGW_, lane_); phase_cachecvt(p, bx * NTHREADS + tid_, G * NTHREADS); } xcd_barrier(bar);
    attn_phase(p, lds, vcu, G); xcd_barrier(bar);
    gemm_call_split(L, Ob, (const bf16_t*)(ws + WB_OUTC), DM, DM, EpiRes{p.xp, p.xs, (bf16_t*)(ws + WS_Y16), (bf16_t*)(ws + WS_XN), SSQ + 2 * SSQ_STRIDE, modv(p, 1, 0, 2), modv(p, 1, 0, 4), p.n2g + DM, 0, 0}, (unsigned char*)Y, SPLITC + 2 * 4096); xcd_barrier(bar);
    gemm_call(L, XN, (const bf16_t*)(ws + WB_FFI1), 2 * DFF, DM, EpiFfnIn{(bf16_t*)(ws + WS_H), SSQ + 2 * SSQ_STRIDE, SW1}); xcd_barrier(bar);
    gemm_call_split(L, Hh, (const bf16_t*)(ws + WB_FFO1), DM, DFF, EpiRes{p.xp, p.xs, (bf16_t*)(ws + WS_Y16), (bf16_t*)(ws + WS_XN), SSQ + 3 * SSQ_STRIDE, modv(p, 1, 0, 5), modv(p, 1, 0, 1), nullptr, 0, 0}, (unsigned char*)Y + SLAB_BYTES, SPLITC + 3 * 4096); xcd_barrier(bar);
    { WAVE_IDS(); phase_final(p, gw_, NGW_, lane_); }
#undef WAVE_IDS
}
static Params make_params(void* const* d_in, void* d_out, void* d_ws) {
    Params p{}; const float** pp = (const float**)&p; for (int i = 0; i < 28; ++i) pp[i] = (const float*)d_in[i];
    p.out = (float*)d_out; p.ws = (unsigned char*)d_ws; return p;
}
extern "C" void kernel_launch(void* const* d_in, const int* in_sizes, int n_in, void* d_out, int out_size, void* d_ws, size_t ws_size, hipStream_t stream) {
    static int grid = 0;
    if (grid == 0) {
        if (n_in != 28 || (size_t)out_size != O_END || ws_size < WS_END || in_sizes[0] != MC * DM || in_sizes[1] != ML * DM) {
            fprintf(stderr, "kernel_launch: shape mismatch n_in %d out %d (want %zu) ws %zu (want %zu)\n", n_in, out_size, (size_t)O_END, ws_size, (size_t)WS_END); grid = -1; return; }
        int dev = 0, cus = 0;
        if (hipGetDevice(&dev) != hipSuccess || hipDeviceGetAttribute(&cus, hipDeviceAttributeMultiprocessorCount, dev) != hipSuccess) { grid = -1; return; }
        if (hipFuncSetAttribute((const void*)mega_fwd, hipFuncAttributeMaxDynamicSharedMemorySize, LDS_BYTES) != hipSuccess) { fprintf(stderr, "hipFuncSetAttribute failed\n"); grid = -1; return; }
        int per_cu = 0; (void)hipOccupancyMaxActiveBlocksPerMultiprocessor(&per_cu, (const void*)mega_fwd, NTHREADS, LDS_BYTES); (void)hipGetLastError();
        if (per_cu < 1) fprintf(stderr, "kernel_launch: occupancy query says %d blocks/CU\n", per_cu);
        grid = cus;
    }
    if (grid < 0) return;
    hipMemsetAsync((char*)d_ws + WS_CTL, 0, CTL_ZERO_BYTES, stream);
    Params p = make_params(d_in, d_out, d_ws);
    hipLaunchKernelGGL(mega_fwd, dim3(grid), dim3(NTHREADS), LDS_BYTES, stream, p);
}
```

```cpp
#ifdef HOST_TEST
#include <cmath>
#include <cstdio>
#include <cstdlib>
#include <cstring>
#include <cstdint>
#include <vector>
#define HD_FN inline
#define DEV_FN inline
#else
#include <hip/hip_runtime.h>
#include <cstdio>
#include <cstdint>
#define HD_FN __host__ __device__ __forceinline__
#define DEV_FN __device__ __forceinline__
#endif

#ifdef TINY
constexpr int DM = 512, NCB = 2, CSEQ = 128, NLB = 2, LSEQ = 128, PAST = 128;
#else
constexpr int DM = 1024, NCB = 16, CSEQ = 256, NLB = 4, LSEQ = 4096, PAST = 256;
#endif
constexpr int GRIDW = 64, CCH = DM / 2, CWID = 31, MH = 4, MDK = CCH / MH, MW = CCH, NGATE = 16;
constexpr int ABIN = 2 * CCH + 4 * MW + NGATE, ABMAIN = 2 * CCH + 4 * MW;
constexpr int HDIM = 128, NQ = DM / HDIM, NKV = 2, GRP = NQ / NKV, CIN = (NQ + 2 * NKV) * HDIM;
constexpr int DFF = ((8 * DM + 3 * 256 - 1) / (3 * 256)) * 256;
constexpr int MC = NCB * CSEQ, ML = NLB * LSEQ, MTOK = MC + ML, NCLS = 1 + NLB, SKVL = LSEQ + PAST;
constexpr float EPSF = 1e-6f;
constexpr int NSEQ = NCB + NLB;

constexpr size_t O_Y = 0, O_C = (size_t)MTOK * DM, O_N = O_C + (size_t)NCB * 2 * MH * MDK * MDK, O_M = O_N + (size_t)NCB * 2 * MH * MDK,
                 O_K = O_M + (size_t)NCB * 2 * MH, O_V = O_K + (size_t)NCB * CSEQ * NKV * HDIM, O_END = O_V + (size_t)NCB * CSEQ * NKV * HDIM;

constexpr size_t MiB = 1u << 20;
#ifdef TINY
constexpr size_t WSCALE = 1;
#endif
constexpr size_t WS_CTL = 0, CTL_ZERO_BYTES = 1 * MiB;
constexpr size_t WS_MOD = 128 * 1024;
constexpr size_t WS_SW = 1 * MiB + 256 * 1024;
constexpr size_t WS_SSQ = 512 * 1024;
constexpr int SSQ_STRIDE = 32768;
constexpr size_t WS_DEN = 232 * MiB;
constexpr size_t WS_WB = 2 * MiB;
constexpr size_t WS_XN = 50 * MiB;
constexpr size_t WS_UPRE = 90 * MiB;
constexpr size_t WS_QKVO = 110 * MiB;
constexpr size_t WS_UH = 190 * MiB;
constexpr size_t WS_GATES = 230 * MiB;
constexpr size_t WS_HS = 50 * MiB;
constexpr size_t WS_Y16 = 90 * MiB;
constexpr size_t WS_H = 130 * MiB;
constexpr size_t WS_QRAW = 130 * MiB;
constexpr size_t WS_LATK = 170 * MiB, WS_LATV = 179 * MiB, WS_CTXK = 188 * MiB, WS_CTXV = 190 * MiB;
constexpr size_t WS_KRAW = 192 * MiB;
constexpr size_t WS_O = 202 * MiB;
constexpr size_t WS_VT8L = 246 * MiB, WS_VT8C = 251 * MiB;
constexpr size_t WS_K8L = 90 * MiB, WS_K8C = 95 * MiB;
constexpr size_t WS_END = 256 * MiB;

typedef unsigned short bf16_t;
HD_FN float bf2f(bf16_t h) { unsigned u = (unsigned)h << 16; return __builtin_bit_cast(float, u); }
HD_FN bf16_t f2bf(float f) { unsigned u = __builtin_bit_cast(unsigned, f); return (bf16_t)((u + 0x7fffu + ((u >> 16) & 1u)) >> 16); }
HD_FN float rbf(float f) { return bf2f(f2bf(f)); }
HD_FN float sigmoidf_(float x) { return 1.0f / (1.0f + expf(-x)); }
HD_FN float siluf_(float x) { return x * sigmoidf_(x); }
HD_FN float logsigmoidf_(float x) { return x >= 0.f ? -log1pf(expf(-x)) : x - log1pf(expf(x)); }
HD_FN int cls_of(int row) { return row < MC ? 0 : 1 + (row - MC) / LSEQ; }
HD_FN int seqlen_of(int row) { return row < MC ? CSEQ : LSEQ; }
HD_FN int seq_base(int sid) { return sid < NCB ? sid * CSEQ : MC + (sid - NCB) * LSEQ; }
HD_FN int pos_of(int row) { return row < MC ? row % CSEQ : (row - MC) % LSEQ; }

struct Params {
    const float *xp, *xs, *c, *stC, *stn, *stm, *ck, *cv, *cctx, *wmod, *bmod, *n1g, *n2g, *winab, *bgate, *convw, *convb, *lng, *lnb, *mng,
        *woutab, *winc, *qng, *kng, *woutc, *wffi, *wffo, *fng;
    float* out; unsigned char* ws;
};
HD_FN const float* xrow(const Params& p, int row) { return row < MC ? p.xp + (size_t)row * DM : p.xs + (size_t)(row - MC) * DM; }
HD_FN const float* modv(const Params& p, int l, int cls, int which) { return (const float*)(p.ws + WS_MOD) + ((size_t)(l * NCLS + cls) * 6 + which) * DM; }
constexpr int NWAVES = 8, NTHREADS = NWAVES * 64;
constexpr int RING_OFF = 0, RING_BYTES = 131072;
constexpr int LDSCTL_OFF = RING_BYTES, MISC_OFF = LDSCTL_OFF + 320;
constexpr int LDS_BYTES = 147456;
constexpr int CW_TMO = 0, CW_CODE = 1, CW_BAR = 4096;
#define GAS __attribute__((address_space(1)))
#define LAS __attribute__((address_space(3)))
constexpr int WTAB_OFF = LDSCTL_OFF + 768;
__device__ __forceinline__ int lane_id() { int l; asm volatile("v_mbcnt_lo_u32_b32 %0, -1, 0\n\tv_mbcnt_hi_u32_b32 %0, -1, %0" : "=v"(l)); return l; }
__device__ __forceinline__ unsigned hw_wave_slot() { return (unsigned)__builtin_amdgcn_s_getreg(63492) & 63u; }
__device__ __forceinline__ int tid_opaque() { const int w = __builtin_amdgcn_readfirstlane(*(const LAS int*)(uintptr_t)(WTAB_OFF + 4 * hw_wave_slot())); int t = (w << 6) | lane_id(); asm volatile("" : "+v"(t)); return t; }
template <int M> __device__ __forceinline__ float swz_xor(float v) { return __int_as_float(__builtin_amdgcn_ds_swizzle(__float_as_int(v), (M << 10) | 0x1f)); }
__device__ __forceinline__ float half_sum(float v) { auto rr = __builtin_amdgcn_permlane32_swap(__float_as_uint(v), __float_as_uint(v), false, false); return __uint_as_float(rr[0]) + __uint_as_float(rr[1]); }
__device__ __forceinline__ float half_max(float v) { auto rr = __builtin_amdgcn_permlane32_swap(__float_as_uint(v), __float_as_uint(v), false, false); return fmaxf(__uint_as_float(rr[0]), __uint_as_float(rr[1])); }
__device__ __forceinline__ float lane_get(float v, int src_lane) { return __int_as_float(__builtin_amdgcn_ds_bpermute(src_lane << 2, __float_as_int(v))); }
typedef GAS unsigned gu32;
#define RLX_AGENT __ATOMIC_RELAXED, __HIP_MEMORY_SCOPE_AGENT
#define XB_TMO      128
#define XB_XCNT(j)  (256  + 64 * (j))
#define XB_XSUB(j)  (1280 + 64 * (j))
#define XB_XGEN(j)  (2304 + 64 * (j))
#define XB_TOP      3328
#define XB_TOPGEN   3392
#define XCD_BAR_WORDS 3456
#define XB_SPIN_CAP (1u << 22)
__device__ __forceinline__ unsigned xb_ld(unsigned* p)              { return __hip_atomic_load(p, __ATOMIC_RELAXED, __HIP_MEMORY_SCOPE_AGENT); }
__device__ __forceinline__ unsigned xb_add(unsigned* p, unsigned v) { return __hip_atomic_fetch_add(p, v, __ATOMIC_RELAXED, __HIP_MEMORY_SCOPE_AGENT); }
__device__ __forceinline__ unsigned xb_xcc_id() { return (unsigned)__builtin_amdgcn_s_getreg((3 << 11) | 20) & 0xFu; }
#define XB_SPIN(cond, bar) do { unsigned _sp = 0; while (cond) { __builtin_amdgcn_s_sleep(1); \
    if ((++_sp & 255u) == 0u) { if (xb_ld(&(bar)[XB_TMO])) break; if (_sp > XB_SPIN_CAP) { atomicAdd(&(bar)[XB_TMO], 1u); break; } } } } while (0)
struct XcdBarrier { unsigned* bar; unsigned x; volatile LAS unsigned* st; };
__device__ __forceinline__ XcdBarrier xcd_barrier_post(unsigned* bar, volatile LAS unsigned* st) {
    XcdBarrier b; b.bar = bar; b.x = xb_xcc_id(); b.st = st;
    if (tid_opaque() == 0) (void)xb_add(&bar[XB_XCNT(b.x)], 1u);
    return b;
}
__device__ __forceinline__ void xcd_barrier_complete(unsigned* bar, unsigned x, unsigned& nloc, unsigned& nx) {
    const unsigned G = gridDim.x * gridDim.y * gridDim.z;
    unsigned sum, cnt, mine, sp = 0u;
    for (;;) {
        sum = 0u; cnt = 0u; mine = 0u;
#pragma unroll
        for (unsigned j = 0; j < 16; ++j) { const unsigned c = xb_ld(&bar[XB_XCNT(j)]); sum += c; cnt += (c > 0u) ? 1u : 0u; mine = (j == x) ? c : mine; }
        if (sum == G) break;
        __builtin_amdgcn_s_sleep(1);
        if ((++sp & 255u) == 0u) { if (xb_ld(&bar[XB_TMO])) break; if (sp > XB_SPIN_CAP) { atomicAdd(&bar[XB_TMO], 1u); break; } }
    }
    nloc = mine > 0u ? mine : 1u; nx = cnt > 0u ? cnt : 1u;
}
__device__ __forceinline__ void xcd_barrier(const XcdBarrier& b) {
    asm volatile("s_waitcnt vmcnt(0)" ::: "memory");
    __syncthreads();
    if (tid_opaque() == 0) {
        unsigned* bar = b.bar;
        __builtin_amdgcn_s_waitcnt(0);
        unsigned nloc = b.st[0], nx = b.st[1];
        if (nloc == 0u) { xcd_barrier_complete(bar, b.x, nloc, nx); b.st[0] = nloc; b.st[1] = nx; }
        const unsigned old = xb_add(&bar[XB_XSUB(b.x)], 1u);
        const unsigned gen = old / nloc;
        if (old + 1u == (gen + 1u) * nloc) {
            __builtin_amdgcn_fence(__ATOMIC_RELEASE, "agent");
            asm volatile("s_waitcnt vmcnt(0)" ::: "memory");
            const unsigned og = xb_add(&bar[XB_TOP], 1u);
            const unsigned tg = og / nx;
            if (og + 1u == (tg + 1u) * nx) xb_add(&bar[XB_TOPGEN], 1u);
            else XB_SPIN(xb_ld(&bar[XB_TOPGEN]) == tg, bar);
            __builtin_amdgcn_fence(__ATOMIC_ACQUIRE, "agent");
            xb_add(&bar[XB_XGEN(b.x)], 1u);
            asm volatile("s_waitcnt vmcnt(0)" ::: "memory");
        } else {
            XB_SPIN(xb_ld(&bar[XB_XGEN(b.x)]) == gen, bar);
            __builtin_amdgcn_fence(__ATOMIC_ACQUIRE, "agent");
            asm volatile("s_waitcnt vmcnt(0)" ::: "memory");
        }
    }
    __syncthreads();
}
namespace pg8 {
#define PG8_LAS __attribute__((address_space(3)))
typedef unsigned short bf16_t;
typedef short bf16x8 __attribute__((ext_vector_type(8)));
typedef float f32x4 __attribute__((ext_vector_type(4)));
typedef unsigned u32x4 __attribute__((ext_vector_type(4)));
constexpr int BM = 256, BK = 64, HALF = 128, HTB = HALF * BK * 2  , STAGE_BYTES = 8 * HTB, NXCD = 8, WGM = 8;

__host__ __device__ __forceinline__ int lds_byte(int r, int c) { const int st = (r >> 4) * 2 + (c >> 5), rr = r & 15, cc = c & 31, ob = rr * 64 + cc * 2; return st * 1024 + (ob ^ (((ob >> 9) & 1) << 5)); }
__host__ __device__ __forceinline__ void stage_rc(int b, int& R, int& C) { const int st = b / 1024, sb = b % 1024, swz = sb ^ (((sb >> 9) & 1) << 5); R = (st >> 1) * 16 + swz / 64; C = (st & 1) * 32 + (swz % 64) / 2; }
__host__ __device__ __forceinline__ int perm32(int rho) { const int n = rho >> 4, i = rho & 15; return 8 * (i >> 2) + 4 * n + (i & 3); }

struct Unit { int pm, pn, k0, nt, role, slot, roff; };
struct Gemm { const bf16_t* A; const bf16_t* Bt; int M, N, K; };

struct StaticOrder {
    int nM, nN, nwg, G, c, ntK;
    __host__ __device__ void init(int M, int N, int K, int G_, int c_) { nM = M / BM; nN = N / BM; nwg = nM * nN; G = G_; c = c_; ntK = K / BK; }
    __host__ __device__ void map(int L, Unit& u) const { int wgid = L; { const int q = nwg / NXCD, r = nwg % NXCD, xcd = wgid % NXCD, off = wgid / NXCD; wgid = (xcd < r ? xcd * (q + 1) : r * (q + 1) + (xcd - r) * q) + off; }
        const int nig = WGM * nN, gid = wgid / nig, fm = gid * WGM, gsz = (nM - fm) < WGM ? (nM - fm) : WGM; u.pm = fm + ((wgid % nig) % gsz); u.pn = (wgid % nig) / gsz; }
    __host__ __device__ bool next(int i, Unit& u) const {
        const long L = (long)i * G + c; if (L >= nwg) return false;
        int wgid = (int)L; { const int q = nwg / NXCD, r = nwg % NXCD, xcd = wgid % NXCD, off = wgid / NXCD; wgid = (xcd < r ? xcd * (q + 1) : r * (q + 1) + (xcd - r) * q) + off; }
        const int nig = WGM * nN, gid = wgid / nig, fm = gid * WGM, gsz = (nM - fm) < WGM ? (nM - fm) : WGM;
        u.pm = fm + ((wgid % nig) % gsz); u.pn = (wgid % nig) / gsz; u.k0 = 0; u.nt = ntK; u.role = 0; u.slot = 0; u.roff = 0; return true;
    }
    __device__ __forceinline__ void a_ready(const Unit&) const {}
    __device__ __forceinline__ void done(const Unit&) const {}
};

__device__ __forceinline__ unsigned cvt_pk_bf16(float lo, float hi) { unsigned r; asm volatile("v_cvt_pk_bf16_f32 %0, %1, %2" : "=v"(r) : "v"(lo), "v"(hi)); return r; }
typedef float f32x2 __attribute__((ext_vector_type(2)));
template <class Epi, class Sched, bool ALIGN_EPI = false, bool SP2 = false>
__device__ __forceinline__ void gemm_phase(PG8_LAS unsigned char* lds, const Gemm g, const Sched& S, const Epi& E) {
    const int tid = tid_opaque(), wid = __builtin_amdgcn_readfirstlane(tid >> 6), lane = tid & 63, wr = wid >> 2, wc = wid & 3, fr = lane & 15, fq = lane >> 4;
    const int K = g.K;
    unsigned voffA[2], voffB[2];
#pragma unroll
    for (int i = 0; i < 2; ++i) { int R, C; stage_rc(tid * 16 + i * 8192, R, C); const int Rb = Epi::PERM ? ((R & ~31) + perm32(R & 31)) : R;
        voffA[i] = (unsigned)(R * K + C) * 2u; voffB[i] = (unsigned)(Rb * K + C) * 2u; }
    const size_t kstep = (size_t)(BK * 2);
    const size_t hstep = (size_t)HALF * K * 2;
    const size_t tstep = 2 * hstep;
    const unsigned ldsw = (unsigned)wid * 1024u;
    const int aoff = lds_byte(wr * 64 + fr, fq * 8), boff = lds_byte(wc * 32 + fr, fq * 8);
#define PG8_SA(b, h) (((b) * 2 + (h)) * HTB)
#define PG8_SB(b, h) ((4 + (b) * 2 + (h)) * HTB)
#define PG8_STAGE(bufoff, gbase, voff) do { _Pragma("unroll") for (int _i = 0; _i < 2; ++_i) \
        __builtin_amdgcn_global_load_lds((const unsigned*)((const char*)(gbase) + (voff)[_i]), (PG8_LAS unsigned*)(lds + (bufoff) + ldsw + _i * 8192), 16, 0, 0); } while (0)
#define PG8_LDA(dst, b, h) do { _Pragma("unroll") for (int m = 0; m < 4; ++m) _Pragma("unroll") for (int k = 0; k < 2; ++k) dst[m][k] = *(const PG8_LAS bf16x8*)(lds + PG8_SA(b, h) + aoff + m * 2048 + k * 1024); } while (0)
#define PG8_LDB(dst, b, h) do { _Pragma("unroll") for (int n = 0; n < 2; ++n) _Pragma("unroll") for (int k = 0; k < 2; ++k) dst[n][k] = *(const PG8_LAS bf16x8*)(lds + PG8_SB(b, h) + boff + n * 2048 + k * 1024); } while (0)
#define PG8_MMA(ai, bj, At, Bt) do { __builtin_amdgcn_s_setprio(1); _Pragma("unroll") for (int m = 0; m < 4; ++m) _Pragma("unroll") for (int n = 0; n < 2; ++n) _Pragma("unroll") for (int k = 0; k < 2; ++k) \
        acc[ai][bj][m][n] = __builtin_amdgcn_mfma_f32_16x16x32_bf16(Bt[n][k], At[m][k], acc[ai][bj][m][n], 0, 0, 0); __builtin_amdgcn_s_setprio(0); } while (0)
#define PG8_WAIT_V(n) asm volatile("s_waitcnt vmcnt(" #n ")" ::: "memory")
#define PG8_WAIT_L(n) asm volatile("s_waitcnt lgkmcnt(" #n ")" ::: "memory")
#define PG8_BAR __builtin_amdgcn_s_barrier()
#define PG8_SCHED __builtin_amdgcn_sched_barrier(0)
    Unit cur, nxt; int ui = 0;
    if (!S.next(0, cur)) return;
    f32x4 acc[2][2][4][2];
#pragma unroll
    for (int a = 0; a < 2; ++a)
#pragma unroll
        for (int b = 0; b < 2; ++b)
#pragma unroll
            for (int m = 0; m < 4; ++m)
#pragma unroll
                for (int n = 0; n < 2; ++n) acc[a][b][m][n] = (f32x4){0.f, 0.f, 0.f, 0.f};
    bf16x8 At[4][2], B0[2][2], B1[2][2];
    const char* cA = (const char*)g.A + (size_t)cur.pm * tstep + (size_t)cur.k0 * kstep + (size_t)cur.roff * K * 2; const char* cB = (const char*)g.Bt + (size_t)cur.pn * tstep + (size_t)cur.k0 * kstep; int nt = cur.nt;
    S.a_ready(cur);
    if constexpr (SP2) {
        PG8_STAGE(PG8_SB(0, 0), cB, voffB); PG8_STAGE(PG8_SB(0, 1), cB + hstep, voffB); PG8_STAGE(PG8_SA(0, 0), cA, voffA); PG8_STAGE(PG8_SA(0, 1), cA + hstep, voffA);
        if (wr == 1) PG8_BAR;
        PG8_WAIT_V(2); PG8_BAR;
        PG8_STAGE(PG8_SB(1, 0), cB + kstep, voffB); PG8_STAGE(PG8_SA(1, 0), cA + kstep, voffA); PG8_STAGE(PG8_SB(1, 1), cB + hstep + kstep, voffB);
        PG8_WAIT_V(6); PG8_BAR;
    } else {
        PG8_STAGE(PG8_SB(0, 0), cB, voffB); PG8_STAGE(PG8_SA(0, 0), cA, voffA); PG8_STAGE(PG8_SB(0, 1), cB + hstep, voffB); PG8_STAGE(PG8_SA(0, 1), cA + hstep, voffA);
        if (wr == 1) PG8_BAR;
        PG8_WAIT_V(4); PG8_BAR;
        PG8_STAGE(PG8_SB(1, 0), cB + kstep, voffB); PG8_STAGE(PG8_SA(1, 0), cA + kstep, voffA); PG8_STAGE(PG8_SB(1, 1), cB + hstep + kstep, voffB);
        PG8_WAIT_V(6); PG8_BAR;
    }
    for (;;) {
        const bool has_next = S.next(ui + 1, nxt);
        const char* nA = has_next ? (const char*)g.A + (size_t)nxt.pm * tstep + (size_t)nxt.k0 * kstep + (size_t)nxt.roff * K * 2 : cA;
        const bool halfm = (cur.role == 9);
        const char* nB = has_next ? (const char*)g.Bt + (size_t)nxt.pn * tstep + (size_t)nxt.k0 * kstep : cB;
        for (int t = 0; t < nt; t += 2) {
            const bool last = (t == nt - 2);
            const char* a1 = cA + (size_t)(t + 1) * kstep;
            const char* a2 = last ? nA : cA + (size_t)(t + 2) * kstep; const char* b2 = last ? nB : cB + (size_t)(t + 2) * kstep;
            const char* a3 = a2 + kstep; const char* b3 = b2 + kstep;
            if (last && has_next) S.a_ready(nxt);
            if constexpr (SP2) {
            PG8_LDB(B0, 0, 0); PG8_LDB(B1, 0, 1); PG8_SCHED; PG8_LDA(At, 0, 0); PG8_STAGE(PG8_SA(1, 1), a1 + hstep, voffA);
            PG8_WAIT_V(8); PG8_WAIT_L(0); PG8_BAR; PG8_MMA(0, 0, At, B0); PG8_MMA(0, 1, At, B1); PG8_BAR; PG8_SCHED;
            if (!halfm) PG8_LDA(At, 0, 1); PG8_STAGE(PG8_SB(0, 0), b2, voffB); PG8_STAGE(PG8_SB(0, 1), b2 + hstep, voffB); PG8_STAGE(PG8_SA(0, 0), a2, voffA);
            PG8_WAIT_V(8); PG8_WAIT_L(0); PG8_BAR; if (!halfm) { PG8_MMA(1, 0, At, B0); PG8_MMA(1, 1, At, B1); } PG8_BAR; PG8_SCHED;
            PG8_LDB(B0, 1, 0); PG8_LDB(B1, 1, 1); PG8_SCHED; PG8_LDA(At, 1, 0); PG8_STAGE(PG8_SA(0, 1), a2 + hstep, voffA);
            PG8_WAIT_V(8); PG8_WAIT_L(0); PG8_BAR; PG8_MMA(0, 0, At, B0); PG8_MMA(0, 1, At, B1); PG8_BAR; PG8_SCHED;
            if (!halfm) PG8_LDA(At, 1, 1); PG8_STAGE(PG8_SB(1, 0), b3, voffB); PG8_STAGE(PG8_SB(1, 1), b3 + hstep, voffB); PG8_STAGE(PG8_SA(1, 0), a3, voffA);
            PG8_WAIT_V(8); PG8_WAIT_L(0); PG8_BAR; if (!halfm) { PG8_MMA(1, 0, At, B0); PG8_MMA(1, 1, At, B1); } PG8_BAR; PG8_SCHED;
            } else {
            PG8_LDB(B0, 0, 0); PG8_SCHED; PG8_LDA(At, 0, 0); PG8_STAGE(PG8_SA(1, 1), a1 + hstep, voffA);
            PG8_WAIT_L(8); PG8_BAR; PG8_WAIT_L(0); PG8_MMA(0, 0, At, B0); PG8_BAR; PG8_SCHED;
            PG8_LDB(B1, 0, 1); PG8_STAGE(PG8_SB(0, 0), b2, voffB);
            PG8_BAR; PG8_WAIT_L(0); PG8_MMA(0, 1, At, B1); PG8_BAR;
            PG8_LDA(At, 0, 1); PG8_STAGE(PG8_SA(0, 0), a2, voffA);
            PG8_BAR; PG8_WAIT_L(0); PG8_MMA(1, 0, At, B0); PG8_BAR; PG8_SCHED;
            PG8_STAGE(PG8_SB(0, 1), b2 + hstep, voffB);
            PG8_WAIT_V(6); PG8_BAR; PG8_MMA(1, 1, At, B1); PG8_BAR;
            PG8_LDB(B0, 1, 0); PG8_SCHED; PG8_LDA(At, 1, 0); PG8_STAGE(PG8_SA(0, 1), a2 + hstep, voffA);
            PG8_WAIT_L(8); PG8_BAR; PG8_WAIT_L(0); PG8_MMA(0, 0, At, B0); PG8_BAR; PG8_SCHED;
            PG8_LDB(B1, 1, 1); PG8_STAGE(PG8_SB(1, 0), b3, voffB);
            PG8_BAR; PG8_WAIT_L(0); PG8_MMA(0, 1, At, B1); PG8_BAR;
            PG8_LDA(At, 1, 1); PG8_STAGE(PG8_SA(1, 0), a3, voffA);
            PG8_BAR; PG8_WAIT_L(0); PG8_MMA(1, 0, At, B0); PG8_BAR; PG8_SCHED;
            PG8_STAGE(PG8_SB(1, 1), b3 + hstep, voffB);
            PG8_WAIT_V(6); PG8_BAR; PG8_MMA(1, 1, At, B1); PG8_BAR;
            }
        }
        if constexpr (ALIGN_EPI) { if (wr == 0) PG8_BAR; }
        if constexpr (!Epi::AFTER_DRAIN) { const int t_ = tid_opaque(), w_ = __builtin_amdgcn_readfirstlane(t_ >> 6), l_ = t_ & 63;
            E(acc, cur, w_ >> 2, w_ & 3, l_ & 15, l_ >> 4); S.done(cur); }
        if (!has_next) break;
#pragma unroll
        for (int a = 0; a < 2; ++a)
#pragma unroll
            for (int b = 0; b < 2; ++b)
#pragma unroll
                for (int m = 0; m < 4; ++m)
#pragma unroll
                    for (int n = 0; n < 2; ++n) acc[a][b][m][n] = (f32x4){0.f, 0.f, 0.f, 0.f};
        cur = nxt; cA = nA; cB = nB; nt = cur.nt; ++ui;
        if constexpr (ALIGN_EPI) { if (wr == 1) PG8_BAR; }
    }
    PG8_WAIT_V(0);
    if constexpr (!ALIGN_EPI) { if (wr == 0) PG8_BAR; }
    PG8_BAR;
    if constexpr (Epi::AFTER_DRAIN) { E.fused(acc, cur, wr, wc, fr, fq, lds, wid, lane); S.done(cur); }
#undef PG8_SA
#undef PG8_SB
#undef PG8_STAGE
#undef PG8_LDA
#undef PG8_LDB
#undef PG8_MMA
#undef PG8_WAIT_V
#undef PG8_WAIT_L
#undef PG8_BAR
#undef PG8_SCHED
}
}
constexpr size_t WB_AB = 2 * MiB, WB_OUTAB = 8 * MiB, WB_FFI0 = 10 * MiB, WB_FFO0 = 21 * MiB, WB_INC = 27 * MiB, WB_OUTC = 30 * MiB, WB_FFI1 = 32 * MiB, WB_FFO1 = 43 * MiB;
static_assert(WB_FFO1 + (size_t)DM * DFF * 2 <= WS_XN && WB_AB + (size_t)ABMAIN * DM * 2 <= WB_OUTAB && WB_FFI0 + (size_t)2 * DFF * DM * 2 <= WB_FFO0 && WB_FFO0 + (size_t)DM * DFF * 2 <= WB_INC &&
              WB_INC + (size_t)CIN * DM * 2 <= WB_OUTC && WB_FFI1 + (size_t)2 * DFF * DM * 2 <= WB_FFO1, "weight copy map");

typedef unsigned v4u __attribute__((ext_vector_type(4)));
typedef unsigned v2u __attribute__((ext_vector_type(2)));
typedef float f32x4 __attribute__((ext_vector_type(4)));
__device__ __forceinline__ unsigned pk2(float lo, float hi) { return (unsigned)f2bf(lo) | ((unsigned)f2bf(hi) << 16); }
__device__ __forceinline__ float fsigmoid(float x) { return __builtin_amdgcn_rcpf(1.0f + __builtin_amdgcn_exp2f(-1.4426950408889634f * x)); }

HD_FN int kperm_dim(int c) { const int wc = c >> 5, fq = (c >> 3) & 3, n = (c >> 2) & 1, e = c & 3; return 64 * (wc >> 1) + 32 * n + 16 * (wc & 1) + 4 * fq + e; }
HD_FN int kperm_col(int d) { const int A = d >> 6, n = (d >> 5) & 1, B = (d >> 4) & 1, fq = (d >> 2) & 3, e = d & 3; return 32 * (2 * A + B) + 8 * fq + 4 * n + e; }
struct CvtItem { const float* src; bf16_t* WT; int K, ldw, k0, drow, kmode, c; };
__device__ __forceinline__ void cvt_item_load(const CvtItem& it, f32x4 (&tv)[8], int lane) {
    const int rr = lane >> 3, cg = (lane & 7) * 4; const float* s = it.src + (size_t)rr * it.ldw + cg;
#pragma unroll
    for (int i = 0; i < 8; ++i) tv[i] = *(const f32x4*)(s + (size_t)(8 * i) * it.ldw);
}
__device__ __forceinline__ void cvt_item_stage(const f32x4 (&tv)[8], LAS float* scr, int lane) {
    const int rr = lane >> 3, cg = (lane & 7) * 4;
#pragma unroll
    for (int i = 0; i < 8; ++i) { LAS float* d = scr + (8 * i + rr) * 33 + cg; d[0] = tv[i][0]; d[1] = tv[i][1]; d[2] = tv[i][2]; d[3] = tv[i][3]; }
    asm volatile("s_waitcnt lgkmcnt(0)" ::: "memory");
}
__device__ __forceinline__ void cvt_item_finish(const CvtItem& it, LAS float* scr, int lane) {
    const int c = lane & 7;
#pragma unroll
    for (int j = 0; j < 4; ++j) { const int n = (lane >> 3) + 8 * j; const LAS float* s = scr + (8 * c) * 33 + n;
        v4u o; o.x = pk2(s[0 * 33], s[1 * 33]); o.y = pk2(s[2 * 33], s[3 * 33]); o.z = pk2(s[4 * 33], s[5 * 33]); o.w = pk2(s[6 * 33], s[7 * 33]);
        const int dr = it.kmode ? (it.drow + kperm_col(((it.c + n) & 127))) : (it.drow + n);
        *(GAS v4u*)(it.WT + (size_t)dr * it.K + it.k0 + 8 * c) = o; }
    asm volatile("s_waitcnt lgkmcnt(0)" ::: "memory");
}
struct CvtJob { const float* W; bf16_t* WT; int K, ldw, c0, ncols, mode, Hn, dbase; };
constexpr __host__ __device__ int cvt_items(int K, int ncols) { return (K / 64) * (ncols / 32); }
__device__ __forceinline__ void cvt_decode(const CvtJob& j, int item, CvtItem& it) {
    const int nblk = j.ncols / 32, kb = item / nblk, nb = item % nblk; const int c = j.c0 + 32 * nb;
    int drow; if (j.mode == 0) drow = j.dbase + 32 * nb; else if (j.mode == 2) drow = j.dbase + ((32 * nb) & ~127); else { const int cc = c < j.Hn ? c : c - j.Hn; drow = 256 * (cc / 128) + (cc % 128) + (c < j.Hn ? 0 : 128); }
    it.src = j.W + (size_t)(64 * kb) * j.ldw + c; it.WT = j.WT; it.K = j.K; it.ldw = j.ldw; it.k0 = 64 * kb; it.drow = drow; it.kmode = (j.mode == 2); it.c = c;
}
template <unsigned MASK> __device__ __forceinline__ void p0_weights(const Params& p, LAS unsigned char* lds, int vcu, int G) {
    const int tid_ = tid_opaque(); const int lane = tid_ & 63, wave = __builtin_amdgcn_readfirstlane(tid_ >> 6);
    __syncthreads();
    LAS float* scr = (LAS float*)(lds + wave * 16384);
    const int gw = vcu * NWAVES + wave, NGW = G * NWAVES;
    constexpr int NI[11] = {cvt_items(DM, 2 * CCH), cvt_items(DM, 4 * MW), cvt_items(DM, DM), cvt_items(DM, 2 * DFF), cvt_items(DFF, DM), cvt_items(DM, NQ * HDIM), cvt_items(DM, NKV * HDIM), cvt_items(DM, NKV * HDIM),
                            cvt_items(DM, DM), cvt_items(DM, 2 * DFF), cvt_items(DFF, DM)};
    int total = 0;
#pragma unroll
    for (int jj = 0; jj < 11; ++jj) if ((MASK >> jj) & 1u) total += NI[jj];
    auto decode = [&](int g, CvtItem& it) {
        CvtJob j{}; int base = 0, loc = 0;
#define CVT_PICK(JJ, ...) if ((MASK >> JJ) & 1u) { if (g >= base) { j = CvtJob{__VA_ARGS__}; loc = g - base; } base += NI[JJ]; }
        CVT_PICK(0, p.winab, (bf16_t*)(p.ws + WB_AB), DM, ABIN, 0, 2 * CCH, 1, CCH, 0)
        CVT_PICK(1, p.winab, (bf16_t*)(p.ws + WB_AB), DM, ABIN, 2 * CCH, 4 * MW, 0, 0, 2 * CCH)
        CVT_PICK(2, p.woutab, (bf16_t*)(p.ws + WB_OUTAB), DM, DM, 0, DM, 0, 0, 0)
        CVT_PICK(3, p.wffi, (bf16_t*)(p.ws + WB_FFI0), DM, 2 * DFF, 0, 2 * DFF, 1, DFF, 0)
        CVT_PICK(4, p.wffo, (bf16_t*)(p.ws + WB_FFO0), DFF, DM, 0, DM, 0, 0, 0)
        CVT_PICK(5, p.winc, (bf16_t*)(p.ws + WB_INC), DM, CIN, 0, NQ * HDIM, 0, 0, 0)
        CVT_PICK(6, p.winc, (bf16_t*)(p.ws + WB_INC), DM, CIN, NQ * HDIM, NKV * HDIM, 2, 0, NQ * HDIM)
        CVT_PICK(7, p.winc, (bf16_t*)(p.ws + WB_INC), DM, CIN, (NQ + NKV) * HDIM, NKV * HDIM, 0, 0, (NQ + NKV) * HDIM)
        CVT_PICK(8, p.woutc, (bf16_t*)(p.ws + WB_OUTC), DM, DM, 0, DM, 0, 0, 0)
        CVT_PICK(9, p.wffi + (size_t)DM * 2 * DFF, (bf16_t*)(p.ws + WB_FFI1), DM, 2 * DFF, 0, 2 * DFF, 1, DFF, 0)
        CVT_PICK(10, p.wffo + (size_t)DFF * DM, (bf16_t*)(p.ws + WB_FFO1), DFF, DM, 0, DM, 0, 0, 0)
#undef CVT_PICK
        cvt_decode(j, loc, it); };
    CvtItem ia, ib; f32x4 ta[8], tb[8]; int g = gw;
    if (g < total) { decode(g, ia); cvt_item_load(ia, ta, lane); }
    if (g + NGW < total) { decode(g + NGW, ib); cvt_item_load(ib, tb, lane); }
#pragma unroll 1
    while (g < total) {
        cvt_item_stage(ta, scr, lane); const CvtItem ca = ia;
        if (g + 2 * NGW < total) { decode(g + 2 * NGW, ia); cvt_item_load(ia, ta, lane); }
        cvt_item_finish(ca, scr, lane);
        g += NGW; if (g >= total) break;
        cvt_item_stage(tb, scr, lane); const CvtItem cb = ib;
        if (g + 2 * NGW < total) { decode(g + 2 * NGW, ib); cvt_item_load(ib, tb, lane); }
        cvt_item_finish(cb, scr, lane);
        g += NGW;
    }
}

struct EpiAB {
    static constexpr bool PERM = true, AFTER_DRAIN = false;
    bf16_t* upre; bf16_t* qkvo;
    __device__ __forceinline__ void operator()(const f32x4 (&acc)[2][2][4][2], const pg8::Unit& u, int wr, int wc, int fr, int fq) const {
        const int row0 = u.pm * 256 + wr * 64 + fr, lc = wc * 32 + 8 * fq;
        if (u.pn < 4) {
#pragma unroll
            for (int ai = 0; ai < 2; ++ai)
#pragma unroll
                for (int m = 0; m < 4; ++m) { const f32x4 a0 = acc[ai][0][m][0], a1 = acc[ai][0][m][1], g0 = acc[ai][1][m][0], g1 = acc[ai][1][m][1]; v4u w;
                    w.x = pg8::cvt_pk_bf16(a0[0] * fsigmoid(g0[0]), a0[1] * fsigmoid(g0[1])); w.y = pg8::cvt_pk_bf16(a0[2] * fsigmoid(g0[2]), a0[3] * fsigmoid(g0[3]));
                    w.z = pg8::cvt_pk_bf16(a1[0] * fsigmoid(g1[0]), a1[1] * fsigmoid(g1[1])); w.w = pg8::cvt_pk_bf16(a1[2] * fsigmoid(g1[2]), a1[3] * fsigmoid(g1[3]));
                    *(v4u*)(upre + (size_t)(row0 + ai * 128 + m * 16) * CCH + 128 * u.pn + lc) = w; }
        } else {
#pragma unroll
            for (int bj = 0; bj < 2; ++bj) { const int col = 256 * (u.pn - 4) + 128 * bj + lc; const int part = col / MW; const float sc = part == 1 ? 0.08838834764831845f : 1.0f;
#pragma unroll
                for (int ai = 0; ai < 2; ++ai)
#pragma unroll
                    for (int m = 0; m < 4; ++m) { f32x4 v0 = acc[ai][bj][m][0] * sc, v1 = acc[ai][bj][m][1] * sc;
                        if (part == 3) { v0 = (f32x4){fsigmoid(v0[0]), fsigmoid(v0[1]), fsigmoid(v0[2]), fsigmoid(v0[3])}; v1 = (f32x4){fsigmoid(v1[0]), fsigmoid(v1[1]), fsigmoid(v1[2]), fsigmoid(v1[3])}; }
                        v4u w; w.x = pg8::cvt_pk_bf16(v0[0], v0[1]); w.y = pg8::cvt_pk_bf16(v0[2], v0[3]); w.z = pg8::cvt_pk_bf16(v1[0], v1[1]); w.w = pg8::cvt_pk_bf16(v1[2], v1[3]);
                        *(v4u*)(qkvo + (size_t)(row0 + ai * 128 + m * 16) * (4 * MW) + col) = w; } }
        }
    }
};
static_assert(MDK == 128, "EpiAB hard-codes MDK^-0.5");
struct EpiRes {
    static constexpr bool PERM = true, AFTER_DRAIN = false;
    const float* xp; const float* xs;
    bf16_t* Y16; bf16_t* S; float* ssq; const float* mod_g; const float* mod_sc; const float* ng; const float* pmod_sc; const float* png;
    int from_input; int pad_;
    __device__ __forceinline__ void piece_load(int row, int col, f32x4& x0, f32x4& x1) const {
        const size_t off = (size_t)row * DM + col;
        if (from_input) { const float* xin = (row < MC ? xp : xs - (size_t)MC * DM) + off; x0 = *(const f32x4*)xin; x1 = *(const f32x4*)(xin + 4); }
        else { const v4u r = *(const v4u*)(S + off); x0 = (f32x4){__uint_as_float(r.x << 16), __uint_as_float(r.x & 0xffff0000u), __uint_as_float(r.y << 16), __uint_as_float(r.y & 0xffff0000u)};
            x1 = (f32x4){__uint_as_float(r.z << 16), __uint_as_float(r.z & 0xffff0000u), __uint_as_float(r.w << 16), __uint_as_float(r.w & 0xffff0000u)}; }
    }
    __device__ __forceinline__ static f32x4 rcp4(f32x4 a) { return (f32x4){__builtin_amdgcn_rcpf(a[0]), __builtin_amdgcn_rcpf(a[1]), __builtin_amdgcn_rcpf(a[2]), __builtin_amdgcn_rcpf(a[3])}; }
    __device__ __forceinline__ f32x4 scale_of(const float* g_, const float* sc_, int cls, int col) const { return *(const f32x4*)(g_ + col) * (*(const f32x4*)(sc_ + (size_t)cls * 6 * DM + col) + 1.0f); }
    __device__ __forceinline__ float piece(int row, int col, int cls, f32x4 v0, f32x4 v1, f32x4 x0, f32x4 x1) const {
        const float* gv = mod_g + (size_t)cls * 6 * DM + col; const size_t off = (size_t)row * DM + col;
        if (!from_input) { x0 *= rcp4(scale_of(png, pmod_sc, cls, col)); x1 *= rcp4(scale_of(png, pmod_sc, cls, col + 4)); }
        x0 += *(const f32x4*)gv * v0; x1 += *(const f32x4*)(gv + 4) * v1;
        if (ng) { const f32x4 t0 = x0 * scale_of(ng, mod_sc, cls, col), t1 = x1 * scale_of(ng, mod_sc, cls, col + 4);
            v4u q; q.x = pg8::cvt_pk_bf16(t0[0], t0[1]); q.y = pg8::cvt_pk_bf16(t0[2], t0[3]); q.z = pg8::cvt_pk_bf16(t1[0], t1[1]); q.w = pg8::cvt_pk_bf16(t1[2], t1[3]); *(v4u*)(S + off) = q; }
        else { v4u w; w.x = pg8::cvt_pk_bf16(x0[0], x0[1]); w.y = pg8::cvt_pk_bf16(x0[2], x0[3]); w.z = pg8::cvt_pk_bf16(x1[0], x1[1]); w.w = pg8::cvt_pk_bf16(x1[2], x1[3]); *(v4u*)(Y16 + off) = w; }
        return ((x0[0] * x0[0] + x0[1] * x0[1]) + (x0[2] * x0[2] + x0[3] * x0[3])) + ((x1[0] * x1[0] + x1[1] * x1[1]) + (x1[2] * x1[2] + x1[3] * x1[3]));
    }
    __device__ __forceinline__ void operator()(const f32x4 (&acc)[2][2][4][2], const pg8::Unit& u, int wr, int wc, int fr, int fq) const {
        const int row0 = u.pm * 256 + wr * 64 + fr + u.roff; const int cls = cls_of(u.pm * 256); const int colb = u.pn * 256 + wc * 32 + 8 * fq;
        const int aimax = (u.role == 9) ? 1 : 2;
        f32x4 g4[2][2], gs4[2][2], ig4[2][2];
#pragma unroll
        for (int bj = 0; bj < 2; ++bj)
#pragma unroll
            for (int n = 0; n < 2; ++n) { const int col = colb + bj * 128 + 4 * n; g4[bj][n] = *(const f32x4*)(mod_g + (size_t)cls * 6 * DM + col);
                gs4[bj][n] = ng ? scale_of(ng, mod_sc, cls, col) : (f32x4){0.f, 0.f, 0.f, 0.f};
                ig4[bj][n] = from_input ? (f32x4){1.f, 1.f, 1.f, 1.f} : rcp4(scale_of(png, pmod_sc, cls, col)); }
        if (!from_input && !ng) run_rows<4>(acc, row0, colb, g4, gs4, ig4, aimax);
        else run_rows<2>(acc, row0, colb, g4, gs4, ig4, aimax);
    }
    template <int MB> __device__ __forceinline__ void run_rows(const f32x4 (&acc)[2][2][4][2], int row0, int colb, const f32x4 (&g4)[2][2], const f32x4 (&gs4)[2][2], const f32x4 (&ig4)[2][2], int aimax) const {
#pragma unroll
        for (int ai = 0; ai < 2; ++ai)
#pragma unroll
            for (int mb = 0; mb < 4; mb += MB) { if (ai >= aimax) continue;
                f32x4 x[MB][2][2];
                if (from_input) {
#pragma unroll
                    for (int mm = 0; mm < MB; ++mm)
#pragma unroll
                        for (int bj = 0; bj < 2; ++bj) { const int row = row0 + ai * 128 + (mb + mm) * 16; const float* xin = (row < MC ? xp : xs - (size_t)MC * DM) + (size_t)row * DM + colb + bj * 128; x[mm][bj][0] = *(const f32x4*)xin; x[mm][bj][1] = *(const f32x4*)(xin + 4); }
                } else { v4u r[MB][2];
#pragma unroll
                    for (int mm = 0; mm < MB; ++mm)
#pragma unroll
                        for (int bj = 0; bj < 2; ++bj) r[mm][bj] = *(const v4u*)(S + (size_t)(row0 + ai * 128 + (mb + mm) * 16) * DM + colb + bj * 128);
#pragma unroll
                    for (int mm = 0; mm < MB; ++mm)
#pragma unroll
                        for (int bj = 0; bj < 2; ++bj) { const v4u q = r[mm][bj]; x[mm][bj][0] = (f32x4){__uint_as_float(q.x << 16), __uint_as_float(q.x & 0xffff0000u), __uint_as_float(q.y << 16), __uint_as_float(q.y & 0xffff0000u)} * ig4[bj][0];
                            x[mm][bj][1] = (f32x4){__uint_as_float(q.z << 16), __uint_as_float(q.z & 0xffff0000u), __uint_as_float(q.w << 16), __uint_as_float(q.w & 0xffff0000u)} * ig4[bj][1]; }
                }
#pragma unroll
                for (int mm = 0; mm < MB; ++mm) { const int m = mb + mm; const int row = row0 + ai * 128 + m * 16; float s = 0.f;
#pragma unroll
                    for (int bj = 0; bj < 2; ++bj) { const size_t off = (size_t)row * DM + colb + bj * 128;
                        const f32x4 x0 = x[mm][bj][0] + g4[bj][0] * acc[ai][bj][m][0], x1 = x[mm][bj][1] + g4[bj][1] * acc[ai][bj][m][1];
                        if (ng) { const f32x4 t0 = x0 * gs4[bj][0], t1 = x1 * gs4[bj][1]; v4u q; q.x = pg8::cvt_pk_bf16(t0[0], t0[1]); q.y = pg8::cvt_pk_bf16(t0[2], t0[3]); q.z = pg8::cvt_pk_bf16(t1[0], t1[1]); q.w = pg8::cvt_pk_bf16(t1[2], t1[3]); *(v4u*)(S + off) = q; }
                        else { v4u w; w.x = pg8::cvt_pk_bf16(x0[0], x0[1]); w.y = pg8::cvt_pk_bf16(x0[2], x0[3]); w.z = pg8::cvt_pk_bf16(x1[0], x1[1]); w.w = pg8::cvt_pk_bf16(x1[2], x1[3]); *(v4u*)(Y16 + off) = w; }
                        s += ((x0[0] * x0[0] + x0[1] * x0[1]) + (x0[2] * x0[2] + x0[3] * x0[3])) + ((x1[0] * x1[0] + x1[1] * x1[1]) + (x1[2] * x1[2] + x1[3] * x1[3])); }
                    s += __shfl_xor(s, 16); s += __shfl_xor(s, 32); if (fq_() == 0) atomicAdd(ssq + row, s); }
                asm volatile("" ::: "memory");
            }
    }
    __device__ __forceinline__ static int fq_() { return (lane_id() >> 4) & 3; }
};
struct EpiFfnIn {
    static constexpr bool PERM = true, AFTER_DRAIN = false;
    bf16_t* H; const float* ssq; const float* sw;
    __device__ __forceinline__ void operator()(const f32x4 (&acc)[2][2][4][2], const pg8::Unit& u, int wr, int wc, int fr, int fq) const {
        const int row0 = u.pm * 256 + wr * 64 + fr, lc = wc * 32 + 8 * fq; const int cls = cls_of(u.pm * 256); const int col = 128 * u.pn + lc;
        const float* swr = sw + (size_t)cls * 2 * DFF;
        const f32x4 sg0 = *(const f32x4*)(swr + col), sg1 = *(const f32x4*)(swr + col + 4), su0 = *(const f32x4*)(swr + DFF + col), su1 = *(const f32x4*)(swr + DFF + col + 4);
#pragma unroll
        for (int ai = 0; ai < 2; ++ai)
#pragma unroll
            for (int m = 0; m < 4; ++m) { const int row = row0 + ai * 128 + m * 16; const float rs = __builtin_amdgcn_rsqf(ssq[row] * (1.0f / DM) + EPSF);
                const f32x4 a0 = acc[ai][0][m][0] * rs + sg0, a1 = acc[ai][0][m][1] * rs + sg1, b0 = acc[ai][1][m][0] * rs + su0, b1 = acc[ai][1][m][1] * rs + su1; v4u w;
                w.x = pg8::cvt_pk_bf16(a0[0] * fsigmoid(a0[0]) * b0[0], a0[1] * fsigmoid(a0[1]) * b0[1]); w.y = pg8::cvt_pk_bf16(a0[2] * fsigmoid(a0[2]) * b0[2], a0[3] * fsigmoid(a0[3]) * b0[3]);
                w.z = pg8::cvt_pk_bf16(a1[0] * fsigmoid(a1[0]) * b1[0], a1[1] * fsigmoid(a1[1]) * b1[1]); w.w = pg8::cvt_pk_bf16(a1[2] * fsigmoid(a1[2]) * b1[2], a1[3] * fsigmoid(a1[3]) * b1[3]);
                *(v4u*)(H + (size_t)row * DFF + col) = w; }
    }
};
struct EpiQkv {
    static constexpr bool PERM = true, AFTER_DRAIN = false;
    bf16_t* qraw; bf16_t* ctxk; bf16_t* latk; bf16_t* ctxv; bf16_t* latv; float* outk; float* outv; const float* ssq; const float* sw; const float* kgain; LAS float* xk;
    __device__ __forceinline__ void operator()(const f32x4 (&acc)[2][2][4][2], const pg8::Unit& u, int wr, int wc, int fr, int fq) const {
        const int row0 = u.pm * 256 + wr * 64 + fr, lc = wc * 32 + 8 * fq; const int cls = cls_of(u.pm * 256); const float* swr = sw + (size_t)cls * CIN;
        float rs[2][4];
#pragma unroll
        for (int ai = 0; ai < 2; ++ai)
#pragma unroll
            for (int m = 0; m < 4; ++m) rs[ai][m] = __builtin_amdgcn_rsqf(ssq[row0 + ai * 128 + m * 16] * (1.0f / DM) + EPSF);
        if (u.pn == NQ * HDIM / 256) {
            const int dA = 64 * (wc >> 1) + 16 * (wc & 1) + 4 * fq; const bool lat = u.pm * 256 >= MC;
            const float* sk = swr + NQ * HDIM + dA;
#pragma unroll
            for (int ai = 0; ai < 2; ++ai)
#pragma unroll
                for (int m = 0; m < 4; ++m)
#pragma unroll
                    for (int bj = 0; bj < 2; ++bj) { const f32x4 v0 = acc[ai][bj][m][0] * rs[ai][m] + *(const f32x4*)(sk + 128 * bj), v1 = acc[ai][bj][m][1] * rs[ai][m] + *(const f32x4*)(sk + 128 * bj + 32);
                        float q = ((v0[0] * v0[0] + v0[1] * v0[1]) + (v0[2] * v0[2] + v0[3] * v0[3])) + ((v1[0] * v1[0] + v1[1] * v1[1]) + (v1[2] * v1[2] + v1[3] * v1[3]));
                        q += __shfl_xor(q, 16); q += __shfl_xor(q, 32);
                        if (fq == 0) xk[(ai * 128 + wr * 64 + m * 16 + fr) * 8 + bj * 4 + wc] = q; }
            asm volatile("s_waitcnt lgkmcnt(0)" ::: "memory"); __builtin_amdgcn_s_barrier(); asm volatile("" ::: "memory");
            const f32x4 g0 = *(const f32x4*)(kgain + dA), g1 = *(const f32x4*)(kgain + dA + 32);
            const float fb = (float)(16 * (wc & 1) + 4 * fq);
#pragma unroll
            for (int ai = 0; ai < 2; ++ai)
#pragma unroll
                for (int m = 0; m < 4; ++m) { const int rl = ai * 128 + wr * 64 + m * 16 + fr, row = u.pm * 256 + rl;
                    f32x4 cs = {1.f, 1.f, 1.f, 1.f}, sn = {0.f, 0.f, 0.f, 0.f};
                    if (lat) { const int sp = (row - MC) % LSEQ; const float pos = (float)((wc >> 1) == 0 ? sp / GRIDW : sp % GRIDW);
#pragma unroll
                        for (int e = 0; e < 4; ++e) { const float ang = pos * __builtin_amdgcn_exp2f(-(fb + (float)e) * (13.287712379549449f / 32.0f)); cs[e] = __cosf(ang); sn[e] = __sinf(ang); } }
#pragma unroll
                    for (int bj = 0; bj < 2; ++bj) { const LAS float* xq = xk + rl * 8 + bj * 4; const float rsk = __builtin_amdgcn_rsqf(((xq[0] + xq[1]) + (xq[2] + xq[3])) * (1.0f / HDIM) + EPSF);
                        const f32x4 a = (acc[ai][bj][m][0] * rs[ai][m] + *(const f32x4*)(sk + 128 * bj)) * rsk * g0, b = (acc[ai][bj][m][1] * rs[ai][m] + *(const f32x4*)(sk + 128 * bj + 32)) * rsk * g1;
                        const f32x4 y1 = a * cs - b * sn, y2 = a * sn + b * cs;
                        v2u w1, w2; w1.x = pg8::cvt_pk_bf16(y1[0], y1[1]); w1.y = pg8::cvt_pk_bf16(y1[2], y1[3]); w2.x = pg8::cvt_pk_bf16(y2[0], y2[1]); w2.y = pg8::cvt_pk_bf16(y2[2], y2[3]);
                        if (!lat) { bf16_t* K = ctxk + (size_t)row * (NKV * HDIM) + 128 * bj + dA; *(v2u*)K = w1; *(v2u*)(K + 32) = w2; float* o = outk + (size_t)row * (NKV * HDIM) + 128 * bj + dA; *(f32x4*)o = y1; *(f32x4*)(o + 32) = y2; }
                        else { const int b_ = (row - MC) / LSEQ, s_ = (row - MC) % LSEQ; bf16_t* K = latk + ((size_t)b_ * SKVL + s_) * (NKV * HDIM) + 128 * bj + dA; *(v2u*)K = w1; *(v2u*)(K + 32) = w2; } } }
            asm volatile("s_waitcnt lgkmcnt(0)" ::: "memory"); __builtin_amdgcn_s_barrier(); asm volatile("" ::: "memory");
            return;
        }
#pragma unroll
        for (int bj = 0; bj < 2; ++bj) { const int col = 256 * u.pn + 128 * bj + lc; const f32x4 s0 = *(const f32x4*)(swr + col), s1 = *(const f32x4*)(swr + col + 4);
#pragma unroll
            for (int ai = 0; ai < 2; ++ai)
#pragma unroll
                for (int m = 0; m < 4; ++m) { const int row = row0 + ai * 128 + m * 16; const f32x4 v0 = acc[ai][bj][m][0] * rs[ai][m] + s0, v1 = acc[ai][bj][m][1] * rs[ai][m] + s1;
                    v4u w; w.x = pg8::cvt_pk_bf16(v0[0], v0[1]); w.y = pg8::cvt_pk_bf16(v0[2], v0[3]); w.z = pg8::cvt_pk_bf16(v1[0], v1[1]); w.w = pg8::cvt_pk_bf16(v1[2], v1[3]);
                    if (u.pn < NQ * HDIM / 256) *(v4u*)(qraw + (size_t)row * (NQ * HDIM) + col) = w;
                    else { const int c2 = col - (NQ + NKV) * HDIM;
                        if (row < MC) { *(v4u*)(ctxv + (size_t)row * (NKV * HDIM) + c2) = w; float* o = outv + (size_t)row * (NKV * HDIM) + c2; *(f32x4*)o = v0; *(f32x4*)(o + 4) = v1; }
                        else { const int b = (row - MC) / LSEQ, s = (row - MC) % LSEQ; *(v4u*)(latv + ((size_t)b * SKVL + s) * (NKV * HDIM) + c2) = w; } } } }
    }
};
static_assert(NKV * HDIM == 256 && (NQ * HDIM) % 256 == 0, "EpiQkv tile mapping");

constexpr int CW_SPLIT = 8192;
constexpr size_t SLAB_BYTES = (size_t)64 * 4 * 16 * 512 * 16;
struct RoundZeroOrder : pg8::StaticOrder {
    bool split;
    __device__ void init(int M, int N, int K, int G_, int c_) { pg8::StaticOrder::init(M, N, K, G_, c_); split = (G == 256 && nwg > 256 && nwg <= 320 && ntK >= 8); }
    __device__ bool next(int i, pg8::Unit& u) const { if (split && i > 0) return false; return pg8::StaticOrder::next(i, u); }
};
struct QuarterOrder : pg8::StaticOrder {
    __device__ bool next(int i, pg8::Unit& u) const {
        if (i > 0) return false; const int L = 256 + (c >> 2), q = c & 3; if (L >= nwg) return false;
        map(L, u); const int base = (ntK / 8) * 2, rem = (ntK - 4 * base) / 2;
        int k0 = 0; for (int j = 0; j < q; ++j) k0 += base + (j < rem ? 2 : 0);
        u.k0 = k0; u.nt = base + (q < rem ? 2 : 0); u.role = 1 + q; u.slot = c >> 2; u.roff = 0; return true;
    }
};
struct EpiPartial {
    static constexpr bool PERM = true, AFTER_DRAIN = false;
    unsigned char* slab; unsigned* cnt;
    __device__ __forceinline__ void operator()(const f32x4 (&acc)[2][2][4][2], const pg8::Unit& u, int wr, int wc, int fr, int fq) const {
        int tid = (wr * 4 + wc) * 64 + fq * 16 + fr; asm volatile("" : "+v"(tid));
        unsigned char* dst = slab + ((size_t)u.slot * 4 + (u.role - 1)) * (16 * 512 * 16) + (size_t)tid * 16;
#pragma unroll
        for (int ai = 0; ai < 2; ++ai)
#pragma unroll
            for (int bj = 0; bj < 2; ++bj)
#pragma unroll
                for (int m = 0; m < 4; ++m) { const f32x4 a = acc[ai][bj][m][0], b = acc[ai][bj][m][1]; v4u w;
                    w.x = pg8::cvt_pk_bf16(a[0], a[1]); w.y = pg8::cvt_pk_bf16(a[2], a[3]); w.z = pg8::cvt_pk_bf16(b[0], b[1]); w.w = pg8::cvt_pk_bf16(b[2], b[3]);
                    asm volatile("global_store_dwordx4 %0, %1, off sc1\n\ts_nop 1" :: "v"(dst), "v"(w) : "memory");
                    dst += 512 * 16; asm volatile("" : "+v"(dst)); }
        asm volatile("s_waitcnt vmcnt(0)" ::: "memory");
        if (fr == 0 && fq == 0) __hip_atomic_fetch_add(cnt + (size_t)u.slot * 64, 1u, __ATOMIC_RELAXED, __HIP_MEMORY_SCOPE_AGENT);
    }
};
__device__ __forceinline__ void tail_reduce(const EpiRes& E, const unsigned char* slab, unsigned* cnt, int G, int bx, int nN, int nM) {
    pg8::StaticOrder S; S.nM = nM; S.nN = nN; S.nwg = nM * nN; S.G = G; S.c = bx; S.ntK = 0;
    const int L = 256 + (bx >> 2), q = bx & 3; if (L >= S.nwg) return;
    pg8::Unit u; S.map(L, u); const int slot = bx >> 2, ai = q >> 1, bj = q & 1;
    const int tid = tid_opaque(), wid = tid >> 6, lane = tid & 63, wr = wid >> 2, wc = wid & 3, fr = lane & 15, fq = lane >> 4;
    const int row0 = u.pm * 256 + ai * 128 + wr * 64 + fr; const int cls = cls_of(u.pm * 256); const int col = u.pn * 256 + bj * 128 + wc * 32 + 8 * fq;
    f32x4 xr[4][2];
#pragma unroll
    for (int m = 0; m < 4; ++m) E.piece_load(row0 + m * 16, col, xr[m][0], xr[m][1]);
    unsigned* c = cnt + (size_t)slot * 64; unsigned spins = 0;
    while ((unsigned)__builtin_amdgcn_readfirstlane(__hip_atomic_load(c, __ATOMIC_RELAXED, __HIP_MEMORY_SCOPE_AGENT)) < 32u) { __builtin_amdgcn_s_sleep(2); if (++spins > (1u << 22)) break; }
    __builtin_amdgcn_fence(__ATOMIC_ACQUIRE, "agent");
    const unsigned char* base = slab + (size_t)slot * 4 * (16 * 512 * 16) + (size_t)tid * 16;
    v4u w[4][4];
#pragma unroll
    for (int m = 0; m < 4; ++m)
#pragma unroll
        for (int r = 0; r < 4; ++r) w[m][r] = *(const v4u*)(base + (size_t)r * (16 * 512 * 16) + (size_t)((ai * 2 + bj) * 4 + m) * (512 * 16));
#pragma unroll
    for (int m = 0; m < 4; ++m) { const int row = row0 + m * 16; f32x4 v[2] = {(f32x4){0.f, 0.f, 0.f, 0.f}, (f32x4){0.f, 0.f, 0.f, 0.f}};
#pragma unroll
        for (int r = 0; r < 4; ++r) { const v4u x = w[m][r]; v[0] += (f32x4){__uint_as_float(x.x << 16), __uint_as_float(x.x & 0xffff0000u), __uint_as_float(x.y << 16), __uint_as_float(x.y & 0xffff0000u)};
            v[1] += (f32x4){__uint_as_float(x.z << 16), __uint_as_float(x.z & 0xffff0000u), __uint_as_float(x.w << 16), __uint_as_float(x.w & 0xffff0000u)}; }
        float sq = E.piece(row, col, cls, v[0], v[1], xr[m][0], xr[m][1]);
        sq += __shfl_xor(sq, 16); sq += __shfl_xor(sq, 32); if (fq == 0) atomicAdd(E.ssq + row, sq); }
}

struct WholeThenQuarterOrder : pg8::StaticOrder {
    bool split, qfirst;
    __device__ void init(int M, int N, int K, int G_, int c_) { pg8::StaticOrder::init(M, N, K, G_, c_); split = (G == 256 && nwg > 256 && nwg <= 320 && ntK >= 8); qfirst = split && nwg == 320 && (((c >> 2) & 1) != 0); }
    __device__ bool next(int i_, pg8::Unit& u) const {
        if (!split) return pg8::StaticOrder::next(i_, u);
        if (i_ > 1) return false; const int i = qfirst ? 1 - i_ : i_;
        if (i == 0) return pg8::StaticOrder::next(0, u);
        const int L = 256 + (c >> 2), q = c & 3; if (L >= nwg) return false;
        map(L, u); const int base = (ntK / 8) * 2, rem = (ntK - 4 * base) / 2;
        int k0 = 0; for (int j = 0; j < q; ++j) k0 += base + (j < rem ? 2 : 0);
        u.k0 = k0; u.nt = base + (q < rem ? 2 : 0); u.role = 1 + q; u.slot = c >> 2; u.roff = 0; return true;
    }
};
struct WholeThenHalfOrder : pg8::StaticOrder {
    bool halves;
    __device__ void init(int M, int N, int K, int G_, int c_) { pg8::StaticOrder::init(M, N, K, G_, c_); halves = (G == 256 && nwg == 320); }
    __device__ bool next(int i, pg8::Unit& u) const {
        if (!halves) return pg8::StaticOrder::next(i, u);
        if (i == 0) return pg8::StaticOrder::next(0, u);
        if (i > 1 || c >= 128) return false;
        map(256 + (c >> 1), u); u.k0 = 0; u.nt = ntK; u.role = 9; u.slot = c & 1; u.roff = 128 * (c & 1); return true;
    }
};
struct EpiResOrPartial {
    static constexpr bool PERM = true, AFTER_DRAIN = false;
    EpiRes res; EpiPartial part;
    __device__ __forceinline__ void operator()(const f32x4 (&acc)[2][2][4][2], const pg8::Unit& u, int wr, int wc, int fr, int fq) const {
        if (u.role == 0) res(acc, u, wr, wc, fr, fq); else part(acc, u, wr, wc, fr, fq);
    }
};
namespace att {
typedef unsigned short bf16;
constexpr int D = 128, NW = 8, QBLK = 32, KVBLK = 64; constexpr float SCALE = 0.088388347648318440f; constexpr float THR = 8.f; constexpr float THR8 = 2.f  ; constexpr int SDEPTH = 2;
constexpr int LDQ = NQ * HDIM, LDK = NKV * HDIM, LDO = DM;
constexpr size_t SHM_V = KVBLK * D  , SHM_K = KVBLK * D  , SHM_ATTN = 4 * SHM_V + 4 * SHM_K;
using bf16x8 = __attribute__((ext_vector_type(8))) short;
using s16x4  = __attribute__((ext_vector_type(4))) short;
using f32x16 = __attribute__((ext_vector_type(16))) float;
using f32x8  = __attribute__((ext_vector_type(8))) float;
using u32x4  = __attribute__((ext_vector_type(4))) unsigned;
#define KSWZ(row, colB) ((row) * 256 + ((colB) ^ (((row) & 7) << 4)))
#define SBAR() __builtin_amdgcn_sched_barrier(0)
__device__ __forceinline__ int crow(int r, int hi) { return (r & 3) + 8 * (r >> 2) + 4 * hi; }
__device__ __forceinline__ unsigned cvtpk(float lo, float hi) {
  unsigned r; asm volatile("v_cvt_pk_bf16_f32 %0, %1, %2" : "=v"(r) : "v"(lo), "v"(hi)); return r;
}
template <typename TIn> struct Stage;
template <> struct Stage<bf16>  { using T = bf16x8;
  __device__ static __forceinline__ T ld8(const bf16* p) { return *reinterpret_cast<const bf16x8*>(p); }
  __device__ static __forceinline__ bf16x8 tobf(T x) { return x; } };
__device__ __forceinline__ void partialSM(f32x16& p0, f32x16& p1, float& m_reg, float& mn, float& alpha) {
  constexpr float C = SCALE * 1.4426950408889634f;
  float pmax = p0[0]; for (int r = 1; r < 16; ++r) pmax = fmaxf(pmax, p0[r]); for (int r = 0; r < 16; ++r) pmax = fmaxf(pmax, p1[r]);
  { auto rr = __builtin_amdgcn_permlane32_swap(__float_as_uint(pmax), __float_as_uint(pmax), false, false);
    pmax = fmaxf(__uint_as_float(rr[0]), __uint_as_float(rr[1])); }
  if (__builtin_expect(__all(pmax - m_reg <= THR / SCALE), 1)) { mn = m_reg; alpha = 1.f; }
  else { mn = fmaxf(m_reg, pmax); alpha = __builtin_amdgcn_exp2f((m_reg - mn) * C); m_reg = mn; }
  float mnC = -mn * C;
  for (int r = 0; r < 16; ++r) p0[r] = fmaf(p0[r], C, mnC); for (int r = 0; r < 16; ++r) p1[r] = fmaf(p1[r], C, mnC);
  for (int r = 0; r < 16; ++r) p0[r] = __builtin_amdgcn_exp2f(p0[r]);
}
__device__ __forceinline__ void finishSM(f32x16& p0, f32x16& p1, float alpha, float& l_reg, bf16x8& pa0, bf16x8& pa1, bf16x8& pa2, bf16x8& pa3) {
  for (int r = 0; r < 16; ++r) p1[r] = __builtin_amdgcn_exp2f(p1[r]);
  float ps = 0; for (int r = 0; r < 16; ++r) ps += p0[r]; for (int r = 0; r < 16; ++r) ps += p1[r];
  { auto rr = __builtin_amdgcn_permlane32_swap(__float_as_uint(ps), __float_as_uint(ps), false, false);
    ps = __uint_as_float(rr[0]) + __uint_as_float(rr[1]); }
  l_reg = l_reg * alpha + ps;
#define PK4(P, BASE, OUT) do { unsigned a0 = cvtpk(P[BASE + 0], P[BASE + 1]), a1 = cvtpk(P[BASE + 2], P[BASE + 3]);   \
    unsigned b0 = cvtpk(P[BASE + 4], P[BASE + 5]), b1 = cvtpk(P[BASE + 6], P[BASE + 7]);                              \
    auto r0 = __builtin_amdgcn_permlane32_swap(a0, b0, false, false); auto r1 = __builtin_amdgcn_permlane32_swap(a1, b1, false, false); \
    u32x4 w = {r0[0], r1[0], r0[1], r1[1]}; OUT = *reinterpret_cast<bf16x8*>(&w); } while (0)
  PK4(p0, 0, pa0); PK4(p0, 8, pa1); PK4(p1, 0, pa2); PK4(p1, 8, pa3);
#undef PK4
}
__device__ __forceinline__ void qkt(f32x16& p0, f32x16& p1, const bf16* Ks, const bf16x8* qr, int r32, int hi) {
  p0 = f32x16{}; p1 = f32x16{};
  for (int d0 = 0; d0 < 8; ++d0) { int cb = (d0 * 16 + hi * 8) * 2;
    bf16x8 b0 = *reinterpret_cast<const bf16x8*>((const char*)Ks + KSWZ(r32, cb));
    bf16x8 b1 = *reinterpret_cast<const bf16x8*>((const char*)Ks + KSWZ(32 + r32, cb));
    p0 = __builtin_amdgcn_mfma_f32_32x32x16_bf16(b0, qr[d0], p0, 0, 0, 0);
    p1 = __builtin_amdgcn_mfma_f32_32x32x16_bf16(b1, qr[d0], p1, 0, 0, 0); }
}
using v8i = __attribute__((ext_vector_type(8))) int;
__device__ __forceinline__ int k8_off(int row, int p) { return row * 128 + ((((p) >> 4) ^ (row & 7)) << 4) + (p & 15); }
__device__ __forceinline__ unsigned pk4_fp8(float a, float b, float c, float d) { int w = __builtin_amdgcn_cvt_pk_fp8_f32(a, b, 0, false); return (unsigned)__builtin_amdgcn_cvt_pk_fp8_f32(c, d, w, true); }
__device__ __forceinline__ void k8_write(char* Kb, int row, int p, bf16x8 k) {
  unsigned lo = pk4_fp8(bf2f((unsigned short)k[0]), bf2f((unsigned short)k[1]), bf2f((unsigned short)k[2]), bf2f((unsigned short)k[3]));
  unsigned hi_ = pk4_fp8(bf2f((unsigned short)k[4]), bf2f((unsigned short)k[5]), bf2f((unsigned short)k[6]), bf2f((unsigned short)k[7]));
  *(unsigned long long*)(Kb + k8_off(row, p)) = ((unsigned long long)hi_ << 32) | lo;
}
__device__ __forceinline__ void qkt8(f32x16& p0, f32x16& p1, const char* Ks, const v8i* qa, int r32, int hi) {
  p0 = f32x16{}; p1 = f32x16{};
#pragma unroll
  for (int blk = 0; blk < 2; ++blk) { const int c = 4 * blk + 2 * hi;
    const u32x4 a0 = *(const u32x4*)(Ks + r32 * 128 + (((c) ^ (r32 & 7)) << 4)), a1 = *(const u32x4*)(Ks + r32 * 128 + (((c + 1) ^ (r32 & 7)) << 4));
    const u32x4 b0 = *(const u32x4*)(Ks + (32 + r32) * 128 + (((c) ^ (r32 & 7)) << 4)), b1 = *(const u32x4*)(Ks + (32 + r32) * 128 + (((c + 1) ^ (r32 & 7)) << 4));
    const v8i A0 = {(int)a0[0], (int)a0[1], (int)a0[2], (int)a0[3], (int)a1[0], (int)a1[1], (int)a1[2], (int)a1[3]};
    const v8i A1 = {(int)b0[0], (int)b0[1], (int)b0[2], (int)b0[3], (int)b1[0], (int)b1[1], (int)b1[2], (int)b1[3]};
    p0 = __builtin_amdgcn_mfma_scale_f32_32x32x64_f8f6f4(A0, qa[blk], p0, 0, 0, 0, 0x7F7F7F7F, 0, 0x7F7F7F7F);
    p1 = __builtin_amdgcn_mfma_scale_f32_32x32x64_f8f6f4(A1, qa[blk], p1, 0, 0, 0, 0x7F7F7F7F, 0, 0x7F7F7F7F); }
}
__device__ __forceinline__ void partialSM8(f32x16& p0, f32x16& p1, float& m_reg, float& mn, float& alpha) {
  constexpr float C = SCALE * 1.4426950408889634f;
  float pmax = p0[0]; for (int r = 1; r < 16; ++r) pmax = fmaxf(pmax, p0[r]); for (int r = 0; r < 16; ++r) pmax = fmaxf(pmax, p1[r]);
  { auto rr = __builtin_amdgcn_permlane32_swap(__float_as_uint(pmax), __float_as_uint(pmax), false, false);
    pmax = fmaxf(__uint_as_float(rr[0]), __uint_as_float(rr[1])); }
  if (__builtin_expect(__all(pmax - m_reg <= THR8 / SCALE), 1)) { mn = m_reg; alpha = 1.f; }
  else { mn = fmaxf(m_reg, pmax); alpha = __builtin_amdgcn_exp2f((m_reg - mn) * C); m_reg = mn; }
  float mnC = -mn * C + 5.0f;
  for (int r = 0; r < 16; ++r) p0[r] = fmaf(p0[r], C, mnC); for (int r = 0; r < 16; ++r) p1[r] = fmaf(p1[r], C, mnC);
  for (int r = 0; r < 16; ++r) p0[r] = __builtin_amdgcn_exp2f(p0[r]);
}
__device__ __forceinline__ void finishSM8(f32x16& p0, f32x16& p1, v8i& P8) {
  for (int r = 0; r < 16; ++r) p1[r] = __builtin_amdgcn_exp2f(p1[r]);
#pragma unroll
  for (int v = 0; v < 4; ++v) { P8[v] = (int)pk4_fp8(p0[4 * v], p0[4 * v + 1], p0[4 * v + 2], p0[4 * v + 3]); P8[4 + v] = (int)pk4_fp8(p1[4 * v], p1[4 * v + 1], p1[4 * v + 2], p1[4 * v + 3]); }
}
__device__ __forceinline__ int vt8_off(int d, int c) { return d * 64 + ((c ^ ((d >> 1) & 3)) << 4); }
__device__ __forceinline__ void pv8(f32x16* o, f32x16& ol, const char* Vt, v8i P8, int r32, int hi) {
  { const v8i ONES = {0x38383838, 0x38383838, 0x38383838, 0x38383838, 0x38383838, 0x38383838, 0x38383838, 0x38383838};
    ol = __builtin_amdgcn_mfma_scale_f32_32x32x64_f8f6f4(P8, ONES, ol, 0, 0, 0, 0x7F7F7F7F, 0, 0x7F7F7F7F); }
#pragma unroll
  for (int d0 = 0; d0 < 4; ++d0) { const int d = 32 * d0 + r32;
    const u32x4 b0 = *(const u32x4*)(Vt + vt8_off(d, 2 * hi)), b1 = *(const u32x4*)(Vt + vt8_off(d, 2 * hi + 1));
    const v8i B = {(int)b0[0], (int)b0[1], (int)b0[2], (int)b0[3], (int)b1[0], (int)b1[1], (int)b1[2], (int)b1[3]};
    o[d0] = __builtin_amdgcn_mfma_scale_f32_32x32x64_f8f6f4(P8, B, o[d0], 0, 0, 0, 0x7F7F7F7F, 0, 0x7F7F7F7F); }
}
__device__ __forceinline__ int v_st(int k, int c) { const int kk = (k & ~0xC) | ((k & 4) << 1) | ((k & 8) >> 1); return ((kk >> 3) * 4 + (c >> 5)) * 512 + ((kk & 7) * 32 + (c & 31)) * 2; }
__device__ __forceinline__ int v_rd_base(int lane) { return ((lane & 3) << 3) | (((lane >> 2) & 3) << 6) | (((lane >> 4) & 1) << 5) | (((lane >> 5) & 1) << 8); }
constexpr int v_rd_off(int d0, int ks, int half) { return d0 * 512 + ks * 4096 + half * 2048; }
template <int OFF> __device__ __forceinline__ s16x4 tr_read(int vb) {
  s16x4 r; asm volatile("ds_read_b64_tr_b16 %0, %1 offset:%2" : "=&v"(r) : "v"(vb), "i"(OFF) : "memory"); return r;
}
template <int D0> __device__ __forceinline__ void pv_one(f32x16& od, int vb, bf16x8 pa0, bf16x8 pa1, bf16x8 pa2, bf16x8 pa3) {
  const s16x4 l0 = tr_read<v_rd_off(D0, 0, 0)>(vb), h0 = tr_read<v_rd_off(D0, 0, 1)>(vb), l1 = tr_read<v_rd_off(D0, 1, 0)>(vb), h1 = tr_read<v_rd_off(D0, 1, 1)>(vb);
  const s16x4 l2 = tr_read<v_rd_off(D0, 2, 0)>(vb), h2 = tr_read<v_rd_off(D0, 2, 1)>(vb), l3 = tr_read<v_rd_off(D0, 3, 0)>(vb), h3 = tr_read<v_rd_off(D0, 3, 1)>(vb);
  asm volatile("s_waitcnt lgkmcnt(0)" ::: "memory"); SBAR();
#define PK(L, H) (bf16x8){L[0], L[1], L[2], L[3], H[0], H[1], H[2], H[3]}
  od = __builtin_amdgcn_mfma_f32_32x32x16_bf16(pa0, PK(l0, h0), od, 0, 0, 0);
  od = __builtin_amdgcn_mfma_f32_32x32x16_bf16(pa1, PK(l1, h1), od, 0, 0, 0);
  od = __builtin_amdgcn_mfma_f32_32x32x16_bf16(pa2, PK(l2, h2), od, 0, 0, 0);
  od = __builtin_amdgcn_mfma_f32_32x32x16_bf16(pa3, PK(l3, h3), od, 0, 0, 0);
#undef PK
}
__device__ __forceinline__ void pv_d0(f32x16* o, int vb, bf16x8 pa0, bf16x8 pa1, bf16x8 pa2, bf16x8 pa3) {
  pv_one<0>(o[0], vb, pa0, pa1, pa2, pa3); pv_one<1>(o[1], vb, pa0, pa1, pa2, pa3); pv_one<2>(o[2], vb, pa0, pa1, pa2, pa3); pv_one<3>(o[3], vb, pa0, pa1, pa2, pa3);
}

__device__ __forceinline__ void attn_dense_body(const bf16* __restrict__ Qb, const unsigned char* __restrict__ K8  , const unsigned char* __restrict__ VT  ,
                                                bf16* __restrict__ Ob, int seq, char* lds, const float* __restrict__ qgain, int spos0) {
  typedef bf16 TQ;
  using St = Stage<bf16>; using SQ = Stage<TQ>;
  const int tid = tid_opaque(), wid = tid >> 6, lane = tid & 63, r32 = lane & 31, hi = lane >> 5;
  char* V_lds = lds; char* K_lds = lds + 4 * SHM_V;
  float* ws = (float*)(lds + 132096) + wid * 64; float* li_l = ws; float* al_l = ws + 32;
  float m_reg = -1e30f; f32x16 o[4] = {}; f32x16 ol = {}; bf16x8 qr[8]; v8i qa[2];
  const TQ* Qw = Qb + (long)(wid * QBLK + r32) * LDQ + hi * 8;
#pragma unroll
  for (int d0 = 0; d0 < 8; ++d0) qr[d0] = SQ::tobf(SQ::ld8(Qw + d0 * 16));
  { float qf[8][8]; float ss = 0.f;
#pragma unroll
    for (int d0 = 0; d0 < 8; ++d0)
#pragma unroll
      for (int j = 0; j < 8; ++j) { qf[d0][j] = bf2f((unsigned short)qr[d0][j]); ss += qf[d0][j] * qf[d0][j]; }
    { auto rr = __builtin_amdgcn_permlane32_swap(__float_as_uint(ss), __float_as_uint(ss), false, false); ss = __uint_as_float(rr[0]) + __uint_as_float(rr[1]); }
    const float rsq = 1.0f / sqrtf(ss * (1.0f / D) + 1e-6f);
#pragma unroll
    for (int d0 = 0; d0 < 8; ++d0) { const float* gq = qgain + d0 * 16 + hi * 8; const f32x8 g8 = *reinterpret_cast<const f32x8*>(gq);
#pragma unroll
      for (int j = 0; j < 8; ++j) qf[d0][j] *= rsq * g8[j]; }
    if (spos0 >= 0) { const int sp = spos0 + wid * QBLK + r32; const float prow = (float)(sp / GRIDW), pcol = (float)(sp % GRIDW);
#pragma unroll
      for (int d0 = 0; d0 < 2; ++d0)
#pragma unroll
        for (int j = 0; j < 8; ++j) { const float inv = __builtin_amdgcn_exp2f(-(float)(16 * d0 + 8 * hi + j) * (13.287712379549449f / 32.0f));
          const float cr = __cosf(prow * inv), sr_ = __sinf(prow * inv), cc = __cosf(pcol * inv), sc_ = __sinf(pcol * inv);
          const float a = qf[d0][j], b2 = qf[d0 + 2][j]; qf[d0][j] = a * cr - b2 * sr_; qf[d0 + 2][j] = a * sr_ + b2 * cr;
          const float c = qf[4 + d0][j], e = qf[6 + d0][j]; qf[4 + d0][j] = c * cc - e * sc_; qf[6 + d0][j] = c * sc_ + e * cc; } }
#pragma unroll
    for (int blk = 0; blk < 2; ++blk)
#pragma unroll
      for (int g = 0; g < 4; ++g) { qa[blk][2 * g] = (int)pk4_fp8(qf[4 * blk + g][0], qf[4 * blk + g][1], qf[4 * blk + g][2], qf[4 * blk + g][3]); qa[blk][2 * g + 1] = (int)pk4_fp8(qf[4 * blk + g][4], qf[4 * blk + g][5], qf[4 * blk + g][6], qf[4 * blk + g][7]); } }
  const int kr = tid >> 3, kc = tid & 7; const unsigned char* K8d = K8 + (long)kr * D + 16 * kc; const int k8w = kr * 128 + ((kc ^ (kr & 7)) << 4);
  const int vd = tid >> 2, vc = tid & 3; const unsigned char* VTd = VT + (long)vd * seq + 16 * vc; const int vtw = vt8_off(vd, vc);
  struct { u32x4 vs, ks; } sr_;
#define SLOAD(k0) do { sr_.vs = *(const u32x4*)(VTd + (k0)); sr_.ks = *(const u32x4*)(K8d + (long)(k0) * D); } while (0)
#define SWRITE(b) do { *(u32x4*)(V_lds + (b) * SHM_V + vtw) = sr_.vs; *(u32x4*)(K_lds + (b) * SHM_K + k8w) = sr_.ks; } while (0)
#define RESC(a) do { if (__any((a) < 1.f)) { if (hi == 0) al_l[r32] = (a); asm volatile("s_waitcnt lgkmcnt(0)" ::: "memory"); \
    for (int r = 0; r < 16; ++r) { const float a_ = al_l[crow(r, hi)]; ol[r] *= a_; for (int d = 0; d < 4; ++d) o[d][r] *= a_; } } } while (0)
  f32x16 pA0, pA1, pB0, pB1; float mnA, mnB, alA, alB; v8i P8; const int NT = seq / KVBLK;
#define ATT_ITER(T_, BK_, BVP_, BW_, C0, C1, MNC, ALC, P0, P1, ALP, DO_WRITE, DO_LOAD) do { \
    SBAR(); qkt8(C0, C1, K_lds + (BK_) * SHM_K, qa, r32, hi); \
    finishSM8(P0, P1, P8); (void)(ALP); SBAR(); \
    if (DO_WRITE) SWRITE(BW_); \
    if (DO_LOAD) SLOAD(((T_) + 2) * KVBLK); SBAR(); \
    pv8(o, ol, V_lds + (BVP_) * SHM_V, P8, r32, hi); partialSM8(C0, C1, m_reg, MNC, ALC); \
    RESC(ALC); __syncthreads(); } while (0)
  SLOAD(0); SWRITE(0); SLOAD(KVBLK); SWRITE(1); SLOAD(2 * KVBLK); __syncthreads();
  qkt8(pA0, pA1, K_lds, qa, r32, hi); partialSM8(pA0, pA1, m_reg, mnA, alA);
  int t = 1;
  for (; t + 3 < NT; t += 4) {
    ATT_ITER(t,     1, 0, 2, pB0, pB1, mnB, alB, pA0, pA1, alA, true, true);
    ATT_ITER(t + 1, 2, 1, 3, pA0, pA1, mnA, alA, pB0, pB1, alB, true, true);
    ATT_ITER(t + 2, 3, 2, 0, pB0, pB1, mnB, alB, pA0, pA1, alA, true, true);
    ATT_ITER(t + 3, 0, 3, 1, pA0, pA1, mnA, alA, pB0, pB1, alB, true, true);
  }
  ATT_ITER(t,     1, 0, 2, pB0, pB1, mnB, alB, pA0, pA1, alA, true, true);
  ATT_ITER(t + 1, 2, 1, 3, pA0, pA1, mnA, alA, pB0, pB1, alB, true, false);
  ATT_ITER(t + 2, 3, 2, 0, pB0, pB1, mnB, alB, pA0, pA1, alA, false, false);
  finishSM8(pB0, pB1, P8); SBAR();
  pv8(o, ol, V_lds + 3 * SHM_V, P8, r32, hi);
#undef ATT_ITER
  float rli[16];
#pragma unroll
  for (int r = 0; r < 16; ++r) rli[r] = __builtin_amdgcn_rcpf(ol[r]);
  bf16* Ow = Ob + (long)(wid * QBLK) * LDO;
  bf16* Tst = (bf16*)((char*)K_lds + wid * 4096);
#pragma unroll
  for (int hb = 0; hb < 2; ++hb) {
#pragma unroll
    for (int r = 0; r < 16; ++r)
#pragma unroll
      for (int dd = 0; dd < 2; ++dd) Tst[crow(r, hi) * 64 + dd * 32 + r32] = f2bf(o[2 * hb + dd][r] * rli[r]);
    asm volatile("s_waitcnt lgkmcnt(0)" ::: "memory");
#pragma unroll
    for (int i = 0; i < 4; ++i) { const int c = lane + 64 * i;
      *(u32x4*)(Ow + (long)(c >> 3) * LDO + hb * 64 + (c & 7) * 8) = *(const u32x4*)((const char*)Tst + c * 16); }
    asm volatile("s_waitcnt lgkmcnt(0)" ::: "memory");
  }
#undef SLOAD
#undef SWRITE
#undef RESC
}
}
__device__ __forceinline__ void k8_tile(const att::bf16* src, unsigned char* dst, int lane) {
    att::bf16x8 v[16]; const int sc = (lane & 15) * 8, kp = 64 * (sc >> 6) + 32 * ((sc >> 3) & 1) + 8 * ((sc >> 4) & 3);
#pragma unroll
    for (int i = 0; i < 16; ++i) v[i] = *(const att::bf16x8*)(src + (size_t)(4 * i + (lane >> 4)) * (NKV * HDIM) + sc);
#pragma unroll
    for (int i = 0; i < 16; ++i) { const unsigned lo = att::pk4_fp8(bf2f((unsigned short)v[i][0]), bf2f((unsigned short)v[i][1]), bf2f((unsigned short)v[i][2]), bf2f((unsigned short)v[i][3]));
        const unsigned hi_ = att::pk4_fp8(bf2f((unsigned short)v[i][4]), bf2f((unsigned short)v[i][5]), bf2f((unsigned short)v[i][6]), bf2f((unsigned short)v[i][7]));
        __hip_atomic_store((unsigned long long*)(dst + (size_t)(4 * i + (lane >> 4)) * HDIM + kp), ((unsigned long long)hi_ << 32) | lo, __ATOMIC_RELAXED, __HIP_MEMORY_SCOPE_AGENT); }
}
__device__ __forceinline__ void vt8_tile(const att::bf16* src, unsigned char* dst, int ldd, char* T, int lane) {
    constexpr int RS = 136;
    att::bf16x8 v[16];
#pragma unroll
    for (int i = 0; i < 16; ++i) v[i] = *(const att::bf16x8*)(src + (size_t)(4 * i + (lane >> 4)) * (NKV * HDIM) + (lane & 15) * 8);
#pragma unroll
    for (int i = 0; i < 16; ++i) { const unsigned lo = att::pk4_fp8(bf2f((unsigned short)v[i][0]), bf2f((unsigned short)v[i][1]), bf2f((unsigned short)v[i][2]), bf2f((unsigned short)v[i][3]));
        const unsigned hi_ = att::pk4_fp8(bf2f((unsigned short)v[i][4]), bf2f((unsigned short)v[i][5]), bf2f((unsigned short)v[i][6]), bf2f((unsigned short)v[i][7]));
        *(unsigned long long*)(T + (4 * i + (lane >> 4)) * RS + (lane & 15) * 8) = ((unsigned long long)hi_ << 32) | lo; }
    asm volatile("s_waitcnt lgkmcnt(0)" ::: "memory");
#pragma unroll 4
    for (int j = 0; j < 32; ++j) { const int item = lane + 64 * j, g = item & 15, d = item >> 4;
        const unsigned char* tp = (const unsigned char*)T + (4 * g) * RS + d;
        const unsigned w = (unsigned)tp[0] | ((unsigned)tp[RS] << 8) | ((unsigned)tp[2 * RS] << 16) | ((unsigned)tp[3 * RS] << 24);
        const int pos = 32 * (g & 1) + 16 * (g >> 3) + 4 * ((g >> 1) & 3);
        __hip_atomic_store((unsigned*)(dst + (size_t)d * ldd + pos), w, __ATOMIC_RELAXED, __HIP_MEMORY_SCOPE_AGENT); }
}
constexpr int VT8_TL = SKVL / 64, VT8_TC = CSEQ / 64, VT8_NL = NLB * NKV * VT8_TL, VT8_NT = VT8_NL + NCB * NKV * VT8_TC;
__device__ __forceinline__ void vt8_do(const Params& p, int tl, char* T, int lane, int part = 0) {
    if (tl < VT8_NL) { const int grp = tl / VT8_TL, t = tl % VT8_TL, b = grp / NKV, kvh = grp % NKV;
        if (part != 2) vt8_tile((const att::bf16*)(p.ws + WS_LATV) + ((size_t)b * SKVL + 64 * t) * (NKV * HDIM) + kvh * HDIM, p.ws + WS_VT8L + (size_t)(grp * HDIM) * SKVL + 64 * t, SKVL, T, lane);
        if (part != 1) k8_tile((const att::bf16*)(p.ws + WS_LATK) + ((size_t)b * SKVL + 64 * t) * (NKV * HDIM) + kvh * HDIM, p.ws + WS_K8L + ((size_t)grp * SKVL + 64 * t) * HDIM, lane); }
    else { const int c = tl - VT8_NL, grp = c / VT8_TC, t = c % VT8_TC, b = grp / NKV, kvh = grp % NKV;
        if (part != 2) vt8_tile((const att::bf16*)(p.ws + WS_CTXV) + ((size_t)b * CSEQ + 64 * t) * (NKV * HDIM) + kvh * HDIM, p.ws + WS_VT8C + (size_t)(grp * HDIM) * CSEQ + 64 * t, CSEQ, T, lane);
        if (part != 1) k8_tile((const att::bf16*)(p.ws + WS_CTXK) + ((size_t)b * CSEQ + 64 * t) * (NKV * HDIM) + kvh * HDIM, p.ws + WS_K8C + ((size_t)grp * CSEQ + 64 * t) * HDIM, lane); }
}
__device__ __forceinline__ void attn_phase(const Params& p, unsigned char* lds, int vcu, int G) {
    constexpr int QB = 256, LQB = LSEQ / QB, CQB = CSEQ / QB;
    constexpr int NUL = NLB * NQ * LQB, NUC = NCB * NQ * CQB, NU = NUL + NUC;
    const att::bf16* QR = (const att::bf16*)(p.ws + WS_QRAW); att::bf16* OB = (att::bf16*)(p.ws + WS_O);
    for (int i = 0;; ++i) {
        int u;
        if (G == 256 && NUL == 512) { if (i < 2) u = (vcu >> 5) * 64 + (vcu & 31) + 32 * i; else u = NUL + vcu + (i - 2) * G; }
        else u = vcu + i * G;
        if (u >= NU) break;
        const att::bf16* Q; const unsigned char *K, *V; att::bf16* O; int seq; int spos0 = -1;
        if (u < NUL) { const int grp = u / (GRP * LQB), j = u % (GRP * LQB); const int b = grp / NKV, kvh = grp % NKV, g = j / LQB, qb = j % LQB, hq = kvh * GRP + g;
            const size_t row0 = (size_t)MC + (size_t)b * LSEQ + (size_t)qb * QB; spos0 = qb * QB;
            Q = QR + row0 * (NQ * HDIM) + hq * HDIM; O = OB + row0 * DM + hq * HDIM;
            K = p.ws + WS_K8L + (size_t)(b * NKV + kvh) * SKVL * HDIM; V = p.ws + WS_VT8L + (size_t)((b * NKV + kvh) * HDIM) * SKVL; seq = SKVL; }
        else { const int uc = u - NUL; const int b = uc / (NQ * CQB), r = uc % (NQ * CQB), hq = r / CQB, qb = r % CQB, kvh = hq / GRP;
            const size_t row0 = (size_t)b * CSEQ + (size_t)qb * QB;
            Q = QR + row0 * (NQ * HDIM) + hq * HDIM; O = OB + row0 * DM + hq * HDIM;
            K = p.ws + WS_K8C + (size_t)(b * NKV + kvh) * CSEQ * HDIM; V = p.ws + WS_VT8C + (size_t)((b * NKV + kvh) * HDIM) * CSEQ; seq = CSEQ; }
        __syncthreads();
        att::attn_dense_body(Q, K, V, O, seq, (char*)lds, p.qng, spos0);
    }
}
static_assert(SKVL % 256 == 0 && CSEQ % 256 == 0 && LSEQ % 256 == 0, "attention tiling (key tile count a multiple of 4: four rotating tile buffers)");
constexpr size_t WS_CST = 232 * MiB;
constexpr int NBLK = LSEQ / 256;
constexpr size_t WS_NST = WS_CST + (size_t)NLB * MH * 2 * NBLK * MDK * MDK * 2;
constexpr size_t WS_FTOT = WS_NST + (size_t)NLB * MH * 2 * NBLK * MDK * 4;
static_assert(WS_FTOT + (size_t)NLB * MH * 2 * NBLK * 4 <= WS_END && MDK == 128 && CSEQ == 256 && LSEQ % 256 == 0, "mLSTM fast path geometry");
namespace att {
constexpr int ML_OFF = 132096;
constexpr int ML_SC = ML_OFF + 6144;
constexpr int ML_N = ML_SC + 128;
constexpr int ML_LI = ML_N + 1024;
constexpr int ML_LI2 = ML_LI + 1024;
static_assert(ML_LI2 + 1024 <= LDS_BYTES, "mLSTM LDS map");
constexpr float L2E = 1.4426950408889634f;
using f32x4v = __attribute__((ext_vector_type(4))) float;


__device__ __forceinline__ void ml_gates(const Params& p, char* lds, int row0, int h, int tid) {
    float* A = (float*)(lds + ML_OFF); float* S = (float*)(lds + ML_SC);
    const int half = tid >> 8, t = tid & 255, tok = half ? 255 - t : t, lane = tid & 63, wv = (tid >> 6) & 3;
    const float* G = (const float*)(p.ws + WS_GATES) + (size_t)(row0 + tok) * NGATE + half * 8 + h;
    const float ig = G[0], lf = G[4];
    float v = lf;
#pragma unroll
    for (int off = 1; off < 64; off <<= 1) { const float u = lane_get(v, lane - off); if (lane >= off) v += u; }
    if (lane == 63) S[4 + half * 4 + wv] = v;
    __syncthreads();
    float pre = 0.f, tot = 0.f;
#pragma unroll
    for (int w = 0; w < 4; ++w) { const float x = S[4 + half * 4 + w]; if (w < wv) pre += x; tot += x; }
    const float P = v + pre, a = ig - P;
    A[(0 + half) * 256 + tok] = P * L2E; A[(2 + half) * 256 + tok] = a * L2E; A[(4 + half) * 256 + tok] = __builtin_amdgcn_exp2f(P * L2E);
    float mx = a;
    mx = fmaxf(mx, swz_xor<1>(mx)); mx = fmaxf(mx, swz_xor<2>(mx)); mx = fmaxf(mx, swz_xor<4>(mx)); mx = fmaxf(mx, swz_xor<8>(mx)); mx = fmaxf(mx, swz_xor<16>(mx)); mx = half_max(mx);
    if (lane == 0) S[12 + half * 4 + wv] = mx;
    if (t == 0) S[half] = tot;
    __syncthreads();
    if (t == 0) S[2 + half] = fmaxf(fmaxf(S[12 + half * 4], S[13 + half * 4]), fmaxf(S[14 + half * 4], S[15 + half * 4]));
    __syncthreads();
}
#define ML_PK(L, H) (bf16x8){L[0], L[1], L[2], L[3], H[0], H[1], H[2], H[3]}
__device__ __forceinline__ s16x4 tr_read_rt(int vb) { s16x4 r; asm volatile("ds_read_b64_tr_b16 %0, %1" : "=&v"(r) : "v"(vb) : "memory"); return r; }

__device__ __forceinline__ void st16_wt(void* ptr, u32x4 v) { asm volatile("global_store_dwordx4 %0, %1, off sc1\n\ts_nop 1" :: "v"(ptr), "v"(v) : "memory"); }
__device__ __forceinline__ void ml_passA_unit(const Params& p, char* lds, int sid, int h, int blk) {
    const int tid = tid_opaque(), wid = tid >> 6, lane = tid & 63, r32 = lane & 31, hi = lane >> 5;
    const bool isctx = sid < NCB; const int row0 = seq_base(sid) + 256 * blk;
    const bf16* QK = (const bf16*)(p.ws + WS_QKVO) + (size_t)row0 * (4 * MW) + h * MDK;
    const int sr = tid >> 4, sc8 = (tid & 15) * 8;
    bf16x8 tv[8], tk[8];
#pragma unroll
    for (int i = 0; i < 8; ++i) tv[i] = *(const bf16x8*)(QK + (size_t)(32 * i + sr) * (4 * MW) + 2 * MW + sc8);
#pragma unroll
    for (int i = 0; i < 8; ++i) tk[i] = *(const bf16x8*)(QK + (size_t)(32 * i + sr) * (4 * MW) + MW + sc8);
    __syncthreads();
    ml_gates(p, lds, row0, h, tid);
    float* A = (float*)(lds + ML_OFF); float* S = (float*)(lds + ML_SC); float* NA = (float*)(lds + ML_N);
#pragma unroll
    for (int i = 0; i < 8; ++i) *(bf16x8*)(lds + 65536 + (i >> 1) * 16384 + v_st(32 * (i & 1) + sr, sc8)) = tv[i];
    if (tid < 256) NA[tid] = 0.f;
    const int a = wid >> 1, dvb0 = 2 * (wid & 1);
    const int ldsb = (int)(uintptr_t)lds; const int vbK = ldsb + v_rd_base(lane) + a * 512, vbV = ldsb + 65536 + v_rd_base(lane) + dvb0 * 512;
#pragma unroll 1
    for (int dir = 0; dir < 2; ++dir) {
        __syncthreads();
        const float ft = S[dir], am = S[2 + dir]; const float mT = isctx ? ft + fmaxf(am, 0.f) : 0.f; const float wl2 = (ft - mT) * L2E;
        float xs[8];
#pragma unroll
        for (int i = 0; i < 8; ++i) xs[i] = 0.f;
#pragma unroll
        for (int j = 0; j < 4; ++j)
#pragma unroll
            for (int hf = 0; hf < 2; ++hf) { const int row = 64 * j + 32 * hf + sr; const float w = __builtin_amdgcn_exp2f(wl2 + A[(2 + dir) * 256 + row]);
                const bf16x8 k8 = tk[2 * j + hf]; float x[8];
#pragma unroll
                for (int i = 0; i < 8; ++i) { x[i] = bf2f((unsigned short)k8[i]) * w; xs[i] += x[i]; }
                u32x4 pk = {cvtpk(x[0], x[1]), cvtpk(x[2], x[3]), cvtpk(x[4], x[5]), cvtpk(x[6], x[7])};
                *(u32x4*)(lds + j * 16384 + v_st(32 * hf + sr, sc8)) = pk; }
#pragma unroll
        for (int i = 0; i < 8; ++i) { float v = xs[i]; v += swz_xor<16>(v); v = half_sum(v); if (lane < 16) atomicAdd(&NA[dir * 128 + sc8 + i], v); }
        __syncthreads();
        f32x16 acc0 = {}, acc1 = {}; unsigned eoff = (unsigned)((32 * a + 4 * hi) * MDK + 32 * dvb0 + r32); asm volatile("" : "+v"(eoff));
#define PA_RD(F, OFF) do { F[0] = tr_read<(OFF)>(vbK); F[1] = tr_read<(OFF) + 2048>(vbK); F[2] = tr_read<(OFF)>(vbV); F[3] = tr_read<(OFF) + 2048>(vbV); \
            F[4] = tr_read<(OFF) + 512>(vbV); F[5] = tr_read<(OFF) + 512 + 2048>(vbV); } while (0)
#define PA_MM(F) do { acc0 = __builtin_amdgcn_mfma_f32_32x32x16_bf16(ML_PK(F[0], F[1]), ML_PK(F[2], F[3]), acc0, 0, 0, 0); \
            acc1 = __builtin_amdgcn_mfma_f32_32x32x16_bf16(ML_PK(F[0], F[1]), ML_PK(F[4], F[5]), acc1, 0, 0, 0); } while (0)
#define PA_OFF(S) (((S) >> 2) * 16384 + ((S) & 3) * 4096)
#define PA_PAIR(S) do { SBAR(); PA_RD(fb, PA_OFF((S) + 1)); asm volatile("s_waitcnt lgkmcnt(6)" ::: "memory"); SBAR(); PA_MM(fa); \
            SBAR(); if ((S) + 2 < 16) { PA_RD(fa, PA_OFF(((S) + 2) & 15)); asm volatile("s_waitcnt lgkmcnt(6)" ::: "memory"); } else asm volatile("s_waitcnt lgkmcnt(0)" ::: "memory"); SBAR(); PA_MM(fb); } while (0)
        { s16x4 fa[6], fb[6]; SBAR(); PA_RD(fa, PA_OFF(0));
          PA_PAIR(0); PA_PAIR(2); PA_PAIR(4); PA_PAIR(6); PA_PAIR(8); PA_PAIR(10); PA_PAIR(12); PA_PAIR(14); }
#undef PA_PAIR
#undef PA_OFF
#undef PA_MM
#undef PA_RD
        if (isctx) {
            float* Co = p.out + O_C + ((size_t)(sid * 2 + dir) * MH + h) * MDK * MDK;
#pragma unroll
            for (int r = 0; r < 16; ++r) { const unsigned eo = eoff + (unsigned)(((r & 3) + 8 * (r >> 2)) * MDK); Co[eo] = acc0[r]; Co[eo + 32] = acc1[r]; }
            if (tid == 0) p.out[O_M + (size_t)(sid * 2 + dir) * MH + h] = mT;
        } else {
            const int b = sid - NCB; bf16* Cs = (bf16*)(p.ws + WS_CST) + ((size_t)((b * MH + h) * 2 + dir) * NBLK + blk) * MDK * MDK;
            __syncthreads();
            bf16* T = (bf16*)(lds + wid * 4096);
#pragma unroll
            for (int r = 0; r < 16; ++r) { const int rl = 4 * hi + (r & 3) + 8 * (r >> 2); T[rl * 64 + r32] = f2bf(acc0[r]); T[rl * 64 + 32 + r32] = f2bf(acc1[r]); }
            asm volatile("s_waitcnt lgkmcnt(0)" ::: "memory");
#pragma unroll
            for (int i = 0; i < 4; ++i) { const int c = lane + 64 * i; st16_wt(Cs + (size_t)(32 * a + (c >> 3)) * MDK + 64 * (wid & 1) + (c & 7) * 8, *(const u32x4*)((const char*)T + c * 16)); }
            if (tid == 0) __hip_atomic_store((float*)(p.ws + WS_FTOT) + ((size_t)(b * MH + h) * 2 + dir) * NBLK + blk, ft, __ATOMIC_RELAXED, __HIP_MEMORY_SCOPE_AGENT);
        }
    }
    __syncthreads();
    if (tid < 256) { const int dir = tid >> 7, d = tid & 127;
        if (isctx) p.out[O_N + ((size_t)(sid * 2 + dir) * MH + h) * MDK + d] = NA[tid];
        else { const int b = sid - NCB; __hip_atomic_store((float*)(p.ws + WS_NST) + (((size_t)(b * MH + h) * 2 + dir) * NBLK + blk) * MDK + d, NA[tid], __ATOMIC_RELAXED, __HIP_MEMORY_SCOPE_AGENT); } }
}

template <int D0> __device__ __forceinline__ void pv_rd8(s16x4 (&f)[8], int vb) {
    f[0] = tr_read<v_rd_off(D0, 0, 0)>(vb); f[1] = tr_read<v_rd_off(D0, 0, 1)>(vb); f[2] = tr_read<v_rd_off(D0, 1, 0)>(vb); f[3] = tr_read<v_rd_off(D0, 1, 1)>(vb);
    f[4] = tr_read<v_rd_off(D0, 2, 0)>(vb); f[5] = tr_read<v_rd_off(D0, 2, 1)>(vb); f[6] = tr_read<v_rd_off(D0, 3, 0)>(vb); f[7] = tr_read<v_rd_off(D0, 3, 1)>(vb);
}
__device__ __forceinline__ void pv_mm4(f32x16& od, const s16x4 (&f)[8], bf16x8 pa0, bf16x8 pa1, bf16x8 pa2, bf16x8 pa3) {
    od = __builtin_amdgcn_mfma_f32_32x32x16_bf16(pa0, ML_PK(f[0], f[1]), od, 0, 0, 0); od = __builtin_amdgcn_mfma_f32_32x32x16_bf16(pa1, ML_PK(f[2], f[3]), od, 0, 0, 0);
    od = __builtin_amdgcn_mfma_f32_32x32x16_bf16(pa2, ML_PK(f[4], f[5]), od, 0, 0, 0); od = __builtin_amdgcn_mfma_f32_32x32x16_bf16(pa3, ML_PK(f[6], f[7]), od, 0, 0, 0);
}
__device__ __forceinline__ void pv_d0p(f32x16* o, int vb, bf16x8 pa0, bf16x8 pa1, bf16x8 pa2, bf16x8 pa3) {
    s16x4 fa[8], fb[8];
    SBAR(); pv_rd8<0>(fa, vb); pv_rd8<1>(fb, vb); asm volatile("s_waitcnt lgkmcnt(8)" ::: "memory"); SBAR();
    pv_mm4(o[0], fa, pa0, pa1, pa2, pa3);
    SBAR(); pv_rd8<2>(fa, vb); asm volatile("s_waitcnt lgkmcnt(8)" ::: "memory"); SBAR();
    pv_mm4(o[1], fb, pa0, pa1, pa2, pa3);
    SBAR(); pv_rd8<3>(fb, vb); asm volatile("s_waitcnt lgkmcnt(8)" ::: "memory"); SBAR();
    pv_mm4(o[2], fa, pa0, pa1, pa2, pa3);
    SBAR(); asm volatile("s_waitcnt lgkmcnt(0)" ::: "memory"); SBAR();
    pv_mm4(o[3], fb, pa0, pa1, pa2, pa3);
}
template <int DIR> __device__ __forceinline__ void ml_tile(f32x16* o, float& den, const bf16x8* qr, const char* Ktile, int vbV, const float* AL2, int j, float cq, int trow, bool diag, int r32, int hi) {
    SBAR(); f32x16 p0, p1; qkt(p0, p1, (const bf16*)Ktile, qr, r32, hi); SBAR();
    float ds = 0.f; const int tl = trow - 64 * j - 4 * hi;
#pragma unroll
    for (int g = 0; g < 4; ++g) { const f32x4v a0 = *(const f32x4v*)(AL2 + 64 * j + 8 * g + 4 * hi), a1 = *(const f32x4v*)(AL2 + 64 * j + 32 + 8 * g + 4 * hi);
#pragma unroll
        for (int e = 0; e < 4; ++e) { float w0 = __builtin_amdgcn_exp2f(cq + a0[e]), w1 = __builtin_amdgcn_exp2f(cq + a1[e]);
            if (diag) { if (DIR == 0 ? (8 * g + e > tl) : (8 * g + e < tl)) w0 = 0.f; if (DIR == 0 ? (8 * g + e + 32 > tl) : (8 * g + e + 32 < tl)) w1 = 0.f; }
            p0[4 * g + e] *= w0; p1[4 * g + e] *= w1; ds += p0[4 * g + e] + p1[4 * g + e]; } }
    den += ds;
    bf16x8 pa0, pa1, pa2, pa3;
#define PK4(P, BASE, OUT) do { unsigned a0_ = cvtpk(P[BASE + 0], P[BASE + 1]), a1_ = cvtpk(P[BASE + 2], P[BASE + 3]);   \
    unsigned b0_ = cvtpk(P[BASE + 4], P[BASE + 5]), b1_ = cvtpk(P[BASE + 6], P[BASE + 7]);                              \
    auto r0_ = __builtin_amdgcn_permlane32_swap(a0_, b0_, false, false); auto r1_ = __builtin_amdgcn_permlane32_swap(a1_, b1_, false, false); \
    u32x4 w_ = {r0_[0], r1_[0], r0_[1], r1_[1]}; OUT = *reinterpret_cast<bf16x8*>(&w_); } while (0)
    PK4(p0, 0, pa0); PK4(p0, 8, pa1); PK4(p1, 0, pa2); PK4(p1, 8, pa3);
#undef PK4
    SBAR(); pv_d0p(o, vbV, pa0, pa1, pa2, pa3); SBAR();
}
struct MlKv { bf16x8 tk[4], tv[4]; };
__device__ __forceinline__ void ml_kv_load(MlKv& r, const bf16* QK, int tile0, int sr, int sc8) {
#pragma unroll
    for (int i = 0; i < 4; ++i) { const int row = 64 * tile0 + 32 * i + sr; r.tk[i] = *(const bf16x8*)(QK + (size_t)row * (4 * MW) + MW + sc8); r.tv[i] = *(const bf16x8*)(QK + (size_t)row * (4 * MW) + 2 * MW + sc8); }
}
__device__ __forceinline__ void ml_kv_write(const MlKv& r, char* lds, int sr, int sc8) {
#pragma unroll
    for (int i = 0; i < 4; ++i) { const int jj = i >> 1, rl = 32 * (i & 1) + sr; *(bf16x8*)(lds + jj * 16384 + KSWZ(rl, sc8 * 2)) = r.tk[i]; *(bf16x8*)(lds + 32768 + jj * 16384 + v_st(rl, sc8)) = r.tv[i]; }
}
struct MlPreC { MlKv kv0; bf16x8 qr[8]; };
__device__ __forceinline__ void ml_passC_preload(const Params& p, int sid, int h, int blk, MlPreC& pre) {
    const int tid = tid_opaque(), wid = tid >> 6, lane = tid & 63, r32 = lane & 31, hi = lane >> 5;
    const int row0 = seq_base(sid) + 256 * blk; const bf16* QK = (const bf16*)(p.ws + WS_QKVO) + (size_t)row0 * (4 * MW) + h * MDK;
    ml_kv_load(pre.kv0, QK, 0, tid >> 4, (tid & 15) * 8);
    const bf16* Qw = QK + (size_t)(wid * 32 + r32) * (4 * MW) + hi * 8;
#pragma unroll
    for (int d0 = 0; d0 < 8; ++d0) pre.qr[d0] = *(const bf16x8*)(Qw + d0 * 16);
}
template <bool PRE, bool KEEPG> __device__ __forceinline__ void ml_passC_unit(const Params& p, char* lds, int sid, int h, int blk, const MlPreC& pre) {
    const int tid = tid_opaque(), wid = tid >> 6, lane = tid & 63, r32 = lane & 31, hi = lane >> 5;
    const bool isctx = sid < NCB; const int row0 = seq_base(sid) + 256 * blk; const int wq = wid >> 1;
    const bf16* QK = (const bf16*)(p.ws + WS_QKVO) + (size_t)row0 * (4 * MW) + h * MDK;
    const int sr = tid >> 4, sc8 = (tid & 15) * 8; const int b = sid - NCB;
    bf16x8 tc[8]; float nsv = 0.f; MlKv kv0; bf16x8 qr[8];
    if (!isctx) {
#pragma unroll
        for (int i = 0; i < 8; ++i) { const int dir = i >> 2, c = tid + 512 * (i & 3); tc[i] = *(const bf16x8*)((const bf16*)(p.ws + WS_CST) + ((size_t)((b * MH + h) * 2 + dir) * NBLK + blk) * MDK * MDK + (size_t)c * 8); }
        if (tid < 256) { const int dir = tid >> 7, d = tid & 127; nsv = ((const float*)(p.ws + WS_NST))[(((size_t)(b * MH + h) * 2 + dir) * NBLK + blk) * MDK + d]; } }
    if constexpr (PRE) { kv0 = pre.kv0;
#pragma unroll
        for (int d0 = 0; d0 < 8; ++d0) qr[d0] = pre.qr[d0]; }
    else { ml_kv_load(kv0, QK, 0, sr, sc8);
      const bf16* Qw = QK + (size_t)(wid * 32 + r32) * (4 * MW) + hi * 8;
#pragma unroll
        for (int d0 = 0; d0 < 8; ++d0) qr[d0] = *(const bf16x8*)(Qw + d0 * 16); }
    __syncthreads();
    if constexpr (!KEEPG) ml_gates(p, lds, row0, h, tid);
    float* A = (float*)(lds + ML_OFF); float* NS = (float*)(lds + ML_N); float* li = (float*)(lds + ML_LI) + wid * 32;
    if (tid < 256) NS[tid] = nsv;
    if (!isctx) {
#pragma unroll
        for (int i = 0; i < 8; ++i) { const int dir = i >> 2, c = tid + 512 * (i & 3), row = c >> 4, col8 = (c & 15) * 8; *(bf16x8*)(lds + 65536 + dir * 32768 + (row >> 6) * 16384 + v_st(row & 63, col8)) = tc[i]; }
    }
    ml_kv_write(kv0, lds, sr, sc8);
    __syncthreads();
    float qn_f = 0.f, qn_b = 0.f;
#pragma unroll
    for (int d0 = 0; d0 < 8; ++d0)
#pragma unroll
        for (int i = 0; i < 8; ++i) { const float qv = bf2f((unsigned short)qr[d0][i]); qn_f += qv * NS[d0 * 16 + hi * 8 + i]; qn_b += qv * NS[128 + d0 * 16 + hi * 8 + i]; }
    qn_f = half_sum(qn_f); qn_b = half_sum(qn_b);
    const int ldsb = (int)(uintptr_t)lds; const int vbV = ldsb + 32768 + v_rd_base(lane), vbC = ldsb + 65536 + v_rd_base(lane);
    const int trow = wid * 32 + r32;
    f32x16 of[4], ob[4];
#pragma unroll
    for (int d0 = 0; d0 < 4; ++d0) { of[d0] = f32x16{}; ob[d0] = f32x16{}; }
    if (!isctx) { pv_d0p(of, vbC, qr[0], qr[1], qr[2], qr[3]); pv_d0p(of, vbC + 16384, qr[4], qr[5], qr[6], qr[7]);
        pv_d0p(ob, vbC + 32768, qr[0], qr[1], qr[2], qr[3]); pv_d0p(ob, vbC + 32768 + 16384, qr[4], qr[5], qr[6], qr[7]);
#pragma unroll
        for (int r = 0; r < 16; ++r) { const float ef = A[4 * 256 + wid * 32 + crow(r, hi)], eb = A[5 * 256 + wid * 32 + crow(r, hi)];
#pragma unroll
            for (int d0 = 0; d0 < 4; ++d0) { of[d0][r] *= ef; ob[d0][r] *= eb; } } }
    const float cqf = A[0 * 256 + trow], cqb = A[1 * 256 + trow]; float denf = 0.f, denb = 0.f;
    __syncthreads();
    { const int wu = __builtin_amdgcn_readfirstlane(wid); const int tb = wu >> 1;
#pragma unroll
      for (int i = 0; i < 8; ++i) { const int o = ((wu & 1) * 8 + i) * 1024 + lane * 16; const bf16* src;
          if (tb < 2) { const int row = o >> 8, colB = (o & 255) ^ ((row & 7) << 4); src = QK + (size_t)(64 * (2 + tb) + row) * (4 * MW) + MW + (colB >> 1); }
          else { const int sub = o >> 9, within = o & 511, kk = (sub >> 2) * 8 + (within >> 6), k = (kk & ~0xC) | ((kk & 4) << 1) | ((kk & 8) >> 1), c = (sub & 3) * 32 + ((within & 63) >> 1);
                 src = QK + (size_t)(64 * tb + k) * (4 * MW) + 2 * MW + c; }
          __builtin_amdgcn_global_load_lds((const unsigned*)src, (__attribute__((address_space(3))) unsigned*)(lds + 65536 + tb * 16384 + ((wu & 1) * 8 + i) * 1024), 16, 0, 0); } }
    ml_tile<0>(of, denf, qr, lds, vbV, A + 2 * 256, 0, cqf, trow, wq == 0, r32, hi);
    if (wq >= 1) ml_tile<0>(of, denf, qr, lds + 16384, vbV + 16384, A + 2 * 256, 1, cqf, trow, wq == 1, r32, hi);
    if (wq <= 1) ml_tile<1>(ob, denb, qr, lds + 16384, vbV + 16384, A + 3 * 256, 1, cqb, trow, wq == 1, r32, hi);
    if (wq <= 0) ml_tile<1>(ob, denb, qr, lds, vbV, A + 3 * 256, 0, cqb, trow, wq == 0, r32, hi);
    asm volatile("s_waitcnt vmcnt(0)" ::: "memory");
    __syncthreads();
    char* ogt = lds + wid * 8192;
    { const bf16* OGg = QK + (size_t)(wid * 32) * (4 * MW) + 3 * MW;
#pragma unroll
      for (int i = 0; i < 8; ++i) { const int c = lane + 64 * i;
          __builtin_amdgcn_global_load_lds((const unsigned*)(OGg + (size_t)(c >> 4) * (4 * MW) + (c & 15) * 8), (__attribute__((address_space(3))) unsigned*)(ogt + i * 1024), 16, 0, 0); } }
    { char* const K2 = lds + 65536; const int vb2 = vbV + 65536;
    if (wq >= 2) ml_tile<0>(of, denf, qr, K2, vb2, A + 2 * 256, 2, cqf, trow, wq == 2, r32, hi);
    if (wq >= 3) ml_tile<0>(of, denf, qr, K2 + 16384, vb2 + 16384, A + 2 * 256, 3, cqf, trow, wq == 3, r32, hi);
    ml_tile<1>(ob, denb, qr, K2 + 16384, vb2 + 16384, A + 3 * 256, 3, cqb, trow, wq == 3, r32, hi);
    if (wq <= 2) ml_tile<1>(ob, denb, qr, K2, vb2, A + 3 * 256, 2, cqb, trow, wq == 2, r32, hi); }
    denf = half_sum(denf); denb = half_sum(denb);
    const float invf = 1.0f / fmaxf(fabsf(denf + __builtin_amdgcn_exp2f(cqf) * qn_f), 1.0f), invb = 1.0f / fmaxf(fabsf(denb + __builtin_amdgcn_exp2f(cqb) * qn_b), 1.0f);
    float* li2 = (float*)(lds + ML_LI2) + wid * 32;
    if (hi == 0) { li[r32] = invf; li2[r32] = invb; } asm volatile("s_waitcnt lgkmcnt(0)" ::: "memory");
    asm volatile("s_waitcnt vmcnt(0)" ::: "memory");
    float mg[4];
#pragma unroll
    for (int d0 = 0; d0 < 4; ++d0) mg[d0] = p.mng[h * MDK + d0 * 32 + r32];
    bf16* T = (bf16*)ogt;
#pragma unroll
    for (int r = 0; r < 16; ++r) { const float rlf = li[crow(r, hi)], rlb = li2[crow(r, hi)]; const int rw = crow(r, hi); float ss = 0.f; float x[4];
#pragma unroll
        for (int d0 = 0; d0 < 4; ++d0) { x[d0] = of[d0][r] * rlf + ob[d0][r] * rlb; ss += x[d0] * x[d0]; }
        ss += swz_xor<1>(ss); ss += swz_xor<2>(ss); ss += swz_xor<4>(ss); ss += swz_xor<8>(ss); ss += swz_xor<16>(ss);
        const float rs = __builtin_amdgcn_rsqf(ss * (1.0f / MDK) + EPSF);
#pragma unroll
        for (int d0 = 0; d0 < 4; ++d0) { bf16* e = T + rw * 128 + d0 * 32 + r32; *e = f2bf(bf2f(*e) * x[d0] * rs * mg[d0]); } }
    asm volatile("s_waitcnt lgkmcnt(0)" ::: "memory");
    bf16* UHo = (bf16*)(p.ws + WS_UH) + (size_t)(row0 + wid * 32) * DM + CCH + h * MDK;
#pragma unroll
    for (int i = 0; i < 8; ++i) { const int c = lane + 64 * i; *(u32x4*)(UHo + (size_t)(c >> 4) * DM + (c & 15) * 8) = *(const u32x4*)(ogt + c * 16); }
}
}

template <int DIR> __device__ __forceinline__ void ml_scan_item(const Params& p, int ch, int b, int h, int e8) {
    const float* FT = (const float*)(p.ws + WS_FTOT) + (size_t)ch * NBLK;
    if (e8 < MDK * MDK) { bf16_t* Cs = (bf16_t*)(p.ws + WS_CST) + (size_t)ch * NBLK * MDK * MDK + e8; const float* c0 = p.stC + ((size_t)(b * 2 + DIR) * MH + h) * MDK * MDK + e8;
        v4u d[NBLK];
#pragma unroll
        for (int i = 0; i < NBLK; ++i) d[i] = *(const v4u*)(Cs + (size_t)i * MDK * MDK);
        const f32x4 ca = *(const f32x4*)c0, cb = *(const f32x4*)(c0 + 4); const float em = __expf(p.stm[(size_t)(b * 2 + DIR) * MH + h]);
        float fd[NBLK];
#pragma unroll
        for (int i = 0; i < NBLK; ++i) fd[i] = __expf(FT[i]);
        float c[8] = {ca[0] * em, ca[1] * em, ca[2] * em, ca[3] * em, cb[0] * em, cb[1] * em, cb[2] * em, cb[3] * em};
#pragma unroll
        for (int i = 0; i < NBLK; ++i) { const int blk = DIR == 0 ? i : NBLK - 1 - i; v4u o;
#pragma unroll
            for (int w = 0; w < 4; ++w) { const float lo = __uint_as_float(d[blk][w] << 16), hi = __uint_as_float(d[blk][w] & 0xffff0000u); o[w] = pg8::cvt_pk_bf16(c[2 * w], c[2 * w + 1]);
                c[2 * w] = fd[blk] * c[2 * w] + lo; c[2 * w + 1] = fd[blk] * c[2 * w + 1] + hi; }
            att::st16_wt(Cs + (size_t)blk * MDK * MDK, __builtin_bit_cast(att::u32x4, o)); } }
    else { const int d_ = e8 - MDK * MDK; float* Ns = (float*)(p.ws + WS_NST) + (size_t)ch * NBLK * MDK + d_; const float* n0 = p.stn + ((size_t)(b * 2 + DIR) * MH + h) * MDK + d_;
        f32x4 da[NBLK], db[NBLK];
#pragma unroll
        for (int i = 0; i < NBLK; ++i) { da[i] = *(const f32x4*)(Ns + (size_t)i * MDK); db[i] = *(const f32x4*)(Ns + (size_t)i * MDK + 4); }
        const float em = __expf(p.stm[(size_t)(b * 2 + DIR) * MH + h]); float fd[NBLK];
#pragma unroll
        for (int i = 0; i < NBLK; ++i) fd[i] = __expf(FT[i]);
        f32x4 ca = *(const f32x4*)n0 * em, cb = *(const f32x4*)(n0 + 4) * em;
#pragma unroll
        for (int i = 0; i < NBLK; ++i) { const int blk = DIR == 0 ? i : NBLK - 1 - i;
            att::st16_wt(Ns + (size_t)blk * MDK, __builtin_bit_cast(att::u32x4, ca)); att::st16_wt(Ns + (size_t)blk * MDK + 4, __builtin_bit_cast(att::u32x4, cb)); ca = ca * fd[blk] + da[blk]; cb = cb * fd[blk] + db[blk]; } }
}
struct MlScan {
    Params p; static HD_FN long count() { return (long)NLB * MH * 2 * ((MDK * MDK + MDK) / 8); }
    __device__ __forceinline__ void operator()(long idx) const {
        constexpr int per = (MDK * MDK + MDK) / 8; const int e8 = (int)(idx % per) * 8; const int ch = (int)(idx / per); const int dir = ch & 1, h = (ch >> 1) % MH, b = ch / (2 * MH);
        if (dir == 0) ml_scan_item<0>(p, ch, b, h, e8); else ml_scan_item<1>(p, ch, b, h, e8);
    }
};
__device__ __forceinline__ void ml_phase_A(const Params& p, unsigned char* lds, int vcu, int G) {
    constexpr int NUL = NLB * MH * NBLK, NU = NUL + NCB * MH;
    for (int u = vcu; u < NU; u += G) {
        if (u < NUL) att::ml_passA_unit(p, (char*)lds, NCB + u / (MH * NBLK), (u / NBLK) % MH, u % NBLK);
        else att::ml_passA_unit(p, (char*)lds, (u - NUL) / MH, (u - NUL) % MH, 0); }
}
__device__ __forceinline__ void ml_phase_C(const Params& p, unsigned char* lds, int vcu, int G) {
    constexpr int NUL = NLB * MH * NBLK, NU = NUL + NCB * MH;
    for (int u = vcu; u < NU; u += G) {
        if (u < NUL) att::ml_passC_unit<false, false>(p, (char*)lds, NCB + u / (MH * NBLK), (u / NBLK) % MH, u % NBLK, att::MlPreC{});
        else att::ml_passC_unit<false, false>(p, (char*)lds, (u - NUL) / MH, (u - NUL) % MH, 0, att::MlPreC{}); }
}
typedef float f4 __attribute__((ext_vector_type(4)));
typedef unsigned u4 __attribute__((ext_vector_type(4)));
typedef unsigned u2 __attribute__((ext_vector_type(2)));
__device__ __forceinline__ float wave_sum64(float v) { v += swz_xor<1>(v); v += swz_xor<2>(v); v += swz_xor<4>(v); v += swz_xor<8>(v); v += swz_xor<16>(v); return half_sum(v); }
__device__ __forceinline__ float fsilu(float x) { return x * fsigmoid(x); }

__device__ __forceinline__ void phase_mod(const Params& p, char* lds, int l, int cu, int ncu) {
    const int tid = tid_opaque(), lane = tid & 63, wave = __builtin_amdgcn_readfirstlane(tid >> 6);
    float* SL = (float*)lds; float* PT = (float*)(lds + 32768);
    constexpr int NCG = 6 * DM / 64, NIT = 2 * NCG;
    if (cu >= NIT) return;
    bool first = true;
    for (int item = cu; item < NIT; item += ncu) {
        const int cg = item >> 1, kh = item & 1; const float* w = p.wmod + (size_t)l * DM * 6 * DM + cg * 64;
        const int k0 = kh * (DM / 2) + wave * (DM / 16);
        float acc[NCLS];
#pragma unroll
        for (int r = 0; r < NCLS; ++r) acc[r] = 0.f;
        float wv[64];
#pragma unroll
        for (int j = 0; j < 64; ++j) wv[j] = (w + (size_t)(k0 + j) * 6 * DM)[lane];
        if (first) { first = false; __syncthreads();
            for (int i = tid; i < NCLS * DM; i += NTHREADS) { const int cls = i / DM, k = i % DM; const float cv = cls == 0 ? p.cctx[k] : p.c[(size_t)(cls - 1) * DM + k]; SL[i] = fsilu(cv); } }
        __syncthreads();
#pragma unroll
        for (int j = 0; j < 64; ++j)
#pragma unroll
            for (int r = 0; r < NCLS; ++r) acc[r] += SL[r * DM + k0 + j] * wv[j];
#pragma unroll
        for (int r = 0; r < NCLS; ++r) PT[(wave * NCLS + r) * 64 + lane] = acc[r];
        __syncthreads();
        if (tid < NCLS * 64) { const int r = tid >> 6; float s = kh == 0 ? p.bmod[(size_t)l * 6 * DM + cg * 64 + lane] : 0.f;
#pragma unroll
            for (int w8 = 0; w8 < 8; ++w8) s += PT[(w8 * NCLS + r) * 64 + lane];
            atomicAdd((float*)(p.ws + WS_MOD) + ((size_t)(l * NCLS + r) * 6 * DM) + cg * 64 + lane, s); }
    }
}
__device__ __forceinline__ void sw_job(const Params& p, const bf16_t* Bt, int nrows, int l, int which, float* sw, int N, int mode, int gw, int NGW, int lane) {
    if (gw >= nrows) return;
    f4 sh[NCLS][4];
#pragma unroll
    for (int cls = 0; cls < NCLS; ++cls) { const float* s_ = modv(p, l, cls, which); sh[cls][0] = *(const f4*)(s_ + lane * 8); sh[cls][1] = *(const f4*)(s_ + lane * 8 + 4); sh[cls][2] = *(const f4*)(s_ + DM / 2 + lane * 8); sh[cls][3] = *(const f4*)(s_ + DM / 2 + lane * 8 + 4); }
    u4 w0 = *(const u4*)(Bt + (size_t)gw * DM + lane * 8), w1 = *(const u4*)(Bt + (size_t)gw * DM + DM / 2 + lane * 8);
    for (int n = gw; n < nrows; n += NGW) {
        const u4 c0 = w0, c1 = w1; const int nn = n + NGW; if (nn < nrows) { w0 = *(const u4*)(Bt + (size_t)nn * DM + lane * 8); w1 = *(const u4*)(Bt + (size_t)nn * DM + DM / 2 + lane * 8); }
        f4 wa, wb, wc, wd; wa = (f4){__uint_as_float(c0.x << 16), __uint_as_float(c0.x & 0xffff0000u), __uint_as_float(c0.y << 16), __uint_as_float(c0.y & 0xffff0000u)};
        wb = (f4){__uint_as_float(c0.z << 16), __uint_as_float(c0.z & 0xffff0000u), __uint_as_float(c0.w << 16), __uint_as_float(c0.w & 0xffff0000u)};
        wc = (f4){__uint_as_float(c1.x << 16), __uint_as_float(c1.x & 0xffff0000u), __uint_as_float(c1.y << 16), __uint_as_float(c1.y & 0xffff0000u)};
        wd = (f4){__uint_as_float(c1.z << 16), __uint_as_float(c1.z & 0xffff0000u), __uint_as_float(c1.w << 16), __uint_as_float(c1.w & 0xffff0000u)};
        int col = n; if (mode == 1) { const int t = n >> 8, r = n & 255; col = r < 128 ? 128 * t + r : (N / 2) + 128 * t + (r - 128); }
        if (mode == 2 && n >= NQ * HDIM && n < (NQ + NKV) * HDIM) col = (n & ~127) + kperm_dim(n & 127);
        float mine = 0.f;
#pragma unroll
        for (int cls = 0; cls < NCLS; ++cls) { const f4 t4 = sh[cls][0] * wa + sh[cls][1] * wb + sh[cls][2] * wc + sh[cls][3] * wd; float s = (t4[0] + t4[1]) + (t4[2] + t4[3]); s = wave_sum64(s); if (lane == cls) mine = s; }
        if (lane < NCLS) sw[(size_t)lane * N + col] = mine;
    }
}
static_assert(DM == 1024, "sw_job / norm passes assume 1024 = 64 lanes x 16");
typedef float f32x4g __attribute__((ext_vector_type(4)));
struct Norm0Pre { f4 x[32]; };
__device__ __forceinline__ void norm0_rowptr(const Params& p, int it, int bx, int G, int wave, int lane, bool& any, int& rb, const float*& xr) {
    const int rb0 = (it * G + bx) * (NWAVES / 2); any = rb0 < MTOK / 16; rb = rb0 + (wave >> 1);
    const int row = (any ? rb : 0) * 16 + (lane & 15); xr = xrow(p, row) + 512 * (wave & 1) + 4 * (lane >> 4);
}
__device__ __forceinline__ void phase_norm0_pre(const Params& p, char* lds, int bx, int G, Norm0Pre& st) {
    const int tid = tid_opaque(), lane = tid & 63, wave = tid >> 6; constexpr int WLD = DM + 4;
    float* WG = (float*)lds;
    __syncthreads();
    { f4 tv[DM * 4 / NTHREADS];
#pragma unroll
      for (int it = 0; it < DM * 4 / NTHREADS; ++it) { const int k = it * (NTHREADS / 4) + (tid >> 2); tv[it] = *(const f4*)(p.winab + (size_t)k * ABIN + ABMAIN + 4 * (tid & 3)); }
#pragma unroll
      for (int it = 0; it < DM * 4 / NTHREADS; ++it) { const int k = it * (NTHREADS / 4) + (tid >> 2), g0 = 4 * (tid & 3); WG[(g0 + 0) * WLD + k] = tv[it][0]; WG[(g0 + 1) * WLD + k] = tv[it][1]; WG[(g0 + 2) * WLD + k] = tv[it][2]; WG[(g0 + 3) * WLD + k] = tv[it][3]; } }
    bool any; int rb; const float* xr; norm0_rowptr(p, 0, bx, G, wave, lane, any, rb, xr);
#pragma unroll
    for (int q = 0; q < 32; ++q) st.x[q] = *(const f4*)(xr + 16 * q);
}
__device__ __forceinline__ void phase_norm0(const Params& p, char* lds, int bx, int G, Norm0Pre& st) {
    const int tid = tid_opaque(), lane = tid & 63, wave = tid >> 6; constexpr int WLD = DM + 4;
    float* WG = (float*)lds; float* XS = (float*)(lds + 16 * WLD * 4);
    const int r = lane & 15, kq = lane >> 4, pair = wave >> 1, kh = wave & 1;
    float* SQ = XS + pair * 32; float* GP = XS + 128 + pair * 256;
    const bool tail8 = (MTOK / 16 == 5 * G); f4 xt[8];
    if (tail8) { const float* xr8 = xrow(p, (4 * G + bx) * 16 + r) + 128 * wave + 4 * kq;
#pragma unroll
        for (int q = 0; q < 8; ++q) xt[q] = *(const f4*)(xr8 + 16 * q); }
    for (int it = 0;; ++it) {
        bool any; int rb; const float* xr; norm0_rowptr(p, it, bx, G, wave, lane, any, rb, xr); if (!any || (tail8 && it > 0)) break;
        const int row = rb * 16 + r; const int cls = cls_of(rb * 16); const int kb = 512 * kh + 4 * kq;
        f4 (&x)[32] = st.x; float s = 0.f;
#pragma unroll
        for (int q = 0; q < 32; ++q) s += (x[q][0] * x[q][0] + x[q][1] * x[q][1]) + (x[q][2] * x[q][2] + x[q][3] * x[q][3]);
        s += swz_xor<16>(s); s = half_sum(s);
        __syncthreads();
        if (kq == 0) SQ[kh * 16 + r] = s;
        __syncthreads();
        const float rs = 1.0f / sqrtf((SQ[r] + SQ[16 + r]) * (1.0f / DM) + EPSF);
        const float* gp = p.n1g + kb; const float* scp = modv(p, 0, cls, 1) + kb; const float* shp = modv(p, 0, cls, 0) + kb; const float* wp = WG + r * WLD + kb;
        bf16_t* xo = (bf16_t*)(p.ws + WS_XN) + (size_t)row * DM + kb;
        f32x4g acc = {0.f, 0.f, 0.f, 0.f};
#pragma unroll
        for (int q = 0; q < 32; ++q) { const f4 gg = *(const f4*)(gp + 16 * q), sc = *(const f4*)(scp + 16 * q), sh = *(const f4*)(shp + 16 * q), w = *(const f4*)(wp + 16 * q);
            const f4 h = x[q] * rs * gg * (sc + 1.0f) + sh;
            u2 o; o.x = pg8::cvt_pk_bf16(h[0], h[1]); o.y = pg8::cvt_pk_bf16(h[2], h[3]); *(u2*)(xo + 16 * q) = o;
            acc = __builtin_amdgcn_mfma_f32_16x16x4f32(h[0], w[0], acc, 0, 0, 0); acc = __builtin_amdgcn_mfma_f32_16x16x4f32(h[1], w[1], acc, 0, 0, 0);
            acc = __builtin_amdgcn_mfma_f32_16x16x4f32(h[2], w[2], acc, 0, 0, 0); acc = __builtin_amdgcn_mfma_f32_16x16x4f32(h[3], w[3], acc, 0, 0, 0); }
        if (kh == 1) *(f32x4g*)(GP + lane * 4) = acc;
        __syncthreads();
        if (kh == 0) { const f32x4g o2 = *(const f32x4g*)(GP + lane * 4); const float bg = p.bgate[r];
#pragma unroll
            for (int e = 0; e < 4; ++e) { float a = acc[e] + o2[e] + bg; if ((r & 7) >= 4) a = logsigmoidf_(a); ((float*)(p.ws + WS_GATES))[(size_t)(rb * 16 + 4 * kq + e) * NGATE + r] = a; } }
        { bool any2; int rb2; const float* xr2; norm0_rowptr(p, it + 1, bx, G, wave, lane, any2, rb2, xr2);
          if (any2 && !tail8) {
#pragma unroll
              for (int q = 0; q < 32; ++q) st.x[q] = *(const f4*)(xr2 + 16 * q); } }
    }
    if (tail8) {
        const int rb = 4 * G + bx, row = rb * 16 + r, cls = cls_of(rb * 16), kb = 128 * wave + 4 * kq;
        float* SQ8 = XS; float* GP8 = XS + 128;
        float s = 0.f;
#pragma unroll
        for (int q = 0; q < 8; ++q) s += (xt[q][0] * xt[q][0] + xt[q][1] * xt[q][1]) + (xt[q][2] * xt[q][2] + xt[q][3] * xt[q][3]);
        s += swz_xor<16>(s); s = half_sum(s);
        __syncthreads();
        if (kq == 0) SQ8[wave * 16 + r] = s;
        __syncthreads();
        float tot = 0.f;
#pragma unroll
        for (int w = 0; w < 8; ++w) tot += SQ8[w * 16 + r];
        const float rs = 1.0f / sqrtf(tot * (1.0f / DM) + EPSF);
        const float* gp = p.n1g + kb; const float* scp = modv(p, 0, cls, 1) + kb; const float* shp = modv(p, 0, cls, 0) + kb; const float* wp = WG + r * WLD + kb;
        bf16_t* xo = (bf16_t*)(p.ws + WS_XN) + (size_t)row * DM + kb;
        f32x4g acc = {0.f, 0.f, 0.f, 0.f};
#pragma unroll
        for (int q = 0; q < 8; ++q) { const f4 gg = *(const f4*)(gp + 16 * q), sc = *(const f4*)(scp + 16 * q), sh = *(const f4*)(shp + 16 * q), w = *(const f4*)(wp + 16 * q);
            const f4 h = xt[q] * rs * gg * (sc + 1.0f) + sh;
            u2 o; o.x = pg8::cvt_pk_bf16(h[0], h[1]); o.y = pg8::cvt_pk_bf16(h[2], h[3]); *(u2*)(xo + 16 * q) = o;
            acc = __builtin_amdgcn_mfma_f32_16x16x4f32(h[0], w[0], acc, 0, 0, 0); acc = __builtin_amdgcn_mfma_f32_16x16x4f32(h[1], w[1], acc, 0, 0, 0);
            acc = __builtin_amdgcn_mfma_f32_16x16x4f32(h[2], w[2], acc, 0, 0, 0); acc = __builtin_amdgcn_mfma_f32_16x16x4f32(h[3], w[3], acc, 0, 0, 0); }
        *(f32x4g*)(GP8 + (wave * 64 + lane) * 4) = acc;
        __syncthreads();
        if (wave == 0) { f32x4g a4 = {0.f, 0.f, 0.f, 0.f};
#pragma unroll
            for (int w = 0; w < 8; ++w) a4 += *(const f32x4g*)(GP8 + (w * 64 + lane) * 4);
            const float bg = p.bgate[r];
#pragma unroll
            for (int e = 0; e < 4; ++e) { float a = a4[e] + bg; if ((r & 7) >= 4) a = logsigmoidf_(a); ((float*)(p.ws + WS_GATES))[(size_t)(rb * 16 + 4 * kq + e) * NGATE + r] = a; } }
    }
}
static_assert(MTOK % 64 == 0 && MC % 16 == 0 && LSEQ % 16 == 0 && DM == 1024, "norm0 row blocks");
__device__ __forceinline__ void phase_conv(const Params& p, char* lds, int ufirst, int ustride, int uend) {
    const int tid = tid_opaque(), lane = tid & 63, wave = tid >> 6; constexpr int TT = 32, NR = TT + CWID - 1;
    bf16_t* X = (bf16_t*)lds; float* OUT = (float*)(lds + 65536);
    const int cp = tid & 255, tg = tid >> 8, c0 = 2 * cp;
    float w0[CWID], w1[CWID];
#pragma unroll
    for (int j = 0; j < CWID; ++j) { w0[j] = p.convw[(size_t)j * CCH + c0]; w1[j] = p.convw[(size_t)j * CCH + c0 + 1]; }
    const float b0 = p.convb[c0], b1 = p.convb[c0 + 1];
    const bf16_t* U = (const bf16_t*)(p.ws + WS_UPRE);
    u4 val[8];
#define CONV_LOAD(UU) do { const int row0_ = (UU) * TT, pos0_ = pos_of(row0_), len_ = seqlen_of(row0_); _Pragma("unroll") \
        for (int i = 0; i < 8; ++i) { const int c = tid + NTHREADS * i, r = c / (CCH / 8), ch = (c % (CCH / 8)) * 8; const int t = pos0_ + r - CWID / 2; \
            val[i] = (u4){0u, 0u, 0u, 0u}; if (c < NR * (CCH / 8) && t >= 0 && t < len_) val[i] = *(const u4*)(U + (size_t)(row0_ + r - CWID / 2) * CCH + ch); } } while (0)
    if (ufirst < uend) CONV_LOAD(ufirst);
    for (int u = ufirst; u < uend; u += ustride) {
        const int row0 = u * TT;
        __syncthreads();
#pragma unroll
        for (int i = 0; i < 8; ++i) { const int c = tid + NTHREADS * i, r = c / (CCH / 8), ch = (c % (CCH / 8)) * 8; if (c < NR * (CCH / 8)) *(u4*)(X + (size_t)r * CCH + ch) = val[i]; }
        __syncthreads();
        if (u + ustride < uend) CONV_LOAD(u + ustride);
#pragma unroll 1
        for (int hb = 0; hb < 2; ++hb) { const int t0 = tg * (TT / 2) + hb * 8; float xa[8 + CWID - 1], xb[8 + CWID - 1];
#pragma unroll
            for (int i = 0; i < 8 + CWID - 1; ++i) { const unsigned xx = *(const unsigned*)(X + (size_t)(t0 + i) * CCH + c0); xa[i] = __uint_as_float(xx << 16); xb[i] = __uint_as_float(xx & 0xffff0000u); }
#pragma unroll
            for (int tt = 0; tt < 8; ++tt) { float a0 = b0, a1 = b1;
#pragma unroll
                for (int j = 0; j < CWID; ++j) { a0 += w0[j] * xa[tt + j]; a1 += w1[j] * xb[tt + j]; }
                *(float2*)(OUT + (size_t)(t0 + tt) * CCH + c0) = make_float2(a0, a1); } }
        __syncthreads();
#pragma unroll
        for (int q = 0; q < TT / NWAVES; ++q) { const int t = wave * (TT / NWAVES) + q; const f4 x0 = *(const f4*)(OUT + (size_t)t * CCH + lane * 8), x1 = *(const f4*)(OUT + (size_t)t * CCH + lane * 8 + 4);
            const float mu = wave_sum64((x0[0] + x0[1]) + (x0[2] + x0[3]) + (x1[0] + x1[1]) + (x1[2] + x1[3])) * (1.0f / CCH);
            const f4 d0 = x0 - mu, d1 = x1 - mu;
            const float var = wave_sum64((d0[0] * d0[0] + d0[1] * d0[1]) + (d0[2] * d0[2] + d0[3] * d0[3]) + (d1[0] * d1[0] + d1[1] * d1[1]) + (d1[2] * d1[2] + d1[3] * d1[3])) * (1.0f / CCH);
            const float rs = 1.0f / sqrtf(var + EPSF);
            const f4 g0 = *(const f4*)(p.lng + lane * 8), g1 = *(const f4*)(p.lng + lane * 8 + 4), be0 = *(const f4*)(p.lnb + lane * 8), be1 = *(const f4*)(p.lnb + lane * 8 + 4);
            const f4 y0 = d0 * rs * g0 + be0, y1 = d1 * rs * g1 + be1; u4 w;
            w.x = pg8::cvt_pk_bf16(fsilu(y0[0]), fsilu(y0[1])); w.y = pg8::cvt_pk_bf16(fsilu(y0[2]), fsilu(y0[3])); w.z = pg8::cvt_pk_bf16(fsilu(y1[0]), fsilu(y1[1])); w.w = pg8::cvt_pk_bf16(fsilu(y1[2]), fsilu(y1[3]));
            *(u4*)((bf16_t*)(p.ws + WS_UH) + (size_t)(row0 + t) * DM + lane * 8) = w; }
    }
#undef CONV_LOAD
}
static_assert(CCH == 512 && CSEQ % 32 == 0 && LSEQ % 32 == 0, "conv phase geometry");
__device__ __forceinline__ void phase_cachecvt(const Params& p, int gtid, int gthreads) {
    constexpr int PER = PAST * NKV * HDIM / 8;
    for (int i = gtid; i < NLB * PER; i += gthreads) { const int b = i / PER, e = (i % PER) * 8; const size_t src = (size_t)b * PAST * NKV * HDIM + e, dst = ((size_t)b * SKVL + LSEQ) * NKV * HDIM + e;
        const f4 k0 = *(const f4*)(p.ck + src), k1 = *(const f4*)(p.ck + src + 4), v0 = *(const f4*)(p.cv + src), v1 = *(const f4*)(p.cv + src + 4); u4 wk, wv;
        wk.x = pg8::cvt_pk_bf16(k0[0], k0[1]); wk.y = pg8::cvt_pk_bf16(k0[2], k0[3]); wk.z = pg8::cvt_pk_bf16(k1[0], k1[1]); wk.w = pg8::cvt_pk_bf16(k1[2], k1[3]);
        wv.x = pg8::cvt_pk_bf16(v0[0], v0[1]); wv.y = pg8::cvt_pk_bf16(v0[2], v0[3]); wv.z = pg8::cvt_pk_bf16(v1[0], v1[1]); wv.w = pg8::cvt_pk_bf16(v1[2], v1[3]);
        *(u4*)((bf16_t*)(p.ws + WS_LATK) + dst) = wk; *(u4*)((bf16_t*)(p.ws + WS_LATV) + dst) = wv; }
}
__device__ __forceinline__ void phase_qkpost(const Params& p, int gw, int NGW, int lane) {
    const int hh = lane >> 5, l5 = lane & 31, half = l5 >> 4, f0 = (l5 & 15) * 2, d1 = half * 64 + f0, d2 = d1 + 32;
    const float inv0 = __builtin_amdgcn_exp2f(-(float)f0 * (13.287712379549449f / 32.0f)), inv1 = __builtin_amdgcn_exp2f(-(float)(f0 + 1) * (13.287712379549449f / 32.0f));
    const float qg[4] = {p.qng[d1], p.qng[d1 + 1], p.qng[d2], p.qng[d2 + 1]}, kg[4] = {p.kng[d1], p.kng[d1 + 1], p.kng[d2], p.kng[d2 + 1]};
    for (int row = gw; row < MTOK; row += NGW) {
        const bool lat = row >= MC; const int sp = pos_of(row); float cs0 = 1.f, sn0 = 0.f, cs1 = 1.f, sn1 = 0.f;
        if (lat) { const float pos = (float)(half == 0 ? sp / GRIDW : sp % GRIDW); cs0 = __cosf(pos * inv0); sn0 = __sinf(pos * inv0); cs1 = __cosf(pos * inv1); sn1 = __sinf(pos * inv1); }
        bf16_t* Q = (bf16_t*)(p.ws + WS_QRAW) + (size_t)row * NQ * HDIM; const bf16_t* KR = (const bf16_t*)(p.ws + WS_KRAW) + (size_t)row * NKV * HDIM;
        unsigned ra[NQ / 2 + 1], rb[NQ / 2 + 1];
#pragma unroll
        for (int it = NQ / 2; it <= NQ / 2; ++it) { const bf16_t* src = it < NQ / 2 ? Q + (2 * it + hh) * HDIM : KR + hh * HDIM; ra[it] = *(const unsigned*)(src + d1); rb[it] = *(const unsigned*)(src + d2); }
#pragma unroll
        for (int it = NQ / 2; it <= NQ / 2; ++it) { const bool isq = it < NQ / 2;
            const float x1a = __uint_as_float(ra[it] << 16), x1b = __uint_as_float(ra[it] & 0xffff0000u), x2a = __uint_as_float(rb[it] << 16), x2b = __uint_as_float(rb[it] & 0xffff0000u);
            float ss = (x1a * x1a + x1b * x1b) + (x2a * x2a + x2b * x2b); ss += swz_xor<1>(ss); ss += swz_xor<2>(ss); ss += swz_xor<4>(ss); ss += swz_xor<8>(ss); ss += swz_xor<16>(ss);
            const float rs = 1.0f / sqrtf(ss * (1.0f / HDIM) + EPSF); const float* g = isq ? qg : kg;
            const float a0 = x1a * rs * g[0], a1 = x1b * rs * g[1], b0 = x2a * rs * g[2], b1 = x2b * rs * g[3];
            const float y1a = a0 * cs0 - b0 * sn0, y2a = a0 * sn0 + b0 * cs0, y1b = a1 * cs1 - b1 * sn1, y2b = a1 * sn1 + b1 * cs1;
            const unsigned w1 = pg8::cvt_pk_bf16(y1a, y1b), w2 = pg8::cvt_pk_bf16(y2a, y2b);
            if (isq) { bf16_t* dst = Q + (2 * it + hh) * HDIM; *(unsigned*)(dst + d1) = w1; *(unsigned*)(dst + d2) = w2; }
            else if (!lat) { bf16_t* K = (bf16_t*)(p.ws + WS_CTXK) + (size_t)row * NKV * HDIM + hh * HDIM; *(unsigned*)(K + d1) = w1; *(unsigned*)(K + d2) = w2;
                float* fo = p.out + O_K + (size_t)row * NKV * HDIM + hh * HDIM; *(float2*)(fo + d1) = make_float2(y1a, y1b); *(float2*)(fo + d2) = make_float2(y2a, y2b); }
            else { const int b_ = (row - MC) / LSEQ, s_ = (row - MC) % LSEQ; bf16_t* K = (bf16_t*)(p.ws + WS_LATK) + ((size_t)b_ * SKVL + s_) * NKV * HDIM + hh * HDIM; *(unsigned*)(K + d1) = w1; *(unsigned*)(K + d2) = w2; } }
    }
}
static_assert(NKV == 2 && NQ % 2 == 0 && HDIM == 128, "qkpost lane mapping");
__device__ __forceinline__ void phase_final(const Params& p, int gw, int NGW, int lane) {
    const f4 g0 = *((const f4*)p.fng + 2 * lane), g1 = *((const f4*)p.fng + 2 * lane + 1), g2 = *((const f4*)p.fng + 128 + 2 * lane), g3 = *((const f4*)p.fng + 128 + 2 * lane + 1);
    const float* sq = (const float*)(p.ws + WS_SSQ) + (size_t)3 * SSQ_STRIDE;
    for (int row = gw; row < MTOK; row += 2 * NGW) { const int row2 = row + NGW; const bool has2 = row2 < MTOK; const int r2 = has2 ? row2 : row;
        const float rsa = 1.0f / sqrtf(sq[row] * (1.0f / DM) + EPSF), rsb = 1.0f / sqrtf(sq[r2] * (1.0f / DM) + EPSF);
        const u4* ya = (const u4*)((const bf16_t*)(p.ws + WS_Y16) + (size_t)row * DM) + lane; const u4* yb = (const u4*)((const bf16_t*)(p.ws + WS_Y16) + (size_t)r2 * DM) + lane;
        const u4 a0 = ya[0], a1 = ya[64], b0 = yb[0], b1 = yb[64];
        f4* oa = (f4*)(p.out + O_Y + (size_t)row * DM) + 2 * lane; f4* ob = (f4*)(p.out + O_Y + (size_t)r2 * DM) + 2 * lane;
#define UNP_LO(V_) (f4){__uint_as_float((V_).x << 16), __uint_as_float((V_).x & 0xffff0000u), __uint_as_float((V_).y << 16), __uint_as_float((V_).y & 0xffff0000u)}
#define UNP_HI(V_) (f4){__uint_as_float((V_).z << 16), __uint_as_float((V_).z & 0xffff0000u), __uint_as_float((V_).w << 16), __uint_as_float((V_).w & 0xffff0000u)}
        oa[0] = UNP_LO(a0) * rsa * g0; oa[1] = UNP_HI(a0) * rsa * g1; oa[128] = UNP_LO(a1) * rsa * g2; oa[129] = UNP_HI(a1) * rsa * g3;
        if (has2) { ob[0] = UNP_LO(b0) * rsb * g0; ob[1] = UNP_HI(b0) * rsb * g1; ob[128] = UNP_LO(b1) * rsb * g2; ob[129] = UNP_HI(b1) * rsb * g3; }
#undef UNP_LO
#undef UNP_HI
    }
}
__device__ __forceinline__ void gemm_call_halves(LAS unsigned char* lds, const bf16_t* A, const bf16_t* Bt, int N, int K, const EpiRes& E) {
    pg8::Gemm g{A, Bt, MTOK, N, K}; WholeThenHalfOrder S; S.init(MTOK, N, K, (int)gridDim.x, (int)blockIdx.x);
    pg8::gemm_phase<EpiRes, WholeThenHalfOrder, true, true>((PG8_LAS unsigned char*)lds, g, S, E);
}
template <class Epi> __device__ __forceinline__ void gemm_call(LAS unsigned char* lds, const bf16_t* A, const bf16_t* Bt, int N, int K, const Epi& E) {
    pg8::Gemm g{A, Bt, MTOK, N, K}; pg8::StaticOrder S; S.init(MTOK, N, K, (int)gridDim.x, (int)blockIdx.x);
    pg8::gemm_phase<Epi, pg8::StaticOrder, true, true>((PG8_LAS unsigned char*)lds, g, S, E);
}
#ifdef PROBE_A
#define ISTAMP(i) do { if (blockIdx.x == 0 && threadIdx.x == 0 && K == PROBE_K) *(volatile LAS unsigned*)(uintptr_t)(MISC_OFF + 4 * (i)) = (unsigned)__builtin_amdgcn_s_memrealtime(); } while (0)
#else
#define ISTAMP(i) do {} while (0)
#endif
__device__ __forceinline__ void gemm_call_split(LAS unsigned char* lds, const bf16_t* A, const bf16_t* Bt, int N, int K, const EpiRes& E, unsigned char* slab, unsigned* cnt) {
    pg8::Gemm g{A, Bt, MTOK, N, K}; WholeThenQuarterOrder S0; S0.init(MTOK, N, K, (int)gridDim.x, (int)blockIdx.x);
    pg8::gemm_phase<EpiResOrPartial, WholeThenQuarterOrder, true, true>((PG8_LAS unsigned char*)lds, g, S0, EpiResOrPartial{E, EpiPartial{slab, cnt}});
    if (S0.split) tail_reduce(E, slab, cnt, (int)gridDim.x, (int)blockIdx.x, N / 256, MTOK / 256);
}
constexpr int CW_GRP = 25600;
__device__ __forceinline__ void group_sync(unsigned* cnt, unsigned target) {
    asm volatile("s_waitcnt vmcnt(0)" ::: "memory");
    __syncthreads();
    if (tid_opaque() == 0) {
        (void)__hip_atomic_fetch_add(cnt, 1u, __ATOMIC_RELAXED, __HIP_MEMORY_SCOPE_AGENT);
        unsigned sp = 0;
        while (__hip_atomic_load(cnt, __ATOMIC_RELAXED, __HIP_MEMORY_SCOPE_AGENT) < target) { __builtin_amdgcn_s_sleep(1); if (++sp > XB_SPIN_CAP) break; }
        __builtin_amdgcn_fence(__ATOMIC_ACQUIRE, "agent"); asm volatile("s_waitcnt vmcnt(0)" ::: "memory");
    }
    __syncthreads();
}
__global__ void __launch_bounds__(NTHREADS, 2) mega_fwd(Params p) {
    extern __shared__ __attribute__((aligned(16))) unsigned char lds[];
    LAS unsigned char* L = (LAS unsigned char*)lds;
    for (int u = threadIdx.x; u < (LDS_BYTES - LDSCTL_OFF) / 4; u += NTHREADS) ((LAS unsigned*)(L + LDSCTL_OFF))[u] = 0u;
    __syncthreads();
    if ((threadIdx.x & 63) == 0) *(LAS int*)(uintptr_t)(WTAB_OFF + 4 * hw_wave_slot()) = (int)(threadIdx.x >> 6);
    __syncthreads();
    volatile LAS unsigned* MISC = (volatile LAS unsigned*)(L + MISC_OFF);
    const XcdBarrier bar = xcd_barrier_post((unsigned*)(p.ws + WS_CTL) + CW_BAR, MISC + 8);
    const int G = gridDim.x, bx = blockIdx.x; const int vcu = (G % 8 == 0) ? (bx % 8) * (G / 8) + bx / 8 : bx;
    unsigned char* ws = p.ws;
    const bf16_t* XN = (const bf16_t*)(ws + WS_XN); const bf16_t* UH = (const bf16_t*)(ws + WS_UH); const bf16_t* Hh = (const bf16_t*)(ws + WS_H); const bf16_t* Ob = (const bf16_t*)(ws + WS_O);
    float* SW0 = (float*)(ws + WS_SW); float* SWC = SW0 + (size_t)NCLS * 2 * DFF; float* SW1 = SWC + (size_t)NCLS * CIN;
    float* SSQ = (float*)(ws + WS_SSQ); float* Y = p.out + O_Y; unsigned* SPLITC = (unsigned*)(ws + WS_CTL) + CW_SPLIT;
#define WAVE_IDS() const int tid_ = tid_opaque(); const int lane_ = tid_ & 63; const int gw_ = bx * NWAVES + (tid_ >> 6); const int NGW_ = G * NWAVES
    if (G == 256) { if (bx < 192) phase_mod(p, (char*)lds, 0, bx, 192); else p0_weights<0x003u>(p, L, bx - 192, 64); }
    else { p0_weights<0x003u>(p, L, vcu, G); phase_mod(p, (char*)lds, 0, bx, G); }
    Norm0Pre n0pre; phase_norm0_pre(p, (char*)lds, bx, G, n0pre);
    xcd_barrier(bar);
    phase_norm0(p, (char*)lds, bx, G, n0pre);
    xcd_barrier(bar);
    gemm_call(L, XN, (const bf16_t*)(ws + WB_AB), ABMAIN, DM, EpiAB{(bf16_t*)(ws + WS_UPRE), (bf16_t*)(ws + WS_QKVO)});
    if (G == 256) { if (bx >= 192) p0_weights<0x0E8u>(p, L, bx - 192, 64); } else p0_weights<0x0E8u>(p, L, vcu, G);
    xcd_barrier(bar);
    if (G == 256 && NLB * MH * NBLK == 256) {
        const int u = vcu, b = u / (MH * NBLK), h = (u / NBLK) % MH, blk = u % NBLK, chain = u / NBLK;
        unsigned* gcnt = (unsigned*)(ws + WS_CTL) + CW_GRP + chain * 64;
        att::ml_passA_unit(p, (char*)lds, NCB + b, h, blk);
        group_sync(gcnt, (unsigned)NBLK);
        { const int tid_ = tid_opaque(); constexpr int PER16 = (MDK * MDK + MDK) / 8 / NBLK;
          if (tid_ < 2 * PER16) { const int dir = tid_ / PER16, it = blk * PER16 + tid_ % PER16;
              if (dir == 0) ml_scan_item<0>(p, chain * 2, b, h, it * 8); else ml_scan_item<1>(p, chain * 2 + 1, b, h, it * 8); } }
        att::MlPreC pre; att::ml_passC_preload(p, NCB + b, h, blk, pre);
        group_sync(gcnt, 2u * (unsigned)NBLK);
        att::ml_passC_unit<true, true>(p, (char*)lds, NCB + b, h, blk, pre);
        constexpr int NCX = NCB * MH;
        if (vcu < NCX) { att::ml_passC_unit<false, false>(p, (char*)lds, vcu / MH, vcu % MH, 0, att::MlPreC{}); p0_weights<0x004u>(p, L, vcu, NCX); }
        else if (vcu < 2 * NCX) { const int uc = vcu - NCX; att::ml_passA_unit(p, (char*)lds, uc / MH, uc % MH, 0); phase_conv(p, (char*)lds, 4 * (G - 2 * NCX) + uc, NCX, MTOK / 32); }
        else phase_conv(p, (char*)lds, vcu - 2 * NCX, G - 2 * NCX, 4 * (G - 2 * NCX));
    } else {
    ml_phase_A(p, lds, vcu, G);
    p0_weights<0x004u>(p, L, vcu, G);
    xcd_barrier(bar);
    { WAVE_IDS(); MlScan sc{p}; for (long i = bx * (long)NTHREADS + tid_; i < MlScan::count(); i += (long)G * NTHREADS) sc(i); }
    xcd_barrier(bar);
    ml_phase_C(p, lds, vcu, G);
    phase_conv(p, (char*)lds, vcu, G, MTOK / 32);
    }
    xcd_barrier(bar);
    gemm_call(L, UH, (const bf16_t*)(ws + WB_OUTAB), DM, DM, EpiRes{p.xp, p.xs, (bf16_t*)(ws + WS_Y16), (bf16_t*)(ws + WS_XN), SSQ + 0 * SSQ_STRIDE, modv(p, 0, 0, 2), modv(p, 0, 0, 4), p.n2g, nullptr, nullptr, 1, 0});
    { WAVE_IDS(); constexpr int NU_OUT = (MTOK / 256) * (DM / 256); const int nsec = (G == 256 && NU_OUT > G) ? NU_OUT - G : 0;
      if (bx >= nsec) { const int gw2 = (bx - nsec) * NWAVES + (tid_ >> 6), ngw2 = (G - nsec) * NWAVES;
        sw_job(p, (const bf16_t*)(ws + WB_FFI0), 2 * DFF, 0, 3, SW0, 2 * DFF, 1, gw2, ngw2, lane_);
        phase_mod(p, (char*)lds, 1, bx - nsec, G - nsec);
        p0_weights<0x110u>(p, L, bx - nsec, G - nsec); } }
    xcd_barrier(bar);
    gemm_call(L, XN, (const bf16_t*)(ws + WB_FFI0), 2 * DFF, DM, EpiFfnIn{(bf16_t*)(ws + WS_H), SSQ + 0 * SSQ_STRIDE, SW0});
    { WAVE_IDS(); constexpr int NU_FFI = (MTOK / 256) * (2 * DFF / 256); const int nfull = NU_FFI % G;
      if (nfull == 0 || bx >= nfull) { const int c0 = nfull == 0 ? 0 : nfull; sw_job(p, (const bf16_t*)(ws + WB_INC), CIN, 1, 0, SWC, CIN, 2, (bx - c0) * NWAVES + (tid_ >> 6), (G - c0) * NWAVES, lane_); } }
    xcd_barrier(bar);
    gemm_call_split(L, Hh, (const bf16_t*)(ws + WB_FFO0), DM, DFF, EpiRes{p.xp, p.xs, (bf16_t*)(ws + WS_Y16), (bf16_t*)(ws + WS_XN), SSQ + 1 * SSQ_STRIDE, modv(p, 0, 0, 5), modv(p, 1, 0, 1), p.n1g + DM, modv(p, 0, 0, 4), p.n2g, 0, 0}, (unsigned char*)Y + SLAB_BYTES, SPLITC + 1 * 4096); xcd_barrier(bar);
    gemm_call(L, XN, (const bf16_t*)(ws + WB_INC), CIN, DM, EpiQkv{(bf16_t*)(ws + WS_QRAW), (bf16_t*)(ws + WS_CTXK), (bf16_t*)(ws + WS_LATK), (bf16_t*)(ws + WS_CTXV), (bf16_t*)(ws + WS_LATV), p.out + O_K, p.out + O_V,
                                                                   SSQ + 1 * SSQ_STRIDE, SWC, p.kng, (LAS float*)(L + 132096)});
    if (G == 256) { if (bx >= 224) { { WAVE_IDS(); phase_cachecvt(p, (bx - 224) * NTHREADS + tid_, 32 * NTHREADS); } p0_weights<0x200u>(p, L, bx - 224, 32); } }
    else { { WAVE_IDS(); phase_cachecvt(p, bx * NTHREADS + tid_, G * NTHREADS); } p0_weights<0x200u>(p, L, vcu, G); }
    xcd_barrier(bar);
    { const int tid_ = tid_opaque(), lane_ = tid_ & 63, wv_ = __builtin_amdgcn_readfirstlane(tid_ >> 6); char* T_ = (char*)lds + wv_ * 16384;
      if (G == 256) { const int grp = vcu >> 5, wg = (vcu & 31) * NWAVES + wv_;
          constexpr int NTG = VT8_TL + 4 * NKV * VT8_TC;
          const int part = wg < 128 ? 1 : 2, wt = wg & 127;
          if (wt < VT8_TL) vt8_do(p, grp * VT8_TL + wt, T_, lane_, part);
          else if (wt < NTG) { const int tl = VT8_NL + (grp * 4 * NKV) * VT8_TC + (wt - VT8_TL); if (tl < VT8_NT) vt8_do(p, tl, T_, lane_, part); }
          group_sync((unsigned*)(ws + WS_CTL) + CW_GRP + (16 + grp) * 64, 32u); }
      else { for (int tl = bx * NWAVES + wv_; tl < VT8_NT; tl += G * NWAVES) vt8_do(p, tl, T_, lane_); xcd_barrier(bar); } }
    attn_phase(p, lds, vcu, G);
    { WAVE_IDS(); constexpr int NUC_ = NCB * NQ * (CSEQ / 256); const int nctx = (G == 256 && NUC_ < G) ? NUC_ : 0;
      if (vcu >= nctx) { p0_weights<0x400u>(p, L, vcu - nctx, G - nctx);
        sw_job(p, (const bf16_t*)(ws + WB_FFI1), 2 * DFF, 1, 3, SW1, 2 * DFF, 1, (vcu - nctx) * NWAVES + (tid_ >> 6), (G - nctx) * NWAVES, lane_); } }
    xcd_barrier(bar);
    gemm_call_halves(L, Ob, (const bf16_t*)(ws + WB_OUTC), DM, DM, EpiRes{p.xp, p.xs, (bf16_t*)(ws + WS_Y16), (bf16_t*)(ws + WS_XN), SSQ + 2 * SSQ_STRIDE, modv(p, 1, 0, 2), modv(p, 1, 0, 4), p.n2g + DM, modv(p, 1, 0, 1), p.n1g + DM, 0, 0});
    xcd_barrier(bar);
    gemm_call(L, XN, (const bf16_t*)(ws + WB_FFI1), 2 * DFF, DM, EpiFfnIn{(bf16_t*)(ws + WS_H), SSQ + 2 * SSQ_STRIDE, SW1}); xcd_barrier(bar);
    gemm_call_split(L, Hh, (const bf16_t*)(ws + WB_FFO1), DM, DFF, EpiRes{p.xp, p.xs, (bf16_t*)(ws + WS_Y16), (bf16_t*)(ws + WS_XN), SSQ + 3 * SSQ_STRIDE, modv(p, 1, 0, 5), modv(p, 1, 0, 1), nullptr, modv(p, 1, 0, 4), p.n2g + DM, 0, 0}, (unsigned char*)Y + SLAB_BYTES, SPLITC + 3 * 4096); xcd_barrier(bar);
    { WAVE_IDS(); phase_final(p, gw_, NGW_, lane_); }
#undef WAVE_IDS
}
static Params make_params(void* const* d_in, void* d_out, void* d_ws) {
    Params p{}; const float** pp = (const float**)&p; for (int i = 0; i < 28; ++i) pp[i] = (const float*)d_in[i];
    p.out = (float*)d_out; p.ws = (unsigned char*)d_ws; return p;
}
extern "C" void kernel_launch(void* const* d_in, const int* in_sizes, int n_in, void* d_out, int out_size, void* d_ws, size_t ws_size, hipStream_t stream) {
    static int grid = 0;
    if (grid == 0) {
        if (n_in != 28 || (size_t)out_size != O_END || ws_size < WS_END || in_sizes[0] != MC * DM || in_sizes[1] != ML * DM) {
            fprintf(stderr, "kernel_launch: shape mismatch n_in %d out %d (want %zu) ws %zu (want %zu)\n", n_in, out_size, (size_t)O_END, ws_size, (size_t)WS_END); grid = -1; return; }
        int dev = 0, cus = 0;
        if (hipGetDevice(&dev) != hipSuccess || hipDeviceGetAttribute(&cus, hipDeviceAttributeMultiprocessorCount, dev) != hipSuccess) { grid = -1; return; }
        if (hipFuncSetAttribute((const void*)mega_fwd, hipFuncAttributeMaxDynamicSharedMemorySize, LDS_BYTES) != hipSuccess) { fprintf(stderr, "hipFuncSetAttribute failed\n"); grid = -1; return; }
        int per_cu = 0; (void)hipOccupancyMaxActiveBlocksPerMultiprocessor(&per_cu, (const void*)mega_fwd, NTHREADS, LDS_BYTES); (void)hipGetLastError();
        if (per_cu < 1) fprintf(stderr, "kernel_launch: occupancy query says %d blocks/CU\n", per_cu);
        grid = cus;
    }
    if (grid < 0) return;
    hipMemsetAsync((char*)d_ws + WS_CTL, 0, CTL_ZERO_BYTES, stream);
    Params p = make_params(d_in, d_out, d_ws);
    hipLaunchKernelGGL(mega_fwd, dim3(grid), dim3(NTHREADS), LDS_BYTES, stream, p);
}
```

```cpp
#ifdef HOST_TEST
#include <cmath>
#include <cstdio>
#include <cstdlib>
#include <cstring>
#include <cstdint>
#include <vector>
#define HD_FN inline
#define DEV_FN inline
#else
#include <hip/hip_runtime.h>
#include <cstdio>
#include <cstdint>
#define HD_FN __host__ __device__ __forceinline__
#define DEV_FN __device__ __forceinline__
#endif

#ifdef TINY
constexpr int DM = 512, NCB = 2, CSEQ = 128, NLB = 2, LSEQ = 128, PAST = 128;
#else
constexpr int DM = 1024, NCB = 16, CSEQ = 256, NLB = 4, LSEQ = 4096, PAST = 256;
#endif
constexpr int GRIDW = 64, CCH = DM / 2, CWID = 31, MH = 4, MDK = CCH / MH, MW = CCH, NGATE = 16;
constexpr int ABIN = 2 * CCH + 4 * MW + NGATE, ABMAIN = 2 * CCH + 4 * MW;
constexpr int HDIM = 128, NQ = DM / HDIM, NKV = 2, GRP = NQ / NKV, CIN = (NQ + 2 * NKV) * HDIM;
constexpr int DFF = ((8 * DM + 3 * 256 - 1) / (3 * 256)) * 256;
constexpr int MC = NCB * CSEQ, ML = NLB * LSEQ, MTOK = MC + ML, NCLS = 1 + NLB, SKVL = LSEQ + PAST;
constexpr float EPSF = 1e-6f;
constexpr int NSEQ = NCB + NLB;

constexpr size_t O_Y = 0, O_C = (size_t)MTOK * DM, O_N = O_C + (size_t)NCB * 2 * MH * MDK * MDK, O_M = O_N + (size_t)NCB * 2 * MH * MDK,
                 O_K = O_M + (size_t)NCB * 2 * MH, O_V = O_K + (size_t)NCB * CSEQ * NKV * HDIM, O_END = O_V + (size_t)NCB * CSEQ * NKV * HDIM;

constexpr size_t MiB = 1u << 20;
#ifdef TINY
constexpr size_t WSCALE = 1;
#endif
constexpr size_t WS_CTL = 0, CTL_ZERO_BYTES = 1 * MiB;
constexpr size_t WS_MOD = 128 * 1024;
constexpr size_t WS_SW = 1 * MiB + 256 * 1024;
constexpr size_t WS_SSQ = 512 * 1024;
constexpr int SSQ_STRIDE = 32768;
constexpr size_t WS_DEN = 232 * MiB;
constexpr size_t WS_WB = 2 * MiB;
constexpr size_t WS_XN = 50 * MiB;
constexpr size_t WS_UPRE = 90 * MiB;
constexpr size_t WS_QKVO = 110 * MiB;
constexpr size_t WS_UH = 190 * MiB;
constexpr size_t WS_GATES = 230 * MiB;
constexpr size_t WS_HS = 50 * MiB;
constexpr size_t WS_Y16 = 90 * MiB;
constexpr size_t WS_H = 130 * MiB;
constexpr size_t WS_QRAW = 130 * MiB;
constexpr size_t WS_LATK = 170 * MiB, WS_LATV = 179 * MiB, WS_CTXK = 188 * MiB, WS_CTXV = 190 * MiB;
constexpr size_t WS_KRAW = 192 * MiB;
constexpr size_t WS_O = 202 * MiB;
constexpr size_t WS_VT8L = 246 * MiB, WS_VT8C = 251 * MiB;
constexpr size_t WS_K8L = 90 * MiB, WS_K8C = 95 * MiB;
constexpr size_t WS_END = 256 * MiB;

typedef unsigned short bf16_t;
HD_FN float bf2f(bf16_t h) { unsigned u = (unsigned)h << 16; return __builtin_bit_cast(float, u); }
HD_FN bf16_t f2bf(float f) { unsigned u = __builtin_bit_cast(unsigned, f); return (bf16_t)((u + 0x7fffu + ((u >> 16) & 1u)) >> 16); }
HD_FN float rbf(float f) { return bf2f(f2bf(f)); }
HD_FN float sigmoidf_(float x) { return 1.0f / (1.0f + expf(-x)); }
HD_FN float siluf_(float x) { return x * sigmoidf_(x); }
HD_FN float logsigmoidf_(float x) { return x >= 0.f ? -log1pf(expf(-x)) : x - log1pf(expf(x)); }
HD_FN int cls_of(int row) { return row < MC ? 0 : 1 + (row - MC) / LSEQ; }
HD_FN int seqlen_of(int row) { return row < MC ? CSEQ : LSEQ; }
HD_FN int seq_base(int sid) { return sid < NCB ? sid * CSEQ : MC + (sid - NCB) * LSEQ; }
HD_FN int pos_of(int row) { return row < MC ? row % CSEQ : (row - MC) % LSEQ; }

struct Params {
    const float *xp, *xs, *c, *stC, *stn, *stm, *ck, *cv, *cctx, *wmod, *bmod, *n1g, *n2g, *winab, *bgate, *convw, *convb, *lng, *lnb, *mng,
        *woutab, *winc, *qng, *kng, *woutc, *wffi, *wffo, *fng;
    float* out; unsigned char* ws;
};
HD_FN const float* xrow(const Params& p, int row) { return row < MC ? p.xp + (size_t)row * DM : p.xs + (size_t)(row - MC) * DM; }
HD_FN const float* modv(const Params& p, int l, int cls, int which) { return (const float*)(p.ws + WS_MOD) + ((size_t)(l * NCLS + cls) * 6 + which) * DM; }
constexpr int NWAVES = 8, NTHREADS = NWAVES * 64;
constexpr int RING_OFF = 0, RING_BYTES = 131072;
constexpr int LDSCTL_OFF = RING_BYTES, MISC_OFF = LDSCTL_OFF + 320;
constexpr int LDS_BYTES = 147456;
constexpr int CW_TMO = 0, CW_CODE = 1, CW_BAR = 4096;
#define GAS __attribute__((address_space(1)))
#define LAS __attribute__((address_space(3)))
constexpr int WTAB_OFF = LDSCTL_OFF + 768;
__device__ __forceinline__ int lane_id() { int l; asm volatile("v_mbcnt_lo_u32_b32 %0, -1, 0\n\tv_mbcnt_hi_u32_b32 %0, -1, %0" : "=v"(l)); return l; }
__device__ __forceinline__ unsigned hw_wave_slot() { return (unsigned)__builtin_amdgcn_s_getreg(63492) & 63u; }
__device__ __forceinline__ int tid_opaque() { const int w = __builtin_amdgcn_readfirstlane(*(const LAS int*)(uintptr_t)(WTAB_OFF + 4 * hw_wave_slot())); int t = (w << 6) | lane_id(); asm volatile("" : "+v"(t)); return t; }
template <int M> __device__ __forceinline__ float swz_xor(float v) { return __int_as_float(__builtin_amdgcn_ds_swizzle(__float_as_int(v), (M << 10) | 0x1f)); }
__device__ __forceinline__ float half_sum(float v) { auto rr = __builtin_amdgcn_permlane32_swap(__float_as_uint(v), __float_as_uint(v), false, false); return __uint_as_float(rr[0]) + __uint_as_float(rr[1]); }
__device__ __forceinline__ float half_max(float v) { auto rr = __builtin_amdgcn_permlane32_swap(__float_as_uint(v), __float_as_uint(v), false, false); return fmaxf(__uint_as_float(rr[0]), __uint_as_float(rr[1])); }
__device__ __forceinline__ float lane_get(float v, int src_lane) { return __int_as_float(__builtin_amdgcn_ds_bpermute(src_lane << 2, __float_as_int(v))); }
typedef GAS unsigned gu32;
#define RLX_AGENT __ATOMIC_RELAXED, __HIP_MEMORY_SCOPE_AGENT
#define XB_TMO      128
#define XB_XCNT(j)  (256  + 64 * (j))
#define XB_XSUB(j)  (1280 + 64 * (j))
#define XB_XGEN(j)  (2304 + 64 * (j))
#define XB_TOP      3328
#define XB_TOPGEN   3392
#define XCD_BAR_WORDS 3456
#define XB_SPIN_CAP (1u << 22)
__device__ __forceinline__ unsigned xb_ld(unsigned* p)              { return __hip_atomic_load(p, __ATOMIC_RELAXED, __HIP_MEMORY_SCOPE_AGENT); }
__device__ __forceinline__ unsigned xb_add(unsigned* p, unsigned v) { return __hip_atomic_fetch_add(p, v, __ATOMIC_RELAXED, __HIP_MEMORY_SCOPE_AGENT); }
__device__ __forceinline__ unsigned xb_xcc_id() { return (unsigned)__builtin_amdgcn_s_getreg((3 << 11) | 20) & 0xFu; }
#define XB_SPIN(cond, bar) do { unsigned _sp = 0; while (cond) { __builtin_amdgcn_s_sleep(1); \
    if ((++_sp & 255u) == 0u) { if (xb_ld(&(bar)[XB_TMO])) break; if (_sp > XB_SPIN_CAP) { atomicAdd(&(bar)[XB_TMO], 1u); break; } } } } while (0)
struct XcdBarrier { unsigned* bar; unsigned x; volatile LAS unsigned* st; };
__device__ __forceinline__ XcdBarrier xcd_barrier_post(unsigned* bar, volatile LAS unsigned* st) {
    XcdBarrier b; b.bar = bar; b.x = xb_xcc_id(); b.st = st;
    if (tid_opaque() == 0) (void)xb_add(&bar[XB_XCNT(b.x)], 1u);
    return b;
}
__device__ __forceinline__ void xcd_barrier_complete(unsigned* bar, unsigned x, unsigned& nloc, unsigned& nx) {
    const unsigned G = gridDim.x * gridDim.y * gridDim.z;
    unsigned sum, cnt, mine, sp = 0u;
    for (;;) {
        sum = 0u; cnt = 0u; mine = 0u;
#pragma unroll
        for (unsigned j = 0; j < 16; ++j) { const unsigned c = xb_ld(&bar[XB_XCNT(j)]); sum += c; cnt += (c > 0u) ? 1u : 0u; mine = (j == x) ? c : mine; }
        if (sum == G) break;
        __builtin_amdgcn_s_sleep(1);
        if ((++sp & 255u) == 0u) { if (xb_ld(&bar[XB_TMO])) break; if (sp > XB_SPIN_CAP) { atomicAdd(&bar[XB_TMO], 1u); break; } }
    }
    nloc = mine > 0u ? mine : 1u; nx = cnt > 0u ? cnt : 1u;
}
__device__ __forceinline__ void xcd_barrier(const XcdBarrier& b) {
    asm volatile("s_waitcnt vmcnt(0)" ::: "memory");
    __syncthreads();
    if (tid_opaque() == 0) {
        unsigned* bar = b.bar;
        __builtin_amdgcn_s_waitcnt(0);
        unsigned nloc = b.st[0], nx = b.st[1];
        if (nloc == 0u) { xcd_barrier_complete(bar, b.x, nloc, nx); b.st[0] = nloc; b.st[1] = nx; }
        const unsigned old = xb_add(&bar[XB_XSUB(b.x)], 1u);
        const unsigned gen = old / nloc;
        if (old + 1u == (gen + 1u) * nloc) {
            __builtin_amdgcn_fence(__ATOMIC_RELEASE, "agent");
            asm volatile("s_waitcnt vmcnt(0)" ::: "memory");
            const unsigned og = xb_add(&bar[XB_TOP], 1u);
            const unsigned tg = og / nx;
            if (og + 1u == (tg + 1u) * nx) xb_add(&bar[XB_TOPGEN], 1u);
            else XB_SPIN(xb_ld(&bar[XB_TOPGEN]) == tg, bar);
            __builtin_amdgcn_fence(__ATOMIC_ACQUIRE, "agent");
            xb_add(&bar[XB_XGEN(b.x)], 1u);
            asm volatile("s_waitcnt vmcnt(0)" ::: "memory");
        } else {
            XB_SPIN(xb_ld(&bar[XB_XGEN(b.x)]) == gen, bar);
            __builtin_amdgcn_fence(__ATOMIC_ACQUIRE, "agent");
            asm volatile("s_waitcnt vmcnt(0)" ::: "memory");
        }
    }
    __syncthreads();
}

__device__ __forceinline__ void group_arrive(unsigned* cnt) {
    asm volatile("s_waitcnt vmcnt(0)" ::: "memory");
    __syncthreads();
    if (tid_opaque() == 0) (void)__hip_atomic_fetch_add(cnt, 1u, __ATOMIC_RELAXED, __HIP_MEMORY_SCOPE_AGENT);
}
__device__ __forceinline__ void group_wait(unsigned* cnt, unsigned target) {
    if (tid_opaque() == 0) { unsigned sp = 0;
        while (__hip_atomic_load(cnt, __ATOMIC_RELAXED, __HIP_MEMORY_SCOPE_AGENT) < target) { __builtin_amdgcn_s_sleep(1); if (++sp > XB_SPIN_CAP) break; }
        __builtin_amdgcn_fence(__ATOMIC_ACQUIRE, "agent"); asm volatile("s_waitcnt vmcnt(0)" ::: "memory"); }
    __syncthreads();
}
namespace pg8 {
#define PG8_LAS __attribute__((address_space(3)))
typedef unsigned short bf16_t;
typedef short bf16x8 __attribute__((ext_vector_type(8)));
typedef float f32x4 __attribute__((ext_vector_type(4)));
typedef unsigned u32x4 __attribute__((ext_vector_type(4)));
constexpr int BM = 256, BK = 64, HALF = 128, HTB = HALF * BK * 2  , STAGE_BYTES = 8 * HTB, NXCD = 8, WGM = 8;

__host__ __device__ __forceinline__ int lds_byte(int r, int c) { const int st = (r >> 4) * 2 + (c >> 5), rr = r & 15, cc = c & 31, ob = rr * 64 + cc * 2; return st * 1024 + (ob ^ (((ob >> 9) & 1) << 5)); }
__host__ __device__ __forceinline__ void stage_rc(int b, int& R, int& C) { const int st = b / 1024, sb = b % 1024, swz = sb ^ (((sb >> 9) & 1) << 5); R = (st >> 1) * 16 + swz / 64; C = (st & 1) * 32 + (swz % 64) / 2; }
__host__ __device__ __forceinline__ int perm32(int rho) { const int n = rho >> 4, i = rho & 15; return 8 * (i >> 2) + 4 * n + (i & 3); }

struct Unit { int pm, pn, k0, nt, role, slot; };
struct Gemm { const bf16_t* A; const bf16_t* Bt; int M, N, K; };

struct StaticOrder {
    int nM, nN, nwg, G, c, ntK;
    __host__ __device__ void init(int M, int N, int K, int G_, int c_) { nM = M / BM; nN = N / BM; nwg = nM * nN; G = G_; c = c_; ntK = K / BK; }
    __host__ __device__ void map(int L, Unit& u) const { int wgid = L; { const int q = nwg / NXCD, r = nwg % NXCD, xcd = wgid % NXCD, off = wgid / NXCD; wgid = (xcd < r ? xcd * (q + 1) : r * (q + 1) + (xcd - r) * q) + off; }
        const int nig = WGM * nN, gid = wgid / nig, fm = gid * WGM, gsz = (nM - fm) < WGM ? (nM - fm) : WGM; u.pm = fm + ((wgid % nig) % gsz); u.pn = (wgid % nig) / gsz; }
    __host__ __device__ bool next(int i, Unit& u) const {
        const long L = (long)i * G + c; if (L >= nwg) return false;
        int wgid = (int)L; { const int q = nwg / NXCD, r = nwg % NXCD, xcd = wgid % NXCD, off = wgid / NXCD; wgid = (xcd < r ? xcd * (q + 1) : r * (q + 1) + (xcd - r) * q) + off; }
        const int nig = WGM * nN, gid = wgid / nig, fm = gid * WGM, gsz = (nM - fm) < WGM ? (nM - fm) : WGM;
        u.pm = fm + ((wgid % nig) % gsz); u.pn = (wgid % nig) / gsz; u.k0 = 0; u.nt = ntK; u.role = 0; u.slot = 0; return true;
    }
    __device__ __forceinline__ void a_ready(const Unit&) const {}
    __device__ __forceinline__ void done(const Unit&) const {}
};

__device__ __forceinline__ unsigned cvt_pk_bf16(float lo, float hi) { unsigned r; asm volatile("v_cvt_pk_bf16_f32 %0, %1, %2" : "=v"(r) : "v"(lo), "v"(hi)); return r; }
typedef float f32x2 __attribute__((ext_vector_type(2)));
template <class Epi, class Sched, bool ALIGN_EPI = false, bool SP2 = false>
__device__ __forceinline__ void gemm_phase(PG8_LAS unsigned char* lds, const Gemm g, const Sched& S, const Epi& E) {
    const int tid = tid_opaque(), wid = __builtin_amdgcn_readfirstlane(tid >> 6), lane = tid & 63, wr = wid >> 2, wc = wid & 3, fr = lane & 15, fq = lane >> 4;
    const int K = g.K;
    unsigned voffA[2], voffB[2];
#pragma unroll
    for (int i = 0; i < 2; ++i) { int R, C; stage_rc(tid * 16 + i * 8192, R, C); const int Rb = Epi::PERM ? ((R & ~31) + perm32(R & 31)) : R;
        voffA[i] = (unsigned)(R * K + C) * 2u; voffB[i] = (unsigned)(Rb * K + C) * 2u; }
    const size_t kstep = (size_t)(BK * 2);
    const size_t hstep = (size_t)HALF * K * 2;
    const size_t tstep = 2 * hstep;
    const unsigned ldsw = (unsigned)wid * 1024u;
    const int aoff = lds_byte(wr * 64 + fr, fq * 8), boff = lds_byte(wc * 32 + fr, fq * 8);
#define PG8_SA(b, h) (((b) * 2 + (h)) * HTB)
#define PG8_SB(b, h) ((4 + (b) * 2 + (h)) * HTB)
#define PG8_STAGE(bufoff, gbase, voff) do { _Pragma("unroll") for (int _i = 0; _i < 2; ++_i) \
        __builtin_amdgcn_global_load_lds((const unsigned*)((const char*)(gbase) + (voff)[_i]), (PG8_LAS unsigned*)(lds + (bufoff) + ldsw + _i * 8192), 16, 0, 0); } while (0)
#define PG8_LDA(dst, b, h) do { _Pragma("unroll") for (int m = 0; m < 4; ++m) _Pragma("unroll") for (int k = 0; k < 2; ++k) dst[m][k] = *(const PG8_LAS bf16x8*)(lds + PG8_SA(b, h) + aoff + m * 2048 + k * 1024); } while (0)
#define PG8_LDB(dst, b, h) do { _Pragma("unroll") for (int n = 0; n < 2; ++n) _Pragma("unroll") for (int k = 0; k < 2; ++k) dst[n][k] = *(const PG8_LAS bf16x8*)(lds + PG8_SB(b, h) + boff + n * 2048 + k * 1024); } while (0)
#define PG8_MMA(ai, bj, At, Bt) do { __builtin_amdgcn_s_setprio(1); _Pragma("unroll") for (int m = 0; m < 4; ++m) _Pragma("unroll") for (int n = 0; n < 2; ++n) _Pragma("unroll") for (int k = 0; k < 2; ++k) \
        acc[ai][bj][m][n] = __builtin_amdgcn_mfma_f32_16x16x32_bf16(Bt[n][k], At[m][k], acc[ai][bj][m][n], 0, 0, 0); __builtin_amdgcn_s_setprio(0); } while (0)
#define PG8_WAIT_V(n) asm volatile("s_waitcnt vmcnt(" #n ")" ::: "memory")
#define PG8_WAIT_L(n) asm volatile("s_waitcnt lgkmcnt(" #n ")" ::: "memory")
#define PG8_BAR __builtin_amdgcn_s_barrier()
#define PG8_SCHED __builtin_amdgcn_sched_barrier(0)
    Unit cur, nxt; int ui = 0;
    if (!S.next(0, cur)) return;
    f32x4 acc[2][2][4][2];
#pragma unroll
    for (int a = 0; a < 2; ++a)
#pragma unroll
        for (int b = 0; b < 2; ++b)
#pragma unroll
            for (int m = 0; m < 4; ++m)
#pragma unroll
                for (int n = 0; n < 2; ++n) acc[a][b][m][n] = (f32x4){0.f, 0.f, 0.f, 0.f};
    bf16x8 At[4][2], B0[2][2], B1[2][2];
    const char* cA = (const char*)g.A + (size_t)cur.pm * tstep + (size_t)cur.k0 * kstep; const char* cB = (const char*)g.Bt + (size_t)cur.pn * tstep + (size_t)cur.k0 * kstep; int nt = cur.nt;
    S.a_ready(cur);
    if constexpr (SP2) {
        PG8_STAGE(PG8_SB(0, 0), cB, voffB); PG8_STAGE(PG8_SB(0, 1), cB + hstep, voffB); PG8_STAGE(PG8_SA(0, 0), cA, voffA); PG8_STAGE(PG8_SA(0, 1), cA + hstep, voffA);
        if (wr == 1) PG8_BAR;
        PG8_WAIT_V(2); PG8_BAR;
        PG8_STAGE(PG8_SB(1, 0), cB + kstep, voffB); PG8_STAGE(PG8_SA(1, 0), cA + kstep, voffA); PG8_STAGE(PG8_SB(1, 1), cB + hstep + kstep, voffB);
        PG8_WAIT_V(6); PG8_BAR;
    } else {
        PG8_STAGE(PG8_SB(0, 0), cB, voffB); PG8_STAGE(PG8_SA(0, 0), cA, voffA); PG8_STAGE(PG8_SB(0, 1), cB + hstep, voffB); PG8_STAGE(PG8_SA(0, 1), cA + hstep, voffA);
        if (wr == 1) PG8_BAR;
        PG8_WAIT_V(4); PG8_BAR;
        PG8_STAGE(PG8_SB(1, 0), cB + kstep, voffB); PG8_STAGE(PG8_SA(1, 0), cA + kstep, voffA); PG8_STAGE(PG8_SB(1, 1), cB + hstep + kstep, voffB);
        PG8_WAIT_V(6); PG8_BAR;
    }
    for (;;) {
        const bool has_next = S.next(ui + 1, nxt);
        const char* nA = has_next ? (const char*)g.A + (size_t)nxt.pm * tstep + (size_t)nxt.k0 * kstep : cA; const char* nB = has_next ? (const char*)g.Bt + (size_t)nxt.pn * tstep + (size_t)nxt.k0 * kstep : cB;
        for (int t = 0; t < nt; t += 2) {
            const bool last = (t == nt - 2);
            const char* a1 = cA + (size_t)(t + 1) * kstep;
            const char* a2 = last ? nA : cA + (size_t)(t + 2) * kstep; const char* b2 = last ? nB : cB + (size_t)(t + 2) * kstep;
            const char* a3 = a2 + kstep; const char* b3 = b2 + kstep;
            if (last && has_next) S.a_ready(nxt);
            if constexpr (SP2) {
            PG8_LDB(B0, 0, 0); PG8_LDB(B1, 0, 1); PG8_SCHED; PG8_LDA(At, 0, 0); PG8_STAGE(PG8_SA(1, 1), a1 + hstep, voffA);
            PG8_WAIT_V(8); PG8_WAIT_L(0); PG8_BAR; PG8_MMA(0, 0, At, B0); PG8_MMA(0, 1, At, B1); PG8_BAR; PG8_SCHED;
            PG8_LDA(At, 0, 1); PG8_STAGE(PG8_SB(0, 0), b2, voffB); PG8_STAGE(PG8_SB(0, 1), b2 + hstep, voffB); PG8_STAGE(PG8_SA(0, 0), a2, voffA);
            PG8_WAIT_V(8); PG8_WAIT_L(0); PG8_BAR; PG8_MMA(1, 0, At, B0); PG8_MMA(1, 1, At, B1); PG8_BAR; PG8_SCHED;
            PG8_LDB(B0, 1, 0); PG8_LDB(B1, 1, 1); PG8_SCHED; PG8_LDA(At, 1, 0); PG8_STAGE(PG8_SA(0, 1), a2 + hstep, voffA);
            PG8_WAIT_V(8); PG8_WAIT_L(0); PG8_BAR; PG8_MMA(0, 0, At, B0); PG8_MMA(0, 1, At, B1); PG8_BAR; PG8_SCHED;
            PG8_LDA(At, 1, 1); PG8_STAGE(PG8_SB(1, 0), b3, voffB); PG8_STAGE(PG8_SB(1, 1), b3 + hstep, voffB); PG8_STAGE(PG8_SA(1, 0), a3, voffA);
            PG8_WAIT_V(8); PG8_WAIT_L(0); PG8_BAR; PG8_MMA(1, 0, At, B0); PG8_MMA(1, 1, At, B1); PG8_BAR; PG8_SCHED;
            } else {
            PG8_LDB(B0, 0, 0); PG8_SCHED; PG8_LDA(At, 0, 0); PG8_STAGE(PG8_SA(1, 1), a1 + hstep, voffA);
            PG8_WAIT_L(8); PG8_BAR; PG8_WAIT_L(0); PG8_MMA(0, 0, At, B0); PG8_BAR; PG8_SCHED;
            PG8_LDB(B1, 0, 1); PG8_STAGE(PG8_SB(0, 0), b2, voffB);
            PG8_BAR; PG8_WAIT_L(0); PG8_MMA(0, 1, At, B1); PG8_BAR;
            PG8_LDA(At, 0, 1); PG8_STAGE(PG8_SA(0, 0), a2, voffA);
            PG8_BAR; PG8_WAIT_L(0); PG8_MMA(1, 0, At, B0); PG8_BAR; PG8_SCHED;
            PG8_STAGE(PG8_SB(0, 1), b2 + hstep, voffB);
            PG8_WAIT_V(6); PG8_BAR; PG8_MMA(1, 1, At, B1); PG8_BAR;
            PG8_LDB(B0, 1, 0); PG8_SCHED; PG8_LDA(At, 1, 0); PG8_STAGE(PG8_SA(0, 1), a2 + hstep, voffA);
            PG8_WAIT_L(8); PG8_BAR; PG8_WAIT_L(0); PG8_MMA(0, 0, At, B0); PG8_BAR; PG8_SCHED;
            PG8_LDB(B1, 1, 1); PG8_STAGE(PG8_SB(1, 0), b3, voffB);
            PG8_BAR; PG8_WAIT_L(0); PG8_MMA(0, 1, At, B1); PG8_BAR;
            PG8_LDA(At, 1, 1); PG8_STAGE(PG8_SA(1, 0), a3, voffA);
            PG8_BAR; PG8_WAIT_L(0); PG8_MMA(1, 0, At, B0); PG8_BAR; PG8_SCHED;
            PG8_STAGE(PG8_SB(1, 1), b3 + hstep, voffB);
            PG8_WAIT_V(6); PG8_BAR; PG8_MMA(1, 1, At, B1); PG8_BAR;
            }
        }
        if constexpr (ALIGN_EPI) { if (wr == 0) PG8_BAR; }
        if constexpr (!Epi::AFTER_DRAIN) { const int t_ = tid_opaque(), w_ = __builtin_amdgcn_readfirstlane(t_ >> 6), l_ = t_ & 63;
            E(acc, cur, w_ >> 2, w_ & 3, l_ & 15, l_ >> 4); S.done(cur); }
        if (!has_next) break;
#pragma unroll
        for (int a = 0; a < 2; ++a)
#pragma unroll
            for (int b = 0; b < 2; ++b)
#pragma unroll
                for (int m = 0; m < 4; ++m)
#pragma unroll
                    for (int n = 0; n < 2; ++n) acc[a][b][m][n] = (f32x4){0.f, 0.f, 0.f, 0.f};
        cur = nxt; cA = nA; cB = nB; nt = cur.nt; ++ui;
        if constexpr (ALIGN_EPI) { if (wr == 1) PG8_BAR; }
    }
    PG8_WAIT_V(0);
    if constexpr (!ALIGN_EPI) { if (wr == 0) PG8_BAR; }
    PG8_BAR;
    if constexpr (Epi::AFTER_DRAIN) { E.fused(acc, cur, wr, wc, fr, fq, lds, wid, lane); S.done(cur); }
#undef PG8_SA
#undef PG8_SB
#undef PG8_STAGE
#undef PG8_LDA
#undef PG8_LDB
#undef PG8_MMA
#undef PG8_WAIT_V
#undef PG8_WAIT_L
#undef PG8_BAR
#undef PG8_SCHED
}
}
constexpr size_t WB_AB = 2 * MiB, WB_OUTAB = 8 * MiB, WB_FFI0 = 10 * MiB, WB_FFO0 = 21 * MiB, WB_INC = 27 * MiB, WB_OUTC = 30 * MiB, WB_FFI1 = 32 * MiB, WB_FFO1 = 43 * MiB;
static_assert(WB_FFO1 + (size_t)DM * DFF * 2 <= WS_XN && WB_AB + (size_t)ABMAIN * DM * 2 <= WB_OUTAB && WB_FFI0 + (size_t)2 * DFF * DM * 2 <= WB_FFO0 && WB_FFO0 + (size_t)DM * DFF * 2 <= WB_INC &&
              WB_INC + (size_t)CIN * DM * 2 <= WB_OUTC && WB_FFI1 + (size_t)2 * DFF * DM * 2 <= WB_FFO1, "weight copy map");

typedef unsigned v4u __attribute__((ext_vector_type(4)));
typedef unsigned v2u __attribute__((ext_vector_type(2)));
typedef float f32x4 __attribute__((ext_vector_type(4)));
__device__ __forceinline__ unsigned pk2(float lo, float hi) { return (unsigned)f2bf(lo) | ((unsigned)f2bf(hi) << 16); }
__device__ __forceinline__ float fsigmoid(float x) { return __builtin_amdgcn_rcpf(1.0f + __builtin_amdgcn_exp2f(-1.4426950408889634f * x)); }

HD_FN int kperm_dim(int c) { const int wc = c >> 5, fq = (c >> 3) & 3, n = (c >> 2) & 1, e = c & 3; return 64 * (wc >> 1) + 32 * n + 16 * (wc & 1) + 4 * fq + e; }
HD_FN int kperm_col(int d) { const int A = d >> 6, n = (d >> 5) & 1, B = (d >> 4) & 1, fq = (d >> 2) & 3, e = d & 3; return 32 * (2 * A + B) + 8 * fq + 4 * n + e; }
struct CvtItem { const float* src; bf16_t* WT; int K, ldw, k0, drow, kmode, c; };
__device__ __forceinline__ void cvt_item_load(const CvtItem& it, f32x4 (&tv)[8], int lane) {
    const int rr = lane >> 3, cg = (lane & 7) * 4; const float* s = it.src + (size_t)rr * it.ldw + cg;
#pragma unroll
    for (int i = 0; i < 8; ++i) tv[i] = *(const f32x4*)(s + (size_t)(8 * i) * it.ldw);
}
__device__ __forceinline__ void cvt_item_stage(const f32x4 (&tv)[8], LAS float* scr, int lane) {
    const int rr = lane >> 3, cg = (lane & 7) * 4;
#pragma unroll
    for (int i = 0; i < 8; ++i) { LAS float* d = scr + (8 * i + rr) * 33 + cg; d[0] = tv[i][0]; d[1] = tv[i][1]; d[2] = tv[i][2]; d[3] = tv[i][3]; }
    asm volatile("s_waitcnt lgkmcnt(0)" ::: "memory");
}
__device__ __forceinline__ void cvt_item_finish(const CvtItem& it, LAS float* scr, int lane) {
    const int c = lane & 7;
#pragma unroll
    for (int j = 0; j < 4; ++j) { const int n = (lane >> 3) + 8 * j; const LAS float* s = scr + (8 * c) * 33 + n;
        v4u o; o.x = pk2(s[0 * 33], s[1 * 33]); o.y = pk2(s[2 * 33], s[3 * 33]); o.z = pk2(s[4 * 33], s[5 * 33]); o.w = pk2(s[6 * 33], s[7 * 33]);
        const int dr = it.kmode ? (it.drow + kperm_col(((it.c + n) & 127))) : (it.drow + n);
        *(GAS v4u*)(it.WT + (size_t)dr * it.K + it.k0 + 8 * c) = o; }
    asm volatile("s_waitcnt lgkmcnt(0)" ::: "memory");
}
struct CvtJob { const float* W; bf16_t* WT; int K, ldw, c0, ncols, mode, Hn, dbase; };
constexpr __host__ __device__ int cvt_items(int K, int ncols) { return (K / 64) * (ncols / 32); }
__device__ __forceinline__ void cvt_decode(const CvtJob& j, int item, CvtItem& it) {
    const int nblk = j.ncols / 32, kb = item / nblk, nb = item % nblk; const int c = j.c0 + 32 * nb;
    int drow; if (j.mode == 0) drow = j.dbase + 32 * nb; else if (j.mode == 2) drow = j.dbase + ((32 * nb) & ~127); else { const int cc = c < j.Hn ? c : c - j.Hn; drow = 256 * (cc / 128) + (cc % 128) + (c < j.Hn ? 0 : 128); }
    it.src = j.W + (size_t)(64 * kb) * j.ldw + c; it.WT = j.WT; it.K = j.K; it.ldw = j.ldw; it.k0 = 64 * kb; it.drow = drow; it.kmode = (j.mode == 2); it.c = c;
}
template <unsigned MASK> __device__ __forceinline__ void p0_weights(const Params& p, LAS unsigned char* lds, int vcu, int G) {
    const int tid_ = tid_opaque(); const int lane = tid_ & 63, wave = __builtin_amdgcn_readfirstlane(tid_ >> 6);
    __syncthreads();
    LAS float* scr = (LAS float*)(lds + wave * 16384);
    const int gw = vcu * NWAVES + wave, NGW = G * NWAVES;
    constexpr int NI[11] = {cvt_items(DM, 2 * CCH), cvt_items(DM, 4 * MW), cvt_items(DM, DM), cvt_items(DM, 2 * DFF), cvt_items(DFF, DM), cvt_items(DM, NQ * HDIM), cvt_items(DM, NKV * HDIM), cvt_items(DM, NKV * HDIM),
                            cvt_items(DM, DM), cvt_items(DM, 2 * DFF), cvt_items(DFF, DM)};
    int total = 0;
#pragma unroll
    for (int jj = 0; jj < 11; ++jj) if ((MASK >> jj) & 1u) total += NI[jj];
    auto decode = [&](int g, CvtItem& it) {
        CvtJob j{}; int base = 0, loc = 0;
#define CVT_PICK(JJ, ...) if ((MASK >> JJ) & 1u) { if (g >= base) { j = CvtJob{__VA_ARGS__}; loc = g - base; } base += NI[JJ]; }
        CVT_PICK(0, p.winab, (bf16_t*)(p.ws + WB_AB), DM, ABIN, 0, 2 * CCH, 1, CCH, 0)
        CVT_PICK(1, p.winab, (bf16_t*)(p.ws + WB_AB), DM, ABIN, 2 * CCH, 4 * MW, 0, 0, 2 * CCH)
        CVT_PICK(2, p.woutab, (bf16_t*)(p.ws + WB_OUTAB), DM, DM, 0, DM, 0, 0, 0)
        CVT_PICK(3, p.wffi, (bf16_t*)(p.ws + WB_FFI0), DM, 2 * DFF, 0, 2 * DFF, 1, DFF, 0)
        CVT_PICK(4, p.wffo, (bf16_t*)(p.ws + WB_FFO0), DFF, DM, 0, DM, 0, 0, 0)
        CVT_PICK(5, p.winc, (bf16_t*)(p.ws + WB_INC), DM, CIN, 0, NQ * HDIM, 0, 0, 0)
        CVT_PICK(6, p.winc, (bf16_t*)(p.ws + WB_INC), DM, CIN, NQ * HDIM, NKV * HDIM, 2, 0, NQ * HDIM)
        CVT_PICK(7, p.winc, (bf16_t*)(p.ws + WB_INC), DM, CIN, (NQ + NKV) * HDIM, NKV * HDIM, 0, 0, (NQ + NKV) * HDIM)
        CVT_PICK(8, p.woutc, (bf16_t*)(p.ws + WB_OUTC), DM, DM, 0, DM, 0, 0, 0)
        CVT_PICK(9, p.wffi + (size_t)DM * 2 * DFF, (bf16_t*)(p.ws + WB_FFI1), DM, 2 * DFF, 0, 2 * DFF, 1, DFF, 0)
        CVT_PICK(10, p.wffo + (size_t)DFF * DM, (bf16_t*)(p.ws + WB_FFO1), DFF, DM, 0, DM, 0, 0, 0)
#undef CVT_PICK
        cvt_decode(j, loc, it); };
    CvtItem ia, ib; f32x4 ta[8], tb[8]; int g = gw;
    if (g < total) { decode(g, ia); cvt_item_load(ia, ta, lane); }
    if (g + NGW < total) { decode(g + NGW, ib); cvt_item_load(ib, tb, lane); }
#pragma unroll 1
    while (g < total) {
        cvt_item_stage(ta, scr, lane); const CvtItem ca = ia;
        if (g + 2 * NGW < total) { decode(g + 2 * NGW, ia); cvt_item_load(ia, ta, lane); }
        cvt_item_finish(ca, scr, lane);
        g += NGW; if (g >= total) break;
        cvt_item_stage(tb, scr, lane); const CvtItem cb = ib;
        if (g + 2 * NGW < total) { decode(g + 2 * NGW, ib); cvt_item_load(ib, tb, lane); }
        cvt_item_finish(cb, scr, lane);
        g += NGW;
    }
}

struct EpiAB {
    static constexpr bool PERM = true, AFTER_DRAIN = false;
    bf16_t* upre; bf16_t* qkvo;
    __device__ __forceinline__ void operator()(const f32x4 (&acc)[2][2][4][2], const pg8::Unit& u, int wr, int wc, int fr, int fq) const {
        const int row0 = u.pm * 256 + wr * 64 + fr, lc = wc * 32 + 8 * fq;
        if (u.pn < 4) {
#pragma unroll
            for (int ai = 0; ai < 2; ++ai)
#pragma unroll
                for (int m = 0; m < 4; ++m) { const f32x4 a0 = acc[ai][0][m][0], a1 = acc[ai][0][m][1], g0 = acc[ai][1][m][0], g1 = acc[ai][1][m][1]; v4u w;
                    w.x = pg8::cvt_pk_bf16(a0[0] * fsigmoid(g0[0]), a0[1] * fsigmoid(g0[1])); w.y = pg8::cvt_pk_bf16(a0[2] * fsigmoid(g0[2]), a0[3] * fsigmoid(g0[3]));
                    w.z = pg8::cvt_pk_bf16(a1[0] * fsigmoid(g1[0]), a1[1] * fsigmoid(g1[1])); w.w = pg8::cvt_pk_bf16(a1[2] * fsigmoid(g1[2]), a1[3] * fsigmoid(g1[3]));
                    *(v4u*)(upre + (size_t)(row0 + ai * 128 + m * 16) * CCH + 128 * u.pn + lc) = w; }
        } else {
#pragma unroll
            for (int bj = 0; bj < 2; ++bj) { const int col = 256 * (u.pn - 4) + 128 * bj + lc; const int part = col / MW; const float sc = part == 1 ? 0.08838834764831845f : 1.0f;
#pragma unroll
                for (int ai = 0; ai < 2; ++ai)
#pragma unroll
                    for (int m = 0; m < 4; ++m) { f32x4 v0 = acc[ai][bj][m][0] * sc, v1 = acc[ai][bj][m][1] * sc;
                        if (part == 3) { v0 = (f32x4){fsigmoid(v0[0]), fsigmoid(v0[1]), fsigmoid(v0[2]), fsigmoid(v0[3])}; v1 = (f32x4){fsigmoid(v1[0]), fsigmoid(v1[1]), fsigmoid(v1[2]), fsigmoid(v1[3])}; }
                        v4u w; w.x = pg8::cvt_pk_bf16(v0[0], v0[1]); w.y = pg8::cvt_pk_bf16(v0[2], v0[3]); w.z = pg8::cvt_pk_bf16(v1[0], v1[1]); w.w = pg8::cvt_pk_bf16(v1[2], v1[3]);
                        *(v4u*)(qkvo + (size_t)(row0 + ai * 128 + m * 16) * (4 * MW) + col) = w; } }
        }
    }
};
static_assert(MDK == 128, "EpiAB hard-codes MDK^-0.5");
struct EpiRes {
    static constexpr bool PERM = true, AFTER_DRAIN = false;
    const float* xp; const float* xs;
    bf16_t* Y16; bf16_t* S; float* ssq; const float* mod_g; const float* mod_sc; const float* ng; const float* pmod_sc; const float* png;
    int from_input; int pad_;
    __device__ __forceinline__ void piece_load(int row, int col, f32x4& x0, f32x4& x1) const {
        const size_t off = (size_t)row * DM + col;
        if (from_input) { const float* xin = (row < MC ? xp : xs - (size_t)MC * DM) + off; x0 = *(const f32x4*)xin; x1 = *(const f32x4*)(xin + 4); }
        else { const v4u r = *(const v4u*)(S + off); x0 = (f32x4){__uint_as_float(r.x << 16), __uint_as_float(r.x & 0xffff0000u), __uint_as_float(r.y << 16), __uint_as_float(r.y & 0xffff0000u)};
            x1 = (f32x4){__uint_as_float(r.z << 16), __uint_as_float(r.z & 0xffff0000u), __uint_as_float(r.w << 16), __uint_as_float(r.w & 0xffff0000u)}; }
    }
    __device__ __forceinline__ static f32x4 rcp4(f32x4 a) { return (f32x4){__builtin_amdgcn_rcpf(a[0]), __builtin_amdgcn_rcpf(a[1]), __builtin_amdgcn_rcpf(a[2]), __builtin_amdgcn_rcpf(a[3])}; }
    __device__ __forceinline__ f32x4 scale_of(const float* g_, const float* sc_, int cls, int col) const { return *(const f32x4*)(g_ + col) * (*(const f32x4*)(sc_ + (size_t)cls * 6 * DM + col) + 1.0f); }
    __device__ __forceinline__ float piece(int row, int col, int cls, f32x4 v0, f32x4 v1, f32x4 x0, f32x4 x1) const {
        const float* gv = mod_g + (size_t)cls * 6 * DM + col; const size_t off = (size_t)row * DM + col;
        if (!from_input) { x0 *= rcp4(scale_of(png, pmod_sc, cls, col)); x1 *= rcp4(scale_of(png, pmod_sc, cls, col + 4)); }
        x0 += *(const f32x4*)gv * v0; x1 += *(const f32x4*)(gv + 4) * v1;
        if (ng) { const f32x4 t0 = x0 * scale_of(ng, mod_sc, cls, col), t1 = x1 * scale_of(ng, mod_sc, cls, col + 4);
            v4u q; q.x = pg8::cvt_pk_bf16(t0[0], t0[1]); q.y = pg8::cvt_pk_bf16(t0[2], t0[3]); q.z = pg8::cvt_pk_bf16(t1[0], t1[1]); q.w = pg8::cvt_pk_bf16(t1[2], t1[3]); *(v4u*)(S + off) = q; }
        else { v4u w; w.x = pg8::cvt_pk_bf16(x0[0], x0[1]); w.y = pg8::cvt_pk_bf16(x0[2], x0[3]); w.z = pg8::cvt_pk_bf16(x1[0], x1[1]); w.w = pg8::cvt_pk_bf16(x1[2], x1[3]); *(v4u*)(Y16 + off) = w; }
        return ((x0[0] * x0[0] + x0[1] * x0[1]) + (x0[2] * x0[2] + x0[3] * x0[3])) + ((x1[0] * x1[0] + x1[1] * x1[1]) + (x1[2] * x1[2] + x1[3] * x1[3]));
    }
    __device__ __forceinline__ void operator()(const f32x4 (&acc)[2][2][4][2], const pg8::Unit& u, int wr, int wc, int fr, int fq) const {
        const int row0 = u.pm * 256 + wr * 64 + fr; const int cls = cls_of(u.pm * 256); const int colb = u.pn * 256 + wc * 32 + 8 * fq;
        f32x4 g4[2][2], gs4[2][2], ig4[2][2];
#pragma unroll
        for (int bj = 0; bj < 2; ++bj)
#pragma unroll
            for (int n = 0; n < 2; ++n) { const int col = colb + bj * 128 + 4 * n; g4[bj][n] = *(const f32x4*)(mod_g + (size_t)cls * 6 * DM + col);
                gs4[bj][n] = ng ? scale_of(ng, mod_sc, cls, col) : (f32x4){0.f, 0.f, 0.f, 0.f};
                ig4[bj][n] = from_input ? (f32x4){1.f, 1.f, 1.f, 1.f} : rcp4(scale_of(png, pmod_sc, cls, col)); }
        if (!from_input && !ng) run_rows<4>(acc, row0, colb, g4, gs4, ig4);
        else run_rows<2>(acc, row0, colb, g4, gs4, ig4);
    }
    template <int MB> __device__ __forceinline__ void run_rows(const f32x4 (&acc)[2][2][4][2], int row0, int colb, const f32x4 (&g4)[2][2], const f32x4 (&gs4)[2][2], const f32x4 (&ig4)[2][2]) const {
#pragma unroll
        for (int ai = 0; ai < 2; ++ai)
#pragma unroll
            for (int mb = 0; mb < 4; mb += MB) {
                f32x4 x[MB][2][2];
                if (from_input) {
#pragma unroll
                    for (int mm = 0; mm < MB; ++mm)
#pragma unroll
                        for (int bj = 0; bj < 2; ++bj) { const int row = row0 + ai * 128 + (mb + mm) * 16; const float* xin = (row < MC ? xp : xs - (size_t)MC * DM) + (size_t)row * DM + colb + bj * 128; x[mm][bj][0] = *(const f32x4*)xin; x[mm][bj][1] = *(const f32x4*)(xin + 4); }
                } else { v4u r[MB][2];
#pragma unroll
                    for (int mm = 0; mm < MB; ++mm)
#pragma unroll
                        for (int bj = 0; bj < 2; ++bj) r[mm][bj] = *(const v4u*)(S + (size_t)(row0 + ai * 128 + (mb + mm) * 16) * DM + colb + bj * 128);
#pragma unroll
                    for (int mm = 0; mm < MB; ++mm)
#pragma unroll
                        for (int bj = 0; bj < 2; ++bj) { const v4u q = r[mm][bj]; x[mm][bj][0] = (f32x4){__uint_as_float(q.x << 16), __uint_as_float(q.x & 0xffff0000u), __uint_as_float(q.y << 16), __uint_as_float(q.y & 0xffff0000u)} * ig4[bj][0];
                            x[mm][bj][1] = (f32x4){__uint_as_float(q.z << 16), __uint_as_float(q.z & 0xffff0000u), __uint_as_float(q.w << 16), __uint_as_float(q.w & 0xffff0000u)} * ig4[bj][1]; }
                }
#pragma unroll
                for (int mm = 0; mm < MB; ++mm) { const int m = mb + mm; const int row = row0 + ai * 128 + m * 16; float s = 0.f;
#pragma unroll
                    for (int bj = 0; bj < 2; ++bj) { const size_t off = (size_t)row * DM + colb + bj * 128;
                        const f32x4 x0 = x[mm][bj][0] + g4[bj][0] * acc[ai][bj][m][0], x1 = x[mm][bj][1] + g4[bj][1] * acc[ai][bj][m][1];
                        if (ng) { const f32x4 t0 = x0 * gs4[bj][0], t1 = x1 * gs4[bj][1]; v4u q; q.x = pg8::cvt_pk_bf16(t0[0], t0[1]); q.y = pg8::cvt_pk_bf16(t0[2], t0[3]); q.z = pg8::cvt_pk_bf16(t1[0], t1[1]); q.w = pg8::cvt_pk_bf16(t1[2], t1[3]); *(v4u*)(S + off) = q; }
                        else { v4u w; w.x = pg8::cvt_pk_bf16(x0[0], x0[1]); w.y = pg8::cvt_pk_bf16(x0[2], x0[3]); w.z = pg8::cvt_pk_bf16(x1[0], x1[1]); w.w = pg8::cvt_pk_bf16(x1[2], x1[3]); *(v4u*)(Y16 + off) = w; }
                        s += ((x0[0] * x0[0] + x0[1] * x0[1]) + (x0[2] * x0[2] + x0[3] * x0[3])) + ((x1[0] * x1[0] + x1[1] * x1[1]) + (x1[2] * x1[2] + x1[3] * x1[3])); }
                    s += __shfl_xor(s, 16); s += __shfl_xor(s, 32); if (fq_() == 0) atomicAdd(ssq + row, s); }
                asm volatile("" ::: "memory");
            }
    }
    __device__ __forceinline__ static int fq_() { return (lane_id() >> 4) & 3; }
};
struct EpiFfnIn {
    static constexpr bool PERM = true, AFTER_DRAIN = false;
    bf16_t* H; const float* ssq; const float* sw;
    __device__ __forceinline__ void operator()(const f32x4 (&acc)[2][2][4][2], const pg8::Unit& u, int wr, int wc, int fr, int fq) const {
        const int row0 = u.pm * 256 + wr * 64 + fr, lc = wc * 32 + 8 * fq; const int cls = cls_of(u.pm * 256); const int col = 128 * u.pn + lc;
        const float* swr = sw + (size_t)cls * 2 * DFF;
        const f32x4 sg0 = *(const f32x4*)(swr + col), sg1 = *(const f32x4*)(swr + col + 4), su0 = *(const f32x4*)(swr + DFF + col), su1 = *(const f32x4*)(swr + DFF + col + 4);
#pragma unroll
        for (int ai = 0; ai < 2; ++ai)
#pragma unroll
            for (int m = 0; m < 4; ++m) { const int row = row0 + ai * 128 + m * 16; const float rs = __builtin_amdgcn_rsqf(ssq[row] * (1.0f / DM) + EPSF);
                const f32x4 a0 = acc[ai][0][m][0] * rs + sg0, a1 = acc[ai][0][m][1] * rs + sg1, b0 = acc[ai][1][m][0] * rs + su0, b1 = acc[ai][1][m][1] * rs + su1; v4u w;
                w.x = pg8::cvt_pk_bf16(a0[0] * fsigmoid(a0[0]) * b0[0], a0[1] * fsigmoid(a0[1]) * b0[1]); w.y = pg8::cvt_pk_bf16(a0[2] * fsigmoid(a0[2]) * b0[2], a0[3] * fsigmoid(a0[3]) * b0[3]);
                w.z = pg8::cvt_pk_bf16(a1[0] * fsigmoid(a1[0]) * b1[0], a1[1] * fsigmoid(a1[1]) * b1[1]); w.w = pg8::cvt_pk_bf16(a1[2] * fsigmoid(a1[2]) * b1[2], a1[3] * fsigmoid(a1[3]) * b1[3]);
                *(v4u*)(H + (size_t)row * DFF + col) = w; }
    }
};
struct EpiQkv {
    static constexpr bool PERM = true, AFTER_DRAIN = false;
    bf16_t* qraw; bf16_t* ctxk; bf16_t* latk; bf16_t* ctxv; bf16_t* latv; float* outk; float* outv; const float* ssq; const float* sw; const float* kgain; LAS float* xk;
    __device__ __forceinline__ void operator()(const f32x4 (&acc)[2][2][4][2], const pg8::Unit& u, int wr, int wc, int fr, int fq) const {
        const int row0 = u.pm * 256 + wr * 64 + fr, lc = wc * 32 + 8 * fq; const int cls = cls_of(u.pm * 256); const float* swr = sw + (size_t)cls * CIN;
        float rs[2][4];
#pragma unroll
        for (int ai = 0; ai < 2; ++ai)
#pragma unroll
            for (int m = 0; m < 4; ++m) rs[ai][m] = __builtin_amdgcn_rsqf(ssq[row0 + ai * 128 + m * 16] * (1.0f / DM) + EPSF);
        if (u.pn == NQ * HDIM / 256) {
            const int dA = 64 * (wc >> 1) + 16 * (wc & 1) + 4 * fq; const bool lat = u.pm * 256 >= MC;
            const float* sk = swr + NQ * HDIM + dA;
#pragma unroll
            for (int ai = 0; ai < 2; ++ai)
#pragma unroll
                for (int m = 0; m < 4; ++m)
#pragma unroll
                    for (int bj = 0; bj < 2; ++bj) { const f32x4 v0 = acc[ai][bj][m][0] * rs[ai][m] + *(const f32x4*)(sk + 128 * bj), v1 = acc[ai][bj][m][1] * rs[ai][m] + *(const f32x4*)(sk + 128 * bj + 32);
                        float q = ((v0[0] * v0[0] + v0[1] * v0[1]) + (v0[2] * v0[2] + v0[3] * v0[3])) + ((v1[0] * v1[0] + v1[1] * v1[1]) + (v1[2] * v1[2] + v1[3] * v1[3]));
                        q += __shfl_xor(q, 16); q += __shfl_xor(q, 32);
                        if (fq == 0) xk[(ai * 128 + wr * 64 + m * 16 + fr) * 8 + bj * 4 + wc] = q; }
            asm volatile("s_waitcnt lgkmcnt(0)" ::: "memory"); __builtin_amdgcn_s_barrier(); asm volatile("" ::: "memory");
            const f32x4 g0 = *(const f32x4*)(kgain + dA), g1 = *(const f32x4*)(kgain + dA + 32);
            const float fb = (float)(16 * (wc & 1) + 4 * fq);
#pragma unroll
            for (int ai = 0; ai < 2; ++ai)
#pragma unroll
                for (int m = 0; m < 4; ++m) { const int rl = ai * 128 + wr * 64 + m * 16 + fr, row = u.pm * 256 + rl;
                    f32x4 cs = {1.f, 1.f, 1.f, 1.f}, sn = {0.f, 0.f, 0.f, 0.f};
                    if (lat) { const int sp = (row - MC) % LSEQ; const float pos = (float)((wc >> 1) == 0 ? sp / GRIDW : sp % GRIDW);
#pragma unroll
                        for (int e = 0; e < 4; ++e) { const float ang = pos * __builtin_amdgcn_exp2f(-(fb + (float)e) * (13.287712379549449f / 32.0f)); cs[e] = __cosf(ang); sn[e] = __sinf(ang); } }
#pragma unroll
                    for (int bj = 0; bj < 2; ++bj) { const LAS float* xq = xk + rl * 8 + bj * 4; const float rsk = __builtin_amdgcn_rsqf(((xq[0] + xq[1]) + (xq[2] + xq[3])) * (1.0f / HDIM) + EPSF);
                        const f32x4 a = (acc[ai][bj][m][0] * rs[ai][m] + *(const f32x4*)(sk + 128 * bj)) * rsk * g0, b = (acc[ai][bj][m][1] * rs[ai][m] + *(const f32x4*)(sk + 128 * bj + 32)) * rsk * g1;
                        const f32x4 y1 = a * cs - b * sn, y2 = a * sn + b * cs;
                        v2u w1, w2; w1.x = pg8::cvt_pk_bf16(y1[0], y1[1]); w1.y = pg8::cvt_pk_bf16(y1[2], y1[3]); w2.x = pg8::cvt_pk_bf16(y2[0], y2[1]); w2.y = pg8::cvt_pk_bf16(y2[2], y2[3]);
                        if (!lat) { bf16_t* K = ctxk + (size_t)row * (NKV * HDIM) + 128 * bj + dA; *(v2u*)K = w1; *(v2u*)(K + 32) = w2; float* o = outk + (size_t)row * (NKV * HDIM) + 128 * bj + dA; *(f32x4*)o = y1; *(f32x4*)(o + 32) = y2; }
                        else { const int b_ = (row - MC) / LSEQ, s_ = (row - MC) % LSEQ; bf16_t* K = latk + ((size_t)b_ * SKVL + s_) * (NKV * HDIM) + 128 * bj + dA; *(v2u*)K = w1; *(v2u*)(K + 32) = w2; } } }
            asm volatile("s_waitcnt lgkmcnt(0)" ::: "memory"); __builtin_amdgcn_s_barrier(); asm volatile("" ::: "memory");
            return;
        }
#pragma unroll
        for (int bj = 0; bj < 2; ++bj) { const int col = 256 * u.pn + 128 * bj + lc; const f32x4 s0 = *(const f32x4*)(swr + col), s1 = *(const f32x4*)(swr + col + 4);
#pragma unroll
            for (int ai = 0; ai < 2; ++ai)
#pragma unroll
                for (int m = 0; m < 4; ++m) { const int row = row0 + ai * 128 + m * 16; const f32x4 v0 = acc[ai][bj][m][0] * rs[ai][m] + s0, v1 = acc[ai][bj][m][1] * rs[ai][m] + s1;
                    v4u w; w.x = pg8::cvt_pk_bf16(v0[0], v0[1]); w.y = pg8::cvt_pk_bf16(v0[2], v0[3]); w.z = pg8::cvt_pk_bf16(v1[0], v1[1]); w.w = pg8::cvt_pk_bf16(v1[2], v1[3]);
                    if (u.pn < NQ * HDIM / 256) *(v4u*)(qraw + (size_t)row * (NQ * HDIM) + col) = w;
                    else { const int c2 = col - (NQ + NKV) * HDIM;
                        if (row < MC) { *(v4u*)(ctxv + (size_t)row * (NKV * HDIM) + c2) = w; float* o = outv + (size_t)row * (NKV * HDIM) + c2; *(f32x4*)o = v0; *(f32x4*)(o + 4) = v1; }
                        else { const int b = (row - MC) / LSEQ, s = (row - MC) % LSEQ; *(v4u*)(latv + ((size_t)b * SKVL + s) * (NKV * HDIM) + c2) = w; } } } }
    }
};
static_assert(NKV * HDIM == 256 && (NQ * HDIM) % 256 == 0, "EpiQkv tile mapping");

constexpr int CW_SPLIT = 8192;
constexpr size_t SLAB_BYTES = (size_t)64 * 4 * 16 * 512 * 16;
struct RoundZeroOrder : pg8::StaticOrder {
    bool split;
    __device__ void init(int M, int N, int K, int G_, int c_) { pg8::StaticOrder::init(M, N, K, G_, c_); split = (G == 256 && nwg > 256 && nwg <= 320 && ntK >= 8); }
    __device__ bool next(int i, pg8::Unit& u) const { if (split && i > 0) return false; return pg8::StaticOrder::next(i, u); }
};
struct QuarterOrder : pg8::StaticOrder {
    __device__ bool next(int i, pg8::Unit& u) const {
        if (i > 0) return false; const int L = 256 + (c >> 2), q = c & 3; if (L >= nwg) return false;
        map(L, u); const int base = (ntK / 8) * 2, rem = (ntK - 4 * base) / 2;
        int k0 = 0; for (int j = 0; j < q; ++j) k0 += base + (j < rem ? 2 : 0);
        u.k0 = k0; u.nt = base + (q < rem ? 2 : 0); u.role = 1 + q; u.slot = c >> 2; return true;
    }
};
struct EpiPartial {
    static constexpr bool PERM = true, AFTER_DRAIN = false;
    unsigned char* slab; unsigned* cnt;
    __device__ __forceinline__ void operator()(const f32x4 (&acc)[2][2][4][2], const pg8::Unit& u, int wr, int wc, int fr, int fq) const {
        int tid = (wr * 4 + wc) * 64 + fq * 16 + fr; asm volatile("" : "+v"(tid));
        unsigned char* dst = slab + ((size_t)u.slot * 4 + (u.role - 1)) * (16 * 512 * 16) + (size_t)tid * 16;
#pragma unroll
        for (int ai = 0; ai < 2; ++ai)
#pragma unroll
            for (int bj = 0; bj < 2; ++bj)
#pragma unroll
                for (int m = 0; m < 4; ++m) { const f32x4 a = acc[ai][bj][m][0], b = acc[ai][bj][m][1]; v4u w;
                    w.x = pg8::cvt_pk_bf16(a[0], a[1]); w.y = pg8::cvt_pk_bf16(a[2], a[3]); w.z = pg8::cvt_pk_bf16(b[0], b[1]); w.w = pg8::cvt_pk_bf16(b[2], b[3]);
                    asm volatile("global_store_dwordx4 %0, %1, off sc1\n\ts_nop 1" :: "v"(dst), "v"(w) : "memory");
                    dst += 512 * 16; asm volatile("" : "+v"(dst)); }
        asm volatile("s_waitcnt vmcnt(0)" ::: "memory");
        if (fr == 0 && fq == 0) __hip_atomic_fetch_add(cnt + (size_t)u.slot * 64, 1u, __ATOMIC_RELAXED, __HIP_MEMORY_SCOPE_AGENT);
    }
};
__device__ __forceinline__ void tail_reduce(const EpiRes& E, const unsigned char* slab, unsigned* cnt, int G, int bx, int nN, int nM) {
    pg8::StaticOrder S; S.nM = nM; S.nN = nN; S.nwg = nM * nN; S.G = G; S.c = bx; S.ntK = 0;
    const int L = 256 + (bx >> 2), q = bx & 3; if (L >= S.nwg) return;
    pg8::Unit u; S.map(L, u); const int slot = bx >> 2, ai = q >> 1, bj = q & 1;
    const int tid = tid_opaque(), wid = tid >> 6, lane = tid & 63, wr = wid >> 2, wc = wid & 3, fr = lane & 15, fq = lane >> 4;
    const int row0 = u.pm * 256 + ai * 128 + wr * 64 + fr; const int cls = cls_of(u.pm * 256); const int col = u.pn * 256 + bj * 128 + wc * 32 + 8 * fq;
    f32x4 xr[4][2];
#pragma unroll
    for (int m = 0; m < 4; ++m) E.piece_load(row0 + m * 16, col, xr[m][0], xr[m][1]);
    unsigned* c = cnt + (size_t)slot * 64; unsigned spins = 0;
    while ((unsigned)__builtin_amdgcn_readfirstlane(__hip_atomic_load(c, __ATOMIC_RELAXED, __HIP_MEMORY_SCOPE_AGENT)) < 32u) { __builtin_amdgcn_s_sleep(2); if (++spins > (1u << 22)) break; }
    __builtin_amdgcn_fence(__ATOMIC_ACQUIRE, "agent");
    const unsigned char* base = slab + (size_t)slot * 4 * (16 * 512 * 16) + (size_t)tid * 16;
    v4u w[4][4];
#pragma unroll
    for (int m = 0; m < 4; ++m)
#pragma unroll
        for (int r = 0; r < 4; ++r) w[m][r] = *(const v4u*)(base + (size_t)r * (16 * 512 * 16) + (size_t)((ai * 2 + bj) * 4 + m) * (512 * 16));
#pragma unroll
    for (int m = 0; m < 4; ++m) { const int row = row0 + m * 16; f32x4 v[2] = {(f32x4){0.f, 0.f, 0.f, 0.f}, (f32x4){0.f, 0.f, 0.f, 0.f}};
#pragma unroll
        for (int r = 0; r < 4; ++r) { const v4u x = w[m][r]; v[0] += (f32x4){__uint_as_float(x.x << 16), __uint_as_float(x.x & 0xffff0000u), __uint_as_float(x.y << 16), __uint_as_float(x.y & 0xffff0000u)};
            v[1] += (f32x4){__uint_as_float(x.z << 16), __uint_as_float(x.z & 0xffff0000u), __uint_as_float(x.w << 16), __uint_as_float(x.w & 0xffff0000u)}; }
        float sq = E.piece(row, col, cls, v[0], v[1], xr[m][0], xr[m][1]);
        sq += __shfl_xor(sq, 16); sq += __shfl_xor(sq, 32); if (fq == 0) atomicAdd(E.ssq + row, sq); }
}

struct WholeThenQuarterOrder : pg8::StaticOrder {
    bool split, qfirst;
    __device__ void init(int M, int N, int K, int G_, int c_) { pg8::StaticOrder::init(M, N, K, G_, c_); split = (G == 256 && nwg > 256 && nwg <= 320 && ntK >= 8); qfirst = split && nwg == 320 && (((c >> 2) & 1) != 0); }
    __device__ bool next(int i_, pg8::Unit& u) const {
        if (!split) return pg8::StaticOrder::next(i_, u);
        if (i_ > 1) return false; const int i = qfirst ? 1 - i_ : i_;
        if (i == 0) return pg8::StaticOrder::next(0, u);
        const int L = 256 + (c >> 2), q = c & 3; if (L >= nwg) return false;
        map(L, u); const int base = (ntK / 8) * 2, rem = (ntK - 4 * base) / 2;
        int k0 = 0; for (int j = 0; j < q; ++j) k0 += base + (j < rem ? 2 : 0);
        u.k0 = k0; u.nt = base + (q < rem ? 2 : 0); u.role = 1 + q; u.slot = c >> 2; return true;
    }
};
struct EpiResOrPartial {
    static constexpr bool PERM = true, AFTER_DRAIN = false;
    EpiRes res; EpiPartial part;
    __device__ __forceinline__ void operator()(const f32x4 (&acc)[2][2][4][2], const pg8::Unit& u, int wr, int wc, int fr, int fq) const {
        if (u.role == 0) res(acc, u, wr, wc, fr, fq); else part(acc, u, wr, wc, fr, fq);
    }
};
namespace att {
typedef unsigned short bf16;
constexpr int D = 128, NW = 8, QBLK = 32, KVBLK = 64; constexpr float SCALE = 0.088388347648318440f; constexpr float THR = 8.f; constexpr float THR8 = 2.f  ; constexpr int SDEPTH = 2;
constexpr int LDQ = NQ * HDIM, LDK = NKV * HDIM, LDO = DM;
constexpr size_t SHM_V = KVBLK * D  , SHM_K = KVBLK * D  , SHM_ATTN = 4 * SHM_V + 4 * SHM_K;
using bf16x8 = __attribute__((ext_vector_type(8))) short;
using s16x4  = __attribute__((ext_vector_type(4))) short;
using f32x16 = __attribute__((ext_vector_type(16))) float;
using f32x8  = __attribute__((ext_vector_type(8))) float;
using u32x4  = __attribute__((ext_vector_type(4))) unsigned;
#define KSWZ(row, colB) ((row) * 256 + ((colB) ^ (((row) & 7) << 4)))
#define SBAR() __builtin_amdgcn_sched_barrier(0)
__device__ __forceinline__ int crow(int r, int hi) { return (r & 3) + 8 * (r >> 2) + 4 * hi; }
__device__ __forceinline__ unsigned cvtpk(float lo, float hi) {
  unsigned r; asm volatile("v_cvt_pk_bf16_f32 %0, %1, %2" : "=v"(r) : "v"(lo), "v"(hi)); return r;
}
template <typename TIn> struct Stage;
template <> struct Stage<bf16>  { using T = bf16x8;
  __device__ static __forceinline__ T ld8(const bf16* p) { return *reinterpret_cast<const bf16x8*>(p); }
  __device__ static __forceinline__ bf16x8 tobf(T x) { return x; } };
__device__ __forceinline__ void partialSM(f32x16& p0, f32x16& p1, float& m_reg, float& mn, float& alpha) {
  constexpr float C = SCALE * 1.4426950408889634f;
  float pmax = p0[0]; for (int r = 1; r < 16; ++r) pmax = fmaxf(pmax, p0[r]); for (int r = 0; r < 16; ++r) pmax = fmaxf(pmax, p1[r]);
  { auto rr = __builtin_amdgcn_permlane32_swap(__float_as_uint(pmax), __float_as_uint(pmax), false, false);
    pmax = fmaxf(__uint_as_float(rr[0]), __uint_as_float(rr[1])); }
  if (__builtin_expect(__all(pmax - m_reg <= THR / SCALE), 1)) { mn = m_reg; alpha = 1.f; }
  else { mn = fmaxf(m_reg, pmax); alpha = __builtin_amdgcn_exp2f((m_reg - mn) * C); m_reg = mn; }
  float mnC = -mn * C;
  for (int r = 0; r < 16; ++r) p0[r] = fmaf(p0[r], C, mnC); for (int r = 0; r < 16; ++r) p1[r] = fmaf(p1[r], C, mnC);
  for (int r = 0; r < 16; ++r) p0[r] = __builtin_amdgcn_exp2f(p0[r]);
}
__device__ __forceinline__ void finishSM(f32x16& p0, f32x16& p1, float alpha, float& l_reg, bf16x8& pa0, bf16x8& pa1, bf16x8& pa2, bf16x8& pa3) {
  for (int r = 0; r < 16; ++r) p1[r] = __builtin_amdgcn_exp2f(p1[r]);
  float ps = 0; for (int r = 0; r < 16; ++r) ps += p0[r]; for (int r = 0; r < 16; ++r) ps += p1[r];
  { auto rr = __builtin_amdgcn_permlane32_swap(__float_as_uint(ps), __float_as_uint(ps), false, false);
    ps = __uint_as_float(rr[0]) + __uint_as_float(rr[1]); }
  l_reg = l_reg * alpha + ps;
#define PK4(P, BASE, OUT) do { unsigned a0 = cvtpk(P[BASE + 0], P[BASE + 1]), a1 = cvtpk(P[BASE + 2], P[BASE + 3]);   \
    unsigned b0 = cvtpk(P[BASE + 4], P[BASE + 5]), b1 = cvtpk(P[BASE + 6], P[BASE + 7]);                              \
    auto r0 = __builtin_amdgcn_permlane32_swap(a0, b0, false, false); auto r1 = __builtin_amdgcn_permlane32_swap(a1, b1, false, false); \
    u32x4 w = {r0[0], r1[0], r0[1], r1[1]}; OUT = *reinterpret_cast<bf16x8*>(&w); } while (0)
  PK4(p0, 0, pa0); PK4(p0, 8, pa1); PK4(p1, 0, pa2); PK4(p1, 8, pa3);
#undef PK4
}
__device__ __forceinline__ void qkt(f32x16& p0, f32x16& p1, const bf16* Ks, const bf16x8* qr, int r32, int hi) {
  p0 = f32x16{}; p1 = f32x16{};
  for (int d0 = 0; d0 < 8; ++d0) { int cb = (d0 * 16 + hi * 8) * 2;
    bf16x8 b0 = *reinterpret_cast<const bf16x8*>((const char*)Ks + KSWZ(r32, cb));
    bf16x8 b1 = *reinterpret_cast<const bf16x8*>((const char*)Ks + KSWZ(32 + r32, cb));
    p0 = __builtin_amdgcn_mfma_f32_32x32x16_bf16(b0, qr[d0], p0, 0, 0, 0);
    p1 = __builtin_amdgcn_mfma_f32_32x32x16_bf16(b1, qr[d0], p1, 0, 0, 0); }
}
using v8i = __attribute__((ext_vector_type(8))) int;
__device__ __forceinline__ int k8_off(int row, int p) { return row * 128 + ((((p) >> 4) ^ (row & 7)) << 4) + (p & 15); }
__device__ __forceinline__ unsigned pk4_fp8(float a, float b, float c, float d) { int w = __builtin_amdgcn_cvt_pk_fp8_f32(a, b, 0, false); return (unsigned)__builtin_amdgcn_cvt_pk_fp8_f32(c, d, w, true); }
__device__ __forceinline__ void k8_write(char* Kb, int row, int p, bf16x8 k) {
  unsigned lo = pk4_fp8(bf2f((unsigned short)k[0]), bf2f((unsigned short)k[1]), bf2f((unsigned short)k[2]), bf2f((unsigned short)k[3]));
  unsigned hi_ = pk4_fp8(bf2f((unsigned short)k[4]), bf2f((unsigned short)k[5]), bf2f((unsigned short)k[6]), bf2f((unsigned short)k[7]));
  *(unsigned long long*)(Kb + k8_off(row, p)) = ((unsigned long long)hi_ << 32) | lo;
}
__device__ __forceinline__ void qkt8(f32x16& p0, f32x16& p1, const char* Ks, const v8i* qa, int r32, int hi) {
  p0 = f32x16{}; p1 = f32x16{};
#pragma unroll
  for (int blk = 0; blk < 2; ++blk) { const int c = 4 * blk + 2 * hi;
    const u32x4 a0 = *(const u32x4*)(Ks + r32 * 128 + (((c) ^ (r32 & 7)) << 4)), a1 = *(const u32x4*)(Ks + r32 * 128 + (((c + 1) ^ (r32 & 7)) << 4));
    const u32x4 b0 = *(const u32x4*)(Ks + (32 + r32) * 128 + (((c) ^ (r32 & 7)) << 4)), b1 = *(const u32x4*)(Ks + (32 + r32) * 128 + (((c + 1) ^ (r32 & 7)) << 4));
    const v8i A0 = {(int)a0[0], (int)a0[1], (int)a0[2], (int)a0[3], (int)a1[0], (int)a1[1], (int)a1[2], (int)a1[3]};
    const v8i A1 = {(int)b0[0], (int)b0[1], (int)b0[2], (int)b0[3], (int)b1[0], (int)b1[1], (int)b1[2], (int)b1[3]};
    p0 = __builtin_amdgcn_mfma_scale_f32_32x32x64_f8f6f4(A0, qa[blk], p0, 0, 0, 0, 0x7F7F7F7F, 0, 0x7F7F7F7F);
    p1 = __builtin_amdgcn_mfma_scale_f32_32x32x64_f8f6f4(A1, qa[blk], p1, 0, 0, 0, 0x7F7F7F7F, 0, 0x7F7F7F7F); }
}
__device__ __forceinline__ void partialSM8(f32x16& p0, f32x16& p1, float& m_reg, float& mn, float& alpha) {
  constexpr float C = SCALE * 1.4426950408889634f;
  float pmax = p0[0]; for (int r = 1; r < 16; ++r) pmax = fmaxf(pmax, p0[r]); for (int r = 0; r < 16; ++r) pmax = fmaxf(pmax, p1[r]);
  { auto rr = __builtin_amdgcn_permlane32_swap(__float_as_uint(pmax), __float_as_uint(pmax), false, false);
    pmax = fmaxf(__uint_as_float(rr[0]), __uint_as_float(rr[1])); }
  if (__builtin_expect(__all(pmax - m_reg <= THR8 / SCALE), 1)) { mn = m_reg; alpha = 1.f; }
  else { mn = fmaxf(m_reg, pmax); alpha = __builtin_amdgcn_exp2f((m_reg - mn) * C); m_reg = mn; }
  float mnC = -mn * C + 5.0f;
  for (int r = 0; r < 16; ++r) p0[r] = fmaf(p0[r], C, mnC); for (int r = 0; r < 16; ++r) p1[r] = fmaf(p1[r], C, mnC);
  for (int r = 0; r < 16; ++r) p0[r] = __builtin_amdgcn_exp2f(p0[r]);
}
__device__ __forceinline__ void finishSM8(f32x16& p0, f32x16& p1, v8i& P8) {
  for (int r = 0; r < 16; ++r) p1[r] = __builtin_amdgcn_exp2f(p1[r]);
#pragma unroll
  for (int v = 0; v < 4; ++v) { P8[v] = (int)pk4_fp8(p0[4 * v], p0[4 * v + 1], p0[4 * v + 2], p0[4 * v + 3]); P8[4 + v] = (int)pk4_fp8(p1[4 * v], p1[4 * v + 1], p1[4 * v + 2], p1[4 * v + 3]); }
}
__device__ __forceinline__ int vt8_off(int d, int c) { return d * 64 + ((c ^ ((d >> 1) & 3)) << 4); }
__device__ __forceinline__ void pv8(f32x16* o, f32x16& ol, const char* Vt, v8i P8, int r32, int hi) {
  { const v8i ONES = {0x38383838, 0x38383838, 0x38383838, 0x38383838, 0x38383838, 0x38383838, 0x38383838, 0x38383838};
    ol = __builtin_amdgcn_mfma_scale_f32_32x32x64_f8f6f4(P8, ONES, ol, 0, 0, 0, 0x7F7F7F7F, 0, 0x7F7F7F7F); }
#pragma unroll
  for (int d0 = 0; d0 < 4; ++d0) { const int d = 32 * d0 + r32;
    const u32x4 b0 = *(const u32x4*)(Vt + vt8_off(d, 2 * hi)), b1 = *(const u32x4*)(Vt + vt8_off(d, 2 * hi + 1));
    const v8i B = {(int)b0[0], (int)b0[1], (int)b0[2], (int)b0[3], (int)b1[0], (int)b1[1], (int)b1[2], (int)b1[3]};
    o[d0] = __builtin_amdgcn_mfma_scale_f32_32x32x64_f8f6f4(P8, B, o[d0], 0, 0, 0, 0x7F7F7F7F, 0, 0x7F7F7F7F); }
}
__device__ __forceinline__ int v_st(int k, int c) { const int kk = (k & ~0xC) | ((k & 4) << 1) | ((k & 8) >> 1); return ((kk >> 3) * 4 + (c >> 5)) * 512 + ((kk & 7) * 32 + (c & 31)) * 2; }
__device__ __forceinline__ int v_rd_base(int lane) { return ((lane & 3) << 3) | (((lane >> 2) & 3) << 6) | (((lane >> 4) & 1) << 5) | (((lane >> 5) & 1) << 8); }
constexpr int v_rd_off(int d0, int ks, int half) { return d0 * 512 + ks * 4096 + half * 2048; }
template <int OFF> __device__ __forceinline__ s16x4 tr_read(int vb) {
  s16x4 r; asm volatile("ds_read_b64_tr_b16 %0, %1 offset:%2" : "=&v"(r) : "v"(vb), "i"(OFF) : "memory"); return r;
}
template <int D0> __device__ __forceinline__ void pv_one(f32x16& od, int vb, bf16x8 pa0, bf16x8 pa1, bf16x8 pa2, bf16x8 pa3) {
  const s16x4 l0 = tr_read<v_rd_off(D0, 0, 0)>(vb), h0 = tr_read<v_rd_off(D0, 0, 1)>(vb), l1 = tr_read<v_rd_off(D0, 1, 0)>(vb), h1 = tr_read<v_rd_off(D0, 1, 1)>(vb);
  const s16x4 l2 = tr_read<v_rd_off(D0, 2, 0)>(vb), h2 = tr_read<v_rd_off(D0, 2, 1)>(vb), l3 = tr_read<v_rd_off(D0, 3, 0)>(vb), h3 = tr_read<v_rd_off(D0, 3, 1)>(vb);
  asm volatile("s_waitcnt lgkmcnt(0)" ::: "memory"); SBAR();
#define PK(L, H) (bf16x8){L[0], L[1], L[2], L[3], H[0], H[1], H[2], H[3]}
  od = __builtin_amdgcn_mfma_f32_32x32x16_bf16(pa0, PK(l0, h0), od, 0, 0, 0);
  od = __builtin_amdgcn_mfma_f32_32x32x16_bf16(pa1, PK(l1, h1), od, 0, 0, 0);
  od = __builtin_amdgcn_mfma_f32_32x32x16_bf16(pa2, PK(l2, h2), od, 0, 0, 0);
  od = __builtin_amdgcn_mfma_f32_32x32x16_bf16(pa3, PK(l3, h3), od, 0, 0, 0);
#undef PK
}
__device__ __forceinline__ void pv_d0(f32x16* o, int vb, bf16x8 pa0, bf16x8 pa1, bf16x8 pa2, bf16x8 pa3) {
  pv_one<0>(o[0], vb, pa0, pa1, pa2, pa3); pv_one<1>(o[1], vb, pa0, pa1, pa2, pa3); pv_one<2>(o[2], vb, pa0, pa1, pa2, pa3); pv_one<3>(o[3], vb, pa0, pa1, pa2, pa3);
}

__device__ __forceinline__ void attn_dense_body(const bf16* __restrict__ Qb, const unsigned char* __restrict__ K8  , const unsigned char* __restrict__ VT  ,
                                                bf16* __restrict__ Ob, int seq, char* lds, const float* __restrict__ qgain, int spos0, unsigned* waitcnt, unsigned waittarget) {
  typedef bf16 TQ;
  using St = Stage<bf16>; using SQ = Stage<TQ>;
  const int tid = tid_opaque(), wid = tid >> 6, lane = tid & 63, r32 = lane & 31, hi = lane >> 5;
  char* V_lds = lds; char* K_lds = lds + 4 * SHM_V;
  float* ws = (float*)(lds + 132096) + wid * 64; float* li_l = ws; float* al_l = ws + 32;
  float m_reg = -1e30f; f32x16 o[4] = {}; f32x16 ol = {}; bf16x8 qr[8]; v8i qa[2];
  const TQ* Qw = Qb + (long)(wid * QBLK + r32) * LDQ + hi * 8;
#pragma unroll
  for (int d0 = 0; d0 < 8; ++d0) qr[d0] = SQ::tobf(SQ::ld8(Qw + d0 * 16));
  { float qf[8][8]; float ss = 0.f;
#pragma unroll
    for (int d0 = 0; d0 < 8; ++d0)
#pragma unroll
      for (int j = 0; j < 8; ++j) { qf[d0][j] = bf2f((unsigned short)qr[d0][j]); ss += qf[d0][j] * qf[d0][j]; }
    { auto rr = __builtin_amdgcn_permlane32_swap(__float_as_uint(ss), __float_as_uint(ss), false, false); ss = __uint_as_float(rr[0]) + __uint_as_float(rr[1]); }
    const float rsq = 1.0f / sqrtf(ss * (1.0f / D) + 1e-6f);
#pragma unroll
    for (int d0 = 0; d0 < 8; ++d0) { const float* gq = qgain + d0 * 16 + hi * 8; const f32x8 g8 = *reinterpret_cast<const f32x8*>(gq);
#pragma unroll
      for (int j = 0; j < 8; ++j) qf[d0][j] *= rsq * g8[j]; }
    if (spos0 >= 0) { const int sp = spos0 + wid * QBLK + r32; const float prow = (float)(sp / GRIDW), pcol = (float)(sp % GRIDW);
#pragma unroll
      for (int d0 = 0; d0 < 2; ++d0)
#pragma unroll
        for (int j = 0; j < 8; ++j) { const float inv = __builtin_amdgcn_exp2f(-(float)(16 * d0 + 8 * hi + j) * (13.287712379549449f / 32.0f));
          const float cr = __cosf(prow * inv), sr_ = __sinf(prow * inv), cc = __cosf(pcol * inv), sc_ = __sinf(pcol * inv);
          const float a = qf[d0][j], b2 = qf[d0 + 2][j]; qf[d0][j] = a * cr - b2 * sr_; qf[d0 + 2][j] = a * sr_ + b2 * cr;
          const float c = qf[4 + d0][j], e = qf[6 + d0][j]; qf[4 + d0][j] = c * cc - e * sc_; qf[6 + d0][j] = c * sc_ + e * cc; } }
#pragma unroll
    for (int blk = 0; blk < 2; ++blk)
#pragma unroll
      for (int g = 0; g < 4; ++g) { qa[blk][2 * g] = (int)pk4_fp8(qf[4 * blk + g][0], qf[4 * blk + g][1], qf[4 * blk + g][2], qf[4 * blk + g][3]); qa[blk][2 * g + 1] = (int)pk4_fp8(qf[4 * blk + g][4], qf[4 * blk + g][5], qf[4 * blk + g][6], qf[4 * blk + g][7]); } }
  const int kr = tid >> 3, kc = tid & 7; const unsigned char* K8d = K8 + (long)kr * D + 16 * kc; const int k8w = kr * 128 + ((kc ^ (kr & 7)) << 4);
  const int vd = tid >> 2, vc = tid & 3; const unsigned char* VTd = VT + (long)vd * seq + 16 * vc; const int vtw = vt8_off(vd, vc);
  struct { u32x4 vs, ks; } sr_;
#define SLOAD(k0) do { sr_.vs = *(const u32x4*)(VTd + (k0)); sr_.ks = *(const u32x4*)(K8d + (long)(k0) * D); } while (0)
#define SWRITE(b) do { *(u32x4*)(V_lds + (b) * SHM_V + vtw) = sr_.vs; *(u32x4*)(K_lds + (b) * SHM_K + k8w) = sr_.ks; } while (0)
#define RESC(a) do { if (__any((a) < 1.f)) { if (hi == 0) al_l[r32] = (a); asm volatile("s_waitcnt lgkmcnt(0)" ::: "memory"); \
    for (int r = 0; r < 16; ++r) { const float a_ = al_l[crow(r, hi)]; ol[r] *= a_; for (int d = 0; d < 4; ++d) o[d][r] *= a_; } } } while (0)
  f32x16 pA0, pA1, pB0, pB1; float mnA, mnB, alA, alB; v8i P8; const int NT = seq / KVBLK;
#define ATT_ITER(T_, BK_, BVP_, BW_, C0, C1, MNC, ALC, P0, P1, ALP, DO_WRITE, DO_LOAD) do { \
    SBAR(); qkt8(C0, C1, K_lds + (BK_) * SHM_K, qa, r32, hi); \
    finishSM8(P0, P1, P8); (void)(ALP); SBAR(); \
    if (DO_WRITE) SWRITE(BW_); \
    if (DO_LOAD) SLOAD(((T_) + 2) * KVBLK); SBAR(); \
    pv8(o, ol, V_lds + (BVP_) * SHM_V, P8, r32, hi); partialSM8(C0, C1, m_reg, MNC, ALC); \
    RESC(ALC); __syncthreads(); } while (0)
  if (waitcnt) group_wait(waitcnt, waittarget);
  SLOAD(0); SWRITE(0); SLOAD(KVBLK); SWRITE(1); SLOAD(2 * KVBLK); __syncthreads();
  qkt8(pA0, pA1, K_lds, qa, r32, hi); partialSM8(pA0, pA1, m_reg, mnA, alA);
  int t = 1;
  for (; t + 3 < NT; t += 4) {
    ATT_ITER(t,     1, 0, 2, pB0, pB1, mnB, alB, pA0, pA1, alA, true, true);
    ATT_ITER(t + 1, 2, 1, 3, pA0, pA1, mnA, alA, pB0, pB1, alB, true, true);
    ATT_ITER(t + 2, 3, 2, 0, pB0, pB1, mnB, alB, pA0, pA1, alA, true, true);
    ATT_ITER(t + 3, 0, 3, 1, pA0, pA1, mnA, alA, pB0, pB1, alB, true, true);
  }
  ATT_ITER(t,     1, 0, 2, pB0, pB1, mnB, alB, pA0, pA1, alA, true, true);
  ATT_ITER(t + 1, 2, 1, 3, pA0, pA1, mnA, alA, pB0, pB1, alB, true, false);
  ATT_ITER(t + 2, 3, 2, 0, pB0, pB1, mnB, alB, pA0, pA1, alA, false, false);
  finishSM8(pB0, pB1, P8); SBAR();
  pv8(o, ol, V_lds + 3 * SHM_V, P8, r32, hi);
#undef ATT_ITER
  float rli[16];
#pragma unroll
  for (int r = 0; r < 16; ++r) rli[r] = __builtin_amdgcn_rcpf(ol[r]);
  bf16* Ow = Ob + (long)(wid * QBLK) * LDO;
  bf16* Tst = (bf16*)((char*)K_lds + wid * 4096);
#pragma unroll
  for (int hb = 0; hb < 2; ++hb) {
#pragma unroll
    for (int r = 0; r < 16; ++r)
#pragma unroll
      for (int dd = 0; dd < 2; ++dd) Tst[crow(r, hi) * 64 + dd * 32 + r32] = f2bf(o[2 * hb + dd][r] * rli[r]);
    asm volatile("s_waitcnt lgkmcnt(0)" ::: "memory");
#pragma unroll
    for (int i = 0; i < 4; ++i) { const int c = lane + 64 * i;
      *(u32x4*)(Ow + (long)(c >> 3) * LDO + hb * 64 + (c & 7) * 8) = *(const u32x4*)((const char*)Tst + c * 16); }
    asm volatile("s_waitcnt lgkmcnt(0)" ::: "memory");
  }
#undef SLOAD
#undef SWRITE
#undef RESC
}
}
__device__ __forceinline__ void k8_tile(const att::bf16* src, unsigned char* dst, int lane) {
    att::bf16x8 v[16]; const int sc = (lane & 15) * 8, kp = 64 * (sc >> 6) + 32 * ((sc >> 3) & 1) + 8 * ((sc >> 4) & 3);
#pragma unroll
    for (int i = 0; i < 16; ++i) v[i] = *(const att::bf16x8*)(src + (size_t)(4 * i + (lane >> 4)) * (NKV * HDIM) + sc);
#pragma unroll
    for (int i = 0; i < 16; ++i) { const unsigned lo = att::pk4_fp8(bf2f((unsigned short)v[i][0]), bf2f((unsigned short)v[i][1]), bf2f((unsigned short)v[i][2]), bf2f((unsigned short)v[i][3]));
        const unsigned hi_ = att::pk4_fp8(bf2f((unsigned short)v[i][4]), bf2f((unsigned short)v[i][5]), bf2f((unsigned short)v[i][6]), bf2f((unsigned short)v[i][7]));
        __hip_atomic_store((unsigned long long*)(dst + (size_t)(4 * i + (lane >> 4)) * HDIM + kp), ((unsigned long long)hi_ << 32) | lo, __ATOMIC_RELAXED, __HIP_MEMORY_SCOPE_AGENT); }
}
__device__ __forceinline__ void vt8_tile(const att::bf16* src, unsigned char* dst, int ldd, char* T, int lane) {
    constexpr int RS = 136;
    att::bf16x8 v[16];
#pragma unroll
    for (int i = 0; i < 16; ++i) v[i] = *(const att::bf16x8*)(src + (size_t)(4 * i + (lane >> 4)) * (NKV * HDIM) + (lane & 15) * 8);
#pragma unroll
    for (int i = 0; i < 16; ++i) { const unsigned lo = att::pk4_fp8(bf2f((unsigned short)v[i][0]), bf2f((unsigned short)v[i][1]), bf2f((unsigned short)v[i][2]), bf2f((unsigned short)v[i][3]));
        const unsigned hi_ = att::pk4_fp8(bf2f((unsigned short)v[i][4]), bf2f((unsigned short)v[i][5]), bf2f((unsigned short)v[i][6]), bf2f((unsigned short)v[i][7]));
        *(unsigned long long*)(T + (4 * i + (lane >> 4)) * RS + (lane & 15) * 8) = ((unsigned long long)hi_ << 32) | lo; }
    asm volatile("s_waitcnt lgkmcnt(0)" ::: "memory");
#pragma unroll 4
    for (int j = 0; j < 32; ++j) { const int item = lane + 64 * j, g = item & 15, d = item >> 4;
        const unsigned char* tp = (const unsigned char*)T + (4 * g) * RS + d;
        const unsigned w = (unsigned)tp[0] | ((unsigned)tp[RS] << 8) | ((unsigned)tp[2 * RS] << 16) | ((unsigned)tp[3 * RS] << 24);
        const int pos = 32 * (g & 1) + 16 * (g >> 3) + 4 * ((g >> 1) & 3);
        __hip_atomic_store((unsigned*)(dst + (size_t)d * ldd + pos), w, __ATOMIC_RELAXED, __HIP_MEMORY_SCOPE_AGENT); }
}
constexpr int VT8_TL = SKVL / 64, VT8_TC = CSEQ / 64, VT8_NL = NLB * NKV * VT8_TL, VT8_NT = VT8_NL + NCB * NKV * VT8_TC;
__device__ __forceinline__ void vt8_do(const Params& p, int tl, char* T, int lane, int part = 0) {
    if (tl < VT8_NL) { const int grp = tl / VT8_TL, t = tl % VT8_TL, b = grp / NKV, kvh = grp % NKV;
        if (part != 2) vt8_tile((const att::bf16*)(p.ws + WS_LATV) + ((size_t)b * SKVL + 64 * t) * (NKV * HDIM) + kvh * HDIM, p.ws + WS_VT8L + (size_t)(grp * HDIM) * SKVL + 64 * t, SKVL, T, lane);
        if (part != 1) k8_tile((const att::bf16*)(p.ws + WS_LATK) + ((size_t)b * SKVL + 64 * t) * (NKV * HDIM) + kvh * HDIM, p.ws + WS_K8L + ((size_t)grp * SKVL + 64 * t) * HDIM, lane); }
    else { const int c = tl - VT8_NL, grp = c / VT8_TC, t = c % VT8_TC, b = grp / NKV, kvh = grp % NKV;
        if (part != 2) vt8_tile((const att::bf16*)(p.ws + WS_CTXV) + ((size_t)b * CSEQ + 64 * t) * (NKV * HDIM) + kvh * HDIM, p.ws + WS_VT8C + (size_t)(grp * HDIM) * CSEQ + 64 * t, CSEQ, T, lane);
        if (part != 1) k8_tile((const att::bf16*)(p.ws + WS_CTXK) + ((size_t)b * CSEQ + 64 * t) * (NKV * HDIM) + kvh * HDIM, p.ws + WS_K8C + ((size_t)grp * CSEQ + 64 * t) * HDIM, lane); }
}
__device__ __forceinline__ void attn_phase(const Params& p, unsigned char* lds, int vcu, int G, unsigned* waitcnt, unsigned waittarget) {
    constexpr int QB = 256, LQB = LSEQ / QB, CQB = CSEQ / QB;
    constexpr int NUL = NLB * NQ * LQB, NUC = NCB * NQ * CQB, NU = NUL + NUC;
    const att::bf16* QR = (const att::bf16*)(p.ws + WS_QRAW); att::bf16* OB = (att::bf16*)(p.ws + WS_O);
    for (int i = 0;; ++i) {
        int u;
        if (G == 256 && NUL == 512) { if (i < 2) u = (vcu >> 5) * 64 + (vcu & 31) + 32 * i; else u = NUL + vcu + (i - 2) * G; }
        else u = vcu + i * G;
        if (u >= NU) break;
        const att::bf16* Q; const unsigned char *K, *V; att::bf16* O; int seq; int spos0 = -1;
        if (u < NUL) { const int grp = u / (GRP * LQB), j = u % (GRP * LQB); const int b = grp / NKV, kvh = grp % NKV, g = j / LQB, qb = j % LQB, hq = kvh * GRP + g;
            const size_t row0 = (size_t)MC + (size_t)b * LSEQ + (size_t)qb * QB; spos0 = qb * QB;
            Q = QR + row0 * (NQ * HDIM) + hq * HDIM; O = OB + row0 * DM + hq * HDIM;
            K = p.ws + WS_K8L + (size_t)(b * NKV + kvh) * SKVL * HDIM; V = p.ws + WS_VT8L + (size_t)((b * NKV + kvh) * HDIM) * SKVL; seq = SKVL; }
        else { const int uc = u - NUL; const int b = uc / (NQ * CQB), r = uc % (NQ * CQB), hq = r / CQB, qb = r % CQB, kvh = hq / GRP;
            const size_t row0 = (size_t)b * CSEQ + (size_t)qb * QB;
            Q = QR + row0 * (NQ * HDIM) + hq * HDIM; O = OB + row0 * DM + hq * HDIM;
            K = p.ws + WS_K8C + (size_t)(b * NKV + kvh) * CSEQ * HDIM; V = p.ws + WS_VT8C + (size_t)((b * NKV + kvh) * HDIM) * CSEQ; seq = CSEQ; }
        __syncthreads();
        att::attn_dense_body(Q, K, V, O, seq, (char*)lds, p.qng, spos0, i == 0 ? waitcnt : nullptr, waittarget);
    }
}
static_assert(SKVL % 256 == 0 && CSEQ % 256 == 0 && LSEQ % 256 == 0, "attention tiling (key tile count a multiple of 4: four rotating tile buffers)");
constexpr size_t WS_CST = 232 * MiB;
constexpr int NBLK = LSEQ / 256;
constexpr size_t WS_NST = WS_CST + (size_t)NLB * MH * 2 * NBLK * MDK * MDK * 2;
constexpr size_t WS_FTOT = WS_NST + (size_t)NLB * MH * 2 * NBLK * MDK * 4;
static_assert(WS_FTOT + (size_t)NLB * MH * 2 * NBLK * 4 <= WS_END && MDK == 128 && CSEQ == 256 && LSEQ % 256 == 0, "mLSTM fast path geometry");
namespace att {
constexpr int ML_OFF = 132096;
constexpr int ML_SC = ML_OFF + 6144;
constexpr int ML_N = ML_SC + 128;
constexpr int ML_LI = ML_N + 1024;
constexpr int ML_LI2 = ML_LI + 1024;
static_assert(ML_LI2 + 1024 <= LDS_BYTES, "mLSTM LDS map");
constexpr float L2E = 1.4426950408889634f;
using f32x4v = __attribute__((ext_vector_type(4))) float;


__device__ __forceinline__ void ml_gates(const Params& p, char* lds, int row0, int h, int tid) {
    float* A = (float*)(lds + ML_OFF); float* S = (float*)(lds + ML_SC);
    const int half = tid >> 8, t = tid & 255, tok = half ? 255 - t : t, lane = tid & 63, wv = (tid >> 6) & 3;
    const float* G = (const float*)(p.ws + WS_GATES) + (size_t)(row0 + tok) * NGATE + half * 8 + h;
    const float ig = G[0], lf = G[4];
    float v = lf;
#pragma unroll
    for (int off = 1; off < 64; off <<= 1) { const float u = lane_get(v, lane - off); if (lane >= off) v += u; }
    if (lane == 63) S[4 + half * 4 + wv] = v;
    __syncthreads();
    float pre = 0.f, tot = 0.f;
#pragma unroll
    for (int w = 0; w < 4; ++w) { const float x = S[4 + half * 4 + w]; if (w < wv) pre += x; tot += x; }
    const float P = v + pre, a = ig - P;
    A[(0 + half) * 256 + tok] = P * L2E; A[(2 + half) * 256 + tok] = a * L2E; A[(4 + half) * 256 + tok] = __builtin_amdgcn_exp2f(P * L2E);
    float mx = a;
    mx = fmaxf(mx, swz_xor<1>(mx)); mx = fmaxf(mx, swz_xor<2>(mx)); mx = fmaxf(mx, swz_xor<4>(mx)); mx = fmaxf(mx, swz_xor<8>(mx)); mx = fmaxf(mx, swz_xor<16>(mx)); mx = half_max(mx);
    if (lane == 0) S[12 + half * 4 + wv] = mx;
    if (t == 0) S[half] = tot;
    __syncthreads();
    if (t == 0) S[2 + half] = fmaxf(fmaxf(S[12 + half * 4], S[13 + half * 4]), fmaxf(S[14 + half * 4], S[15 + half * 4]));
    __syncthreads();
}
#define ML_PK(L, H) (bf16x8){L[0], L[1], L[2], L[3], H[0], H[1], H[2], H[3]}
__device__ __forceinline__ s16x4 tr_read_rt(int vb) { s16x4 r; asm volatile("ds_read_b64_tr_b16 %0, %1" : "=&v"(r) : "v"(vb) : "memory"); return r; }

__device__ __forceinline__ void st16_wt(void* ptr, u32x4 v) { asm volatile("global_store_dwordx4 %0, %1, off sc1\n\ts_nop 1" :: "v"(ptr), "v"(v) : "memory"); }
__device__ __forceinline__ void ml_passA_unit(const Params& p, char* lds, int sid, int h, int blk) {
    const int tid = tid_opaque(), wid = tid >> 6, lane = tid & 63, r32 = lane & 31, hi = lane >> 5;
    const bool isctx = sid < NCB; const int row0 = seq_base(sid) + 256 * blk;
    const bf16* QK = (const bf16*)(p.ws + WS_QKVO) + (size_t)row0 * (4 * MW) + h * MDK;
    const int sr = tid >> 4, sc8 = (tid & 15) * 8;
    bf16x8 tv[8], tk[8];
#pragma unroll
    for (int i = 0; i < 8; ++i) tv[i] = *(const bf16x8*)(QK + (size_t)(32 * i + sr) * (4 * MW) + 2 * MW + sc8);
#pragma unroll
    for (int i = 0; i < 8; ++i) tk[i] = *(const bf16x8*)(QK + (size_t)(32 * i + sr) * (4 * MW) + MW + sc8);
    __syncthreads();
    ml_gates(p, lds, row0, h, tid);
    float* A = (float*)(lds + ML_OFF); float* S = (float*)(lds + ML_SC); float* NA = (float*)(lds + ML_N);
#pragma unroll
    for (int i = 0; i < 8; ++i) *(bf16x8*)(lds + 65536 + (i >> 1) * 16384 + v_st(32 * (i & 1) + sr, sc8)) = tv[i];
    if (tid < 256) NA[tid] = 0.f;
    const int a = wid >> 1, dvb0 = 2 * (wid & 1);
    const int ldsb = (int)(uintptr_t)lds; const int vbK = ldsb + v_rd_base(lane) + a * 512, vbV = ldsb + 65536 + v_rd_base(lane) + dvb0 * 512;
#pragma unroll 1
    for (int dir = 0; dir < 2; ++dir) {
        __syncthreads();
        const float ft = S[dir], am = S[2 + dir]; const float mT = isctx ? ft + fmaxf(am, 0.f) : 0.f; const float wl2 = (ft - mT) * L2E;
        float xs[8];
#pragma unroll
        for (int i = 0; i < 8; ++i) xs[i] = 0.f;
#pragma unroll
        for (int j = 0; j < 4; ++j)
#pragma unroll
            for (int hf = 0; hf < 2; ++hf) { const int row = 64 * j + 32 * hf + sr; const float w = __builtin_amdgcn_exp2f(wl2 + A[(2 + dir) * 256 + row]);
                const bf16x8 k8 = tk[2 * j + hf]; float x[8];
#pragma unroll
                for (int i = 0; i < 8; ++i) { x[i] = bf2f((unsigned short)k8[i]) * w; xs[i] += x[i]; }
                u32x4 pk = {cvtpk(x[0], x[1]), cvtpk(x[2], x[3]), cvtpk(x[4], x[5]), cvtpk(x[6], x[7])};
                *(u32x4*)(lds + j * 16384 + v_st(32 * hf + sr, sc8)) = pk; }
#pragma unroll
        for (int i = 0; i < 8; ++i) { float v = xs[i]; v += swz_xor<16>(v); v = half_sum(v); if (lane < 16) atomicAdd(&NA[dir * 128 + sc8 + i], v); }
        __syncthreads();
        f32x16 acc0 = {}, acc1 = {}; unsigned eoff = (unsigned)((32 * a + 4 * hi) * MDK + 32 * dvb0 + r32); asm volatile("" : "+v"(eoff));
#define PA_RD(F, OFF) do { F[0] = tr_read<(OFF)>(vbK); F[1] = tr_read<(OFF) + 2048>(vbK); F[2] = tr_read<(OFF)>(vbV); F[3] = tr_read<(OFF) + 2048>(vbV); \
            F[4] = tr_read<(OFF) + 512>(vbV); F[5] = tr_read<(OFF) + 512 + 2048>(vbV); } while (0)
#define PA_MM(F) do { acc0 = __builtin_amdgcn_mfma_f32_32x32x16_bf16(ML_PK(F[0], F[1]), ML_PK(F[2], F[3]), acc0, 0, 0, 0); \
            acc1 = __builtin_amdgcn_mfma_f32_32x32x16_bf16(ML_PK(F[0], F[1]), ML_PK(F[4], F[5]), acc1, 0, 0, 0); } while (0)
#define PA_OFF(S) (((S) >> 2) * 16384 + ((S) & 3) * 4096)
#define PA_PAIR(S) do { SBAR(); PA_RD(fb, PA_OFF((S) + 1)); asm volatile("s_waitcnt lgkmcnt(6)" ::: "memory"); SBAR(); PA_MM(fa); \
            SBAR(); if ((S) + 2 < 16) { PA_RD(fa, PA_OFF(((S) + 2) & 15)); asm volatile("s_waitcnt lgkmcnt(6)" ::: "memory"); } else asm volatile("s_waitcnt lgkmcnt(0)" ::: "memory"); SBAR(); PA_MM(fb); } while (0)
        { s16x4 fa[6], fb[6]; SBAR(); PA_RD(fa, PA_OFF(0));
          PA_PAIR(0); PA_PAIR(2); PA_PAIR(4); PA_PAIR(6); PA_PAIR(8); PA_PAIR(10); PA_PAIR(12); PA_PAIR(14); }
#undef PA_PAIR
#undef PA_OFF
#undef PA_MM
#undef PA_RD
        if (isctx) {
            float* Co = p.out + O_C + ((size_t)(sid * 2 + dir) * MH + h) * MDK * MDK;
#pragma unroll
            for (int r = 0; r < 16; ++r) { const unsigned eo = eoff + (unsigned)(((r & 3) + 8 * (r >> 2)) * MDK); Co[eo] = acc0[r]; Co[eo + 32] = acc1[r]; }
            if (tid == 0) p.out[O_M + (size_t)(sid * 2 + dir) * MH + h] = mT;
        } else {
            const int b = sid - NCB; bf16* Cs = (bf16*)(p.ws + WS_CST) + ((size_t)((b * MH + h) * 2 + dir) * NBLK + blk) * MDK * MDK;
            __syncthreads();
            bf16* T = (bf16*)(lds + wid * 4096);
#pragma unroll
            for (int r = 0; r < 16; ++r) { const int rl = 4 * hi + (r & 3) + 8 * (r >> 2); T[rl * 64 + r32] = f2bf(acc0[r]); T[rl * 64 + 32 + r32] = f2bf(acc1[r]); }
            asm volatile("s_waitcnt lgkmcnt(0)" ::: "memory");
#pragma unroll
            for (int i = 0; i < 4; ++i) { const int c = lane + 64 * i; st16_wt(Cs + (size_t)(32 * a + (c >> 3)) * MDK + 64 * (wid & 1) + (c & 7) * 8, *(const u32x4*)((const char*)T + c * 16)); }
            if (tid == 0) __hip_atomic_store((float*)(p.ws + WS_FTOT) + ((size_t)(b * MH + h) * 2 + dir) * NBLK + blk, ft, __ATOMIC_RELAXED, __HIP_MEMORY_SCOPE_AGENT);
        }
    }
    __syncthreads();
    if (tid < 256) { const int dir = tid >> 7, d = tid & 127;
        if (isctx) p.out[O_N + ((size_t)(sid * 2 + dir) * MH + h) * MDK + d] = NA[tid];
        else { const int b = sid - NCB; __hip_atomic_store((float*)(p.ws + WS_NST) + (((size_t)(b * MH + h) * 2 + dir) * NBLK + blk) * MDK + d, NA[tid], __ATOMIC_RELAXED, __HIP_MEMORY_SCOPE_AGENT); } }
}

template <int D0> __device__ __forceinline__ void pv_rd8(s16x4 (&f)[8], int vb) {
    f[0] = tr_read<v_rd_off(D0, 0, 0)>(vb); f[1] = tr_read<v_rd_off(D0, 0, 1)>(vb); f[2] = tr_read<v_rd_off(D0, 1, 0)>(vb); f[3] = tr_read<v_rd_off(D0, 1, 1)>(vb);
    f[4] = tr_read<v_rd_off(D0, 2, 0)>(vb); f[5] = tr_read<v_rd_off(D0, 2, 1)>(vb); f[6] = tr_read<v_rd_off(D0, 3, 0)>(vb); f[7] = tr_read<v_rd_off(D0, 3, 1)>(vb);
}
__device__ __forceinline__ void pv_mm4(f32x16& od, const s16x4 (&f)[8], bf16x8 pa0, bf16x8 pa1, bf16x8 pa2, bf16x8 pa3) {
    od = __builtin_amdgcn_mfma_f32_32x32x16_bf16(pa0, ML_PK(f[0], f[1]), od, 0, 0, 0); od = __builtin_amdgcn_mfma_f32_32x32x16_bf16(pa1, ML_PK(f[2], f[3]), od, 0, 0, 0);
    od = __builtin_amdgcn_mfma_f32_32x32x16_bf16(pa2, ML_PK(f[4], f[5]), od, 0, 0, 0); od = __builtin_amdgcn_mfma_f32_32x32x16_bf16(pa3, ML_PK(f[6], f[7]), od, 0, 0, 0);
}
__device__ __forceinline__ void pv_d0p(f32x16* o, int vb, bf16x8 pa0, bf16x8 pa1, bf16x8 pa2, bf16x8 pa3) {
    s16x4 fa[8], fb[8];
    SBAR(); pv_rd8<0>(fa, vb); pv_rd8<1>(fb, vb); asm volatile("s_waitcnt lgkmcnt(8)" ::: "memory"); SBAR();
    pv_mm4(o[0], fa, pa0, pa1, pa2, pa3);
    SBAR(); pv_rd8<2>(fa, vb); asm volatile("s_waitcnt lgkmcnt(8)" ::: "memory"); SBAR();
    pv_mm4(o[1], fb, pa0, pa1, pa2, pa3);
    SBAR(); pv_rd8<3>(fb, vb); asm volatile("s_waitcnt lgkmcnt(8)" ::: "memory"); SBAR();
    pv_mm4(o[2], fa, pa0, pa1, pa2, pa3);
    SBAR(); asm volatile("s_waitcnt lgkmcnt(0)" ::: "memory"); SBAR();
    pv_mm4(o[3], fb, pa0, pa1, pa2, pa3);
}
template <int DIR> __device__ __forceinline__ void ml_tile(f32x16* o, float& den, const bf16x8* qr, const char* Ktile, int vbV, const float* AL2, int j, float cq, int trow, bool diag, int r32, int hi) {
    SBAR(); f32x16 p0, p1; qkt(p0, p1, (const bf16*)Ktile, qr, r32, hi); SBAR();
    float ds = 0.f; const int tl = trow - 64 * j - 4 * hi;
#pragma unroll
    for (int g = 0; g < 4; ++g) { const f32x4v a0 = *(const f32x4v*)(AL2 + 64 * j + 8 * g + 4 * hi), a1 = *(const f32x4v*)(AL2 + 64 * j + 32 + 8 * g + 4 * hi);
#pragma unroll
        for (int e = 0; e < 4; ++e) { float w0 = __builtin_amdgcn_exp2f(cq + a0[e]), w1 = __builtin_amdgcn_exp2f(cq + a1[e]);
            if (diag) { if (DIR == 0 ? (8 * g + e > tl) : (8 * g + e < tl)) w0 = 0.f; if (DIR == 0 ? (8 * g + e + 32 > tl) : (8 * g + e + 32 < tl)) w1 = 0.f; }
            p0[4 * g + e] *= w0; p1[4 * g + e] *= w1; ds += p0[4 * g + e] + p1[4 * g + e]; } }
    den += ds;
    bf16x8 pa0, pa1, pa2, pa3;
#define PK4(P, BASE, OUT) do { unsigned a0_ = cvtpk(P[BASE + 0], P[BASE + 1]), a1_ = cvtpk(P[BASE + 2], P[BASE + 3]);   \
    unsigned b0_ = cvtpk(P[BASE + 4], P[BASE + 5]), b1_ = cvtpk(P[BASE + 6], P[BASE + 7]);                              \
    auto r0_ = __builtin_amdgcn_permlane32_swap(a0_, b0_, false, false); auto r1_ = __builtin_amdgcn_permlane32_swap(a1_, b1_, false, false); \
    u32x4 w_ = {r0_[0], r1_[0], r0_[1], r1_[1]}; OUT = *reinterpret_cast<bf16x8*>(&w_); } while (0)
    PK4(p0, 0, pa0); PK4(p0, 8, pa1); PK4(p1, 0, pa2); PK4(p1, 8, pa3);
#undef PK4
    SBAR(); pv_d0p(o, vbV, pa0, pa1, pa2, pa3); SBAR();
}
struct MlKv { bf16x8 tk[4], tv[4]; };
__device__ __forceinline__ void ml_kv_load(MlKv& r, const bf16* QK, int tile0, int sr, int sc8) {
#pragma unroll
    for (int i = 0; i < 4; ++i) { const int row = 64 * tile0 + 32 * i + sr; r.tk[i] = *(const bf16x8*)(QK + (size_t)row * (4 * MW) + MW + sc8); r.tv[i] = *(const bf16x8*)(QK + (size_t)row * (4 * MW) + 2 * MW + sc8); }
}
__device__ __forceinline__ void ml_kv_write(const MlKv& r, char* lds, int sr, int sc8) {
#pragma unroll
    for (int i = 0; i < 4; ++i) { const int jj = i >> 1, rl = 32 * (i & 1) + sr; *(bf16x8*)(lds + jj * 16384 + KSWZ(rl, sc8 * 2)) = r.tk[i]; *(bf16x8*)(lds + 32768 + jj * 16384 + v_st(rl, sc8)) = r.tv[i]; }
}
struct MlPreC { MlKv kv0; bf16x8 qr[8]; };
__device__ __forceinline__ void ml_passC_preload(const Params& p, int sid, int h, int blk, MlPreC& pre) {
    const int tid = tid_opaque(), wid = tid >> 6, lane = tid & 63, r32 = lane & 31, hi = lane >> 5;
    const int row0 = seq_base(sid) + 256 * blk; const bf16* QK = (const bf16*)(p.ws + WS_QKVO) + (size_t)row0 * (4 * MW) + h * MDK;
    ml_kv_load(pre.kv0, QK, 0, tid >> 4, (tid & 15) * 8);
    const bf16* Qw = QK + (size_t)(wid * 32 + r32) * (4 * MW) + hi * 8;
#pragma unroll
    for (int d0 = 0; d0 < 8; ++d0) pre.qr[d0] = *(const bf16x8*)(Qw + d0 * 16);
}
template <bool PRE, bool KEEPG> __device__ __forceinline__ void ml_passC_unit(const Params& p, char* lds, int sid, int h, int blk, const MlPreC& pre) {
    const int tid = tid_opaque(), wid = tid >> 6, lane = tid & 63, r32 = lane & 31, hi = lane >> 5;
    const bool isctx = sid < NCB; const int row0 = seq_base(sid) + 256 * blk; const int wq = wid >> 1;
    const bf16* QK = (const bf16*)(p.ws + WS_QKVO) + (size_t)row0 * (4 * MW) + h * MDK;
    const int sr = tid >> 4, sc8 = (tid & 15) * 8; const int b = sid - NCB;
    bf16x8 tc[8]; float nsv = 0.f; MlKv kv0; bf16x8 qr[8];
    if (!isctx) {
#pragma unroll
        for (int i = 0; i < 8; ++i) { const int dir = i >> 2, c = tid + 512 * (i & 3); tc[i] = *(const bf16x8*)((const bf16*)(p.ws + WS_CST) + ((size_t)((b * MH + h) * 2 + dir) * NBLK + blk) * MDK * MDK + (size_t)c * 8); }
        if (tid < 256) { const int dir = tid >> 7, d = tid & 127; nsv = ((const float*)(p.ws + WS_NST))[(((size_t)(b * MH + h) * 2 + dir) * NBLK + blk) * MDK + d]; } }
    if constexpr (PRE) { kv0 = pre.kv0;
#pragma unroll
        for (int d0 = 0; d0 < 8; ++d0) qr[d0] = pre.qr[d0]; }
    else { ml_kv_load(kv0, QK, 0, sr, sc8);
      const bf16* Qw = QK + (size_t)(wid * 32 + r32) * (4 * MW) + hi * 8;
#pragma unroll
        for (int d0 = 0; d0 < 8; ++d0) qr[d0] = *(const bf16x8*)(Qw + d0 * 16); }
    __syncthreads();
    if constexpr (!KEEPG) ml_gates(p, lds, row0, h, tid);
    float* A = (float*)(lds + ML_OFF); float* NS = (float*)(lds + ML_N); float* li = (float*)(lds + ML_LI) + wid * 32;
    if (tid < 256) NS[tid] = nsv;
    if (!isctx) {
#pragma unroll
        for (int i = 0; i < 8; ++i) { const int dir = i >> 2, c = tid + 512 * (i & 3), row = c >> 4, col8 = (c & 15) * 8; *(bf16x8*)(lds + 65536 + dir * 32768 + (row >> 6) * 16384 + v_st(row & 63, col8)) = tc[i]; }
    }
    ml_kv_write(kv0, lds, sr, sc8);
    __syncthreads();
    float qn_f = 0.f, qn_b = 0.f;
#pragma unroll
    for (int d0 = 0; d0 < 8; ++d0)
#pragma unroll
        for (int i = 0; i < 8; ++i) { const float qv = bf2f((unsigned short)qr[d0][i]); qn_f += qv * NS[d0 * 16 + hi * 8 + i]; qn_b += qv * NS[128 + d0 * 16 + hi * 8 + i]; }
    qn_f = half_sum(qn_f); qn_b = half_sum(qn_b);
    const int ldsb = (int)(uintptr_t)lds; const int vbV = ldsb + 32768 + v_rd_base(lane), vbC = ldsb + 65536 + v_rd_base(lane);
    const int trow = wid * 32 + r32;
    f32x16 of[4], ob[4];
#pragma unroll
    for (int d0 = 0; d0 < 4; ++d0) { of[d0] = f32x16{}; ob[d0] = f32x16{}; }
    if (!isctx) { pv_d0p(of, vbC, qr[0], qr[1], qr[2], qr[3]); pv_d0p(of, vbC + 16384, qr[4], qr[5], qr[6], qr[7]);
        pv_d0p(ob, vbC + 32768, qr[0], qr[1], qr[2], qr[3]); pv_d0p(ob, vbC + 32768 + 16384, qr[4], qr[5], qr[6], qr[7]);
#pragma unroll
        for (int r = 0; r < 16; ++r) { const float ef = A[4 * 256 + wid * 32 + crow(r, hi)], eb = A[5 * 256 + wid * 32 + crow(r, hi)];
#pragma unroll
            for (int d0 = 0; d0 < 4; ++d0) { of[d0][r] *= ef; ob[d0][r] *= eb; } } }
    const float cqf = A[0 * 256 + trow], cqb = A[1 * 256 + trow]; float denf = 0.f, denb = 0.f;
    __syncthreads();
    { const int wu = __builtin_amdgcn_readfirstlane(wid); const int tb = wu >> 1;
#pragma unroll
      for (int i = 0; i < 8; ++i) { const int o = ((wu & 1) * 8 + i) * 1024 + lane * 16; const bf16* src;
          if (tb < 2) { const int row = o >> 8, colB = (o & 255) ^ ((row & 7) << 4); src = QK + (size_t)(64 * (2 + tb) + row) * (4 * MW) + MW + (colB >> 1); }
          else { const int sub = o >> 9, within = o & 511, kk = (sub >> 2) * 8 + (within >> 6), k = (kk & ~0xC) | ((kk & 4) << 1) | ((kk & 8) >> 1), c = (sub & 3) * 32 + ((within & 63) >> 1);
                 src = QK + (size_t)(64 * tb + k) * (4 * MW) + 2 * MW + c; }
          __builtin_amdgcn_global_load_lds((const unsigned*)src, (__attribute__((address_space(3))) unsigned*)(lds + 65536 + tb * 16384 + ((wu & 1) * 8 + i) * 1024), 16, 0, 0); } }
    ml_tile<0>(of, denf, qr, lds, vbV, A + 2 * 256, 0, cqf, trow, wq == 0, r32, hi);
    if (wq >= 1) ml_tile<0>(of, denf, qr, lds + 16384, vbV + 16384, A + 2 * 256, 1, cqf, trow, wq == 1, r32, hi);
    if (wq <= 1) ml_tile<1>(ob, denb, qr, lds + 16384, vbV + 16384, A + 3 * 256, 1, cqb, trow, wq == 1, r32, hi);
    if (wq <= 0) ml_tile<1>(ob, denb, qr, lds, vbV, A + 3 * 256, 0, cqb, trow, wq == 0, r32, hi);
    asm volatile("s_waitcnt vmcnt(0)" ::: "memory");
    __syncthreads();
    char* ogt = lds + wid * 8192;
    { const bf16* OGg = QK + (size_t)(wid * 32) * (4 * MW) + 3 * MW;
#pragma unroll
      for (int i = 0; i < 8; ++i) { const int c = lane + 64 * i;
          __builtin_amdgcn_global_load_lds((const unsigned*)(OGg + (size_t)(c >> 4) * (4 * MW) + (c & 15) * 8), (__attribute__((address_space(3))) unsigned*)(ogt + i * 1024), 16, 0, 0); } }
    { char* const K2 = lds + 65536; const int vb2 = vbV + 65536;
    if (wq >= 2) ml_tile<0>(of, denf, qr, K2, vb2, A + 2 * 256, 2, cqf, trow, wq == 2, r32, hi);
    if (wq >= 3) ml_tile<0>(of, denf, qr, K2 + 16384, vb2 + 16384, A + 2 * 256, 3, cqf, trow, wq == 3, r32, hi);
    ml_tile<1>(ob, denb, qr, K2 + 16384, vb2 + 16384, A + 3 * 256, 3, cqb, trow, wq == 3, r32, hi);
    if (wq <= 2) ml_tile<1>(ob, denb, qr, K2, vb2, A + 3 * 256, 2, cqb, trow, wq == 2, r32, hi); }
    denf = half_sum(denf); denb = half_sum(denb);
    const float invf = 1.0f / fmaxf(fabsf(denf + __builtin_amdgcn_exp2f(cqf) * qn_f), 1.0f), invb = 1.0f / fmaxf(fabsf(denb + __builtin_amdgcn_exp2f(cqb) * qn_b), 1.0f);
    float* li2 = (float*)(lds + ML_LI2) + wid * 32;
    if (hi == 0) { li[r32] = invf; li2[r32] = invb; } asm volatile("s_waitcnt lgkmcnt(0)" ::: "memory");
    asm volatile("s_waitcnt vmcnt(0)" ::: "memory");
    float mg[4];
#pragma unroll
    for (int d0 = 0; d0 < 4; ++d0) mg[d0] = p.mng[h * MDK + d0 * 32 + r32];
    bf16* T = (bf16*)ogt;
#pragma unroll
    for (int r = 0; r < 16; ++r) { const float rlf = li[crow(r, hi)], rlb = li2[crow(r, hi)]; const int rw = crow(r, hi); float ss = 0.f; float x[4];
#pragma unroll
        for (int d0 = 0; d0 < 4; ++d0) { x[d0] = of[d0][r] * rlf + ob[d0][r] * rlb; ss += x[d0] * x[d0]; }
        ss += swz_xor<1>(ss); ss += swz_xor<2>(ss); ss += swz_xor<4>(ss); ss += swz_xor<8>(ss); ss += swz_xor<16>(ss);
        const float rs = __builtin_amdgcn_rsqf(ss * (1.0f / MDK) + EPSF);
#pragma unroll
        for (int d0 = 0; d0 < 4; ++d0) { bf16* e = T + rw * 128 + d0 * 32 + r32; *e = f2bf(bf2f(*e) * x[d0] * rs * mg[d0]); } }
    asm volatile("s_waitcnt lgkmcnt(0)" ::: "memory");
    bf16* UHo = (bf16*)(p.ws + WS_UH) + (size_t)(row0 + wid * 32) * DM + CCH + h * MDK;
#pragma unroll
    for (int i = 0; i < 8; ++i) { const int c = lane + 64 * i; *(u32x4*)(UHo + (size_t)(c >> 4) * DM + (c & 15) * 8) = *(const u32x4*)(ogt + c * 16); }
}
}

template <int DIR> __device__ __forceinline__ void ml_scan_item(const Params& p, int ch, int b, int h, int e8) {
    const float* FT = (const float*)(p.ws + WS_FTOT) + (size_t)ch * NBLK;
    if (e8 < MDK * MDK) { bf16_t* Cs = (bf16_t*)(p.ws + WS_CST) + (size_t)ch * NBLK * MDK * MDK + e8; const float* c0 = p.stC + ((size_t)(b * 2 + DIR) * MH + h) * MDK * MDK + e8;
        v4u d[NBLK];
#pragma unroll
        for (int i = 0; i < NBLK; ++i) d[i] = *(const v4u*)(Cs + (size_t)i * MDK * MDK);
        const f32x4 ca = *(const f32x4*)c0, cb = *(const f32x4*)(c0 + 4); const float em = __expf(p.stm[(size_t)(b * 2 + DIR) * MH + h]);
        float fd[NBLK];
#pragma unroll
        for (int i = 0; i < NBLK; ++i) fd[i] = __expf(FT[i]);
        float c[8] = {ca[0] * em, ca[1] * em, ca[2] * em, ca[3] * em, cb[0] * em, cb[1] * em, cb[2] * em, cb[3] * em};
#pragma unroll
        for (int i = 0; i < NBLK; ++i) { const int blk = DIR == 0 ? i : NBLK - 1 - i; v4u o;
#pragma unroll
            for (int w = 0; w < 4; ++w) { const float lo = __uint_as_float(d[blk][w] << 16), hi = __uint_as_float(d[blk][w] & 0xffff0000u); o[w] = pg8::cvt_pk_bf16(c[2 * w], c[2 * w + 1]);
                c[2 * w] = fd[blk] * c[2 * w] + lo; c[2 * w + 1] = fd[blk] * c[2 * w + 1] + hi; }
            att::st16_wt(Cs + (size_t)blk * MDK * MDK, __builtin_bit_cast(att::u32x4, o)); } }
    else { const int d_ = e8 - MDK * MDK; float* Ns = (float*)(p.ws + WS_NST) + (size_t)ch * NBLK * MDK + d_; const float* n0 = p.stn + ((size_t)(b * 2 + DIR) * MH + h) * MDK + d_;
        f32x4 da[NBLK], db[NBLK];
#pragma unroll
        for (int i = 0; i < NBLK; ++i) { da[i] = *(const f32x4*)(Ns + (size_t)i * MDK); db[i] = *(const f32x4*)(Ns + (size_t)i * MDK + 4); }
        const float em = __expf(p.stm[(size_t)(b * 2 + DIR) * MH + h]); float fd[NBLK];
#pragma unroll
        for (int i = 0; i < NBLK; ++i) fd[i] = __expf(FT[i]);
        f32x4 ca = *(const f32x4*)n0 * em, cb = *(const f32x4*)(n0 + 4) * em;
#pragma unroll
        for (int i = 0; i < NBLK; ++i) { const int blk = DIR == 0 ? i : NBLK - 1 - i;
            att::st16_wt(Ns + (size_t)blk * MDK, __builtin_bit_cast(att::u32x4, ca)); att::st16_wt(Ns + (size_t)blk * MDK + 4, __builtin_bit_cast(att::u32x4, cb)); ca = ca * fd[blk] + da[blk]; cb = cb * fd[blk] + db[blk]; } }
}
struct MlScan {
    Params p; static HD_FN long count() { return (long)NLB * MH * 2 * ((MDK * MDK + MDK) / 8); }
    __device__ __forceinline__ void operator()(long idx) const {
        constexpr int per = (MDK * MDK + MDK) / 8; const int e8 = (int)(idx % per) * 8; const int ch = (int)(idx / per); const int dir = ch & 1, h = (ch >> 1) % MH, b = ch / (2 * MH);
        if (dir == 0) ml_scan_item<0>(p, ch, b, h, e8); else ml_scan_item<1>(p, ch, b, h, e8);
    }
};
__device__ __forceinline__ void ml_phase_A(const Params& p, unsigned char* lds, int vcu, int G) {
    constexpr int NUL = NLB * MH * NBLK, NU = NUL + NCB * MH;
    for (int u = vcu; u < NU; u += G) {
        if (u < NUL) att::ml_passA_unit(p, (char*)lds, NCB + u / (MH * NBLK), (u / NBLK) % MH, u % NBLK);
        else att::ml_passA_unit(p, (char*)lds, (u - NUL) / MH, (u - NUL) % MH, 0); }
}
__device__ __forceinline__ void ml_phase_C(const Params& p, unsigned char* lds, int vcu, int G) {
    constexpr int NUL = NLB * MH * NBLK, NU = NUL + NCB * MH;
    for (int u = vcu; u < NU; u += G) {
        if (u < NUL) att::ml_passC_unit<false, false>(p, (char*)lds, NCB + u / (MH * NBLK), (u / NBLK) % MH, u % NBLK, att::MlPreC{});
        else att::ml_passC_unit<false, false>(p, (char*)lds, (u - NUL) / MH, (u - NUL) % MH, 0, att::MlPreC{}); }
}
typedef float f4 __attribute__((ext_vector_type(4)));
typedef unsigned u4 __attribute__((ext_vector_type(4)));
typedef unsigned u2 __attribute__((ext_vector_type(2)));
__device__ __forceinline__ float wave_sum64(float v) { v += swz_xor<1>(v); v += swz_xor<2>(v); v += swz_xor<4>(v); v += swz_xor<8>(v); v += swz_xor<16>(v); return half_sum(v); }
__device__ __forceinline__ float fsilu(float x) { return x * fsigmoid(x); }

__device__ __forceinline__ void phase_mod(const Params& p, char* lds, int l, int cu, int ncu) {
    const int tid = tid_opaque(), lane = tid & 63, wave = __builtin_amdgcn_readfirstlane(tid >> 6);
    float* SL = (float*)lds; float* PT = (float*)(lds + 32768);
    constexpr int NCG = 6 * DM / 64, NIT = 2 * NCG;
    if (cu >= NIT) return;
    bool first = true;
    for (int item = cu; item < NIT; item += ncu) {
        const int cg = item >> 1, kh = item & 1; const float* w = p.wmod + (size_t)l * DM * 6 * DM + cg * 64;
        const int k0 = kh * (DM / 2) + wave * (DM / 16);
        float acc[NCLS];
#pragma unroll
        for (int r = 0; r < NCLS; ++r) acc[r] = 0.f;
        float wv[64];
#pragma unroll
        for (int j = 0; j < 64; ++j) wv[j] = (w + (size_t)(k0 + j) * 6 * DM)[lane];
        if (first) { first = false; __syncthreads();
            for (int i = tid; i < NCLS * DM; i += NTHREADS) { const int cls = i / DM, k = i % DM; const float cv = cls == 0 ? p.cctx[k] : p.c[(size_t)(cls - 1) * DM + k]; SL[i] = fsilu(cv); } }
        __syncthreads();
#pragma unroll
        for (int j = 0; j < 64; ++j)
#pragma unroll
            for (int r = 0; r < NCLS; ++r) acc[r] += SL[r * DM + k0 + j] * wv[j];
#pragma unroll
        for (int r = 0; r < NCLS; ++r) PT[(wave * NCLS + r) * 64 + lane] = acc[r];
        __syncthreads();
        if (tid < NCLS * 64) { const int r = tid >> 6; float s = kh == 0 ? p.bmod[(size_t)l * 6 * DM + cg * 64 + lane] : 0.f;
#pragma unroll
            for (int w8 = 0; w8 < 8; ++w8) s += PT[(w8 * NCLS + r) * 64 + lane];
            atomicAdd((float*)(p.ws + WS_MOD) + ((size_t)(l * NCLS + r) * 6 * DM) + cg * 64 + lane, s); }
    }
}
__device__ __forceinline__ void sw_job(const Params& p, const bf16_t* Bt, int nrows, int l, int which, float* sw, int N, int mode, int gw, int NGW, int lane) {
    if (gw >= nrows) return;
    f4 sh[NCLS][4];
#pragma unroll
    for (int cls = 0; cls < NCLS; ++cls) { const float* s_ = modv(p, l, cls, which); sh[cls][0] = *(const f4*)(s_ + lane * 8); sh[cls][1] = *(const f4*)(s_ + lane * 8 + 4); sh[cls][2] = *(const f4*)(s_ + DM / 2 + lane * 8); sh[cls][3] = *(const f4*)(s_ + DM / 2 + lane * 8 + 4); }
    u4 w0 = *(const u4*)(Bt + (size_t)gw * DM + lane * 8), w1 = *(const u4*)(Bt + (size_t)gw * DM + DM / 2 + lane * 8);
    for (int n = gw; n < nrows; n += NGW) {
        const u4 c0 = w0, c1 = w1; const int nn = n + NGW; if (nn < nrows) { w0 = *(const u4*)(Bt + (size_t)nn * DM + lane * 8); w1 = *(const u4*)(Bt + (size_t)nn * DM + DM / 2 + lane * 8); }
        f4 wa, wb, wc, wd; wa = (f4){__uint_as_float(c0.x << 16), __uint_as_float(c0.x & 0xffff0000u), __uint_as_float(c0.y << 16), __uint_as_float(c0.y & 0xffff0000u)};
        wb = (f4){__uint_as_float(c0.z << 16), __uint_as_float(c0.z & 0xffff0000u), __uint_as_float(c0.w << 16), __uint_as_float(c0.w & 0xffff0000u)};
        wc = (f4){__uint_as_float(c1.x << 16), __uint_as_float(c1.x & 0xffff0000u), __uint_as_float(c1.y << 16), __uint_as_float(c1.y & 0xffff0000u)};
        wd = (f4){__uint_as_float(c1.z << 16), __uint_as_float(c1.z & 0xffff0000u), __uint_as_float(c1.w << 16), __uint_as_float(c1.w & 0xffff0000u)};
        int col = n; if (mode == 1) { const int t = n >> 8, r = n & 255; col = r < 128 ? 128 * t + r : (N / 2) + 128 * t + (r - 128); }
        if (mode == 2 && n >= NQ * HDIM && n < (NQ + NKV) * HDIM) col = (n & ~127) + kperm_dim(n & 127);
        float mine = 0.f;
#pragma unroll
        for (int cls = 0; cls < NCLS; ++cls) { const f4 t4 = sh[cls][0] * wa + sh[cls][1] * wb + sh[cls][2] * wc + sh[cls][3] * wd; float s = (t4[0] + t4[1]) + (t4[2] + t4[3]); s = wave_sum64(s); if (lane == cls) mine = s; }
        if (lane < NCLS) sw[(size_t)lane * N + col] = mine;
    }
}
static_assert(DM == 1024, "sw_job / norm passes assume 1024 = 64 lanes x 16");
typedef float f32x4g __attribute__((ext_vector_type(4)));
struct Norm0Pre { f4 x[32]; };
__device__ __forceinline__ void norm0_rowptr(const Params& p, int it, int bx, int G, int wave, int lane, bool& any, int& rb, const float*& xr) {
    const int rb0 = (it * G + bx) * (NWAVES / 2); any = rb0 < MTOK / 16; rb = rb0 + (wave >> 1);
    const int row = (any ? rb : 0) * 16 + (lane & 15); xr = xrow(p, row) + 512 * (wave & 1) + 4 * (lane >> 4);
}
__device__ __forceinline__ void phase_norm0_pre(const Params& p, char* lds, int bx, int G, Norm0Pre& st) {
    const int tid = tid_opaque(), lane = tid & 63, wave = tid >> 6; constexpr int WLD = DM + 4;
    float* WG = (float*)lds;
    __syncthreads();
    { f4 tv[DM * 4 / NTHREADS];
#pragma unroll
      for (int it = 0; it < DM * 4 / NTHREADS; ++it) { const int k = it * (NTHREADS / 4) + (tid >> 2); tv[it] = *(const f4*)(p.winab + (size_t)k * ABIN + ABMAIN + 4 * (tid & 3)); }
#pragma unroll
      for (int it = 0; it < DM * 4 / NTHREADS; ++it) { const int k = it * (NTHREADS / 4) + (tid >> 2), g0 = 4 * (tid & 3); WG[(g0 + 0) * WLD + k] = tv[it][0]; WG[(g0 + 1) * WLD + k] = tv[it][1]; WG[(g0 + 2) * WLD + k] = tv[it][2]; WG[(g0 + 3) * WLD + k] = tv[it][3]; } }
    bool any; int rb; const float* xr; norm0_rowptr(p, 0, bx, G, wave, lane, any, rb, xr);
#pragma unroll
    for (int q = 0; q < 32; ++q) st.x[q] = *(const f4*)(xr + 16 * q);
}
__device__ __forceinline__ void phase_norm0(const Params& p, char* lds, int bx, int G, Norm0Pre& st) {
    const int tid = tid_opaque(), lane = tid & 63, wave = tid >> 6; constexpr int WLD = DM + 4;
    float* WG = (float*)lds; float* XS = (float*)(lds + 16 * WLD * 4);
    const int r = lane & 15, kq = lane >> 4, pair = wave >> 1, kh = wave & 1;
    float* SQ = XS + pair * 32; float* GP = XS + 128 + pair * 256;
    const bool tail8 = (MTOK / 16 == 5 * G); f4 xt[8];
    if (tail8) { const float* xr8 = xrow(p, (4 * G + bx) * 16 + r) + 128 * wave + 4 * kq;
#pragma unroll
        for (int q = 0; q < 8; ++q) xt[q] = *(const f4*)(xr8 + 16 * q); }
    for (int it = 0;; ++it) {
        bool any; int rb; const float* xr; norm0_rowptr(p, it, bx, G, wave, lane, any, rb, xr); if (!any || (tail8 && it > 0)) break;
        const int row = rb * 16 + r; const int cls = cls_of(rb * 16); const int kb = 512 * kh + 4 * kq;
        f4 (&x)[32] = st.x; float s = 0.f;
#pragma unroll
        for (int q = 0; q < 32; ++q) s += (x[q][0] * x[q][0] + x[q][1] * x[q][1]) + (x[q][2] * x[q][2] + x[q][3] * x[q][3]);
        s += swz_xor<16>(s); s = half_sum(s);
        __syncthreads();
        if (kq == 0) SQ[kh * 16 + r] = s;
        __syncthreads();
        const float rs = 1.0f / sqrtf((SQ[r] + SQ[16 + r]) * (1.0f / DM) + EPSF);
        const float* gp = p.n1g + kb; const float* scp = modv(p, 0, cls, 1) + kb; const float* shp = modv(p, 0, cls, 0) + kb; const float* wp = WG + r * WLD + kb;
        bf16_t* xo = (bf16_t*)(p.ws + WS_XN) + (size_t)row * DM + kb;
        f32x4g acc = {0.f, 0.f, 0.f, 0.f};
#pragma unroll
        for (int q = 0; q < 32; ++q) { const f4 gg = *(const f4*)(gp + 16 * q), sc = *(const f4*)(scp + 16 * q), sh = *(const f4*)(shp + 16 * q), w = *(const f4*)(wp + 16 * q);
            const f4 h = x[q] * rs * gg * (sc + 1.0f) + sh;
            u2 o; o.x = pg8::cvt_pk_bf16(h[0], h[1]); o.y = pg8::cvt_pk_bf16(h[2], h[3]); *(u2*)(xo + 16 * q) = o;
            acc = __builtin_amdgcn_mfma_f32_16x16x4f32(h[0], w[0], acc, 0, 0, 0); acc = __builtin_amdgcn_mfma_f32_16x16x4f32(h[1], w[1], acc, 0, 0, 0);
            acc = __builtin_amdgcn_mfma_f32_16x16x4f32(h[2], w[2], acc, 0, 0, 0); acc = __builtin_amdgcn_mfma_f32_16x16x4f32(h[3], w[3], acc, 0, 0, 0); }
        if (kh == 1) *(f32x4g*)(GP + lane * 4) = acc;
        __syncthreads();
        if (kh == 0) { const f32x4g o2 = *(const f32x4g*)(GP + lane * 4); const float bg = p.bgate[r];
#pragma unroll
            for (int e = 0; e < 4; ++e) { float a = acc[e] + o2[e] + bg; if ((r & 7) >= 4) a = logsigmoidf_(a); ((float*)(p.ws + WS_GATES))[(size_t)(rb * 16 + 4 * kq + e) * NGATE + r] = a; } }
        { bool any2; int rb2; const float* xr2; norm0_rowptr(p, it + 1, bx, G, wave, lane, any2, rb2, xr2);
          if (any2 && !tail8) {
#pragma unroll
              for (int q = 0; q < 32; ++q) st.x[q] = *(const f4*)(xr2 + 16 * q); } }
    }
    if (tail8) {
        const int rb = 4 * G + bx, row = rb * 16 + r, cls = cls_of(rb * 16), kb = 128 * wave + 4 * kq;
        float* SQ8 = XS; float* GP8 = XS + 128;
        float s = 0.f;
#pragma unroll
        for (int q = 0; q < 8; ++q) s += (xt[q][0] * xt[q][0] + xt[q][1] * xt[q][1]) + (xt[q][2] * xt[q][2] + xt[q][3] * xt[q][3]);
        s += swz_xor<16>(s); s = half_sum(s);
        __syncthreads();
        if (kq == 0) SQ8[wave * 16 + r] = s;
        __syncthreads();
        float tot = 0.f;
#pragma unroll
        for (int w = 0; w < 8; ++w) tot += SQ8[w * 16 + r];
        const float rs = 1.0f / sqrtf(tot * (1.0f / DM) + EPSF);
        const float* gp = p.n1g + kb; const float* scp = modv(p, 0, cls, 1) + kb; const float* shp = modv(p, 0, cls, 0) + kb; const float* wp = WG + r * WLD + kb;
        bf16_t* xo = (bf16_t*)(p.ws + WS_XN) + (size_t)row * DM + kb;
        f32x4g acc = {0.f, 0.f, 0.f, 0.f};
#pragma unroll
        for (int q = 0; q < 8; ++q) { const f4 gg = *(const f4*)(gp + 16 * q), sc = *(const f4*)(scp + 16 * q), sh = *(const f4*)(shp + 16 * q), w = *(const f4*)(wp + 16 * q);
            const f4 h = xt[q] * rs * gg * (sc + 1.0f) + sh;
            u2 o; o.x = pg8::cvt_pk_bf16(h[0], h[1]); o.y = pg8::cvt_pk_bf16(h[2], h[3]); *(u2*)(xo + 16 * q) = o;
            acc = __builtin_amdgcn_mfma_f32_16x16x4f32(h[0], w[0], acc, 0, 0, 0); acc = __builtin_amdgcn_mfma_f32_16x16x4f32(h[1], w[1], acc, 0, 0, 0);
            acc = __builtin_amdgcn_mfma_f32_16x16x4f32(h[2], w[2], acc, 0, 0, 0); acc = __builtin_amdgcn_mfma_f32_16x16x4f32(h[3], w[3], acc, 0, 0, 0); }
        *(f32x4g*)(GP8 + (wave * 64 + lane) * 4) = acc;
        __syncthreads();
        if (wave == 0) { f32x4g a4 = {0.f, 0.f, 0.f, 0.f};
#pragma unroll
            for (int w = 0; w < 8; ++w) a4 += *(const f32x4g*)(GP8 + (w * 64 + lane) * 4);
            const float bg = p.bgate[r];
#pragma unroll
            for (int e = 0; e < 4; ++e) { float a = a4[e] + bg; if ((r & 7) >= 4) a = logsigmoidf_(a); ((float*)(p.ws + WS_GATES))[(size_t)(rb * 16 + 4 * kq + e) * NGATE + r] = a; } }
    }
}
static_assert(MTOK % 64 == 0 && MC % 16 == 0 && LSEQ % 16 == 0 && DM == 1024, "norm0 row blocks");
__device__ __forceinline__ void phase_conv(const Params& p, char* lds, int ufirst, int ustride, int uend) {
    const int tid = tid_opaque(), lane = tid & 63, wave = tid >> 6; constexpr int TT = 32, NR = TT + CWID - 1;
    bf16_t* X = (bf16_t*)lds; float* OUT = (float*)(lds + 65536);
    const int cp = tid & 255, tg = tid >> 8, c0 = 2 * cp;
    float w0[CWID], w1[CWID];
#pragma unroll
    for (int j = 0; j < CWID; ++j) { w0[j] = p.convw[(size_t)j * CCH + c0]; w1[j] = p.convw[(size_t)j * CCH + c0 + 1]; }
    const float b0 = p.convb[c0], b1 = p.convb[c0 + 1];
    const bf16_t* U = (const bf16_t*)(p.ws + WS_UPRE);
    u4 val[8];
#define CONV_LOAD(UU) do { const int row0_ = (UU) * TT, pos0_ = pos_of(row0_), len_ = seqlen_of(row0_); _Pragma("unroll") \
        for (int i = 0; i < 8; ++i) { const int c = tid + NTHREADS * i, r = c / (CCH / 8), ch = (c % (CCH / 8)) * 8; const int t = pos0_ + r - CWID / 2; \
            val[i] = (u4){0u, 0u, 0u, 0u}; if (c < NR * (CCH / 8) && t >= 0 && t < len_) val[i] = *(const u4*)(U + (size_t)(row0_ + r - CWID / 2) * CCH + ch); } } while (0)
    if (ufirst < uend) CONV_LOAD(ufirst);
    for (int u = ufirst; u < uend; u += ustride) {
        const int row0 = u * TT;
        __syncthreads();
#pragma unroll
        for (int i = 0; i < 8; ++i) { const int c = tid + NTHREADS * i, r = c / (CCH / 8), ch = (c % (CCH / 8)) * 8; if (c < NR * (CCH / 8)) *(u4*)(X + (size_t)r * CCH + ch) = val[i]; }
        __syncthreads();
        if (u + ustride < uend) CONV_LOAD(u + ustride);
#pragma unroll 1
        for (int hb = 0; hb < 2; ++hb) { const int t0 = tg * (TT / 2) + hb * 8; float xa[8 + CWID - 1], xb[8 + CWID - 1];
#pragma unroll
            for (int i = 0; i < 8 + CWID - 1; ++i) { const unsigned xx = *(const unsigned*)(X + (size_t)(t0 + i) * CCH + c0); xa[i] = __uint_as_float(xx << 16); xb[i] = __uint_as_float(xx & 0xffff0000u); }
#pragma unroll
            for (int tt = 0; tt < 8; ++tt) { float a0 = b0, a1 = b1;
#pragma unroll
                for (int j = 0; j < CWID; ++j) { a0 += w0[j] * xa[tt + j]; a1 += w1[j] * xb[tt + j]; }
                *(float2*)(OUT + (size_t)(t0 + tt) * CCH + c0) = make_float2(a0, a1); } }
        __syncthreads();
#pragma unroll
        for (int q = 0; q < TT / NWAVES; ++q) { const int t = wave * (TT / NWAVES) + q; const f4 x0 = *(const f4*)(OUT + (size_t)t * CCH + lane * 8), x1 = *(const f4*)(OUT + (size_t)t * CCH + lane * 8 + 4);
            const float mu = wave_sum64((x0[0] + x0[1]) + (x0[2] + x0[3]) + (x1[0] + x1[1]) + (x1[2] + x1[3])) * (1.0f / CCH);
            const f4 d0 = x0 - mu, d1 = x1 - mu;
            const float var = wave_sum64((d0[0] * d0[0] + d0[1] * d0[1]) + (d0[2] * d0[2] + d0[3] * d0[3]) + (d1[0] * d1[0] + d1[1] * d1[1]) + (d1[2] * d1[2] + d1[3] * d1[3])) * (1.0f / CCH);
            const float rs = 1.0f / sqrtf(var + EPSF);
            const f4 g0 = *(const f4*)(p.lng + lane * 8), g1 = *(const f4*)(p.lng + lane * 8 + 4), be0 = *(const f4*)(p.lnb + lane * 8), be1 = *(const f4*)(p.lnb + lane * 8 + 4);
            const f4 y0 = d0 * rs * g0 + be0, y1 = d1 * rs * g1 + be1; u4 w;
            w.x = pg8::cvt_pk_bf16(fsilu(y0[0]), fsilu(y0[1])); w.y = pg8::cvt_pk_bf16(fsilu(y0[2]), fsilu(y0[3])); w.z = pg8::cvt_pk_bf16(fsilu(y1[0]), fsilu(y1[1])); w.w = pg8::cvt_pk_bf16(fsilu(y1[2]), fsilu(y1[3]));
            *(u4*)((bf16_t*)(p.ws + WS_UH) + (size_t)(row0 + t) * DM + lane * 8) = w; }
    }
#undef CONV_LOAD
}
static_assert(CCH == 512 && CSEQ % 32 == 0 && LSEQ % 32 == 0, "conv phase geometry");
__device__ __forceinline__ void phase_cachecvt(const Params& p, int gtid, int gthreads) {
    constexpr int PER = PAST * NKV * HDIM / 8;
    for (int i = gtid; i < NLB * PER; i += gthreads) { const int b = i / PER, e = (i % PER) * 8; const size_t src = (size_t)b * PAST * NKV * HDIM + e, dst = ((size_t)b * SKVL + LSEQ) * NKV * HDIM + e;
        const f4 k0 = *(const f4*)(p.ck + src), k1 = *(const f4*)(p.ck + src + 4), v0 = *(const f4*)(p.cv + src), v1 = *(const f4*)(p.cv + src + 4); u4 wk, wv;
        wk.x = pg8::cvt_pk_bf16(k0[0], k0[1]); wk.y = pg8::cvt_pk_bf16(k0[2], k0[3]); wk.z = pg8::cvt_pk_bf16(k1[0], k1[1]); wk.w = pg8::cvt_pk_bf16(k1[2], k1[3]);
        wv.x = pg8::cvt_pk_bf16(v0[0], v0[1]); wv.y = pg8::cvt_pk_bf16(v0[2], v0[3]); wv.z = pg8::cvt_pk_bf16(v1[0], v1[1]); wv.w = pg8::cvt_pk_bf16(v1[2], v1[3]);
        *(u4*)((bf16_t*)(p.ws + WS_LATK) + dst) = wk; *(u4*)((bf16_t*)(p.ws + WS_LATV) + dst) = wv; }
}
__device__ __forceinline__ void phase_qkpost(const Params& p, int gw, int NGW, int lane) {
    const int hh = lane >> 5, l5 = lane & 31, half = l5 >> 4, f0 = (l5 & 15) * 2, d1 = half * 64 + f0, d2 = d1 + 32;
    const float inv0 = __builtin_amdgcn_exp2f(-(float)f0 * (13.287712379549449f / 32.0f)), inv1 = __builtin_amdgcn_exp2f(-(float)(f0 + 1) * (13.287712379549449f / 32.0f));
    const float qg[4] = {p.qng[d1], p.qng[d1 + 1], p.qng[d2], p.qng[d2 + 1]}, kg[4] = {p.kng[d1], p.kng[d1 + 1], p.kng[d2], p.kng[d2 + 1]};
    for (int row = gw; row < MTOK; row += NGW) {
        const bool lat = row >= MC; const int sp = pos_of(row); float cs0 = 1.f, sn0 = 0.f, cs1 = 1.f, sn1 = 0.f;
        if (lat) { const float pos = (float)(half == 0 ? sp / GRIDW : sp % GRIDW); cs0 = __cosf(pos * inv0); sn0 = __sinf(pos * inv0); cs1 = __cosf(pos * inv1); sn1 = __sinf(pos * inv1); }
        bf16_t* Q = (bf16_t*)(p.ws + WS_QRAW) + (size_t)row * NQ * HDIM; const bf16_t* KR = (const bf16_t*)(p.ws + WS_KRAW) + (size_t)row * NKV * HDIM;
        unsigned ra[NQ / 2 + 1], rb[NQ / 2 + 1];
#pragma unroll
        for (int it = NQ / 2; it <= NQ / 2; ++it) { const bf16_t* src = it < NQ / 2 ? Q + (2 * it + hh) * HDIM : KR + hh * HDIM; ra[it] = *(const unsigned*)(src + d1); rb[it] = *(const unsigned*)(src + d2); }
#pragma unroll
        for (int it = NQ / 2; it <= NQ / 2; ++it) { const bool isq = it < NQ / 2;
            const float x1a = __uint_as_float(ra[it] << 16), x1b = __uint_as_float(ra[it] & 0xffff0000u), x2a = __uint_as_float(rb[it] << 16), x2b = __uint_as_float(rb[it] & 0xffff0000u);
            float ss = (x1a * x1a + x1b * x1b) + (x2a * x2a + x2b * x2b); ss += swz_xor<1>(ss); ss += swz_xor<2>(ss); ss += swz_xor<4>(ss); ss += swz_xor<8>(ss); ss += swz_xor<16>(ss);
            const float rs = 1.0f / sqrtf(ss * (1.0f / HDIM) + EPSF); const float* g = isq ? qg : kg;
            const float a0 = x1a * rs * g[0], a1 = x1b * rs * g[1], b0 = x2a * rs * g[2], b1 = x2b * rs * g[3];
            const float y1a = a0 * cs0 - b0 * sn0, y2a = a0 * sn0 + b0 * cs0, y1b = a1 * cs1 - b1 * sn1, y2b = a1 * sn1 + b1 * cs1;
            const unsigned w1 = pg8::cvt_pk_bf16(y1a, y1b), w2 = pg8::cvt_pk_bf16(y2a, y2b);
            if (isq) { bf16_t* dst = Q + (2 * it + hh) * HDIM; *(unsigned*)(dst + d1) = w1; *(unsigned*)(dst + d2) = w2; }
            else if (!lat) { bf16_t* K = (bf16_t*)(p.ws + WS_CTXK) + (size_t)row * NKV * HDIM + hh * HDIM; *(unsigned*)(K + d1) = w1; *(unsigned*)(K + d2) = w2;
                float* fo = p.out + O_K + (size_t)row * NKV * HDIM + hh * HDIM; *(float2*)(fo + d1) = make_float2(y1a, y1b); *(float2*)(fo + d2) = make_float2(y2a, y2b); }
            else { const int b_ = (row - MC) / LSEQ, s_ = (row - MC) % LSEQ; bf16_t* K = (bf16_t*)(p.ws + WS_LATK) + ((size_t)b_ * SKVL + s_) * NKV * HDIM + hh * HDIM; *(unsigned*)(K + d1) = w1; *(unsigned*)(K + d2) = w2; } }
    }
}
static_assert(NKV == 2 && NQ % 2 == 0 && HDIM == 128, "qkpost lane mapping");
__device__ __forceinline__ void phase_final(const Params& p, int gw, int NGW, int lane) {
    const f4 g0 = *((const f4*)p.fng + 2 * lane), g1 = *((const f4*)p.fng + 2 * lane + 1), g2 = *((const f4*)p.fng + 128 + 2 * lane), g3 = *((const f4*)p.fng + 128 + 2 * lane + 1);
    const float* sq = (const float*)(p.ws + WS_SSQ) + (size_t)3 * SSQ_STRIDE;
    for (int row = gw; row < MTOK; row += 2 * NGW) { const int row2 = row + NGW; const bool has2 = row2 < MTOK; const int r2 = has2 ? row2 : row;
        const float rsa = 1.0f / sqrtf(sq[row] * (1.0f / DM) + EPSF), rsb = 1.0f / sqrtf(sq[r2] * (1.0f / DM) + EPSF);
        const u4* ya = (const u4*)((const bf16_t*)(p.ws + WS_Y16) + (size_t)row * DM) + lane; const u4* yb = (const u4*)((const bf16_t*)(p.ws + WS_Y16) + (size_t)r2 * DM) + lane;
        const u4 a0 = ya[0], a1 = ya[64], b0 = yb[0], b1 = yb[64];
        f4* oa = (f4*)(p.out + O_Y + (size_t)row * DM) + 2 * lane; f4* ob = (f4*)(p.out + O_Y + (size_t)r2 * DM) + 2 * lane;
#define UNP_LO(V_) (f4){__uint_as_float((V_).x << 16), __uint_as_float((V_).x & 0xffff0000u), __uint_as_float((V_).y << 16), __uint_as_float((V_).y & 0xffff0000u)}
#define UNP_HI(V_) (f4){__uint_as_float((V_).z << 16), __uint_as_float((V_).z & 0xffff0000u), __uint_as_float((V_).w << 16), __uint_as_float((V_).w & 0xffff0000u)}
        oa[0] = UNP_LO(a0) * rsa * g0; oa[1] = UNP_HI(a0) * rsa * g1; oa[128] = UNP_LO(a1) * rsa * g2; oa[129] = UNP_HI(a1) * rsa * g3;
        if (has2) { ob[0] = UNP_LO(b0) * rsb * g0; ob[1] = UNP_HI(b0) * rsb * g1; ob[128] = UNP_LO(b1) * rsb * g2; ob[129] = UNP_HI(b1) * rsb * g3; }
#undef UNP_LO
#undef UNP_HI
    }
}
template <class Epi> __device__ __forceinline__ void gemm_call(LAS unsigned char* lds, const bf16_t* A, const bf16_t* Bt, int N, int K, const Epi& E) {
    pg8::Gemm g{A, Bt, MTOK, N, K}; pg8::StaticOrder S; S.init(MTOK, N, K, (int)gridDim.x, (int)blockIdx.x);
    pg8::gemm_phase<Epi, pg8::StaticOrder, true, true>((PG8_LAS unsigned char*)lds, g, S, E);
}
#ifdef PROBE_A
#define ISTAMP(i) do { if (blockIdx.x == 0 && threadIdx.x == 0 && K == PROBE_K) *(volatile LAS unsigned*)(uintptr_t)(MISC_OFF + 4 * (i)) = (unsigned)__builtin_amdgcn_s_memrealtime(); } while (0)
#else
#define ISTAMP(i) do {} while (0)
#endif
__device__ __forceinline__ void gemm_call_split(LAS unsigned char* lds, const bf16_t* A, const bf16_t* Bt, int N, int K, const EpiRes& E, unsigned char* slab, unsigned* cnt) {
    pg8::Gemm g{A, Bt, MTOK, N, K}; WholeThenQuarterOrder S0; S0.init(MTOK, N, K, (int)gridDim.x, (int)blockIdx.x);
    pg8::gemm_phase<EpiResOrPartial, WholeThenQuarterOrder, true, true>((PG8_LAS unsigned char*)lds, g, S0, EpiResOrPartial{E, EpiPartial{slab, cnt}});
    if (S0.split) tail_reduce(E, slab, cnt, (int)gridDim.x, (int)blockIdx.x, N / 256, MTOK / 256);
}
constexpr int CW_GRP = 25600;
__device__ __forceinline__ void group_sync(unsigned* cnt, unsigned target) {
    asm volatile("s_waitcnt vmcnt(0)" ::: "memory");
    __syncthreads();
    if (tid_opaque() == 0) {
        (void)__hip_atomic_fetch_add(cnt, 1u, __ATOMIC_RELAXED, __HIP_MEMORY_SCOPE_AGENT);
        unsigned sp = 0;
        while (__hip_atomic_load(cnt, __ATOMIC_RELAXED, __HIP_MEMORY_SCOPE_AGENT) < target) { __builtin_amdgcn_s_sleep(1); if (++sp > XB_SPIN_CAP) break; }
        __builtin_amdgcn_fence(__ATOMIC_ACQUIRE, "agent"); asm volatile("s_waitcnt vmcnt(0)" ::: "memory");
    }
    __syncthreads();
}
__global__ void __launch_bounds__(NTHREADS, 2) mega_fwd(Params p) {
    extern __shared__ __attribute__((aligned(16))) unsigned char lds[];
    LAS unsigned char* L = (LAS unsigned char*)lds;
    for (int u = threadIdx.x; u < (LDS_BYTES - LDSCTL_OFF) / 4; u += NTHREADS) ((LAS unsigned*)(L + LDSCTL_OFF))[u] = 0u;
    __syncthreads();
    if ((threadIdx.x & 63) == 0) *(LAS int*)(uintptr_t)(WTAB_OFF + 4 * hw_wave_slot()) = (int)(threadIdx.x >> 6);
    __syncthreads();
    volatile LAS unsigned* MISC = (volatile LAS unsigned*)(L + MISC_OFF);
    const XcdBarrier bar = xcd_barrier_post((unsigned*)(p.ws + WS_CTL) + CW_BAR, MISC + 8);
    const int G = gridDim.x, bx = blockIdx.x; const int vcu = (G % 8 == 0) ? (bx % 8) * (G / 8) + bx / 8 : bx;
    unsigned char* ws = p.ws;
    const bf16_t* XN = (const bf16_t*)(ws + WS_XN); const bf16_t* UH = (const bf16_t*)(ws + WS_UH); const bf16_t* Hh = (const bf16_t*)(ws + WS_H); const bf16_t* Ob = (const bf16_t*)(ws + WS_O);
    float* SW0 = (float*)(ws + WS_SW); float* SWC = SW0 + (size_t)NCLS * 2 * DFF; float* SW1 = SWC + (size_t)NCLS * CIN;
    float* SSQ = (float*)(ws + WS_SSQ); float* Y = p.out + O_Y; unsigned* SPLITC = (unsigned*)(ws + WS_CTL) + CW_SPLIT;
#define WAVE_IDS() const int tid_ = tid_opaque(); const int lane_ = tid_ & 63; const int gw_ = bx * NWAVES + (tid_ >> 6); const int NGW_ = G * NWAVES
    if (G == 256) { if (bx < 192) phase_mod(p, (char*)lds, 0, bx, 192); else p0_weights<0x003u>(p, L, bx - 192, 64); }
    else { p0_weights<0x003u>(p, L, vcu, G); phase_mod(p, (char*)lds, 0, bx, G); }
    Norm0Pre n0pre; phase_norm0_pre(p, (char*)lds, bx, G, n0pre);
    xcd_barrier(bar);
    phase_norm0(p, (char*)lds, bx, G, n0pre);
    xcd_barrier(bar);
    gemm_call(L, XN, (const bf16_t*)(ws + WB_AB), ABMAIN, DM, EpiAB{(bf16_t*)(ws + WS_UPRE), (bf16_t*)(ws + WS_QKVO)});
    if (G == 256) { if (bx >= 192) p0_weights<0x0E8u>(p, L, bx - 192, 64); } else p0_weights<0x0E8u>(p, L, vcu, G);
    xcd_barrier(bar);
    if (G == 256 && NLB * MH * NBLK == 256) {
        const int u = vcu, b = u / (MH * NBLK), h = (u / NBLK) % MH, blk = u % NBLK, chain = u / NBLK;
        unsigned* gcnt = (unsigned*)(ws + WS_CTL) + CW_GRP + chain * 64;
        att::ml_passA_unit(p, (char*)lds, NCB + b, h, blk);
        group_sync(gcnt, (unsigned)NBLK);
        { const int tid_ = tid_opaque(); constexpr int PER16 = (MDK * MDK + MDK) / 8 / NBLK;
          if (tid_ < 2 * PER16) { const int dir = tid_ / PER16, it = blk * PER16 + tid_ % PER16;
              if (dir == 0) ml_scan_item<0>(p, chain * 2, b, h, it * 8); else ml_scan_item<1>(p, chain * 2 + 1, b, h, it * 8); } }
        att::MlPreC pre; att::ml_passC_preload(p, NCB + b, h, blk, pre);
        group_sync(gcnt, 2u * (unsigned)NBLK);
        att::ml_passC_unit<true, true>(p, (char*)lds, NCB + b, h, blk, pre);
        constexpr int NCX = NCB * MH;
        if (vcu < NCX) { att::ml_passC_unit<false, false>(p, (char*)lds, vcu / MH, vcu % MH, 0, att::MlPreC{}); p0_weights<0x004u>(p, L, vcu, NCX); }
        else if (vcu < 2 * NCX) { const int uc = vcu - NCX; att::ml_passA_unit(p, (char*)lds, uc / MH, uc % MH, 0); phase_conv(p, (char*)lds, 4 * (G - 2 * NCX) + uc, NCX, MTOK / 32); }
        else phase_conv(p, (char*)lds, vcu - 2 * NCX, G - 2 * NCX, 4 * (G - 2 * NCX));
    } else {
    ml_phase_A(p, lds, vcu, G);
    p0_weights<0x004u>(p, L, vcu, G);
    xcd_barrier(bar);
    { WAVE_IDS(); MlScan sc{p}; for (long i = bx * (long)NTHREADS + tid_; i < MlScan::count(); i += (long)G * NTHREADS) sc(i); }
    xcd_barrier(bar);
    ml_phase_C(p, lds, vcu, G);
    phase_conv(p, (char*)lds, vcu, G, MTOK / 32);
    }
    xcd_barrier(bar);
    gemm_call(L, UH, (const bf16_t*)(ws + WB_OUTAB), DM, DM, EpiRes{p.xp, p.xs, (bf16_t*)(ws + WS_Y16), (bf16_t*)(ws + WS_XN), SSQ + 0 * SSQ_STRIDE, modv(p, 0, 0, 2), modv(p, 0, 0, 4), p.n2g, nullptr, nullptr, 1, 0});
    { WAVE_IDS(); constexpr int NU_OUT = (MTOK / 256) * (DM / 256); const int nsec = (G == 256 && NU_OUT > G) ? NU_OUT - G : 0;
      if (bx >= nsec) { const int gw2 = (bx - nsec) * NWAVES + (tid_ >> 6), ngw2 = (G - nsec) * NWAVES;
        sw_job(p, (const bf16_t*)(ws + WB_FFI0), 2 * DFF, 0, 3, SW0, 2 * DFF, 1, gw2, ngw2, lane_);
        phase_mod(p, (char*)lds, 1, bx - nsec, G - nsec);
        p0_weights<0x110u>(p, L, bx - nsec, G - nsec); } }
    xcd_barrier(bar);
    gemm_call(L, XN, (const bf16_t*)(ws + WB_FFI0), 2 * DFF, DM, EpiFfnIn{(bf16_t*)(ws + WS_H), SSQ + 0 * SSQ_STRIDE, SW0});
    { WAVE_IDS(); constexpr int NU_FFI = (MTOK / 256) * (2 * DFF / 256); const int nfull = NU_FFI % G;
      if (nfull == 0 || bx >= nfull) { const int c0 = nfull == 0 ? 0 : nfull; sw_job(p, (const bf16_t*)(ws + WB_INC), CIN, 1, 0, SWC, CIN, 2, (bx - c0) * NWAVES + (tid_ >> 6), (G - c0) * NWAVES, lane_); } }
    xcd_barrier(bar);
    gemm_call_split(L, Hh, (const bf16_t*)(ws + WB_FFO0), DM, DFF, EpiRes{p.xp, p.xs, (bf16_t*)(ws + WS_Y16), (bf16_t*)(ws + WS_XN), SSQ + 1 * SSQ_STRIDE, modv(p, 0, 0, 5), modv(p, 1, 0, 1), p.n1g + DM, modv(p, 0, 0, 4), p.n2g, 0, 0}, (unsigned char*)Y + SLAB_BYTES, SPLITC + 1 * 4096); xcd_barrier(bar);
    gemm_call(L, XN, (const bf16_t*)(ws + WB_INC), CIN, DM, EpiQkv{(bf16_t*)(ws + WS_QRAW), (bf16_t*)(ws + WS_CTXK), (bf16_t*)(ws + WS_LATK), (bf16_t*)(ws + WS_CTXV), (bf16_t*)(ws + WS_LATV), p.out + O_K, p.out + O_V,
                                                                   SSQ + 1 * SSQ_STRIDE, SWC, p.kng, (LAS float*)(L + 132096)});
    if (G == 256) { if (bx >= 224) { { WAVE_IDS(); phase_cachecvt(p, (bx - 224) * NTHREADS + tid_, 32 * NTHREADS); } p0_weights<0x200u>(p, L, bx - 224, 32); } }
    else { { WAVE_IDS(); phase_cachecvt(p, bx * NTHREADS + tid_, G * NTHREADS); } p0_weights<0x200u>(p, L, vcu, G); }
    xcd_barrier(bar);
    { const int tid_ = tid_opaque(), lane_ = tid_ & 63, wv_ = __builtin_amdgcn_readfirstlane(tid_ >> 6); char* T_ = (char*)lds + wv_ * 16384;
      if (G == 256) { const int grp = vcu >> 5, wg = (vcu & 31) * NWAVES + wv_;
          constexpr int NTG = VT8_TL + 4 * NKV * VT8_TC;
          const int part = wg < 128 ? 1 : 2, wt = wg & 127;
          if (wt < VT8_TL) vt8_do(p, grp * VT8_TL + wt, T_, lane_, part);
          else if (wt < NTG) { const int tl = VT8_NL + (grp * 4 * NKV) * VT8_TC + (wt - VT8_TL); if (tl < VT8_NT) vt8_do(p, tl, T_, lane_, part); }
          group_arrive((unsigned*)(ws + WS_CTL) + CW_GRP + (16 + grp) * 64); }
      else { for (int tl = bx * NWAVES + wv_; tl < VT8_NT; tl += G * NWAVES) vt8_do(p, tl, T_, lane_); xcd_barrier(bar); } }
    attn_phase(p, lds, vcu, G, G == 256 ? (unsigned*)(ws + WS_CTL) + CW_GRP + (16 + (vcu >> 5)) * 64 : nullptr, 32u);
    { WAVE_IDS(); constexpr int NUC_ = NCB * NQ * (CSEQ / 256); const int nctx = (G == 256 && NUC_ < G) ? NUC_ : 0;
      if (vcu >= nctx) { p0_weights<0x400u>(p, L, vcu - nctx, G - nctx);
        sw_job(p, (const bf16_t*)(ws + WB_FFI1), 2 * DFF, 1, 3, SW1, 2 * DFF, 1, (vcu - nctx) * NWAVES + (tid_ >> 6), (G - nctx) * NWAVES, lane_); } }
    xcd_barrier(bar);
    gemm_call(L, Ob, (const bf16_t*)(ws + WB_OUTC), DM, DM, EpiRes{p.xp, p.xs, (bf16_t*)(ws + WS_Y16), (bf16_t*)(ws + WS_XN), SSQ + 2 * SSQ_STRIDE, modv(p, 1, 0, 2), modv(p, 1, 0, 4), p.n2g + DM, modv(p, 1, 0, 1), p.n1g + DM, 0, 0});
    xcd_barrier(bar);
    gemm_call(L, XN, (const bf16_t*)(ws + WB_FFI1), 2 * DFF, DM, EpiFfnIn{(bf16_t*)(ws + WS_H), SSQ + 2 * SSQ_STRIDE, SW1}); xcd_barrier(bar);
    gemm_call_split(L, Hh, (const bf16_t*)(ws + WB_FFO1), DM, DFF, EpiRes{p.xp, p.xs, (bf16_t*)(ws + WS_Y16), (bf16_t*)(ws + WS_XN), SSQ + 3 * SSQ_STRIDE, modv(p, 1, 0, 5), modv(p, 1, 0, 1), nullptr, modv(p, 1, 0, 4), p.n2g + DM, 0, 0}, (unsigned char*)Y + SLAB_BYTES, SPLITC + 3 * 4096); xcd_barrier(bar);
    { WAVE_IDS(); phase_final(p, gw_, NGW_, lane_); }
#undef WAVE_IDS
}
static Params make_params(void* const* d_in, void* d_out, void* d_ws) {
    Params p{}; const float** pp = (const float**)&p; for (int i = 0; i < 28; ++i) pp[i] = (const float*)d_in[i];
    p.out = (float*)d_out; p.ws = (unsigned char*)d_ws; return p;
}
extern "C" void kernel_launch(void* const* d_in, const int* in_sizes, int n_in, void* d_out, int out_size, void* d_ws, size_t ws_size, hipStream_t stream) {
    static int grid = 0;
    if (grid == 0) {
        if (n_in != 28 || (size_t)out_size != O_END || ws_size < WS_END || in_sizes[0] != MC * DM || in_sizes[1] != ML * DM) {
            fprintf(stderr, "kernel_launch: shape mismatch n_in %d out %d (want %zu) ws %zu (want %zu)\n", n_in, out_size, (size_t)O_END, ws_size, (size_t)WS_END); grid = -1; return; }
        int dev = 0, cus = 0;
        if (hipGetDevice(&dev) != hipSuccess || hipDeviceGetAttribute(&cus, hipDeviceAttributeMultiprocessorCount, dev) != hipSuccess) { grid = -1; return; }
        if (hipFuncSetAttribute((const void*)mega_fwd, hipFuncAttributeMaxDynamicSharedMemorySize, LDS_BYTES) != hipSuccess) { fprintf(stderr, "hipFuncSetAttribute failed\n"); grid = -1; return; }
        int per_cu = 0; (void)hipOccupancyMaxActiveBlocksPerMultiprocessor(&per_cu, (const void*)mega_fwd, NTHREADS, LDS_BYTES); (void)hipGetLastError();
        if (per_cu < 1) fprintf(stderr, "kernel_launch: occupancy query says %d blocks/CU\n", per_cu);
        grid = cus;
    }
    if (grid < 0) return;
    hipMemsetAsync((char*)d_ws + WS_CTL, 0, CTL_ZERO_BYTES, stream);
    Params p = make_params(d_in, d_out, d_ws);
    hipLaunchKernelGGL(mega_fwd, dim3(grid), dim3(NTHREADS), LDS_BYTES, stream, p);
}
```
